# Optimizing an MI355X kernel written in HIP

```python
import jax, jax.numpy as jnp
from jax import lax
import numpy as np

D_MODEL = 1024
BATCH = 2
SEQ = 8192
DEPTH = 2

CTX_LEN = 256
GRID_W = 64
ROPE_THETA = 10000.0
NORM_EPS = 1e-6

RET_HEADS = 4
RET_DK = 32
RET_DV = 64
RET_CHUNK = 128
RET_WIDTH = RET_HEADS * RET_DV
MLA_HEADS = 8
MLA_Q_RANK = 384
MLA_KV_RANK = 256
MLA_NOPE = 64
MLA_ROPE = 32
MLA_DV = 64
MLA_SCALE = (MLA_NOPE + MLA_ROPE) ** -0.5
ATTN_BLOCK = 128
MLA_WIDTH = MLA_HEADS * MLA_DV
POOL_WINDOWS = (2, 4, 8, 16)
POOL_GROUP = 64
POOL_WIDTH = 4 * POOL_GROUP

MIX_WIDTH = RET_WIDTH + MLA_WIDTH + POOL_WIDTH
IN_SECTIONS = (RET_HEADS * RET_DK, RET_HEADS * RET_DK, RET_WIDTH, RET_WIDTH,
               MLA_Q_RANK, MLA_KV_RANK, MLA_ROPE, POOL_WIDTH)
IN_WIDTH = 2 * RET_HEADS * RET_DK + 2 * RET_WIDTH + MLA_Q_RANK + MLA_KV_RANK + MLA_ROPE + POOL_WIDTH

D_FF = 2816
CONV_WIDTH = 3

kernel_name = 'hybrid_ret_mla_pool_prefix_dit'


def rms_norm(x, g):
    xf = x.astype(jnp.float32)
    y = xf * lax.rsqrt(jnp.mean(xf * xf, axis=-1, keepdims=True) + NORM_EPS)
    return (y * g.astype(jnp.float32)).astype(x.dtype)


def modulate(h, shift, scale):
    return h * (1.0 + scale) + shift


def split_in_proj(p):
    offs = []
    acc = 0
    for s in IN_SECTIONS[:-1]:
        acc += s
        offs.append(acc)
    return jnp.split(p, offs, axis=-1)


def split_heads(t, n_heads):
    B, T, _ = t.shape
    return t.reshape(B, T, n_heads, -1).transpose(0, 2, 1, 3)


def merge_heads(t):
    B, H, T, d = t.shape
    return t.transpose(0, 2, 1, 3).reshape(B, T, H * d)


def axial_rope_tables(rows, rot_dim):
    row = jnp.repeat(jnp.arange(rows, dtype=jnp.float32), GRID_W)
    col = jnp.tile(jnp.arange(GRID_W, dtype=jnp.float32), rows)
    n_freq = rot_dim // 4
    inv = ROPE_THETA ** (-jnp.arange(n_freq, dtype=jnp.float32) / n_freq)
    ang = jnp.concatenate([row[:, None] * inv, col[:, None] * inv], axis=-1)
    return jnp.cos(ang), jnp.sin(ang)


def apply_rope(x, cos, sin):
    xf = x.astype(jnp.float32)
    h = xf.shape[-1] // 2
    x1, x2 = xf[..., :h], xf[..., h:]
    return jnp.concatenate([x1 * cos - x2 * sin, x2 * cos + x1 * sin], axis=-1).astype(x.dtype)


def retention_chunkwise(q, k, v, log_g, s0, include_diag):
    B, H, T, _ = q.shape
    dv = v.shape[-1]
    n = T // RET_CHUNK
    idx = jnp.arange(RET_CHUNK, dtype=jnp.float32)
    diff = idx[:, None] - idx[None, :]
    mask = diff >= (0.0 if include_diag else 1.0)
    dmat = jnp.where(mask, jnp.exp(log_g[:, None, None] * jnp.maximum(diff, 0.0)), 0.0)
    q_dec = jnp.exp(log_g[:, None] * (idx + 1.0))[:, :, None]
    k_dec = jnp.exp(log_g[:, None] * (RET_CHUNK - 1.0 - idx))[:, :, None]
    c_dec = jnp.exp(log_g * RET_CHUNK)[:, None, None]

    def chunks(t):
        return jnp.moveaxis(t.reshape(B, H, n, RET_CHUNK, t.shape[-1]), 2, 0)

    def step(s, inp):
        qi, ki, vi = inp
        a = jnp.einsum('bhqd,bhkd->bhqk', qi, ki) * dmat
        o = jnp.einsum('bhqk,bhkv->bhqv', a, vi) + jnp.einsum('bhqd,bhdv->bhqv', qi * q_dec, s)
        s = s * c_dec + jnp.einsum('bhkd,bhkv->bhdv', ki * k_dec, vi)
        return s, o

    _, o = lax.scan(step, s0, (chunks(q), chunks(k), chunks(v)))
    return jnp.moveaxis(o, 0, 2).reshape(B, H, T, dv)


def retention_mixer(lat, ctx, decay_f, decay_b, cos, sin, with_ctx_out):
    log_gf = jax.nn.log_sigmoid(decay_f.astype(jnp.float32))
    log_gb = jax.nn.log_sigmoid(decay_b.astype(jnp.float32))

    def ret_q(q, rotate):
        q = split_heads(q, RET_HEADS).astype(jnp.float32)
        return apply_rope(q, cos, sin) if rotate else q

    def ret_kv(k, v, rotate):
        k = split_heads(k, RET_HEADS).astype(jnp.float32) * (RET_DK ** -0.5)
        if rotate:
            k = apply_rope(k, cos, sin)
        return k, split_heads(v, RET_HEADS).astype(jnp.float32)

    def bidir(q, k, v, s_f, s_b):
        fwd = retention_chunkwise(q, k, v, log_gf, s_f, True)
        bwd = retention_chunkwise(jnp.flip(q, 2), jnp.flip(k, 2), jnp.flip(v, 2), log_gb, s_b, False)
        return fwd + jnp.flip(bwd, 2)

    def finish(o, g):
        o = o * lax.rsqrt(jnp.mean(o * o, axis=-1, keepdims=True) + NORM_EPS)
        return (merge_heads(o) * jax.nn.silu(g.astype(jnp.float32))).astype(g.dtype)

    kc, vc = ret_kv(ctx[1], ctx[2], False)
    tc = kc.shape[2]
    m = jnp.arange(tc, dtype=jnp.float32)
    s_f = jnp.einsum('bhmd,bhme->bhde', kc * jnp.exp(log_gf[:, None] * (tc - 1.0 - m))[:, :, None], vc)
    s_b = jnp.einsum('bhmd,bhme->bhde', kc * jnp.exp(log_gb[:, None] * m)[:, :, None], vc)

    ql = ret_q(lat[0], True)
    kl, vl = ret_kv(lat[1], lat[2], True)
    y_lat = finish(bidir(ql, kl, vl, s_f, s_b), lat[3])
    y_ctx = None
    if with_ctx_out:
        z = jnp.zeros_like(s_f)
        y_ctx = finish(bidir(ret_q(ctx[0], False), kc, vc, z, z), ctx[3])
    return y_lat, y_ctx


def mla_attend(qn, qr, kn, kr, v):
    s = jnp.einsum('bhqd,bhkd->bhqk', qn, kn) + jnp.einsum('bhqr,bkr->bhqk', qr, kr)
    p = jax.nn.softmax(s.astype(jnp.float32) * MLA_SCALE, axis=-1)
    return jnp.einsum('bhqk,bhkd->bhqd', p.astype(v.dtype), v)


def mla_mixer(lat, ctx, q_norm_g, w_uq, kv_norm_g, w_ukv, cos, sin, with_ctx_out):
    def queries(cq, rotate):
        B, T, _ = cq.shape
        q = (rms_norm(cq, q_norm_g) @ w_uq).reshape(B, T, MLA_HEADS, MLA_NOPE + MLA_ROPE).transpose(0, 2, 1, 3)
        qn, qr = q[..., :MLA_NOPE], q[..., MLA_NOPE:]
        return qn, (apply_rope(qr, cos, sin) if rotate else qr)

    def keys_values(ckv, kr, rotate):
        B, T, _ = ckv.shape
        kv = (rms_norm(ckv, kv_norm_g) @ w_ukv).reshape(B, T, MLA_HEADS, MLA_NOPE + MLA_DV).transpose(0, 2, 1, 3)
        kr = apply_rope(kr, cos, sin) if rotate else kr
        return kv[..., :MLA_NOPE], kr, kv[..., MLA_NOPE:]

    kn_c, kr_c, v_c = keys_values(ctx[1], ctx[2], False)
    kn_l, kr_l, v_l = keys_values(lat[1], lat[2], True)
    kn = jnp.concatenate([kn_c, kn_l], axis=2)
    kr = jnp.concatenate([kr_c, kr_l], axis=1)
    v = jnp.concatenate([v_c, v_l], axis=2)

    qn, qr = queries(lat[0], True)
    B, H, T, _ = qn.shape
    nb = T // ATTN_BLOCK

    def blocks(t):
        return jnp.moveaxis(t.reshape(B, H, nb, ATTN_BLOCK, t.shape[-1]), 2, 0)

    o = lax.map(lambda qb: mla_attend(qb[0], qb[1], kn, kr, v), (blocks(qn), blocks(qr)))
    y_lat = merge_heads(jnp.moveaxis(o, 0, 2).reshape(B, H, T, MLA_DV))
    y_ctx = None
    if with_ctx_out:
        qn_c, qr_c = queries(ctx[0], False)
        y_ctx = merge_heads(mla_attend(qn_c, qr_c, kn_c, kr_c, v_c))
    return y_lat, y_ctx


def pool_mixer(x, pool_w, pool_scale):
    B, T, _ = x.shape
    xf = x.astype(jnp.float32)
    cs = jnp.pad(jnp.cumsum(xf, axis=1), ((0, 0), (1, 0), (0, 0)))
    t = jnp.arange(T)
    parts = []
    for gi, w in enumerate(POOL_WINDOWS):
        sl = slice(gi * POOL_GROUP, (gi + 1) * POOL_GROUP)
        lo = jnp.clip(t - w // 2, 0, T)
        hi = jnp.clip(t + w - w // 2, 0, T)
        csg = cs[:, :, sl]
        mean = (csg[:, hi] - csg[:, lo]) / (hi - lo).astype(jnp.float32)[None, :, None]
        parts.append(mean - xf[:, :, sl])
    d = jnp.stack(parts, axis=2)
    y = jnp.einsum('btgc,gcd->btgd', d, pool_w.astype(jnp.float32)).reshape(B, T, POOL_WIDTH)
    return (y * pool_scale.astype(jnp.float32)).astype(x.dtype)


def conv_ffn(h, w_up, conv_w, conv_b, w_down):
    u = h @ w_up
    up = jnp.pad(u, ((0, 0), (1, 1), (0, 0)))
    u = up[:, :-2] * conv_w[0] + up[:, 1:-1] * conv_w[1] + up[:, 2:] * conv_w[2] + conv_b
    a, b = jnp.split(u, 2, axis=-1)
    return (jax.nn.silu(a) * b) @ w_down


def trunk_layer(x, xc, mod, mod_c, norm1_g, w_in, ret_decay_f, ret_decay_b, mla_q_norm_g, w_uq,
                mla_kv_norm_g, w_ukv, pool_w, pool_scale, w_out, norm2_g, w_up, conv_w, conv_b, w_down,
                cos_r, sin_r, cos_m, sin_m, with_ctx_out):
    sh1, sc1, g1, sh2, sc2, g2 = jnp.split(mod, 6, axis=-1)
    sh1c, sc1c, g1c, sh2c, sc2c, g2c = jnp.split(mod_c, 6, axis=-1)
    p = split_in_proj(modulate(rms_norm(x, norm1_g), sh1, sc1) @ w_in)
    pc = split_in_proj(modulate(rms_norm(xc, norm1_g), sh1c, sc1c) @ w_in)

    y_ret, y_ret_c = retention_mixer((p[0], p[1], p[2], p[3]), (pc[0], pc[1], pc[2], pc[3]),
                                     ret_decay_f, ret_decay_b, cos_r, sin_r, with_ctx_out)
    y_mla, y_mla_c = mla_mixer((p[4], p[5], p[6]), (pc[4], pc[5], pc[6]), mla_q_norm_g, w_uq,
                               mla_kv_norm_g, w_ukv, cos_m, sin_m, with_ctx_out)
    y_pool = pool_mixer(p[7], pool_w, pool_scale)

    x = x + g1 * (jnp.concatenate([y_ret, y_mla, y_pool], axis=-1) @ w_out)
    x = x + g2 * conv_ffn(modulate(rms_norm(x, norm2_g), sh2, sc2), w_up, conv_w, conv_b, w_down)
    if with_ctx_out:
        y_pool_c = pool_mixer(pc[7], pool_w, pool_scale)
        xc = xc + g1c * (jnp.concatenate([y_ret_c, y_mla_c, y_pool_c], axis=-1) @ w_out)
        xc = xc + g2c * conv_ffn(modulate(rms_norm(xc, norm2_g), sh2c, sc2c), w_up, conv_w, conv_b, w_down)
    return x, xc


def setup_inputs(seed: int = 0) -> dict:
    key = jax.random.key(seed)
    ks = jax.random.split(key, 24)
    f32 = jnp.float32
    L = DEPTH

    def nrm(k, shape, scale):
        return jax.random.normal(k, shape, f32) * scale

    def gain(k, shape):
        return 1.0 + 0.02 * jax.random.normal(k, shape, f32)

    heads = jnp.arange(RET_HEADS, dtype=f32)
    decay_logit = jnp.log(jnp.exp2(5.0 + heads) - 1.0)
    return {
        'x': nrm(ks[0], (BATCH, SEQ, D_MODEL), 1.0),
        'c': nrm(ks[1], (BATCH, D_MODEL), 1.0),
        'ctx': nrm(ks[2], (BATCH, CTX_LEN, D_MODEL), 1.0),
        'c_ctx': nrm(ks[3], (D_MODEL,), 1.0),
        'w_mod': nrm(ks[4], (L, D_MODEL, 6 * D_MODEL), 0.5 * D_MODEL ** -0.5),
        'b_mod': nrm(ks[5], (L, 6 * D_MODEL), 0.01),
        'norm1_g': gain(ks[6], (L, D_MODEL)),
        'w_in': nrm(ks[7], (L, D_MODEL, IN_WIDTH), D_MODEL ** -0.5),
        'ret_decay_f': decay_logit + nrm(ks[8], (L, RET_HEADS), 0.1),
        'ret_decay_b': decay_logit + nrm(ks[9], (L, RET_HEADS), 0.1),
        'mla_q_norm_g': gain(ks[10], (L, MLA_Q_RANK)),
        'w_uq': nrm(ks[11], (L, MLA_Q_RANK, MLA_HEADS * (MLA_NOPE + MLA_ROPE)), MLA_Q_RANK ** -0.5),
        'mla_kv_norm_g': gain(ks[12], (L, MLA_KV_RANK)),
        'w_ukv': nrm(ks[13], (L, MLA_KV_RANK, MLA_HEADS * (MLA_NOPE + MLA_DV)), MLA_KV_RANK ** -0.5),
        'pool_w': nrm(ks[14], (L, len(POOL_WINDOWS), POOL_GROUP, POOL_GROUP), POOL_GROUP ** -0.5),
        'pool_scale': gain(ks[15], (L, POOL_WIDTH)),
        'w_out': nrm(ks[16], (L, MIX_WIDTH, D_MODEL), MIX_WIDTH ** -0.5),
        'norm2_g': gain(ks[17], (L, D_MODEL)),
        'w_up': nrm(ks[18], (L, D_MODEL, 2 * D_FF), D_MODEL ** -0.5),
        'conv_w': nrm(ks[19], (L, CONV_WIDTH, 2 * D_FF), CONV_WIDTH ** -0.5),
        'conv_b': nrm(ks[20], (L, 2 * D_FF), 0.01),
        'w_down': nrm(ks[21], (L, D_FF, D_MODEL), D_FF ** -0.5),
        'final_norm_g': gain(ks[22], (D_MODEL,)),
    }


def reference(x, c, ctx, c_ctx, w_mod, b_mod, norm1_g, w_in, ret_decay_f, ret_decay_b, mla_q_norm_g, w_uq,
              mla_kv_norm_g, w_ukv, pool_w, pool_scale, w_out, norm2_g, w_up, conv_w, conv_b, w_down,
              final_norm_g):
    n_tokens = x.shape[1]
    ROWS = n_tokens // GRID_W
    cos_r, sin_r = axial_rope_tables(ROWS, RET_DK)
    cos_m, sin_m = axial_rope_tables(ROWS, MLA_ROPE)
    sc = jax.nn.silu(c)
    sc_ctx = jax.nn.silu(c_ctx)
    xc = ctx
    for l in range(DEPTH):
        mod = (sc @ w_mod[l] + b_mod[l])[:, None, :]
        mod_c = (sc_ctx @ w_mod[l] + b_mod[l])[None, None, :]
        x, xc = trunk_layer(x, xc, mod, mod_c, norm1_g[l], w_in[l], ret_decay_f[l], ret_decay_b[l],
                            mla_q_norm_g[l], w_uq[l], mla_kv_norm_g[l], w_ukv[l], pool_w[l], pool_scale[l],
                            w_out[l], norm2_g[l], w_up[l], conv_w[l], conv_b[l], w_down[l],
                            cos_r, sin_r, cos_m, sin_m, l < DEPTH - 1)
    return rms_norm(x, final_norm_g)
```

```cpp
#include <hip/hip_runtime.h>
#include <hip/hip_cooperative_groups.h>
#include <cstdio>
#include <cstdint>
namespace cg = cooperative_groups;

#ifndef MK_MULTI
#define MK_MULTI 0
#endif

namespace pg8 {
#define PG8_LAS __attribute__((address_space(3)))
typedef unsigned short bf16_t;
typedef short bf16x8 __attribute__((ext_vector_type(8)));
typedef float f32x4 __attribute__((ext_vector_type(4)));
typedef unsigned u32x4 __attribute__((ext_vector_type(4)));
constexpr int BM = 256, BK = 64, HALF = 128, HTB = HALF * BK * 2  , STAGE_BYTES = 8 * HTB, NXCD = 8, WGM = 8;

__host__ __device__ __forceinline__ int lds_byte(int r, int c) { const int st = (r >> 4) * 2 + (c >> 5), rr = r & 15, cc = c & 31, ob = rr * 64 + cc * 2; return st * 1024 + (ob ^ (((ob >> 9) & 1) << 5)); }
__host__ __device__ __forceinline__ void stage_rc(int b, int& R, int& C) { const int st = b / 1024, sb = b % 1024, swz = sb ^ (((sb >> 9) & 1) << 5); R = (st >> 1) * 16 + swz / 64; C = (st & 1) * 32 + (swz % 64) / 2; }
__host__ __device__ __forceinline__ int perm32(int rho) { const int n = rho >> 4, i = rho & 15; return 8 * (i >> 2) + 4 * n + (i & 3); }

struct Unit { int pm, pn; };
struct Gemm { const bf16_t* A; const bf16_t* Bt; int M, N, K, lda, ldb; };

struct StaticOrder {
    int nM, nN, nwg, G, c;
    __host__ __device__ void init(int M, int N, int G_, int c_) { nM = M / BM; nN = N / BM; nwg = nM * nN; G = G_; c = c_; }
    __host__ __device__ bool next(int i, Unit& u) const {
        const long L = (long)i * G + c; if (L >= nwg) return false;
        int wgid = (int)L; { const int q = nwg / NXCD, r = nwg % NXCD, xcd = wgid % NXCD, off = wgid / NXCD; wgid = (xcd < r ? xcd * (q + 1) : r * (q + 1) + (xcd - r) * q) + off; }
        const int nig = WGM * nN, gid = wgid / nig, fm = gid * WGM, gsz = (nM - fm) < WGM ? (nM - fm) : WGM;
        u.pm = fm + ((wgid % nig) % gsz); u.pn = (wgid % nig) / gsz; return true;
    }
    __device__ __forceinline__ void a_ready(const Unit&) const {}
    __device__ __forceinline__ void done(const Unit&) const {}
};

__device__ __forceinline__ unsigned cvt_pk_bf16(float lo, float hi) { unsigned r; asm volatile("v_cvt_pk_bf16_f32 %0, %1, %2" : "=v"(r) : "v"(lo), "v"(hi)); return r; }

struct EpiStore {
    static constexpr bool PERM = true, AFTER_DRAIN = false;
    bf16_t* O; int ldc; int ncols; float scale;
    __device__ __forceinline__ void operator()(const f32x4 (&acc)[2][2][4][2], const Unit& u, int wr, int wc, int fr, int fq) const {
        const int row0 = u.pm * BM + wr * 64 + fr; const int col0 = u.pn * BM + wc * 32 + 8 * fq;
#pragma unroll
        for (int ai = 0; ai < 2; ++ai)
#pragma unroll
            for (int m = 0; m < 4; ++m) { bf16_t* rowp = O + (size_t)(row0 + ai * HALF + m * 16) * ldc + col0;
#pragma unroll
                for (int bj = 0; bj < 2; ++bj) { if (col0 + bj * HALF < ncols) {
                    f32x4 v0 = acc[ai][bj][m][0] * scale, v1 = acc[ai][bj][m][1] * scale;
                    u32x4 w; w.x = cvt_pk_bf16(v0[0], v0[1]); w.y = cvt_pk_bf16(v0[2], v0[3]); w.z = cvt_pk_bf16(v1[0], v1[1]); w.w = cvt_pk_bf16(v1[2], v1[3]);
                    *(u32x4*)(rowp + bj * HALF) = w; } } }
    }
};
struct EpiResid {
    static constexpr bool PERM = false, AFTER_DRAIN = false;
    float* X; const float* gate; int row_tile0;
    __device__ __forceinline__ void operator()(const f32x4 (&acc)[2][2][4][2], const Unit& u, int wr, int wc, int fr, int fq) const {
        const int tpm = u.pm + row_tile0; const int bb = tpm / 33, jj = tpm - bb * 33; const float* gv = gate + (jj == 0 ? 2 : bb) * 6144;
        const int col0 = u.pn * BM + wc * 32 + 4 * fq;
#pragma unroll
        for (int ai = 0; ai < 2; ++ai)
#pragma unroll
            for (int m = 0; m < 4; ++m) { float* rowp = X + (size_t)(tpm * BM + ai * HALF + wr * 64 + m * 16 + fr) * 1024 + col0;
#pragma unroll
                for (int bj = 0; bj < 2; ++bj) {
#pragma unroll
                    for (int n = 0; n < 2; ++n) { f32x4* q = (f32x4*)(rowp + bj * HALF + n * 16); const f32x4 gq = *(const f32x4*)(gv + col0 + bj * HALF + n * 16); f32x4 xv = *q; xv = xv + gq * acc[ai][bj][m][n]; *q = xv; }
                    asm volatile("" ::: "memory"); } }
    }
};

template <class Epi, class Sched, bool ALIGN_EPI = false, bool SP2 = false>
__device__ __forceinline__ void gemm_phase(PG8_LAS unsigned char* lds, const Gemm g, const Sched& S, const Epi& E) {
    int tid = threadIdx.x; asm volatile("" : "+v"(tid));
    const int wid = __builtin_amdgcn_readfirstlane(tid >> 6), lane = tid & 63, wr = wid >> 2, wc = wid & 3, fr = lane & 15, fq = lane >> 4;
    int K = g.K; asm volatile("" : "+s"(K));
    const int nt = K / BK;
    unsigned voffA[2], voffB[2];
#pragma unroll
    for (int i = 0; i < 2; ++i) { int R, C; stage_rc(tid * 16 + i * 8192, R, C); const int Rb = Epi::PERM ? ((R & ~31) + perm32(R & 31)) : R;
        voffA[i] = (unsigned)(R * g.lda + C) * 2u; voffB[i] = (unsigned)(Rb * g.ldb + C) * 2u; }
    const size_t kstep = (size_t)(BK * 2);
    const size_t hstepA = (size_t)HALF * g.lda * 2, hstepB = (size_t)HALF * g.ldb * 2;
    const size_t tstepA = 2 * hstepA, tstepB = 2 * hstepB;
    const unsigned ldsw = (unsigned)wid * 1024u;
    const int aoff = lds_byte(wr * 64 + fr, fq * 8), boff = lds_byte(wc * 32 + fr, fq * 8);
#define PG8_SA(b, h) (((b) * 2 + (h)) * HTB)
#define PG8_SB(b, h) ((4 + (b) * 2 + (h)) * HTB)
#define PG8_STAGE(bufoff, gbase, voff) do { _Pragma("unroll") for (int _i = 0; _i < 2; ++_i) \
        __builtin_amdgcn_global_load_lds((const unsigned*)((const char*)(gbase) + (voff)[_i]), (PG8_LAS unsigned*)(lds + (bufoff) + ldsw + _i * 8192), 16, 0, 0); } while (0)
#define PG8_LDA(dst, b, h) do { _Pragma("unroll") for (int m = 0; m < 4; ++m) _Pragma("unroll") for (int k = 0; k < 2; ++k) dst[m][k] = *(const PG8_LAS bf16x8*)(lds + PG8_SA(b, h) + aoff + m * 2048 + k * 1024); } while (0)
#define PG8_LDB(dst, b, h) do { _Pragma("unroll") for (int n = 0; n < 2; ++n) _Pragma("unroll") for (int k = 0; k < 2; ++k) dst[n][k] = *(const PG8_LAS bf16x8*)(lds + PG8_SB(b, h) + boff + n * 2048 + k * 1024); } while (0)
#define PG8_MMA(ai, bj, At, Bt) do { __builtin_amdgcn_s_setprio(1); _Pragma("unroll") for (int m = 0; m < 4; ++m) _Pragma("unroll") for (int n = 0; n < 2; ++n) _Pragma("unroll") for (int k = 0; k < 2; ++k) \
        acc[ai][bj][m][n] = __builtin_amdgcn_mfma_f32_16x16x32_bf16(Bt[n][k], At[m][k], acc[ai][bj][m][n], 0, 0, 0); __builtin_amdgcn_s_setprio(0); } while (0)
#define PG8_WAIT_V(n) asm volatile("s_waitcnt vmcnt(" #n ")" ::: "memory")
#define PG8_WAIT_L(n) asm volatile("s_waitcnt lgkmcnt(" #n ")" ::: "memory")
#define PG8_BAR __builtin_amdgcn_s_barrier()
#define PG8_SCHED __builtin_amdgcn_sched_barrier(0)
    Unit cur, nxt; int ui = 0;
    if (!S.next(0, cur)) return;
    f32x4 acc[2][2][4][2];
#pragma unroll
    for (int a = 0; a < 2; ++a)
#pragma unroll
        for (int b = 0; b < 2; ++b)
#pragma unroll
            for (int m = 0; m < 4; ++m)
#pragma unroll
                for (int n = 0; n < 2; ++n) acc[a][b][m][n] = (f32x4){0.f, 0.f, 0.f, 0.f};
    bf16x8 At[4][2], B0[2][2], B1[2][2];
    const char* cA = (const char*)g.A + (size_t)cur.pm * tstepA; const char* cB = (const char*)g.Bt + (size_t)cur.pn * tstepB;
    S.a_ready(cur);
    if constexpr (SP2) {
        PG8_STAGE(PG8_SB(0, 0), cB, voffB); PG8_STAGE(PG8_SB(0, 1), cB + hstepB, voffB); PG8_STAGE(PG8_SA(0, 0), cA, voffA); PG8_STAGE(PG8_SA(0, 1), cA + hstepA, voffA);
        if (wr == 1) PG8_BAR;
        PG8_WAIT_V(2); PG8_BAR;
        PG8_STAGE(PG8_SB(1, 0), cB + kstep, voffB); PG8_STAGE(PG8_SA(1, 0), cA + kstep, voffA); PG8_STAGE(PG8_SB(1, 1), cB + hstepB + kstep, voffB);
        PG8_WAIT_V(6); PG8_BAR;
    } else {
        PG8_STAGE(PG8_SB(0, 0), cB, voffB); PG8_STAGE(PG8_SA(0, 0), cA, voffA); PG8_STAGE(PG8_SB(0, 1), cB + hstepB, voffB); PG8_STAGE(PG8_SA(0, 1), cA + hstepA, voffA);
        if (wr == 1) PG8_BAR;
        PG8_WAIT_V(4); PG8_BAR;
        PG8_STAGE(PG8_SB(1, 0), cB + kstep, voffB); PG8_STAGE(PG8_SA(1, 0), cA + kstep, voffA); PG8_STAGE(PG8_SB(1, 1), cB + hstepB + kstep, voffB);
        PG8_WAIT_V(6); PG8_BAR;
    }
    for (;;) {
        const bool has_next = S.next(ui + 1, nxt);
        const char* nA = has_next ? (const char*)g.A + (size_t)nxt.pm * tstepA : cA; const char* nB = has_next ? (const char*)g.Bt + (size_t)nxt.pn * tstepB : cB;
        for (int t = 0; t < nt; t += 2) {
            const bool last = (t == nt - 2);
            const char* a1 = cA + (size_t)(t + 1) * kstep;
            const char* a2 = last ? nA : cA + (size_t)(t + 2) * kstep; const char* b2 = last ? nB : cB + (size_t)(t + 2) * kstep;
            const char* a3 = a2 + kstep; const char* b3 = b2 + kstep;
            if (last && has_next) S.a_ready(nxt);
            if constexpr (SP2) {
            PG8_LDB(B0, 0, 0); PG8_LDB(B1, 0, 1); PG8_SCHED; PG8_LDA(At, 0, 0); PG8_STAGE(PG8_SA(1, 1), a1 + hstepA, voffA);
            PG8_WAIT_V(8); PG8_WAIT_L(0); PG8_BAR; PG8_MMA(0, 0, At, B0); PG8_MMA(0, 1, At, B1); PG8_BAR; PG8_SCHED;
            PG8_LDA(At, 0, 1); PG8_STAGE(PG8_SB(0, 0), b2, voffB); PG8_STAGE(PG8_SB(0, 1), b2 + hstepB, voffB); PG8_STAGE(PG8_SA(0, 0), a2, voffA);
            PG8_WAIT_V(8); PG8_WAIT_L(0); PG8_BAR; PG8_MMA(1, 0, At, B0); PG8_MMA(1, 1, At, B1); PG8_BAR; PG8_SCHED;
            PG8_LDB(B0, 1, 0); PG8_LDB(B1, 1, 1); PG8_SCHED; PG8_LDA(At, 1, 0); PG8_STAGE(PG8_SA(0, 1), a2 + hstepA, voffA);
            PG8_WAIT_V(8); PG8_WAIT_L(0); PG8_BAR; PG8_MMA(0, 0, At, B0); PG8_MMA(0, 1, At, B1); PG8_BAR; PG8_SCHED;
            PG8_LDA(At, 1, 1); PG8_STAGE(PG8_SB(1, 0), b3, voffB); PG8_STAGE(PG8_SB(1, 1), b3 + hstepB, voffB); PG8_STAGE(PG8_SA(1, 0), a3, voffA);
            PG8_WAIT_V(8); PG8_WAIT_L(0); PG8_BAR; PG8_MMA(1, 0, At, B0); PG8_MMA(1, 1, At, B1); PG8_BAR; PG8_SCHED;
            } else {
            PG8_LDB(B0, 0, 0); PG8_SCHED; PG8_LDA(At, 0, 0); PG8_STAGE(PG8_SA(1, 1), a1 + hstepA, voffA);
            PG8_WAIT_L(8); PG8_BAR; PG8_WAIT_L(0); PG8_MMA(0, 0, At, B0); PG8_BAR; PG8_SCHED;
            PG8_LDB(B1, 0, 1); PG8_STAGE(PG8_SB(0, 0), b2, voffB);
            PG8_BAR; PG8_WAIT_L(0); PG8_MMA(0, 1, At, B1); PG8_BAR;
            PG8_LDA(At, 0, 1); PG8_STAGE(PG8_SA(0, 0), a2, voffA);
            PG8_BAR; PG8_WAIT_L(0); PG8_MMA(1, 0, At, B0); PG8_BAR; PG8_SCHED;
            PG8_STAGE(PG8_SB(0, 1), b2 + hstepB, voffB);
            PG8_WAIT_V(6); PG8_BAR; PG8_MMA(1, 1, At, B1); PG8_BAR;
            PG8_LDB(B0, 1, 0); PG8_SCHED; PG8_LDA(At, 1, 0); PG8_STAGE(PG8_SA(0, 1), a2 + hstepA, voffA);
            PG8_WAIT_L(8); PG8_BAR; PG8_WAIT_L(0); PG8_MMA(0, 0, At, B0); PG8_BAR; PG8_SCHED;
            PG8_LDB(B1, 1, 1); PG8_STAGE(PG8_SB(1, 0), b3, voffB);
            PG8_BAR; PG8_WAIT_L(0); PG8_MMA(0, 1, At, B1); PG8_BAR;
            PG8_LDA(At, 1, 1); PG8_STAGE(PG8_SA(1, 0), a3, voffA);
            PG8_BAR; PG8_WAIT_L(0); PG8_MMA(1, 0, At, B0); PG8_BAR; PG8_SCHED;
            PG8_STAGE(PG8_SB(1, 1), b3 + hstepB, voffB);
            PG8_WAIT_V(6); PG8_BAR; PG8_MMA(1, 1, At, B1); PG8_BAR;
            }
        }
        if constexpr (ALIGN_EPI) { if (wr == 0) PG8_BAR; }
        if constexpr (!Epi::AFTER_DRAIN) { E(acc, cur, wr, wc, fr, fq); S.done(cur); }
        if (!has_next) break;
#pragma unroll
        for (int a = 0; a < 2; ++a)
#pragma unroll
            for (int b = 0; b < 2; ++b)
#pragma unroll
                for (int m = 0; m < 4; ++m)
#pragma unroll
                    for (int n = 0; n < 2; ++n) acc[a][b][m][n] = (f32x4){0.f, 0.f, 0.f, 0.f};
        cur = nxt; cA = nA; cB = nB; ++ui;
        if constexpr (ALIGN_EPI) { if (wr == 1) PG8_BAR; }
    }
    PG8_WAIT_V(0);
    if constexpr (!ALIGN_EPI) { if (wr == 0) PG8_BAR; }
    PG8_BAR;
    if constexpr (Epi::AFTER_DRAIN) { E.fused(acc, cur, wr, wc, fr, fq, lds, wid, lane); S.done(cur); }
#undef PG8_SA
#undef PG8_SB
#undef PG8_STAGE
#undef PG8_LDA
#undef PG8_LDB
#undef PG8_MMA
#undef PG8_WAIT_V
#undef PG8_WAIT_L
#undef PG8_BAR
#undef PG8_SCHED
}
}

#define DEV __device__ __forceinline__
#define LAS __attribute__((address_space(3)))
typedef unsigned short bf16_t;
typedef short bf16x8 __attribute__((ext_vector_type(8)));
typedef float f32x4 __attribute__((ext_vector_type(4)));
typedef float f32x2 __attribute__((ext_vector_type(2)));
typedef float f32x16 __attribute__((ext_vector_type(16)));
typedef unsigned u32x4 __attribute__((ext_vector_type(4)));
typedef unsigned u32x2 __attribute__((ext_vector_type(2)));

constexpr int R = 16896, RB = 8448, NCTX = 256, TL = 8192, DM = 1024, INW = 1696, DFF = 2816, HFF = 1408;
constexpr int NWG_T = 512;
constexpr float EPS = 1e-6f;
constexpr int LDS_BYTES = 147456;
constexpr size_t OFF_X = 0, OFF_HN = 69206016, OFF_W = 103809024, OFF_MOD = 152174592, OFF_ROPE = 152436736, OFF_OV = 153485312;
constexpr size_t OV_Q = 0, OV_KN = 25952256, OV_VT = 43253760, OV_SLOC = 60555264, OV_SIN = 69206016, OV_U = 0;
constexpr size_t WS_NEED = OFF_OV + 95158272;
constexpr size_t W_IN = 0, W_UQ = 1835008, W_KN = 2129920, W_V = 2260992, W_OUT = 2392064, W_UP = 3440640, W_DN = 9207808, W_LAYER = 12091392;

struct Params {
    const float *x, *c, *ctx, *c_ctx, *w_mod, *b_mod, *norm1_g, *w_in, *ret_decay_f, *ret_decay_b, *mla_q_norm_g, *w_uq, *mla_kv_norm_g, *w_ukv,
        *pool_w, *pool_scale, *w_out, *norm2_g, *w_up, *conv_w, *conv_b, *w_down, *final_norm_g;
    float* out; unsigned char* ws; int ph_lo, ph_hi;
};

DEV int otid() { int t = threadIdx.x; asm volatile("" : "+v"(t)); return t; }
DEV float bf2f(unsigned short x) { return __uint_as_float((unsigned)x << 16); }
DEV unsigned f2bf(float f) { unsigned u = __float_as_uint(f); return (u + 0x7fffu + ((u >> 16) & 1u)) >> 16; }
DEV unsigned pk2(float lo, float hi) { return f2bf(lo) | (f2bf(hi) << 16); }
DEV float wave_sum(float v) {
#pragma unroll
    for (int o = 1; o < 64; o <<= 1) v += __shfl_xor(v, o);
    return v;
}
DEV float siluf(float x) { return x / (1.0f + __expf(-x)); }
DEV int crow(int r, int hi) { return (r & 3) + 8 * (r >> 2) + 4 * hi; }
DEV bf16x8 pack8(float a0, float a1, float a2, float a3, float a4, float a5, float a6, float a7) {
    u32x4 w; w.x = pg8::cvt_pk_bf16(a0, a1); w.y = pg8::cvt_pk_bf16(a2, a3); w.z = pg8::cvt_pk_bf16(a4, a5); w.w = pg8::cvt_pk_bf16(a6, a7);
    return __builtin_bit_cast(bf16x8, w);
}
DEV int row_mi(int r) { const int b = r / RB; const int s = r - b * RB; return s < NCTX ? 2 : b; }

DEV void transpose_item(const float* W, int K, int Nsrc, bf16_t* WT, int n0, int cs, int k0, float* scr, int lane) {
#pragma unroll 8
    for (int i = 0; i < 32; ++i) { const int kk = 2 * i + (lane >> 5); scr[kk * 33 + (lane & 31)] = cs >= 0 ? W[(size_t)(k0 + kk) * Nsrc + cs + (lane & 31)] : 0.f; }
    asm volatile("s_waitcnt lgkmcnt(0)" ::: "memory");
    const int c = lane & 7;
#pragma unroll
    for (int j = 0; j < 4; ++j) { const int n = (lane >> 3) + 8 * j; const float* s = scr + (8 * c) * 33 + n;
        u32x4 o; o.x = pk2(s[0 * 33], s[1 * 33]); o.y = pk2(s[2 * 33], s[3 * 33]); o.z = pk2(s[4 * 33], s[5 * 33]); o.w = pk2(s[6 * 33], s[7 * 33]);
        *(u32x4*)(WT + (size_t)(n0 + n) * K + k0 + 8 * c) = o; }
    asm volatile("s_waitcnt lgkmcnt(0)" ::: "memory");
}
DEV int map_in(int n0) { return n0 < INW ? n0 : -1; }
DEV int map_kn(int n0) { return (n0 >> 6) * 128 + (n0 & 63); }
DEV int map_v(int n0) { return (n0 >> 6) * 128 + 64 + (n0 & 63); }
DEV int map_up(int n0) { const int hf = n0 / DFF, w = n0 - hf * DFF; return w < HFF ? hf * HFF + w : DFF + hf * HFF + (w - HFF); }

DEV void phase_prep(const Params& p, unsigned char* lds) {
    const int tid = otid(), lane = tid & 63, wid = tid >> 6;
    unsigned char* ws = p.ws;
    { f32x2* rope = (f32x2*)(ws + OFF_ROPE);
      for (int idx = blockIdx.x * NWG_T + tid; idx < TL * 16; idx += gridDim.x * NWG_T) { const int t = idx >> 4, i = idx & 15; const int pos = i < 8 ? (t >> 6) : (t & 63);
          const float inv = exp2f(-(float)(i & 7) * 0.125f * 13.287712379549449f); const float ang = (float)pos * inv; f32x2 cs; cs.x = __cosf(ang); cs.y = __sinf(ang); rope[idx] = cs; } }
    { float* scv = (float*)lds;
      float* red = scv + 3 * 1024;
      for (int i = tid; i < 3 * 1024; i += NWG_T) { const int v = i >> 10, k = i & 1023; const float cv = v < 2 ? p.c[v * 1024 + k] : p.c_ctx[k]; scv[i] = siluf(cv); }
      __syncthreads();
      float* modv = (float*)(ws + OFF_MOD);
      for (int it = blockIdx.x; it < 192; it += gridDim.x) { const int l = it / 96, col0 = (it % 96) * 64;
          const float* wm = p.w_mod + (size_t)l * 1024 * 6144 + col0 + lane; float a0 = 0.f, a1 = 0.f, a2 = 0.f;
#pragma unroll 8
          for (int k = wid * 128; k < wid * 128 + 128; ++k) { const float w = wm[(size_t)k * 6144]; a0 += scv[k] * w; a1 += scv[1024 + k] * w; a2 += scv[2048 + k] * w; }
          red[(wid * 3 + 0) * 64 + lane] = a0; red[(wid * 3 + 1) * 64 + lane] = a1; red[(wid * 3 + 2) * 64 + lane] = a2;
          __syncthreads();
          if (tid < 192) { const int v = tid >> 6, cl = tid & 63; float s = 0.f;
#pragma unroll
              for (int w = 0; w < 8; ++w) s += red[(w * 3 + v) * 64 + cl];
              modv[((size_t)l * 3 + v) * 6144 + col0 + cl] = s + p.b_mod[l * 6144 + col0 + cl]; }
          __syncthreads(); }
    }
    { float* scr = (float*)(lds + 32768 + wid * 8704);
      const int gw = blockIdx.x * 8 + wid, NGW = gridDim.x * 8;
      constexpr int I_IN = 16 * 56, I_UQ = 6 * 24, I_KN = 4 * 16, I_V = 4 * 16, I_OUT = 16 * 32, I_UP = 16 * 176, I_DN = 44 * 32, I_L = I_IN + I_UQ + I_KN + I_V + I_OUT + I_UP + I_DN;
      for (int it = gw; it < 2 * I_L; it += NGW) { const int l = it / I_L; int r = it - l * I_L; bf16_t* wl = (bf16_t*)(ws + OFF_W) + (size_t)l * W_LAYER;
          const float* src; int K, Nsrc, nbn, mp; size_t doff;
          if (r < I_IN) { src = p.w_in + (size_t)l * 1024 * INW; K = 1024; Nsrc = INW; nbn = 56; mp = 1; doff = W_IN; }
          else if ((r -= I_IN) < I_UQ) { src = p.w_uq + (size_t)l * 384 * 768; K = 384; Nsrc = 768; nbn = 24; mp = 0; doff = W_UQ; }
          else if ((r -= I_UQ) < I_KN) { src = p.w_ukv + (size_t)l * 256 * 1024; K = 256; Nsrc = 1024; nbn = 16; mp = 2; doff = W_KN; }
          else if ((r -= I_KN) < I_V) { src = p.w_ukv + (size_t)l * 256 * 1024; K = 256; Nsrc = 1024; nbn = 16; mp = 3; doff = W_V; }
          else if ((r -= I_V) < I_OUT) { src = p.w_out + (size_t)l * 1024 * 1024; K = 1024; Nsrc = 1024; nbn = 32; mp = 0; doff = W_OUT; }
          else if ((r -= I_OUT) < I_UP) { src = p.w_up + (size_t)l * 1024 * 5632; K = 1024; Nsrc = 5632; nbn = 176; mp = 4; doff = W_UP; }
          else { r -= I_UP; src = p.w_down + (size_t)l * DFF * 1024; K = DFF; Nsrc = 1024; nbn = 32; mp = 0; doff = W_DN; }
          const int kb = r / nbn, nb = r - kb * nbn, n0 = nb * 32;
          const int cs = mp == 0 ? n0 : mp == 1 ? map_in(n0) : mp == 2 ? map_kn(n0) : mp == 3 ? map_v(n0) : map_up(n0);
          transpose_item(src, K, Nsrc, wl + doff, n0, cs, kb * 64, scr, lane); }
    }
}

DEV void phase_norm(const Params& p, int l, int which, bool first) {
    const int tid = otid(); const int lane = tid & 63, wid = tid >> 6; const int gw = blockIdx.x * 8 + wid, NGW = gridDim.x * 8;
    float* X = (float*)(p.ws + OFF_X); bf16_t* HN = (bf16_t*)(p.ws + OFF_HN);
    const float* modv = (const float*)(p.ws + OFF_MOD) + (size_t)l * 3 * 6144;
    const float* g = (which == 0 ? p.norm1_g : p.norm2_g) + l * 1024;
    for (int r = gw; r < R; r += NGW) {
        const int b = r / RB, s = r - b * RB; const int mi = s < NCTX ? 2 : b;
        const float* src = first ? (s < NCTX ? p.ctx + ((size_t)b * NCTX + s) * 1024 : p.x + ((size_t)b * TL + (s - NCTX)) * 1024) : X + (size_t)r * 1024;
        const f32x4* xr = (const f32x4*)src + lane; f32x4 v[4]; float ss = 0.f;
#pragma unroll
        for (int j = 0; j < 4; ++j) { v[j] = xr[64 * j]; ss += (v[j].x * v[j].x + v[j].y * v[j].y) + (v[j].z * v[j].z + v[j].w * v[j].w); }
        if (first) { f32x4* xo = (f32x4*)(X + (size_t)r * 1024) + lane;
#pragma unroll
            for (int j = 0; j < 4; ++j) xo[64 * j] = v[j]; }
        const float rs = rsqrtf(wave_sum(ss) * (1.f / 1024.f) + EPS);
        const float* mv = modv + mi * 6144 + (which == 0 ? 0 : 3072);
        u32x2* o8 = (u32x2*)(HN + (size_t)r * 1024) + lane;
#pragma unroll
        for (int j = 0; j < 4; ++j) { const f32x4 gg = ((const f32x4*)g)[lane + 64 * j], sh = ((const f32x4*)mv)[lane + 64 * j], sc = ((const f32x4*)(mv + 1024))[lane + 64 * j];
            const f32x4 y = v[j] * rs * gg; const f32x4 h = y * (sc + 1.0f) + sh; u32x2 w; w.x = pk2(h.x, h.y); w.y = pk2(h.z, h.w); o8[64 * j] = w; }
    }
}
DEV void phase_final(const Params& p) {
    const int tid = otid(); const int lane = tid & 63, wid = tid >> 6; const int gw = blockIdx.x * 8 + wid, NGW = gridDim.x * 8;
    const float* X = (const float*)(p.ws + OFF_X);
    for (int q = gw; q < 2 * TL; q += NGW) { const int b = q / TL, t = q - b * TL; const int r = b * RB + NCTX + t;
        const f32x4* xr = (const f32x4*)(X + (size_t)r * 1024) + lane; f32x4 v[4]; float ss = 0.f;
#pragma unroll
        for (int j = 0; j < 4; ++j) { v[j] = xr[64 * j]; ss += (v[j].x * v[j].x + v[j].y * v[j].y) + (v[j].z * v[j].z + v[j].w * v[j].w); }
        const float rs = rsqrtf(wave_sum(ss) * (1.f / 1024.f) + EPS);
        f32x4* o = (f32x4*)(p.out + (size_t)q * 1024) + lane;
#pragma unroll
        for (int j = 0; j < 4; ++j) { const f32x4 gg = ((const f32x4*)p.final_norm_g)[lane + 64 * j]; o[64 * j] = v[j] * rs * gg; } }
}

DEV void phase_rowwise(const Params& p, int l) {
    const int tid = otid(); const int lane = tid & 63, wid = tid >> 6; const int gw = blockIdx.x * 8 + wid, NGW = gridDim.x * 8;
    bf16_t* P = (bf16_t*)p.out; const f32x2* rope = (const f32x2*)(p.ws + OFF_ROPE);
    const float* qg = p.mla_q_norm_g + l * 384; const float* kg = p.mla_kv_norm_g + l * 256;
    for (int r = gw; r < R; r += NGW) {
        bf16_t* pr = P + (size_t)r * INW; const int b = r / RB, s = r - b * RB;
        { unsigned* q2 = (unsigned*)(pr + 768) + lane; unsigned w[3]; float ss = 0.f;
#pragma unroll
          for (int j = 0; j < 3; ++j) { w[j] = q2[64 * j]; const float a = bf2f(w[j] & 0xffff), c2 = bf2f(w[j] >> 16); ss += a * a + c2 * c2; }
          const float rs = rsqrtf(wave_sum(ss) * (1.f / 384.f) + EPS);
#pragma unroll
          for (int j = 0; j < 3; ++j) { const int c0 = 2 * (lane + 64 * j); q2[64 * j] = pk2(bf2f(w[j] & 0xffff) * rs * qg[c0], bf2f(w[j] >> 16) * rs * qg[c0 + 1]); } }
        { u32x2* k4 = (u32x2*)(pr + 1152) + lane; const u32x2 w = *k4;
          const float a0 = bf2f(w.x & 0xffff), a1 = bf2f(w.x >> 16), a2 = bf2f(w.y & 0xffff), a3 = bf2f(w.y >> 16);
          const float rs = rsqrtf(wave_sum((a0 * a0 + a1 * a1) + (a2 * a2 + a3 * a3)) * (1.f / 256.f) + EPS);
          const f32x4 gg = ((const f32x4*)kg)[lane]; u32x2 o; o.x = pk2(a0 * rs * gg.x, a1 * rs * gg.y); o.y = pk2(a2 * rs * gg.z, a3 * rs * gg.w); *k4 = o; }
        if (s >= NCTX && lane < 16) { const f32x2 cs = rope[(s - NCTX) * 16 + lane];
          const float x1 = bf2f(pr[1408 + lane]), x2 = bf2f(pr[1408 + 16 + lane]);
          pr[1408 + lane] = (bf16_t)f2bf(x1 * cs.x - x2 * cs.y); pr[1408 + 16 + lane] = (bf16_t)f2bf(x2 * cs.x + x1 * cs.y); }
    }
}

DEV void pool_item(const Params& p, int l, unsigned char* lds, int it) {
    const int tid = otid(); const bf16_t* P = (const bf16_t*)p.out; bf16_t* MIX = (bf16_t*)(p.ws + OFF_HN);
    float* dl = (float*)lds;
    float* Wl = dl + 64 * 256;
    const int r0 = it * 64; const int b = r0 / RB, s0 = r0 - b * RB; const int seq0 = s0 < NCTX ? b * RB : b * RB + NCTX; const int T = s0 < NCTX ? NCTX : TL;
    for (int i = tid; i < 4 * 64 * 64; i += NWG_T) Wl[i] = p.pool_w[(size_t)l * 16384 + i];
    { const int ch = tid & 255, g = ch >> 6, half = 1 << g;
      for (int rr = tid >> 8; rr < 64; rr += 2) { const int t = r0 + rr - seq0; const int lo = max(t - half, 0), hi = min(t + half, T); float sum = 0.f;
          for (int tt = lo; tt < hi; ++tt) sum += bf2f(P[(size_t)(seq0 + tt) * INW + 1440 + ch]);
          dl[rr * 256 + ch] = sum / (float)(hi - lo) - bf2f(P[(size_t)(r0 + rr) * INW + 1440 + ch]); } }
    __syncthreads();
    { const int o = tid & 255, g = o >> 6, dd = o & 63, rh = tid >> 8; float acc[32];
#pragma unroll
      for (int i = 0; i < 32; ++i) acc[i] = 0.f;
      for (int c4 = 0; c4 < 16; ++c4) { const float w0 = Wl[(g * 64 + 4 * c4 + 0) * 64 + dd], w1 = Wl[(g * 64 + 4 * c4 + 1) * 64 + dd], w2 = Wl[(g * 64 + 4 * c4 + 2) * 64 + dd], w3 = Wl[(g * 64 + 4 * c4 + 3) * 64 + dd];
#pragma unroll
          for (int i = 0; i < 32; ++i) { const f32x4 d4 = *(const f32x4*)(dl + (rh * 32 + i) * 256 + g * 64 + 4 * c4); acc[i] += (d4.x * w0 + d4.y * w1) + (d4.z * w2 + d4.w * w3); } }
      const float sc = p.pool_scale[l * 256 + o];
#pragma unroll
      for (int i = 0; i < 32; ++i) MIX[(size_t)(r0 + rh * 32 + i) * 1024 + 768 + o] = (bf16_t)f2bf(acc[i] * sc); }
    __syncthreads();
}

DEV float log2_sigmoid(float d) { return -log1pf(__expf(-d)) * 1.4426950408889634f; }
DEV void states_item(const Params& p, int l, unsigned char* lds, int gc) {
    const int tid = otid(); const bf16_t* P = (const bf16_t*)p.out; const f32x2* rope = (const f32x2*)(p.ws + OFF_ROPE);
    float* SLOC = (float*)(p.ws + OFF_OV + OV_SLOC);
    bf16_t* kk = (bf16_t*)lds;
    bf16_t* vv = kk + 4 * 128 * 32;
    float* dec = (float*)(vv + 128 * 256);
    const int cb = gc % 66; const bool lat = cb >= 2; const int t0 = (cb - 2) * 128; const int r0 = gc * 128;
    for (int i = tid; i < 1024; i += NWG_T) { const int h = i >> 8, dir = (i >> 7) & 1, idx = i & 127;
        const float lg = log2_sigmoid((dir == 0 ? p.ret_decay_f : p.ret_decay_b)[l * 4 + h]); dec[i] = exp2f(lg * (dir == 0 ? (float)(127 - idx) : (float)idx)); }
    for (int task = tid; task < 1024; task += NWG_T) { const int tok = task >> 3, h = (task >> 1) & 3, c = task & 1;
        const bf16_t* src = P + (size_t)(r0 + tok) * INW + 128 + h * 32 + 8 * c; const bf16x8 lo = *(const bf16x8*)src, hi = *(const bf16x8*)(src + 16);
        float o1[8], o2[8];
#pragma unroll
        for (int j = 0; j < 8; ++j) { float x1 = bf2f((unsigned short)lo[j]), x2 = bf2f((unsigned short)hi[j]);
            if (lat) { const f32x2 cs = rope[(t0 + tok) * 16 + 8 * c + j]; const float y1 = x1 * cs.x - x2 * cs.y, y2 = x2 * cs.x + x1 * cs.y; x1 = y1; x2 = y2; }
            o1[j] = x1 * 0.17677669529663687f; o2[j] = x2 * 0.17677669529663687f; }
        bf16_t* dst = kk + (h * 128 + tok) * 32 + 8 * c;
        *(bf16x8*)dst = pack8(o1[0], o1[1], o1[2], o1[3], o1[4], o1[5], o1[6], o1[7]); *(bf16x8*)(dst + 16) = pack8(o2[0], o2[1], o2[2], o2[3], o2[4], o2[5], o2[6], o2[7]); }
    for (int task = tid; task < 4096; task += NWG_T) { const int tok = task >> 5, ch = task & 31; *(u32x4*)(vv + tok * 256 + ch * 8) = *(const u32x4*)(P + (size_t)(r0 + tok) * INW + 256 + ch * 8); }
    __syncthreads();
    { const int h = tid >> 7, d = (tid >> 2) & 31, dvg = tid & 3; float af[16], ab[16];
#pragma unroll
      for (int j = 0; j < 16; ++j) { af[j] = 0.f; ab[j] = 0.f; }
      for (int i = 0; i < 128; ++i) { const float kv = bf2f(kk[(h * 128 + i) * 32 + d]); const float kf = kv * dec[(h * 2 + 0) * 128 + i], kb = kv * dec[(h * 2 + 1) * 128 + i];
          const bf16x8 v0 = *(const bf16x8*)(vv + i * 256 + h * 64 + dvg * 16), v1 = *(const bf16x8*)(vv + i * 256 + h * 64 + dvg * 16 + 8);
#pragma unroll
          for (int j = 0; j < 8; ++j) { const float a = bf2f((unsigned short)v0[j]), c2 = bf2f((unsigned short)v1[j]); af[j] += kf * a; ab[j] += kb * a; af[8 + j] += kf * c2; ab[8 + j] += kb * c2; } }
      float* of = SLOC + ((size_t)(gc * 4 + h) * 2 + 0) * 2048 + d * 64 + dvg * 16; float* ob = of + 2048;
#pragma unroll
      for (int j = 0; j < 4; ++j) { ((f32x4*)of)[j] = (f32x4){af[4 * j], af[4 * j + 1], af[4 * j + 2], af[4 * j + 3]}; ((f32x4*)ob)[j] = (f32x4){ab[4 * j], ab[4 * j + 1], ab[4 * j + 2], ab[4 * j + 3]}; } }
    __syncthreads();
}
DEV void scan_threads(const Params& p, int l, int gid) {
    if (gid >= 32768) return;
    const int e = gid & 2047, dir = (gid >> 11) & 1, h = (gid >> 12) & 3, b = gid >> 14;
    const float* SLOC = (const float*)(p.ws + OFF_OV + OV_SLOC); float* SIN = (float*)(p.ws + OFF_OV + OV_SIN);
    const float gC = exp2f(log2_sigmoid((dir == 0 ? p.ret_decay_f : p.ret_decay_b)[l * 4 + h]) * 128.f);
    float S = 0.f;
#pragma unroll 6
    for (int st = 0; st < 66; ++st) { const int cb = dir == 0 ? st : (st < 2 ? 1 - st : 67 - st); const size_t idx = ((size_t)((b * 66 + cb) * 4 + h) * 2 + dir) * 2048 + e;
        const float v = SLOC[idx]; SIN[idx] = S; S = S * gC + v; }
}

constexpr int AT_KP = 208, AT_VP = 136, AT_KB = 64 * AT_KP, AT_BUF = AT_KB + 64 * AT_VP;
DEV void attn_unit(const Params& p, unsigned char* lds, int u) {
    const int tid = otid(), lane = tid & 63, wid = tid >> 6, l32 = lane & 31, hi = lane >> 5;
    const bf16_t* Q = (const bf16_t*)(p.ws + OFF_OV + OV_Q); const bf16_t* KN = (const bf16_t*)(p.ws + OFF_OV + OV_KN); const bf16_t* VT = (const bf16_t*)(p.ws + OFF_OV + OV_VT);
    const bf16_t* P = (const bf16_t*)p.out; bf16_t* MIX = (bf16_t*)(p.ws + OFF_HN); const f32x2* rope = (const f32x2*)(p.ws + OFF_ROPE);
    const bool isctx = u >= 512; int b, h, qrow0, NT;
    if (!isctx) { b = u >> 8; h = (u >> 5) & 7; qrow0 = b * RB + NCTX + (u & 31) * 256; NT = 132; } else { const int v = u - 512; b = v >> 3; h = v & 7; qrow0 = b * RB; NT = 4; }
    const int krow0 = b * RB; const int qrow = qrow0 + wid * 32 + l32;
    bf16x8 qf[6];
    { const bf16_t* qp = Q + (size_t)qrow * 768 + h * 96 + hi * 8;
#pragma unroll
      for (int d0 = 0; d0 < 6; ++d0) qf[d0] = *(const bf16x8*)(qp + d0 * 16);
      if (!isctx) { const f32x2* rp = rope + (size_t)(qrow - (b * RB + NCTX)) * 16 + hi * 8;
#pragma unroll
          for (int j = 0; j < 8; ++j) { const f32x2 cs = rp[j]; const float x1 = bf2f((unsigned short)qf[4][j]), x2 = bf2f((unsigned short)qf[5][j]);
              qf[4][j] = (short)f2bf(x1 * cs.x - x2 * cs.y); qf[5][j] = (short)f2bf(x2 * cs.x + x1 * cs.y); } } }
    const bf16_t* sp[3]; int sstep[3], lo[3];
#pragma unroll
    for (int k = 0; k < 3; ++k) { const int c = tid + k * 512;
        if (c < 768) { const int key = c / 12, part = c - key * 12; lo[k] = key * AT_KP + part * 16;
            if (part < 8) { sp[k] = KN + (size_t)(krow0 + key) * 512 + h * 64 + part * 8; sstep[k] = 64 * 512; } else { sp[k] = P + (size_t)(krow0 + key) * INW + 1408 + (part - 8) * 8; sstep[k] = 64 * INW; } }
        else { const int cc = c - 768, dv = cc >> 3, kc = cc & 7; lo[k] = AT_KB + dv * AT_VP + kc * 16; sp[k] = VT + (size_t)(h * 64 + dv) * R + krow0 + kc * 8; sstep[k] = 64; } }
    const bool has3 = tid < 256;
    u32x4 st[3];
#define AT_GLOAD() do { st[0] = *(const u32x4*)sp[0]; sp[0] += sstep[0]; st[1] = *(const u32x4*)sp[1]; sp[1] += sstep[1]; if (has3) { st[2] = *(const u32x4*)sp[2]; sp[2] += sstep[2]; } } while (0)
#define AT_LSTORE1(buf, k) do { unsigned char* d_ = (buf) + lo[k]; if (lo[k] < AT_KB) { *(u32x4*)d_ = st[k]; } else { *(u32x2*)d_ = (u32x2){st[k].x, st[k].y}; *(u32x2*)(d_ + 8) = (u32x2){st[k].z, st[k].w}; } } while (0)
#define AT_LSTORE(buf) do { AT_LSTORE1(buf, 0); AT_LSTORE1(buf, 1); if (has3) AT_LSTORE1(buf, 2); } while (0)
    f32x16 o0, o1;
#pragma unroll
    for (int r = 0; r < 16; ++r) { o0[r] = 0.f; o1[r] = 0.f; }
    float mrun = -1e30f, lsum = 0.f;
    __syncthreads();
    AT_GLOAD(); AT_LSTORE(lds);
    __syncthreads();
    for (int t = 0; t < NT; ++t) {
        unsigned char* kbuf = lds + (t & 1) * AT_BUF; unsigned char* vbuf = kbuf + AT_KB; unsigned char* nbuf = lds + ((t + 1) & 1) * AT_BUF;
        const bool more = t + 1 < NT;
        if (more) AT_GLOAD();
        f32x16 s0, s1;
#pragma unroll
        for (int r = 0; r < 16; ++r) { s0[r] = 0.f; s1[r] = 0.f; }
        { const unsigned char* ka = kbuf + l32 * AT_KP + hi * 16;
#pragma unroll
          for (int d0 = 0; d0 < 6; ++d0) { const bf16x8 a0 = *(const bf16x8*)(ka + d0 * 32), a1 = *(const bf16x8*)(ka + 32 * AT_KP + d0 * 32);
              s0 = __builtin_amdgcn_mfma_f32_32x32x16_bf16(a0, qf[d0], s0, 0, 0, 0); s1 = __builtin_amdgcn_mfma_f32_32x32x16_bf16(a1, qf[d0], s1, 0, 0, 0); } }
        float mx = fmaxf(s0[0], s1[0]);
#pragma unroll
        for (int r = 1; r < 16; ++r) mx = fmaxf(mx, fmaxf(s0[r], s1[r]));
        mx = fmaxf(mx, __shfl_xor(mx, 32));
        const float mn = fmaxf(mrun, mx); const float alpha = __builtin_amdgcn_exp2f(mrun - mn); mrun = mn;
        float ls = 0.f;
#pragma unroll
        for (int r = 0; r < 16; ++r) { s0[r] = __builtin_amdgcn_exp2f(s0[r] - mn); s1[r] = __builtin_amdgcn_exp2f(s1[r] - mn); ls += s0[r] + s1[r]; }
        lsum = lsum * alpha + ls;
#pragma unroll
        for (int r = 0; r < 16; ++r) { o0[r] *= alpha; o1[r] *= alpha; }
        { const unsigned char* va = vbuf + l32 * AT_VP + hi * 8;
#pragma unroll
          for (int kb = 0; kb < 2; ++kb)
#pragma unroll
              for (int jp = 0; jp < 2; ++jp) { const f32x16& s = kb == 0 ? s0 : s1;
                  const bf16x8 pb = pack8(s[8 * jp + 0], s[8 * jp + 1], s[8 * jp + 2], s[8 * jp + 3], s[8 * jp + 4], s[8 * jp + 5], s[8 * jp + 6], s[8 * jp + 7]);
                  const unsigned char* vp = va + (32 * kb + 16 * jp) * 2;
                  const u32x2 a00 = *(const u32x2*)vp, a01 = *(const u32x2*)(vp + 16), a10 = *(const u32x2*)(vp + 32 * AT_VP), a11 = *(const u32x2*)(vp + 32 * AT_VP + 16);
                  const bf16x8 A0 = __builtin_bit_cast(bf16x8, (u32x4){a00.x, a00.y, a01.x, a01.y}), A1 = __builtin_bit_cast(bf16x8, (u32x4){a10.x, a10.y, a11.x, a11.y});
                  o0 = __builtin_amdgcn_mfma_f32_32x32x16_bf16(A0, pb, o0, 0, 0, 0); o1 = __builtin_amdgcn_mfma_f32_32x32x16_bf16(A1, pb, o1, 0, 0, 0); } }
        if (more) AT_LSTORE(nbuf);
        __syncthreads();
    }
    lsum += __shfl_xor(lsum, 32);
    const float inv = 1.0f / lsum;
    bf16_t* op = MIX + (size_t)qrow * 1024 + 256 + h * 64 + 4 * hi;
#pragma unroll
    for (int g4 = 0; g4 < 4; ++g4) { u32x2 w0, w1; w0.x = pk2(o0[4 * g4] * inv, o0[4 * g4 + 1] * inv); w0.y = pk2(o0[4 * g4 + 2] * inv, o0[4 * g4 + 3] * inv);
        w1.x = pk2(o1[4 * g4] * inv, o1[4 * g4 + 1] * inv); w1.y = pk2(o1[4 * g4 + 2] * inv, o1[4 * g4 + 3] * inv);
        *(u32x2*)(op + 8 * g4) = w0; *(u32x2*)(op + 32 + 8 * g4) = w1; }
#undef AT_GLOAD
#undef AT_LSTORE1
#undef AT_LSTORE
}

constexpr int RT_VP = 264, RT_SP = 144, RT_VB = 2 * 64 * RT_VP;
DEV void retout_unit(const Params& p, int l, unsigned char* lds, int u) {
    const int tid = otid(), lane = tid & 63, wid = tid >> 6, l32 = lane & 31, hi = lane >> 5;
    const int gc = u >> 1, hp = u & 1; const int cb = gc % 66; const bool lat = cb >= 2; const int t0 = (cb - 2) * 128; const int r0 = gc * 128;
    const bf16_t* P = (const bf16_t*)p.out; bf16_t* MIX = (bf16_t*)(p.ws + OFF_HN); const f32x2* rope = (const f32x2*)(p.ws + OFF_ROPE);
    const float* SIN = (const float*)(p.ws + OFF_OV + OV_SIN);
    bf16_t* VTl = (bf16_t*)lds; bf16_t* STl = (bf16_t*)(lds + RT_VB);
    __syncthreads();
    for (int task = tid; task < 2048; task += NWG_T) { const int hh = task >> 10, key = (task >> 3) & 127, ch = task & 7;
        const bf16x8 v = *(const bf16x8*)(P + (size_t)(r0 + key) * INW + 256 + (2 * hp + hh) * 64 + ch * 8);
#pragma unroll
        for (int j = 0; j < 8; ++j) VTl[(hh * 64 + ch * 8 + j) * (RT_VP / 2) + key] = (bf16_t)v[j]; }
    for (int task = tid; task < 8192; task += NWG_T) { const int dv = task & 63, k = (task >> 6) & 31, dir = (task >> 11) & 1, hh = task >> 12;
        STl[(hh * 64 + dv) * (RT_SP / 2) + dir * 32 + k] = (bf16_t)f2bf(SIN[((size_t)(gc * 4 + 2 * hp + hh) * 2 + dir) * 2048 + k * 64 + dv]); }
    __syncthreads();
    const int hh = wid >> 2, h = 2 * hp + hh, qblk = wid & 3; const int n = 32 * qblk + l32; const int rq = r0 + n;
    const float lf = log2_sigmoid(p.ret_decay_f[l * 4 + h]), lb = log2_sigmoid(p.ret_decay_b[l * 4 + h]);
    float qv0[8], qv1[8]; bf16x8 qf0, qf1;
    { const bf16_t* qp = P + (size_t)rq * INW + h * 32 + 8 * hi; const bf16x8 a = *(const bf16x8*)qp, c2 = *(const bf16x8*)(qp + 16);
#pragma unroll
      for (int j = 0; j < 8; ++j) { float x1 = bf2f((unsigned short)a[j]), x2 = bf2f((unsigned short)c2[j]);
          if (lat) { const f32x2 cs = rope[(size_t)(t0 + n) * 16 + 8 * hi + j]; const float y1 = x1 * cs.x - x2 * cs.y, y2 = x2 * cs.x + x1 * cs.y; x1 = y1; x2 = y2; }
          qv0[j] = x1; qv1[j] = x2; }
      qf0 = pack8(qv0[0], qv0[1], qv0[2], qv0[3], qv0[4], qv0[5], qv0[6], qv0[7]); qf1 = pack8(qv1[0], qv1[1], qv1[2], qv1[3], qv1[4], qv1[5], qv1[6], qv1[7]); }
    f32x16 o0, o1;
#pragma unroll
    for (int r = 0; r < 16; ++r) { o0[r] = 0.f; o1[r] = 0.f; }
    const unsigned char* vbase = (const unsigned char*)VTl + (size_t)(hh * 64 + l32) * RT_VP + hi * 8;
#pragma unroll
    for (int kb = 0; kb < 4; ++kb) {
        bf16x8 kf0, kf1;
        { const int key = 32 * kb + l32; const bf16_t* kp = P + (size_t)(r0 + key) * INW + 128 + h * 32 + 8 * hi; const bf16x8 a = *(const bf16x8*)kp, c2 = *(const bf16x8*)(kp + 16);
          float y1[8], y2[8];
#pragma unroll
          for (int j = 0; j < 8; ++j) { float x1 = bf2f((unsigned short)a[j]), x2 = bf2f((unsigned short)c2[j]);
              if (lat) { const f32x2 cs = rope[(size_t)(t0 + key) * 16 + 8 * hi + j]; const float z1 = x1 * cs.x - x2 * cs.y, z2 = x2 * cs.x + x1 * cs.y; x1 = z1; x2 = z2; }
              y1[j] = x1 * 0.17677669529663687f; y2[j] = x2 * 0.17677669529663687f; }
          kf0 = pack8(y1[0], y1[1], y1[2], y1[3], y1[4], y1[5], y1[6], y1[7]); kf1 = pack8(y2[0], y2[1], y2[2], y2[3], y2[4], y2[5], y2[6], y2[7]); }
        f32x16 s;
#pragma unroll
        for (int r = 0; r < 16; ++r) s[r] = 0.f;
        s = __builtin_amdgcn_mfma_f32_32x32x16_bf16(kf0, qf0, s, 0, 0, 0); s = __builtin_amdgcn_mfma_f32_32x32x16_bf16(kf1, qf1, s, 0, 0, 0);
#pragma unroll
        for (int r = 0; r < 16; ++r) { const int m = 32 * kb + crow(r, hi); const int dl = n - m; const float e = dl >= 0 ? lf * (float)dl : lb * (float)(-dl); s[r] *= __builtin_amdgcn_exp2f(e); }
#pragma unroll
        for (int jp = 0; jp < 2; ++jp) { const bf16x8 pb = pack8(s[8 * jp + 0], s[8 * jp + 1], s[8 * jp + 2], s[8 * jp + 3], s[8 * jp + 4], s[8 * jp + 5], s[8 * jp + 6], s[8 * jp + 7]);
            const unsigned char* vp = vbase + (32 * kb + 16 * jp) * 2;
            const u32x2 a00 = *(const u32x2*)vp, a01 = *(const u32x2*)(vp + 16), a10 = *(const u32x2*)(vp + 32 * RT_VP), a11 = *(const u32x2*)(vp + 32 * RT_VP + 16);
            const bf16x8 A0 = __builtin_bit_cast(bf16x8, (u32x4){a00.x, a00.y, a01.x, a01.y}), A1 = __builtin_bit_cast(bf16x8, (u32x4){a10.x, a10.y, a11.x, a11.y});
            o0 = __builtin_amdgcn_mfma_f32_32x32x16_bf16(A0, pb, o0, 0, 0, 0); o1 = __builtin_amdgcn_mfma_f32_32x32x16_bf16(A1, pb, o1, 0, 0, 0); }
    }
    { const float df = __builtin_amdgcn_exp2f(lf * (float)(n + 1)), db = __builtin_amdgcn_exp2f(lb * (float)(128 - n));
      const unsigned char* sbase = (const unsigned char*)STl + (size_t)(hh * 64 + l32) * RT_SP + hi * 16;
#pragma unroll
      for (int ks = 0; ks < 4; ++ks) { const float dd = ks < 2 ? df : db;
          const bf16x8 qb = (ks & 1) ? pack8(qv1[0] * dd, qv1[1] * dd, qv1[2] * dd, qv1[3] * dd, qv1[4] * dd, qv1[5] * dd, qv1[6] * dd, qv1[7] * dd)
                                     : pack8(qv0[0] * dd, qv0[1] * dd, qv0[2] * dd, qv0[3] * dd, qv0[4] * dd, qv0[5] * dd, qv0[6] * dd, qv0[7] * dd);
          const bf16x8 A0 = *(const bf16x8*)(sbase + ks * 32), A1 = *(const bf16x8*)(sbase + 32 * RT_SP + ks * 32);
          o0 = __builtin_amdgcn_mfma_f32_32x32x16_bf16(A0, qb, o0, 0, 0, 0); o1 = __builtin_amdgcn_mfma_f32_32x32x16_bf16(A1, qb, o1, 0, 0, 0); } }
    float ssq = 0.f;
#pragma unroll
    for (int r = 0; r < 16; ++r) ssq += o0[r] * o0[r] + o1[r] * o1[r];
    ssq += __shfl_xor(ssq, 32);
    const float rstd = rsqrtf(ssq * (1.f / 64.f) + EPS);
    const bf16_t* gp = P + (size_t)rq * INW + 512 + h * 64 + 4 * hi; bf16_t* op = MIX + (size_t)rq * 1024 + h * 64 + 4 * hi;
#pragma unroll
    for (int g4 = 0; g4 < 4; ++g4) { const u32x2 ga = *(const u32x2*)(gp + 8 * g4), gb = *(const u32x2*)(gp + 32 + 8 * g4);
        u32x2 w0, w1;
        w0.x = pk2(o0[4 * g4] * rstd * siluf(bf2f(ga.x & 0xffff)), o0[4 * g4 + 1] * rstd * siluf(bf2f(ga.x >> 16))); w0.y = pk2(o0[4 * g4 + 2] * rstd * siluf(bf2f(ga.y & 0xffff)), o0[4 * g4 + 3] * rstd * siluf(bf2f(ga.y >> 16)));
        w1.x = pk2(o1[4 * g4] * rstd * siluf(bf2f(gb.x & 0xffff)), o1[4 * g4 + 1] * rstd * siluf(bf2f(gb.x >> 16))); w1.y = pk2(o1[4 * g4 + 2] * rstd * siluf(bf2f(gb.y & 0xffff)), o1[4 * g4 + 3] * rstd * siluf(bf2f(gb.y >> 16)));
        *(u32x2*)(op + 8 * g4) = w0; *(u32x2*)(op + 32 + 8 * g4) = w1; }
}

DEV void phase_convact(const Params& p, int l, int hf) {
    const bf16_t* U = (const bf16_t*)(p.ws + OFF_OV + OV_U); bf16_t* ACT = (bf16_t*)p.out;
    const float* cw = p.conv_w + (size_t)l * 3 * 5632; const float* cbv = p.conv_b + (size_t)l * 5632;
    const int total = R * 176;
    for (int idx = blockIdx.x * NWG_T + threadIdx.x; idx < total; idx += gridDim.x * NWG_T) {
        const int r = idx / 176, j8 = idx - r * 176; const int b = r / RB, s = r - b * RB;
        const bool hasp = (s != 0) && (s != NCTX), hasn = (s != NCTX - 1) && (s != RB - 1);
        const bf16_t* ur = U + (size_t)r * DFF + j8 * 8; const bf16x8 z = {0, 0, 0, 0, 0, 0, 0, 0};
        const bf16x8 a1 = *(const bf16x8*)ur, b1 = *(const bf16x8*)(ur + HFF);
        const bf16x8 a0 = hasp ? *(const bf16x8*)(ur - DFF) : z, b0 = hasp ? *(const bf16x8*)(ur - DFF + HFF) : z;
        const bf16x8 a2 = hasn ? *(const bf16x8*)(ur + DFF) : z, b2 = hasn ? *(const bf16x8*)(ur + DFF + HFF) : z;
        const int ca = hf * HFF + j8 * 8, cbc = DFF + hf * HFF + j8 * 8; float o[8];
#pragma unroll
        for (int j = 0; j < 8; ++j) {
            const float ua = bf2f((unsigned short)a0[j]) * cw[ca + j] + bf2f((unsigned short)a1[j]) * cw[5632 + ca + j] + bf2f((unsigned short)a2[j]) * cw[2 * 5632 + ca + j] + cbv[ca + j];
            const float ub = bf2f((unsigned short)b0[j]) * cw[cbc + j] + bf2f((unsigned short)b1[j]) * cw[5632 + cbc + j] + bf2f((unsigned short)b2[j]) * cw[2 * 5632 + cbc + j] + cbv[cbc + j];
            o[j] = siluf(ua) * ub; }
        *(bf16x8*)(ACT + (size_t)r * HFF + j8 * 8) = pack8(o[0], o[1], o[2], o[3], o[4], o[5], o[6], o[7]);
    }
}

constexpr int PH_PER_LAYER = 12, N_PHASES = 2 + 2 * PH_PER_LAYER;
__global__ void __launch_bounds__(512, 2) mk_fwd(Params p_arg) {
    extern __shared__ __attribute__((aligned(16))) unsigned char lds[];
    cg::grid_group grid = cg::this_grid();
    const int G = gridDim.x, bx = blockIdx.x; const int vcu = (G % 8 == 0) ? (bx % 8) * (G / 8) + bx / 8 : bx;
    LAS unsigned char* ldsl = (LAS unsigned char*)lds;
    const int ph_lo = p_arg.ph_lo, ph_hi = p_arg.ph_hi;
    for (int ph = ph_lo; ph < ph_hi; ++ph) {
        const __attribute__((address_space(4))) Params* kp = (const __attribute__((address_space(4))) Params*)__builtin_amdgcn_kernarg_segment_ptr();
        asm volatile("" : "+s"(kp));
#if defined(__HIP_DEVICE_COMPILE__)
        const Params p = *kp;
#else
        const Params p = p_arg;
#endif
        bf16_t* HN = (bf16_t*)(p.ws + OFF_HN); bf16_t* P = (bf16_t*)p.out; float* X = (float*)(p.ws + OFF_X);
        if (ph == 0) { phase_prep(p, lds); }
        else if (ph == N_PHASES - 1) { phase_final(p); }
        else {
            const int l = (ph - 1) / PH_PER_LAYER, sp = (ph - 1) % PH_PER_LAYER;
            const bf16_t* wl = (const bf16_t*)(p.ws + OFF_W) + (size_t)l * W_LAYER;
            const float* modv = (const float*)(p.ws + OFF_MOD) + (size_t)l * 3 * 6144;
            if (sp == 0) { phase_norm(p, l, 0, l == 0); }
            else if (sp == 1) { __syncthreads();
                pg8::Gemm g{HN, wl + W_IN, R, 1792, 1024, 1024, 1024}; pg8::StaticOrder S; S.init(R, 1792, G, bx);
                pg8::EpiStore E{P, INW, INW, 1.0f};
                pg8::gemm_phase<pg8::EpiStore, pg8::StaticOrder, true, true>(ldsl, g, S, E); }
            else if (sp == 2) { phase_rowwise(p, l); __syncthreads();
                for (int it = bx; it < 264; it += G) pool_item(p, l, lds, it);
                for (int it = G - 1 - bx; it < 132; it += G) states_item(p, l, lds, it); }
            else if (sp == 3) { __syncthreads();
                { pg8::Gemm g{P + 768, wl + W_UQ, R, 768, 384, INW, 384}; pg8::StaticOrder S; S.init(R, 768, G, bx);
                  pg8::EpiStore E{(bf16_t*)(p.ws + OFF_OV + OV_Q), 768, 768, 0.14724444f};
                  pg8::gemm_phase<pg8::EpiStore, pg8::StaticOrder, true, true>(ldsl, g, S, E); }
                __syncthreads();
                { pg8::Gemm g{P + 1152, wl + W_KN, R, 512, 256, INW, 256}; pg8::StaticOrder S; S.init(R, 512, G, (bx + 58) % G);
                  pg8::EpiStore E{(bf16_t*)(p.ws + OFF_OV + OV_KN), 512, 512, 1.0f};
                  pg8::gemm_phase<pg8::EpiStore, pg8::StaticOrder, true, true>(ldsl, g, S, E); }
                __syncthreads();
                { pg8::Gemm g{wl + W_V, P + 1152, 512, R, 256, 256, INW}; pg8::StaticOrder S; S.init(512, R, G, (bx + 182) % G);
                  pg8::EpiStore E{(bf16_t*)(p.ws + OFF_OV + OV_VT), R, R, 1.0f};
                  pg8::gemm_phase<pg8::EpiStore, pg8::StaticOrder, true, true>(ldsl, g, S, E); }
                if (bx >= G - 64) scan_threads(p, l, (bx - (G - 64)) * NWG_T + (int)threadIdx.x); }
            else if (sp == 4) {
                for (int u = vcu; u < 528; u += G) attn_unit(p, lds, u);
                for (int u = G - 1 - bx; u < 264; u += G) retout_unit(p, l, lds, u); }
            else if (sp == 5) { __syncthreads();
                pg8::Gemm g{HN, wl + W_OUT, R, 1024, 1024, 1024, 1024}; pg8::StaticOrder S; S.init(R, 1024, G, bx);
                pg8::EpiResid E{X, modv + 2048, 0};
                pg8::gemm_phase<pg8::EpiResid, pg8::StaticOrder, true, true>(ldsl, g, S, E); }
            else if (sp == 6) { phase_norm(p, l, 1, false); }
            else if (sp == 7 || sp == 9 || sp == 11) {
                __syncthreads();
                if (sp >= 9) { const int hf = sp == 9 ? 0 : 1;
                    pg8::Gemm g{P, wl + W_DN + hf * HFF, R, 1024, HFF, HFF, DFF}; pg8::StaticOrder S; S.init(R, 1024, G, bx);
                    pg8::EpiResid E{X, modv + 5120, 0};
                    pg8::gemm_phase<pg8::EpiResid, pg8::StaticOrder, true, true>(ldsl, g, S, E); __syncthreads(); }
                if (sp <= 9) { const int hf = sp == 7 ? 0 : 1;
                    pg8::Gemm g{HN, wl + W_UP + (size_t)hf * DFF * 1024, R, DFF, 1024, 1024, 1024}; pg8::StaticOrder S; S.init(R, DFF, G, (bx + (sp == 9 ? 8 : 0)) % G);
                    pg8::EpiStore E{(bf16_t*)(p.ws + OFF_OV + OV_U), DFF, DFF, 1.0f};
                    pg8::gemm_phase<pg8::EpiStore, pg8::StaticOrder, true, true>(ldsl, g, S, E); } }
            else if (sp == 8) { phase_convact(p, l, 0); }
            else if (sp == 10) { phase_convact(p, l, 1); }
        }
        if (ph + 1 < ph_hi) grid.sync();
    }
}

extern "C" void kernel_launch(void* const* d_in, const int* in_sizes, int n_in, void* d_out, int out_size, void* d_ws, size_t ws_size, hipStream_t stream) {
    static int grid = 0;
    if (grid == 0) {
        if (n_in != 23 || ws_size < WS_NEED) { fprintf(stderr, "kernel_launch: unexpected problem (n_in %d, ws %zu, need %zu)\n", n_in, ws_size, (size_t)WS_NEED); grid = -1; return; }
        int dev = 0, cus = 0, per_cu = 0;
        hipGetDevice(&dev); hipDeviceGetAttribute(&cus, hipDeviceAttributeMultiprocessorCount, dev);
        if (hipFuncSetAttribute((const void*)mk_fwd, hipFuncAttributeMaxDynamicSharedMemorySize, LDS_BYTES) != hipSuccess) { fprintf(stderr, "kernel_launch: hipFuncSetAttribute failed\n"); grid = -1; return; }
        if (hipOccupancyMaxActiveBlocksPerMultiprocessor(&per_cu, (const void*)mk_fwd, 512, LDS_BYTES) != hipSuccess || per_cu < 1) { fprintf(stderr, "kernel_launch: occupancy query says %d\n", per_cu); per_cu = 1; }
        (void)hipGetLastError();
        grid = cus * per_cu; if (grid > 256) grid = 256;
        fprintf(stderr, "kernel_launch: grid %d (cus %d, per_cu %d)\n", grid, cus, per_cu);
    }
    if (grid < 0) return;
    Params p{};
    const float** pp = (const float**)&p;
    for (int i = 0; i < 23; ++i) pp[i] = (const float*)d_in[i];
    p.out = (float*)d_out; p.ws = (unsigned char*)d_ws;
#if MK_MULTI
    for (int ph = 0; ph < N_PHASES; ++ph) { p.ph_lo = ph; p.ph_hi = ph + 1; void* args[] = {&p};
        hipError_t e = hipLaunchCooperativeKernel((void*)mk_fwd, dim3(grid), dim3(512), args, LDS_BYTES, stream);
        if (e != hipSuccess) { fprintf(stderr, "launch %d failed: %s\n", ph, hipGetErrorString(e)); break; } }
#else
    p.ph_lo = 0; p.ph_hi = N_PHASES; void* args[] = {&p};
    hipError_t e = hipLaunchCooperativeKernel((void*)mk_fwd, dim3(grid), dim3(512), args, LDS_BYTES, stream);
    if (e != hipSuccess) fprintf(stderr, "cooperative launch failed: %s (grid %d)\n", hipGetErrorString(e), grid);
#endif
}
```

```cpp
#include <hip/hip_runtime.h>
#include <hip/hip_cooperative_groups.h>
#include <cstdio>
#include <cstdint>
namespace cg = cooperative_groups;

#ifndef MK_MULTI
#define MK_MULTI 0
#endif

namespace pg8 {
#define PG8_LAS __attribute__((address_space(3)))
typedef unsigned short bf16_t;
typedef short bf16x8 __attribute__((ext_vector_type(8)));
typedef float f32x4 __attribute__((ext_vector_type(4)));
typedef unsigned u32x4 __attribute__((ext_vector_type(4)));
constexpr int BM = 256, BK = 64, HALF = 128, HTB = HALF * BK * 2  , STAGE_BYTES = 8 * HTB, NXCD = 8, WGM = 8;

__host__ __device__ __forceinline__ int lds_byte(int r, int c) { const int st = (r >> 4) * 2 + (c >> 5), rr = r & 15, cc = c & 31, ob = rr * 64 + cc * 2; return st * 1024 + (ob ^ (((ob >> 9) & 1) << 5)); }
__host__ __device__ __forceinline__ void stage_rc(int b, int& R, int& C) { const int st = b / 1024, sb = b % 1024, swz = sb ^ (((sb >> 9) & 1) << 5); R = (st >> 1) * 16 + swz / 64; C = (st & 1) * 32 + (swz % 64) / 2; }
__host__ __device__ __forceinline__ int perm32(int rho) { const int n = rho >> 4, i = rho & 15; return 8 * (i >> 2) + 4 * n + (i & 3); }

struct Unit { int pm, pn; };
struct Gemm { const bf16_t* A; const bf16_t* Bt; int M, N, K, lda, ldb; };

struct StaticOrder {
    int nM, nN, nwg, G, c;
    __host__ __device__ void init(int M, int N, int G_, int c_) { nM = M / BM; nN = N / BM; nwg = nM * nN; G = G_; c = c_; }
    __host__ __device__ bool next(int i, Unit& u) const {
        const long L = (long)i * G + c; if (L >= nwg) return false;
        int wgid = (int)L; { const int q = nwg / NXCD, r = nwg % NXCD, xcd = wgid % NXCD, off = wgid / NXCD; wgid = (xcd < r ? xcd * (q + 1) : r * (q + 1) + (xcd - r) * q) + off; }
        const int nig = WGM * nN, gid = wgid / nig, fm = gid * WGM, gsz = (nM - fm) < WGM ? (nM - fm) : WGM;
        u.pm = fm + ((wgid % nig) % gsz); u.pn = (wgid % nig) / gsz; return true;
    }
    __device__ __forceinline__ void a_ready(const Unit&) const {}
    __device__ __forceinline__ void done(const Unit&) const {}
};

__device__ __forceinline__ unsigned cvt_pk_bf16(float lo, float hi) { unsigned r; asm volatile("v_cvt_pk_bf16_f32 %0, %1, %2" : "=v"(r) : "v"(lo), "v"(hi)); return r; }

struct EpiStore {
    static constexpr bool PERM = true, AFTER_DRAIN = false;
    bf16_t* O; int ldc; int ncols; float scale;
    __device__ __forceinline__ void operator()(const f32x4 (&acc)[2][2][4][2], const Unit& u, int wr, int wc, int fr, int fq) const {
        const int row0 = u.pm * BM + wr * 64 + fr; const int col0 = u.pn * BM + wc * 32 + 8 * fq;
#pragma unroll
        for (int ai = 0; ai < 2; ++ai)
#pragma unroll
            for (int m = 0; m < 4; ++m) { bf16_t* rowp = O + (size_t)(row0 + ai * HALF + m * 16) * ldc + col0;
#pragma unroll
                for (int bj = 0; bj < 2; ++bj) { if (col0 + bj * HALF < ncols) {
                    f32x4 v0 = acc[ai][bj][m][0] * scale, v1 = acc[ai][bj][m][1] * scale;
                    u32x4 w; w.x = cvt_pk_bf16(v0[0], v0[1]); w.y = cvt_pk_bf16(v0[2], v0[3]); w.z = cvt_pk_bf16(v1[0], v1[1]); w.w = cvt_pk_bf16(v1[2], v1[3]);
                    *(u32x4*)(rowp + bj * HALF) = w; } } }
    }
};
struct EpiResid {
    static constexpr bool PERM = false, AFTER_DRAIN = false;
    float* X; const float* gate; int row_tile0;
    __device__ __forceinline__ void operator()(const f32x4 (&acc)[2][2][4][2], const Unit& u, int wr, int wc, int fr, int fq) const {
        const int tpm = u.pm + row_tile0; const int bb = tpm / 33, jj = tpm - bb * 33; const float* gv = gate + (jj == 0 ? 2 : bb) * 6144;
        const int col0 = u.pn * BM + wc * 32 + 4 * fq;
#pragma unroll
        for (int ai = 0; ai < 2; ++ai)
#pragma unroll
            for (int m = 0; m < 4; ++m) { float* rowp = X + (size_t)(tpm * BM + ai * HALF + wr * 64 + m * 16 + fr) * 1024 + col0;
#pragma unroll
                for (int bj = 0; bj < 2; ++bj) {
#pragma unroll
                    for (int n = 0; n < 2; ++n) { f32x4* q = (f32x4*)(rowp + bj * HALF + n * 16); const f32x4 gq = *(const f32x4*)(gv + col0 + bj * HALF + n * 16); f32x4 xv = *q; xv = xv + gq * acc[ai][bj][m][n]; *q = xv; }
                    asm volatile("" ::: "memory"); } }
    }
};

template <class Epi, class Sched, bool ALIGN_EPI = false, bool SP2 = false>
__device__ __forceinline__ void gemm_phase(PG8_LAS unsigned char* lds, const Gemm g, const Sched& S, const Epi& E) {
    int tid = threadIdx.x; asm volatile("" : "+v"(tid));
    const int wid = __builtin_amdgcn_readfirstlane(tid >> 6), lane = tid & 63, wr = wid >> 2, wc = wid & 3, fr = lane & 15, fq = lane >> 4;
    int K = g.K; asm volatile("" : "+s"(K));
    const int nt = K / BK;
    unsigned voffA[2], voffB[2];
#pragma unroll
    for (int i = 0; i < 2; ++i) { int R, C; stage_rc(tid * 16 + i * 8192, R, C); const int Rb = Epi::PERM ? ((R & ~31) + perm32(R & 31)) : R;
        voffA[i] = (unsigned)(R * g.lda + C) * 2u; voffB[i] = (unsigned)(Rb * g.ldb + C) * 2u; }
    const size_t kstep = (size_t)(BK * 2);
    const size_t hstepA = (size_t)HALF * g.lda * 2, hstepB = (size_t)HALF * g.ldb * 2;
    const size_t tstepA = 2 * hstepA, tstepB = 2 * hstepB;
    const unsigned ldsw = (unsigned)wid * 1024u;
    const int aoff = lds_byte(wr * 64 + fr, fq * 8), boff = lds_byte(wc * 32 + fr, fq * 8);
#define PG8_SA(b, h) (((b) * 2 + (h)) * HTB)
#define PG8_SB(b, h) ((4 + (b) * 2 + (h)) * HTB)
#define PG8_STAGE(bufoff, gbase, voff) do { _Pragma("unroll") for (int _i = 0; _i < 2; ++_i) \
        __builtin_amdgcn_global_load_lds((const unsigned*)((const char*)(gbase) + (voff)[_i]), (PG8_LAS unsigned*)(lds + (bufoff) + ldsw + _i * 8192), 16, 0, 0); } while (0)
#define PG8_LDA(dst, b, h) do { _Pragma("unroll") for (int m = 0; m < 4; ++m) _Pragma("unroll") for (int k = 0; k < 2; ++k) dst[m][k] = *(const PG8_LAS bf16x8*)(lds + PG8_SA(b, h) + aoff + m * 2048 + k * 1024); } while (0)
#define PG8_LDB(dst, b, h) do { _Pragma("unroll") for (int n = 0; n < 2; ++n) _Pragma("unroll") for (int k = 0; k < 2; ++k) dst[n][k] = *(const PG8_LAS bf16x8*)(lds + PG8_SB(b, h) + boff + n * 2048 + k * 1024); } while (0)
#define PG8_MMA(ai, bj, At, Bt) do { __builtin_amdgcn_s_setprio(1); _Pragma("unroll") for (int m = 0; m < 4; ++m) _Pragma("unroll") for (int n = 0; n < 2; ++n) _Pragma("unroll") for (int k = 0; k < 2; ++k) \
        acc[ai][bj][m][n] = __builtin_amdgcn_mfma_f32_16x16x32_bf16(Bt[n][k], At[m][k], acc[ai][bj][m][n], 0, 0, 0); __builtin_amdgcn_s_setprio(0); } while (0)
#define PG8_WAIT_V(n) asm volatile("s_waitcnt vmcnt(" #n ")" ::: "memory")
#define PG8_WAIT_L(n) asm volatile("s_waitcnt lgkmcnt(" #n ")" ::: "memory")
#define PG8_BAR __builtin_amdgcn_s_barrier()
#define PG8_SCHED __builtin_amdgcn_sched_barrier(0)
    Unit cur, nxt; int ui = 0;
    if (!S.next(0, cur)) return;
    f32x4 acc[2][2][4][2];
#pragma unroll
    for (int a = 0; a < 2; ++a)
#pragma unroll
        for (int b = 0; b < 2; ++b)
#pragma unroll
            for (int m = 0; m < 4; ++m)
#pragma unroll
                for (int n = 0; n < 2; ++n) acc[a][b][m][n] = (f32x4){0.f, 0.f, 0.f, 0.f};
    bf16x8 At[4][2], B0[2][2], B1[2][2];
    const char* cA = (const char*)g.A + (size_t)cur.pm * tstepA; const char* cB = (const char*)g.Bt + (size_t)cur.pn * tstepB;
    S.a_ready(cur);
    if constexpr (SP2) {
        PG8_STAGE(PG8_SB(0, 0), cB, voffB); PG8_STAGE(PG8_SB(0, 1), cB + hstepB, voffB); PG8_STAGE(PG8_SA(0, 0), cA, voffA); PG8_STAGE(PG8_SA(0, 1), cA + hstepA, voffA);
        if (wr == 1) PG8_BAR;
        PG8_WAIT_V(2); PG8_BAR;
        PG8_STAGE(PG8_SB(1, 0), cB + kstep, voffB); PG8_STAGE(PG8_SA(1, 0), cA + kstep, voffA); PG8_STAGE(PG8_SB(1, 1), cB + hstepB + kstep, voffB);
        PG8_WAIT_V(6); PG8_BAR;
    } else {
        PG8_STAGE(PG8_SB(0, 0), cB, voffB); PG8_STAGE(PG8_SA(0, 0), cA, voffA); PG8_STAGE(PG8_SB(0, 1), cB + hstepB, voffB); PG8_STAGE(PG8_SA(0, 1), cA + hstepA, voffA);
        if (wr == 1) PG8_BAR;
        PG8_WAIT_V(4); PG8_BAR;
        PG8_STAGE(PG8_SB(1, 0), cB + kstep, voffB); PG8_STAGE(PG8_SA(1, 0), cA + kstep, voffA); PG8_STAGE(PG8_SB(1, 1), cB + hstepB + kstep, voffB);
        PG8_WAIT_V(6); PG8_BAR;
    }
    for (;;) {
        const bool has_next = S.next(ui + 1, nxt);
        const char* nA = has_next ? (const char*)g.A + (size_t)nxt.pm * tstepA : cA; const char* nB = has_next ? (const char*)g.Bt + (size_t)nxt.pn * tstepB : cB;
        for (int t = 0; t < nt; t += 2) {
            const bool last = (t == nt - 2);
            const char* a1 = cA + (size_t)(t + 1) * kstep;
            const char* a2 = last ? nA : cA + (size_t)(t + 2) * kstep; const char* b2 = last ? nB : cB + (size_t)(t + 2) * kstep;
            const char* a3 = a2 + kstep; const char* b3 = b2 + kstep;
            if (last && has_next) S.a_ready(nxt);
            if constexpr (SP2) {
            PG8_LDB(B0, 0, 0); PG8_LDB(B1, 0, 1); PG8_SCHED; PG8_LDA(At, 0, 0); PG8_STAGE(PG8_SA(1, 1), a1 + hstepA, voffA);
            PG8_WAIT_V(8); PG8_WAIT_L(0); PG8_BAR; PG8_MMA(0, 0, At, B0); PG8_MMA(0, 1, At, B1); PG8_BAR; PG8_SCHED;
            PG8_LDA(At, 0, 1); PG8_STAGE(PG8_SB(0, 0), b2, voffB); PG8_STAGE(PG8_SB(0, 1), b2 + hstepB, voffB); PG8_STAGE(PG8_SA(0, 0), a2, voffA);
            PG8_WAIT_V(8); PG8_WAIT_L(0); PG8_BAR; PG8_MMA(1, 0, At, B0); PG8_MMA(1, 1, At, B1); PG8_BAR; PG8_SCHED;
            PG8_LDB(B0, 1, 0); PG8_LDB(B1, 1, 1); PG8_SCHED; PG8_LDA(At, 1, 0); PG8_STAGE(PG8_SA(0, 1), a2 + hstepA, voffA);
            PG8_WAIT_V(8); PG8_WAIT_L(0); PG8_BAR; PG8_MMA(0, 0, At, B0); PG8_MMA(0, 1, At, B1); PG8_BAR; PG8_SCHED;
            PG8_LDA(At, 1, 1); PG8_STAGE(PG8_SB(1, 0), b3, voffB); PG8_STAGE(PG8_SB(1, 1), b3 + hstepB, voffB); PG8_STAGE(PG8_SA(1, 0), a3, voffA);
            PG8_WAIT_V(8); PG8_WAIT_L(0); PG8_BAR; PG8_MMA(1, 0, At, B0); PG8_MMA(1, 1, At, B1); PG8_BAR; PG8_SCHED;
            } else {
            PG8_LDB(B0, 0, 0); PG8_SCHED; PG8_LDA(At, 0, 0); PG8_STAGE(PG8_SA(1, 1), a1 + hstepA, voffA);
            PG8_WAIT_L(8); PG8_BAR; PG8_WAIT_L(0); PG8_MMA(0, 0, At, B0); PG8_BAR; PG8_SCHED;
            PG8_LDB(B1, 0, 1); PG8_STAGE(PG8_SB(0, 0), b2, voffB);
            PG8_BAR; PG8_WAIT_L(0); PG8_MMA(0, 1, At, B1); PG8_BAR;
            PG8_LDA(At, 0, 1); PG8_STAGE(PG8_SA(0, 0), a2, voffA);
            PG8_BAR; PG8_WAIT_L(0); PG8_MMA(1, 0, At, B0); PG8_BAR; PG8_SCHED;
            PG8_STAGE(PG8_SB(0, 1), b2 + hstepB, voffB);
            PG8_WAIT_V(6); PG8_BAR; PG8_MMA(1, 1, At, B1); PG8_BAR;
            PG8_LDB(B0, 1, 0); PG8_SCHED; PG8_LDA(At, 1, 0); PG8_STAGE(PG8_SA(0, 1), a2 + hstepA, voffA);
            PG8_WAIT_L(8); PG8_BAR; PG8_WAIT_L(0); PG8_MMA(0, 0, At, B0); PG8_BAR; PG8_SCHED;
            PG8_LDB(B1, 1, 1); PG8_STAGE(PG8_SB(1, 0), b3, voffB);
            PG8_BAR; PG8_WAIT_L(0); PG8_MMA(0, 1, At, B1); PG8_BAR;
            PG8_LDA(At, 1, 1); PG8_STAGE(PG8_SA(1, 0), a3, voffA);
            PG8_BAR; PG8_WAIT_L(0); PG8_MMA(1, 0, At, B0); PG8_BAR; PG8_SCHED;
            PG8_STAGE(PG8_SB(1, 1), b3 + hstepB, voffB);
            PG8_WAIT_V(6); PG8_BAR; PG8_MMA(1, 1, At, B1); PG8_BAR;
            }
        }
        if constexpr (ALIGN_EPI) { if (wr == 0) PG8_BAR; }
        if constexpr (!Epi::AFTER_DRAIN) { E(acc, cur, wr, wc, fr, fq); S.done(cur); }
        if (!has_next) break;
#pragma unroll
        for (int a = 0; a < 2; ++a)
#pragma unroll
            for (int b = 0; b < 2; ++b)
#pragma unroll
                for (int m = 0; m < 4; ++m)
#pragma unroll
                    for (int n = 0; n < 2; ++n) acc[a][b][m][n] = (f32x4){0.f, 0.f, 0.f, 0.f};
        cur = nxt; cA = nA; cB = nB; ++ui;
        if constexpr (ALIGN_EPI) { if (wr == 1) PG8_BAR; }
    }
    PG8_WAIT_V(0);
    if constexpr (!ALIGN_EPI) { if (wr == 0) PG8_BAR; }
    PG8_BAR;
    if constexpr (Epi::AFTER_DRAIN) { E.fused(acc, cur, wr, wc, fr, fq, lds, wid, lane); S.done(cur); }
#undef PG8_SA
#undef PG8_SB
#undef PG8_STAGE
#undef PG8_LDA
#undef PG8_LDB
#undef PG8_MMA
#undef PG8_WAIT_V
#undef PG8_WAIT_L
#undef PG8_BAR
#undef PG8_SCHED
}
}

#define DEV __device__ __forceinline__
#define LAS __attribute__((address_space(3)))
typedef unsigned short bf16_t;
typedef short bf16x8 __attribute__((ext_vector_type(8)));
typedef float f32x4 __attribute__((ext_vector_type(4)));
typedef float f32x2 __attribute__((ext_vector_type(2)));
typedef float f32x16 __attribute__((ext_vector_type(16)));
typedef unsigned u32x4 __attribute__((ext_vector_type(4)));
typedef unsigned u32x2 __attribute__((ext_vector_type(2)));

constexpr int R = 16896, RB = 8448, NCTX = 256, TL = 8192, DM = 1024, INW = 1696, DFF = 2816, HFF = 1408;
constexpr int NWG_T = 512;
constexpr float EPS = 1e-6f;
constexpr int LDS_BYTES = 147456;
constexpr size_t OFF_X = 0, OFF_HN = 69206016, OFF_W = 103809024, OFF_MOD = 152174592, OFF_ROPE = 152436736, OFF_OV = 153485312;
constexpr size_t OV_Q = 0, OV_KN = 25952256, OV_VT = 43253760, OV_SLOC = 60555264, OV_SIN = 69206016, OV_U = 0;
constexpr size_t WS_NEED = 250000128 + 16384;
constexpr size_t W_IN = 0, W_UQ = 1835008, W_KN = 2129920, W_V = 2260992, W_OUT = 2392064, W_UP = 3440640, W_DN = 9207808, W_LAYER = 12091392;

struct Params {
    const float *x, *c, *ctx, *c_ctx, *w_mod, *b_mod, *norm1_g, *w_in, *ret_decay_f, *ret_decay_b, *mla_q_norm_g, *w_uq, *mla_kv_norm_g, *w_ukv,
        *pool_w, *pool_scale, *w_out, *norm2_g, *w_up, *conv_w, *conv_b, *w_down, *final_norm_g;
    float* out; unsigned char* ws; int ph_lo, ph_hi;
};

DEV int otid() { int t = threadIdx.x; asm volatile("" : "+v"(t)); return t; }
DEV float bf2f(unsigned short x) { return __uint_as_float((unsigned)x << 16); }
DEV unsigned f2bf(float f) { unsigned u = __float_as_uint(f); return (u + 0x7fffu + ((u >> 16) & 1u)) >> 16; }
DEV unsigned pk2(float lo, float hi) { return f2bf(lo) | (f2bf(hi) << 16); }
DEV float wave_sum(float v) {
#pragma unroll
    for (int o = 1; o < 64; o <<= 1) v += __shfl_xor(v, o);
    return v;
}
DEV float siluf(float x) { return x / (1.0f + __expf(-x)); }
DEV int crow(int r, int hi) { return (r & 3) + 8 * (r >> 2) + 4 * hi; }
DEV bf16x8 pack8(float a0, float a1, float a2, float a3, float a4, float a5, float a6, float a7) {
    u32x4 w; w.x = pg8::cvt_pk_bf16(a0, a1); w.y = pg8::cvt_pk_bf16(a2, a3); w.z = pg8::cvt_pk_bf16(a4, a5); w.w = pg8::cvt_pk_bf16(a6, a7);
    return __builtin_bit_cast(bf16x8, w);
}
DEV int row_mi(int r) { const int b = r / RB; const int s = r - b * RB; return s < NCTX ? 2 : b; }

DEV void transpose_item(const float* W, int K, int Nsrc, bf16_t* WT, int n0, int cs, int k0, float* scr, int lane) {
#pragma unroll 8
    for (int i = 0; i < 32; ++i) { const int kk = 2 * i + (lane >> 5); scr[kk * 33 + (lane & 31)] = cs >= 0 ? W[(size_t)(k0 + kk) * Nsrc + cs + (lane & 31)] : 0.f; }
    asm volatile("s_waitcnt lgkmcnt(0)" ::: "memory");
    const int c = lane & 7;
#pragma unroll
    for (int j = 0; j < 4; ++j) { const int n = (lane >> 3) + 8 * j; const float* s = scr + (8 * c) * 33 + n;
        u32x4 o; o.x = pk2(s[0 * 33], s[1 * 33]); o.y = pk2(s[2 * 33], s[3 * 33]); o.z = pk2(s[4 * 33], s[5 * 33]); o.w = pk2(s[6 * 33], s[7 * 33]);
        *(u32x4*)(WT + (size_t)(n0 + n) * K + k0 + 8 * c) = o; }
    asm volatile("s_waitcnt lgkmcnt(0)" ::: "memory");
}
DEV int map_in(int n0) { return n0 < INW ? n0 : -1; }
DEV int map_kn(int n0) { return (n0 >> 6) * 128 + (n0 & 63); }
DEV int map_v(int n0) { return (n0 >> 6) * 128 + 64 + (n0 & 63); }
DEV int map_up(int n0) { const int hf = n0 / DFF, w = n0 - hf * DFF; return w < HFF ? hf * HFF + w : DFF + hf * HFF + (w - HFF); }

DEV void phase_prep(const Params& p, unsigned char* lds) {
    const int tid = otid(), lane = tid & 63, wid = tid >> 6;
    unsigned char* ws = p.ws;
    { f32x2* rope = (f32x2*)(ws + OFF_ROPE);
      for (int idx = blockIdx.x * NWG_T + tid; idx < TL * 16; idx += gridDim.x * NWG_T) { const int t = idx >> 4, i = idx & 15; const int pos = i < 8 ? (t >> 6) : (t & 63);
          const float inv = exp2f(-(float)(i & 7) * 0.125f * 13.287712379549449f); const float ang = (float)pos * inv; f32x2 cs; cs.x = __cosf(ang); cs.y = __sinf(ang); rope[idx] = cs; } }
    { float* scv = (float*)lds;
      float* red = scv + 3 * 1024;
      for (int i = tid; i < 3 * 1024; i += NWG_T) { const int v = i >> 10, k = i & 1023; const float cv = v < 2 ? p.c[v * 1024 + k] : p.c_ctx[k]; scv[i] = siluf(cv); }
      __syncthreads();
      float* modv = (float*)(ws + OFF_MOD);
      for (int it = blockIdx.x; it < 192; it += gridDim.x) { const int l = it / 96, col0 = (it % 96) * 64;
          const float* wm = p.w_mod + (size_t)l * 1024 * 6144 + col0 + lane; float a0 = 0.f, a1 = 0.f, a2 = 0.f;
#pragma unroll 8
          for (int k = wid * 128; k < wid * 128 + 128; ++k) { const float w = wm[(size_t)k * 6144]; a0 += scv[k] * w; a1 += scv[1024 + k] * w; a2 += scv[2048 + k] * w; }
          red[(wid * 3 + 0) * 64 + lane] = a0; red[(wid * 3 + 1) * 64 + lane] = a1; red[(wid * 3 + 2) * 64 + lane] = a2;
          __syncthreads();
          if (tid < 192) { const int v = tid >> 6, cl = tid & 63; float s = 0.f;
#pragma unroll
              for (int w = 0; w < 8; ++w) s += red[(w * 3 + v) * 64 + cl];
              modv[((size_t)l * 3 + v) * 6144 + col0 + cl] = s + p.b_mod[l * 6144 + col0 + cl]; }
          __syncthreads(); }
    }
    { float* scr = (float*)(lds + 32768 + wid * 8704);
      const int gw = blockIdx.x * 8 + wid, NGW = gridDim.x * 8;
      constexpr int I_IN = 16 * 56, I_UQ = 6 * 24, I_KN = 4 * 16, I_V = 4 * 16, I_OUT = 16 * 32, I_UP = 16 * 176, I_DN = 44 * 32, I_L = I_IN + I_UQ + I_KN + I_V + I_OUT + I_UP + I_DN;
      for (int it = gw; it < 2 * I_L; it += NGW) { const int l = it / I_L; int r = it - l * I_L; bf16_t* wl = (bf16_t*)(ws + OFF_W) + (size_t)l * W_LAYER;
          const float* src; int K, Nsrc, nbn, mp; size_t doff;
          if (r < I_IN) { src = p.w_in + (size_t)l * 1024 * INW; K = 1024; Nsrc = INW; nbn = 56; mp = 1; doff = W_IN; }
          else if ((r -= I_IN) < I_UQ) { src = p.w_uq + (size_t)l * 384 * 768; K = 384; Nsrc = 768; nbn = 24; mp = 0; doff = W_UQ; }
          else if ((r -= I_UQ) < I_KN) { src = p.w_ukv + (size_t)l * 256 * 1024; K = 256; Nsrc = 1024; nbn = 16; mp = 2; doff = W_KN; }
          else if ((r -= I_KN) < I_V) { src = p.w_ukv + (size_t)l * 256 * 1024; K = 256; Nsrc = 1024; nbn = 16; mp = 3; doff = W_V; }
          else if ((r -= I_V) < I_OUT) { src = p.w_out + (size_t)l * 1024 * 1024; K = 1024; Nsrc = 1024; nbn = 32; mp = 0; doff = W_OUT; }
          else if ((r -= I_OUT) < I_UP) { src = p.w_up + (size_t)l * 1024 * 5632; K = 1024; Nsrc = 5632; nbn = 176; mp = 4; doff = W_UP; }
          else { r -= I_UP; src = p.w_down + (size_t)l * DFF * 1024; K = DFF; Nsrc = 1024; nbn = 32; mp = 0; doff = W_DN; }
          const int kb = r / nbn, nb = r - kb * nbn, n0 = nb * 32;
          const int cs = mp == 0 ? n0 : mp == 1 ? map_in(n0) : mp == 2 ? map_kn(n0) : mp == 3 ? map_v(n0) : map_up(n0);
          transpose_item(src, K, Nsrc, wl + doff, n0, cs, kb * 64, scr, lane); }
    }
}

DEV void phase_norm(const Params& p, int l, int which, bool first) {
    const int tid = otid(); const int lane = tid & 63, wid = tid >> 6; const int gw = blockIdx.x * 8 + wid, NGW = gridDim.x * 8;
    float* X = (float*)(p.ws + OFF_X); bf16_t* HN = (bf16_t*)(p.ws + OFF_HN);
    const float* modv = (const float*)(p.ws + OFF_MOD) + (size_t)l * 3 * 6144;
    const float* g = (which == 0 ? p.norm1_g : p.norm2_g) + l * 1024;
    for (int r = gw; r < R; r += NGW) {
        const int b = r / RB, s = r - b * RB; const int mi = s < NCTX ? 2 : b;
        const float* src = first ? (s < NCTX ? p.ctx + ((size_t)b * NCTX + s) * 1024 : p.x + ((size_t)b * TL + (s - NCTX)) * 1024) : X + (size_t)r * 1024;
        const f32x4* xr = (const f32x4*)src + lane; f32x4 v[4]; float ss = 0.f;
#pragma unroll
        for (int j = 0; j < 4; ++j) { v[j] = xr[64 * j]; ss += (v[j].x * v[j].x + v[j].y * v[j].y) + (v[j].z * v[j].z + v[j].w * v[j].w); }
        if (first) { f32x4* xo = (f32x4*)(X + (size_t)r * 1024) + lane;
#pragma unroll
            for (int j = 0; j < 4; ++j) xo[64 * j] = v[j]; }
        const float rs = rsqrtf(wave_sum(ss) * (1.f / 1024.f) + EPS);
        const float* mv = modv + mi * 6144 + (which == 0 ? 0 : 3072);
        u32x2* o8 = (u32x2*)(HN + (size_t)r * 1024) + lane;
#pragma unroll
        for (int j = 0; j < 4; ++j) { const f32x4 gg = ((const f32x4*)g)[lane + 64 * j], sh = ((const f32x4*)mv)[lane + 64 * j], sc = ((const f32x4*)(mv + 1024))[lane + 64 * j];
            const f32x4 y = v[j] * rs * gg; const f32x4 h = y * (sc + 1.0f) + sh; u32x2 w; w.x = pk2(h.x, h.y); w.y = pk2(h.z, h.w); o8[64 * j] = w; }
    }
}
DEV void phase_final(const Params& p) {
    const int tid = otid(); const int lane = tid & 63, wid = tid >> 6; const int gw = blockIdx.x * 8 + wid, NGW = gridDim.x * 8;
    const float* X = (const float*)(p.ws + OFF_X);
    for (int q = gw; q < 2 * TL; q += NGW) { const int b = q / TL, t = q - b * TL; const int r = b * RB + NCTX + t;
        const f32x4* xr = (const f32x4*)(X + (size_t)r * 1024) + lane; f32x4 v[4]; float ss = 0.f;
#pragma unroll
        for (int j = 0; j < 4; ++j) { v[j] = xr[64 * j]; ss += (v[j].x * v[j].x + v[j].y * v[j].y) + (v[j].z * v[j].z + v[j].w * v[j].w); }
        const float rs = rsqrtf(wave_sum(ss) * (1.f / 1024.f) + EPS);
        f32x4* o = (f32x4*)(p.out + (size_t)q * 1024) + lane;
#pragma unroll
        for (int j = 0; j < 4; ++j) { const f32x4 gg = ((const f32x4*)p.final_norm_g)[lane + 64 * j]; o[64 * j] = v[j] * rs * gg; } }
}

DEV void phase_rowwise(const Params& p, int l) {
    const int tid = otid(); const int lane = tid & 63, wid = tid >> 6; const int gw = blockIdx.x * 8 + wid, NGW = gridDim.x * 8;
    bf16_t* P = (bf16_t*)p.out; const f32x2* rope = (const f32x2*)(p.ws + OFF_ROPE);
    const float* qg = p.mla_q_norm_g + l * 384; const float* kg = p.mla_kv_norm_g + l * 256;
    for (int r = gw; r < R; r += NGW) {
        bf16_t* pr = P + (size_t)r * INW; const int b = r / RB, s = r - b * RB;
        { unsigned* q2 = (unsigned*)(pr + 768) + lane; unsigned w[3]; float ss = 0.f;
#pragma unroll
          for (int j = 0; j < 3; ++j) { w[j] = q2[64 * j]; const float a = bf2f(w[j] & 0xffff), c2 = bf2f(w[j] >> 16); ss += a * a + c2 * c2; }
          const float rs = rsqrtf(wave_sum(ss) * (1.f / 384.f) + EPS);
#pragma unroll
          for (int j = 0; j < 3; ++j) { const int c0 = 2 * (lane + 64 * j); q2[64 * j] = pk2(bf2f(w[j] & 0xffff) * rs * qg[c0], bf2f(w[j] >> 16) * rs * qg[c0 + 1]); } }
        { u32x2* k4 = (u32x2*)(pr + 1152) + lane; const u32x2 w = *k4;
          const float a0 = bf2f(w.x & 0xffff), a1 = bf2f(w.x >> 16), a2 = bf2f(w.y & 0xffff), a3 = bf2f(w.y >> 16);
          const float rs = rsqrtf(wave_sum((a0 * a0 + a1 * a1) + (a2 * a2 + a3 * a3)) * (1.f / 256.f) + EPS);
          const f32x4 gg = ((const f32x4*)kg)[lane]; u32x2 o; o.x = pk2(a0 * rs * gg.x, a1 * rs * gg.y); o.y = pk2(a2 * rs * gg.z, a3 * rs * gg.w); *k4 = o; }
        if (s >= NCTX && lane < 16) { const f32x2 cs = rope[(s - NCTX) * 16 + lane];
          const float x1 = bf2f(pr[1408 + lane]), x2 = bf2f(pr[1408 + 16 + lane]);
          pr[1408 + lane] = (bf16_t)f2bf(x1 * cs.x - x2 * cs.y); pr[1408 + 16 + lane] = (bf16_t)f2bf(x2 * cs.x + x1 * cs.y); }
    }
}

DEV void pool_item(const Params& p, int l, unsigned char* lds, int it) {
    const int tid = otid(); const bf16_t* P = (const bf16_t*)p.out; bf16_t* MIX = (bf16_t*)(p.ws + OFF_HN);
    float* dl = (float*)lds;
    float* Wl = dl + 64 * 256;
    const int r0 = it * 64; const int b = r0 / RB, s0 = r0 - b * RB; const int seq0 = s0 < NCTX ? b * RB : b * RB + NCTX; const int T = s0 < NCTX ? NCTX : TL;
    for (int i = tid; i < 4 * 64 * 64; i += NWG_T) Wl[i] = p.pool_w[(size_t)l * 16384 + i];
    { const int ch = tid & 255, g = ch >> 6, half = 1 << g;
      for (int rr = tid >> 8; rr < 64; rr += 2) { const int t = r0 + rr - seq0; const int lo = max(t - half, 0), hi = min(t + half, T); float sum = 0.f;
          for (int tt = lo; tt < hi; ++tt) sum += bf2f(P[(size_t)(seq0 + tt) * INW + 1440 + ch]);
          dl[rr * 256 + ch] = sum / (float)(hi - lo) - bf2f(P[(size_t)(r0 + rr) * INW + 1440 + ch]); } }
    __syncthreads();
    { const int o = tid & 255, g = o >> 6, dd = o & 63, rh = tid >> 8; float acc[32];
#pragma unroll
      for (int i = 0; i < 32; ++i) acc[i] = 0.f;
      for (int c4 = 0; c4 < 16; ++c4) { const float w0 = Wl[(g * 64 + 4 * c4 + 0) * 64 + dd], w1 = Wl[(g * 64 + 4 * c4 + 1) * 64 + dd], w2 = Wl[(g * 64 + 4 * c4 + 2) * 64 + dd], w3 = Wl[(g * 64 + 4 * c4 + 3) * 64 + dd];
#pragma unroll
          for (int i = 0; i < 32; ++i) { const f32x4 d4 = *(const f32x4*)(dl + (rh * 32 + i) * 256 + g * 64 + 4 * c4); acc[i] += (d4.x * w0 + d4.y * w1) + (d4.z * w2 + d4.w * w3); } }
      const float sc = p.pool_scale[l * 256 + o];
#pragma unroll
      for (int i = 0; i < 32; ++i) MIX[(size_t)(r0 + rh * 32 + i) * 1024 + 768 + o] = (bf16_t)f2bf(acc[i] * sc); }
    __syncthreads();
}

DEV float log2_sigmoid(float d) { return -log1pf(__expf(-d)) * 1.4426950408889634f; }
DEV void states_item(const Params& p, int l, unsigned char* lds, int gc) {
    const int tid = otid(); const bf16_t* P = (const bf16_t*)p.out; const f32x2* rope = (const f32x2*)(p.ws + OFF_ROPE);
    float* SLOC = (float*)(p.ws + OFF_OV + OV_SLOC);
    bf16_t* kk = (bf16_t*)lds;
    bf16_t* vv = kk + 4 * 128 * 32;
    float* dec = (float*)(vv + 128 * 256);
    const int cb = gc % 66; const bool lat = cb >= 2; const int t0 = (cb - 2) * 128; const int r0 = gc * 128;
    for (int i = tid; i < 1024; i += NWG_T) { const int h = i >> 8, dir = (i >> 7) & 1, idx = i & 127;
        const float lg = log2_sigmoid((dir == 0 ? p.ret_decay_f : p.ret_decay_b)[l * 4 + h]); dec[i] = exp2f(lg * (dir == 0 ? (float)(127 - idx) : (float)idx)); }
    for (int task = tid; task < 1024; task += NWG_T) { const int tok = task >> 3, h = (task >> 1) & 3, c = task & 1;
        const bf16_t* src = P + (size_t)(r0 + tok) * INW + 128 + h * 32 + 8 * c; const bf16x8 lo = *(const bf16x8*)src, hi = *(const bf16x8*)(src + 16);
        float o1[8], o2[8];
#pragma unroll
        for (int j = 0; j < 8; ++j) { float x1 = bf2f((unsigned short)lo[j]), x2 = bf2f((unsigned short)hi[j]);
            if (lat) { const f32x2 cs = rope[(t0 + tok) * 16 + 8 * c + j]; const float y1 = x1 * cs.x - x2 * cs.y, y2 = x2 * cs.x + x1 * cs.y; x1 = y1; x2 = y2; }
            o1[j] = x1 * 0.17677669529663687f; o2[j] = x2 * 0.17677669529663687f; }
        bf16_t* dst = kk + (h * 128 + tok) * 32 + 8 * c;
        *(bf16x8*)dst = pack8(o1[0], o1[1], o1[2], o1[3], o1[4], o1[5], o1[6], o1[7]); *(bf16x8*)(dst + 16) = pack8(o2[0], o2[1], o2[2], o2[3], o2[4], o2[5], o2[6], o2[7]); }
    for (int task = tid; task < 4096; task += NWG_T) { const int tok = task >> 5, ch = task & 31; *(u32x4*)(vv + tok * 256 + ch * 8) = *(const u32x4*)(P + (size_t)(r0 + tok) * INW + 256 + ch * 8); }
    __syncthreads();
    { const int h = tid >> 7, d = (tid >> 2) & 31, dvg = tid & 3; float af[16], ab[16];
#pragma unroll
      for (int j = 0; j < 16; ++j) { af[j] = 0.f; ab[j] = 0.f; }
      for (int i = 0; i < 128; ++i) { const float kv = bf2f(kk[(h * 128 + i) * 32 + d]); const float kf = kv * dec[(h * 2 + 0) * 128 + i], kb = kv * dec[(h * 2 + 1) * 128 + i];
          const bf16x8 v0 = *(const bf16x8*)(vv + i * 256 + h * 64 + dvg * 16), v1 = *(const bf16x8*)(vv + i * 256 + h * 64 + dvg * 16 + 8);
#pragma unroll
          for (int j = 0; j < 8; ++j) { const float a = bf2f((unsigned short)v0[j]), c2 = bf2f((unsigned short)v1[j]); af[j] += kf * a; ab[j] += kb * a; af[8 + j] += kf * c2; ab[8 + j] += kb * c2; } }
      float* of = SLOC + ((size_t)(gc * 4 + h) * 2 + 0) * 2048 + d * 64 + dvg * 16; float* ob = of + 2048;
#pragma unroll
      for (int j = 0; j < 4; ++j) { ((f32x4*)of)[j] = (f32x4){af[4 * j], af[4 * j + 1], af[4 * j + 2], af[4 * j + 3]}; ((f32x4*)ob)[j] = (f32x4){ab[4 * j], ab[4 * j + 1], ab[4 * j + 2], ab[4 * j + 3]}; } }
    __syncthreads();
}
DEV void scan_threads(const Params& p, int l, int gid) {
    if (gid >= 32768) return;
    const int e = gid & 2047, dir = (gid >> 11) & 1, h = (gid >> 12) & 3, b = gid >> 14;
    const float* SLOC = (const float*)(p.ws + OFF_OV + OV_SLOC); float* SIN = (float*)(p.ws + OFF_OV + OV_SIN);
    const float gC = exp2f(log2_sigmoid((dir == 0 ? p.ret_decay_f : p.ret_decay_b)[l * 4 + h]) * 128.f);
    float S = 0.f;
#pragma unroll 6
    for (int st = 0; st < 66; ++st) { const int cb = dir == 0 ? st : (st < 2 ? 1 - st : 67 - st); const size_t idx = ((size_t)((b * 66 + cb) * 4 + h) * 2 + dir) * 2048 + e;
        const float v = SLOC[idx]; SIN[idx] = S; S = S * gC + v; }
}

constexpr int AT_KP = 208, AT_VP = 136, AT_KB = 64 * AT_KP, AT_BUF = AT_KB + 64 * AT_VP;
DEV void attn_unit(const Params& p, unsigned char* lds, int u) {
    const int tid = otid(), lane = tid & 63, wid = tid >> 6, l32 = lane & 31, hi = lane >> 5;
    const bf16_t* Q = (const bf16_t*)(p.ws + OFF_OV + OV_Q); const bf16_t* KN = (const bf16_t*)(p.ws + OFF_OV + OV_KN); const bf16_t* VT = (const bf16_t*)(p.ws + OFF_OV + OV_VT);
    const bf16_t* P = (const bf16_t*)p.out; bf16_t* MIX = (bf16_t*)(p.ws + OFF_HN); const f32x2* rope = (const f32x2*)(p.ws + OFF_ROPE);
    const bool isctx = u >= 512; int b, h, qrow0, NT;
    if (!isctx) { b = u >> 8; h = (u >> 5) & 7; qrow0 = b * RB + NCTX + (u & 31) * 256; NT = 132; } else { const int v = u - 512; b = v >> 3; h = v & 7; qrow0 = b * RB; NT = 4; }
    const int krow0 = b * RB; const int qrow = qrow0 + wid * 32 + l32;
    bf16x8 qf[6];
    { const bf16_t* qp = Q + (size_t)qrow * 768 + h * 96 + hi * 8;
#pragma unroll
      for (int d0 = 0; d0 < 6; ++d0) qf[d0] = *(const bf16x8*)(qp + d0 * 16);
      if (!isctx) { const f32x2* rp = rope + (size_t)(qrow - (b * RB + NCTX)) * 16 + hi * 8;
#pragma unroll
          for (int j = 0; j < 8; ++j) { const f32x2 cs = rp[j]; const float x1 = bf2f((unsigned short)qf[4][j]), x2 = bf2f((unsigned short)qf[5][j]);
              qf[4][j] = (short)f2bf(x1 * cs.x - x2 * cs.y); qf[5][j] = (short)f2bf(x2 * cs.x + x1 * cs.y); } } }
    const bf16_t* sp[3]; int sstep[3], lo[3];
#pragma unroll
    for (int k = 0; k < 3; ++k) { const int c = tid + k * 512;
        if (c < 768) { const int key = c / 12, part = c - key * 12; lo[k] = key * AT_KP + part * 16;
            if (part < 8) { sp[k] = KN + (size_t)(krow0 + key) * 512 + h * 64 + part * 8; sstep[k] = 64 * 512; } else { sp[k] = P + (size_t)(krow0 + key) * INW + 1408 + (part - 8) * 8; sstep[k] = 64 * INW; } }
        else { const int cc = c - 768, dv = cc >> 3, kc = cc & 7; lo[k] = AT_KB + dv * AT_VP + kc * 16; sp[k] = VT + (size_t)(h * 64 + dv) * R + krow0 + kc * 8; sstep[k] = 64; } }
    const bool has3 = tid < 256;
    u32x4 st[3];
#define AT_GLOAD() do { st[0] = *(const u32x4*)sp[0]; sp[0] += sstep[0]; st[1] = *(const u32x4*)sp[1]; sp[1] += sstep[1]; if (has3) { st[2] = *(const u32x4*)sp[2]; sp[2] += sstep[2]; } } while (0)
#define AT_LSTORE1(buf, k) do { unsigned char* d_ = (buf) + lo[k]; if (lo[k] < AT_KB) { *(u32x4*)d_ = st[k]; } else { *(u32x2*)d_ = (u32x2){st[k].x, st[k].y}; *(u32x2*)(d_ + 8) = (u32x2){st[k].z, st[k].w}; } } while (0)
#define AT_LSTORE(buf) do { AT_LSTORE1(buf, 0); AT_LSTORE1(buf, 1); if (has3) AT_LSTORE1(buf, 2); } while (0)
    f32x16 o0, o1;
#pragma unroll
    for (int r = 0; r < 16; ++r) { o0[r] = 0.f; o1[r] = 0.f; }
    float mrun = -1e30f, lsum = 0.f;
    __syncthreads();
    AT_GLOAD(); AT_LSTORE(lds);
    __syncthreads();
    for (int t = 0; t < NT; ++t) {
        unsigned char* kbuf = lds + (t & 1) * AT_BUF; unsigned char* vbuf = kbuf + AT_KB; unsigned char* nbuf = lds + ((t + 1) & 1) * AT_BUF;
        const bool more = t + 1 < NT;
        if (more) AT_GLOAD();
        f32x16 s0, s1;
#pragma unroll
        for (int r = 0; r < 16; ++r) { s0[r] = 0.f; s1[r] = 0.f; }
        { const unsigned char* ka = kbuf + l32 * AT_KP + hi * 16;
#pragma unroll
          for (int d0 = 0; d0 < 6; ++d0) { const bf16x8 a0 = *(const bf16x8*)(ka + d0 * 32), a1 = *(const bf16x8*)(ka + 32 * AT_KP + d0 * 32);
              s0 = __builtin_amdgcn_mfma_f32_32x32x16_bf16(a0, qf[d0], s0, 0, 0, 0); s1 = __builtin_amdgcn_mfma_f32_32x32x16_bf16(a1, qf[d0], s1, 0, 0, 0); } }
        float mx = fmaxf(s0[0], s1[0]);
#pragma unroll
        for (int r = 1; r < 16; ++r) mx = fmaxf(mx, fmaxf(s0[r], s1[r]));
        mx = fmaxf(mx, __shfl_xor(mx, 32));
        const float mn = fmaxf(mrun, mx); const float alpha = __builtin_amdgcn_exp2f(mrun - mn); mrun = mn;
        float ls = 0.f;
#pragma unroll
        for (int r = 0; r < 16; ++r) { s0[r] = __builtin_amdgcn_exp2f(s0[r] - mn); s1[r] = __builtin_amdgcn_exp2f(s1[r] - mn); ls += s0[r] + s1[r]; }
        lsum = lsum * alpha + ls;
#pragma unroll
        for (int r = 0; r < 16; ++r) { o0[r] *= alpha; o1[r] *= alpha; }
        { const unsigned char* va = vbuf + l32 * AT_VP + hi * 8;
#pragma unroll
          for (int kb = 0; kb < 2; ++kb)
#pragma unroll
              for (int jp = 0; jp < 2; ++jp) { const f32x16& s = kb == 0 ? s0 : s1;
                  const bf16x8 pb = pack8(s[8 * jp + 0], s[8 * jp + 1], s[8 * jp + 2], s[8 * jp + 3], s[8 * jp + 4], s[8 * jp + 5], s[8 * jp + 6], s[8 * jp + 7]);
                  const unsigned char* vp = va + (32 * kb + 16 * jp) * 2;
                  const u32x2 a00 = *(const u32x2*)vp, a01 = *(const u32x2*)(vp + 16), a10 = *(const u32x2*)(vp + 32 * AT_VP), a11 = *(const u32x2*)(vp + 32 * AT_VP + 16);
                  const bf16x8 A0 = __builtin_bit_cast(bf16x8, (u32x4){a00.x, a00.y, a01.x, a01.y}), A1 = __builtin_bit_cast(bf16x8, (u32x4){a10.x, a10.y, a11.x, a11.y});
                  o0 = __builtin_amdgcn_mfma_f32_32x32x16_bf16(A0, pb, o0, 0, 0, 0); o1 = __builtin_amdgcn_mfma_f32_32x32x16_bf16(A1, pb, o1, 0, 0, 0); } }
        if (more) AT_LSTORE(nbuf);
        __syncthreads();
    }
    lsum += __shfl_xor(lsum, 32);
    const float inv = 1.0f / lsum;
    bf16_t* op = MIX + (size_t)qrow * 1024 + 256 + h * 64 + 4 * hi;
#pragma unroll
    for (int g4 = 0; g4 < 4; ++g4) { u32x2 w0, w1; w0.x = pk2(o0[4 * g4] * inv, o0[4 * g4 + 1] * inv); w0.y = pk2(o0[4 * g4 + 2] * inv, o0[4 * g4 + 3] * inv);
        w1.x = pk2(o1[4 * g4] * inv, o1[4 * g4 + 1] * inv); w1.y = pk2(o1[4 * g4 + 2] * inv, o1[4 * g4 + 3] * inv);
        *(u32x2*)(op + 8 * g4) = w0; *(u32x2*)(op + 32 + 8 * g4) = w1; }
#undef AT_GLOAD
#undef AT_LSTORE1
#undef AT_LSTORE
}

constexpr int RT_VP = 264, RT_SP = 144, RT_VB = 2 * 64 * RT_VP;
DEV void retout_unit(const Params& p, int l, unsigned char* lds, int u) {
    const int tid = otid(), lane = tid & 63, wid = tid >> 6, l32 = lane & 31, hi = lane >> 5;
    const int gc = u >> 1, hp = u & 1; const int cb = gc % 66; const bool lat = cb >= 2; const int t0 = (cb - 2) * 128; const int r0 = gc * 128;
    const bf16_t* P = (const bf16_t*)p.out; bf16_t* MIX = (bf16_t*)(p.ws + OFF_HN); const f32x2* rope = (const f32x2*)(p.ws + OFF_ROPE);
    const float* SIN = (const float*)(p.ws + OFF_OV + OV_SIN);
    bf16_t* VTl = (bf16_t*)lds; bf16_t* STl = (bf16_t*)(lds + RT_VB);
    __syncthreads();
    for (int task = tid; task < 2048; task += NWG_T) { const int hh = task >> 10, key = (task >> 3) & 127, ch = task & 7;
        const bf16x8 v = *(const bf16x8*)(P + (size_t)(r0 + key) * INW + 256 + (2 * hp + hh) * 64 + ch * 8);
#pragma unroll
        for (int j = 0; j < 8; ++j) VTl[(hh * 64 + ch * 8 + j) * (RT_VP / 2) + key] = (bf16_t)v[j]; }
    for (int task = tid; task < 8192; task += NWG_T) { const int dv = task & 63, k = (task >> 6) & 31, dir = (task >> 11) & 1, hh = task >> 12;
        STl[(hh * 64 + dv) * (RT_SP / 2) + dir * 32 + k] = (bf16_t)f2bf(SIN[((size_t)(gc * 4 + 2 * hp + hh) * 2 + dir) * 2048 + k * 64 + dv]); }
    __syncthreads();
    const int hh = wid >> 2, h = 2 * hp + hh, qblk = wid & 3; const int n = 32 * qblk + l32; const int rq = r0 + n;
    const float lf = log2_sigmoid(p.ret_decay_f[l * 4 + h]), lb = log2_sigmoid(p.ret_decay_b[l * 4 + h]);
    float qv0[8], qv1[8]; bf16x8 qf0, qf1;
    { const bf16_t* qp = P + (size_t)rq * INW + h * 32 + 8 * hi; const bf16x8 a = *(const bf16x8*)qp, c2 = *(const bf16x8*)(qp + 16);
#pragma unroll
      for (int j = 0; j < 8; ++j) { float x1 = bf2f((unsigned short)a[j]), x2 = bf2f((unsigned short)c2[j]);
          if (lat) { const f32x2 cs = rope[(size_t)(t0 + n) * 16 + 8 * hi + j]; const float y1 = x1 * cs.x - x2 * cs.y, y2 = x2 * cs.x + x1 * cs.y; x1 = y1; x2 = y2; }
          qv0[j] = x1; qv1[j] = x2; }
      qf0 = pack8(qv0[0], qv0[1], qv0[2], qv0[3], qv0[4], qv0[5], qv0[6], qv0[7]); qf1 = pack8(qv1[0], qv1[1], qv1[2], qv1[3], qv1[4], qv1[5], qv1[6], qv1[7]); }
    f32x16 o0, o1;
#pragma unroll
    for (int r = 0; r < 16; ++r) { o0[r] = 0.f; o1[r] = 0.f; }
    const unsigned char* vbase = (const unsigned char*)VTl + (size_t)(hh * 64 + l32) * RT_VP + hi * 8;
#pragma unroll
    for (int kb = 0; kb < 4; ++kb) {
        bf16x8 kf0, kf1;
        { const int key = 32 * kb + l32; const bf16_t* kp = P + (size_t)(r0 + key) * INW + 128 + h * 32 + 8 * hi; const bf16x8 a = *(const bf16x8*)kp, c2 = *(const bf16x8*)(kp + 16);
          float y1[8], y2[8];
#pragma unroll
          for (int j = 0; j < 8; ++j) { float x1 = bf2f((unsigned short)a[j]), x2 = bf2f((unsigned short)c2[j]);
              if (lat) { const f32x2 cs = rope[(size_t)(t0 + key) * 16 + 8 * hi + j]; const float z1 = x1 * cs.x - x2 * cs.y, z2 = x2 * cs.x + x1 * cs.y; x1 = z1; x2 = z2; }
              y1[j] = x1 * 0.17677669529663687f; y2[j] = x2 * 0.17677669529663687f; }
          kf0 = pack8(y1[0], y1[1], y1[2], y1[3], y1[4], y1[5], y1[6], y1[7]); kf1 = pack8(y2[0], y2[1], y2[2], y2[3], y2[4], y2[5], y2[6], y2[7]); }
        f32x16 s;
#pragma unroll
        for (int r = 0; r < 16; ++r) s[r] = 0.f;
        s = __builtin_amdgcn_mfma_f32_32x32x16_bf16(kf0, qf0, s, 0, 0, 0); s = __builtin_amdgcn_mfma_f32_32x32x16_bf16(kf1, qf1, s, 0, 0, 0);
#pragma unroll
        for (int r = 0; r < 16; ++r) { const int m = 32 * kb + crow(r, hi); const int dl = n - m; const float e = dl >= 0 ? lf * (float)dl : lb * (float)(-dl); s[r] *= __builtin_amdgcn_exp2f(e); }
#pragma unroll
        for (int jp = 0; jp < 2; ++jp) { const bf16x8 pb = pack8(s[8 * jp + 0], s[8 * jp + 1], s[8 * jp + 2], s[8 * jp + 3], s[8 * jp + 4], s[8 * jp + 5], s[8 * jp + 6], s[8 * jp + 7]);
            const unsigned char* vp = vbase + (32 * kb + 16 * jp) * 2;
            const u32x2 a00 = *(const u32x2*)vp, a01 = *(const u32x2*)(vp + 16), a10 = *(const u32x2*)(vp + 32 * RT_VP), a11 = *(const u32x2*)(vp + 32 * RT_VP + 16);
            const bf16x8 A0 = __builtin_bit_cast(bf16x8, (u32x4){a00.x, a00.y, a01.x, a01.y}), A1 = __builtin_bit_cast(bf16x8, (u32x4){a10.x, a10.y, a11.x, a11.y});
            o0 = __builtin_amdgcn_mfma_f32_32x32x16_bf16(A0, pb, o0, 0, 0, 0); o1 = __builtin_amdgcn_mfma_f32_32x32x16_bf16(A1, pb, o1, 0, 0, 0); }
    }
    { const float df = __builtin_amdgcn_exp2f(lf * (float)(n + 1)), db = __builtin_amdgcn_exp2f(lb * (float)(128 - n));
      const unsigned char* sbase = (const unsigned char*)STl + (size_t)(hh * 64 + l32) * RT_SP + hi * 16;
#pragma unroll
      for (int ks = 0; ks < 4; ++ks) { const float dd = ks < 2 ? df : db;
          const bf16x8 qb = (ks & 1) ? pack8(qv1[0] * dd, qv1[1] * dd, qv1[2] * dd, qv1[3] * dd, qv1[4] * dd, qv1[5] * dd, qv1[6] * dd, qv1[7] * dd)
                                     : pack8(qv0[0] * dd, qv0[1] * dd, qv0[2] * dd, qv0[3] * dd, qv0[4] * dd, qv0[5] * dd, qv0[6] * dd, qv0[7] * dd);
          const bf16x8 A0 = *(const bf16x8*)(sbase + ks * 32), A1 = *(const bf16x8*)(sbase + 32 * RT_SP + ks * 32);
          o0 = __builtin_amdgcn_mfma_f32_32x32x16_bf16(A0, qb, o0, 0, 0, 0); o1 = __builtin_amdgcn_mfma_f32_32x32x16_bf16(A1, qb, o1, 0, 0, 0); } }
    float ssq = 0.f;
#pragma unroll
    for (int r = 0; r < 16; ++r) ssq += o0[r] * o0[r] + o1[r] * o1[r];
    ssq += __shfl_xor(ssq, 32);
    const float rstd = rsqrtf(ssq * (1.f / 64.f) + EPS);
    const bf16_t* gp = P + (size_t)rq * INW + 512 + h * 64 + 4 * hi; bf16_t* op = MIX + (size_t)rq * 1024 + h * 64 + 4 * hi;
#pragma unroll
    for (int g4 = 0; g4 < 4; ++g4) { const u32x2 ga = *(const u32x2*)(gp + 8 * g4), gb = *(const u32x2*)(gp + 32 + 8 * g4);
        u32x2 w0, w1;
        w0.x = pk2(o0[4 * g4] * rstd * siluf(bf2f(ga.x & 0xffff)), o0[4 * g4 + 1] * rstd * siluf(bf2f(ga.x >> 16))); w0.y = pk2(o0[4 * g4 + 2] * rstd * siluf(bf2f(ga.y & 0xffff)), o0[4 * g4 + 3] * rstd * siluf(bf2f(ga.y >> 16)));
        w1.x = pk2(o1[4 * g4] * rstd * siluf(bf2f(gb.x & 0xffff)), o1[4 * g4 + 1] * rstd * siluf(bf2f(gb.x >> 16))); w1.y = pk2(o1[4 * g4 + 2] * rstd * siluf(bf2f(gb.y & 0xffff)), o1[4 * g4 + 3] * rstd * siluf(bf2f(gb.y >> 16)));
        *(u32x2*)(op + 8 * g4) = w0; *(u32x2*)(op + 32 + 8 * g4) = w1; }
}

DEV void phase_convact(const Params& p, int l, int hf) {
    const bf16_t* U = (const bf16_t*)(p.ws + OFF_OV + OV_U); bf16_t* ACT = (bf16_t*)p.out;
    const float* cw = p.conv_w + (size_t)l * 3 * 5632; const float* cbv = p.conv_b + (size_t)l * 5632;
    const int total = R * 176;
    for (int idx = blockIdx.x * NWG_T + otid(); idx < total; idx += gridDim.x * NWG_T) {
        const int r = idx / 176, j8 = idx - r * 176; const int b = r / RB, s = r - b * RB;
        const bool hasp = (s != 0) && (s != NCTX), hasn = (s != NCTX - 1) && (s != RB - 1);
        const bf16_t* ur = U + (size_t)r * DFF + j8 * 8; const bf16x8 z = {0, 0, 0, 0, 0, 0, 0, 0};
        const bf16x8 a1 = *(const bf16x8*)ur, b1 = *(const bf16x8*)(ur + HFF);
        const bf16x8 a0 = hasp ? *(const bf16x8*)(ur - DFF) : z, b0 = hasp ? *(const bf16x8*)(ur - DFF + HFF) : z;
        const bf16x8 a2 = hasn ? *(const bf16x8*)(ur + DFF) : z, b2 = hasn ? *(const bf16x8*)(ur + DFF + HFF) : z;
        const int ca = hf * HFF + j8 * 8, cbc = DFF + hf * HFF + j8 * 8; float o[8];
#pragma unroll
        for (int j = 0; j < 8; ++j) {
            const float ua = bf2f((unsigned short)a0[j]) * cw[ca + j] + bf2f((unsigned short)a1[j]) * cw[5632 + ca + j] + bf2f((unsigned short)a2[j]) * cw[2 * 5632 + ca + j] + cbv[ca + j];
            const float ub = bf2f((unsigned short)b0[j]) * cw[cbc + j] + bf2f((unsigned short)b1[j]) * cw[5632 + cbc + j] + bf2f((unsigned short)b2[j]) * cw[2 * 5632 + cbc + j] + cbv[cbc + j];
            o[j] = siluf(ua) * ub; }
        *(bf16x8*)(ACT + (size_t)r * HFF + j8 * 8) = pack8(o[0], o[1], o[2], o[3], o[4], o[5], o[6], o[7]);
    }
}

#define RLX_AGENT __ATOMIC_RELAXED, __HIP_MEMORY_SCOPE_AGENT
#define XB_TMO      128
#define XB_XCNT(j)  (256  + 64 * (j))
#define XB_XSUB(j)  (1280 + 64 * (j))
#define XB_XGEN(j)  (2304 + 64 * (j))
#define XB_TOP      3328
#define XB_TOPGEN   3392
#define XCD_BAR_WORDS 3456
#define XB_SPIN_CAP (1u << 18)

__device__ __forceinline__ unsigned xb_ld(unsigned* p)              { return __hip_atomic_load(p, __ATOMIC_RELAXED, __HIP_MEMORY_SCOPE_AGENT); }
__device__ __forceinline__ unsigned xb_add(unsigned* p, unsigned v) { return __hip_atomic_fetch_add(p, v, __ATOMIC_RELAXED, __HIP_MEMORY_SCOPE_AGENT); }
__device__ __forceinline__ unsigned xb_xcc_id() { return (unsigned)__builtin_amdgcn_s_getreg((3 << 11) | 20) & 0xFu; }
#define XB_SPIN(cond, bar) do { unsigned _sp = 0; while (cond) { __builtin_amdgcn_s_sleep(1); \
    if ((++_sp & 255u) == 0u) { if (xb_ld(&(bar)[XB_TMO])) break; if (_sp > XB_SPIN_CAP) { atomicAdd(&(bar)[XB_TMO], 1u); break; } } } } while (0)

struct XcdBarrier {
    unsigned* bar; unsigned x;
    volatile LAS unsigned* st;
};

__device__ __forceinline__ XcdBarrier xcd_barrier_post(unsigned* bar, volatile LAS unsigned* st) {
    XcdBarrier b; b.bar = bar; b.x = xb_xcc_id(); b.st = st;
    if (threadIdx.x == 0) (void)xb_add(&bar[XB_XCNT(b.x)], 1u);
    return b;
}
__device__ __forceinline__ void xcd_barrier_complete(unsigned* bar, unsigned x, unsigned& nloc, unsigned& nx) {
    const unsigned G = gridDim.x * gridDim.y * gridDim.z;
    unsigned sum, cnt, mine, sp = 0u;
    for (;;) {
        sum = 0u; cnt = 0u; mine = 0u;
#pragma unroll
        for (unsigned j = 0; j < 16; ++j) { const unsigned c = xb_ld(&bar[XB_XCNT(j)]); sum += c; cnt += (c > 0u) ? 1u : 0u; mine = (j == x) ? c : mine; }
        if (sum == G) break;
        __builtin_amdgcn_s_sleep(1);
        if ((++sp & 255u) == 0u) { if (xb_ld(&bar[XB_TMO])) break; if (sp > XB_SPIN_CAP) { atomicAdd(&bar[XB_TMO], 1u); break; } }
    }
    nloc = mine > 0u ? mine : 1u; nx = cnt > 0u ? cnt : 1u;
}

__device__ __forceinline__ void xcd_barrier(const XcdBarrier& b) {
    asm volatile("s_waitcnt vmcnt(0)" ::: "memory");
    __syncthreads();
    if (threadIdx.x == 0) {
        unsigned* bar = b.bar;
        __builtin_amdgcn_s_waitcnt(0);
        unsigned nloc = b.st[0], nx = b.st[1];
        if (nloc == 0u) { xcd_barrier_complete(bar, b.x, nloc, nx); b.st[0] = nloc; b.st[1] = nx; }
        const unsigned old = xb_add(&bar[XB_XSUB(b.x)], 1u);
        const unsigned gen = old / nloc;
        if (old + 1u == (gen + 1u) * nloc) {
            __builtin_amdgcn_fence(__ATOMIC_RELEASE, "agent");
            asm volatile("s_waitcnt vmcnt(0)" ::: "memory");
            const unsigned og = xb_add(&bar[XB_TOP], 1u);
            const unsigned tg = og / nx;
            if (og + 1u == (tg + 1u) * nx) xb_add(&bar[XB_TOPGEN], 1u);
            else XB_SPIN(xb_ld(&bar[XB_TOPGEN]) == tg, bar);
            __builtin_amdgcn_fence(__ATOMIC_ACQUIRE, "agent");
            xb_add(&bar[XB_XGEN(b.x)], 1u);
            asm volatile("s_waitcnt vmcnt(0)" ::: "memory");
        } else {
            XB_SPIN(xb_ld(&bar[XB_XGEN(b.x)]) == gen, bar);
            __builtin_amdgcn_fence(__ATOMIC_ACQUIRE, "agent");
            asm volatile("s_waitcnt vmcnt(0)" ::: "memory");
        }
    }
    __syncthreads();
}


constexpr size_t OFF_CTL = 250000128; constexpr int CTL_BYTES = 16384;
#if defined(__HIP_DEVICE_COMPILE__)
#define KP() const __attribute__((address_space(4))) Params* kp_ = (const __attribute__((address_space(4))) Params*)__builtin_amdgcn_kernarg_segment_ptr(); asm volatile("" : "+s"(kp_)); const Params p = *kp_; \
    bf16_t* HN = (bf16_t*)(p.ws + OFF_HN); bf16_t* P = (bf16_t*)p.out; float* X = (float*)(p.ws + OFF_X); (void)HN; (void)P; (void)X
#else
#define KP() const Params p = p_arg; bf16_t* HN = (bf16_t*)(p.ws + OFF_HN); bf16_t* P = (bf16_t*)p.out; float* X = (float*)(p.ws + OFF_X); (void)HN; (void)P; (void)X
#endif
#define WL() const bf16_t* wl = (const bf16_t*)(p.ws + OFF_W) + (size_t)l * W_LAYER; const float* modv = (const float*)(p.ws + OFF_MOD) + (size_t)l * 3 * 6144; (void)wl; (void)modv
#ifndef DUPM
#define DUPM 0
#endif
#define REP(bit) for (int rep_ = 0; rep_ < (((DUPM) >> (bit)) & 1) + 1; ++rep_)
constexpr int PH_PER_LAYER = 12, N_PHASES = 2 + 2 * PH_PER_LAYER;
__global__ void __launch_bounds__(512, 2) mk_fwd(Params p_arg) {
    extern __shared__ __attribute__((aligned(16))) unsigned char lds[];
    cg::grid_group grid = cg::this_grid();
    const int G = gridDim.x, bx = blockIdx.x; const int vcu = (G % 8 == 0) ? (bx % 8) * (G / 8) + bx / 8 : bx;
    LAS unsigned char* ldsl = (LAS unsigned char*)lds;
    const int ph_lo = p_arg.ph_lo, ph_hi = p_arg.ph_hi;
    volatile LAS unsigned* misc = (volatile LAS unsigned*)(ldsl + (LDS_BYTES - 64));
    { const int t0_ = otid(); if (t0_ < 16) misc[t0_] = 0u; }
    __syncthreads();
    if (ph_hi - ph_lo > 1) (void)xcd_barrier_post((unsigned*)(p_arg.ws + OFF_CTL), misc);
    for (int ph = ph_lo; ph < ph_hi; ++ph) {
        if (ph == 0) { KP(); REP(9) { phase_prep(p, lds); __syncthreads(); } }
        else if (ph == N_PHASES - 1) { KP(); REP(0) phase_final(p);
#if (DUPM >> 10) & 1
            for (int i = 0; i < 20; ++i) grid.sync();
#endif
        }
        else {
            const int l = (ph - 1) / PH_PER_LAYER, sp = (ph - 1) % PH_PER_LAYER;
            if (sp == 0) { KP(); REP(0) phase_norm(p, l, 0, l == 0); }
            else if (sp == 1) { KP(); WL(); REP(1) { __syncthreads();
                pg8::Gemm g{HN, wl + W_IN, R, 1792, 1024, 1024, 1024}; pg8::StaticOrder S; S.init(R, 1792, G, bx);
                pg8::EpiStore E{P, INW, INW, 1.0f};
                pg8::gemm_phase<pg8::EpiStore, pg8::StaticOrder, true, true>(ldsl, g, S, E); } }
            else if (sp == 2) { KP(); phase_rowwise(p, l); __syncthreads();
                REP(2) for (int it = bx; it < 264; it += G) pool_item(p, l, lds, it);
                REP(3) for (int it = G - 1 - bx; it < 132; it += G) states_item(p, l, lds, it); }
            else if (sp == 3) { KP(); WL(); REP(4) { __syncthreads();
                { pg8::Gemm g{P + 768, wl + W_UQ, R, 768, 384, INW, 384}; pg8::StaticOrder S; S.init(R, 768, G, bx);
                  pg8::EpiStore E{(bf16_t*)(p.ws + OFF_OV + OV_Q), 768, 768, 0.14724444f};
                  pg8::gemm_phase<pg8::EpiStore, pg8::StaticOrder, true, true>(ldsl, g, S, E); }
                __syncthreads();
                { pg8::Gemm g{P + 1152, wl + W_KN, R, 512, 256, INW, 256}; pg8::StaticOrder S; S.init(R, 512, G, (bx + 58) % G);
                  pg8::EpiStore E{(bf16_t*)(p.ws + OFF_OV + OV_KN), 512, 512, 1.0f};
                  pg8::gemm_phase<pg8::EpiStore, pg8::StaticOrder, true, true>(ldsl, g, S, E); }
                __syncthreads();
                { pg8::Gemm g{wl + W_V, P + 1152, 512, R, 256, 256, INW}; pg8::StaticOrder S; S.init(512, R, G, (bx + 182) % G);
                  pg8::EpiStore E{(bf16_t*)(p.ws + OFF_OV + OV_VT), R, R, 1.0f};
                  pg8::gemm_phase<pg8::EpiStore, pg8::StaticOrder, true, true>(ldsl, g, S, E); }
                if (bx >= G - 64) scan_threads(p, l, (bx - (G - 64)) * NWG_T + otid()); } }
            else if (sp == 4) { KP();
                REP(5) for (int u = vcu; u < 528; u += G) attn_unit(p, lds, u);
                REP(6) for (int u = G - 1 - bx; u < 264; u += G) retout_unit(p, l, lds, u); }
            else if (sp == 5) { KP(); WL(); __syncthreads();
                pg8::Gemm g{HN, wl + W_OUT, R, 1024, 1024, 1024, 1024}; pg8::StaticOrder S; S.init(R, 1024, G, bx);
                pg8::EpiResid E{X, modv + 2048, 0};
                pg8::gemm_phase<pg8::EpiResid, pg8::StaticOrder, true, true>(ldsl, g, S, E); }
            else if (sp == 6) { KP(); REP(0) phase_norm(p, l, 1, false); }
            else if (sp == 7 || sp == 9 || sp == 11) { KP(); WL();
                __syncthreads();
                if (sp >= 9) { const int hf = sp == 9 ? 0 : 1;
                    pg8::Gemm g{P, wl + W_DN + hf * HFF, R, 1024, HFF, HFF, DFF}; pg8::StaticOrder S; S.init(R, 1024, G, bx);
                    pg8::EpiResid E{X, modv + 5120, 0};
                    pg8::gemm_phase<pg8::EpiResid, pg8::StaticOrder, true, true>(ldsl, g, S, E); __syncthreads(); }
                if (sp <= 9) REP(7) { __syncthreads(); const int hf = sp == 7 ? 0 : 1;
                    pg8::Gemm g{HN, wl + W_UP + (size_t)hf * DFF * 1024, R, DFF, 1024, 1024, 1024}; pg8::StaticOrder S; S.init(R, DFF, G, (bx + (sp == 9 ? 8 : 0)) % G);
                    pg8::EpiStore E{(bf16_t*)(p.ws + OFF_OV + OV_U), DFF, DFF, 1.0f};
                    pg8::gemm_phase<pg8::EpiStore, pg8::StaticOrder, true, true>(ldsl, g, S, E); } }
            else if (sp == 8) { KP(); REP(8) phase_convact(p, l, 0); }
            else if (sp == 10) { KP(); REP(8) phase_convact(p, l, 1); }
        }
        if (ph + 1 < ph_hi) {
            if (ph == ph_lo) grid.sync();
            else { KP(); XcdBarrier b; b.bar = (unsigned*)(p.ws + OFF_CTL); b.x = xb_xcc_id(); b.st = misc; xcd_barrier(b); }
        }
    }
}

extern "C" void kernel_launch(void* const* d_in, const int* in_sizes, int n_in, void* d_out, int out_size, void* d_ws, size_t ws_size, hipStream_t stream) {
    static int grid = 0;
    if (grid == 0) {
        if (n_in != 23 || ws_size < WS_NEED) { fprintf(stderr, "kernel_launch: unexpected problem (n_in %d, ws %zu, need %zu)\n", n_in, ws_size, (size_t)WS_NEED); grid = -1; return; }
        int dev = 0, cus = 0, per_cu = 0;
        hipGetDevice(&dev); hipDeviceGetAttribute(&cus, hipDeviceAttributeMultiprocessorCount, dev);
        if (hipFuncSetAttribute((const void*)mk_fwd, hipFuncAttributeMaxDynamicSharedMemorySize, LDS_BYTES) != hipSuccess) { fprintf(stderr, "kernel_launch: hipFuncSetAttribute failed\n"); grid = -1; return; }
        if (hipOccupancyMaxActiveBlocksPerMultiprocessor(&per_cu, (const void*)mk_fwd, 512, LDS_BYTES) != hipSuccess || per_cu < 1) { fprintf(stderr, "kernel_launch: occupancy query says %d\n", per_cu); per_cu = 1; }
        (void)hipGetLastError();
        grid = cus * per_cu; if (grid > 256) grid = 256;
        fprintf(stderr, "kernel_launch: grid %d (cus %d, per_cu %d)\n", grid, cus, per_cu);
    }
    if (grid < 0) return;
    Params p{};
    const float** pp = (const float**)&p;
    for (int i = 0; i < 23; ++i) pp[i] = (const float*)d_in[i];
    p.out = (float*)d_out; p.ws = (unsigned char*)d_ws;
#if MK_MULTI
    for (int ph = 0; ph < N_PHASES; ++ph) { p.ph_lo = ph; p.ph_hi = ph + 1; void* args[] = {&p};
        hipError_t e = hipLaunchCooperativeKernel((void*)mk_fwd, dim3(grid), dim3(512), args, LDS_BYTES, stream);
        if (e != hipSuccess) { fprintf(stderr, "launch %d failed: %s\n", ph, hipGetErrorString(e)); break; } }
#else
    if (hipMemsetAsync((char*)d_ws + OFF_CTL, 0, CTL_BYTES, stream) != hipSuccess) { fprintf(stderr, "kernel_launch: memset of the barrier words failed\n"); return; }
    p.ph_lo = 0; p.ph_hi = N_PHASES; void* args[] = {&p};
    hipError_t e = hipLaunchCooperativeKernel((void*)mk_fwd, dim3(grid), dim3(512), args, LDS_BYTES, stream);
    if (e != hipSuccess) fprintf(stderr, "cooperative launch failed: %s (grid %d)\n", hipGetErrorString(e), grid);
#endif
}
```

```cpp
#include <hip/hip_runtime.h>
#include <hip/hip_cooperative_groups.h>
#include <cstdio>
#include <cstdint>
namespace cg = cooperative_groups;

#ifndef MK_MULTI
#define MK_MULTI 0
#endif

namespace pg8 {
#define PG8_LAS __attribute__((address_space(3)))
typedef unsigned short bf16_t;
typedef short bf16x8 __attribute__((ext_vector_type(8)));
typedef float f32x4 __attribute__((ext_vector_type(4)));
typedef unsigned u32x4 __attribute__((ext_vector_type(4)));
constexpr int BM = 256, BK = 64, HALF = 128, HTB = HALF * BK * 2  , STAGE_BYTES = 8 * HTB, NXCD = 8, WGM = 8;

__host__ __device__ __forceinline__ int lds_byte(int r, int c) { const int st = (r >> 4) * 2 + (c >> 5), rr = r & 15, cc = c & 31, ob = rr * 64 + cc * 2; return st * 1024 + (ob ^ (((ob >> 9) & 1) << 5)); }
__host__ __device__ __forceinline__ void stage_rc(int b, int& R, int& C) { const int st = b / 1024, sb = b % 1024, swz = sb ^ (((sb >> 9) & 1) << 5); R = (st >> 1) * 16 + swz / 64; C = (st & 1) * 32 + (swz % 64) / 2; }
__host__ __device__ __forceinline__ int perm32(int rho) { const int n = rho >> 4, i = rho & 15; return 8 * (i >> 2) + 4 * n + (i & 3); }

struct Unit { int pm, pn; };
struct Gemm { const bf16_t* A; const bf16_t* Bt; int M, N, K, lda, ldb; };

struct StaticOrder {
    int nM, nN, nwg, G, c, skip;
    __host__ __device__ void init(int M, int N, int G_, int c_, int skip_ = 0) { nM = M / BM; nN = N / BM; nwg = nM * nN; G = G_; c = c_; skip = skip_; }
    __host__ __device__ bool next(int i, Unit& u) const {
        const long L = (long)i * G + c; if (L >= nwg) return false;
        int wgid = (int)L; { const int q = nwg / NXCD, r = nwg % NXCD, xcd = wgid % NXCD, off = wgid / NXCD; wgid = (xcd < r ? xcd * (q + 1) : r * (q + 1) + (xcd - r) * q) + off; }
        const int nig = WGM * nN, gid = wgid / nig, fm = gid * WGM, gsz = (nM - fm) < WGM ? (nM - fm) : WGM;
        u.pm = fm + ((wgid % nig) % gsz); u.pn = (wgid % nig) / gsz; if (skip) u.pm += 1 + (u.pm >= 32 ? 1 : 0); return true;
    }
    __device__ __forceinline__ void a_ready(const Unit&) const {}
    __device__ __forceinline__ void done(const Unit&) const {}
};

__device__ __forceinline__ unsigned cvt_pk_bf16(float lo, float hi) { unsigned r; asm volatile("v_cvt_pk_bf16_f32 %0, %1, %2" : "=v"(r) : "v"(lo), "v"(hi)); return r; }

struct EpiStore {
    static constexpr bool PERM = true, AFTER_DRAIN = false;
    bf16_t* O; int ldc; int ncols; float scale;
    __device__ __forceinline__ void operator()(const f32x4 (&acc)[2][2][4][2], const Unit& u, int wr, int wc, int fr, int fq) const {
        const int row0 = u.pm * BM + wr * 64 + fr; const int col0 = u.pn * BM + wc * 32 + 8 * fq;
#pragma unroll
        for (int ai = 0; ai < 2; ++ai)
#pragma unroll
            for (int m = 0; m < 4; ++m) { bf16_t* rowp = O + (size_t)(row0 + ai * HALF + m * 16) * ldc + col0;
#pragma unroll
                for (int bj = 0; bj < 2; ++bj) { if (col0 + bj * HALF < ncols) {
                    f32x4 v0 = acc[ai][bj][m][0] * scale, v1 = acc[ai][bj][m][1] * scale;
                    u32x4 w; w.x = cvt_pk_bf16(v0[0], v0[1]); w.y = cvt_pk_bf16(v0[2], v0[3]); w.z = cvt_pk_bf16(v1[0], v1[1]); w.w = cvt_pk_bf16(v1[2], v1[3]);
                    *(u32x4*)(rowp + bj * HALF) = w; } } }
    }
};
struct EpiResid {
    static constexpr bool PERM = false, AFTER_DRAIN = false;
    float* X; const float* gate; int row_tile0;
    __device__ __forceinline__ void operator()(const f32x4 (&acc)[2][2][4][2], const Unit& u, int wr, int wc, int fr, int fq) const {
        const int tpm = u.pm + row_tile0; const int bb = tpm / 33, jj = tpm - bb * 33; const float* gv = gate + (jj == 0 ? 2 : bb) * 6144;
        const int col0 = u.pn * BM + wc * 32 + 4 * fq;
#pragma unroll
        for (int ai = 0; ai < 2; ++ai)
#pragma unroll
            for (int m = 0; m < 4; ++m) { float* rowp = X + (size_t)(tpm * BM + ai * HALF + wr * 64 + m * 16 + fr) * 1024 + col0;
#pragma unroll
                for (int bj = 0; bj < 2; ++bj) {
#pragma unroll
                    for (int n = 0; n < 2; ++n) { f32x4* q = (f32x4*)(rowp + bj * HALF + n * 16); const f32x4 gq = *(const f32x4*)(gv + col0 + bj * HALF + n * 16); f32x4 xv = *q; xv = xv + gq * acc[ai][bj][m][n]; *q = xv; }
                    asm volatile("" ::: "memory"); } }
    }
};

template <class Epi, class Sched, bool ALIGN_EPI = false, bool SP2 = false>
__device__ __forceinline__ void gemm_phase(PG8_LAS unsigned char* lds, const Gemm g, const Sched& S, const Epi& E) {
    int tid = threadIdx.x; asm volatile("" : "+v"(tid));
    const int wid = __builtin_amdgcn_readfirstlane(tid >> 6), lane = tid & 63, wr = wid >> 2, wc = wid & 3, fr = lane & 15, fq = lane >> 4;
    int K = g.K; asm volatile("" : "+s"(K));
    const int nt = K / BK;
    unsigned voffA[2], voffB[2];
#pragma unroll
    for (int i = 0; i < 2; ++i) { int R, C; stage_rc(tid * 16 + i * 8192, R, C); const int Rb = Epi::PERM ? ((R & ~31) + perm32(R & 31)) : R;
        voffA[i] = (unsigned)(R * g.lda + C) * 2u; voffB[i] = (unsigned)(Rb * g.ldb + C) * 2u; }
    const size_t kstep = (size_t)(BK * 2);
    const size_t hstepA = (size_t)HALF * g.lda * 2, hstepB = (size_t)HALF * g.ldb * 2;
    const size_t tstepA = 2 * hstepA, tstepB = 2 * hstepB;
    const unsigned ldsw = (unsigned)wid * 1024u;
    const int aoff = lds_byte(wr * 64 + fr, fq * 8), boff = lds_byte(wc * 32 + fr, fq * 8);
#define PG8_SA(b, h) (((b) * 2 + (h)) * HTB)
#define PG8_SB(b, h) ((4 + (b) * 2 + (h)) * HTB)
#define PG8_STAGE(bufoff, gbase, voff) do { _Pragma("unroll") for (int _i = 0; _i < 2; ++_i) \
        __builtin_amdgcn_global_load_lds((const unsigned*)((const char*)(gbase) + (voff)[_i]), (PG8_LAS unsigned*)(lds + (bufoff) + ldsw + _i * 8192), 16, 0, 0); } while (0)
#define PG8_LDA(dst, b, h) do { _Pragma("unroll") for (int m = 0; m < 4; ++m) _Pragma("unroll") for (int k = 0; k < 2; ++k) dst[m][k] = *(const PG8_LAS bf16x8*)(lds + PG8_SA(b, h) + aoff + m * 2048 + k * 1024); } while (0)
#define PG8_LDB(dst, b, h) do { _Pragma("unroll") for (int n = 0; n < 2; ++n) _Pragma("unroll") for (int k = 0; k < 2; ++k) dst[n][k] = *(const PG8_LAS bf16x8*)(lds + PG8_SB(b, h) + boff + n * 2048 + k * 1024); } while (0)
#define PG8_MMA(ai, bj, At, Bt) do { __builtin_amdgcn_s_setprio(1); _Pragma("unroll") for (int m = 0; m < 4; ++m) _Pragma("unroll") for (int n = 0; n < 2; ++n) _Pragma("unroll") for (int k = 0; k < 2; ++k) \
        acc[ai][bj][m][n] = __builtin_amdgcn_mfma_f32_16x16x32_bf16(Bt[n][k], At[m][k], acc[ai][bj][m][n], 0, 0, 0); __builtin_amdgcn_s_setprio(0); } while (0)
#define PG8_WAIT_V(n) asm volatile("s_waitcnt vmcnt(" #n ")" ::: "memory")
#define PG8_WAIT_L(n) asm volatile("s_waitcnt lgkmcnt(" #n ")" ::: "memory")
#define PG8_BAR __builtin_amdgcn_s_barrier()
#define PG8_SCHED __builtin_amdgcn_sched_barrier(0)
    Unit cur, nxt; int ui = 0;
    if (!S.next(0, cur)) return;
    f32x4 acc[2][2][4][2];
#pragma unroll
    for (int a = 0; a < 2; ++a)
#pragma unroll
        for (int b = 0; b < 2; ++b)
#pragma unroll
            for (int m = 0; m < 4; ++m)
#pragma unroll
                for (int n = 0; n < 2; ++n) acc[a][b][m][n] = (f32x4){0.f, 0.f, 0.f, 0.f};
    bf16x8 At[4][2], B0[2][2], B1[2][2];
    const char* cA = (const char*)g.A + (size_t)cur.pm * tstepA; const char* cB = (const char*)g.Bt + (size_t)cur.pn * tstepB;
    S.a_ready(cur);
    if constexpr (SP2) {
        PG8_STAGE(PG8_SB(0, 0), cB, voffB); PG8_STAGE(PG8_SB(0, 1), cB + hstepB, voffB); PG8_STAGE(PG8_SA(0, 0), cA, voffA); PG8_STAGE(PG8_SA(0, 1), cA + hstepA, voffA);
        if (wr == 1) PG8_BAR;
        PG8_WAIT_V(2); PG8_BAR;
        PG8_STAGE(PG8_SB(1, 0), cB + kstep, voffB); PG8_STAGE(PG8_SA(1, 0), cA + kstep, voffA); PG8_STAGE(PG8_SB(1, 1), cB + hstepB + kstep, voffB);
        PG8_WAIT_V(6); PG8_BAR;
    } else {
        PG8_STAGE(PG8_SB(0, 0), cB, voffB); PG8_STAGE(PG8_SA(0, 0), cA, voffA); PG8_STAGE(PG8_SB(0, 1), cB + hstepB, voffB); PG8_STAGE(PG8_SA(0, 1), cA + hstepA, voffA);
        if (wr == 1) PG8_BAR;
        PG8_WAIT_V(4); PG8_BAR;
        PG8_STAGE(PG8_SB(1, 0), cB + kstep, voffB); PG8_STAGE(PG8_SA(1, 0), cA + kstep, voffA); PG8_STAGE(PG8_SB(1, 1), cB + hstepB + kstep, voffB);
        PG8_WAIT_V(6); PG8_BAR;
    }
    for (;;) {
        const bool has_next = S.next(ui + 1, nxt);
        const char* nA = has_next ? (const char*)g.A + (size_t)nxt.pm * tstepA : cA; const char* nB = has_next ? (const char*)g.Bt + (size_t)nxt.pn * tstepB : cB;
        for (int t = 0; t < nt; t += 2) {
            const bool last = (t == nt - 2);
            const char* a1 = cA + (size_t)(t + 1) * kstep;
            const char* a2 = last ? nA : cA + (size_t)(t + 2) * kstep; const char* b2 = last ? nB : cB + (size_t)(t + 2) * kstep;
            const char* a3 = a2 + kstep; const char* b3 = b2 + kstep;
            if (last && has_next) S.a_ready(nxt);
            if constexpr (SP2) {
            PG8_LDB(B0, 0, 0); PG8_LDB(B1, 0, 1); PG8_SCHED; PG8_LDA(At, 0, 0); PG8_STAGE(PG8_SA(1, 1), a1 + hstepA, voffA);
            PG8_WAIT_V(8); PG8_WAIT_L(0); PG8_BAR; PG8_MMA(0, 0, At, B0); PG8_MMA(0, 1, At, B1); PG8_BAR; PG8_SCHED;
            PG8_LDA(At, 0, 1); PG8_STAGE(PG8_SB(0, 0), b2, voffB); PG8_STAGE(PG8_SB(0, 1), b2 + hstepB, voffB); PG8_STAGE(PG8_SA(0, 0), a2, voffA);
            PG8_WAIT_V(8); PG8_WAIT_L(0); PG8_BAR; PG8_MMA(1, 0, At, B0); PG8_MMA(1, 1, At, B1); PG8_BAR; PG8_SCHED;
            PG8_LDB(B0, 1, 0); PG8_LDB(B1, 1, 1); PG8_SCHED; PG8_LDA(At, 1, 0); PG8_STAGE(PG8_SA(0, 1), a2 + hstepA, voffA);
            PG8_WAIT_V(8); PG8_WAIT_L(0); PG8_BAR; PG8_MMA(0, 0, At, B0); PG8_MMA(0, 1, At, B1); PG8_BAR; PG8_SCHED;
            PG8_LDA(At, 1, 1); PG8_STAGE(PG8_SB(1, 0), b3, voffB); PG8_STAGE(PG8_SB(1, 1), b3 + hstepB, voffB); PG8_STAGE(PG8_SA(1, 0), a3, voffA);
            PG8_WAIT_V(8); PG8_WAIT_L(0); PG8_BAR; PG8_MMA(1, 0, At, B0); PG8_MMA(1, 1, At, B1); PG8_BAR; PG8_SCHED;
            } else {
            PG8_LDB(B0, 0, 0); PG8_SCHED; PG8_LDA(At, 0, 0); PG8_STAGE(PG8_SA(1, 1), a1 + hstepA, voffA);
            PG8_WAIT_L(8); PG8_BAR; PG8_WAIT_L(0); PG8_MMA(0, 0, At, B0); PG8_BAR; PG8_SCHED;
            PG8_LDB(B1, 0, 1); PG8_STAGE(PG8_SB(0, 0), b2, voffB);
            PG8_BAR; PG8_WAIT_L(0); PG8_MMA(0, 1, At, B1); PG8_BAR;
            PG8_LDA(At, 0, 1); PG8_STAGE(PG8_SA(0, 0), a2, voffA);
            PG8_BAR; PG8_WAIT_L(0); PG8_MMA(1, 0, At, B0); PG8_BAR; PG8_SCHED;
            PG8_STAGE(PG8_SB(0, 1), b2 + hstepB, voffB);
            PG8_WAIT_V(6); PG8_BAR; PG8_MMA(1, 1, At, B1); PG8_BAR;
            PG8_LDB(B0, 1, 0); PG8_SCHED; PG8_LDA(At, 1, 0); PG8_STAGE(PG8_SA(0, 1), a2 + hstepA, voffA);
            PG8_WAIT_L(8); PG8_BAR; PG8_WAIT_L(0); PG8_MMA(0, 0, At, B0); PG8_BAR; PG8_SCHED;
            PG8_LDB(B1, 1, 1); PG8_STAGE(PG8_SB(1, 0), b3, voffB);
            PG8_BAR; PG8_WAIT_L(0); PG8_MMA(0, 1, At, B1); PG8_BAR;
            PG8_LDA(At, 1, 1); PG8_STAGE(PG8_SA(1, 0), a3, voffA);
            PG8_BAR; PG8_WAIT_L(0); PG8_MMA(1, 0, At, B0); PG8_BAR; PG8_SCHED;
            PG8_STAGE(PG8_SB(1, 1), b3 + hstepB, voffB);
            PG8_WAIT_V(6); PG8_BAR; PG8_MMA(1, 1, At, B1); PG8_BAR;
            }
        }
        if constexpr (ALIGN_EPI) { if (wr == 0) PG8_BAR; }
        if constexpr (!Epi::AFTER_DRAIN) { E(acc, cur, wr, wc, fr, fq); S.done(cur); }
        if (!has_next) break;
#pragma unroll
        for (int a = 0; a < 2; ++a)
#pragma unroll
            for (int b = 0; b < 2; ++b)
#pragma unroll
                for (int m = 0; m < 4; ++m)
#pragma unroll
                    for (int n = 0; n < 2; ++n) acc[a][b][m][n] = (f32x4){0.f, 0.f, 0.f, 0.f};
        cur = nxt; cA = nA; cB = nB; ++ui;
        if constexpr (ALIGN_EPI) { if (wr == 1) PG8_BAR; }
    }
    PG8_WAIT_V(0);
    if constexpr (!ALIGN_EPI) { if (wr == 0) PG8_BAR; }
    PG8_BAR;
    if constexpr (Epi::AFTER_DRAIN) { E.fused(acc, cur, wr, wc, fr, fq, lds, wid, lane); S.done(cur); }
#undef PG8_SA
#undef PG8_SB
#undef PG8_STAGE
#undef PG8_LDA
#undef PG8_LDB
#undef PG8_MMA
#undef PG8_WAIT_V
#undef PG8_WAIT_L
#undef PG8_BAR
#undef PG8_SCHED
}
}

#define DEV __device__ __forceinline__
#define LAS __attribute__((address_space(3)))
typedef unsigned short bf16_t;
typedef short bf16x8 __attribute__((ext_vector_type(8)));
typedef float f32x4 __attribute__((ext_vector_type(4)));
typedef float f32x2 __attribute__((ext_vector_type(2)));
typedef float f32x16 __attribute__((ext_vector_type(16)));
typedef unsigned u32x4 __attribute__((ext_vector_type(4)));
typedef unsigned u32x2 __attribute__((ext_vector_type(2)));

constexpr int R = 16896, RB = 8448, NCTX = 256, TL = 8192, DM = 1024, INW = 1696, DFF = 2816, HFF = 1408;
constexpr int NWG_T = 512;
constexpr float EPS = 1e-6f;
constexpr int LDS_BYTES = 147456;
constexpr size_t OFF_X = 0, OFF_HN = 69206016, OFF_W = 103809024, OFF_MOD = 152174592, OFF_ROPE = 152436736, OFF_OV = 153485312;
constexpr size_t OV_Q = 0, OV_KN = 25952256, OV_VT = 43253760, OV_SLOC = 60555264, OV_SIN = 69206016, OV_U = 0;
constexpr size_t WS_NEED = 250000128 + 16384;
constexpr size_t W_IN = 0, W_UQ = 1835008, W_KN = 2129920, W_V = 2260992, W_OUT = 2392064, W_UP = 3440640, W_DN = 9207808, W_LAYER = 12091392;

struct Params {
    const float *x, *c, *ctx, *c_ctx, *w_mod, *b_mod, *norm1_g, *w_in, *ret_decay_f, *ret_decay_b, *mla_q_norm_g, *w_uq, *mla_kv_norm_g, *w_ukv,
        *pool_w, *pool_scale, *w_out, *norm2_g, *w_up, *conv_w, *conv_b, *w_down, *final_norm_g;
    float* out; unsigned char* ws; int ph_lo, ph_hi;
};

DEV int otid() { int t = threadIdx.x; asm volatile("" : "+v"(t)); return t; }
DEV float bf2f(unsigned short x) { return __uint_as_float((unsigned)x << 16); }
DEV unsigned f2bf(float f) { unsigned u = __float_as_uint(f); return (u + 0x7fffu + ((u >> 16) & 1u)) >> 16; }
DEV unsigned pk2(float lo, float hi) { return f2bf(lo) | (f2bf(hi) << 16); }
DEV float wave_sum(float v) {
#pragma unroll
    for (int o = 1; o < 64; o <<= 1) v += __shfl_xor(v, o);
    return v;
}
DEV float siluf(float x) { return x / (1.0f + __expf(-x)); }
DEV int crow(int r, int hi) { return (r & 3) + 8 * (r >> 2) + 4 * hi; }
DEV bf16x8 pack8(float a0, float a1, float a2, float a3, float a4, float a5, float a6, float a7) {
    u32x4 w; w.x = pg8::cvt_pk_bf16(a0, a1); w.y = pg8::cvt_pk_bf16(a2, a3); w.z = pg8::cvt_pk_bf16(a4, a5); w.w = pg8::cvt_pk_bf16(a6, a7);
    return __builtin_bit_cast(bf16x8, w);
}
DEV int row_mi(int r) { const int b = r / RB; const int s = r - b * RB; return s < NCTX ? 2 : b; }

DEV void transpose_item(const float* W, int K, int Nsrc, bf16_t* WT, int n0, int cs, int k0, float* scr, int lane) {
#pragma unroll 8
    for (int i = 0; i < 32; ++i) { const int kk = 2 * i + (lane >> 5); scr[kk * 33 + (lane & 31)] = cs >= 0 ? W[(size_t)(k0 + kk) * Nsrc + cs + (lane & 31)] : 0.f; }
    asm volatile("s_waitcnt lgkmcnt(0)" ::: "memory");
    const int c = lane & 7;
#pragma unroll
    for (int j = 0; j < 4; ++j) { const int n = (lane >> 3) + 8 * j; const float* s = scr + (8 * c) * 33 + n;
        u32x4 o; o.x = pk2(s[0 * 33], s[1 * 33]); o.y = pk2(s[2 * 33], s[3 * 33]); o.z = pk2(s[4 * 33], s[5 * 33]); o.w = pk2(s[6 * 33], s[7 * 33]);
        *(u32x4*)(WT + (size_t)(n0 + n) * K + k0 + 8 * c) = o; }
    asm volatile("s_waitcnt lgkmcnt(0)" ::: "memory");
}
DEV int map_in(int n0) { return n0 < 1440 ? n0 : (n0 < INW ? -2 : -1); }
DEV int map_kn(int n0) { return (n0 >> 6) * 128 + (n0 & 63); }
DEV int map_v(int n0) { return (n0 >> 6) * 128 + 64 + (n0 & 63); }
DEV int map_up(int n0) { const int hf = n0 / DFF, w = n0 - hf * DFF; return w < HFF ? hf * HFF + w : DFF + hf * HFF + (w - HFF); }

DEV void phase_prep(const Params& p, unsigned char* lds) {
    const int tid = otid(), lane = tid & 63, wid = tid >> 6;
    unsigned char* ws = p.ws;
    { f32x2* rope = (f32x2*)(ws + OFF_ROPE);
      for (int idx = blockIdx.x * NWG_T + tid; idx < TL * 16; idx += gridDim.x * NWG_T) { const int t = idx >> 4, i = idx & 15; const int pos = i < 8 ? (t >> 6) : (t & 63);
          const float inv = exp2f(-(float)(i & 7) * 0.125f * 13.287712379549449f); const float ang = (float)pos * inv; f32x2 cs; cs.x = __cosf(ang); cs.y = __sinf(ang); rope[idx] = cs; } }
    { float* scv = (float*)lds;
      float* red = scv + 3 * 1024;
      for (int i = tid; i < 3 * 1024; i += NWG_T) { const int v = i >> 10, k = i & 1023; const float cv = v < 2 ? p.c[v * 1024 + k] : p.c_ctx[k]; scv[i] = siluf(cv); }
      __syncthreads();
      float* modv = (float*)(ws + OFF_MOD);
      for (int it = blockIdx.x; it < 192; it += gridDim.x) { const int l = it / 96, col0 = (it % 96) * 64;
          const float* wm = p.w_mod + (size_t)l * 1024 * 6144 + col0 + lane; float a0 = 0.f, a1 = 0.f, a2 = 0.f;
#pragma unroll 8
          for (int k = wid * 128; k < wid * 128 + 128; ++k) { const float w = wm[(size_t)k * 6144]; a0 += scv[k] * w; a1 += scv[1024 + k] * w; a2 += scv[2048 + k] * w; }
          red[(wid * 3 + 0) * 64 + lane] = a0; red[(wid * 3 + 1) * 64 + lane] = a1; red[(wid * 3 + 2) * 64 + lane] = a2;
          __syncthreads();
          if (tid < 192) { const int v = tid >> 6, cl = tid & 63; float s = 0.f;
#pragma unroll
              for (int w = 0; w < 8; ++w) s += red[(w * 3 + v) * 64 + cl];
              modv[((size_t)l * 3 + v) * 6144 + col0 + cl] = s + p.b_mod[l * 6144 + col0 + cl]; }
          __syncthreads(); }
    }
    { float* scr = (float*)(lds + 32768 + wid * 8704);
      const int gw = blockIdx.x * 8 + wid, NGW = gridDim.x * 8;
      constexpr int I_IN = 16 * 56, I_UQ = 6 * 24, I_KN = 4 * 16, I_V = 4 * 16, I_OUT = 16 * 32, I_UP = 16 * 176, I_DN = 44 * 32, I_L = I_IN + I_UQ + I_KN + I_V + I_OUT + I_UP + I_DN;
      for (int it = gw; it < 2 * I_L; it += NGW) { const int l = it / I_L; int r = it - l * I_L; bf16_t* wl = (bf16_t*)(ws + OFF_W) + (size_t)l * W_LAYER;
          const float* src; int K, Nsrc, nbn, mp; size_t doff;
          if (r < I_IN) { src = p.w_in + (size_t)l * 1024 * INW; K = 1024; Nsrc = INW; nbn = 56; mp = 1; doff = W_IN; }
          else if ((r -= I_IN) < I_UQ) { src = p.w_uq + (size_t)l * 384 * 768; K = 384; Nsrc = 768; nbn = 24; mp = 0; doff = W_UQ; }
          else if ((r -= I_UQ) < I_KN) { src = p.w_ukv + (size_t)l * 256 * 1024; K = 256; Nsrc = 1024; nbn = 16; mp = 2; doff = W_KN; }
          else if ((r -= I_KN) < I_V) { src = p.w_ukv + (size_t)l * 256 * 1024; K = 256; Nsrc = 1024; nbn = 16; mp = 3; doff = W_V; }
          else if ((r -= I_V) < I_OUT) { src = p.w_out + (size_t)l * 1024 * 1024; K = 1024; Nsrc = 1024; nbn = 32; mp = 0; doff = W_OUT; }
          else if ((r -= I_OUT) < I_UP) { src = p.w_up + (size_t)l * 1024 * 5632; K = 1024; Nsrc = 5632; nbn = 176; mp = 4; doff = W_UP; }
          else { r -= I_UP; src = p.w_down + (size_t)l * DFF * 1024; K = DFF; Nsrc = 1024; nbn = 32; mp = 0; doff = W_DN; }
          const int kb = r / nbn, nb = r - kb * nbn, n0 = nb * 32;
          const int cs = mp == 0 ? n0 : mp == 1 ? map_in(n0) : mp == 2 ? map_kn(n0) : mp == 3 ? map_v(n0) : map_up(n0);
          if (cs != -2) transpose_item(src, K, Nsrc, wl + doff, n0, cs, kb * 64, scr, lane); }
    }
    { for (int idx = blockIdx.x * NWG_T + tid; idx < 2 * 1024 * 256; idx += gridDim.x * NWG_T) { const int n = idx & 255, k = (idx >> 8) & 1023, l = idx >> 18; const int g = n >> 6, d = n & 63;
          const float* wr = p.w_in + ((size_t)l * 1024 + k) * INW + 1440 + g * 64; const float* pw = p.pool_w + ((size_t)(l * 4 + g) * 64) * 64 + d; float s = 0.f;
#pragma unroll 8
          for (int c = 0; c < 64; ++c) s += wr[c] * pw[c * 64];
          ((bf16_t*)(ws + OFF_W) + (size_t)l * W_LAYER + W_IN)[(size_t)(1440 + n) * 1024 + k] = (bf16_t)f2bf(s * p.pool_scale[l * 256 + n]); } }
}

DEV void phase_norm(const Params& p, int l, int which, bool first) {
    const int tid = otid(); const int lane = tid & 63, wid = tid >> 6; const int gw = blockIdx.x * 8 + wid, NGW = gridDim.x * 8;
    float* X = (float*)(p.ws + OFF_X); bf16_t* HN = (bf16_t*)(p.ws + OFF_HN);
    const float* modv = (const float*)(p.ws + OFF_MOD) + (size_t)l * 3 * 6144;
    const float* g = (which == 0 ? p.norm1_g : p.norm2_g) + l * 1024;
    for (int r = gw; r < R; r += NGW) {
        const int b = r / RB, s = r - b * RB; const int mi = s < NCTX ? 2 : b;
        const float* src = first ? (s < NCTX ? p.ctx + ((size_t)b * NCTX + s) * 1024 : p.x + ((size_t)b * TL + (s - NCTX)) * 1024) : X + (size_t)r * 1024;
        const f32x4* xr = (const f32x4*)src + lane; f32x4 v[4]; float ss = 0.f;
#pragma unroll
        for (int j = 0; j < 4; ++j) { v[j] = xr[64 * j]; ss += (v[j].x * v[j].x + v[j].y * v[j].y) + (v[j].z * v[j].z + v[j].w * v[j].w); }
        if (first) { f32x4* xo = (f32x4*)(X + (size_t)r * 1024) + lane;
#pragma unroll
            for (int j = 0; j < 4; ++j) xo[64 * j] = v[j]; }
        const float rs = rsqrtf(wave_sum(ss) * (1.f / 1024.f) + EPS);
        const float* mv = modv + mi * 6144 + (which == 0 ? 0 : 3072);
        u32x2* o8 = (u32x2*)(HN + (size_t)r * 1024) + lane;
#pragma unroll
        for (int j = 0; j < 4; ++j) { const f32x4 gg = ((const f32x4*)g)[lane + 64 * j], sh = ((const f32x4*)mv)[lane + 64 * j], sc = ((const f32x4*)(mv + 1024))[lane + 64 * j];
            const f32x4 y = v[j] * rs * gg; const f32x4 h = y * (sc + 1.0f) + sh; u32x2 w; w.x = pk2(h.x, h.y); w.y = pk2(h.z, h.w); o8[64 * j] = w; }
    }
}
DEV void phase_final(const Params& p) {
    const int tid = otid(); const int lane = tid & 63, wid = tid >> 6; const int gw = blockIdx.x * 8 + wid, NGW = gridDim.x * 8;
    const float* X = (const float*)(p.ws + OFF_X);
    for (int q = gw; q < 2 * TL; q += NGW) { const int b = q / TL, t = q - b * TL; const int r = b * RB + NCTX + t;
        const f32x4* xr = (const f32x4*)(X + (size_t)r * 1024) + lane; f32x4 v[4]; float ss = 0.f;
#pragma unroll
        for (int j = 0; j < 4; ++j) { v[j] = xr[64 * j]; ss += (v[j].x * v[j].x + v[j].y * v[j].y) + (v[j].z * v[j].z + v[j].w * v[j].w); }
        const float rs = rsqrtf(wave_sum(ss) * (1.f / 1024.f) + EPS);
        f32x4* o = (f32x4*)(p.out + (size_t)q * 1024) + lane;
#pragma unroll
        for (int j = 0; j < 4; ++j) { const f32x4 gg = ((const f32x4*)p.final_norm_g)[lane + 64 * j]; o[64 * j] = v[j] * rs * gg; } }
}

DEV void phase_rowwise(const Params& p, int l) {
    const int tid = otid(); const int lane = tid & 63, wid = tid >> 6; const int gw = blockIdx.x * 8 + wid, NGW = gridDim.x * 8;
    bf16_t* P = (bf16_t*)p.out; const f32x2* rope = (const f32x2*)(p.ws + OFF_ROPE);
    const float* qg = p.mla_q_norm_g + l * 384; const float* kg = p.mla_kv_norm_g + l * 256;
    for (int r = gw; r < R; r += NGW) {
        bf16_t* pr = P + (size_t)r * INW; const int b = r / RB, s = r - b * RB;
        { unsigned* q2 = (unsigned*)(pr + 768) + lane; unsigned w[3]; float ss = 0.f;
#pragma unroll
          for (int j = 0; j < 3; ++j) { w[j] = q2[64 * j]; const float a = bf2f(w[j] & 0xffff), c2 = bf2f(w[j] >> 16); ss += a * a + c2 * c2; }
          const float rs = rsqrtf(wave_sum(ss) * (1.f / 384.f) + EPS);
#pragma unroll
          for (int j = 0; j < 3; ++j) { const int c0 = 2 * (lane + 64 * j); q2[64 * j] = pk2(bf2f(w[j] & 0xffff) * rs * qg[c0], bf2f(w[j] >> 16) * rs * qg[c0 + 1]); } }
        { u32x2* k4 = (u32x2*)(pr + 1152) + lane; const u32x2 w = *k4;
          const float a0 = bf2f(w.x & 0xffff), a1 = bf2f(w.x >> 16), a2 = bf2f(w.y & 0xffff), a3 = bf2f(w.y >> 16);
          const float rs = rsqrtf(wave_sum((a0 * a0 + a1 * a1) + (a2 * a2 + a3 * a3)) * (1.f / 256.f) + EPS);
          const f32x4 gg = ((const f32x4*)kg)[lane]; u32x2 o; o.x = pk2(a0 * rs * gg.x, a1 * rs * gg.y); o.y = pk2(a2 * rs * gg.z, a3 * rs * gg.w); *k4 = o; }
        if (s >= NCTX && lane < 16) { const f32x2 cs = rope[(s - NCTX) * 16 + lane];
          const float x1 = bf2f(pr[1408 + lane]), x2 = bf2f(pr[1408 + 16 + lane]);
          pr[1408 + lane] = (bf16_t)f2bf(x1 * cs.x - x2 * cs.y); pr[1408 + 16 + lane] = (bf16_t)f2bf(x2 * cs.x + x1 * cs.y); }
    }
}

DEV void phase_pool(const Params& p) {
    const int tid = otid(); const bf16_t* P = (const bf16_t*)p.out; bf16_t* MIX = (bf16_t*)(p.ws + OFF_HN);
    for (int idx = blockIdx.x * NWG_T + tid; idx < R * 32; idx += gridDim.x * NWG_T) { const int r = idx >> 5, cg = idx & 31; const int half = 1 << (cg >> 3);
        const int b = r / RB, s = r - b * RB; const int seq0 = s < NCTX ? b * RB : b * RB + NCTX; const int T = s < NCTX ? NCTX : TL; const int t = r - seq0;
        const int lo = max(t - half, 0), hi = min(t + half, T); float sum[8];
#pragma unroll
        for (int j = 0; j < 8; ++j) sum[j] = 0.f;
        const bf16_t* base = P + (size_t)seq0 * INW + 1440 + cg * 8;
        for (int tt = lo; tt < hi; ++tt) { const bf16x8 v = *(const bf16x8*)(base + (size_t)tt * INW);
#pragma unroll
            for (int j = 0; j < 8; ++j) sum[j] += bf2f((unsigned short)v[j]); }
        const bf16x8 me = *(const bf16x8*)(base + (size_t)t * INW); const float ic = 1.0f / (float)(hi - lo); float o[8];
#pragma unroll
        for (int j = 0; j < 8; ++j) o[j] = sum[j] * ic - bf2f((unsigned short)me[j]);
        *(bf16x8*)(MIX + (size_t)r * 1024 + 768 + cg * 8) = pack8(o[0], o[1], o[2], o[3], o[4], o[5], o[6], o[7]); }
}

DEV float log2_sigmoid(float d) { return -log1pf(__expf(-d)) * 1.4426950408889634f; }
DEV void states_item(const Params& p, int l, unsigned char* lds, int it) {
    const int tid = otid(); const bf16_t* P = (const bf16_t*)p.out; const f32x2* rope = (const f32x2*)(p.ws + OFF_ROPE);
    float* SLOC = (float*)(p.ws + OFF_OV + OV_SLOC);
    const int gc = it >> 2, h = it & 3;
    bf16_t* kk = (bf16_t*)lds;
    bf16_t* vv = kk + 128 * 32;
    float* dec = (float*)(vv + 128 * 64);
    const int cb = gc % 66; const bool lat = cb >= 2; const int t0 = (cb - 2) * 128; const int r0 = gc * 128;
    if (tid < 256) { const int dir = tid >> 7, idx = tid & 127;
        const float lg = log2_sigmoid((dir == 0 ? p.ret_decay_f : p.ret_decay_b)[l * 4 + h]); dec[tid] = exp2f(lg * (dir == 0 ? (float)(127 - idx) : (float)idx)); }
    else { const int task = tid - 256; const int tok = task >> 1, c = task & 1;
        const bf16_t* src = P + (size_t)(r0 + tok) * INW + 128 + h * 32 + 8 * c; const bf16x8 lo = *(const bf16x8*)src, hi = *(const bf16x8*)(src + 16);
        float o1[8], o2[8];
#pragma unroll
        for (int j = 0; j < 8; ++j) { float x1 = bf2f((unsigned short)lo[j]), x2 = bf2f((unsigned short)hi[j]);
            if (lat) { const f32x2 cs = rope[(t0 + tok) * 16 + 8 * c + j]; const float y1 = x1 * cs.x - x2 * cs.y, y2 = x2 * cs.x + x1 * cs.y; x1 = y1; x2 = y2; }
            o1[j] = x1 * 0.17677669529663687f; o2[j] = x2 * 0.17677669529663687f; }
        bf16_t* dst = kk + tok * 32 + 8 * c;
        *(bf16x8*)dst = pack8(o1[0], o1[1], o1[2], o1[3], o1[4], o1[5], o1[6], o1[7]); *(bf16x8*)(dst + 16) = pack8(o2[0], o2[1], o2[2], o2[3], o2[4], o2[5], o2[6], o2[7]); }
    for (int task = tid; task < 1024; task += NWG_T) { const int tok = task >> 3, ch = task & 7; *(u32x4*)(vv + tok * 64 + ch * 8) = *(const u32x4*)(P + (size_t)(r0 + tok) * INW + 256 + h * 64 + ch * 8); }
    __syncthreads();
    { const int d = tid >> 4, dvg = tid & 15; float af[4], ab[4];
#pragma unroll
      for (int j = 0; j < 4; ++j) { af[j] = 0.f; ab[j] = 0.f; }
#pragma unroll 4
      for (int i = 0; i < 128; ++i) { const float kv = bf2f(kk[i * 32 + d]); const float kf = kv * dec[i], kb = kv * dec[128 + i];
          const u32x2 v = *(const u32x2*)(vv + i * 64 + dvg * 4);
          const float v0 = bf2f(v.x & 0xffff), v1 = bf2f(v.x >> 16), v2 = bf2f(v.y & 0xffff), v3 = bf2f(v.y >> 16);
          af[0] += kf * v0; af[1] += kf * v1; af[2] += kf * v2; af[3] += kf * v3; ab[0] += kb * v0; ab[1] += kb * v1; ab[2] += kb * v2; ab[3] += kb * v3; }
      float* of = SLOC + ((size_t)(gc * 4 + h) * 2 + 0) * 2048 + d * 64 + dvg * 4;
      *(f32x4*)of = (f32x4){af[0], af[1], af[2], af[3]}; *(f32x4*)(of + 2048) = (f32x4){ab[0], ab[1], ab[2], ab[3]}; }
    __syncthreads();
}
DEV void scan_threads(const Params& p, int l, int gid) {
    if (gid >= 32768) return;
    const int e = gid & 2047, dir = (gid >> 11) & 1, h = (gid >> 12) & 3, b = gid >> 14;
    const float* SLOC = (const float*)(p.ws + OFF_OV + OV_SLOC); float* SIN = (float*)(p.ws + OFF_OV + OV_SIN);
    const float gC = exp2f(log2_sigmoid((dir == 0 ? p.ret_decay_f : p.ret_decay_b)[l * 4 + h]) * 128.f);
    float S = 0.f;
#pragma unroll 6
    for (int st = 0; st < 66; ++st) { const int cb = dir == 0 ? st : (st < 2 ? 1 - st : 67 - st); const size_t idx = ((size_t)((b * 66 + cb) * 4 + h) * 2 + dir) * 2048 + e;
        const float v = SLOC[idx]; SIN[idx] = S; S = S * gC + v; }
}

constexpr int AT_KP = 208, AT_VP = 136, AT_KB = 64 * AT_KP, AT_BUF = AT_KB + 64 * AT_VP;
DEV void attn_unit(const Params& p, unsigned char* lds, int u) {
    const int tid = otid(), lane = tid & 63, wid = tid >> 6, l32 = lane & 31, hi = lane >> 5;
    const bf16_t* Q = (const bf16_t*)(p.ws + OFF_OV + OV_Q); const bf16_t* KN = (const bf16_t*)(p.ws + OFF_OV + OV_KN); const bf16_t* VT = (const bf16_t*)(p.ws + OFF_OV + OV_VT);
    const bf16_t* P = (const bf16_t*)p.out; bf16_t* MIX = (bf16_t*)(p.ws + OFF_HN); const f32x2* rope = (const f32x2*)(p.ws + OFF_ROPE);
    const bool isctx = u >= 512; int b, h, qrow0, NT;
    if (!isctx) { b = u >> 8; h = (u >> 5) & 7; qrow0 = b * RB + NCTX + (u & 31) * 256; NT = 132; } else { const int v = u - 512; b = v >> 3; h = v & 7; qrow0 = b * RB; NT = 4; }
    const int krow0 = b * RB; const int qrow = qrow0 + wid * 32 + l32;
    bf16x8 qf[6];
    { const bf16_t* qp = Q + (size_t)qrow * 768 + h * 96 + hi * 8;
#pragma unroll
      for (int d0 = 0; d0 < 6; ++d0) qf[d0] = *(const bf16x8*)(qp + d0 * 16);
      if (!isctx) { const f32x2* rp = rope + (size_t)(qrow - (b * RB + NCTX)) * 16 + hi * 8;
#pragma unroll
          for (int j = 0; j < 8; ++j) { const f32x2 cs = rp[j]; const float x1 = bf2f((unsigned short)qf[4][j]), x2 = bf2f((unsigned short)qf[5][j]);
              qf[4][j] = (short)f2bf(x1 * cs.x - x2 * cs.y); qf[5][j] = (short)f2bf(x2 * cs.x + x1 * cs.y); } } }
    const bf16_t* sp[3]; int sstep[3], lo[3];
#pragma unroll
    for (int k = 0; k < 3; ++k) { const int c = tid + k * 512;
        if (c < 768) { const int key = c / 12, part = c - key * 12; lo[k] = key * AT_KP + part * 16;
            if (part < 8) { sp[k] = KN + (size_t)(krow0 + key) * 512 + h * 64 + part * 8; sstep[k] = 64 * 512; } else { sp[k] = P + (size_t)(krow0 + key) * INW + 1408 + (part - 8) * 8; sstep[k] = 64 * INW; } }
        else { const int cc = c - 768, dv = cc >> 3, kc = cc & 7; lo[k] = AT_KB + dv * AT_VP + kc * 16; sp[k] = VT + (size_t)(h * 64 + dv) * R + krow0 + kc * 8; sstep[k] = 64; } }
    const bool has3 = tid < 256;
    u32x4 st[3];
#define AT_GLOAD() do { st[0] = *(const u32x4*)sp[0]; sp[0] += sstep[0]; st[1] = *(const u32x4*)sp[1]; sp[1] += sstep[1]; if (has3) { st[2] = *(const u32x4*)sp[2]; sp[2] += sstep[2]; } } while (0)
#define AT_LSTORE1(buf, k) do { unsigned char* d_ = (buf) + lo[k]; if (lo[k] < AT_KB) { *(u32x4*)d_ = st[k]; } else { *(u32x2*)d_ = (u32x2){st[k].x, st[k].y}; *(u32x2*)(d_ + 8) = (u32x2){st[k].z, st[k].w}; } } while (0)
#define AT_LSTORE(buf) do { AT_LSTORE1(buf, 0); AT_LSTORE1(buf, 1); if (has3) AT_LSTORE1(buf, 2); } while (0)
    f32x16 o0, o1;
#pragma unroll
    for (int r = 0; r < 16; ++r) { o0[r] = 0.f; o1[r] = 0.f; }
    float mrun = -1e30f, lsum = 0.f;
    __syncthreads();
    AT_GLOAD(); AT_LSTORE(lds);
    __syncthreads();
    for (int t = 0; t < NT; ++t) {
        unsigned char* kbuf = lds + (t & 1) * AT_BUF; unsigned char* vbuf = kbuf + AT_KB; unsigned char* nbuf = lds + ((t + 1) & 1) * AT_BUF;
        const bool more = t + 1 < NT;
        if (more) AT_GLOAD();
        f32x16 s0, s1;
#pragma unroll
        for (int r = 0; r < 16; ++r) { s0[r] = 0.f; s1[r] = 0.f; }
        { const unsigned char* ka = kbuf + l32 * AT_KP + hi * 16;
#pragma unroll
          for (int d0 = 0; d0 < 6; ++d0) { const bf16x8 a0 = *(const bf16x8*)(ka + d0 * 32), a1 = *(const bf16x8*)(ka + 32 * AT_KP + d0 * 32);
              s0 = __builtin_amdgcn_mfma_f32_32x32x16_bf16(a0, qf[d0], s0, 0, 0, 0); s1 = __builtin_amdgcn_mfma_f32_32x32x16_bf16(a1, qf[d0], s1, 0, 0, 0); } }
        float mx = fmaxf(s0[0], s1[0]);
#pragma unroll
        for (int r = 1; r < 16; ++r) mx = fmaxf(mx, fmaxf(s0[r], s1[r]));
        mx = fmaxf(mx, __shfl_xor(mx, 32));
        const float mn = fmaxf(mrun, mx); const float alpha = __builtin_amdgcn_exp2f(mrun - mn); mrun = mn;
        float ls = 0.f;
#pragma unroll
        for (int r = 0; r < 16; ++r) { s0[r] = __builtin_amdgcn_exp2f(s0[r] - mn); s1[r] = __builtin_amdgcn_exp2f(s1[r] - mn); ls += s0[r] + s1[r]; }
        lsum = lsum * alpha + ls;
#pragma unroll
        for (int r = 0; r < 16; ++r) { o0[r] *= alpha; o1[r] *= alpha; }
        { const unsigned char* va = vbuf + l32 * AT_VP + hi * 8;
#pragma unroll
          for (int kb = 0; kb < 2; ++kb)
#pragma unroll
              for (int jp = 0; jp < 2; ++jp) { const f32x16& s = kb == 0 ? s0 : s1;
                  const bf16x8 pb = pack8(s[8 * jp + 0], s[8 * jp + 1], s[8 * jp + 2], s[8 * jp + 3], s[8 * jp + 4], s[8 * jp + 5], s[8 * jp + 6], s[8 * jp + 7]);
                  const unsigned char* vp = va + (32 * kb + 16 * jp) * 2;
                  const u32x2 a00 = *(const u32x2*)vp, a01 = *(const u32x2*)(vp + 16), a10 = *(const u32x2*)(vp + 32 * AT_VP), a11 = *(const u32x2*)(vp + 32 * AT_VP + 16);
                  const bf16x8 A0 = __builtin_bit_cast(bf16x8, (u32x4){a00.x, a00.y, a01.x, a01.y}), A1 = __builtin_bit_cast(bf16x8, (u32x4){a10.x, a10.y, a11.x, a11.y});
                  o0 = __builtin_amdgcn_mfma_f32_32x32x16_bf16(A0, pb, o0, 0, 0, 0); o1 = __builtin_amdgcn_mfma_f32_32x32x16_bf16(A1, pb, o1, 0, 0, 0); } }
        if (more) AT_LSTORE(nbuf);
        __syncthreads();
    }
    lsum += __shfl_xor(lsum, 32);
    const float inv = 1.0f / lsum;
    bf16_t* op = MIX + (size_t)qrow * 1024 + 256 + h * 64 + 4 * hi;
#pragma unroll
    for (int g4 = 0; g4 < 4; ++g4) { u32x2 w0, w1; w0.x = pk2(o0[4 * g4] * inv, o0[4 * g4 + 1] * inv); w0.y = pk2(o0[4 * g4 + 2] * inv, o0[4 * g4 + 3] * inv);
        w1.x = pk2(o1[4 * g4] * inv, o1[4 * g4 + 1] * inv); w1.y = pk2(o1[4 * g4 + 2] * inv, o1[4 * g4 + 3] * inv);
        *(u32x2*)(op + 8 * g4) = w0; *(u32x2*)(op + 32 + 8 * g4) = w1; }
#undef AT_GLOAD
#undef AT_LSTORE1
#undef AT_LSTORE
}

constexpr int RT_VP = 264, RT_SP = 144, RT_VB = 2 * 64 * RT_VP;
DEV void retout_unit(const Params& p, int l, unsigned char* lds, int u) {
    const int tid = otid(), lane = tid & 63, wid = tid >> 6, l32 = lane & 31, hi = lane >> 5;
    const int gc = u >> 1, hp = u & 1; const int cb = gc % 66; const bool lat = cb >= 2; const int t0 = (cb - 2) * 128; const int r0 = gc * 128;
    const bf16_t* P = (const bf16_t*)p.out; bf16_t* MIX = (bf16_t*)(p.ws + OFF_HN); const f32x2* rope = (const f32x2*)(p.ws + OFF_ROPE);
    const float* SIN = (const float*)(p.ws + OFF_OV + OV_SIN);
    bf16_t* VTl = (bf16_t*)lds; bf16_t* STl = (bf16_t*)(lds + RT_VB);
    __syncthreads();
    for (int task = tid; task < 2048; task += NWG_T) { const int hh = task >> 10, key = (task >> 3) & 127, ch = task & 7;
        const bf16x8 v = *(const bf16x8*)(P + (size_t)(r0 + key) * INW + 256 + (2 * hp + hh) * 64 + ch * 8);
#pragma unroll
        for (int j = 0; j < 8; ++j) VTl[(hh * 64 + ch * 8 + j) * (RT_VP / 2) + key] = (bf16_t)v[j]; }
    for (int task = tid; task < 8192; task += NWG_T) { const int dv = task & 63, k = (task >> 6) & 31, dir = (task >> 11) & 1, hh = task >> 12;
        STl[(hh * 64 + dv) * (RT_SP / 2) + dir * 32 + k] = (bf16_t)f2bf(SIN[((size_t)(gc * 4 + 2 * hp + hh) * 2 + dir) * 2048 + k * 64 + dv]); }
    __syncthreads();
    const int hh = wid >> 2, h = 2 * hp + hh, qblk = wid & 3; const int n = 32 * qblk + l32; const int rq = r0 + n;
    const float lf = log2_sigmoid(p.ret_decay_f[l * 4 + h]), lb = log2_sigmoid(p.ret_decay_b[l * 4 + h]);
    float qv0[8], qv1[8]; bf16x8 qf0, qf1;
    { const bf16_t* qp = P + (size_t)rq * INW + h * 32 + 8 * hi; const bf16x8 a = *(const bf16x8*)qp, c2 = *(const bf16x8*)(qp + 16);
#pragma unroll
      for (int j = 0; j < 8; ++j) { float x1 = bf2f((unsigned short)a[j]), x2 = bf2f((unsigned short)c2[j]);
          if (lat) { const f32x2 cs = rope[(size_t)(t0 + n) * 16 + 8 * hi + j]; const float y1 = x1 * cs.x - x2 * cs.y, y2 = x2 * cs.x + x1 * cs.y; x1 = y1; x2 = y2; }
          qv0[j] = x1; qv1[j] = x2; }
      qf0 = pack8(qv0[0], qv0[1], qv0[2], qv0[3], qv0[4], qv0[5], qv0[6], qv0[7]); qf1 = pack8(qv1[0], qv1[1], qv1[2], qv1[3], qv1[4], qv1[5], qv1[6], qv1[7]); }
    f32x16 o0, o1;
#pragma unroll
    for (int r = 0; r < 16; ++r) { o0[r] = 0.f; o1[r] = 0.f; }
    const unsigned char* vbase = (const unsigned char*)VTl + (size_t)(hh * 64 + l32) * RT_VP + hi * 8;
#pragma unroll
    for (int kb = 0; kb < 4; ++kb) {
        bf16x8 kf0, kf1;
        { const int key = 32 * kb + l32; const bf16_t* kp = P + (size_t)(r0 + key) * INW + 128 + h * 32 + 8 * hi; const bf16x8 a = *(const bf16x8*)kp, c2 = *(const bf16x8*)(kp + 16);
          float y1[8], y2[8];
#pragma unroll
          for (int j = 0; j < 8; ++j) { float x1 = bf2f((unsigned short)a[j]), x2 = bf2f((unsigned short)c2[j]);
              if (lat) { const f32x2 cs = rope[(size_t)(t0 + key) * 16 + 8 * hi + j]; const float z1 = x1 * cs.x - x2 * cs.y, z2 = x2 * cs.x + x1 * cs.y; x1 = z1; x2 = z2; }
              y1[j] = x1 * 0.17677669529663687f; y2[j] = x2 * 0.17677669529663687f; }
          kf0 = pack8(y1[0], y1[1], y1[2], y1[3], y1[4], y1[5], y1[6], y1[7]); kf1 = pack8(y2[0], y2[1], y2[2], y2[3], y2[4], y2[5], y2[6], y2[7]); }
        f32x16 s;
#pragma unroll
        for (int r = 0; r < 16; ++r) s[r] = 0.f;
        s = __builtin_amdgcn_mfma_f32_32x32x16_bf16(kf0, qf0, s, 0, 0, 0); s = __builtin_amdgcn_mfma_f32_32x32x16_bf16(kf1, qf1, s, 0, 0, 0);
#pragma unroll
        for (int r = 0; r < 16; ++r) { const int m = 32 * kb + crow(r, hi); const int dl = n - m; const float e = dl >= 0 ? lf * (float)dl : lb * (float)(-dl); s[r] *= __builtin_amdgcn_exp2f(e); }
#pragma unroll
        for (int jp = 0; jp < 2; ++jp) { const bf16x8 pb = pack8(s[8 * jp + 0], s[8 * jp + 1], s[8 * jp + 2], s[8 * jp + 3], s[8 * jp + 4], s[8 * jp + 5], s[8 * jp + 6], s[8 * jp + 7]);
            const unsigned char* vp = vbase + (32 * kb + 16 * jp) * 2;
            const u32x2 a00 = *(const u32x2*)vp, a01 = *(const u32x2*)(vp + 16), a10 = *(const u32x2*)(vp + 32 * RT_VP), a11 = *(const u32x2*)(vp + 32 * RT_VP + 16);
            const bf16x8 A0 = __builtin_bit_cast(bf16x8, (u32x4){a00.x, a00.y, a01.x, a01.y}), A1 = __builtin_bit_cast(bf16x8, (u32x4){a10.x, a10.y, a11.x, a11.y});
            o0 = __builtin_amdgcn_mfma_f32_32x32x16_bf16(A0, pb, o0, 0, 0, 0); o1 = __builtin_amdgcn_mfma_f32_32x32x16_bf16(A1, pb, o1, 0, 0, 0); }
    }
    { const float df = __builtin_amdgcn_exp2f(lf * (float)(n + 1)), db = __builtin_amdgcn_exp2f(lb * (float)(128 - n));
      const unsigned char* sbase = (const unsigned char*)STl + (size_t)(hh * 64 + l32) * RT_SP + hi * 16;
#pragma unroll
      for (int ks = 0; ks < 4; ++ks) { const float dd = ks < 2 ? df : db;
          const bf16x8 qb = (ks & 1) ? pack8(qv1[0] * dd, qv1[1] * dd, qv1[2] * dd, qv1[3] * dd, qv1[4] * dd, qv1[5] * dd, qv1[6] * dd, qv1[7] * dd)
                                     : pack8(qv0[0] * dd, qv0[1] * dd, qv0[2] * dd, qv0[3] * dd, qv0[4] * dd, qv0[5] * dd, qv0[6] * dd, qv0[7] * dd);
          const bf16x8 A0 = *(const bf16x8*)(sbase + ks * 32), A1 = *(const bf16x8*)(sbase + 32 * RT_SP + ks * 32);
          o0 = __builtin_amdgcn_mfma_f32_32x32x16_bf16(A0, qb, o0, 0, 0, 0); o1 = __builtin_amdgcn_mfma_f32_32x32x16_bf16(A1, qb, o1, 0, 0, 0); } }
    float ssq = 0.f;
#pragma unroll
    for (int r = 0; r < 16; ++r) ssq += o0[r] * o0[r] + o1[r] * o1[r];
    ssq += __shfl_xor(ssq, 32);
    const float rstd = rsqrtf(ssq * (1.f / 64.f) + EPS);
    const bf16_t* gp = P + (size_t)rq * INW + 512 + h * 64 + 4 * hi; bf16_t* op = MIX + (size_t)rq * 1024 + h * 64 + 4 * hi;
#pragma unroll
    for (int g4 = 0; g4 < 4; ++g4) { const u32x2 ga = *(const u32x2*)(gp + 8 * g4), gb = *(const u32x2*)(gp + 32 + 8 * g4);
        u32x2 w0, w1;
        w0.x = pk2(o0[4 * g4] * rstd * siluf(bf2f(ga.x & 0xffff)), o0[4 * g4 + 1] * rstd * siluf(bf2f(ga.x >> 16))); w0.y = pk2(o0[4 * g4 + 2] * rstd * siluf(bf2f(ga.y & 0xffff)), o0[4 * g4 + 3] * rstd * siluf(bf2f(ga.y >> 16)));
        w1.x = pk2(o1[4 * g4] * rstd * siluf(bf2f(gb.x & 0xffff)), o1[4 * g4 + 1] * rstd * siluf(bf2f(gb.x >> 16))); w1.y = pk2(o1[4 * g4 + 2] * rstd * siluf(bf2f(gb.y & 0xffff)), o1[4 * g4 + 3] * rstd * siluf(bf2f(gb.y >> 16)));
        *(u32x2*)(op + 8 * g4) = w0; *(u32x2*)(op + 32 + 8 * g4) = w1; }
}

DEV void phase_convact(const Params& p, int l, int hf) {
    const bf16_t* U = (const bf16_t*)(p.ws + OFF_OV + OV_U); bf16_t* ACT = (bf16_t*)p.out;
    const float* cw = p.conv_w + (size_t)l * 3 * 5632; const float* cbv = p.conv_b + (size_t)l * 5632;
    const bf16x8 z = {0, 0, 0, 0, 0, 0, 0, 0};
    for (int idx = blockIdx.x * NWG_T + otid(); idx < 176 * 528; idx += gridDim.x * NWG_T) {
        const int rc = idx / 176, j8 = idx - rc * 176; const int r0 = rc * 32; const int b = r0 / RB, s0 = r0 - b * RB;
        if (l == 1 && s0 < NCTX) continue;
        const int ca = hf * HFF + j8 * 8, cbc = DFF + hf * HFF + j8 * 8;
        f32x4 wa[3][2], wb[3][2], ba[2], bb[2];
#pragma unroll
        for (int k = 0; k < 3; ++k)
#pragma unroll
            for (int q = 0; q < 2; ++q) { wa[k][q] = *(const f32x4*)(cw + k * 5632 + ca + 4 * q); wb[k][q] = *(const f32x4*)(cw + k * 5632 + cbc + 4 * q); }
#pragma unroll
        for (int q = 0; q < 2; ++q) { ba[q] = *(const f32x4*)(cbv + ca + 4 * q); bb[q] = *(const f32x4*)(cbv + cbc + 4 * q); }
        const bool first = (s0 == 0) || (s0 == NCTX); const bool lastc = (s0 + 32 == NCTX) || (s0 + 32 == RB);
        const bf16_t* ur = U + (size_t)r0 * DFF + j8 * 8;
        bf16x8 pa = first ? z : *(const bf16x8*)(ur - DFF), pb = first ? z : *(const bf16x8*)(ur - DFF + HFF);
        bf16x8 ca8 = *(const bf16x8*)ur, cb8 = *(const bf16x8*)(ur + HFF);
        bf16x8 na = *(const bf16x8*)(ur + DFF), nb = *(const bf16x8*)(ur + DFF + HFF);
        for (int i = 0; i < 32; ++i) {
            bf16x8 fa = z, fb = z;
            if (i + 2 < 32 || !lastc) { fa = *(const bf16x8*)(ur + (size_t)(i + 2) * DFF); fb = *(const bf16x8*)(ur + (size_t)(i + 2) * DFF + HFF); }
            if (i + 1 == 32 && lastc) { na = z; nb = z; }
            float o[8];
#pragma unroll
            for (int j = 0; j < 8; ++j) { const int q = j >> 2, e = j & 3;
                const float ua = bf2f((unsigned short)pa[j]) * wa[0][q][e] + bf2f((unsigned short)ca8[j]) * wa[1][q][e] + bf2f((unsigned short)na[j]) * wa[2][q][e] + ba[q][e];
                const float ub = bf2f((unsigned short)pb[j]) * wb[0][q][e] + bf2f((unsigned short)cb8[j]) * wb[1][q][e] + bf2f((unsigned short)nb[j]) * wb[2][q][e] + bb[q][e];
                o[j] = siluf(ua) * ub; }
            *(bf16x8*)(ACT + (size_t)(r0 + i) * HFF + j8 * 8) = pack8(o[0], o[1], o[2], o[3], o[4], o[5], o[6], o[7]);
            pa = ca8; pb = cb8; ca8 = na; cb8 = nb; na = fa; nb = fb; }
    }
}

#define RLX_AGENT __ATOMIC_RELAXED, __HIP_MEMORY_SCOPE_AGENT
#define XB_TMO      128
#define XB_XCNT(j)  (256  + 64 * (j))
#define XB_XSUB(j)  (1280 + 64 * (j))
#define XB_XGEN(j)  (2304 + 64 * (j))
#define XB_TOP      3328
#define XB_TOPGEN   3392
#define XCD_BAR_WORDS 3456
#define XB_SPIN_CAP (1u << 18)

__device__ __forceinline__ unsigned xb_ld(unsigned* p)              { return __hip_atomic_load(p, __ATOMIC_RELAXED, __HIP_MEMORY_SCOPE_AGENT); }
__device__ __forceinline__ unsigned xb_add(unsigned* p, unsigned v) { return __hip_atomic_fetch_add(p, v, __ATOMIC_RELAXED, __HIP_MEMORY_SCOPE_AGENT); }
__device__ __forceinline__ unsigned xb_xcc_id() { return (unsigned)__builtin_amdgcn_s_getreg((3 << 11) | 20) & 0xFu; }
#define XB_SPIN(cond, bar) do { unsigned _sp = 0; while (cond) { __builtin_amdgcn_s_sleep(1); \
    if ((++_sp & 255u) == 0u) { if (xb_ld(&(bar)[XB_TMO])) break; if (_sp > XB_SPIN_CAP) { atomicAdd(&(bar)[XB_TMO], 1u); break; } } } } while (0)

struct XcdBarrier {
    unsigned* bar; unsigned x;
    volatile LAS unsigned* st;
};

__device__ __forceinline__ XcdBarrier xcd_barrier_post(unsigned* bar, volatile LAS unsigned* st) {
    XcdBarrier b; b.bar = bar; b.x = xb_xcc_id(); b.st = st;
    if (threadIdx.x == 0) (void)xb_add(&bar[XB_XCNT(b.x)], 1u);
    return b;
}
__device__ __forceinline__ void xcd_barrier_complete(unsigned* bar, unsigned x, unsigned& nloc, unsigned& nx) {
    const unsigned G = gridDim.x * gridDim.y * gridDim.z;
    unsigned sum, cnt, mine, sp = 0u;
    for (;;) {
        sum = 0u; cnt = 0u; mine = 0u;
#pragma unroll
        for (unsigned j = 0; j < 16; ++j) { const unsigned c = xb_ld(&bar[XB_XCNT(j)]); sum += c; cnt += (c > 0u) ? 1u : 0u; mine = (j == x) ? c : mine; }
        if (sum == G) break;
        __builtin_amdgcn_s_sleep(1);
        if ((++sp & 255u) == 0u) { if (xb_ld(&bar[XB_TMO])) break; if (sp > XB_SPIN_CAP) { atomicAdd(&bar[XB_TMO], 1u); break; } }
    }
    nloc = mine > 0u ? mine : 1u; nx = cnt > 0u ? cnt : 1u;
}

__device__ __forceinline__ void xcd_barrier(const XcdBarrier& b) {
    asm volatile("s_waitcnt vmcnt(0)" ::: "memory");
    __syncthreads();
    if (threadIdx.x == 0) {
        unsigned* bar = b.bar;
        __builtin_amdgcn_s_waitcnt(0);
        unsigned nloc = b.st[0], nx = b.st[1];
        if (nloc == 0u) { xcd_barrier_complete(bar, b.x, nloc, nx); b.st[0] = nloc; b.st[1] = nx; }
        const unsigned old = xb_add(&bar[XB_XSUB(b.x)], 1u);
        const unsigned gen = old / nloc;
        if (old + 1u == (gen + 1u) * nloc) {
            __builtin_amdgcn_fence(__ATOMIC_RELEASE, "agent");
            asm volatile("s_waitcnt vmcnt(0)" ::: "memory");
            const unsigned og = xb_add(&bar[XB_TOP], 1u);
            const unsigned tg = og / nx;
            if (og + 1u == (tg + 1u) * nx) xb_add(&bar[XB_TOPGEN], 1u);
            else XB_SPIN(xb_ld(&bar[XB_TOPGEN]) == tg, bar);
            __builtin_amdgcn_fence(__ATOMIC_ACQUIRE, "agent");
            xb_add(&bar[XB_XGEN(b.x)], 1u);
            asm volatile("s_waitcnt vmcnt(0)" ::: "memory");
        } else {
            XB_SPIN(xb_ld(&bar[XB_XGEN(b.x)]) == gen, bar);
            __builtin_amdgcn_fence(__ATOMIC_ACQUIRE, "agent");
            asm volatile("s_waitcnt vmcnt(0)" ::: "memory");
        }
    }
    __syncthreads();
}


constexpr size_t OFF_CTL = 250000128; constexpr int CTL_BYTES = 16384;
#if defined(__HIP_DEVICE_COMPILE__)
#define KP() const __attribute__((address_space(4))) Params* kp_ = (const __attribute__((address_space(4))) Params*)__builtin_amdgcn_kernarg_segment_ptr(); asm volatile("" : "+s"(kp_)); const Params p = *kp_; \
    bf16_t* HN = (bf16_t*)(p.ws + OFF_HN); bf16_t* P = (bf16_t*)p.out; float* X = (float*)(p.ws + OFF_X); (void)HN; (void)P; (void)X
#else
#define KP() const Params p = p_arg; bf16_t* HN = (bf16_t*)(p.ws + OFF_HN); bf16_t* P = (bf16_t*)p.out; float* X = (float*)(p.ws + OFF_X); (void)HN; (void)P; (void)X
#endif
#define WL() const bf16_t* wl = (const bf16_t*)(p.ws + OFF_W) + (size_t)l * W_LAYER; const float* modv = (const float*)(p.ws + OFF_MOD) + (size_t)l * 3 * 6144; (void)wl; (void)modv
#ifndef DUPM
#define DUPM 0
#endif
#define REP(bit) for (int rep_ = 0; rep_ < (((DUPM) >> (bit)) & 1) + 1; ++rep_)
constexpr int PH_PER_LAYER = 12, N_PHASES = 2 + 2 * PH_PER_LAYER;
__global__ void __launch_bounds__(512, 2) mk_fwd(Params p_arg) {
    extern __shared__ __attribute__((aligned(16))) unsigned char lds[];
    cg::grid_group grid = cg::this_grid();
    const int G = gridDim.x, bx = blockIdx.x; const int vcu = (G % 8 == 0) ? (bx % 8) * (G / 8) + bx / 8 : bx;
    LAS unsigned char* ldsl = (LAS unsigned char*)lds;
    const int ph_lo = p_arg.ph_lo, ph_hi = p_arg.ph_hi;
    volatile LAS unsigned* misc = (volatile LAS unsigned*)(ldsl + (LDS_BYTES - 64));
    { const int t0_ = otid(); if (t0_ < 16) misc[t0_] = 0u; }
    __syncthreads();
    if (ph_hi - ph_lo > 1) (void)xcd_barrier_post((unsigned*)(p_arg.ws + OFF_CTL), misc);
    for (int ph = ph_lo; ph < ph_hi; ++ph) {
        if (ph == 0) { KP(); REP(9) { phase_prep(p, lds); __syncthreads(); } }
        else if (ph == N_PHASES - 1) { KP(); REP(0) phase_final(p);
#if (DUPM >> 10) & 1
            for (int i = 0; i < 20; ++i) grid.sync();
#endif
        }
        else {
            const int l = (ph - 1) / PH_PER_LAYER, sp = (ph - 1) % PH_PER_LAYER;
            if (sp == 0) { KP(); REP(0) phase_norm(p, l, 0, l == 0); }
            else if (sp == 1) { KP(); WL(); REP(1) { __syncthreads();
                pg8::Gemm g{HN, wl + W_IN, R, 1792, 1024, 1024, 1024}; pg8::StaticOrder S; S.init(R, 1792, G, bx);
                pg8::EpiStore E{P, INW, INW, 1.0f};
                pg8::gemm_phase<pg8::EpiStore, pg8::StaticOrder, true, true>(ldsl, g, S, E); } }
            else if (sp == 2) { KP(); phase_rowwise(p, l); __syncthreads();
                REP(2) phase_pool(p);
                REP(3) for (int it = bx; it < 528; it += G) states_item(p, l, lds, it); }
            else if (sp == 3) { KP(); WL(); REP(4) { __syncthreads();
                { pg8::Gemm g{P + 768, wl + W_UQ, R, 768, 384, INW, 384}; pg8::StaticOrder S; S.init(R, 768, G, bx);
                  pg8::EpiStore E{(bf16_t*)(p.ws + OFF_OV + OV_Q), 768, 768, 0.14724444f};
                  pg8::gemm_phase<pg8::EpiStore, pg8::StaticOrder, true, true>(ldsl, g, S, E); }
                __syncthreads();
                { pg8::Gemm g{P + 1152, wl + W_KN, R, 512, 256, INW, 256}; pg8::StaticOrder S; S.init(R, 512, G, (bx + 58) % G);
                  pg8::EpiStore E{(bf16_t*)(p.ws + OFF_OV + OV_KN), 512, 512, 1.0f};
                  pg8::gemm_phase<pg8::EpiStore, pg8::StaticOrder, true, true>(ldsl, g, S, E); }
                __syncthreads();
                { pg8::Gemm g{wl + W_V, P + 1152, 512, R, 256, 256, INW}; pg8::StaticOrder S; S.init(512, R, G, (bx + 182) % G);
                  pg8::EpiStore E{(bf16_t*)(p.ws + OFF_OV + OV_VT), R, R, 1.0f};
                  pg8::gemm_phase<pg8::EpiStore, pg8::StaticOrder, true, true>(ldsl, g, S, E); }
                if (bx >= G - 64) scan_threads(p, l, (bx - (G - 64)) * NWG_T + otid()); } }
            else if (sp == 4) { KP();
                REP(5) for (int u = vcu; u < 528; u += G) attn_unit(p, lds, u);
                REP(6) for (int u = G - 1 - bx; u < 264; u += G) retout_unit(p, l, lds, u); }
            else if (sp == 5) { KP(); WL(); __syncthreads();
                pg8::Gemm g{HN, wl + W_OUT, R, 1024, 1024, 1024, 1024}; pg8::StaticOrder S; S.init(l == 1 ? 16384 : R, 1024, G, bx, l == 1 ? 1 : 0);
                pg8::EpiResid E{X, modv + 2048, 0};
                pg8::gemm_phase<pg8::EpiResid, pg8::StaticOrder, true, true>(ldsl, g, S, E); }
            else if (sp == 6) { KP(); REP(0) phase_norm(p, l, 1, false); }
            else if (sp == 7 || sp == 9 || sp == 11) { KP(); WL();
                __syncthreads();
                if (sp >= 9) { const int hf = sp == 9 ? 0 : 1;
                    pg8::Gemm g{P, wl + W_DN + hf * HFF, R, 1024, HFF, HFF, DFF}; pg8::StaticOrder S; S.init(l == 1 ? 16384 : R, 1024, G, bx, l == 1 ? 1 : 0);
                    pg8::EpiResid E{X, modv + 5120, 0};
                    pg8::gemm_phase<pg8::EpiResid, pg8::StaticOrder, true, true>(ldsl, g, S, E); __syncthreads(); }
                if (sp <= 9) REP(7) { __syncthreads(); const int hf = sp == 7 ? 0 : 1;
                    pg8::Gemm g{HN, wl + W_UP + (size_t)hf * DFF * 1024, R, DFF, 1024, 1024, 1024}; pg8::StaticOrder S; S.init(l == 1 ? 16384 : R, DFF, G, (bx + (sp == 9 && l == 0 ? 8 : 0)) % G, l == 1 ? 1 : 0);
                    pg8::EpiStore E{(bf16_t*)(p.ws + OFF_OV + OV_U), DFF, DFF, 1.0f};
                    pg8::gemm_phase<pg8::EpiStore, pg8::StaticOrder, true, true>(ldsl, g, S, E); } }
            else if (sp == 8) { KP(); REP(8) phase_convact(p, l, 0); }
            else if (sp == 10) { KP(); REP(8) phase_convact(p, l, 1); }
        }
        if (ph + 1 < ph_hi) {
            if (ph == ph_lo) grid.sync();
            else { KP(); XcdBarrier b; b.bar = (unsigned*)(p.ws + OFF_CTL); b.x = xb_xcc_id(); b.st = misc; xcd_barrier(b); }
        }
    }
}

extern "C" void kernel_launch(void* const* d_in, const int* in_sizes, int n_in, void* d_out, int out_size, void* d_ws, size_t ws_size, hipStream_t stream) {
    static int grid = 0;
    if (grid == 0) {
        if (n_in != 23 || ws_size < WS_NEED) { fprintf(stderr, "kernel_launch: unexpected problem (n_in %d, ws %zu, need %zu)\n", n_in, ws_size, (size_t)WS_NEED); grid = -1; return; }
        int dev = 0, cus = 0, per_cu = 0;
        hipGetDevice(&dev); hipDeviceGetAttribute(&cus, hipDeviceAttributeMultiprocessorCount, dev);
        if (hipFuncSetAttribute((const void*)mk_fwd, hipFuncAttributeMaxDynamicSharedMemorySize, LDS_BYTES) != hipSuccess) { fprintf(stderr, "kernel_launch: hipFuncSetAttribute failed\n"); grid = -1; return; }
        if (hipOccupancyMaxActiveBlocksPerMultiprocessor(&per_cu, (const void*)mk_fwd, 512, LDS_BYTES) != hipSuccess || per_cu < 1) { fprintf(stderr, "kernel_launch: occupancy query says %d\n", per_cu); per_cu = 1; }
        (void)hipGetLastError();
        grid = cus * per_cu; if (grid > 256) grid = 256;
        fprintf(stderr, "kernel_launch: grid %d (cus %d, per_cu %d)\n", grid, cus, per_cu);
    }
    if (grid < 0) return;
    Params p{};
    const float** pp = (const float**)&p;
    for (int i = 0; i < 23; ++i) pp[i] = (const float*)d_in[i];
    p.out = (float*)d_out; p.ws = (unsigned char*)d_ws;
#if MK_MULTI
    for (int ph = 0; ph < N_PHASES; ++ph) { p.ph_lo = ph; p.ph_hi = ph + 1; void* args[] = {&p};
        hipError_t e = hipLaunchCooperativeKernel((void*)mk_fwd, dim3(grid), dim3(512), args, LDS_BYTES, stream);
        if (e != hipSuccess) { fprintf(stderr, "launch %d failed: %s\n", ph, hipGetErrorString(e)); break; } }
#else
    if (hipMemsetAsync((char*)d_ws + OFF_CTL, 0, CTL_BYTES, stream) != hipSuccess) { fprintf(stderr, "kernel_launch: memset of the barrier words failed\n"); return; }
    p.ph_lo = 0; p.ph_hi = N_PHASES; void* args[] = {&p};
    hipError_t e = hipLaunchCooperativeKernel((void*)mk_fwd, dim3(grid), dim3(512), args, LDS_BYTES, stream);
    if (e != hipSuccess) fprintf(stderr, "cooperative launch failed: %s (grid %d)\n", hipGetErrorString(e), grid);
#endif
}
```

```cpp
#include <hip/hip_runtime.h>
#include <hip/hip_cooperative_groups.h>
#include <cstdio>
#include <cstdint>
namespace cg = cooperative_groups;

#ifndef MK_MULTI
#define MK_MULTI 0
#endif

namespace pg8 {
#define PG8_LAS __attribute__((address_space(3)))
typedef unsigned short bf16_t;
typedef short bf16x8 __attribute__((ext_vector_type(8)));
typedef float f32x4 __attribute__((ext_vector_type(4)));
typedef unsigned u32x4 __attribute__((ext_vector_type(4)));
constexpr int BM = 256, BK = 64, HALF = 128, HTB = HALF * BK * 2  , STAGE_BYTES = 8 * HTB, NXCD = 8, WGM = 8;

__host__ __device__ __forceinline__ int lds_byte(int r, int c) { const int st = (r >> 4) * 2 + (c >> 5), rr = r & 15, cc = c & 31, ob = rr * 64 + cc * 2; return st * 1024 + (ob ^ (((ob >> 9) & 1) << 5)); }
__host__ __device__ __forceinline__ void stage_rc(int b, int& R, int& C) { const int st = b / 1024, sb = b % 1024, swz = sb ^ (((sb >> 9) & 1) << 5); R = (st >> 1) * 16 + swz / 64; C = (st & 1) * 32 + (swz % 64) / 2; }
__host__ __device__ __forceinline__ int perm32(int rho) { const int n = rho >> 4, i = rho & 15; return 8 * (i >> 2) + 4 * n + (i & 3); }

struct Unit { int pm, pn; };
struct Gemm { const bf16_t* A; const bf16_t* Bt; int M, N, K, lda, ldb; };

struct StaticOrder {
    int nM, nN, nwg, G, c, skip;
    __host__ __device__ void init(int M, int N, int G_, int c_, int skip_ = 0) { nM = M / BM; nN = N / BM; nwg = nM * nN; G = G_; c = c_; skip = skip_; }
    __host__ __device__ bool next(int i, Unit& u) const {
        const long L = (long)i * G + c; if (L >= nwg) return false;
        int wgid = (int)L; { const int q = nwg / NXCD, r = nwg % NXCD, xcd = wgid % NXCD, off = wgid / NXCD; wgid = (xcd < r ? xcd * (q + 1) : r * (q + 1) + (xcd - r) * q) + off; }
        const int nig = WGM * nN, gid = wgid / nig, fm = gid * WGM, gsz = (nM - fm) < WGM ? (nM - fm) : WGM;
        u.pm = fm + ((wgid % nig) % gsz); u.pn = (wgid % nig) / gsz; if (skip) u.pm += 1 + (u.pm >= 32 ? 1 : 0); return true;
    }
    __device__ __forceinline__ void a_ready(const Unit&) const {}
    __device__ __forceinline__ void done(const Unit&) const {}
};

__device__ __forceinline__ unsigned cvt_pk_bf16(float lo, float hi) { unsigned r; asm volatile("v_cvt_pk_bf16_f32 %0, %1, %2" : "=v"(r) : "v"(lo), "v"(hi)); return r; }

struct EpiStore {
    static constexpr bool PERM = true, AFTER_DRAIN = false;
    bf16_t* O; int ldc; int ncols; float scale;
    __device__ __forceinline__ void operator()(const f32x4 (&acc)[2][2][4][2], const Unit& u, int wr, int wc, int fr, int fq) const {
        const int row0 = u.pm * BM + wr * 64 + fr; const int col0 = u.pn * BM + wc * 32 + 8 * fq;
#pragma unroll
        for (int ai = 0; ai < 2; ++ai)
#pragma unroll
            for (int m = 0; m < 4; ++m) { bf16_t* rowp = O + (size_t)(row0 + ai * HALF + m * 16) * ldc + col0;
#pragma unroll
                for (int bj = 0; bj < 2; ++bj) { if (col0 + bj * HALF < ncols) {
                    f32x4 v0 = acc[ai][bj][m][0] * scale, v1 = acc[ai][bj][m][1] * scale;
                    u32x4 w; w.x = cvt_pk_bf16(v0[0], v0[1]); w.y = cvt_pk_bf16(v0[2], v0[3]); w.z = cvt_pk_bf16(v1[0], v1[1]); w.w = cvt_pk_bf16(v1[2], v1[3]);
                    *(u32x4*)(rowp + bj * HALF) = w; } } }
    }
};
struct EpiResid {
    static constexpr bool PERM = false, AFTER_DRAIN = false;
    float* X; const float* gate; int row_tile0;
    __device__ __forceinline__ void operator()(const f32x4 (&acc)[2][2][4][2], const Unit& u, int wr, int wc, int fr, int fq) const {
        const int tpm = u.pm + row_tile0; const int bb = tpm / 33, jj = tpm - bb * 33; const float* gv = gate + (jj == 0 ? 2 : bb) * 6144;
        const int col0 = u.pn * BM + wc * 32 + 4 * fq;
#pragma unroll
        for (int ai = 0; ai < 2; ++ai)
#pragma unroll
            for (int m = 0; m < 4; ++m) { float* rowp = X + (size_t)(tpm * BM + ai * HALF + wr * 64 + m * 16 + fr) * 1024 + col0;
#pragma unroll
                for (int bj = 0; bj < 2; ++bj) {
#pragma unroll
                    for (int n = 0; n < 2; ++n) { f32x4* q = (f32x4*)(rowp + bj * HALF + n * 16); const f32x4 gq = *(const f32x4*)(gv + col0 + bj * HALF + n * 16); f32x4 xv = *q; xv = xv + gq * acc[ai][bj][m][n]; *q = xv; }
                    asm volatile("" ::: "memory"); } }
    }
};

template <class Epi, class Sched, bool ALIGN_EPI = false, bool SP2 = false>
__device__ __forceinline__ void gemm_phase(PG8_LAS unsigned char* lds, const Gemm g, const Sched& S, const Epi& E) {
    int tid = threadIdx.x; asm volatile("" : "+v"(tid));
    const int wid = __builtin_amdgcn_readfirstlane(tid >> 6), lane = tid & 63, wr = wid >> 2, wc = wid & 3, fr = lane & 15, fq = lane >> 4;
    int K = g.K; asm volatile("" : "+s"(K));
    const int nt = K / BK;
    unsigned voffA[2], voffB[2];
#pragma unroll
    for (int i = 0; i < 2; ++i) { int R, C; stage_rc(tid * 16 + i * 8192, R, C); const int Rb = Epi::PERM ? ((R & ~31) + perm32(R & 31)) : R;
        voffA[i] = (unsigned)(R * g.lda + C) * 2u; voffB[i] = (unsigned)(Rb * g.ldb + C) * 2u; }
    const size_t kstep = (size_t)(BK * 2);
    const size_t hstepA = (size_t)HALF * g.lda * 2, hstepB = (size_t)HALF * g.ldb * 2;
    const size_t tstepA = 2 * hstepA, tstepB = 2 * hstepB;
    const unsigned ldsw = (unsigned)wid * 1024u;
    const int aoff = lds_byte(wr * 64 + fr, fq * 8), boff = lds_byte(wc * 32 + fr, fq * 8);
#define PG8_SA(b, h) (((b) * 2 + (h)) * HTB)
#define PG8_SB(b, h) ((4 + (b) * 2 + (h)) * HTB)
#define PG8_STAGE(bufoff, gbase, voff) do { _Pragma("unroll") for (int _i = 0; _i < 2; ++_i) \
        __builtin_amdgcn_global_load_lds((const unsigned*)((const char*)(gbase) + (voff)[_i]), (PG8_LAS unsigned*)(lds + (bufoff) + ldsw + _i * 8192), 16, 0, 0); } while (0)
#define PG8_LDA(dst, b, h) do { _Pragma("unroll") for (int m = 0; m < 4; ++m) _Pragma("unroll") for (int k = 0; k < 2; ++k) dst[m][k] = *(const PG8_LAS bf16x8*)(lds + PG8_SA(b, h) + aoff + m * 2048 + k * 1024); } while (0)
#define PG8_LDB(dst, b, h) do { _Pragma("unroll") for (int n = 0; n < 2; ++n) _Pragma("unroll") for (int k = 0; k < 2; ++k) dst[n][k] = *(const PG8_LAS bf16x8*)(lds + PG8_SB(b, h) + boff + n * 2048 + k * 1024); } while (0)
#define PG8_MMA(ai, bj, At, Bt) do { __builtin_amdgcn_s_setprio(1); _Pragma("unroll") for (int m = 0; m < 4; ++m) _Pragma("unroll") for (int n = 0; n < 2; ++n) _Pragma("unroll") for (int k = 0; k < 2; ++k) \
        acc[ai][bj][m][n] = __builtin_amdgcn_mfma_f32_16x16x32_bf16(Bt[n][k], At[m][k], acc[ai][bj][m][n], 0, 0, 0); __builtin_amdgcn_s_setprio(0); } while (0)
#define PG8_WAIT_V(n) asm volatile("s_waitcnt vmcnt(" #n ")" ::: "memory")
#define PG8_WAIT_L(n) asm volatile("s_waitcnt lgkmcnt(" #n ")" ::: "memory")
#define PG8_BAR __builtin_amdgcn_s_barrier()
#define PG8_SCHED __builtin_amdgcn_sched_barrier(0)
    Unit cur, nxt; int ui = 0;
    if (!S.next(0, cur)) return;
    f32x4 acc[2][2][4][2];
#pragma unroll
    for (int a = 0; a < 2; ++a)
#pragma unroll
        for (int b = 0; b < 2; ++b)
#pragma unroll
            for (int m = 0; m < 4; ++m)
#pragma unroll
                for (int n = 0; n < 2; ++n) acc[a][b][m][n] = (f32x4){0.f, 0.f, 0.f, 0.f};
    bf16x8 At[4][2], B0[2][2], B1[2][2];
    const char* cA = (const char*)g.A + (size_t)cur.pm * tstepA; const char* cB = (const char*)g.Bt + (size_t)cur.pn * tstepB;
    S.a_ready(cur);
    if constexpr (SP2) {
        PG8_STAGE(PG8_SB(0, 0), cB, voffB); PG8_STAGE(PG8_SB(0, 1), cB + hstepB, voffB); PG8_STAGE(PG8_SA(0, 0), cA, voffA); PG8_STAGE(PG8_SA(0, 1), cA + hstepA, voffA);
        if (wr == 1) PG8_BAR;
        PG8_WAIT_V(2); PG8_BAR;
        PG8_STAGE(PG8_SB(1, 0), cB + kstep, voffB); PG8_STAGE(PG8_SA(1, 0), cA + kstep, voffA); PG8_STAGE(PG8_SB(1, 1), cB + hstepB + kstep, voffB);
        PG8_WAIT_V(6); PG8_BAR;
    } else {
        PG8_STAGE(PG8_SB(0, 0), cB, voffB); PG8_STAGE(PG8_SA(0, 0), cA, voffA); PG8_STAGE(PG8_SB(0, 1), cB + hstepB, voffB); PG8_STAGE(PG8_SA(0, 1), cA + hstepA, voffA);
        if (wr == 1) PG8_BAR;
        PG8_WAIT_V(4); PG8_BAR;
        PG8_STAGE(PG8_SB(1, 0), cB + kstep, voffB); PG8_STAGE(PG8_SA(1, 0), cA + kstep, voffA); PG8_STAGE(PG8_SB(1, 1), cB + hstepB + kstep, voffB);
        PG8_WAIT_V(6); PG8_BAR;
    }
    for (;;) {
        const bool has_next = S.next(ui + 1, nxt);
        const char* nA = has_next ? (const char*)g.A + (size_t)nxt.pm * tstepA : cA; const char* nB = has_next ? (const char*)g.Bt + (size_t)nxt.pn * tstepB : cB;
        for (int t = 0; t < nt; t += 2) {
            const bool last = (t == nt - 2);
            const char* a1 = cA + (size_t)(t + 1) * kstep;
            const char* a2 = last ? nA : cA + (size_t)(t + 2) * kstep; const char* b2 = last ? nB : cB + (size_t)(t + 2) * kstep;
            const char* a3 = a2 + kstep; const char* b3 = b2 + kstep;
            if (last && has_next) S.a_ready(nxt);
            if constexpr (SP2) {
            PG8_LDB(B0, 0, 0); PG8_LDB(B1, 0, 1); PG8_SCHED; PG8_LDA(At, 0, 0); PG8_STAGE(PG8_SA(1, 1), a1 + hstepA, voffA);
            PG8_WAIT_V(8); PG8_WAIT_L(0); PG8_BAR; PG8_MMA(0, 0, At, B0); PG8_MMA(0, 1, At, B1); PG8_BAR; PG8_SCHED;
            PG8_LDA(At, 0, 1); PG8_STAGE(PG8_SB(0, 0), b2, voffB); PG8_STAGE(PG8_SB(0, 1), b2 + hstepB, voffB); PG8_STAGE(PG8_SA(0, 0), a2, voffA);
            PG8_WAIT_V(8); PG8_WAIT_L(0); PG8_BAR; PG8_MMA(1, 0, At, B0); PG8_MMA(1, 1, At, B1); PG8_BAR; PG8_SCHED;
            PG8_LDB(B0, 1, 0); PG8_LDB(B1, 1, 1); PG8_SCHED; PG8_LDA(At, 1, 0); PG8_STAGE(PG8_SA(0, 1), a2 + hstepA, voffA);
            PG8_WAIT_V(8); PG8_WAIT_L(0); PG8_BAR; PG8_MMA(0, 0, At, B0); PG8_MMA(0, 1, At, B1); PG8_BAR; PG8_SCHED;
            PG8_LDA(At, 1, 1); PG8_STAGE(PG8_SB(1, 0), b3, voffB); PG8_STAGE(PG8_SB(1, 1), b3 + hstepB, voffB); PG8_STAGE(PG8_SA(1, 0), a3, voffA);
            PG8_WAIT_V(8); PG8_WAIT_L(0); PG8_BAR; PG8_MMA(1, 0, At, B0); PG8_MMA(1, 1, At, B1); PG8_BAR; PG8_SCHED;
            } else {
            PG8_LDB(B0, 0, 0); PG8_SCHED; PG8_LDA(At, 0, 0); PG8_STAGE(PG8_SA(1, 1), a1 + hstepA, voffA);
            PG8_WAIT_L(8); PG8_BAR; PG8_WAIT_L(0); PG8_MMA(0, 0, At, B0); PG8_BAR; PG8_SCHED;
            PG8_LDB(B1, 0, 1); PG8_STAGE(PG8_SB(0, 0), b2, voffB);
            PG8_BAR; PG8_WAIT_L(0); PG8_MMA(0, 1, At, B1); PG8_BAR;
            PG8_LDA(At, 0, 1); PG8_STAGE(PG8_SA(0, 0), a2, voffA);
            PG8_BAR; PG8_WAIT_L(0); PG8_MMA(1, 0, At, B0); PG8_BAR; PG8_SCHED;
            PG8_STAGE(PG8_SB(0, 1), b2 + hstepB, voffB);
            PG8_WAIT_V(6); PG8_BAR; PG8_MMA(1, 1, At, B1); PG8_BAR;
            PG8_LDB(B0, 1, 0); PG8_SCHED; PG8_LDA(At, 1, 0); PG8_STAGE(PG8_SA(0, 1), a2 + hstepA, voffA);
            PG8_WAIT_L(8); PG8_BAR; PG8_WAIT_L(0); PG8_MMA(0, 0, At, B0); PG8_BAR; PG8_SCHED;
            PG8_LDB(B1, 1, 1); PG8_STAGE(PG8_SB(1, 0), b3, voffB);
            PG8_BAR; PG8_WAIT_L(0); PG8_MMA(0, 1, At, B1); PG8_BAR;
            PG8_LDA(At, 1, 1); PG8_STAGE(PG8_SA(1, 0), a3, voffA);
            PG8_BAR; PG8_WAIT_L(0); PG8_MMA(1, 0, At, B0); PG8_BAR; PG8_SCHED;
            PG8_STAGE(PG8_SB(1, 1), b3 + hstepB, voffB);
            PG8_WAIT_V(6); PG8_BAR; PG8_MMA(1, 1, At, B1); PG8_BAR;
            }
        }
        if constexpr (ALIGN_EPI) { if (wr == 0) PG8_BAR; }
        if constexpr (!Epi::AFTER_DRAIN) { E(acc, cur, wr, wc, fr, fq); S.done(cur); }
        if (!has_next) break;
#pragma unroll
        for (int a = 0; a < 2; ++a)
#pragma unroll
            for (int b = 0; b < 2; ++b)
#pragma unroll
                for (int m = 0; m < 4; ++m)
#pragma unroll
                    for (int n = 0; n < 2; ++n) acc[a][b][m][n] = (f32x4){0.f, 0.f, 0.f, 0.f};
        cur = nxt; cA = nA; cB = nB; ++ui;
        if constexpr (ALIGN_EPI) { if (wr == 1) PG8_BAR; }
    }
    PG8_WAIT_V(0);
    if constexpr (!ALIGN_EPI) { if (wr == 0) PG8_BAR; }
    PG8_BAR;
    if constexpr (Epi::AFTER_DRAIN) { E.fused(acc, cur, wr, wc, fr, fq, lds, wid, lane); S.done(cur); }
#undef PG8_SA
#undef PG8_SB
#undef PG8_STAGE
#undef PG8_LDA
#undef PG8_LDB
#undef PG8_MMA
#undef PG8_WAIT_V
#undef PG8_WAIT_L
#undef PG8_BAR
#undef PG8_SCHED
}
}

#define DEV __device__ __forceinline__
#define LAS __attribute__((address_space(3)))
typedef unsigned short bf16_t;
typedef short bf16x8 __attribute__((ext_vector_type(8)));
typedef float f32x4 __attribute__((ext_vector_type(4)));
typedef float f32x2 __attribute__((ext_vector_type(2)));
typedef float f32x16 __attribute__((ext_vector_type(16)));
typedef unsigned u32x4 __attribute__((ext_vector_type(4)));
typedef unsigned u32x2 __attribute__((ext_vector_type(2)));

constexpr int R = 16896, RB = 8448, NCTX = 256, TL = 8192, DM = 1024, INW = 1696, DFF = 2816, HFF = 1408;
constexpr int NWG_T = 512;
constexpr float EPS = 1e-6f;
constexpr int LDS_BYTES = 147456;
constexpr size_t OFF_X = 0, OFF_HN = 69206016, OFF_W = 103809024, OFF_MOD = 152174592, OFF_ROPE = 152436736, OFF_OV = 153485312;
constexpr size_t OV_Q = 0, OV_KN = 25952256, OV_VT = 43253760, OV_SLOC = 60555264, OV_SIN = 69206016, OV_U = 0;
constexpr size_t WS_NEED = 250000128 + 16384;
constexpr size_t W_IN = 0, W_UQ = 1835008, W_KN = 2129920, W_V = 2260992, W_OUT = 2392064, W_UP = 3440640, W_DN = 9207808, W_LAYER = 12091392;

struct Params {
    const float *x, *c, *ctx, *c_ctx, *w_mod, *b_mod, *norm1_g, *w_in, *ret_decay_f, *ret_decay_b, *mla_q_norm_g, *w_uq, *mla_kv_norm_g, *w_ukv,
        *pool_w, *pool_scale, *w_out, *norm2_g, *w_up, *conv_w, *conv_b, *w_down, *final_norm_g;
    float* out; unsigned char* ws; int ph_lo, ph_hi;
};

DEV int otid() { int t = threadIdx.x; asm volatile("" : "+v"(t)); return t; }
DEV float bf2f(unsigned short x) { return __uint_as_float((unsigned)x << 16); }
DEV unsigned f2bf(float f) { unsigned u = __float_as_uint(f); return (u + 0x7fffu + ((u >> 16) & 1u)) >> 16; }
DEV unsigned pk2(float lo, float hi) { return f2bf(lo) | (f2bf(hi) << 16); }
DEV float wave_sum(float v) {
#pragma unroll
    for (int o = 1; o < 64; o <<= 1) v += __shfl_xor(v, o);
    return v;
}
DEV float siluf(float x) { return x / (1.0f + __expf(-x)); }
DEV int crow(int r, int hi) { return (r & 3) + 8 * (r >> 2) + 4 * hi; }
DEV bf16x8 pack8(float a0, float a1, float a2, float a3, float a4, float a5, float a6, float a7) {
    u32x4 w; w.x = pg8::cvt_pk_bf16(a0, a1); w.y = pg8::cvt_pk_bf16(a2, a3); w.z = pg8::cvt_pk_bf16(a4, a5); w.w = pg8::cvt_pk_bf16(a6, a7);
    return __builtin_bit_cast(bf16x8, w);
}
DEV int row_mi(int r) { const int b = r / RB; const int s = r - b * RB; return s < NCTX ? 2 : b; }

DEV void transpose_item(const float* W, int K, int Nsrc, bf16_t* WT, int n0, int cs, int k0, float* scr, int lane) {
#pragma unroll 8
    for (int i = 0; i < 32; ++i) { const int kk = 2 * i + (lane >> 5); scr[kk * 33 + (lane & 31)] = cs >= 0 ? W[(size_t)(k0 + kk) * Nsrc + cs + (lane & 31)] : 0.f; }
    asm volatile("s_waitcnt lgkmcnt(0)" ::: "memory");
    const int c = lane & 7;
#pragma unroll
    for (int j = 0; j < 4; ++j) { const int n = (lane >> 3) + 8 * j; const float* s = scr + (8 * c) * 33 + n;
        u32x4 o; o.x = pk2(s[0 * 33], s[1 * 33]); o.y = pk2(s[2 * 33], s[3 * 33]); o.z = pk2(s[4 * 33], s[5 * 33]); o.w = pk2(s[6 * 33], s[7 * 33]);
        *(u32x4*)(WT + (size_t)(n0 + n) * K + k0 + 8 * c) = o; }
    asm volatile("s_waitcnt lgkmcnt(0)" ::: "memory");
}
DEV int map_in(int n0) { return n0 < 1440 ? n0 : (n0 < INW ? -2 : -1); }
DEV int map_kn(int n0) { return (n0 >> 6) * 128 + (n0 & 63); }
DEV int map_v(int n0) { return (n0 >> 6) * 128 + 64 + (n0 & 63); }
DEV int map_up(int n0) { const int hf = n0 / DFF, w = n0 - hf * DFF; return w < HFF ? hf * HFF + w : DFF + hf * HFF + (w - HFF); }

DEV void phase_prep(const Params& p, unsigned char* lds) {
    const int tid = otid(), lane = tid & 63, wid = tid >> 6;
    unsigned char* ws = p.ws;
    { f32x2* rope = (f32x2*)(ws + OFF_ROPE);
      for (int idx = blockIdx.x * NWG_T + tid; idx < TL * 16; idx += gridDim.x * NWG_T) { const int t = idx >> 4, i = idx & 15; const int pos = i < 8 ? (t >> 6) : (t & 63);
          const float inv = exp2f(-(float)(i & 7) * 0.125f * 13.287712379549449f); const float ang = (float)pos * inv; f32x2 cs; cs.x = __cosf(ang); cs.y = __sinf(ang); rope[idx] = cs; } }
    { float* scv = (float*)lds;
      float* red = scv + 3 * 1024;
      for (int i = tid; i < 3 * 1024; i += NWG_T) { const int v = i >> 10, k = i & 1023; const float cv = v < 2 ? p.c[v * 1024 + k] : p.c_ctx[k]; scv[i] = siluf(cv); }
      __syncthreads();
      float* modv = (float*)(ws + OFF_MOD);
      for (int it = blockIdx.x; it < 192; it += gridDim.x) { const int l = it / 96, col0 = (it % 96) * 64;
          const float* wm = p.w_mod + (size_t)l * 1024 * 6144 + col0 + lane; float a0 = 0.f, a1 = 0.f, a2 = 0.f;
#pragma unroll 8
          for (int k = wid * 128; k < wid * 128 + 128; ++k) { const float w = wm[(size_t)k * 6144]; a0 += scv[k] * w; a1 += scv[1024 + k] * w; a2 += scv[2048 + k] * w; }
          red[(wid * 3 + 0) * 64 + lane] = a0; red[(wid * 3 + 1) * 64 + lane] = a1; red[(wid * 3 + 2) * 64 + lane] = a2;
          __syncthreads();
          if (tid < 192) { const int v = tid >> 6, cl = tid & 63; float s = 0.f;
#pragma unroll
              for (int w = 0; w < 8; ++w) s += red[(w * 3 + v) * 64 + cl];
              modv[((size_t)l * 3 + v) * 6144 + col0 + cl] = s + p.b_mod[l * 6144 + col0 + cl]; }
          __syncthreads(); }
    }
    { float* scr = (float*)(lds + 32768 + wid * 8704);
      const int gw = blockIdx.x * 8 + wid, NGW = gridDim.x * 8;
      constexpr int I_IN = 16 * 56, I_UQ = 6 * 24, I_KN = 4 * 16, I_V = 4 * 16, I_OUT = 16 * 32, I_UP = 16 * 176, I_DN = 44 * 32, I_L = I_IN + I_UQ + I_KN + I_V + I_OUT + I_UP + I_DN;
      for (int it = gw; it < 2 * I_L; it += NGW) { const int l = it / I_L; int r = it - l * I_L; bf16_t* wl = (bf16_t*)(ws + OFF_W) + (size_t)l * W_LAYER;
          const float* src; int K, Nsrc, nbn, mp; size_t doff;
          if (r < I_IN) { src = p.w_in + (size_t)l * 1024 * INW; K = 1024; Nsrc = INW; nbn = 56; mp = 1; doff = W_IN; }
          else if ((r -= I_IN) < I_UQ) { src = p.w_uq + (size_t)l * 384 * 768; K = 384; Nsrc = 768; nbn = 24; mp = 0; doff = W_UQ; }
          else if ((r -= I_UQ) < I_KN) { src = p.w_ukv + (size_t)l * 256 * 1024; K = 256; Nsrc = 1024; nbn = 16; mp = 2; doff = W_KN; }
          else if ((r -= I_KN) < I_V) { src = p.w_ukv + (size_t)l * 256 * 1024; K = 256; Nsrc = 1024; nbn = 16; mp = 3; doff = W_V; }
          else if ((r -= I_V) < I_OUT) { src = p.w_out + (size_t)l * 1024 * 1024; K = 1024; Nsrc = 1024; nbn = 32; mp = 0; doff = W_OUT; }
          else if ((r -= I_OUT) < I_UP) { src = p.w_up + (size_t)l * 1024 * 5632; K = 1024; Nsrc = 5632; nbn = 176; mp = 4; doff = W_UP; }
          else { r -= I_UP; src = p.w_down + (size_t)l * DFF * 1024; K = DFF; Nsrc = 1024; nbn = 32; mp = 0; doff = W_DN; }
          const int kb = r / nbn, nb = r - kb * nbn, n0 = nb * 32;
          const int cs = mp == 0 ? n0 : mp == 1 ? map_in(n0) : mp == 2 ? map_kn(n0) : mp == 3 ? map_v(n0) : map_up(n0);
          if (cs != -2) transpose_item(src, K, Nsrc, wl + doff, n0, cs, kb * 64, scr, lane); }
    }
    { for (int idx = blockIdx.x * NWG_T + tid; idx < 2 * 1024 * 256; idx += gridDim.x * NWG_T) { const int n = idx & 255, k = (idx >> 8) & 1023, l = idx >> 18; const int g = n >> 6, d = n & 63;
          const float* wr = p.w_in + ((size_t)l * 1024 + k) * INW + 1440 + g * 64; const float* pw = p.pool_w + ((size_t)(l * 4 + g) * 64) * 64 + d; float s = 0.f;
#pragma unroll 8
          for (int c = 0; c < 64; ++c) s += wr[c] * pw[c * 64];
          ((bf16_t*)(ws + OFF_W) + (size_t)l * W_LAYER + W_IN)[(size_t)(1440 + n) * 1024 + k] = (bf16_t)f2bf(s * p.pool_scale[l * 256 + n]); } }
}

DEV void phase_norm(const Params& p, int l, int which, bool first) {
    const int tid = otid(); const int lane = tid & 63, wid = tid >> 6; const int gw = blockIdx.x * 8 + wid, NGW = gridDim.x * 8;
    float* X = (float*)(p.ws + OFF_X); bf16_t* HN = (bf16_t*)(p.ws + OFF_HN);
    const float* modv = (const float*)(p.ws + OFF_MOD) + (size_t)l * 3 * 6144;
    const float* g = (which == 0 ? p.norm1_g : p.norm2_g) + l * 1024;
    for (int r = gw; r < R; r += NGW) {
        const int b = r / RB, s = r - b * RB; const int mi = s < NCTX ? 2 : b;
        const float* src = first ? (s < NCTX ? p.ctx + ((size_t)b * NCTX + s) * 1024 : p.x + ((size_t)b * TL + (s - NCTX)) * 1024) : X + (size_t)r * 1024;
        const f32x4* xr = (const f32x4*)src + lane; f32x4 v[4]; float ss = 0.f;
#pragma unroll
        for (int j = 0; j < 4; ++j) { v[j] = xr[64 * j]; ss += (v[j].x * v[j].x + v[j].y * v[j].y) + (v[j].z * v[j].z + v[j].w * v[j].w); }
        if (first) { f32x4* xo = (f32x4*)(X + (size_t)r * 1024) + lane;
#pragma unroll
            for (int j = 0; j < 4; ++j) xo[64 * j] = v[j]; }
        const float rs = rsqrtf(wave_sum(ss) * (1.f / 1024.f) + EPS);
        const float* mv = modv + mi * 6144 + (which == 0 ? 0 : 3072);
        u32x2* o8 = (u32x2*)(HN + (size_t)r * 1024) + lane;
#pragma unroll
        for (int j = 0; j < 4; ++j) { const f32x4 gg = ((const f32x4*)g)[lane + 64 * j], sh = ((const f32x4*)mv)[lane + 64 * j], sc = ((const f32x4*)(mv + 1024))[lane + 64 * j];
            const f32x4 y = v[j] * rs * gg; const f32x4 h = y * (sc + 1.0f) + sh; u32x2 w; w.x = pk2(h.x, h.y); w.y = pk2(h.z, h.w); o8[64 * j] = w; }
    }
}
DEV void phase_final(const Params& p) {
    const int tid = otid(); const int lane = tid & 63, wid = tid >> 6; const int gw = blockIdx.x * 8 + wid, NGW = gridDim.x * 8;
    const float* X = (const float*)(p.ws + OFF_X);
    for (int q = gw; q < 2 * TL; q += NGW) { const int b = q / TL, t = q - b * TL; const int r = b * RB + NCTX + t;
        const f32x4* xr = (const f32x4*)(X + (size_t)r * 1024) + lane; f32x4 v[4]; float ss = 0.f;
#pragma unroll
        for (int j = 0; j < 4; ++j) { v[j] = xr[64 * j]; ss += (v[j].x * v[j].x + v[j].y * v[j].y) + (v[j].z * v[j].z + v[j].w * v[j].w); }
        const float rs = rsqrtf(wave_sum(ss) * (1.f / 1024.f) + EPS);
        f32x4* o = (f32x4*)(p.out + (size_t)q * 1024) + lane;
#pragma unroll
        for (int j = 0; j < 4; ++j) { const f32x4 gg = ((const f32x4*)p.final_norm_g)[lane + 64 * j]; o[64 * j] = v[j] * rs * gg; } }
}

DEV void phase_rowwise(const Params& p, int l) {
    const int tid = otid(); const int lane = tid & 63, wid = tid >> 6; const int gw = blockIdx.x * 8 + wid, NGW = gridDim.x * 8;
    bf16_t* P = (bf16_t*)p.out; const f32x2* rope = (const f32x2*)(p.ws + OFF_ROPE);
    const float* qg = p.mla_q_norm_g + l * 384; const float* kg = p.mla_kv_norm_g + l * 256;
    for (int r = gw; r < R; r += NGW) {
        bf16_t* pr = P + (size_t)r * INW; const int b = r / RB, s = r - b * RB;
        { unsigned* q2 = (unsigned*)(pr + 768) + lane; unsigned w[3]; float ss = 0.f;
#pragma unroll
          for (int j = 0; j < 3; ++j) { w[j] = q2[64 * j]; const float a = bf2f(w[j] & 0xffff), c2 = bf2f(w[j] >> 16); ss += a * a + c2 * c2; }
          const float rs = rsqrtf(wave_sum(ss) * (1.f / 384.f) + EPS);
#pragma unroll
          for (int j = 0; j < 3; ++j) { const int c0 = 2 * (lane + 64 * j); q2[64 * j] = pk2(bf2f(w[j] & 0xffff) * rs * qg[c0], bf2f(w[j] >> 16) * rs * qg[c0 + 1]); } }
        { u32x2* k4 = (u32x2*)(pr + 1152) + lane; const u32x2 w = *k4;
          const float a0 = bf2f(w.x & 0xffff), a1 = bf2f(w.x >> 16), a2 = bf2f(w.y & 0xffff), a3 = bf2f(w.y >> 16);
          const float rs = rsqrtf(wave_sum((a0 * a0 + a1 * a1) + (a2 * a2 + a3 * a3)) * (1.f / 256.f) + EPS);
          const f32x4 gg = ((const f32x4*)kg)[lane]; u32x2 o; o.x = pk2(a0 * rs * gg.x, a1 * rs * gg.y); o.y = pk2(a2 * rs * gg.z, a3 * rs * gg.w); *k4 = o; }
        if (s >= NCTX && lane < 16) { const f32x2 cs = rope[(s - NCTX) * 16 + lane];
          const float x1 = bf2f(pr[1408 + lane]), x2 = bf2f(pr[1408 + 16 + lane]);
          pr[1408 + lane] = (bf16_t)f2bf(x1 * cs.x - x2 * cs.y); pr[1408 + 16 + lane] = (bf16_t)f2bf(x2 * cs.x + x1 * cs.y); }
    }
}

DEV void phase_pool(const Params& p) {
    const int tid = otid(); const bf16_t* P = (const bf16_t*)p.out; bf16_t* MIX = (bf16_t*)(p.ws + OFF_HN);
    for (int idx = blockIdx.x * NWG_T + tid; idx < R * 32; idx += gridDim.x * NWG_T) { const int r = idx >> 5, cg = idx & 31; const int half = 1 << (cg >> 3);
        const int b = r / RB, s = r - b * RB; const int seq0 = s < NCTX ? b * RB : b * RB + NCTX; const int T = s < NCTX ? NCTX : TL; const int t = r - seq0;
        const int lo = max(t - half, 0), hi = min(t + half, T); float sum[8];
#pragma unroll
        for (int j = 0; j < 8; ++j) sum[j] = 0.f;
        const bf16_t* base = P + (size_t)seq0 * INW + 1440 + cg * 8;
        for (int tt = lo; tt < hi; ++tt) { const bf16x8 v = *(const bf16x8*)(base + (size_t)tt * INW);
#pragma unroll
            for (int j = 0; j < 8; ++j) sum[j] += bf2f((unsigned short)v[j]); }
        const bf16x8 me = *(const bf16x8*)(base + (size_t)t * INW); const float ic = 1.0f / (float)(hi - lo); float o[8];
#pragma unroll
        for (int j = 0; j < 8; ++j) o[j] = sum[j] * ic - bf2f((unsigned short)me[j]);
        *(bf16x8*)(MIX + (size_t)r * 1024 + 768 + cg * 8) = pack8(o[0], o[1], o[2], o[3], o[4], o[5], o[6], o[7]); }
}

DEV float log2_sigmoid(float d) { return -log1pf(__expf(-d)) * 1.4426950408889634f; }
DEV void states_item(const Params& p, int l, unsigned char* lds, int it) {
    const int tid = otid(); const bf16_t* P = (const bf16_t*)p.out; const f32x2* rope = (const f32x2*)(p.ws + OFF_ROPE);
    float* SLOC = (float*)(p.ws + OFF_OV + OV_SLOC);
    const int gc = it >> 2, h = it & 3;
    bf16_t* kk = (bf16_t*)lds;
    bf16_t* vv = kk + 128 * 32;
    float* dec = (float*)(vv + 128 * 64);
    const int cb = gc % 66; const bool lat = cb >= 2; const int t0 = (cb - 2) * 128; const int r0 = gc * 128;
    if (tid < 256) { const int dir = tid >> 7, idx = tid & 127;
        const float lg = log2_sigmoid((dir == 0 ? p.ret_decay_f : p.ret_decay_b)[l * 4 + h]); dec[tid] = exp2f(lg * (dir == 0 ? (float)(127 - idx) : (float)idx)); }
    else { const int task = tid - 256; const int tok = task >> 1, c = task & 1;
        const bf16_t* src = P + (size_t)(r0 + tok) * INW + 128 + h * 32 + 8 * c; const bf16x8 lo = *(const bf16x8*)src, hi = *(const bf16x8*)(src + 16);
        float o1[8], o2[8];
#pragma unroll
        for (int j = 0; j < 8; ++j) { float x1 = bf2f((unsigned short)lo[j]), x2 = bf2f((unsigned short)hi[j]);
            if (lat) { const f32x2 cs = rope[(t0 + tok) * 16 + 8 * c + j]; const float y1 = x1 * cs.x - x2 * cs.y, y2 = x2 * cs.x + x1 * cs.y; x1 = y1; x2 = y2; }
            o1[j] = x1 * 0.17677669529663687f; o2[j] = x2 * 0.17677669529663687f; }
        bf16_t* dst = kk + tok * 32 + 8 * c;
        *(bf16x8*)dst = pack8(o1[0], o1[1], o1[2], o1[3], o1[4], o1[5], o1[6], o1[7]); *(bf16x8*)(dst + 16) = pack8(o2[0], o2[1], o2[2], o2[3], o2[4], o2[5], o2[6], o2[7]); }
    for (int task = tid; task < 1024; task += NWG_T) { const int tok = task >> 3, ch = task & 7; *(u32x4*)(vv + tok * 64 + ch * 8) = *(const u32x4*)(P + (size_t)(r0 + tok) * INW + 256 + h * 64 + ch * 8); }
    __syncthreads();
    { const int d = tid >> 4, dvg = tid & 15; float af[4], ab[4];
#pragma unroll
      for (int j = 0; j < 4; ++j) { af[j] = 0.f; ab[j] = 0.f; }
#pragma unroll 4
      for (int i = 0; i < 128; ++i) { const float kv = bf2f(kk[i * 32 + d]); const float kf = kv * dec[i], kb = kv * dec[128 + i];
          const u32x2 v = *(const u32x2*)(vv + i * 64 + dvg * 4);
          const float v0 = bf2f(v.x & 0xffff), v1 = bf2f(v.x >> 16), v2 = bf2f(v.y & 0xffff), v3 = bf2f(v.y >> 16);
          af[0] += kf * v0; af[1] += kf * v1; af[2] += kf * v2; af[3] += kf * v3; ab[0] += kb * v0; ab[1] += kb * v1; ab[2] += kb * v2; ab[3] += kb * v3; }
      float* of = SLOC + ((size_t)(gc * 4 + h) * 2 + 0) * 2048 + d * 64 + dvg * 4;
      *(f32x4*)of = (f32x4){af[0], af[1], af[2], af[3]}; *(f32x4*)(of + 2048) = (f32x4){ab[0], ab[1], ab[2], ab[3]}; }
    __syncthreads();
}
DEV void scan_threads(const Params& p, int l, int gid) {
    if (gid >= 32768) return;
    const int e = gid & 2047, dir = (gid >> 11) & 1, h = (gid >> 12) & 3, b = gid >> 14;
    const float* SLOC = (const float*)(p.ws + OFF_OV + OV_SLOC); float* SIN = (float*)(p.ws + OFF_OV + OV_SIN);
    const float gC = exp2f(log2_sigmoid((dir == 0 ? p.ret_decay_f : p.ret_decay_b)[l * 4 + h]) * 128.f);
    float S = 0.f;
#pragma unroll 6
    for (int st = 0; st < 66; ++st) { const int cb = dir == 0 ? st : (st < 2 ? 1 - st : 67 - st); const size_t idx = ((size_t)((b * 66 + cb) * 4 + h) * 2 + dir) * 2048 + e;
        const float v = SLOC[idx]; SIN[idx] = S; S = S * gC + v; }
}

constexpr int AT_KP = 208, AT_VP = 136, AT_KB = 64 * AT_KP, AT_BUF = AT_KB + 64 * AT_VP;
DEV void attn_unit(const Params& p, unsigned char* lds, int u) {
    const int tid = otid(), lane = tid & 63, wid = tid >> 6, l32 = lane & 31, hi = lane >> 5;
    const bf16_t* Q = (const bf16_t*)(p.ws + OFF_OV + OV_Q); const bf16_t* KN = (const bf16_t*)(p.ws + OFF_OV + OV_KN); const bf16_t* VT = (const bf16_t*)(p.ws + OFF_OV + OV_VT);
    const bf16_t* P = (const bf16_t*)p.out; bf16_t* MIX = (bf16_t*)(p.ws + OFF_HN); const f32x2* rope = (const f32x2*)(p.ws + OFF_ROPE);
    const bool isctx = u >= 512; int b, h, qrow0, NT;
    if (!isctx) { b = u >> 8; h = (u >> 5) & 7; qrow0 = b * RB + NCTX + (u & 31) * 256; NT = 132; } else { const int v = u - 512; b = v >> 3; h = v & 7; qrow0 = b * RB; NT = 4; }
    const int krow0 = b * RB; const int qrow = qrow0 + wid * 32 + l32;
    bf16x8 qf[6];
    { const bf16_t* qp = Q + (size_t)qrow * 768 + h * 96 + hi * 8;
#pragma unroll
      for (int d0 = 0; d0 < 6; ++d0) qf[d0] = *(const bf16x8*)(qp + d0 * 16);
      if (!isctx) { const f32x2* rp = rope + (size_t)(qrow - (b * RB + NCTX)) * 16 + hi * 8;
#pragma unroll
          for (int j = 0; j < 8; ++j) { const f32x2 cs = rp[j]; const float x1 = bf2f((unsigned short)qf[4][j]), x2 = bf2f((unsigned short)qf[5][j]);
              qf[4][j] = (short)f2bf(x1 * cs.x - x2 * cs.y); qf[5][j] = (short)f2bf(x2 * cs.x + x1 * cs.y); } } }
    const bf16_t* sp[3]; int sstep[3], lo[3];
#pragma unroll
    for (int k = 0; k < 3; ++k) { const int c = tid + k * 512;
        if (c < 768) { const int key = c / 12, part = c - key * 12; lo[k] = key * AT_KP + part * 16;
            if (part < 8) { sp[k] = KN + (size_t)(krow0 + key) * 512 + h * 64 + part * 8; sstep[k] = 64 * 512; } else { sp[k] = P + (size_t)(krow0 + key) * INW + 1408 + (part - 8) * 8; sstep[k] = 64 * INW; } }
        else { const int cc = c - 768, dv = cc >> 3, kc = cc & 7; lo[k] = AT_KB + dv * AT_VP + kc * 16; sp[k] = VT + (size_t)(h * 64 + dv) * R + krow0 + kc * 8; sstep[k] = 64; } }
    const bool has3 = tid < 256;
    u32x4 st[3];
#define AT_GLOAD() do { st[0] = *(const u32x4*)sp[0]; sp[0] += sstep[0]; st[1] = *(const u32x4*)sp[1]; sp[1] += sstep[1]; if (has3) { st[2] = *(const u32x4*)sp[2]; sp[2] += sstep[2]; } } while (0)
#define AT_LSTORE1(buf, k) do { unsigned char* d_ = (buf) + lo[k]; if (lo[k] < AT_KB) { *(u32x4*)d_ = st[k]; } else { *(u32x2*)d_ = (u32x2){st[k].x, st[k].y}; *(u32x2*)(d_ + 8) = (u32x2){st[k].z, st[k].w}; } } while (0)
#define AT_LSTORE(buf) do { AT_LSTORE1(buf, 0); AT_LSTORE1(buf, 1); if (has3) AT_LSTORE1(buf, 2); } while (0)
    f32x16 o0, o1;
#pragma unroll
    for (int r = 0; r < 16; ++r) { o0[r] = 0.f; o1[r] = 0.f; }
    float mrun = 0.f, lsum = 0.f;
    __syncthreads();
    AT_GLOAD(); AT_LSTORE(lds);
    __syncthreads();
    for (int t = 0; t < NT; ++t) {
        unsigned char* kbuf = lds + (t & 1) * AT_BUF; unsigned char* vbuf = kbuf + AT_KB; unsigned char* nbuf = lds + ((t + 1) & 1) * AT_BUF;
        const bool more = t + 1 < NT;
        if (more) AT_GLOAD();
        f32x16 s0, s1;
        { const float nm = -mrun;
#pragma unroll
          for (int r = 0; r < 16; ++r) { s0[r] = nm; s1[r] = nm; } }
        { const unsigned char* ka = kbuf + l32 * AT_KP + hi * 16;
#pragma unroll
          for (int d0 = 0; d0 < 6; ++d0) { const bf16x8 a0 = *(const bf16x8*)(ka + d0 * 32), a1 = *(const bf16x8*)(ka + 32 * AT_KP + d0 * 32);
              s0 = __builtin_amdgcn_mfma_f32_32x32x16_bf16(a0, qf[d0], s0, 0, 0, 0); s1 = __builtin_amdgcn_mfma_f32_32x32x16_bf16(a1, qf[d0], s1, 0, 0, 0); } }
        float mx;
        { float m0 = __builtin_fmaxf(__builtin_fmaxf(s0[0], s0[1]), s0[2]), m1 = __builtin_fmaxf(__builtin_fmaxf(s1[0], s1[1]), s1[2]);
          m0 = __builtin_fmaxf(__builtin_fmaxf(m0, s0[3]), s0[4]); m1 = __builtin_fmaxf(__builtin_fmaxf(m1, s1[3]), s1[4]);
          m0 = __builtin_fmaxf(__builtin_fmaxf(m0, s0[5]), s0[6]); m1 = __builtin_fmaxf(__builtin_fmaxf(m1, s1[5]), s1[6]);
          m0 = __builtin_fmaxf(__builtin_fmaxf(m0, s0[7]), s0[8]); m1 = __builtin_fmaxf(__builtin_fmaxf(m1, s1[7]), s1[8]);
          m0 = __builtin_fmaxf(__builtin_fmaxf(m0, s0[9]), s0[10]); m1 = __builtin_fmaxf(__builtin_fmaxf(m1, s1[9]), s1[10]);
          m0 = __builtin_fmaxf(__builtin_fmaxf(m0, s0[11]), s0[12]); m1 = __builtin_fmaxf(__builtin_fmaxf(m1, s1[11]), s1[12]);
          m0 = __builtin_fmaxf(__builtin_fmaxf(m0, s0[13]), s0[14]); m1 = __builtin_fmaxf(__builtin_fmaxf(m1, s1[13]), s1[14]);
          mx = __builtin_fmaxf(__builtin_fmaxf(m0, s0[15]), __builtin_fmaxf(m1, s1[15])); }
        if (t == 0 || __any(mx > 8.0f)) {
            const float rm = fmaxf(mx, __shfl_xor(mx, 32));
            const float delta = (t == 0) ? rm : fmaxf(rm, 0.f);
            const float alpha = (t == 0) ? 1.0f : __builtin_amdgcn_exp2f(-delta);
            mrun += delta;
#pragma unroll
            for (int r = 0; r < 16; ++r) { s0[r] -= delta; s1[r] -= delta; o0[r] *= alpha; o1[r] *= alpha; }
            lsum *= alpha;
        }
        { float ls0 = 0.f, ls1 = 0.f;
#pragma unroll
          for (int r = 0; r < 16; ++r) { s0[r] = __builtin_amdgcn_exp2f(s0[r]); s1[r] = __builtin_amdgcn_exp2f(s1[r]); ls0 += s0[r]; ls1 += s1[r]; }
          lsum += ls0 + ls1; }
        { const unsigned char* va = vbuf + l32 * AT_VP + hi * 8;
#pragma unroll
          for (int kb = 0; kb < 2; ++kb)
#pragma unroll
              for (int jp = 0; jp < 2; ++jp) { const f32x16& s = kb == 0 ? s0 : s1;
                  const bf16x8 pb = pack8(s[8 * jp + 0], s[8 * jp + 1], s[8 * jp + 2], s[8 * jp + 3], s[8 * jp + 4], s[8 * jp + 5], s[8 * jp + 6], s[8 * jp + 7]);
                  const unsigned char* vp = va + (32 * kb + 16 * jp) * 2;
                  const u32x2 a00 = *(const u32x2*)vp, a01 = *(const u32x2*)(vp + 16), a10 = *(const u32x2*)(vp + 32 * AT_VP), a11 = *(const u32x2*)(vp + 32 * AT_VP + 16);
                  const bf16x8 A0 = __builtin_bit_cast(bf16x8, (u32x4){a00.x, a00.y, a01.x, a01.y}), A1 = __builtin_bit_cast(bf16x8, (u32x4){a10.x, a10.y, a11.x, a11.y});
                  o0 = __builtin_amdgcn_mfma_f32_32x32x16_bf16(A0, pb, o0, 0, 0, 0); o1 = __builtin_amdgcn_mfma_f32_32x32x16_bf16(A1, pb, o1, 0, 0, 0); } }
        if (more) AT_LSTORE(nbuf);
        __syncthreads();
    }
    lsum += __shfl_xor(lsum, 32);
    const float inv = 1.0f / lsum;
    bf16_t* op = MIX + (size_t)qrow * 1024 + 256 + h * 64 + 4 * hi;
#pragma unroll
    for (int g4 = 0; g4 < 4; ++g4) { u32x2 w0, w1; w0.x = pk2(o0[4 * g4] * inv, o0[4 * g4 + 1] * inv); w0.y = pk2(o0[4 * g4 + 2] * inv, o0[4 * g4 + 3] * inv);
        w1.x = pk2(o1[4 * g4] * inv, o1[4 * g4 + 1] * inv); w1.y = pk2(o1[4 * g4 + 2] * inv, o1[4 * g4 + 3] * inv);
        *(u32x2*)(op + 8 * g4) = w0; *(u32x2*)(op + 32 + 8 * g4) = w1; }
#undef AT_GLOAD
#undef AT_LSTORE1
#undef AT_LSTORE
}

constexpr int RT_VP = 264, RT_SP = 144, RT_VB = 2 * 64 * RT_VP;
DEV void retout_unit(const Params& p, int l, unsigned char* lds, int u) {
    const int tid = otid(), lane = tid & 63, wid = tid >> 6, l32 = lane & 31, hi = lane >> 5;
    const int gc = u >> 1, hp = u & 1; const int cb = gc % 66; const bool lat = cb >= 2; const int t0 = (cb - 2) * 128; const int r0 = gc * 128;
    const bf16_t* P = (const bf16_t*)p.out; bf16_t* MIX = (bf16_t*)(p.ws + OFF_HN); const f32x2* rope = (const f32x2*)(p.ws + OFF_ROPE);
    const float* SIN = (const float*)(p.ws + OFF_OV + OV_SIN);
    bf16_t* VTl = (bf16_t*)lds; bf16_t* STl = (bf16_t*)(lds + RT_VB);
    __syncthreads();
    for (int task = tid; task < 2048; task += NWG_T) { const int hh = task >> 10, key = (task >> 3) & 127, ch = task & 7;
        const bf16x8 v = *(const bf16x8*)(P + (size_t)(r0 + key) * INW + 256 + (2 * hp + hh) * 64 + ch * 8);
#pragma unroll
        for (int j = 0; j < 8; ++j) VTl[(hh * 64 + ch * 8 + j) * (RT_VP / 2) + key] = (bf16_t)v[j]; }
    for (int task = tid; task < 8192; task += NWG_T) { const int dv = task & 63, k = (task >> 6) & 31, dir = (task >> 11) & 1, hh = task >> 12;
        STl[(hh * 64 + dv) * (RT_SP / 2) + dir * 32 + k] = (bf16_t)f2bf(SIN[((size_t)(gc * 4 + 2 * hp + hh) * 2 + dir) * 2048 + k * 64 + dv]); }
    __syncthreads();
    const int hh = wid >> 2, h = 2 * hp + hh, qblk = wid & 3; const int n = 32 * qblk + l32; const int rq = r0 + n;
    const float lf = log2_sigmoid(p.ret_decay_f[l * 4 + h]), lb = log2_sigmoid(p.ret_decay_b[l * 4 + h]);
    float qv0[8], qv1[8]; bf16x8 qf0, qf1;
    { const bf16_t* qp = P + (size_t)rq * INW + h * 32 + 8 * hi; const bf16x8 a = *(const bf16x8*)qp, c2 = *(const bf16x8*)(qp + 16);
#pragma unroll
      for (int j = 0; j < 8; ++j) { float x1 = bf2f((unsigned short)a[j]), x2 = bf2f((unsigned short)c2[j]);
          if (lat) { const f32x2 cs = rope[(size_t)(t0 + n) * 16 + 8 * hi + j]; const float y1 = x1 * cs.x - x2 * cs.y, y2 = x2 * cs.x + x1 * cs.y; x1 = y1; x2 = y2; }
          qv0[j] = x1; qv1[j] = x2; }
      qf0 = pack8(qv0[0], qv0[1], qv0[2], qv0[3], qv0[4], qv0[5], qv0[6], qv0[7]); qf1 = pack8(qv1[0], qv1[1], qv1[2], qv1[3], qv1[4], qv1[5], qv1[6], qv1[7]); }
    f32x16 o0, o1;
#pragma unroll
    for (int r = 0; r < 16; ++r) { o0[r] = 0.f; o1[r] = 0.f; }
    const unsigned char* vbase = (const unsigned char*)VTl + (size_t)(hh * 64 + l32) * RT_VP + hi * 8;
#pragma unroll
    for (int kb = 0; kb < 4; ++kb) {
        bf16x8 kf0, kf1;
        { const int key = 32 * kb + l32; const bf16_t* kp = P + (size_t)(r0 + key) * INW + 128 + h * 32 + 8 * hi; const bf16x8 a = *(const bf16x8*)kp, c2 = *(const bf16x8*)(kp + 16);
          float y1[8], y2[8];
#pragma unroll
          for (int j = 0; j < 8; ++j) { float x1 = bf2f((unsigned short)a[j]), x2 = bf2f((unsigned short)c2[j]);
              if (lat) { const f32x2 cs = rope[(size_t)(t0 + key) * 16 + 8 * hi + j]; const float z1 = x1 * cs.x - x2 * cs.y, z2 = x2 * cs.x + x1 * cs.y; x1 = z1; x2 = z2; }
              y1[j] = x1 * 0.17677669529663687f; y2[j] = x2 * 0.17677669529663687f; }
          kf0 = pack8(y1[0], y1[1], y1[2], y1[3], y1[4], y1[5], y1[6], y1[7]); kf1 = pack8(y2[0], y2[1], y2[2], y2[3], y2[4], y2[5], y2[6], y2[7]); }
        f32x16 s;
#pragma unroll
        for (int r = 0; r < 16; ++r) s[r] = 0.f;
        s = __builtin_amdgcn_mfma_f32_32x32x16_bf16(kf0, qf0, s, 0, 0, 0); s = __builtin_amdgcn_mfma_f32_32x32x16_bf16(kf1, qf1, s, 0, 0, 0);
#pragma unroll
        for (int r = 0; r < 16; ++r) { const int m = 32 * kb + crow(r, hi); const int dl = n - m; const float e = dl >= 0 ? lf * (float)dl : lb * (float)(-dl); s[r] *= __builtin_amdgcn_exp2f(e); }
#pragma unroll
        for (int jp = 0; jp < 2; ++jp) { const bf16x8 pb = pack8(s[8 * jp + 0], s[8 * jp + 1], s[8 * jp + 2], s[8 * jp + 3], s[8 * jp + 4], s[8 * jp + 5], s[8 * jp + 6], s[8 * jp + 7]);
            const unsigned char* vp = vbase + (32 * kb + 16 * jp) * 2;
            const u32x2 a00 = *(const u32x2*)vp, a01 = *(const u32x2*)(vp + 16), a10 = *(const u32x2*)(vp + 32 * RT_VP), a11 = *(const u32x2*)(vp + 32 * RT_VP + 16);
            const bf16x8 A0 = __builtin_bit_cast(bf16x8, (u32x4){a00.x, a00.y, a01.x, a01.y}), A1 = __builtin_bit_cast(bf16x8, (u32x4){a10.x, a10.y, a11.x, a11.y});
            o0 = __builtin_amdgcn_mfma_f32_32x32x16_bf16(A0, pb, o0, 0, 0, 0); o1 = __builtin_amdgcn_mfma_f32_32x32x16_bf16(A1, pb, o1, 0, 0, 0); }
    }
    { const float df = __builtin_amdgcn_exp2f(lf * (float)(n + 1)), db = __builtin_amdgcn_exp2f(lb * (float)(128 - n));
      const unsigned char* sbase = (const unsigned char*)STl + (size_t)(hh * 64 + l32) * RT_SP + hi * 16;
#pragma unroll
      for (int ks = 0; ks < 4; ++ks) { const float dd = ks < 2 ? df : db;
          const bf16x8 qb = (ks & 1) ? pack8(qv1[0] * dd, qv1[1] * dd, qv1[2] * dd, qv1[3] * dd, qv1[4] * dd, qv1[5] * dd, qv1[6] * dd, qv1[7] * dd)
                                     : pack8(qv0[0] * dd, qv0[1] * dd, qv0[2] * dd, qv0[3] * dd, qv0[4] * dd, qv0[5] * dd, qv0[6] * dd, qv0[7] * dd);
          const bf16x8 A0 = *(const bf16x8*)(sbase + ks * 32), A1 = *(const bf16x8*)(sbase + 32 * RT_SP + ks * 32);
          o0 = __builtin_amdgcn_mfma_f32_32x32x16_bf16(A0, qb, o0, 0, 0, 0); o1 = __builtin_amdgcn_mfma_f32_32x32x16_bf16(A1, qb, o1, 0, 0, 0); } }
    float ssq = 0.f;
#pragma unroll
    for (int r = 0; r < 16; ++r) ssq += o0[r] * o0[r] + o1[r] * o1[r];
    ssq += __shfl_xor(ssq, 32);
    const float rstd = rsqrtf(ssq * (1.f / 64.f) + EPS);
    const bf16_t* gp = P + (size_t)rq * INW + 512 + h * 64 + 4 * hi; bf16_t* op = MIX + (size_t)rq * 1024 + h * 64 + 4 * hi;
#pragma unroll
    for (int g4 = 0; g4 < 4; ++g4) { const u32x2 ga = *(const u32x2*)(gp + 8 * g4), gb = *(const u32x2*)(gp + 32 + 8 * g4);
        u32x2 w0, w1;
        w0.x = pk2(o0[4 * g4] * rstd * siluf(bf2f(ga.x & 0xffff)), o0[4 * g4 + 1] * rstd * siluf(bf2f(ga.x >> 16))); w0.y = pk2(o0[4 * g4 + 2] * rstd * siluf(bf2f(ga.y & 0xffff)), o0[4 * g4 + 3] * rstd * siluf(bf2f(ga.y >> 16)));
        w1.x = pk2(o1[4 * g4] * rstd * siluf(bf2f(gb.x & 0xffff)), o1[4 * g4 + 1] * rstd * siluf(bf2f(gb.x >> 16))); w1.y = pk2(o1[4 * g4 + 2] * rstd * siluf(bf2f(gb.y & 0xffff)), o1[4 * g4 + 3] * rstd * siluf(bf2f(gb.y >> 16)));
        *(u32x2*)(op + 8 * g4) = w0; *(u32x2*)(op + 32 + 8 * g4) = w1; }
}

DEV void phase_convact(const Params& p, int l, int hf) {
    const bf16_t* U = (const bf16_t*)(p.ws + OFF_OV + OV_U); bf16_t* ACT = (bf16_t*)p.out;
    const float* cw = p.conv_w + (size_t)l * 3 * 5632; const float* cbv = p.conv_b + (size_t)l * 5632;
    const bf16x8 z = {0, 0, 0, 0, 0, 0, 0, 0};
    for (int idx = blockIdx.x * NWG_T + otid(); idx < 176 * 528; idx += gridDim.x * NWG_T) {
        const int rc = idx / 176, j8 = idx - rc * 176; const int r0 = rc * 32; const int b = r0 / RB, s0 = r0 - b * RB;
        if (l == 1 && s0 < NCTX) continue;
        const int ca = hf * HFF + j8 * 8, cbc = DFF + hf * HFF + j8 * 8;
        f32x4 wa[3][2], wb[3][2], ba[2], bb[2];
#pragma unroll
        for (int k = 0; k < 3; ++k)
#pragma unroll
            for (int q = 0; q < 2; ++q) { wa[k][q] = *(const f32x4*)(cw + k * 5632 + ca + 4 * q); wb[k][q] = *(const f32x4*)(cw + k * 5632 + cbc + 4 * q); }
#pragma unroll
        for (int q = 0; q < 2; ++q) { ba[q] = *(const f32x4*)(cbv + ca + 4 * q); bb[q] = *(const f32x4*)(cbv + cbc + 4 * q); }
        const bool first = (s0 == 0) || (s0 == NCTX); const bool lastc = (s0 + 32 == NCTX) || (s0 + 32 == RB);
        const bf16_t* ur = U + (size_t)r0 * DFF + j8 * 8;
        bf16x8 pa = first ? z : *(const bf16x8*)(ur - DFF), pb = first ? z : *(const bf16x8*)(ur - DFF + HFF);
        bf16x8 ca8 = *(const bf16x8*)ur, cb8 = *(const bf16x8*)(ur + HFF);
        bf16x8 na = *(const bf16x8*)(ur + DFF), nb = *(const bf16x8*)(ur + DFF + HFF);
        for (int i = 0; i < 32; ++i) {
            bf16x8 fa = z, fb = z;
            if (i + 2 < 32 || !lastc) { fa = *(const bf16x8*)(ur + (size_t)(i + 2) * DFF); fb = *(const bf16x8*)(ur + (size_t)(i + 2) * DFF + HFF); }
            if (i + 1 == 32 && lastc) { na = z; nb = z; }
            float o[8];
#pragma unroll
            for (int j = 0; j < 8; ++j) { const int q = j >> 2, e = j & 3;
                const float ua = bf2f((unsigned short)pa[j]) * wa[0][q][e] + bf2f((unsigned short)ca8[j]) * wa[1][q][e] + bf2f((unsigned short)na[j]) * wa[2][q][e] + ba[q][e];
                const float ub = bf2f((unsigned short)pb[j]) * wb[0][q][e] + bf2f((unsigned short)cb8[j]) * wb[1][q][e] + bf2f((unsigned short)nb[j]) * wb[2][q][e] + bb[q][e];
                o[j] = siluf(ua) * ub; }
            *(bf16x8*)(ACT + (size_t)(r0 + i) * HFF + j8 * 8) = pack8(o[0], o[1], o[2], o[3], o[4], o[5], o[6], o[7]);
            pa = ca8; pb = cb8; ca8 = na; cb8 = nb; na = fa; nb = fb; }
    }
}

#define RLX_AGENT __ATOMIC_RELAXED, __HIP_MEMORY_SCOPE_AGENT
#define XB_TMO      128
#define XB_XCNT(j)  (256  + 64 * (j))
#define XB_XSUB(j)  (1280 + 64 * (j))
#define XB_XGEN(j)  (2304 + 64 * (j))
#define XB_TOP      3328
#define XB_TOPGEN   3392
#define XCD_BAR_WORDS 3456
#define XB_SPIN_CAP (1u << 18)

__device__ __forceinline__ unsigned xb_ld(unsigned* p)              { return __hip_atomic_load(p, __ATOMIC_RELAXED, __HIP_MEMORY_SCOPE_AGENT); }
__device__ __forceinline__ unsigned xb_add(unsigned* p, unsigned v) { return __hip_atomic_fetch_add(p, v, __ATOMIC_RELAXED, __HIP_MEMORY_SCOPE_AGENT); }
__device__ __forceinline__ unsigned xb_xcc_id() { return (unsigned)__builtin_amdgcn_s_getreg((3 << 11) | 20) & 0xFu; }
#define XB_SPIN(cond, bar) do { unsigned _sp = 0; while (cond) { __builtin_amdgcn_s_sleep(1); \
    if ((++_sp & 255u) == 0u) { if (xb_ld(&(bar)[XB_TMO])) break; if (_sp > XB_SPIN_CAP) { atomicAdd(&(bar)[XB_TMO], 1u); break; } } } } while (0)

struct XcdBarrier {
    unsigned* bar; unsigned x;
    volatile LAS unsigned* st;
};

__device__ __forceinline__ XcdBarrier xcd_barrier_post(unsigned* bar, volatile LAS unsigned* st) {
    XcdBarrier b; b.bar = bar; b.x = xb_xcc_id(); b.st = st;
    if (threadIdx.x == 0) (void)xb_add(&bar[XB_XCNT(b.x)], 1u);
    return b;
}
__device__ __forceinline__ void xcd_barrier_complete(unsigned* bar, unsigned x, unsigned& nloc, unsigned& nx) {
    const unsigned G = gridDim.x * gridDim.y * gridDim.z;
    unsigned sum, cnt, mine, sp = 0u;
    for (;;) {
        sum = 0u; cnt = 0u; mine = 0u;
#pragma unroll
        for (unsigned j = 0; j < 16; ++j) { const unsigned c = xb_ld(&bar[XB_XCNT(j)]); sum += c; cnt += (c > 0u) ? 1u : 0u; mine = (j == x) ? c : mine; }
        if (sum == G) break;
        __builtin_amdgcn_s_sleep(1);
        if ((++sp & 255u) == 0u) { if (xb_ld(&bar[XB_TMO])) break; if (sp > XB_SPIN_CAP) { atomicAdd(&bar[XB_TMO], 1u); break; } }
    }
    nloc = mine > 0u ? mine : 1u; nx = cnt > 0u ? cnt : 1u;
}

__device__ __forceinline__ void xcd_barrier(const XcdBarrier& b) {
    asm volatile("s_waitcnt vmcnt(0)" ::: "memory");
    __syncthreads();
    if (threadIdx.x == 0) {
        unsigned* bar = b.bar;
        __builtin_amdgcn_s_waitcnt(0);
        unsigned nloc = b.st[0], nx = b.st[1];
        if (nloc == 0u) { xcd_barrier_complete(bar, b.x, nloc, nx); b.st[0] = nloc; b.st[1] = nx; }
        const unsigned old = xb_add(&bar[XB_XSUB(b.x)], 1u);
        const unsigned gen = old / nloc;
        if (old + 1u == (gen + 1u) * nloc) {
            __builtin_amdgcn_fence(__ATOMIC_RELEASE, "agent");
            asm volatile("s_waitcnt vmcnt(0)" ::: "memory");
            const unsigned og = xb_add(&bar[XB_TOP], 1u);
            const unsigned tg = og / nx;
            if (og + 1u == (tg + 1u) * nx) xb_add(&bar[XB_TOPGEN], 1u);
            else XB_SPIN(xb_ld(&bar[XB_TOPGEN]) == tg, bar);
            __builtin_amdgcn_fence(__ATOMIC_ACQUIRE, "agent");
            xb_add(&bar[XB_XGEN(b.x)], 1u);
            asm volatile("s_waitcnt vmcnt(0)" ::: "memory");
        } else {
            XB_SPIN(xb_ld(&bar[XB_XGEN(b.x)]) == gen, bar);
            __builtin_amdgcn_fence(__ATOMIC_ACQUIRE, "agent");
            asm volatile("s_waitcnt vmcnt(0)" ::: "memory");
        }
    }
    __syncthreads();
}


constexpr size_t OFF_CTL = 250000128; constexpr int CTL_BYTES = 16384;
#if defined(__HIP_DEVICE_COMPILE__)
#define KP() const __attribute__((address_space(4))) Params* kp_ = (const __attribute__((address_space(4))) Params*)__builtin_amdgcn_kernarg_segment_ptr(); asm volatile("" : "+s"(kp_)); const Params p = *kp_; \
    bf16_t* HN = (bf16_t*)(p.ws + OFF_HN); bf16_t* P = (bf16_t*)p.out; float* X = (float*)(p.ws + OFF_X); (void)HN; (void)P; (void)X
#else
#define KP() const Params p = p_arg; bf16_t* HN = (bf16_t*)(p.ws + OFF_HN); bf16_t* P = (bf16_t*)p.out; float* X = (float*)(p.ws + OFF_X); (void)HN; (void)P; (void)X
#endif
#define WL() const bf16_t* wl = (const bf16_t*)(p.ws + OFF_W) + (size_t)l * W_LAYER; const float* modv = (const float*)(p.ws + OFF_MOD) + (size_t)l * 3 * 6144; (void)wl; (void)modv
#ifndef DUPM
#define DUPM 0
#endif
#define REP(bit) for (int rep_ = 0; rep_ < (((DUPM) >> (bit)) & 1) + 1; ++rep_)
constexpr int PH_PER_LAYER = 12, N_PHASES = 2 + 2 * PH_PER_LAYER;
__global__ void __launch_bounds__(512, 2) mk_fwd(Params p_arg) {
    extern __shared__ __attribute__((aligned(16))) unsigned char lds[];
    cg::grid_group grid = cg::this_grid();
    const int G = gridDim.x, bx = blockIdx.x; const int vcu = (G % 8 == 0) ? (bx % 8) * (G / 8) + bx / 8 : bx;
    LAS unsigned char* ldsl = (LAS unsigned char*)lds;
    const int ph_lo = p_arg.ph_lo, ph_hi = p_arg.ph_hi;
    volatile LAS unsigned* misc = (volatile LAS unsigned*)(ldsl + (LDS_BYTES - 64));
    { const int t0_ = otid(); if (t0_ < 16) misc[t0_] = 0u; }
    __syncthreads();
    if (ph_hi - ph_lo > 1) (void)xcd_barrier_post((unsigned*)(p_arg.ws + OFF_CTL), misc);
    for (int ph = ph_lo; ph < ph_hi; ++ph) {
        if (ph == 0) { KP(); REP(9) { phase_prep(p, lds); __syncthreads(); } }
        else if (ph == N_PHASES - 1) { KP(); REP(0) phase_final(p);
#if (DUPM >> 10) & 1
            for (int i = 0; i < 20; ++i) grid.sync();
#endif
        }
        else {
            const int l = (ph - 1) / PH_PER_LAYER, sp = (ph - 1) % PH_PER_LAYER;
            if (sp == 0) { KP(); REP(0) phase_norm(p, l, 0, l == 0); }
            else if (sp == 1) { KP(); WL(); REP(1) { __syncthreads();
                pg8::Gemm g{HN, wl + W_IN, R, 1792, 1024, 1024, 1024}; pg8::StaticOrder S; S.init(R, 1792, G, bx);
                pg8::EpiStore E{P, INW, INW, 1.0f};
                pg8::gemm_phase<pg8::EpiStore, pg8::StaticOrder, true, true>(ldsl, g, S, E); } }
            else if (sp == 2) { KP(); phase_rowwise(p, l); __syncthreads();
                REP(2) phase_pool(p);
                REP(3) for (int it = bx; it < 528; it += G) states_item(p, l, lds, it); }
            else if (sp == 3) { KP(); WL(); REP(4) { __syncthreads();
                { pg8::Gemm g{P + 768, wl + W_UQ, R, 768, 384, INW, 384}; pg8::StaticOrder S; S.init(R, 768, G, bx);
                  pg8::EpiStore E{(bf16_t*)(p.ws + OFF_OV + OV_Q), 768, 768, 0.14724444f};
                  pg8::gemm_phase<pg8::EpiStore, pg8::StaticOrder, true, true>(ldsl, g, S, E); }
                __syncthreads();
                { pg8::Gemm g{P + 1152, wl + W_KN, R, 512, 256, INW, 256}; pg8::StaticOrder S; S.init(R, 512, G, (bx + 58) % G);
                  pg8::EpiStore E{(bf16_t*)(p.ws + OFF_OV + OV_KN), 512, 512, 1.0f};
                  pg8::gemm_phase<pg8::EpiStore, pg8::StaticOrder, true, true>(ldsl, g, S, E); }
                __syncthreads();
                { pg8::Gemm g{wl + W_V, P + 1152, 512, R, 256, 256, INW}; pg8::StaticOrder S; S.init(512, R, G, (bx + 182) % G);
                  pg8::EpiStore E{(bf16_t*)(p.ws + OFF_OV + OV_VT), R, R, 1.0f};
                  pg8::gemm_phase<pg8::EpiStore, pg8::StaticOrder, true, true>(ldsl, g, S, E); }
                if (bx >= G - 64) scan_threads(p, l, (bx - (G - 64)) * NWG_T + otid()); } }
            else if (sp == 4) { KP();
                REP(5) for (int u = vcu; u < 528; u += G) attn_unit(p, lds, u);
                REP(6) for (int u = G - 1 - bx; u < 264; u += G) retout_unit(p, l, lds, u); }
            else if (sp == 5) { KP(); WL(); __syncthreads();
                pg8::Gemm g{HN, wl + W_OUT, R, 1024, 1024, 1024, 1024}; pg8::StaticOrder S; S.init(l == 1 ? 16384 : R, 1024, G, bx, l == 1 ? 1 : 0);
                pg8::EpiResid E{X, modv + 2048, 0};
                pg8::gemm_phase<pg8::EpiResid, pg8::StaticOrder, true, true>(ldsl, g, S, E); }
            else if (sp == 6) { KP(); REP(0) phase_norm(p, l, 1, false); }
            else if (sp == 7 || sp == 9 || sp == 11) { KP(); WL();
                __syncthreads();
                if (sp >= 9) { const int hf = sp == 9 ? 0 : 1;
                    pg8::Gemm g{P, wl + W_DN + hf * HFF, R, 1024, HFF, HFF, DFF}; pg8::StaticOrder S; S.init(l == 1 ? 16384 : R, 1024, G, bx, l == 1 ? 1 : 0);
                    pg8::EpiResid E{X, modv + 5120, 0};
                    pg8::gemm_phase<pg8::EpiResid, pg8::StaticOrder, true, true>(ldsl, g, S, E); __syncthreads(); }
                if (sp <= 9) REP(7) { __syncthreads(); const int hf = sp == 7 ? 0 : 1;
                    pg8::Gemm g{HN, wl + W_UP + (size_t)hf * DFF * 1024, R, DFF, 1024, 1024, 1024}; pg8::StaticOrder S; S.init(l == 1 ? 16384 : R, DFF, G, (bx + (sp == 9 && l == 0 ? 8 : 0)) % G, l == 1 ? 1 : 0);
                    pg8::EpiStore E{(bf16_t*)(p.ws + OFF_OV + OV_U), DFF, DFF, 1.0f};
                    pg8::gemm_phase<pg8::EpiStore, pg8::StaticOrder, true, true>(ldsl, g, S, E); } }
            else if (sp == 8) { KP(); REP(8) phase_convact(p, l, 0); }
            else if (sp == 10) { KP(); REP(8) phase_convact(p, l, 1); }
        }
        if (ph + 1 < ph_hi) {
            if (ph == ph_lo) grid.sync();
            else { KP(); XcdBarrier b; b.bar = (unsigned*)(p.ws + OFF_CTL); b.x = xb_xcc_id(); b.st = misc; xcd_barrier(b); }
        }
    }
}

extern "C" void kernel_launch(void* const* d_in, const int* in_sizes, int n_in, void* d_out, int out_size, void* d_ws, size_t ws_size, hipStream_t stream) {
    static int grid = 0;
    if (grid == 0) {
        if (n_in != 23 || ws_size < WS_NEED) { fprintf(stderr, "kernel_launch: unexpected problem (n_in %d, ws %zu, need %zu)\n", n_in, ws_size, (size_t)WS_NEED); grid = -1; return; }
        int dev = 0, cus = 0, per_cu = 0;
        hipGetDevice(&dev); hipDeviceGetAttribute(&cus, hipDeviceAttributeMultiprocessorCount, dev);
        if (hipFuncSetAttribute((const void*)mk_fwd, hipFuncAttributeMaxDynamicSharedMemorySize, LDS_BYTES) != hipSuccess) { fprintf(stderr, "kernel_launch: hipFuncSetAttribute failed\n"); grid = -1; return; }
        if (hipOccupancyMaxActiveBlocksPerMultiprocessor(&per_cu, (const void*)mk_fwd, 512, LDS_BYTES) != hipSuccess || per_cu < 1) { fprintf(stderr, "kernel_launch: occupancy query says %d\n", per_cu); per_cu = 1; }
        (void)hipGetLastError();
        grid = cus * per_cu; if (grid > 256) grid = 256;
        fprintf(stderr, "kernel_launch: grid %d (cus %d, per_cu %d)\n", grid, cus, per_cu);
    }
    if (grid < 0) return;
    Params p{};
    const float** pp = (const float**)&p;
    for (int i = 0; i < 23; ++i) pp[i] = (const float*)d_in[i];
    p.out = (float*)d_out; p.ws = (unsigned char*)d_ws;
#if MK_MULTI
    for (int ph = 0; ph < N_PHASES; ++ph) { p.ph_lo = ph; p.ph_hi = ph + 1; void* args[] = {&p};
        hipError_t e = hipLaunchCooperativeKernel((void*)mk_fwd, dim3(grid), dim3(512), args, LDS_BYTES, stream);
        if (e != hipSuccess) { fprintf(stderr, "launch %d failed: %s\n", ph, hipGetErrorString(e)); break; } }
#else
    if (hipMemsetAsync((char*)d_ws + OFF_CTL, 0, CTL_BYTES, stream) != hipSuccess) { fprintf(stderr, "kernel_launch: memset of the barrier words failed\n"); return; }
    p.ph_lo = 0; p.ph_hi = N_PHASES; void* args[] = {&p};
    hipError_t e = hipLaunchCooperativeKernel((void*)mk_fwd, dim3(grid), dim3(512), args, LDS_BYTES, stream);
    if (e != hipSuccess) fprintf(stderr, "cooperative launch failed: %s (grid %d)\n", hipGetErrorString(e), grid);
#endif
}
```

```cpp
#include <hip/hip_runtime.h>
#include <hip/hip_cooperative_groups.h>
#include <cstdio>
#include <cstdint>
namespace cg = cooperative_groups;

#ifndef MK_MULTI
#define MK_MULTI 0
#endif

namespace pg8 {
#define PG8_LAS __attribute__((address_space(3)))
typedef unsigned short bf16_t;
typedef short bf16x8 __attribute__((ext_vector_type(8)));
typedef float f32x4 __attribute__((ext_vector_type(4)));
typedef unsigned u32x4 __attribute__((ext_vector_type(4)));
constexpr int BM = 256, BK = 64, HALF = 128, HTB = HALF * BK * 2  , STAGE_BYTES = 8 * HTB, NXCD = 8, WGM = 8;

__host__ __device__ __forceinline__ int lds_byte(int r, int c) { const int st = (r >> 4) * 2 + (c >> 5), rr = r & 15, cc = c & 31, ob = rr * 64 + cc * 2; return st * 1024 + (ob ^ (((ob >> 9) & 1) << 5)); }
__host__ __device__ __forceinline__ void stage_rc(int b, int& R, int& C) { const int st = b / 1024, sb = b % 1024, swz = sb ^ (((sb >> 9) & 1) << 5); R = (st >> 1) * 16 + swz / 64; C = (st & 1) * 32 + (swz % 64) / 2; }
__host__ __device__ __forceinline__ int perm32(int rho) { const int n = rho >> 4, i = rho & 15; return 8 * (i >> 2) + 4 * n + (i & 3); }

struct Unit { int pm, pn; };
struct Gemm { const bf16_t* A; const bf16_t* Bt; int M, N, K, lda, ldb; };

struct StaticOrder {
    int nM, nN, nwg, G, c, skip;
    __host__ __device__ void init(int M, int N, int G_, int c_, int skip_ = 0) { nM = M / BM; nN = N / BM; nwg = nM * nN; G = G_; c = c_; skip = skip_; }
    __host__ __device__ bool next(int i, Unit& u) const {
        const long L = (long)i * G + c; if (L >= nwg) return false;
        int wgid = (int)L; { const int q = nwg / NXCD, r = nwg % NXCD, xcd = wgid % NXCD, off = wgid / NXCD; wgid = (xcd < r ? xcd * (q + 1) : r * (q + 1) + (xcd - r) * q) + off; }
        const int nig = WGM * nN, gid = wgid / nig, fm = gid * WGM, gsz = (nM - fm) < WGM ? (nM - fm) : WGM;
        u.pm = fm + ((wgid % nig) % gsz); u.pn = (wgid % nig) / gsz; if (skip) u.pm += 1 + (u.pm >= 32 ? 1 : 0); return true;
    }
    __device__ __forceinline__ void a_ready(const Unit&) const {}
    __device__ __forceinline__ void done(const Unit&) const {}
};

__device__ __forceinline__ unsigned cvt_pk_bf16(float lo, float hi) { unsigned r; asm volatile("v_cvt_pk_bf16_f32 %0, %1, %2" : "=v"(r) : "v"(lo), "v"(hi)); return r; }

struct EpiStore {
    static constexpr bool PERM = true, AFTER_DRAIN = false;
    bf16_t* O; int ldc; int ncols; float scale;
    __device__ __forceinline__ void operator()(const f32x4 (&acc)[2][2][4][2], const Unit& u, int wr, int wc, int fr, int fq) const {
        const int row0 = u.pm * BM + wr * 64 + fr; const int col0 = u.pn * BM + wc * 32 + 8 * fq;
#pragma unroll
        for (int ai = 0; ai < 2; ++ai)
#pragma unroll
            for (int m = 0; m < 4; ++m) { bf16_t* rowp = O + (size_t)(row0 + ai * HALF + m * 16) * ldc + col0;
#pragma unroll
                for (int bj = 0; bj < 2; ++bj) { if (col0 + bj * HALF < ncols) {
                    f32x4 v0 = acc[ai][bj][m][0] * scale, v1 = acc[ai][bj][m][1] * scale;
                    u32x4 w; w.x = cvt_pk_bf16(v0[0], v0[1]); w.y = cvt_pk_bf16(v0[2], v0[3]); w.z = cvt_pk_bf16(v1[0], v1[1]); w.w = cvt_pk_bf16(v1[2], v1[3]);
                    *(u32x4*)(rowp + bj * HALF) = w; } } }
    }
};
struct EpiResid {
    static constexpr bool PERM = false, AFTER_DRAIN = false;
    float* X; const float* gate; int row_tile0;
    __device__ __forceinline__ void operator()(const f32x4 (&acc)[2][2][4][2], const Unit& u, int wr, int wc, int fr, int fq) const {
        const int tpm = u.pm + row_tile0; const int bb = tpm / 33, jj = tpm - bb * 33; const float* gv = gate + (jj == 0 ? 2 : bb) * 6144;
        const int col0 = u.pn * BM + wc * 32 + 4 * fq;
#pragma unroll
        for (int ai = 0; ai < 2; ++ai)
#pragma unroll
            for (int m = 0; m < 4; ++m) { float* rowp = X + (size_t)(tpm * BM + ai * HALF + wr * 64 + m * 16 + fr) * 1024 + col0;
#pragma unroll
                for (int bj = 0; bj < 2; ++bj) {
#pragma unroll
                    for (int n = 0; n < 2; ++n) { f32x4* q = (f32x4*)(rowp + bj * HALF + n * 16); const f32x4 gq = *(const f32x4*)(gv + col0 + bj * HALF + n * 16); f32x4 xv = *q; xv = xv + gq * acc[ai][bj][m][n]; *q = xv; }
                    asm volatile("" ::: "memory"); } }
    }
};

template <class Epi, class Sched, bool ALIGN_EPI = false, bool SP2 = false>
__device__ __forceinline__ void gemm_phase(PG8_LAS unsigned char* lds, const Gemm g, const Sched& S, const Epi& E) {
    int tid = threadIdx.x; asm volatile("" : "+v"(tid));
    const int wid = __builtin_amdgcn_readfirstlane(tid >> 6), lane = tid & 63, wr = wid >> 2, wc = wid & 3, fr = lane & 15, fq = lane >> 4;
    int K = g.K; asm volatile("" : "+s"(K));
    const int nt = K / BK;
    unsigned voffA[2], voffB[2];
#pragma unroll
    for (int i = 0; i < 2; ++i) { int R, C; stage_rc(tid * 16 + i * 8192, R, C); const int Rb = Epi::PERM ? ((R & ~31) + perm32(R & 31)) : R;
        voffA[i] = (unsigned)(R * g.lda + C) * 2u; voffB[i] = (unsigned)(Rb * g.ldb + C) * 2u; }
    const size_t kstep = (size_t)(BK * 2);
    const size_t hstepA = (size_t)HALF * g.lda * 2, hstepB = (size_t)HALF * g.ldb * 2;
    const size_t tstepA = 2 * hstepA, tstepB = 2 * hstepB;
    const unsigned ldsw = (unsigned)wid * 1024u;
    const int aoff = lds_byte(wr * 64 + fr, fq * 8), boff = lds_byte(wc * 32 + fr, fq * 8);
#define PG8_SA(b, h) (((b) * 2 + (h)) * HTB)
#define PG8_SB(b, h) ((4 + (b) * 2 + (h)) * HTB)
#define PG8_STAGE(bufoff, gbase, voff) do { _Pragma("unroll") for (int _i = 0; _i < 2; ++_i) \
        __builtin_amdgcn_global_load_lds((const unsigned*)((const char*)(gbase) + (voff)[_i]), (PG8_LAS unsigned*)(lds + (bufoff) + ldsw + _i * 8192), 16, 0, 0); } while (0)
#define PG8_LDA(dst, b, h) do { _Pragma("unroll") for (int m = 0; m < 4; ++m) _Pragma("unroll") for (int k = 0; k < 2; ++k) dst[m][k] = *(const PG8_LAS bf16x8*)(lds + PG8_SA(b, h) + aoff + m * 2048 + k * 1024); } while (0)
#define PG8_LDB(dst, b, h) do { _Pragma("unroll") for (int n = 0; n < 2; ++n) _Pragma("unroll") for (int k = 0; k < 2; ++k) dst[n][k] = *(const PG8_LAS bf16x8*)(lds + PG8_SB(b, h) + boff + n * 2048 + k * 1024); } while (0)
#define PG8_MMA(ai, bj, At, Bt) do { __builtin_amdgcn_s_setprio(1); _Pragma("unroll") for (int m = 0; m < 4; ++m) _Pragma("unroll") for (int n = 0; n < 2; ++n) _Pragma("unroll") for (int k = 0; k < 2; ++k) \
        acc[ai][bj][m][n] = __builtin_amdgcn_mfma_f32_16x16x32_bf16(Bt[n][k], At[m][k], acc[ai][bj][m][n], 0, 0, 0); __builtin_amdgcn_s_setprio(0); } while (0)
#define PG8_WAIT_V(n) asm volatile("s_waitcnt vmcnt(" #n ")" ::: "memory")
#define PG8_WAIT_L(n) asm volatile("s_waitcnt lgkmcnt(" #n ")" ::: "memory")
#define PG8_BAR __builtin_amdgcn_s_barrier()
#define PG8_SCHED __builtin_amdgcn_sched_barrier(0)
    Unit cur, nxt; int ui = 0;
    if (!S.next(0, cur)) return;
    f32x4 acc[2][2][4][2];
#pragma unroll
    for (int a = 0; a < 2; ++a)
#pragma unroll
        for (int b = 0; b < 2; ++b)
#pragma unroll
            for (int m = 0; m < 4; ++m)
#pragma unroll
                for (int n = 0; n < 2; ++n) acc[a][b][m][n] = (f32x4){0.f, 0.f, 0.f, 0.f};
    bf16x8 At[4][2], B0[2][2], B1[2][2];
    const char* cA = (const char*)g.A + (size_t)cur.pm * tstepA; const char* cB = (const char*)g.Bt + (size_t)cur.pn * tstepB;
    S.a_ready(cur);
    if constexpr (SP2) {
        PG8_STAGE(PG8_SB(0, 0), cB, voffB); PG8_STAGE(PG8_SB(0, 1), cB + hstepB, voffB); PG8_STAGE(PG8_SA(0, 0), cA, voffA); PG8_STAGE(PG8_SA(0, 1), cA + hstepA, voffA);
        if (wr == 1) PG8_BAR;
        PG8_WAIT_V(2); PG8_BAR;
        PG8_STAGE(PG8_SB(1, 0), cB + kstep, voffB); PG8_STAGE(PG8_SA(1, 0), cA + kstep, voffA); PG8_STAGE(PG8_SB(1, 1), cB + hstepB + kstep, voffB);
        PG8_WAIT_V(6); PG8_BAR;
    } else {
        PG8_STAGE(PG8_SB(0, 0), cB, voffB); PG8_STAGE(PG8_SA(0, 0), cA, voffA); PG8_STAGE(PG8_SB(0, 1), cB + hstepB, voffB); PG8_STAGE(PG8_SA(0, 1), cA + hstepA, voffA);
        if (wr == 1) PG8_BAR;
        PG8_WAIT_V(4); PG8_BAR;
        PG8_STAGE(PG8_SB(1, 0), cB + kstep, voffB); PG8_STAGE(PG8_SA(1, 0), cA + kstep, voffA); PG8_STAGE(PG8_SB(1, 1), cB + hstepB + kstep, voffB);
        PG8_WAIT_V(6); PG8_BAR;
    }
    for (;;) {
        const bool has_next = S.next(ui + 1, nxt);
        const char* nA = has_next ? (const char*)g.A + (size_t)nxt.pm * tstepA : cA; const char* nB = has_next ? (const char*)g.Bt + (size_t)nxt.pn * tstepB : cB;
        for (int t = 0; t < nt; t += 2) {
            const bool last = (t == nt - 2);
            const char* a1 = cA + (size_t)(t + 1) * kstep;
            const char* a2 = last ? nA : cA + (size_t)(t + 2) * kstep; const char* b2 = last ? nB : cB + (size_t)(t + 2) * kstep;
            const char* a3 = a2 + kstep; const char* b3 = b2 + kstep;
            if (last && has_next) S.a_ready(nxt);
            if constexpr (SP2) {
            PG8_LDB(B0, 0, 0); PG8_LDB(B1, 0, 1); PG8_SCHED; PG8_LDA(At, 0, 0); PG8_STAGE(PG8_SA(1, 1), a1 + hstepA, voffA);
            PG8_WAIT_V(8); PG8_WAIT_L(0); PG8_BAR; PG8_MMA(0, 0, At, B0); PG8_MMA(0, 1, At, B1); PG8_BAR; PG8_SCHED;
            PG8_LDA(At, 0, 1); PG8_STAGE(PG8_SB(0, 0), b2, voffB); PG8_STAGE(PG8_SB(0, 1), b2 + hstepB, voffB); PG8_STAGE(PG8_SA(0, 0), a2, voffA);
            PG8_WAIT_V(8); PG8_WAIT_L(0); PG8_BAR; PG8_MMA(1, 0, At, B0); PG8_MMA(1, 1, At, B1); PG8_BAR; PG8_SCHED;
            PG8_LDB(B0, 1, 0); PG8_LDB(B1, 1, 1); PG8_SCHED; PG8_LDA(At, 1, 0); PG8_STAGE(PG8_SA(0, 1), a2 + hstepA, voffA);
            PG8_WAIT_V(8); PG8_WAIT_L(0); PG8_BAR; PG8_MMA(0, 0, At, B0); PG8_MMA(0, 1, At, B1); PG8_BAR; PG8_SCHED;
            PG8_LDA(At, 1, 1); PG8_STAGE(PG8_SB(1, 0), b3, voffB); PG8_STAGE(PG8_SB(1, 1), b3 + hstepB, voffB); PG8_STAGE(PG8_SA(1, 0), a3, voffA);
            PG8_WAIT_V(8); PG8_WAIT_L(0); PG8_BAR; PG8_MMA(1, 0, At, B0); PG8_MMA(1, 1, At, B1); PG8_BAR; PG8_SCHED;
            } else {
            PG8_LDB(B0, 0, 0); PG8_SCHED; PG8_LDA(At, 0, 0); PG8_STAGE(PG8_SA(1, 1), a1 + hstepA, voffA);
            PG8_WAIT_L(8); PG8_BAR; PG8_WAIT_L(0); PG8_MMA(0, 0, At, B0); PG8_BAR; PG8_SCHED;
            PG8_LDB(B1, 0, 1); PG8_STAGE(PG8_SB(0, 0), b2, voffB);
            PG8_BAR; PG8_WAIT_L(0); PG8_MMA(0, 1, At, B1); PG8_BAR;
            PG8_LDA(At, 0, 1); PG8_STAGE(PG8_SA(0, 0), a2, voffA);
            PG8_BAR; PG8_WAIT_L(0); PG8_MMA(1, 0, At, B0); PG8_BAR; PG8_SCHED;
            PG8_STAGE(PG8_SB(0, 1), b2 + hstepB, voffB);
            PG8_WAIT_V(6); PG8_BAR; PG8_MMA(1, 1, At, B1); PG8_BAR;
            PG8_LDB(B0, 1, 0); PG8_SCHED; PG8_LDA(At, 1, 0); PG8_STAGE(PG8_SA(0, 1), a2 + hstepA, voffA);
            PG8_WAIT_L(8); PG8_BAR; PG8_WAIT_L(0); PG8_MMA(0, 0, At, B0); PG8_BAR; PG8_SCHED;
            PG8_LDB(B1, 1, 1); PG8_STAGE(PG8_SB(1, 0), b3, voffB);
            PG8_BAR; PG8_WAIT_L(0); PG8_MMA(0, 1, At, B1); PG8_BAR;
            PG8_LDA(At, 1, 1); PG8_STAGE(PG8_SA(1, 0), a3, voffA);
            PG8_BAR; PG8_WAIT_L(0); PG8_MMA(1, 0, At, B0); PG8_BAR; PG8_SCHED;
            PG8_STAGE(PG8_SB(1, 1), b3 + hstepB, voffB);
            PG8_WAIT_V(6); PG8_BAR; PG8_MMA(1, 1, At, B1); PG8_BAR;
            }
        }
        if constexpr (ALIGN_EPI) { if (wr == 0) PG8_BAR; }
        if constexpr (!Epi::AFTER_DRAIN) { E(acc, cur, wr, wc, fr, fq); S.done(cur); }
        if (!has_next) break;
#pragma unroll
        for (int a = 0; a < 2; ++a)
#pragma unroll
            for (int b = 0; b < 2; ++b)
#pragma unroll
                for (int m = 0; m < 4; ++m)
#pragma unroll
                    for (int n = 0; n < 2; ++n) acc[a][b][m][n] = (f32x4){0.f, 0.f, 0.f, 0.f};
        cur = nxt; cA = nA; cB = nB; ++ui;
        if constexpr (ALIGN_EPI) { if (wr == 1) PG8_BAR; }
    }
    PG8_WAIT_V(0);
    if constexpr (!ALIGN_EPI) { if (wr == 0) PG8_BAR; }
    PG8_BAR;
    if constexpr (Epi::AFTER_DRAIN) { E.fused(acc, cur, wr, wc, fr, fq, lds, wid, lane); S.done(cur); }
#undef PG8_SA
#undef PG8_SB
#undef PG8_STAGE
#undef PG8_LDA
#undef PG8_LDB
#undef PG8_MMA
#undef PG8_WAIT_V
#undef PG8_WAIT_L
#undef PG8_BAR
#undef PG8_SCHED
}
}

#define DEV __device__ __forceinline__
#define LAS __attribute__((address_space(3)))
typedef unsigned short bf16_t;
typedef short bf16x8 __attribute__((ext_vector_type(8)));
typedef float f32x4 __attribute__((ext_vector_type(4)));
typedef float f32x2 __attribute__((ext_vector_type(2)));
typedef float f32x16 __attribute__((ext_vector_type(16)));
typedef unsigned u32x4 __attribute__((ext_vector_type(4)));
typedef unsigned u32x2 __attribute__((ext_vector_type(2)));

constexpr int R = 16896, RB = 8448, NCTX = 256, TL = 8192, DM = 1024, INW = 1696, DFF = 2816, HFF = 1408;
constexpr int NWG_T = 512;
constexpr float EPS = 1e-6f;
constexpr int LDS_BYTES = 147456;
constexpr size_t OFF_X = 0, OFF_HN = 69206016, OFF_W = 103809024, OFF_MOD = 152174592, OFF_ROPE = 152436736, OFF_OV = 153485312;
constexpr size_t OV_Q = 0, OV_KN = 25952256, OV_VT = 43253760, OV_SLOC = 60555264, OV_SIN = 69206016, OV_U = 0;
constexpr size_t WS_NEED = 250000128 + 16384;
constexpr size_t W_IN = 0, W_UQ = 1835008, W_KN = 2129920, W_V = 2260992, W_OUT = 2392064, W_UP = 3440640, W_DN = 9207808, W_LAYER = 12091392;

struct Params {
    const float *x, *c, *ctx, *c_ctx, *w_mod, *b_mod, *norm1_g, *w_in, *ret_decay_f, *ret_decay_b, *mla_q_norm_g, *w_uq, *mla_kv_norm_g, *w_ukv,
        *pool_w, *pool_scale, *w_out, *norm2_g, *w_up, *conv_w, *conv_b, *w_down, *final_norm_g;
    float* out; unsigned char* ws; int ph_lo, ph_hi;
};

DEV int otid() { int t = threadIdx.x; asm volatile("" : "+v"(t)); return t; }
DEV float bf2f(unsigned short x) { return __uint_as_float((unsigned)x << 16); }
DEV unsigned f2bf(float f) { unsigned u = __float_as_uint(f); return (u + 0x7fffu + ((u >> 16) & 1u)) >> 16; }
DEV unsigned pk2(float lo, float hi) { return f2bf(lo) | (f2bf(hi) << 16); }
DEV float wave_sum(float v) {
#pragma unroll
    for (int o = 1; o < 64; o <<= 1) v += __shfl_xor(v, o);
    return v;
}
DEV float siluf(float x) { return x / (1.0f + __expf(-x)); }
DEV int crow(int r, int hi) { return (r & 3) + 8 * (r >> 2) + 4 * hi; }
DEV bf16x8 pack8(float a0, float a1, float a2, float a3, float a4, float a5, float a6, float a7) {
    u32x4 w; w.x = pg8::cvt_pk_bf16(a0, a1); w.y = pg8::cvt_pk_bf16(a2, a3); w.z = pg8::cvt_pk_bf16(a4, a5); w.w = pg8::cvt_pk_bf16(a6, a7);
    return __builtin_bit_cast(bf16x8, w);
}
DEV int row_mi(int r) { const int b = r / RB; const int s = r - b * RB; return s < NCTX ? 2 : b; }

DEV void transpose_item(const float* W, int K, int Nsrc, bf16_t* WT, int n0, int cs, int k0, float* scr, int lane) {
#pragma unroll 8
    for (int i = 0; i < 32; ++i) { const int kk = 2 * i + (lane >> 5); scr[kk * 33 + (lane & 31)] = cs >= 0 ? W[(size_t)(k0 + kk) * Nsrc + cs + (lane & 31)] : 0.f; }
    asm volatile("s_waitcnt lgkmcnt(0)" ::: "memory");
    const int c = lane & 7;
#pragma unroll
    for (int j = 0; j < 4; ++j) { const int n = (lane >> 3) + 8 * j; const float* s = scr + (8 * c) * 33 + n;
        u32x4 o; o.x = pk2(s[0 * 33], s[1 * 33]); o.y = pk2(s[2 * 33], s[3 * 33]); o.z = pk2(s[4 * 33], s[5 * 33]); o.w = pk2(s[6 * 33], s[7 * 33]);
        *(u32x4*)(WT + (size_t)(n0 + n) * K + k0 + 8 * c) = o; }
    asm volatile("s_waitcnt lgkmcnt(0)" ::: "memory");
}
DEV int map_in(int n0) { return n0 < 1440 ? n0 : (n0 < INW ? -2 : -1); }
DEV int map_kn(int n0) { return (n0 >> 6) * 128 + (n0 & 63); }
DEV int map_v(int n0) { return (n0 >> 6) * 128 + 64 + (n0 & 63); }
DEV int map_up(int n0) { const int hf = n0 / DFF, w = n0 - hf * DFF; return w < HFF ? hf * HFF + w : DFF + hf * HFF + (w - HFF); }

DEV void phase_prep(const Params& p, unsigned char* lds) {
    const int tid = otid(), lane = tid & 63, wid = tid >> 6;
    unsigned char* ws = p.ws;
    { f32x2* rope = (f32x2*)(ws + OFF_ROPE);
      for (int idx = blockIdx.x * NWG_T + tid; idx < TL * 16; idx += gridDim.x * NWG_T) { const int t = idx >> 4, i = idx & 15; const int pos = i < 8 ? (t >> 6) : (t & 63);
          const float inv = exp2f(-(float)(i & 7) * 0.125f * 13.287712379549449f); const float ang = (float)pos * inv; f32x2 cs; cs.x = __cosf(ang); cs.y = __sinf(ang); rope[idx] = cs; } }
    { float* scv = (float*)lds;
      float* red = scv + 3 * 1024;
      for (int i = tid; i < 3 * 1024; i += NWG_T) { const int v = i >> 10, k = i & 1023; const float cv = v < 2 ? p.c[v * 1024 + k] : p.c_ctx[k]; scv[i] = siluf(cv); }
      __syncthreads();
      float* modv = (float*)(ws + OFF_MOD);
      for (int it = blockIdx.x; it < 192; it += gridDim.x) { const int l = it / 96, col0 = (it % 96) * 64;
          const float* wm = p.w_mod + (size_t)l * 1024 * 6144 + col0 + lane; float a0 = 0.f, a1 = 0.f, a2 = 0.f;
#pragma unroll 8
          for (int k = wid * 128; k < wid * 128 + 128; ++k) { const float w = wm[(size_t)k * 6144]; a0 += scv[k] * w; a1 += scv[1024 + k] * w; a2 += scv[2048 + k] * w; }
          red[(wid * 3 + 0) * 64 + lane] = a0; red[(wid * 3 + 1) * 64 + lane] = a1; red[(wid * 3 + 2) * 64 + lane] = a2;
          __syncthreads();
          if (tid < 192) { const int v = tid >> 6, cl = tid & 63; float s = 0.f;
#pragma unroll
              for (int w = 0; w < 8; ++w) s += red[(w * 3 + v) * 64 + cl];
              modv[((size_t)l * 3 + v) * 6144 + col0 + cl] = s + p.b_mod[l * 6144 + col0 + cl]; }
          __syncthreads(); }
    }
    { float* scr = (float*)(lds + 32768 + wid * 8704);
      const int gw = blockIdx.x * 8 + wid, NGW = gridDim.x * 8;
      constexpr int I_IN = 16 * 56, I_UQ = 6 * 24, I_KN = 4 * 16, I_V = 4 * 16, I_OUT = 16 * 32, I_UP = 16 * 176, I_DN = 44 * 32, I_L = I_IN + I_UQ + I_KN + I_V + I_OUT + I_UP + I_DN;
      for (int it = gw; it < 2 * I_L; it += NGW) { const int l = it / I_L; int r = it - l * I_L; bf16_t* wl = (bf16_t*)(ws + OFF_W) + (size_t)l * W_LAYER;
          const float* src; int K, Nsrc, nbn, mp; size_t doff;
          if (r < I_IN) { src = p.w_in + (size_t)l * 1024 * INW; K = 1024; Nsrc = INW; nbn = 56; mp = 1; doff = W_IN; }
          else if ((r -= I_IN) < I_UQ) { src = p.w_uq + (size_t)l * 384 * 768; K = 384; Nsrc = 768; nbn = 24; mp = 0; doff = W_UQ; }
          else if ((r -= I_UQ) < I_KN) { src = p.w_ukv + (size_t)l * 256 * 1024; K = 256; Nsrc = 1024; nbn = 16; mp = 2; doff = W_KN; }
          else if ((r -= I_KN) < I_V) { src = p.w_ukv + (size_t)l * 256 * 1024; K = 256; Nsrc = 1024; nbn = 16; mp = 3; doff = W_V; }
          else if ((r -= I_V) < I_OUT) { src = p.w_out + (size_t)l * 1024 * 1024; K = 1024; Nsrc = 1024; nbn = 32; mp = 0; doff = W_OUT; }
          else if ((r -= I_OUT) < I_UP) { src = p.w_up + (size_t)l * 1024 * 5632; K = 1024; Nsrc = 5632; nbn = 176; mp = 4; doff = W_UP; }
          else { r -= I_UP; src = p.w_down + (size_t)l * DFF * 1024; K = DFF; Nsrc = 1024; nbn = 32; mp = 0; doff = W_DN; }
          const int kb = r / nbn, nb = r - kb * nbn, n0 = nb * 32;
          const int cs = mp == 0 ? n0 : mp == 1 ? map_in(n0) : mp == 2 ? map_kn(n0) : mp == 3 ? map_v(n0) : map_up(n0);
          if (cs != -2) transpose_item(src, K, Nsrc, wl + doff, n0, cs, kb * 64, scr, lane); }
    }
    { for (int idx = blockIdx.x * NWG_T + tid; idx < 2 * 1024 * 256; idx += gridDim.x * NWG_T) { const int n = idx & 255, k = (idx >> 8) & 1023, l = idx >> 18; const int g = n >> 6, d = n & 63;
          const float* wr = p.w_in + ((size_t)l * 1024 + k) * INW + 1440 + g * 64; const float* pw = p.pool_w + ((size_t)(l * 4 + g) * 64) * 64 + d; float s = 0.f;
#pragma unroll 8
          for (int c = 0; c < 64; ++c) s += wr[c] * pw[c * 64];
          ((bf16_t*)(ws + OFF_W) + (size_t)l * W_LAYER + W_IN)[(size_t)(1440 + n) * 1024 + k] = (bf16_t)f2bf(s * p.pool_scale[l * 256 + n]); } }
}

DEV void phase_norm(const Params& p, int l, int which, bool first) {
    const int tid = otid(); const int lane = tid & 63, wid = tid >> 6; const int gw = blockIdx.x * 8 + wid, NGW = gridDim.x * 8;
    float* X = (float*)(p.ws + OFF_X); bf16_t* HN = (bf16_t*)(p.ws + OFF_HN);
    const float* modv = (const float*)(p.ws + OFF_MOD) + (size_t)l * 3 * 6144;
    const float* g = (which == 0 ? p.norm1_g : p.norm2_g) + l * 1024;
    for (int r = gw; r < R; r += NGW) {
        const int b = r / RB, s = r - b * RB; const int mi = s < NCTX ? 2 : b;
        const float* src = first ? (s < NCTX ? p.ctx + ((size_t)b * NCTX + s) * 1024 : p.x + ((size_t)b * TL + (s - NCTX)) * 1024) : X + (size_t)r * 1024;
        const f32x4* xr = (const f32x4*)src + lane; f32x4 v[4]; float ss = 0.f;
#pragma unroll
        for (int j = 0; j < 4; ++j) { v[j] = xr[64 * j]; ss += (v[j].x * v[j].x + v[j].y * v[j].y) + (v[j].z * v[j].z + v[j].w * v[j].w); }
        if (first) { f32x4* xo = (f32x4*)(X + (size_t)r * 1024) + lane;
#pragma unroll
            for (int j = 0; j < 4; ++j) xo[64 * j] = v[j]; }
        const float rs = rsqrtf(wave_sum(ss) * (1.f / 1024.f) + EPS);
        const float* mv = modv + mi * 6144 + (which == 0 ? 0 : 3072);
        u32x2* o8 = (u32x2*)(HN + (size_t)r * 1024) + lane;
#pragma unroll
        for (int j = 0; j < 4; ++j) { const f32x4 gg = ((const f32x4*)g)[lane + 64 * j], sh = ((const f32x4*)mv)[lane + 64 * j], sc = ((const f32x4*)(mv + 1024))[lane + 64 * j];
            const f32x4 y = v[j] * rs * gg; const f32x4 h = y * (sc + 1.0f) + sh; u32x2 w; w.x = pk2(h.x, h.y); w.y = pk2(h.z, h.w); o8[64 * j] = w; }
    }
}
DEV void phase_final(const Params& p) {
    const int tid = otid(); const int lane = tid & 63, wid = tid >> 6; const int gw = blockIdx.x * 8 + wid, NGW = gridDim.x * 8;
    const float* X = (const float*)(p.ws + OFF_X);
    for (int q = gw; q < 2 * TL; q += NGW) { const int b = q / TL, t = q - b * TL; const int r = b * RB + NCTX + t;
        const f32x4* xr = (const f32x4*)(X + (size_t)r * 1024) + lane; f32x4 v[4]; float ss = 0.f;
#pragma unroll
        for (int j = 0; j < 4; ++j) { v[j] = xr[64 * j]; ss += (v[j].x * v[j].x + v[j].y * v[j].y) + (v[j].z * v[j].z + v[j].w * v[j].w); }
        const float rs = rsqrtf(wave_sum(ss) * (1.f / 1024.f) + EPS);
        f32x4* o = (f32x4*)(p.out + (size_t)q * 1024) + lane;
#pragma unroll
        for (int j = 0; j < 4; ++j) { const f32x4 gg = ((const f32x4*)p.final_norm_g)[lane + 64 * j]; o[64 * j] = v[j] * rs * gg; } }
}

DEV void phase_rowwise(const Params& p, int l) {
    const int tid = otid(); const int lane = tid & 63, wid = tid >> 6; const int gw = blockIdx.x * 8 + wid, NGW = gridDim.x * 8;
    bf16_t* P = (bf16_t*)p.out; const f32x2* rope = (const f32x2*)(p.ws + OFF_ROPE);
    const float* qg = p.mla_q_norm_g + l * 384; const float* kg = p.mla_kv_norm_g + l * 256;
    for (int r = gw; r < R; r += NGW) {
        bf16_t* pr = P + (size_t)r * INW; const int b = r / RB, s = r - b * RB;
        { unsigned* q2 = (unsigned*)(pr + 768) + lane; unsigned w[3]; float ss = 0.f;
#pragma unroll
          for (int j = 0; j < 3; ++j) { w[j] = q2[64 * j]; const float a = bf2f(w[j] & 0xffff), c2 = bf2f(w[j] >> 16); ss += a * a + c2 * c2; }
          const float rs = rsqrtf(wave_sum(ss) * (1.f / 384.f) + EPS);
#pragma unroll
          for (int j = 0; j < 3; ++j) { const int c0 = 2 * (lane + 64 * j); q2[64 * j] = pk2(bf2f(w[j] & 0xffff) * rs * qg[c0], bf2f(w[j] >> 16) * rs * qg[c0 + 1]); } }
        { u32x2* k4 = (u32x2*)(pr + 1152) + lane; const u32x2 w = *k4;
          const float a0 = bf2f(w.x & 0xffff), a1 = bf2f(w.x >> 16), a2 = bf2f(w.y & 0xffff), a3 = bf2f(w.y >> 16);
          const float rs = rsqrtf(wave_sum((a0 * a0 + a1 * a1) + (a2 * a2 + a3 * a3)) * (1.f / 256.f) + EPS);
          const f32x4 gg = ((const f32x4*)kg)[lane]; u32x2 o; o.x = pk2(a0 * rs * gg.x, a1 * rs * gg.y); o.y = pk2(a2 * rs * gg.z, a3 * rs * gg.w); *k4 = o; }
        if (s >= NCTX && lane < 16) { const f32x2 cs = rope[(s - NCTX) * 16 + lane];
          const float x1 = bf2f(pr[1408 + lane]), x2 = bf2f(pr[1408 + 16 + lane]);
          pr[1408 + lane] = (bf16_t)f2bf(x1 * cs.x - x2 * cs.y); pr[1408 + 16 + lane] = (bf16_t)f2bf(x2 * cs.x + x1 * cs.y); }
    }
}

DEV void phase_pool(const Params& p) {
    const int tid = otid(); const bf16_t* P = (const bf16_t*)p.out; bf16_t* MIX = (bf16_t*)(p.ws + OFF_HN);
    for (int idx = blockIdx.x * NWG_T + tid; idx < R * 32; idx += gridDim.x * NWG_T) { const int r = idx >> 5, cg = idx & 31; const int half = 1 << (cg >> 3);
        const int b = r / RB, s = r - b * RB; const int seq0 = s < NCTX ? b * RB : b * RB + NCTX; const int T = s < NCTX ? NCTX : TL; const int t = r - seq0;
        const int lo = max(t - half, 0), hi = min(t + half, T); float sum[8];
#pragma unroll
        for (int j = 0; j < 8; ++j) sum[j] = 0.f;
        const bf16_t* base = P + (size_t)seq0 * INW + 1440 + cg * 8;
        for (int tt = lo; tt < hi; ++tt) { const bf16x8 v = *(const bf16x8*)(base + (size_t)tt * INW);
#pragma unroll
            for (int j = 0; j < 8; ++j) sum[j] += bf2f((unsigned short)v[j]); }
        const bf16x8 me = *(const bf16x8*)(base + (size_t)t * INW); const float ic = 1.0f / (float)(hi - lo); float o[8];
#pragma unroll
        for (int j = 0; j < 8; ++j) o[j] = sum[j] * ic - bf2f((unsigned short)me[j]);
        *(bf16x8*)(MIX + (size_t)r * 1024 + 768 + cg * 8) = pack8(o[0], o[1], o[2], o[3], o[4], o[5], o[6], o[7]); }
}

DEV float log2_sigmoid(float d) { return -log1pf(__expf(-d)) * 1.4426950408889634f; }
DEV void states_item(const Params& p, int l, unsigned char* lds, int it) {
    const int tid = otid(); const bf16_t* P = (const bf16_t*)p.out; const f32x2* rope = (const f32x2*)(p.ws + OFF_ROPE);
    float* SLOC = (float*)(p.ws + OFF_OV + OV_SLOC);
    const int gc = it >> 2, h = it & 3;
    bf16_t* kk = (bf16_t*)lds;
    bf16_t* vv = kk + 128 * 32;
    float* dec = (float*)(vv + 128 * 64);
    const int cb = gc % 66; const bool lat = cb >= 2; const int t0 = (cb - 2) * 128; const int r0 = gc * 128;
    if (tid < 256) { const int dir = tid >> 7, idx = tid & 127;
        const float lg = log2_sigmoid((dir == 0 ? p.ret_decay_f : p.ret_decay_b)[l * 4 + h]); dec[tid] = exp2f(lg * (dir == 0 ? (float)(127 - idx) : (float)idx)); }
    else { const int task = tid - 256; const int tok = task >> 1, c = task & 1;
        const bf16_t* src = P + (size_t)(r0 + tok) * INW + 128 + h * 32 + 8 * c; const bf16x8 lo = *(const bf16x8*)src, hi = *(const bf16x8*)(src + 16);
        float o1[8], o2[8];
#pragma unroll
        for (int j = 0; j < 8; ++j) { float x1 = bf2f((unsigned short)lo[j]), x2 = bf2f((unsigned short)hi[j]);
            if (lat) { const f32x2 cs = rope[(t0 + tok) * 16 + 8 * c + j]; const float y1 = x1 * cs.x - x2 * cs.y, y2 = x2 * cs.x + x1 * cs.y; x1 = y1; x2 = y2; }
            o1[j] = x1 * 0.17677669529663687f; o2[j] = x2 * 0.17677669529663687f; }
        bf16_t* dst = kk + tok * 32 + 8 * c;
        *(bf16x8*)dst = pack8(o1[0], o1[1], o1[2], o1[3], o1[4], o1[5], o1[6], o1[7]); *(bf16x8*)(dst + 16) = pack8(o2[0], o2[1], o2[2], o2[3], o2[4], o2[5], o2[6], o2[7]); }
    for (int task = tid; task < 1024; task += NWG_T) { const int tok = task >> 3, ch = task & 7; *(u32x4*)(vv + tok * 64 + ch * 8) = *(const u32x4*)(P + (size_t)(r0 + tok) * INW + 256 + h * 64 + ch * 8); }
    __syncthreads();
    { const int d = tid >> 4, dvg = tid & 15; float af[4], ab[4];
#pragma unroll
      for (int j = 0; j < 4; ++j) { af[j] = 0.f; ab[j] = 0.f; }
#pragma unroll 4
      for (int i = 0; i < 128; ++i) { const float kv = bf2f(kk[i * 32 + d]); const float kf = kv * dec[i], kb = kv * dec[128 + i];
          const u32x2 v = *(const u32x2*)(vv + i * 64 + dvg * 4);
          const float v0 = bf2f(v.x & 0xffff), v1 = bf2f(v.x >> 16), v2 = bf2f(v.y & 0xffff), v3 = bf2f(v.y >> 16);
          af[0] += kf * v0; af[1] += kf * v1; af[2] += kf * v2; af[3] += kf * v3; ab[0] += kb * v0; ab[1] += kb * v1; ab[2] += kb * v2; ab[3] += kb * v3; }
      float* of = SLOC + ((size_t)(gc * 4 + h) * 2 + 0) * 2048 + d * 64 + dvg * 4;
      *(f32x4*)of = (f32x4){af[0], af[1], af[2], af[3]}; *(f32x4*)(of + 2048) = (f32x4){ab[0], ab[1], ab[2], ab[3]}; }
    __syncthreads();
}
DEV void scan_threads(const Params& p, int l, int gid) {
    if (gid >= 32768) return;
    const int e = gid & 2047, dir = (gid >> 11) & 1, h = (gid >> 12) & 3, b = gid >> 14;
    const float* SLOC = (const float*)(p.ws + OFF_OV + OV_SLOC); float* SIN = (float*)(p.ws + OFF_OV + OV_SIN);
    const float gC = exp2f(log2_sigmoid((dir == 0 ? p.ret_decay_f : p.ret_decay_b)[l * 4 + h]) * 128.f);
    float S = 0.f;
#pragma unroll 6
    for (int st = 0; st < 66; ++st) { const int cb = dir == 0 ? st : (st < 2 ? 1 - st : 67 - st); const size_t idx = ((size_t)((b * 66 + cb) * 4 + h) * 2 + dir) * 2048 + e;
        const float v = SLOC[idx]; SIN[idx] = S; S = S * gC + v; }
}

constexpr int AT_KP = 208, AT_VP = 136, AT_KB = 64 * AT_KP, AT_BUF = AT_KB + 64 * AT_VP;
DEV void attn_unit(const Params& p, unsigned char* lds, int u) {
    const int tid = otid(), lane = tid & 63, wid = tid >> 6, l32 = lane & 31, hi = lane >> 5;
    const bf16_t* Q = (const bf16_t*)(p.ws + OFF_OV + OV_Q); const bf16_t* KN = (const bf16_t*)(p.ws + OFF_OV + OV_KN); const bf16_t* VT = (const bf16_t*)(p.ws + OFF_OV + OV_VT);
    const bf16_t* P = (const bf16_t*)p.out; bf16_t* MIX = (bf16_t*)(p.ws + OFF_HN); const f32x2* rope = (const f32x2*)(p.ws + OFF_ROPE);
    const bool isctx = u >= 512; int b, h, qrow0, NT;
    if (!isctx) { b = u >> 8; h = (u >> 5) & 7; qrow0 = b * RB + NCTX + (u & 31) * 256; NT = 132; } else { const int v = u - 512; b = v >> 3; h = v & 7; qrow0 = b * RB; NT = 4; }
    const int krow0 = b * RB; const int qrow = qrow0 + wid * 32 + l32;
    bf16x8 qf[6];
    { const bf16_t* qp = Q + (size_t)qrow * 768 + h * 96 + hi * 8;
#pragma unroll
      for (int d0 = 0; d0 < 6; ++d0) qf[d0] = *(const bf16x8*)(qp + d0 * 16);
      if (!isctx) { const f32x2* rp = rope + (size_t)(qrow - (b * RB + NCTX)) * 16 + hi * 8;
#pragma unroll
          for (int j = 0; j < 8; ++j) { const f32x2 cs = rp[j]; const float x1 = bf2f((unsigned short)qf[4][j]), x2 = bf2f((unsigned short)qf[5][j]);
              qf[4][j] = (short)f2bf(x1 * cs.x - x2 * cs.y); qf[5][j] = (short)f2bf(x2 * cs.x + x1 * cs.y); } } }
    const bf16_t* sp[3]; int sstep[3], lo[3];
#pragma unroll
    for (int k = 0; k < 3; ++k) { const int c = tid + k * 512;
        if (c < 768) { const int key = c / 12, part = c - key * 12; lo[k] = key * AT_KP + part * 16;
            if (part < 8) { sp[k] = KN + (size_t)(krow0 + key) * 512 + h * 64 + part * 8; sstep[k] = 64 * 512; } else { sp[k] = P + (size_t)(krow0 + key) * INW + 1408 + (part - 8) * 8; sstep[k] = 64 * INW; } }
        else { const int cc = c - 768, dv = cc >> 3, kc = cc & 7; lo[k] = AT_KB + dv * AT_VP + kc * 16; sp[k] = VT + (size_t)(h * 64 + dv) * R + krow0 + kc * 8; sstep[k] = 64; } }
    const bool has3 = tid < 256;
    u32x4 st[3];
#define AT_GLOAD() do { st[0] = *(const u32x4*)sp[0]; sp[0] += sstep[0]; st[1] = *(const u32x4*)sp[1]; sp[1] += sstep[1]; if (has3) { st[2] = *(const u32x4*)sp[2]; sp[2] += sstep[2]; } } while (0)
#define AT_LSTORE1(buf, k) do { unsigned char* d_ = (buf) + lo[k]; if (lo[k] < AT_KB) { *(u32x4*)d_ = st[k]; } else { *(u32x2*)d_ = (u32x2){st[k].x, st[k].y}; *(u32x2*)(d_ + 8) = (u32x2){st[k].z, st[k].w}; } } while (0)
#define AT_LSTORE(buf) do { AT_LSTORE1(buf, 0); AT_LSTORE1(buf, 1); if (has3) AT_LSTORE1(buf, 2); } while (0)
    f32x16 o0, o1;
#pragma unroll
    for (int r = 0; r < 16; ++r) { o0[r] = 0.f; o1[r] = 0.f; }
    float mrun = 0.f, lsum = 0.f;
    __syncthreads();
    AT_GLOAD(); AT_LSTORE(lds);
    __syncthreads();
    for (int t = 0; t < NT; ++t) {
        unsigned char* kbuf = lds + (t & 1) * AT_BUF; unsigned char* vbuf = kbuf + AT_KB; unsigned char* nbuf = lds + ((t + 1) & 1) * AT_BUF;
        const bool more = t + 1 < NT;
        if (more) AT_GLOAD();
        f32x16 s0, s1;
        { const float nm = -mrun;
#pragma unroll
          for (int r = 0; r < 16; ++r) { s0[r] = nm; s1[r] = nm; } }
        bf16x8 kfr[12]; u32x2 vfr[16];
        { const unsigned char* ka = kbuf + l32 * AT_KP + hi * 16;
#pragma unroll
          for (int d0 = 0; d0 < 6; ++d0) { kfr[2 * d0] = *(const bf16x8*)(ka + d0 * 32); kfr[2 * d0 + 1] = *(const bf16x8*)(ka + 32 * AT_KP + d0 * 32); }
          const unsigned char* va = vbuf + l32 * AT_VP + hi * 8;
#pragma unroll
          for (int kj = 0; kj < 4; ++kj) { const unsigned char* vp = va + kj * 32;
              vfr[4 * kj + 0] = *(const u32x2*)vp; vfr[4 * kj + 1] = *(const u32x2*)(vp + 16); vfr[4 * kj + 2] = *(const u32x2*)(vp + 32 * AT_VP); vfr[4 * kj + 3] = *(const u32x2*)(vp + 32 * AT_VP + 16); } }
        __builtin_amdgcn_sched_barrier(0);
#pragma unroll
        for (int d0 = 0; d0 < 6; ++d0) { s0 = __builtin_amdgcn_mfma_f32_32x32x16_bf16(kfr[2 * d0], qf[d0], s0, 0, 0, 0); s1 = __builtin_amdgcn_mfma_f32_32x32x16_bf16(kfr[2 * d0 + 1], qf[d0], s1, 0, 0, 0); }
        __builtin_amdgcn_sched_barrier(0);
        float mx;
        { float m0 = __builtin_fmaxf(__builtin_fmaxf(s0[0], s0[1]), s0[2]), m1 = __builtin_fmaxf(__builtin_fmaxf(s1[0], s1[1]), s1[2]);
          m0 = __builtin_fmaxf(__builtin_fmaxf(m0, s0[3]), s0[4]); m1 = __builtin_fmaxf(__builtin_fmaxf(m1, s1[3]), s1[4]);
          m0 = __builtin_fmaxf(__builtin_fmaxf(m0, s0[5]), s0[6]); m1 = __builtin_fmaxf(__builtin_fmaxf(m1, s1[5]), s1[6]);
          m0 = __builtin_fmaxf(__builtin_fmaxf(m0, s0[7]), s0[8]); m1 = __builtin_fmaxf(__builtin_fmaxf(m1, s1[7]), s1[8]);
          m0 = __builtin_fmaxf(__builtin_fmaxf(m0, s0[9]), s0[10]); m1 = __builtin_fmaxf(__builtin_fmaxf(m1, s1[9]), s1[10]);
          m0 = __builtin_fmaxf(__builtin_fmaxf(m0, s0[11]), s0[12]); m1 = __builtin_fmaxf(__builtin_fmaxf(m1, s1[11]), s1[12]);
          m0 = __builtin_fmaxf(__builtin_fmaxf(m0, s0[13]), s0[14]); m1 = __builtin_fmaxf(__builtin_fmaxf(m1, s1[13]), s1[14]);
          mx = __builtin_fmaxf(__builtin_fmaxf(m0, s0[15]), __builtin_fmaxf(m1, s1[15])); }
        if (t == 0 || __any(mx > 8.0f)) {
            const float rm = fmaxf(mx, __shfl_xor(mx, 32));
            const float delta = (t == 0) ? rm : fmaxf(rm, 0.f);
            const float alpha = (t == 0) ? 1.0f : __builtin_amdgcn_exp2f(-delta);
            mrun += delta;
#pragma unroll
            for (int r = 0; r < 16; ++r) { s0[r] -= delta; s1[r] -= delta; o0[r] *= alpha; o1[r] *= alpha; }
            lsum *= alpha;
        }
        { float ls0 = 0.f, ls1 = 0.f;
#pragma unroll
          for (int r = 0; r < 16; ++r) { s0[r] = __builtin_amdgcn_exp2f(s0[r]); s1[r] = __builtin_amdgcn_exp2f(s1[r]); ls0 += s0[r]; ls1 += s1[r]; }
          lsum += ls0 + ls1; }
#pragma unroll
        for (int kj = 0; kj < 4; ++kj) { const f32x16& sv = kj < 2 ? s0 : s1; const int jp = kj & 1;
            const bf16x8 pb = pack8(sv[8 * jp + 0], sv[8 * jp + 1], sv[8 * jp + 2], sv[8 * jp + 3], sv[8 * jp + 4], sv[8 * jp + 5], sv[8 * jp + 6], sv[8 * jp + 7]);
            const bf16x8 A0 = __builtin_bit_cast(bf16x8, (u32x4){vfr[4 * kj].x, vfr[4 * kj].y, vfr[4 * kj + 1].x, vfr[4 * kj + 1].y});
            const bf16x8 A1 = __builtin_bit_cast(bf16x8, (u32x4){vfr[4 * kj + 2].x, vfr[4 * kj + 2].y, vfr[4 * kj + 3].x, vfr[4 * kj + 3].y});
            o0 = __builtin_amdgcn_mfma_f32_32x32x16_bf16(A0, pb, o0, 0, 0, 0); o1 = __builtin_amdgcn_mfma_f32_32x32x16_bf16(A1, pb, o1, 0, 0, 0); }
        if (more) AT_LSTORE(nbuf);
        __syncthreads();
    }
    lsum += __shfl_xor(lsum, 32);
    const float inv = 1.0f / lsum;
    bf16_t* op = MIX + (size_t)qrow * 1024 + 256 + h * 64 + 4 * hi;
#pragma unroll
    for (int g4 = 0; g4 < 4; ++g4) { u32x2 w0, w1; w0.x = pk2(o0[4 * g4] * inv, o0[4 * g4 + 1] * inv); w0.y = pk2(o0[4 * g4 + 2] * inv, o0[4 * g4 + 3] * inv);
        w1.x = pk2(o1[4 * g4] * inv, o1[4 * g4 + 1] * inv); w1.y = pk2(o1[4 * g4 + 2] * inv, o1[4 * g4 + 3] * inv);
        *(u32x2*)(op + 8 * g4) = w0; *(u32x2*)(op + 32 + 8 * g4) = w1; }
#undef AT_GLOAD
#undef AT_LSTORE1
#undef AT_LSTORE
}

constexpr int RT_VP = 264, RT_SP = 144, RT_VB = 2 * 64 * RT_VP;
DEV void retout_unit(const Params& p, int l, unsigned char* lds, int u) {
    const int tid = otid(), lane = tid & 63, wid = tid >> 6, l32 = lane & 31, hi = lane >> 5;
    const int gc = u >> 1, hp = u & 1; const int cb = gc % 66; const bool lat = cb >= 2; const int t0 = (cb - 2) * 128; const int r0 = gc * 128;
    const bf16_t* P = (const bf16_t*)p.out; bf16_t* MIX = (bf16_t*)(p.ws + OFF_HN); const f32x2* rope = (const f32x2*)(p.ws + OFF_ROPE);
    const float* SIN = (const float*)(p.ws + OFF_OV + OV_SIN);
    bf16_t* VTl = (bf16_t*)lds; bf16_t* STl = (bf16_t*)(lds + RT_VB);
    __syncthreads();
    for (int task = tid; task < 2048; task += NWG_T) { const int hh = task >> 10, key = (task >> 3) & 127, ch = task & 7;
        const bf16x8 v = *(const bf16x8*)(P + (size_t)(r0 + key) * INW + 256 + (2 * hp + hh) * 64 + ch * 8);
#pragma unroll
        for (int j = 0; j < 8; ++j) VTl[(hh * 64 + ch * 8 + j) * (RT_VP / 2) + key] = (bf16_t)v[j]; }
    for (int task = tid; task < 8192; task += NWG_T) { const int dv = task & 63, k = (task >> 6) & 31, dir = (task >> 11) & 1, hh = task >> 12;
        STl[(hh * 64 + dv) * (RT_SP / 2) + dir * 32 + k] = (bf16_t)f2bf(SIN[((size_t)(gc * 4 + 2 * hp + hh) * 2 + dir) * 2048 + k * 64 + dv]); }
    __syncthreads();
    const int hh = wid >> 2, h = 2 * hp + hh, qblk = wid & 3; const int n = 32 * qblk + l32; const int rq = r0 + n;
    const float lf = log2_sigmoid(p.ret_decay_f[l * 4 + h]), lb = log2_sigmoid(p.ret_decay_b[l * 4 + h]);
    float qv0[8], qv1[8]; bf16x8 qf0, qf1;
    { const bf16_t* qp = P + (size_t)rq * INW + h * 32 + 8 * hi; const bf16x8 a = *(const bf16x8*)qp, c2 = *(const bf16x8*)(qp + 16);
#pragma unroll
      for (int j = 0; j < 8; ++j) { float x1 = bf2f((unsigned short)a[j]), x2 = bf2f((unsigned short)c2[j]);
          if (lat) { const f32x2 cs = rope[(size_t)(t0 + n) * 16 + 8 * hi + j]; const float y1 = x1 * cs.x - x2 * cs.y, y2 = x2 * cs.x + x1 * cs.y; x1 = y1; x2 = y2; }
          qv0[j] = x1; qv1[j] = x2; }
      qf0 = pack8(qv0[0], qv0[1], qv0[2], qv0[3], qv0[4], qv0[5], qv0[6], qv0[7]); qf1 = pack8(qv1[0], qv1[1], qv1[2], qv1[3], qv1[4], qv1[5], qv1[6], qv1[7]); }
    f32x16 o0, o1;
#pragma unroll
    for (int r = 0; r < 16; ++r) { o0[r] = 0.f; o1[r] = 0.f; }
    const unsigned char* vbase = (const unsigned char*)VTl + (size_t)(hh * 64 + l32) * RT_VP + hi * 8;
#pragma unroll
    for (int kb = 0; kb < 4; ++kb) {
        bf16x8 kf0, kf1;
        { const int key = 32 * kb + l32; const bf16_t* kp = P + (size_t)(r0 + key) * INW + 128 + h * 32 + 8 * hi; const bf16x8 a = *(const bf16x8*)kp, c2 = *(const bf16x8*)(kp + 16);
          float y1[8], y2[8];
#pragma unroll
          for (int j = 0; j < 8; ++j) { float x1 = bf2f((unsigned short)a[j]), x2 = bf2f((unsigned short)c2[j]);
              if (lat) { const f32x2 cs = rope[(size_t)(t0 + key) * 16 + 8 * hi + j]; const float z1 = x1 * cs.x - x2 * cs.y, z2 = x2 * cs.x + x1 * cs.y; x1 = z1; x2 = z2; }
              y1[j] = x1 * 0.17677669529663687f; y2[j] = x2 * 0.17677669529663687f; }
          kf0 = pack8(y1[0], y1[1], y1[2], y1[3], y1[4], y1[5], y1[6], y1[7]); kf1 = pack8(y2[0], y2[1], y2[2], y2[3], y2[4], y2[5], y2[6], y2[7]); }
        f32x16 s;
#pragma unroll
        for (int r = 0; r < 16; ++r) s[r] = 0.f;
        s = __builtin_amdgcn_mfma_f32_32x32x16_bf16(kf0, qf0, s, 0, 0, 0); s = __builtin_amdgcn_mfma_f32_32x32x16_bf16(kf1, qf1, s, 0, 0, 0);
#pragma unroll
        for (int r = 0; r < 16; ++r) { const int m = 32 * kb + crow(r, hi); const int dl = n - m; const float e = dl >= 0 ? lf * (float)dl : lb * (float)(-dl); s[r] *= __builtin_amdgcn_exp2f(e); }
#pragma unroll
        for (int jp = 0; jp < 2; ++jp) { const bf16x8 pb = pack8(s[8 * jp + 0], s[8 * jp + 1], s[8 * jp + 2], s[8 * jp + 3], s[8 * jp + 4], s[8 * jp + 5], s[8 * jp + 6], s[8 * jp + 7]);
            const unsigned char* vp = vbase + (32 * kb + 16 * jp) * 2;
            const u32x2 a00 = *(const u32x2*)vp, a01 = *(const u32x2*)(vp + 16), a10 = *(const u32x2*)(vp + 32 * RT_VP), a11 = *(const u32x2*)(vp + 32 * RT_VP + 16);
            const bf16x8 A0 = __builtin_bit_cast(bf16x8, (u32x4){a00.x, a00.y, a01.x, a01.y}), A1 = __builtin_bit_cast(bf16x8, (u32x4){a10.x, a10.y, a11.x, a11.y});
            o0 = __builtin_amdgcn_mfma_f32_32x32x16_bf16(A0, pb, o0, 0, 0, 0); o1 = __builtin_amdgcn_mfma_f32_32x32x16_bf16(A1, pb, o1, 0, 0, 0); }
    }
    { const float df = __builtin_amdgcn_exp2f(lf * (float)(n + 1)), db = __builtin_amdgcn_exp2f(lb * (float)(128 - n));
      const unsigned char* sbase = (const unsigned char*)STl + (size_t)(hh * 64 + l32) * RT_SP + hi * 16;
#pragma unroll
      for (int ks = 0; ks < 4; ++ks) { const float dd = ks < 2 ? df : db;
          const bf16x8 qb = (ks & 1) ? pack8(qv1[0] * dd, qv1[1] * dd, qv1[2] * dd, qv1[3] * dd, qv1[4] * dd, qv1[5] * dd, qv1[6] * dd, qv1[7] * dd)
                                     : pack8(qv0[0] * dd, qv0[1] * dd, qv0[2] * dd, qv0[3] * dd, qv0[4] * dd, qv0[5] * dd, qv0[6] * dd, qv0[7] * dd);
          const bf16x8 A0 = *(const bf16x8*)(sbase + ks * 32), A1 = *(const bf16x8*)(sbase + 32 * RT_SP + ks * 32);
          o0 = __builtin_amdgcn_mfma_f32_32x32x16_bf16(A0, qb, o0, 0, 0, 0); o1 = __builtin_amdgcn_mfma_f32_32x32x16_bf16(A1, qb, o1, 0, 0, 0); } }
    float ssq = 0.f;
#pragma unroll
    for (int r = 0; r < 16; ++r) ssq += o0[r] * o0[r] + o1[r] * o1[r];
    ssq += __shfl_xor(ssq, 32);
    const float rstd = rsqrtf(ssq * (1.f / 64.f) + EPS);
    const bf16_t* gp = P + (size_t)rq * INW + 512 + h * 64 + 4 * hi; bf16_t* op = MIX + (size_t)rq * 1024 + h * 64 + 4 * hi;
#pragma unroll
    for (int g4 = 0; g4 < 4; ++g4) { const u32x2 ga = *(const u32x2*)(gp + 8 * g4), gb = *(const u32x2*)(gp + 32 + 8 * g4);
        u32x2 w0, w1;
        w0.x = pk2(o0[4 * g4] * rstd * siluf(bf2f(ga.x & 0xffff)), o0[4 * g4 + 1] * rstd * siluf(bf2f(ga.x >> 16))); w0.y = pk2(o0[4 * g4 + 2] * rstd * siluf(bf2f(ga.y & 0xffff)), o0[4 * g4 + 3] * rstd * siluf(bf2f(ga.y >> 16)));
        w1.x = pk2(o1[4 * g4] * rstd * siluf(bf2f(gb.x & 0xffff)), o1[4 * g4 + 1] * rstd * siluf(bf2f(gb.x >> 16))); w1.y = pk2(o1[4 * g4 + 2] * rstd * siluf(bf2f(gb.y & 0xffff)), o1[4 * g4 + 3] * rstd * siluf(bf2f(gb.y >> 16)));
        *(u32x2*)(op + 8 * g4) = w0; *(u32x2*)(op + 32 + 8 * g4) = w1; }
}

DEV void phase_convact(const Params& p, int l, int hf) {
    const bf16_t* U = (const bf16_t*)(p.ws + OFF_OV + OV_U); bf16_t* ACT = (bf16_t*)p.out;
    const float* cw = p.conv_w + (size_t)l * 3 * 5632; const float* cbv = p.conv_b + (size_t)l * 5632;
    const bf16x8 z = {0, 0, 0, 0, 0, 0, 0, 0};
    for (int idx = blockIdx.x * NWG_T + otid(); idx < 176 * 528; idx += gridDim.x * NWG_T) {
        const int rc = idx / 176, j8 = idx - rc * 176; const int r0 = rc * 32; const int b = r0 / RB, s0 = r0 - b * RB;
        if (l == 1 && s0 < NCTX) continue;
        const int ca = hf * HFF + j8 * 8, cbc = DFF + hf * HFF + j8 * 8;
        f32x4 wa[3][2], wb[3][2], ba[2], bb[2];
#pragma unroll
        for (int k = 0; k < 3; ++k)
#pragma unroll
            for (int q = 0; q < 2; ++q) { wa[k][q] = *(const f32x4*)(cw + k * 5632 + ca + 4 * q); wb[k][q] = *(const f32x4*)(cw + k * 5632 + cbc + 4 * q); }
#pragma unroll
        for (int q = 0; q < 2; ++q) { ba[q] = *(const f32x4*)(cbv + ca + 4 * q); bb[q] = *(const f32x4*)(cbv + cbc + 4 * q); }
        const bool first = (s0 == 0) || (s0 == NCTX); const bool lastc = (s0 + 32 == NCTX) || (s0 + 32 == RB);
        const bf16_t* ur = U + (size_t)r0 * DFF + j8 * 8;
        bf16x8 pa = first ? z : *(const bf16x8*)(ur - DFF), pb = first ? z : *(const bf16x8*)(ur - DFF + HFF);
        bf16x8 ca8 = *(const bf16x8*)ur, cb8 = *(const bf16x8*)(ur + HFF);
        bf16x8 na = *(const bf16x8*)(ur + DFF), nb = *(const bf16x8*)(ur + DFF + HFF);
        for (int i = 0; i < 32; ++i) {
            bf16x8 fa = z, fb = z;
            if (i + 2 < 32 || !lastc) { fa = *(const bf16x8*)(ur + (size_t)(i + 2) * DFF); fb = *(const bf16x8*)(ur + (size_t)(i + 2) * DFF + HFF); }
            if (i + 1 == 32 && lastc) { na = z; nb = z; }
            float o[8];
#pragma unroll
            for (int j = 0; j < 8; ++j) { const int q = j >> 2, e = j & 3;
                const float ua = bf2f((unsigned short)pa[j]) * wa[0][q][e] + bf2f((unsigned short)ca8[j]) * wa[1][q][e] + bf2f((unsigned short)na[j]) * wa[2][q][e] + ba[q][e];
                const float ub = bf2f((unsigned short)pb[j]) * wb[0][q][e] + bf2f((unsigned short)cb8[j]) * wb[1][q][e] + bf2f((unsigned short)nb[j]) * wb[2][q][e] + bb[q][e];
                o[j] = siluf(ua) * ub; }
            *(bf16x8*)(ACT + (size_t)(r0 + i) * HFF + j8 * 8) = pack8(o[0], o[1], o[2], o[3], o[4], o[5], o[6], o[7]);
            pa = ca8; pb = cb8; ca8 = na; cb8 = nb; na = fa; nb = fb; }
    }
}

#define RLX_AGENT __ATOMIC_RELAXED, __HIP_MEMORY_SCOPE_AGENT
#define XB_TMO      128
#define XB_XCNT(j)  (256  + 64 * (j))
#define XB_XSUB(j)  (1280 + 64 * (j))
#define XB_XGEN(j)  (2304 + 64 * (j))
#define XB_TOP      3328
#define XB_TOPGEN   3392
#define XCD_BAR_WORDS 3456
#define XB_SPIN_CAP (1u << 18)

__device__ __forceinline__ unsigned xb_ld(unsigned* p)              { return __hip_atomic_load(p, __ATOMIC_RELAXED, __HIP_MEMORY_SCOPE_AGENT); }
__device__ __forceinline__ unsigned xb_add(unsigned* p, unsigned v) { return __hip_atomic_fetch_add(p, v, __ATOMIC_RELAXED, __HIP_MEMORY_SCOPE_AGENT); }
__device__ __forceinline__ unsigned xb_xcc_id() { return (unsigned)__builtin_amdgcn_s_getreg((3 << 11) | 20) & 0xFu; }
#define XB_SPIN(cond, bar) do { unsigned _sp = 0; while (cond) { __builtin_amdgcn_s_sleep(1); \
    if ((++_sp & 255u) == 0u) { if (xb_ld(&(bar)[XB_TMO])) break; if (_sp > XB_SPIN_CAP) { atomicAdd(&(bar)[XB_TMO], 1u); break; } } } } while (0)

struct XcdBarrier {
    unsigned* bar; unsigned x;
    volatile LAS unsigned* st;
};

__device__ __forceinline__ XcdBarrier xcd_barrier_post(unsigned* bar, volatile LAS unsigned* st) {
    XcdBarrier b; b.bar = bar; b.x = xb_xcc_id(); b.st = st;
    if (threadIdx.x == 0) (void)xb_add(&bar[XB_XCNT(b.x)], 1u);
    return b;
}
__device__ __forceinline__ void xcd_barrier_complete(unsigned* bar, unsigned x, unsigned& nloc, unsigned& nx) {
    const unsigned G = gridDim.x * gridDim.y * gridDim.z;
    unsigned sum, cnt, mine, sp = 0u;
    for (;;) {
        sum = 0u; cnt = 0u; mine = 0u;
#pragma unroll
        for (unsigned j = 0; j < 16; ++j) { const unsigned c = xb_ld(&bar[XB_XCNT(j)]); sum += c; cnt += (c > 0u) ? 1u : 0u; mine = (j == x) ? c : mine; }
        if (sum == G) break;
        __builtin_amdgcn_s_sleep(1);
        if ((++sp & 255u) == 0u) { if (xb_ld(&bar[XB_TMO])) break; if (sp > XB_SPIN_CAP) { atomicAdd(&bar[XB_TMO], 1u); break; } }
    }
    nloc = mine > 0u ? mine : 1u; nx = cnt > 0u ? cnt : 1u;
}

__device__ __forceinline__ void xcd_barrier(const XcdBarrier& b) {
    asm volatile("s_waitcnt vmcnt(0)" ::: "memory");
    __syncthreads();
    if (threadIdx.x == 0) {
        unsigned* bar = b.bar;
        __builtin_amdgcn_s_waitcnt(0);
        unsigned nloc = b.st[0], nx = b.st[1];
        if (nloc == 0u) { xcd_barrier_complete(bar, b.x, nloc, nx); b.st[0] = nloc; b.st[1] = nx; }
        const unsigned old = xb_add(&bar[XB_XSUB(b.x)], 1u);
        const unsigned gen = old / nloc;
        if (old + 1u == (gen + 1u) * nloc) {
            __builtin_amdgcn_fence(__ATOMIC_RELEASE, "agent");
            asm volatile("s_waitcnt vmcnt(0)" ::: "memory");
            const unsigned og = xb_add(&bar[XB_TOP], 1u);
            const unsigned tg = og / nx;
            if (og + 1u == (tg + 1u) * nx) xb_add(&bar[XB_TOPGEN], 1u);
            else XB_SPIN(xb_ld(&bar[XB_TOPGEN]) == tg, bar);
            __builtin_amdgcn_fence(__ATOMIC_ACQUIRE, "agent");
            xb_add(&bar[XB_XGEN(b.x)], 1u);
            asm volatile("s_waitcnt vmcnt(0)" ::: "memory");
        } else {
            XB_SPIN(xb_ld(&bar[XB_XGEN(b.x)]) == gen, bar);
            __builtin_amdgcn_fence(__ATOMIC_ACQUIRE, "agent");
            asm volatile("s_waitcnt vmcnt(0)" ::: "memory");
        }
    }
    __syncthreads();
}


constexpr size_t OFF_CTL = 250000128; constexpr int CTL_BYTES = 16384;
#if defined(__HIP_DEVICE_COMPILE__)
#define KP() const __attribute__((address_space(4))) Params* kp_ = (const __attribute__((address_space(4))) Params*)__builtin_amdgcn_kernarg_segment_ptr(); asm volatile("" : "+s"(kp_)); const Params p = *kp_; \
    bf16_t* HN = (bf16_t*)(p.ws + OFF_HN); bf16_t* P = (bf16_t*)p.out; float* X = (float*)(p.ws + OFF_X); (void)HN; (void)P; (void)X
#else
#define KP() const Params p = p_arg; bf16_t* HN = (bf16_t*)(p.ws + OFF_HN); bf16_t* P = (bf16_t*)p.out; float* X = (float*)(p.ws + OFF_X); (void)HN; (void)P; (void)X
#endif
#define WL() const bf16_t* wl = (const bf16_t*)(p.ws + OFF_W) + (size_t)l * W_LAYER; const float* modv = (const float*)(p.ws + OFF_MOD) + (size_t)l * 3 * 6144; (void)wl; (void)modv
#ifndef DUPM
#define DUPM 0
#endif
#define REP(bit) for (int rep_ = 0; rep_ < (((DUPM) >> (bit)) & 1) + 1; ++rep_)
constexpr int PH_PER_LAYER = 12, N_PHASES = 2 + 2 * PH_PER_LAYER;
__global__ void __launch_bounds__(512, 2) mk_fwd(Params p_arg) {
    extern __shared__ __attribute__((aligned(16))) unsigned char lds[];
    cg::grid_group grid = cg::this_grid();
    const int G = gridDim.x, bx = blockIdx.x; const int vcu = (G % 8 == 0) ? (bx % 8) * (G / 8) + bx / 8 : bx;
    LAS unsigned char* ldsl = (LAS unsigned char*)lds;
    const int ph_lo = p_arg.ph_lo, ph_hi = p_arg.ph_hi;
    volatile LAS unsigned* misc = (volatile LAS unsigned*)(ldsl + (LDS_BYTES - 64));
    { const int t0_ = otid(); if (t0_ < 16) misc[t0_] = 0u; }
    __syncthreads();
    if (ph_hi - ph_lo > 1) (void)xcd_barrier_post((unsigned*)(p_arg.ws + OFF_CTL), misc);
    for (int ph = ph_lo; ph < ph_hi; ++ph) {
        if (ph == 0) { KP(); REP(9) { phase_prep(p, lds); __syncthreads(); } }
        else if (ph == N_PHASES - 1) { KP(); REP(0) phase_final(p);
#if (DUPM >> 10) & 1
            for (int i = 0; i < 20; ++i) grid.sync();
#endif
        }
        else {
            const int l = (ph - 1) / PH_PER_LAYER, sp = (ph - 1) % PH_PER_LAYER;
            if (sp == 0) { KP(); REP(0) phase_norm(p, l, 0, l == 0); }
            else if (sp == 1) { KP(); WL(); REP(1) { __syncthreads();
                pg8::Gemm g{HN, wl + W_IN, R, 1792, 1024, 1024, 1024}; pg8::StaticOrder S; S.init(R, 1792, G, bx);
                pg8::EpiStore E{P, INW, INW, 1.0f};
                pg8::gemm_phase<pg8::EpiStore, pg8::StaticOrder, true, true>(ldsl, g, S, E); } }
            else if (sp == 2) { KP(); phase_rowwise(p, l); __syncthreads();
                REP(2) phase_pool(p);
                REP(3) for (int it = bx; it < 528; it += G) states_item(p, l, lds, it); }
            else if (sp == 3) { KP(); WL(); REP(4) { __syncthreads();
                { pg8::Gemm g{P + 768, wl + W_UQ, R, 768, 384, INW, 384}; pg8::StaticOrder S; S.init(R, 768, G, bx);
                  pg8::EpiStore E{(bf16_t*)(p.ws + OFF_OV + OV_Q), 768, 768, 0.14724444f};
                  pg8::gemm_phase<pg8::EpiStore, pg8::StaticOrder, true, true>(ldsl, g, S, E); }
                __syncthreads();
                { pg8::Gemm g{P + 1152, wl + W_KN, R, 512, 256, INW, 256}; pg8::StaticOrder S; S.init(R, 512, G, (bx + 58) % G);
                  pg8::EpiStore E{(bf16_t*)(p.ws + OFF_OV + OV_KN), 512, 512, 1.0f};
                  pg8::gemm_phase<pg8::EpiStore, pg8::StaticOrder, true, true>(ldsl, g, S, E); }
                __syncthreads();
                { pg8::Gemm g{wl + W_V, P + 1152, 512, R, 256, 256, INW}; pg8::StaticOrder S; S.init(512, R, G, (bx + 182) % G);
                  pg8::EpiStore E{(bf16_t*)(p.ws + OFF_OV + OV_VT), R, R, 1.0f};
                  pg8::gemm_phase<pg8::EpiStore, pg8::StaticOrder, true, true>(ldsl, g, S, E); }
                if (bx >= G - 64) scan_threads(p, l, (bx - (G - 64)) * NWG_T + otid()); } }
            else if (sp == 4) { KP();
                REP(5) for (int u = vcu; u < 528; u += G) attn_unit(p, lds, u);
                REP(6) for (int u = G - 1 - bx; u < 264; u += G) retout_unit(p, l, lds, u); }
            else if (sp == 5) { KP(); WL(); __syncthreads();
                pg8::Gemm g{HN, wl + W_OUT, R, 1024, 1024, 1024, 1024}; pg8::StaticOrder S; S.init(l == 1 ? 16384 : R, 1024, G, bx, l == 1 ? 1 : 0);
                pg8::EpiResid E{X, modv + 2048, 0};
                pg8::gemm_phase<pg8::EpiResid, pg8::StaticOrder, true, true>(ldsl, g, S, E); }
            else if (sp == 6) { KP(); REP(0) phase_norm(p, l, 1, false); }
            else if (sp == 7 || sp == 9 || sp == 11) { KP(); WL();
                __syncthreads();
                if (sp >= 9) { const int hf = sp == 9 ? 0 : 1;
                    pg8::Gemm g{P, wl + W_DN + hf * HFF, R, 1024, HFF, HFF, DFF}; pg8::StaticOrder S; S.init(l == 1 ? 16384 : R, 1024, G, bx, l == 1 ? 1 : 0);
                    pg8::EpiResid E{X, modv + 5120, 0};
                    pg8::gemm_phase<pg8::EpiResid, pg8::StaticOrder, true, true>(ldsl, g, S, E); __syncthreads(); }
                if (sp <= 9) REP(7) { __syncthreads(); const int hf = sp == 7 ? 0 : 1;
                    pg8::Gemm g{HN, wl + W_UP + (size_t)hf * DFF * 1024, R, DFF, 1024, 1024, 1024}; pg8::StaticOrder S; S.init(l == 1 ? 16384 : R, DFF, G, (bx + (sp == 9 && l == 0 ? 8 : 0)) % G, l == 1 ? 1 : 0);
                    pg8::EpiStore E{(bf16_t*)(p.ws + OFF_OV + OV_U), DFF, DFF, 1.0f};
                    pg8::gemm_phase<pg8::EpiStore, pg8::StaticOrder, true, true>(ldsl, g, S, E); } }
            else if (sp == 8) { KP(); REP(8) phase_convact(p, l, 0); }
            else if (sp == 10) { KP(); REP(8) phase_convact(p, l, 1); }
        }
        if (ph + 1 < ph_hi) {
            if (ph == ph_lo) grid.sync();
            else { KP(); XcdBarrier b; b.bar = (unsigned*)(p.ws + OFF_CTL); b.x = xb_xcc_id(); b.st = misc; xcd_barrier(b); }
        }
    }
}

extern "C" void kernel_launch(void* const* d_in, const int* in_sizes, int n_in, void* d_out, int out_size, void* d_ws, size_t ws_size, hipStream_t stream) {
    static int grid = 0;
    if (grid == 0) {
        if (n_in != 23 || ws_size < WS_NEED) { fprintf(stderr, "kernel_launch: unexpected problem (n_in %d, ws %zu, need %zu)\n", n_in, ws_size, (size_t)WS_NEED); grid = -1; return; }
        int dev = 0, cus = 0, per_cu = 0;
        hipGetDevice(&dev); hipDeviceGetAttribute(&cus, hipDeviceAttributeMultiprocessorCount, dev);
        if (hipFuncSetAttribute((const void*)mk_fwd, hipFuncAttributeMaxDynamicSharedMemorySize, LDS_BYTES) != hipSuccess) { fprintf(stderr, "kernel_launch: hipFuncSetAttribute failed\n"); grid = -1; return; }
        if (hipOccupancyMaxActiveBlocksPerMultiprocessor(&per_cu, (const void*)mk_fwd, 512, LDS_BYTES) != hipSuccess || per_cu < 1) { fprintf(stderr, "kernel_launch: occupancy query says %d\n", per_cu); per_cu = 1; }
        (void)hipGetLastError();
        grid = cus * per_cu; if (grid > 256) grid = 256;
        fprintf(stderr, "kernel_launch: grid %d (cus %d, per_cu %d)\n", grid, cus, per_cu);
    }
    if (grid < 0) return;
    Params p{};
    const float** pp = (const float**)&p;
    for (int i = 0; i < 23; ++i) pp[i] = (const float*)d_in[i];
    p.out = (float*)d_out; p.ws = (unsigned char*)d_ws;
#if MK_MULTI
    for (int ph = 0; ph < N_PHASES; ++ph) { p.ph_lo = ph; p.ph_hi = ph + 1; void* args[] = {&p};
        hipError_t e = hipLaunchCooperativeKernel((void*)mk_fwd, dim3(grid), dim3(512), args, LDS_BYTES, stream);
        if (e != hipSuccess) { fprintf(stderr, "launch %d failed: %s\n", ph, hipGetErrorString(e)); break; } }
#else
    if (hipMemsetAsync((char*)d_ws + OFF_CTL, 0, CTL_BYTES, stream) != hipSuccess) { fprintf(stderr, "kernel_launch: memset of the barrier words failed\n"); return; }
    p.ph_lo = 0; p.ph_hi = N_PHASES; void* args[] = {&p};
    hipError_t e = hipLaunchCooperativeKernel((void*)mk_fwd, dim3(grid), dim3(512), args, LDS_BYTES, stream);
    if (e != hipSuccess) fprintf(stderr, "cooperative launch failed: %s (grid %d)\n", hipGetErrorString(e), grid);
#endif
}
```

```cpp
#include <hip/hip_runtime.h>
#include <hip/hip_cooperative_groups.h>
#include <cstdio>
#include <cstdint>
namespace cg = cooperative_groups;

#ifndef MK_MULTI
#define MK_MULTI 0
#endif

namespace pg8 {
#define PG8_LAS __attribute__((address_space(3)))
typedef unsigned short bf16_t;
typedef short bf16x8 __attribute__((ext_vector_type(8)));
typedef float f32x4 __attribute__((ext_vector_type(4)));
typedef unsigned u32x4 __attribute__((ext_vector_type(4)));
constexpr int BM = 256, BK = 64, HALF = 128, HTB = HALF * BK * 2  , STAGE_BYTES = 8 * HTB, NXCD = 8, WGM = 8;

__host__ __device__ __forceinline__ int lds_byte(int r, int c) { const int st = (r >> 4) * 2 + (c >> 5), rr = r & 15, cc = c & 31, ob = rr * 64 + cc * 2; return st * 1024 + (ob ^ (((ob >> 9) & 1) << 5)); }
__host__ __device__ __forceinline__ void stage_rc(int b, int& R, int& C) { const int st = b / 1024, sb = b % 1024, swz = sb ^ (((sb >> 9) & 1) << 5); R = (st >> 1) * 16 + swz / 64; C = (st & 1) * 32 + (swz % 64) / 2; }
__host__ __device__ __forceinline__ int perm32(int rho) { const int n = rho >> 4, i = rho & 15; return 8 * (i >> 2) + 4 * n + (i & 3); }

struct Unit { int pm, pn; };
struct Gemm { const bf16_t* A; const bf16_t* Bt; int M, N, K, lda, ldb; };

struct StaticOrder {
    int nM, nN, nwg, G, c, skip;
    __host__ __device__ void init(int M, int N, int G_, int c_, int skip_ = 0) { nM = M / BM; nN = N / BM; nwg = nM * nN; G = G_; c = c_; skip = skip_; }
    __host__ __device__ bool next(int i, Unit& u) const {
        const long L = (long)i * G + c; if (L >= nwg) return false;
        int wgid = (int)L; { const int q = nwg / NXCD, r = nwg % NXCD, xcd = wgid % NXCD, off = wgid / NXCD; wgid = (xcd < r ? xcd * (q + 1) : r * (q + 1) + (xcd - r) * q) + off; }
        const int nig = WGM * nN, gid = wgid / nig, fm = gid * WGM, gsz = (nM - fm) < WGM ? (nM - fm) : WGM;
        u.pm = fm + ((wgid % nig) % gsz); u.pn = (wgid % nig) / gsz; if (skip) u.pm += 1 + (u.pm >= 32 ? 1 : 0); return true;
    }
    __device__ __forceinline__ void a_ready(const Unit&) const {}
    __device__ __forceinline__ void done(const Unit&) const {}
};

__device__ __forceinline__ unsigned cvt_pk_bf16(float lo, float hi) { unsigned r; asm volatile("v_cvt_pk_bf16_f32 %0, %1, %2" : "=v"(r) : "v"(lo), "v"(hi)); return r; }

struct EpiStore {
    static constexpr bool PERM = true, AFTER_DRAIN = false;
    bf16_t* O; int ldc; int ncols; float scale;
    __device__ __forceinline__ void operator()(const f32x4 (&acc)[2][2][4][2], const Unit& u, int wr, int wc, int fr, int fq) const {
        const int row0 = u.pm * BM + wr * 64 + fr; const int col0 = u.pn * BM + wc * 32 + 8 * fq;
#pragma unroll
        for (int ai = 0; ai < 2; ++ai)
#pragma unroll
            for (int m = 0; m < 4; ++m) { bf16_t* rowp = O + (size_t)(row0 + ai * HALF + m * 16) * ldc + col0;
#pragma unroll
                for (int bj = 0; bj < 2; ++bj) { if (col0 + bj * HALF < ncols) {
                    f32x4 v0 = acc[ai][bj][m][0] * scale, v1 = acc[ai][bj][m][1] * scale;
                    u32x4 w; w.x = cvt_pk_bf16(v0[0], v0[1]); w.y = cvt_pk_bf16(v0[2], v0[3]); w.z = cvt_pk_bf16(v1[0], v1[1]); w.w = cvt_pk_bf16(v1[2], v1[3]);
                    *(u32x4*)(rowp + bj * HALF) = w; } } }
    }
};
struct EpiResid {
    static constexpr bool PERM = false, AFTER_DRAIN = false;
    float* X; const float* gate; int row_tile0;
    __device__ __forceinline__ void operator()(const f32x4 (&acc)[2][2][4][2], const Unit& u, int wr, int wc, int fr, int fq) const {
        const int tpm = u.pm + row_tile0; const int bb = tpm / 33, jj = tpm - bb * 33; const float* gv = gate + (jj == 0 ? 2 : bb) * 6144;
        const int col0 = u.pn * BM + wc * 32 + 4 * fq;
#pragma unroll
        for (int ai = 0; ai < 2; ++ai)
#pragma unroll
            for (int m = 0; m < 4; ++m) { float* rowp = X + (size_t)(tpm * BM + ai * HALF + wr * 64 + m * 16 + fr) * 1024 + col0;
#pragma unroll
                for (int bj = 0; bj < 2; ++bj) {
#pragma unroll
                    for (int n = 0; n < 2; ++n) { f32x4* q = (f32x4*)(rowp + bj * HALF + n * 16); const f32x4 gq = *(const f32x4*)(gv + col0 + bj * HALF + n * 16); f32x4 xv = *q; xv = xv + gq * acc[ai][bj][m][n]; *q = xv; }
                    asm volatile("" ::: "memory"); } }
    }
};

template <class Epi, class Sched, bool ALIGN_EPI = false, bool SP2 = false>
__device__ __forceinline__ void gemm_phase(PG8_LAS unsigned char* lds, const Gemm g, const Sched& S, const Epi& E) {
    int tid = threadIdx.x; asm volatile("" : "+v"(tid));
    const int wid = __builtin_amdgcn_readfirstlane(tid >> 6), lane = tid & 63, wr = wid >> 2, wc = wid & 3, fr = lane & 15, fq = lane >> 4;
    int K = g.K; asm volatile("" : "+s"(K));
    const int nt = K / BK;
    unsigned voffA[2], voffB[2];
#pragma unroll
    for (int i = 0; i < 2; ++i) { int R, C; stage_rc(tid * 16 + i * 8192, R, C); const int Rb = Epi::PERM ? ((R & ~31) + perm32(R & 31)) : R;
        voffA[i] = (unsigned)(R * g.lda + C) * 2u; voffB[i] = (unsigned)(Rb * g.ldb + C) * 2u; }
    const size_t kstep = (size_t)(BK * 2);
    const size_t hstepA = (size_t)HALF * g.lda * 2, hstepB = (size_t)HALF * g.ldb * 2;
    const size_t tstepA = 2 * hstepA, tstepB = 2 * hstepB;
    const unsigned ldsw = (unsigned)wid * 1024u;
    const int aoff = lds_byte(wr * 64 + fr, fq * 8), boff = lds_byte(wc * 32 + fr, fq * 8);
#define PG8_SA(b, h) (((b) * 2 + (h)) * HTB)
#define PG8_SB(b, h) ((4 + (b) * 2 + (h)) * HTB)
#define PG8_STAGE(bufoff, gbase, voff) do { _Pragma("unroll") for (int _i = 0; _i < 2; ++_i) \
        __builtin_amdgcn_global_load_lds((const unsigned*)((const char*)(gbase) + (voff)[_i]), (PG8_LAS unsigned*)(lds + (bufoff) + ldsw + _i * 8192), 16, 0, 0); } while (0)
#define PG8_LDA(dst, b, h) do { _Pragma("unroll") for (int m = 0; m < 4; ++m) _Pragma("unroll") for (int k = 0; k < 2; ++k) dst[m][k] = *(const PG8_LAS bf16x8*)(lds + PG8_SA(b, h) + aoff + m * 2048 + k * 1024); } while (0)
#define PG8_LDB(dst, b, h) do { _Pragma("unroll") for (int n = 0; n < 2; ++n) _Pragma("unroll") for (int k = 0; k < 2; ++k) dst[n][k] = *(const PG8_LAS bf16x8*)(lds + PG8_SB(b, h) + boff + n * 2048 + k * 1024); } while (0)
#define PG8_MMA(ai, bj, At, Bt) do { __builtin_amdgcn_s_setprio(1); _Pragma("unroll") for (int m = 0; m < 4; ++m) _Pragma("unroll") for (int n = 0; n < 2; ++n) _Pragma("unroll") for (int k = 0; k < 2; ++k) \
        acc[ai][bj][m][n] = __builtin_amdgcn_mfma_f32_16x16x32_bf16(Bt[n][k], At[m][k], acc[ai][bj][m][n], 0, 0, 0); __builtin_amdgcn_s_setprio(0); } while (0)
#define PG8_WAIT_V(n) asm volatile("s_waitcnt vmcnt(" #n ")" ::: "memory")
#define PG8_WAIT_L(n) asm volatile("s_waitcnt lgkmcnt(" #n ")" ::: "memory")
#define PG8_BAR __builtin_amdgcn_s_barrier()
#define PG8_SCHED __builtin_amdgcn_sched_barrier(0)
    Unit cur, nxt; int ui = 0;
    if (!S.next(0, cur)) return;
    f32x4 acc[2][2][4][2];
#pragma unroll
    for (int a = 0; a < 2; ++a)
#pragma unroll
        for (int b = 0; b < 2; ++b)
#pragma unroll
            for (int m = 0; m < 4; ++m)
#pragma unroll
                for (int n = 0; n < 2; ++n) acc[a][b][m][n] = (f32x4){0.f, 0.f, 0.f, 0.f};
    bf16x8 At[4][2], B0[2][2], B1[2][2];
    const char* cA = (const char*)g.A + (size_t)cur.pm * tstepA; const char* cB = (const char*)g.Bt + (size_t)cur.pn * tstepB;
    S.a_ready(cur);
    if constexpr (SP2) {
        PG8_STAGE(PG8_SB(0, 0), cB, voffB); PG8_STAGE(PG8_SB(0, 1), cB + hstepB, voffB); PG8_STAGE(PG8_SA(0, 0), cA, voffA); PG8_STAGE(PG8_SA(0, 1), cA + hstepA, voffA);
        if (wr == 1) PG8_BAR;
        PG8_WAIT_V(2); PG8_BAR;
        PG8_STAGE(PG8_SB(1, 0), cB + kstep, voffB); PG8_STAGE(PG8_SA(1, 0), cA + kstep, voffA); PG8_STAGE(PG8_SB(1, 1), cB + hstepB + kstep, voffB);
        PG8_WAIT_V(6); PG8_BAR;
    } else {
        PG8_STAGE(PG8_SB(0, 0), cB, voffB); PG8_STAGE(PG8_SA(0, 0), cA, voffA); PG8_STAGE(PG8_SB(0, 1), cB + hstepB, voffB); PG8_STAGE(PG8_SA(0, 1), cA + hstepA, voffA);
        if (wr == 1) PG8_BAR;
        PG8_WAIT_V(4); PG8_BAR;
        PG8_STAGE(PG8_SB(1, 0), cB + kstep, voffB); PG8_STAGE(PG8_SA(1, 0), cA + kstep, voffA); PG8_STAGE(PG8_SB(1, 1), cB + hstepB + kstep, voffB);
        PG8_WAIT_V(6); PG8_BAR;
    }
    for (;;) {
        const bool has_next = S.next(ui + 1, nxt);
        const char* nA = has_next ? (const char*)g.A + (size_t)nxt.pm * tstepA : cA; const char* nB = has_next ? (const char*)g.Bt + (size_t)nxt.pn * tstepB : cB;
        for (int t = 0; t < nt; t += 2) {
            const bool last = (t == nt - 2);
            const char* a1 = cA + (size_t)(t + 1) * kstep;
            const char* a2 = last ? nA : cA + (size_t)(t + 2) * kstep; const char* b2 = last ? nB : cB + (size_t)(t + 2) * kstep;
            const char* a3 = a2 + kstep; const char* b3 = b2 + kstep;
            if (last && has_next) S.a_ready(nxt);
            if constexpr (SP2) {
            PG8_LDB(B0, 0, 0); PG8_LDB(B1, 0, 1); PG8_SCHED; PG8_LDA(At, 0, 0); PG8_STAGE(PG8_SA(1, 1), a1 + hstepA, voffA);
            PG8_WAIT_V(8); PG8_WAIT_L(0); PG8_BAR; PG8_MMA(0, 0, At, B0); PG8_MMA(0, 1, At, B1); PG8_BAR; PG8_SCHED;
            PG8_LDA(At, 0, 1); PG8_STAGE(PG8_SB(0, 0), b2, voffB); PG8_STAGE(PG8_SB(0, 1), b2 + hstepB, voffB); PG8_STAGE(PG8_SA(0, 0), a2, voffA);
            PG8_WAIT_V(8); PG8_WAIT_L(0); PG8_BAR; PG8_MMA(1, 0, At, B0); PG8_MMA(1, 1, At, B1); PG8_BAR; PG8_SCHED;
            PG8_LDB(B0, 1, 0); PG8_LDB(B1, 1, 1); PG8_SCHED; PG8_LDA(At, 1, 0); PG8_STAGE(PG8_SA(0, 1), a2 + hstepA, voffA);
            PG8_WAIT_V(8); PG8_WAIT_L(0); PG8_BAR; PG8_MMA(0, 0, At, B0); PG8_MMA(0, 1, At, B1); PG8_BAR; PG8_SCHED;
            PG8_LDA(At, 1, 1); PG8_STAGE(PG8_SB(1, 0), b3, voffB); PG8_STAGE(PG8_SB(1, 1), b3 + hstepB, voffB); PG8_STAGE(PG8_SA(1, 0), a3, voffA);
            PG8_WAIT_V(8); PG8_WAIT_L(0); PG8_BAR; PG8_MMA(1, 0, At, B0); PG8_MMA(1, 1, At, B1); PG8_BAR; PG8_SCHED;
            } else {
            PG8_LDB(B0, 0, 0); PG8_SCHED; PG8_LDA(At, 0, 0); PG8_STAGE(PG8_SA(1, 1), a1 + hstepA, voffA);
            PG8_WAIT_L(8); PG8_BAR; PG8_WAIT_L(0); PG8_MMA(0, 0, At, B0); PG8_BAR; PG8_SCHED;
            PG8_LDB(B1, 0, 1); PG8_STAGE(PG8_SB(0, 0), b2, voffB);
            PG8_BAR; PG8_WAIT_L(0); PG8_MMA(0, 1, At, B1); PG8_BAR;
            PG8_LDA(At, 0, 1); PG8_STAGE(PG8_SA(0, 0), a2, voffA);
            PG8_BAR; PG8_WAIT_L(0); PG8_MMA(1, 0, At, B0); PG8_BAR; PG8_SCHED;
            PG8_STAGE(PG8_SB(0, 1), b2 + hstepB, voffB);
            PG8_WAIT_V(6); PG8_BAR; PG8_MMA(1, 1, At, B1); PG8_BAR;
            PG8_LDB(B0, 1, 0); PG8_SCHED; PG8_LDA(At, 1, 0); PG8_STAGE(PG8_SA(0, 1), a2 + hstepA, voffA);
            PG8_WAIT_L(8); PG8_BAR; PG8_WAIT_L(0); PG8_MMA(0, 0, At, B0); PG8_BAR; PG8_SCHED;
            PG8_LDB(B1, 1, 1); PG8_STAGE(PG8_SB(1, 0), b3, voffB);
            PG8_BAR; PG8_WAIT_L(0); PG8_MMA(0, 1, At, B1); PG8_BAR;
            PG8_LDA(At, 1, 1); PG8_STAGE(PG8_SA(1, 0), a3, voffA);
            PG8_BAR; PG8_WAIT_L(0); PG8_MMA(1, 0, At, B0); PG8_BAR; PG8_SCHED;
            PG8_STAGE(PG8_SB(1, 1), b3 + hstepB, voffB);
            PG8_WAIT_V(6); PG8_BAR; PG8_MMA(1, 1, At, B1); PG8_BAR;
            }
        }
        if constexpr (ALIGN_EPI) { if (wr == 0) PG8_BAR; }
        if constexpr (!Epi::AFTER_DRAIN) { E(acc, cur, wr, wc, fr, fq); S.done(cur); }
        if (!has_next) break;
#pragma unroll
        for (int a = 0; a < 2; ++a)
#pragma unroll
            for (int b = 0; b < 2; ++b)
#pragma unroll
                for (int m = 0; m < 4; ++m)
#pragma unroll
                    for (int n = 0; n < 2; ++n) acc[a][b][m][n] = (f32x4){0.f, 0.f, 0.f, 0.f};
        cur = nxt; cA = nA; cB = nB; ++ui;
        if constexpr (ALIGN_EPI) { if (wr == 1) PG8_BAR; }
    }
    PG8_WAIT_V(0);
    if constexpr (!ALIGN_EPI) { if (wr == 0) PG8_BAR; }
    PG8_BAR;
    if constexpr (Epi::AFTER_DRAIN) { E.fused(acc, cur, wr, wc, fr, fq, lds, wid, lane); S.done(cur); }
#undef PG8_SA
#undef PG8_SB
#undef PG8_STAGE
#undef PG8_LDA
#undef PG8_LDB
#undef PG8_MMA
#undef PG8_WAIT_V
#undef PG8_WAIT_L
#undef PG8_BAR
#undef PG8_SCHED
}
}

#define DEV __device__ __forceinline__
#define LAS __attribute__((address_space(3)))
typedef unsigned short bf16_t;
typedef short bf16x8 __attribute__((ext_vector_type(8)));
typedef float f32x4 __attribute__((ext_vector_type(4)));
typedef float f32x2 __attribute__((ext_vector_type(2)));
typedef float f32x16 __attribute__((ext_vector_type(16)));
typedef unsigned u32x4 __attribute__((ext_vector_type(4)));
typedef unsigned u32x2 __attribute__((ext_vector_type(2)));

constexpr int R = 16896, RB = 8448, NCTX = 256, TL = 8192, DM = 1024, INW = 1696, DFF = 2816, HFF = 1408;
constexpr int NWG_T = 512;
constexpr float EPS = 1e-6f;
constexpr int LDS_BYTES = 147456;
constexpr size_t OFF_X = 0, OFF_HN = 69206016, OFF_W = 103809024, OFF_MOD = 152174592, OFF_ROPE = 152436736, OFF_OV = 153485312;
constexpr size_t OV_Q = 0, OV_KN = 25952256, OV_VT = 43253760, OV_SLOC = 60555264, OV_SIN = 69206016, OV_U = 0;
constexpr size_t WS_NEED = 250000128 + 16384;
constexpr size_t W_IN = 0, W_UQ = 1835008, W_KN = 2129920, W_V = 2260992, W_OUT = 2392064, W_UP = 3440640, W_DN = 9207808, W_LAYER = 12091392;

struct Params {
    const float *x, *c, *ctx, *c_ctx, *w_mod, *b_mod, *norm1_g, *w_in, *ret_decay_f, *ret_decay_b, *mla_q_norm_g, *w_uq, *mla_kv_norm_g, *w_ukv,
        *pool_w, *pool_scale, *w_out, *norm2_g, *w_up, *conv_w, *conv_b, *w_down, *final_norm_g;
    float* out; unsigned char* ws; int ph_lo, ph_hi;
};

DEV int otid() { int t = threadIdx.x; asm volatile("" : "+v"(t)); return t; }
DEV float bf2f(unsigned short x) { return __uint_as_float((unsigned)x << 16); }
DEV unsigned f2bf(float f) { unsigned u = __float_as_uint(f); return (u + 0x7fffu + ((u >> 16) & 1u)) >> 16; }
DEV unsigned pk2(float lo, float hi) { return f2bf(lo) | (f2bf(hi) << 16); }
DEV float wave_sum(float v) {
#pragma unroll
    for (int o = 1; o < 64; o <<= 1) v += __shfl_xor(v, o);
    return v;
}
DEV float siluf(float x) { return x / (1.0f + __expf(-x)); }
DEV int crow(int r, int hi) { return (r & 3) + 8 * (r >> 2) + 4 * hi; }
DEV bf16x8 pack8(float a0, float a1, float a2, float a3, float a4, float a5, float a6, float a7) {
    u32x4 w; w.x = pg8::cvt_pk_bf16(a0, a1); w.y = pg8::cvt_pk_bf16(a2, a3); w.z = pg8::cvt_pk_bf16(a4, a5); w.w = pg8::cvt_pk_bf16(a6, a7);
    return __builtin_bit_cast(bf16x8, w);
}
DEV int row_mi(int r) { const int b = r / RB; const int s = r - b * RB; return s < NCTX ? 2 : b; }

DEV void transpose_item(const float* W, int K, int Nsrc, bf16_t* WT, int n0, int cs, int k0, float* scr, int lane) {
#pragma unroll
    for (int i = 0; i < 32; ++i) { const int kk = 2 * i + (lane >> 5); scr[kk * 33 + (lane & 31)] = cs >= 0 ? W[(size_t)(k0 + kk) * Nsrc + cs + (lane & 31)] : 0.f; }
    asm volatile("s_waitcnt lgkmcnt(0)" ::: "memory");
    const int c = lane & 7;
#pragma unroll
    for (int j = 0; j < 4; ++j) { const int n = (lane >> 3) + 8 * j; const float* s = scr + (8 * c) * 33 + n;
        u32x4 o; o.x = pk2(s[0 * 33], s[1 * 33]); o.y = pk2(s[2 * 33], s[3 * 33]); o.z = pk2(s[4 * 33], s[5 * 33]); o.w = pk2(s[6 * 33], s[7 * 33]);
        *(u32x4*)(WT + (size_t)(n0 + n) * K + k0 + 8 * c) = o; }
    asm volatile("s_waitcnt lgkmcnt(0)" ::: "memory");
}
DEV int map_in(int n0) { return n0 < 1440 ? n0 : (n0 < INW ? -2 : -1); }
DEV int map_kn(int n0) { return (n0 >> 6) * 128 + (n0 & 63); }
DEV int map_v(int n0) { return (n0 >> 6) * 128 + 64 + (n0 & 63); }
DEV int map_up(int n0) { const int hf = n0 / DFF, w = n0 - hf * DFF; return w < HFF ? hf * HFF + w : DFF + hf * HFF + (w - HFF); }

DEV void phase_prep(const Params& p, unsigned char* lds) {
    const int tid = otid(), lane = tid & 63, wid = tid >> 6;
    unsigned char* ws = p.ws;
    { f32x2* rope = (f32x2*)(ws + OFF_ROPE);
      for (int idx = blockIdx.x * NWG_T + tid; idx < TL * 16; idx += gridDim.x * NWG_T) { const int t = idx >> 4, i = idx & 15; const int pos = i < 8 ? (t >> 6) : (t & 63);
          const float inv = exp2f(-(float)(i & 7) * 0.125f * 13.287712379549449f); const float ang = (float)pos * inv; f32x2 cs; cs.x = __cosf(ang); cs.y = __sinf(ang); rope[idx] = cs; } }
    { float* scv = (float*)lds;
      float* red = scv + 3 * 1024;
      for (int i = tid; i < 3 * 1024; i += NWG_T) { const int v = i >> 10, k = i & 1023; const float cv = v < 2 ? p.c[v * 1024 + k] : p.c_ctx[k]; scv[i] = siluf(cv); }
      __syncthreads();
      float* modv = (float*)(ws + OFF_MOD);
      for (int it = blockIdx.x; it < 192; it += gridDim.x) { const int l = it / 96, col0 = (it % 96) * 64;
          const float* wm = p.w_mod + (size_t)l * 1024 * 6144 + col0 + lane; float a0 = 0.f, a1 = 0.f, a2 = 0.f;
#pragma unroll 16
          for (int k = wid * 128; k < wid * 128 + 128; ++k) { const float w = wm[(size_t)k * 6144]; a0 += scv[k] * w; a1 += scv[1024 + k] * w; a2 += scv[2048 + k] * w; }
          red[(wid * 3 + 0) * 64 + lane] = a0; red[(wid * 3 + 1) * 64 + lane] = a1; red[(wid * 3 + 2) * 64 + lane] = a2;
          __syncthreads();
          if (tid < 192) { const int v = tid >> 6, cl = tid & 63; float s = 0.f;
#pragma unroll
              for (int w = 0; w < 8; ++w) s += red[(w * 3 + v) * 64 + cl];
              modv[((size_t)l * 3 + v) * 6144 + col0 + cl] = s + p.b_mod[l * 6144 + col0 + cl]; }
          __syncthreads(); }
    }
    { float* scr = (float*)(lds + 32768 + wid * 8704);
      const int gw = blockIdx.x * 8 + wid, NGW = gridDim.x * 8;
      constexpr int I_IN = 16 * 56, I_UQ = 6 * 24, I_KN = 4 * 16, I_V = 4 * 16, I_OUT = 16 * 32, I_UP = 16 * 176, I_DN = 44 * 32, I_L = I_IN + I_UQ + I_KN + I_V + I_OUT + I_UP + I_DN;
      for (int it = gw; it < 2 * I_L; it += NGW) { const int l = it / I_L; int r = it - l * I_L; bf16_t* wl = (bf16_t*)(ws + OFF_W) + (size_t)l * W_LAYER;
          const float* src; int K, Nsrc, nbn, mp; size_t doff;
          if (r < I_IN) { src = p.w_in + (size_t)l * 1024 * INW; K = 1024; Nsrc = INW; nbn = 56; mp = 1; doff = W_IN; }
          else if ((r -= I_IN) < I_UQ) { src = p.w_uq + (size_t)l * 384 * 768; K = 384; Nsrc = 768; nbn = 24; mp = 0; doff = W_UQ; }
          else if ((r -= I_UQ) < I_KN) { src = p.w_ukv + (size_t)l * 256 * 1024; K = 256; Nsrc = 1024; nbn = 16; mp = 2; doff = W_KN; }
          else if ((r -= I_KN) < I_V) { src = p.w_ukv + (size_t)l * 256 * 1024; K = 256; Nsrc = 1024; nbn = 16; mp = 3; doff = W_V; }
          else if ((r -= I_V) < I_OUT) { src = p.w_out + (size_t)l * 1024 * 1024; K = 1024; Nsrc = 1024; nbn = 32; mp = 0; doff = W_OUT; }
          else if ((r -= I_OUT) < I_UP) { src = p.w_up + (size_t)l * 1024 * 5632; K = 1024; Nsrc = 5632; nbn = 176; mp = 4; doff = W_UP; }
          else { r -= I_UP; src = p.w_down + (size_t)l * DFF * 1024; K = DFF; Nsrc = 1024; nbn = 32; mp = 0; doff = W_DN; }
          const int kb = r / nbn, nb = r - kb * nbn, n0 = nb * 32;
          const int cs = mp == 0 ? n0 : mp == 1 ? map_in(n0) : mp == 2 ? map_kn(n0) : mp == 3 ? map_v(n0) : map_up(n0);
          if (cs != -2) transpose_item(src, K, Nsrc, wl + doff, n0, cs, kb * 64, scr, lane); }
    }
    { for (int idx = blockIdx.x * NWG_T + tid; idx < 2 * 1024 * 256; idx += gridDim.x * NWG_T) { const int n = idx & 255, k = (idx >> 8) & 1023, l = idx >> 18; const int g = n >> 6, d = n & 63;
          const float* wr = p.w_in + ((size_t)l * 1024 + k) * INW + 1440 + g * 64; const float* pw = p.pool_w + ((size_t)(l * 4 + g) * 64) * 64 + d; float s = 0.f;
#pragma unroll 8
          for (int c = 0; c < 64; ++c) s += wr[c] * pw[c * 64];
          ((bf16_t*)(ws + OFF_W) + (size_t)l * W_LAYER + W_IN)[(size_t)(1440 + n) * 1024 + k] = (bf16_t)f2bf(s * p.pool_scale[l * 256 + n]); } }
}

DEV void phase_norm(const Params& p, int l, int which, bool first) {
    const int tid = otid(); const int lane = tid & 63, wid = tid >> 6; const int gw = blockIdx.x * 8 + wid, NGW = gridDim.x * 8;
    float* X = (float*)(p.ws + OFF_X); bf16_t* HN = (bf16_t*)(p.ws + OFF_HN);
    const float* modv = (const float*)(p.ws + OFF_MOD) + (size_t)l * 3 * 6144;
    const float* g = (which == 0 ? p.norm1_g : p.norm2_g) + l * 1024;
    for (int r = gw; r < R; r += NGW) {
        const int b = r / RB, s = r - b * RB; const int mi = s < NCTX ? 2 : b;
        const float* src = first ? (s < NCTX ? p.ctx + ((size_t)b * NCTX + s) * 1024 : p.x + ((size_t)b * TL + (s - NCTX)) * 1024) : X + (size_t)r * 1024;
        const f32x4* xr = (const f32x4*)src + lane; f32x4 v[4]; float ss = 0.f;
#pragma unroll
        for (int j = 0; j < 4; ++j) { v[j] = xr[64 * j]; ss += (v[j].x * v[j].x + v[j].y * v[j].y) + (v[j].z * v[j].z + v[j].w * v[j].w); }
        if (first) { f32x4* xo = (f32x4*)(X + (size_t)r * 1024) + lane;
#pragma unroll
            for (int j = 0; j < 4; ++j) xo[64 * j] = v[j]; }
        const float rs = rsqrtf(wave_sum(ss) * (1.f / 1024.f) + EPS);
        const float* mv = modv + mi * 6144 + (which == 0 ? 0 : 3072);
        u32x2* o8 = (u32x2*)(HN + (size_t)r * 1024) + lane;
#pragma unroll
        for (int j = 0; j < 4; ++j) { const f32x4 gg = ((const f32x4*)g)[lane + 64 * j], sh = ((const f32x4*)mv)[lane + 64 * j], sc = ((const f32x4*)(mv + 1024))[lane + 64 * j];
            const f32x4 y = v[j] * rs * gg; const f32x4 h = y * (sc + 1.0f) + sh; u32x2 w; w.x = pk2(h.x, h.y); w.y = pk2(h.z, h.w); o8[64 * j] = w; }
    }
}
DEV void phase_final(const Params& p) {
    const int tid = otid(); const int lane = tid & 63, wid = tid >> 6; const int gw = blockIdx.x * 8 + wid, NGW = gridDim.x * 8;
    const float* X = (const float*)(p.ws + OFF_X);
    for (int q = gw; q < 2 * TL; q += NGW) { const int b = q / TL, t = q - b * TL; const int r = b * RB + NCTX + t;
        const f32x4* xr = (const f32x4*)(X + (size_t)r * 1024) + lane; f32x4 v[4]; float ss = 0.f;
#pragma unroll
        for (int j = 0; j < 4; ++j) { v[j] = xr[64 * j]; ss += (v[j].x * v[j].x + v[j].y * v[j].y) + (v[j].z * v[j].z + v[j].w * v[j].w); }
        const float rs = rsqrtf(wave_sum(ss) * (1.f / 1024.f) + EPS);
        f32x4* o = (f32x4*)(p.out + (size_t)q * 1024) + lane;
#pragma unroll
        for (int j = 0; j < 4; ++j) { const f32x4 gg = ((const f32x4*)p.final_norm_g)[lane + 64 * j]; o[64 * j] = v[j] * rs * gg; } }
}

DEV void phase_rowwise(const Params& p, int l) {
    const int tid = otid(); const int lane = tid & 63, wid = tid >> 6; const int gw = blockIdx.x * 8 + wid, NGW = gridDim.x * 8;
    bf16_t* P = (bf16_t*)p.out; const f32x2* rope = (const f32x2*)(p.ws + OFF_ROPE);
    const float* qg = p.mla_q_norm_g + l * 384; const float* kg = p.mla_kv_norm_g + l * 256;
    for (int r = gw; r < R; r += NGW) {
        bf16_t* pr = P + (size_t)r * INW; const int b = r / RB, s = r - b * RB;
        { unsigned* q2 = (unsigned*)(pr + 768) + lane; unsigned w[3]; float ss = 0.f;
#pragma unroll
          for (int j = 0; j < 3; ++j) { w[j] = q2[64 * j]; const float a = bf2f(w[j] & 0xffff), c2 = bf2f(w[j] >> 16); ss += a * a + c2 * c2; }
          const float rs = rsqrtf(wave_sum(ss) * (1.f / 384.f) + EPS);
#pragma unroll
          for (int j = 0; j < 3; ++j) { const int c0 = 2 * (lane + 64 * j); q2[64 * j] = pk2(bf2f(w[j] & 0xffff) * rs * qg[c0], bf2f(w[j] >> 16) * rs * qg[c0 + 1]); } }
        { u32x2* k4 = (u32x2*)(pr + 1152) + lane; const u32x2 w = *k4;
          const float a0 = bf2f(w.x & 0xffff), a1 = bf2f(w.x >> 16), a2 = bf2f(w.y & 0xffff), a3 = bf2f(w.y >> 16);
          const float rs = rsqrtf(wave_sum((a0 * a0 + a1 * a1) + (a2 * a2 + a3 * a3)) * (1.f / 256.f) + EPS);
          const f32x4 gg = ((const f32x4*)kg)[lane]; u32x2 o; o.x = pk2(a0 * rs * gg.x, a1 * rs * gg.y); o.y = pk2(a2 * rs * gg.z, a3 * rs * gg.w); *k4 = o; }
        if (s >= NCTX && lane < 16) { const f32x2 cs = rope[(s - NCTX) * 16 + lane];
          const float x1 = bf2f(pr[1408 + lane]), x2 = bf2f(pr[1408 + 16 + lane]);
          pr[1408 + lane] = (bf16_t)f2bf(x1 * cs.x - x2 * cs.y); pr[1408 + 16 + lane] = (bf16_t)f2bf(x2 * cs.x + x1 * cs.y); }
    }
}

DEV void phase_pool(const Params& p) {
    const int tid = otid(); const bf16_t* P = (const bf16_t*)p.out; bf16_t* MIX = (bf16_t*)(p.ws + OFF_HN);
    for (int idx = blockIdx.x * NWG_T + tid; idx < R * 32; idx += gridDim.x * NWG_T) { const int r = idx >> 5, cg = idx & 31; const int half = 1 << (cg >> 3);
        const int b = r / RB, s = r - b * RB; const int seq0 = s < NCTX ? b * RB : b * RB + NCTX; const int T = s < NCTX ? NCTX : TL; const int t = r - seq0;
        const int lo = max(t - half, 0), hi = min(t + half, T); float sum[8];
#pragma unroll
        for (int j = 0; j < 8; ++j) sum[j] = 0.f;
        const bf16_t* base = P + (size_t)seq0 * INW + 1440 + cg * 8;
        for (int tt = lo; tt < hi; ++tt) { const bf16x8 v = *(const bf16x8*)(base + (size_t)tt * INW);
#pragma unroll
            for (int j = 0; j < 8; ++j) sum[j] += bf2f((unsigned short)v[j]); }
        const bf16x8 me = *(const bf16x8*)(base + (size_t)t * INW); const float ic = 1.0f / (float)(hi - lo); float o[8];
#pragma unroll
        for (int j = 0; j < 8; ++j) o[j] = sum[j] * ic - bf2f((unsigned short)me[j]);
        *(bf16x8*)(MIX + (size_t)r * 1024 + 768 + cg * 8) = pack8(o[0], o[1], o[2], o[3], o[4], o[5], o[6], o[7]); }
}

DEV float log2_sigmoid(float d) { return -log1pf(__expf(-d)) * 1.4426950408889634f; }
DEV void states_item(const Params& p, int l, unsigned char* lds, int it) {
    const int tid = otid(); const bf16_t* P = (const bf16_t*)p.out; const f32x2* rope = (const f32x2*)(p.ws + OFF_ROPE);
    float* SLOC = (float*)(p.ws + OFF_OV + OV_SLOC);
    const int gc = it >> 2, h = it & 3;
    bf16_t* kk = (bf16_t*)lds;
    bf16_t* vv = kk + 128 * 32;
    float* dec = (float*)(vv + 128 * 64);
    const int cb = gc % 66; const bool lat = cb >= 2; const int t0 = (cb - 2) * 128; const int r0 = gc * 128;
    if (tid < 256) { const int dir = tid >> 7, idx = tid & 127;
        const float lg = log2_sigmoid((dir == 0 ? p.ret_decay_f : p.ret_decay_b)[l * 4 + h]); dec[tid] = exp2f(lg * (dir == 0 ? (float)(127 - idx) : (float)idx)); }
    else { const int task = tid - 256; const int tok = task >> 1, c = task & 1;
        const bf16_t* src = P + (size_t)(r0 + tok) * INW + 128 + h * 32 + 8 * c; const bf16x8 lo = *(const bf16x8*)src, hi = *(const bf16x8*)(src + 16);
        float o1[8], o2[8];
#pragma unroll
        for (int j = 0; j < 8; ++j) { float x1 = bf2f((unsigned short)lo[j]), x2 = bf2f((unsigned short)hi[j]);
            if (lat) { const f32x2 cs = rope[(t0 + tok) * 16 + 8 * c + j]; const float y1 = x1 * cs.x - x2 * cs.y, y2 = x2 * cs.x + x1 * cs.y; x1 = y1; x2 = y2; }
            o1[j] = x1 * 0.17677669529663687f; o2[j] = x2 * 0.17677669529663687f; }
        bf16_t* dst = kk + tok * 32 + 8 * c;
        *(bf16x8*)dst = pack8(o1[0], o1[1], o1[2], o1[3], o1[4], o1[5], o1[6], o1[7]); *(bf16x8*)(dst + 16) = pack8(o2[0], o2[1], o2[2], o2[3], o2[4], o2[5], o2[6], o2[7]); }
    for (int task = tid; task < 1024; task += NWG_T) { const int tok = task >> 3, ch = task & 7; *(u32x4*)(vv + tok * 64 + ch * 8) = *(const u32x4*)(P + (size_t)(r0 + tok) * INW + 256 + h * 64 + ch * 8); }
    __syncthreads();
    { const int d = tid >> 4, dvg = tid & 15; float af[4], ab[4];
#pragma unroll
      for (int j = 0; j < 4; ++j) { af[j] = 0.f; ab[j] = 0.f; }
#pragma unroll 4
      for (int i = 0; i < 128; ++i) { const float kv = bf2f(kk[i * 32 + d]); const float kf = kv * dec[i], kb = kv * dec[128 + i];
          const u32x2 v = *(const u32x2*)(vv + i * 64 + dvg * 4);
          const float v0 = bf2f(v.x & 0xffff), v1 = bf2f(v.x >> 16), v2 = bf2f(v.y & 0xffff), v3 = bf2f(v.y >> 16);
          af[0] += kf * v0; af[1] += kf * v1; af[2] += kf * v2; af[3] += kf * v3; ab[0] += kb * v0; ab[1] += kb * v1; ab[2] += kb * v2; ab[3] += kb * v3; }
      float* of = SLOC + ((size_t)(gc * 4 + h) * 2 + 0) * 2048 + d * 64 + dvg * 4;
      *(f32x4*)of = (f32x4){af[0], af[1], af[2], af[3]}; *(f32x4*)(of + 2048) = (f32x4){ab[0], ab[1], ab[2], ab[3]}; }
    __syncthreads();
}
DEV void scan_threads(const Params& p, int l, int gid) {
    if (gid >= 32768) return;
    const int e = gid & 2047, dir = (gid >> 11) & 1, h = (gid >> 12) & 3, b = gid >> 14;
    const float* SLOC = (const float*)(p.ws + OFF_OV + OV_SLOC); float* SIN = (float*)(p.ws + OFF_OV + OV_SIN);
    const float gC = exp2f(log2_sigmoid((dir == 0 ? p.ret_decay_f : p.ret_decay_b)[l * 4 + h]) * 128.f);
    float S = 0.f;
#pragma unroll 6
    for (int st = 0; st < 66; ++st) { const int cb = dir == 0 ? st : (st < 2 ? 1 - st : 67 - st); const size_t idx = ((size_t)((b * 66 + cb) * 4 + h) * 2 + dir) * 2048 + e;
        const float v = SLOC[idx]; SIN[idx] = S; S = S * gC + v; }
}

constexpr int AT_KP = 208, AT_VP = 136, AT_KB = 64 * AT_KP, AT_VBS = 64 * AT_VP, AT_V0 = 2 * AT_KB;
DEV float at_max32(const f32x16& s0, const f32x16& s1) {
    float m0 = __builtin_fmaxf(__builtin_fmaxf(s0[0], s0[1]), s0[2]), m1 = __builtin_fmaxf(__builtin_fmaxf(s1[0], s1[1]), s1[2]);
    m0 = __builtin_fmaxf(__builtin_fmaxf(m0, s0[3]), s0[4]); m1 = __builtin_fmaxf(__builtin_fmaxf(m1, s1[3]), s1[4]);
    m0 = __builtin_fmaxf(__builtin_fmaxf(m0, s0[5]), s0[6]); m1 = __builtin_fmaxf(__builtin_fmaxf(m1, s1[5]), s1[6]);
    m0 = __builtin_fmaxf(__builtin_fmaxf(m0, s0[7]), s0[8]); m1 = __builtin_fmaxf(__builtin_fmaxf(m1, s1[7]), s1[8]);
    m0 = __builtin_fmaxf(__builtin_fmaxf(m0, s0[9]), s0[10]); m1 = __builtin_fmaxf(__builtin_fmaxf(m1, s1[9]), s1[10]);
    m0 = __builtin_fmaxf(__builtin_fmaxf(m0, s0[11]), s0[12]); m1 = __builtin_fmaxf(__builtin_fmaxf(m1, s1[11]), s1[12]);
    m0 = __builtin_fmaxf(__builtin_fmaxf(m0, s0[13]), s0[14]); m1 = __builtin_fmaxf(__builtin_fmaxf(m1, s1[13]), s1[14]);
    return __builtin_fmaxf(__builtin_fmaxf(m0, s0[15]), __builtin_fmaxf(m1, s1[15]));
}
DEV void attn_unit(const Params& p, unsigned char* lds, int u) {
    const int tid = otid(), lane = tid & 63, wid = tid >> 6, l32 = lane & 31, hi = lane >> 5;
    const bf16_t* Q = (const bf16_t*)(p.ws + OFF_OV + OV_Q); const bf16_t* KN = (const bf16_t*)(p.ws + OFF_OV + OV_KN); const bf16_t* VT = (const bf16_t*)(p.ws + OFF_OV + OV_VT);
    const bf16_t* P = (const bf16_t*)p.out; bf16_t* MIX = (bf16_t*)(p.ws + OFF_HN); const f32x2* rope = (const f32x2*)(p.ws + OFF_ROPE);
    const bool isctx = u >= 512; int b, h, qrow0, NT;
    if (!isctx) { b = u >> 8; h = (u >> 5) & 7; qrow0 = b * RB + NCTX + (u & 31) * 256; NT = 132; } else { const int v = u - 512; b = v >> 3; h = v & 7; qrow0 = b * RB; NT = 4; }
    const int krow0 = b * RB; const int qrow = qrow0 + wid * 32 + l32;
    bf16x8 qf[6];
    { const bf16_t* qp = Q + (size_t)qrow * 768 + h * 96 + hi * 8;
#pragma unroll
      for (int d0 = 0; d0 < 6; ++d0) qf[d0] = *(const bf16x8*)(qp + d0 * 16);
      if (!isctx) { const f32x2* rp = rope + (size_t)(qrow - (b * RB + NCTX)) * 16 + hi * 8;
#pragma unroll
          for (int j = 0; j < 8; ++j) { const f32x2 cs = rp[j]; const float x1 = bf2f((unsigned short)qf[4][j]), x2 = bf2f((unsigned short)qf[5][j]);
              qf[4][j] = (short)f2bf(x1 * cs.x - x2 * cs.y); qf[5][j] = (short)f2bf(x2 * cs.x + x1 * cs.y); } } }
    const bf16_t* sp[3]; int sstep[3], lo[3];
#pragma unroll
    for (int k = 0; k < 2; ++k) { const int c = tid + k * 512; const int key = c / 12, part = c - key * 12; lo[k] = key * AT_KP + part * 16;
        if (part < 8) { sp[k] = KN + (size_t)(krow0 + key) * 512 + h * 64 + part * 8; sstep[k] = 64 * 512; } else { sp[k] = P + (size_t)(krow0 + key) * INW + 1408 + (part - 8) * 8; sstep[k] = 64 * INW; } }
    { const int dv = tid >> 3, kc = tid & 7; lo[2] = dv * AT_VP + kc * 16; sp[2] = VT + (size_t)(h * 64 + dv) * R + krow0 + kc * 8; sstep[2] = 64; }
    const bool hasK2 = tid < 256;
    u32x4 st[3];
#define AT_GLOADK() do { st[0] = *(const u32x4*)sp[0]; sp[0] += sstep[0]; if (hasK2) { st[1] = *(const u32x4*)sp[1]; sp[1] += sstep[1]; } } while (0)
#define AT_GLOADV() do { st[2] = *(const u32x4*)sp[2]; sp[2] += sstep[2]; } while (0)
#define AT_LSTOREK(buf) do { *(u32x4*)((buf) + lo[0]) = st[0]; if (hasK2) *(u32x4*)((buf) + lo[1]) = st[1]; } while (0)
#define AT_LSTOREV(buf) do { unsigned char* d_ = (buf) + lo[2]; *(u32x2*)d_ = (u32x2){st[2].x, st[2].y}; *(u32x2*)(d_ + 8) = (u32x2){st[2].z, st[2].w}; } while (0)
#define AT_SB() __builtin_amdgcn_sched_barrier(0)
    f32x16 o0, o1, sa0, sa1, sb0, sb1;
#pragma unroll
    for (int r = 0; r < 16; ++r) { o0[r] = 0.f; o1[r] = 0.f; sa0[r] = 0.f; sa1[r] = 0.f; }
    float mrun = 0.f, lsum = 0.f;
    __syncthreads();
    AT_GLOADK(); AT_GLOADV(); AT_LSTOREK(lds); AT_LSTOREV(lds + AT_V0);
    AT_GLOADK(); AT_LSTOREK(lds + AT_KB);
    __syncthreads();
    { const unsigned char* ka = lds + l32 * AT_KP + hi * 16;
#pragma unroll
      for (int d0 = 0; d0 < 6; ++d0) { const bf16x8 a0 = *(const bf16x8*)(ka + d0 * 32), a1 = *(const bf16x8*)(ka + 32 * AT_KP + d0 * 32);
          sa0 = __builtin_amdgcn_mfma_f32_32x32x16_bf16(a0, qf[d0], sa0, 0, 0, 0); sa1 = __builtin_amdgcn_mfma_f32_32x32x16_bf16(a1, qf[d0], sa1, 0, 0, 0); } }
#define AT_STEP(SA0, SA1, SB0, SB1, tt) do { \
        const int t_ = (tt); const bool nxt_ = t_ + 1 < NT; \
        const unsigned char* kb_ = lds + ((t_ + 1) & 1) * AT_KB; const unsigned char* vb_ = lds + AT_V0 + (t_ & 1) * AT_VBS; \
        if (t_ + 2 < NT) AT_GLOADK(); \
        if (nxt_) AT_GLOADV(); \
        bf16x8 kfr[12]; u32x2 vfr[16]; \
        { const unsigned char* ka = kb_ + l32 * AT_KP + hi * 16; \
          _Pragma("unroll") for (int d0 = 0; d0 < 6; ++d0) { kfr[2 * d0] = *(const bf16x8*)(ka + d0 * 32); kfr[2 * d0 + 1] = *(const bf16x8*)(ka + 32 * AT_KP + d0 * 32); } } \
        { const float mx = at_max32(SA0, SA1); \
          if (t_ == 0 || __any(mx > 8.0f)) { \
              const float rm = fmaxf(mx, __shfl_xor(mx, 32)); const float delta = (t_ == 0) ? rm : fmaxf(rm, 0.f); const float alpha = (t_ == 0) ? 1.0f : __builtin_amdgcn_exp2f(-delta); \
              mrun += delta; \
              _Pragma("unroll") for (int r = 0; r < 16; ++r) { SA0[r] -= delta; SA1[r] -= delta; o0[r] *= alpha; o1[r] *= alpha; } \
              lsum *= alpha; } } \
        { const float nm = -mrun; _Pragma("unroll") for (int r = 0; r < 16; ++r) { SB0[r] = nm; SB1[r] = nm; } } \
        float ls0 = 0.f, ls1 = 0.f; \
        AT_SB(); \
        _Pragma("unroll") for (int i = 0; i < 8; ++i) { \
            if (i & 1) SB1 = __builtin_amdgcn_mfma_f32_32x32x16_bf16(kfr[i], qf[i >> 1], SB1, 0, 0, 0); else SB0 = __builtin_amdgcn_mfma_f32_32x32x16_bf16(kfr[i], qf[i >> 1], SB0, 0, 0, 0); \
            SA0[2 * i] = __builtin_amdgcn_exp2f(SA0[2 * i]); SA0[2 * i + 1] = __builtin_amdgcn_exp2f(SA0[2 * i + 1]); SA1[2 * i] = __builtin_amdgcn_exp2f(SA1[2 * i]); SA1[2 * i + 1] = __builtin_amdgcn_exp2f(SA1[2 * i + 1]); \
            ls0 += SA0[2 * i] + SA0[2 * i + 1]; ls1 += SA1[2 * i] + SA1[2 * i + 1]; \
            AT_SB(); } \
        { const unsigned char* va = vb_ + l32 * AT_VP + hi * 8; \
          _Pragma("unroll") for (int kj = 0; kj < 4; ++kj) { const unsigned char* vp = va + kj * 32; \
              vfr[4 * kj + 0] = *(const u32x2*)vp; vfr[4 * kj + 1] = *(const u32x2*)(vp + 16); vfr[4 * kj + 2] = *(const u32x2*)(vp + 32 * AT_VP); vfr[4 * kj + 3] = *(const u32x2*)(vp + 32 * AT_VP + 16); } } \
        bf16x8 pb[4]; \
        _Pragma("unroll") for (int i = 8; i < 12; ++i) { const int kj = i - 8; const int jp = kj & 1; \
            if (i & 1) SB1 = __builtin_amdgcn_mfma_f32_32x32x16_bf16(kfr[i], qf[i >> 1], SB1, 0, 0, 0); else SB0 = __builtin_amdgcn_mfma_f32_32x32x16_bf16(kfr[i], qf[i >> 1], SB0, 0, 0, 0); \
            if (kj < 2) pb[kj] = pack8(SA0[8 * jp + 0], SA0[8 * jp + 1], SA0[8 * jp + 2], SA0[8 * jp + 3], SA0[8 * jp + 4], SA0[8 * jp + 5], SA0[8 * jp + 6], SA0[8 * jp + 7]); \
            else        pb[kj] = pack8(SA1[8 * jp + 0], SA1[8 * jp + 1], SA1[8 * jp + 2], SA1[8 * jp + 3], SA1[8 * jp + 4], SA1[8 * jp + 5], SA1[8 * jp + 6], SA1[8 * jp + 7]); \
            AT_SB(); } \
        lsum += ls0 + ls1; \
        _Pragma("unroll") for (int kj = 0; kj < 4; ++kj) { \
            const bf16x8 A0 = __builtin_bit_cast(bf16x8, (u32x4){vfr[4 * kj].x, vfr[4 * kj].y, vfr[4 * kj + 1].x, vfr[4 * kj + 1].y}); \
            const bf16x8 A1 = __builtin_bit_cast(bf16x8, (u32x4){vfr[4 * kj + 2].x, vfr[4 * kj + 2].y, vfr[4 * kj + 3].x, vfr[4 * kj + 3].y}); \
            o0 = __builtin_amdgcn_mfma_f32_32x32x16_bf16(A0, pb[kj], o0, 0, 0, 0); o1 = __builtin_amdgcn_mfma_f32_32x32x16_bf16(A1, pb[kj], o1, 0, 0, 0); } \
        if (t_ + 2 < NT) AT_LSTOREK(lds + (t_ & 1) * AT_KB); \
        if (nxt_) AT_LSTOREV(lds + AT_V0 + ((t_ + 1) & 1) * AT_VBS); \
        __syncthreads(); \
    } while (0)
    for (int t = 0; t < NT; t += 2) { AT_STEP(sa0, sa1, sb0, sb1, t); AT_STEP(sb0, sb1, sa0, sa1, t + 1); }
    lsum += __shfl_xor(lsum, 32);
    const float inv = 1.0f / lsum;
    bf16_t* op = MIX + (size_t)qrow * 1024 + 256 + h * 64 + 4 * hi;
#pragma unroll
    for (int g4 = 0; g4 < 4; ++g4) { u32x2 w0, w1; w0.x = pk2(o0[4 * g4] * inv, o0[4 * g4 + 1] * inv); w0.y = pk2(o0[4 * g4 + 2] * inv, o0[4 * g4 + 3] * inv);
        w1.x = pk2(o1[4 * g4] * inv, o1[4 * g4 + 1] * inv); w1.y = pk2(o1[4 * g4 + 2] * inv, o1[4 * g4 + 3] * inv);
        *(u32x2*)(op + 8 * g4) = w0; *(u32x2*)(op + 32 + 8 * g4) = w1; }
#undef AT_GLOADK
#undef AT_GLOADV
#undef AT_LSTOREK
#undef AT_LSTOREV
#undef AT_STEP
#undef AT_SB
}

constexpr int RT_VP = 264, RT_SP = 144, RT_VB = 2 * 64 * RT_VP;
DEV void retout_unit(const Params& p, int l, unsigned char* lds, int u) {
    const int tid = otid(), lane = tid & 63, wid = tid >> 6, l32 = lane & 31, hi = lane >> 5;
    const int gc = u >> 1, hp = u & 1; const int cb = gc % 66; const bool lat = cb >= 2; const int t0 = (cb - 2) * 128; const int r0 = gc * 128;
    const bf16_t* P = (const bf16_t*)p.out; bf16_t* MIX = (bf16_t*)(p.ws + OFF_HN); const f32x2* rope = (const f32x2*)(p.ws + OFF_ROPE);
    const float* SIN = (const float*)(p.ws + OFF_OV + OV_SIN);
    bf16_t* VTl = (bf16_t*)lds; bf16_t* STl = (bf16_t*)(lds + RT_VB);
    __syncthreads();
    for (int task = tid; task < 2048; task += NWG_T) { const int hh = task >> 10, key = (task >> 3) & 127, ch = task & 7;
        const bf16x8 v = *(const bf16x8*)(P + (size_t)(r0 + key) * INW + 256 + (2 * hp + hh) * 64 + ch * 8);
#pragma unroll
        for (int j = 0; j < 8; ++j) VTl[(hh * 64 + ch * 8 + j) * (RT_VP / 2) + key] = (bf16_t)v[j]; }
    for (int task = tid; task < 8192; task += NWG_T) { const int dv = task & 63, k = (task >> 6) & 31, dir = (task >> 11) & 1, hh = task >> 12;
        STl[(hh * 64 + dv) * (RT_SP / 2) + dir * 32 + k] = (bf16_t)f2bf(SIN[((size_t)(gc * 4 + 2 * hp + hh) * 2 + dir) * 2048 + k * 64 + dv]); }
    __syncthreads();
    const int hh = wid >> 2, h = 2 * hp + hh, qblk = wid & 3; const int n = 32 * qblk + l32; const int rq = r0 + n;
    const float lf = log2_sigmoid(p.ret_decay_f[l * 4 + h]), lb = log2_sigmoid(p.ret_decay_b[l * 4 + h]);
    float qv0[8], qv1[8]; bf16x8 qf0, qf1;
    { const bf16_t* qp = P + (size_t)rq * INW + h * 32 + 8 * hi; const bf16x8 a = *(const bf16x8*)qp, c2 = *(const bf16x8*)(qp + 16);
#pragma unroll
      for (int j = 0; j < 8; ++j) { float x1 = bf2f((unsigned short)a[j]), x2 = bf2f((unsigned short)c2[j]);
          if (lat) { const f32x2 cs = rope[(size_t)(t0 + n) * 16 + 8 * hi + j]; const float y1 = x1 * cs.x - x2 * cs.y, y2 = x2 * cs.x + x1 * cs.y; x1 = y1; x2 = y2; }
          qv0[j] = x1; qv1[j] = x2; }
      qf0 = pack8(qv0[0], qv0[1], qv0[2], qv0[3], qv0[4], qv0[5], qv0[6], qv0[7]); qf1 = pack8(qv1[0], qv1[1], qv1[2], qv1[3], qv1[4], qv1[5], qv1[6], qv1[7]); }
    f32x16 o0, o1;
#pragma unroll
    for (int r = 0; r < 16; ++r) { o0[r] = 0.f; o1[r] = 0.f; }
    const unsigned char* vbase = (const unsigned char*)VTl + (size_t)(hh * 64 + l32) * RT_VP + hi * 8;
#pragma unroll
    for (int kb = 0; kb < 4; ++kb) {
        bf16x8 kf0, kf1;
        { const int key = 32 * kb + l32; const bf16_t* kp = P + (size_t)(r0 + key) * INW + 128 + h * 32 + 8 * hi; const bf16x8 a = *(const bf16x8*)kp, c2 = *(const bf16x8*)(kp + 16);
          float y1[8], y2[8];
#pragma unroll
          for (int j = 0; j < 8; ++j) { float x1 = bf2f((unsigned short)a[j]), x2 = bf2f((unsigned short)c2[j]);
              if (lat) { const f32x2 cs = rope[(size_t)(t0 + key) * 16 + 8 * hi + j]; const float z1 = x1 * cs.x - x2 * cs.y, z2 = x2 * cs.x + x1 * cs.y; x1 = z1; x2 = z2; }
              y1[j] = x1 * 0.17677669529663687f; y2[j] = x2 * 0.17677669529663687f; }
          kf0 = pack8(y1[0], y1[1], y1[2], y1[3], y1[4], y1[5], y1[6], y1[7]); kf1 = pack8(y2[0], y2[1], y2[2], y2[3], y2[4], y2[5], y2[6], y2[7]); }
        f32x16 s;
#pragma unroll
        for (int r = 0; r < 16; ++r) s[r] = 0.f;
        s = __builtin_amdgcn_mfma_f32_32x32x16_bf16(kf0, qf0, s, 0, 0, 0); s = __builtin_amdgcn_mfma_f32_32x32x16_bf16(kf1, qf1, s, 0, 0, 0);
#pragma unroll
        for (int r = 0; r < 16; ++r) { const int m = 32 * kb + crow(r, hi); const int dl = n - m; const float e = dl >= 0 ? lf * (float)dl : lb * (float)(-dl); s[r] *= __builtin_amdgcn_exp2f(e); }
#pragma unroll
        for (int jp = 0; jp < 2; ++jp) { const bf16x8 pb = pack8(s[8 * jp + 0], s[8 * jp + 1], s[8 * jp + 2], s[8 * jp + 3], s[8 * jp + 4], s[8 * jp + 5], s[8 * jp + 6], s[8 * jp + 7]);
            const unsigned char* vp = vbase + (32 * kb + 16 * jp) * 2;
            const u32x2 a00 = *(const u32x2*)vp, a01 = *(const u32x2*)(vp + 16), a10 = *(const u32x2*)(vp + 32 * RT_VP), a11 = *(const u32x2*)(vp + 32 * RT_VP + 16);
            const bf16x8 A0 = __builtin_bit_cast(bf16x8, (u32x4){a00.x, a00.y, a01.x, a01.y}), A1 = __builtin_bit_cast(bf16x8, (u32x4){a10.x, a10.y, a11.x, a11.y});
            o0 = __builtin_amdgcn_mfma_f32_32x32x16_bf16(A0, pb, o0, 0, 0, 0); o1 = __builtin_amdgcn_mfma_f32_32x32x16_bf16(A1, pb, o1, 0, 0, 0); }
    }
    { const float df = __builtin_amdgcn_exp2f(lf * (float)(n + 1)), db = __builtin_amdgcn_exp2f(lb * (float)(128 - n));
      const unsigned char* sbase = (const unsigned char*)STl + (size_t)(hh * 64 + l32) * RT_SP + hi * 16;
#pragma unroll
      for (int ks = 0; ks < 4; ++ks) { const float dd = ks < 2 ? df : db;
          const bf16x8 qb = (ks & 1) ? pack8(qv1[0] * dd, qv1[1] * dd, qv1[2] * dd, qv1[3] * dd, qv1[4] * dd, qv1[5] * dd, qv1[6] * dd, qv1[7] * dd)
                                     : pack8(qv0[0] * dd, qv0[1] * dd, qv0[2] * dd, qv0[3] * dd, qv0[4] * dd, qv0[5] * dd, qv0[6] * dd, qv0[7] * dd);
          const bf16x8 A0 = *(const bf16x8*)(sbase + ks * 32), A1 = *(const bf16x8*)(sbase + 32 * RT_SP + ks * 32);
          o0 = __builtin_amdgcn_mfma_f32_32x32x16_bf16(A0, qb, o0, 0, 0, 0); o1 = __builtin_amdgcn_mfma_f32_32x32x16_bf16(A1, qb, o1, 0, 0, 0); } }
    float ssq = 0.f;
#pragma unroll
    for (int r = 0; r < 16; ++r) ssq += o0[r] * o0[r] + o1[r] * o1[r];
    ssq += __shfl_xor(ssq, 32);
    const float rstd = rsqrtf(ssq * (1.f / 64.f) + EPS);
    const bf16_t* gp = P + (size_t)rq * INW + 512 + h * 64 + 4 * hi; bf16_t* op = MIX + (size_t)rq * 1024 + h * 64 + 4 * hi;
#pragma unroll
    for (int g4 = 0; g4 < 4; ++g4) { const u32x2 ga = *(const u32x2*)(gp + 8 * g4), gb = *(const u32x2*)(gp + 32 + 8 * g4);
        u32x2 w0, w1;
        w0.x = pk2(o0[4 * g4] * rstd * siluf(bf2f(ga.x & 0xffff)), o0[4 * g4 + 1] * rstd * siluf(bf2f(ga.x >> 16))); w0.y = pk2(o0[4 * g4 + 2] * rstd * siluf(bf2f(ga.y & 0xffff)), o0[4 * g4 + 3] * rstd * siluf(bf2f(ga.y >> 16)));
        w1.x = pk2(o1[4 * g4] * rstd * siluf(bf2f(gb.x & 0xffff)), o1[4 * g4 + 1] * rstd * siluf(bf2f(gb.x >> 16))); w1.y = pk2(o1[4 * g4 + 2] * rstd * siluf(bf2f(gb.y & 0xffff)), o1[4 * g4 + 3] * rstd * siluf(bf2f(gb.y >> 16)));
        *(u32x2*)(op + 8 * g4) = w0; *(u32x2*)(op + 32 + 8 * g4) = w1; }
}

DEV void phase_convact(const Params& p, int l, int hf) {
    const bf16_t* U = (const bf16_t*)(p.ws + OFF_OV + OV_U); bf16_t* ACT = (bf16_t*)p.out;
    const float* cw = p.conv_w + (size_t)l * 3 * 5632; const float* cbv = p.conv_b + (size_t)l * 5632;
    const bf16x8 z = {0, 0, 0, 0, 0, 0, 0, 0};
    for (int idx = blockIdx.x * NWG_T + otid(); idx < 176 * 528; idx += gridDim.x * NWG_T) {
        const int rc = idx / 176, j8 = idx - rc * 176; const int r0 = rc * 32; const int b = r0 / RB, s0 = r0 - b * RB;
        if (l == 1 && s0 < NCTX) continue;
        const int ca = hf * HFF + j8 * 8, cbc = DFF + hf * HFF + j8 * 8;
        f32x4 wa[3][2], wb[3][2], ba[2], bb[2];
#pragma unroll
        for (int k = 0; k < 3; ++k)
#pragma unroll
            for (int q = 0; q < 2; ++q) { wa[k][q] = *(const f32x4*)(cw + k * 5632 + ca + 4 * q); wb[k][q] = *(const f32x4*)(cw + k * 5632 + cbc + 4 * q); }
#pragma unroll
        for (int q = 0; q < 2; ++q) { ba[q] = *(const f32x4*)(cbv + ca + 4 * q); bb[q] = *(const f32x4*)(cbv + cbc + 4 * q); }
        const bool first = (s0 == 0) || (s0 == NCTX); const bool lastc = (s0 + 32 == NCTX) || (s0 + 32 == RB);
        const bf16_t* ur = U + (size_t)r0 * DFF + j8 * 8;
        bf16x8 ra[6], rb[6], na[4], nb[4];
        ra[0] = first ? z : *(const bf16x8*)(ur - DFF); rb[0] = first ? z : *(const bf16x8*)(ur - DFF + HFF);
#pragma unroll
        for (int k = 1; k < 6; ++k) { ra[k] = *(const bf16x8*)(ur + (size_t)(k - 1) * DFF); rb[k] = *(const bf16x8*)(ur + (size_t)(k - 1) * DFF + HFF); }
        for (int g = 0; g < 8; ++g) {
#pragma unroll
            for (int k = 0; k < 4; ++k) { const int i = 4 * g + 5 + k;
                const bool ok = i < 32 || (i == 32 && !lastc);
                na[k] = ok ? *(const bf16x8*)(ur + (size_t)i * DFF) : z; nb[k] = ok ? *(const bf16x8*)(ur + (size_t)i * DFF + HFF) : z; }
#pragma unroll
            for (int k = 0; k < 4; ++k) { float o[8];
#pragma unroll
                for (int j = 0; j < 8; ++j) { const int q = j >> 2, e = j & 3;
                    const float ua = bf2f((unsigned short)ra[k][j]) * wa[0][q][e] + bf2f((unsigned short)ra[k + 1][j]) * wa[1][q][e] + bf2f((unsigned short)ra[k + 2][j]) * wa[2][q][e] + ba[q][e];
                    const float ub = bf2f((unsigned short)rb[k][j]) * wb[0][q][e] + bf2f((unsigned short)rb[k + 1][j]) * wb[1][q][e] + bf2f((unsigned short)rb[k + 2][j]) * wb[2][q][e] + bb[q][e];
                    o[j] = siluf(ua) * ub; }
                *(bf16x8*)(ACT + (size_t)(r0 + 4 * g + k) * HFF + j8 * 8) = pack8(o[0], o[1], o[2], o[3], o[4], o[5], o[6], o[7]); }
            ra[0] = ra[4]; rb[0] = rb[4]; ra[1] = ra[5]; rb[1] = rb[5];
#pragma unroll
            for (int k = 0; k < 4; ++k) { ra[2 + k] = na[k]; rb[2 + k] = nb[k]; }
        }
    }
}

#define RLX_AGENT __ATOMIC_RELAXED, __HIP_MEMORY_SCOPE_AGENT
#define XB_TMO      128
#define XB_XCNT(j)  (256  + 64 * (j))
#define XB_XSUB(j)  (1280 + 64 * (j))
#define XB_XGEN(j)  (2304 + 64 * (j))
#define XB_TOP      3328
#define XB_TOPGEN   3392
#define XCD_BAR_WORDS 3456
#define XB_SPIN_CAP (1u << 18)

__device__ __forceinline__ unsigned xb_ld(unsigned* p)              { return __hip_atomic_load(p, __ATOMIC_RELAXED, __HIP_MEMORY_SCOPE_AGENT); }
__device__ __forceinline__ unsigned xb_add(unsigned* p, unsigned v) { return __hip_atomic_fetch_add(p, v, __ATOMIC_RELAXED, __HIP_MEMORY_SCOPE_AGENT); }
__device__ __forceinline__ unsigned xb_xcc_id() { return (unsigned)__builtin_amdgcn_s_getreg((3 << 11) | 20) & 0xFu; }
#define XB_SPIN(cond, bar) do { unsigned _sp = 0; while (cond) { __builtin_amdgcn_s_sleep(1); \
    if ((++_sp & 255u) == 0u) { if (xb_ld(&(bar)[XB_TMO])) break; if (_sp > XB_SPIN_CAP) { atomicAdd(&(bar)[XB_TMO], 1u); break; } } } } while (0)

struct XcdBarrier {
    unsigned* bar; unsigned x;
    volatile LAS unsigned* st;
};

__device__ __forceinline__ XcdBarrier xcd_barrier_post(unsigned* bar, volatile LAS unsigned* st) {
    XcdBarrier b; b.bar = bar; b.x = xb_xcc_id(); b.st = st;
    if (threadIdx.x == 0) (void)xb_add(&bar[XB_XCNT(b.x)], 1u);
    return b;
}
__device__ __forceinline__ void xcd_barrier_complete(unsigned* bar, unsigned x, unsigned& nloc, unsigned& nx) {
    const unsigned G = gridDim.x * gridDim.y * gridDim.z;
    unsigned sum, cnt, mine, sp = 0u;
    for (;;) {
        sum = 0u; cnt = 0u; mine = 0u;
#pragma unroll
        for (unsigned j = 0; j < 16; ++j) { const unsigned c = xb_ld(&bar[XB_XCNT(j)]); sum += c; cnt += (c > 0u) ? 1u : 0u; mine = (j == x) ? c : mine; }
        if (sum == G) break;
        __builtin_amdgcn_s_sleep(1);
        if ((++sp & 255u) == 0u) { if (xb_ld(&bar[XB_TMO])) break; if (sp > XB_SPIN_CAP) { atomicAdd(&bar[XB_TMO], 1u); break; } }
    }
    nloc = mine > 0u ? mine : 1u; nx = cnt > 0u ? cnt : 1u;
}

__device__ __forceinline__ void xcd_barrier(const XcdBarrier& b) {
    asm volatile("s_waitcnt vmcnt(0)" ::: "memory");
    __syncthreads();
    if (threadIdx.x == 0) {
        unsigned* bar = b.bar;
        __builtin_amdgcn_s_waitcnt(0);
        unsigned nloc = b.st[0], nx = b.st[1];
        if (nloc == 0u) { xcd_barrier_complete(bar, b.x, nloc, nx); b.st[0] = nloc; b.st[1] = nx; }
        const unsigned old = xb_add(&bar[XB_XSUB(b.x)], 1u);
        const unsigned gen = old / nloc;
        if (old + 1u == (gen + 1u) * nloc) {
            __builtin_amdgcn_fence(__ATOMIC_RELEASE, "agent");
            asm volatile("s_waitcnt vmcnt(0)" ::: "memory");
            const unsigned og = xb_add(&bar[XB_TOP], 1u);
            const unsigned tg = og / nx;
            if (og + 1u == (tg + 1u) * nx) xb_add(&bar[XB_TOPGEN], 1u);
            else XB_SPIN(xb_ld(&bar[XB_TOPGEN]) == tg, bar);
            __builtin_amdgcn_fence(__ATOMIC_ACQUIRE, "agent");
            xb_add(&bar[XB_XGEN(b.x)], 1u);
            asm volatile("s_waitcnt vmcnt(0)" ::: "memory");
        } else {
            XB_SPIN(xb_ld(&bar[XB_XGEN(b.x)]) == gen, bar);
            __builtin_amdgcn_fence(__ATOMIC_ACQUIRE, "agent");
            asm volatile("s_waitcnt vmcnt(0)" ::: "memory");
        }
    }
    __syncthreads();
}


constexpr size_t OFF_CTL = 250000128; constexpr int CTL_BYTES = 16384;
#if defined(__HIP_DEVICE_COMPILE__)
#define KP() const __attribute__((address_space(4))) Params* kp_ = (const __attribute__((address_space(4))) Params*)__builtin_amdgcn_kernarg_segment_ptr(); asm volatile("" : "+s"(kp_)); const Params p = *kp_; \
    bf16_t* HN = (bf16_t*)(p.ws + OFF_HN); bf16_t* P = (bf16_t*)p.out; float* X = (float*)(p.ws + OFF_X); (void)HN; (void)P; (void)X
#else
#define KP() const Params p = p_arg; bf16_t* HN = (bf16_t*)(p.ws + OFF_HN); bf16_t* P = (bf16_t*)p.out; float* X = (float*)(p.ws + OFF_X); (void)HN; (void)P; (void)X
#endif
#define WL() const bf16_t* wl = (const bf16_t*)(p.ws + OFF_W) + (size_t)l * W_LAYER; const float* modv = (const float*)(p.ws + OFF_MOD) + (size_t)l * 3 * 6144; (void)wl; (void)modv
#ifndef DUPM
#define DUPM 0
#endif
#define REP(bit) for (int rep_ = 0; rep_ < (((DUPM) >> (bit)) & 1) + 1; ++rep_)
constexpr int PH_PER_LAYER = 12, N_PHASES = 2 + 2 * PH_PER_LAYER;
__global__ void __launch_bounds__(512, 2) mk_fwd(Params p_arg) {
    extern __shared__ __attribute__((aligned(16))) unsigned char lds[];
    cg::grid_group grid = cg::this_grid();
    const int G = gridDim.x, bx = blockIdx.x; const int vcu = (G % 8 == 0) ? (bx % 8) * (G / 8) + bx / 8 : bx;
    LAS unsigned char* ldsl = (LAS unsigned char*)lds;
    const int ph_lo = p_arg.ph_lo, ph_hi = p_arg.ph_hi;
    volatile LAS unsigned* misc = (volatile LAS unsigned*)(ldsl + (LDS_BYTES - 64));
    { const int t0_ = otid(); if (t0_ < 16) misc[t0_] = 0u; }
    __syncthreads();
    if (ph_hi - ph_lo > 1) (void)xcd_barrier_post((unsigned*)(p_arg.ws + OFF_CTL), misc);
    for (int ph = ph_lo; ph < ph_hi; ++ph) {
        if (ph == 0) { KP(); REP(9) { phase_prep(p, lds); __syncthreads(); } }
        else if (ph == N_PHASES - 1) { KP(); REP(0) phase_final(p);
#if (DUPM >> 10) & 1
            for (int i = 0; i < 20; ++i) grid.sync();
#endif
        }
        else {
            const int l = (ph - 1) / PH_PER_LAYER, sp = (ph - 1) % PH_PER_LAYER;
            if (sp == 0) { KP(); REP(0) phase_norm(p, l, 0, l == 0); }
            else if (sp == 1) { KP(); WL(); REP(1) { __syncthreads();
                pg8::Gemm g{HN, wl + W_IN, R, 1792, 1024, 1024, 1024}; pg8::StaticOrder S; S.init(R, 1792, G, bx);
                pg8::EpiStore E{P, INW, INW, 1.0f};
                pg8::gemm_phase<pg8::EpiStore, pg8::StaticOrder, true, true>(ldsl, g, S, E); } }
            else if (sp == 2) { KP(); phase_rowwise(p, l); __syncthreads();
                REP(2) phase_pool(p);
                REP(3) for (int it = bx; it < 528; it += G) states_item(p, l, lds, it); }
            else if (sp == 3) { KP(); WL(); REP(4) { __syncthreads();
                { pg8::Gemm g{P + 768, wl + W_UQ, R, 768, 384, INW, 384}; pg8::StaticOrder S; S.init(R, 768, G, bx);
                  pg8::EpiStore E{(bf16_t*)(p.ws + OFF_OV + OV_Q), 768, 768, 0.14724444f};
                  pg8::gemm_phase<pg8::EpiStore, pg8::StaticOrder, true, true>(ldsl, g, S, E); }
                __syncthreads();
                { pg8::Gemm g{P + 1152, wl + W_KN, R, 512, 256, INW, 256}; pg8::StaticOrder S; S.init(R, 512, G, (bx + 58) % G);
                  pg8::EpiStore E{(bf16_t*)(p.ws + OFF_OV + OV_KN), 512, 512, 1.0f};
                  pg8::gemm_phase<pg8::EpiStore, pg8::StaticOrder, true, true>(ldsl, g, S, E); }
                __syncthreads();
                { pg8::Gemm g{wl + W_V, P + 1152, 512, R, 256, 256, INW}; pg8::StaticOrder S; S.init(512, R, G, (bx + 182) % G);
                  pg8::EpiStore E{(bf16_t*)(p.ws + OFF_OV + OV_VT), R, R, 1.0f};
                  pg8::gemm_phase<pg8::EpiStore, pg8::StaticOrder, true, true>(ldsl, g, S, E); }
                if (bx >= G - 64) scan_threads(p, l, (bx - (G - 64)) * NWG_T + otid()); } }
            else if (sp == 4) { KP();
                REP(5) for (int u = vcu; u < (l == 0 ? 528 : 512); u += G) attn_unit(p, lds, u);
                REP(6) for (int u = G - 1 - bx; u < (l == 0 ? 264 : 256); u += G) retout_unit(p, l, lds, l == 0 ? u : u + 4 * (u >> 7) + 4); }
            else if (sp == 5) { KP(); WL(); __syncthreads();
                pg8::Gemm g{HN, wl + W_OUT, R, 1024, 1024, 1024, 1024}; pg8::StaticOrder S; S.init(l == 1 ? 16384 : R, 1024, G, bx, l == 1 ? 1 : 0);
                pg8::EpiResid E{X, modv + 2048, 0};
                pg8::gemm_phase<pg8::EpiResid, pg8::StaticOrder, true, true>(ldsl, g, S, E); }
            else if (sp == 6) { KP(); REP(0) phase_norm(p, l, 1, false); }
            else if (sp == 7 || sp == 9 || sp == 11) { KP(); WL();
                __syncthreads();
                if (sp >= 9) { const int hf = sp == 9 ? 0 : 1;
                    pg8::Gemm g{P, wl + W_DN + hf * HFF, R, 1024, HFF, HFF, DFF}; pg8::StaticOrder S; S.init(l == 1 ? 16384 : R, 1024, G, bx, l == 1 ? 1 : 0);
                    pg8::EpiResid E{X, modv + 5120, 0};
                    pg8::gemm_phase<pg8::EpiResid, pg8::StaticOrder, true, true>(ldsl, g, S, E); __syncthreads(); }
                if (sp <= 9) REP(7) { __syncthreads(); const int hf = sp == 7 ? 0 : 1;
                    pg8::Gemm g{HN, wl + W_UP + (size_t)hf * DFF * 1024, R, DFF, 1024, 1024, 1024}; pg8::StaticOrder S; S.init(l == 1 ? 16384 : R, DFF, G, (bx + (sp == 9 && l == 0 ? 8 : 0)) % G, l == 1 ? 1 : 0);
                    pg8::EpiStore E{(bf16_t*)(p.ws + OFF_OV + OV_U), DFF, DFF, 1.0f};
                    pg8::gemm_phase<pg8::EpiStore, pg8::StaticOrder, true, true>(ldsl, g, S, E); } }
            else if (sp == 8) { KP(); REP(8) phase_convact(p, l, 0); }
            else if (sp == 10) { KP(); REP(8) phase_convact(p, l, 1); }
        }
        if (ph + 1 < ph_hi) {
            if (ph == ph_lo) grid.sync();
            else { KP(); XcdBarrier b; b.bar = (unsigned*)(p.ws + OFF_CTL); b.x = xb_xcc_id(); b.st = misc; xcd_barrier(b); }
        }
    }
}

extern "C" void kernel_launch(void* const* d_in, const int* in_sizes, int n_in, void* d_out, int out_size, void* d_ws, size_t ws_size, hipStream_t stream) {
    static int grid = 0;
    if (grid == 0) {
        if (n_in != 23 || ws_size < WS_NEED) { fprintf(stderr, "kernel_launch: unexpected problem (n_in %d, ws %zu, need %zu)\n", n_in, ws_size, (size_t)WS_NEED); grid = -1; return; }
        int dev = 0, cus = 0, per_cu = 0;
        hipGetDevice(&dev); hipDeviceGetAttribute(&cus, hipDeviceAttributeMultiprocessorCount, dev);
        if (hipFuncSetAttribute((const void*)mk_fwd, hipFuncAttributeMaxDynamicSharedMemorySize, LDS_BYTES) != hipSuccess) { fprintf(stderr, "kernel_launch: hipFuncSetAttribute failed\n"); grid = -1; return; }
        if (hipOccupancyMaxActiveBlocksPerMultiprocessor(&per_cu, (const void*)mk_fwd, 512, LDS_BYTES) != hipSuccess || per_cu < 1) { fprintf(stderr, "kernel_launch: occupancy query says %d\n", per_cu); per_cu = 1; }
        (void)hipGetLastError();
        grid = cus * per_cu; if (grid > 256) grid = 256;
        fprintf(stderr, "kernel_launch: grid %d (cus %d, per_cu %d)\n", grid, cus, per_cu);
    }
    if (grid < 0) return;
    Params p{};
    const float** pp = (const float**)&p;
    for (int i = 0; i < 23; ++i) pp[i] = (const float*)d_in[i];
    p.out = (float*)d_out; p.ws = (unsigned char*)d_ws;
#if MK_MULTI
    for (int ph = 0; ph < N_PHASES; ++ph) { p.ph_lo = ph; p.ph_hi = ph + 1; void* args[] = {&p};
        hipError_t e = hipLaunchCooperativeKernel((void*)mk_fwd, dim3(grid), dim3(512), args, LDS_BYTES, stream);
        if (e != hipSuccess) { fprintf(stderr, "launch %d failed: %s\n", ph, hipGetErrorString(e)); break; } }
#else
    if (hipMemsetAsync((char*)d_ws + OFF_CTL, 0, CTL_BYTES, stream) != hipSuccess) { fprintf(stderr, "kernel_launch: memset of the barrier words failed\n"); return; }
    p.ph_lo = 0; p.ph_hi = N_PHASES; void* args[] = {&p};
    hipError_t e = hipLaunchCooperativeKernel((void*)mk_fwd, dim3(grid), dim3(512), args, LDS_BYTES, stream);
    if (e != hipSuccess) fprintf(stderr, "cooperative launch failed: %s (grid %d)\n", hipGetErrorString(e), grid);
#endif
}
```

```cpp
#include <hip/hip_runtime.h>
#include <hip/hip_cooperative_groups.h>
#include <cstdio>
#include <cstdint>
namespace cg = cooperative_groups;

#ifndef MK_MULTI
#define MK_MULTI 0
#endif

namespace pg8 {
#define PG8_LAS __attribute__((address_space(3)))
typedef unsigned short bf16_t;
typedef short bf16x8 __attribute__((ext_vector_type(8)));
typedef float f32x4 __attribute__((ext_vector_type(4)));
typedef unsigned u32x4 __attribute__((ext_vector_type(4)));
constexpr int BM = 256, BK = 64, HALF = 128, HTB = HALF * BK * 2  , STAGE_BYTES = 8 * HTB, NXCD = 8, WGM = 8;

__host__ __device__ __forceinline__ int lds_byte(int r, int c) { const int st = (r >> 4) * 2 + (c >> 5), rr = r & 15, cc = c & 31, ob = rr * 64 + cc * 2; return st * 1024 + (ob ^ (((ob >> 9) & 1) << 5)); }
__host__ __device__ __forceinline__ void stage_rc(int b, int& R, int& C) { const int st = b / 1024, sb = b % 1024, swz = sb ^ (((sb >> 9) & 1) << 5); R = (st >> 1) * 16 + swz / 64; C = (st & 1) * 32 + (swz % 64) / 2; }
__host__ __device__ __forceinline__ int perm32(int rho) { const int n = rho >> 4, i = rho & 15; return 8 * (i >> 2) + 4 * n + (i & 3); }

struct Unit { int pm, pn; };
struct Gemm { const bf16_t* A; const bf16_t* Bt; int M, N, K, lda, ldb; };

struct StaticOrder {
    int nM, nN, nwg, G, c, skip;
    __host__ __device__ void init(int M, int N, int G_, int c_, int skip_ = 0) { nM = M / BM; nN = N / BM; nwg = nM * nN; G = G_; c = c_; skip = skip_; }
    __host__ __device__ bool next(int i, Unit& u) const {
        const long L = (long)i * G + c; if (L >= nwg) return false;
        int wgid = (int)L; { const int q = nwg / NXCD, r = nwg % NXCD, xcd = wgid % NXCD, off = wgid / NXCD; wgid = (xcd < r ? xcd * (q + 1) : r * (q + 1) + (xcd - r) * q) + off; }
        const int nig = WGM * nN, gid = wgid / nig, fm = gid * WGM, gsz = (nM - fm) < WGM ? (nM - fm) : WGM;
        u.pm = fm + ((wgid % nig) % gsz); u.pn = (wgid % nig) / gsz; if (skip == 1) u.pm += 1 + (u.pm >= 32 ? 1 : 0); else if (skip == 2) u.pm *= 33; return true;
    }
    __device__ __forceinline__ void a_ready(const Unit&) const {}
    __device__ __forceinline__ void done(const Unit&) const {}
};

__device__ __forceinline__ unsigned cvt_pk_bf16(float lo, float hi) { unsigned r; asm volatile("v_cvt_pk_bf16_f32 %0, %1, %2" : "=v"(r) : "v"(lo), "v"(hi)); return r; }

struct EpiStore {
    static constexpr bool PERM = true, AFTER_DRAIN = false;
    bf16_t* O; int ldc; int ncols; float scale;
    __device__ __forceinline__ void operator()(const f32x4 (&acc)[2][2][4][2], const Unit& u, int wr, int wc, int fr, int fq) const {
        const int row0 = u.pm * BM + wr * 64 + fr; const int col0 = u.pn * BM + wc * 32 + 8 * fq;
#pragma unroll
        for (int ai = 0; ai < 2; ++ai)
#pragma unroll
            for (int m = 0; m < 4; ++m) { bf16_t* rowp = O + (size_t)(row0 + ai * HALF + m * 16) * ldc + col0;
#pragma unroll
                for (int bj = 0; bj < 2; ++bj) { if (col0 + bj * HALF < ncols) {
                    f32x4 v0 = acc[ai][bj][m][0] * scale, v1 = acc[ai][bj][m][1] * scale;
                    u32x4 w; w.x = cvt_pk_bf16(v0[0], v0[1]); w.y = cvt_pk_bf16(v0[2], v0[3]); w.z = cvt_pk_bf16(v1[0], v1[1]); w.w = cvt_pk_bf16(v1[2], v1[3]);
                    *(u32x4*)(rowp + bj * HALF) = w; } } }
    }
};
struct EpiResid {
    static constexpr bool PERM = false, AFTER_DRAIN = false;
    float* X; const float* gate; int row_tile0;
    __device__ __forceinline__ void operator()(const f32x4 (&acc)[2][2][4][2], const Unit& u, int wr, int wc, int fr, int fq) const {
        const int tpm = u.pm + row_tile0; const int bb = tpm / 33, jj = tpm - bb * 33; const float* gv = gate + (jj == 0 ? 2 : bb) * 6144;
        const int col0 = u.pn * BM + wc * 32 + 4 * fq;
#pragma unroll
        for (int ai = 0; ai < 2; ++ai)
#pragma unroll
            for (int m = 0; m < 4; ++m) { float* rowp = X + (size_t)(tpm * BM + ai * HALF + wr * 64 + m * 16 + fr) * 1024 + col0;
#pragma unroll
                for (int bj = 0; bj < 2; ++bj) {
#pragma unroll
                    for (int n = 0; n < 2; ++n) { f32x4* q = (f32x4*)(rowp + bj * HALF + n * 16); const f32x4 gq = *(const f32x4*)(gv + col0 + bj * HALF + n * 16); f32x4 xv = *q; xv = xv + gq * acc[ai][bj][m][n]; *q = xv; }
                    asm volatile("" ::: "memory"); } }
    }
};
struct EpiPart {
    static constexpr bool PERM = false, AFTER_DRAIN = false;
    float* out; int accum;
    __device__ __forceinline__ void operator()(const f32x4 (&acc)[2][2][4][2], const Unit& u, int wr, int wc, int fr, int fq) const {
        const int t = u.pm / 33; const int col0 = u.pn * BM + wc * 32 + 4 * fq;
#pragma unroll
        for (int ai = 0; ai < 2; ++ai)
#pragma unroll
            for (int m = 0; m < 4; ++m) { float* rowp = out + (size_t)(t * BM + ai * HALF + wr * 64 + m * 16 + fr) * 1024 + col0;
#pragma unroll
                for (int bj = 0; bj < 2; ++bj) {
#pragma unroll
                    for (int n = 0; n < 2; ++n) { f32x4* q = (f32x4*)(rowp + bj * HALF + n * 16); f32x4 v = acc[ai][bj][m][n]; if (accum) v = v + *q; *q = v; }
                    asm volatile("" ::: "memory"); } }
    }
};

template <class Epi, class Sched, bool ALIGN_EPI = false, bool SP2 = false>
__device__ __forceinline__ void gemm_phase(PG8_LAS unsigned char* lds, const Gemm g, const Sched& S, const Epi& E) {
    int tid = threadIdx.x; asm volatile("" : "+v"(tid));
    const int wid = __builtin_amdgcn_readfirstlane(tid >> 6), lane = tid & 63, wr = wid >> 2, wc = wid & 3, fr = lane & 15, fq = lane >> 4;
    int K = g.K; asm volatile("" : "+s"(K));
    const int nt = K / BK;
    unsigned voffA[2], voffB[2];
#pragma unroll
    for (int i = 0; i < 2; ++i) { int R, C; stage_rc(tid * 16 + i * 8192, R, C); const int Rb = Epi::PERM ? ((R & ~31) + perm32(R & 31)) : R;
        voffA[i] = (unsigned)(R * g.lda + C) * 2u; voffB[i] = (unsigned)(Rb * g.ldb + C) * 2u; }
    const size_t kstep = (size_t)(BK * 2);
    const size_t hstepA = (size_t)HALF * g.lda * 2, hstepB = (size_t)HALF * g.ldb * 2;
    const size_t tstepA = 2 * hstepA, tstepB = 2 * hstepB;
    const unsigned ldsw = (unsigned)wid * 1024u;
    const int aoff = lds_byte(wr * 64 + fr, fq * 8), boff = lds_byte(wc * 32 + fr, fq * 8);
#define PG8_SA(b, h) (((b) * 2 + (h)) * HTB)
#define PG8_SB(b, h) ((4 + (b) * 2 + (h)) * HTB)
#define PG8_STAGE(bufoff, gbase, voff) do { _Pragma("unroll") for (int _i = 0; _i < 2; ++_i) \
        __builtin_amdgcn_global_load_lds((const unsigned*)((const char*)(gbase) + (voff)[_i]), (PG8_LAS unsigned*)(lds + (bufoff) + ldsw + _i * 8192), 16, 0, 0); } while (0)
#define PG8_LDA(dst, b, h) do { _Pragma("unroll") for (int m = 0; m < 4; ++m) _Pragma("unroll") for (int k = 0; k < 2; ++k) dst[m][k] = *(const PG8_LAS bf16x8*)(lds + PG8_SA(b, h) + aoff + m * 2048 + k * 1024); } while (0)
#define PG8_LDB(dst, b, h) do { _Pragma("unroll") for (int n = 0; n < 2; ++n) _Pragma("unroll") for (int k = 0; k < 2; ++k) dst[n][k] = *(const PG8_LAS bf16x8*)(lds + PG8_SB(b, h) + boff + n * 2048 + k * 1024); } while (0)
#define PG8_MMA(ai, bj, At, Bt) do { __builtin_amdgcn_s_setprio(1); _Pragma("unroll") for (int m = 0; m < 4; ++m) _Pragma("unroll") for (int n = 0; n < 2; ++n) _Pragma("unroll") for (int k = 0; k < 2; ++k) \
        acc[ai][bj][m][n] = __builtin_amdgcn_mfma_f32_16x16x32_bf16(Bt[n][k], At[m][k], acc[ai][bj][m][n], 0, 0, 0); __builtin_amdgcn_s_setprio(0); } while (0)
#define PG8_WAIT_V(n) asm volatile("s_waitcnt vmcnt(" #n ")" ::: "memory")
#define PG8_WAIT_L(n) asm volatile("s_waitcnt lgkmcnt(" #n ")" ::: "memory")
#define PG8_BAR __builtin_amdgcn_s_barrier()
#define PG8_SCHED __builtin_amdgcn_sched_barrier(0)
    Unit cur, nxt; int ui = 0;
    if (!S.next(0, cur)) return;
    f32x4 acc[2][2][4][2];
#pragma unroll
    for (int a = 0; a < 2; ++a)
#pragma unroll
        for (int b = 0; b < 2; ++b)
#pragma unroll
            for (int m = 0; m < 4; ++m)
#pragma unroll
                for (int n = 0; n < 2; ++n) acc[a][b][m][n] = (f32x4){0.f, 0.f, 0.f, 0.f};
    bf16x8 At[4][2], B0[2][2], B1[2][2];
    const char* cA = (const char*)g.A + (size_t)cur.pm * tstepA; const char* cB = (const char*)g.Bt + (size_t)cur.pn * tstepB;
    S.a_ready(cur);
    if constexpr (SP2) {
        PG8_STAGE(PG8_SB(0, 0), cB, voffB); PG8_STAGE(PG8_SB(0, 1), cB + hstepB, voffB); PG8_STAGE(PG8_SA(0, 0), cA, voffA); PG8_STAGE(PG8_SA(0, 1), cA + hstepA, voffA);
        if (wr == 1) PG8_BAR;
        PG8_WAIT_V(2); PG8_BAR;
        PG8_STAGE(PG8_SB(1, 0), cB + kstep, voffB); PG8_STAGE(PG8_SA(1, 0), cA + kstep, voffA); PG8_STAGE(PG8_SB(1, 1), cB + hstepB + kstep, voffB);
        PG8_WAIT_V(6); PG8_BAR;
    } else {
        PG8_STAGE(PG8_SB(0, 0), cB, voffB); PG8_STAGE(PG8_SA(0, 0), cA, voffA); PG8_STAGE(PG8_SB(0, 1), cB + hstepB, voffB); PG8_STAGE(PG8_SA(0, 1), cA + hstepA, voffA);
        if (wr == 1) PG8_BAR;
        PG8_WAIT_V(4); PG8_BAR;
        PG8_STAGE(PG8_SB(1, 0), cB + kstep, voffB); PG8_STAGE(PG8_SA(1, 0), cA + kstep, voffA); PG8_STAGE(PG8_SB(1, 1), cB + hstepB + kstep, voffB);
        PG8_WAIT_V(6); PG8_BAR;
    }
    for (;;) {
        const bool has_next = S.next(ui + 1, nxt);
        const char* nA = has_next ? (const char*)g.A + (size_t)nxt.pm * tstepA : cA; const char* nB = has_next ? (const char*)g.Bt + (size_t)nxt.pn * tstepB : cB;
        for (int t = 0; t < nt; t += 2) {
            const bool last = (t == nt - 2);
            const char* a1 = cA + (size_t)(t + 1) * kstep;
            const char* a2 = last ? nA : cA + (size_t)(t + 2) * kstep; const char* b2 = last ? nB : cB + (size_t)(t + 2) * kstep;
            const char* a3 = a2 + kstep; const char* b3 = b2 + kstep;
            if (last && has_next) S.a_ready(nxt);
            if constexpr (SP2) {
            PG8_LDB(B0, 0, 0); PG8_LDB(B1, 0, 1); PG8_SCHED; PG8_LDA(At, 0, 0); PG8_STAGE(PG8_SA(1, 1), a1 + hstepA, voffA);
            PG8_WAIT_V(8); PG8_WAIT_L(0); PG8_BAR; PG8_MMA(0, 0, At, B0); PG8_MMA(0, 1, At, B1); PG8_BAR; PG8_SCHED;
            PG8_LDA(At, 0, 1); PG8_STAGE(PG8_SB(0, 0), b2, voffB); PG8_STAGE(PG8_SB(0, 1), b2 + hstepB, voffB); PG8_STAGE(PG8_SA(0, 0), a2, voffA);
            PG8_WAIT_V(8); PG8_WAIT_L(0); PG8_BAR; PG8_MMA(1, 0, At, B0); PG8_MMA(1, 1, At, B1); PG8_BAR; PG8_SCHED;
            PG8_LDB(B0, 1, 0); PG8_LDB(B1, 1, 1); PG8_SCHED; PG8_LDA(At, 1, 0); PG8_STAGE(PG8_SA(0, 1), a2 + hstepA, voffA);
            PG8_WAIT_V(8); PG8_WAIT_L(0); PG8_BAR; PG8_MMA(0, 0, At, B0); PG8_MMA(0, 1, At, B1); PG8_BAR; PG8_SCHED;
            PG8_LDA(At, 1, 1); PG8_STAGE(PG8_SB(1, 0), b3, voffB); PG8_STAGE(PG8_SB(1, 1), b3 + hstepB, voffB); PG8_STAGE(PG8_SA(1, 0), a3, voffA);
            PG8_WAIT_V(8); PG8_WAIT_L(0); PG8_BAR; PG8_MMA(1, 0, At, B0); PG8_MMA(1, 1, At, B1); PG8_BAR; PG8_SCHED;
            } else {
            PG8_LDB(B0, 0, 0); PG8_SCHED; PG8_LDA(At, 0, 0); PG8_STAGE(PG8_SA(1, 1), a1 + hstepA, voffA);
            PG8_WAIT_L(8); PG8_BAR; PG8_WAIT_L(0); PG8_MMA(0, 0, At, B0); PG8_BAR; PG8_SCHED;
            PG8_LDB(B1, 0, 1); PG8_STAGE(PG8_SB(0, 0), b2, voffB);
            PG8_BAR; PG8_WAIT_L(0); PG8_MMA(0, 1, At, B1); PG8_BAR;
            PG8_LDA(At, 0, 1); PG8_STAGE(PG8_SA(0, 0), a2, voffA);
            PG8_BAR; PG8_WAIT_L(0); PG8_MMA(1, 0, At, B0); PG8_BAR; PG8_SCHED;
            PG8_STAGE(PG8_SB(0, 1), b2 + hstepB, voffB);
            PG8_WAIT_V(6); PG8_BAR; PG8_MMA(1, 1, At, B1); PG8_BAR;
            PG8_LDB(B0, 1, 0); PG8_SCHED; PG8_LDA(At, 1, 0); PG8_STAGE(PG8_SA(0, 1), a2 + hstepA, voffA);
            PG8_WAIT_L(8); PG8_BAR; PG8_WAIT_L(0); PG8_MMA(0, 0, At, B0); PG8_BAR; PG8_SCHED;
            PG8_LDB(B1, 1, 1); PG8_STAGE(PG8_SB(1, 0), b3, voffB);
            PG8_BAR; PG8_WAIT_L(0); PG8_MMA(0, 1, At, B1); PG8_BAR;
            PG8_LDA(At, 1, 1); PG8_STAGE(PG8_SA(1, 0), a3, voffA);
            PG8_BAR; PG8_WAIT_L(0); PG8_MMA(1, 0, At, B0); PG8_BAR; PG8_SCHED;
            PG8_STAGE(PG8_SB(1, 1), b3 + hstepB, voffB);
            PG8_WAIT_V(6); PG8_BAR; PG8_MMA(1, 1, At, B1); PG8_BAR;
            }
        }
        if constexpr (ALIGN_EPI) { if (wr == 0) PG8_BAR; }
        if constexpr (!Epi::AFTER_DRAIN) { E(acc, cur, wr, wc, fr, fq); S.done(cur); }
        if (!has_next) break;
#pragma unroll
        for (int a = 0; a < 2; ++a)
#pragma unroll
            for (int b = 0; b < 2; ++b)
#pragma unroll
                for (int m = 0; m < 4; ++m)
#pragma unroll
                    for (int n = 0; n < 2; ++n) acc[a][b][m][n] = (f32x4){0.f, 0.f, 0.f, 0.f};
        cur = nxt; cA = nA; cB = nB; ++ui;
        if constexpr (ALIGN_EPI) { if (wr == 1) PG8_BAR; }
    }
    PG8_WAIT_V(0);
    if constexpr (!ALIGN_EPI) { if (wr == 0) PG8_BAR; }
    PG8_BAR;
    if constexpr (Epi::AFTER_DRAIN) { E.fused(acc, cur, wr, wc, fr, fq, lds, wid, lane); S.done(cur); }
#undef PG8_SA
#undef PG8_SB
#undef PG8_STAGE
#undef PG8_LDA
#undef PG8_LDB
#undef PG8_MMA
#undef PG8_WAIT_V
#undef PG8_WAIT_L
#undef PG8_BAR
#undef PG8_SCHED
}
}

#define DEV __device__ __forceinline__
#define LAS __attribute__((address_space(3)))
typedef unsigned short bf16_t;
typedef short bf16x8 __attribute__((ext_vector_type(8)));
typedef float f32x4 __attribute__((ext_vector_type(4)));
typedef float f32x2 __attribute__((ext_vector_type(2)));
typedef float f32x16 __attribute__((ext_vector_type(16)));
typedef unsigned u32x4 __attribute__((ext_vector_type(4)));
typedef unsigned u32x2 __attribute__((ext_vector_type(2)));

constexpr int R = 16896, RB = 8448, NCTX = 256, TL = 8192, DM = 1024, INW = 1696, DFF = 2816, HFF = 1408;
constexpr int NWG_T = 512;
constexpr float EPS = 1e-6f;
constexpr int LDS_BYTES = 147456;
constexpr size_t OFF_X = 0, OFF_HN = 69206016, OFF_W = 103809024, OFF_MOD = 152174592, OFF_ROPE = 152436736, OFF_OV = 153485312;
constexpr size_t OV_Q = 0, OV_KN = 25952256, OV_VT = 43253760, OV_SLOC = 60555264, OV_SIN = 69206016, OV_U = 0;
constexpr size_t OFF_PART = 250100224;
constexpr size_t WS_NEED = OFF_PART + 8388608;
constexpr size_t W_IN = 0, W_UQ = 1835008, W_KN = 2129920, W_V = 2260992, W_OUT = 2392064, W_UP = 3440640, W_DN = 9207808, W_LAYER = 12091392;

struct Params {
    const float *x, *c, *ctx, *c_ctx, *w_mod, *b_mod, *norm1_g, *w_in, *ret_decay_f, *ret_decay_b, *mla_q_norm_g, *w_uq, *mla_kv_norm_g, *w_ukv,
        *pool_w, *pool_scale, *w_out, *norm2_g, *w_up, *conv_w, *conv_b, *w_down, *final_norm_g;
    float* out; unsigned char* ws; int ph_lo, ph_hi;
};

DEV int otid() { int t = threadIdx.x; asm volatile("" : "+v"(t)); return t; }
DEV float bf2f(unsigned short x) { return __uint_as_float((unsigned)x << 16); }
DEV unsigned f2bf(float f) { unsigned u = __float_as_uint(f); return (u + 0x7fffu + ((u >> 16) & 1u)) >> 16; }
DEV unsigned pk2(float lo, float hi) { return f2bf(lo) | (f2bf(hi) << 16); }
DEV float wave_sum(float v) {
#pragma unroll
    for (int o = 1; o < 64; o <<= 1) v += __shfl_xor(v, o);
    return v;
}
DEV float siluf(float x) { return x / (1.0f + __expf(-x)); }
DEV int crow(int r, int hi) { return (r & 3) + 8 * (r >> 2) + 4 * hi; }
DEV bf16x8 pack8(float a0, float a1, float a2, float a3, float a4, float a5, float a6, float a7) {
    u32x4 w; w.x = pg8::cvt_pk_bf16(a0, a1); w.y = pg8::cvt_pk_bf16(a2, a3); w.z = pg8::cvt_pk_bf16(a4, a5); w.w = pg8::cvt_pk_bf16(a6, a7);
    return __builtin_bit_cast(bf16x8, w);
}
DEV int row_mi(int r) { const int b = r / RB; const int s = r - b * RB; return s < NCTX ? 2 : b; }

DEV void transpose_item(const float* W, int K, int Nsrc, bf16_t* WT, int n0, int cs, int k0, float* scr, int lane) {
#pragma unroll
    for (int i = 0; i < 32; ++i) { const int kk = 2 * i + (lane >> 5); scr[kk * 33 + (lane & 31)] = cs >= 0 ? W[(size_t)(k0 + kk) * Nsrc + cs + (lane & 31)] : 0.f; }
    asm volatile("s_waitcnt lgkmcnt(0)" ::: "memory");
    const int c = lane & 7;
#pragma unroll
    for (int j = 0; j < 4; ++j) { const int n = (lane >> 3) + 8 * j; const float* s = scr + (8 * c) * 33 + n;
        u32x4 o; o.x = pk2(s[0 * 33], s[1 * 33]); o.y = pk2(s[2 * 33], s[3 * 33]); o.z = pk2(s[4 * 33], s[5 * 33]); o.w = pk2(s[6 * 33], s[7 * 33]);
        *(u32x4*)(WT + (size_t)(n0 + n) * K + k0 + 8 * c) = o; }
    asm volatile("s_waitcnt lgkmcnt(0)" ::: "memory");
}
DEV int map_in(int n0) { return n0 < 1440 ? n0 : (n0 < INW ? -2 : -1); }
DEV int map_kn(int n0) { return (n0 >> 6) * 128 + (n0 & 63); }
DEV int map_v(int n0) { return (n0 >> 6) * 128 + 64 + (n0 & 63); }
DEV int map_up(int n0) { const int hf = n0 / DFF, w = n0 - hf * DFF; return w < HFF ? hf * HFF + w : DFF + hf * HFF + (w - HFF); }

DEV void phase_prep(const Params& p, unsigned char* lds) {
    const int tid = otid(), lane = tid & 63, wid = tid >> 6;
    unsigned char* ws = p.ws;
    { f32x2* rope = (f32x2*)(ws + OFF_ROPE);
      for (int idx = blockIdx.x * NWG_T + tid; idx < TL * 16; idx += gridDim.x * NWG_T) { const int t = idx >> 4, i = idx & 15; const int pos = i < 8 ? (t >> 6) : (t & 63);
          const float inv = exp2f(-(float)(i & 7) * 0.125f * 13.287712379549449f); const float ang = (float)pos * inv; f32x2 cs; cs.x = __cosf(ang); cs.y = __sinf(ang); rope[idx] = cs; } }
    { float* scv = (float*)lds;
      float* red = scv + 3 * 1024;
      for (int i = tid; i < 3 * 1024; i += NWG_T) { const int v = i >> 10, k = i & 1023; const float cv = v < 2 ? p.c[v * 1024 + k] : p.c_ctx[k]; scv[i] = siluf(cv); }
      __syncthreads();
      float* modv = (float*)(ws + OFF_MOD);
      for (int it = blockIdx.x; it < 192; it += gridDim.x) { const int l = it / 96, col0 = (it % 96) * 64;
          const float* wm = p.w_mod + (size_t)l * 1024 * 6144 + col0 + lane; float a0 = 0.f, a1 = 0.f, a2 = 0.f;
#pragma unroll 16
          for (int k = wid * 128; k < wid * 128 + 128; ++k) { const float w = wm[(size_t)k * 6144]; a0 += scv[k] * w; a1 += scv[1024 + k] * w; a2 += scv[2048 + k] * w; }
          red[(wid * 3 + 0) * 64 + lane] = a0; red[(wid * 3 + 1) * 64 + lane] = a1; red[(wid * 3 + 2) * 64 + lane] = a2;
          __syncthreads();
          if (tid < 192) { const int v = tid >> 6, cl = tid & 63; float s = 0.f;
#pragma unroll
              for (int w = 0; w < 8; ++w) s += red[(w * 3 + v) * 64 + cl];
              modv[((size_t)l * 3 + v) * 6144 + col0 + cl] = s + p.b_mod[l * 6144 + col0 + cl]; }
          __syncthreads(); }
    }
    { float* scr = (float*)(lds + 32768 + wid * 8704);
      const int gw = blockIdx.x * 8 + wid, NGW = gridDim.x * 8;
      constexpr int I_IN = 16 * 56, I_UQ = 6 * 24, I_KN = 4 * 16, I_V = 4 * 16, I_OUT = 16 * 32, I_UP = 16 * 176, I_DN = 44 * 32, I_L = I_IN + I_UQ + I_KN + I_V + I_OUT + I_UP + I_DN;
      for (int it = gw; it < 2 * I_L; it += NGW) { const int l = it / I_L; int r = it - l * I_L; bf16_t* wl = (bf16_t*)(ws + OFF_W) + (size_t)l * W_LAYER;
          const float* src; int K, Nsrc, nbn, mp; size_t doff;
          if (r < I_IN) { src = p.w_in + (size_t)l * 1024 * INW; K = 1024; Nsrc = INW; nbn = 56; mp = 1; doff = W_IN; }
          else if ((r -= I_IN) < I_UQ) { src = p.w_uq + (size_t)l * 384 * 768; K = 384; Nsrc = 768; nbn = 24; mp = 0; doff = W_UQ; }
          else if ((r -= I_UQ) < I_KN) { src = p.w_ukv + (size_t)l * 256 * 1024; K = 256; Nsrc = 1024; nbn = 16; mp = 2; doff = W_KN; }
          else if ((r -= I_KN) < I_V) { src = p.w_ukv + (size_t)l * 256 * 1024; K = 256; Nsrc = 1024; nbn = 16; mp = 3; doff = W_V; }
          else if ((r -= I_V) < I_OUT) { src = p.w_out + (size_t)l * 1024 * 1024; K = 1024; Nsrc = 1024; nbn = 32; mp = 0; doff = W_OUT; }
          else if ((r -= I_OUT) < I_UP) { src = p.w_up + (size_t)l * 1024 * 5632; K = 1024; Nsrc = 5632; nbn = 176; mp = 4; doff = W_UP; }
          else { r -= I_UP; src = p.w_down + (size_t)l * DFF * 1024; K = DFF; Nsrc = 1024; nbn = 32; mp = 0; doff = W_DN; }
          const int kb = r / nbn, nb = r - kb * nbn, n0 = nb * 32;
          const int cs = mp == 0 ? n0 : mp == 1 ? map_in(n0) : mp == 2 ? map_kn(n0) : mp == 3 ? map_v(n0) : map_up(n0);
          if (cs != -2) transpose_item(src, K, Nsrc, wl + doff, n0, cs, kb * 64, scr, lane); }
    }
    { for (int idx = blockIdx.x * NWG_T + tid; idx < 2 * 1024 * 256; idx += gridDim.x * NWG_T) { const int n = idx & 255, k = (idx >> 8) & 1023, l = idx >> 18; const int g = n >> 6, d = n & 63;
          const float* wr = p.w_in + ((size_t)l * 1024 + k) * INW + 1440 + g * 64; const float* pw = p.pool_w + ((size_t)(l * 4 + g) * 64) * 64 + d; float s = 0.f;
#pragma unroll 8
          for (int c = 0; c < 64; ++c) s += wr[c] * pw[c * 64];
          ((bf16_t*)(ws + OFF_W) + (size_t)l * W_LAYER + W_IN)[(size_t)(1440 + n) * 1024 + k] = (bf16_t)f2bf(s * p.pool_scale[l * 256 + n]); } }
}

DEV void phase_norm(const Params& p, int l, int which, bool first, const float* pgate) {
    const int tid = otid(); const int lane = tid & 63, wid = tid >> 6; const int gw = blockIdx.x * 8 + wid, NGW = gridDim.x * 8;
    float* X = (float*)(p.ws + OFF_X); bf16_t* HN = (bf16_t*)(p.ws + OFF_HN);
    const float* modv = (const float*)(p.ws + OFF_MOD) + (size_t)l * 3 * 6144;
    const float* g = (which == 0 ? p.norm1_g : p.norm2_g) + l * 1024;
    for (int r = gw; r < R; r += NGW) {
        const int b = r / RB, s = r - b * RB; const int mi = s < NCTX ? 2 : b;
        const float* src = first ? (s < NCTX ? p.ctx + ((size_t)b * NCTX + s) * 1024 : p.x + ((size_t)b * TL + (s - NCTX)) * 1024) : X + (size_t)r * 1024;
        const f32x4* xr = (const f32x4*)src + lane; f32x4 v[4]; float ss = 0.f;
#pragma unroll
        for (int j = 0; j < 4; ++j) { v[j] = xr[64 * j]; ss += (v[j].x * v[j].x + v[j].y * v[j].y) + (v[j].z * v[j].z + v[j].w * v[j].w); }
        if (pgate != nullptr && s < NCTX) { const float* PART = (const float*)(p.ws + OFF_PART) + (size_t)(b * NCTX + s) * 1024; ss = 0.f;
#pragma unroll
            for (int j = 0; j < 4; ++j) { const f32x4 gq = ((const f32x4*)pgate)[lane + 64 * j]; f32x4 a = ((const f32x4*)PART)[lane + 64 * j];
#pragma unroll
                for (int q = 1; q < 4; ++q) a = a + ((const f32x4*)(PART + (size_t)q * 524288))[lane + 64 * j];
                v[j] = v[j] + gq * a; ss += (v[j].x * v[j].x + v[j].y * v[j].y) + (v[j].z * v[j].z + v[j].w * v[j].w); } }
        if (first || (pgate != nullptr && s < NCTX)) { f32x4* xo = (f32x4*)(X + (size_t)r * 1024) + lane;
#pragma unroll
            for (int j = 0; j < 4; ++j) xo[64 * j] = v[j]; }
        const float rs = rsqrtf(wave_sum(ss) * (1.f / 1024.f) + EPS);
        const float* mv = modv + mi * 6144 + (which == 0 ? 0 : 3072);
        u32x2* o8 = (u32x2*)(HN + (size_t)r * 1024) + lane;
#pragma unroll
        for (int j = 0; j < 4; ++j) { const f32x4 gg = ((const f32x4*)g)[lane + 64 * j], sh = ((const f32x4*)mv)[lane + 64 * j], sc = ((const f32x4*)(mv + 1024))[lane + 64 * j];
            const f32x4 y = v[j] * rs * gg; const f32x4 h = y * (sc + 1.0f) + sh; u32x2 w; w.x = pk2(h.x, h.y); w.y = pk2(h.z, h.w); o8[64 * j] = w; }
    }
}
DEV void phase_final(const Params& p) {
    const int tid = otid(); const int lane = tid & 63, wid = tid >> 6; const int gw = blockIdx.x * 8 + wid, NGW = gridDim.x * 8;
    const float* X = (const float*)(p.ws + OFF_X);
    for (int q = gw; q < 2 * TL; q += NGW) { const int b = q / TL, t = q - b * TL; const int r = b * RB + NCTX + t;
        const f32x4* xr = (const f32x4*)(X + (size_t)r * 1024) + lane; f32x4 v[4]; float ss = 0.f;
#pragma unroll
        for (int j = 0; j < 4; ++j) { v[j] = xr[64 * j]; ss += (v[j].x * v[j].x + v[j].y * v[j].y) + (v[j].z * v[j].z + v[j].w * v[j].w); }
        const float rs = rsqrtf(wave_sum(ss) * (1.f / 1024.f) + EPS);
        f32x4* o = (f32x4*)(p.out + (size_t)q * 1024) + lane;
#pragma unroll
        for (int j = 0; j < 4; ++j) { const f32x4 gg = ((const f32x4*)p.final_norm_g)[lane + 64 * j]; o[64 * j] = v[j] * rs * gg; } }
}

DEV void phase_rowwise(const Params& p, int l) {
    const int tid = otid(); const int lane = tid & 63, wid = tid >> 6; const int gw = blockIdx.x * 8 + wid, NGW = gridDim.x * 8;
    bf16_t* P = (bf16_t*)p.out; const f32x2* rope = (const f32x2*)(p.ws + OFF_ROPE);
    const float* qg = p.mla_q_norm_g + l * 384; const float* kg = p.mla_kv_norm_g + l * 256;
    for (int r = gw; r < R; r += NGW) {
        bf16_t* pr = P + (size_t)r * INW; const int b = r / RB, s = r - b * RB;
        { unsigned* q2 = (unsigned*)(pr + 768) + lane; unsigned w[3]; float ss = 0.f;
#pragma unroll
          for (int j = 0; j < 3; ++j) { w[j] = q2[64 * j]; const float a = bf2f(w[j] & 0xffff), c2 = bf2f(w[j] >> 16); ss += a * a + c2 * c2; }
          const float rs = rsqrtf(wave_sum(ss) * (1.f / 384.f) + EPS);
#pragma unroll
          for (int j = 0; j < 3; ++j) { const int c0 = 2 * (lane + 64 * j); q2[64 * j] = pk2(bf2f(w[j] & 0xffff) * rs * qg[c0], bf2f(w[j] >> 16) * rs * qg[c0 + 1]); } }
        { u32x2* k4 = (u32x2*)(pr + 1152) + lane; const u32x2 w = *k4;
          const float a0 = bf2f(w.x & 0xffff), a1 = bf2f(w.x >> 16), a2 = bf2f(w.y & 0xffff), a3 = bf2f(w.y >> 16);
          const float rs = rsqrtf(wave_sum((a0 * a0 + a1 * a1) + (a2 * a2 + a3 * a3)) * (1.f / 256.f) + EPS);
          const f32x4 gg = ((const f32x4*)kg)[lane]; u32x2 o; o.x = pk2(a0 * rs * gg.x, a1 * rs * gg.y); o.y = pk2(a2 * rs * gg.z, a3 * rs * gg.w); *k4 = o; }
        if (s >= NCTX && lane < 16) { const f32x2 cs = rope[(s - NCTX) * 16 + lane];
          const float x1 = bf2f(pr[1408 + lane]), x2 = bf2f(pr[1408 + 16 + lane]);
          pr[1408 + lane] = (bf16_t)f2bf(x1 * cs.x - x2 * cs.y); pr[1408 + 16 + lane] = (bf16_t)f2bf(x2 * cs.x + x1 * cs.y); }
    }
}

DEV void phase_pool(const Params& p) {
    const int tid = otid(); const bf16_t* P = (const bf16_t*)p.out; bf16_t* MIX = (bf16_t*)(p.ws + OFF_HN);
    for (int idx = blockIdx.x * NWG_T + tid; idx < R * 32; idx += gridDim.x * NWG_T) { const int r = idx >> 5, cg = idx & 31; const int half = 1 << (cg >> 3);
        const int b = r / RB, s = r - b * RB; const int seq0 = s < NCTX ? b * RB : b * RB + NCTX; const int T = s < NCTX ? NCTX : TL; const int t = r - seq0;
        const int lo = max(t - half, 0), hi = min(t + half, T); float sum[8];
#pragma unroll
        for (int j = 0; j < 8; ++j) sum[j] = 0.f;
        const bf16_t* base = P + (size_t)seq0 * INW + 1440 + cg * 8;
        for (int tt = lo; tt < hi; ++tt) { const bf16x8 v = *(const bf16x8*)(base + (size_t)tt * INW);
#pragma unroll
            for (int j = 0; j < 8; ++j) sum[j] += bf2f((unsigned short)v[j]); }
        const bf16x8 me = *(const bf16x8*)(base + (size_t)t * INW); const float ic = 1.0f / (float)(hi - lo); float o[8];
#pragma unroll
        for (int j = 0; j < 8; ++j) o[j] = sum[j] * ic - bf2f((unsigned short)me[j]);
        *(bf16x8*)(MIX + (size_t)r * 1024 + 768 + cg * 8) = pack8(o[0], o[1], o[2], o[3], o[4], o[5], o[6], o[7]); }
}

DEV float log2_sigmoid(float d) { return -log1pf(__expf(-d)) * 1.4426950408889634f; }
DEV void states_item(const Params& p, int l, unsigned char* lds, int it) {
    const int tid = otid(); const bf16_t* P = (const bf16_t*)p.out; const f32x2* rope = (const f32x2*)(p.ws + OFF_ROPE);
    float* SLOC = (float*)(p.ws + OFF_OV + OV_SLOC);
    const int gc = it >> 2, h = it & 3;
    bf16_t* kk = (bf16_t*)lds;
    bf16_t* vv = kk + 128 * 32;
    float* dec = (float*)(vv + 128 * 64);
    const int cb = gc % 66; const bool lat = cb >= 2; const int t0 = (cb - 2) * 128; const int r0 = gc * 128;
    if (tid < 256) { const int dir = tid >> 7, idx = tid & 127;
        const float lg = log2_sigmoid((dir == 0 ? p.ret_decay_f : p.ret_decay_b)[l * 4 + h]); dec[tid] = exp2f(lg * (dir == 0 ? (float)(127 - idx) : (float)idx)); }
    else { const int task = tid - 256; const int tok = task >> 1, c = task & 1;
        const bf16_t* src = P + (size_t)(r0 + tok) * INW + 128 + h * 32 + 8 * c; const bf16x8 lo = *(const bf16x8*)src, hi = *(const bf16x8*)(src + 16);
        float o1[8], o2[8];
#pragma unroll
        for (int j = 0; j < 8; ++j) { float x1 = bf2f((unsigned short)lo[j]), x2 = bf2f((unsigned short)hi[j]);
            if (lat) { const f32x2 cs = rope[(t0 + tok) * 16 + 8 * c + j]; const float y1 = x1 * cs.x - x2 * cs.y, y2 = x2 * cs.x + x1 * cs.y; x1 = y1; x2 = y2; }
            o1[j] = x1 * 0.17677669529663687f; o2[j] = x2 * 0.17677669529663687f; }
        bf16_t* dst = kk + tok * 32 + 8 * c;
        *(bf16x8*)dst = pack8(o1[0], o1[1], o1[2], o1[3], o1[4], o1[5], o1[6], o1[7]); *(bf16x8*)(dst + 16) = pack8(o2[0], o2[1], o2[2], o2[3], o2[4], o2[5], o2[6], o2[7]); }
    for (int task = tid; task < 1024; task += NWG_T) { const int tok = task >> 3, ch = task & 7; *(u32x4*)(vv + tok * 64 + ch * 8) = *(const u32x4*)(P + (size_t)(r0 + tok) * INW + 256 + h * 64 + ch * 8); }
    __syncthreads();
    { const int d = tid >> 4, dvg = tid & 15; float af[4], ab[4];
#pragma unroll
      for (int j = 0; j < 4; ++j) { af[j] = 0.f; ab[j] = 0.f; }
#pragma unroll 4
      for (int i = 0; i < 128; ++i) { const float kv = bf2f(kk[i * 32 + d]); const float kf = kv * dec[i], kb = kv * dec[128 + i];
          const u32x2 v = *(const u32x2*)(vv + i * 64 + dvg * 4);
          const float v0 = bf2f(v.x & 0xffff), v1 = bf2f(v.x >> 16), v2 = bf2f(v.y & 0xffff), v3 = bf2f(v.y >> 16);
          af[0] += kf * v0; af[1] += kf * v1; af[2] += kf * v2; af[3] += kf * v3; ab[0] += kb * v0; ab[1] += kb * v1; ab[2] += kb * v2; ab[3] += kb * v3; }
      float* of = SLOC + ((size_t)(gc * 4 + h) * 2 + 0) * 2048 + d * 64 + dvg * 4;
      *(f32x4*)of = (f32x4){af[0], af[1], af[2], af[3]}; *(f32x4*)(of + 2048) = (f32x4){ab[0], ab[1], ab[2], ab[3]}; }
    __syncthreads();
}
DEV void scan_threads(const Params& p, int l, int gid) {
    if (gid >= 32768) return;
    const int e = gid & 2047, dir = (gid >> 11) & 1, h = (gid >> 12) & 3, b = gid >> 14;
    const float* SLOC = (const float*)(p.ws + OFF_OV + OV_SLOC); float* SIN = (float*)(p.ws + OFF_OV + OV_SIN);
    const float gC = exp2f(log2_sigmoid((dir == 0 ? p.ret_decay_f : p.ret_decay_b)[l * 4 + h]) * 128.f);
    float S = 0.f;
#pragma unroll 6
    for (int st = 0; st < 66; ++st) { const int cb = dir == 0 ? st : (st < 2 ? 1 - st : 67 - st); const size_t idx = ((size_t)((b * 66 + cb) * 4 + h) * 2 + dir) * 2048 + e;
        const float v = SLOC[idx]; SIN[idx] = S; S = S * gC + v; }
}

constexpr int AT_KP = 208, AT_VP = 136, AT_KB = 64 * AT_KP, AT_VBS = 64 * AT_VP, AT_V0 = 2 * AT_KB;
DEV float at_max32(const f32x16& s0, const f32x16& s1) {
    float m0 = __builtin_fmaxf(__builtin_fmaxf(s0[0], s0[1]), s0[2]), m1 = __builtin_fmaxf(__builtin_fmaxf(s1[0], s1[1]), s1[2]);
    m0 = __builtin_fmaxf(__builtin_fmaxf(m0, s0[3]), s0[4]); m1 = __builtin_fmaxf(__builtin_fmaxf(m1, s1[3]), s1[4]);
    m0 = __builtin_fmaxf(__builtin_fmaxf(m0, s0[5]), s0[6]); m1 = __builtin_fmaxf(__builtin_fmaxf(m1, s1[5]), s1[6]);
    m0 = __builtin_fmaxf(__builtin_fmaxf(m0, s0[7]), s0[8]); m1 = __builtin_fmaxf(__builtin_fmaxf(m1, s1[7]), s1[8]);
    m0 = __builtin_fmaxf(__builtin_fmaxf(m0, s0[9]), s0[10]); m1 = __builtin_fmaxf(__builtin_fmaxf(m1, s1[9]), s1[10]);
    m0 = __builtin_fmaxf(__builtin_fmaxf(m0, s0[11]), s0[12]); m1 = __builtin_fmaxf(__builtin_fmaxf(m1, s1[11]), s1[12]);
    m0 = __builtin_fmaxf(__builtin_fmaxf(m0, s0[13]), s0[14]); m1 = __builtin_fmaxf(__builtin_fmaxf(m1, s1[13]), s1[14]);
    return __builtin_fmaxf(__builtin_fmaxf(m0, s0[15]), __builtin_fmaxf(m1, s1[15]));
}
DEV void attn_unit(const Params& p, unsigned char* lds, int u) {
    const int tid = otid(), lane = tid & 63, wid = tid >> 6, l32 = lane & 31, hi = lane >> 5;
    const bf16_t* Q = (const bf16_t*)(p.ws + OFF_OV + OV_Q); const bf16_t* KN = (const bf16_t*)(p.ws + OFF_OV + OV_KN); const bf16_t* VT = (const bf16_t*)(p.ws + OFF_OV + OV_VT);
    const bf16_t* P = (const bf16_t*)p.out; bf16_t* MIX = (bf16_t*)(p.ws + OFF_HN); const f32x2* rope = (const f32x2*)(p.ws + OFF_ROPE);
    const bool isctx = u >= 512; int b, h, qrow0, NT;
    if (!isctx) { b = u >> 8; h = (u >> 5) & 7; qrow0 = b * RB + NCTX + (u & 31) * 256; NT = 132; } else { const int v = u - 512; b = v >> 3; h = v & 7; qrow0 = b * RB; NT = 4; }
    const int krow0 = b * RB; const int qrow = qrow0 + wid * 32 + l32;
    bf16x8 qf[6];
    { const bf16_t* qp = Q + (size_t)qrow * 768 + h * 96 + hi * 8;
#pragma unroll
      for (int d0 = 0; d0 < 6; ++d0) qf[d0] = *(const bf16x8*)(qp + d0 * 16);
      if (!isctx) { const f32x2* rp = rope + (size_t)(qrow - (b * RB + NCTX)) * 16 + hi * 8;
#pragma unroll
          for (int j = 0; j < 8; ++j) { const f32x2 cs = rp[j]; const float x1 = bf2f((unsigned short)qf[4][j]), x2 = bf2f((unsigned short)qf[5][j]);
              qf[4][j] = (short)f2bf(x1 * cs.x - x2 * cs.y); qf[5][j] = (short)f2bf(x2 * cs.x + x1 * cs.y); } } }
    const bf16_t* sp[3]; int sstep[3], lo[3];
#pragma unroll
    for (int k = 0; k < 2; ++k) { const int c = tid + k * 512; const int key = c / 12, part = c - key * 12; lo[k] = key * AT_KP + part * 16;
        if (part < 8) { sp[k] = KN + (size_t)(krow0 + key) * 512 + h * 64 + part * 8; sstep[k] = 64 * 512; } else { sp[k] = P + (size_t)(krow0 + key) * INW + 1408 + (part - 8) * 8; sstep[k] = 64 * INW; } }
    { const int dv = tid >> 3, kc = tid & 7; lo[2] = dv * AT_VP + kc * 16; sp[2] = VT + (size_t)(h * 64 + dv) * R + krow0 + kc * 8; sstep[2] = 64; }
    const bool hasK2 = tid < 256;
    u32x4 st[3];
#define AT_GLOADK() do { st[0] = *(const u32x4*)sp[0]; sp[0] += sstep[0]; if (hasK2) { st[1] = *(const u32x4*)sp[1]; sp[1] += sstep[1]; } } while (0)
#define AT_GLOADV() do { st[2] = *(const u32x4*)sp[2]; sp[2] += sstep[2]; } while (0)
#define AT_LSTOREK(buf) do { *(u32x4*)((buf) + lo[0]) = st[0]; if (hasK2) *(u32x4*)((buf) + lo[1]) = st[1]; } while (0)
#define AT_LSTOREV(buf) do { unsigned char* d_ = (buf) + lo[2]; *(u32x2*)d_ = (u32x2){st[2].x, st[2].y}; *(u32x2*)(d_ + 8) = (u32x2){st[2].z, st[2].w}; } while (0)
#define AT_SB() __builtin_amdgcn_sched_barrier(0)
    f32x16 o0, o1, sa0, sa1, sb0, sb1;
#pragma unroll
    for (int r = 0; r < 16; ++r) { o0[r] = 0.f; o1[r] = 0.f; sa0[r] = 0.f; sa1[r] = 0.f; }
    float mrun = 0.f, lsum = 0.f;
    __syncthreads();
    AT_GLOADK(); AT_GLOADV(); AT_LSTOREK(lds); AT_LSTOREV(lds + AT_V0);
    AT_GLOADK(); AT_LSTOREK(lds + AT_KB);
    __syncthreads();
    { const unsigned char* ka = lds + l32 * AT_KP + hi * 16;
#pragma unroll
      for (int d0 = 0; d0 < 6; ++d0) { const bf16x8 a0 = *(const bf16x8*)(ka + d0 * 32), a1 = *(const bf16x8*)(ka + 32 * AT_KP + d0 * 32);
          sa0 = __builtin_amdgcn_mfma_f32_32x32x16_bf16(a0, qf[d0], sa0, 0, 0, 0); sa1 = __builtin_amdgcn_mfma_f32_32x32x16_bf16(a1, qf[d0], sa1, 0, 0, 0); } }
#define AT_STEP(SA0, SA1, SB0, SB1, tt) do { \
        const int t_ = (tt); const bool nxt_ = t_ + 1 < NT; \
        const unsigned char* kb_ = lds + ((t_ + 1) & 1) * AT_KB; const unsigned char* vb_ = lds + AT_V0 + (t_ & 1) * AT_VBS; \
        if (t_ + 2 < NT) AT_GLOADK(); \
        if (nxt_) AT_GLOADV(); \
        bf16x8 kfr[12]; u32x2 vfr[16]; \
        { const unsigned char* ka = kb_ + l32 * AT_KP + hi * 16; \
          _Pragma("unroll") for (int d0 = 0; d0 < 6; ++d0) { kfr[2 * d0] = *(const bf16x8*)(ka + d0 * 32); kfr[2 * d0 + 1] = *(const bf16x8*)(ka + 32 * AT_KP + d0 * 32); } } \
        { const float mx = at_max32(SA0, SA1); \
          if (t_ == 0 || __any(mx > 8.0f)) { \
              const float rm = fmaxf(mx, __shfl_xor(mx, 32)); const float delta = (t_ == 0) ? rm : fmaxf(rm, 0.f); const float alpha = (t_ == 0) ? 1.0f : __builtin_amdgcn_exp2f(-delta); \
              mrun += delta; \
              _Pragma("unroll") for (int r = 0; r < 16; ++r) { SA0[r] -= delta; SA1[r] -= delta; o0[r] *= alpha; o1[r] *= alpha; } \
              lsum *= alpha; } } \
        { const float nm = -mrun; _Pragma("unroll") for (int r = 0; r < 16; ++r) { SB0[r] = nm; SB1[r] = nm; } } \
        float ls0 = 0.f, ls1 = 0.f; \
        AT_SB(); \
        _Pragma("unroll") for (int i = 0; i < 8; ++i) { \
            if (i & 1) SB1 = __builtin_amdgcn_mfma_f32_32x32x16_bf16(kfr[i], qf[i >> 1], SB1, 0, 0, 0); else SB0 = __builtin_amdgcn_mfma_f32_32x32x16_bf16(kfr[i], qf[i >> 1], SB0, 0, 0, 0); \
            SA0[2 * i] = __builtin_amdgcn_exp2f(SA0[2 * i]); SA0[2 * i + 1] = __builtin_amdgcn_exp2f(SA0[2 * i + 1]); SA1[2 * i] = __builtin_amdgcn_exp2f(SA1[2 * i]); SA1[2 * i + 1] = __builtin_amdgcn_exp2f(SA1[2 * i + 1]); \
            ls0 += SA0[2 * i] + SA0[2 * i + 1]; ls1 += SA1[2 * i] + SA1[2 * i + 1]; \
            AT_SB(); } \
        { const unsigned char* va = vb_ + l32 * AT_VP + hi * 8; \
          _Pragma("unroll") for (int kj = 0; kj < 4; ++kj) { const unsigned char* vp = va + kj * 32; \
              vfr[4 * kj + 0] = *(const u32x2*)vp; vfr[4 * kj + 1] = *(const u32x2*)(vp + 16); vfr[4 * kj + 2] = *(const u32x2*)(vp + 32 * AT_VP); vfr[4 * kj + 3] = *(const u32x2*)(vp + 32 * AT_VP + 16); } } \
        bf16x8 pb[4]; \
        _Pragma("unroll") for (int i = 8; i < 12; ++i) { const int kj = i - 8; const int jp = kj & 1; \
            if (i & 1) SB1 = __builtin_amdgcn_mfma_f32_32x32x16_bf16(kfr[i], qf[i >> 1], SB1, 0, 0, 0); else SB0 = __builtin_amdgcn_mfma_f32_32x32x16_bf16(kfr[i], qf[i >> 1], SB0, 0, 0, 0); \
            if (kj < 2) pb[kj] = pack8(SA0[8 * jp + 0], SA0[8 * jp + 1], SA0[8 * jp + 2], SA0[8 * jp + 3], SA0[8 * jp + 4], SA0[8 * jp + 5], SA0[8 * jp + 6], SA0[8 * jp + 7]); \
            else        pb[kj] = pack8(SA1[8 * jp + 0], SA1[8 * jp + 1], SA1[8 * jp + 2], SA1[8 * jp + 3], SA1[8 * jp + 4], SA1[8 * jp + 5], SA1[8 * jp + 6], SA1[8 * jp + 7]); \
            AT_SB(); } \
        lsum += ls0 + ls1; \
        _Pragma("unroll") for (int kj = 0; kj < 4; ++kj) { \
            const bf16x8 A0 = __builtin_bit_cast(bf16x8, (u32x4){vfr[4 * kj].x, vfr[4 * kj].y, vfr[4 * kj + 1].x, vfr[4 * kj + 1].y}); \
            const bf16x8 A1 = __builtin_bit_cast(bf16x8, (u32x4){vfr[4 * kj + 2].x, vfr[4 * kj + 2].y, vfr[4 * kj + 3].x, vfr[4 * kj + 3].y}); \
            o0 = __builtin_amdgcn_mfma_f32_32x32x16_bf16(A0, pb[kj], o0, 0, 0, 0); o1 = __builtin_amdgcn_mfma_f32_32x32x16_bf16(A1, pb[kj], o1, 0, 0, 0); } \
        if (t_ + 2 < NT) AT_LSTOREK(lds + (t_ & 1) * AT_KB); \
        if (nxt_) AT_LSTOREV(lds + AT_V0 + ((t_ + 1) & 1) * AT_VBS); \
        __syncthreads(); \
    } while (0)
    for (int t = 0; t < NT; t += 2) { AT_STEP(sa0, sa1, sb0, sb1, t); AT_STEP(sb0, sb1, sa0, sa1, t + 1); }
    lsum += __shfl_xor(lsum, 32);
    const float inv = 1.0f / lsum;
    bf16_t* op = MIX + (size_t)qrow * 1024 + 256 + h * 64 + 4 * hi;
#pragma unroll
    for (int g4 = 0; g4 < 4; ++g4) { u32x2 w0, w1; w0.x = pk2(o0[4 * g4] * inv, o0[4 * g4 + 1] * inv); w0.y = pk2(o0[4 * g4 + 2] * inv, o0[4 * g4 + 3] * inv);
        w1.x = pk2(o1[4 * g4] * inv, o1[4 * g4 + 1] * inv); w1.y = pk2(o1[4 * g4 + 2] * inv, o1[4 * g4 + 3] * inv);
        *(u32x2*)(op + 8 * g4) = w0; *(u32x2*)(op + 32 + 8 * g4) = w1; }
#undef AT_GLOADK
#undef AT_GLOADV
#undef AT_LSTOREK
#undef AT_LSTOREV
#undef AT_STEP
#undef AT_SB
}

constexpr int RT_VP = 264, RT_SP = 144, RT_VB = 2 * 64 * RT_VP;
DEV void retout_unit(const Params& p, int l, unsigned char* lds, int u) {
    const int tid = otid(), lane = tid & 63, wid = tid >> 6, l32 = lane & 31, hi = lane >> 5;
    const int gc = u >> 1, hp = u & 1; const int cb = gc % 66; const bool lat = cb >= 2; const int t0 = (cb - 2) * 128; const int r0 = gc * 128;
    const bf16_t* P = (const bf16_t*)p.out; bf16_t* MIX = (bf16_t*)(p.ws + OFF_HN); const f32x2* rope = (const f32x2*)(p.ws + OFF_ROPE);
    const float* SIN = (const float*)(p.ws + OFF_OV + OV_SIN);
    bf16_t* VTl = (bf16_t*)lds; bf16_t* STl = (bf16_t*)(lds + RT_VB);
    __syncthreads();
    for (int task = tid; task < 2048; task += NWG_T) { const int hh = task >> 10, key = (task >> 3) & 127, ch = task & 7;
        const bf16x8 v = *(const bf16x8*)(P + (size_t)(r0 + key) * INW + 256 + (2 * hp + hh) * 64 + ch * 8);
#pragma unroll
        for (int j = 0; j < 8; ++j) VTl[(hh * 64 + ch * 8 + j) * (RT_VP / 2) + key] = (bf16_t)v[j]; }
    for (int task = tid; task < 8192; task += NWG_T) { const int dv = task & 63, k = (task >> 6) & 31, dir = (task >> 11) & 1, hh = task >> 12;
        STl[(hh * 64 + dv) * (RT_SP / 2) + dir * 32 + k] = (bf16_t)f2bf(SIN[((size_t)(gc * 4 + 2 * hp + hh) * 2 + dir) * 2048 + k * 64 + dv]); }
    __syncthreads();
    const int hh = wid >> 2, h = 2 * hp + hh, qblk = wid & 3; const int n = 32 * qblk + l32; const int rq = r0 + n;
    const float lf = log2_sigmoid(p.ret_decay_f[l * 4 + h]), lb = log2_sigmoid(p.ret_decay_b[l * 4 + h]);
    float qv0[8], qv1[8]; bf16x8 qf0, qf1;
    { const bf16_t* qp = P + (size_t)rq * INW + h * 32 + 8 * hi; const bf16x8 a = *(const bf16x8*)qp, c2 = *(const bf16x8*)(qp + 16);
#pragma unroll
      for (int j = 0; j < 8; ++j) { float x1 = bf2f((unsigned short)a[j]), x2 = bf2f((unsigned short)c2[j]);
          if (lat) { const f32x2 cs = rope[(size_t)(t0 + n) * 16 + 8 * hi + j]; const float y1 = x1 * cs.x - x2 * cs.y, y2 = x2 * cs.x + x1 * cs.y; x1 = y1; x2 = y2; }
          qv0[j] = x1; qv1[j] = x2; }
      qf0 = pack8(qv0[0], qv0[1], qv0[2], qv0[3], qv0[4], qv0[5], qv0[6], qv0[7]); qf1 = pack8(qv1[0], qv1[1], qv1[2], qv1[3], qv1[4], qv1[5], qv1[6], qv1[7]); }
    f32x16 o0, o1;
#pragma unroll
    for (int r = 0; r < 16; ++r) { o0[r] = 0.f; o1[r] = 0.f; }
    const unsigned char* vbase = (const unsigned char*)VTl + (size_t)(hh * 64 + l32) * RT_VP + hi * 8;
#pragma unroll
    for (int kb = 0; kb < 4; ++kb) {
        bf16x8 kf0, kf1;
        { const int key = 32 * kb + l32; const bf16_t* kp = P + (size_t)(r0 + key) * INW + 128 + h * 32 + 8 * hi; const bf16x8 a = *(const bf16x8*)kp, c2 = *(const bf16x8*)(kp + 16);
          float y1[8], y2[8];
#pragma unroll
          for (int j = 0; j < 8; ++j) { float x1 = bf2f((unsigned short)a[j]), x2 = bf2f((unsigned short)c2[j]);
              if (lat) { const f32x2 cs = rope[(size_t)(t0 + key) * 16 + 8 * hi + j]; const float z1 = x1 * cs.x - x2 * cs.y, z2 = x2 * cs.x + x1 * cs.y; x1 = z1; x2 = z2; }
              y1[j] = x1 * 0.17677669529663687f; y2[j] = x2 * 0.17677669529663687f; }
          kf0 = pack8(y1[0], y1[1], y1[2], y1[3], y1[4], y1[5], y1[6], y1[7]); kf1 = pack8(y2[0], y2[1], y2[2], y2[3], y2[4], y2[5], y2[6], y2[7]); }
        f32x16 s;
#pragma unroll
        for (int r = 0; r < 16; ++r) s[r] = 0.f;
        s = __builtin_amdgcn_mfma_f32_32x32x16_bf16(kf0, qf0, s, 0, 0, 0); s = __builtin_amdgcn_mfma_f32_32x32x16_bf16(kf1, qf1, s, 0, 0, 0);
#pragma unroll
        for (int r = 0; r < 16; ++r) { const int m = 32 * kb + crow(r, hi); const int dl = n - m; const float e = dl >= 0 ? lf * (float)dl : lb * (float)(-dl); s[r] *= __builtin_amdgcn_exp2f(e); }
#pragma unroll
        for (int jp = 0; jp < 2; ++jp) { const bf16x8 pb = pack8(s[8 * jp + 0], s[8 * jp + 1], s[8 * jp + 2], s[8 * jp + 3], s[8 * jp + 4], s[8 * jp + 5], s[8 * jp + 6], s[8 * jp + 7]);
            const unsigned char* vp = vbase + (32 * kb + 16 * jp) * 2;
            const u32x2 a00 = *(const u32x2*)vp, a01 = *(const u32x2*)(vp + 16), a10 = *(const u32x2*)(vp + 32 * RT_VP), a11 = *(const u32x2*)(vp + 32 * RT_VP + 16);
            const bf16x8 A0 = __builtin_bit_cast(bf16x8, (u32x4){a00.x, a00.y, a01.x, a01.y}), A1 = __builtin_bit_cast(bf16x8, (u32x4){a10.x, a10.y, a11.x, a11.y});
            o0 = __builtin_amdgcn_mfma_f32_32x32x16_bf16(A0, pb, o0, 0, 0, 0); o1 = __builtin_amdgcn_mfma_f32_32x32x16_bf16(A1, pb, o1, 0, 0, 0); }
    }
    { const float df = __builtin_amdgcn_exp2f(lf * (float)(n + 1)), db = __builtin_amdgcn_exp2f(lb * (float)(128 - n));
      const unsigned char* sbase = (const unsigned char*)STl + (size_t)(hh * 64 + l32) * RT_SP + hi * 16;
#pragma unroll
      for (int ks = 0; ks < 4; ++ks) { const float dd = ks < 2 ? df : db;
          const bf16x8 qb = (ks & 1) ? pack8(qv1[0] * dd, qv1[1] * dd, qv1[2] * dd, qv1[3] * dd, qv1[4] * dd, qv1[5] * dd, qv1[6] * dd, qv1[7] * dd)
                                     : pack8(qv0[0] * dd, qv0[1] * dd, qv0[2] * dd, qv0[3] * dd, qv0[4] * dd, qv0[5] * dd, qv0[6] * dd, qv0[7] * dd);
          const bf16x8 A0 = *(const bf16x8*)(sbase + ks * 32), A1 = *(const bf16x8*)(sbase + 32 * RT_SP + ks * 32);
          o0 = __builtin_amdgcn_mfma_f32_32x32x16_bf16(A0, qb, o0, 0, 0, 0); o1 = __builtin_amdgcn_mfma_f32_32x32x16_bf16(A1, qb, o1, 0, 0, 0); } }
    float ssq = 0.f;
#pragma unroll
    for (int r = 0; r < 16; ++r) ssq += o0[r] * o0[r] + o1[r] * o1[r];
    ssq += __shfl_xor(ssq, 32);
    const float rstd = rsqrtf(ssq * (1.f / 64.f) + EPS);
    const bf16_t* gp = P + (size_t)rq * INW + 512 + h * 64 + 4 * hi; bf16_t* op = MIX + (size_t)rq * 1024 + h * 64 + 4 * hi;
#pragma unroll
    for (int g4 = 0; g4 < 4; ++g4) { const u32x2 ga = *(const u32x2*)(gp + 8 * g4), gb = *(const u32x2*)(gp + 32 + 8 * g4);
        u32x2 w0, w1;
        w0.x = pk2(o0[4 * g4] * rstd * siluf(bf2f(ga.x & 0xffff)), o0[4 * g4 + 1] * rstd * siluf(bf2f(ga.x >> 16))); w0.y = pk2(o0[4 * g4 + 2] * rstd * siluf(bf2f(ga.y & 0xffff)), o0[4 * g4 + 3] * rstd * siluf(bf2f(ga.y >> 16)));
        w1.x = pk2(o1[4 * g4] * rstd * siluf(bf2f(gb.x & 0xffff)), o1[4 * g4 + 1] * rstd * siluf(bf2f(gb.x >> 16))); w1.y = pk2(o1[4 * g4 + 2] * rstd * siluf(bf2f(gb.y & 0xffff)), o1[4 * g4 + 3] * rstd * siluf(bf2f(gb.y >> 16)));
        *(u32x2*)(op + 8 * g4) = w0; *(u32x2*)(op + 32 + 8 * g4) = w1; }
}

DEV void phase_convact(const Params& p, int l, int hf) {
    const bf16_t* U = (const bf16_t*)(p.ws + OFF_OV + OV_U); bf16_t* ACT = (bf16_t*)p.out;
    const float* cw = p.conv_w + (size_t)l * 3 * 5632; const float* cbv = p.conv_b + (size_t)l * 5632;
    const bf16x8 z = {0, 0, 0, 0, 0, 0, 0, 0};
    for (int idx = blockIdx.x * NWG_T + otid(); idx < 176 * 528; idx += gridDim.x * NWG_T) {
        const int rc = idx / 176, j8 = idx - rc * 176; const int r0 = rc * 32; const int b = r0 / RB, s0 = r0 - b * RB;
        if (l == 1 && s0 < NCTX) continue;
        const int ca = hf * HFF + j8 * 8, cbc = DFF + hf * HFF + j8 * 8;
        f32x4 wa[3][2], wb[3][2], ba[2], bb[2];
#pragma unroll
        for (int k = 0; k < 3; ++k)
#pragma unroll
            for (int q = 0; q < 2; ++q) { wa[k][q] = *(const f32x4*)(cw + k * 5632 + ca + 4 * q); wb[k][q] = *(const f32x4*)(cw + k * 5632 + cbc + 4 * q); }
#pragma unroll
        for (int q = 0; q < 2; ++q) { ba[q] = *(const f32x4*)(cbv + ca + 4 * q); bb[q] = *(const f32x4*)(cbv + cbc + 4 * q); }
        const bool first = (s0 == 0) || (s0 == NCTX); const bool lastc = (s0 + 32 == NCTX) || (s0 + 32 == RB);
        const bf16_t* ur = U + (size_t)r0 * DFF + j8 * 8;
        bf16x8 ra[6], rb[6], na[4], nb[4];
        ra[0] = first ? z : *(const bf16x8*)(ur - DFF); rb[0] = first ? z : *(const bf16x8*)(ur - DFF + HFF);
#pragma unroll
        for (int k = 1; k < 6; ++k) { ra[k] = *(const bf16x8*)(ur + (size_t)(k - 1) * DFF); rb[k] = *(const bf16x8*)(ur + (size_t)(k - 1) * DFF + HFF); }
        for (int g = 0; g < 8; ++g) {
#pragma unroll
            for (int k = 0; k < 4; ++k) { const int i = 4 * g + 5 + k;
                const bool ok = i < 32 || (i == 32 && !lastc);
                na[k] = ok ? *(const bf16x8*)(ur + (size_t)i * DFF) : z; nb[k] = ok ? *(const bf16x8*)(ur + (size_t)i * DFF + HFF) : z; }
#pragma unroll
            for (int k = 0; k < 4; ++k) { float o[8];
#pragma unroll
                for (int j = 0; j < 8; ++j) { const int q = j >> 2, e = j & 3;
                    const float ua = bf2f((unsigned short)ra[k][j]) * wa[0][q][e] + bf2f((unsigned short)ra[k + 1][j]) * wa[1][q][e] + bf2f((unsigned short)ra[k + 2][j]) * wa[2][q][e] + ba[q][e];
                    const float ub = bf2f((unsigned short)rb[k][j]) * wb[0][q][e] + bf2f((unsigned short)rb[k + 1][j]) * wb[1][q][e] + bf2f((unsigned short)rb[k + 2][j]) * wb[2][q][e] + bb[q][e];
                    o[j] = siluf(ua) * ub; }
                *(bf16x8*)(ACT + (size_t)(r0 + 4 * g + k) * HFF + j8 * 8) = pack8(o[0], o[1], o[2], o[3], o[4], o[5], o[6], o[7]); }
            ra[0] = ra[4]; rb[0] = rb[4]; ra[1] = ra[5]; rb[1] = rb[5];
#pragma unroll
            for (int k = 0; k < 4; ++k) { ra[2 + k] = na[k]; rb[2 + k] = nb[k]; }
        }
    }
}

#define RLX_AGENT __ATOMIC_RELAXED, __HIP_MEMORY_SCOPE_AGENT
#define XB_TMO      128
#define XB_XCNT(j)  (256  + 64 * (j))
#define XB_XSUB(j)  (1280 + 64 * (j))
#define XB_XGEN(j)  (2304 + 64 * (j))
#define XB_TOP      3328
#define XB_TOPGEN   3392
#define XCD_BAR_WORDS 3456
#define XB_SPIN_CAP (1u << 18)

__device__ __forceinline__ unsigned xb_ld(unsigned* p)              { return __hip_atomic_load(p, __ATOMIC_RELAXED, __HIP_MEMORY_SCOPE_AGENT); }
__device__ __forceinline__ unsigned xb_add(unsigned* p, unsigned v) { return __hip_atomic_fetch_add(p, v, __ATOMIC_RELAXED, __HIP_MEMORY_SCOPE_AGENT); }
__device__ __forceinline__ unsigned xb_xcc_id() { return (unsigned)__builtin_amdgcn_s_getreg((3 << 11) | 20) & 0xFu; }
#define XB_SPIN(cond, bar) do { unsigned _sp = 0; while (cond) { __builtin_amdgcn_s_sleep(1); \
    if ((++_sp & 255u) == 0u) { if (xb_ld(&(bar)[XB_TMO])) break; if (_sp > XB_SPIN_CAP) { atomicAdd(&(bar)[XB_TMO], 1u); break; } } } } while (0)

struct XcdBarrier {
    unsigned* bar; unsigned x;
    volatile LAS unsigned* st;
};

__device__ __forceinline__ XcdBarrier xcd_barrier_post(unsigned* bar, volatile LAS unsigned* st) {
    XcdBarrier b; b.bar = bar; b.x = xb_xcc_id(); b.st = st;
    if (threadIdx.x == 0) (void)xb_add(&bar[XB_XCNT(b.x)], 1u);
    return b;
}
__device__ __forceinline__ void xcd_barrier_complete(unsigned* bar, unsigned x, unsigned& nloc, unsigned& nx) {
    const unsigned G = gridDim.x * gridDim.y * gridDim.z;
    unsigned sum, cnt, mine, sp = 0u;
    for (;;) {
        sum = 0u; cnt = 0u; mine = 0u;
#pragma unroll
        for (unsigned j = 0; j < 16; ++j) { const unsigned c = xb_ld(&bar[XB_XCNT(j)]); sum += c; cnt += (c > 0u) ? 1u : 0u; mine = (j == x) ? c : mine; }
        if (sum == G) break;
        __builtin_amdgcn_s_sleep(1);
        if ((++sp & 255u) == 0u) { if (xb_ld(&bar[XB_TMO])) break; if (sp > XB_SPIN_CAP) { atomicAdd(&bar[XB_TMO], 1u); break; } }
    }
    nloc = mine > 0u ? mine : 1u; nx = cnt > 0u ? cnt : 1u;
}

__device__ __forceinline__ void xcd_barrier(const XcdBarrier& b) {
    asm volatile("s_waitcnt vmcnt(0)" ::: "memory");
    __syncthreads();
    if (threadIdx.x == 0) {
        unsigned* bar = b.bar;
        __builtin_amdgcn_s_waitcnt(0);
        unsigned nloc = b.st[0], nx = b.st[1];
        if (nloc == 0u) { xcd_barrier_complete(bar, b.x, nloc, nx); b.st[0] = nloc; b.st[1] = nx; }
        const unsigned old = xb_add(&bar[XB_XSUB(b.x)], 1u);
        const unsigned gen = old / nloc;
        if (old + 1u == (gen + 1u) * nloc) {
            __builtin_amdgcn_fence(__ATOMIC_RELEASE, "agent");
            asm volatile("s_waitcnt vmcnt(0)" ::: "memory");
            const unsigned og = xb_add(&bar[XB_TOP], 1u);
            const unsigned tg = og / nx;
            if (og + 1u == (tg + 1u) * nx) xb_add(&bar[XB_TOPGEN], 1u);
            else XB_SPIN(xb_ld(&bar[XB_TOPGEN]) == tg, bar);
            __builtin_amdgcn_fence(__ATOMIC_ACQUIRE, "agent");
            xb_add(&bar[XB_XGEN(b.x)], 1u);
            asm volatile("s_waitcnt vmcnt(0)" ::: "memory");
        } else {
            XB_SPIN(xb_ld(&bar[XB_XGEN(b.x)]) == gen, bar);
            __builtin_amdgcn_fence(__ATOMIC_ACQUIRE, "agent");
            asm volatile("s_waitcnt vmcnt(0)" ::: "memory");
        }
    }
    __syncthreads();
}


constexpr size_t OFF_CTL = 250000128; constexpr int CTL_BYTES = 16384;
#if defined(__HIP_DEVICE_COMPILE__)
#define KP() const __attribute__((address_space(4))) Params* kp_ = (const __attribute__((address_space(4))) Params*)__builtin_amdgcn_kernarg_segment_ptr(); asm volatile("" : "+s"(kp_)); const Params p = *kp_; \
    bf16_t* HN = (bf16_t*)(p.ws + OFF_HN); bf16_t* P = (bf16_t*)p.out; float* X = (float*)(p.ws + OFF_X); (void)HN; (void)P; (void)X
#else
#define KP() const Params p = p_arg; bf16_t* HN = (bf16_t*)(p.ws + OFF_HN); bf16_t* P = (bf16_t*)p.out; float* X = (float*)(p.ws + OFF_X); (void)HN; (void)P; (void)X
#endif
#define WL() const bf16_t* wl = (const bf16_t*)(p.ws + OFF_W) + (size_t)l * W_LAYER; const float* modv = (const float*)(p.ws + OFF_MOD) + (size_t)l * 3 * 6144; (void)wl; (void)modv
#ifndef DUPM
#define DUPM 0
#endif
#define REP(bit) for (int rep_ = 0; rep_ < (((DUPM) >> (bit)) & 1) + 1; ++rep_)
constexpr int PH_PER_LAYER = 12, N_PHASES = 2 + 2 * PH_PER_LAYER;
__global__ void __launch_bounds__(512, 2) mk_fwd(Params p_arg) {
    extern __shared__ __attribute__((aligned(16))) unsigned char lds[];
    cg::grid_group grid = cg::this_grid();
    const int G = gridDim.x, bx = blockIdx.x; const int vcu = (G % 8 == 0) ? (bx % 8) * (G / 8) + bx / 8 : bx;
    LAS unsigned char* ldsl = (LAS unsigned char*)lds;
    const int ph_lo = p_arg.ph_lo, ph_hi = p_arg.ph_hi;
    volatile LAS unsigned* misc = (volatile LAS unsigned*)(ldsl + (LDS_BYTES - 64));
    { const int t0_ = otid(); if (t0_ < 16) misc[t0_] = 0u; }
    __syncthreads();
    if (ph_hi - ph_lo > 1) (void)xcd_barrier_post((unsigned*)(p_arg.ws + OFF_CTL), misc);
    for (int ph = ph_lo; ph < ph_hi; ++ph) {
        if (ph == 0) { KP(); REP(9) { phase_prep(p, lds); __syncthreads(); } }
        else if (ph == N_PHASES - 1) { KP(); phase_final(p);
#if (DUPM >> 10) & 1
            for (int i = 0; i < 20; ++i) grid.sync();
#endif
        }
        else {
            const int l = (ph - 1) / PH_PER_LAYER, sp = (ph - 1) % PH_PER_LAYER;
            if (sp == 0) { KP(); phase_norm(p, l, 0, l == 0, l == 1 ? (const float*)(p.ws + OFF_MOD) + 2 * 6144 + 5120 : nullptr); }
            else if (sp == 1) { KP(); WL(); REP(1) { __syncthreads();
                pg8::Gemm g{HN, wl + W_IN, R, 1792, 1024, 1024, 1024}; pg8::StaticOrder S; S.init(R, 1792, G, bx);
                pg8::EpiStore E{P, INW, INW, 1.0f};
                pg8::gemm_phase<pg8::EpiStore, pg8::StaticOrder, true, true>(ldsl, g, S, E); } }
            else if (sp == 2) { KP(); phase_rowwise(p, l); __syncthreads();
                REP(2) phase_pool(p);
                REP(3) for (int it = bx; it < 528; it += G) states_item(p, l, lds, it); }
            else if (sp == 3) { KP(); WL(); REP(4) { __syncthreads();
                { pg8::Gemm g{P + 768, wl + W_UQ, R, 768, 384, INW, 384}; pg8::StaticOrder S; S.init(R, 768, G, bx);
                  pg8::EpiStore E{(bf16_t*)(p.ws + OFF_OV + OV_Q), 768, 768, 0.14724444f};
                  pg8::gemm_phase<pg8::EpiStore, pg8::StaticOrder, true, true>(ldsl, g, S, E); }
                __syncthreads();
                { pg8::Gemm g{P + 1152, wl + W_KN, R, 512, 256, INW, 256}; pg8::StaticOrder S; S.init(R, 512, G, (bx + 58) % G);
                  pg8::EpiStore E{(bf16_t*)(p.ws + OFF_OV + OV_KN), 512, 512, 1.0f};
                  pg8::gemm_phase<pg8::EpiStore, pg8::StaticOrder, true, true>(ldsl, g, S, E); }
                __syncthreads();
                { pg8::Gemm g{wl + W_V, P + 1152, 512, R, 256, 256, INW}; pg8::StaticOrder S; S.init(512, R, G, (bx + 182) % G);
                  pg8::EpiStore E{(bf16_t*)(p.ws + OFF_OV + OV_VT), R, R, 1.0f};
                  pg8::gemm_phase<pg8::EpiStore, pg8::StaticOrder, true, true>(ldsl, g, S, E); }
                if (bx >= G - 64) scan_threads(p, l, (bx - (G - 64)) * NWG_T + otid()); } }
            else if (sp == 4) { KP();
                REP(5) for (int u = vcu; u < (l == 0 ? 528 : 512); u += G) attn_unit(p, lds, u);
                REP(6) for (int u = G - 1 - bx; u < (l == 0 ? 264 : 256); u += G) retout_unit(p, l, lds, l == 0 ? u : u + 4 * (u >> 7) + 4); }
            else if (sp == 5) { KP(); WL(); __syncthreads();
                { pg8::Gemm g{HN, wl + W_OUT, R, 1024, 1024, 1024, 1024}; pg8::StaticOrder S; S.init(16384, 1024, G, bx, 1);
                  pg8::EpiResid E{X, modv + 2048, 0};
                  pg8::gemm_phase<pg8::EpiResid, pg8::StaticOrder, true, true>(ldsl, g, S, E); }
                if (l == 0 && bx < 32) { __syncthreads(); const int q = bx >> 3;
                  pg8::Gemm g{HN + q * 256, wl + W_OUT + q * 256, 512, 1024, 256, 1024, 1024}; pg8::StaticOrder S; S.init(512, 1024, G, bx & 7, 2);
                  pg8::EpiPart E{(float*)(p.ws + OFF_PART) + (size_t)q * 524288, 0};
                  pg8::gemm_phase<pg8::EpiPart, pg8::StaticOrder, true, true>(ldsl, g, S, E); } }
            else if (sp == 6) { KP(); WL(); phase_norm(p, l, 1, false, l == 0 ? modv + 2 * 6144 + 2048 : nullptr); }
            else if (sp == 7 || sp == 9 || sp == 11) { KP(); WL();
                __syncthreads();
                if (sp >= 9) { const int hf = sp == 9 ? 0 : 1;
                    { pg8::Gemm g{P, wl + W_DN + hf * HFF, R, 1024, HFF, HFF, DFF}; pg8::StaticOrder S; S.init(16384, 1024, G, bx, 1);
                      pg8::EpiResid E{X, modv + 5120, 0};
                      pg8::gemm_phase<pg8::EpiResid, pg8::StaticOrder, true, true>(ldsl, g, S, E); __syncthreads(); }
                    if (l == 0 && bx < 32) { const int q = bx >> 3; const int koff = q * 384, klen = q < 3 ? 384 : 256;
                      pg8::Gemm g{P + koff, wl + W_DN + hf * HFF + koff, 512, 1024, klen, HFF, DFF}; pg8::StaticOrder S; S.init(512, 1024, G, bx & 7, 2);
                      pg8::EpiPart E{(float*)(p.ws + OFF_PART) + (size_t)q * 524288, hf};
                      pg8::gemm_phase<pg8::EpiPart, pg8::StaticOrder, true, true>(ldsl, g, S, E); __syncthreads(); } }
                if (sp <= 9) REP(7) { __syncthreads(); const int hf = sp == 7 ? 0 : 1;
                    pg8::Gemm g{HN, wl + W_UP + (size_t)hf * DFF * 1024, R, DFF, 1024, 1024, 1024}; pg8::StaticOrder S; S.init(l == 1 ? 16384 : R, DFF, G, (bx + (sp == 9 && l == 0 ? 214 : 0)) % G, l == 1 ? 1 : 0);
                    pg8::EpiStore E{(bf16_t*)(p.ws + OFF_OV + OV_U), DFF, DFF, 1.0f};
                    pg8::gemm_phase<pg8::EpiStore, pg8::StaticOrder, true, true>(ldsl, g, S, E); } }
            else if (sp == 8) { KP(); REP(8) phase_convact(p, l, 0); }
            else if (sp == 10) { KP(); REP(8) phase_convact(p, l, 1); }
        }
        if (ph + 1 < ph_hi) {
            if (ph == ph_lo) grid.sync();
            else { KP(); XcdBarrier b; b.bar = (unsigned*)(p.ws + OFF_CTL); b.x = xb_xcc_id(); b.st = misc; xcd_barrier(b); }
        }
    }
}

extern "C" void kernel_launch(void* const* d_in, const int* in_sizes, int n_in, void* d_out, int out_size, void* d_ws, size_t ws_size, hipStream_t stream) {
    static int grid = 0;
    if (grid == 0) {
        if (n_in != 23 || ws_size < WS_NEED) { fprintf(stderr, "kernel_launch: unexpected problem (n_in %d, ws %zu, need %zu)\n", n_in, ws_size, (size_t)WS_NEED); grid = -1; return; }
        int dev = 0, cus = 0, per_cu = 0;
        hipGetDevice(&dev); hipDeviceGetAttribute(&cus, hipDeviceAttributeMultiprocessorCount, dev);
        if (hipFuncSetAttribute((const void*)mk_fwd, hipFuncAttributeMaxDynamicSharedMemorySize, LDS_BYTES) != hipSuccess) { fprintf(stderr, "kernel_launch: hipFuncSetAttribute failed\n"); grid = -1; return; }
        if (hipOccupancyMaxActiveBlocksPerMultiprocessor(&per_cu, (const void*)mk_fwd, 512, LDS_BYTES) != hipSuccess || per_cu < 1) { fprintf(stderr, "kernel_launch: occupancy query says %d\n", per_cu); per_cu = 1; }
        (void)hipGetLastError();
        grid = cus * per_cu; if (grid > 256) grid = 256;
        fprintf(stderr, "kernel_launch: grid %d (cus %d, per_cu %d)\n", grid, cus, per_cu);
    }
    if (grid < 0) return;
    Params p{};
    const float** pp = (const float**)&p;
    for (int i = 0; i < 23; ++i) pp[i] = (const float*)d_in[i];
    p.out = (float*)d_out; p.ws = (unsigned char*)d_ws;
#if MK_MULTI
    for (int ph = 0; ph < N_PHASES; ++ph) { p.ph_lo = ph; p.ph_hi = ph + 1; void* args[] = {&p};
        hipError_t e = hipLaunchCooperativeKernel((void*)mk_fwd, dim3(grid), dim3(512), args, LDS_BYTES, stream);
        if (e != hipSuccess) { fprintf(stderr, "launch %d failed: %s\n", ph, hipGetErrorString(e)); break; } }
#else
    if (hipMemsetAsync((char*)d_ws + OFF_CTL, 0, CTL_BYTES, stream) != hipSuccess) { fprintf(stderr, "kernel_launch: memset of the barrier words failed\n"); return; }
    p.ph_lo = 0; p.ph_hi = N_PHASES; void* args[] = {&p};
    hipError_t e = hipLaunchCooperativeKernel((void*)mk_fwd, dim3(grid), dim3(512), args, LDS_BYTES, stream);
    if (e != hipSuccess) fprintf(stderr, "cooperative launch failed: %s (grid %d)\n", hipGetErrorString(e), grid);
#endif
}
```

```cpp
#include <hip/hip_runtime.h>
#include <hip/hip_cooperative_groups.h>
#include <cstdio>
#include <cstdint>
namespace cg = cooperative_groups;

#ifndef MK_MULTI
#define MK_MULTI 0
#endif

namespace pg8 {
#define PG8_LAS __attribute__((address_space(3)))
typedef unsigned short bf16_t;
typedef short bf16x8 __attribute__((ext_vector_type(8)));
typedef float f32x4 __attribute__((ext_vector_type(4)));
typedef unsigned u32x4 __attribute__((ext_vector_type(4)));
constexpr int BM = 256, BK = 64, HALF = 128, HTB = HALF * BK * 2  , STAGE_BYTES = 8 * HTB, NXCD = 8, WGM = 8;

__host__ __device__ __forceinline__ int lds_byte(int r, int c) { const int st = (r >> 4) * 2 + (c >> 5), rr = r & 15, cc = c & 31, ob = rr * 64 + cc * 2; return st * 1024 + (ob ^ (((ob >> 9) & 1) << 5)); }
__host__ __device__ __forceinline__ void stage_rc(int b, int& R, int& C) { const int st = b / 1024, sb = b % 1024, swz = sb ^ (((sb >> 9) & 1) << 5); R = (st >> 1) * 16 + swz / 64; C = (st & 1) * 32 + (swz % 64) / 2; }
__host__ __device__ __forceinline__ int perm32(int rho) { const int n = rho >> 4, i = rho & 15; return 8 * (i >> 2) + 4 * n + (i & 3); }

struct Unit { int pm, pn; };
struct Gemm { const bf16_t* A; const bf16_t* Bt; int M, N, K, lda, ldb; };

struct StaticOrder {
    int nM, nN, nwg, G, c, skip;
    __host__ __device__ void init(int M, int N, int G_, int c_, int skip_ = 0) { nM = M / BM; nN = N / BM; nwg = nM * nN; G = G_; c = c_; skip = skip_; }
    __host__ __device__ bool next(int i, Unit& u) const {
        const long L = (long)i * G + c; if (L >= nwg) return false;
        int wgid = (int)L; { const int q = nwg / NXCD, r = nwg % NXCD, xcd = wgid % NXCD, off = wgid / NXCD; wgid = (xcd < r ? xcd * (q + 1) : r * (q + 1) + (xcd - r) * q) + off; }
        const int nig = WGM * nN, gid = wgid / nig, fm = gid * WGM, gsz = (nM - fm) < WGM ? (nM - fm) : WGM;
        u.pm = fm + ((wgid % nig) % gsz); u.pn = (wgid % nig) / gsz; if (skip == 1) u.pm += 1 + (u.pm >= 32 ? 1 : 0); else if (skip == 2) u.pm *= 33; return true;
    }
    __device__ __forceinline__ void a_ready(const Unit&) const {}
    __device__ __forceinline__ void done(const Unit&) const {}
};

__device__ __forceinline__ unsigned cvt_pk_bf16(float lo, float hi) { unsigned r; asm volatile("v_cvt_pk_bf16_f32 %0, %1, %2" : "=v"(r) : "v"(lo), "v"(hi)); return r; }

struct EpiStore {
    static constexpr bool PERM = true, AFTER_DRAIN = false;
    bf16_t* O; int ldc; int ncols; float scale;
    __device__ __forceinline__ void operator()(const f32x4 (&acc)[2][2][4][2], const Unit& u, int wr, int wc, int fr, int fq) const {
        const int row0 = u.pm * BM + wr * 64 + fr; const int col0 = u.pn * BM + wc * 32 + 8 * fq;
#pragma unroll
        for (int ai = 0; ai < 2; ++ai)
#pragma unroll
            for (int m = 0; m < 4; ++m) { bf16_t* rowp = O + (size_t)(row0 + ai * HALF + m * 16) * ldc + col0;
#pragma unroll
                for (int bj = 0; bj < 2; ++bj) { if (col0 + bj * HALF < ncols) {
                    f32x4 v0 = acc[ai][bj][m][0] * scale, v1 = acc[ai][bj][m][1] * scale;
                    u32x4 w; w.x = cvt_pk_bf16(v0[0], v0[1]); w.y = cvt_pk_bf16(v0[2], v0[3]); w.z = cvt_pk_bf16(v1[0], v1[1]); w.w = cvt_pk_bf16(v1[2], v1[3]);
                    *(u32x4*)(rowp + bj * HALF) = w; } } }
    }
};
struct EpiResid {
    static constexpr bool PERM = false, AFTER_DRAIN = false;
    float* X; const float* gate; int row_tile0;
    __device__ __forceinline__ void operator()(const f32x4 (&acc)[2][2][4][2], const Unit& u, int wr, int wc, int fr, int fq) const {
        const int tpm = u.pm + row_tile0; const int bb = tpm / 33, jj = tpm - bb * 33; const float* gv = gate + (jj == 0 ? 2 : bb) * 6144;
        const int col0 = u.pn * BM + wc * 32 + 4 * fq;
#pragma unroll
        for (int ai = 0; ai < 2; ++ai)
#pragma unroll
            for (int m = 0; m < 4; ++m) { float* rowp = X + (size_t)(tpm * BM + ai * HALF + wr * 64 + m * 16 + fr) * 1024 + col0;
#pragma unroll
                for (int bj = 0; bj < 2; ++bj) {
#pragma unroll
                    for (int n = 0; n < 2; ++n) { f32x4* q = (f32x4*)(rowp + bj * HALF + n * 16); const f32x4 gq = *(const f32x4*)(gv + col0 + bj * HALF + n * 16); f32x4 xv = *q; xv = xv + gq * acc[ai][bj][m][n]; *q = xv; }
                    asm volatile("" ::: "memory"); } }
    }
};
struct EpiPart {
    static constexpr bool PERM = false, AFTER_DRAIN = false;
    float* out; int accum;
    __device__ __forceinline__ void operator()(const f32x4 (&acc)[2][2][4][2], const Unit& u, int wr, int wc, int fr, int fq) const {
        const int t = u.pm / 33; const int col0 = u.pn * BM + wc * 32 + 4 * fq;
#pragma unroll
        for (int ai = 0; ai < 2; ++ai)
#pragma unroll
            for (int m = 0; m < 4; ++m) { float* rowp = out + (size_t)(t * BM + ai * HALF + wr * 64 + m * 16 + fr) * 1024 + col0;
#pragma unroll
                for (int bj = 0; bj < 2; ++bj) {
#pragma unroll
                    for (int n = 0; n < 2; ++n) { f32x4* q = (f32x4*)(rowp + bj * HALF + n * 16); f32x4 v = acc[ai][bj][m][n]; if (accum) v = v + *q; *q = v; }
                    asm volatile("" ::: "memory"); } }
    }
};
template <int CTRL> __device__ __forceinline__ float dpp0(float x) { return __builtin_bit_cast(float, __builtin_amdgcn_update_dpp(0, __builtin_bit_cast(int, x), CTRL, 0xf, 0xf, true)); }
struct EpiFfn {
    static constexpr bool PERM = false, AFTER_DRAIN = false;
    bf16_t* ACT; float* EDGE; const float* cw; const float* cb; PG8_LAS float* xl;
    __device__ __forceinline__ void operator()(const f32x4 (&acc)[2][2][4][2], const Unit& u, int wr, int wc, int fr, int fq) const {
        PG8_LAS float* FIRST = xl; PG8_LAS float* LAST = xl + 1024;
        const int cb0 = wc * 32 + 4 * fq;
#pragma unroll
        for (int ai = 0; ai < 2; ++ai)
#pragma unroll
            for (int bj = 0; bj < 2; ++bj)
#pragma unroll
                for (int n = 0; n < 2; ++n) { const int col = bj * HALF + cb0 + n * 16;
                    if (fr == 0) *(PG8_LAS f32x4*)(FIRST + (2 * ai + wr) * 256 + col) = acc[ai][bj][0][n];
                    if (fr == 15) *(PG8_LAS f32x4*)(LAST + (2 * ai + wr) * 256 + col) = acc[ai][bj][3][n]; }
        if (wr == 0 && fr < 2) {
#pragma unroll
            for (int bj = 0; bj < 2; ++bj)
#pragma unroll
                for (int n = 0; n < 2; ++n) *(f32x4*)(EDGE + ((size_t)(u.pm * 4 + fr) * 22 + u.pn) * 256 + bj * HALF + cb0 + n * 16) = acc[0][bj][0][n]; }
        if (wr == 1 && fr >= 14) {
#pragma unroll
            for (int bj = 0; bj < 2; ++bj)
#pragma unroll
                for (int n = 0; n < 2; ++n) *(f32x4*)(EDGE + ((size_t)(u.pm * 4 + 2 + (fr - 14)) * 22 + u.pn) * 256 + bj * HALF + cb0 + n * 16) = acc[1][bj][3][n]; }
        asm volatile("s_waitcnt lgkmcnt(0)" ::: "memory"); __builtin_amdgcn_s_barrier(); asm volatile("" ::: "memory");
#pragma unroll
        for (int n = 0; n < 2; ++n) { const int ch0 = u.pn * HALF + cb0 + n * 16;
            f32x4 wa[3], wb[3];
#pragma unroll
            for (int k = 0; k < 3; ++k) { wa[k] = *(const f32x4*)(cw + k * 5632 + ch0); wb[k] = *(const f32x4*)(cw + k * 5632 + 2816 + ch0); }
            const f32x4 ba = *(const f32x4*)(cb + ch0), bb = *(const f32x4*)(cb + 2816 + ch0);
#pragma unroll
            for (int ai = 0; ai < 2; ++ai) { const int g = 2 * ai + wr;
                f32x4 bu[2], bd[2];
#pragma unroll
                for (int bj = 0; bj < 2; ++bj) { const int col = bj * HALF + cb0 + n * 16; const f32x4 zz = {0.f, 0.f, 0.f, 0.f};
                    bu[bj] = g > 0 ? *(const PG8_LAS f32x4*)(LAST + (g - 1) * 256 + col) : zz; bd[bj] = g < 3 ? *(const PG8_LAS f32x4*)(FIRST + (g + 1) * 256 + col) : zz; }
#pragma unroll
                for (int m = 0; m < 4; ++m) { float o[4];
#pragma unroll
                    for (int e = 0; e < 4; ++e) { float up[2], dn[2];
#pragma unroll
                        for (int bj = 0; bj < 2; ++bj) { const float cur = acc[ai][bj][m][n][e];
                            float x = dpp0<0x111>(cur);
                            if (m > 0) x += dpp0<0x10F>(acc[ai][bj][m - 1][n][e]); else x += (fr == 0 ? bu[bj][e] : 0.f);
                            float y = dpp0<0x101>(cur);
                            if (m < 3) y += dpp0<0x11F>(acc[ai][bj][m + 1][n][e]); else y += (fr == 15 ? bd[bj][e] : 0.f);
                            up[bj] = x; dn[bj] = y; }
                        const float ua = wa[0][e] * up[0] + wa[1][e] * acc[ai][0][m][n][e] + wa[2][e] * dn[0] + ba[e];
                        const float ub = wb[0][e] * up[1] + wb[1][e] * acc[ai][1][m][n][e] + wb[2][e] * dn[1] + bb[e];
                        o[e] = ua / (1.0f + __expf(-ua)) * ub; }
                    typedef unsigned u32x2 __attribute__((ext_vector_type(2))); u32x2 w; w.x = cvt_pk_bf16(o[0], o[1]); w.y = cvt_pk_bf16(o[2], o[3]);
                    *(u32x2*)(ACT + (size_t)(u.pm * BM + ai * HALF + wr * 64 + m * 16 + fr) * 2816 + ch0) = w; } } }
    }
};

template <class Epi, class Sched, bool ALIGN_EPI = false, bool SP2 = false>
__device__ __forceinline__ void gemm_phase(PG8_LAS unsigned char* lds, const Gemm g, const Sched& S, const Epi& E) {
    int tid = threadIdx.x; asm volatile("" : "+v"(tid));
    const int wid = __builtin_amdgcn_readfirstlane(tid >> 6), lane = tid & 63, wr = wid >> 2, wc = wid & 3, fr = lane & 15, fq = lane >> 4;
    int K = g.K; asm volatile("" : "+s"(K));
    const int nt = K / BK;
    unsigned voffA[2], voffB[2];
#pragma unroll
    for (int i = 0; i < 2; ++i) { int R, C; stage_rc(tid * 16 + i * 8192, R, C); const int Rb = Epi::PERM ? ((R & ~31) + perm32(R & 31)) : R;
        voffA[i] = (unsigned)(R * g.lda + C) * 2u; voffB[i] = (unsigned)(Rb * g.ldb + C) * 2u; }
    const size_t kstep = (size_t)(BK * 2);
    const size_t hstepA = (size_t)HALF * g.lda * 2, hstepB = (size_t)HALF * g.ldb * 2;
    const size_t tstepA = 2 * hstepA, tstepB = 2 * hstepB;
    const unsigned ldsw = (unsigned)wid * 1024u;
    const int aoff = lds_byte(wr * 64 + fr, fq * 8), boff = lds_byte(wc * 32 + fr, fq * 8);
#define PG8_SA(b, h) (((b) * 2 + (h)) * HTB)
#define PG8_SB(b, h) ((4 + (b) * 2 + (h)) * HTB)
#define PG8_STAGE(bufoff, gbase, voff) do { _Pragma("unroll") for (int _i = 0; _i < 2; ++_i) \
        __builtin_amdgcn_global_load_lds((const unsigned*)((const char*)(gbase) + (voff)[_i]), (PG8_LAS unsigned*)(lds + (bufoff) + ldsw + _i * 8192), 16, 0, 0); } while (0)
#define PG8_LDA(dst, b, h) do { _Pragma("unroll") for (int m = 0; m < 4; ++m) _Pragma("unroll") for (int k = 0; k < 2; ++k) dst[m][k] = *(const PG8_LAS bf16x8*)(lds + PG8_SA(b, h) + aoff + m * 2048 + k * 1024); } while (0)
#define PG8_LDB(dst, b, h) do { _Pragma("unroll") for (int n = 0; n < 2; ++n) _Pragma("unroll") for (int k = 0; k < 2; ++k) dst[n][k] = *(const PG8_LAS bf16x8*)(lds + PG8_SB(b, h) + boff + n * 2048 + k * 1024); } while (0)
#define PG8_MMA(ai, bj, At, Bt) do { __builtin_amdgcn_s_setprio(1); _Pragma("unroll") for (int m = 0; m < 4; ++m) _Pragma("unroll") for (int n = 0; n < 2; ++n) _Pragma("unroll") for (int k = 0; k < 2; ++k) \
        acc[ai][bj][m][n] = __builtin_amdgcn_mfma_f32_16x16x32_bf16(Bt[n][k], At[m][k], acc[ai][bj][m][n], 0, 0, 0); __builtin_amdgcn_s_setprio(0); } while (0)
#define PG8_WAIT_V(n) asm volatile("s_waitcnt vmcnt(" #n ")" ::: "memory")
#define PG8_WAIT_L(n) asm volatile("s_waitcnt lgkmcnt(" #n ")" ::: "memory")
#define PG8_BAR __builtin_amdgcn_s_barrier()
#define PG8_SCHED __builtin_amdgcn_sched_barrier(0)
    Unit cur, nxt; int ui = 0;
    if (!S.next(0, cur)) return;
    f32x4 acc[2][2][4][2];
#pragma unroll
    for (int a = 0; a < 2; ++a)
#pragma unroll
        for (int b = 0; b < 2; ++b)
#pragma unroll
            for (int m = 0; m < 4; ++m)
#pragma unroll
                for (int n = 0; n < 2; ++n) acc[a][b][m][n] = (f32x4){0.f, 0.f, 0.f, 0.f};
    bf16x8 At[4][2], B0[2][2], B1[2][2];
    const char* cA = (const char*)g.A + (size_t)cur.pm * tstepA; const char* cB = (const char*)g.Bt + (size_t)cur.pn * tstepB;
    S.a_ready(cur);
    if constexpr (SP2) {
        PG8_STAGE(PG8_SB(0, 0), cB, voffB); PG8_STAGE(PG8_SB(0, 1), cB + hstepB, voffB); PG8_STAGE(PG8_SA(0, 0), cA, voffA); PG8_STAGE(PG8_SA(0, 1), cA + hstepA, voffA);
        if (wr == 1) PG8_BAR;
        PG8_WAIT_V(2); PG8_BAR;
        PG8_STAGE(PG8_SB(1, 0), cB + kstep, voffB); PG8_STAGE(PG8_SA(1, 0), cA + kstep, voffA); PG8_STAGE(PG8_SB(1, 1), cB + hstepB + kstep, voffB);
        PG8_WAIT_V(6); PG8_BAR;
    } else {
        PG8_STAGE(PG8_SB(0, 0), cB, voffB); PG8_STAGE(PG8_SA(0, 0), cA, voffA); PG8_STAGE(PG8_SB(0, 1), cB + hstepB, voffB); PG8_STAGE(PG8_SA(0, 1), cA + hstepA, voffA);
        if (wr == 1) PG8_BAR;
        PG8_WAIT_V(4); PG8_BAR;
        PG8_STAGE(PG8_SB(1, 0), cB + kstep, voffB); PG8_STAGE(PG8_SA(1, 0), cA + kstep, voffA); PG8_STAGE(PG8_SB(1, 1), cB + hstepB + kstep, voffB);
        PG8_WAIT_V(6); PG8_BAR;
    }
    for (;;) {
        const bool has_next = S.next(ui + 1, nxt);
        const char* nA = has_next ? (const char*)g.A + (size_t)nxt.pm * tstepA : cA; const char* nB = has_next ? (const char*)g.Bt + (size_t)nxt.pn * tstepB : cB;
        for (int t = 0; t < nt; t += 2) {
            const bool last = (t == nt - 2);
            const char* a1 = cA + (size_t)(t + 1) * kstep;
            const char* a2 = last ? nA : cA + (size_t)(t + 2) * kstep; const char* b2 = last ? nB : cB + (size_t)(t + 2) * kstep;
            const char* a3 = a2 + kstep; const char* b3 = b2 + kstep;
            if (last && has_next) S.a_ready(nxt);
            if constexpr (SP2) {
            PG8_LDB(B0, 0, 0); PG8_LDB(B1, 0, 1); PG8_SCHED; PG8_LDA(At, 0, 0); PG8_STAGE(PG8_SA(1, 1), a1 + hstepA, voffA);
            PG8_WAIT_V(8); PG8_WAIT_L(0); PG8_BAR; PG8_MMA(0, 0, At, B0); PG8_MMA(0, 1, At, B1); PG8_BAR; PG8_SCHED;
            PG8_LDA(At, 0, 1); PG8_STAGE(PG8_SB(0, 0), b2, voffB); PG8_STAGE(PG8_SB(0, 1), b2 + hstepB, voffB); PG8_STAGE(PG8_SA(0, 0), a2, voffA);
            PG8_WAIT_V(8); PG8_WAIT_L(0); PG8_BAR; PG8_MMA(1, 0, At, B0); PG8_MMA(1, 1, At, B1); PG8_BAR; PG8_SCHED;
            PG8_LDB(B0, 1, 0); PG8_LDB(B1, 1, 1); PG8_SCHED; PG8_LDA(At, 1, 0); PG8_STAGE(PG8_SA(0, 1), a2 + hstepA, voffA);
            PG8_WAIT_V(8); PG8_WAIT_L(0); PG8_BAR; PG8_MMA(0, 0, At, B0); PG8_MMA(0, 1, At, B1); PG8_BAR; PG8_SCHED;
            PG8_LDA(At, 1, 1); PG8_STAGE(PG8_SB(1, 0), b3, voffB); PG8_STAGE(PG8_SB(1, 1), b3 + hstepB, voffB); PG8_STAGE(PG8_SA(1, 0), a3, voffA);
            PG8_WAIT_V(8); PG8_WAIT_L(0); PG8_BAR; PG8_MMA(1, 0, At, B0); PG8_MMA(1, 1, At, B1); PG8_BAR; PG8_SCHED;
            } else {
            PG8_LDB(B0, 0, 0); PG8_SCHED; PG8_LDA(At, 0, 0); PG8_STAGE(PG8_SA(1, 1), a1 + hstepA, voffA);
            PG8_WAIT_L(8); PG8_BAR; PG8_WAIT_L(0); PG8_MMA(0, 0, At, B0); PG8_BAR; PG8_SCHED;
            PG8_LDB(B1, 0, 1); PG8_STAGE(PG8_SB(0, 0), b2, voffB);
            PG8_BAR; PG8_WAIT_L(0); PG8_MMA(0, 1, At, B1); PG8_BAR;
            PG8_LDA(At, 0, 1); PG8_STAGE(PG8_SA(0, 0), a2, voffA);
            PG8_BAR; PG8_WAIT_L(0); PG8_MMA(1, 0, At, B0); PG8_BAR; PG8_SCHED;
            PG8_STAGE(PG8_SB(0, 1), b2 + hstepB, voffB);
            PG8_WAIT_V(6); PG8_BAR; PG8_MMA(1, 1, At, B1); PG8_BAR;
            PG8_LDB(B0, 1, 0); PG8_SCHED; PG8_LDA(At, 1, 0); PG8_STAGE(PG8_SA(0, 1), a2 + hstepA, voffA);
            PG8_WAIT_L(8); PG8_BAR; PG8_WAIT_L(0); PG8_MMA(0, 0, At, B0); PG8_BAR; PG8_SCHED;
            PG8_LDB(B1, 1, 1); PG8_STAGE(PG8_SB(1, 0), b3, voffB);
            PG8_BAR; PG8_WAIT_L(0); PG8_MMA(0, 1, At, B1); PG8_BAR;
            PG8_LDA(At, 1, 1); PG8_STAGE(PG8_SA(1, 0), a3, voffA);
            PG8_BAR; PG8_WAIT_L(0); PG8_MMA(1, 0, At, B0); PG8_BAR; PG8_SCHED;
            PG8_STAGE(PG8_SB(1, 1), b3 + hstepB, voffB);
            PG8_WAIT_V(6); PG8_BAR; PG8_MMA(1, 1, At, B1); PG8_BAR;
            }
        }
        if constexpr (ALIGN_EPI) { if (wr == 0) PG8_BAR; }
        if constexpr (!Epi::AFTER_DRAIN) { E(acc, cur, wr, wc, fr, fq); S.done(cur); }
        if (!has_next) break;
#pragma unroll
        for (int a = 0; a < 2; ++a)
#pragma unroll
            for (int b = 0; b < 2; ++b)
#pragma unroll
                for (int m = 0; m < 4; ++m)
#pragma unroll
                    for (int n = 0; n < 2; ++n) acc[a][b][m][n] = (f32x4){0.f, 0.f, 0.f, 0.f};
        cur = nxt; cA = nA; cB = nB; ++ui;
        if constexpr (ALIGN_EPI) { if (wr == 1) PG8_BAR; }
    }
    PG8_WAIT_V(0);
    if constexpr (!ALIGN_EPI) { if (wr == 0) PG8_BAR; }
    PG8_BAR;
    if constexpr (Epi::AFTER_DRAIN) { E.fused(acc, cur, wr, wc, fr, fq, lds, wid, lane); S.done(cur); }
#undef PG8_SA
#undef PG8_SB
#undef PG8_STAGE
#undef PG8_LDA
#undef PG8_LDB
#undef PG8_MMA
#undef PG8_WAIT_V
#undef PG8_WAIT_L
#undef PG8_BAR
#undef PG8_SCHED
}
}

#define DEV __device__ __forceinline__
#define LAS __attribute__((address_space(3)))
typedef unsigned short bf16_t;
typedef short bf16x8 __attribute__((ext_vector_type(8)));
typedef float f32x4 __attribute__((ext_vector_type(4)));
typedef float f32x2 __attribute__((ext_vector_type(2)));
typedef float f32x16 __attribute__((ext_vector_type(16)));
typedef unsigned u32x4 __attribute__((ext_vector_type(4)));
typedef unsigned u32x2 __attribute__((ext_vector_type(2)));

constexpr int R = 16896, RB = 8448, NCTX = 256, TL = 8192, DM = 1024, INW = 1696, DFF = 2816, HFF = 1408;
constexpr int NWG_T = 512;
constexpr float EPS = 1e-6f;
constexpr int LDS_BYTES = 147456;
constexpr size_t OFF_X = 0, OFF_HN = 69206016, OFF_W = 103809024, OFF_MOD = 152174592, OFF_ROPE = 152436736, OFF_OV = 153485312;
constexpr size_t OV_Q = 0, OV_KN = 25952256, OV_VT = 43253760, OV_SLOC = 60555264, OV_SIN = 69206016, OV_U = 0;
constexpr size_t OFF_PART = 250100224;
constexpr size_t OFF_EDGE = 258488832;
constexpr size_t WS_NEED = OFF_EDGE + 5947392;
constexpr size_t W_IN = 0, W_UQ = 1835008, W_KN = 2129920, W_V = 2260992, W_OUT = 2392064, W_UP = 3440640, W_DN = 9207808, W_LAYER = 12091392;

struct Params {
    const float *x, *c, *ctx, *c_ctx, *w_mod, *b_mod, *norm1_g, *w_in, *ret_decay_f, *ret_decay_b, *mla_q_norm_g, *w_uq, *mla_kv_norm_g, *w_ukv,
        *pool_w, *pool_scale, *w_out, *norm2_g, *w_up, *conv_w, *conv_b, *w_down, *final_norm_g;
    float* out; unsigned char* ws; int ph_lo, ph_hi;
};

DEV int otid() { int t = threadIdx.x; asm volatile("" : "+v"(t)); return t; }
DEV float bf2f(unsigned short x) { return __uint_as_float((unsigned)x << 16); }
DEV unsigned f2bf(float f) { unsigned u = __float_as_uint(f); return (u + 0x7fffu + ((u >> 16) & 1u)) >> 16; }
DEV unsigned pk2(float lo, float hi) { return f2bf(lo) | (f2bf(hi) << 16); }
DEV float wave_sum(float v) {
#pragma unroll
    for (int o = 1; o < 64; o <<= 1) v += __shfl_xor(v, o);
    return v;
}
DEV float siluf(float x) { return x / (1.0f + __expf(-x)); }
DEV int crow(int r, int hi) { return (r & 3) + 8 * (r >> 2) + 4 * hi; }
DEV bf16x8 pack8(float a0, float a1, float a2, float a3, float a4, float a5, float a6, float a7) {
    u32x4 w; w.x = pg8::cvt_pk_bf16(a0, a1); w.y = pg8::cvt_pk_bf16(a2, a3); w.z = pg8::cvt_pk_bf16(a4, a5); w.w = pg8::cvt_pk_bf16(a6, a7);
    return __builtin_bit_cast(bf16x8, w);
}
DEV int row_mi(int r) { const int b = r / RB; const int s = r - b * RB; return s < NCTX ? 2 : b; }

DEV void transpose_item(const float* W, int K, int Nsrc, bf16_t* WT, int n0, int cs, int k0, float* scr, int lane) {
#pragma unroll
    for (int i = 0; i < 32; ++i) { const int kk = 2 * i + (lane >> 5); scr[kk * 33 + (lane & 31)] = cs >= 0 ? W[(size_t)(k0 + kk) * Nsrc + cs + (lane & 31)] : 0.f; }
    asm volatile("s_waitcnt lgkmcnt(0)" ::: "memory");
    const int c = lane & 7;
#pragma unroll
    for (int j = 0; j < 4; ++j) { const int n = (lane >> 3) + 8 * j; const float* s = scr + (8 * c) * 33 + n;
        u32x4 o; o.x = pk2(s[0 * 33], s[1 * 33]); o.y = pk2(s[2 * 33], s[3 * 33]); o.z = pk2(s[4 * 33], s[5 * 33]); o.w = pk2(s[6 * 33], s[7 * 33]);
        *(u32x4*)(WT + (size_t)(n0 + n) * K + k0 + 8 * c) = o; }
    asm volatile("s_waitcnt lgkmcnt(0)" ::: "memory");
}
DEV int map_in(int n0) { return n0 < 1440 ? n0 : (n0 < INW ? -2 : -1); }
DEV int map_kn(int n0) { return (n0 >> 6) * 128 + (n0 & 63); }
DEV int map_v(int n0) { return (n0 >> 6) * 128 + 64 + (n0 & 63); }
DEV int map_up(int n0) { const int pn = n0 >> 8, w = n0 & 255; return w < 128 ? 128 * pn + w : DFF + 128 * pn + (w - 128); }

DEV void phase_prep(const Params& p, unsigned char* lds) {
    const int tid = otid(), lane = tid & 63, wid = tid >> 6;
    unsigned char* ws = p.ws;
    { f32x2* rope = (f32x2*)(ws + OFF_ROPE);
      for (int idx = blockIdx.x * NWG_T + tid; idx < TL * 16; idx += gridDim.x * NWG_T) { const int t = idx >> 4, i = idx & 15; const int pos = i < 8 ? (t >> 6) : (t & 63);
          const float inv = exp2f(-(float)(i & 7) * 0.125f * 13.287712379549449f); const float ang = (float)pos * inv; f32x2 cs; cs.x = __cosf(ang); cs.y = __sinf(ang); rope[idx] = cs; } }
    { float* scv = (float*)lds;
      float* red = scv + 3 * 1024;
      for (int i = tid; i < 3 * 1024; i += NWG_T) { const int v = i >> 10, k = i & 1023; const float cv = v < 2 ? p.c[v * 1024 + k] : p.c_ctx[k]; scv[i] = siluf(cv); }
      __syncthreads();
      float* modv = (float*)(ws + OFF_MOD);
      for (int it = blockIdx.x; it < 192; it += gridDim.x) { const int l = it / 96, col0 = (it % 96) * 64;
          const float* wm = p.w_mod + (size_t)l * 1024 * 6144 + col0 + lane; float a0 = 0.f, a1 = 0.f, a2 = 0.f;
#pragma unroll 16
          for (int k = wid * 128; k < wid * 128 + 128; ++k) { const float w = wm[(size_t)k * 6144]; a0 += scv[k] * w; a1 += scv[1024 + k] * w; a2 += scv[2048 + k] * w; }
          red[(wid * 3 + 0) * 64 + lane] = a0; red[(wid * 3 + 1) * 64 + lane] = a1; red[(wid * 3 + 2) * 64 + lane] = a2;
          __syncthreads();
          if (tid < 192) { const int v = tid >> 6, cl = tid & 63; float s = 0.f;
#pragma unroll
              for (int w = 0; w < 8; ++w) s += red[(w * 3 + v) * 64 + cl];
              modv[((size_t)l * 3 + v) * 6144 + col0 + cl] = s + p.b_mod[l * 6144 + col0 + cl]; }
          __syncthreads(); }
    }
    { float* scr = (float*)(lds + 32768 + wid * 8704);
      const int gw = blockIdx.x * 8 + wid, NGW = gridDim.x * 8;
      constexpr int I_IN = 16 * 56, I_UQ = 6 * 24, I_KN = 4 * 16, I_V = 4 * 16, I_OUT = 16 * 32, I_UP = 16 * 176, I_DN = 44 * 32, I_L = I_IN + I_UQ + I_KN + I_V + I_OUT + I_UP + I_DN;
      for (int it = gw; it < 2 * I_L; it += NGW) { const int l = it / I_L; int r = it - l * I_L; bf16_t* wl = (bf16_t*)(ws + OFF_W) + (size_t)l * W_LAYER;
          const float* src; int K, Nsrc, nbn, mp; size_t doff;
          if (r < I_IN) { src = p.w_in + (size_t)l * 1024 * INW; K = 1024; Nsrc = INW; nbn = 56; mp = 1; doff = W_IN; }
          else if ((r -= I_IN) < I_UQ) { src = p.w_uq + (size_t)l * 384 * 768; K = 384; Nsrc = 768; nbn = 24; mp = 0; doff = W_UQ; }
          else if ((r -= I_UQ) < I_KN) { src = p.w_ukv + (size_t)l * 256 * 1024; K = 256; Nsrc = 1024; nbn = 16; mp = 2; doff = W_KN; }
          else if ((r -= I_KN) < I_V) { src = p.w_ukv + (size_t)l * 256 * 1024; K = 256; Nsrc = 1024; nbn = 16; mp = 3; doff = W_V; }
          else if ((r -= I_V) < I_OUT) { src = p.w_out + (size_t)l * 1024 * 1024; K = 1024; Nsrc = 1024; nbn = 32; mp = 0; doff = W_OUT; }
          else if ((r -= I_OUT) < I_UP) { src = p.w_up + (size_t)l * 1024 * 5632; K = 1024; Nsrc = 5632; nbn = 176; mp = 4; doff = W_UP; }
          else { r -= I_UP; src = p.w_down + (size_t)l * DFF * 1024; K = DFF; Nsrc = 1024; nbn = 32; mp = 0; doff = W_DN; }
          const int kb = r / nbn, nb = r - kb * nbn, n0 = nb * 32;
          const int cs = mp == 0 ? n0 : mp == 1 ? map_in(n0) : mp == 2 ? map_kn(n0) : mp == 3 ? map_v(n0) : map_up(n0);
          if (cs != -2) transpose_item(src, K, Nsrc, wl + doff, n0, cs, kb * 64, scr, lane); }
    }
    { for (int idx = blockIdx.x * NWG_T + tid; idx < 2 * 1024 * 256; idx += gridDim.x * NWG_T) { const int n = idx & 255, k = (idx >> 8) & 1023, l = idx >> 18; const int g = n >> 6, d = n & 63;
          const float* wr = p.w_in + ((size_t)l * 1024 + k) * INW + 1440 + g * 64; const float* pw = p.pool_w + ((size_t)(l * 4 + g) * 64) * 64 + d; float s = 0.f;
#pragma unroll 8
          for (int c = 0; c < 64; ++c) s += wr[c] * pw[c * 64];
          ((bf16_t*)(ws + OFF_W) + (size_t)l * W_LAYER + W_IN)[(size_t)(1440 + n) * 1024 + k] = (bf16_t)f2bf(s * p.pool_scale[l * 256 + n]); } }
}

DEV void phase_norm(const Params& p, int l, int which, bool first, const float* pgate) {
    const int tid = otid(); const int lane = tid & 63, wid = tid >> 6; const int gw = blockIdx.x * 8 + wid, NGW = gridDim.x * 8;
    float* X = (float*)(p.ws + OFF_X); bf16_t* HN = (bf16_t*)(p.ws + OFF_HN);
    const float* modv = (const float*)(p.ws + OFF_MOD) + (size_t)l * 3 * 6144;
    const float* g = (which == 0 ? p.norm1_g : p.norm2_g) + l * 1024;
    for (int r = gw; r < R; r += NGW) {
        const int b = r / RB, s = r - b * RB; const int mi = s < NCTX ? 2 : b;
        const float* src = first ? (s < NCTX ? p.ctx + ((size_t)b * NCTX + s) * 1024 : p.x + ((size_t)b * TL + (s - NCTX)) * 1024) : X + (size_t)r * 1024;
        const f32x4* xr = (const f32x4*)src + lane; f32x4 v[4]; float ss = 0.f;
#pragma unroll
        for (int j = 0; j < 4; ++j) { v[j] = xr[64 * j]; ss += (v[j].x * v[j].x + v[j].y * v[j].y) + (v[j].z * v[j].z + v[j].w * v[j].w); }
        if (pgate != nullptr && s < NCTX) { const float* PART = (const float*)(p.ws + OFF_PART) + (size_t)(b * NCTX + s) * 1024; ss = 0.f;
#pragma unroll
            for (int j = 0; j < 4; ++j) { const f32x4 gq = ((const f32x4*)pgate)[lane + 64 * j]; f32x4 a = ((const f32x4*)PART)[lane + 64 * j];
#pragma unroll
                for (int q = 1; q < 4; ++q) a = a + ((const f32x4*)(PART + (size_t)q * 524288))[lane + 64 * j];
                v[j] = v[j] + gq * a; ss += (v[j].x * v[j].x + v[j].y * v[j].y) + (v[j].z * v[j].z + v[j].w * v[j].w); } }
        if (first || (pgate != nullptr && s < NCTX)) { f32x4* xo = (f32x4*)(X + (size_t)r * 1024) + lane;
#pragma unroll
            for (int j = 0; j < 4; ++j) xo[64 * j] = v[j]; }
        const float rs = rsqrtf(wave_sum(ss) * (1.f / 1024.f) + EPS);
        const float* mv = modv + mi * 6144 + (which == 0 ? 0 : 3072);
        u32x2* o8 = (u32x2*)(HN + (size_t)r * 1024) + lane;
#pragma unroll
        for (int j = 0; j < 4; ++j) { const f32x4 gg = ((const f32x4*)g)[lane + 64 * j], sh = ((const f32x4*)mv)[lane + 64 * j], sc = ((const f32x4*)(mv + 1024))[lane + 64 * j];
            const f32x4 y = v[j] * rs * gg; const f32x4 h = y * (sc + 1.0f) + sh; u32x2 w; w.x = pk2(h.x, h.y); w.y = pk2(h.z, h.w); o8[64 * j] = w; }
    }
}
DEV void phase_final(const Params& p) {
    const int tid = otid(); const int lane = tid & 63, wid = tid >> 6; const int gw = blockIdx.x * 8 + wid, NGW = gridDim.x * 8;
    const float* X = (const float*)(p.ws + OFF_X);
    for (int q = gw; q < 2 * TL; q += NGW) { const int b = q / TL, t = q - b * TL; const int r = b * RB + NCTX + t;
        const f32x4* xr = (const f32x4*)(X + (size_t)r * 1024) + lane; f32x4 v[4]; float ss = 0.f;
#pragma unroll
        for (int j = 0; j < 4; ++j) { v[j] = xr[64 * j]; ss += (v[j].x * v[j].x + v[j].y * v[j].y) + (v[j].z * v[j].z + v[j].w * v[j].w); }
        const float rs = rsqrtf(wave_sum(ss) * (1.f / 1024.f) + EPS);
        f32x4* o = (f32x4*)(p.out + (size_t)q * 1024) + lane;
#pragma unroll
        for (int j = 0; j < 4; ++j) { const f32x4 gg = ((const f32x4*)p.final_norm_g)[lane + 64 * j]; o[64 * j] = v[j] * rs * gg; } }
}

DEV void phase_rowwise(const Params& p, int l) {
    const int tid = otid(); const int lane = tid & 63, wid = tid >> 6; const int gw = blockIdx.x * 8 + wid, NGW = gridDim.x * 8;
    bf16_t* P = (bf16_t*)p.out; const f32x2* rope = (const f32x2*)(p.ws + OFF_ROPE);
    const float* qg = p.mla_q_norm_g + l * 384; const float* kg = p.mla_kv_norm_g + l * 256;
    for (int r = gw; r < R; r += NGW) {
        bf16_t* pr = P + (size_t)r * INW; const int b = r / RB, s = r - b * RB;
        { unsigned* q2 = (unsigned*)(pr + 768) + lane; unsigned w[3]; float ss = 0.f;
#pragma unroll
          for (int j = 0; j < 3; ++j) { w[j] = q2[64 * j]; const float a = bf2f(w[j] & 0xffff), c2 = bf2f(w[j] >> 16); ss += a * a + c2 * c2; }
          const float rs = rsqrtf(wave_sum(ss) * (1.f / 384.f) + EPS);
#pragma unroll
          for (int j = 0; j < 3; ++j) { const int c0 = 2 * (lane + 64 * j); q2[64 * j] = pk2(bf2f(w[j] & 0xffff) * rs * qg[c0], bf2f(w[j] >> 16) * rs * qg[c0 + 1]); } }
        { u32x2* k4 = (u32x2*)(pr + 1152) + lane; const u32x2 w = *k4;
          const float a0 = bf2f(w.x & 0xffff), a1 = bf2f(w.x >> 16), a2 = bf2f(w.y & 0xffff), a3 = bf2f(w.y >> 16);
          const float rs = rsqrtf(wave_sum((a0 * a0 + a1 * a1) + (a2 * a2 + a3 * a3)) * (1.f / 256.f) + EPS);
          const f32x4 gg = ((const f32x4*)kg)[lane]; u32x2 o; o.x = pk2(a0 * rs * gg.x, a1 * rs * gg.y); o.y = pk2(a2 * rs * gg.z, a3 * rs * gg.w); *k4 = o; }
        if (s >= NCTX && lane < 16) { const f32x2 cs = rope[(s - NCTX) * 16 + lane];
          const float x1 = bf2f(pr[1408 + lane]), x2 = bf2f(pr[1408 + 16 + lane]);
          pr[1408 + lane] = (bf16_t)f2bf(x1 * cs.x - x2 * cs.y); pr[1408 + 16 + lane] = (bf16_t)f2bf(x2 * cs.x + x1 * cs.y); }
    }
}

DEV void phase_pool(const Params& p) {
    const int tid = otid(); const bf16_t* P = (const bf16_t*)p.out; bf16_t* MIX = (bf16_t*)(p.ws + OFF_HN);
    for (int idx = blockIdx.x * NWG_T + tid; idx < R * 32; idx += gridDim.x * NWG_T) { const int r = idx >> 5, cg = idx & 31; const int half = 1 << (cg >> 3);
        const int b = r / RB, s = r - b * RB; const int seq0 = s < NCTX ? b * RB : b * RB + NCTX; const int T = s < NCTX ? NCTX : TL; const int t = r - seq0;
        const int lo = max(t - half, 0), hi = min(t + half, T); float sum[8];
#pragma unroll
        for (int j = 0; j < 8; ++j) sum[j] = 0.f;
        const bf16_t* base = P + (size_t)seq0 * INW + 1440 + cg * 8;
        for (int tt = lo; tt < hi; ++tt) { const bf16x8 v = *(const bf16x8*)(base + (size_t)tt * INW);
#pragma unroll
            for (int j = 0; j < 8; ++j) sum[j] += bf2f((unsigned short)v[j]); }
        const bf16x8 me = *(const bf16x8*)(base + (size_t)t * INW); const float ic = 1.0f / (float)(hi - lo); float o[8];
#pragma unroll
        for (int j = 0; j < 8; ++j) o[j] = sum[j] * ic - bf2f((unsigned short)me[j]);
        *(bf16x8*)(MIX + (size_t)r * 1024 + 768 + cg * 8) = pack8(o[0], o[1], o[2], o[3], o[4], o[5], o[6], o[7]); }
}

DEV float log2_sigmoid(float d) { return -log1pf(__expf(-d)) * 1.4426950408889634f; }
DEV void states_item(const Params& p, int l, unsigned char* lds, int it) {
    const int tid = otid(); const bf16_t* P = (const bf16_t*)p.out; const f32x2* rope = (const f32x2*)(p.ws + OFF_ROPE);
    float* SLOC = (float*)(p.ws + OFF_OV + OV_SLOC);
    const int gc = it >> 2, h = it & 3;
    bf16_t* kk = (bf16_t*)lds;
    bf16_t* vv = kk + 128 * 32;
    float* dec = (float*)(vv + 128 * 64);
    const int cb = gc % 66; const bool lat = cb >= 2; const int t0 = (cb - 2) * 128; const int r0 = gc * 128;
    if (tid < 256) { const int dir = tid >> 7, idx = tid & 127;
        const float lg = log2_sigmoid((dir == 0 ? p.ret_decay_f : p.ret_decay_b)[l * 4 + h]); dec[tid] = exp2f(lg * (dir == 0 ? (float)(127 - idx) : (float)idx)); }
    else { const int task = tid - 256; const int tok = task >> 1, c = task & 1;
        const bf16_t* src = P + (size_t)(r0 + tok) * INW + 128 + h * 32 + 8 * c; const bf16x8 lo = *(const bf16x8*)src, hi = *(const bf16x8*)(src + 16);
        float o1[8], o2[8];
#pragma unroll
        for (int j = 0; j < 8; ++j) { float x1 = bf2f((unsigned short)lo[j]), x2 = bf2f((unsigned short)hi[j]);
            if (lat) { const f32x2 cs = rope[(t0 + tok) * 16 + 8 * c + j]; const float y1 = x1 * cs.x - x2 * cs.y, y2 = x2 * cs.x + x1 * cs.y; x1 = y1; x2 = y2; }
            o1[j] = x1 * 0.17677669529663687f; o2[j] = x2 * 0.17677669529663687f; }
        bf16_t* dst = kk + tok * 32 + 8 * c;
        *(bf16x8*)dst = pack8(o1[0], o1[1], o1[2], o1[3], o1[4], o1[5], o1[6], o1[7]); *(bf16x8*)(dst + 16) = pack8(o2[0], o2[1], o2[2], o2[3], o2[4], o2[5], o2[6], o2[7]); }
    for (int task = tid; task < 1024; task += NWG_T) { const int tok = task >> 3, ch = task & 7; *(u32x4*)(vv + tok * 64 + ch * 8) = *(const u32x4*)(P + (size_t)(r0 + tok) * INW + 256 + h * 64 + ch * 8); }
    __syncthreads();
    { const int d = tid >> 4, dvg = tid & 15; float af[4], ab[4];
#pragma unroll
      for (int j = 0; j < 4; ++j) { af[j] = 0.f; ab[j] = 0.f; }
#pragma unroll 4
      for (int i = 0; i < 128; ++i) { const float kv = bf2f(kk[i * 32 + d]); const float kf = kv * dec[i], kb = kv * dec[128 + i];
          const u32x2 v = *(const u32x2*)(vv + i * 64 + dvg * 4);
          const float v0 = bf2f(v.x & 0xffff), v1 = bf2f(v.x >> 16), v2 = bf2f(v.y & 0xffff), v3 = bf2f(v.y >> 16);
          af[0] += kf * v0; af[1] += kf * v1; af[2] += kf * v2; af[3] += kf * v3; ab[0] += kb * v0; ab[1] += kb * v1; ab[2] += kb * v2; ab[3] += kb * v3; }
      float* of = SLOC + ((size_t)(gc * 4 + h) * 2 + 0) * 2048 + d * 64 + dvg * 4;
      *(f32x4*)of = (f32x4){af[0], af[1], af[2], af[3]}; *(f32x4*)(of + 2048) = (f32x4){ab[0], ab[1], ab[2], ab[3]}; }
    __syncthreads();
}
DEV void scan_threads(const Params& p, int l, int gid) {
    if (gid >= 32768) return;
    const int e = gid & 2047, dir = (gid >> 11) & 1, h = (gid >> 12) & 3, b = gid >> 14;
    const float* SLOC = (const float*)(p.ws + OFF_OV + OV_SLOC); float* SIN = (float*)(p.ws + OFF_OV + OV_SIN);
    const float gC = exp2f(log2_sigmoid((dir == 0 ? p.ret_decay_f : p.ret_decay_b)[l * 4 + h]) * 128.f);
    float S = 0.f;
#pragma unroll 6
    for (int st = 0; st < 66; ++st) { const int cb = dir == 0 ? st : (st < 2 ? 1 - st : 67 - st); const size_t idx = ((size_t)((b * 66 + cb) * 4 + h) * 2 + dir) * 2048 + e;
        const float v = SLOC[idx]; SIN[idx] = S; S = S * gC + v; }
}

constexpr int AT_KP = 208, AT_VP = 136, AT_KB = 64 * AT_KP, AT_VBS = 64 * AT_VP, AT_V0 = 2 * AT_KB;
DEV float at_max32(const f32x16& s0, const f32x16& s1) {
    float m0 = __builtin_fmaxf(__builtin_fmaxf(s0[0], s0[1]), s0[2]), m1 = __builtin_fmaxf(__builtin_fmaxf(s1[0], s1[1]), s1[2]);
    m0 = __builtin_fmaxf(__builtin_fmaxf(m0, s0[3]), s0[4]); m1 = __builtin_fmaxf(__builtin_fmaxf(m1, s1[3]), s1[4]);
    m0 = __builtin_fmaxf(__builtin_fmaxf(m0, s0[5]), s0[6]); m1 = __builtin_fmaxf(__builtin_fmaxf(m1, s1[5]), s1[6]);
    m0 = __builtin_fmaxf(__builtin_fmaxf(m0, s0[7]), s0[8]); m1 = __builtin_fmaxf(__builtin_fmaxf(m1, s1[7]), s1[8]);
    m0 = __builtin_fmaxf(__builtin_fmaxf(m0, s0[9]), s0[10]); m1 = __builtin_fmaxf(__builtin_fmaxf(m1, s1[9]), s1[10]);
    m0 = __builtin_fmaxf(__builtin_fmaxf(m0, s0[11]), s0[12]); m1 = __builtin_fmaxf(__builtin_fmaxf(m1, s1[11]), s1[12]);
    m0 = __builtin_fmaxf(__builtin_fmaxf(m0, s0[13]), s0[14]); m1 = __builtin_fmaxf(__builtin_fmaxf(m1, s1[13]), s1[14]);
    return __builtin_fmaxf(__builtin_fmaxf(m0, s0[15]), __builtin_fmaxf(m1, s1[15]));
}
DEV void attn_unit(const Params& p, unsigned char* lds, int u) {
    const int tid = otid(), lane = tid & 63, wid = tid >> 6, l32 = lane & 31, hi = lane >> 5;
    const bf16_t* Q = (const bf16_t*)(p.ws + OFF_OV + OV_Q); const bf16_t* KN = (const bf16_t*)(p.ws + OFF_OV + OV_KN); const bf16_t* VT = (const bf16_t*)(p.ws + OFF_OV + OV_VT);
    const bf16_t* P = (const bf16_t*)p.out; bf16_t* MIX = (bf16_t*)(p.ws + OFF_HN); const f32x2* rope = (const f32x2*)(p.ws + OFF_ROPE);
    const bool isctx = u >= 512; int b, h, qrow0, NT;
    if (!isctx) { b = u >> 8; h = (u >> 5) & 7; qrow0 = b * RB + NCTX + (u & 31) * 256; NT = 132; } else { const int v = u - 512; b = v >> 3; h = v & 7; qrow0 = b * RB; NT = 4; }
    const int krow0 = b * RB; const int qrow = qrow0 + wid * 32 + l32;
    bf16x8 qf[6];
    { const bf16_t* qp = Q + (size_t)qrow * 768 + h * 96 + hi * 8;
#pragma unroll
      for (int d0 = 0; d0 < 6; ++d0) qf[d0] = *(const bf16x8*)(qp + d0 * 16);
      if (!isctx) { const f32x2* rp = rope + (size_t)(qrow - (b * RB + NCTX)) * 16 + hi * 8;
#pragma unroll
          for (int j = 0; j < 8; ++j) { const f32x2 cs = rp[j]; const float x1 = bf2f((unsigned short)qf[4][j]), x2 = bf2f((unsigned short)qf[5][j]);
              qf[4][j] = (short)f2bf(x1 * cs.x - x2 * cs.y); qf[5][j] = (short)f2bf(x2 * cs.x + x1 * cs.y); } } }
    const bf16_t* sp[3]; int sstep[3], lo[3];
#pragma unroll
    for (int k = 0; k < 2; ++k) { const int c = tid + k * 512; const int key = c / 12, part = c - key * 12; lo[k] = key * AT_KP + part * 16;
        if (part < 8) { sp[k] = KN + (size_t)(krow0 + key) * 512 + h * 64 + part * 8; sstep[k] = 64 * 512; } else { sp[k] = P + (size_t)(krow0 + key) * INW + 1408 + (part - 8) * 8; sstep[k] = 64 * INW; } }
    { const int dv = tid >> 3, kc = tid & 7; lo[2] = dv * AT_VP + kc * 16; sp[2] = VT + (size_t)(h * 64 + dv) * R + krow0 + kc * 8; sstep[2] = 64; }
    const bool hasK2 = tid < 256;
    u32x4 st[3];
#define AT_GLOADK() do { st[0] = *(const u32x4*)sp[0]; sp[0] += sstep[0]; if (hasK2) { st[1] = *(const u32x4*)sp[1]; sp[1] += sstep[1]; } } while (0)
#define AT_GLOADV() do { st[2] = *(const u32x4*)sp[2]; sp[2] += sstep[2]; } while (0)
#define AT_LSTOREK(buf) do { *(u32x4*)((buf) + lo[0]) = st[0]; if (hasK2) *(u32x4*)((buf) + lo[1]) = st[1]; } while (0)
#define AT_LSTOREV(buf) do { unsigned char* d_ = (buf) + lo[2]; *(u32x2*)d_ = (u32x2){st[2].x, st[2].y}; *(u32x2*)(d_ + 8) = (u32x2){st[2].z, st[2].w}; } while (0)
#define AT_SB() __builtin_amdgcn_sched_barrier(0)
    f32x16 o0, o1, sa0, sa1, sb0, sb1;
#pragma unroll
    for (int r = 0; r < 16; ++r) { o0[r] = 0.f; o1[r] = 0.f; sa0[r] = 0.f; sa1[r] = 0.f; }
    float mrun = 0.f, lsum = 0.f;
    __syncthreads();
    AT_GLOADK(); AT_GLOADV(); AT_LSTOREK(lds); AT_LSTOREV(lds + AT_V0);
    AT_GLOADK(); AT_LSTOREK(lds + AT_KB);
    __syncthreads();
    { const unsigned char* ka = lds + l32 * AT_KP + hi * 16;
#pragma unroll
      for (int d0 = 0; d0 < 6; ++d0) { const bf16x8 a0 = *(const bf16x8*)(ka + d0 * 32), a1 = *(const bf16x8*)(ka + 32 * AT_KP + d0 * 32);
          sa0 = __builtin_amdgcn_mfma_f32_32x32x16_bf16(a0, qf[d0], sa0, 0, 0, 0); sa1 = __builtin_amdgcn_mfma_f32_32x32x16_bf16(a1, qf[d0], sa1, 0, 0, 0); } }
#define AT_STEP(SA0, SA1, SB0, SB1, tt) do { \
        const int t_ = (tt); const bool nxt_ = t_ + 1 < NT; \
        const unsigned char* kb_ = lds + ((t_ + 1) & 1) * AT_KB; const unsigned char* vb_ = lds + AT_V0 + (t_ & 1) * AT_VBS; \
        if (t_ + 2 < NT) AT_GLOADK(); \
        if (nxt_) AT_GLOADV(); \
        bf16x8 kfr[12]; u32x2 vfr[16]; \
        { const unsigned char* ka = kb_ + l32 * AT_KP + hi * 16; \
          _Pragma("unroll") for (int d0 = 0; d0 < 6; ++d0) { kfr[2 * d0] = *(const bf16x8*)(ka + d0 * 32); kfr[2 * d0 + 1] = *(const bf16x8*)(ka + 32 * AT_KP + d0 * 32); } } \
        { const float mx = at_max32(SA0, SA1); \
          if (t_ == 0 || __any(mx > 8.0f)) { \
              const float rm = fmaxf(mx, __shfl_xor(mx, 32)); const float delta = (t_ == 0) ? rm : fmaxf(rm, 0.f); const float alpha = (t_ == 0) ? 1.0f : __builtin_amdgcn_exp2f(-delta); \
              mrun += delta; \
              _Pragma("unroll") for (int r = 0; r < 16; ++r) { SA0[r] -= delta; SA1[r] -= delta; o0[r] *= alpha; o1[r] *= alpha; } \
              lsum *= alpha; } } \
        { const float nm = -mrun; _Pragma("unroll") for (int r = 0; r < 16; ++r) { SB0[r] = nm; SB1[r] = nm; } } \
        float ls0 = 0.f, ls1 = 0.f; \
        AT_SB(); \
        _Pragma("unroll") for (int i = 0; i < 8; ++i) { \
            if (i & 1) SB1 = __builtin_amdgcn_mfma_f32_32x32x16_bf16(kfr[i], qf[i >> 1], SB1, 0, 0, 0); else SB0 = __builtin_amdgcn_mfma_f32_32x32x16_bf16(kfr[i], qf[i >> 1], SB0, 0, 0, 0); \
            SA0[2 * i] = __builtin_amdgcn_exp2f(SA0[2 * i]); SA0[2 * i + 1] = __builtin_amdgcn_exp2f(SA0[2 * i + 1]); SA1[2 * i] = __builtin_amdgcn_exp2f(SA1[2 * i]); SA1[2 * i + 1] = __builtin_amdgcn_exp2f(SA1[2 * i + 1]); \
            ls0 += SA0[2 * i] + SA0[2 * i + 1]; ls1 += SA1[2 * i] + SA1[2 * i + 1]; \
            AT_SB(); } \
        { const unsigned char* va = vb_ + l32 * AT_VP + hi * 8; \
          _Pragma("unroll") for (int kj = 0; kj < 4; ++kj) { const unsigned char* vp = va + kj * 32; \
              vfr[4 * kj + 0] = *(const u32x2*)vp; vfr[4 * kj + 1] = *(const u32x2*)(vp + 16); vfr[4 * kj + 2] = *(const u32x2*)(vp + 32 * AT_VP); vfr[4 * kj + 3] = *(const u32x2*)(vp + 32 * AT_VP + 16); } } \
        bf16x8 pb[4]; \
        _Pragma("unroll") for (int i = 8; i < 12; ++i) { const int kj = i - 8; const int jp = kj & 1; \
            if (i & 1) SB1 = __builtin_amdgcn_mfma_f32_32x32x16_bf16(kfr[i], qf[i >> 1], SB1, 0, 0, 0); else SB0 = __builtin_amdgcn_mfma_f32_32x32x16_bf16(kfr[i], qf[i >> 1], SB0, 0, 0, 0); \
            if (kj < 2) pb[kj] = pack8(SA0[8 * jp + 0], SA0[8 * jp + 1], SA0[8 * jp + 2], SA0[8 * jp + 3], SA0[8 * jp + 4], SA0[8 * jp + 5], SA0[8 * jp + 6], SA0[8 * jp + 7]); \
            else        pb[kj] = pack8(SA1[8 * jp + 0], SA1[8 * jp + 1], SA1[8 * jp + 2], SA1[8 * jp + 3], SA1[8 * jp + 4], SA1[8 * jp + 5], SA1[8 * jp + 6], SA1[8 * jp + 7]); \
            AT_SB(); } \
        lsum += ls0 + ls1; \
        _Pragma("unroll") for (int kj = 0; kj < 4; ++kj) { \
            const bf16x8 A0 = __builtin_bit_cast(bf16x8, (u32x4){vfr[4 * kj].x, vfr[4 * kj].y, vfr[4 * kj + 1].x, vfr[4 * kj + 1].y}); \
            const bf16x8 A1 = __builtin_bit_cast(bf16x8, (u32x4){vfr[4 * kj + 2].x, vfr[4 * kj + 2].y, vfr[4 * kj + 3].x, vfr[4 * kj + 3].y}); \
            o0 = __builtin_amdgcn_mfma_f32_32x32x16_bf16(A0, pb[kj], o0, 0, 0, 0); o1 = __builtin_amdgcn_mfma_f32_32x32x16_bf16(A1, pb[kj], o1, 0, 0, 0); } \
        if (t_ + 2 < NT) AT_LSTOREK(lds + (t_ & 1) * AT_KB); \
        if (nxt_) AT_LSTOREV(lds + AT_V0 + ((t_ + 1) & 1) * AT_VBS); \
        __syncthreads(); \
    } while (0)
    for (int t = 0; t < NT; t += 2) { AT_STEP(sa0, sa1, sb0, sb1, t); AT_STEP(sb0, sb1, sa0, sa1, t + 1); }
    lsum += __shfl_xor(lsum, 32);
    const float inv = 1.0f / lsum;
    bf16_t* op = MIX + (size_t)qrow * 1024 + 256 + h * 64 + 4 * hi;
#pragma unroll
    for (int g4 = 0; g4 < 4; ++g4) { u32x2 w0, w1; w0.x = pk2(o0[4 * g4] * inv, o0[4 * g4 + 1] * inv); w0.y = pk2(o0[4 * g4 + 2] * inv, o0[4 * g4 + 3] * inv);
        w1.x = pk2(o1[4 * g4] * inv, o1[4 * g4 + 1] * inv); w1.y = pk2(o1[4 * g4 + 2] * inv, o1[4 * g4 + 3] * inv);
        *(u32x2*)(op + 8 * g4) = w0; *(u32x2*)(op + 32 + 8 * g4) = w1; }
#undef AT_GLOADK
#undef AT_GLOADV
#undef AT_LSTOREK
#undef AT_LSTOREV
#undef AT_STEP
#undef AT_SB
}

constexpr int RT_VP = 264, RT_SP = 144, RT_VB = 2 * 64 * RT_VP;
DEV void retout_unit(const Params& p, int l, unsigned char* lds, int u) {
    const int tid = otid(), lane = tid & 63, wid = tid >> 6, l32 = lane & 31, hi = lane >> 5;
    const int gc = u >> 1, hp = u & 1; const int cb = gc % 66; const bool lat = cb >= 2; const int t0 = (cb - 2) * 128; const int r0 = gc * 128;
    const bf16_t* P = (const bf16_t*)p.out; bf16_t* MIX = (bf16_t*)(p.ws + OFF_HN); const f32x2* rope = (const f32x2*)(p.ws + OFF_ROPE);
    const float* SIN = (const float*)(p.ws + OFF_OV + OV_SIN);
    bf16_t* VTl = (bf16_t*)lds; bf16_t* STl = (bf16_t*)(lds + RT_VB);
    __syncthreads();
    for (int task = tid; task < 2048; task += NWG_T) { const int hh = task >> 10, key = (task >> 3) & 127, ch = task & 7;
        const bf16x8 v = *(const bf16x8*)(P + (size_t)(r0 + key) * INW + 256 + (2 * hp + hh) * 64 + ch * 8);
#pragma unroll
        for (int j = 0; j < 8; ++j) VTl[(hh * 64 + ch * 8 + j) * (RT_VP / 2) + key] = (bf16_t)v[j]; }
    for (int task = tid; task < 8192; task += NWG_T) { const int dv = task & 63, k = (task >> 6) & 31, dir = (task >> 11) & 1, hh = task >> 12;
        STl[(hh * 64 + dv) * (RT_SP / 2) + dir * 32 + k] = (bf16_t)f2bf(SIN[((size_t)(gc * 4 + 2 * hp + hh) * 2 + dir) * 2048 + k * 64 + dv]); }
    __syncthreads();
    const int hh = wid >> 2, h = 2 * hp + hh, qblk = wid & 3; const int n = 32 * qblk + l32; const int rq = r0 + n;
    const float lf = log2_sigmoid(p.ret_decay_f[l * 4 + h]), lb = log2_sigmoid(p.ret_decay_b[l * 4 + h]);
    float qv0[8], qv1[8]; bf16x8 qf0, qf1;
    { const bf16_t* qp = P + (size_t)rq * INW + h * 32 + 8 * hi; const bf16x8 a = *(const bf16x8*)qp, c2 = *(const bf16x8*)(qp + 16);
#pragma unroll
      for (int j = 0; j < 8; ++j) { float x1 = bf2f((unsigned short)a[j]), x2 = bf2f((unsigned short)c2[j]);
          if (lat) { const f32x2 cs = rope[(size_t)(t0 + n) * 16 + 8 * hi + j]; const float y1 = x1 * cs.x - x2 * cs.y, y2 = x2 * cs.x + x1 * cs.y; x1 = y1; x2 = y2; }
          qv0[j] = x1; qv1[j] = x2; }
      qf0 = pack8(qv0[0], qv0[1], qv0[2], qv0[3], qv0[4], qv0[5], qv0[6], qv0[7]); qf1 = pack8(qv1[0], qv1[1], qv1[2], qv1[3], qv1[4], qv1[5], qv1[6], qv1[7]); }
    f32x16 o0, o1;
#pragma unroll
    for (int r = 0; r < 16; ++r) { o0[r] = 0.f; o1[r] = 0.f; }
    const unsigned char* vbase = (const unsigned char*)VTl + (size_t)(hh * 64 + l32) * RT_VP + hi * 8;
#pragma unroll
    for (int kb = 0; kb < 4; ++kb) {
        bf16x8 kf0, kf1;
        { const int key = 32 * kb + l32; const bf16_t* kp = P + (size_t)(r0 + key) * INW + 128 + h * 32 + 8 * hi; const bf16x8 a = *(const bf16x8*)kp, c2 = *(const bf16x8*)(kp + 16);
          float y1[8], y2[8];
#pragma unroll
          for (int j = 0; j < 8; ++j) { float x1 = bf2f((unsigned short)a[j]), x2 = bf2f((unsigned short)c2[j]);
              if (lat) { const f32x2 cs = rope[(size_t)(t0 + key) * 16 + 8 * hi + j]; const float z1 = x1 * cs.x - x2 * cs.y, z2 = x2 * cs.x + x1 * cs.y; x1 = z1; x2 = z2; }
              y1[j] = x1 * 0.17677669529663687f; y2[j] = x2 * 0.17677669529663687f; }
          kf0 = pack8(y1[0], y1[1], y1[2], y1[3], y1[4], y1[5], y1[6], y1[7]); kf1 = pack8(y2[0], y2[1], y2[2], y2[3], y2[4], y2[5], y2[6], y2[7]); }
        f32x16 s;
#pragma unroll
        for (int r = 0; r < 16; ++r) s[r] = 0.f;
        s = __builtin_amdgcn_mfma_f32_32x32x16_bf16(kf0, qf0, s, 0, 0, 0); s = __builtin_amdgcn_mfma_f32_32x32x16_bf16(kf1, qf1, s, 0, 0, 0);
#pragma unroll
        for (int r = 0; r < 16; ++r) { const int m = 32 * kb + crow(r, hi); const int dl = n - m; const float e = dl >= 0 ? lf * (float)dl : lb * (float)(-dl); s[r] *= __builtin_amdgcn_exp2f(e); }
#pragma unroll
        for (int jp = 0; jp < 2; ++jp) { const bf16x8 pb = pack8(s[8 * jp + 0], s[8 * jp + 1], s[8 * jp + 2], s[8 * jp + 3], s[8 * jp + 4], s[8 * jp + 5], s[8 * jp + 6], s[8 * jp + 7]);
            const unsigned char* vp = vbase + (32 * kb + 16 * jp) * 2;
            const u32x2 a00 = *(const u32x2*)vp, a01 = *(const u32x2*)(vp + 16), a10 = *(const u32x2*)(vp + 32 * RT_VP), a11 = *(const u32x2*)(vp + 32 * RT_VP + 16);
            const bf16x8 A0 = __builtin_bit_cast(bf16x8, (u32x4){a00.x, a00.y, a01.x, a01.y}), A1 = __builtin_bit_cast(bf16x8, (u32x4){a10.x, a10.y, a11.x, a11.y});
            o0 = __builtin_amdgcn_mfma_f32_32x32x16_bf16(A0, pb, o0, 0, 0, 0); o1 = __builtin_amdgcn_mfma_f32_32x32x16_bf16(A1, pb, o1, 0, 0, 0); }
    }
    { const float df = __builtin_amdgcn_exp2f(lf * (float)(n + 1)), db = __builtin_amdgcn_exp2f(lb * (float)(128 - n));
      const unsigned char* sbase = (const unsigned char*)STl + (size_t)(hh * 64 + l32) * RT_SP + hi * 16;
#pragma unroll
      for (int ks = 0; ks < 4; ++ks) { const float dd = ks < 2 ? df : db;
          const bf16x8 qb = (ks & 1) ? pack8(qv1[0] * dd, qv1[1] * dd, qv1[2] * dd, qv1[3] * dd, qv1[4] * dd, qv1[5] * dd, qv1[6] * dd, qv1[7] * dd)
                                     : pack8(qv0[0] * dd, qv0[1] * dd, qv0[2] * dd, qv0[3] * dd, qv0[4] * dd, qv0[5] * dd, qv0[6] * dd, qv0[7] * dd);
          const bf16x8 A0 = *(const bf16x8*)(sbase + ks * 32), A1 = *(const bf16x8*)(sbase + 32 * RT_SP + ks * 32);
          o0 = __builtin_amdgcn_mfma_f32_32x32x16_bf16(A0, qb, o0, 0, 0, 0); o1 = __builtin_amdgcn_mfma_f32_32x32x16_bf16(A1, qb, o1, 0, 0, 0); } }
    float ssq = 0.f;
#pragma unroll
    for (int r = 0; r < 16; ++r) ssq += o0[r] * o0[r] + o1[r] * o1[r];
    ssq += __shfl_xor(ssq, 32);
    const float rstd = rsqrtf(ssq * (1.f / 64.f) + EPS);
    const bf16_t* gp = P + (size_t)rq * INW + 512 + h * 64 + 4 * hi; bf16_t* op = MIX + (size_t)rq * 1024 + h * 64 + 4 * hi;
#pragma unroll
    for (int g4 = 0; g4 < 4; ++g4) { const u32x2 ga = *(const u32x2*)(gp + 8 * g4), gb = *(const u32x2*)(gp + 32 + 8 * g4);
        u32x2 w0, w1;
        w0.x = pk2(o0[4 * g4] * rstd * siluf(bf2f(ga.x & 0xffff)), o0[4 * g4 + 1] * rstd * siluf(bf2f(ga.x >> 16))); w0.y = pk2(o0[4 * g4 + 2] * rstd * siluf(bf2f(ga.y & 0xffff)), o0[4 * g4 + 3] * rstd * siluf(bf2f(ga.y >> 16)));
        w1.x = pk2(o1[4 * g4] * rstd * siluf(bf2f(gb.x & 0xffff)), o1[4 * g4 + 1] * rstd * siluf(bf2f(gb.x >> 16))); w1.y = pk2(o1[4 * g4 + 2] * rstd * siluf(bf2f(gb.y & 0xffff)), o1[4 * g4 + 3] * rstd * siluf(bf2f(gb.y >> 16)));
        *(u32x2*)(op + 8 * g4) = w0; *(u32x2*)(op + 32 + 8 * g4) = w1; }
}

DEV void phase_ffn_fixup(const Params& p, int l) {
    const float* EDGE = (const float*)(p.ws + OFF_EDGE); bf16_t* ACT = (bf16_t*)(p.ws + OFF_OV);
    const float* cw = p.conv_w + (size_t)l * 3 * 5632; const float* cbv = p.conv_b + (size_t)l * 5632;
    for (int idx = blockIdx.x * NWG_T + otid(); idx < 66 * 2 * 704; idx += gridDim.x * NWG_T) {
        const int ch4 = idx % 704, rest = idx / 704; const int which = rest & 1, pm = rest >> 1; const int jj = pm % 33;
        if (l == 1 && jj == 0) continue;
        const int ch = 4 * ch4, pn = ch >> 7, c = ch & 127;
        const bool sstart = jj <= 1, send = (jj == 0) || (jj == 32);
        const f32x4 zz = {0.f, 0.f, 0.f, 0.f};
#define EDG(tile, k, half) (*(const f32x4*)(EDGE + ((size_t)((tile) * 4 + (k)) * 22 + pn) * 256 + (half) * 128 + c))
        f32x4 ua, ub, ca, cb2, da, db;
        if (which == 0) { ua = sstart ? zz : EDG(pm - 1, 3, 0); ub = sstart ? zz : EDG(pm - 1, 3, 1); ca = EDG(pm, 0, 0); cb2 = EDG(pm, 0, 1); da = EDG(pm, 1, 0); db = EDG(pm, 1, 1); }
        else { ua = EDG(pm, 2, 0); ub = EDG(pm, 2, 1); ca = EDG(pm, 3, 0); cb2 = EDG(pm, 3, 1); da = send ? zz : EDG(pm + 1, 0, 0); db = send ? zz : EDG(pm + 1, 0, 1); }
#undef EDG
        const f32x4 wa0 = *(const f32x4*)(cw + ch), wa1 = *(const f32x4*)(cw + 5632 + ch), wa2 = *(const f32x4*)(cw + 2 * 5632 + ch), ba = *(const f32x4*)(cbv + ch);
        const f32x4 wb0 = *(const f32x4*)(cw + DFF + ch), wb1 = *(const f32x4*)(cw + 5632 + DFF + ch), wb2 = *(const f32x4*)(cw + 2 * 5632 + DFF + ch), bb = *(const f32x4*)(cbv + DFF + ch);
        const f32x4 xa = wa0 * ua + wa1 * ca + wa2 * da + ba, xb = wb0 * ub + wb1 * cb2 + wb2 * db + bb;
        u32x2 w; w.x = pk2(siluf(xa.x) * xb.x, siluf(xa.y) * xb.y); w.y = pk2(siluf(xa.z) * xb.z, siluf(xa.w) * xb.w);
        *(u32x2*)(ACT + (size_t)(pm * 256 + (which ? 255 : 0)) * DFF + ch) = w;
    }
}

#define RLX_AGENT __ATOMIC_RELAXED, __HIP_MEMORY_SCOPE_AGENT
#define XB_TMO      128
#define XB_XCNT(j)  (256  + 64 * (j))
#define XB_XSUB(j)  (1280 + 64 * (j))
#define XB_XGEN(j)  (2304 + 64 * (j))
#define XB_TOP      3328
#define XB_TOPGEN   3392
#define XCD_BAR_WORDS 3456
#define XB_SPIN_CAP (1u << 18)

__device__ __forceinline__ unsigned xb_ld(unsigned* p)              { return __hip_atomic_load(p, __ATOMIC_RELAXED, __HIP_MEMORY_SCOPE_AGENT); }
__device__ __forceinline__ unsigned xb_add(unsigned* p, unsigned v) { return __hip_atomic_fetch_add(p, v, __ATOMIC_RELAXED, __HIP_MEMORY_SCOPE_AGENT); }
__device__ __forceinline__ unsigned xb_xcc_id() { return (unsigned)__builtin_amdgcn_s_getreg((3 << 11) | 20) & 0xFu; }
#define XB_SPIN(cond, bar) do { unsigned _sp = 0; while (cond) { __builtin_amdgcn_s_sleep(1); \
    if ((++_sp & 255u) == 0u) { if (xb_ld(&(bar)[XB_TMO])) break; if (_sp > XB_SPIN_CAP) { atomicAdd(&(bar)[XB_TMO], 1u); break; } } } } while (0)

struct XcdBarrier {
    unsigned* bar; unsigned x;
    volatile LAS unsigned* st;
};

__device__ __forceinline__ XcdBarrier xcd_barrier_post(unsigned* bar, volatile LAS unsigned* st) {
    XcdBarrier b; b.bar = bar; b.x = xb_xcc_id(); b.st = st;
    if (threadIdx.x == 0) (void)xb_add(&bar[XB_XCNT(b.x)], 1u);
    return b;
}
__device__ __forceinline__ void xcd_barrier_complete(unsigned* bar, unsigned x, unsigned& nloc, unsigned& nx) {
    const unsigned G = gridDim.x * gridDim.y * gridDim.z;
    unsigned sum, cnt, mine, sp = 0u;
    for (;;) {
        sum = 0u; cnt = 0u; mine = 0u;
#pragma unroll
        for (unsigned j = 0; j < 16; ++j) { const unsigned c = xb_ld(&bar[XB_XCNT(j)]); sum += c; cnt += (c > 0u) ? 1u : 0u; mine = (j == x) ? c : mine; }
        if (sum == G) break;
        __builtin_amdgcn_s_sleep(1);
        if ((++sp & 255u) == 0u) { if (xb_ld(&bar[XB_TMO])) break; if (sp > XB_SPIN_CAP) { atomicAdd(&bar[XB_TMO], 1u); break; } }
    }
    nloc = mine > 0u ? mine : 1u; nx = cnt > 0u ? cnt : 1u;
}

__device__ __forceinline__ void xcd_barrier(const XcdBarrier& b) {
    asm volatile("s_waitcnt vmcnt(0)" ::: "memory");
    __syncthreads();
    if (threadIdx.x == 0) {
        unsigned* bar = b.bar;
        __builtin_amdgcn_s_waitcnt(0);
        unsigned nloc = b.st[0], nx = b.st[1];
        if (nloc == 0u) { xcd_barrier_complete(bar, b.x, nloc, nx); b.st[0] = nloc; b.st[1] = nx; }
        const unsigned old = xb_add(&bar[XB_XSUB(b.x)], 1u);
        const unsigned gen = old / nloc;
        if (old + 1u == (gen + 1u) * nloc) {
            __builtin_amdgcn_fence(__ATOMIC_RELEASE, "agent");
            asm volatile("s_waitcnt vmcnt(0)" ::: "memory");
            const unsigned og = xb_add(&bar[XB_TOP], 1u);
            const unsigned tg = og / nx;
            if (og + 1u == (tg + 1u) * nx) xb_add(&bar[XB_TOPGEN], 1u);
            else XB_SPIN(xb_ld(&bar[XB_TOPGEN]) == tg, bar);
            __builtin_amdgcn_fence(__ATOMIC_ACQUIRE, "agent");
            xb_add(&bar[XB_XGEN(b.x)], 1u);
            asm volatile("s_waitcnt vmcnt(0)" ::: "memory");
        } else {
            XB_SPIN(xb_ld(&bar[XB_XGEN(b.x)]) == gen, bar);
            __builtin_amdgcn_fence(__ATOMIC_ACQUIRE, "agent");
            asm volatile("s_waitcnt vmcnt(0)" ::: "memory");
        }
    }
    __syncthreads();
}


constexpr size_t OFF_CTL = 250000128; constexpr int CTL_BYTES = 16384;
#if defined(__HIP_DEVICE_COMPILE__)
#define KP() const __attribute__((address_space(4))) Params* kp_ = (const __attribute__((address_space(4))) Params*)__builtin_amdgcn_kernarg_segment_ptr(); asm volatile("" : "+s"(kp_)); const Params p = *kp_; \
    bf16_t* HN = (bf16_t*)(p.ws + OFF_HN); bf16_t* P = (bf16_t*)p.out; float* X = (float*)(p.ws + OFF_X); (void)HN; (void)P; (void)X
#else
#define KP() const Params p = p_arg; bf16_t* HN = (bf16_t*)(p.ws + OFF_HN); bf16_t* P = (bf16_t*)p.out; float* X = (float*)(p.ws + OFF_X); (void)HN; (void)P; (void)X
#endif
#define WL() const bf16_t* wl = (const bf16_t*)(p.ws + OFF_W) + (size_t)l * W_LAYER; const float* modv = (const float*)(p.ws + OFF_MOD) + (size_t)l * 3 * 6144; (void)wl; (void)modv
#ifndef DUPM
#define DUPM 0
#endif
#define REP(bit) for (int rep_ = 0; rep_ < (((DUPM) >> (bit)) & 1) + 1; ++rep_)
constexpr int PH_PER_LAYER = 10, N_PHASES = 2 + 2 * PH_PER_LAYER;
__global__ void __launch_bounds__(512, 2) mk_fwd(Params p_arg) {
    extern __shared__ __attribute__((aligned(16))) unsigned char lds[];
    cg::grid_group grid = cg::this_grid();
    const int G = gridDim.x, bx = blockIdx.x; const int vcu = (G % 8 == 0) ? (bx % 8) * (G / 8) + bx / 8 : bx;
    LAS unsigned char* ldsl = (LAS unsigned char*)lds;
    const int ph_lo = p_arg.ph_lo, ph_hi = p_arg.ph_hi;
    volatile LAS unsigned* misc = (volatile LAS unsigned*)(ldsl + (LDS_BYTES - 64));
    { const int t0_ = otid(); if (t0_ < 16) misc[t0_] = 0u; }
    __syncthreads();
    if (ph_hi - ph_lo > 1) (void)xcd_barrier_post((unsigned*)(p_arg.ws + OFF_CTL), misc);
    for (int ph = ph_lo; ph < ph_hi; ++ph) {
        if (ph == 0) { KP(); REP(9) { phase_prep(p, lds); __syncthreads(); } }
        else if (ph == N_PHASES - 1) { KP(); phase_final(p);
#if (DUPM >> 10) & 1
            for (int i = 0; i < 20; ++i) grid.sync();
#endif
        }
        else {
            const int l = (ph - 1) / PH_PER_LAYER, sp = (ph - 1) % PH_PER_LAYER;
            if (sp == 0) { KP(); phase_norm(p, l, 0, l == 0, l == 1 ? (const float*)(p.ws + OFF_MOD) + 2 * 6144 + 5120 : nullptr); }
            else if (sp == 1) { KP(); WL(); REP(1) { __syncthreads();
                pg8::Gemm g{HN, wl + W_IN, R, 1792, 1024, 1024, 1024}; pg8::StaticOrder S; S.init(R, 1792, G, bx);
                pg8::EpiStore E{P, INW, INW, 1.0f};
                pg8::gemm_phase<pg8::EpiStore, pg8::StaticOrder, true, true>(ldsl, g, S, E); } }
            else if (sp == 2) { KP(); phase_rowwise(p, l); __syncthreads();
                REP(2) phase_pool(p);
                REP(3) for (int it = bx; it < 528; it += G) states_item(p, l, lds, it); }
            else if (sp == 3) { KP(); WL(); REP(4) { __syncthreads();
                { pg8::Gemm g{P + 768, wl + W_UQ, R, 768, 384, INW, 384}; pg8::StaticOrder S; S.init(R, 768, G, bx);
                  pg8::EpiStore E{(bf16_t*)(p.ws + OFF_OV + OV_Q), 768, 768, 0.14724444f};
                  pg8::gemm_phase<pg8::EpiStore, pg8::StaticOrder, true, true>(ldsl, g, S, E); }
                __syncthreads();
                { pg8::Gemm g{P + 1152, wl + W_KN, R, 512, 256, INW, 256}; pg8::StaticOrder S; S.init(R, 512, G, (bx + 58) % G);
                  pg8::EpiStore E{(bf16_t*)(p.ws + OFF_OV + OV_KN), 512, 512, 1.0f};
                  pg8::gemm_phase<pg8::EpiStore, pg8::StaticOrder, true, true>(ldsl, g, S, E); }
                __syncthreads();
                { pg8::Gemm g{wl + W_V, P + 1152, 512, R, 256, 256, INW}; pg8::StaticOrder S; S.init(512, R, G, (bx + 182) % G);
                  pg8::EpiStore E{(bf16_t*)(p.ws + OFF_OV + OV_VT), R, R, 1.0f};
                  pg8::gemm_phase<pg8::EpiStore, pg8::StaticOrder, true, true>(ldsl, g, S, E); }
                if (bx >= G - 64) scan_threads(p, l, (bx - (G - 64)) * NWG_T + otid()); } }
            else if (sp == 4) { KP();
                REP(5) for (int u = vcu; u < (l == 0 ? 528 : 512); u += G) attn_unit(p, lds, u);
                REP(6) for (int u = G - 1 - bx; u < (l == 0 ? 264 : 256); u += G) retout_unit(p, l, lds, l == 0 ? u : u + 4 * (u >> 7) + 4); }
            else if (sp == 5) { KP(); WL(); __syncthreads();
                { pg8::Gemm g{HN, wl + W_OUT, R, 1024, 1024, 1024, 1024}; pg8::StaticOrder S; S.init(16384, 1024, G, bx, 1);
                  pg8::EpiResid E{X, modv + 2048, 0};
                  pg8::gemm_phase<pg8::EpiResid, pg8::StaticOrder, true, true>(ldsl, g, S, E); }
                if (l == 0 && bx < 32) { __syncthreads(); const int q = bx >> 3;
                  pg8::Gemm g{HN + q * 256, wl + W_OUT + q * 256, 512, 1024, 256, 1024, 1024}; pg8::StaticOrder S; S.init(512, 1024, G, bx & 7, 2);
                  pg8::EpiPart E{(float*)(p.ws + OFF_PART) + (size_t)q * 524288, 0};
                  pg8::gemm_phase<pg8::EpiPart, pg8::StaticOrder, true, true>(ldsl, g, S, E); } }
            else if (sp == 6) { KP(); WL(); phase_norm(p, l, 1, false, l == 0 ? modv + 2 * 6144 + 2048 : nullptr); }
            else if (sp == 7) { KP(); WL(); REP(7) { __syncthreads();
                pg8::Gemm g{HN, wl + W_UP, R, 2 * DFF, 1024, 1024, 1024}; pg8::StaticOrder S; S.init(l == 1 ? 16384 : R, 2 * DFF, G, bx, l == 1 ? 1 : 0);
                pg8::EpiFfn E{(bf16_t*)(p.ws + OFF_OV), (float*)(p.ws + OFF_EDGE), p.conv_w + (size_t)l * 3 * 5632, p.conv_b + (size_t)l * 5632, (LAS float*)(ldsl + 131072)};
                pg8::gemm_phase<pg8::EpiFfn, pg8::StaticOrder, true, true>(ldsl, g, S, E); } }
            else if (sp == 8) { KP(); REP(8) phase_ffn_fixup(p, l); }
            else if (sp == 9) { KP(); WL(); __syncthreads();
                { pg8::Gemm g{(const bf16_t*)(p.ws + OFF_OV), wl + W_DN, R, 1024, DFF, DFF, DFF}; pg8::StaticOrder S; S.init(16384, 1024, G, bx, 1);
                  pg8::EpiResid E{X, modv + 5120, 0};
                  pg8::gemm_phase<pg8::EpiResid, pg8::StaticOrder, true, true>(ldsl, g, S, E); }
                if (l == 0 && bx < 32) { __syncthreads(); const int q = bx >> 3; const int koff = q < 2 ? q * 768 : 1536 + (q - 2) * 640, klen = q < 2 ? 768 : 640;
                  pg8::Gemm g{(const bf16_t*)(p.ws + OFF_OV) + koff, wl + W_DN + koff, 512, 1024, klen, DFF, DFF}; pg8::StaticOrder S; S.init(512, 1024, G, bx & 7, 2);
                  pg8::EpiPart E{(float*)(p.ws + OFF_PART) + (size_t)q * 524288, 0};
                  pg8::gemm_phase<pg8::EpiPart, pg8::StaticOrder, true, true>(ldsl, g, S, E); } }
        }
        if (ph + 1 < ph_hi) {
            if (ph == ph_lo) grid.sync();
            else { KP(); XcdBarrier b; b.bar = (unsigned*)(p.ws + OFF_CTL); b.x = xb_xcc_id(); b.st = misc; xcd_barrier(b); }
        }
    }
}

extern "C" void kernel_launch(void* const* d_in, const int* in_sizes, int n_in, void* d_out, int out_size, void* d_ws, size_t ws_size, hipStream_t stream) {
    static int grid = 0;
    if (grid == 0) {
        if (n_in != 23 || ws_size < WS_NEED) { fprintf(stderr, "kernel_launch: unexpected problem (n_in %d, ws %zu, need %zu)\n", n_in, ws_size, (size_t)WS_NEED); grid = -1; return; }
        int dev = 0, cus = 0, per_cu = 0;
        hipGetDevice(&dev); hipDeviceGetAttribute(&cus, hipDeviceAttributeMultiprocessorCount, dev);
        if (hipFuncSetAttribute((const void*)mk_fwd, hipFuncAttributeMaxDynamicSharedMemorySize, LDS_BYTES) != hipSuccess) { fprintf(stderr, "kernel_launch: hipFuncSetAttribute failed\n"); grid = -1; return; }
        if (hipOccupancyMaxActiveBlocksPerMultiprocessor(&per_cu, (const void*)mk_fwd, 512, LDS_BYTES) != hipSuccess || per_cu < 1) { fprintf(stderr, "kernel_launch: occupancy query says %d\n", per_cu); per_cu = 1; }
        (void)hipGetLastError();
        grid = cus * per_cu; if (grid > 256) grid = 256;
        fprintf(stderr, "kernel_launch: grid %d (cus %d, per_cu %d)\n", grid, cus, per_cu);
    }
    if (grid < 0) return;
    Params p{};
    const float** pp = (const float**)&p;
    for (int i = 0; i < 23; ++i) pp[i] = (const float*)d_in[i];
    p.out = (float*)d_out; p.ws = (unsigned char*)d_ws;
#if MK_MULTI
    for (int ph = 0; ph < N_PHASES; ++ph) { p.ph_lo = ph; p.ph_hi = ph + 1; void* args[] = {&p};
        hipError_t e = hipLaunchCooperativeKernel((void*)mk_fwd, dim3(grid), dim3(512), args, LDS_BYTES, stream);
        if (e != hipSuccess) { fprintf(stderr, "launch %d failed: %s\n", ph, hipGetErrorString(e)); break; } }
#else
    if (hipMemsetAsync((char*)d_ws + OFF_CTL, 0, CTL_BYTES, stream) != hipSuccess) { fprintf(stderr, "kernel_launch: memset of the barrier words failed\n"); return; }
    p.ph_lo = 0; p.ph_hi = N_PHASES; void* args[] = {&p};
    hipError_t e = hipLaunchCooperativeKernel((void*)mk_fwd, dim3(grid), dim3(512), args, LDS_BYTES, stream);
    if (e != hipSuccess) fprintf(stderr, "cooperative launch failed: %s (grid %d)\n", hipGetErrorString(e), grid);
#endif
}
```

```cpp
#include <hip/hip_runtime.h>
#include <hip/hip_cooperative_groups.h>
#include <cstdio>
#include <cstdint>
namespace cg = cooperative_groups;

#ifndef MK_MULTI
#define MK_MULTI 0
#endif

namespace pg8 {
#define PG8_LAS __attribute__((address_space(3)))
typedef unsigned short bf16_t;
typedef short bf16x8 __attribute__((ext_vector_type(8)));
typedef float f32x4 __attribute__((ext_vector_type(4)));
typedef unsigned u32x4 __attribute__((ext_vector_type(4)));
constexpr int BM = 256, BK = 64, HALF = 128, HTB = HALF * BK * 2  , STAGE_BYTES = 8 * HTB, NXCD = 8, WGM = 8;

__host__ __device__ __forceinline__ int lds_byte(int r, int c) { const int st = (r >> 4) * 2 + (c >> 5), rr = r & 15, cc = c & 31, ob = rr * 64 + cc * 2; return st * 1024 + (ob ^ (((ob >> 9) & 1) << 5)); }
__host__ __device__ __forceinline__ void stage_rc(int b, int& R, int& C) { const int st = b / 1024, sb = b % 1024, swz = sb ^ (((sb >> 9) & 1) << 5); R = (st >> 1) * 16 + swz / 64; C = (st & 1) * 32 + (swz % 64) / 2; }
__host__ __device__ __forceinline__ int perm32(int rho) { const int n = rho >> 4, i = rho & 15; return 8 * (i >> 2) + 4 * n + (i & 3); }

struct Unit { int pm, pn; };
struct Gemm { const bf16_t* A; const bf16_t* Bt; int M, N, K, lda, ldb; };

struct StaticOrder {
    int nM, nN, nwg, G, c, skip;
    __host__ __device__ void init(int M, int N, int G_, int c_, int skip_ = 0) { nM = M / BM; nN = N / BM; nwg = nM * nN; G = G_; c = c_; skip = skip_; }
    __host__ __device__ bool next(int i, Unit& u) const {
        const long L = (long)i * G + c; if (L >= nwg) return false;
        int wgid = (int)L; { const int q = nwg / NXCD, r = nwg % NXCD, xcd = wgid % NXCD, off = wgid / NXCD; wgid = (xcd < r ? xcd * (q + 1) : r * (q + 1) + (xcd - r) * q) + off; }
        const int nig = WGM * nN, gid = wgid / nig, fm = gid * WGM, gsz = (nM - fm) < WGM ? (nM - fm) : WGM;
        u.pm = fm + ((wgid % nig) % gsz); u.pn = (wgid % nig) / gsz; if (skip == 1) u.pm += 1 + (u.pm >= 32 ? 1 : 0); else if (skip == 2) u.pm *= 33; return true;
    }
    __device__ __forceinline__ void a_ready(const Unit&) const {}
    __device__ __forceinline__ void done(const Unit&) const {}
};

__device__ __forceinline__ unsigned cvt_pk_bf16(float lo, float hi) { unsigned r; asm volatile("v_cvt_pk_bf16_f32 %0, %1, %2" : "=v"(r) : "v"(lo), "v"(hi)); return r; }

struct EpiStore {
    static constexpr bool PERM = true, AFTER_DRAIN = false;
    bf16_t* O; int ldc; int ncols; float scale;
    __device__ __forceinline__ void operator()(const f32x4 (&acc)[2][2][4][2], const Unit& u, int wr, int wc, int fr, int fq) const {
        const int row0 = u.pm * BM + wr * 64 + fr; const int col0 = u.pn * BM + wc * 32 + 8 * fq;
#pragma unroll
        for (int ai = 0; ai < 2; ++ai)
#pragma unroll
            for (int m = 0; m < 4; ++m) { bf16_t* rowp = O + (size_t)(row0 + ai * HALF + m * 16) * ldc + col0;
#pragma unroll
                for (int bj = 0; bj < 2; ++bj) { if (col0 + bj * HALF < ncols) {
                    f32x4 v0 = acc[ai][bj][m][0] * scale, v1 = acc[ai][bj][m][1] * scale;
                    u32x4 w; w.x = cvt_pk_bf16(v0[0], v0[1]); w.y = cvt_pk_bf16(v0[2], v0[3]); w.z = cvt_pk_bf16(v1[0], v1[1]); w.w = cvt_pk_bf16(v1[2], v1[3]);
                    *(u32x4*)(rowp + bj * HALF) = w; } } }
    }
};
struct EpiResid {
    static constexpr bool PERM = false, AFTER_DRAIN = false;
    float* X; const float* gate; int row_tile0;
    __device__ __forceinline__ void operator()(const f32x4 (&acc)[2][2][4][2], const Unit& u, int wr, int wc, int fr, int fq) const {
        const int tpm = u.pm + row_tile0; const int bb = tpm / 33, jj = tpm - bb * 33; const float* gv = gate + (jj == 0 ? 2 : bb) * 6144;
        const int col0 = u.pn * BM + wc * 32 + 4 * fq;
#pragma unroll
        for (int ai = 0; ai < 2; ++ai)
#pragma unroll
            for (int m = 0; m < 4; ++m) { float* rowp = X + (size_t)(tpm * BM + ai * HALF + wr * 64 + m * 16 + fr) * 1024 + col0;
#pragma unroll
                for (int bj = 0; bj < 2; ++bj) {
#pragma unroll
                    for (int n = 0; n < 2; ++n) { f32x4* q = (f32x4*)(rowp + bj * HALF + n * 16); const f32x4 gq = *(const f32x4*)(gv + col0 + bj * HALF + n * 16); f32x4 xv = *q; xv = xv + gq * acc[ai][bj][m][n]; *q = xv; }
                    asm volatile("" ::: "memory"); } }
    }
};
struct EpiPart {
    static constexpr bool PERM = false, AFTER_DRAIN = false;
    float* out; int accum;
    __device__ __forceinline__ void operator()(const f32x4 (&acc)[2][2][4][2], const Unit& u, int wr, int wc, int fr, int fq) const {
        const int t = u.pm / 33; const int col0 = u.pn * BM + wc * 32 + 4 * fq;
#pragma unroll
        for (int ai = 0; ai < 2; ++ai)
#pragma unroll
            for (int m = 0; m < 4; ++m) { float* rowp = out + (size_t)(t * BM + ai * HALF + wr * 64 + m * 16 + fr) * 1024 + col0;
#pragma unroll
                for (int bj = 0; bj < 2; ++bj) {
#pragma unroll
                    for (int n = 0; n < 2; ++n) { f32x4* q = (f32x4*)(rowp + bj * HALF + n * 16); f32x4 v = acc[ai][bj][m][n]; if (accum) v = v + *q; *q = v; }
                    asm volatile("" ::: "memory"); } }
    }
};
template <int CTRL> __device__ __forceinline__ float dpp0(float x) { return __builtin_bit_cast(float, __builtin_amdgcn_update_dpp(0, __builtin_bit_cast(int, x), CTRL, 0xf, 0xf, true)); }
struct EpiFfn {
    static constexpr bool PERM = false, AFTER_DRAIN = false;
    bf16_t* ACT; float* EDGE; const float* cw; const float* cb; PG8_LAS float* xl;
    __device__ __forceinline__ void operator()(const f32x4 (&acc)[2][2][4][2], const Unit& u, int wr, int wc, int fr, int fq) const {
        PG8_LAS float* FIRST = xl; PG8_LAS float* LAST = xl + 1024;
        const int cb0 = wc * 32 + 4 * fq;
#pragma unroll
        for (int ai = 0; ai < 2; ++ai)
#pragma unroll
            for (int bj = 0; bj < 2; ++bj)
#pragma unroll
                for (int n = 0; n < 2; ++n) { const int col = bj * HALF + cb0 + n * 16;
                    if (fr == 0) *(PG8_LAS f32x4*)(FIRST + (2 * ai + wr) * 256 + col) = acc[ai][bj][0][n];
                    if (fr == 15) *(PG8_LAS f32x4*)(LAST + (2 * ai + wr) * 256 + col) = acc[ai][bj][3][n]; }
        if (wr == 0 && fr < 2) {
#pragma unroll
            for (int bj = 0; bj < 2; ++bj)
#pragma unroll
                for (int n = 0; n < 2; ++n) *(f32x4*)(EDGE + ((size_t)(u.pm * 4 + fr) * 22 + u.pn) * 256 + bj * HALF + cb0 + n * 16) = acc[0][bj][0][n]; }
        if (wr == 1 && fr >= 14) {
#pragma unroll
            for (int bj = 0; bj < 2; ++bj)
#pragma unroll
                for (int n = 0; n < 2; ++n) *(f32x4*)(EDGE + ((size_t)(u.pm * 4 + 2 + (fr - 14)) * 22 + u.pn) * 256 + bj * HALF + cb0 + n * 16) = acc[1][bj][3][n]; }
        asm volatile("s_waitcnt lgkmcnt(0)" ::: "memory"); __builtin_amdgcn_s_barrier(); asm volatile("" ::: "memory");
#pragma unroll
        for (int n = 0; n < 2; ++n) { const int ch0 = u.pn * HALF + cb0 + n * 16;
            f32x4 wa[3], wb[3];
#pragma unroll
            for (int k = 0; k < 3; ++k) { wa[k] = *(const f32x4*)(cw + k * 5632 + ch0); wb[k] = *(const f32x4*)(cw + k * 5632 + 2816 + ch0); }
            const f32x4 ba = *(const f32x4*)(cb + ch0), bb = *(const f32x4*)(cb + 2816 + ch0);
#pragma unroll
            for (int ai = 0; ai < 2; ++ai) { const int g = 2 * ai + wr;
                f32x4 bu[2], bd[2];
#pragma unroll
                for (int bj = 0; bj < 2; ++bj) { const int col = bj * HALF + cb0 + n * 16; const f32x4 zz = {0.f, 0.f, 0.f, 0.f};
                    bu[bj] = g > 0 ? *(const PG8_LAS f32x4*)(LAST + (g - 1) * 256 + col) : zz; bd[bj] = g < 3 ? *(const PG8_LAS f32x4*)(FIRST + (g + 1) * 256 + col) : zz; }
#pragma unroll
                for (int m = 0; m < 4; ++m) { float o[4];
#pragma unroll
                    for (int e = 0; e < 4; ++e) { float up[2], dn[2];
#pragma unroll
                        for (int bj = 0; bj < 2; ++bj) { const float cur = acc[ai][bj][m][n][e];
                            float x = dpp0<0x111>(cur);
                            if (m > 0) x += dpp0<0x10F>(acc[ai][bj][m - 1][n][e]); else x += (fr == 0 ? bu[bj][e] : 0.f);
                            float y = dpp0<0x101>(cur);
                            if (m < 3) y += dpp0<0x11F>(acc[ai][bj][m + 1][n][e]); else y += (fr == 15 ? bd[bj][e] : 0.f);
                            up[bj] = x; dn[bj] = y; }
                        const float ua = wa[0][e] * up[0] + wa[1][e] * acc[ai][0][m][n][e] + wa[2][e] * dn[0] + ba[e];
                        const float ub = wb[0][e] * up[1] + wb[1][e] * acc[ai][1][m][n][e] + wb[2][e] * dn[1] + bb[e];
                        o[e] = ua / (1.0f + __expf(-ua)) * ub; }
                    typedef unsigned u32x2 __attribute__((ext_vector_type(2))); u32x2 w; w.x = cvt_pk_bf16(o[0], o[1]); w.y = cvt_pk_bf16(o[2], o[3]);
                    *(u32x2*)(ACT + (size_t)(u.pm * BM + ai * HALF + wr * 64 + m * 16 + fr) * 2816 + ch0) = w; } } }
    }
};

template <class Epi, class Sched, bool ALIGN_EPI = false, bool SP2 = false>
__device__ __forceinline__ void gemm_phase(PG8_LAS unsigned char* lds, const Gemm g, const Sched& S, const Epi& E) {
    int tid = threadIdx.x; asm volatile("" : "+v"(tid));
    const int wid = __builtin_amdgcn_readfirstlane(tid >> 6), lane = tid & 63, wr = wid >> 2, wc = wid & 3, fr = lane & 15, fq = lane >> 4;
    int K = g.K; asm volatile("" : "+s"(K));
    const int nt = K / BK;
    unsigned voffA[2], voffB[2];
#pragma unroll
    for (int i = 0; i < 2; ++i) { int R, C; stage_rc(tid * 16 + i * 8192, R, C); const int Rb = Epi::PERM ? ((R & ~31) + perm32(R & 31)) : R;
        voffA[i] = (unsigned)(R * g.lda + C) * 2u; voffB[i] = (unsigned)(Rb * g.ldb + C) * 2u; }
    const size_t kstep = (size_t)(BK * 2);
    const size_t hstepA = (size_t)HALF * g.lda * 2, hstepB = (size_t)HALF * g.ldb * 2;
    const size_t tstepA = 2 * hstepA, tstepB = 2 * hstepB;
    const unsigned ldsw = (unsigned)wid * 1024u;
    const int aoff = lds_byte(wr * 64 + fr, fq * 8), boff = lds_byte(wc * 32 + fr, fq * 8);
#define PG8_SA(b, h) (((b) * 2 + (h)) * HTB)
#define PG8_SB(b, h) ((4 + (b) * 2 + (h)) * HTB)
#define PG8_STAGE(bufoff, gbase, voff) do { _Pragma("unroll") for (int _i = 0; _i < 2; ++_i) \
        __builtin_amdgcn_global_load_lds((const unsigned*)((const char*)(gbase) + (voff)[_i]), (PG8_LAS unsigned*)(lds + (bufoff) + ldsw + _i * 8192), 16, 0, 0); } while (0)
#define PG8_LDA(dst, b, h) do { _Pragma("unroll") for (int m = 0; m < 4; ++m) _Pragma("unroll") for (int k = 0; k < 2; ++k) dst[m][k] = *(const PG8_LAS bf16x8*)(lds + PG8_SA(b, h) + aoff + m * 2048 + k * 1024); } while (0)
#define PG8_LDB(dst, b, h) do { _Pragma("unroll") for (int n = 0; n < 2; ++n) _Pragma("unroll") for (int k = 0; k < 2; ++k) dst[n][k] = *(const PG8_LAS bf16x8*)(lds + PG8_SB(b, h) + boff + n * 2048 + k * 1024); } while (0)
#define PG8_MMA(ai, bj, At, Bt) do { __builtin_amdgcn_s_setprio(1); _Pragma("unroll") for (int m = 0; m < 4; ++m) _Pragma("unroll") for (int n = 0; n < 2; ++n) _Pragma("unroll") for (int k = 0; k < 2; ++k) \
        acc[ai][bj][m][n] = __builtin_amdgcn_mfma_f32_16x16x32_bf16(Bt[n][k], At[m][k], acc[ai][bj][m][n], 0, 0, 0); __builtin_amdgcn_s_setprio(0); } while (0)
#define PG8_WAIT_V(n) asm volatile("s_waitcnt vmcnt(" #n ")" ::: "memory")
#define PG8_WAIT_L(n) asm volatile("s_waitcnt lgkmcnt(" #n ")" ::: "memory")
#define PG8_BAR __builtin_amdgcn_s_barrier()
#define PG8_SCHED __builtin_amdgcn_sched_barrier(0)
    Unit cur, nxt; int ui = 0;
    if (!S.next(0, cur)) return;
    f32x4 acc[2][2][4][2];
#pragma unroll
    for (int a = 0; a < 2; ++a)
#pragma unroll
        for (int b = 0; b < 2; ++b)
#pragma unroll
            for (int m = 0; m < 4; ++m)
#pragma unroll
                for (int n = 0; n < 2; ++n) acc[a][b][m][n] = (f32x4){0.f, 0.f, 0.f, 0.f};
    bf16x8 At[4][2], B0[2][2], B1[2][2];
    const char* cA = (const char*)g.A + (size_t)cur.pm * tstepA; const char* cB = (const char*)g.Bt + (size_t)cur.pn * tstepB;
    S.a_ready(cur);
    if constexpr (SP2) {
        PG8_STAGE(PG8_SB(0, 0), cB, voffB); PG8_STAGE(PG8_SB(0, 1), cB + hstepB, voffB); PG8_STAGE(PG8_SA(0, 0), cA, voffA); PG8_STAGE(PG8_SA(0, 1), cA + hstepA, voffA);
        if (wr == 1) PG8_BAR;
        PG8_WAIT_V(2); PG8_BAR;
        PG8_STAGE(PG8_SB(1, 0), cB + kstep, voffB); PG8_STAGE(PG8_SA(1, 0), cA + kstep, voffA); PG8_STAGE(PG8_SB(1, 1), cB + hstepB + kstep, voffB);
        PG8_WAIT_V(6); PG8_BAR;
    } else {
        PG8_STAGE(PG8_SB(0, 0), cB, voffB); PG8_STAGE(PG8_SA(0, 0), cA, voffA); PG8_STAGE(PG8_SB(0, 1), cB + hstepB, voffB); PG8_STAGE(PG8_SA(0, 1), cA + hstepA, voffA);
        if (wr == 1) PG8_BAR;
        PG8_WAIT_V(4); PG8_BAR;
        PG8_STAGE(PG8_SB(1, 0), cB + kstep, voffB); PG8_STAGE(PG8_SA(1, 0), cA + kstep, voffA); PG8_STAGE(PG8_SB(1, 1), cB + hstepB + kstep, voffB);
        PG8_WAIT_V(6); PG8_BAR;
    }
    for (;;) {
        const bool has_next = S.next(ui + 1, nxt);
        const char* nA = has_next ? (const char*)g.A + (size_t)nxt.pm * tstepA : cA; const char* nB = has_next ? (const char*)g.Bt + (size_t)nxt.pn * tstepB : cB;
        for (int t = 0; t < nt; t += 2) {
            const bool last = (t == nt - 2);
            const char* a1 = cA + (size_t)(t + 1) * kstep;
            const char* a2 = last ? nA : cA + (size_t)(t + 2) * kstep; const char* b2 = last ? nB : cB + (size_t)(t + 2) * kstep;
            const char* a3 = a2 + kstep; const char* b3 = b2 + kstep;
            if (last && has_next) S.a_ready(nxt);
            if constexpr (SP2) {
            PG8_LDB(B0, 0, 0); PG8_LDB(B1, 0, 1); PG8_SCHED; PG8_LDA(At, 0, 0); PG8_STAGE(PG8_SA(1, 1), a1 + hstepA, voffA);
            PG8_WAIT_V(8); PG8_WAIT_L(0); PG8_BAR; PG8_MMA(0, 0, At, B0); PG8_MMA(0, 1, At, B1); PG8_BAR; PG8_SCHED;
            PG8_LDA(At, 0, 1); PG8_STAGE(PG8_SB(0, 0), b2, voffB); PG8_STAGE(PG8_SB(0, 1), b2 + hstepB, voffB); PG8_STAGE(PG8_SA(0, 0), a2, voffA);
            PG8_WAIT_V(8); PG8_WAIT_L(0); PG8_BAR; PG8_MMA(1, 0, At, B0); PG8_MMA(1, 1, At, B1); PG8_BAR; PG8_SCHED;
            PG8_LDB(B0, 1, 0); PG8_LDB(B1, 1, 1); PG8_SCHED; PG8_LDA(At, 1, 0); PG8_STAGE(PG8_SA(0, 1), a2 + hstepA, voffA);
            PG8_WAIT_V(8); PG8_WAIT_L(0); PG8_BAR; PG8_MMA(0, 0, At, B0); PG8_MMA(0, 1, At, B1); PG8_BAR; PG8_SCHED;
            PG8_LDA(At, 1, 1); PG8_STAGE(PG8_SB(1, 0), b3, voffB); PG8_STAGE(PG8_SB(1, 1), b3 + hstepB, voffB); PG8_STAGE(PG8_SA(1, 0), a3, voffA);
            PG8_WAIT_V(8); PG8_WAIT_L(0); PG8_BAR; PG8_MMA(1, 0, At, B0); PG8_MMA(1, 1, At, B1); PG8_BAR; PG8_SCHED;
            } else {
            PG8_LDB(B0, 0, 0); PG8_SCHED; PG8_LDA(At, 0, 0); PG8_STAGE(PG8_SA(1, 1), a1 + hstepA, voffA);
            PG8_WAIT_L(8); PG8_BAR; PG8_WAIT_L(0); PG8_MMA(0, 0, At, B0); PG8_BAR; PG8_SCHED;
            PG8_LDB(B1, 0, 1); PG8_STAGE(PG8_SB(0, 0), b2, voffB);
            PG8_BAR; PG8_WAIT_L(0); PG8_MMA(0, 1, At, B1); PG8_BAR;
            PG8_LDA(At, 0, 1); PG8_STAGE(PG8_SA(0, 0), a2, voffA);
            PG8_BAR; PG8_WAIT_L(0); PG8_MMA(1, 0, At, B0); PG8_BAR; PG8_SCHED;
            PG8_STAGE(PG8_SB(0, 1), b2 + hstepB, voffB);
            PG8_WAIT_V(6); PG8_BAR; PG8_MMA(1, 1, At, B1); PG8_BAR;
            PG8_LDB(B0, 1, 0); PG8_SCHED; PG8_LDA(At, 1, 0); PG8_STAGE(PG8_SA(0, 1), a2 + hstepA, voffA);
            PG8_WAIT_L(8); PG8_BAR; PG8_WAIT_L(0); PG8_MMA(0, 0, At, B0); PG8_BAR; PG8_SCHED;
            PG8_LDB(B1, 1, 1); PG8_STAGE(PG8_SB(1, 0), b3, voffB);
            PG8_BAR; PG8_WAIT_L(0); PG8_MMA(0, 1, At, B1); PG8_BAR;
            PG8_LDA(At, 1, 1); PG8_STAGE(PG8_SA(1, 0), a3, voffA);
            PG8_BAR; PG8_WAIT_L(0); PG8_MMA(1, 0, At, B0); PG8_BAR; PG8_SCHED;
            PG8_STAGE(PG8_SB(1, 1), b3 + hstepB, voffB);
            PG8_WAIT_V(6); PG8_BAR; PG8_MMA(1, 1, At, B1); PG8_BAR;
            }
        }
        if constexpr (ALIGN_EPI) { if (wr == 0) PG8_BAR; }
        if constexpr (!Epi::AFTER_DRAIN) { E(acc, cur, wr, wc, fr, fq); S.done(cur); }
        if (!has_next) break;
#pragma unroll
        for (int a = 0; a < 2; ++a)
#pragma unroll
            for (int b = 0; b < 2; ++b)
#pragma unroll
                for (int m = 0; m < 4; ++m)
#pragma unroll
                    for (int n = 0; n < 2; ++n) acc[a][b][m][n] = (f32x4){0.f, 0.f, 0.f, 0.f};
        cur = nxt; cA = nA; cB = nB; ++ui;
        if constexpr (ALIGN_EPI) { if (wr == 1) PG8_BAR; }
    }
    PG8_WAIT_V(0);
    if constexpr (!ALIGN_EPI) { if (wr == 0) PG8_BAR; }
    PG8_BAR;
    if constexpr (Epi::AFTER_DRAIN) { E.fused(acc, cur, wr, wc, fr, fq, lds, wid, lane); S.done(cur); }
#undef PG8_SA
#undef PG8_SB
#undef PG8_STAGE
#undef PG8_LDA
#undef PG8_LDB
#undef PG8_MMA
#undef PG8_WAIT_V
#undef PG8_WAIT_L
#undef PG8_BAR
#undef PG8_SCHED
}
}

#define DEV __device__ __forceinline__
#define LAS __attribute__((address_space(3)))
typedef unsigned short bf16_t;
typedef short bf16x8 __attribute__((ext_vector_type(8)));
typedef float f32x4 __attribute__((ext_vector_type(4)));
typedef float f32x2 __attribute__((ext_vector_type(2)));
typedef float f32x16 __attribute__((ext_vector_type(16)));
typedef unsigned u32x4 __attribute__((ext_vector_type(4)));
typedef unsigned u32x2 __attribute__((ext_vector_type(2)));

constexpr int R = 16896, RB = 8448, NCTX = 256, TL = 8192, DM = 1024, INW = 1696, DFF = 2816, HFF = 1408;
constexpr int NWG_T = 512;
constexpr float EPS = 1e-6f;
constexpr int LDS_BYTES = 147456;
constexpr size_t OFF_X = 0, OFF_HN = 69206016, OFF_W = 103809024, OFF_MOD = 152174592, OFF_ROPE = 152436736, OFF_OV = 153485312;
constexpr size_t OV_Q = 0, OV_KN = 25952256, OV_VT = 43253760, OV_SLOC = 60555264, OV_SIN = 69206016, OV_U = 0;
constexpr size_t OFF_PART = 250100224;
constexpr size_t OFF_EDGE = 258488832;
constexpr size_t WS_NEED = OFF_EDGE + 5947392;
constexpr size_t W_IN = 0, W_UQ = 1835008, W_KN = 2129920, W_V = 2260992, W_OUT = 2392064, W_UP = 3440640, W_DN = 9207808, W_LAYER = 12091392;

struct Params {
    const float *x, *c, *ctx, *c_ctx, *w_mod, *b_mod, *norm1_g, *w_in, *ret_decay_f, *ret_decay_b, *mla_q_norm_g, *w_uq, *mla_kv_norm_g, *w_ukv,
        *pool_w, *pool_scale, *w_out, *norm2_g, *w_up, *conv_w, *conv_b, *w_down, *final_norm_g;
    float* out; unsigned char* ws; int ph_lo, ph_hi;
};

DEV int otid() { int t = threadIdx.x; asm volatile("" : "+v"(t)); return t; }
DEV float bf2f(unsigned short x) { return __uint_as_float((unsigned)x << 16); }
DEV unsigned f2bf(float f) { unsigned u = __float_as_uint(f); return (u + 0x7fffu + ((u >> 16) & 1u)) >> 16; }
DEV unsigned pk2(float lo, float hi) { return f2bf(lo) | (f2bf(hi) << 16); }
DEV float wave_sum(float v) {
#pragma unroll
    for (int o = 1; o < 64; o <<= 1) v += __shfl_xor(v, o);
    return v;
}
DEV float siluf(float x) { return x / (1.0f + __expf(-x)); }
DEV int crow(int r, int hi) { return (r & 3) + 8 * (r >> 2) + 4 * hi; }
DEV bf16x8 pack8(float a0, float a1, float a2, float a3, float a4, float a5, float a6, float a7) {
    u32x4 w; w.x = pg8::cvt_pk_bf16(a0, a1); w.y = pg8::cvt_pk_bf16(a2, a3); w.z = pg8::cvt_pk_bf16(a4, a5); w.w = pg8::cvt_pk_bf16(a6, a7);
    return __builtin_bit_cast(bf16x8, w);
}
DEV int row_mi(int r) { const int b = r / RB; const int s = r - b * RB; return s < NCTX ? 2 : b; }

DEV void transpose_item(const float* W, int K, int Nsrc, bf16_t* WT, int n0, int cs, int k0, float* scr, int lane) {
#pragma unroll
    for (int i = 0; i < 32; ++i) { const int kk = 2 * i + (lane >> 5); scr[kk * 33 + (lane & 31)] = cs >= 0 ? W[(size_t)(k0 + kk) * Nsrc + cs + (lane & 31)] : 0.f; }
    asm volatile("s_waitcnt lgkmcnt(0)" ::: "memory");
    const int c = lane & 7;
#pragma unroll
    for (int j = 0; j < 4; ++j) { const int n = (lane >> 3) + 8 * j; const float* s = scr + (8 * c) * 33 + n;
        u32x4 o; o.x = pk2(s[0 * 33], s[1 * 33]); o.y = pk2(s[2 * 33], s[3 * 33]); o.z = pk2(s[4 * 33], s[5 * 33]); o.w = pk2(s[6 * 33], s[7 * 33]);
        *(u32x4*)(WT + (size_t)(n0 + n) * K + k0 + 8 * c) = o; }
    asm volatile("s_waitcnt lgkmcnt(0)" ::: "memory");
}
DEV int map_in(int n0) { return n0 < 1440 ? n0 : (n0 < INW ? -2 : -1); }
DEV int map_kn(int n0) { return (n0 >> 6) * 128 + (n0 & 63); }
DEV int map_v(int n0) { return (n0 >> 6) * 128 + 64 + (n0 & 63); }
DEV int map_up(int n0) { const int pn = n0 >> 8, w = n0 & 255; return w < 128 ? 128 * pn + w : DFF + 128 * pn + (w - 128); }

DEV void phase_prep(const Params& p, unsigned char* lds) {
    const int tid = otid(), lane = tid & 63, wid = tid >> 6;
    unsigned char* ws = p.ws;
    { f32x2* rope = (f32x2*)(ws + OFF_ROPE);
      for (int idx = blockIdx.x * NWG_T + tid; idx < TL * 16; idx += gridDim.x * NWG_T) { const int t = idx >> 4, i = idx & 15; const int pos = i < 8 ? (t >> 6) : (t & 63);
          const float inv = exp2f(-(float)(i & 7) * 0.125f * 13.287712379549449f); const float ang = (float)pos * inv; f32x2 cs; cs.x = __cosf(ang); cs.y = __sinf(ang); rope[idx] = cs; } }
    { float* scv = (float*)lds;
      float* red = scv + 3 * 1024;
      for (int i = tid; i < 3 * 1024; i += NWG_T) { const int v = i >> 10, k = i & 1023; const float cv = v < 2 ? p.c[v * 1024 + k] : p.c_ctx[k]; scv[i] = siluf(cv); }
      __syncthreads();
      float* modv = (float*)(ws + OFF_MOD);
      for (int it = blockIdx.x; it < 192; it += gridDim.x) { const int l = it / 96, col0 = (it % 96) * 64;
          const float* wm = p.w_mod + (size_t)l * 1024 * 6144 + col0 + lane; float a0 = 0.f, a1 = 0.f, a2 = 0.f;
#pragma unroll 16
          for (int k = wid * 128; k < wid * 128 + 128; ++k) { const float w = wm[(size_t)k * 6144]; a0 += scv[k] * w; a1 += scv[1024 + k] * w; a2 += scv[2048 + k] * w; }
          red[(wid * 3 + 0) * 64 + lane] = a0; red[(wid * 3 + 1) * 64 + lane] = a1; red[(wid * 3 + 2) * 64 + lane] = a2;
          __syncthreads();
          if (tid < 192) { const int v = tid >> 6, cl = tid & 63; float s = 0.f;
#pragma unroll
              for (int w = 0; w < 8; ++w) s += red[(w * 3 + v) * 64 + cl];
              modv[((size_t)l * 3 + v) * 6144 + col0 + cl] = s + p.b_mod[l * 6144 + col0 + cl]; }
          __syncthreads(); }
    }
}
DEV void phase_prep_weights(const Params& p, unsigned char* lds) {
    const int tid = otid(), lane = tid & 63, wid = tid >> 6;
    unsigned char* ws = p.ws;
    { float* scr = (float*)(lds + 32768 + wid * 8704);
      const int gw = blockIdx.x * 8 + wid, NGW = gridDim.x * 8;
      constexpr int I_IN = 16 * 56, I_UQ = 6 * 24, I_KN = 4 * 16, I_V = 4 * 16, I_OUT = 16 * 32, I_UP = 16 * 176, I_DN = 44 * 32, I_L = I_IN + I_UQ + I_KN + I_V + I_OUT + I_UP + I_DN;
      for (int it = gw; it < 2 * I_L; it += NGW) { const int l = it / I_L; int r = it - l * I_L; bf16_t* wl = (bf16_t*)(ws + OFF_W) + (size_t)l * W_LAYER;
          const float* src; int K, Nsrc, nbn, mp; size_t doff;
          if (r < I_IN) { src = p.w_in + (size_t)l * 1024 * INW; K = 1024; Nsrc = INW; nbn = 56; mp = 1; doff = W_IN; }
          else if ((r -= I_IN) < I_UQ) { src = p.w_uq + (size_t)l * 384 * 768; K = 384; Nsrc = 768; nbn = 24; mp = 0; doff = W_UQ; }
          else if ((r -= I_UQ) < I_KN) { src = p.w_ukv + (size_t)l * 256 * 1024; K = 256; Nsrc = 1024; nbn = 16; mp = 2; doff = W_KN; }
          else if ((r -= I_KN) < I_V) { src = p.w_ukv + (size_t)l * 256 * 1024; K = 256; Nsrc = 1024; nbn = 16; mp = 3; doff = W_V; }
          else if ((r -= I_V) < I_OUT) { src = p.w_out + (size_t)l * 1024 * 1024; K = 1024; Nsrc = 1024; nbn = 32; mp = 0; doff = W_OUT; }
          else if ((r -= I_OUT) < I_UP) { src = p.w_up + (size_t)l * 1024 * 5632; K = 1024; Nsrc = 5632; nbn = 176; mp = 4; doff = W_UP; }
          else { r -= I_UP; src = p.w_down + (size_t)l * DFF * 1024; K = DFF; Nsrc = 1024; nbn = 32; mp = 0; doff = W_DN; }
          const int kb = r / nbn, nb = r - kb * nbn, n0 = nb * 32;
          const int cs = mp == 0 ? n0 : mp == 1 ? map_in(n0) : mp == 2 ? map_kn(n0) : mp == 3 ? map_v(n0) : map_up(n0);
          if (cs != -2) transpose_item(src, K, Nsrc, wl + doff, n0, cs, kb * 64, scr, lane); }
    }
    { for (int idx = blockIdx.x * NWG_T + tid; idx < 2 * 1024 * 256; idx += gridDim.x * NWG_T) { const int n = idx & 255, k = (idx >> 8) & 1023, l = idx >> 18; const int g = n >> 6, d = n & 63;
          const float* wr = p.w_in + ((size_t)l * 1024 + k) * INW + 1440 + g * 64; const float* pw = p.pool_w + ((size_t)(l * 4 + g) * 64) * 64 + d; float s = 0.f;
#pragma unroll 8
          for (int c = 0; c < 64; ++c) s += wr[c] * pw[c * 64];
          ((bf16_t*)(ws + OFF_W) + (size_t)l * W_LAYER + W_IN)[(size_t)(1440 + n) * 1024 + k] = (bf16_t)f2bf(s * p.pool_scale[l * 256 + n]); } }
}

DEV void phase_norm(const Params& p, int l, int which, bool first, const float* pgate) {
    const int tid = otid(); const int lane = tid & 63, wid = tid >> 6; const int gw = blockIdx.x * 8 + wid, NGW = gridDim.x * 8;
    float* X = (float*)(p.ws + OFF_X); bf16_t* HN = (bf16_t*)(p.ws + OFF_HN);
    const float* modv = (const float*)(p.ws + OFF_MOD) + (size_t)l * 3 * 6144;
    const float* g = (which == 0 ? p.norm1_g : p.norm2_g) + l * 1024;
    for (int r = gw; r < R; r += NGW) {
        const int b = r / RB, s = r - b * RB; const int mi = s < NCTX ? 2 : b;
        const float* src = first ? (s < NCTX ? p.ctx + ((size_t)b * NCTX + s) * 1024 : p.x + ((size_t)b * TL + (s - NCTX)) * 1024) : X + (size_t)r * 1024;
        const f32x4* xr = (const f32x4*)src + lane; f32x4 v[4]; float ss = 0.f;
#pragma unroll
        for (int j = 0; j < 4; ++j) { v[j] = xr[64 * j]; ss += (v[j].x * v[j].x + v[j].y * v[j].y) + (v[j].z * v[j].z + v[j].w * v[j].w); }
        if (pgate != nullptr && s < NCTX) { const float* PART = (const float*)(p.ws + OFF_PART) + (size_t)(b * NCTX + s) * 1024; ss = 0.f;
#pragma unroll
            for (int j = 0; j < 4; ++j) { const f32x4 gq = ((const f32x4*)pgate)[lane + 64 * j]; f32x4 a = ((const f32x4*)PART)[lane + 64 * j];
#pragma unroll
                for (int q = 1; q < 4; ++q) a = a + ((const f32x4*)(PART + (size_t)q * 524288))[lane + 64 * j];
                v[j] = v[j] + gq * a; ss += (v[j].x * v[j].x + v[j].y * v[j].y) + (v[j].z * v[j].z + v[j].w * v[j].w); } }
        if (first || (pgate != nullptr && s < NCTX)) { f32x4* xo = (f32x4*)(X + (size_t)r * 1024) + lane;
#pragma unroll
            for (int j = 0; j < 4; ++j) xo[64 * j] = v[j]; }
        const float rs = rsqrtf(wave_sum(ss) * (1.f / 1024.f) + EPS);
        const float* mv = modv + mi * 6144 + (which == 0 ? 0 : 3072);
        u32x2* o8 = (u32x2*)(HN + (size_t)r * 1024) + lane;
#pragma unroll
        for (int j = 0; j < 4; ++j) { const f32x4 gg = ((const f32x4*)g)[lane + 64 * j], sh = ((const f32x4*)mv)[lane + 64 * j], sc = ((const f32x4*)(mv + 1024))[lane + 64 * j];
            const f32x4 y = v[j] * rs * gg; const f32x4 h = y * (sc + 1.0f) + sh; u32x2 w; w.x = pk2(h.x, h.y); w.y = pk2(h.z, h.w); o8[64 * j] = w; }
    }
}
DEV void phase_final(const Params& p) {
    const int tid = otid(); const int lane = tid & 63, wid = tid >> 6; const int gw = blockIdx.x * 8 + wid, NGW = gridDim.x * 8;
    const float* X = (const float*)(p.ws + OFF_X);
    for (int q = gw; q < 2 * TL; q += NGW) { const int b = q / TL, t = q - b * TL; const int r = b * RB + NCTX + t;
        const f32x4* xr = (const f32x4*)(X + (size_t)r * 1024) + lane; f32x4 v[4]; float ss = 0.f;
#pragma unroll
        for (int j = 0; j < 4; ++j) { v[j] = xr[64 * j]; ss += (v[j].x * v[j].x + v[j].y * v[j].y) + (v[j].z * v[j].z + v[j].w * v[j].w); }
        const float rs = rsqrtf(wave_sum(ss) * (1.f / 1024.f) + EPS);
        f32x4* o = (f32x4*)(p.out + (size_t)q * 1024) + lane;
#pragma unroll
        for (int j = 0; j < 4; ++j) { const f32x4 gg = ((const f32x4*)p.final_norm_g)[lane + 64 * j]; o[64 * j] = v[j] * rs * gg; } }
}

DEV void phase_rowwise(const Params& p, int l) {
    const int tid = otid(); const int lane = tid & 63, wid = tid >> 6; const int gw = blockIdx.x * 8 + wid, NGW = gridDim.x * 8;
    bf16_t* P = (bf16_t*)p.out; const f32x2* rope = (const f32x2*)(p.ws + OFF_ROPE);
    const float* qg = p.mla_q_norm_g + l * 384; const float* kg = p.mla_kv_norm_g + l * 256;
    for (int r = gw; r < R; r += NGW) {
        bf16_t* pr = P + (size_t)r * INW; const int b = r / RB, s = r - b * RB;
        { unsigned* q2 = (unsigned*)(pr + 768) + lane; unsigned w[3]; float ss = 0.f;
#pragma unroll
          for (int j = 0; j < 3; ++j) { w[j] = q2[64 * j]; const float a = bf2f(w[j] & 0xffff), c2 = bf2f(w[j] >> 16); ss += a * a + c2 * c2; }
          const float rs = rsqrtf(wave_sum(ss) * (1.f / 384.f) + EPS);
#pragma unroll
          for (int j = 0; j < 3; ++j) { const int c0 = 2 * (lane + 64 * j); q2[64 * j] = pk2(bf2f(w[j] & 0xffff) * rs * qg[c0], bf2f(w[j] >> 16) * rs * qg[c0 + 1]); } }
        { u32x2* k4 = (u32x2*)(pr + 1152) + lane; const u32x2 w = *k4;
          const float a0 = bf2f(w.x & 0xffff), a1 = bf2f(w.x >> 16), a2 = bf2f(w.y & 0xffff), a3 = bf2f(w.y >> 16);
          const float rs = rsqrtf(wave_sum((a0 * a0 + a1 * a1) + (a2 * a2 + a3 * a3)) * (1.f / 256.f) + EPS);
          const f32x4 gg = ((const f32x4*)kg)[lane]; u32x2 o; o.x = pk2(a0 * rs * gg.x, a1 * rs * gg.y); o.y = pk2(a2 * rs * gg.z, a3 * rs * gg.w); *k4 = o; }
        if (s >= NCTX && lane < 16) { const f32x2 cs = rope[(s - NCTX) * 16 + lane];
          const float x1 = bf2f(pr[1408 + lane]), x2 = bf2f(pr[1408 + 16 + lane]);
          pr[1408 + lane] = (bf16_t)f2bf(x1 * cs.x - x2 * cs.y); pr[1408 + 16 + lane] = (bf16_t)f2bf(x2 * cs.x + x1 * cs.y); }
    }
}

DEV void phase_pool(const Params& p) {
    const int tid = otid(); const bf16_t* P = (const bf16_t*)p.out; bf16_t* MIX = (bf16_t*)(p.ws + OFF_HN);
    for (int idx = blockIdx.x * NWG_T + tid; idx < R * 32; idx += gridDim.x * NWG_T) { const int r = idx >> 5, cg = idx & 31; const int half = 1 << (cg >> 3);
        const int b = r / RB, s = r - b * RB; const int seq0 = s < NCTX ? b * RB : b * RB + NCTX; const int T = s < NCTX ? NCTX : TL; const int t = r - seq0;
        const int lo = max(t - half, 0), hi = min(t + half, T); float sum[8];
#pragma unroll
        for (int j = 0; j < 8; ++j) sum[j] = 0.f;
        const bf16_t* base = P + (size_t)seq0 * INW + 1440 + cg * 8;
        { bf16x8 wv[16]; const bf16x8 zz = {0, 0, 0, 0, 0, 0, 0, 0};
#pragma unroll
          for (int k = 0; k < 16; ++k) { const int tt = t - 8 + k; wv[k] = (tt >= lo && tt < hi) ? *(const bf16x8*)(base + (size_t)tt * INW) : zz; }
#pragma unroll
          for (int k = 0; k < 16; ++k)
#pragma unroll
              for (int j = 0; j < 8; ++j) sum[j] += bf2f((unsigned short)wv[k][j]); }
        const bf16x8 me = *(const bf16x8*)(base + (size_t)t * INW); const float ic = 1.0f / (float)(hi - lo); float o[8];
#pragma unroll
        for (int j = 0; j < 8; ++j) o[j] = sum[j] * ic - bf2f((unsigned short)me[j]);
        *(bf16x8*)(MIX + (size_t)r * 1024 + 768 + cg * 8) = pack8(o[0], o[1], o[2], o[3], o[4], o[5], o[6], o[7]); }
}

DEV float log2_sigmoid(float d) { return -log1pf(__expf(-d)) * 1.4426950408889634f; }
DEV void states_item(const Params& p, int l, unsigned char* lds, int it) {
    const int tid = otid(); const bf16_t* P = (const bf16_t*)p.out; const f32x2* rope = (const f32x2*)(p.ws + OFF_ROPE);
    float* SLOC = (float*)(p.ws + OFF_OV + OV_SLOC);
    const int gc = it >> 2, h = it & 3;
    bf16_t* kk = (bf16_t*)lds;
    bf16_t* vv = kk + 128 * 32;
    float* dec = (float*)(vv + 128 * 64);
    const int cb = gc % 66; const bool lat = cb >= 2; const int t0 = (cb - 2) * 128; const int r0 = gc * 128;
    if (tid < 256) { const int dir = tid >> 7, idx = tid & 127;
        const float lg = log2_sigmoid((dir == 0 ? p.ret_decay_f : p.ret_decay_b)[l * 4 + h]); dec[tid] = exp2f(lg * (dir == 0 ? (float)(127 - idx) : (float)idx)); }
    else { const int task = tid - 256; const int tok = task >> 1, c = task & 1;
        const bf16_t* src = P + (size_t)(r0 + tok) * INW + 128 + h * 32 + 8 * c; const bf16x8 lo = *(const bf16x8*)src, hi = *(const bf16x8*)(src + 16);
        float o1[8], o2[8];
#pragma unroll
        for (int j = 0; j < 8; ++j) { float x1 = bf2f((unsigned short)lo[j]), x2 = bf2f((unsigned short)hi[j]);
            if (lat) { const f32x2 cs = rope[(t0 + tok) * 16 + 8 * c + j]; const float y1 = x1 * cs.x - x2 * cs.y, y2 = x2 * cs.x + x1 * cs.y; x1 = y1; x2 = y2; }
            o1[j] = x1 * 0.17677669529663687f; o2[j] = x2 * 0.17677669529663687f; }
        bf16_t* dst = kk + tok * 32 + 8 * c;
        *(bf16x8*)dst = pack8(o1[0], o1[1], o1[2], o1[3], o1[4], o1[5], o1[6], o1[7]); *(bf16x8*)(dst + 16) = pack8(o2[0], o2[1], o2[2], o2[3], o2[4], o2[5], o2[6], o2[7]); }
    for (int task = tid; task < 1024; task += NWG_T) { const int tok = task >> 3, ch = task & 7; *(u32x4*)(vv + tok * 64 + ch * 8) = *(const u32x4*)(P + (size_t)(r0 + tok) * INW + 256 + h * 64 + ch * 8); }
    __syncthreads();
    { const int d = tid >> 4, dvg = tid & 15; float af[4], ab[4];
#pragma unroll
      for (int j = 0; j < 4; ++j) { af[j] = 0.f; ab[j] = 0.f; }
#pragma unroll 4
      for (int i = 0; i < 128; ++i) { const float kv = bf2f(kk[i * 32 + d]); const float kf = kv * dec[i], kb = kv * dec[128 + i];
          const u32x2 v = *(const u32x2*)(vv + i * 64 + dvg * 4);
          const float v0 = bf2f(v.x & 0xffff), v1 = bf2f(v.x >> 16), v2 = bf2f(v.y & 0xffff), v3 = bf2f(v.y >> 16);
          af[0] += kf * v0; af[1] += kf * v1; af[2] += kf * v2; af[3] += kf * v3; ab[0] += kb * v0; ab[1] += kb * v1; ab[2] += kb * v2; ab[3] += kb * v3; }
      float* of = SLOC + ((size_t)(gc * 4 + h) * 2 + 0) * 2048 + d * 64 + dvg * 4;
      *(f32x4*)of = (f32x4){af[0], af[1], af[2], af[3]}; *(f32x4*)(of + 2048) = (f32x4){ab[0], ab[1], ab[2], ab[3]}; }
    __syncthreads();
}
DEV void scan_threads(const Params& p, int l, int gid) {
    if (gid >= 32768) return;
    const int e = gid & 2047, dir = (gid >> 11) & 1, h = (gid >> 12) & 3, b = gid >> 14;
    const float* SLOC = (const float*)(p.ws + OFF_OV + OV_SLOC); float* SIN = (float*)(p.ws + OFF_OV + OV_SIN);
    const float gC = exp2f(log2_sigmoid((dir == 0 ? p.ret_decay_f : p.ret_decay_b)[l * 4 + h]) * 128.f);
    float S = 0.f;
#pragma unroll 6
    for (int st = 0; st < 66; ++st) { const int cb = dir == 0 ? st : (st < 2 ? 1 - st : 67 - st); const size_t idx = ((size_t)((b * 66 + cb) * 4 + h) * 2 + dir) * 2048 + e;
        const float v = SLOC[idx]; SIN[idx] = S; S = S * gC + v; }
}

constexpr int AT_KP = 208, AT_VP = 136, AT_KB = 64 * AT_KP, AT_VBS = 64 * AT_VP, AT_V0 = 2 * AT_KB;
DEV float at_max32(const f32x16& s0, const f32x16& s1) {
    float m0 = __builtin_fmaxf(__builtin_fmaxf(s0[0], s0[1]), s0[2]), m1 = __builtin_fmaxf(__builtin_fmaxf(s1[0], s1[1]), s1[2]);
    m0 = __builtin_fmaxf(__builtin_fmaxf(m0, s0[3]), s0[4]); m1 = __builtin_fmaxf(__builtin_fmaxf(m1, s1[3]), s1[4]);
    m0 = __builtin_fmaxf(__builtin_fmaxf(m0, s0[5]), s0[6]); m1 = __builtin_fmaxf(__builtin_fmaxf(m1, s1[5]), s1[6]);
    m0 = __builtin_fmaxf(__builtin_fmaxf(m0, s0[7]), s0[8]); m1 = __builtin_fmaxf(__builtin_fmaxf(m1, s1[7]), s1[8]);
    m0 = __builtin_fmaxf(__builtin_fmaxf(m0, s0[9]), s0[10]); m1 = __builtin_fmaxf(__builtin_fmaxf(m1, s1[9]), s1[10]);
    m0 = __builtin_fmaxf(__builtin_fmaxf(m0, s0[11]), s0[12]); m1 = __builtin_fmaxf(__builtin_fmaxf(m1, s1[11]), s1[12]);
    m0 = __builtin_fmaxf(__builtin_fmaxf(m0, s0[13]), s0[14]); m1 = __builtin_fmaxf(__builtin_fmaxf(m1, s1[13]), s1[14]);
    return __builtin_fmaxf(__builtin_fmaxf(m0, s0[15]), __builtin_fmaxf(m1, s1[15]));
}
DEV void attn_unit(const Params& p, unsigned char* lds, int u) {
    const int tid = otid(), lane = tid & 63, wid = tid >> 6, l32 = lane & 31, hi = lane >> 5;
    const bf16_t* Q = (const bf16_t*)(p.ws + OFF_OV + OV_Q); const bf16_t* KN = (const bf16_t*)(p.ws + OFF_OV + OV_KN); const bf16_t* VT = (const bf16_t*)(p.ws + OFF_OV + OV_VT);
    const bf16_t* P = (const bf16_t*)p.out; bf16_t* MIX = (bf16_t*)(p.ws + OFF_HN); const f32x2* rope = (const f32x2*)(p.ws + OFF_ROPE);
    const bool isctx = u >= 512; int b, h, qrow0, NT;
    if (!isctx) { b = u >> 8; h = (u >> 5) & 7; qrow0 = b * RB + NCTX + (u & 31) * 256; NT = 132; } else { const int v = u - 512; b = v >> 3; h = v & 7; qrow0 = b * RB; NT = 4; }
    const int krow0 = b * RB; const int qrow = qrow0 + wid * 32 + l32;
    bf16x8 qf[6];
    { const bf16_t* qp = Q + (size_t)qrow * 768 + h * 96 + hi * 8;
#pragma unroll
      for (int d0 = 0; d0 < 6; ++d0) qf[d0] = *(const bf16x8*)(qp + d0 * 16);
      if (!isctx) { const f32x2* rp = rope + (size_t)(qrow - (b * RB + NCTX)) * 16 + hi * 8;
#pragma unroll
          for (int j = 0; j < 8; ++j) { const f32x2 cs = rp[j]; const float x1 = bf2f((unsigned short)qf[4][j]), x2 = bf2f((unsigned short)qf[5][j]);
              qf[4][j] = (short)f2bf(x1 * cs.x - x2 * cs.y); qf[5][j] = (short)f2bf(x2 * cs.x + x1 * cs.y); } } }
    const bf16_t* sp[3]; int sstep[3], lo[3];
#pragma unroll
    for (int k = 0; k < 2; ++k) { const int c = tid + k * 512; const int key = c / 12, part = c - key * 12; lo[k] = key * AT_KP + part * 16;
        if (part < 8) { sp[k] = KN + (size_t)(krow0 + key) * 512 + h * 64 + part * 8; sstep[k] = 64 * 512; } else { sp[k] = P + (size_t)(krow0 + key) * INW + 1408 + (part - 8) * 8; sstep[k] = 64 * INW; } }
    { const int dv = tid >> 3, kc = tid & 7; lo[2] = dv * AT_VP + kc * 16; sp[2] = VT + (size_t)(h * 64 + dv) * R + krow0 + kc * 8; sstep[2] = 64; }
    const bool hasK2 = tid < 256;
    u32x4 st[3];
#define AT_GLOADK() do { st[0] = *(const u32x4*)sp[0]; sp[0] += sstep[0]; if (hasK2) { st[1] = *(const u32x4*)sp[1]; sp[1] += sstep[1]; } } while (0)
#define AT_GLOADV() do { st[2] = *(const u32x4*)sp[2]; sp[2] += sstep[2]; } while (0)
#define AT_LSTOREK(buf) do { *(u32x4*)((buf) + lo[0]) = st[0]; if (hasK2) *(u32x4*)((buf) + lo[1]) = st[1]; } while (0)
#define AT_LSTOREV(buf) do { unsigned char* d_ = (buf) + lo[2]; *(u32x2*)d_ = (u32x2){st[2].x, st[2].y}; *(u32x2*)(d_ + 8) = (u32x2){st[2].z, st[2].w}; } while (0)
#define AT_SB() __builtin_amdgcn_sched_barrier(0)
    f32x16 o0, o1, sa0, sa1, sb0, sb1, negm;
#pragma unroll
    for (int r = 0; r < 16; ++r) { o0[r] = 0.f; o1[r] = 0.f; sa0[r] = 0.f; sa1[r] = 0.f; negm[r] = 0.f; }
    float mrun = 0.f, lsum = 0.f;
    __syncthreads();
    AT_GLOADK(); AT_GLOADV(); AT_LSTOREK(lds); AT_LSTOREV(lds + AT_V0);
    AT_GLOADK(); AT_LSTOREK(lds + AT_KB);
    __syncthreads();
    { const unsigned char* ka = lds + l32 * AT_KP + hi * 16;
#pragma unroll
      for (int d0 = 0; d0 < 6; ++d0) { const bf16x8 a0 = *(const bf16x8*)(ka + d0 * 32), a1 = *(const bf16x8*)(ka + 32 * AT_KP + d0 * 32);
          sa0 = __builtin_amdgcn_mfma_f32_32x32x16_bf16(a0, qf[d0], sa0, 0, 0, 0); sa1 = __builtin_amdgcn_mfma_f32_32x32x16_bf16(a1, qf[d0], sa1, 0, 0, 0); } }
#define AT_STEP(SA0, SA1, SB0, SB1, tt) do { \
        const int t_ = (tt); const bool nxt_ = t_ + 1 < NT; \
        const unsigned char* kb_ = lds + ((t_ + 1) & 1) * AT_KB; const unsigned char* vb_ = lds + AT_V0 + (t_ & 1) * AT_VBS; \
        if (t_ + 2 < NT) AT_GLOADK(); \
        if (nxt_) AT_GLOADV(); \
        bf16x8 kfr[12]; u32x2 vfr[16]; \
        { const unsigned char* ka = kb_ + l32 * AT_KP + hi * 16; \
          _Pragma("unroll") for (int d0 = 0; d0 < 6; ++d0) { kfr[2 * d0] = *(const bf16x8*)(ka + d0 * 32); kfr[2 * d0 + 1] = *(const bf16x8*)(ka + 32 * AT_KP + d0 * 32); } } \
        { const float mx = mxc; \
          if (t_ == 0 || __any(mx > 8.0f)) { \
              const float rm = fmaxf(mx, __shfl_xor(mx, 32)); const float delta = (t_ == 0) ? rm : fmaxf(rm, 0.f); const float alpha = (t_ == 0) ? 1.0f : __builtin_amdgcn_exp2f(-delta); \
              mrun += delta; \
              _Pragma("unroll") for (int r = 0; r < 16; ++r) { SA0[r] -= delta; SA1[r] -= delta; o0[r] *= alpha; o1[r] *= alpha; } \
              lsum *= alpha; { const float nm = -mrun; _Pragma("unroll") for (int r = 0; r < 16; ++r) negm[r] = nm; } } } \
        float ls0 = 0.f, ls1 = 0.f; \
        AT_SB(); \
        _Pragma("unroll") for (int i = 0; i < 8; ++i) { \
            if (i == 0) SB0 = __builtin_amdgcn_mfma_f32_32x32x16_bf16(kfr[0], qf[0], negm, 0, 0, 0); else if (i == 1) SB1 = __builtin_amdgcn_mfma_f32_32x32x16_bf16(kfr[1], qf[0], negm, 0, 0, 0); \
            else if (i & 1) SB1 = __builtin_amdgcn_mfma_f32_32x32x16_bf16(kfr[i], qf[i >> 1], SB1, 0, 0, 0); else SB0 = __builtin_amdgcn_mfma_f32_32x32x16_bf16(kfr[i], qf[i >> 1], SB0, 0, 0, 0); \
            SA0[2 * i] = __builtin_amdgcn_exp2f(SA0[2 * i]); SA0[2 * i + 1] = __builtin_amdgcn_exp2f(SA0[2 * i + 1]); SA1[2 * i] = __builtin_amdgcn_exp2f(SA1[2 * i]); SA1[2 * i + 1] = __builtin_amdgcn_exp2f(SA1[2 * i + 1]); \
            ls0 += SA0[2 * i] + SA0[2 * i + 1]; ls1 += SA1[2 * i] + SA1[2 * i + 1]; \
            AT_SB(); } \
        { const unsigned char* va = vb_ + l32 * AT_VP + hi * 8; \
          _Pragma("unroll") for (int kj = 0; kj < 4; ++kj) { const unsigned char* vp = va + kj * 32; \
              vfr[4 * kj + 0] = *(const u32x2*)vp; vfr[4 * kj + 1] = *(const u32x2*)(vp + 16); vfr[4 * kj + 2] = *(const u32x2*)(vp + 32 * AT_VP); vfr[4 * kj + 3] = *(const u32x2*)(vp + 32 * AT_VP + 16); } } \
        bf16x8 pb[4]; \
        _Pragma("unroll") for (int i = 8; i < 12; ++i) { const int kj = i - 8; const int jp = kj & 1; \
            if (i & 1) SB1 = __builtin_amdgcn_mfma_f32_32x32x16_bf16(kfr[i], qf[i >> 1], SB1, 0, 0, 0); else SB0 = __builtin_amdgcn_mfma_f32_32x32x16_bf16(kfr[i], qf[i >> 1], SB0, 0, 0, 0); \
            if (kj < 2) pb[kj] = pack8(SA0[8 * jp + 0], SA0[8 * jp + 1], SA0[8 * jp + 2], SA0[8 * jp + 3], SA0[8 * jp + 4], SA0[8 * jp + 5], SA0[8 * jp + 6], SA0[8 * jp + 7]); \
            else        pb[kj] = pack8(SA1[8 * jp + 0], SA1[8 * jp + 1], SA1[8 * jp + 2], SA1[8 * jp + 3], SA1[8 * jp + 4], SA1[8 * jp + 5], SA1[8 * jp + 6], SA1[8 * jp + 7]); \
            AT_SB(); } \
        lsum += ls0 + ls1; \
        float mq0 = SB0[0], mq1 = SB1[0]; \
        _Pragma("unroll") for (int kj = 0; kj < 4; ++kj) { \
            const bf16x8 A0 = __builtin_bit_cast(bf16x8, (u32x4){vfr[4 * kj].x, vfr[4 * kj].y, vfr[4 * kj + 1].x, vfr[4 * kj + 1].y}); \
            const bf16x8 A1 = __builtin_bit_cast(bf16x8, (u32x4){vfr[4 * kj + 2].x, vfr[4 * kj + 2].y, vfr[4 * kj + 3].x, vfr[4 * kj + 3].y}); \
            o0 = __builtin_amdgcn_mfma_f32_32x32x16_bf16(A0, pb[kj], o0, 0, 0, 0); o1 = __builtin_amdgcn_mfma_f32_32x32x16_bf16(A1, pb[kj], o1, 0, 0, 0); \
            mq0 = __builtin_fmaxf(__builtin_fmaxf(mq0, SB0[4 * kj]), SB0[4 * kj + 1]); mq1 = __builtin_fmaxf(__builtin_fmaxf(mq1, SB1[4 * kj]), SB1[4 * kj + 1]); \
            mq0 = __builtin_fmaxf(__builtin_fmaxf(mq0, SB0[4 * kj + 2]), SB0[4 * kj + 3]); mq1 = __builtin_fmaxf(__builtin_fmaxf(mq1, SB1[4 * kj + 2]), SB1[4 * kj + 3]); \
            AT_SB(); } \
        mxc = __builtin_fmaxf(mq0, mq1);            \
        if (t_ + 2 < NT) AT_LSTOREK(lds + (t_ & 1) * AT_KB); \
        if (nxt_) AT_LSTOREV(lds + AT_V0 + ((t_ + 1) & 1) * AT_VBS); \
        __syncthreads(); \
    } while (0)
    float mxc = at_max32(sa0, sa1);
    for (int t = 0; t < NT; t += 2) { AT_STEP(sa0, sa1, sb0, sb1, t); AT_STEP(sb0, sb1, sa0, sa1, t + 1); }
    lsum += __shfl_xor(lsum, 32);
    const float inv = 1.0f / lsum;
    bf16_t* op = MIX + (size_t)qrow * 1024 + 256 + h * 64 + 4 * hi;
#pragma unroll
    for (int g4 = 0; g4 < 4; ++g4) { u32x2 w0, w1; w0.x = pk2(o0[4 * g4] * inv, o0[4 * g4 + 1] * inv); w0.y = pk2(o0[4 * g4 + 2] * inv, o0[4 * g4 + 3] * inv);
        w1.x = pk2(o1[4 * g4] * inv, o1[4 * g4 + 1] * inv); w1.y = pk2(o1[4 * g4 + 2] * inv, o1[4 * g4 + 3] * inv);
        *(u32x2*)(op + 8 * g4) = w0; *(u32x2*)(op + 32 + 8 * g4) = w1; }
#undef AT_GLOADK
#undef AT_GLOADV
#undef AT_LSTOREK
#undef AT_LSTOREV
#undef AT_STEP
#undef AT_SB
}

constexpr int RT_VP = 264, RT_SP = 144, RT_VB = 2 * 64 * RT_VP;
DEV void retout_unit(const Params& p, int l, unsigned char* lds, int u) {
    const int tid = otid(), lane = tid & 63, wid = tid >> 6, l32 = lane & 31, hi = lane >> 5;
    const int gc = u >> 1, hp = u & 1; const int cb = gc % 66; const bool lat = cb >= 2; const int t0 = (cb - 2) * 128; const int r0 = gc * 128;
    const bf16_t* P = (const bf16_t*)p.out; bf16_t* MIX = (bf16_t*)(p.ws + OFF_HN); const f32x2* rope = (const f32x2*)(p.ws + OFF_ROPE);
    const float* SIN = (const float*)(p.ws + OFF_OV + OV_SIN);
    bf16_t* VTl = (bf16_t*)lds; bf16_t* STl = (bf16_t*)(lds + RT_VB);
    __syncthreads();
    for (int task = tid; task < 2048; task += NWG_T) { const int hh = task >> 10, key = (task >> 3) & 127, ch = task & 7;
        const bf16x8 v = *(const bf16x8*)(P + (size_t)(r0 + key) * INW + 256 + (2 * hp + hh) * 64 + ch * 8);
#pragma unroll
        for (int j = 0; j < 8; ++j) VTl[(hh * 64 + ch * 8 + j) * (RT_VP / 2) + key] = (bf16_t)v[j]; }
    for (int task = tid; task < 8192; task += NWG_T) { const int dv = task & 63, k = (task >> 6) & 31, dir = (task >> 11) & 1, hh = task >> 12;
        STl[(hh * 64 + dv) * (RT_SP / 2) + dir * 32 + k] = (bf16_t)f2bf(SIN[((size_t)(gc * 4 + 2 * hp + hh) * 2 + dir) * 2048 + k * 64 + dv]); }
    __syncthreads();
    const int hh = wid >> 2, h = 2 * hp + hh, qblk = wid & 3; const int n = 32 * qblk + l32; const int rq = r0 + n;
    const float lf = log2_sigmoid(p.ret_decay_f[l * 4 + h]), lb = log2_sigmoid(p.ret_decay_b[l * 4 + h]);
    float qv0[8], qv1[8]; bf16x8 qf0, qf1;
    { const bf16_t* qp = P + (size_t)rq * INW + h * 32 + 8 * hi; const bf16x8 a = *(const bf16x8*)qp, c2 = *(const bf16x8*)(qp + 16);
#pragma unroll
      for (int j = 0; j < 8; ++j) { float x1 = bf2f((unsigned short)a[j]), x2 = bf2f((unsigned short)c2[j]);
          if (lat) { const f32x2 cs = rope[(size_t)(t0 + n) * 16 + 8 * hi + j]; const float y1 = x1 * cs.x - x2 * cs.y, y2 = x2 * cs.x + x1 * cs.y; x1 = y1; x2 = y2; }
          qv0[j] = x1; qv1[j] = x2; }
      qf0 = pack8(qv0[0], qv0[1], qv0[2], qv0[3], qv0[4], qv0[5], qv0[6], qv0[7]); qf1 = pack8(qv1[0], qv1[1], qv1[2], qv1[3], qv1[4], qv1[5], qv1[6], qv1[7]); }
    f32x16 o0, o1;
#pragma unroll
    for (int r = 0; r < 16; ++r) { o0[r] = 0.f; o1[r] = 0.f; }
    const unsigned char* vbase = (const unsigned char*)VTl + (size_t)(hh * 64 + l32) * RT_VP + hi * 8;
#pragma unroll
    for (int kb = 0; kb < 4; ++kb) {
        bf16x8 kf0, kf1;
        { const int key = 32 * kb + l32; const bf16_t* kp = P + (size_t)(r0 + key) * INW + 128 + h * 32 + 8 * hi; const bf16x8 a = *(const bf16x8*)kp, c2 = *(const bf16x8*)(kp + 16);
          float y1[8], y2[8];
#pragma unroll
          for (int j = 0; j < 8; ++j) { float x1 = bf2f((unsigned short)a[j]), x2 = bf2f((unsigned short)c2[j]);
              if (lat) { const f32x2 cs = rope[(size_t)(t0 + key) * 16 + 8 * hi + j]; const float z1 = x1 * cs.x - x2 * cs.y, z2 = x2 * cs.x + x1 * cs.y; x1 = z1; x2 = z2; }
              y1[j] = x1 * 0.17677669529663687f; y2[j] = x2 * 0.17677669529663687f; }
          kf0 = pack8(y1[0], y1[1], y1[2], y1[3], y1[4], y1[5], y1[6], y1[7]); kf1 = pack8(y2[0], y2[1], y2[2], y2[3], y2[4], y2[5], y2[6], y2[7]); }
        f32x16 s;
#pragma unroll
        for (int r = 0; r < 16; ++r) s[r] = 0.f;
        s = __builtin_amdgcn_mfma_f32_32x32x16_bf16(kf0, qf0, s, 0, 0, 0); s = __builtin_amdgcn_mfma_f32_32x32x16_bf16(kf1, qf1, s, 0, 0, 0);
#pragma unroll
        for (int r = 0; r < 16; ++r) { const int m = 32 * kb + crow(r, hi); const int dl = n - m; const float e = dl >= 0 ? lf * (float)dl : lb * (float)(-dl); s[r] *= __builtin_amdgcn_exp2f(e); }
#pragma unroll
        for (int jp = 0; jp < 2; ++jp) { const bf16x8 pb = pack8(s[8 * jp + 0], s[8 * jp + 1], s[8 * jp + 2], s[8 * jp + 3], s[8 * jp + 4], s[8 * jp + 5], s[8 * jp + 6], s[8 * jp + 7]);
            const unsigned char* vp = vbase + (32 * kb + 16 * jp) * 2;
            const u32x2 a00 = *(const u32x2*)vp, a01 = *(const u32x2*)(vp + 16), a10 = *(const u32x2*)(vp + 32 * RT_VP), a11 = *(const u32x2*)(vp + 32 * RT_VP + 16);
            const bf16x8 A0 = __builtin_bit_cast(bf16x8, (u32x4){a00.x, a00.y, a01.x, a01.y}), A1 = __builtin_bit_cast(bf16x8, (u32x4){a10.x, a10.y, a11.x, a11.y});
            o0 = __builtin_amdgcn_mfma_f32_32x32x16_bf16(A0, pb, o0, 0, 0, 0); o1 = __builtin_amdgcn_mfma_f32_32x32x16_bf16(A1, pb, o1, 0, 0, 0); }
    }
    { const float df = __builtin_amdgcn_exp2f(lf * (float)(n + 1)), db = __builtin_amdgcn_exp2f(lb * (float)(128 - n));
      const unsigned char* sbase = (const unsigned char*)STl + (size_t)(hh * 64 + l32) * RT_SP + hi * 16;
#pragma unroll
      for (int ks = 0; ks < 4; ++ks) { const float dd = ks < 2 ? df : db;
          const bf16x8 qb = (ks & 1) ? pack8(qv1[0] * dd, qv1[1] * dd, qv1[2] * dd, qv1[3] * dd, qv1[4] * dd, qv1[5] * dd, qv1[6] * dd, qv1[7] * dd)
                                     : pack8(qv0[0] * dd, qv0[1] * dd, qv0[2] * dd, qv0[3] * dd, qv0[4] * dd, qv0[5] * dd, qv0[6] * dd, qv0[7] * dd);
          const bf16x8 A0 = *(const bf16x8*)(sbase + ks * 32), A1 = *(const bf16x8*)(sbase + 32 * RT_SP + ks * 32);
          o0 = __builtin_amdgcn_mfma_f32_32x32x16_bf16(A0, qb, o0, 0, 0, 0); o1 = __builtin_amdgcn_mfma_f32_32x32x16_bf16(A1, qb, o1, 0, 0, 0); } }
    float ssq = 0.f;
#pragma unroll
    for (int r = 0; r < 16; ++r) ssq += o0[r] * o0[r] + o1[r] * o1[r];
    ssq += __shfl_xor(ssq, 32);
    const float rstd = rsqrtf(ssq * (1.f / 64.f) + EPS);
    const bf16_t* gp = P + (size_t)rq * INW + 512 + h * 64 + 4 * hi; bf16_t* op = MIX + (size_t)rq * 1024 + h * 64 + 4 * hi;
#pragma unroll
    for (int g4 = 0; g4 < 4; ++g4) { const u32x2 ga = *(const u32x2*)(gp + 8 * g4), gb = *(const u32x2*)(gp + 32 + 8 * g4);
        u32x2 w0, w1;
        w0.x = pk2(o0[4 * g4] * rstd * siluf(bf2f(ga.x & 0xffff)), o0[4 * g4 + 1] * rstd * siluf(bf2f(ga.x >> 16))); w0.y = pk2(o0[4 * g4 + 2] * rstd * siluf(bf2f(ga.y & 0xffff)), o0[4 * g4 + 3] * rstd * siluf(bf2f(ga.y >> 16)));
        w1.x = pk2(o1[4 * g4] * rstd * siluf(bf2f(gb.x & 0xffff)), o1[4 * g4 + 1] * rstd * siluf(bf2f(gb.x >> 16))); w1.y = pk2(o1[4 * g4 + 2] * rstd * siluf(bf2f(gb.y & 0xffff)), o1[4 * g4 + 3] * rstd * siluf(bf2f(gb.y >> 16)));
        *(u32x2*)(op + 8 * g4) = w0; *(u32x2*)(op + 32 + 8 * g4) = w1; }
}

DEV void phase_ffn_fixup(const Params& p, int l) {
    const float* EDGE = (const float*)(p.ws + OFF_EDGE); bf16_t* ACT = (bf16_t*)(p.ws + OFF_OV);
    const float* cw = p.conv_w + (size_t)l * 3 * 5632; const float* cbv = p.conv_b + (size_t)l * 5632;
    for (int idx = blockIdx.x * NWG_T + otid(); idx < 66 * 2 * 704; idx += gridDim.x * NWG_T) {
        const int ch4 = idx % 704, rest = idx / 704; const int which = rest & 1, pm = rest >> 1; const int jj = pm % 33;
        if (l == 1 && jj == 0) continue;
        const int ch = 4 * ch4, pn = ch >> 7, c = ch & 127;
        const bool sstart = jj <= 1, send = (jj == 0) || (jj == 32);
        const f32x4 zz = {0.f, 0.f, 0.f, 0.f};
#define EDG(tile, k, half) (*(const f32x4*)(EDGE + ((size_t)((tile) * 4 + (k)) * 22 + pn) * 256 + (half) * 128 + c))
        f32x4 ua, ub, ca, cb2, da, db;
        if (which == 0) { ua = sstart ? zz : EDG(pm - 1, 3, 0); ub = sstart ? zz : EDG(pm - 1, 3, 1); ca = EDG(pm, 0, 0); cb2 = EDG(pm, 0, 1); da = EDG(pm, 1, 0); db = EDG(pm, 1, 1); }
        else { ua = EDG(pm, 2, 0); ub = EDG(pm, 2, 1); ca = EDG(pm, 3, 0); cb2 = EDG(pm, 3, 1); da = send ? zz : EDG(pm + 1, 0, 0); db = send ? zz : EDG(pm + 1, 0, 1); }
#undef EDG
        const f32x4 wa0 = *(const f32x4*)(cw + ch), wa1 = *(const f32x4*)(cw + 5632 + ch), wa2 = *(const f32x4*)(cw + 2 * 5632 + ch), ba = *(const f32x4*)(cbv + ch);
        const f32x4 wb0 = *(const f32x4*)(cw + DFF + ch), wb1 = *(const f32x4*)(cw + 5632 + DFF + ch), wb2 = *(const f32x4*)(cw + 2 * 5632 + DFF + ch), bb = *(const f32x4*)(cbv + DFF + ch);
        const f32x4 xa = wa0 * ua + wa1 * ca + wa2 * da + ba, xb = wb0 * ub + wb1 * cb2 + wb2 * db + bb;
        u32x2 w; w.x = pk2(siluf(xa.x) * xb.x, siluf(xa.y) * xb.y); w.y = pk2(siluf(xa.z) * xb.z, siluf(xa.w) * xb.w);
        *(u32x2*)(ACT + (size_t)(pm * 256 + (which ? 255 : 0)) * DFF + ch) = w;
    }
}

#define RLX_AGENT __ATOMIC_RELAXED, __HIP_MEMORY_SCOPE_AGENT
#define XB_TMO      128
#define XB_XCNT(j)  (256  + 64 * (j))
#define XB_XSUB(j)  (1280 + 64 * (j))
#define XB_XGEN(j)  (2304 + 64 * (j))
#define XB_TOP      3328
#define XB_TOPGEN   3392
#define XCD_BAR_WORDS 3456
#define XB_SPIN_CAP (1u << 18)

__device__ __forceinline__ unsigned xb_ld(unsigned* p)              { return __hip_atomic_load(p, __ATOMIC_RELAXED, __HIP_MEMORY_SCOPE_AGENT); }
__device__ __forceinline__ unsigned xb_add(unsigned* p, unsigned v) { return __hip_atomic_fetch_add(p, v, __ATOMIC_RELAXED, __HIP_MEMORY_SCOPE_AGENT); }
__device__ __forceinline__ unsigned xb_xcc_id() { return (unsigned)__builtin_amdgcn_s_getreg((3 << 11) | 20) & 0xFu; }
#define XB_SPIN(cond, bar) do { unsigned _sp = 0; while (cond) { __builtin_amdgcn_s_sleep(1); \
    if ((++_sp & 255u) == 0u) { if (xb_ld(&(bar)[XB_TMO])) break; if (_sp > XB_SPIN_CAP) { atomicAdd(&(bar)[XB_TMO], 1u); break; } } } } while (0)

struct XcdBarrier {
    unsigned* bar; unsigned x;
    volatile LAS unsigned* st;
};

__device__ __forceinline__ XcdBarrier xcd_barrier_post(unsigned* bar, volatile LAS unsigned* st) {
    XcdBarrier b; b.bar = bar; b.x = xb_xcc_id(); b.st = st;
    if (threadIdx.x == 0) (void)xb_add(&bar[XB_XCNT(b.x)], 1u);
    return b;
}
__device__ __forceinline__ void xcd_barrier_complete(unsigned* bar, unsigned x, unsigned& nloc, unsigned& nx) {
    const unsigned G = gridDim.x * gridDim.y * gridDim.z;
    unsigned sum, cnt, mine, sp = 0u;
    for (;;) {
        sum = 0u; cnt = 0u; mine = 0u;
#pragma unroll
        for (unsigned j = 0; j < 16; ++j) { const unsigned c = xb_ld(&bar[XB_XCNT(j)]); sum += c; cnt += (c > 0u) ? 1u : 0u; mine = (j == x) ? c : mine; }
        if (sum == G) break;
        __builtin_amdgcn_s_sleep(1);
        if ((++sp & 255u) == 0u) { if (xb_ld(&bar[XB_TMO])) break; if (sp > XB_SPIN_CAP) { atomicAdd(&bar[XB_TMO], 1u); break; } }
    }
    nloc = mine > 0u ? mine : 1u; nx = cnt > 0u ? cnt : 1u;
}

__device__ __forceinline__ void xcd_barrier(const XcdBarrier& b) {
    asm volatile("s_waitcnt vmcnt(0)" ::: "memory");
    __syncthreads();
    if (threadIdx.x == 0) {
        unsigned* bar = b.bar;
        __builtin_amdgcn_s_waitcnt(0);
        unsigned nloc = b.st[0], nx = b.st[1];
        if (nloc == 0u) { xcd_barrier_complete(bar, b.x, nloc, nx); b.st[0] = nloc; b.st[1] = nx; }
        const unsigned old = xb_add(&bar[XB_XSUB(b.x)], 1u);
        const unsigned gen = old / nloc;
        if (old + 1u == (gen + 1u) * nloc) {
            __builtin_amdgcn_fence(__ATOMIC_RELEASE, "agent");
            asm volatile("s_waitcnt vmcnt(0)" ::: "memory");
            const unsigned og = xb_add(&bar[XB_TOP], 1u);
            const unsigned tg = og / nx;
            if (og + 1u == (tg + 1u) * nx) xb_add(&bar[XB_TOPGEN], 1u);
            else XB_SPIN(xb_ld(&bar[XB_TOPGEN]) == tg, bar);
            __builtin_amdgcn_fence(__ATOMIC_ACQUIRE, "agent");
            xb_add(&bar[XB_XGEN(b.x)], 1u);
            asm volatile("s_waitcnt vmcnt(0)" ::: "memory");
        } else {
            XB_SPIN(xb_ld(&bar[XB_XGEN(b.x)]) == gen, bar);
            __builtin_amdgcn_fence(__ATOMIC_ACQUIRE, "agent");
            asm volatile("s_waitcnt vmcnt(0)" ::: "memory");
        }
    }
    __syncthreads();
}


constexpr size_t OFF_CTL = 250000128; constexpr int CTL_BYTES = 16384;
#if defined(__HIP_DEVICE_COMPILE__)
#define KP() const __attribute__((address_space(4))) Params* kp_ = (const __attribute__((address_space(4))) Params*)__builtin_amdgcn_kernarg_segment_ptr(); asm volatile("" : "+s"(kp_)); const Params p = *kp_; \
    bf16_t* HN = (bf16_t*)(p.ws + OFF_HN); bf16_t* P = (bf16_t*)p.out; float* X = (float*)(p.ws + OFF_X); (void)HN; (void)P; (void)X
#else
#define KP() const Params p = p_arg; bf16_t* HN = (bf16_t*)(p.ws + OFF_HN); bf16_t* P = (bf16_t*)p.out; float* X = (float*)(p.ws + OFF_X); (void)HN; (void)P; (void)X
#endif
#define WL() const bf16_t* wl = (const bf16_t*)(p.ws + OFF_W) + (size_t)l * W_LAYER; const float* modv = (const float*)(p.ws + OFF_MOD) + (size_t)l * 3 * 6144; (void)wl; (void)modv
#ifndef DUPM
#define DUPM 0
#endif
#define REP(bit) for (int rep_ = 0; rep_ < (((DUPM) >> (bit)) & 1) + 1; ++rep_)
constexpr int PH_PER_LAYER = 10, N_PHASES = 2 + 2 * PH_PER_LAYER;
__global__ void __launch_bounds__(512, 2) mk_fwd(Params p_arg) {
    extern __shared__ __attribute__((aligned(16))) unsigned char lds[];
    cg::grid_group grid = cg::this_grid();
    const int G = gridDim.x, bx = blockIdx.x; const int vcu = (G % 8 == 0) ? (bx % 8) * (G / 8) + bx / 8 : bx;
    LAS unsigned char* ldsl = (LAS unsigned char*)lds;
    const int ph_lo = p_arg.ph_lo, ph_hi = p_arg.ph_hi;
    volatile LAS unsigned* misc = (volatile LAS unsigned*)(ldsl + (LDS_BYTES - 64));
    { const int t0_ = otid(); if (t0_ < 16) misc[t0_] = 0u; }
    __syncthreads();
    if (ph_hi - ph_lo > 1) (void)xcd_barrier_post((unsigned*)(p_arg.ws + OFF_CTL), misc);
    for (int ph = ph_lo; ph < ph_hi; ++ph) {
        if (ph == 0) { KP(); phase_prep(p, lds); __syncthreads(); }
        else if (ph == N_PHASES - 1) { KP(); phase_final(p);
#if (DUPM >> 10) & 1
            for (int i = 0; i < 20; ++i) grid.sync();
#endif
        }
        else {
            const int l = (ph - 1) / PH_PER_LAYER, sp = (ph - 1) % PH_PER_LAYER;
            if (sp == 0) { KP(); if (l == 0) REP(9) { phase_prep_weights(p, lds); __syncthreads(); }
                phase_norm(p, l, 0, l == 0, l == 1 ? (const float*)(p.ws + OFF_MOD) + 2 * 6144 + 5120 : nullptr); }
            else if (sp == 1) { KP(); WL(); REP(1) { __syncthreads();
                pg8::Gemm g{HN, wl + W_IN, R, 1792, 1024, 1024, 1024}; pg8::StaticOrder S; S.init(R, 1792, G, bx);
                pg8::EpiStore E{P, INW, INW, 1.0f};
                pg8::gemm_phase<pg8::EpiStore, pg8::StaticOrder, true, true>(ldsl, g, S, E); } }
            else if (sp == 2) { KP(); phase_rowwise(p, l); __syncthreads();
                REP(2) phase_pool(p);
                REP(3) for (int it = bx; it < 528; it += G) states_item(p, l, lds, it); }
            else if (sp == 3) { KP(); WL(); REP(4) { __syncthreads();
                { pg8::Gemm g{P + 768, wl + W_UQ, R, 768, 384, INW, 384}; pg8::StaticOrder S; S.init(R, 768, G, bx);
                  pg8::EpiStore E{(bf16_t*)(p.ws + OFF_OV + OV_Q), 768, 768, 0.14724444f};
                  pg8::gemm_phase<pg8::EpiStore, pg8::StaticOrder, true, true>(ldsl, g, S, E); }
                __syncthreads();
                { pg8::Gemm g{P + 1152, wl + W_KN, R, 512, 256, INW, 256}; pg8::StaticOrder S; S.init(R, 512, G, (bx + 58) % G);
                  pg8::EpiStore E{(bf16_t*)(p.ws + OFF_OV + OV_KN), 512, 512, 1.0f};
                  pg8::gemm_phase<pg8::EpiStore, pg8::StaticOrder, true, true>(ldsl, g, S, E); }
                __syncthreads();
                { pg8::Gemm g{wl + W_V, P + 1152, 512, R, 256, 256, INW}; pg8::StaticOrder S; S.init(512, R, G, (bx + 182) % G);
                  pg8::EpiStore E{(bf16_t*)(p.ws + OFF_OV + OV_VT), R, R, 1.0f};
                  pg8::gemm_phase<pg8::EpiStore, pg8::StaticOrder, true, true>(ldsl, g, S, E); }
                if (bx >= G - 64) scan_threads(p, l, (bx - (G - 64)) * NWG_T + otid()); } }
            else if (sp == 4) { KP();
                REP(5) for (int u = vcu; u < (l == 0 ? 528 : 512); u += G) attn_unit(p, lds, u);
                REP(6) for (int u = G - 1 - bx; u < (l == 0 ? 264 : 256); u += G) retout_unit(p, l, lds, l == 0 ? u : u + 4 * (u >> 7) + 4); }
            else if (sp == 5) { KP(); WL(); __syncthreads();
                { pg8::Gemm g{HN, wl + W_OUT, R, 1024, 1024, 1024, 1024}; pg8::StaticOrder S; S.init(16384, 1024, G, bx, 1);
                  pg8::EpiResid E{X, modv + 2048, 0};
                  pg8::gemm_phase<pg8::EpiResid, pg8::StaticOrder, true, true>(ldsl, g, S, E); }
                if (l == 0 && bx < 32) { __syncthreads(); const int q = bx >> 3;
                  pg8::Gemm g{HN + q * 256, wl + W_OUT + q * 256, 512, 1024, 256, 1024, 1024}; pg8::StaticOrder S; S.init(512, 1024, G, bx & 7, 2);
                  pg8::EpiPart E{(float*)(p.ws + OFF_PART) + (size_t)q * 524288, 0};
                  pg8::gemm_phase<pg8::EpiPart, pg8::StaticOrder, true, true>(ldsl, g, S, E); } }
            else if (sp == 6) { KP(); WL(); phase_norm(p, l, 1, false, l == 0 ? modv + 2 * 6144 + 2048 : nullptr); }
            else if (sp == 7) { KP(); WL(); REP(7) { __syncthreads();
                pg8::Gemm g{HN, wl + W_UP, R, 2 * DFF, 1024, 1024, 1024}; pg8::StaticOrder S; S.init(l == 1 ? 16384 : R, 2 * DFF, G, bx, l == 1 ? 1 : 0);
                pg8::EpiFfn E{(bf16_t*)(p.ws + OFF_OV), (float*)(p.ws + OFF_EDGE), p.conv_w + (size_t)l * 3 * 5632, p.conv_b + (size_t)l * 5632, (LAS float*)(ldsl + 131072)};
                pg8::gemm_phase<pg8::EpiFfn, pg8::StaticOrder, true, true>(ldsl, g, S, E); } }
            else if (sp == 8) { KP(); REP(8) phase_ffn_fixup(p, l); }
            else if (sp == 9) { KP(); WL(); __syncthreads();
                { pg8::Gemm g{(const bf16_t*)(p.ws + OFF_OV), wl + W_DN, R, 1024, DFF, DFF, DFF}; pg8::StaticOrder S; S.init(16384, 1024, G, bx, 1);
                  pg8::EpiResid E{X, modv + 5120, 0};
                  pg8::gemm_phase<pg8::EpiResid, pg8::StaticOrder, true, true>(ldsl, g, S, E); }
                if (l == 0 && bx < 32) { __syncthreads(); const int q = bx >> 3; const int koff = q < 2 ? q * 768 : 1536 + (q - 2) * 640, klen = q < 2 ? 768 : 640;
                  pg8::Gemm g{(const bf16_t*)(p.ws + OFF_OV) + koff, wl + W_DN + koff, 512, 1024, klen, DFF, DFF}; pg8::StaticOrder S; S.init(512, 1024, G, bx & 7, 2);
                  pg8::EpiPart E{(float*)(p.ws + OFF_PART) + (size_t)q * 524288, 0};
                  pg8::gemm_phase<pg8::EpiPart, pg8::StaticOrder, true, true>(ldsl, g, S, E); } }
        }
        if (ph + 1 < ph_hi) {
            if (ph == ph_lo) grid.sync();
            else { KP(); XcdBarrier b; b.bar = (unsigned*)(p.ws + OFF_CTL); b.x = xb_xcc_id(); b.st = misc; xcd_barrier(b); }
        }
    }
}

extern "C" void kernel_launch(void* const* d_in, const int* in_sizes, int n_in, void* d_out, int out_size, void* d_ws, size_t ws_size, hipStream_t stream) {
    static int grid = 0;
    if (grid == 0) {
        if (n_in != 23 || ws_size < WS_NEED) { fprintf(stderr, "kernel_launch: unexpected problem (n_in %d, ws %zu, need %zu)\n", n_in, ws_size, (size_t)WS_NEED); grid = -1; return; }
        int dev = 0, cus = 0, per_cu = 0;
        hipGetDevice(&dev); hipDeviceGetAttribute(&cus, hipDeviceAttributeMultiprocessorCount, dev);
        if (hipFuncSetAttribute((const void*)mk_fwd, hipFuncAttributeMaxDynamicSharedMemorySize, LDS_BYTES) != hipSuccess) { fprintf(stderr, "kernel_launch: hipFuncSetAttribute failed\n"); grid = -1; return; }
        if (hipOccupancyMaxActiveBlocksPerMultiprocessor(&per_cu, (const void*)mk_fwd, 512, LDS_BYTES) != hipSuccess || per_cu < 1) { fprintf(stderr, "kernel_launch: occupancy query says %d\n", per_cu); per_cu = 1; }
        (void)hipGetLastError();
        grid = cus * per_cu; if (grid > 256) grid = 256;
        fprintf(stderr, "kernel_launch: grid %d (cus %d, per_cu %d)\n", grid, cus, per_cu);
    }
    if (grid < 0) return;
    Params p{};
    const float** pp = (const float**)&p;
    for (int i = 0; i < 23; ++i) pp[i] = (const float*)d_in[i];
    p.out = (float*)d_out; p.ws = (unsigned char*)d_ws;
#if MK_MULTI
    for (int ph = 0; ph < N_PHASES; ++ph) { p.ph_lo = ph; p.ph_hi = ph + 1; void* args[] = {&p};
        hipError_t e = hipLaunchCooperativeKernel((void*)mk_fwd, dim3(grid), dim3(512), args, LDS_BYTES, stream);
        if (e != hipSuccess) { fprintf(stderr, "launch %d failed: %s\n", ph, hipGetErrorString(e)); break; } }
#else
    if (hipMemsetAsync((char*)d_ws + OFF_CTL, 0, CTL_BYTES, stream) != hipSuccess) { fprintf(stderr, "kernel_launch: memset of the barrier words failed\n"); return; }
    p.ph_lo = 0; p.ph_hi = N_PHASES; void* args[] = {&p};
    hipError_t e = hipLaunchCooperativeKernel((void*)mk_fwd, dim3(grid), dim3(512), args, LDS_BYTES, stream);
    if (e != hipSuccess) fprintf(stderr, "cooperative launch failed: %s (grid %d)\n", hipGetErrorString(e), grid);
#endif
}
```

```cpp
#include <hip/hip_runtime.h>
#include <hip/hip_cooperative_groups.h>
#include <cstdio>
#include <cstdint>
namespace cg = cooperative_groups;

#ifndef MK_MULTI
#define MK_MULTI 0
#endif

namespace pg8 {
#define PG8_LAS __attribute__((address_space(3)))
typedef unsigned short bf16_t;
typedef short bf16x8 __attribute__((ext_vector_type(8)));
typedef float f32x4 __attribute__((ext_vector_type(4)));
typedef unsigned u32x4 __attribute__((ext_vector_type(4)));
constexpr int BM = 256, BK = 64, HALF = 128, HTB = HALF * BK * 2  , STAGE_BYTES = 8 * HTB, NXCD = 8, WGM = 8;

__host__ __device__ __forceinline__ int lds_byte(int r, int c) { const int st = (r >> 4) * 2 + (c >> 5), rr = r & 15, cc = c & 31, ob = rr * 64 + cc * 2; return st * 1024 + (ob ^ (((ob >> 9) & 1) << 5)); }
__host__ __device__ __forceinline__ void stage_rc(int b, int& R, int& C) { const int st = b / 1024, sb = b % 1024, swz = sb ^ (((sb >> 9) & 1) << 5); R = (st >> 1) * 16 + swz / 64; C = (st & 1) * 32 + (swz % 64) / 2; }
__host__ __device__ __forceinline__ int perm32(int rho) { const int n = rho >> 4, i = rho & 15; return 8 * (i >> 2) + 4 * n + (i & 3); }

struct Unit { int pm, pn; };
struct Gemm { const bf16_t* A; const bf16_t* Bt; int M, N, K, lda, ldb; };

struct StaticOrder {
    int nM, nN, nwg, G, c, skip;
    __host__ __device__ void init(int M, int N, int G_, int c_, int skip_ = 0) { nM = M / BM; nN = N / BM; nwg = nM * nN; G = G_; c = c_; skip = skip_; }
    __host__ __device__ bool next(int i, Unit& u) const {
        const long L = (long)i * G + c; if (L >= nwg) return false;
        int wgid = (int)L; { const int q = nwg / NXCD, r = nwg % NXCD, xcd = wgid % NXCD, off = wgid / NXCD; wgid = (xcd < r ? xcd * (q + 1) : r * (q + 1) + (xcd - r) * q) + off; }
        const int nig = WGM * nN, gid = wgid / nig, fm = gid * WGM, gsz = (nM - fm) < WGM ? (nM - fm) : WGM;
        u.pm = fm + ((wgid % nig) % gsz); u.pn = (wgid % nig) / gsz; if (skip == 1) u.pm += 1 + (u.pm >= 32 ? 1 : 0); else if (skip == 2) u.pm *= 33; return true;
    }
    __device__ __forceinline__ void a_ready(const Unit&) const {}
    __device__ __forceinline__ void done(const Unit&) const {}
};

__device__ __forceinline__ unsigned cvt_pk_bf16(float lo, float hi) { unsigned r; asm volatile("v_cvt_pk_bf16_f32 %0, %1, %2" : "=v"(r) : "v"(lo), "v"(hi)); return r; }

struct EpiStore {
    static constexpr bool PERM = true, AFTER_DRAIN = false;
    bf16_t* O; int ldc; int ncols; float scale;
    __device__ __forceinline__ void operator()(const f32x4 (&acc)[2][2][4][2], const Unit& u, int wr, int wc, int fr, int fq) const {
        const int row0 = u.pm * BM + wr * 64 + fr; const int col0 = u.pn * BM + wc * 32 + 8 * fq;
#pragma unroll
        for (int ai = 0; ai < 2; ++ai)
#pragma unroll
            for (int m = 0; m < 4; ++m) { bf16_t* rowp = O + (size_t)(row0 + ai * HALF + m * 16) * ldc + col0;
#pragma unroll
                for (int bj = 0; bj < 2; ++bj) { if (col0 + bj * HALF < ncols) {
                    f32x4 v0 = acc[ai][bj][m][0] * scale, v1 = acc[ai][bj][m][1] * scale;
                    u32x4 w; w.x = cvt_pk_bf16(v0[0], v0[1]); w.y = cvt_pk_bf16(v0[2], v0[3]); w.z = cvt_pk_bf16(v1[0], v1[1]); w.w = cvt_pk_bf16(v1[2], v1[3]);
                    *(u32x4*)(rowp + bj * HALF) = w; } } }
    }
};
struct EpiResid {
    static constexpr bool PERM = false, AFTER_DRAIN = false;
    float* X; const float* gate; int row_tile0;
    __device__ __forceinline__ void operator()(const f32x4 (&acc)[2][2][4][2], const Unit& u, int wr, int wc, int fr, int fq) const {
        const int tpm = u.pm + row_tile0; const int bb = tpm / 33, jj = tpm - bb * 33; const float* gv = gate + (jj == 0 ? 2 : bb) * 6144;
        const int col0 = u.pn * BM + wc * 32 + 4 * fq;
#pragma unroll
        for (int ai = 0; ai < 2; ++ai)
#pragma unroll
            for (int m = 0; m < 4; ++m) { float* rowp = X + (size_t)(tpm * BM + ai * HALF + wr * 64 + m * 16 + fr) * 1024 + col0;
#pragma unroll
                for (int bj = 0; bj < 2; ++bj) {
#pragma unroll
                    for (int n = 0; n < 2; ++n) { f32x4* q = (f32x4*)(rowp + bj * HALF + n * 16); const f32x4 gq = *(const f32x4*)(gv + col0 + bj * HALF + n * 16); f32x4 xv = *q; xv = xv + gq * acc[ai][bj][m][n]; *q = xv; }
                    asm volatile("" ::: "memory"); } }
    }
};
struct EpiPart {
    static constexpr bool PERM = false, AFTER_DRAIN = false;
    float* out; int accum;
    __device__ __forceinline__ void operator()(const f32x4 (&acc)[2][2][4][2], const Unit& u, int wr, int wc, int fr, int fq) const {
        const int t = u.pm / 33; const int col0 = u.pn * BM + wc * 32 + 4 * fq;
#pragma unroll
        for (int ai = 0; ai < 2; ++ai)
#pragma unroll
            for (int m = 0; m < 4; ++m) { float* rowp = out + (size_t)(t * BM + ai * HALF + wr * 64 + m * 16 + fr) * 1024 + col0;
#pragma unroll
                for (int bj = 0; bj < 2; ++bj) {
#pragma unroll
                    for (int n = 0; n < 2; ++n) { f32x4* q = (f32x4*)(rowp + bj * HALF + n * 16); f32x4 v = acc[ai][bj][m][n]; if (accum) v = v + *q; *q = v; }
                    asm volatile("" ::: "memory"); } }
    }
};
template <int CTRL> __device__ __forceinline__ float dpp0(float x) { return __builtin_bit_cast(float, __builtin_amdgcn_update_dpp(0, __builtin_bit_cast(int, x), CTRL, 0xf, 0xf, true)); }
struct EpiFfn {
    static constexpr bool PERM = false, AFTER_DRAIN = false;
    bf16_t* ACT; float* EDGE; const float* cw; const float* cb; PG8_LAS float* xl;
    __device__ __forceinline__ void operator()(const f32x4 (&acc)[2][2][4][2], const Unit& u, int wr, int wc, int fr, int fq) const {
        PG8_LAS float* FIRST = xl; PG8_LAS float* LAST = xl + 1024;
        const int cb0 = wc * 32 + 4 * fq;
#pragma unroll
        for (int ai = 0; ai < 2; ++ai)
#pragma unroll
            for (int bj = 0; bj < 2; ++bj)
#pragma unroll
                for (int n = 0; n < 2; ++n) { const int col = bj * HALF + cb0 + n * 16;
                    if (fr == 0) *(PG8_LAS f32x4*)(FIRST + (2 * ai + wr) * 256 + col) = acc[ai][bj][0][n];
                    if (fr == 15) *(PG8_LAS f32x4*)(LAST + (2 * ai + wr) * 256 + col) = acc[ai][bj][3][n]; }
        if (wr == 0 && fr < 2) {
#pragma unroll
            for (int bj = 0; bj < 2; ++bj)
#pragma unroll
                for (int n = 0; n < 2; ++n) *(f32x4*)(EDGE + ((size_t)(u.pm * 4 + fr) * 22 + u.pn) * 256 + bj * HALF + cb0 + n * 16) = acc[0][bj][0][n]; }
        if (wr == 1 && fr >= 14) {
#pragma unroll
            for (int bj = 0; bj < 2; ++bj)
#pragma unroll
                for (int n = 0; n < 2; ++n) *(f32x4*)(EDGE + ((size_t)(u.pm * 4 + 2 + (fr - 14)) * 22 + u.pn) * 256 + bj * HALF + cb0 + n * 16) = acc[1][bj][3][n]; }
        asm volatile("s_waitcnt lgkmcnt(0)" ::: "memory"); __builtin_amdgcn_s_barrier(); asm volatile("" ::: "memory");
#pragma unroll
        for (int n = 0; n < 2; ++n) { const int ch0 = u.pn * HALF + cb0 + n * 16;
            f32x4 wa[3], wb[3];
#pragma unroll
            for (int k = 0; k < 3; ++k) { wa[k] = *(const f32x4*)(cw + k * 5632 + ch0); wb[k] = *(const f32x4*)(cw + k * 5632 + 2816 + ch0); }
            const f32x4 ba = *(const f32x4*)(cb + ch0), bb = *(const f32x4*)(cb + 2816 + ch0);
#pragma unroll
            for (int ai = 0; ai < 2; ++ai) { const int g = 2 * ai + wr;
                f32x4 bu[2], bd[2];
#pragma unroll
                for (int bj = 0; bj < 2; ++bj) { const int col = bj * HALF + cb0 + n * 16; const f32x4 zz = {0.f, 0.f, 0.f, 0.f};
                    bu[bj] = g > 0 ? *(const PG8_LAS f32x4*)(LAST + (g - 1) * 256 + col) : zz; bd[bj] = g < 3 ? *(const PG8_LAS f32x4*)(FIRST + (g + 1) * 256 + col) : zz; }
#pragma unroll
                for (int m = 0; m < 4; ++m) { float o[4];
#pragma unroll
                    for (int e = 0; e < 4; ++e) { float up[2], dn[2];
#pragma unroll
                        for (int bj = 0; bj < 2; ++bj) { const float cur = acc[ai][bj][m][n][e];
                            float x = dpp0<0x111>(cur);
                            if (m > 0) x += dpp0<0x10F>(acc[ai][bj][m - 1][n][e]); else x += (fr == 0 ? bu[bj][e] : 0.f);
                            float y = dpp0<0x101>(cur);
                            if (m < 3) y += dpp0<0x11F>(acc[ai][bj][m + 1][n][e]); else y += (fr == 15 ? bd[bj][e] : 0.f);
                            up[bj] = x; dn[bj] = y; }
                        const float ua = wa[0][e] * up[0] + wa[1][e] * acc[ai][0][m][n][e] + wa[2][e] * dn[0] + ba[e];
                        const float ub = wb[0][e] * up[1] + wb[1][e] * acc[ai][1][m][n][e] + wb[2][e] * dn[1] + bb[e];
                        o[e] = ua * __builtin_amdgcn_rcpf(1.0f + __builtin_amdgcn_exp2f(-1.4426950408889634f * ua)) * ub; }
                    typedef unsigned u32x2 __attribute__((ext_vector_type(2))); u32x2 w; w.x = cvt_pk_bf16(o[0], o[1]); w.y = cvt_pk_bf16(o[2], o[3]);
                    *(u32x2*)(ACT + (size_t)(u.pm * BM + ai * HALF + wr * 64 + m * 16 + fr) * 2816 + ch0) = w; } } }
    }
};

template <class Epi, class Sched, bool ALIGN_EPI = false, bool SP2 = false>
__device__ __forceinline__ void gemm_phase(PG8_LAS unsigned char* lds, const Gemm g, const Sched& S, const Epi& E) {
    int tid = threadIdx.x; asm volatile("" : "+v"(tid));
    const int wid = __builtin_amdgcn_readfirstlane(tid >> 6), lane = tid & 63, wr = wid >> 2, wc = wid & 3, fr = lane & 15, fq = lane >> 4;
    int K = g.K; asm volatile("" : "+s"(K));
    const int nt = K / BK;
    unsigned voffA[2], voffB[2];
#pragma unroll
    for (int i = 0; i < 2; ++i) { int R, C; stage_rc(tid * 16 + i * 8192, R, C); const int Rb = Epi::PERM ? ((R & ~31) + perm32(R & 31)) : R;
        voffA[i] = (unsigned)(R * g.lda + C) * 2u; voffB[i] = (unsigned)(Rb * g.ldb + C) * 2u; }
    const size_t kstep = (size_t)(BK * 2);
    const size_t hstepA = (size_t)HALF * g.lda * 2, hstepB = (size_t)HALF * g.ldb * 2;
    const size_t tstepA = 2 * hstepA, tstepB = 2 * hstepB;
    const unsigned ldsw = (unsigned)wid * 1024u;
    const int aoff = lds_byte(wr * 64 + fr, fq * 8), boff = lds_byte(wc * 32 + fr, fq * 8);
#define PG8_SA(b, h) (((b) * 2 + (h)) * HTB)
#define PG8_SB(b, h) ((4 + (b) * 2 + (h)) * HTB)
#define PG8_STAGE(bufoff, gbase, voff) do { _Pragma("unroll") for (int _i = 0; _i < 2; ++_i) \
        __builtin_amdgcn_global_load_lds((const unsigned*)((const char*)(gbase) + (voff)[_i]), (PG8_LAS unsigned*)(lds + (bufoff) + ldsw + _i * 8192), 16, 0, 0); } while (0)
#define PG8_LDA(dst, b, h) do { _Pragma("unroll") for (int m = 0; m < 4; ++m) _Pragma("unroll") for (int k = 0; k < 2; ++k) dst[m][k] = *(const PG8_LAS bf16x8*)(lds + PG8_SA(b, h) + aoff + m * 2048 + k * 1024); } while (0)
#define PG8_LDB(dst, b, h) do { _Pragma("unroll") for (int n = 0; n < 2; ++n) _Pragma("unroll") for (int k = 0; k < 2; ++k) dst[n][k] = *(const PG8_LAS bf16x8*)(lds + PG8_SB(b, h) + boff + n * 2048 + k * 1024); } while (0)
#define PG8_MMA(ai, bj, At, Bt) do { __builtin_amdgcn_s_setprio(1); _Pragma("unroll") for (int m = 0; m < 4; ++m) _Pragma("unroll") for (int n = 0; n < 2; ++n) _Pragma("unroll") for (int k = 0; k < 2; ++k) \
        acc[ai][bj][m][n] = __builtin_amdgcn_mfma_f32_16x16x32_bf16(Bt[n][k], At[m][k], acc[ai][bj][m][n], 0, 0, 0); __builtin_amdgcn_s_setprio(0); } while (0)
#define PG8_WAIT_V(n) asm volatile("s_waitcnt vmcnt(" #n ")" ::: "memory")
#define PG8_WAIT_L(n) asm volatile("s_waitcnt lgkmcnt(" #n ")" ::: "memory")
#define PG8_BAR __builtin_amdgcn_s_barrier()
#define PG8_SCHED __builtin_amdgcn_sched_barrier(0)
    Unit cur, nxt; int ui = 0;
    if (!S.next(0, cur)) return;
    f32x4 acc[2][2][4][2];
#pragma unroll
    for (int a = 0; a < 2; ++a)
#pragma unroll
        for (int b = 0; b < 2; ++b)
#pragma unroll
            for (int m = 0; m < 4; ++m)
#pragma unroll
                for (int n = 0; n < 2; ++n) acc[a][b][m][n] = (f32x4){0.f, 0.f, 0.f, 0.f};
    bf16x8 At[4][2], B0[2][2], B1[2][2];
    const char* cA = (const char*)g.A + (size_t)cur.pm * tstepA; const char* cB = (const char*)g.Bt + (size_t)cur.pn * tstepB;
    S.a_ready(cur);
    if constexpr (SP2) {
        PG8_STAGE(PG8_SB(0, 0), cB, voffB); PG8_STAGE(PG8_SB(0, 1), cB + hstepB, voffB); PG8_STAGE(PG8_SA(0, 0), cA, voffA); PG8_STAGE(PG8_SA(0, 1), cA + hstepA, voffA);
        if (wr == 1) PG8_BAR;
        PG8_WAIT_V(2); PG8_BAR;
        PG8_STAGE(PG8_SB(1, 0), cB + kstep, voffB); PG8_STAGE(PG8_SA(1, 0), cA + kstep, voffA); PG8_STAGE(PG8_SB(1, 1), cB + hstepB + kstep, voffB);
        PG8_WAIT_V(6); PG8_BAR;
    } else {
        PG8_STAGE(PG8_SB(0, 0), cB, voffB); PG8_STAGE(PG8_SA(0, 0), cA, voffA); PG8_STAGE(PG8_SB(0, 1), cB + hstepB, voffB); PG8_STAGE(PG8_SA(0, 1), cA + hstepA, voffA);
        if (wr == 1) PG8_BAR;
        PG8_WAIT_V(4); PG8_BAR;
        PG8_STAGE(PG8_SB(1, 0), cB + kstep, voffB); PG8_STAGE(PG8_SA(1, 0), cA + kstep, voffA); PG8_STAGE(PG8_SB(1, 1), cB + hstepB + kstep, voffB);
        PG8_WAIT_V(6); PG8_BAR;
    }
    for (;;) {
        const bool has_next = S.next(ui + 1, nxt);
        const char* nA = has_next ? (const char*)g.A + (size_t)nxt.pm * tstepA : cA; const char* nB = has_next ? (const char*)g.Bt + (size_t)nxt.pn * tstepB : cB;
        for (int t = 0; t < nt; t += 2) {
            const bool last = (t == nt - 2);
            const char* a1 = cA + (size_t)(t + 1) * kstep;
            const char* a2 = last ? nA : cA + (size_t)(t + 2) * kstep; const char* b2 = last ? nB : cB + (size_t)(t + 2) * kstep;
            const char* a3 = a2 + kstep; const char* b3 = b2 + kstep;
            if (last && has_next) S.a_ready(nxt);
            if constexpr (SP2) {
            PG8_LDB(B0, 0, 0); PG8_LDB(B1, 0, 1); PG8_SCHED; PG8_LDA(At, 0, 0); PG8_STAGE(PG8_SA(1, 1), a1 + hstepA, voffA);
            PG8_WAIT_V(8); PG8_WAIT_L(0); PG8_BAR; PG8_MMA(0, 0, At, B0); PG8_MMA(0, 1, At, B1); PG8_BAR; PG8_SCHED;
            PG8_LDA(At, 0, 1); PG8_STAGE(PG8_SB(0, 0), b2, voffB); PG8_STAGE(PG8_SB(0, 1), b2 + hstepB, voffB); PG8_STAGE(PG8_SA(0, 0), a2, voffA);
            PG8_WAIT_V(8); PG8_WAIT_L(0); PG8_BAR; PG8_MMA(1, 0, At, B0); PG8_MMA(1, 1, At, B1); PG8_BAR; PG8_SCHED;
            PG8_LDB(B0, 1, 0); PG8_LDB(B1, 1, 1); PG8_SCHED; PG8_LDA(At, 1, 0); PG8_STAGE(PG8_SA(0, 1), a2 + hstepA, voffA);
            PG8_WAIT_V(8); PG8_WAIT_L(0); PG8_BAR; PG8_MMA(0, 0, At, B0); PG8_MMA(0, 1, At, B1); PG8_BAR; PG8_SCHED;
            PG8_LDA(At, 1, 1); PG8_STAGE(PG8_SB(1, 0), b3, voffB); PG8_STAGE(PG8_SB(1, 1), b3 + hstepB, voffB); PG8_STAGE(PG8_SA(1, 0), a3, voffA);
            PG8_WAIT_V(8); PG8_WAIT_L(0); PG8_BAR; PG8_MMA(1, 0, At, B0); PG8_MMA(1, 1, At, B1); PG8_BAR; PG8_SCHED;
            } else {
            PG8_LDB(B0, 0, 0); PG8_SCHED; PG8_LDA(At, 0, 0); PG8_STAGE(PG8_SA(1, 1), a1 + hstepA, voffA);
            PG8_WAIT_L(8); PG8_BAR; PG8_WAIT_L(0); PG8_MMA(0, 0, At, B0); PG8_BAR; PG8_SCHED;
            PG8_LDB(B1, 0, 1); PG8_STAGE(PG8_SB(0, 0), b2, voffB);
            PG8_BAR; PG8_WAIT_L(0); PG8_MMA(0, 1, At, B1); PG8_BAR;
            PG8_LDA(At, 0, 1); PG8_STAGE(PG8_SA(0, 0), a2, voffA);
            PG8_BAR; PG8_WAIT_L(0); PG8_MMA(1, 0, At, B0); PG8_BAR; PG8_SCHED;
            PG8_STAGE(PG8_SB(0, 1), b2 + hstepB, voffB);
            PG8_WAIT_V(6); PG8_BAR; PG8_MMA(1, 1, At, B1); PG8_BAR;
            PG8_LDB(B0, 1, 0); PG8_SCHED; PG8_LDA(At, 1, 0); PG8_STAGE(PG8_SA(0, 1), a2 + hstepA, voffA);
            PG8_WAIT_L(8); PG8_BAR; PG8_WAIT_L(0); PG8_MMA(0, 0, At, B0); PG8_BAR; PG8_SCHED;
            PG8_LDB(B1, 1, 1); PG8_STAGE(PG8_SB(1, 0), b3, voffB);
            PG8_BAR; PG8_WAIT_L(0); PG8_MMA(0, 1, At, B1); PG8_BAR;
            PG8_LDA(At, 1, 1); PG8_STAGE(PG8_SA(1, 0), a3, voffA);
            PG8_BAR; PG8_WAIT_L(0); PG8_MMA(1, 0, At, B0); PG8_BAR; PG8_SCHED;
            PG8_STAGE(PG8_SB(1, 1), b3 + hstepB, voffB);
            PG8_WAIT_V(6); PG8_BAR; PG8_MMA(1, 1, At, B1); PG8_BAR;
            }
        }
        if constexpr (ALIGN_EPI) { if (wr == 0) PG8_BAR; }
        if constexpr (!Epi::AFTER_DRAIN) { E(acc, cur, wr, wc, fr, fq); S.done(cur); }
        if (!has_next) break;
#pragma unroll
        for (int a = 0; a < 2; ++a)
#pragma unroll
            for (int b = 0; b < 2; ++b)
#pragma unroll
                for (int m = 0; m < 4; ++m)
#pragma unroll
                    for (int n = 0; n < 2; ++n) acc[a][b][m][n] = (f32x4){0.f, 0.f, 0.f, 0.f};
        cur = nxt; cA = nA; cB = nB; ++ui;
        if constexpr (ALIGN_EPI) { if (wr == 1) PG8_BAR; }
    }
    PG8_WAIT_V(0);
    if constexpr (!ALIGN_EPI) { if (wr == 0) PG8_BAR; }
    PG8_BAR;
    if constexpr (Epi::AFTER_DRAIN) { E.fused(acc, cur, wr, wc, fr, fq, lds, wid, lane); S.done(cur); }
#undef PG8_SA
#undef PG8_SB
#undef PG8_STAGE
#undef PG8_LDA
#undef PG8_LDB
#undef PG8_MMA
#undef PG8_WAIT_V
#undef PG8_WAIT_L
#undef PG8_BAR
#undef PG8_SCHED
}
}

#define DEV __device__ __forceinline__
#define LAS __attribute__((address_space(3)))
typedef unsigned short bf16_t;
typedef short bf16x8 __attribute__((ext_vector_type(8)));
typedef float f32x4 __attribute__((ext_vector_type(4)));
typedef float f32x2 __attribute__((ext_vector_type(2)));
typedef float f32x16 __attribute__((ext_vector_type(16)));
typedef unsigned u32x4 __attribute__((ext_vector_type(4)));
typedef unsigned u32x2 __attribute__((ext_vector_type(2)));

constexpr int R = 16896, RB = 8448, NCTX = 256, TL = 8192, DM = 1024, INW = 1696, DFF = 2816, HFF = 1408;
constexpr int NWG_T = 512;
constexpr float EPS = 1e-6f;
constexpr int LDS_BYTES = 147456;
constexpr size_t OFF_X = 0, OFF_HN = 69206016, OFF_W = 103809024, OFF_MOD = 152174592, OFF_ROPE = 152436736, OFF_OV = 153485312;
constexpr size_t OV_Q = 0, OV_KN = 25952256, OV_VT = 43253760, OV_SLOC = 60555264, OV_SIN = 69206016, OV_U = 0;
constexpr size_t OFF_PART = 250100224;
constexpr size_t OFF_EDGE = 258488832;
constexpr size_t WS_NEED = OFF_EDGE + 5947392;
constexpr size_t W_IN = 0, W_UQ = 1835008, W_KN = 2129920, W_V = 2260992, W_OUT = 2392064, W_UP = 3440640, W_DN = 9207808, W_LAYER = 12091392;

struct Params {
    const float *x, *c, *ctx, *c_ctx, *w_mod, *b_mod, *norm1_g, *w_in, *ret_decay_f, *ret_decay_b, *mla_q_norm_g, *w_uq, *mla_kv_norm_g, *w_ukv,
        *pool_w, *pool_scale, *w_out, *norm2_g, *w_up, *conv_w, *conv_b, *w_down, *final_norm_g;
    float* out; unsigned char* ws; int ph_lo, ph_hi;
};

DEV int otid() { int t = threadIdx.x; asm volatile("" : "+v"(t)); return t; }
DEV float bf2f(unsigned short x) { return __uint_as_float((unsigned)x << 16); }
DEV unsigned f2bf(float f) { unsigned u = __float_as_uint(f); return (u + 0x7fffu + ((u >> 16) & 1u)) >> 16; }
DEV unsigned pk2(float lo, float hi) { return f2bf(lo) | (f2bf(hi) << 16); }
DEV float wave_sum(float v) {
#pragma unroll
    for (int o = 1; o < 64; o <<= 1) v += __shfl_xor(v, o);
    return v;
}
DEV float siluf(float x) { return x * __builtin_amdgcn_rcpf(1.0f + __builtin_amdgcn_exp2f(-1.4426950408889634f * x)); }
DEV int crow(int r, int hi) { return (r & 3) + 8 * (r >> 2) + 4 * hi; }
DEV bf16x8 pack8(float a0, float a1, float a2, float a3, float a4, float a5, float a6, float a7) {
    u32x4 w; w.x = pg8::cvt_pk_bf16(a0, a1); w.y = pg8::cvt_pk_bf16(a2, a3); w.z = pg8::cvt_pk_bf16(a4, a5); w.w = pg8::cvt_pk_bf16(a6, a7);
    return __builtin_bit_cast(bf16x8, w);
}
DEV int row_mi(int r) { const int b = r / RB; const int s = r - b * RB; return s < NCTX ? 2 : b; }

DEV void transpose_item(const float* W, int K, int Nsrc, bf16_t* WT, int n0, int cs, int k0, float* scr, int lane) {
#pragma unroll
    for (int i = 0; i < 32; ++i) { const int kk = 2 * i + (lane >> 5); scr[kk * 33 + (lane & 31)] = cs >= 0 ? W[(size_t)(k0 + kk) * Nsrc + cs + (lane & 31)] : 0.f; }
    asm volatile("s_waitcnt lgkmcnt(0)" ::: "memory");
    const int c = lane & 7;
#pragma unroll
    for (int j = 0; j < 4; ++j) { const int n = (lane >> 3) + 8 * j; const float* s = scr + (8 * c) * 33 + n;
        u32x4 o; o.x = pk2(s[0 * 33], s[1 * 33]); o.y = pk2(s[2 * 33], s[3 * 33]); o.z = pk2(s[4 * 33], s[5 * 33]); o.w = pk2(s[6 * 33], s[7 * 33]);
        *(u32x4*)(WT + (size_t)(n0 + n) * K + k0 + 8 * c) = o; }
    asm volatile("s_waitcnt lgkmcnt(0)" ::: "memory");
}
DEV int map_in(int n0) { return n0 < 1440 ? n0 : (n0 < INW ? -2 : -1); }
DEV int map_kn(int n0) { return (n0 >> 6) * 128 + (n0 & 63); }
DEV int map_v(int n0) { return (n0 >> 6) * 128 + 64 + (n0 & 63); }
DEV int map_up(int n0) { const int pn = n0 >> 8, w = n0 & 255; return w < 128 ? 128 * pn + w : DFF + 128 * pn + (w - 128); }

DEV void phase_prep(const Params& p, unsigned char* lds) {
    const int tid = otid(), lane = tid & 63, wid = tid >> 6;
    unsigned char* ws = p.ws;
    { f32x2* rope = (f32x2*)(ws + OFF_ROPE);
      for (int idx = blockIdx.x * NWG_T + tid; idx < TL * 16; idx += gridDim.x * NWG_T) { const int t = idx >> 4, i = idx & 15; const int pos = i < 8 ? (t >> 6) : (t & 63);
          const float inv = exp2f(-(float)(i & 7) * 0.125f * 13.287712379549449f); const float ang = (float)pos * inv; f32x2 cs; cs.x = __cosf(ang); cs.y = __sinf(ang); rope[idx] = cs; } }
    { float* scv = (float*)lds;
      float* red = scv + 3 * 1024;
      for (int i = tid; i < 3 * 1024; i += NWG_T) { const int v = i >> 10, k = i & 1023; const float cv = v < 2 ? p.c[v * 1024 + k] : p.c_ctx[k]; scv[i] = siluf(cv); }
      __syncthreads();
      float* modv = (float*)(ws + OFF_MOD);
      for (int it = blockIdx.x; it < 192; it += gridDim.x) { const int l = it / 96, col0 = (it % 96) * 64;
          const float* wm = p.w_mod + (size_t)l * 1024 * 6144 + col0 + lane; float a0 = 0.f, a1 = 0.f, a2 = 0.f;
#pragma unroll 16
          for (int k = wid * 128; k < wid * 128 + 128; ++k) { const float w = wm[(size_t)k * 6144]; a0 += scv[k] * w; a1 += scv[1024 + k] * w; a2 += scv[2048 + k] * w; }
          red[(wid * 3 + 0) * 64 + lane] = a0; red[(wid * 3 + 1) * 64 + lane] = a1; red[(wid * 3 + 2) * 64 + lane] = a2;
          __syncthreads();
          if (tid < 192) { const int v = tid >> 6, cl = tid & 63; float s = 0.f;
#pragma unroll
              for (int w = 0; w < 8; ++w) s += red[(w * 3 + v) * 64 + cl];
              modv[((size_t)l * 3 + v) * 6144 + col0 + cl] = s + p.b_mod[l * 6144 + col0 + cl]; }
          __syncthreads(); }
    }
}
DEV void phase_prep_weights(const Params& p, unsigned char* lds) {
    const int tid = otid(), lane = tid & 63, wid = tid >> 6;
    unsigned char* ws = p.ws;
    { float* scr = (float*)(lds + 32768 + wid * 8704);
      const int gw = blockIdx.x * 8 + wid, NGW = gridDim.x * 8;
      constexpr int I_IN = 16 * 56, I_UQ = 6 * 24, I_KN = 4 * 16, I_V = 4 * 16, I_OUT = 16 * 32, I_UP = 16 * 176, I_DN = 44 * 32, I_L = I_IN + I_UQ + I_KN + I_V + I_OUT + I_UP + I_DN;
      for (int it = gw; it < 2 * I_L; it += NGW) { const int l = it / I_L; int r = it - l * I_L; bf16_t* wl = (bf16_t*)(ws + OFF_W) + (size_t)l * W_LAYER;
          const float* src; int K, Nsrc, nbn, mp; size_t doff;
          if (r < I_IN) { src = p.w_in + (size_t)l * 1024 * INW; K = 1024; Nsrc = INW; nbn = 56; mp = 1; doff = W_IN; }
          else if ((r -= I_IN) < I_UQ) { src = p.w_uq + (size_t)l * 384 * 768; K = 384; Nsrc = 768; nbn = 24; mp = 0; doff = W_UQ; }
          else if ((r -= I_UQ) < I_KN) { src = p.w_ukv + (size_t)l * 256 * 1024; K = 256; Nsrc = 1024; nbn = 16; mp = 2; doff = W_KN; }
          else if ((r -= I_KN) < I_V) { src = p.w_ukv + (size_t)l * 256 * 1024; K = 256; Nsrc = 1024; nbn = 16; mp = 3; doff = W_V; }
          else if ((r -= I_V) < I_OUT) { src = p.w_out + (size_t)l * 1024 * 1024; K = 1024; Nsrc = 1024; nbn = 32; mp = 0; doff = W_OUT; }
          else if ((r -= I_OUT) < I_UP) { src = p.w_up + (size_t)l * 1024 * 5632; K = 1024; Nsrc = 5632; nbn = 176; mp = 4; doff = W_UP; }
          else { r -= I_UP; src = p.w_down + (size_t)l * DFF * 1024; K = DFF; Nsrc = 1024; nbn = 32; mp = 0; doff = W_DN; }
          const int kb = r / nbn, nb = r - kb * nbn, n0 = nb * 32;
          const int cs = mp == 0 ? n0 : mp == 1 ? map_in(n0) : mp == 2 ? map_kn(n0) : mp == 3 ? map_v(n0) : map_up(n0);
          if (cs != -2) transpose_item(src, K, Nsrc, wl + doff, n0, cs, kb * 64, scr, lane); }
    }
    { for (int idx = blockIdx.x * NWG_T + tid; idx < 2 * 1024 * 256; idx += gridDim.x * NWG_T) { const int n = idx & 255, k = (idx >> 8) & 1023, l = idx >> 18; const int g = n >> 6, d = n & 63;
          const float* wr = p.w_in + ((size_t)l * 1024 + k) * INW + 1440 + g * 64; const float* pw = p.pool_w + ((size_t)(l * 4 + g) * 64) * 64 + d; float s = 0.f;
#pragma unroll 8
          for (int c = 0; c < 64; ++c) s += wr[c] * pw[c * 64];
          ((bf16_t*)(ws + OFF_W) + (size_t)l * W_LAYER + W_IN)[(size_t)(1440 + n) * 1024 + k] = (bf16_t)f2bf(s * p.pool_scale[l * 256 + n]); } }
}

DEV void phase_norm(const Params& p, int l, int which, bool first, const float* pgate) {
    const int tid = otid(); const int lane = tid & 63, wid = tid >> 6; const int gw = blockIdx.x * 8 + wid, NGW = gridDim.x * 8;
    float* X = (float*)(p.ws + OFF_X); bf16_t* HN = (bf16_t*)(p.ws + OFF_HN);
    const float* modv = (const float*)(p.ws + OFF_MOD) + (size_t)l * 3 * 6144;
    const float* g = (which == 0 ? p.norm1_g : p.norm2_g) + l * 1024;
    for (int r = gw; r < R; r += NGW) {
        const int b = r / RB, s = r - b * RB; const int mi = s < NCTX ? 2 : b;
        const float* src = first ? (s < NCTX ? p.ctx + ((size_t)b * NCTX + s) * 1024 : p.x + ((size_t)b * TL + (s - NCTX)) * 1024) : X + (size_t)r * 1024;
        const f32x4* xr = (const f32x4*)src + lane; f32x4 v[4]; float ss = 0.f;
#pragma unroll
        for (int j = 0; j < 4; ++j) { v[j] = xr[64 * j]; ss += (v[j].x * v[j].x + v[j].y * v[j].y) + (v[j].z * v[j].z + v[j].w * v[j].w); }
        if (pgate != nullptr && s < NCTX) { const float* PART = (const float*)(p.ws + OFF_PART) + (size_t)(b * NCTX + s) * 1024; ss = 0.f;
#pragma unroll
            for (int j = 0; j < 4; ++j) { const f32x4 gq = ((const f32x4*)pgate)[lane + 64 * j]; f32x4 a = ((const f32x4*)PART)[lane + 64 * j];
#pragma unroll
                for (int q = 1; q < 4; ++q) a = a + ((const f32x4*)(PART + (size_t)q * 524288))[lane + 64 * j];
                v[j] = v[j] + gq * a; ss += (v[j].x * v[j].x + v[j].y * v[j].y) + (v[j].z * v[j].z + v[j].w * v[j].w); } }
        if (first || (pgate != nullptr && s < NCTX)) { f32x4* xo = (f32x4*)(X + (size_t)r * 1024) + lane;
#pragma unroll
            for (int j = 0; j < 4; ++j) xo[64 * j] = v[j]; }
        const float rs = rsqrtf(wave_sum(ss) * (1.f / 1024.f) + EPS);
        const float* mv = modv + mi * 6144 + (which == 0 ? 0 : 3072);
        u32x2* o8 = (u32x2*)(HN + (size_t)r * 1024) + lane;
#pragma unroll
        for (int j = 0; j < 4; ++j) { const f32x4 gg = ((const f32x4*)g)[lane + 64 * j], sh = ((const f32x4*)mv)[lane + 64 * j], sc = ((const f32x4*)(mv + 1024))[lane + 64 * j];
            const f32x4 y = v[j] * rs * gg; const f32x4 h = y * (sc + 1.0f) + sh; u32x2 w; w.x = pk2(h.x, h.y); w.y = pk2(h.z, h.w); o8[64 * j] = w; }
    }
}
DEV void phase_final(const Params& p) {
    const int tid = otid(); const int lane = tid & 63, wid = tid >> 6; const int gw = blockIdx.x * 8 + wid, NGW = gridDim.x * 8;
    const float* X = (const float*)(p.ws + OFF_X);
    for (int q = gw; q < 2 * TL; q += NGW) { const int b = q / TL, t = q - b * TL; const int r = b * RB + NCTX + t;
        const f32x4* xr = (const f32x4*)(X + (size_t)r * 1024) + lane; f32x4 v[4]; float ss = 0.f;
#pragma unroll
        for (int j = 0; j < 4; ++j) { v[j] = xr[64 * j]; ss += (v[j].x * v[j].x + v[j].y * v[j].y) + (v[j].z * v[j].z + v[j].w * v[j].w); }
        const float rs = rsqrtf(wave_sum(ss) * (1.f / 1024.f) + EPS);
        f32x4* o = (f32x4*)(p.out + (size_t)q * 1024) + lane;
#pragma unroll
        for (int j = 0; j < 4; ++j) { const f32x4 gg = ((const f32x4*)p.final_norm_g)[lane + 64 * j]; o[64 * j] = v[j] * rs * gg; } }
}

DEV void phase_rowwise(const Params& p, int l) {
    const int tid = otid(); const int lane = tid & 63, wid = tid >> 6; const int gw = blockIdx.x * 8 + wid, NGW = gridDim.x * 8;
    bf16_t* P = (bf16_t*)p.out; const f32x2* rope = (const f32x2*)(p.ws + OFF_ROPE);
    const float* qg = p.mla_q_norm_g + l * 384; const float* kg = p.mla_kv_norm_g + l * 256;
    for (int r = gw; r < R; r += NGW) {
        bf16_t* pr = P + (size_t)r * INW; const int b = r / RB, s = r - b * RB;
        { unsigned* q2 = (unsigned*)(pr + 768) + lane; unsigned w[3]; float ss = 0.f;
#pragma unroll
          for (int j = 0; j < 3; ++j) { w[j] = q2[64 * j]; const float a = bf2f(w[j] & 0xffff), c2 = bf2f(w[j] >> 16); ss += a * a + c2 * c2; }
          const float rs = rsqrtf(wave_sum(ss) * (1.f / 384.f) + EPS);
#pragma unroll
          for (int j = 0; j < 3; ++j) { const int c0 = 2 * (lane + 64 * j); q2[64 * j] = pk2(bf2f(w[j] & 0xffff) * rs * qg[c0], bf2f(w[j] >> 16) * rs * qg[c0 + 1]); } }
        { u32x2* k4 = (u32x2*)(pr + 1152) + lane; const u32x2 w = *k4;
          const float a0 = bf2f(w.x & 0xffff), a1 = bf2f(w.x >> 16), a2 = bf2f(w.y & 0xffff), a3 = bf2f(w.y >> 16);
          const float rs = rsqrtf(wave_sum((a0 * a0 + a1 * a1) + (a2 * a2 + a3 * a3)) * (1.f / 256.f) + EPS);
          const f32x4 gg = ((const f32x4*)kg)[lane]; u32x2 o; o.x = pk2(a0 * rs * gg.x, a1 * rs * gg.y); o.y = pk2(a2 * rs * gg.z, a3 * rs * gg.w); *k4 = o; }
        if (s >= NCTX && lane < 16) { const f32x2 cs = rope[(s - NCTX) * 16 + lane];
          const float x1 = bf2f(pr[1408 + lane]), x2 = bf2f(pr[1408 + 16 + lane]);
          pr[1408 + lane] = (bf16_t)f2bf(x1 * cs.x - x2 * cs.y); pr[1408 + 16 + lane] = (bf16_t)f2bf(x2 * cs.x + x1 * cs.y); }
    }
}

DEV void phase_pool(const Params& p) {
    const int tid = otid(); const bf16_t* P = (const bf16_t*)p.out; bf16_t* MIX = (bf16_t*)(p.ws + OFF_HN);
    for (int idx = blockIdx.x * NWG_T + tid; idx < R * 32; idx += gridDim.x * NWG_T) { const int r = idx >> 5, cg = idx & 31; const int half = 1 << (cg >> 3);
        const int b = r / RB, s = r - b * RB; const int seq0 = s < NCTX ? b * RB : b * RB + NCTX; const int T = s < NCTX ? NCTX : TL; const int t = r - seq0;
        const int lo = max(t - half, 0), hi = min(t + half, T); float sum[8];
#pragma unroll
        for (int j = 0; j < 8; ++j) sum[j] = 0.f;
        const bf16_t* base = P + (size_t)seq0 * INW + 1440 + cg * 8;
        { bf16x8 wv[16]; const bf16x8 zz = {0, 0, 0, 0, 0, 0, 0, 0};
#pragma unroll
          for (int k = 0; k < 16; ++k) { const int tt = t - 8 + k; wv[k] = (tt >= lo && tt < hi) ? *(const bf16x8*)(base + (size_t)tt * INW) : zz; }
#pragma unroll
          for (int k = 0; k < 16; ++k)
#pragma unroll
              for (int j = 0; j < 8; ++j) sum[j] += bf2f((unsigned short)wv[k][j]); }
        const bf16x8 me = *(const bf16x8*)(base + (size_t)t * INW); const float ic = 1.0f / (float)(hi - lo); float o[8];
#pragma unroll
        for (int j = 0; j < 8; ++j) o[j] = sum[j] * ic - bf2f((unsigned short)me[j]);
        *(bf16x8*)(MIX + (size_t)r * 1024 + 768 + cg * 8) = pack8(o[0], o[1], o[2], o[3], o[4], o[5], o[6], o[7]); }
}

DEV float log2_sigmoid(float d) { return -log1pf(__expf(-d)) * 1.4426950408889634f; }
constexpr int ST_P = 272;
DEV void states_item(const Params& p, int l, unsigned char* lds, int it) {
    const int tid = otid(), lane = tid & 63, wid = tid >> 6, l32 = lane & 31, hi = lane >> 5;
    const bf16_t* P = (const bf16_t*)p.out; const f32x2* rope = (const f32x2*)(p.ws + OFF_ROPE);
    float* SLOC = (float*)(p.ws + OFF_OV + OV_SLOC);
    const int gc = it >> 1, hp = it & 1;
    unsigned char* VTl = lds;
    unsigned char* KTl = lds + 2 * 64 * ST_P;
    const int cb = gc % 66; const bool lat = cb >= 2; const int t0 = (cb - 2) * 128; const int r0 = gc * 128;
    __syncthreads();
    { const int tok = tid >> 2, hh = (tid >> 1) & 1, c = tid & 1; const int h = 2 * hp + hh;
      const bf16_t* src = P + (size_t)(r0 + tok) * INW + 128 + h * 32 + 8 * c; const bf16x8 lo = *(const bf16x8*)src, hi8 = *(const bf16x8*)(src + 16);
      const float df = exp2f(log2_sigmoid(p.ret_decay_f[l * 4 + h]) * (float)(127 - tok)) * 0.17677669529663687f, db = exp2f(log2_sigmoid(p.ret_decay_b[l * 4 + h]) * (float)tok) * 0.17677669529663687f;
#pragma unroll
      for (int j = 0; j < 8; ++j) { float x1 = bf2f((unsigned short)lo[j]), x2 = bf2f((unsigned short)hi8[j]);
          if (lat) { const f32x2 cs = rope[(t0 + tok) * 16 + 8 * c + j]; const float y1 = x1 * cs.x - x2 * cs.y, y2 = x2 * cs.x + x1 * cs.y; x1 = y1; x2 = y2; }
          bf16_t* kf = (bf16_t*)(KTl + ((hh * 2 + 0) * 32 + 8 * c + j) * ST_P) + tok; bf16_t* kb = (bf16_t*)(KTl + ((hh * 2 + 1) * 32 + 8 * c + j) * ST_P) + tok;
          kf[0] = (bf16_t)f2bf(x1 * df); kb[0] = (bf16_t)f2bf(x1 * db);
          *(bf16_t*)((unsigned char*)kf + 16 * ST_P) = (bf16_t)f2bf(x2 * df); *(bf16_t*)((unsigned char*)kb + 16 * ST_P) = (bf16_t)f2bf(x2 * db); } }
    for (int task = tid; task < 2048; task += NWG_T) { const int hh = task >> 10, tok = (task >> 3) & 127, ch = task & 7;
        const bf16x8 v = *(const bf16x8*)(P + (size_t)(r0 + tok) * INW + 256 + (2 * hp + hh) * 64 + ch * 8);
#pragma unroll
        for (int j = 0; j < 8; ++j) *((bf16_t*)(VTl + (hh * 64 + ch * 8 + j) * ST_P) + tok) = (bf16_t)v[j]; }
    __syncthreads();
    { const int hh = wid >> 2, dir = (wid >> 1) & 1, dvb = wid & 1; const int h = 2 * hp + hh;
      const unsigned char* ap = VTl + (hh * 64 + 32 * dvb + l32) * ST_P + hi * 16; const unsigned char* bp = KTl + ((hh * 2 + dir) * 32 + l32) * ST_P + hi * 16;
      bf16x8 af[8], bfr[8];
#pragma unroll
      for (int ks = 0; ks < 8; ++ks) { af[ks] = *(const bf16x8*)(ap + ks * 32); bfr[ks] = *(const bf16x8*)(bp + ks * 32); }
      f32x16 acc;
#pragma unroll
      for (int r = 0; r < 16; ++r) acc[r] = 0.f;
#pragma unroll
      for (int ks = 0; ks < 8; ++ks) acc = __builtin_amdgcn_mfma_f32_32x32x16_bf16(af[ks], bfr[ks], acc, 0, 0, 0);
      float* o = SLOC + ((size_t)(gc * 4 + h) * 2 + dir) * 2048 + l32 * 64 + 32 * dvb + 4 * hi;
#pragma unroll
      for (int g4 = 0; g4 < 4; ++g4) *(f32x4*)(o + 8 * g4) = (f32x4){acc[4 * g4], acc[4 * g4 + 1], acc[4 * g4 + 2], acc[4 * g4 + 3]}; }
}
DEV void scan_threads(const Params& p, int l, int gid) {
    if (gid >= 32768) return;
    const int e = gid & 2047, dir = (gid >> 11) & 1, h = (gid >> 12) & 3, b = gid >> 14;
    const float* SLOC = (const float*)(p.ws + OFF_OV + OV_SLOC); float* SIN = (float*)(p.ws + OFF_OV + OV_SIN);
    const float gC = exp2f(log2_sigmoid((dir == 0 ? p.ret_decay_f : p.ret_decay_b)[l * 4 + h]) * 128.f);
    float S = 0.f;
#pragma unroll 6
    for (int st = 0; st < 66; ++st) { const int cb = dir == 0 ? st : (st < 2 ? 1 - st : 67 - st); const size_t idx = ((size_t)((b * 66 + cb) * 4 + h) * 2 + dir) * 2048 + e;
        const float v = SLOC[idx]; SIN[idx] = S; S = S * gC + v; }
}

constexpr int AT_KP = 208, AT_VP = 136, AT_KB = 64 * AT_KP, AT_VBS = 64 * AT_VP, AT_V0 = 4 * AT_KB;
DEV float at_max32(const f32x16& s0, const f32x16& s1) {
    float m0 = __builtin_fmaxf(__builtin_fmaxf(s0[0], s0[1]), s0[2]), m1 = __builtin_fmaxf(__builtin_fmaxf(s1[0], s1[1]), s1[2]);
    m0 = __builtin_fmaxf(__builtin_fmaxf(m0, s0[3]), s0[4]); m1 = __builtin_fmaxf(__builtin_fmaxf(m1, s1[3]), s1[4]);
    m0 = __builtin_fmaxf(__builtin_fmaxf(m0, s0[5]), s0[6]); m1 = __builtin_fmaxf(__builtin_fmaxf(m1, s1[5]), s1[6]);
    m0 = __builtin_fmaxf(__builtin_fmaxf(m0, s0[7]), s0[8]); m1 = __builtin_fmaxf(__builtin_fmaxf(m1, s1[7]), s1[8]);
    m0 = __builtin_fmaxf(__builtin_fmaxf(m0, s0[9]), s0[10]); m1 = __builtin_fmaxf(__builtin_fmaxf(m1, s1[9]), s1[10]);
    m0 = __builtin_fmaxf(__builtin_fmaxf(m0, s0[11]), s0[12]); m1 = __builtin_fmaxf(__builtin_fmaxf(m1, s1[11]), s1[12]);
    m0 = __builtin_fmaxf(__builtin_fmaxf(m0, s0[13]), s0[14]); m1 = __builtin_fmaxf(__builtin_fmaxf(m1, s1[13]), s1[14]);
    return __builtin_fmaxf(__builtin_fmaxf(m0, s0[15]), __builtin_fmaxf(m1, s1[15]));
}
DEV void attn_unit(const Params& p, unsigned char* lds, int u) {
    const int tid = otid(), lane = tid & 63, wid = tid >> 6, l32 = lane & 31, hi = lane >> 5;
    const bf16_t* Q = (const bf16_t*)(p.ws + OFF_OV + OV_Q); const bf16_t* KN = (const bf16_t*)(p.ws + OFF_OV + OV_KN); const bf16_t* VT = (const bf16_t*)(p.ws + OFF_OV + OV_VT);
    const bf16_t* P = (const bf16_t*)p.out; bf16_t* MIX = (bf16_t*)(p.ws + OFF_HN); const f32x2* rope = (const f32x2*)(p.ws + OFF_ROPE);
    const bool isctx = u >= 512; int b, h, qrow0, NT;
    if (!isctx) { b = u >> 8; h = (u >> 5) & 7; qrow0 = b * RB + NCTX + (u & 31) * 256; NT = 132; } else { const int v = u - 512; b = v >> 3; h = v & 7; qrow0 = b * RB; NT = 4; }
    const int krow0 = b * RB; const int qrow = qrow0 + wid * 32 + l32;
    bf16x8 qf[6];
    { const bf16_t* qp = Q + (size_t)qrow * 768 + h * 96 + hi * 8;
#pragma unroll
      for (int d0 = 0; d0 < 6; ++d0) qf[d0] = *(const bf16x8*)(qp + d0 * 16);
      if (!isctx) { const f32x2* rp = rope + (size_t)(qrow - (b * RB + NCTX)) * 16 + hi * 8;
#pragma unroll
          for (int j = 0; j < 8; ++j) { const f32x2 cs = rp[j]; const float x1 = bf2f((unsigned short)qf[4][j]), x2 = bf2f((unsigned short)qf[5][j]);
              qf[4][j] = (short)f2bf(x1 * cs.x - x2 * cs.y); qf[5][j] = (short)f2bf(x2 * cs.x + x1 * cs.y); } } }
    const bf16_t* sp[3]; int sstep[3], lo[3];
#pragma unroll
    for (int k = 0; k < 2; ++k) { const int c = tid + k * 512; const int key = c / 12, part = c - key * 12; lo[k] = key * AT_KP + part * 16;
        if (part < 8) { sp[k] = KN + (size_t)(krow0 + key) * 512 + h * 64 + part * 8; sstep[k] = 64 * 512; } else { sp[k] = P + (size_t)(krow0 + key) * INW + 1408 + (part - 8) * 8; sstep[k] = 64 * INW; } }
    { const int dv = tid >> 3, kc = tid & 7; lo[2] = dv * AT_VP + kc * 16; sp[2] = VT + (size_t)(h * 64 + dv) * R + krow0 + kc * 8; sstep[2] = 64; }
    const bool hasK2 = tid < 256;
    u32x4 st[3];
#define AT_GLOADK() do { st[0] = *(const u32x4*)sp[0]; sp[0] += sstep[0]; if (hasK2) { st[1] = *(const u32x4*)sp[1]; sp[1] += sstep[1]; } } while (0)
#define AT_GLOADV() do { st[2] = *(const u32x4*)sp[2]; sp[2] += sstep[2]; } while (0)
#define AT_LSTOREK(buf) do { *(u32x4*)((buf) + lo[0]) = st[0]; if (hasK2) *(u32x4*)((buf) + lo[1]) = st[1]; } while (0)
#define AT_LSTOREV(buf) do { unsigned char* d_ = (buf) + lo[2]; *(u32x2*)d_ = (u32x2){st[2].x, st[2].y}; *(u32x2*)(d_ + 8) = (u32x2){st[2].z, st[2].w}; } while (0)
#define AT_SB() __builtin_amdgcn_sched_barrier(0)
    f32x16 o0, o1, sa0, sa1, sb0, sb1, negm;
#pragma unroll
    for (int r = 0; r < 16; ++r) { o0[r] = 0.f; o1[r] = 0.f; sa0[r] = 0.f; sa1[r] = 0.f; negm[r] = 0.f; }
    float mrun = 0.f, lsum = 0.f;
    __syncthreads();
    AT_GLOADK(); AT_GLOADV(); AT_LSTOREK(lds); AT_LSTOREV(lds + AT_V0);
    AT_GLOADK(); AT_GLOADV(); AT_LSTOREK(lds + AT_KB); AT_LSTOREV(lds + AT_V0 + AT_VBS);
    AT_GLOADK(); AT_LSTOREK(lds + 2 * AT_KB);
    __syncthreads();
    { const unsigned char* ka = lds + l32 * AT_KP + hi * 16;
#pragma unroll
      for (int d0 = 0; d0 < 6; ++d0) { const bf16x8 a0 = *(const bf16x8*)(ka + d0 * 32), a1 = *(const bf16x8*)(ka + 32 * AT_KP + d0 * 32);
          sa0 = __builtin_amdgcn_mfma_f32_32x32x16_bf16(a0, qf[d0], sa0, 0, 0, 0); sa1 = __builtin_amdgcn_mfma_f32_32x32x16_bf16(a1, qf[d0], sa1, 0, 0, 0); } }
#define AT_STEP(SA0, SA1, SB0, SB1, tt) do { \
        const int t_ = (tt); const bool nxt_ = t_ + 1 < NT; \
        const unsigned char* kb_ = lds + ((t_ + 1) & 3) * AT_KB; const unsigned char* vb_ = lds + AT_V0 + (t_ & 3) * AT_VBS; \
        if (t_ + 3 < NT) AT_GLOADK(); \
        if (t_ + 2 < NT) AT_GLOADV(); \
        bf16x8 kfr[12]; u32x2 vfr[16]; \
        { const unsigned char* ka = kb_ + l32 * AT_KP + hi * 16; \
          _Pragma("unroll") for (int d0 = 0; d0 < 6; ++d0) { kfr[2 * d0] = *(const bf16x8*)(ka + d0 * 32); kfr[2 * d0 + 1] = *(const bf16x8*)(ka + 32 * AT_KP + d0 * 32); } } \
        { const float mx = mxc; \
          if (t_ == 0 || __any(mx > 8.0f)) { \
              const float rm = fmaxf(mx, __shfl_xor(mx, 32)); const float delta = (t_ == 0) ? rm : fmaxf(rm, 0.f); const float alpha = (t_ == 0) ? 1.0f : __builtin_amdgcn_exp2f(-delta); \
              mrun += delta; \
              _Pragma("unroll") for (int r = 0; r < 16; ++r) { SA0[r] -= delta; SA1[r] -= delta; o0[r] *= alpha; o1[r] *= alpha; } \
              lsum *= alpha; { const float nm = -mrun; _Pragma("unroll") for (int r = 0; r < 16; ++r) negm[r] = nm; } } } \
        float ls0 = 0.f, ls1 = 0.f; \
        AT_SB(); \
        _Pragma("unroll") for (int i = 0; i < 8; ++i) { \
            if (i == 0) SB0 = __builtin_amdgcn_mfma_f32_32x32x16_bf16(kfr[0], qf[0], negm, 0, 0, 0); else if (i == 1) SB1 = __builtin_amdgcn_mfma_f32_32x32x16_bf16(kfr[1], qf[0], negm, 0, 0, 0); \
            else if (i & 1) SB1 = __builtin_amdgcn_mfma_f32_32x32x16_bf16(kfr[i], qf[i >> 1], SB1, 0, 0, 0); else SB0 = __builtin_amdgcn_mfma_f32_32x32x16_bf16(kfr[i], qf[i >> 1], SB0, 0, 0, 0); \
            SA0[2 * i] = __builtin_amdgcn_exp2f(SA0[2 * i]); SA0[2 * i + 1] = __builtin_amdgcn_exp2f(SA0[2 * i + 1]); SA1[2 * i] = __builtin_amdgcn_exp2f(SA1[2 * i]); SA1[2 * i + 1] = __builtin_amdgcn_exp2f(SA1[2 * i + 1]); \
            ls0 += SA0[2 * i] + SA0[2 * i + 1]; ls1 += SA1[2 * i] + SA1[2 * i + 1]; \
            AT_SB(); } \
        { const unsigned char* va = vb_ + l32 * AT_VP + hi * 8; \
          _Pragma("unroll") for (int kj = 0; kj < 4; ++kj) { const unsigned char* vp = va + kj * 32; \
              vfr[4 * kj + 0] = *(const u32x2*)vp; vfr[4 * kj + 1] = *(const u32x2*)(vp + 16); vfr[4 * kj + 2] = *(const u32x2*)(vp + 32 * AT_VP); vfr[4 * kj + 3] = *(const u32x2*)(vp + 32 * AT_VP + 16); } } \
        bf16x8 pb[4]; \
        _Pragma("unroll") for (int i = 8; i < 12; ++i) { const int kj = i - 8; const int jp = kj & 1; \
            if (i & 1) SB1 = __builtin_amdgcn_mfma_f32_32x32x16_bf16(kfr[i], qf[i >> 1], SB1, 0, 0, 0); else SB0 = __builtin_amdgcn_mfma_f32_32x32x16_bf16(kfr[i], qf[i >> 1], SB0, 0, 0, 0); \
            if (kj < 2) pb[kj] = pack8(SA0[8 * jp + 0], SA0[8 * jp + 1], SA0[8 * jp + 2], SA0[8 * jp + 3], SA0[8 * jp + 4], SA0[8 * jp + 5], SA0[8 * jp + 6], SA0[8 * jp + 7]); \
            else        pb[kj] = pack8(SA1[8 * jp + 0], SA1[8 * jp + 1], SA1[8 * jp + 2], SA1[8 * jp + 3], SA1[8 * jp + 4], SA1[8 * jp + 5], SA1[8 * jp + 6], SA1[8 * jp + 7]); \
            AT_SB(); } \
        lsum += ls0 + ls1; \
        float mq0 = SB0[0], mq1 = SB1[0]; \
        _Pragma("unroll") for (int kj = 0; kj < 4; ++kj) { \
            const bf16x8 A0 = __builtin_bit_cast(bf16x8, (u32x4){vfr[4 * kj].x, vfr[4 * kj].y, vfr[4 * kj + 1].x, vfr[4 * kj + 1].y}); \
            const bf16x8 A1 = __builtin_bit_cast(bf16x8, (u32x4){vfr[4 * kj + 2].x, vfr[4 * kj + 2].y, vfr[4 * kj + 3].x, vfr[4 * kj + 3].y}); \
            o0 = __builtin_amdgcn_mfma_f32_32x32x16_bf16(A0, pb[kj], o0, 0, 0, 0); o1 = __builtin_amdgcn_mfma_f32_32x32x16_bf16(A1, pb[kj], o1, 0, 0, 0); \
            mq0 = __builtin_fmaxf(__builtin_fmaxf(mq0, SB0[4 * kj]), SB0[4 * kj + 1]); mq1 = __builtin_fmaxf(__builtin_fmaxf(mq1, SB1[4 * kj]), SB1[4 * kj + 1]); \
            mq0 = __builtin_fmaxf(__builtin_fmaxf(mq0, SB0[4 * kj + 2]), SB0[4 * kj + 3]); mq1 = __builtin_fmaxf(__builtin_fmaxf(mq1, SB1[4 * kj + 2]), SB1[4 * kj + 3]); \
            AT_SB(); } \
        mxc = __builtin_fmaxf(mq0, mq1);            \
        if (t_ + 3 < NT) AT_LSTOREK(lds + ((t_ + 3) & 3) * AT_KB); \
        if (t_ + 2 < NT) AT_LSTOREV(lds + AT_V0 + ((t_ + 2) & 3) * AT_VBS); \
        if (t_ & 1) __syncthreads(); \
    } while (0)
    float mxc = at_max32(sa0, sa1);
    for (int t = 0; t < NT; t += 2) { AT_STEP(sa0, sa1, sb0, sb1, t); AT_STEP(sb0, sb1, sa0, sa1, t + 1); }
    lsum += __shfl_xor(lsum, 32);
    const float inv = 1.0f / lsum;
    bf16_t* op = MIX + (size_t)qrow * 1024 + 256 + h * 64 + 4 * hi;
#pragma unroll
    for (int g4 = 0; g4 < 4; ++g4) { u32x2 w0, w1; w0.x = pk2(o0[4 * g4] * inv, o0[4 * g4 + 1] * inv); w0.y = pk2(o0[4 * g4 + 2] * inv, o0[4 * g4 + 3] * inv);
        w1.x = pk2(o1[4 * g4] * inv, o1[4 * g4 + 1] * inv); w1.y = pk2(o1[4 * g4 + 2] * inv, o1[4 * g4 + 3] * inv);
        *(u32x2*)(op + 8 * g4) = w0; *(u32x2*)(op + 32 + 8 * g4) = w1; }
#undef AT_GLOADK
#undef AT_GLOADV
#undef AT_LSTOREK
#undef AT_LSTOREV
#undef AT_STEP
#undef AT_SB
}

constexpr int RT_VP = 264, RT_SP = 144, RT_VB = 2 * 64 * RT_VP;
DEV void retout_unit(const Params& p, int l, unsigned char* lds, int u) {
    const int tid = otid(), lane = tid & 63, wid = tid >> 6, l32 = lane & 31, hi = lane >> 5;
    const int gc = u >> 1, hp = u & 1; const int cb = gc % 66; const bool lat = cb >= 2; const int t0 = (cb - 2) * 128; const int r0 = gc * 128;
    const bf16_t* P = (const bf16_t*)p.out; bf16_t* MIX = (bf16_t*)(p.ws + OFF_HN); const f32x2* rope = (const f32x2*)(p.ws + OFF_ROPE);
    const float* SIN = (const float*)(p.ws + OFF_OV + OV_SIN);
    bf16_t* VTl = (bf16_t*)lds; bf16_t* STl = (bf16_t*)(lds + RT_VB);
    __syncthreads();
    for (int task = tid; task < 2048; task += NWG_T) { const int hh = task >> 10, key = (task >> 3) & 127, ch = task & 7;
        const bf16x8 v = *(const bf16x8*)(P + (size_t)(r0 + key) * INW + 256 + (2 * hp + hh) * 64 + ch * 8);
#pragma unroll
        for (int j = 0; j < 8; ++j) VTl[(hh * 64 + ch * 8 + j) * (RT_VP / 2) + key] = (bf16_t)v[j]; }
    for (int task = tid; task < 8192; task += NWG_T) { const int dv = task & 63, k = (task >> 6) & 31, dir = (task >> 11) & 1, hh = task >> 12;
        STl[(hh * 64 + dv) * (RT_SP / 2) + dir * 32 + k] = (bf16_t)f2bf(SIN[((size_t)(gc * 4 + 2 * hp + hh) * 2 + dir) * 2048 + k * 64 + dv]); }
    __syncthreads();
    const int hh = wid >> 2, h = 2 * hp + hh, qblk = wid & 3; const int n = 32 * qblk + l32; const int rq = r0 + n;
    const float lf = log2_sigmoid(p.ret_decay_f[l * 4 + h]), lb = log2_sigmoid(p.ret_decay_b[l * 4 + h]);
    float qv0[8], qv1[8]; bf16x8 qf0, qf1;
    { const bf16_t* qp = P + (size_t)rq * INW + h * 32 + 8 * hi; const bf16x8 a = *(const bf16x8*)qp, c2 = *(const bf16x8*)(qp + 16);
#pragma unroll
      for (int j = 0; j < 8; ++j) { float x1 = bf2f((unsigned short)a[j]), x2 = bf2f((unsigned short)c2[j]);
          if (lat) { const f32x2 cs = rope[(size_t)(t0 + n) * 16 + 8 * hi + j]; const float y1 = x1 * cs.x - x2 * cs.y, y2 = x2 * cs.x + x1 * cs.y; x1 = y1; x2 = y2; }
          qv0[j] = x1; qv1[j] = x2; }
      qf0 = pack8(qv0[0], qv0[1], qv0[2], qv0[3], qv0[4], qv0[5], qv0[6], qv0[7]); qf1 = pack8(qv1[0], qv1[1], qv1[2], qv1[3], qv1[4], qv1[5], qv1[6], qv1[7]); }
    f32x16 o0, o1;
#pragma unroll
    for (int r = 0; r < 16; ++r) { o0[r] = 0.f; o1[r] = 0.f; }
    const unsigned char* vbase = (const unsigned char*)VTl + (size_t)(hh * 64 + l32) * RT_VP + hi * 8;
    bf16x8 kga[4], kgc[4];
#pragma unroll
    for (int kb = 0; kb < 4; ++kb) { const bf16_t* kp = P + (size_t)(r0 + 32 * kb + l32) * INW + 128 + h * 32 + 8 * hi; kga[kb] = *(const bf16x8*)kp; kgc[kb] = *(const bf16x8*)(kp + 16); }
    __builtin_amdgcn_sched_barrier(0);
#pragma unroll
    for (int kb = 0; kb < 4; ++kb) {
        bf16x8 kf0, kf1;
        { const int key = 32 * kb + l32; const bf16x8 a = kga[kb], c2 = kgc[kb];
          float y1[8], y2[8];
#pragma unroll
          for (int j = 0; j < 8; ++j) { float x1 = bf2f((unsigned short)a[j]), x2 = bf2f((unsigned short)c2[j]);
              if (lat) { const f32x2 cs = rope[(size_t)(t0 + key) * 16 + 8 * hi + j]; const float z1 = x1 * cs.x - x2 * cs.y, z2 = x2 * cs.x + x1 * cs.y; x1 = z1; x2 = z2; }
              y1[j] = x1 * 0.17677669529663687f; y2[j] = x2 * 0.17677669529663687f; }
          kf0 = pack8(y1[0], y1[1], y1[2], y1[3], y1[4], y1[5], y1[6], y1[7]); kf1 = pack8(y2[0], y2[1], y2[2], y2[3], y2[4], y2[5], y2[6], y2[7]); }
        f32x16 s;
#pragma unroll
        for (int r = 0; r < 16; ++r) s[r] = 0.f;
        s = __builtin_amdgcn_mfma_f32_32x32x16_bf16(kf0, qf0, s, 0, 0, 0); s = __builtin_amdgcn_mfma_f32_32x32x16_bf16(kf1, qf1, s, 0, 0, 0);
#pragma unroll
        for (int r = 0; r < 16; ++r) { const int m = 32 * kb + crow(r, hi); const int dl = n - m; const float e = dl >= 0 ? lf * (float)dl : lb * (float)(-dl); s[r] *= __builtin_amdgcn_exp2f(e); }
#pragma unroll
        for (int jp = 0; jp < 2; ++jp) { const bf16x8 pb = pack8(s[8 * jp + 0], s[8 * jp + 1], s[8 * jp + 2], s[8 * jp + 3], s[8 * jp + 4], s[8 * jp + 5], s[8 * jp + 6], s[8 * jp + 7]);
            const unsigned char* vp = vbase + (32 * kb + 16 * jp) * 2;
            const u32x2 a00 = *(const u32x2*)vp, a01 = *(const u32x2*)(vp + 16), a10 = *(const u32x2*)(vp + 32 * RT_VP), a11 = *(const u32x2*)(vp + 32 * RT_VP + 16);
            const bf16x8 A0 = __builtin_bit_cast(bf16x8, (u32x4){a00.x, a00.y, a01.x, a01.y}), A1 = __builtin_bit_cast(bf16x8, (u32x4){a10.x, a10.y, a11.x, a11.y});
            o0 = __builtin_amdgcn_mfma_f32_32x32x16_bf16(A0, pb, o0, 0, 0, 0); o1 = __builtin_amdgcn_mfma_f32_32x32x16_bf16(A1, pb, o1, 0, 0, 0); }
    }
    { const float df = __builtin_amdgcn_exp2f(lf * (float)(n + 1)), db = __builtin_amdgcn_exp2f(lb * (float)(128 - n));
      const unsigned char* sbase = (const unsigned char*)STl + (size_t)(hh * 64 + l32) * RT_SP + hi * 16;
#pragma unroll
      for (int ks = 0; ks < 4; ++ks) { const float dd = ks < 2 ? df : db;
          const bf16x8 qb = (ks & 1) ? pack8(qv1[0] * dd, qv1[1] * dd, qv1[2] * dd, qv1[3] * dd, qv1[4] * dd, qv1[5] * dd, qv1[6] * dd, qv1[7] * dd)
                                     : pack8(qv0[0] * dd, qv0[1] * dd, qv0[2] * dd, qv0[3] * dd, qv0[4] * dd, qv0[5] * dd, qv0[6] * dd, qv0[7] * dd);
          const bf16x8 A0 = *(const bf16x8*)(sbase + ks * 32), A1 = *(const bf16x8*)(sbase + 32 * RT_SP + ks * 32);
          o0 = __builtin_amdgcn_mfma_f32_32x32x16_bf16(A0, qb, o0, 0, 0, 0); o1 = __builtin_amdgcn_mfma_f32_32x32x16_bf16(A1, qb, o1, 0, 0, 0); } }
    float ssq = 0.f;
#pragma unroll
    for (int r = 0; r < 16; ++r) ssq += o0[r] * o0[r] + o1[r] * o1[r];
    ssq += __shfl_xor(ssq, 32);
    const float rstd = rsqrtf(ssq * (1.f / 64.f) + EPS);
    const bf16_t* gp = P + (size_t)rq * INW + 512 + h * 64 + 4 * hi; bf16_t* op = MIX + (size_t)rq * 1024 + h * 64 + 4 * hi;
#pragma unroll
    for (int g4 = 0; g4 < 4; ++g4) { const u32x2 ga = *(const u32x2*)(gp + 8 * g4), gb = *(const u32x2*)(gp + 32 + 8 * g4);
        u32x2 w0, w1;
        w0.x = pk2(o0[4 * g4] * rstd * siluf(bf2f(ga.x & 0xffff)), o0[4 * g4 + 1] * rstd * siluf(bf2f(ga.x >> 16))); w0.y = pk2(o0[4 * g4 + 2] * rstd * siluf(bf2f(ga.y & 0xffff)), o0[4 * g4 + 3] * rstd * siluf(bf2f(ga.y >> 16)));
        w1.x = pk2(o1[4 * g4] * rstd * siluf(bf2f(gb.x & 0xffff)), o1[4 * g4 + 1] * rstd * siluf(bf2f(gb.x >> 16))); w1.y = pk2(o1[4 * g4 + 2] * rstd * siluf(bf2f(gb.y & 0xffff)), o1[4 * g4 + 3] * rstd * siluf(bf2f(gb.y >> 16)));
        *(u32x2*)(op + 8 * g4) = w0; *(u32x2*)(op + 32 + 8 * g4) = w1; }
}

DEV void phase_ffn_fixup(const Params& p, int l) {
    const float* EDGE = (const float*)(p.ws + OFF_EDGE); bf16_t* ACT = (bf16_t*)(p.ws + OFF_OV);
    const float* cw = p.conv_w + (size_t)l * 3 * 5632; const float* cbv = p.conv_b + (size_t)l * 5632;
    for (int idx = blockIdx.x * NWG_T + otid(); idx < 66 * 2 * 704; idx += gridDim.x * NWG_T) {
        const int ch4 = idx % 704, rest = idx / 704; const int which = rest & 1, pm = rest >> 1; const int jj = pm % 33;
        if (l == 1 && jj == 0) continue;
        const int ch = 4 * ch4, pn = ch >> 7, c = ch & 127;
        const bool sstart = jj <= 1, send = (jj == 0) || (jj == 32);
        const f32x4 zz = {0.f, 0.f, 0.f, 0.f};
#define EDG(tile, k, half) (*(const f32x4*)(EDGE + ((size_t)((tile) * 4 + (k)) * 22 + pn) * 256 + (half) * 128 + c))
        f32x4 ua, ub, ca, cb2, da, db;
        if (which == 0) { ua = sstart ? zz : EDG(pm - 1, 3, 0); ub = sstart ? zz : EDG(pm - 1, 3, 1); ca = EDG(pm, 0, 0); cb2 = EDG(pm, 0, 1); da = EDG(pm, 1, 0); db = EDG(pm, 1, 1); }
        else { ua = EDG(pm, 2, 0); ub = EDG(pm, 2, 1); ca = EDG(pm, 3, 0); cb2 = EDG(pm, 3, 1); da = send ? zz : EDG(pm + 1, 0, 0); db = send ? zz : EDG(pm + 1, 0, 1); }
#undef EDG
        const f32x4 wa0 = *(const f32x4*)(cw + ch), wa1 = *(const f32x4*)(cw + 5632 + ch), wa2 = *(const f32x4*)(cw + 2 * 5632 + ch), ba = *(const f32x4*)(cbv + ch);
        const f32x4 wb0 = *(const f32x4*)(cw + DFF + ch), wb1 = *(const f32x4*)(cw + 5632 + DFF + ch), wb2 = *(const f32x4*)(cw + 2 * 5632 + DFF + ch), bb = *(const f32x4*)(cbv + DFF + ch);
        const f32x4 xa = wa0 * ua + wa1 * ca + wa2 * da + ba, xb = wb0 * ub + wb1 * cb2 + wb2 * db + bb;
        u32x2 w; w.x = pk2(siluf(xa.x) * xb.x, siluf(xa.y) * xb.y); w.y = pk2(siluf(xa.z) * xb.z, siluf(xa.w) * xb.w);
        *(u32x2*)(ACT + (size_t)(pm * 256 + (which ? 255 : 0)) * DFF + ch) = w;
    }
}

#define RLX_AGENT __ATOMIC_RELAXED, __HIP_MEMORY_SCOPE_AGENT
#define XB_TMO      128
#define XB_XCNT(j)  (256  + 64 * (j))
#define XB_XSUB(j)  (1280 + 64 * (j))
#define XB_XGEN(j)  (2304 + 64 * (j))
#define XB_TOP      3328
#define XB_TOPGEN   3392
#define XCD_BAR_WORDS 3456
#define XB_SPIN_CAP (1u << 18)

__device__ __forceinline__ unsigned xb_ld(unsigned* p)              { return __hip_atomic_load(p, __ATOMIC_RELAXED, __HIP_MEMORY_SCOPE_AGENT); }
__device__ __forceinline__ unsigned xb_add(unsigned* p, unsigned v) { return __hip_atomic_fetch_add(p, v, __ATOMIC_RELAXED, __HIP_MEMORY_SCOPE_AGENT); }
__device__ __forceinline__ unsigned xb_xcc_id() { return (unsigned)__builtin_amdgcn_s_getreg((3 << 11) | 20) & 0xFu; }
#define XB_SPIN(cond, bar) do { unsigned _sp = 0; while (cond) { __builtin_amdgcn_s_sleep(1); \
    if ((++_sp & 255u) == 0u) { if (xb_ld(&(bar)[XB_TMO])) break; if (_sp > XB_SPIN_CAP) { atomicAdd(&(bar)[XB_TMO], 1u); break; } } } } while (0)

struct XcdBarrier {
    unsigned* bar; unsigned x;
    volatile LAS unsigned* st;
};

__device__ __forceinline__ XcdBarrier xcd_barrier_post(unsigned* bar, volatile LAS unsigned* st) {
    XcdBarrier b; b.bar = bar; b.x = xb_xcc_id(); b.st = st;
    if (threadIdx.x == 0) (void)xb_add(&bar[XB_XCNT(b.x)], 1u);
    return b;
}
__device__ __forceinline__ void xcd_barrier_complete(unsigned* bar, unsigned x, unsigned& nloc, unsigned& nx) {
    const unsigned G = gridDim.x * gridDim.y * gridDim.z;
    unsigned sum, cnt, mine, sp = 0u;
    for (;;) {
        sum = 0u; cnt = 0u; mine = 0u;
#pragma unroll
        for (unsigned j = 0; j < 16; ++j) { const unsigned c = xb_ld(&bar[XB_XCNT(j)]); sum += c; cnt += (c > 0u) ? 1u : 0u; mine = (j == x) ? c : mine; }
        if (sum == G) break;
        __builtin_amdgcn_s_sleep(1);
        if ((++sp & 255u) == 0u) { if (xb_ld(&bar[XB_TMO])) break; if (sp > XB_SPIN_CAP) { atomicAdd(&bar[XB_TMO], 1u); break; } }
    }
    nloc = mine > 0u ? mine : 1u; nx = cnt > 0u ? cnt : 1u;
}

__device__ __forceinline__ void xcd_barrier(const XcdBarrier& b) {
    asm volatile("s_waitcnt vmcnt(0)" ::: "memory");
    __syncthreads();
    if (threadIdx.x == 0) {
        unsigned* bar = b.bar;
        __builtin_amdgcn_s_waitcnt(0);
        unsigned nloc = b.st[0], nx = b.st[1];
        if (nloc == 0u) { xcd_barrier_complete(bar, b.x, nloc, nx); b.st[0] = nloc; b.st[1] = nx; }
        const unsigned old = xb_add(&bar[XB_XSUB(b.x)], 1u);
        const unsigned gen = old / nloc;
        if (old + 1u == (gen + 1u) * nloc) {
            __builtin_amdgcn_fence(__ATOMIC_RELEASE, "agent");
            asm volatile("s_waitcnt vmcnt(0)" ::: "memory");
            const unsigned og = xb_add(&bar[XB_TOP], 1u);
            const unsigned tg = og / nx;
            if (og + 1u == (tg + 1u) * nx) xb_add(&bar[XB_TOPGEN], 1u);
            else XB_SPIN(xb_ld(&bar[XB_TOPGEN]) == tg, bar);
            __builtin_amdgcn_fence(__ATOMIC_ACQUIRE, "agent");
            xb_add(&bar[XB_XGEN(b.x)], 1u);
            asm volatile("s_waitcnt vmcnt(0)" ::: "memory");
        } else {
            XB_SPIN(xb_ld(&bar[XB_XGEN(b.x)]) == gen, bar);
            __builtin_amdgcn_fence(__ATOMIC_ACQUIRE, "agent");
            asm volatile("s_waitcnt vmcnt(0)" ::: "memory");
        }
    }
    __syncthreads();
}


constexpr size_t OFF_CTL = 250000128; constexpr int CTL_BYTES = 16384;
#if defined(__HIP_DEVICE_COMPILE__)
#define KP() const __attribute__((address_space(4))) Params* kp_ = (const __attribute__((address_space(4))) Params*)__builtin_amdgcn_kernarg_segment_ptr(); asm volatile("" : "+s"(kp_)); const Params p = *kp_; \
    bf16_t* HN = (bf16_t*)(p.ws + OFF_HN); bf16_t* P = (bf16_t*)p.out; float* X = (float*)(p.ws + OFF_X); (void)HN; (void)P; (void)X
#else
#define KP() const Params p = p_arg; bf16_t* HN = (bf16_t*)(p.ws + OFF_HN); bf16_t* P = (bf16_t*)p.out; float* X = (float*)(p.ws + OFF_X); (void)HN; (void)P; (void)X
#endif
#define WL() const bf16_t* wl = (const bf16_t*)(p.ws + OFF_W) + (size_t)l * W_LAYER; const float* modv = (const float*)(p.ws + OFF_MOD) + (size_t)l * 3 * 6144; (void)wl; (void)modv
#ifndef DUPM
#define DUPM 0
#endif
#define REP(bit) for (int rep_ = 0; rep_ < (((DUPM) >> (bit)) & 1) + 1; ++rep_)
constexpr int PH_PER_LAYER = 10, N_PHASES = 2 + 2 * PH_PER_LAYER;
__global__ void __launch_bounds__(512, 2) mk_fwd(Params p_arg) {
    extern __shared__ __attribute__((aligned(16))) unsigned char lds[];
    cg::grid_group grid = cg::this_grid();
    const int G = gridDim.x, bx = blockIdx.x; const int vcu = (G % 8 == 0) ? (bx % 8) * (G / 8) + bx / 8 : bx;
    LAS unsigned char* ldsl = (LAS unsigned char*)lds;
    const int ph_lo = p_arg.ph_lo, ph_hi = p_arg.ph_hi;
    volatile LAS unsigned* misc = (volatile LAS unsigned*)(ldsl + (LDS_BYTES - 64));
    { const int t0_ = otid(); if (t0_ < 16) misc[t0_] = 0u; }
    __syncthreads();
    if (ph_hi - ph_lo > 1) (void)xcd_barrier_post((unsigned*)(p_arg.ws + OFF_CTL), misc);
    for (int ph = ph_lo; ph < ph_hi; ++ph) {
        if (ph == 0) { KP(); phase_prep(p, lds); __syncthreads(); }
        else if (ph == N_PHASES - 1) { KP(); phase_final(p);
#if (DUPM >> 10) & 1
            for (int i = 0; i < 20; ++i) grid.sync();
#endif
        }
        else {
            const int l = (ph - 1) / PH_PER_LAYER, sp = (ph - 1) % PH_PER_LAYER;
            if (sp == 0) { KP(); if (l == 0) REP(9) { phase_prep_weights(p, lds); __syncthreads(); }
                phase_norm(p, l, 0, l == 0, l == 1 ? (const float*)(p.ws + OFF_MOD) + 2 * 6144 + 5120 : nullptr); }
            else if (sp == 1) { KP(); WL(); REP(1) { __syncthreads();
                pg8::Gemm g{HN, wl + W_IN, R, 1792, 1024, 1024, 1024}; pg8::StaticOrder S; S.init(R, 1792, G, bx);
                pg8::EpiStore E{P, INW, INW, 1.0f};
                pg8::gemm_phase<pg8::EpiStore, pg8::StaticOrder, true, true>(ldsl, g, S, E); } }
            else if (sp == 2) { KP(); phase_rowwise(p, l); __syncthreads();
                REP(2) phase_pool(p);
                REP(3) for (int it = G - 1 - bx; it < 264; it += G) states_item(p, l, lds, it); __syncthreads(); }
            else if (sp == 3) { KP(); WL(); REP(4) { __syncthreads();
                { pg8::Gemm g{P + 768, wl + W_UQ, R, 768, 384, INW, 384}; pg8::StaticOrder S; S.init(R, 768, G, bx);
                  pg8::EpiStore E{(bf16_t*)(p.ws + OFF_OV + OV_Q), 768, 768, 0.14724444f};
                  pg8::gemm_phase<pg8::EpiStore, pg8::StaticOrder, true, true>(ldsl, g, S, E); }
                __syncthreads();
                { pg8::Gemm g{P + 1152, wl + W_KN, R, 512, 256, INW, 256}; pg8::StaticOrder S; S.init(R, 512, G, (bx + 58) % G);
                  pg8::EpiStore E{(bf16_t*)(p.ws + OFF_OV + OV_KN), 512, 512, 1.0f};
                  pg8::gemm_phase<pg8::EpiStore, pg8::StaticOrder, true, true>(ldsl, g, S, E); }
                __syncthreads();
                { pg8::Gemm g{wl + W_V, P + 1152, 512, R, 256, 256, INW}; pg8::StaticOrder S; S.init(512, R, G, (bx + 182) % G);
                  pg8::EpiStore E{(bf16_t*)(p.ws + OFF_OV + OV_VT), R, R, 1.0f};
                  pg8::gemm_phase<pg8::EpiStore, pg8::StaticOrder, true, true>(ldsl, g, S, E); }
                if (bx >= G - 64) scan_threads(p, l, (bx - (G - 64)) * NWG_T + otid()); } }
            else if (sp == 4) { KP();
                REP(5) for (int u = vcu; u < (l == 0 ? 528 : 512); u += G) attn_unit(p, lds, u);
                REP(6) for (int u = G - 1 - bx; u < (l == 0 ? 264 : 256); u += G) retout_unit(p, l, lds, l == 0 ? u : u + 4 * (u >> 7) + 4); }
            else if (sp == 5) { KP(); WL(); __syncthreads();
                { pg8::Gemm g{HN, wl + W_OUT, R, 1024, 1024, 1024, 1024}; pg8::StaticOrder S; S.init(16384, 1024, G, bx, 1);
                  pg8::EpiResid E{X, modv + 2048, 0};
                  pg8::gemm_phase<pg8::EpiResid, pg8::StaticOrder, true, true>(ldsl, g, S, E); }
                if (l == 0 && bx < 32) { __syncthreads(); const int q = bx >> 3;
                  pg8::Gemm g{HN + q * 256, wl + W_OUT + q * 256, 512, 1024, 256, 1024, 1024}; pg8::StaticOrder S; S.init(512, 1024, G, bx & 7, 2);
                  pg8::EpiPart E{(float*)(p.ws + OFF_PART) + (size_t)q * 524288, 0};
                  pg8::gemm_phase<pg8::EpiPart, pg8::StaticOrder, true, true>(ldsl, g, S, E); } }
            else if (sp == 6) { KP(); WL(); phase_norm(p, l, 1, false, l == 0 ? modv + 2 * 6144 + 2048 : nullptr); }
            else if (sp == 7) { KP(); WL(); REP(7) { __syncthreads();
                pg8::Gemm g{HN, wl + W_UP, R, 2 * DFF, 1024, 1024, 1024}; pg8::StaticOrder S; S.init(l == 1 ? 16384 : R, 2 * DFF, G, bx, l == 1 ? 1 : 0);
                pg8::EpiFfn E{(bf16_t*)(p.ws + OFF_OV), (float*)(p.ws + OFF_EDGE), p.conv_w + (size_t)l * 3 * 5632, p.conv_b + (size_t)l * 5632, (LAS float*)(ldsl + 131072)};
                pg8::gemm_phase<pg8::EpiFfn, pg8::StaticOrder, true, true>(ldsl, g, S, E); } }
            else if (sp == 8) { KP(); REP(8) phase_ffn_fixup(p, l); }
            else if (sp == 9) { KP(); WL(); __syncthreads();
                { pg8::Gemm g{(const bf16_t*)(p.ws + OFF_OV), wl + W_DN, R, 1024, DFF, DFF, DFF}; pg8::StaticOrder S; S.init(16384, 1024, G, bx, 1);
                  pg8::EpiResid E{X, modv + 5120, 0};
                  pg8::gemm_phase<pg8::EpiResid, pg8::StaticOrder, true, true>(ldsl, g, S, E); }
                if (l == 0 && bx < 32) { __syncthreads(); const int q = bx >> 3; const int koff = q < 2 ? q * 768 : 1536 + (q - 2) * 640, klen = q < 2 ? 768 : 640;
                  pg8::Gemm g{(const bf16_t*)(p.ws + OFF_OV) + koff, wl + W_DN + koff, 512, 1024, klen, DFF, DFF}; pg8::StaticOrder S; S.init(512, 1024, G, bx & 7, 2);
                  pg8::EpiPart E{(float*)(p.ws + OFF_PART) + (size_t)q * 524288, 0};
                  pg8::gemm_phase<pg8::EpiPart, pg8::StaticOrder, true, true>(ldsl, g, S, E); } }
        }
        if (ph + 1 < ph_hi) {
            if (ph == ph_lo) grid.sync();
            else { KP(); XcdBarrier b; b.bar = (unsigned*)(p.ws + OFF_CTL); b.x = xb_xcc_id(); b.st = misc; xcd_barrier(b); }
        }
    }
}

extern "C" void kernel_launch(void* const* d_in, const int* in_sizes, int n_in, void* d_out, int out_size, void* d_ws, size_t ws_size, hipStream_t stream) {
    static int grid = 0;
    if (grid == 0) {
        if (n_in != 23 || ws_size < WS_NEED) { fprintf(stderr, "kernel_launch: unexpected problem (n_in %d, ws %zu, need %zu)\n", n_in, ws_size, (size_t)WS_NEED); grid = -1; return; }
        int dev = 0, cus = 0, per_cu = 0;
        hipGetDevice(&dev); hipDeviceGetAttribute(&cus, hipDeviceAttributeMultiprocessorCount, dev);
        if (hipFuncSetAttribute((const void*)mk_fwd, hipFuncAttributeMaxDynamicSharedMemorySize, LDS_BYTES) != hipSuccess) { fprintf(stderr, "kernel_launch: hipFuncSetAttribute failed\n"); grid = -1; return; }
        if (hipOccupancyMaxActiveBlocksPerMultiprocessor(&per_cu, (const void*)mk_fwd, 512, LDS_BYTES) != hipSuccess || per_cu < 1) { fprintf(stderr, "kernel_launch: occupancy query says %d\n", per_cu); per_cu = 1; }
        (void)hipGetLastError();
        grid = cus * per_cu; if (grid > 256) grid = 256;
        fprintf(stderr, "kernel_launch: grid %d (cus %d, per_cu %d)\n", grid, cus, per_cu);
    }
    if (grid < 0) return;
    Params p{};
    const float** pp = (const float**)&p;
    for (int i = 0; i < 23; ++i) pp[i] = (const float*)d_in[i];
    p.out = (float*)d_out; p.ws = (unsigned char*)d_ws;
#if MK_MULTI
    for (int ph = 0; ph < N_PHASES; ++ph) { p.ph_lo = ph; p.ph_hi = ph + 1; void* args[] = {&p};
        hipError_t e = hipLaunchCooperativeKernel((void*)mk_fwd, dim3(grid), dim3(512), args, LDS_BYTES, stream);
        if (e != hipSuccess) { fprintf(stderr, "launch %d failed: %s\n", ph, hipGetErrorString(e)); break; } }
#else
    if (hipMemsetAsync((char*)d_ws + OFF_CTL, 0, CTL_BYTES, stream) != hipSuccess) { fprintf(stderr, "kernel_launch: memset of the barrier words failed\n"); return; }
    p.ph_lo = 0; p.ph_hi = N_PHASES; void* args[] = {&p};
    hipError_t e = hipLaunchCooperativeKernel((void*)mk_fwd, dim3(grid), dim3(512), args, LDS_BYTES, stream);
    if (e != hipSuccess) fprintf(stderr, "cooperative launch failed: %s (grid %d)\n", hipGetErrorString(e), grid);
#endif
}
```

```cpp
#include <hip/hip_runtime.h>
#include <hip/hip_cooperative_groups.h>
#include <cstdio>
#include <cstdint>
namespace cg = cooperative_groups;

#ifndef MK_MULTI
#define MK_MULTI 0
#endif

namespace pg8 {
#define PG8_LAS __attribute__((address_space(3)))
typedef unsigned short bf16_t;
typedef short bf16x8 __attribute__((ext_vector_type(8)));
typedef float f32x4 __attribute__((ext_vector_type(4)));
typedef unsigned u32x4 __attribute__((ext_vector_type(4)));
constexpr int BM = 256, BK = 64, HALF = 128, HTB = HALF * BK * 2  , STAGE_BYTES = 8 * HTB, NXCD = 8, WGM = 8;

__host__ __device__ __forceinline__ int lds_byte(int r, int c) { const int st = (r >> 4) * 2 + (c >> 5), rr = r & 15, cc = c & 31, ob = rr * 64 + cc * 2; return st * 1024 + (ob ^ (((ob >> 9) & 1) << 5)); }
__host__ __device__ __forceinline__ void stage_rc(int b, int& R, int& C) { const int st = b / 1024, sb = b % 1024, swz = sb ^ (((sb >> 9) & 1) << 5); R = (st >> 1) * 16 + swz / 64; C = (st & 1) * 32 + (swz % 64) / 2; }
__host__ __device__ __forceinline__ int perm32(int rho) { const int n = rho >> 4, i = rho & 15; return 8 * (i >> 2) + 4 * n + (i & 3); }

struct Unit { int pm, pn; };
struct Gemm { const bf16_t* A; const bf16_t* Bt; int M, N, K, lda, ldb; };

struct StaticOrder {
    int nM, nN, nwg, G, c, skip;
    __host__ __device__ void init(int M, int N, int G_, int c_, int skip_ = 0) { nM = M / BM; nN = N / BM; nwg = nM * nN; G = G_; c = c_; skip = skip_; }
    __host__ __device__ bool next(int i, Unit& u) const {
        const long L = (long)i * G + c; if (L >= nwg) return false;
        int wgid = (int)L; { const int q = nwg / NXCD, r = nwg % NXCD, xcd = wgid % NXCD, off = wgid / NXCD; wgid = (xcd < r ? xcd * (q + 1) : r * (q + 1) + (xcd - r) * q) + off; }
        const int nig = WGM * nN, gid = wgid / nig, fm = gid * WGM, gsz = (nM - fm) < WGM ? (nM - fm) : WGM;
        u.pm = fm + ((wgid % nig) % gsz); u.pn = (wgid % nig) / gsz; if (skip == 1) u.pm += 1 + (u.pm >= 32 ? 1 : 0); else if (skip == 2) u.pm *= 33; return true;
    }
    __device__ __forceinline__ void a_ready(const Unit&) const {}
    __device__ __forceinline__ void done(const Unit&) const {}
};

__device__ __forceinline__ unsigned cvt_pk_bf16(float lo, float hi) { unsigned r; asm volatile("v_cvt_pk_bf16_f32 %0, %1, %2" : "=v"(r) : "v"(lo), "v"(hi)); return r; }

struct EpiStore {
    static constexpr bool PERM = true, AFTER_DRAIN = false;
    bf16_t* O; int ldc; int ncols; float scale;
    __device__ __forceinline__ void operator()(const f32x4 (&acc)[2][2][4][2], const Unit& u, int wr, int wc, int fr, int fq) const {
        const int row0 = u.pm * BM + wr * 64 + fr; const int col0 = u.pn * BM + wc * 32 + 8 * fq;
#pragma unroll
        for (int ai = 0; ai < 2; ++ai)
#pragma unroll
            for (int m = 0; m < 4; ++m) { bf16_t* rowp = O + (size_t)(row0 + ai * HALF + m * 16) * ldc + col0;
#pragma unroll
                for (int bj = 0; bj < 2; ++bj) { if (col0 + bj * HALF < ncols) {
                    f32x4 v0 = acc[ai][bj][m][0] * scale, v1 = acc[ai][bj][m][1] * scale;
                    u32x4 w; w.x = cvt_pk_bf16(v0[0], v0[1]); w.y = cvt_pk_bf16(v0[2], v0[3]); w.z = cvt_pk_bf16(v1[0], v1[1]); w.w = cvt_pk_bf16(v1[2], v1[3]);
                    *(u32x4*)(rowp + bj * HALF) = w; } } }
    }
};
struct EpiResid {
    static constexpr bool PERM = false, AFTER_DRAIN = false;
    float* X; const float* gate; int row_tile0;
    __device__ __forceinline__ void operator()(const f32x4 (&acc)[2][2][4][2], const Unit& u, int wr, int wc, int fr, int fq) const {
        const int tpm = u.pm + row_tile0; const int bb = tpm / 33, jj = tpm - bb * 33; const float* gv = gate + (jj == 0 ? 2 : bb) * 6144;
        const int col0 = u.pn * BM + wc * 32 + 4 * fq;
#pragma unroll
        for (int ai = 0; ai < 2; ++ai)
#pragma unroll
            for (int m = 0; m < 4; ++m) { float* rowp = X + (size_t)(tpm * BM + ai * HALF + wr * 64 + m * 16 + fr) * 1024 + col0;
#pragma unroll
                for (int bj = 0; bj < 2; ++bj) {
#pragma unroll
                    for (int n = 0; n < 2; ++n) { f32x4* q = (f32x4*)(rowp + bj * HALF + n * 16); const f32x4 gq = *(const f32x4*)(gv + col0 + bj * HALF + n * 16); f32x4 xv = *q; xv = xv + gq * acc[ai][bj][m][n]; *q = xv; }
                    asm volatile("" ::: "memory"); } }
    }
};
struct EpiPart {
    static constexpr bool PERM = false, AFTER_DRAIN = false;
    float* out; int accum;
    __device__ __forceinline__ void operator()(const f32x4 (&acc)[2][2][4][2], const Unit& u, int wr, int wc, int fr, int fq) const {
        const int t = u.pm / 33; const int col0 = u.pn * BM + wc * 32 + 4 * fq;
#pragma unroll
        for (int ai = 0; ai < 2; ++ai)
#pragma unroll
            for (int m = 0; m < 4; ++m) { float* rowp = out + (size_t)(t * BM + ai * HALF + wr * 64 + m * 16 + fr) * 1024 + col0;
#pragma unroll
                for (int bj = 0; bj < 2; ++bj) {
#pragma unroll
                    for (int n = 0; n < 2; ++n) { f32x4* q = (f32x4*)(rowp + bj * HALF + n * 16); f32x4 v = acc[ai][bj][m][n]; if (accum) v = v + *q; *q = v; }
                    asm volatile("" ::: "memory"); } }
    }
};
template <int CTRL> __device__ __forceinline__ float dpp0(float x) { return __builtin_bit_cast(float, __builtin_amdgcn_update_dpp(0, __builtin_bit_cast(int, x), CTRL, 0xf, 0xf, true)); }
struct EpiFfn {
    static constexpr bool PERM = false, AFTER_DRAIN = false;
    bf16_t* ACT; float* EDGE; const float* cw; const float* cb; PG8_LAS float* xl;
    __device__ __forceinline__ void operator()(const f32x4 (&acc)[2][2][4][2], const Unit& u, int wr, int wc, int fr, int fq) const {
        PG8_LAS float* FIRST = xl; PG8_LAS float* LAST = xl + 1024;
        const int cb0 = wc * 32 + 4 * fq;
#pragma unroll
        for (int ai = 0; ai < 2; ++ai)
#pragma unroll
            for (int bj = 0; bj < 2; ++bj)
#pragma unroll
                for (int n = 0; n < 2; ++n) { const int col = bj * HALF + cb0 + n * 16;
                    if (fr == 0) *(PG8_LAS f32x4*)(FIRST + (2 * ai + wr) * 256 + col) = acc[ai][bj][0][n];
                    if (fr == 15) *(PG8_LAS f32x4*)(LAST + (2 * ai + wr) * 256 + col) = acc[ai][bj][3][n]; }
        if (wr == 0 && fr < 2) {
#pragma unroll
            for (int bj = 0; bj < 2; ++bj)
#pragma unroll
                for (int n = 0; n < 2; ++n) *(f32x4*)(EDGE + ((size_t)(u.pm * 4 + fr) * 22 + u.pn) * 256 + bj * HALF + cb0 + n * 16) = acc[0][bj][0][n]; }
        if (wr == 1 && fr >= 14) {
#pragma unroll
            for (int bj = 0; bj < 2; ++bj)
#pragma unroll
                for (int n = 0; n < 2; ++n) *(f32x4*)(EDGE + ((size_t)(u.pm * 4 + 2 + (fr - 14)) * 22 + u.pn) * 256 + bj * HALF + cb0 + n * 16) = acc[1][bj][3][n]; }
        asm volatile("s_waitcnt lgkmcnt(0)" ::: "memory"); __builtin_amdgcn_s_barrier(); asm volatile("" ::: "memory");
#pragma unroll
        for (int n = 0; n < 2; ++n) { const int ch0 = u.pn * HALF + cb0 + n * 16;
            f32x4 wa[3], wb[3];
#pragma unroll
            for (int k = 0; k < 3; ++k) { wa[k] = *(const f32x4*)(cw + k * 5632 + ch0); wb[k] = *(const f32x4*)(cw + k * 5632 + 2816 + ch0); }
            const f32x4 ba = *(const f32x4*)(cb + ch0), bb = *(const f32x4*)(cb + 2816 + ch0);
#pragma unroll
            for (int ai = 0; ai < 2; ++ai) { const int g = 2 * ai + wr;
                f32x4 bu[2], bd[2];
#pragma unroll
                for (int bj = 0; bj < 2; ++bj) { const int col = bj * HALF + cb0 + n * 16; const f32x4 zz = {0.f, 0.f, 0.f, 0.f};
                    bu[bj] = g > 0 ? *(const PG8_LAS f32x4*)(LAST + (g - 1) * 256 + col) : zz; bd[bj] = g < 3 ? *(const PG8_LAS f32x4*)(FIRST + (g + 1) * 256 + col) : zz; }
#pragma unroll
                for (int m = 0; m < 4; ++m) { float o[4];
#pragma unroll
                    for (int e = 0; e < 4; ++e) { float up[2], dn[2];
#pragma unroll
                        for (int bj = 0; bj < 2; ++bj) { const float cur = acc[ai][bj][m][n][e];
                            float x = dpp0<0x111>(cur);
                            if (m > 0) x += dpp0<0x10F>(acc[ai][bj][m - 1][n][e]); else x += (fr == 0 ? bu[bj][e] : 0.f);
                            float y = dpp0<0x101>(cur);
                            if (m < 3) y += dpp0<0x11F>(acc[ai][bj][m + 1][n][e]); else y += (fr == 15 ? bd[bj][e] : 0.f);
                            up[bj] = x; dn[bj] = y; }
                        const float ua = wa[0][e] * up[0] + wa[1][e] * acc[ai][0][m][n][e] + wa[2][e] * dn[0] + ba[e];
                        const float ub = wb[0][e] * up[1] + wb[1][e] * acc[ai][1][m][n][e] + wb[2][e] * dn[1] + bb[e];
                        o[e] = ua * __builtin_amdgcn_rcpf(1.0f + __builtin_amdgcn_exp2f(-1.4426950408889634f * ua)) * ub; }
                    typedef unsigned u32x2 __attribute__((ext_vector_type(2))); u32x2 w; w.x = cvt_pk_bf16(o[0], o[1]); w.y = cvt_pk_bf16(o[2], o[3]);
                    *(u32x2*)(ACT + (size_t)(u.pm * BM + ai * HALF + wr * 64 + m * 16 + fr) * 2816 + ch0) = w; } } }
    }
};

template <class Epi, class Sched, bool ALIGN_EPI = false, bool SP2 = false>
__device__ __forceinline__ void gemm_phase(PG8_LAS unsigned char* lds, const Gemm g, const Sched& S, const Epi& E) {
    int tid = threadIdx.x; asm volatile("" : "+v"(tid));
    const int wid = __builtin_amdgcn_readfirstlane(tid >> 6), lane = tid & 63, wr = wid >> 2, wc = wid & 3, fr = lane & 15, fq = lane >> 4;
    int K = g.K; asm volatile("" : "+s"(K));
    const int nt = K / BK;
    unsigned voffA[2], voffB[2];
#pragma unroll
    for (int i = 0; i < 2; ++i) { int R, C; stage_rc(tid * 16 + i * 8192, R, C); const int Rb = Epi::PERM ? ((R & ~31) + perm32(R & 31)) : R;
        voffA[i] = (unsigned)(R * g.lda + C) * 2u; voffB[i] = (unsigned)(Rb * g.ldb + C) * 2u; }
    const size_t kstep = (size_t)(BK * 2);
    const size_t hstepA = (size_t)HALF * g.lda * 2, hstepB = (size_t)HALF * g.ldb * 2;
    const size_t tstepA = 2 * hstepA, tstepB = 2 * hstepB;
    const unsigned ldsw = (unsigned)wid * 1024u;
    const int aoff = lds_byte(wr * 64 + fr, fq * 8), boff = lds_byte(wc * 32 + fr, fq * 8);
#define PG8_SA(b, h) (((b) * 2 + (h)) * HTB)
#define PG8_SB(b, h) ((4 + (b) * 2 + (h)) * HTB)
#define PG8_STAGE(bufoff, gbase, voff) do { _Pragma("unroll") for (int _i = 0; _i < 2; ++_i) \
        __builtin_amdgcn_global_load_lds((const unsigned*)((const char*)(gbase) + (voff)[_i]), (PG8_LAS unsigned*)(lds + (bufoff) + ldsw + _i * 8192), 16, 0, 0); } while (0)
#define PG8_LDA(dst, b, h) do { _Pragma("unroll") for (int m = 0; m < 4; ++m) _Pragma("unroll") for (int k = 0; k < 2; ++k) dst[m][k] = *(const PG8_LAS bf16x8*)(lds + PG8_SA(b, h) + aoff + m * 2048 + k * 1024); } while (0)
#define PG8_LDB(dst, b, h) do { _Pragma("unroll") for (int n = 0; n < 2; ++n) _Pragma("unroll") for (int k = 0; k < 2; ++k) dst[n][k] = *(const PG8_LAS bf16x8*)(lds + PG8_SB(b, h) + boff + n * 2048 + k * 1024); } while (0)
#define PG8_MMA(ai, bj, At, Bt) do { __builtin_amdgcn_s_setprio(1); _Pragma("unroll") for (int m = 0; m < 4; ++m) _Pragma("unroll") for (int n = 0; n < 2; ++n) _Pragma("unroll") for (int k = 0; k < 2; ++k) \
        acc[ai][bj][m][n] = __builtin_amdgcn_mfma_f32_16x16x32_bf16(Bt[n][k], At[m][k], acc[ai][bj][m][n], 0, 0, 0); __builtin_amdgcn_s_setprio(0); } while (0)
#define PG8_WAIT_V(n) asm volatile("s_waitcnt vmcnt(" #n ")" ::: "memory")
#define PG8_WAIT_L(n) asm volatile("s_waitcnt lgkmcnt(" #n ")" ::: "memory")
#define PG8_BAR __builtin_amdgcn_s_barrier()
#define PG8_SCHED __builtin_amdgcn_sched_barrier(0)
    Unit cur, nxt; int ui = 0;
    if (!S.next(0, cur)) return;
    f32x4 acc[2][2][4][2];
#pragma unroll
    for (int a = 0; a < 2; ++a)
#pragma unroll
        for (int b = 0; b < 2; ++b)
#pragma unroll
            for (int m = 0; m < 4; ++m)
#pragma unroll
                for (int n = 0; n < 2; ++n) acc[a][b][m][n] = (f32x4){0.f, 0.f, 0.f, 0.f};
    bf16x8 At[4][2], B0[2][2], B1[2][2];
    const char* cA = (const char*)g.A + (size_t)cur.pm * tstepA; const char* cB = (const char*)g.Bt + (size_t)cur.pn * tstepB;
    S.a_ready(cur);
    if constexpr (SP2) {
        PG8_STAGE(PG8_SB(0, 0), cB, voffB); PG8_STAGE(PG8_SB(0, 1), cB + hstepB, voffB); PG8_STAGE(PG8_SA(0, 0), cA, voffA); PG8_STAGE(PG8_SA(0, 1), cA + hstepA, voffA);
        if (wr == 1) PG8_BAR;
        PG8_WAIT_V(2); PG8_BAR;
        PG8_STAGE(PG8_SB(1, 0), cB + kstep, voffB); PG8_STAGE(PG8_SA(1, 0), cA + kstep, voffA); PG8_STAGE(PG8_SB(1, 1), cB + hstepB + kstep, voffB);
        PG8_WAIT_V(6); PG8_BAR;
    } else {
        PG8_STAGE(PG8_SB(0, 0), cB, voffB); PG8_STAGE(PG8_SA(0, 0), cA, voffA); PG8_STAGE(PG8_SB(0, 1), cB + hstepB, voffB); PG8_STAGE(PG8_SA(0, 1), cA + hstepA, voffA);
        if (wr == 1) PG8_BAR;
        PG8_WAIT_V(4); PG8_BAR;
        PG8_STAGE(PG8_SB(1, 0), cB + kstep, voffB); PG8_STAGE(PG8_SA(1, 0), cA + kstep, voffA); PG8_STAGE(PG8_SB(1, 1), cB + hstepB + kstep, voffB);
        PG8_WAIT_V(6); PG8_BAR;
    }
    for (;;) {
        const bool has_next = S.next(ui + 1, nxt);
        const char* nA = has_next ? (const char*)g.A + (size_t)nxt.pm * tstepA : cA; const char* nB = has_next ? (const char*)g.Bt + (size_t)nxt.pn * tstepB : cB;
        for (int t = 0; t < nt; t += 2) {
            const bool last = (t == nt - 2);
            const char* a1 = cA + (size_t)(t + 1) * kstep;
            const char* a2 = last ? nA : cA + (size_t)(t + 2) * kstep; const char* b2 = last ? nB : cB + (size_t)(t + 2) * kstep;
            const char* a3 = a2 + kstep; const char* b3 = b2 + kstep;
            if (last && has_next) S.a_ready(nxt);
            if constexpr (SP2) {
            PG8_LDB(B0, 0, 0); PG8_LDB(B1, 0, 1); PG8_SCHED; PG8_LDA(At, 0, 0); PG8_STAGE(PG8_SA(1, 1), a1 + hstepA, voffA);
            PG8_WAIT_V(8); PG8_WAIT_L(0); PG8_BAR; PG8_MMA(0, 0, At, B0); PG8_MMA(0, 1, At, B1); PG8_BAR; PG8_SCHED;
            PG8_LDA(At, 0, 1); PG8_STAGE(PG8_SB(0, 0), b2, voffB); PG8_STAGE(PG8_SB(0, 1), b2 + hstepB, voffB); PG8_STAGE(PG8_SA(0, 0), a2, voffA);
            PG8_WAIT_V(8); PG8_WAIT_L(0); PG8_BAR; PG8_MMA(1, 0, At, B0); PG8_MMA(1, 1, At, B1); PG8_BAR; PG8_SCHED;
            PG8_LDB(B0, 1, 0); PG8_LDB(B1, 1, 1); PG8_SCHED; PG8_LDA(At, 1, 0); PG8_STAGE(PG8_SA(0, 1), a2 + hstepA, voffA);
            PG8_WAIT_V(8); PG8_WAIT_L(0); PG8_BAR; PG8_MMA(0, 0, At, B0); PG8_MMA(0, 1, At, B1); PG8_BAR; PG8_SCHED;
            PG8_LDA(At, 1, 1); PG8_STAGE(PG8_SB(1, 0), b3, voffB); PG8_STAGE(PG8_SB(1, 1), b3 + hstepB, voffB); PG8_STAGE(PG8_SA(1, 0), a3, voffA);
            PG8_WAIT_V(8); PG8_WAIT_L(0); PG8_BAR; PG8_MMA(1, 0, At, B0); PG8_MMA(1, 1, At, B1); PG8_BAR; PG8_SCHED;
            } else {
            PG8_LDB(B0, 0, 0); PG8_SCHED; PG8_LDA(At, 0, 0); PG8_STAGE(PG8_SA(1, 1), a1 + hstepA, voffA);
            PG8_WAIT_L(8); PG8_BAR; PG8_WAIT_L(0); PG8_MMA(0, 0, At, B0); PG8_BAR; PG8_SCHED;
            PG8_LDB(B1, 0, 1); PG8_STAGE(PG8_SB(0, 0), b2, voffB);
            PG8_BAR; PG8_WAIT_L(0); PG8_MMA(0, 1, At, B1); PG8_BAR;
            PG8_LDA(At, 0, 1); PG8_STAGE(PG8_SA(0, 0), a2, voffA);
            PG8_BAR; PG8_WAIT_L(0); PG8_MMA(1, 0, At, B0); PG8_BAR; PG8_SCHED;
            PG8_STAGE(PG8_SB(0, 1), b2 + hstepB, voffB);
            PG8_WAIT_V(6); PG8_BAR; PG8_MMA(1, 1, At, B1); PG8_BAR;
            PG8_LDB(B0, 1, 0); PG8_SCHED; PG8_LDA(At, 1, 0); PG8_STAGE(PG8_SA(0, 1), a2 + hstepA, voffA);
            PG8_WAIT_L(8); PG8_BAR; PG8_WAIT_L(0); PG8_MMA(0, 0, At, B0); PG8_BAR; PG8_SCHED;
            PG8_LDB(B1, 1, 1); PG8_STAGE(PG8_SB(1, 0), b3, voffB);
            PG8_BAR; PG8_WAIT_L(0); PG8_MMA(0, 1, At, B1); PG8_BAR;
            PG8_LDA(At, 1, 1); PG8_STAGE(PG8_SA(1, 0), a3, voffA);
            PG8_BAR; PG8_WAIT_L(0); PG8_MMA(1, 0, At, B0); PG8_BAR; PG8_SCHED;
            PG8_STAGE(PG8_SB(1, 1), b3 + hstepB, voffB);
            PG8_WAIT_V(6); PG8_BAR; PG8_MMA(1, 1, At, B1); PG8_BAR;
            }
        }
        if constexpr (ALIGN_EPI) { if (wr == 0) PG8_BAR; }
        if constexpr (!Epi::AFTER_DRAIN) { E(acc, cur, wr, wc, fr, fq); S.done(cur); }
        if (!has_next) break;
#pragma unroll
        for (int a = 0; a < 2; ++a)
#pragma unroll
            for (int b = 0; b < 2; ++b)
#pragma unroll
                for (int m = 0; m < 4; ++m)
#pragma unroll
                    for (int n = 0; n < 2; ++n) acc[a][b][m][n] = (f32x4){0.f, 0.f, 0.f, 0.f};
        cur = nxt; cA = nA; cB = nB; ++ui;
        if constexpr (ALIGN_EPI) { if (wr == 1) PG8_BAR; }
    }
    PG8_WAIT_V(0);
    if constexpr (!ALIGN_EPI) { if (wr == 0) PG8_BAR; }
    PG8_BAR;
    if constexpr (Epi::AFTER_DRAIN) { E.fused(acc, cur, wr, wc, fr, fq, lds, wid, lane); S.done(cur); }
#undef PG8_SA
#undef PG8_SB
#undef PG8_STAGE
#undef PG8_LDA
#undef PG8_LDB
#undef PG8_MMA
#undef PG8_WAIT_V
#undef PG8_WAIT_L
#undef PG8_BAR
#undef PG8_SCHED
}
}

#define DEV __device__ __forceinline__
#define LAS __attribute__((address_space(3)))
typedef unsigned short bf16_t;
typedef short bf16x8 __attribute__((ext_vector_type(8)));
typedef float f32x4 __attribute__((ext_vector_type(4)));
typedef float f32x2 __attribute__((ext_vector_type(2)));
typedef float f32x16 __attribute__((ext_vector_type(16)));
typedef unsigned u32x4 __attribute__((ext_vector_type(4)));
typedef unsigned u32x2 __attribute__((ext_vector_type(2)));

constexpr int R = 16896, RB = 8448, NCTX = 256, TL = 8192, DM = 1024, INW = 1696, DFF = 2816, HFF = 1408;
constexpr int NWG_T = 512;
constexpr float EPS = 1e-6f;
constexpr int LDS_BYTES = 147456;
constexpr size_t OFF_X = 0, OFF_HN = 69206016, OFF_W = 103809024, OFF_MOD = 152174592, OFF_ROPE = 152436736, OFF_OV = 153485312;
constexpr size_t OV_Q = 0, OV_KN = 25952256, OV_VT = 43253760, OV_SLOC = 60555264, OV_SIN = 69206016, OV_U = 0;
constexpr size_t OFF_PART = 250100224;
constexpr size_t OFF_EDGE = 258488832;
constexpr size_t WS_NEED = OFF_EDGE + 5947392;
constexpr size_t W_IN = 0, W_UQ = 1835008, W_KN = 2129920, W_V = 2260992, W_OUT = 2392064, W_UP = 3440640, W_DN = 9207808, W_LAYER = 12091392;

struct Params {
    const float *x, *c, *ctx, *c_ctx, *w_mod, *b_mod, *norm1_g, *w_in, *ret_decay_f, *ret_decay_b, *mla_q_norm_g, *w_uq, *mla_kv_norm_g, *w_ukv,
        *pool_w, *pool_scale, *w_out, *norm2_g, *w_up, *conv_w, *conv_b, *w_down, *final_norm_g;
    float* out; unsigned char* ws; int ph_lo, ph_hi;
};

DEV int otid() { int t = threadIdx.x; asm volatile("" : "+v"(t)); return t; }
DEV float bf2f(unsigned short x) { return __uint_as_float((unsigned)x << 16); }
DEV unsigned f2bf(float f) { unsigned u = __float_as_uint(f); return (u + 0x7fffu + ((u >> 16) & 1u)) >> 16; }
DEV unsigned pk2(float lo, float hi) { return f2bf(lo) | (f2bf(hi) << 16); }
DEV float wave_sum(float v) {
#pragma unroll
    for (int o = 1; o < 64; o <<= 1) v += __shfl_xor(v, o);
    return v;
}
DEV float siluf(float x) { return x * __builtin_amdgcn_rcpf(1.0f + __builtin_amdgcn_exp2f(-1.4426950408889634f * x)); }
DEV int crow(int r, int hi) { return (r & 3) + 8 * (r >> 2) + 4 * hi; }
DEV bf16x8 pack8(float a0, float a1, float a2, float a3, float a4, float a5, float a6, float a7) {
    u32x4 w; w.x = pg8::cvt_pk_bf16(a0, a1); w.y = pg8::cvt_pk_bf16(a2, a3); w.z = pg8::cvt_pk_bf16(a4, a5); w.w = pg8::cvt_pk_bf16(a6, a7);
    return __builtin_bit_cast(bf16x8, w);
}
DEV int row_mi(int r) { const int b = r / RB; const int s = r - b * RB; return s < NCTX ? 2 : b; }

DEV void transpose_item(const float* W, int K, int Nsrc, bf16_t* WT, int n0, int cs, int k0, float* scr, int lane) {
#pragma unroll
    for (int i = 0; i < 32; ++i) { const int kk = 2 * i + (lane >> 5); scr[kk * 33 + (lane & 31)] = cs >= 0 ? W[(size_t)(k0 + kk) * Nsrc + cs + (lane & 31)] : 0.f; }
    asm volatile("s_waitcnt lgkmcnt(0)" ::: "memory");
    const int c = lane & 7;
#pragma unroll
    for (int j = 0; j < 4; ++j) { const int n = (lane >> 3) + 8 * j; const float* s = scr + (8 * c) * 33 + n;
        u32x4 o; o.x = pk2(s[0 * 33], s[1 * 33]); o.y = pk2(s[2 * 33], s[3 * 33]); o.z = pk2(s[4 * 33], s[5 * 33]); o.w = pk2(s[6 * 33], s[7 * 33]);
        *(u32x4*)(WT + (size_t)(n0 + n) * K + k0 + 8 * c) = o; }
    asm volatile("s_waitcnt lgkmcnt(0)" ::: "memory");
}
DEV int map_in(int n0) { return n0 < 1440 ? n0 : (n0 < INW ? -2 : -1); }
DEV int map_kn(int n0) { return (n0 >> 6) * 128 + (n0 & 63); }
DEV int map_v(int n0) { return (n0 >> 6) * 128 + 64 + (n0 & 63); }
DEV int map_up(int n0) { const int pn = n0 >> 8, w = n0 & 255; return w < 128 ? 128 * pn + w : DFF + 128 * pn + (w - 128); }

DEV void phase_prep(const Params& p, unsigned char* lds) {
    const int tid = otid(), lane = tid & 63, wid = tid >> 6;
    unsigned char* ws = p.ws;
    { f32x2* rope = (f32x2*)(ws + OFF_ROPE);
      for (int idx = blockIdx.x * NWG_T + tid; idx < TL * 16; idx += gridDim.x * NWG_T) { const int t = idx >> 4, i = idx & 15; const int pos = i < 8 ? (t >> 6) : (t & 63);
          const float inv = exp2f(-(float)(i & 7) * 0.125f * 13.287712379549449f); const float ang = (float)pos * inv; f32x2 cs; cs.x = __cosf(ang); cs.y = __sinf(ang); rope[idx] = cs; } }
    { float* scv = (float*)lds;
      float* red = scv + 3 * 1024;
      for (int i = tid; i < 3 * 1024; i += NWG_T) { const int v = i >> 10, k = i & 1023; const float cv = v < 2 ? p.c[v * 1024 + k] : p.c_ctx[k]; scv[i] = siluf(cv); }
      __syncthreads();
      float* modv = (float*)(ws + OFF_MOD);
      for (int it = blockIdx.x; it < 192; it += gridDim.x) { const int l = it / 96, col0 = (it % 96) * 64;
          const float* wm = p.w_mod + (size_t)l * 1024 * 6144 + col0 + lane; float a0 = 0.f, a1 = 0.f, a2 = 0.f;
#pragma unroll 16
          for (int k = wid * 128; k < wid * 128 + 128; ++k) { const float w = wm[(size_t)k * 6144]; a0 += scv[k] * w; a1 += scv[1024 + k] * w; a2 += scv[2048 + k] * w; }
          red[(wid * 3 + 0) * 64 + lane] = a0; red[(wid * 3 + 1) * 64 + lane] = a1; red[(wid * 3 + 2) * 64 + lane] = a2;
          __syncthreads();
          if (tid < 192) { const int v = tid >> 6, cl = tid & 63; float s = 0.f;
#pragma unroll
              for (int w = 0; w < 8; ++w) s += red[(w * 3 + v) * 64 + cl];
              modv[((size_t)l * 3 + v) * 6144 + col0 + cl] = s + p.b_mod[l * 6144 + col0 + cl]; }
          __syncthreads(); }
    }
}
DEV void phase_prep_weights(const Params& p, unsigned char* lds) {
    const int tid = otid(), lane = tid & 63, wid = tid >> 6;
    unsigned char* ws = p.ws;
    { float* scr = (float*)(lds + 32768 + wid * 8704);
      const int gw = blockIdx.x * 8 + wid, NGW = gridDim.x * 8;
      constexpr int I_IN = 16 * 56, I_UQ = 6 * 24, I_KN = 4 * 16, I_V = 4 * 16, I_OUT = 16 * 32, I_UP = 16 * 176, I_DN = 44 * 32, I_L = I_IN + I_UQ + I_KN + I_V + I_OUT + I_UP + I_DN;
      for (int it = gw; it < 2 * I_L; it += NGW) { const int l = it / I_L; int r = it - l * I_L; bf16_t* wl = (bf16_t*)(ws + OFF_W) + (size_t)l * W_LAYER;
          const float* src; int K, Nsrc, nbn, mp; size_t doff;
          if (r < I_IN) { src = p.w_in + (size_t)l * 1024 * INW; K = 1024; Nsrc = INW; nbn = 56; mp = 1; doff = W_IN; }
          else if ((r -= I_IN) < I_UQ) { src = p.w_uq + (size_t)l * 384 * 768; K = 384; Nsrc = 768; nbn = 24; mp = 0; doff = W_UQ; }
          else if ((r -= I_UQ) < I_KN) { src = p.w_ukv + (size_t)l * 256 * 1024; K = 256; Nsrc = 1024; nbn = 16; mp = 2; doff = W_KN; }
          else if ((r -= I_KN) < I_V) { src = p.w_ukv + (size_t)l * 256 * 1024; K = 256; Nsrc = 1024; nbn = 16; mp = 3; doff = W_V; }
          else if ((r -= I_V) < I_OUT) { src = p.w_out + (size_t)l * 1024 * 1024; K = 1024; Nsrc = 1024; nbn = 32; mp = 0; doff = W_OUT; }
          else if ((r -= I_OUT) < I_UP) { src = p.w_up + (size_t)l * 1024 * 5632; K = 1024; Nsrc = 5632; nbn = 176; mp = 4; doff = W_UP; }
          else { r -= I_UP; src = p.w_down + (size_t)l * DFF * 1024; K = DFF; Nsrc = 1024; nbn = 32; mp = 0; doff = W_DN; }
          const int kb = r / nbn, nb = r - kb * nbn, n0 = nb * 32;
          const int cs = mp == 0 ? n0 : mp == 1 ? map_in(n0) : mp == 2 ? map_kn(n0) : mp == 3 ? map_v(n0) : map_up(n0);
          if (cs != -2) transpose_item(src, K, Nsrc, wl + doff, n0, cs, kb * 64, scr, lane); }
    }
    { for (int idx = blockIdx.x * NWG_T + tid; idx < 2 * 1024 * 256; idx += gridDim.x * NWG_T) { const int n = idx & 255, k = (idx >> 8) & 1023, l = idx >> 18; const int g = n >> 6, d = n & 63;
          const float* wr = p.w_in + ((size_t)l * 1024 + k) * INW + 1440 + g * 64; const float* pw = p.pool_w + ((size_t)(l * 4 + g) * 64) * 64 + d; float s = 0.f;
#pragma unroll 8
          for (int c = 0; c < 64; ++c) s += wr[c] * pw[c * 64];
          ((bf16_t*)(ws + OFF_W) + (size_t)l * W_LAYER + W_IN)[(size_t)(1440 + n) * 1024 + k] = (bf16_t)f2bf(s * p.pool_scale[l * 256 + n]); } }
}

DEV void phase_norm(const Params& p, int l, int which, bool first, const float* pgate) {
    const int tid = otid(); const int lane = tid & 63, wid = tid >> 6; const int gw = blockIdx.x * 8 + wid, NGW = gridDim.x * 8;
    float* X = (float*)(p.ws + OFF_X); bf16_t* HN = (bf16_t*)(p.ws + OFF_HN);
    const float* modv = (const float*)(p.ws + OFF_MOD) + (size_t)l * 3 * 6144;
    const float* g = (which == 0 ? p.norm1_g : p.norm2_g) + l * 1024;
    for (int r = gw; r < R; r += NGW) {
        const int b = r / RB, s = r - b * RB; const int mi = s < NCTX ? 2 : b;
        const float* src = first ? (s < NCTX ? p.ctx + ((size_t)b * NCTX + s) * 1024 : p.x + ((size_t)b * TL + (s - NCTX)) * 1024) : X + (size_t)r * 1024;
        const f32x4* xr = (const f32x4*)src + lane; f32x4 v[4]; float ss = 0.f;
#pragma unroll
        for (int j = 0; j < 4; ++j) { v[j] = xr[64 * j]; ss += (v[j].x * v[j].x + v[j].y * v[j].y) + (v[j].z * v[j].z + v[j].w * v[j].w); }
        if (pgate != nullptr && s < NCTX) { const float* PART = (const float*)(p.ws + OFF_PART) + (size_t)(b * NCTX + s) * 1024; ss = 0.f;
#pragma unroll
            for (int j = 0; j < 4; ++j) { const f32x4 gq = ((const f32x4*)pgate)[lane + 64 * j]; f32x4 a = ((const f32x4*)PART)[lane + 64 * j];
#pragma unroll
                for (int q = 1; q < 4; ++q) a = a + ((const f32x4*)(PART + (size_t)q * 524288))[lane + 64 * j];
                v[j] = v[j] + gq * a; ss += (v[j].x * v[j].x + v[j].y * v[j].y) + (v[j].z * v[j].z + v[j].w * v[j].w); } }
        if (first || (pgate != nullptr && s < NCTX)) { f32x4* xo = (f32x4*)(X + (size_t)r * 1024) + lane;
#pragma unroll
            for (int j = 0; j < 4; ++j) xo[64 * j] = v[j]; }
        const float rs = rsqrtf(wave_sum(ss) * (1.f / 1024.f) + EPS);
        const float* mv = modv + mi * 6144 + (which == 0 ? 0 : 3072);
        u32x2* o8 = (u32x2*)(HN + (size_t)r * 1024) + lane;
#pragma unroll
        for (int j = 0; j < 4; ++j) { const f32x4 gg = ((const f32x4*)g)[lane + 64 * j], sh = ((const f32x4*)mv)[lane + 64 * j], sc = ((const f32x4*)(mv + 1024))[lane + 64 * j];
            const f32x4 y = v[j] * rs * gg; const f32x4 h = y * (sc + 1.0f) + sh; u32x2 w; w.x = pk2(h.x, h.y); w.y = pk2(h.z, h.w); o8[64 * j] = w; }
    }
}
DEV void phase_final(const Params& p) {
    const int tid = otid(); const int lane = tid & 63, wid = tid >> 6; const int gw = blockIdx.x * 8 + wid, NGW = gridDim.x * 8;
    const float* X = (const float*)(p.ws + OFF_X);
    for (int q = gw; q < 2 * TL; q += NGW) { const int b = q / TL, t = q - b * TL; const int r = b * RB + NCTX + t;
        const f32x4* xr = (const f32x4*)(X + (size_t)r * 1024) + lane; f32x4 v[4]; float ss = 0.f;
#pragma unroll
        for (int j = 0; j < 4; ++j) { v[j] = xr[64 * j]; ss += (v[j].x * v[j].x + v[j].y * v[j].y) + (v[j].z * v[j].z + v[j].w * v[j].w); }
        const float rs = rsqrtf(wave_sum(ss) * (1.f / 1024.f) + EPS);
        f32x4* o = (f32x4*)(p.out + (size_t)q * 1024) + lane;
#pragma unroll
        for (int j = 0; j < 4; ++j) { const f32x4 gg = ((const f32x4*)p.final_norm_g)[lane + 64 * j]; o[64 * j] = v[j] * rs * gg; } }
}

DEV void phase_rowwise(const Params& p, int l) {
    const int tid = otid(); const int lane = tid & 63, wid = tid >> 6; const int gw = blockIdx.x * 8 + wid, NGW = gridDim.x * 8;
    bf16_t* P = (bf16_t*)p.out; const f32x2* rope = (const f32x2*)(p.ws + OFF_ROPE);
    const float* qg = p.mla_q_norm_g + l * 384; const float* kg = p.mla_kv_norm_g + l * 256;
    float qgv[6];
#pragma unroll
    for (int j = 0; j < 3; ++j) { qgv[2 * j] = qg[2 * (lane + 64 * j)]; qgv[2 * j + 1] = qg[2 * (lane + 64 * j) + 1]; }
    const f32x4 kgv = ((const f32x4*)kg)[lane];
    for (int r0 = gw; r0 < R; r0 += 2 * NGW) {
        unsigned wq[2][3]; u32x2 wk[2]; float x1[2], x2[2]; f32x2 cs[2]; bool val[2], lat[2];
#pragma unroll
        for (int i = 0; i < 2; ++i) { const int r = r0 + i * NGW; val[i] = r < R; const int rr = val[i] ? r : r0; bf16_t* pr = P + (size_t)rr * INW; const int s = rr % RB; lat[i] = s >= NCTX;
            const unsigned* q2 = (const unsigned*)(pr + 768) + lane;
#pragma unroll
            for (int j = 0; j < 3; ++j) wq[i][j] = q2[64 * j];
            wk[i] = *((const u32x2*)(pr + 1152) + lane);
            const int li = lane & 15; x1[i] = bf2f(pr[1408 + li]); x2[i] = bf2f(pr[1408 + 16 + li]); cs[i] = rope[(lat[i] ? s - NCTX : 0) * 16 + li]; }
#pragma unroll
        for (int i = 0; i < 2; ++i) { if (!val[i]) continue; const int r = r0 + i * NGW; bf16_t* pr = P + (size_t)r * INW;
            { float ss = 0.f;
#pragma unroll
              for (int j = 0; j < 3; ++j) { const float a = bf2f(wq[i][j] & 0xffff), c2 = bf2f(wq[i][j] >> 16); ss += a * a + c2 * c2; }
              const float rs = rsqrtf(wave_sum(ss) * (1.f / 384.f) + EPS); unsigned* q2 = (unsigned*)(pr + 768) + lane;
#pragma unroll
              for (int j = 0; j < 3; ++j) q2[64 * j] = pk2(bf2f(wq[i][j] & 0xffff) * rs * qgv[2 * j], bf2f(wq[i][j] >> 16) * rs * qgv[2 * j + 1]); }
            { const float a0 = bf2f(wk[i].x & 0xffff), a1 = bf2f(wk[i].x >> 16), a2 = bf2f(wk[i].y & 0xffff), a3 = bf2f(wk[i].y >> 16);
              const float rs = rsqrtf(wave_sum((a0 * a0 + a1 * a1) + (a2 * a2 + a3 * a3)) * (1.f / 256.f) + EPS);
              u32x2 o; o.x = pk2(a0 * rs * kgv.x, a1 * rs * kgv.y); o.y = pk2(a2 * rs * kgv.z, a3 * rs * kgv.w); *((u32x2*)(pr + 1152) + lane) = o; }
            if (lat[i] && lane < 16) { pr[1408 + lane] = (bf16_t)f2bf(x1[i] * cs[i].x - x2[i] * cs[i].y); pr[1408 + 16 + lane] = (bf16_t)f2bf(x2[i] * cs[i].x + x1[i] * cs[i].y); } }
    }
}

DEV void phase_pool(const Params& p) {
    const int tid = otid(); const bf16_t* P = (const bf16_t*)p.out; bf16_t* MIX = (bf16_t*)(p.ws + OFF_HN);
    for (int idx = blockIdx.x * NWG_T + tid; idx < R * 32; idx += gridDim.x * NWG_T) { const int r = idx >> 5, cg = idx & 31; const int half = 1 << (cg >> 3);
        const int b = r / RB, s = r - b * RB; const int seq0 = s < NCTX ? b * RB : b * RB + NCTX; const int T = s < NCTX ? NCTX : TL; const int t = r - seq0;
        const int lo = max(t - half, 0), hi = min(t + half, T); float sum[8];
#pragma unroll
        for (int j = 0; j < 8; ++j) sum[j] = 0.f;
        const bf16_t* base = P + (size_t)seq0 * INW + 1440 + cg * 8;
        { bf16x8 wv[16]; const bf16x8 zz = {0, 0, 0, 0, 0, 0, 0, 0};
#pragma unroll
          for (int k = 0; k < 16; ++k) { const int tt = t - 8 + k; wv[k] = (tt >= lo && tt < hi) ? *(const bf16x8*)(base + (size_t)tt * INW) : zz; }
#pragma unroll
          for (int k = 0; k < 16; ++k)
#pragma unroll
              for (int j = 0; j < 8; ++j) sum[j] += bf2f((unsigned short)wv[k][j]); }
        const bf16x8 me = *(const bf16x8*)(base + (size_t)t * INW); const float ic = 1.0f / (float)(hi - lo); float o[8];
#pragma unroll
        for (int j = 0; j < 8; ++j) o[j] = sum[j] * ic - bf2f((unsigned short)me[j]);
        *(bf16x8*)(MIX + (size_t)r * 1024 + 768 + cg * 8) = pack8(o[0], o[1], o[2], o[3], o[4], o[5], o[6], o[7]); }
}

DEV float log2_sigmoid(float d) { return -log1pf(__expf(-d)) * 1.4426950408889634f; }
constexpr int ST_P = 272;
DEV void states_item(const Params& p, int l, unsigned char* lds, int it) {
    const int tid = otid(), lane = tid & 63, wid = tid >> 6, l32 = lane & 31, hi = lane >> 5;
    const bf16_t* P = (const bf16_t*)p.out; const f32x2* rope = (const f32x2*)(p.ws + OFF_ROPE);
    float* SLOC = (float*)(p.ws + OFF_OV + OV_SLOC);
    const int gc = it >> 1, hp = it & 1;
    unsigned char* VTl = lds;
    unsigned char* KTl = lds + 2 * 64 * ST_P;
    const int cb = gc % 66; const bool lat = cb >= 2; const int t0 = (cb - 2) * 128; const int r0 = gc * 128;
    __syncthreads();
    { const int tok = tid >> 2, hh = (tid >> 1) & 1, c = tid & 1; const int h = 2 * hp + hh;
      const bf16_t* src = P + (size_t)(r0 + tok) * INW + 128 + h * 32 + 8 * c; const bf16x8 lo = *(const bf16x8*)src, hi8 = *(const bf16x8*)(src + 16);
      const float df = exp2f(log2_sigmoid(p.ret_decay_f[l * 4 + h]) * (float)(127 - tok)) * 0.17677669529663687f, db = exp2f(log2_sigmoid(p.ret_decay_b[l * 4 + h]) * (float)tok) * 0.17677669529663687f;
#pragma unroll
      for (int j = 0; j < 8; ++j) { float x1 = bf2f((unsigned short)lo[j]), x2 = bf2f((unsigned short)hi8[j]);
          if (lat) { const f32x2 cs = rope[(t0 + tok) * 16 + 8 * c + j]; const float y1 = x1 * cs.x - x2 * cs.y, y2 = x2 * cs.x + x1 * cs.y; x1 = y1; x2 = y2; }
          bf16_t* kf = (bf16_t*)(KTl + ((hh * 2 + 0) * 32 + 8 * c + j) * ST_P) + tok; bf16_t* kb = (bf16_t*)(KTl + ((hh * 2 + 1) * 32 + 8 * c + j) * ST_P) + tok;
          kf[0] = (bf16_t)f2bf(x1 * df); kb[0] = (bf16_t)f2bf(x1 * db);
          *(bf16_t*)((unsigned char*)kf + 16 * ST_P) = (bf16_t)f2bf(x2 * df); *(bf16_t*)((unsigned char*)kb + 16 * ST_P) = (bf16_t)f2bf(x2 * db); } }
    for (int task = tid; task < 2048; task += NWG_T) { const int hh = task >> 10, tok = (task >> 3) & 127, ch = task & 7;
        const bf16x8 v = *(const bf16x8*)(P + (size_t)(r0 + tok) * INW + 256 + (2 * hp + hh) * 64 + ch * 8);
#pragma unroll
        for (int j = 0; j < 8; ++j) *((bf16_t*)(VTl + (hh * 64 + ch * 8 + j) * ST_P) + tok) = (bf16_t)v[j]; }
    __syncthreads();
    { const int hh = wid >> 2, dir = (wid >> 1) & 1, dvb = wid & 1; const int h = 2 * hp + hh;
      const unsigned char* ap = VTl + (hh * 64 + 32 * dvb + l32) * ST_P + hi * 16; const unsigned char* bp = KTl + ((hh * 2 + dir) * 32 + l32) * ST_P + hi * 16;
      bf16x8 af[8], bfr[8];
#pragma unroll
      for (int ks = 0; ks < 8; ++ks) { af[ks] = *(const bf16x8*)(ap + ks * 32); bfr[ks] = *(const bf16x8*)(bp + ks * 32); }
      f32x16 acc;
#pragma unroll
      for (int r = 0; r < 16; ++r) acc[r] = 0.f;
#pragma unroll
      for (int ks = 0; ks < 8; ++ks) acc = __builtin_amdgcn_mfma_f32_32x32x16_bf16(af[ks], bfr[ks], acc, 0, 0, 0);
      float* o = SLOC + ((size_t)(gc * 4 + h) * 2 + dir) * 2048 + l32 * 64 + 32 * dvb + 4 * hi;
#pragma unroll
      for (int g4 = 0; g4 < 4; ++g4) *(f32x4*)(o + 8 * g4) = (f32x4){acc[4 * g4], acc[4 * g4 + 1], acc[4 * g4 + 2], acc[4 * g4 + 3]}; }
}
DEV void scan_threads(const Params& p, int l, int gid) {
    if (gid >= 32768) return;
    const int e = gid & 2047, dir = (gid >> 11) & 1, h = (gid >> 12) & 3, b = gid >> 14;
    const float* SLOC = (const float*)(p.ws + OFF_OV + OV_SLOC); float* SIN = (float*)(p.ws + OFF_OV + OV_SIN);
    const float gC = exp2f(log2_sigmoid((dir == 0 ? p.ret_decay_f : p.ret_decay_b)[l * 4 + h]) * 128.f);
    float S = 0.f;
#pragma unroll 6
    for (int st = 0; st < 66; ++st) { const int cb = dir == 0 ? st : (st < 2 ? 1 - st : 67 - st); const size_t idx = ((size_t)((b * 66 + cb) * 4 + h) * 2 + dir) * 2048 + e;
        const float v = SLOC[idx]; SIN[idx] = S; S = S * gC + v; }
}

constexpr int AT_KP = 208, AT_VP = 144, AT_KB = 64 * AT_KP, AT_VBS = 64 * AT_VP, AT_V0 = 4 * AT_KB;
DEV float at_max32(const f32x16& s0, const f32x16& s1) {
    float m0 = __builtin_fmaxf(__builtin_fmaxf(s0[0], s0[1]), s0[2]), m1 = __builtin_fmaxf(__builtin_fmaxf(s1[0], s1[1]), s1[2]);
    m0 = __builtin_fmaxf(__builtin_fmaxf(m0, s0[3]), s0[4]); m1 = __builtin_fmaxf(__builtin_fmaxf(m1, s1[3]), s1[4]);
    m0 = __builtin_fmaxf(__builtin_fmaxf(m0, s0[5]), s0[6]); m1 = __builtin_fmaxf(__builtin_fmaxf(m1, s1[5]), s1[6]);
    m0 = __builtin_fmaxf(__builtin_fmaxf(m0, s0[7]), s0[8]); m1 = __builtin_fmaxf(__builtin_fmaxf(m1, s1[7]), s1[8]);
    m0 = __builtin_fmaxf(__builtin_fmaxf(m0, s0[9]), s0[10]); m1 = __builtin_fmaxf(__builtin_fmaxf(m1, s1[9]), s1[10]);
    m0 = __builtin_fmaxf(__builtin_fmaxf(m0, s0[11]), s0[12]); m1 = __builtin_fmaxf(__builtin_fmaxf(m1, s1[11]), s1[12]);
    m0 = __builtin_fmaxf(__builtin_fmaxf(m0, s0[13]), s0[14]); m1 = __builtin_fmaxf(__builtin_fmaxf(m1, s1[13]), s1[14]);
    return __builtin_fmaxf(__builtin_fmaxf(m0, s0[15]), __builtin_fmaxf(m1, s1[15]));
}
DEV void attn_unit(const Params& p, unsigned char* lds, int u) {
    const int tid = otid(), lane = tid & 63, wid = tid >> 6, l32 = lane & 31, hi = lane >> 5;
    const bf16_t* Q = (const bf16_t*)(p.ws + OFF_OV + OV_Q); const bf16_t* KN = (const bf16_t*)(p.ws + OFF_OV + OV_KN); const bf16_t* VT = (const bf16_t*)(p.ws + OFF_OV + OV_VT);
    const bf16_t* P = (const bf16_t*)p.out; bf16_t* MIX = (bf16_t*)(p.ws + OFF_HN); const f32x2* rope = (const f32x2*)(p.ws + OFF_ROPE);
    const bool isctx = u >= 512; int b, h, qrow0, NT;
    if (!isctx) { b = u >> 8; h = (u >> 5) & 7; qrow0 = b * RB + NCTX + (u & 31) * 256; NT = 132; } else { const int v = u - 512; b = v >> 3; h = v & 7; qrow0 = b * RB; NT = 4; }
    const int krow0 = b * RB; const int qrow = qrow0 + wid * 32 + l32;
    bf16x8 qf[6];
    { const bf16_t* qp = Q + (size_t)qrow * 768 + h * 96 + hi * 8;
#pragma unroll
      for (int d0 = 0; d0 < 6; ++d0) qf[d0] = *(const bf16x8*)(qp + d0 * 16);
      if (!isctx) { const f32x2* rp = rope + (size_t)(qrow - (b * RB + NCTX)) * 16 + hi * 8;
#pragma unroll
          for (int j = 0; j < 8; ++j) { const f32x2 cs = rp[j]; const float x1 = bf2f((unsigned short)qf[4][j]), x2 = bf2f((unsigned short)qf[5][j]);
              qf[4][j] = (short)f2bf(x1 * cs.x - x2 * cs.y); qf[5][j] = (short)f2bf(x2 * cs.x + x1 * cs.y); } } }
    const bf16_t* sp[3]; int sstep[3], lo[3];
#pragma unroll
    for (int k = 0; k < 2; ++k) { const int c = tid + k * 512; const int key = c / 12, part = c - key * 12; lo[k] = key * AT_KP + part * 16;
        if (part < 8) { sp[k] = KN + (size_t)(krow0 + key) * 512 + h * 64 + part * 8; sstep[k] = 64 * 512; } else { sp[k] = P + (size_t)(krow0 + key) * INW + 1408 + (part - 8) * 8; sstep[k] = 64 * INW; } }
    { const int dv = tid >> 3, kc = tid & 7; lo[2] = dv * AT_VP + (kc >> 1) * 32 + (kc & 1) * 8;   sp[2] = VT + (size_t)(h * 64 + dv) * R + krow0 + kc * 8; sstep[2] = 64; }
    const bool hasK2 = tid < 256;
    u32x4 st[3];
#define AT_GLOADK() do { st[0] = *(const u32x4*)sp[0]; sp[0] += sstep[0]; if (hasK2) { st[1] = *(const u32x4*)sp[1]; sp[1] += sstep[1]; } } while (0)
#define AT_GLOADV() do { st[2] = *(const u32x4*)sp[2]; sp[2] += sstep[2]; } while (0)
#define AT_LSTOREK(buf) do { *(u32x4*)((buf) + lo[0]) = st[0]; if (hasK2) *(u32x4*)((buf) + lo[1]) = st[1]; } while (0)
#define AT_LSTOREV(buf) do { unsigned char* d_ = (buf) + lo[2]; *(u32x2*)d_ = (u32x2){st[2].x, st[2].y}; *(u32x2*)(d_ + 16) = (u32x2){st[2].z, st[2].w}; } while (0)
#define AT_SB() __builtin_amdgcn_sched_barrier(0)
    f32x16 o0, o1, sa0, sa1, sb0, sb1, negm;
#pragma unroll
    for (int r = 0; r < 16; ++r) { o0[r] = 0.f; o1[r] = 0.f; sa0[r] = 0.f; sa1[r] = 0.f; negm[r] = 0.f; }
    float mrun = 0.f, lsum = 0.f;
    __syncthreads();
    AT_GLOADK(); AT_GLOADV(); AT_LSTOREK(lds); AT_LSTOREV(lds + AT_V0);
    AT_GLOADK(); AT_GLOADV(); AT_LSTOREK(lds + AT_KB); AT_LSTOREV(lds + AT_V0 + AT_VBS);
    AT_GLOADK(); AT_LSTOREK(lds + 2 * AT_KB);
    __syncthreads();
    { const unsigned char* ka = lds + l32 * AT_KP + hi * 16;
#pragma unroll
      for (int d0 = 0; d0 < 6; ++d0) { const bf16x8 a0 = *(const bf16x8*)(ka + d0 * 32), a1 = *(const bf16x8*)(ka + 32 * AT_KP + d0 * 32);
          sa0 = __builtin_amdgcn_mfma_f32_32x32x16_bf16(a0, qf[d0], sa0, 0, 0, 0); sa1 = __builtin_amdgcn_mfma_f32_32x32x16_bf16(a1, qf[d0], sa1, 0, 0, 0); } }
#define AT_STEP(SA0, SA1, SB0, SB1, tt) do { \
        const int t_ = (tt); const bool nxt_ = t_ + 1 < NT; \
        const unsigned char* kb_ = lds + ((t_ + 1) & 3) * AT_KB; const unsigned char* vb_ = lds + AT_V0 + (t_ & 3) * AT_VBS; \
        if (t_ + 3 < NT) AT_GLOADK(); \
        if (t_ + 2 < NT) AT_GLOADV(); \
        bf16x8 kfr[12]; bf16x8 vfr[8]; \
        { const unsigned char* ka = kb_ + l32 * AT_KP + hi * 16; \
          _Pragma("unroll") for (int d0 = 0; d0 < 6; ++d0) { kfr[2 * d0] = *(const bf16x8*)(ka + d0 * 32); kfr[2 * d0 + 1] = *(const bf16x8*)(ka + 32 * AT_KP + d0 * 32); } } \
        { const float mx = mxc; \
          if (t_ == 0 || __any(mx > 8.0f)) { \
              const float rm = fmaxf(mx, __shfl_xor(mx, 32)); const float delta = (t_ == 0) ? rm : fmaxf(rm, 0.f); const float alpha = (t_ == 0) ? 1.0f : __builtin_amdgcn_exp2f(-delta); \
              mrun += delta; \
              _Pragma("unroll") for (int r = 0; r < 16; ++r) { SA0[r] -= delta; SA1[r] -= delta; o0[r] *= alpha; o1[r] *= alpha; } \
              lsum *= alpha; { const float nm = -mrun; _Pragma("unroll") for (int r = 0; r < 16; ++r) negm[r] = nm; } } } \
        float ls0 = 0.f, ls1 = 0.f; \
        AT_SB(); \
        _Pragma("unroll") for (int i = 0; i < 8; ++i) { \
            if (i == 0) SB0 = __builtin_amdgcn_mfma_f32_32x32x16_bf16(kfr[0], qf[0], negm, 0, 0, 0); else if (i == 1) SB1 = __builtin_amdgcn_mfma_f32_32x32x16_bf16(kfr[1], qf[0], negm, 0, 0, 0); \
            else if (i & 1) SB1 = __builtin_amdgcn_mfma_f32_32x32x16_bf16(kfr[i], qf[i >> 1], SB1, 0, 0, 0); else SB0 = __builtin_amdgcn_mfma_f32_32x32x16_bf16(kfr[i], qf[i >> 1], SB0, 0, 0, 0); \
            SA0[2 * i] = __builtin_amdgcn_exp2f(SA0[2 * i]); SA0[2 * i + 1] = __builtin_amdgcn_exp2f(SA0[2 * i + 1]); SA1[2 * i] = __builtin_amdgcn_exp2f(SA1[2 * i]); SA1[2 * i + 1] = __builtin_amdgcn_exp2f(SA1[2 * i + 1]); \
            ls0 += SA0[2 * i] + SA0[2 * i + 1]; ls1 += SA1[2 * i] + SA1[2 * i + 1]; \
            AT_SB(); } \
        { const unsigned char* va = vb_ + l32 * AT_VP + hi * 16; \
          _Pragma("unroll") for (int kj = 0; kj < 4; ++kj) { vfr[2 * kj] = *(const bf16x8*)(va + kj * 32); vfr[2 * kj + 1] = *(const bf16x8*)(va + 32 * AT_VP + kj * 32); } } \
        bf16x8 pb[4]; \
        _Pragma("unroll") for (int i = 8; i < 12; ++i) { const int kj = i - 8; const int jp = kj & 1; \
            if (i & 1) SB1 = __builtin_amdgcn_mfma_f32_32x32x16_bf16(kfr[i], qf[i >> 1], SB1, 0, 0, 0); else SB0 = __builtin_amdgcn_mfma_f32_32x32x16_bf16(kfr[i], qf[i >> 1], SB0, 0, 0, 0); \
            if (kj < 2) pb[kj] = pack8(SA0[8 * jp + 0], SA0[8 * jp + 1], SA0[8 * jp + 2], SA0[8 * jp + 3], SA0[8 * jp + 4], SA0[8 * jp + 5], SA0[8 * jp + 6], SA0[8 * jp + 7]); \
            else        pb[kj] = pack8(SA1[8 * jp + 0], SA1[8 * jp + 1], SA1[8 * jp + 2], SA1[8 * jp + 3], SA1[8 * jp + 4], SA1[8 * jp + 5], SA1[8 * jp + 6], SA1[8 * jp + 7]); \
            AT_SB(); } \
        lsum += ls0 + ls1; \
        float mq0 = SB0[0], mq1 = SB1[0]; \
        _Pragma("unroll") for (int kj = 0; kj < 4; ++kj) { \
            o0 = __builtin_amdgcn_mfma_f32_32x32x16_bf16(vfr[2 * kj], pb[kj], o0, 0, 0, 0); o1 = __builtin_amdgcn_mfma_f32_32x32x16_bf16(vfr[2 * kj + 1], pb[kj], o1, 0, 0, 0); \
            mq0 = __builtin_fmaxf(__builtin_fmaxf(mq0, SB0[4 * kj]), SB0[4 * kj + 1]); mq1 = __builtin_fmaxf(__builtin_fmaxf(mq1, SB1[4 * kj]), SB1[4 * kj + 1]); \
            mq0 = __builtin_fmaxf(__builtin_fmaxf(mq0, SB0[4 * kj + 2]), SB0[4 * kj + 3]); mq1 = __builtin_fmaxf(__builtin_fmaxf(mq1, SB1[4 * kj + 2]), SB1[4 * kj + 3]); \
            AT_SB(); } \
        mxc = __builtin_fmaxf(mq0, mq1);            \
        if (t_ + 3 < NT) AT_LSTOREK(lds + ((t_ + 3) & 3) * AT_KB); \
        if (t_ + 2 < NT) AT_LSTOREV(lds + AT_V0 + ((t_ + 2) & 3) * AT_VBS); \
        if (t_ & 1) __syncthreads(); \
    } while (0)
    float mxc = at_max32(sa0, sa1);
    for (int t = 0; t < NT; t += 2) { AT_STEP(sa0, sa1, sb0, sb1, t); AT_STEP(sb0, sb1, sa0, sa1, t + 1); }
    lsum += __shfl_xor(lsum, 32);
    const float inv = 1.0f / lsum;
    bf16_t* op = MIX + (size_t)qrow * 1024 + 256 + h * 64 + 4 * hi;
#pragma unroll
    for (int g4 = 0; g4 < 4; ++g4) { u32x2 w0, w1; w0.x = pk2(o0[4 * g4] * inv, o0[4 * g4 + 1] * inv); w0.y = pk2(o0[4 * g4 + 2] * inv, o0[4 * g4 + 3] * inv);
        w1.x = pk2(o1[4 * g4] * inv, o1[4 * g4 + 1] * inv); w1.y = pk2(o1[4 * g4 + 2] * inv, o1[4 * g4 + 3] * inv);
        *(u32x2*)(op + 8 * g4) = w0; *(u32x2*)(op + 32 + 8 * g4) = w1; }
#undef AT_GLOADK
#undef AT_GLOADV
#undef AT_LSTOREK
#undef AT_LSTOREV
#undef AT_STEP
#undef AT_SB
}

constexpr int RT_VP = 264, RT_SP = 144, RT_VB = 2 * 64 * RT_VP;
DEV void retout_unit(const Params& p, int l, unsigned char* lds, int u) {
    const int tid = otid(), lane = tid & 63, wid = tid >> 6, l32 = lane & 31, hi = lane >> 5;
    const int gc = u >> 1, hp = u & 1; const int cb = gc % 66; const bool lat = cb >= 2; const int t0 = (cb - 2) * 128; const int r0 = gc * 128;
    const bf16_t* P = (const bf16_t*)p.out; bf16_t* MIX = (bf16_t*)(p.ws + OFF_HN); const f32x2* rope = (const f32x2*)(p.ws + OFF_ROPE);
    const float* SIN = (const float*)(p.ws + OFF_OV + OV_SIN);
    bf16_t* VTl = (bf16_t*)lds; bf16_t* STl = (bf16_t*)(lds + RT_VB);
    __syncthreads();
    for (int task = tid; task < 2048; task += NWG_T) { const int hh = task >> 10, key = (task >> 3) & 127, ch = task & 7;
        const bf16x8 v = *(const bf16x8*)(P + (size_t)(r0 + key) * INW + 256 + (2 * hp + hh) * 64 + ch * 8);
#pragma unroll
        for (int j = 0; j < 8; ++j) VTl[(hh * 64 + ch * 8 + j) * (RT_VP / 2) + key] = (bf16_t)v[j]; }
    for (int task = tid; task < 8192; task += NWG_T) { const int dv = task & 63, k = (task >> 6) & 31, dir = (task >> 11) & 1, hh = task >> 12;
        STl[(hh * 64 + dv) * (RT_SP / 2) + dir * 32 + k] = (bf16_t)f2bf(SIN[((size_t)(gc * 4 + 2 * hp + hh) * 2 + dir) * 2048 + k * 64 + dv]); }
    __syncthreads();
    const int hh = wid >> 2, h = 2 * hp + hh, qblk = wid & 3; const int n = 32 * qblk + l32; const int rq = r0 + n;
    const float lf = log2_sigmoid(p.ret_decay_f[l * 4 + h]), lb = log2_sigmoid(p.ret_decay_b[l * 4 + h]);
    float qv0[8], qv1[8]; bf16x8 qf0, qf1;
    { const bf16_t* qp = P + (size_t)rq * INW + h * 32 + 8 * hi; const bf16x8 a = *(const bf16x8*)qp, c2 = *(const bf16x8*)(qp + 16);
#pragma unroll
      for (int j = 0; j < 8; ++j) { float x1 = bf2f((unsigned short)a[j]), x2 = bf2f((unsigned short)c2[j]);
          if (lat) { const f32x2 cs = rope[(size_t)(t0 + n) * 16 + 8 * hi + j]; const float y1 = x1 * cs.x - x2 * cs.y, y2 = x2 * cs.x + x1 * cs.y; x1 = y1; x2 = y2; }
          qv0[j] = x1; qv1[j] = x2; }
      qf0 = pack8(qv0[0], qv0[1], qv0[2], qv0[3], qv0[4], qv0[5], qv0[6], qv0[7]); qf1 = pack8(qv1[0], qv1[1], qv1[2], qv1[3], qv1[4], qv1[5], qv1[6], qv1[7]); }
    f32x16 o0, o1;
#pragma unroll
    for (int r = 0; r < 16; ++r) { o0[r] = 0.f; o1[r] = 0.f; }
    const unsigned char* vbase = (const unsigned char*)VTl + (size_t)(hh * 64 + l32) * RT_VP + hi * 8;
    bf16x8 kga[4], kgc[4];
#pragma unroll
    for (int kb = 0; kb < 4; ++kb) { const bf16_t* kp = P + (size_t)(r0 + 32 * kb + l32) * INW + 128 + h * 32 + 8 * hi; kga[kb] = *(const bf16x8*)kp; kgc[kb] = *(const bf16x8*)(kp + 16); }
    __builtin_amdgcn_sched_barrier(0);
#pragma unroll
    for (int kb = 0; kb < 4; ++kb) {
        bf16x8 kf0, kf1;
        { const int key = 32 * kb + l32; const bf16x8 a = kga[kb], c2 = kgc[kb];
          float y1[8], y2[8];
#pragma unroll
          for (int j = 0; j < 8; ++j) { float x1 = bf2f((unsigned short)a[j]), x2 = bf2f((unsigned short)c2[j]);
              if (lat) { const f32x2 cs = rope[(size_t)(t0 + key) * 16 + 8 * hi + j]; const float z1 = x1 * cs.x - x2 * cs.y, z2 = x2 * cs.x + x1 * cs.y; x1 = z1; x2 = z2; }
              y1[j] = x1 * 0.17677669529663687f; y2[j] = x2 * 0.17677669529663687f; }
          kf0 = pack8(y1[0], y1[1], y1[2], y1[3], y1[4], y1[5], y1[6], y1[7]); kf1 = pack8(y2[0], y2[1], y2[2], y2[3], y2[4], y2[5], y2[6], y2[7]); }
        f32x16 s;
#pragma unroll
        for (int r = 0; r < 16; ++r) s[r] = 0.f;
        s = __builtin_amdgcn_mfma_f32_32x32x16_bf16(kf0, qf0, s, 0, 0, 0); s = __builtin_amdgcn_mfma_f32_32x32x16_bf16(kf1, qf1, s, 0, 0, 0);
#pragma unroll
        for (int r = 0; r < 16; ++r) { const int m = 32 * kb + crow(r, hi); const int dl = n - m; const float e = dl >= 0 ? lf * (float)dl : lb * (float)(-dl); s[r] *= __builtin_amdgcn_exp2f(e); }
#pragma unroll
        for (int jp = 0; jp < 2; ++jp) { const bf16x8 pb = pack8(s[8 * jp + 0], s[8 * jp + 1], s[8 * jp + 2], s[8 * jp + 3], s[8 * jp + 4], s[8 * jp + 5], s[8 * jp + 6], s[8 * jp + 7]);
            const unsigned char* vp = vbase + (32 * kb + 16 * jp) * 2;
            const u32x2 a00 = *(const u32x2*)vp, a01 = *(const u32x2*)(vp + 16), a10 = *(const u32x2*)(vp + 32 * RT_VP), a11 = *(const u32x2*)(vp + 32 * RT_VP + 16);
            const bf16x8 A0 = __builtin_bit_cast(bf16x8, (u32x4){a00.x, a00.y, a01.x, a01.y}), A1 = __builtin_bit_cast(bf16x8, (u32x4){a10.x, a10.y, a11.x, a11.y});
            o0 = __builtin_amdgcn_mfma_f32_32x32x16_bf16(A0, pb, o0, 0, 0, 0); o1 = __builtin_amdgcn_mfma_f32_32x32x16_bf16(A1, pb, o1, 0, 0, 0); }
    }
    { const float df = __builtin_amdgcn_exp2f(lf * (float)(n + 1)), db = __builtin_amdgcn_exp2f(lb * (float)(128 - n));
      const unsigned char* sbase = (const unsigned char*)STl + (size_t)(hh * 64 + l32) * RT_SP + hi * 16;
#pragma unroll
      for (int ks = 0; ks < 4; ++ks) { const float dd = ks < 2 ? df : db;
          const bf16x8 qb = (ks & 1) ? pack8(qv1[0] * dd, qv1[1] * dd, qv1[2] * dd, qv1[3] * dd, qv1[4] * dd, qv1[5] * dd, qv1[6] * dd, qv1[7] * dd)
                                     : pack8(qv0[0] * dd, qv0[1] * dd, qv0[2] * dd, qv0[3] * dd, qv0[4] * dd, qv0[5] * dd, qv0[6] * dd, qv0[7] * dd);
          const bf16x8 A0 = *(const bf16x8*)(sbase + ks * 32), A1 = *(const bf16x8*)(sbase + 32 * RT_SP + ks * 32);
          o0 = __builtin_amdgcn_mfma_f32_32x32x16_bf16(A0, qb, o0, 0, 0, 0); o1 = __builtin_amdgcn_mfma_f32_32x32x16_bf16(A1, qb, o1, 0, 0, 0); } }
    float ssq = 0.f;
#pragma unroll
    for (int r = 0; r < 16; ++r) ssq += o0[r] * o0[r] + o1[r] * o1[r];
    ssq += __shfl_xor(ssq, 32);
    const float rstd = rsqrtf(ssq * (1.f / 64.f) + EPS);
    const bf16_t* gp = P + (size_t)rq * INW + 512 + h * 64 + 4 * hi; bf16_t* op = MIX + (size_t)rq * 1024 + h * 64 + 4 * hi;
#pragma unroll
    for (int g4 = 0; g4 < 4; ++g4) { const u32x2 ga = *(const u32x2*)(gp + 8 * g4), gb = *(const u32x2*)(gp + 32 + 8 * g4);
        u32x2 w0, w1;
        w0.x = pk2(o0[4 * g4] * rstd * siluf(bf2f(ga.x & 0xffff)), o0[4 * g4 + 1] * rstd * siluf(bf2f(ga.x >> 16))); w0.y = pk2(o0[4 * g4 + 2] * rstd * siluf(bf2f(ga.y & 0xffff)), o0[4 * g4 + 3] * rstd * siluf(bf2f(ga.y >> 16)));
        w1.x = pk2(o1[4 * g4] * rstd * siluf(bf2f(gb.x & 0xffff)), o1[4 * g4 + 1] * rstd * siluf(bf2f(gb.x >> 16))); w1.y = pk2(o1[4 * g4 + 2] * rstd * siluf(bf2f(gb.y & 0xffff)), o1[4 * g4 + 3] * rstd * siluf(bf2f(gb.y >> 16)));
        *(u32x2*)(op + 8 * g4) = w0; *(u32x2*)(op + 32 + 8 * g4) = w1; }
}

DEV void phase_ffn_fixup(const Params& p, int l) {
    const float* EDGE = (const float*)(p.ws + OFF_EDGE); bf16_t* ACT = (bf16_t*)(p.ws + OFF_OV);
    const float* cw = p.conv_w + (size_t)l * 3 * 5632; const float* cbv = p.conv_b + (size_t)l * 5632;
    for (int idx = blockIdx.x * NWG_T + otid(); idx < 66 * 2 * 704; idx += gridDim.x * NWG_T) {
        const int ch4 = idx % 704, rest = idx / 704; const int which = rest & 1, pm = rest >> 1; const int jj = pm % 33;
        if (l == 1 && jj == 0) continue;
        const int ch = 4 * ch4, pn = ch >> 7, c = ch & 127;
        const bool sstart = jj <= 1, send = (jj == 0) || (jj == 32);
        const f32x4 zz = {0.f, 0.f, 0.f, 0.f};
#define EDG(tile, k, half) (*(const f32x4*)(EDGE + ((size_t)((tile) * 4 + (k)) * 22 + pn) * 256 + (half) * 128 + c))
        f32x4 ua, ub, ca, cb2, da, db;
        if (which == 0) { ua = sstart ? zz : EDG(pm - 1, 3, 0); ub = sstart ? zz : EDG(pm - 1, 3, 1); ca = EDG(pm, 0, 0); cb2 = EDG(pm, 0, 1); da = EDG(pm, 1, 0); db = EDG(pm, 1, 1); }
        else { ua = EDG(pm, 2, 0); ub = EDG(pm, 2, 1); ca = EDG(pm, 3, 0); cb2 = EDG(pm, 3, 1); da = send ? zz : EDG(pm + 1, 0, 0); db = send ? zz : EDG(pm + 1, 0, 1); }
#undef EDG
        const f32x4 wa0 = *(const f32x4*)(cw + ch), wa1 = *(const f32x4*)(cw + 5632 + ch), wa2 = *(const f32x4*)(cw + 2 * 5632 + ch), ba = *(const f32x4*)(cbv + ch);
        const f32x4 wb0 = *(const f32x4*)(cw + DFF + ch), wb1 = *(const f32x4*)(cw + 5632 + DFF + ch), wb2 = *(const f32x4*)(cw + 2 * 5632 + DFF + ch), bb = *(const f32x4*)(cbv + DFF + ch);
        const f32x4 xa = wa0 * ua + wa1 * ca + wa2 * da + ba, xb = wb0 * ub + wb1 * cb2 + wb2 * db + bb;
        u32x2 w; w.x = pk2(siluf(xa.x) * xb.x, siluf(xa.y) * xb.y); w.y = pk2(siluf(xa.z) * xb.z, siluf(xa.w) * xb.w);
        *(u32x2*)(ACT + (size_t)(pm * 256 + (which ? 255 : 0)) * DFF + ch) = w;
    }
}

#define RLX_AGENT __ATOMIC_RELAXED, __HIP_MEMORY_SCOPE_AGENT
#define XB_TMO      128
#define XB_XCNT(j)  (256  + 64 * (j))
#define XB_XSUB(j)  (1280 + 64 * (j))
#define XB_XGEN(j)  (2304 + 64 * (j))
#define XB_TOP      3328
#define XB_TOPGEN   3392
#define XCD_BAR_WORDS 3456
#define XB_SPIN_CAP (1u << 18)

__device__ __forceinline__ unsigned xb_ld(unsigned* p)              { return __hip_atomic_load(p, __ATOMIC_RELAXED, __HIP_MEMORY_SCOPE_AGENT); }
__device__ __forceinline__ unsigned xb_add(unsigned* p, unsigned v) { return __hip_atomic_fetch_add(p, v, __ATOMIC_RELAXED, __HIP_MEMORY_SCOPE_AGENT); }
__device__ __forceinline__ unsigned xb_xcc_id() { return (unsigned)__builtin_amdgcn_s_getreg((3 << 11) | 20) & 0xFu; }
#define XB_SPIN(cond, bar) do { unsigned _sp = 0; while (cond) { __builtin_amdgcn_s_sleep(1); \
    if ((++_sp & 255u) == 0u) { if (xb_ld(&(bar)[XB_TMO])) break; if (_sp > XB_SPIN_CAP) { atomicAdd(&(bar)[XB_TMO], 1u); break; } } } } while (0)

struct XcdBarrier {
    unsigned* bar; unsigned x;
    volatile LAS unsigned* st;
};

__device__ __forceinline__ XcdBarrier xcd_barrier_post(unsigned* bar, volatile LAS unsigned* st) {
    XcdBarrier b; b.bar = bar; b.x = xb_xcc_id(); b.st = st;
    if (threadIdx.x == 0) (void)xb_add(&bar[XB_XCNT(b.x)], 1u);
    return b;
}
__device__ __forceinline__ void xcd_barrier_complete(unsigned* bar, unsigned x, unsigned& nloc, unsigned& nx) {
    const unsigned G = gridDim.x * gridDim.y * gridDim.z;
    unsigned sum, cnt, mine, sp = 0u;
    for (;;) {
        sum = 0u; cnt = 0u; mine = 0u;
#pragma unroll
        for (unsigned j = 0; j < 16; ++j) { const unsigned c = xb_ld(&bar[XB_XCNT(j)]); sum += c; cnt += (c > 0u) ? 1u : 0u; mine = (j == x) ? c : mine; }
        if (sum == G) break;
        __builtin_amdgcn_s_sleep(1);
        if ((++sp & 255u) == 0u) { if (xb_ld(&bar[XB_TMO])) break; if (sp > XB_SPIN_CAP) { atomicAdd(&bar[XB_TMO], 1u); break; } }
    }
    nloc = mine > 0u ? mine : 1u; nx = cnt > 0u ? cnt : 1u;
}

__device__ __forceinline__ void xcd_barrier(const XcdBarrier& b) {
    asm volatile("s_waitcnt vmcnt(0)" ::: "memory");
    __syncthreads();
    if (threadIdx.x == 0) {
        unsigned* bar = b.bar;
        __builtin_amdgcn_s_waitcnt(0);
        unsigned nloc = b.st[0], nx = b.st[1];
        if (nloc == 0u) { xcd_barrier_complete(bar, b.x, nloc, nx); b.st[0] = nloc; b.st[1] = nx; }
        const unsigned old = xb_add(&bar[XB_XSUB(b.x)], 1u);
        const unsigned gen = old / nloc;
        if (old + 1u == (gen + 1u) * nloc) {
            __builtin_amdgcn_fence(__ATOMIC_RELEASE, "agent");
            asm volatile("s_waitcnt vmcnt(0)" ::: "memory");
            const unsigned og = xb_add(&bar[XB_TOP], 1u);
            const unsigned tg = og / nx;
            if (og + 1u == (tg + 1u) * nx) xb_add(&bar[XB_TOPGEN], 1u);
            else XB_SPIN(xb_ld(&bar[XB_TOPGEN]) == tg, bar);
            __builtin_amdgcn_fence(__ATOMIC_ACQUIRE, "agent");
            xb_add(&bar[XB_XGEN(b.x)], 1u);
            asm volatile("s_waitcnt vmcnt(0)" ::: "memory");
        } else {
            XB_SPIN(xb_ld(&bar[XB_XGEN(b.x)]) == gen, bar);
            __builtin_amdgcn_fence(__ATOMIC_ACQUIRE, "agent");
            asm volatile("s_waitcnt vmcnt(0)" ::: "memory");
        }
    }
    __syncthreads();
}


constexpr size_t OFF_CTL = 250000128; constexpr int CTL_BYTES = 16384;
#if defined(__HIP_DEVICE_COMPILE__)
#define KP() const __attribute__((address_space(4))) Params* kp_ = (const __attribute__((address_space(4))) Params*)__builtin_amdgcn_kernarg_segment_ptr(); asm volatile("" : "+s"(kp_)); const Params p = *kp_; \
    bf16_t* HN = (bf16_t*)(p.ws + OFF_HN); bf16_t* P = (bf16_t*)p.out; float* X = (float*)(p.ws + OFF_X); (void)HN; (void)P; (void)X
#else
#define KP() const Params p = p_arg; bf16_t* HN = (bf16_t*)(p.ws + OFF_HN); bf16_t* P = (bf16_t*)p.out; float* X = (float*)(p.ws + OFF_X); (void)HN; (void)P; (void)X
#endif
#define WL() const bf16_t* wl = (const bf16_t*)(p.ws + OFF_W) + (size_t)l * W_LAYER; const float* modv = (const float*)(p.ws + OFF_MOD) + (size_t)l * 3 * 6144; (void)wl; (void)modv
#ifndef DUPM
#define DUPM 0
#endif
#define REP(bit) for (int rep_ = 0; rep_ < (((DUPM) >> (bit)) & 1) + 1; ++rep_)
constexpr int PH_PER_LAYER = 10, N_PHASES = 2 + 2 * PH_PER_LAYER;
__global__ void __launch_bounds__(512, 2) mk_fwd(Params p_arg) {
    extern __shared__ __attribute__((aligned(16))) unsigned char lds[];
    cg::grid_group grid = cg::this_grid();
    const int G = gridDim.x, bx = blockIdx.x; const int vcu = (G % 8 == 0) ? (bx % 8) * (G / 8) + bx / 8 : bx;
    LAS unsigned char* ldsl = (LAS unsigned char*)lds;
    const int ph_lo = p_arg.ph_lo, ph_hi = p_arg.ph_hi;
    volatile LAS unsigned* misc = (volatile LAS unsigned*)(ldsl + (LDS_BYTES - 64));
    { const int t0_ = otid(); if (t0_ < 16) misc[t0_] = 0u; }
    __syncthreads();
    if (ph_hi - ph_lo > 1) (void)xcd_barrier_post((unsigned*)(p_arg.ws + OFF_CTL), misc);
    for (int ph = ph_lo; ph < ph_hi; ++ph) {
        if (ph == 0) { KP(); phase_prep(p, lds); __syncthreads(); }
        else if (ph == N_PHASES - 1) { KP(); phase_final(p);
#if (DUPM >> 10) & 1
            for (int i = 0; i < 20; ++i) grid.sync();
#endif
        }
        else {
            const int l = (ph - 1) / PH_PER_LAYER, sp = (ph - 1) % PH_PER_LAYER;
            if (sp == 0) { KP(); if (l == 0) REP(9) { phase_prep_weights(p, lds); __syncthreads(); }
                phase_norm(p, l, 0, l == 0, l == 1 ? (const float*)(p.ws + OFF_MOD) + 2 * 6144 + 5120 : nullptr); }
            else if (sp == 1) { KP(); WL(); REP(1) { __syncthreads();
                pg8::Gemm g{HN, wl + W_IN, R, 1792, 1024, 1024, 1024}; pg8::StaticOrder S; S.init(R, 1792, G, bx);
                pg8::EpiStore E{P, INW, INW, 1.0f};
                pg8::gemm_phase<pg8::EpiStore, pg8::StaticOrder, true, true>(ldsl, g, S, E); } }
            else if (sp == 2) { KP(); phase_rowwise(p, l); __syncthreads();
                REP(2) phase_pool(p);
                REP(3) for (int it = G - 1 - bx; it < 264; it += G) states_item(p, l, lds, it); __syncthreads(); }
            else if (sp == 3) { KP(); WL(); REP(4) { __syncthreads();
                { pg8::Gemm g{P + 768, wl + W_UQ, R, 768, 384, INW, 384}; pg8::StaticOrder S; S.init(R, 768, G, bx);
                  pg8::EpiStore E{(bf16_t*)(p.ws + OFF_OV + OV_Q), 768, 768, 0.14724444f};
                  pg8::gemm_phase<pg8::EpiStore, pg8::StaticOrder, true, true>(ldsl, g, S, E); }
                __syncthreads();
                { pg8::Gemm g{P + 1152, wl + W_KN, R, 512, 256, INW, 256}; pg8::StaticOrder S; S.init(R, 512, G, (bx + 58) % G);
                  pg8::EpiStore E{(bf16_t*)(p.ws + OFF_OV + OV_KN), 512, 512, 1.0f};
                  pg8::gemm_phase<pg8::EpiStore, pg8::StaticOrder, true, true>(ldsl, g, S, E); }
                __syncthreads();
                { pg8::Gemm g{wl + W_V, P + 1152, 512, R, 256, 256, INW}; pg8::StaticOrder S; S.init(512, R, G, (bx + 182) % G);
                  pg8::EpiStore E{(bf16_t*)(p.ws + OFF_OV + OV_VT), R, R, 1.0f};
                  pg8::gemm_phase<pg8::EpiStore, pg8::StaticOrder, true, true>(ldsl, g, S, E); }
                if (bx >= G - 64) scan_threads(p, l, (bx - (G - 64)) * NWG_T + otid()); } }
            else if (sp == 4) { KP();
                REP(5) for (int u = vcu; u < (l == 0 ? 528 : 512); u += G) attn_unit(p, lds, u);
                REP(6) for (int u = G - 1 - bx; u < (l == 0 ? 264 : 256); u += G) retout_unit(p, l, lds, l == 0 ? u : u + 4 * (u >> 7) + 4); }
            else if (sp == 5) { KP(); WL(); __syncthreads();
                { pg8::Gemm g{HN, wl + W_OUT, R, 1024, 1024, 1024, 1024}; pg8::StaticOrder S; S.init(16384, 1024, G, bx, 1);
                  pg8::EpiResid E{X, modv + 2048, 0};
                  pg8::gemm_phase<pg8::EpiResid, pg8::StaticOrder, true, true>(ldsl, g, S, E); }
                if (l == 0 && bx < 32) { __syncthreads(); const int q = bx >> 3;
                  pg8::Gemm g{HN + q * 256, wl + W_OUT + q * 256, 512, 1024, 256, 1024, 1024}; pg8::StaticOrder S; S.init(512, 1024, G, bx & 7, 2);
                  pg8::EpiPart E{(float*)(p.ws + OFF_PART) + (size_t)q * 524288, 0};
                  pg8::gemm_phase<pg8::EpiPart, pg8::StaticOrder, true, true>(ldsl, g, S, E); } }
            else if (sp == 6) { KP(); WL(); phase_norm(p, l, 1, false, l == 0 ? modv + 2 * 6144 + 2048 : nullptr); }
            else if (sp == 7) { KP(); WL(); REP(7) { __syncthreads();
                pg8::Gemm g{HN, wl + W_UP, R, 2 * DFF, 1024, 1024, 1024}; pg8::StaticOrder S; S.init(l == 1 ? 16384 : R, 2 * DFF, G, bx, l == 1 ? 1 : 0);
                pg8::EpiFfn E{(bf16_t*)(p.ws + OFF_OV), (float*)(p.ws + OFF_EDGE), p.conv_w + (size_t)l * 3 * 5632, p.conv_b + (size_t)l * 5632, (LAS float*)(ldsl + 131072)};
                pg8::gemm_phase<pg8::EpiFfn, pg8::StaticOrder, true, true>(ldsl, g, S, E); } }
            else if (sp == 8) { KP(); REP(8) phase_ffn_fixup(p, l); }
            else if (sp == 9) { KP(); WL(); __syncthreads();
                { pg8::Gemm g{(const bf16_t*)(p.ws + OFF_OV), wl + W_DN, R, 1024, DFF, DFF, DFF}; pg8::StaticOrder S; S.init(16384, 1024, G, bx, 1);
                  pg8::EpiResid E{X, modv + 5120, 0};
                  pg8::gemm_phase<pg8::EpiResid, pg8::StaticOrder, true, true>(ldsl, g, S, E); }
                if (l == 0 && bx < 32) { __syncthreads(); const int q = bx >> 3; const int koff = q < 2 ? q * 768 : 1536 + (q - 2) * 640, klen = q < 2 ? 768 : 640;
                  pg8::Gemm g{(const bf16_t*)(p.ws + OFF_OV) + koff, wl + W_DN + koff, 512, 1024, klen, DFF, DFF}; pg8::StaticOrder S; S.init(512, 1024, G, bx & 7, 2);
                  pg8::EpiPart E{(float*)(p.ws + OFF_PART) + (size_t)q * 524288, 0};
                  pg8::gemm_phase<pg8::EpiPart, pg8::StaticOrder, true, true>(ldsl, g, S, E); } }
        }
        if (ph + 1 < ph_hi) {
            if (ph == ph_lo) grid.sync();
            else { KP(); XcdBarrier b; b.bar = (unsigned*)(p.ws + OFF_CTL); b.x = xb_xcc_id(); b.st = misc; xcd_barrier(b); }
        }
    }
}

extern "C" void kernel_launch(void* const* d_in, const int* in_sizes, int n_in, void* d_out, int out_size, void* d_ws, size_t ws_size, hipStream_t stream) {
    static int grid = 0;
    if (grid == 0) {
        if (n_in != 23 || ws_size < WS_NEED) { fprintf(stderr, "kernel_launch: unexpected problem (n_in %d, ws %zu, need %zu)\n", n_in, ws_size, (size_t)WS_NEED); grid = -1; return; }
        int dev = 0, cus = 0, per_cu = 0;
        hipGetDevice(&dev); hipDeviceGetAttribute(&cus, hipDeviceAttributeMultiprocessorCount, dev);
        if (hipFuncSetAttribute((const void*)mk_fwd, hipFuncAttributeMaxDynamicSharedMemorySize, LDS_BYTES) != hipSuccess) { fprintf(stderr, "kernel_launch: hipFuncSetAttribute failed\n"); grid = -1; return; }
        if (hipOccupancyMaxActiveBlocksPerMultiprocessor(&per_cu, (const void*)mk_fwd, 512, LDS_BYTES) != hipSuccess || per_cu < 1) { fprintf(stderr, "kernel_launch: occupancy query says %d\n", per_cu); per_cu = 1; }
        (void)hipGetLastError();
        grid = cus * per_cu; if (grid > 256) grid = 256;
        fprintf(stderr, "kernel_launch: grid %d (cus %d, per_cu %d)\n", grid, cus, per_cu);
    }
    if (grid < 0) return;
    Params p{};
    const float** pp = (const float**)&p;
    for (int i = 0; i < 23; ++i) pp[i] = (const float*)d_in[i];
    p.out = (float*)d_out; p.ws = (unsigned char*)d_ws;
#if MK_MULTI
    for (int ph = 0; ph < N_PHASES; ++ph) { p.ph_lo = ph; p.ph_hi = ph + 1; void* args[] = {&p};
        hipError_t e = hipLaunchCooperativeKernel((void*)mk_fwd, dim3(grid), dim3(512), args, LDS_BYTES, stream);
        if (e != hipSuccess) { fprintf(stderr, "launch %d failed: %s\n", ph, hipGetErrorString(e)); break; } }
#else
    if (hipMemsetAsync((char*)d_ws + OFF_CTL, 0, CTL_BYTES, stream) != hipSuccess) { fprintf(stderr, "kernel_launch: memset of the barrier words failed\n"); return; }
    p.ph_lo = 0; p.ph_hi = N_PHASES; void* args[] = {&p};
    hipError_t e = hipLaunchCooperativeKernel((void*)mk_fwd, dim3(grid), dim3(512), args, LDS_BYTES, stream);
    if (e != hipSuccess) fprintf(stderr, "cooperative launch failed: %s (grid %d)\n", hipGetErrorString(e), grid);
#endif
}
```

```cpp
#include <hip/hip_runtime.h>
#include <hip/hip_cooperative_groups.h>
#include <cstdio>
#include <cstdint>
namespace cg = cooperative_groups;

#ifndef MK_MULTI
#define MK_MULTI 0
#endif

namespace pg8 {
#define PG8_LAS __attribute__((address_space(3)))
typedef unsigned short bf16_t;
typedef short bf16x8 __attribute__((ext_vector_type(8)));
typedef float f32x4 __attribute__((ext_vector_type(4)));
typedef unsigned u32x4 __attribute__((ext_vector_type(4)));
constexpr int BM = 256, BK = 64, HALF = 128, HTB = HALF * BK * 2  , STAGE_BYTES = 8 * HTB, NXCD = 8, WGM = 8;

__host__ __device__ __forceinline__ int lds_byte(int r, int c) { const int st = (r >> 4) * 2 + (c >> 5), rr = r & 15, cc = c & 31, ob = rr * 64 + cc * 2; return st * 1024 + (ob ^ (((ob >> 9) & 1) << 5)); }
__host__ __device__ __forceinline__ void stage_rc(int b, int& R, int& C) { const int st = b / 1024, sb = b % 1024, swz = sb ^ (((sb >> 9) & 1) << 5); R = (st >> 1) * 16 + swz / 64; C = (st & 1) * 32 + (swz % 64) / 2; }
__host__ __device__ __forceinline__ int perm32(int rho) { const int n = rho >> 4, i = rho & 15; return 8 * (i >> 2) + 4 * n + (i & 3); }

struct Unit { int pm, pn; };
struct Gemm { const bf16_t* A; const bf16_t* Bt; int M, N, K, lda, ldb; };

struct StaticOrder {
    int nM, nN, nwg, G, c, skip;
    __host__ __device__ void init(int M, int N, int G_, int c_, int skip_ = 0) { nM = M / BM; nN = N / BM; nwg = nM * nN; G = G_; c = c_; skip = skip_; }
    __host__ __device__ bool next(int i, Unit& u) const {
        const long L = (long)i * G + c; if (L >= nwg) return false;
        int wgid = (int)L; { const int q = nwg / NXCD, r = nwg % NXCD, xcd = wgid % NXCD, off = wgid / NXCD; wgid = (xcd < r ? xcd * (q + 1) : r * (q + 1) + (xcd - r) * q) + off; }
        const int nig = WGM * nN, gid = wgid / nig, fm = gid * WGM, gsz = (nM - fm) < WGM ? (nM - fm) : WGM;
        u.pm = fm + ((wgid % nig) % gsz); u.pn = (wgid % nig) / gsz; if (skip == 1) u.pm += 1 + (u.pm >= 32 ? 1 : 0); else if (skip == 2) u.pm *= 33; return true;
    }
    __device__ __forceinline__ void a_ready(const Unit&) const {}
    __device__ __forceinline__ void done(const Unit&) const {}
};

__device__ __forceinline__ unsigned cvt_pk_bf16(float lo, float hi) { unsigned r; asm volatile("v_cvt_pk_bf16_f32 %0, %1, %2" : "=v"(r) : "v"(lo), "v"(hi)); return r; }

struct EpiStore {
    static constexpr bool PERM = true, AFTER_DRAIN = false;
    bf16_t* O; int ldc; int ncols; float scale;
    __device__ __forceinline__ void operator()(const f32x4 (&acc)[2][2][4][2], const Unit& u, int wr, int wc, int fr, int fq) const {
        const int row0 = u.pm * BM + wr * 64 + fr; const int col0 = u.pn * BM + wc * 32 + 8 * fq;
#pragma unroll
        for (int ai = 0; ai < 2; ++ai)
#pragma unroll
            for (int m = 0; m < 4; ++m) { bf16_t* rowp = O + (size_t)(row0 + ai * HALF + m * 16) * ldc + col0;
#pragma unroll
                for (int bj = 0; bj < 2; ++bj) { if (col0 + bj * HALF < ncols) {
                    f32x4 v0 = acc[ai][bj][m][0] * scale, v1 = acc[ai][bj][m][1] * scale;
                    u32x4 w; w.x = cvt_pk_bf16(v0[0], v0[1]); w.y = cvt_pk_bf16(v0[2], v0[3]); w.z = cvt_pk_bf16(v1[0], v1[1]); w.w = cvt_pk_bf16(v1[2], v1[3]);
                    *(u32x4*)(rowp + bj * HALF) = w; } } }
    }
};
struct EpiResid {
    static constexpr bool PERM = false, AFTER_DRAIN = false;
    float* X; const float* gate; int row_tile0;
    __device__ __forceinline__ void operator()(const f32x4 (&acc)[2][2][4][2], const Unit& u, int wr, int wc, int fr, int fq) const {
        const int tpm = u.pm + row_tile0; const int bb = tpm / 33, jj = tpm - bb * 33; const float* gv = gate + (jj == 0 ? 2 : bb) * 6144;
        const int col0 = u.pn * BM + wc * 32 + 4 * fq;
#pragma unroll
        for (int ai = 0; ai < 2; ++ai)
#pragma unroll
            for (int m = 0; m < 4; ++m) { float* rowp = X + (size_t)(tpm * BM + ai * HALF + wr * 64 + m * 16 + fr) * 1024 + col0;
#pragma unroll
                for (int bj = 0; bj < 2; ++bj) {
#pragma unroll
                    for (int n = 0; n < 2; ++n) { f32x4* q = (f32x4*)(rowp + bj * HALF + n * 16); const f32x4 gq = *(const f32x4*)(gv + col0 + bj * HALF + n * 16); f32x4 xv = *q; xv = xv + gq * acc[ai][bj][m][n]; *q = xv; }
                    asm volatile("" ::: "memory"); } }
    }
};
struct EpiPart {
    static constexpr bool PERM = false, AFTER_DRAIN = false;
    float* out; int accum;
    __device__ __forceinline__ void operator()(const f32x4 (&acc)[2][2][4][2], const Unit& u, int wr, int wc, int fr, int fq) const {
        const int t = u.pm / 33; const int col0 = u.pn * BM + wc * 32 + 4 * fq;
#pragma unroll
        for (int ai = 0; ai < 2; ++ai)
#pragma unroll
            for (int m = 0; m < 4; ++m) { float* rowp = out + (size_t)(t * BM + ai * HALF + wr * 64 + m * 16 + fr) * 1024 + col0;
#pragma unroll
                for (int bj = 0; bj < 2; ++bj) {
#pragma unroll
                    for (int n = 0; n < 2; ++n) { f32x4* q = (f32x4*)(rowp + bj * HALF + n * 16); f32x4 v = acc[ai][bj][m][n]; if (accum) v = v + *q; *q = v; }
                    asm volatile("" ::: "memory"); } }
    }
};
template <int CTRL> __device__ __forceinline__ float dpp0(float x) { return __builtin_bit_cast(float, __builtin_amdgcn_update_dpp(0, __builtin_bit_cast(int, x), CTRL, 0xf, 0xf, true)); }
struct EpiFfn {
    static constexpr bool PERM = false, AFTER_DRAIN = false;
    bf16_t* ACT; float* EDGE; const float* cw; const float* cb; PG8_LAS float* xl;
    __device__ __forceinline__ void operator()(const f32x4 (&acc)[2][2][4][2], const Unit& u, int wr, int wc, int fr, int fq) const {
        PG8_LAS float* FIRST = xl; PG8_LAS float* LAST = xl + 1024;
        const int cb0 = wc * 32 + 4 * fq;
#pragma unroll
        for (int ai = 0; ai < 2; ++ai)
#pragma unroll
            for (int bj = 0; bj < 2; ++bj)
#pragma unroll
                for (int n = 0; n < 2; ++n) { const int col = bj * HALF + cb0 + n * 16;
                    if (fr == 0) *(PG8_LAS f32x4*)(FIRST + (2 * ai + wr) * 256 + col) = acc[ai][bj][0][n];
                    if (fr == 15) *(PG8_LAS f32x4*)(LAST + (2 * ai + wr) * 256 + col) = acc[ai][bj][3][n]; }
        if (wr == 0 && fr < 2) {
#pragma unroll
            for (int bj = 0; bj < 2; ++bj)
#pragma unroll
                for (int n = 0; n < 2; ++n) *(f32x4*)(EDGE + ((size_t)(u.pm * 4 + fr) * 22 + u.pn) * 256 + bj * HALF + cb0 + n * 16) = acc[0][bj][0][n]; }
        if (wr == 1 && fr >= 14) {
#pragma unroll
            for (int bj = 0; bj < 2; ++bj)
#pragma unroll
                for (int n = 0; n < 2; ++n) *(f32x4*)(EDGE + ((size_t)(u.pm * 4 + 2 + (fr - 14)) * 22 + u.pn) * 256 + bj * HALF + cb0 + n * 16) = acc[1][bj][3][n]; }
        asm volatile("s_waitcnt lgkmcnt(0)" ::: "memory"); __builtin_amdgcn_s_barrier(); asm volatile("" ::: "memory");
#pragma unroll
        for (int n = 0; n < 2; ++n) { const int ch0 = u.pn * HALF + cb0 + n * 16;
            f32x4 wa[3], wb[3];
#pragma unroll
            for (int k = 0; k < 3; ++k) { wa[k] = *(const f32x4*)(cw + k * 5632 + ch0); wb[k] = *(const f32x4*)(cw + k * 5632 + 2816 + ch0); }
            const f32x4 ba = *(const f32x4*)(cb + ch0), bb = *(const f32x4*)(cb + 2816 + ch0);
#pragma unroll
            for (int ai = 0; ai < 2; ++ai) { const int g = 2 * ai + wr;
                f32x4 bu[2], bd[2];
#pragma unroll
                for (int bj = 0; bj < 2; ++bj) { const int col = bj * HALF + cb0 + n * 16; const f32x4 zz = {0.f, 0.f, 0.f, 0.f};
                    bu[bj] = g > 0 ? *(const PG8_LAS f32x4*)(LAST + (g - 1) * 256 + col) : zz; bd[bj] = g < 3 ? *(const PG8_LAS f32x4*)(FIRST + (g + 1) * 256 + col) : zz; }
#pragma unroll
                for (int m = 0; m < 4; ++m) { float o[4];
#pragma unroll
                    for (int e = 0; e < 4; ++e) { float up[2], dn[2];
#pragma unroll
                        for (int bj = 0; bj < 2; ++bj) { const float cur = acc[ai][bj][m][n][e];
                            float x = dpp0<0x111>(cur);
                            if (m > 0) x += dpp0<0x10F>(acc[ai][bj][m - 1][n][e]); else x += (fr == 0 ? bu[bj][e] : 0.f);
                            float y = dpp0<0x101>(cur);
                            if (m < 3) y += dpp0<0x11F>(acc[ai][bj][m + 1][n][e]); else y += (fr == 15 ? bd[bj][e] : 0.f);
                            up[bj] = x; dn[bj] = y; }
                        const float ua = wa[0][e] * up[0] + wa[1][e] * acc[ai][0][m][n][e] + wa[2][e] * dn[0] + ba[e];
                        const float ub = wb[0][e] * up[1] + wb[1][e] * acc[ai][1][m][n][e] + wb[2][e] * dn[1] + bb[e];
                        o[e] = ua * __builtin_amdgcn_rcpf(1.0f + __builtin_amdgcn_exp2f(-1.4426950408889634f * ua)) * ub; }
                    typedef unsigned u32x2 __attribute__((ext_vector_type(2))); u32x2 w; w.x = cvt_pk_bf16(o[0], o[1]); w.y = cvt_pk_bf16(o[2], o[3]);
                    *(u32x2*)(ACT + (size_t)(u.pm * BM + ai * HALF + wr * 64 + m * 16 + fr) * 2816 + ch0) = w; } } }
    }
};

template <class Epi, class Sched, bool ALIGN_EPI = false, bool SP2 = false>
__device__ __forceinline__ void gemm_phase(PG8_LAS unsigned char* lds, const Gemm g, const Sched& S, const Epi& E) {
    int tid = threadIdx.x; asm volatile("" : "+v"(tid));
    const int wid = __builtin_amdgcn_readfirstlane(tid >> 6), lane = tid & 63, wr = wid >> 2, wc = wid & 3, fr = lane & 15, fq = lane >> 4;
    int K = g.K; asm volatile("" : "+s"(K));
    const int nt = K / BK;
    unsigned voffA[2], voffB[2];
#pragma unroll
    for (int i = 0; i < 2; ++i) { int R, C; stage_rc(tid * 16 + i * 8192, R, C); const int Rb = Epi::PERM ? ((R & ~31) + perm32(R & 31)) : R;
        voffA[i] = (unsigned)(R * g.lda + C) * 2u; voffB[i] = (unsigned)(Rb * g.ldb + C) * 2u; }
    const size_t kstep = (size_t)(BK * 2);
    const size_t hstepA = (size_t)HALF * g.lda * 2, hstepB = (size_t)HALF * g.ldb * 2;
    const size_t tstepA = 2 * hstepA, tstepB = 2 * hstepB;
    const unsigned ldsw = (unsigned)wid * 1024u;
    const int aoff = lds_byte(wr * 64 + fr, fq * 8), boff = lds_byte(wc * 32 + fr, fq * 8);
#define PG8_SA(b, h) (((b) * 2 + (h)) * HTB)
#define PG8_SB(b, h) ((4 + (b) * 2 + (h)) * HTB)
#define PG8_STAGE(bufoff, gbase, voff) do { _Pragma("unroll") for (int _i = 0; _i < 2; ++_i) \
        __builtin_amdgcn_global_load_lds((const unsigned*)((const char*)(gbase) + (voff)[_i]), (PG8_LAS unsigned*)(lds + (bufoff) + ldsw + _i * 8192), 16, 0, 0); } while (0)
#define PG8_LDA(dst, b, h) do { _Pragma("unroll") for (int m = 0; m < 4; ++m) _Pragma("unroll") for (int k = 0; k < 2; ++k) dst[m][k] = *(const PG8_LAS bf16x8*)(lds + PG8_SA(b, h) + aoff + m * 2048 + k * 1024); } while (0)
#define PG8_LDB(dst, b, h) do { _Pragma("unroll") for (int n = 0; n < 2; ++n) _Pragma("unroll") for (int k = 0; k < 2; ++k) dst[n][k] = *(const PG8_LAS bf16x8*)(lds + PG8_SB(b, h) + boff + n * 2048 + k * 1024); } while (0)
#define PG8_MMA(ai, bj, At, Bt) do { __builtin_amdgcn_s_setprio(1); _Pragma("unroll") for (int m = 0; m < 4; ++m) _Pragma("unroll") for (int n = 0; n < 2; ++n) _Pragma("unroll") for (int k = 0; k < 2; ++k) \
        acc[ai][bj][m][n] = __builtin_amdgcn_mfma_f32_16x16x32_bf16(Bt[n][k], At[m][k], acc[ai][bj][m][n], 0, 0, 0); __builtin_amdgcn_s_setprio(0); } while (0)
#define PG8_WAIT_V(n) asm volatile("s_waitcnt vmcnt(" #n ")" ::: "memory")
#define PG8_WAIT_L(n) asm volatile("s_waitcnt lgkmcnt(" #n ")" ::: "memory")
#define PG8_BAR __builtin_amdgcn_s_barrier()
#define PG8_SCHED __builtin_amdgcn_sched_barrier(0)
    Unit cur, nxt; int ui = 0;
    if (!S.next(0, cur)) return;
    f32x4 acc[2][2][4][2];
#pragma unroll
    for (int a = 0; a < 2; ++a)
#pragma unroll
        for (int b = 0; b < 2; ++b)
#pragma unroll
            for (int m = 0; m < 4; ++m)
#pragma unroll
                for (int n = 0; n < 2; ++n) acc[a][b][m][n] = (f32x4){0.f, 0.f, 0.f, 0.f};
    bf16x8 At[4][2], B0[2][2], B1[2][2];
    const char* cA = (const char*)g.A + (size_t)cur.pm * tstepA; const char* cB = (const char*)g.Bt + (size_t)cur.pn * tstepB;
    S.a_ready(cur);
    if constexpr (SP2) {
        PG8_STAGE(PG8_SB(0, 0), cB, voffB); PG8_STAGE(PG8_SB(0, 1), cB + hstepB, voffB); PG8_STAGE(PG8_SA(0, 0), cA, voffA); PG8_STAGE(PG8_SA(0, 1), cA + hstepA, voffA);
        if (wr == 1) PG8_BAR;
        PG8_WAIT_V(2); PG8_BAR;
        PG8_STAGE(PG8_SB(1, 0), cB + kstep, voffB); PG8_STAGE(PG8_SA(1, 0), cA + kstep, voffA); PG8_STAGE(PG8_SB(1, 1), cB + hstepB + kstep, voffB);
        PG8_WAIT_V(6); PG8_BAR;
    } else {
        PG8_STAGE(PG8_SB(0, 0), cB, voffB); PG8_STAGE(PG8_SA(0, 0), cA, voffA); PG8_STAGE(PG8_SB(0, 1), cB + hstepB, voffB); PG8_STAGE(PG8_SA(0, 1), cA + hstepA, voffA);
        if (wr == 1) PG8_BAR;
        PG8_WAIT_V(4); PG8_BAR;
        PG8_STAGE(PG8_SB(1, 0), cB + kstep, voffB); PG8_STAGE(PG8_SA(1, 0), cA + kstep, voffA); PG8_STAGE(PG8_SB(1, 1), cB + hstepB + kstep, voffB);
        PG8_WAIT_V(6); PG8_BAR;
    }
    for (;;) {
        const bool has_next = S.next(ui + 1, nxt);
        const char* nA = has_next ? (const char*)g.A + (size_t)nxt.pm * tstepA : cA; const char* nB = has_next ? (const char*)g.Bt + (size_t)nxt.pn * tstepB : cB;
        for (int t = 0; t < nt; t += 2) {
            const bool last = (t == nt - 2);
            const char* a1 = cA + (size_t)(t + 1) * kstep;
            const char* a2 = last ? nA : cA + (size_t)(t + 2) * kstep; const char* b2 = last ? nB : cB + (size_t)(t + 2) * kstep;
            const char* a3 = a2 + kstep; const char* b3 = b2 + kstep;
            if (last && has_next) S.a_ready(nxt);
            if constexpr (SP2) {
            PG8_LDB(B0, 0, 0); PG8_LDB(B1, 0, 1); PG8_SCHED; PG8_LDA(At, 0, 0); PG8_STAGE(PG8_SA(1, 1), a1 + hstepA, voffA);
            PG8_WAIT_V(8); PG8_WAIT_L(0); PG8_BAR; PG8_MMA(0, 0, At, B0); PG8_MMA(0, 1, At, B1); PG8_BAR; PG8_SCHED;
            PG8_LDA(At, 0, 1); PG8_STAGE(PG8_SB(0, 0), b2, voffB); PG8_STAGE(PG8_SB(0, 1), b2 + hstepB, voffB); PG8_STAGE(PG8_SA(0, 0), a2, voffA);
            PG8_WAIT_V(8); PG8_WAIT_L(0); PG8_BAR; PG8_MMA(1, 0, At, B0); PG8_MMA(1, 1, At, B1); PG8_BAR; PG8_SCHED;
            PG8_LDB(B0, 1, 0); PG8_LDB(B1, 1, 1); PG8_SCHED; PG8_LDA(At, 1, 0); PG8_STAGE(PG8_SA(0, 1), a2 + hstepA, voffA);
            PG8_WAIT_V(8); PG8_WAIT_L(0); PG8_BAR; PG8_MMA(0, 0, At, B0); PG8_MMA(0, 1, At, B1); PG8_BAR; PG8_SCHED;
            PG8_LDA(At, 1, 1); PG8_STAGE(PG8_SB(1, 0), b3, voffB); PG8_STAGE(PG8_SB(1, 1), b3 + hstepB, voffB); PG8_STAGE(PG8_SA(1, 0), a3, voffA);
            PG8_WAIT_V(8); PG8_WAIT_L(0); PG8_BAR; PG8_MMA(1, 0, At, B0); PG8_MMA(1, 1, At, B1); PG8_BAR; PG8_SCHED;
            } else {
            PG8_LDB(B0, 0, 0); PG8_SCHED; PG8_LDA(At, 0, 0); PG8_STAGE(PG8_SA(1, 1), a1 + hstepA, voffA);
            PG8_WAIT_L(8); PG8_BAR; PG8_WAIT_L(0); PG8_MMA(0, 0, At, B0); PG8_BAR; PG8_SCHED;
            PG8_LDB(B1, 0, 1); PG8_STAGE(PG8_SB(0, 0), b2, voffB);
            PG8_BAR; PG8_WAIT_L(0); PG8_MMA(0, 1, At, B1); PG8_BAR;
            PG8_LDA(At, 0, 1); PG8_STAGE(PG8_SA(0, 0), a2, voffA);
            PG8_BAR; PG8_WAIT_L(0); PG8_MMA(1, 0, At, B0); PG8_BAR; PG8_SCHED;
            PG8_STAGE(PG8_SB(0, 1), b2 + hstepB, voffB);
            PG8_WAIT_V(6); PG8_BAR; PG8_MMA(1, 1, At, B1); PG8_BAR;
            PG8_LDB(B0, 1, 0); PG8_SCHED; PG8_LDA(At, 1, 0); PG8_STAGE(PG8_SA(0, 1), a2 + hstepA, voffA);
            PG8_WAIT_L(8); PG8_BAR; PG8_WAIT_L(0); PG8_MMA(0, 0, At, B0); PG8_BAR; PG8_SCHED;
            PG8_LDB(B1, 1, 1); PG8_STAGE(PG8_SB(1, 0), b3, voffB);
            PG8_BAR; PG8_WAIT_L(0); PG8_MMA(0, 1, At, B1); PG8_BAR;
            PG8_LDA(At, 1, 1); PG8_STAGE(PG8_SA(1, 0), a3, voffA);
            PG8_BAR; PG8_WAIT_L(0); PG8_MMA(1, 0, At, B0); PG8_BAR; PG8_SCHED;
            PG8_STAGE(PG8_SB(1, 1), b3 + hstepB, voffB);
            PG8_WAIT_V(6); PG8_BAR; PG8_MMA(1, 1, At, B1); PG8_BAR;
            }
        }
        if constexpr (ALIGN_EPI) { if (wr == 0) PG8_BAR; }
        if constexpr (!Epi::AFTER_DRAIN) { E(acc, cur, wr, wc, fr, fq); S.done(cur); }
        if (!has_next) break;
#pragma unroll
        for (int a = 0; a < 2; ++a)
#pragma unroll
            for (int b = 0; b < 2; ++b)
#pragma unroll
                for (int m = 0; m < 4; ++m)
#pragma unroll
                    for (int n = 0; n < 2; ++n) acc[a][b][m][n] = (f32x4){0.f, 0.f, 0.f, 0.f};
        cur = nxt; cA = nA; cB = nB; ++ui;
        if constexpr (ALIGN_EPI) { if (wr == 1) PG8_BAR; }
    }
    PG8_WAIT_V(0);
    if constexpr (!ALIGN_EPI) { if (wr == 0) PG8_BAR; }
    PG8_BAR;
    if constexpr (Epi::AFTER_DRAIN) { E.fused(acc, cur, wr, wc, fr, fq, lds, wid, lane); S.done(cur); }
#undef PG8_SA
#undef PG8_SB
#undef PG8_STAGE
#undef PG8_LDA
#undef PG8_LDB
#undef PG8_MMA
#undef PG8_WAIT_V
#undef PG8_WAIT_L
#undef PG8_BAR
#undef PG8_SCHED
}
}

#define DEV __device__ __forceinline__
#define LAS __attribute__((address_space(3)))
typedef unsigned short bf16_t;
typedef short bf16x8 __attribute__((ext_vector_type(8)));
typedef float f32x4 __attribute__((ext_vector_type(4)));
typedef float f32x2 __attribute__((ext_vector_type(2)));
typedef float f32x16 __attribute__((ext_vector_type(16)));
typedef unsigned u32x4 __attribute__((ext_vector_type(4)));
typedef unsigned u32x2 __attribute__((ext_vector_type(2)));

constexpr int R = 16896, RB = 8448, NCTX = 256, TL = 8192, DM = 1024, INW = 1696, DFF = 2816, HFF = 1408;
constexpr int NWG_T = 512;
constexpr float EPS = 1e-6f;
constexpr int LDS_BYTES = 147456;
constexpr size_t OFF_X = 0, OFF_HN = 69206016, OFF_W = 103809024, OFF_MOD = 152174592, OFF_ROPE = 152436736, OFF_OV = 153485312;
constexpr size_t OV_Q = 0, OV_KN = 25952256, OV_VT = 43253760, OV_SLOC = 60555264, OV_SIN = 69206016, OV_U = 0;
constexpr size_t OFF_PART = 250100224;
constexpr size_t OFF_EDGE = 258488832;
constexpr size_t WS_NEED = OFF_EDGE + 5947392;
constexpr size_t W_IN = 0, W_UQ = 1835008, W_KN = 2129920, W_V = 2260992, W_OUT = 2392064, W_UP = 3440640, W_DN = 9207808, W_LAYER = 12091392;

struct Params {
    const float *x, *c, *ctx, *c_ctx, *w_mod, *b_mod, *norm1_g, *w_in, *ret_decay_f, *ret_decay_b, *mla_q_norm_g, *w_uq, *mla_kv_norm_g, *w_ukv,
        *pool_w, *pool_scale, *w_out, *norm2_g, *w_up, *conv_w, *conv_b, *w_down, *final_norm_g;
    float* out; unsigned char* ws; int ph_lo, ph_hi;
};

DEV int otid() { int t = threadIdx.x; asm volatile("" : "+v"(t)); return t; }
DEV float bf2f(unsigned short x) { return __uint_as_float((unsigned)x << 16); }
DEV unsigned f2bf(float f) { unsigned u = __float_as_uint(f); return (u + 0x7fffu + ((u >> 16) & 1u)) >> 16; }
DEV unsigned pk2(float lo, float hi) { return f2bf(lo) | (f2bf(hi) << 16); }
DEV float wave_sum(float v) {
#pragma unroll
    for (int o = 1; o < 64; o <<= 1) v += __shfl_xor(v, o);
    return v;
}
DEV float siluf(float x) { return x * __builtin_amdgcn_rcpf(1.0f + __builtin_amdgcn_exp2f(-1.4426950408889634f * x)); }
DEV int crow(int r, int hi) { return (r & 3) + 8 * (r >> 2) + 4 * hi; }
DEV bf16x8 pack8(float a0, float a1, float a2, float a3, float a4, float a5, float a6, float a7) {
    u32x4 w; w.x = pg8::cvt_pk_bf16(a0, a1); w.y = pg8::cvt_pk_bf16(a2, a3); w.z = pg8::cvt_pk_bf16(a4, a5); w.w = pg8::cvt_pk_bf16(a6, a7);
    return __builtin_bit_cast(bf16x8, w);
}
DEV int row_mi(int r) { const int b = r / RB; const int s = r - b * RB; return s < NCTX ? 2 : b; }

DEV void transpose_item(const float* W, int K, int Nsrc, bf16_t* WT, int n0, int cs, int k0, float* scr, int lane) {
#pragma unroll
    for (int i = 0; i < 32; ++i) { const int kk = 2 * i + (lane >> 5); scr[kk * 33 + (lane & 31)] = cs >= 0 ? W[(size_t)(k0 + kk) * Nsrc + cs + (lane & 31)] : 0.f; }
    asm volatile("s_waitcnt lgkmcnt(0)" ::: "memory");
    const int c = lane & 7;
#pragma unroll
    for (int j = 0; j < 4; ++j) { const int n = (lane >> 3) + 8 * j; const float* s = scr + (8 * c) * 33 + n;
        u32x4 o; o.x = pk2(s[0 * 33], s[1 * 33]); o.y = pk2(s[2 * 33], s[3 * 33]); o.z = pk2(s[4 * 33], s[5 * 33]); o.w = pk2(s[6 * 33], s[7 * 33]);
        *(u32x4*)(WT + (size_t)(n0 + n) * K + k0 + 8 * c) = o; }
    asm volatile("s_waitcnt lgkmcnt(0)" ::: "memory");
}
DEV int map_in(int n0) { return n0 < 1440 ? n0 : (n0 < INW ? -2 : -1); }
DEV int map_kn(int n0) { return (n0 >> 6) * 128 + (n0 & 63); }
DEV int map_v(int n0) { return (n0 >> 6) * 128 + 64 + (n0 & 63); }
DEV int map_up(int n0) { const int pn = n0 >> 8, w = n0 & 255; return w < 128 ? 128 * pn + w : DFF + 128 * pn + (w - 128); }

DEV void phase_prep(const Params& p, unsigned char* lds) {
    const int tid = otid(), lane = tid & 63, wid = tid >> 6;
    unsigned char* ws = p.ws;
    { f32x2* rope = (f32x2*)(ws + OFF_ROPE);
      for (int idx = blockIdx.x * NWG_T + tid; idx < TL * 16; idx += gridDim.x * NWG_T) { const int t = idx >> 4, i = idx & 15; const int pos = i < 8 ? (t >> 6) : (t & 63);
          const float inv = exp2f(-(float)(i & 7) * 0.125f * 13.287712379549449f); const float ang = (float)pos * inv; f32x2 cs; cs.x = __cosf(ang); cs.y = __sinf(ang); rope[idx] = cs; } }
    { float* scv = (float*)lds;
      float* red = scv + 3 * 1024;
      for (int i = tid; i < 3 * 1024; i += NWG_T) { const int v = i >> 10, k = i & 1023; const float cv = v < 2 ? p.c[v * 1024 + k] : p.c_ctx[k]; scv[i] = siluf(cv); }
      __syncthreads();
      float* modv = (float*)(ws + OFF_MOD);
      for (int it = blockIdx.x; it < 192; it += gridDim.x) { const int l = it / 96, col0 = (it % 96) * 64;
          const float* wm = p.w_mod + (size_t)l * 1024 * 6144 + col0 + lane; float a0 = 0.f, a1 = 0.f, a2 = 0.f;
#pragma unroll 16
          for (int k = wid * 128; k < wid * 128 + 128; ++k) { const float w = wm[(size_t)k * 6144]; a0 += scv[k] * w; a1 += scv[1024 + k] * w; a2 += scv[2048 + k] * w; }
          red[(wid * 3 + 0) * 64 + lane] = a0; red[(wid * 3 + 1) * 64 + lane] = a1; red[(wid * 3 + 2) * 64 + lane] = a2;
          __syncthreads();
          if (tid < 192) { const int v = tid >> 6, cl = tid & 63; float s = 0.f;
#pragma unroll
              for (int w = 0; w < 8; ++w) s += red[(w * 3 + v) * 64 + cl];
              modv[((size_t)l * 3 + v) * 6144 + col0 + cl] = s + p.b_mod[l * 6144 + col0 + cl]; }
          __syncthreads(); }
    }
}
DEV void phase_prep_weights(const Params& p, unsigned char* lds) {
    const int tid = otid(), lane = tid & 63, wid = tid >> 6;
    unsigned char* ws = p.ws;
    { float* scr = (float*)(lds + 32768 + wid * 8704);
      const int gw = blockIdx.x * 8 + wid, NGW = gridDim.x * 8;
      constexpr int I_IN = 16 * 56, I_UQ = 6 * 24, I_KN = 4 * 16, I_V = 4 * 16, I_OUT = 16 * 32, I_UP = 16 * 176, I_DN = 44 * 32, I_L = I_IN + I_UQ + I_KN + I_V + I_OUT + I_UP + I_DN;
      for (int it = gw; it < 2 * I_L; it += NGW) { const int l = it / I_L; int r = it - l * I_L; bf16_t* wl = (bf16_t*)(ws + OFF_W) + (size_t)l * W_LAYER;
          const float* src; int K, Nsrc, nbn, mp; size_t doff;
          if (r < I_IN) { src = p.w_in + (size_t)l * 1024 * INW; K = 1024; Nsrc = INW; nbn = 56; mp = 1; doff = W_IN; }
          else if ((r -= I_IN) < I_UQ) { src = p.w_uq + (size_t)l * 384 * 768; K = 384; Nsrc = 768; nbn = 24; mp = 0; doff = W_UQ; }
          else if ((r -= I_UQ) < I_KN) { src = p.w_ukv + (size_t)l * 256 * 1024; K = 256; Nsrc = 1024; nbn = 16; mp = 2; doff = W_KN; }
          else if ((r -= I_KN) < I_V) { src = p.w_ukv + (size_t)l * 256 * 1024; K = 256; Nsrc = 1024; nbn = 16; mp = 3; doff = W_V; }
          else if ((r -= I_V) < I_OUT) { src = p.w_out + (size_t)l * 1024 * 1024; K = 1024; Nsrc = 1024; nbn = 32; mp = 0; doff = W_OUT; }
          else if ((r -= I_OUT) < I_UP) { src = p.w_up + (size_t)l * 1024 * 5632; K = 1024; Nsrc = 5632; nbn = 176; mp = 4; doff = W_UP; }
          else { r -= I_UP; src = p.w_down + (size_t)l * DFF * 1024; K = DFF; Nsrc = 1024; nbn = 32; mp = 0; doff = W_DN; }
          const int kb = r / nbn, nb = r - kb * nbn, n0 = nb * 32;
          const int cs = mp == 0 ? n0 : mp == 1 ? map_in(n0) : mp == 2 ? map_kn(n0) : mp == 3 ? map_v(n0) : map_up(n0);
          if (cs != -2) transpose_item(src, K, Nsrc, wl + doff, n0, cs, kb * 64, scr, lane); }
    }
    { for (int idx = blockIdx.x * NWG_T + tid; idx < 2 * 1024 * 256; idx += gridDim.x * NWG_T) { const int n = idx & 255, k = (idx >> 8) & 1023, l = idx >> 18; const int g = n >> 6, d = n & 63;
          const float* wr = p.w_in + ((size_t)l * 1024 + k) * INW + 1440 + g * 64; const float* pw = p.pool_w + ((size_t)(l * 4 + g) * 64) * 64 + d; float s = 0.f;
#pragma unroll 8
          for (int c = 0; c < 64; ++c) s += wr[c] * pw[c * 64];
          ((bf16_t*)(ws + OFF_W) + (size_t)l * W_LAYER + W_IN)[(size_t)(1440 + n) * 1024 + k] = (bf16_t)f2bf(s * p.pool_scale[l * 256 + n]); } }
}

DEV void phase_norm(const Params& p, int l, int which, bool first, const float* pgate) {
    const int tid = otid(); const int lane = tid & 63, wid = tid >> 6; const int gw = blockIdx.x * 8 + wid, NGW = gridDim.x * 8;
    float* X = (float*)(p.ws + OFF_X); bf16_t* HN = (bf16_t*)(p.ws + OFF_HN);
    const float* modv = (const float*)(p.ws + OFF_MOD) + (size_t)l * 3 * 6144;
    const float* g = (which == 0 ? p.norm1_g : p.norm2_g) + l * 1024;
    for (int r = gw; r < R; r += NGW) {
        const int b = r / RB, s = r - b * RB; const int mi = s < NCTX ? 2 : b;
        const float* src = first ? (s < NCTX ? p.ctx + ((size_t)b * NCTX + s) * 1024 : p.x + ((size_t)b * TL + (s - NCTX)) * 1024) : X + (size_t)r * 1024;
        const f32x4* xr = (const f32x4*)src + lane; f32x4 v[4]; float ss = 0.f;
#pragma unroll
        for (int j = 0; j < 4; ++j) { v[j] = xr[64 * j]; ss += (v[j].x * v[j].x + v[j].y * v[j].y) + (v[j].z * v[j].z + v[j].w * v[j].w); }
        if (pgate != nullptr && s < NCTX) { const float* PART = (const float*)(p.ws + OFF_PART) + (size_t)(b * NCTX + s) * 1024; ss = 0.f;
#pragma unroll
            for (int j = 0; j < 4; ++j) { const f32x4 gq = ((const f32x4*)pgate)[lane + 64 * j]; f32x4 a = ((const f32x4*)PART)[lane + 64 * j];
#pragma unroll
                for (int q = 1; q < 4; ++q) a = a + ((const f32x4*)(PART + (size_t)q * 524288))[lane + 64 * j];
                v[j] = v[j] + gq * a; ss += (v[j].x * v[j].x + v[j].y * v[j].y) + (v[j].z * v[j].z + v[j].w * v[j].w); } }
        if (first || (pgate != nullptr && s < NCTX)) { f32x4* xo = (f32x4*)(X + (size_t)r * 1024) + lane;
#pragma unroll
            for (int j = 0; j < 4; ++j) xo[64 * j] = v[j]; }
        const float rs = rsqrtf(wave_sum(ss) * (1.f / 1024.f) + EPS);
        const float* mv = modv + mi * 6144 + (which == 0 ? 0 : 3072);
        u32x2* o8 = (u32x2*)(HN + (size_t)r * 1024) + lane;
#pragma unroll
        for (int j = 0; j < 4; ++j) { const f32x4 gg = ((const f32x4*)g)[lane + 64 * j], sh = ((const f32x4*)mv)[lane + 64 * j], sc = ((const f32x4*)(mv + 1024))[lane + 64 * j];
            const f32x4 y = v[j] * rs * gg; const f32x4 h = y * (sc + 1.0f) + sh; u32x2 w; w.x = pk2(h.x, h.y); w.y = pk2(h.z, h.w); o8[64 * j] = w; }
    }
}
DEV void phase_final(const Params& p) {
    const int tid = otid(); const int lane = tid & 63, wid = tid >> 6; const int gw = blockIdx.x * 8 + wid, NGW = gridDim.x * 8;
    const float* X = (const float*)(p.ws + OFF_X);
    for (int q = gw; q < 2 * TL; q += NGW) { const int b = q / TL, t = q - b * TL; const int r = b * RB + NCTX + t;
        const f32x4* xr = (const f32x4*)(X + (size_t)r * 1024) + lane; f32x4 v[4]; float ss = 0.f;
#pragma unroll
        for (int j = 0; j < 4; ++j) { v[j] = xr[64 * j]; ss += (v[j].x * v[j].x + v[j].y * v[j].y) + (v[j].z * v[j].z + v[j].w * v[j].w); }
        const float rs = rsqrtf(wave_sum(ss) * (1.f / 1024.f) + EPS);
        f32x4* o = (f32x4*)(p.out + (size_t)q * 1024) + lane;
#pragma unroll
        for (int j = 0; j < 4; ++j) { const f32x4 gg = ((const f32x4*)p.final_norm_g)[lane + 64 * j]; o[64 * j] = v[j] * rs * gg; } }
}

DEV void phase_rowwise(const Params& p, int l) {
    const int tid = otid(); const int lane = tid & 63, wid = tid >> 6; const int gw = blockIdx.x * 8 + wid, NGW = gridDim.x * 8;
    bf16_t* P = (bf16_t*)p.out; const f32x2* rope = (const f32x2*)(p.ws + OFF_ROPE);
    const float* qg = p.mla_q_norm_g + l * 384; const float* kg = p.mla_kv_norm_g + l * 256;
    float qgv[6];
#pragma unroll
    for (int j = 0; j < 3; ++j) { qgv[2 * j] = qg[2 * (lane + 64 * j)]; qgv[2 * j + 1] = qg[2 * (lane + 64 * j) + 1]; }
    const f32x4 kgv = ((const f32x4*)kg)[lane];
    for (int r0 = gw; r0 < R; r0 += 2 * NGW) {
        unsigned wq[2][3]; u32x2 wk[2]; float x1[2], x2[2]; f32x2 cs[2]; bool val[2], lat[2];
#pragma unroll
        for (int i = 0; i < 2; ++i) { const int r = r0 + i * NGW; val[i] = r < R; const int rr = val[i] ? r : r0; bf16_t* pr = P + (size_t)rr * INW; const int s = rr % RB; lat[i] = s >= NCTX;
            const unsigned* q2 = (const unsigned*)(pr + 768) + lane;
#pragma unroll
            for (int j = 0; j < 3; ++j) wq[i][j] = q2[64 * j];
            wk[i] = *((const u32x2*)(pr + 1152) + lane);
            const int li = lane & 15; x1[i] = bf2f(pr[1408 + li]); x2[i] = bf2f(pr[1408 + 16 + li]); cs[i] = rope[(lat[i] ? s - NCTX : 0) * 16 + li]; }
#pragma unroll
        for (int i = 0; i < 2; ++i) { if (!val[i]) continue; const int r = r0 + i * NGW; bf16_t* pr = P + (size_t)r * INW;
            { float ss = 0.f;
#pragma unroll
              for (int j = 0; j < 3; ++j) { const float a = bf2f(wq[i][j] & 0xffff), c2 = bf2f(wq[i][j] >> 16); ss += a * a + c2 * c2; }
              const float rs = rsqrtf(wave_sum(ss) * (1.f / 384.f) + EPS); unsigned* q2 = (unsigned*)(pr + 768) + lane;
#pragma unroll
              for (int j = 0; j < 3; ++j) q2[64 * j] = pk2(bf2f(wq[i][j] & 0xffff) * rs * qgv[2 * j], bf2f(wq[i][j] >> 16) * rs * qgv[2 * j + 1]); }
            { const float a0 = bf2f(wk[i].x & 0xffff), a1 = bf2f(wk[i].x >> 16), a2 = bf2f(wk[i].y & 0xffff), a3 = bf2f(wk[i].y >> 16);
              const float rs = rsqrtf(wave_sum((a0 * a0 + a1 * a1) + (a2 * a2 + a3 * a3)) * (1.f / 256.f) + EPS);
              u32x2 o; o.x = pk2(a0 * rs * kgv.x, a1 * rs * kgv.y); o.y = pk2(a2 * rs * kgv.z, a3 * rs * kgv.w); *((u32x2*)(pr + 1152) + lane) = o; }
            if (lat[i] && lane < 16) { pr[1408 + lane] = (bf16_t)f2bf(x1[i] * cs[i].x - x2[i] * cs[i].y); pr[1408 + 16 + lane] = (bf16_t)f2bf(x2[i] * cs[i].x + x1[i] * cs[i].y); } }
    }
}

DEV void phase_pool(const Params& p) {
    const int tid = otid(); const bf16_t* P = (const bf16_t*)p.out; bf16_t* MIX = (bf16_t*)(p.ws + OFF_HN);
    for (int idx = blockIdx.x * NWG_T + tid; idx < R * 32; idx += gridDim.x * NWG_T) { const int r = idx >> 5, cg = idx & 31; const int half = 1 << (cg >> 3);
        const int b = r / RB, s = r - b * RB; const int seq0 = s < NCTX ? b * RB : b * RB + NCTX; const int T = s < NCTX ? NCTX : TL; const int t = r - seq0;
        const int lo = max(t - half, 0), hi = min(t + half, T); float sum[8];
#pragma unroll
        for (int j = 0; j < 8; ++j) sum[j] = 0.f;
        const bf16_t* base = P + (size_t)seq0 * INW + 1440 + cg * 8;
        { bf16x8 wv[16]; const bf16x8 zz = {0, 0, 0, 0, 0, 0, 0, 0};
#pragma unroll
          for (int k = 0; k < 16; ++k) { const int tt = t - 8 + k; wv[k] = (tt >= lo && tt < hi) ? *(const bf16x8*)(base + (size_t)tt * INW) : zz; }
#pragma unroll
          for (int k = 0; k < 16; ++k)
#pragma unroll
              for (int j = 0; j < 8; ++j) sum[j] += bf2f((unsigned short)wv[k][j]); }
        const bf16x8 me = *(const bf16x8*)(base + (size_t)t * INW); const float ic = 1.0f / (float)(hi - lo); float o[8];
#pragma unroll
        for (int j = 0; j < 8; ++j) o[j] = sum[j] * ic - bf2f((unsigned short)me[j]);
        *(bf16x8*)(MIX + (size_t)r * 1024 + 768 + cg * 8) = pack8(o[0], o[1], o[2], o[3], o[4], o[5], o[6], o[7]); }
}

DEV float log2_sigmoid(float d) { return -log1pf(__expf(-d)) * 1.4426950408889634f; }
constexpr int ST_P = 272;
DEV void states_item(const Params& p, int l, unsigned char* lds, int it) {
    const int tid = otid(), lane = tid & 63, wid = tid >> 6, l32 = lane & 31, hi = lane >> 5;
    const bf16_t* P = (const bf16_t*)p.out; const f32x2* rope = (const f32x2*)(p.ws + OFF_ROPE);
    float* SLOC = (float*)(p.ws + OFF_OV + OV_SLOC);
    const int gc = it >> 1, hp = it & 1;
    unsigned char* VTl = lds;
    unsigned char* KTl = lds + 2 * 64 * ST_P;
    const int cb = gc % 66; const bool lat = cb >= 2; const int t0 = (cb - 2) * 128; const int r0 = gc * 128;
    __syncthreads();
    { const int tok = tid >> 2, hh = (tid >> 1) & 1, c = tid & 1; const int h = 2 * hp + hh;
      const bf16_t* src = P + (size_t)(r0 + tok) * INW + 128 + h * 32 + 8 * c; const bf16x8 lo = *(const bf16x8*)src, hi8 = *(const bf16x8*)(src + 16);
      const float df = exp2f(log2_sigmoid(p.ret_decay_f[l * 4 + h]) * (float)(127 - tok)) * 0.17677669529663687f, db = exp2f(log2_sigmoid(p.ret_decay_b[l * 4 + h]) * (float)tok) * 0.17677669529663687f;
#pragma unroll
      for (int j = 0; j < 8; ++j) { float x1 = bf2f((unsigned short)lo[j]), x2 = bf2f((unsigned short)hi8[j]);
          if (lat) { const f32x2 cs = rope[(t0 + tok) * 16 + 8 * c + j]; const float y1 = x1 * cs.x - x2 * cs.y, y2 = x2 * cs.x + x1 * cs.y; x1 = y1; x2 = y2; }
          bf16_t* kf = (bf16_t*)(KTl + ((hh * 2 + 0) * 32 + 8 * c + j) * ST_P) + tok; bf16_t* kb = (bf16_t*)(KTl + ((hh * 2 + 1) * 32 + 8 * c + j) * ST_P) + tok;
          kf[0] = (bf16_t)f2bf(x1 * df); kb[0] = (bf16_t)f2bf(x1 * db);
          *(bf16_t*)((unsigned char*)kf + 16 * ST_P) = (bf16_t)f2bf(x2 * df); *(bf16_t*)((unsigned char*)kb + 16 * ST_P) = (bf16_t)f2bf(x2 * db); } }
    for (int task = tid; task < 2048; task += NWG_T) { const int hh = task >> 10, tok = (task >> 3) & 127, ch = task & 7;
        const bf16x8 v = *(const bf16x8*)(P + (size_t)(r0 + tok) * INW + 256 + (2 * hp + hh) * 64 + ch * 8);
#pragma unroll
        for (int j = 0; j < 8; ++j) *((bf16_t*)(VTl + (hh * 64 + ch * 8 + j) * ST_P) + tok) = (bf16_t)v[j]; }
    __syncthreads();
    { const int hh = wid >> 2, dir = (wid >> 1) & 1, dvb = wid & 1; const int h = 2 * hp + hh;
      const unsigned char* ap = VTl + (hh * 64 + 32 * dvb + l32) * ST_P + hi * 16; const unsigned char* bp = KTl + ((hh * 2 + dir) * 32 + l32) * ST_P + hi * 16;
      bf16x8 af[8], bfr[8];
#pragma unroll
      for (int ks = 0; ks < 8; ++ks) { af[ks] = *(const bf16x8*)(ap + ks * 32); bfr[ks] = *(const bf16x8*)(bp + ks * 32); }
      f32x16 acc;
#pragma unroll
      for (int r = 0; r < 16; ++r) acc[r] = 0.f;
#pragma unroll
      for (int ks = 0; ks < 8; ++ks) acc = __builtin_amdgcn_mfma_f32_32x32x16_bf16(af[ks], bfr[ks], acc, 0, 0, 0);
      float* o = SLOC + ((size_t)(gc * 4 + h) * 2 + dir) * 2048 + l32 * 64 + 32 * dvb + 4 * hi;
#pragma unroll
      for (int g4 = 0; g4 < 4; ++g4) *(f32x4*)(o + 8 * g4) = (f32x4){acc[4 * g4], acc[4 * g4 + 1], acc[4 * g4 + 2], acc[4 * g4 + 3]}; }
}
DEV void scan_threads(const Params& p, int l, int gid) {
    if (gid >= 32768) return;
    const int e = gid & 2047, dir = (gid >> 11) & 1, h = (gid >> 12) & 3, b = gid >> 14;
    const float* SLOC = (const float*)(p.ws + OFF_OV + OV_SLOC); float* SIN = (float*)(p.ws + OFF_OV + OV_SIN);
    const float gC = exp2f(log2_sigmoid((dir == 0 ? p.ret_decay_f : p.ret_decay_b)[l * 4 + h]) * 128.f);
    float S = 0.f;
#pragma unroll 6
    for (int st = 0; st < 66; ++st) { const int cb = dir == 0 ? st : (st < 2 ? 1 - st : 67 - st); const size_t idx = ((size_t)((b * 66 + cb) * 4 + h) * 2 + dir) * 2048 + e;
        const float v = SLOC[idx]; SIN[idx] = S; S = S * gC + v; }
}

constexpr int AT_KP = 208, AT_VP = 144, AT_KB = 64 * AT_KP, AT_VBS = 64 * AT_VP, AT_V0 = 4 * AT_KB;
DEV float at_max32(const f32x16& s0, const f32x16& s1) {
    float m0 = __builtin_fmaxf(__builtin_fmaxf(s0[0], s0[1]), s0[2]), m1 = __builtin_fmaxf(__builtin_fmaxf(s1[0], s1[1]), s1[2]);
    m0 = __builtin_fmaxf(__builtin_fmaxf(m0, s0[3]), s0[4]); m1 = __builtin_fmaxf(__builtin_fmaxf(m1, s1[3]), s1[4]);
    m0 = __builtin_fmaxf(__builtin_fmaxf(m0, s0[5]), s0[6]); m1 = __builtin_fmaxf(__builtin_fmaxf(m1, s1[5]), s1[6]);
    m0 = __builtin_fmaxf(__builtin_fmaxf(m0, s0[7]), s0[8]); m1 = __builtin_fmaxf(__builtin_fmaxf(m1, s1[7]), s1[8]);
    m0 = __builtin_fmaxf(__builtin_fmaxf(m0, s0[9]), s0[10]); m1 = __builtin_fmaxf(__builtin_fmaxf(m1, s1[9]), s1[10]);
    m0 = __builtin_fmaxf(__builtin_fmaxf(m0, s0[11]), s0[12]); m1 = __builtin_fmaxf(__builtin_fmaxf(m1, s1[11]), s1[12]);
    m0 = __builtin_fmaxf(__builtin_fmaxf(m0, s0[13]), s0[14]); m1 = __builtin_fmaxf(__builtin_fmaxf(m1, s1[13]), s1[14]);
    return __builtin_fmaxf(__builtin_fmaxf(m0, s0[15]), __builtin_fmaxf(m1, s1[15]));
}
DEV void attn_unit(const Params& p, unsigned char* lds, int u) {
    const int tid = otid(), lane = tid & 63, wid = tid >> 6, l32 = lane & 31, hi = lane >> 5;
    const bf16_t* Q = (const bf16_t*)(p.ws + OFF_OV + OV_Q); const bf16_t* KN = (const bf16_t*)(p.ws + OFF_OV + OV_KN); const bf16_t* VT = (const bf16_t*)(p.ws + OFF_OV + OV_VT);
    const bf16_t* P = (const bf16_t*)p.out; bf16_t* MIX = (bf16_t*)(p.ws + OFF_HN); const f32x2* rope = (const f32x2*)(p.ws + OFF_ROPE);
    const bool isctx = u >= 512; int b, h, qrow0, NT;
    if (!isctx) { b = u >> 8; h = (u >> 5) & 7; qrow0 = b * RB + NCTX + (u & 31) * 256; NT = 132; } else { const int v = u - 512; b = v >> 3; h = v & 7; qrow0 = b * RB; NT = 4; }
    const int krow0 = b * RB; const int qrow = qrow0 + wid * 32 + l32;
    bf16x8 qf[6];
    { const bf16_t* qp = Q + (size_t)qrow * 768 + h * 96 + hi * 8;
#pragma unroll
      for (int d0 = 0; d0 < 6; ++d0) qf[d0] = *(const bf16x8*)(qp + d0 * 16);
      if (!isctx) { const f32x2* rp = rope + (size_t)(qrow - (b * RB + NCTX)) * 16 + hi * 8;
#pragma unroll
          for (int j = 0; j < 8; ++j) { const f32x2 cs = rp[j]; const float x1 = bf2f((unsigned short)qf[4][j]), x2 = bf2f((unsigned short)qf[5][j]);
              qf[4][j] = (short)f2bf(x1 * cs.x - x2 * cs.y); qf[5][j] = (short)f2bf(x2 * cs.x + x1 * cs.y); } } }
    const bf16_t* sp[3]; int sstep[3], lo[3];
#pragma unroll
    for (int k = 0; k < 2; ++k) { const int c = tid + k * 512; const int key = c / 12, part = c - key * 12; lo[k] = key * AT_KP + part * 16;
        if (part < 8) { sp[k] = KN + (size_t)(krow0 + key) * 512 + h * 64 + part * 8; sstep[k] = 64 * 512; } else { sp[k] = P + (size_t)(krow0 + key) * INW + 1408 + (part - 8) * 8; sstep[k] = 64 * INW; } }
    { const int dv = tid >> 3, kc = tid & 7; lo[2] = dv * AT_VP + (kc >> 1) * 32 + (kc & 1) * 8;   sp[2] = VT + (size_t)(h * 64 + dv) * R + krow0 + kc * 8; sstep[2] = 64; }
    const bool hasK2 = tid < 256;
    u32x4 st[3];
#define AT_GLOADK() do { st[0] = *(const u32x4*)sp[0]; sp[0] += sstep[0]; if (hasK2) { st[1] = *(const u32x4*)sp[1]; sp[1] += sstep[1]; } } while (0)
#define AT_GLOADV() do { st[2] = *(const u32x4*)sp[2]; sp[2] += sstep[2]; } while (0)
#define AT_LSTOREK(buf) do { *(u32x4*)((buf) + lo[0]) = st[0]; if (hasK2) *(u32x4*)((buf) + lo[1]) = st[1]; } while (0)
#define AT_LSTOREV(buf) do { unsigned char* d_ = (buf) + lo[2]; *(u32x2*)d_ = (u32x2){st[2].x, st[2].y}; *(u32x2*)(d_ + 16) = (u32x2){st[2].z, st[2].w}; } while (0)
#define AT_SB() __builtin_amdgcn_sched_barrier(0)
    f32x16 o0, o1, sa0, sa1, sb0, sb1, negm;
#pragma unroll
    for (int r = 0; r < 16; ++r) { o0[r] = 0.f; o1[r] = 0.f; sa0[r] = 0.f; sa1[r] = 0.f; negm[r] = 0.f; }
    float mrun = 0.f, lsum = 0.f;
    __syncthreads();
    AT_GLOADK(); AT_GLOADV(); AT_LSTOREK(lds); AT_LSTOREV(lds + AT_V0);
    AT_GLOADK(); AT_GLOADV(); AT_LSTOREK(lds + AT_KB); AT_LSTOREV(lds + AT_V0 + AT_VBS);
    AT_GLOADK(); AT_LSTOREK(lds + 2 * AT_KB);
    __syncthreads();
    { const unsigned char* ka = lds + l32 * AT_KP + hi * 16;
#pragma unroll
      for (int d0 = 0; d0 < 6; ++d0) { const bf16x8 a0 = *(const bf16x8*)(ka + d0 * 32), a1 = *(const bf16x8*)(ka + 32 * AT_KP + d0 * 32);
          sa0 = __builtin_amdgcn_mfma_f32_32x32x16_bf16(a0, qf[d0], sa0, 0, 0, 0); sa1 = __builtin_amdgcn_mfma_f32_32x32x16_bf16(a1, qf[d0], sa1, 0, 0, 0); } }
#define AT_STEP(SA0, SA1, SB0, SB1, tt) do { \
        const int t_ = (tt); const bool nxt_ = t_ + 1 < NT; \
        const unsigned char* kb_ = lds + ((t_ + 1) & 3) * AT_KB; const unsigned char* vb_ = lds + AT_V0 + (t_ & 3) * AT_VBS; \
        if (t_ + 3 < NT) AT_GLOADK(); \
        if (t_ + 2 < NT) AT_GLOADV(); \
        bf16x8 kfr[12]; bf16x8 vfr[8]; \
        { const unsigned char* ka = kb_ + l32 * AT_KP + hi * 16; \
          _Pragma("unroll") for (int d0 = 0; d0 < 6; ++d0) { kfr[2 * d0] = *(const bf16x8*)(ka + d0 * 32); kfr[2 * d0 + 1] = *(const bf16x8*)(ka + 32 * AT_KP + d0 * 32); } } \
        { const float mx = mxc; \
          if (t_ == 0 || __any(mx > 8.0f)) { \
              const float rm = fmaxf(mx, __shfl_xor(mx, 32)); const float delta = (t_ == 0) ? rm : fmaxf(rm, 0.f); const float alpha = (t_ == 0) ? 1.0f : __builtin_amdgcn_exp2f(-delta); \
              mrun += delta; \
              _Pragma("unroll") for (int r = 0; r < 16; ++r) { SA0[r] -= delta; SA1[r] -= delta; o0[r] *= alpha; o1[r] *= alpha; } \
              lsum *= alpha; { const float nm = -mrun; _Pragma("unroll") for (int r = 0; r < 16; ++r) negm[r] = nm; } } } \
        float ls0 = 0.f, ls1 = 0.f; \
        AT_SB(); \
        _Pragma("unroll") for (int i = 0; i < 8; ++i) { \
            if (i == 0) SB0 = __builtin_amdgcn_mfma_f32_32x32x16_bf16(kfr[0], qf[0], negm, 0, 0, 0); else if (i == 1) SB1 = __builtin_amdgcn_mfma_f32_32x32x16_bf16(kfr[1], qf[0], negm, 0, 0, 0); \
            else if (i & 1) SB1 = __builtin_amdgcn_mfma_f32_32x32x16_bf16(kfr[i], qf[i >> 1], SB1, 0, 0, 0); else SB0 = __builtin_amdgcn_mfma_f32_32x32x16_bf16(kfr[i], qf[i >> 1], SB0, 0, 0, 0); \
            SA0[2 * i] = __builtin_amdgcn_exp2f(SA0[2 * i]); SA0[2 * i + 1] = __builtin_amdgcn_exp2f(SA0[2 * i + 1]); SA1[2 * i] = __builtin_amdgcn_exp2f(SA1[2 * i]); SA1[2 * i + 1] = __builtin_amdgcn_exp2f(SA1[2 * i + 1]); \
            ls0 += SA0[2 * i] + SA0[2 * i + 1]; ls1 += SA1[2 * i] + SA1[2 * i + 1]; \
            AT_SB(); } \
        { const unsigned char* va = vb_ + l32 * AT_VP + hi * 16; \
          _Pragma("unroll") for (int kj = 0; kj < 4; ++kj) { vfr[2 * kj] = *(const bf16x8*)(va + kj * 32); vfr[2 * kj + 1] = *(const bf16x8*)(va + 32 * AT_VP + kj * 32); } } \
        bf16x8 pb[4]; \
        _Pragma("unroll") for (int i = 8; i < 12; ++i) { const int kj = i - 8; const int jp = kj & 1; \
            if (i & 1) SB1 = __builtin_amdgcn_mfma_f32_32x32x16_bf16(kfr[i], qf[i >> 1], SB1, 0, 0, 0); else SB0 = __builtin_amdgcn_mfma_f32_32x32x16_bf16(kfr[i], qf[i >> 1], SB0, 0, 0, 0); \
            if (kj < 2) pb[kj] = pack8(SA0[8 * jp + 0], SA0[8 * jp + 1], SA0[8 * jp + 2], SA0[8 * jp + 3], SA0[8 * jp + 4], SA0[8 * jp + 5], SA0[8 * jp + 6], SA0[8 * jp + 7]); \
            else        pb[kj] = pack8(SA1[8 * jp + 0], SA1[8 * jp + 1], SA1[8 * jp + 2], SA1[8 * jp + 3], SA1[8 * jp + 4], SA1[8 * jp + 5], SA1[8 * jp + 6], SA1[8 * jp + 7]); \
            AT_SB(); } \
        lsum += ls0 + ls1; \
        float mq0 = SB0[0], mq1 = SB1[0]; \
        _Pragma("unroll") for (int kj = 0; kj < 4; ++kj) { \
            o0 = __builtin_amdgcn_mfma_f32_32x32x16_bf16(vfr[2 * kj], pb[kj], o0, 0, 0, 0); o1 = __builtin_amdgcn_mfma_f32_32x32x16_bf16(vfr[2 * kj + 1], pb[kj], o1, 0, 0, 0); \
            mq0 = __builtin_fmaxf(__builtin_fmaxf(mq0, SB0[4 * kj]), SB0[4 * kj + 1]); mq1 = __builtin_fmaxf(__builtin_fmaxf(mq1, SB1[4 * kj]), SB1[4 * kj + 1]); \
            mq0 = __builtin_fmaxf(__builtin_fmaxf(mq0, SB0[4 * kj + 2]), SB0[4 * kj + 3]); mq1 = __builtin_fmaxf(__builtin_fmaxf(mq1, SB1[4 * kj + 2]), SB1[4 * kj + 3]); \
            AT_SB(); } \
        mxc = __builtin_fmaxf(mq0, mq1);            \
        if (t_ + 3 < NT) AT_LSTOREK(lds + ((t_ + 3) & 3) * AT_KB); \
        if (t_ + 2 < NT) AT_LSTOREV(lds + AT_V0 + ((t_ + 2) & 3) * AT_VBS); \
        if (t_ & 1) __syncthreads(); \
    } while (0)
    float mxc = at_max32(sa0, sa1);
    for (int t = 0; t < NT; t += 2) { AT_STEP(sa0, sa1, sb0, sb1, t); AT_STEP(sb0, sb1, sa0, sa1, t + 1); }
    lsum += __shfl_xor(lsum, 32);
    const float inv = 1.0f / lsum;
    bf16_t* op = MIX + (size_t)qrow * 1024 + 256 + h * 64 + 4 * hi;
#pragma unroll
    for (int g4 = 0; g4 < 4; ++g4) { u32x2 w0, w1; w0.x = pk2(o0[4 * g4] * inv, o0[4 * g4 + 1] * inv); w0.y = pk2(o0[4 * g4 + 2] * inv, o0[4 * g4 + 3] * inv);
        w1.x = pk2(o1[4 * g4] * inv, o1[4 * g4 + 1] * inv); w1.y = pk2(o1[4 * g4 + 2] * inv, o1[4 * g4 + 3] * inv);
        *(u32x2*)(op + 8 * g4) = w0; *(u32x2*)(op + 32 + 8 * g4) = w1; }
#undef AT_GLOADK
#undef AT_GLOADV
#undef AT_LSTOREK
#undef AT_LSTOREV
#undef AT_STEP
#undef AT_SB
}

constexpr int RT_VP = 264, RT_SP = 144, RT_VB = 2 * 64 * RT_VP;
DEV void retout_unit(const Params& p, int l, unsigned char* lds, int u) {
    const int tid = otid(), lane = tid & 63, wid = tid >> 6, l32 = lane & 31, hi = lane >> 5;
    const int gc = u >> 1, hp = u & 1; const int cb = gc % 66; const bool lat = cb >= 2; const int t0 = (cb - 2) * 128; const int r0 = gc * 128;
    const bf16_t* P = (const bf16_t*)p.out; bf16_t* MIX = (bf16_t*)(p.ws + OFF_HN); const f32x2* rope = (const f32x2*)(p.ws + OFF_ROPE);
    const float* SIN = (const float*)(p.ws + OFF_OV + OV_SIN);
    bf16_t* VTl = (bf16_t*)lds; bf16_t* STl = (bf16_t*)(lds + RT_VB);
    __syncthreads();
    for (int task = tid; task < 2048; task += NWG_T) { const int hh = task >> 10, key = (task >> 3) & 127, ch = task & 7;
        const bf16x8 v = *(const bf16x8*)(P + (size_t)(r0 + key) * INW + 256 + (2 * hp + hh) * 64 + ch * 8);
#pragma unroll
        for (int j = 0; j < 8; ++j) VTl[(hh * 64 + ch * 8 + j) * (RT_VP / 2) + key] = (bf16_t)v[j]; }
    for (int task = tid; task < 8192; task += NWG_T) { const int dv = task & 63, k = (task >> 6) & 31, dir = (task >> 11) & 1, hh = task >> 12;
        STl[(hh * 64 + dv) * (RT_SP / 2) + dir * 32 + k] = (bf16_t)f2bf(SIN[((size_t)(gc * 4 + 2 * hp + hh) * 2 + dir) * 2048 + k * 64 + dv]); }
    __syncthreads();
    const int hh = wid >> 2, h = 2 * hp + hh, qblk = wid & 3; const int n = 32 * qblk + l32; const int rq = r0 + n;
    const float lf = log2_sigmoid(p.ret_decay_f[l * 4 + h]), lb = log2_sigmoid(p.ret_decay_b[l * 4 + h]);
    float qv0[8], qv1[8]; bf16x8 qf0, qf1;
    { const bf16_t* qp = P + (size_t)rq * INW + h * 32 + 8 * hi; const bf16x8 a = *(const bf16x8*)qp, c2 = *(const bf16x8*)(qp + 16);
#pragma unroll
      for (int j = 0; j < 8; ++j) { float x1 = bf2f((unsigned short)a[j]), x2 = bf2f((unsigned short)c2[j]);
          if (lat) { const f32x2 cs = rope[(size_t)(t0 + n) * 16 + 8 * hi + j]; const float y1 = x1 * cs.x - x2 * cs.y, y2 = x2 * cs.x + x1 * cs.y; x1 = y1; x2 = y2; }
          qv0[j] = x1; qv1[j] = x2; }
      qf0 = pack8(qv0[0], qv0[1], qv0[2], qv0[3], qv0[4], qv0[5], qv0[6], qv0[7]); qf1 = pack8(qv1[0], qv1[1], qv1[2], qv1[3], qv1[4], qv1[5], qv1[6], qv1[7]); }
    f32x16 o0, o1;
#pragma unroll
    for (int r = 0; r < 16; ++r) { o0[r] = 0.f; o1[r] = 0.f; }
    const unsigned char* vbase = (const unsigned char*)VTl + (size_t)(hh * 64 + l32) * RT_VP + hi * 8;
    bf16x8 kga[4], kgc[4];
#pragma unroll
    for (int kb = 0; kb < 4; ++kb) { const bf16_t* kp = P + (size_t)(r0 + 32 * kb + l32) * INW + 128 + h * 32 + 8 * hi; kga[kb] = *(const bf16x8*)kp; kgc[kb] = *(const bf16x8*)(kp + 16); }
    __builtin_amdgcn_sched_barrier(0);
#pragma unroll
    for (int kb = 0; kb < 4; ++kb) {
        bf16x8 kf0, kf1;
        { const int key = 32 * kb + l32; const bf16x8 a = kga[kb], c2 = kgc[kb];
          float y1[8], y2[8];
#pragma unroll
          for (int j = 0; j < 8; ++j) { float x1 = bf2f((unsigned short)a[j]), x2 = bf2f((unsigned short)c2[j]);
              if (lat) { const f32x2 cs = rope[(size_t)(t0 + key) * 16 + 8 * hi + j]; const float z1 = x1 * cs.x - x2 * cs.y, z2 = x2 * cs.x + x1 * cs.y; x1 = z1; x2 = z2; }
              y1[j] = x1 * 0.17677669529663687f; y2[j] = x2 * 0.17677669529663687f; }
          kf0 = pack8(y1[0], y1[1], y1[2], y1[3], y1[4], y1[5], y1[6], y1[7]); kf1 = pack8(y2[0], y2[1], y2[2], y2[3], y2[4], y2[5], y2[6], y2[7]); }
        f32x16 s;
#pragma unroll
        for (int r = 0; r < 16; ++r) s[r] = 0.f;
        s = __builtin_amdgcn_mfma_f32_32x32x16_bf16(kf0, qf0, s, 0, 0, 0); s = __builtin_amdgcn_mfma_f32_32x32x16_bf16(kf1, qf1, s, 0, 0, 0);
#pragma unroll
        for (int r = 0; r < 16; ++r) { const int m = 32 * kb + crow(r, hi); const int dl = n - m; const float e = dl >= 0 ? lf * (float)dl : lb * (float)(-dl); s[r] *= __builtin_amdgcn_exp2f(e); }
#pragma unroll
        for (int jp = 0; jp < 2; ++jp) { const bf16x8 pb = pack8(s[8 * jp + 0], s[8 * jp + 1], s[8 * jp + 2], s[8 * jp + 3], s[8 * jp + 4], s[8 * jp + 5], s[8 * jp + 6], s[8 * jp + 7]);
            const unsigned char* vp = vbase + (32 * kb + 16 * jp) * 2;
            const u32x2 a00 = *(const u32x2*)vp, a01 = *(const u32x2*)(vp + 16), a10 = *(const u32x2*)(vp + 32 * RT_VP), a11 = *(const u32x2*)(vp + 32 * RT_VP + 16);
            const bf16x8 A0 = __builtin_bit_cast(bf16x8, (u32x4){a00.x, a00.y, a01.x, a01.y}), A1 = __builtin_bit_cast(bf16x8, (u32x4){a10.x, a10.y, a11.x, a11.y});
            o0 = __builtin_amdgcn_mfma_f32_32x32x16_bf16(A0, pb, o0, 0, 0, 0); o1 = __builtin_amdgcn_mfma_f32_32x32x16_bf16(A1, pb, o1, 0, 0, 0); }
    }
    { const float df = __builtin_amdgcn_exp2f(lf * (float)(n + 1)), db = __builtin_amdgcn_exp2f(lb * (float)(128 - n));
      const unsigned char* sbase = (const unsigned char*)STl + (size_t)(hh * 64 + l32) * RT_SP + hi * 16;
#pragma unroll
      for (int ks = 0; ks < 4; ++ks) { const float dd = ks < 2 ? df : db;
          const bf16x8 qb = (ks & 1) ? pack8(qv1[0] * dd, qv1[1] * dd, qv1[2] * dd, qv1[3] * dd, qv1[4] * dd, qv1[5] * dd, qv1[6] * dd, qv1[7] * dd)
                                     : pack8(qv0[0] * dd, qv0[1] * dd, qv0[2] * dd, qv0[3] * dd, qv0[4] * dd, qv0[5] * dd, qv0[6] * dd, qv0[7] * dd);
          const bf16x8 A0 = *(const bf16x8*)(sbase + ks * 32), A1 = *(const bf16x8*)(sbase + 32 * RT_SP + ks * 32);
          o0 = __builtin_amdgcn_mfma_f32_32x32x16_bf16(A0, qb, o0, 0, 0, 0); o1 = __builtin_amdgcn_mfma_f32_32x32x16_bf16(A1, qb, o1, 0, 0, 0); } }
    float ssq = 0.f;
#pragma unroll
    for (int r = 0; r < 16; ++r) ssq += o0[r] * o0[r] + o1[r] * o1[r];
    ssq += __shfl_xor(ssq, 32);
    const float rstd = rsqrtf(ssq * (1.f / 64.f) + EPS);
    const bf16_t* gp = P + (size_t)rq * INW + 512 + h * 64 + 4 * hi; bf16_t* op = MIX + (size_t)rq * 1024 + h * 64 + 4 * hi;
#pragma unroll
    for (int g4 = 0; g4 < 4; ++g4) { const u32x2 ga = *(const u32x2*)(gp + 8 * g4), gb = *(const u32x2*)(gp + 32 + 8 * g4);
        u32x2 w0, w1;
        w0.x = pk2(o0[4 * g4] * rstd * siluf(bf2f(ga.x & 0xffff)), o0[4 * g4 + 1] * rstd * siluf(bf2f(ga.x >> 16))); w0.y = pk2(o0[4 * g4 + 2] * rstd * siluf(bf2f(ga.y & 0xffff)), o0[4 * g4 + 3] * rstd * siluf(bf2f(ga.y >> 16)));
        w1.x = pk2(o1[4 * g4] * rstd * siluf(bf2f(gb.x & 0xffff)), o1[4 * g4 + 1] * rstd * siluf(bf2f(gb.x >> 16))); w1.y = pk2(o1[4 * g4 + 2] * rstd * siluf(bf2f(gb.y & 0xffff)), o1[4 * g4 + 3] * rstd * siluf(bf2f(gb.y >> 16)));
        *(u32x2*)(op + 8 * g4) = w0; *(u32x2*)(op + 32 + 8 * g4) = w1; }
}

DEV void phase_ffn_fixup(const Params& p, int l) {
    const float* EDGE = (const float*)(p.ws + OFF_EDGE); bf16_t* ACT = (bf16_t*)(p.ws + OFF_OV);
    const float* cw = p.conv_w + (size_t)l * 3 * 5632; const float* cbv = p.conv_b + (size_t)l * 5632;
    for (int idx = blockIdx.x * NWG_T + otid(); idx < 66 * 2 * 704; idx += gridDim.x * NWG_T) {
        const int ch4 = idx % 704, rest = idx / 704; const int which = rest & 1, pm = rest >> 1; const int jj = pm % 33;
        if (l == 1 && jj == 0) continue;
        const int ch = 4 * ch4, pn = ch >> 7, c = ch & 127;
        const bool sstart = jj <= 1, send = (jj == 0) || (jj == 32);
        const f32x4 zz = {0.f, 0.f, 0.f, 0.f};
#define EDG(tile, k, half) (*(const f32x4*)(EDGE + ((size_t)((tile) * 4 + (k)) * 22 + pn) * 256 + (half) * 128 + c))
        f32x4 ua, ub, ca, cb2, da, db;
        if (which == 0) { ua = sstart ? zz : EDG(pm - 1, 3, 0); ub = sstart ? zz : EDG(pm - 1, 3, 1); ca = EDG(pm, 0, 0); cb2 = EDG(pm, 0, 1); da = EDG(pm, 1, 0); db = EDG(pm, 1, 1); }
        else { ua = EDG(pm, 2, 0); ub = EDG(pm, 2, 1); ca = EDG(pm, 3, 0); cb2 = EDG(pm, 3, 1); da = send ? zz : EDG(pm + 1, 0, 0); db = send ? zz : EDG(pm + 1, 0, 1); }
#undef EDG
        const f32x4 wa0 = *(const f32x4*)(cw + ch), wa1 = *(const f32x4*)(cw + 5632 + ch), wa2 = *(const f32x4*)(cw + 2 * 5632 + ch), ba = *(const f32x4*)(cbv + ch);
        const f32x4 wb0 = *(const f32x4*)(cw + DFF + ch), wb1 = *(const f32x4*)(cw + 5632 + DFF + ch), wb2 = *(const f32x4*)(cw + 2 * 5632 + DFF + ch), bb = *(const f32x4*)(cbv + DFF + ch);
        const f32x4 xa = wa0 * ua + wa1 * ca + wa2 * da + ba, xb = wb0 * ub + wb1 * cb2 + wb2 * db + bb;
        u32x2 w; w.x = pk2(siluf(xa.x) * xb.x, siluf(xa.y) * xb.y); w.y = pk2(siluf(xa.z) * xb.z, siluf(xa.w) * xb.w);
        *(u32x2*)(ACT + (size_t)(pm * 256 + (which ? 255 : 0)) * DFF + ch) = w;
    }
}

#define RLX_AGENT __ATOMIC_RELAXED, __HIP_MEMORY_SCOPE_AGENT
#define XB_TMO      128
#define XB_XCNT(j)  (256  + 64 * (j))
#define XB_XSUB(j)  (1280 + 64 * (j))
#define XB_XGEN(j)  (2304 + 64 * (j))
#define XB_TOP      3328
#define XB_TOPGEN   3392
#define XCD_BAR_WORDS 3456
#define XB_SPIN_CAP (1u << 18)

__device__ __forceinline__ unsigned xb_ld(unsigned* p)              { return __hip_atomic_load(p, __ATOMIC_RELAXED, __HIP_MEMORY_SCOPE_AGENT); }
__device__ __forceinline__ unsigned xb_add(unsigned* p, unsigned v) { return __hip_atomic_fetch_add(p, v, __ATOMIC_RELAXED, __HIP_MEMORY_SCOPE_AGENT); }
__device__ __forceinline__ unsigned xb_xcc_id() { return (unsigned)__builtin_amdgcn_s_getreg((3 << 11) | 20) & 0xFu; }
#define XB_SPIN(cond, bar) do { unsigned _sp = 0; while (cond) { __builtin_amdgcn_s_sleep(1); \
    if ((++_sp & 255u) == 0u) { if (xb_ld(&(bar)[XB_TMO])) break; if (_sp > XB_SPIN_CAP) { atomicAdd(&(bar)[XB_TMO], 1u); break; } } } } while (0)

struct XcdBarrier {
    unsigned* bar; unsigned x;
    volatile LAS unsigned* st;
};

__device__ __forceinline__ XcdBarrier xcd_barrier_post(unsigned* bar, volatile LAS unsigned* st) {
    XcdBarrier b; b.bar = bar; b.x = xb_xcc_id(); b.st = st;
    if (threadIdx.x == 0) (void)xb_add(&bar[XB_XCNT(b.x)], 1u);
    return b;
}
__device__ __forceinline__ void xcd_barrier_complete(unsigned* bar, unsigned x, unsigned& nloc, unsigned& nx) {
    const unsigned G = gridDim.x * gridDim.y * gridDim.z;
    unsigned sum, cnt, mine, sp = 0u;
    for (;;) {
        sum = 0u; cnt = 0u; mine = 0u;
#pragma unroll
        for (unsigned j = 0; j < 16; ++j) { const unsigned c = xb_ld(&bar[XB_XCNT(j)]); sum += c; cnt += (c > 0u) ? 1u : 0u; mine = (j == x) ? c : mine; }
        if (sum == G) break;
        __builtin_amdgcn_s_sleep(1);
        if ((++sp & 255u) == 0u) { if (xb_ld(&bar[XB_TMO])) break; if (sp > XB_SPIN_CAP) { atomicAdd(&bar[XB_TMO], 1u); break; } }
    }
    nloc = mine > 0u ? mine : 1u; nx = cnt > 0u ? cnt : 1u;
}

__device__ __forceinline__ void xcd_barrier(const XcdBarrier& b) {
    asm volatile("s_waitcnt vmcnt(0)" ::: "memory");
    __syncthreads();
    if (threadIdx.x == 0) {
        unsigned* bar = b.bar;
        __builtin_amdgcn_s_waitcnt(0);
        unsigned nloc = b.st[0], nx = b.st[1];
        if (nloc == 0u) { xcd_barrier_complete(bar, b.x, nloc, nx); b.st[0] = nloc; b.st[1] = nx; }
        const unsigned old = xb_add(&bar[XB_XSUB(b.x)], 1u);
        const unsigned gen = old / nloc;
        if (old + 1u == (gen + 1u) * nloc) {
            __builtin_amdgcn_fence(__ATOMIC_RELEASE, "agent");
            asm volatile("s_waitcnt vmcnt(0)" ::: "memory");
            const unsigned og = xb_add(&bar[XB_TOP], 1u);
            const unsigned tg = og / nx;
            if (og + 1u == (tg + 1u) * nx) xb_add(&bar[XB_TOPGEN], 1u);
            else XB_SPIN(xb_ld(&bar[XB_TOPGEN]) == tg, bar);
            __builtin_amdgcn_fence(__ATOMIC_ACQUIRE, "agent");
            xb_add(&bar[XB_XGEN(b.x)], 1u);
            asm volatile("s_waitcnt vmcnt(0)" ::: "memory");
        } else {
            XB_SPIN(xb_ld(&bar[XB_XGEN(b.x)]) == gen, bar);
            __builtin_amdgcn_fence(__ATOMIC_ACQUIRE, "agent");
            asm volatile("s_waitcnt vmcnt(0)" ::: "memory");
        }
    }
    __syncthreads();
}


constexpr size_t OFF_CTL = 250000128; constexpr int CTL_BYTES = 16384;
#if defined(__HIP_DEVICE_COMPILE__)
#define KP() const __attribute__((address_space(4))) Params* kp_ = (const __attribute__((address_space(4))) Params*)__builtin_amdgcn_kernarg_segment_ptr(); asm volatile("" : "+s"(kp_)); const Params p = *kp_; \
    bf16_t* HN = (bf16_t*)(p.ws + OFF_HN); bf16_t* P = (bf16_t*)p.out; float* X = (float*)(p.ws + OFF_X); (void)HN; (void)P; (void)X
#else
#define KP() const Params p = p_arg; bf16_t* HN = (bf16_t*)(p.ws + OFF_HN); bf16_t* P = (bf16_t*)p.out; float* X = (float*)(p.ws + OFF_X); (void)HN; (void)P; (void)X
#endif
#define WL() const bf16_t* wl = (const bf16_t*)(p.ws + OFF_W) + (size_t)l * W_LAYER; const float* modv = (const float*)(p.ws + OFF_MOD) + (size_t)l * 3 * 6144; (void)wl; (void)modv
#ifndef DUPM
#define DUPM 0
#endif
#define REP(bit) for (int rep_ = 0; rep_ < (((DUPM) >> (bit)) & 1) + 1; ++rep_)
constexpr int PH_PER_LAYER = 10, N_PHASES = 2 + 2 * PH_PER_LAYER;
__global__ void __launch_bounds__(512, 2) mk_fwd(Params p_arg) {
    extern __shared__ __attribute__((aligned(16))) unsigned char lds[];
    cg::grid_group grid = cg::this_grid();
    const int G = gridDim.x, bx = blockIdx.x; const int vcu = (G % 8 == 0) ? (bx % 8) * (G / 8) + bx / 8 : bx;
    LAS unsigned char* ldsl = (LAS unsigned char*)lds;
    const int ph_lo = p_arg.ph_lo, ph_hi = p_arg.ph_hi;
    volatile LAS unsigned* misc = (volatile LAS unsigned*)(ldsl + (LDS_BYTES - 64));
    { const int t0_ = otid(); if (t0_ < 16) misc[t0_] = 0u; }
    __syncthreads();
    if (ph_hi - ph_lo > 1) (void)xcd_barrier_post((unsigned*)(p_arg.ws + OFF_CTL), misc);
    for (int ph = ph_lo; ph < ph_hi; ++ph) {
        if (ph == 0) { KP(); phase_prep(p, lds); __syncthreads(); }
        else if (ph == N_PHASES - 1) { KP(); phase_final(p);
#if (DUPM >> 10) & 1
            for (int i = 0; i < 20; ++i) grid.sync();
#endif
        }
        else {
            const int l = (ph - 1) / PH_PER_LAYER, sp = (ph - 1) % PH_PER_LAYER;
            if (sp == 0) { KP(); if (l == 0) REP(9) { phase_prep_weights(p, lds); __syncthreads(); }
                phase_norm(p, l, 0, l == 0, l == 1 ? (const float*)(p.ws + OFF_MOD) + 2 * 6144 + 5120 : nullptr); }
            else if (sp == 1) { KP(); WL(); REP(1) { __syncthreads();
                pg8::Gemm g{HN, wl + W_IN, R, 1792, 1024, 1024, 1024}; pg8::StaticOrder S; S.init(R, 1792, G, bx);
                pg8::EpiStore E{P, INW, INW, 1.0f};
                pg8::gemm_phase<pg8::EpiStore, pg8::StaticOrder, true, true>(ldsl, g, S, E); } }
            else if (sp == 2) { KP(); phase_rowwise(p, l); __syncthreads();
                REP(2) phase_pool(p);
                REP(3) for (int it = G - 1 - bx; it < 264; it += G) states_item(p, l, lds, it); __syncthreads(); }
            else if (sp == 3) { KP(); WL(); REP(4) { __syncthreads();
                { pg8::Gemm g{P + 768, wl + W_UQ, R, 768, 384, INW, 384}; pg8::StaticOrder S; S.init(R, 768, G, bx);
                  pg8::EpiStore E{(bf16_t*)(p.ws + OFF_OV + OV_Q), 768, 768, 0.14724444f};
                  pg8::gemm_phase<pg8::EpiStore, pg8::StaticOrder, true, true>(ldsl, g, S, E); }
                __syncthreads();
                { pg8::Gemm g{P + 1152, wl + W_KN, R, 512, 256, INW, 256}; pg8::StaticOrder S; S.init(R, 512, G, (bx + 58) % G);
                  pg8::EpiStore E{(bf16_t*)(p.ws + OFF_OV + OV_KN), 512, 512, 1.0f};
                  pg8::gemm_phase<pg8::EpiStore, pg8::StaticOrder, true, true>(ldsl, g, S, E); }
                __syncthreads();
                { pg8::Gemm g{wl + W_V, P + 1152, 512, R, 256, 256, INW}; pg8::StaticOrder S; S.init(512, R, G, (bx + 182) % G);
                  pg8::EpiStore E{(bf16_t*)(p.ws + OFF_OV + OV_VT), R, R, 1.0f};
                  pg8::gemm_phase<pg8::EpiStore, pg8::StaticOrder, true, true>(ldsl, g, S, E); }
                if (bx >= G - 64) scan_threads(p, l, (bx - (G - 64)) * NWG_T + otid()); } }
            else if (sp == 4) { KP();
                REP(5) for (int u = vcu; u < (l == 0 ? 528 : 512); u += G) attn_unit(p, lds, u);
                REP(6) for (int u = G - 1 - bx; u < (l == 0 ? 264 : 256); u += G) retout_unit(p, l, lds, l == 0 ? u : u + 4 * (u >> 7) + 4); }
            else if (sp == 5) { KP(); WL(); __syncthreads();
                { pg8::Gemm g{HN, wl + W_OUT, R, 1024, 1024, 1024, 1024}; pg8::StaticOrder S; S.init(16384, 1024, G, bx, 1);
                  pg8::EpiResid E{X, modv + 2048, 0};
                  pg8::gemm_phase<pg8::EpiResid, pg8::StaticOrder, true, true>(ldsl, g, S, E); }
                if (l == 0 && bx < 32) { __syncthreads(); const int q = bx >> 3;
                  pg8::Gemm g{HN + q * 256, wl + W_OUT + q * 256, 512, 1024, 256, 1024, 1024}; pg8::StaticOrder S; S.init(512, 1024, G, bx & 7, 2);
                  pg8::EpiPart E{(float*)(p.ws + OFF_PART) + (size_t)q * 524288, 0};
                  pg8::gemm_phase<pg8::EpiPart, pg8::StaticOrder, true, true>(ldsl, g, S, E); } }
            else if (sp == 6) { KP(); WL(); phase_norm(p, l, 1, false, l == 0 ? modv + 2 * 6144 + 2048 : nullptr); }
            else if (sp == 7) { KP(); WL(); REP(7) { __syncthreads();
                pg8::Gemm g{HN, wl + W_UP, R, 2 * DFF, 1024, 1024, 1024}; pg8::StaticOrder S; S.init(l == 1 ? 16384 : R, 2 * DFF, G, bx, l == 1 ? 1 : 0);
                pg8::EpiFfn E{(bf16_t*)(p.ws + OFF_OV), (float*)(p.ws + OFF_EDGE), p.conv_w + (size_t)l * 3 * 5632, p.conv_b + (size_t)l * 5632, (LAS float*)(ldsl + 131072)};
                pg8::gemm_phase<pg8::EpiFfn, pg8::StaticOrder, true, true>(ldsl, g, S, E); } }
            else if (sp == 8) { KP(); REP(8) phase_ffn_fixup(p, l); }
            else if (sp == 9) { KP(); WL(); __syncthreads();
                { pg8::Gemm g{(const bf16_t*)(p.ws + OFF_OV), wl + W_DN, R, 1024, DFF, DFF, DFF}; pg8::StaticOrder S; S.init(16384, 1024, G, bx, 1);
                  pg8::EpiResid E{X, modv + 5120, 0};
                  pg8::gemm_phase<pg8::EpiResid, pg8::StaticOrder, true, true>(ldsl, g, S, E); }
                if (l == 0 && bx < 32) { __syncthreads(); const int q = bx >> 3; const int koff = q < 2 ? q * 768 : 1536 + (q - 2) * 640, klen = q < 2 ? 768 : 640;
                  pg8::Gemm g{(const bf16_t*)(p.ws + OFF_OV) + koff, wl + W_DN + koff, 512, 1024, klen, DFF, DFF}; pg8::StaticOrder S; S.init(512, 1024, G, bx & 7, 2);
                  pg8::EpiPart E{(float*)(p.ws + OFF_PART) + (size_t)q * 524288, 0};
                  pg8::gemm_phase<pg8::EpiPart, pg8::StaticOrder, true, true>(ldsl, g, S, E); } }
        }
        if (ph + 1 < ph_hi) {
            if (ph_lo < 0) grid.sync();
            { KP(); XcdBarrier b; b.bar = (unsigned*)(p.ws + OFF_CTL); b.x = xb_xcc_id(); b.st = misc; xcd_barrier(b); }
        }
    }
}

extern "C" void kernel_launch(void* const* d_in, const int* in_sizes, int n_in, void* d_out, int out_size, void* d_ws, size_t ws_size, hipStream_t stream) {
    static int grid = 0;
    if (grid == 0) {
        if (n_in != 23 || ws_size < WS_NEED) { fprintf(stderr, "kernel_launch: unexpected problem (n_in %d, ws %zu, need %zu)\n", n_in, ws_size, (size_t)WS_NEED); grid = -1; return; }
        int dev = 0, cus = 0, per_cu = 0;
        hipGetDevice(&dev); hipDeviceGetAttribute(&cus, hipDeviceAttributeMultiprocessorCount, dev);
        if (hipFuncSetAttribute((const void*)mk_fwd, hipFuncAttributeMaxDynamicSharedMemorySize, LDS_BYTES) != hipSuccess) { fprintf(stderr, "kernel_launch: hipFuncSetAttribute failed\n"); grid = -1; return; }
        if (hipOccupancyMaxActiveBlocksPerMultiprocessor(&per_cu, (const void*)mk_fwd, 512, LDS_BYTES) != hipSuccess || per_cu < 1) { fprintf(stderr, "kernel_launch: occupancy query says %d\n", per_cu); per_cu = 1; }
        (void)hipGetLastError();
        grid = cus * per_cu; if (grid > 256) grid = 256;
        fprintf(stderr, "kernel_launch: grid %d (cus %d, per_cu %d)\n", grid, cus, per_cu);
    }
    if (grid < 0) return;
    Params p{};
    const float** pp = (const float**)&p;
    for (int i = 0; i < 23; ++i) pp[i] = (const float*)d_in[i];
    p.out = (float*)d_out; p.ws = (unsigned char*)d_ws;
#if MK_MULTI
    for (int ph = 0; ph < N_PHASES; ++ph) { p.ph_lo = ph; p.ph_hi = ph + 1; void* args[] = {&p};
        hipError_t e = hipLaunchCooperativeKernel((void*)mk_fwd, dim3(grid), dim3(512), args, LDS_BYTES, stream);
        if (e != hipSuccess) { fprintf(stderr, "launch %d failed: %s\n", ph, hipGetErrorString(e)); break; } }
#else
    if (hipMemsetAsync((char*)d_ws + OFF_CTL, 0, CTL_BYTES, stream) != hipSuccess) { fprintf(stderr, "kernel_launch: memset of the barrier words failed\n"); return; }
    p.ph_lo = 0; p.ph_hi = N_PHASES; void* args[] = {&p};
    hipError_t e = hipLaunchCooperativeKernel((void*)mk_fwd, dim3(grid), dim3(512), args, LDS_BYTES, stream);
    if (e != hipSuccess) fprintf(stderr, "cooperative launch failed: %s (grid %d)\n", hipGetErrorString(e), grid);
#endif
}
```

```cpp
#include <hip/hip_runtime.h>
#include <hip/hip_cooperative_groups.h>
#include <cstdio>
#include <cstdint>
namespace cg = cooperative_groups;

#ifndef MK_MULTI
#define MK_MULTI 0
#endif

namespace pg8 {
#define PG8_LAS __attribute__((address_space(3)))
typedef unsigned short bf16_t;
typedef short bf16x8 __attribute__((ext_vector_type(8)));
typedef float f32x4 __attribute__((ext_vector_type(4)));
typedef unsigned u32x4 __attribute__((ext_vector_type(4)));
constexpr int BM = 256, BK = 64, HALF = 128, HTB = HALF * BK * 2  , STAGE_BYTES = 8 * HTB, NXCD = 8, WGM = 8;

__host__ __device__ __forceinline__ int lds_byte(int r, int c) { const int st = (r >> 4) * 2 + (c >> 5), rr = r & 15, cc = c & 31, ob = rr * 64 + cc * 2; return st * 1024 + (ob ^ (((ob >> 9) & 1) << 5)); }
__host__ __device__ __forceinline__ void stage_rc(int b, int& R, int& C) { const int st = b / 1024, sb = b % 1024, swz = sb ^ (((sb >> 9) & 1) << 5); R = (st >> 1) * 16 + swz / 64; C = (st & 1) * 32 + (swz % 64) / 2; }
__host__ __device__ __forceinline__ int perm32(int rho) { const int n = rho >> 4, i = rho & 15; return 8 * (i >> 2) + 4 * n + (i & 3); }

struct Unit { int pm, pn; };
struct Gemm { const bf16_t* A; const bf16_t* Bt; int M, N, K, lda, ldb; };

struct StaticOrder {
    int nM, nN, nwg, G, c, skip;
    __host__ __device__ void init(int M, int N, int G_, int c_, int skip_ = 0) { nM = M / BM; nN = N / BM; nwg = nM * nN; G = G_; c = c_; skip = skip_; }
    __host__ __device__ bool next(int i, Unit& u) const {
        const long L = (long)i * G + c; if (L >= nwg) return false;
        int wgid = (int)L; { const int q = nwg / NXCD, r = nwg % NXCD, xcd = wgid % NXCD, off = wgid / NXCD; wgid = (xcd < r ? xcd * (q + 1) : r * (q + 1) + (xcd - r) * q) + off; }
        const int nig = WGM * nN, gid = wgid / nig, fm = gid * WGM, gsz = (nM - fm) < WGM ? (nM - fm) : WGM;
        u.pm = fm + ((wgid % nig) % gsz); u.pn = (wgid % nig) / gsz; if (skip == 1) u.pm += 1 + (u.pm >= 32 ? 1 : 0); else if (skip == 2) u.pm *= 33; return true;
    }
    __device__ __forceinline__ void a_ready(const Unit&) const {}
    __device__ __forceinline__ void done(const Unit&) const {}
};

__device__ __forceinline__ unsigned cvt_pk_bf16(float lo, float hi) { unsigned r; asm volatile("v_cvt_pk_bf16_f32 %0, %1, %2" : "=v"(r) : "v"(lo), "v"(hi)); return r; }

struct EpiStore {
    static constexpr bool PERM = true, AFTER_DRAIN = false;
    bf16_t* O; int ldc; int ncols; float scale;
    __device__ __forceinline__ void operator()(const f32x4 (&acc)[2][2][4][2], const Unit& u, int wr, int wc, int fr, int fq) const {
        const int row0 = u.pm * BM + wr * 64 + fr; const int col0 = u.pn * BM + wc * 32 + 8 * fq;
#pragma unroll
        for (int ai = 0; ai < 2; ++ai)
#pragma unroll
            for (int m = 0; m < 4; ++m) { bf16_t* rowp = O + (size_t)(row0 + ai * HALF + m * 16) * ldc + col0;
#pragma unroll
                for (int bj = 0; bj < 2; ++bj) { if (col0 + bj * HALF < ncols) {
                    f32x4 v0 = acc[ai][bj][m][0] * scale, v1 = acc[ai][bj][m][1] * scale;
                    u32x4 w; w.x = cvt_pk_bf16(v0[0], v0[1]); w.y = cvt_pk_bf16(v0[2], v0[3]); w.z = cvt_pk_bf16(v1[0], v1[1]); w.w = cvt_pk_bf16(v1[2], v1[3]);
                    *(u32x4*)(rowp + bj * HALF) = w; } } }
    }
};
struct EpiResid {
    static constexpr bool PERM = false, AFTER_DRAIN = false;
    float* X; const float* gate; int row_tile0;
    __device__ __forceinline__ void operator()(const f32x4 (&acc)[2][2][4][2], const Unit& u, int wr, int wc, int fr, int fq) const {
        const int tpm = u.pm + row_tile0; const int bb = tpm / 33, jj = tpm - bb * 33; const float* gv = gate + (jj == 0 ? 2 : bb) * 6144;
        const int col0 = u.pn * BM + wc * 32 + 4 * fq;
#pragma unroll
        for (int ai = 0; ai < 2; ++ai)
#pragma unroll
            for (int m = 0; m < 4; ++m) { float* rowp = X + (size_t)(tpm * BM + ai * HALF + wr * 64 + m * 16 + fr) * 1024 + col0;
#pragma unroll
                for (int bj = 0; bj < 2; ++bj) {
#pragma unroll
                    for (int n = 0; n < 2; ++n) { f32x4* q = (f32x4*)(rowp + bj * HALF + n * 16); const f32x4 gq = *(const f32x4*)(gv + col0 + bj * HALF + n * 16); f32x4 xv = *q; xv = xv + gq * acc[ai][bj][m][n]; *q = xv; }
                    asm volatile("" ::: "memory"); } }
    }
};
struct EpiPart {
    static constexpr bool PERM = false, AFTER_DRAIN = false;
    float* out; int accum;
    __device__ __forceinline__ void operator()(const f32x4 (&acc)[2][2][4][2], const Unit& u, int wr, int wc, int fr, int fq) const {
        const int t = u.pm / 33; const int col0 = u.pn * BM + wc * 32 + 4 * fq;
#pragma unroll
        for (int ai = 0; ai < 2; ++ai)
#pragma unroll
            for (int m = 0; m < 4; ++m) { float* rowp = out + (size_t)(t * BM + ai * HALF + wr * 64 + m * 16 + fr) * 1024 + col0;
#pragma unroll
                for (int bj = 0; bj < 2; ++bj) {
#pragma unroll
                    for (int n = 0; n < 2; ++n) { f32x4* q = (f32x4*)(rowp + bj * HALF + n * 16); f32x4 v = acc[ai][bj][m][n]; if (accum) v = v + *q; *q = v; }
                    asm volatile("" ::: "memory"); } }
    }
};
template <int CTRL> __device__ __forceinline__ float dpp0(float x) { return __builtin_bit_cast(float, __builtin_amdgcn_update_dpp(0, __builtin_bit_cast(int, x), CTRL, 0xf, 0xf, true)); }
struct EpiFfn {
    static constexpr bool PERM = false, AFTER_DRAIN = false;
    bf16_t* ACT; float* EDGE; const float* cw; const float* cb; PG8_LAS float* xl;
    __device__ __forceinline__ void operator()(const f32x4 (&acc)[2][2][4][2], const Unit& u, int wr, int wc, int fr, int fq) const {
        PG8_LAS float* FIRST = xl; PG8_LAS float* LAST = xl + 1024;
        const int cb0 = wc * 32 + 4 * fq;
#pragma unroll
        for (int ai = 0; ai < 2; ++ai)
#pragma unroll
            for (int bj = 0; bj < 2; ++bj)
#pragma unroll
                for (int n = 0; n < 2; ++n) { const int col = bj * HALF + cb0 + n * 16;
                    if (fr == 0) *(PG8_LAS f32x4*)(FIRST + (2 * ai + wr) * 256 + col) = acc[ai][bj][0][n];
                    if (fr == 15) *(PG8_LAS f32x4*)(LAST + (2 * ai + wr) * 256 + col) = acc[ai][bj][3][n]; }
        if (wr == 0 && fr < 2) {
#pragma unroll
            for (int bj = 0; bj < 2; ++bj)
#pragma unroll
                for (int n = 0; n < 2; ++n) *(f32x4*)(EDGE + ((size_t)(u.pm * 4 + fr) * 22 + u.pn) * 256 + bj * HALF + cb0 + n * 16) = acc[0][bj][0][n]; }
        if (wr == 1 && fr >= 14) {
#pragma unroll
            for (int bj = 0; bj < 2; ++bj)
#pragma unroll
                for (int n = 0; n < 2; ++n) *(f32x4*)(EDGE + ((size_t)(u.pm * 4 + 2 + (fr - 14)) * 22 + u.pn) * 256 + bj * HALF + cb0 + n * 16) = acc[1][bj][3][n]; }
        asm volatile("s_waitcnt lgkmcnt(0)" ::: "memory"); __builtin_amdgcn_s_barrier(); asm volatile("" ::: "memory");
#pragma unroll
        for (int n = 0; n < 2; ++n) { const int ch0 = u.pn * HALF + cb0 + n * 16;
            f32x4 wa[3], wb[3];
#pragma unroll
            for (int k = 0; k < 3; ++k) { wa[k] = *(const f32x4*)(cw + k * 5632 + ch0); wb[k] = *(const f32x4*)(cw + k * 5632 + 2816 + ch0); }
            const f32x4 ba = *(const f32x4*)(cb + ch0), bb = *(const f32x4*)(cb + 2816 + ch0);
#pragma unroll
            for (int ai = 0; ai < 2; ++ai) { const int g = 2 * ai + wr;
                f32x4 bu[2], bd[2];
#pragma unroll
                for (int bj = 0; bj < 2; ++bj) { const int col = bj * HALF + cb0 + n * 16; const f32x4 zz = {0.f, 0.f, 0.f, 0.f};
                    bu[bj] = g > 0 ? *(const PG8_LAS f32x4*)(LAST + (g - 1) * 256 + col) : zz; bd[bj] = g < 3 ? *(const PG8_LAS f32x4*)(FIRST + (g + 1) * 256 + col) : zz; }
#pragma unroll
                for (int m = 0; m < 4; ++m) { float o[4];
#pragma unroll
                    for (int e = 0; e < 4; ++e) { float up[2], dn[2];
#pragma unroll
                        for (int bj = 0; bj < 2; ++bj) { const float cur = acc[ai][bj][m][n][e];
                            float x = dpp0<0x111>(cur);
                            if (m > 0) x += dpp0<0x10F>(acc[ai][bj][m - 1][n][e]); else x += (fr == 0 ? bu[bj][e] : 0.f);
                            float y = dpp0<0x101>(cur);
                            if (m < 3) y += dpp0<0x11F>(acc[ai][bj][m + 1][n][e]); else y += (fr == 15 ? bd[bj][e] : 0.f);
                            up[bj] = x; dn[bj] = y; }
                        const float ua = wa[0][e] * up[0] + wa[1][e] * acc[ai][0][m][n][e] + wa[2][e] * dn[0] + ba[e];
                        const float ub = wb[0][e] * up[1] + wb[1][e] * acc[ai][1][m][n][e] + wb[2][e] * dn[1] + bb[e];
                        o[e] = ua * __builtin_amdgcn_rcpf(1.0f + __builtin_amdgcn_exp2f(-1.4426950408889634f * ua)) * ub; }
                    typedef unsigned u32x2 __attribute__((ext_vector_type(2))); u32x2 w; w.x = cvt_pk_bf16(o[0], o[1]); w.y = cvt_pk_bf16(o[2], o[3]);
                    *(u32x2*)(ACT + (size_t)(u.pm * BM + ai * HALF + wr * 64 + m * 16 + fr) * 2816 + ch0) = w; } } }
    }
};

template <class Epi, class Sched, bool ALIGN_EPI = false, bool SP2 = false>
__device__ __forceinline__ void gemm_phase(PG8_LAS unsigned char* lds, const Gemm g, const Sched& S, const Epi& E) {
    int tid = threadIdx.x; asm volatile("" : "+v"(tid));
    const int wid = __builtin_amdgcn_readfirstlane(tid >> 6), lane = tid & 63, wr = wid >> 2, wc = wid & 3, fr = lane & 15, fq = lane >> 4;
    int K = g.K; asm volatile("" : "+s"(K));
    const int nt = K / BK;
    unsigned voffA[2], voffB[2];
#pragma unroll
    for (int i = 0; i < 2; ++i) { int R, C; stage_rc(tid * 16 + i * 8192, R, C); const int Rb = Epi::PERM ? ((R & ~31) + perm32(R & 31)) : R;
        voffA[i] = (unsigned)(R * g.lda + C) * 2u; voffB[i] = (unsigned)(Rb * g.ldb + C) * 2u; }
    const size_t kstep = (size_t)(BK * 2);
    const size_t hstepA = (size_t)HALF * g.lda * 2, hstepB = (size_t)HALF * g.ldb * 2;
    const size_t tstepA = 2 * hstepA, tstepB = 2 * hstepB;
    const unsigned ldsw = (unsigned)wid * 1024u;
    const int aoff = lds_byte(wr * 64 + fr, fq * 8), boff = lds_byte(wc * 32 + fr, fq * 8);
#define PG8_SA(b, h) (((b) * 2 + (h)) * HTB)
#define PG8_SB(b, h) ((4 + (b) * 2 + (h)) * HTB)
#define PG8_STAGE(bufoff, gbase, voff) do { _Pragma("unroll") for (int _i = 0; _i < 2; ++_i) \
        __builtin_amdgcn_global_load_lds((const unsigned*)((const char*)(gbase) + (voff)[_i]), (PG8_LAS unsigned*)(lds + (bufoff) + ldsw + _i * 8192), 16, 0, 0); } while (0)
#define PG8_LDA(dst, b, h) do { _Pragma("unroll") for (int m = 0; m < 4; ++m) _Pragma("unroll") for (int k = 0; k < 2; ++k) dst[m][k] = *(const PG8_LAS bf16x8*)(lds + PG8_SA(b, h) + aoff + m * 2048 + k * 1024); } while (0)
#define PG8_LDB(dst, b, h) do { _Pragma("unroll") for (int n = 0; n < 2; ++n) _Pragma("unroll") for (int k = 0; k < 2; ++k) dst[n][k] = *(const PG8_LAS bf16x8*)(lds + PG8_SB(b, h) + boff + n * 2048 + k * 1024); } while (0)
#define PG8_MMA(ai, bj, At, Bt) do { __builtin_amdgcn_s_setprio(1); _Pragma("unroll") for (int m = 0; m < 4; ++m) _Pragma("unroll") for (int n = 0; n < 2; ++n) _Pragma("unroll") for (int k = 0; k < 2; ++k) \
        acc[ai][bj][m][n] = __builtin_amdgcn_mfma_f32_16x16x32_bf16(Bt[n][k], At[m][k], acc[ai][bj][m][n], 0, 0, 0); __builtin_amdgcn_s_setprio(0); } while (0)
#define PG8_WAIT_V(n) asm volatile("s_waitcnt vmcnt(" #n ")" ::: "memory")
#define PG8_WAIT_L(n) asm volatile("s_waitcnt lgkmcnt(" #n ")" ::: "memory")
#define PG8_BAR __builtin_amdgcn_s_barrier()
#define PG8_SCHED __builtin_amdgcn_sched_barrier(0)
    Unit cur, nxt; int ui = 0;
    if (!S.next(0, cur)) return;
    f32x4 acc[2][2][4][2];
#pragma unroll
    for (int a = 0; a < 2; ++a)
#pragma unroll
        for (int b = 0; b < 2; ++b)
#pragma unroll
            for (int m = 0; m < 4; ++m)
#pragma unroll
                for (int n = 0; n < 2; ++n) acc[a][b][m][n] = (f32x4){0.f, 0.f, 0.f, 0.f};
    bf16x8 At[4][2], B0[2][2], B1[2][2];
    const char* cA = (const char*)g.A + (size_t)cur.pm * tstepA; const char* cB = (const char*)g.Bt + (size_t)cur.pn * tstepB;
    S.a_ready(cur);
    if constexpr (SP2) {
        PG8_STAGE(PG8_SB(0, 0), cB, voffB); PG8_STAGE(PG8_SB(0, 1), cB + hstepB, voffB); PG8_STAGE(PG8_SA(0, 0), cA, voffA); PG8_STAGE(PG8_SA(0, 1), cA + hstepA, voffA);
        if (wr == 1) PG8_BAR;
        PG8_WAIT_V(2); PG8_BAR;
        PG8_STAGE(PG8_SB(1, 0), cB + kstep, voffB); PG8_STAGE(PG8_SA(1, 0), cA + kstep, voffA); PG8_STAGE(PG8_SB(1, 1), cB + hstepB + kstep, voffB);
        PG8_WAIT_V(6); PG8_BAR;
    } else {
        PG8_STAGE(PG8_SB(0, 0), cB, voffB); PG8_STAGE(PG8_SA(0, 0), cA, voffA); PG8_STAGE(PG8_SB(0, 1), cB + hstepB, voffB); PG8_STAGE(PG8_SA(0, 1), cA + hstepA, voffA);
        if (wr == 1) PG8_BAR;
        PG8_WAIT_V(4); PG8_BAR;
        PG8_STAGE(PG8_SB(1, 0), cB + kstep, voffB); PG8_STAGE(PG8_SA(1, 0), cA + kstep, voffA); PG8_STAGE(PG8_SB(1, 1), cB + hstepB + kstep, voffB);
        PG8_WAIT_V(6); PG8_BAR;
    }
    for (;;) {
        const bool has_next = S.next(ui + 1, nxt);
        const char* nA = has_next ? (const char*)g.A + (size_t)nxt.pm * tstepA : cA; const char* nB = has_next ? (const char*)g.Bt + (size_t)nxt.pn * tstepB : cB;
        for (int t = 0; t < nt; t += 2) {
            const bool last = (t == nt - 2);
            const char* a1 = cA + (size_t)(t + 1) * kstep;
            const char* a2 = last ? nA : cA + (size_t)(t + 2) * kstep; const char* b2 = last ? nB : cB + (size_t)(t + 2) * kstep;
            const char* a3 = a2 + kstep; const char* b3 = b2 + kstep;
            if (last && has_next) S.a_ready(nxt);
            if constexpr (SP2) {
            PG8_LDB(B0, 0, 0); PG8_LDB(B1, 0, 1); PG8_SCHED; PG8_LDA(At, 0, 0); PG8_STAGE(PG8_SA(1, 1), a1 + hstepA, voffA);
            PG8_WAIT_V(8); PG8_WAIT_L(0); PG8_BAR; PG8_MMA(0, 0, At, B0); PG8_MMA(0, 1, At, B1); PG8_BAR; PG8_SCHED;
            PG8_LDA(At, 0, 1); PG8_STAGE(PG8_SB(0, 0), b2, voffB); PG8_STAGE(PG8_SB(0, 1), b2 + hstepB, voffB); PG8_STAGE(PG8_SA(0, 0), a2, voffA);
            PG8_WAIT_V(8); PG8_WAIT_L(0); PG8_BAR; PG8_MMA(1, 0, At, B0); PG8_MMA(1, 1, At, B1); PG8_BAR; PG8_SCHED;
            PG8_LDB(B0, 1, 0); PG8_LDB(B1, 1, 1); PG8_SCHED; PG8_LDA(At, 1, 0); PG8_STAGE(PG8_SA(0, 1), a2 + hstepA, voffA);
            PG8_WAIT_V(8); PG8_WAIT_L(0); PG8_BAR; PG8_MMA(0, 0, At, B0); PG8_MMA(0, 1, At, B1); PG8_BAR; PG8_SCHED;
            PG8_LDA(At, 1, 1); PG8_STAGE(PG8_SB(1, 0), b3, voffB); PG8_STAGE(PG8_SB(1, 1), b3 + hstepB, voffB); PG8_STAGE(PG8_SA(1, 0), a3, voffA);
            PG8_WAIT_V(8); PG8_WAIT_L(0); PG8_BAR; PG8_MMA(1, 0, At, B0); PG8_MMA(1, 1, At, B1); PG8_BAR; PG8_SCHED;
            } else {
            PG8_LDB(B0, 0, 0); PG8_SCHED; PG8_LDA(At, 0, 0); PG8_STAGE(PG8_SA(1, 1), a1 + hstepA, voffA);
            PG8_WAIT_L(8); PG8_BAR; PG8_WAIT_L(0); PG8_MMA(0, 0, At, B0); PG8_BAR; PG8_SCHED;
            PG8_LDB(B1, 0, 1); PG8_STAGE(PG8_SB(0, 0), b2, voffB);
            PG8_BAR; PG8_WAIT_L(0); PG8_MMA(0, 1, At, B1); PG8_BAR;
            PG8_LDA(At, 0, 1); PG8_STAGE(PG8_SA(0, 0), a2, voffA);
            PG8_BAR; PG8_WAIT_L(0); PG8_MMA(1, 0, At, B0); PG8_BAR; PG8_SCHED;
            PG8_STAGE(PG8_SB(0, 1), b2 + hstepB, voffB);
            PG8_WAIT_V(6); PG8_BAR; PG8_MMA(1, 1, At, B1); PG8_BAR;
            PG8_LDB(B0, 1, 0); PG8_SCHED; PG8_LDA(At, 1, 0); PG8_STAGE(PG8_SA(0, 1), a2 + hstepA, voffA);
            PG8_WAIT_L(8); PG8_BAR; PG8_WAIT_L(0); PG8_MMA(0, 0, At, B0); PG8_BAR; PG8_SCHED;
            PG8_LDB(B1, 1, 1); PG8_STAGE(PG8_SB(1, 0), b3, voffB);
            PG8_BAR; PG8_WAIT_L(0); PG8_MMA(0, 1, At, B1); PG8_BAR;
            PG8_LDA(At, 1, 1); PG8_STAGE(PG8_SA(1, 0), a3, voffA);
            PG8_BAR; PG8_WAIT_L(0); PG8_MMA(1, 0, At, B0); PG8_BAR; PG8_SCHED;
            PG8_STAGE(PG8_SB(1, 1), b3 + hstepB, voffB);
            PG8_WAIT_V(6); PG8_BAR; PG8_MMA(1, 1, At, B1); PG8_BAR;
            }
        }
        if constexpr (ALIGN_EPI) { if (wr == 0) PG8_BAR; }
        if constexpr (!Epi::AFTER_DRAIN) { E(acc, cur, wr, wc, fr, fq); S.done(cur); }
        if (!has_next) break;
#pragma unroll
        for (int a = 0; a < 2; ++a)
#pragma unroll
            for (int b = 0; b < 2; ++b)
#pragma unroll
                for (int m = 0; m < 4; ++m)
#pragma unroll
                    for (int n = 0; n < 2; ++n) acc[a][b][m][n] = (f32x4){0.f, 0.f, 0.f, 0.f};
        cur = nxt; cA = nA; cB = nB; ++ui;
        if constexpr (ALIGN_EPI) { if (wr == 1) PG8_BAR; }
    }
    PG8_WAIT_V(0);
    if constexpr (!ALIGN_EPI) { if (wr == 0) PG8_BAR; }
    PG8_BAR;
    if constexpr (Epi::AFTER_DRAIN) { E.fused(acc, cur, wr, wc, fr, fq, lds, wid, lane); S.done(cur); }
#undef PG8_SA
#undef PG8_SB
#undef PG8_STAGE
#undef PG8_LDA
#undef PG8_LDB
#undef PG8_MMA
#undef PG8_WAIT_V
#undef PG8_WAIT_L
#undef PG8_BAR
#undef PG8_SCHED
}
}

#define DEV __device__ __forceinline__
#define LAS __attribute__((address_space(3)))
typedef unsigned short bf16_t;
typedef short bf16x8 __attribute__((ext_vector_type(8)));
typedef float f32x4 __attribute__((ext_vector_type(4)));
typedef float f32x2 __attribute__((ext_vector_type(2)));
typedef float f32x16 __attribute__((ext_vector_type(16)));
typedef unsigned u32x4 __attribute__((ext_vector_type(4)));
typedef unsigned u32x2 __attribute__((ext_vector_type(2)));

constexpr int R = 16896, RB = 8448, NCTX = 256, TL = 8192, DM = 1024, INW = 1696, DFF = 2816, HFF = 1408;
constexpr int NWG_T = 512;
constexpr float EPS = 1e-6f;
constexpr int LDS_BYTES = 147456;
constexpr size_t OFF_X = 0, OFF_HN = 69206016, OFF_W = 103809024, OFF_MOD = 152174592, OFF_ROPE = 152436736, OFF_OV = 153485312;
constexpr size_t OV_Q = 0, OV_KN = 25952256, OV_VT = 43253760, OV_SLOC = 60555264, OV_SIN = 69206016, OV_U = 0;
constexpr size_t OFF_PART = 250100224;
constexpr size_t OFF_EDGE = 258488832;
constexpr size_t WS_NEED = OFF_EDGE + 5947392;
constexpr size_t W_IN = 0, W_UQ = 1835008, W_KN = 2129920, W_V = 2260992, W_OUT = 2392064, W_UP = 3440640, W_DN = 9207808, W_LAYER = 12091392;

struct Params {
    const float *x, *c, *ctx, *c_ctx, *w_mod, *b_mod, *norm1_g, *w_in, *ret_decay_f, *ret_decay_b, *mla_q_norm_g, *w_uq, *mla_kv_norm_g, *w_ukv,
        *pool_w, *pool_scale, *w_out, *norm2_g, *w_up, *conv_w, *conv_b, *w_down, *final_norm_g;
    float* out; unsigned char* ws; int ph_lo, ph_hi;
};

DEV int otid() { int t = threadIdx.x; asm volatile("" : "+v"(t)); return t; }
DEV float bf2f(unsigned short x) { return __uint_as_float((unsigned)x << 16); }
DEV unsigned f2bf(float f) { unsigned u = __float_as_uint(f); return (u + 0x7fffu + ((u >> 16) & 1u)) >> 16; }
DEV unsigned pk2(float lo, float hi) { return f2bf(lo) | (f2bf(hi) << 16); }
DEV float wave_sum(float v) {
#pragma unroll
    for (int o = 1; o < 64; o <<= 1) v += __shfl_xor(v, o);
    return v;
}
DEV float siluf(float x) { return x * __builtin_amdgcn_rcpf(1.0f + __builtin_amdgcn_exp2f(-1.4426950408889634f * x)); }
DEV int crow(int r, int hi) { return (r & 3) + 8 * (r >> 2) + 4 * hi; }
DEV bf16x8 pack8(float a0, float a1, float a2, float a3, float a4, float a5, float a6, float a7) {
    u32x4 w; w.x = pg8::cvt_pk_bf16(a0, a1); w.y = pg8::cvt_pk_bf16(a2, a3); w.z = pg8::cvt_pk_bf16(a4, a5); w.w = pg8::cvt_pk_bf16(a6, a7);
    return __builtin_bit_cast(bf16x8, w);
}
DEV int row_mi(int r) { const int b = r / RB; const int s = r - b * RB; return s < NCTX ? 2 : b; }

DEV void transpose_item(const float* W, int K, int Nsrc, bf16_t* WT, int n0, int cs, int k0, float* scr, int lane) {
#pragma unroll
    for (int i = 0; i < 32; ++i) { const int kk = 2 * i + (lane >> 5); scr[kk * 33 + (lane & 31)] = cs >= 0 ? W[(size_t)(k0 + kk) * Nsrc + cs + (lane & 31)] : 0.f; }
    asm volatile("s_waitcnt lgkmcnt(0)" ::: "memory");
    const int c = lane & 7;
#pragma unroll
    for (int j = 0; j < 4; ++j) { const int n = (lane >> 3) + 8 * j; const float* s = scr + (8 * c) * 33 + n;
        u32x4 o; o.x = pk2(s[0 * 33], s[1 * 33]); o.y = pk2(s[2 * 33], s[3 * 33]); o.z = pk2(s[4 * 33], s[5 * 33]); o.w = pk2(s[6 * 33], s[7 * 33]);
        *(u32x4*)(WT + (size_t)(n0 + n) * K + k0 + 8 * c) = o; }
    asm volatile("s_waitcnt lgkmcnt(0)" ::: "memory");
}
DEV int map_in(int n0) { return n0 < 1440 ? n0 : (n0 < INW ? -2 : -1); }
DEV int map_kn(int n0) { return (n0 >> 6) * 128 + (n0 & 63); }
DEV int map_v(int n0) { return (n0 >> 6) * 128 + 64 + (n0 & 63); }
DEV int map_up(int n0) { const int pn = n0 >> 8, w = n0 & 255; return w < 128 ? 128 * pn + w : DFF + 128 * pn + (w - 128); }

DEV void phase_prep(const Params& p, unsigned char* lds) {
    const int tid = otid(), lane = tid & 63, wid = tid >> 6;
    unsigned char* ws = p.ws;
    { f32x2* rope = (f32x2*)(ws + OFF_ROPE);
      for (int idx = blockIdx.x * NWG_T + tid; idx < TL * 16; idx += gridDim.x * NWG_T) { const int t = idx >> 4, i = idx & 15; const int pos = i < 8 ? (t >> 6) : (t & 63);
          const float inv = exp2f(-(float)(i & 7) * 0.125f * 13.287712379549449f); const float ang = (float)pos * inv; f32x2 cs; cs.x = __cosf(ang); cs.y = __sinf(ang); rope[idx] = cs; } }
    { float* scv = (float*)lds;
      float* red = scv + 3 * 1024;
      for (int i = tid; i < 3 * 1024; i += NWG_T) { const int v = i >> 10, k = i & 1023; const float cv = v < 2 ? p.c[v * 1024 + k] : p.c_ctx[k]; scv[i] = siluf(cv); }
      __syncthreads();
      float* modv = (float*)(ws + OFF_MOD);
      for (int it = blockIdx.x; it < 192; it += gridDim.x) { const int l = it / 96, col0 = (it % 96) * 64;
          const float* wm = p.w_mod + (size_t)l * 1024 * 6144 + col0 + lane; float a0 = 0.f, a1 = 0.f, a2 = 0.f;
#pragma unroll 16
          for (int k = wid * 128; k < wid * 128 + 128; ++k) { const float w = wm[(size_t)k * 6144]; a0 += scv[k] * w; a1 += scv[1024 + k] * w; a2 += scv[2048 + k] * w; }
          red[(wid * 3 + 0) * 64 + lane] = a0; red[(wid * 3 + 1) * 64 + lane] = a1; red[(wid * 3 + 2) * 64 + lane] = a2;
          __syncthreads();
          if (tid < 192) { const int v = tid >> 6, cl = tid & 63; float s = 0.f;
#pragma unroll
              for (int w = 0; w < 8; ++w) s += red[(w * 3 + v) * 64 + cl];
              modv[((size_t)l * 3 + v) * 6144 + col0 + cl] = s + p.b_mod[l * 6144 + col0 + cl]; }
          __syncthreads(); }
    }
}
DEV void phase_prep_weights(const Params& p, unsigned char* lds) {
    const int tid = otid(), lane = tid & 63, wid = tid >> 6;
    unsigned char* ws = p.ws;
    { float* scr = (float*)(lds + 32768 + wid * 8704);
      const int gw = blockIdx.x * 8 + wid, NGW = gridDim.x * 8;
      constexpr int I_IN = 16 * 56, I_UQ = 6 * 24, I_KN = 4 * 16, I_V = 4 * 16, I_OUT = 16 * 32, I_UP = 16 * 176, I_DN = 44 * 32, I_L = I_IN + I_UQ + I_KN + I_V + I_OUT + I_UP + I_DN;
      for (int it = gw; it < 2 * I_L; it += NGW) { const int l = it / I_L; int r = it - l * I_L; bf16_t* wl = (bf16_t*)(ws + OFF_W) + (size_t)l * W_LAYER;
          const float* src; int K, Nsrc, nbn, mp; size_t doff;
          if (r < I_IN) { src = p.w_in + (size_t)l * 1024 * INW; K = 1024; Nsrc = INW; nbn = 56; mp = 1; doff = W_IN; }
          else if ((r -= I_IN) < I_UQ) { src = p.w_uq + (size_t)l * 384 * 768; K = 384; Nsrc = 768; nbn = 24; mp = 0; doff = W_UQ; }
          else if ((r -= I_UQ) < I_KN) { src = p.w_ukv + (size_t)l * 256 * 1024; K = 256; Nsrc = 1024; nbn = 16; mp = 2; doff = W_KN; }
          else if ((r -= I_KN) < I_V) { src = p.w_ukv + (size_t)l * 256 * 1024; K = 256; Nsrc = 1024; nbn = 16; mp = 3; doff = W_V; }
          else if ((r -= I_V) < I_OUT) { src = p.w_out + (size_t)l * 1024 * 1024; K = 1024; Nsrc = 1024; nbn = 32; mp = 0; doff = W_OUT; }
          else if ((r -= I_OUT) < I_UP) { src = p.w_up + (size_t)l * 1024 * 5632; K = 1024; Nsrc = 5632; nbn = 176; mp = 4; doff = W_UP; }
          else { r -= I_UP; src = p.w_down + (size_t)l * DFF * 1024; K = DFF; Nsrc = 1024; nbn = 32; mp = 0; doff = W_DN; }
          const int kb = r / nbn, nb = r - kb * nbn, n0 = nb * 32;
          const int cs = mp == 0 ? n0 : mp == 1 ? map_in(n0) : mp == 2 ? map_kn(n0) : mp == 3 ? map_v(n0) : map_up(n0);
          if (cs != -2) transpose_item(src, K, Nsrc, wl + doff, n0, cs, kb * 64, scr, lane); }
    }
    { for (int idx = blockIdx.x * NWG_T + tid; idx < 2 * 1024 * 256; idx += gridDim.x * NWG_T) { const int n = idx & 255, k = (idx >> 8) & 1023, l = idx >> 18; const int g = n >> 6, d = n & 63;
          const float* wr = p.w_in + ((size_t)l * 1024 + k) * INW + 1440 + g * 64; const float* pw = p.pool_w + ((size_t)(l * 4 + g) * 64) * 64 + d; float s = 0.f;
#pragma unroll 8
          for (int c = 0; c < 64; ++c) s += wr[c] * pw[c * 64];
          ((bf16_t*)(ws + OFF_W) + (size_t)l * W_LAYER + W_IN)[(size_t)(1440 + n) * 1024 + k] = (bf16_t)f2bf(s * p.pool_scale[l * 256 + n]); } }
}

DEV void phase_norm(const Params& p, int l, int which, bool first, const float* pgate) {
    const int tid = otid(); const int lane = tid & 63, wid = tid >> 6; const int gw = blockIdx.x * 8 + wid, NGW = gridDim.x * 8;
    float* X = (float*)(p.ws + OFF_X); bf16_t* HN = (bf16_t*)(p.ws + OFF_HN);
    const float* modv = (const float*)(p.ws + OFF_MOD) + (size_t)l * 3 * 6144;
    const float* g = (which == 0 ? p.norm1_g : p.norm2_g) + l * 1024;
    for (int r = gw; r < R; r += NGW) {
        const int b = r / RB, s = r - b * RB; const int mi = s < NCTX ? 2 : b;
        const float* src = first ? (s < NCTX ? p.ctx + ((size_t)b * NCTX + s) * 1024 : p.x + ((size_t)b * TL + (s - NCTX)) * 1024) : X + (size_t)r * 1024;
        const f32x4* xr = (const f32x4*)src + lane; f32x4 v[4]; float ss = 0.f;
#pragma unroll
        for (int j = 0; j < 4; ++j) { v[j] = xr[64 * j]; ss += (v[j].x * v[j].x + v[j].y * v[j].y) + (v[j].z * v[j].z + v[j].w * v[j].w); }
        if (pgate != nullptr && s < NCTX) { const float* PART = (const float*)(p.ws + OFF_PART) + (size_t)(b * NCTX + s) * 1024; ss = 0.f;
#pragma unroll
            for (int j = 0; j < 4; ++j) { const f32x4 gq = ((const f32x4*)pgate)[lane + 64 * j]; f32x4 a = ((const f32x4*)PART)[lane + 64 * j];
#pragma unroll
                for (int q = 1; q < 4; ++q) a = a + ((const f32x4*)(PART + (size_t)q * 524288))[lane + 64 * j];
                v[j] = v[j] + gq * a; ss += (v[j].x * v[j].x + v[j].y * v[j].y) + (v[j].z * v[j].z + v[j].w * v[j].w); } }
        if (first || (pgate != nullptr && s < NCTX)) { f32x4* xo = (f32x4*)(X + (size_t)r * 1024) + lane;
#pragma unroll
            for (int j = 0; j < 4; ++j) xo[64 * j] = v[j]; }
        const float rs = rsqrtf(wave_sum(ss) * (1.f / 1024.f) + EPS);
        const float* mv = modv + mi * 6144 + (which == 0 ? 0 : 3072);
        u32x2* o8 = (u32x2*)(HN + (size_t)r * 1024) + lane;
#pragma unroll
        for (int j = 0; j < 4; ++j) { const f32x4 gg = ((const f32x4*)g)[lane + 64 * j], sh = ((const f32x4*)mv)[lane + 64 * j], sc = ((const f32x4*)(mv + 1024))[lane + 64 * j];
            const f32x4 y = v[j] * rs * gg; const f32x4 h = y * (sc + 1.0f) + sh; u32x2 w; w.x = pk2(h.x, h.y); w.y = pk2(h.z, h.w); o8[64 * j] = w; }
    }
}
DEV void phase_final(const Params& p) {
    const int tid = otid(); const int lane = tid & 63, wid = tid >> 6; const int gw = blockIdx.x * 8 + wid, NGW = gridDim.x * 8;
    const float* X = (const float*)(p.ws + OFF_X);
    for (int q = gw; q < 2 * TL; q += NGW) { const int b = q / TL, t = q - b * TL; const int r = b * RB + NCTX + t;
        const f32x4* xr = (const f32x4*)(X + (size_t)r * 1024) + lane; f32x4 v[4]; float ss = 0.f;
#pragma unroll
        for (int j = 0; j < 4; ++j) { v[j] = xr[64 * j]; ss += (v[j].x * v[j].x + v[j].y * v[j].y) + (v[j].z * v[j].z + v[j].w * v[j].w); }
        const float rs = rsqrtf(wave_sum(ss) * (1.f / 1024.f) + EPS);
        f32x4* o = (f32x4*)(p.out + (size_t)q * 1024) + lane;
#pragma unroll
        for (int j = 0; j < 4; ++j) { const f32x4 gg = ((const f32x4*)p.final_norm_g)[lane + 64 * j]; o[64 * j] = v[j] * rs * gg; } }
}

DEV void phase_rowwise(const Params& p, int l) {
    const int tid = otid(); const int lane = tid & 63, wid = tid >> 6; const int gw = blockIdx.x * 8 + wid, NGW = gridDim.x * 8;
    bf16_t* P = (bf16_t*)p.out; const f32x2* rope = (const f32x2*)(p.ws + OFF_ROPE);
    const float* qg = p.mla_q_norm_g + l * 384; const float* kg = p.mla_kv_norm_g + l * 256;
    float qgv[6];
#pragma unroll
    for (int j = 0; j < 3; ++j) { qgv[2 * j] = qg[2 * (lane + 64 * j)]; qgv[2 * j + 1] = qg[2 * (lane + 64 * j) + 1]; }
    const f32x4 kgv = ((const f32x4*)kg)[lane];
    for (int r0 = gw; r0 < R; r0 += 2 * NGW) {
        unsigned wq[2][3]; u32x2 wk[2]; float x1[2], x2[2]; f32x2 cs[2]; bool val[2], lat[2];
#pragma unroll
        for (int i = 0; i < 2; ++i) { const int r = r0 + i * NGW; val[i] = r < R; const int rr = val[i] ? r : r0; bf16_t* pr = P + (size_t)rr * INW; const int s = rr % RB; lat[i] = s >= NCTX;
            const unsigned* q2 = (const unsigned*)(pr + 768) + lane;
#pragma unroll
            for (int j = 0; j < 3; ++j) wq[i][j] = q2[64 * j];
            wk[i] = *((const u32x2*)(pr + 1152) + lane);
            const int li = lane & 15; x1[i] = bf2f(pr[1408 + li]); x2[i] = bf2f(pr[1408 + 16 + li]); cs[i] = rope[(lat[i] ? s - NCTX : 0) * 16 + li]; }
#pragma unroll
        for (int i = 0; i < 2; ++i) { if (!val[i]) continue; const int r = r0 + i * NGW; bf16_t* pr = P + (size_t)r * INW;
            { float ss = 0.f;
#pragma unroll
              for (int j = 0; j < 3; ++j) { const float a = bf2f(wq[i][j] & 0xffff), c2 = bf2f(wq[i][j] >> 16); ss += a * a + c2 * c2; }
              const float rs = rsqrtf(wave_sum(ss) * (1.f / 384.f) + EPS); unsigned* q2 = (unsigned*)(pr + 768) + lane;
#pragma unroll
              for (int j = 0; j < 3; ++j) q2[64 * j] = pk2(bf2f(wq[i][j] & 0xffff) * rs * qgv[2 * j], bf2f(wq[i][j] >> 16) * rs * qgv[2 * j + 1]); }
            { const float a0 = bf2f(wk[i].x & 0xffff), a1 = bf2f(wk[i].x >> 16), a2 = bf2f(wk[i].y & 0xffff), a3 = bf2f(wk[i].y >> 16);
              const float rs = rsqrtf(wave_sum((a0 * a0 + a1 * a1) + (a2 * a2 + a3 * a3)) * (1.f / 256.f) + EPS);
              u32x2 o; o.x = pk2(a0 * rs * kgv.x, a1 * rs * kgv.y); o.y = pk2(a2 * rs * kgv.z, a3 * rs * kgv.w); *((u32x2*)(pr + 1152) + lane) = o; }
            if (lat[i] && lane < 16) { pr[1408 + lane] = (bf16_t)f2bf(x1[i] * cs[i].x - x2[i] * cs[i].y); pr[1408 + 16 + lane] = (bf16_t)f2bf(x2[i] * cs[i].x + x1[i] * cs[i].y); } }
    }
}

DEV void phase_pool(const Params& p) {
    const int tid = otid(); const bf16_t* P = (const bf16_t*)p.out; bf16_t* MIX = (bf16_t*)(p.ws + OFF_HN);
    for (int idx = blockIdx.x * NWG_T + tid; idx < R * 32; idx += gridDim.x * NWG_T) { const int r = idx >> 5, cg = idx & 31; const int half = 1 << (cg >> 3);
        const int b = r / RB, s = r - b * RB; const int seq0 = s < NCTX ? b * RB : b * RB + NCTX; const int T = s < NCTX ? NCTX : TL; const int t = r - seq0;
        const int lo = max(t - half, 0), hi = min(t + half, T); float sum[8];
#pragma unroll
        for (int j = 0; j < 8; ++j) sum[j] = 0.f;
        const bf16_t* base = P + (size_t)seq0 * INW + 1440 + cg * 8;
        { bf16x8 wv[16]; const bf16x8 zz = {0, 0, 0, 0, 0, 0, 0, 0};
#pragma unroll
          for (int k = 0; k < 16; ++k) { const int tt = t - 8 + k; wv[k] = (tt >= lo && tt < hi) ? *(const bf16x8*)(base + (size_t)tt * INW) : zz; }
#pragma unroll
          for (int k = 0; k < 16; ++k)
#pragma unroll
              for (int j = 0; j < 8; ++j) sum[j] += bf2f((unsigned short)wv[k][j]); }
        const bf16x8 me = *(const bf16x8*)(base + (size_t)t * INW); const float ic = 1.0f / (float)(hi - lo); float o[8];
#pragma unroll
        for (int j = 0; j < 8; ++j) o[j] = sum[j] * ic - bf2f((unsigned short)me[j]);
        *(bf16x8*)(MIX + (size_t)r * 1024 + 768 + cg * 8) = pack8(o[0], o[1], o[2], o[3], o[4], o[5], o[6], o[7]); }
}

DEV float log2_sigmoid(float d) { return -log1pf(__expf(-d)) * 1.4426950408889634f; }
constexpr int ST_P = 272;
DEV void states_item(const Params& p, int l, unsigned char* lds, int it) {
    const int tid = otid(), lane = tid & 63, wid = tid >> 6, l32 = lane & 31, hi = lane >> 5;
    const bf16_t* P = (const bf16_t*)p.out; const f32x2* rope = (const f32x2*)(p.ws + OFF_ROPE);
    float* SLOC = (float*)(p.ws + OFF_OV + OV_SLOC);
    const int gc = it >> 1, hp = it & 1;
    unsigned char* VTl = lds;
    unsigned char* KTl = lds + 2 * 64 * ST_P;
    const int cb = gc % 66; const bool lat = cb >= 2; const int t0 = (cb - 2) * 128; const int r0 = gc * 128;
    __syncthreads();
    { const int tok = tid >> 2, hh = (tid >> 1) & 1, c = tid & 1; const int h = 2 * hp + hh;
      const bf16_t* src = P + (size_t)(r0 + tok) * INW + 128 + h * 32 + 8 * c; const bf16x8 lo = *(const bf16x8*)src, hi8 = *(const bf16x8*)(src + 16);
      const float df = exp2f(log2_sigmoid(p.ret_decay_f[l * 4 + h]) * (float)(127 - tok)) * 0.17677669529663687f, db = exp2f(log2_sigmoid(p.ret_decay_b[l * 4 + h]) * (float)tok) * 0.17677669529663687f;
#pragma unroll
      for (int j = 0; j < 8; ++j) { float x1 = bf2f((unsigned short)lo[j]), x2 = bf2f((unsigned short)hi8[j]);
          if (lat) { const f32x2 cs = rope[(t0 + tok) * 16 + 8 * c + j]; const float y1 = x1 * cs.x - x2 * cs.y, y2 = x2 * cs.x + x1 * cs.y; x1 = y1; x2 = y2; }
          bf16_t* kf = (bf16_t*)(KTl + ((hh * 2 + 0) * 32 + 8 * c + j) * ST_P) + tok; bf16_t* kb = (bf16_t*)(KTl + ((hh * 2 + 1) * 32 + 8 * c + j) * ST_P) + tok;
          kf[0] = (bf16_t)f2bf(x1 * df); kb[0] = (bf16_t)f2bf(x1 * db);
          *(bf16_t*)((unsigned char*)kf + 16 * ST_P) = (bf16_t)f2bf(x2 * df); *(bf16_t*)((unsigned char*)kb + 16 * ST_P) = (bf16_t)f2bf(x2 * db); } }
    for (int task = tid; task < 2048; task += NWG_T) { const int hh = task >> 10, tok = (task >> 3) & 127, ch = task & 7;
        const bf16x8 v = *(const bf16x8*)(P + (size_t)(r0 + tok) * INW + 256 + (2 * hp + hh) * 64 + ch * 8);
#pragma unroll
        for (int j = 0; j < 8; ++j) *((bf16_t*)(VTl + (hh * 64 + ch * 8 + j) * ST_P) + tok) = (bf16_t)v[j]; }
    __syncthreads();
    { const int hh = wid >> 2, dir = (wid >> 1) & 1, dvb = wid & 1; const int h = 2 * hp + hh;
      const unsigned char* ap = VTl + (hh * 64 + 32 * dvb + l32) * ST_P + hi * 16; const unsigned char* bp = KTl + ((hh * 2 + dir) * 32 + l32) * ST_P + hi * 16;
      bf16x8 af[8], bfr[8];
#pragma unroll
      for (int ks = 0; ks < 8; ++ks) { af[ks] = *(const bf16x8*)(ap + ks * 32); bfr[ks] = *(const bf16x8*)(bp + ks * 32); }
      f32x16 acc;
#pragma unroll
      for (int r = 0; r < 16; ++r) acc[r] = 0.f;
#pragma unroll
      for (int ks = 0; ks < 8; ++ks) acc = __builtin_amdgcn_mfma_f32_32x32x16_bf16(af[ks], bfr[ks], acc, 0, 0, 0);
      float* o = SLOC + ((size_t)(gc * 4 + h) * 2 + dir) * 2048 + l32 * 64 + 32 * dvb + 4 * hi;
#pragma unroll
      for (int g4 = 0; g4 < 4; ++g4) *(f32x4*)(o + 8 * g4) = (f32x4){acc[4 * g4], acc[4 * g4 + 1], acc[4 * g4 + 2], acc[4 * g4 + 3]}; }
}
DEV void scan_threads(const Params& p, int l, int gid) {
    if (gid >= 32768) return;
    const int e = gid & 2047, dir = (gid >> 11) & 1, h = (gid >> 12) & 3, b = gid >> 14;
    const float* SLOC = (const float*)(p.ws + OFF_OV + OV_SLOC); float* SIN = (float*)(p.ws + OFF_OV + OV_SIN);
    const float gC = exp2f(log2_sigmoid((dir == 0 ? p.ret_decay_f : p.ret_decay_b)[l * 4 + h]) * 128.f);
    float S = 0.f;
#pragma unroll 11
    for (int st = 0; st < 66; ++st) { const int cb = dir == 0 ? st : (st < 2 ? 1 - st : 67 - st); const size_t idx = ((size_t)((b * 66 + cb) * 4 + h) * 2 + dir) * 2048 + e;
        const float v = SLOC[idx]; SIN[idx] = S; S = S * gC + v; }
}

constexpr int AT_KP = 208, AT_VP = 144, AT_KB = 64 * AT_KP, AT_VBS = 64 * AT_VP, AT_V0 = 4 * AT_KB;
DEV float at_max32(const f32x16& s0, const f32x16& s1) {
    float m0 = __builtin_fmaxf(__builtin_fmaxf(s0[0], s0[1]), s0[2]), m1 = __builtin_fmaxf(__builtin_fmaxf(s1[0], s1[1]), s1[2]);
    m0 = __builtin_fmaxf(__builtin_fmaxf(m0, s0[3]), s0[4]); m1 = __builtin_fmaxf(__builtin_fmaxf(m1, s1[3]), s1[4]);
    m0 = __builtin_fmaxf(__builtin_fmaxf(m0, s0[5]), s0[6]); m1 = __builtin_fmaxf(__builtin_fmaxf(m1, s1[5]), s1[6]);
    m0 = __builtin_fmaxf(__builtin_fmaxf(m0, s0[7]), s0[8]); m1 = __builtin_fmaxf(__builtin_fmaxf(m1, s1[7]), s1[8]);
    m0 = __builtin_fmaxf(__builtin_fmaxf(m0, s0[9]), s0[10]); m1 = __builtin_fmaxf(__builtin_fmaxf(m1, s1[9]), s1[10]);
    m0 = __builtin_fmaxf(__builtin_fmaxf(m0, s0[11]), s0[12]); m1 = __builtin_fmaxf(__builtin_fmaxf(m1, s1[11]), s1[12]);
    m0 = __builtin_fmaxf(__builtin_fmaxf(m0, s0[13]), s0[14]); m1 = __builtin_fmaxf(__builtin_fmaxf(m1, s1[13]), s1[14]);
    return __builtin_fmaxf(__builtin_fmaxf(m0, s0[15]), __builtin_fmaxf(m1, s1[15]));
}
DEV void attn_unit(const Params& p, unsigned char* lds, int u) {
    const int tid = otid(), lane = tid & 63, wid = tid >> 6, l32 = lane & 31, hi = lane >> 5;
    const bf16_t* Q = (const bf16_t*)(p.ws + OFF_OV + OV_Q); const bf16_t* KN = (const bf16_t*)(p.ws + OFF_OV + OV_KN); const bf16_t* VT = (const bf16_t*)(p.ws + OFF_OV + OV_VT);
    const bf16_t* P = (const bf16_t*)p.out; bf16_t* MIX = (bf16_t*)(p.ws + OFF_HN); const f32x2* rope = (const f32x2*)(p.ws + OFF_ROPE);
    const bool isctx = u >= 512; int b, h, qrow0, NT;
    if (!isctx) { b = u >> 8; h = (u >> 5) & 7; qrow0 = b * RB + NCTX + (u & 31) * 256; NT = 132; } else { const int v = u - 512; b = v >> 3; h = v & 7; qrow0 = b * RB; NT = 4; }
    const int krow0 = b * RB; const int qrow = qrow0 + wid * 32 + l32;
    bf16x8 qf[6];
    { const bf16_t* qp = Q + (size_t)qrow * 768 + h * 96 + hi * 8;
#pragma unroll
      for (int d0 = 0; d0 < 6; ++d0) qf[d0] = *(const bf16x8*)(qp + d0 * 16);
      if (!isctx) { const f32x2* rp = rope + (size_t)(qrow - (b * RB + NCTX)) * 16 + hi * 8;
#pragma unroll
          for (int j = 0; j < 8; ++j) { const f32x2 cs = rp[j]; const float x1 = bf2f((unsigned short)qf[4][j]), x2 = bf2f((unsigned short)qf[5][j]);
              qf[4][j] = (short)f2bf(x1 * cs.x - x2 * cs.y); qf[5][j] = (short)f2bf(x2 * cs.x + x1 * cs.y); } } }
    const bf16_t* sp[3]; int sstep[3], lo[3];
#pragma unroll
    for (int k = 0; k < 2; ++k) { const int c = tid + k * 512; const int key = c / 12, part = c - key * 12; lo[k] = key * AT_KP + part * 16;
        if (part < 8) { sp[k] = KN + (size_t)(krow0 + key) * 512 + h * 64 + part * 8; sstep[k] = 64 * 512; } else { sp[k] = P + (size_t)(krow0 + key) * INW + 1408 + (part - 8) * 8; sstep[k] = 64 * INW; } }
    { const int dv = tid >> 3, kc = tid & 7; lo[2] = dv * AT_VP + (kc >> 1) * 32 + (kc & 1) * 8;   sp[2] = VT + (size_t)(h * 64 + dv) * R + krow0 + kc * 8; sstep[2] = 64; }
    const bool hasK2 = tid < 256;
    u32x4 st[3];
#define AT_GLOADK() do { st[0] = *(const u32x4*)sp[0]; sp[0] += sstep[0]; if (hasK2) { st[1] = *(const u32x4*)sp[1]; sp[1] += sstep[1]; } } while (0)
#define AT_GLOADV() do { st[2] = *(const u32x4*)sp[2]; sp[2] += sstep[2]; } while (0)
#define AT_LSTOREK(buf) do { *(u32x4*)((buf) + lo[0]) = st[0]; if (hasK2) *(u32x4*)((buf) + lo[1]) = st[1]; } while (0)
#define AT_LSTOREV(buf) do { unsigned char* d_ = (buf) + lo[2]; *(u32x2*)d_ = (u32x2){st[2].x, st[2].y}; *(u32x2*)(d_ + 16) = (u32x2){st[2].z, st[2].w}; } while (0)
#define AT_SB() __builtin_amdgcn_sched_barrier(0)
    f32x16 o0, o1, sa0, sa1, sb0, sb1, negm;
#pragma unroll
    for (int r = 0; r < 16; ++r) { o0[r] = 0.f; o1[r] = 0.f; sa0[r] = 0.f; sa1[r] = 0.f; negm[r] = 0.f; }
    float mrun = 0.f, lsum = 0.f;
    __syncthreads();
    AT_GLOADK(); AT_GLOADV(); AT_LSTOREK(lds); AT_LSTOREV(lds + AT_V0);
    AT_GLOADK(); AT_GLOADV(); AT_LSTOREK(lds + AT_KB); AT_LSTOREV(lds + AT_V0 + AT_VBS);
    AT_GLOADK(); AT_LSTOREK(lds + 2 * AT_KB);
    __syncthreads();
    { const unsigned char* ka = lds + l32 * AT_KP + hi * 16;
#pragma unroll
      for (int d0 = 0; d0 < 6; ++d0) { const bf16x8 a0 = *(const bf16x8*)(ka + d0 * 32), a1 = *(const bf16x8*)(ka + 32 * AT_KP + d0 * 32);
          sa0 = __builtin_amdgcn_mfma_f32_32x32x16_bf16(a0, qf[d0], sa0, 0, 0, 0); sa1 = __builtin_amdgcn_mfma_f32_32x32x16_bf16(a1, qf[d0], sa1, 0, 0, 0); } }
#define AT_STEP(SA0, SA1, SB0, SB1, tt) do { \
        const int t_ = (tt); const bool nxt_ = t_ + 1 < NT; \
        const unsigned char* kb_ = lds + ((t_ + 1) & 3) * AT_KB; const unsigned char* vb_ = lds + AT_V0 + (t_ & 3) * AT_VBS; \
        if (t_ + 3 < NT) AT_GLOADK(); \
        if (t_ + 2 < NT) AT_GLOADV(); \
        bf16x8 kfr[12]; bf16x8 vfr[8]; \
        { const unsigned char* ka = kb_ + l32 * AT_KP + hi * 16; \
          _Pragma("unroll") for (int d0 = 0; d0 < 6; ++d0) { kfr[2 * d0] = *(const bf16x8*)(ka + d0 * 32); kfr[2 * d0 + 1] = *(const bf16x8*)(ka + 32 * AT_KP + d0 * 32); } } \
        { const float mx = mxc; \
          if (t_ == 0 || __any(mx > 8.0f)) { \
              const float rm = fmaxf(mx, __shfl_xor(mx, 32)); const float delta = (t_ == 0) ? rm : fmaxf(rm, 0.f); const float alpha = (t_ == 0) ? 1.0f : __builtin_amdgcn_exp2f(-delta); \
              mrun += delta; \
              _Pragma("unroll") for (int r = 0; r < 16; ++r) { SA0[r] -= delta; SA1[r] -= delta; o0[r] *= alpha; o1[r] *= alpha; } \
              lsum *= alpha; { const float nm = -mrun; _Pragma("unroll") for (int r = 0; r < 16; ++r) negm[r] = nm; } } } \
        float ls0 = 0.f, ls1 = 0.f; \
        AT_SB(); __builtin_amdgcn_s_setprio(1); \
        _Pragma("unroll") for (int i = 0; i < 8; ++i) { \
            if (i == 0) SB0 = __builtin_amdgcn_mfma_f32_32x32x16_bf16(kfr[0], qf[0], negm, 0, 0, 0); else if (i == 1) SB1 = __builtin_amdgcn_mfma_f32_32x32x16_bf16(kfr[1], qf[0], negm, 0, 0, 0); \
            else if (i & 1) SB1 = __builtin_amdgcn_mfma_f32_32x32x16_bf16(kfr[i], qf[i >> 1], SB1, 0, 0, 0); else SB0 = __builtin_amdgcn_mfma_f32_32x32x16_bf16(kfr[i], qf[i >> 1], SB0, 0, 0, 0); \
            SA0[2 * i] = __builtin_amdgcn_exp2f(SA0[2 * i]); SA0[2 * i + 1] = __builtin_amdgcn_exp2f(SA0[2 * i + 1]); SA1[2 * i] = __builtin_amdgcn_exp2f(SA1[2 * i]); SA1[2 * i + 1] = __builtin_amdgcn_exp2f(SA1[2 * i + 1]); \
            ls0 += SA0[2 * i] + SA0[2 * i + 1]; ls1 += SA1[2 * i] + SA1[2 * i + 1]; \
            AT_SB(); } \
        { const unsigned char* va = vb_ + l32 * AT_VP + hi * 16; \
          _Pragma("unroll") for (int kj = 0; kj < 4; ++kj) { vfr[2 * kj] = *(const bf16x8*)(va + kj * 32); vfr[2 * kj + 1] = *(const bf16x8*)(va + 32 * AT_VP + kj * 32); } } \
        bf16x8 pb[4]; \
        _Pragma("unroll") for (int i = 8; i < 12; ++i) { const int kj = i - 8; const int jp = kj & 1; \
            if (i & 1) SB1 = __builtin_amdgcn_mfma_f32_32x32x16_bf16(kfr[i], qf[i >> 1], SB1, 0, 0, 0); else SB0 = __builtin_amdgcn_mfma_f32_32x32x16_bf16(kfr[i], qf[i >> 1], SB0, 0, 0, 0); \
            if (kj < 2) pb[kj] = pack8(SA0[8 * jp + 0], SA0[8 * jp + 1], SA0[8 * jp + 2], SA0[8 * jp + 3], SA0[8 * jp + 4], SA0[8 * jp + 5], SA0[8 * jp + 6], SA0[8 * jp + 7]); \
            else        pb[kj] = pack8(SA1[8 * jp + 0], SA1[8 * jp + 1], SA1[8 * jp + 2], SA1[8 * jp + 3], SA1[8 * jp + 4], SA1[8 * jp + 5], SA1[8 * jp + 6], SA1[8 * jp + 7]); \
            AT_SB(); } \
        lsum += ls0 + ls1; \
        float mq0 = SB0[0], mq1 = SB1[0]; \
        _Pragma("unroll") for (int kj = 0; kj < 4; ++kj) { \
            o0 = __builtin_amdgcn_mfma_f32_32x32x16_bf16(vfr[2 * kj], pb[kj], o0, 0, 0, 0); o1 = __builtin_amdgcn_mfma_f32_32x32x16_bf16(vfr[2 * kj + 1], pb[kj], o1, 0, 0, 0); \
            mq0 = __builtin_fmaxf(__builtin_fmaxf(mq0, SB0[4 * kj]), SB0[4 * kj + 1]); mq1 = __builtin_fmaxf(__builtin_fmaxf(mq1, SB1[4 * kj]), SB1[4 * kj + 1]); \
            mq0 = __builtin_fmaxf(__builtin_fmaxf(mq0, SB0[4 * kj + 2]), SB0[4 * kj + 3]); mq1 = __builtin_fmaxf(__builtin_fmaxf(mq1, SB1[4 * kj + 2]), SB1[4 * kj + 3]); \
            AT_SB(); } \
        __builtin_amdgcn_s_setprio(0); mxc = __builtin_fmaxf(mq0, mq1);            \
        if (t_ + 3 < NT) AT_LSTOREK(lds + ((t_ + 3) & 3) * AT_KB); \
        if (t_ + 2 < NT) AT_LSTOREV(lds + AT_V0 + ((t_ + 2) & 3) * AT_VBS); \
        if (t_ & 1) __syncthreads(); \
    } while (0)
    float mxc = at_max32(sa0, sa1);
    for (int t = 0; t < NT; t += 2) { AT_STEP(sa0, sa1, sb0, sb1, t); AT_STEP(sb0, sb1, sa0, sa1, t + 1); }
    lsum += __shfl_xor(lsum, 32);
    const float inv = 1.0f / lsum;
    bf16_t* op = MIX + (size_t)qrow * 1024 + 256 + h * 64 + 4 * hi;
#pragma unroll
    for (int g4 = 0; g4 < 4; ++g4) { u32x2 w0, w1; w0.x = pk2(o0[4 * g4] * inv, o0[4 * g4 + 1] * inv); w0.y = pk2(o0[4 * g4 + 2] * inv, o0[4 * g4 + 3] * inv);
        w1.x = pk2(o1[4 * g4] * inv, o1[4 * g4 + 1] * inv); w1.y = pk2(o1[4 * g4 + 2] * inv, o1[4 * g4 + 3] * inv);
        *(u32x2*)(op + 8 * g4) = w0; *(u32x2*)(op + 32 + 8 * g4) = w1; }
#undef AT_GLOADK
#undef AT_GLOADV
#undef AT_LSTOREK
#undef AT_LSTOREV
#undef AT_STEP
#undef AT_SB
}

constexpr int RT_VP = 264, RT_SP = 144, RT_VB = 2 * 64 * RT_VP;
DEV void retout_unit(const Params& p, int l, unsigned char* lds, int u) {
    const int tid = otid(), lane = tid & 63, wid = tid >> 6, l32 = lane & 31, hi = lane >> 5;
    const int gc = u >> 1, hp = u & 1; const int cb = gc % 66; const bool lat = cb >= 2; const int t0 = (cb - 2) * 128; const int r0 = gc * 128;
    const bf16_t* P = (const bf16_t*)p.out; bf16_t* MIX = (bf16_t*)(p.ws + OFF_HN); const f32x2* rope = (const f32x2*)(p.ws + OFF_ROPE);
    const float* SIN = (const float*)(p.ws + OFF_OV + OV_SIN);
    bf16_t* VTl = (bf16_t*)lds; bf16_t* STl = (bf16_t*)(lds + RT_VB);
    __syncthreads();
    for (int task = tid; task < 2048; task += NWG_T) { const int hh = task >> 10, key = (task >> 3) & 127, ch = task & 7;
        const bf16x8 v = *(const bf16x8*)(P + (size_t)(r0 + key) * INW + 256 + (2 * hp + hh) * 64 + ch * 8);
#pragma unroll
        for (int j = 0; j < 8; ++j) VTl[(hh * 64 + ch * 8 + j) * (RT_VP / 2) + key] = (bf16_t)v[j]; }
    for (int task = tid; task < 8192; task += NWG_T) { const int dv = task & 63, k = (task >> 6) & 31, dir = (task >> 11) & 1, hh = task >> 12;
        STl[(hh * 64 + dv) * (RT_SP / 2) + dir * 32 + k] = (bf16_t)f2bf(SIN[((size_t)(gc * 4 + 2 * hp + hh) * 2 + dir) * 2048 + k * 64 + dv]); }
    __syncthreads();
    const int hh = wid >> 2, h = 2 * hp + hh, qblk = wid & 3; const int n = 32 * qblk + l32; const int rq = r0 + n;
    const float lf = log2_sigmoid(p.ret_decay_f[l * 4 + h]), lb = log2_sigmoid(p.ret_decay_b[l * 4 + h]);
    float qv0[8], qv1[8]; bf16x8 qf0, qf1;
    { const bf16_t* qp = P + (size_t)rq * INW + h * 32 + 8 * hi; const bf16x8 a = *(const bf16x8*)qp, c2 = *(const bf16x8*)(qp + 16);
#pragma unroll
      for (int j = 0; j < 8; ++j) { float x1 = bf2f((unsigned short)a[j]), x2 = bf2f((unsigned short)c2[j]);
          if (lat) { const f32x2 cs = rope[(size_t)(t0 + n) * 16 + 8 * hi + j]; const float y1 = x1 * cs.x - x2 * cs.y, y2 = x2 * cs.x + x1 * cs.y; x1 = y1; x2 = y2; }
          qv0[j] = x1; qv1[j] = x2; }
      qf0 = pack8(qv0[0], qv0[1], qv0[2], qv0[3], qv0[4], qv0[5], qv0[6], qv0[7]); qf1 = pack8(qv1[0], qv1[1], qv1[2], qv1[3], qv1[4], qv1[5], qv1[6], qv1[7]); }
    f32x16 o0, o1;
#pragma unroll
    for (int r = 0; r < 16; ++r) { o0[r] = 0.f; o1[r] = 0.f; }
    const unsigned char* vbase = (const unsigned char*)VTl + (size_t)(hh * 64 + l32) * RT_VP + hi * 8;
    bf16x8 kga[4], kgc[4];
#pragma unroll
    for (int kb = 0; kb < 4; ++kb) { const bf16_t* kp = P + (size_t)(r0 + 32 * kb + l32) * INW + 128 + h * 32 + 8 * hi; kga[kb] = *(const bf16x8*)kp; kgc[kb] = *(const bf16x8*)(kp + 16); }
    __builtin_amdgcn_sched_barrier(0);
#pragma unroll
    for (int kb = 0; kb < 4; ++kb) {
        bf16x8 kf0, kf1;
        { const int key = 32 * kb + l32; const bf16x8 a = kga[kb], c2 = kgc[kb];
          float y1[8], y2[8];
#pragma unroll
          for (int j = 0; j < 8; ++j) { float x1 = bf2f((unsigned short)a[j]), x2 = bf2f((unsigned short)c2[j]);
              if (lat) { const f32x2 cs = rope[(size_t)(t0 + key) * 16 + 8 * hi + j]; const float z1 = x1 * cs.x - x2 * cs.y, z2 = x2 * cs.x + x1 * cs.y; x1 = z1; x2 = z2; }
              y1[j] = x1 * 0.17677669529663687f; y2[j] = x2 * 0.17677669529663687f; }
          kf0 = pack8(y1[0], y1[1], y1[2], y1[3], y1[4], y1[5], y1[6], y1[7]); kf1 = pack8(y2[0], y2[1], y2[2], y2[3], y2[4], y2[5], y2[6], y2[7]); }
        f32x16 s;
#pragma unroll
        for (int r = 0; r < 16; ++r) s[r] = 0.f;
        s = __builtin_amdgcn_mfma_f32_32x32x16_bf16(kf0, qf0, s, 0, 0, 0); s = __builtin_amdgcn_mfma_f32_32x32x16_bf16(kf1, qf1, s, 0, 0, 0);
#pragma unroll
        for (int r = 0; r < 16; ++r) { const int m = 32 * kb + crow(r, hi); const int dl = n - m; const float e = dl >= 0 ? lf * (float)dl : lb * (float)(-dl); s[r] *= __builtin_amdgcn_exp2f(e); }
#pragma unroll
        for (int jp = 0; jp < 2; ++jp) { const bf16x8 pb = pack8(s[8 * jp + 0], s[8 * jp + 1], s[8 * jp + 2], s[8 * jp + 3], s[8 * jp + 4], s[8 * jp + 5], s[8 * jp + 6], s[8 * jp + 7]);
            const unsigned char* vp = vbase + (32 * kb + 16 * jp) * 2;
            const u32x2 a00 = *(const u32x2*)vp, a01 = *(const u32x2*)(vp + 16), a10 = *(const u32x2*)(vp + 32 * RT_VP), a11 = *(const u32x2*)(vp + 32 * RT_VP + 16);
            const bf16x8 A0 = __builtin_bit_cast(bf16x8, (u32x4){a00.x, a00.y, a01.x, a01.y}), A1 = __builtin_bit_cast(bf16x8, (u32x4){a10.x, a10.y, a11.x, a11.y});
            o0 = __builtin_amdgcn_mfma_f32_32x32x16_bf16(A0, pb, o0, 0, 0, 0); o1 = __builtin_amdgcn_mfma_f32_32x32x16_bf16(A1, pb, o1, 0, 0, 0); }
    }
    { const float df = __builtin_amdgcn_exp2f(lf * (float)(n + 1)), db = __builtin_amdgcn_exp2f(lb * (float)(128 - n));
      const unsigned char* sbase = (const unsigned char*)STl + (size_t)(hh * 64 + l32) * RT_SP + hi * 16;
#pragma unroll
      for (int ks = 0; ks < 4; ++ks) { const float dd = ks < 2 ? df : db;
          const bf16x8 qb = (ks & 1) ? pack8(qv1[0] * dd, qv1[1] * dd, qv1[2] * dd, qv1[3] * dd, qv1[4] * dd, qv1[5] * dd, qv1[6] * dd, qv1[7] * dd)
                                     : pack8(qv0[0] * dd, qv0[1] * dd, qv0[2] * dd, qv0[3] * dd, qv0[4] * dd, qv0[5] * dd, qv0[6] * dd, qv0[7] * dd);
          const bf16x8 A0 = *(const bf16x8*)(sbase + ks * 32), A1 = *(const bf16x8*)(sbase + 32 * RT_SP + ks * 32);
          o0 = __builtin_amdgcn_mfma_f32_32x32x16_bf16(A0, qb, o0, 0, 0, 0); o1 = __builtin_amdgcn_mfma_f32_32x32x16_bf16(A1, qb, o1, 0, 0, 0); } }
    float ssq = 0.f;
#pragma unroll
    for (int r = 0; r < 16; ++r) ssq += o0[r] * o0[r] + o1[r] * o1[r];
    ssq += __shfl_xor(ssq, 32);
    const float rstd = rsqrtf(ssq * (1.f / 64.f) + EPS);
    const bf16_t* gp = P + (size_t)rq * INW + 512 + h * 64 + 4 * hi; bf16_t* op = MIX + (size_t)rq * 1024 + h * 64 + 4 * hi;
#pragma unroll
    for (int g4 = 0; g4 < 4; ++g4) { const u32x2 ga = *(const u32x2*)(gp + 8 * g4), gb = *(const u32x2*)(gp + 32 + 8 * g4);
        u32x2 w0, w1;
        w0.x = pk2(o0[4 * g4] * rstd * siluf(bf2f(ga.x & 0xffff)), o0[4 * g4 + 1] * rstd * siluf(bf2f(ga.x >> 16))); w0.y = pk2(o0[4 * g4 + 2] * rstd * siluf(bf2f(ga.y & 0xffff)), o0[4 * g4 + 3] * rstd * siluf(bf2f(ga.y >> 16)));
        w1.x = pk2(o1[4 * g4] * rstd * siluf(bf2f(gb.x & 0xffff)), o1[4 * g4 + 1] * rstd * siluf(bf2f(gb.x >> 16))); w1.y = pk2(o1[4 * g4 + 2] * rstd * siluf(bf2f(gb.y & 0xffff)), o1[4 * g4 + 3] * rstd * siluf(bf2f(gb.y >> 16)));
        *(u32x2*)(op + 8 * g4) = w0; *(u32x2*)(op + 32 + 8 * g4) = w1; }
}

DEV void phase_ffn_fixup(const Params& p, int l) {
    const float* EDGE = (const float*)(p.ws + OFF_EDGE); bf16_t* ACT = (bf16_t*)(p.ws + OFF_OV);
    const float* cw = p.conv_w + (size_t)l * 3 * 5632; const float* cbv = p.conv_b + (size_t)l * 5632;
    for (int idx = blockIdx.x * NWG_T + otid(); idx < 66 * 2 * 704; idx += gridDim.x * NWG_T) {
        const int ch4 = idx % 704, rest = idx / 704; const int which = rest & 1, pm = rest >> 1; const int jj = pm % 33;
        if (l == 1 && jj == 0) continue;
        const int ch = 4 * ch4, pn = ch >> 7, c = ch & 127;
        const bool sstart = jj <= 1, send = (jj == 0) || (jj == 32);
        const f32x4 zz = {0.f, 0.f, 0.f, 0.f};
#define EDG(tile, k, half) (*(const f32x4*)(EDGE + ((size_t)((tile) * 4 + (k)) * 22 + pn) * 256 + (half) * 128 + c))
        f32x4 ua, ub, ca, cb2, da, db;
        if (which == 0) { ua = sstart ? zz : EDG(pm - 1, 3, 0); ub = sstart ? zz : EDG(pm - 1, 3, 1); ca = EDG(pm, 0, 0); cb2 = EDG(pm, 0, 1); da = EDG(pm, 1, 0); db = EDG(pm, 1, 1); }
        else { ua = EDG(pm, 2, 0); ub = EDG(pm, 2, 1); ca = EDG(pm, 3, 0); cb2 = EDG(pm, 3, 1); da = send ? zz : EDG(pm + 1, 0, 0); db = send ? zz : EDG(pm + 1, 0, 1); }
#undef EDG
        const f32x4 wa0 = *(const f32x4*)(cw + ch), wa1 = *(const f32x4*)(cw + 5632 + ch), wa2 = *(const f32x4*)(cw + 2 * 5632 + ch), ba = *(const f32x4*)(cbv + ch);
        const f32x4 wb0 = *(const f32x4*)(cw + DFF + ch), wb1 = *(const f32x4*)(cw + 5632 + DFF + ch), wb2 = *(const f32x4*)(cw + 2 * 5632 + DFF + ch), bb = *(const f32x4*)(cbv + DFF + ch);
        const f32x4 xa = wa0 * ua + wa1 * ca + wa2 * da + ba, xb = wb0 * ub + wb1 * cb2 + wb2 * db + bb;
        u32x2 w; w.x = pk2(siluf(xa.x) * xb.x, siluf(xa.y) * xb.y); w.y = pk2(siluf(xa.z) * xb.z, siluf(xa.w) * xb.w);
        *(u32x2*)(ACT + (size_t)(pm * 256 + (which ? 255 : 0)) * DFF + ch) = w;
    }
}

#define RLX_AGENT __ATOMIC_RELAXED, __HIP_MEMORY_SCOPE_AGENT
#define XB_TMO      128
#define XB_XCNT(j)  (256  + 64 * (j))
#define XB_XSUB(j)  (1280 + 64 * (j))
#define XB_XGEN(j)  (2304 + 64 * (j))
#define XB_TOP      3328
#define XB_TOPGEN   3392
#define XCD_BAR_WORDS 3456
#define XB_SPIN_CAP (1u << 18)

__device__ __forceinline__ unsigned xb_ld(unsigned* p)              { return __hip_atomic_load(p, __ATOMIC_RELAXED, __HIP_MEMORY_SCOPE_AGENT); }
__device__ __forceinline__ unsigned xb_add(unsigned* p, unsigned v) { return __hip_atomic_fetch_add(p, v, __ATOMIC_RELAXED, __HIP_MEMORY_SCOPE_AGENT); }
__device__ __forceinline__ unsigned xb_xcc_id() { return (unsigned)__builtin_amdgcn_s_getreg((3 << 11) | 20) & 0xFu; }
#define XB_SPIN(cond, bar) do { unsigned _sp = 0; while (cond) { __builtin_amdgcn_s_sleep(1); \
    if ((++_sp & 255u) == 0u) { if (xb_ld(&(bar)[XB_TMO])) break; if (_sp > XB_SPIN_CAP) { atomicAdd(&(bar)[XB_TMO], 1u); break; } } } } while (0)

struct XcdBarrier {
    unsigned* bar; unsigned x;
    volatile LAS unsigned* st;
};

__device__ __forceinline__ XcdBarrier xcd_barrier_post(unsigned* bar, volatile LAS unsigned* st) {
    XcdBarrier b; b.bar = bar; b.x = xb_xcc_id(); b.st = st;
    if (threadIdx.x == 0) (void)xb_add(&bar[XB_XCNT(b.x)], 1u);
    return b;
}
__device__ __forceinline__ void xcd_barrier_complete(unsigned* bar, unsigned x, unsigned& nloc, unsigned& nx) {
    const unsigned G = gridDim.x * gridDim.y * gridDim.z;
    unsigned sum, cnt, mine, sp = 0u;
    for (;;) {
        sum = 0u; cnt = 0u; mine = 0u;
#pragma unroll
        for (unsigned j = 0; j < 16; ++j) { const unsigned c = xb_ld(&bar[XB_XCNT(j)]); sum += c; cnt += (c > 0u) ? 1u : 0u; mine = (j == x) ? c : mine; }
        if (sum == G) break;
        __builtin_amdgcn_s_sleep(1);
        if ((++sp & 255u) == 0u) { if (xb_ld(&bar[XB_TMO])) break; if (sp > XB_SPIN_CAP) { atomicAdd(&bar[XB_TMO], 1u); break; } }
    }
    nloc = mine > 0u ? mine : 1u; nx = cnt > 0u ? cnt : 1u;
}

__device__ __forceinline__ void xcd_barrier(const XcdBarrier& b) {
    asm volatile("s_waitcnt vmcnt(0)" ::: "memory");
    __syncthreads();
    if (threadIdx.x == 0) {
        unsigned* bar = b.bar;
        __builtin_amdgcn_s_waitcnt(0);
        unsigned nloc = b.st[0], nx = b.st[1];
        if (nloc == 0u) { xcd_barrier_complete(bar, b.x, nloc, nx); b.st[0] = nloc; b.st[1] = nx; }
        const unsigned old = xb_add(&bar[XB_XSUB(b.x)], 1u);
        const unsigned gen = old / nloc;
        if (old + 1u == (gen + 1u) * nloc) {
            __builtin_amdgcn_fence(__ATOMIC_RELEASE, "agent");
            asm volatile("s_waitcnt vmcnt(0)" ::: "memory");
            const unsigned og = xb_add(&bar[XB_TOP], 1u);
            const unsigned tg = og / nx;
            if (og + 1u == (tg + 1u) * nx) xb_add(&bar[XB_TOPGEN], 1u);
            else XB_SPIN(xb_ld(&bar[XB_TOPGEN]) == tg, bar);
            __builtin_amdgcn_fence(__ATOMIC_ACQUIRE, "agent");
            xb_add(&bar[XB_XGEN(b.x)], 1u);
            asm volatile("s_waitcnt vmcnt(0)" ::: "memory");
        } else {
            XB_SPIN(xb_ld(&bar[XB_XGEN(b.x)]) == gen, bar);
            __builtin_amdgcn_fence(__ATOMIC_ACQUIRE, "agent");
            asm volatile("s_waitcnt vmcnt(0)" ::: "memory");
        }
    }
    __syncthreads();
}


constexpr size_t OFF_CTL = 250000128; constexpr int CTL_BYTES = 16384;
#if defined(__HIP_DEVICE_COMPILE__)
#define KP() const __attribute__((address_space(4))) Params* kp_ = (const __attribute__((address_space(4))) Params*)__builtin_amdgcn_kernarg_segment_ptr(); asm volatile("" : "+s"(kp_)); const Params p = *kp_; \
    bf16_t* HN = (bf16_t*)(p.ws + OFF_HN); bf16_t* P = (bf16_t*)p.out; float* X = (float*)(p.ws + OFF_X); (void)HN; (void)P; (void)X
#else
#define KP() const Params p = p_arg; bf16_t* HN = (bf16_t*)(p.ws + OFF_HN); bf16_t* P = (bf16_t*)p.out; float* X = (float*)(p.ws + OFF_X); (void)HN; (void)P; (void)X
#endif
#define WL() const bf16_t* wl = (const bf16_t*)(p.ws + OFF_W) + (size_t)l * W_LAYER; const float* modv = (const float*)(p.ws + OFF_MOD) + (size_t)l * 3 * 6144; (void)wl; (void)modv
#ifndef DUPM
#define DUPM 0
#endif
#define REP(bit) for (int rep_ = 0; rep_ < (((DUPM) >> (bit)) & 1) + 1; ++rep_)
constexpr int PH_PER_LAYER = 10, N_PHASES = 2 + 2 * PH_PER_LAYER;
__global__ void __launch_bounds__(512, 2) mk_fwd(Params p_arg) {
    extern __shared__ __attribute__((aligned(16))) unsigned char lds[];
    cg::grid_group grid = cg::this_grid();
    const int G = gridDim.x, bx = blockIdx.x; const int vcu = (G % 8 == 0) ? (bx % 8) * (G / 8) + bx / 8 : bx;
    LAS unsigned char* ldsl = (LAS unsigned char*)lds;
    const int ph_lo = p_arg.ph_lo, ph_hi = p_arg.ph_hi;
    volatile LAS unsigned* misc = (volatile LAS unsigned*)(ldsl + (LDS_BYTES - 64));
    { const int t0_ = otid(); if (t0_ < 16) misc[t0_] = 0u; }
    __syncthreads();
    if (ph_hi - ph_lo > 1) (void)xcd_barrier_post((unsigned*)(p_arg.ws + OFF_CTL), misc);
    for (int ph = ph_lo; ph < ph_hi; ++ph) {
        if (ph == 0) { KP(); phase_prep(p, lds); __syncthreads(); }
        else if (ph == N_PHASES - 1) { KP(); phase_final(p);
#if (DUPM >> 10) & 1
            for (int i = 0; i < 20; ++i) grid.sync();
#endif
        }
        else {
            const int l = (ph - 1) / PH_PER_LAYER, sp = (ph - 1) % PH_PER_LAYER;
            if (sp == 0) { KP(); if (l == 0) REP(9) { phase_prep_weights(p, lds); __syncthreads(); }
                phase_norm(p, l, 0, l == 0, l == 1 ? (const float*)(p.ws + OFF_MOD) + 2 * 6144 + 5120 : nullptr); }
            else if (sp == 1) { KP(); WL(); REP(1) { __syncthreads();
                pg8::Gemm g{HN, wl + W_IN, R, 1792, 1024, 1024, 1024}; pg8::StaticOrder S; S.init(R, 1792, G, bx);
                pg8::EpiStore E{P, INW, INW, 1.0f};
                pg8::gemm_phase<pg8::EpiStore, pg8::StaticOrder, true, true>(ldsl, g, S, E); } }
            else if (sp == 2) { KP(); phase_rowwise(p, l); __syncthreads();
                REP(2) phase_pool(p);
                REP(3) for (int it = G - 1 - bx; it < 264; it += G) states_item(p, l, lds, it); __syncthreads(); }
            else if (sp == 3) { KP(); WL(); REP(4) { __syncthreads();
                { pg8::Gemm g{P + 768, wl + W_UQ, R, 768, 384, INW, 384}; pg8::StaticOrder S; S.init(R, 768, G, bx);
                  pg8::EpiStore E{(bf16_t*)(p.ws + OFF_OV + OV_Q), 768, 768, 0.14724444f};
                  pg8::gemm_phase<pg8::EpiStore, pg8::StaticOrder, true, true>(ldsl, g, S, E); }
                __syncthreads();
                { pg8::Gemm g{P + 1152, wl + W_KN, R, 512, 256, INW, 256}; pg8::StaticOrder S; S.init(R, 512, G, (bx + 58) % G);
                  pg8::EpiStore E{(bf16_t*)(p.ws + OFF_OV + OV_KN), 512, 512, 1.0f};
                  pg8::gemm_phase<pg8::EpiStore, pg8::StaticOrder, true, true>(ldsl, g, S, E); }
                __syncthreads();
                { pg8::Gemm g{wl + W_V, P + 1152, 512, R, 256, 256, INW}; pg8::StaticOrder S; S.init(512, R, G, (bx + 182) % G);
                  pg8::EpiStore E{(bf16_t*)(p.ws + OFF_OV + OV_VT), R, R, 1.0f};
                  pg8::gemm_phase<pg8::EpiStore, pg8::StaticOrder, true, true>(ldsl, g, S, E); }
                if (bx >= G - 64) scan_threads(p, l, (bx - (G - 64)) * NWG_T + otid()); } }
            else if (sp == 4) { KP();
                REP(5) for (int u = vcu; u < (l == 0 ? 528 : 512); u += G) attn_unit(p, lds, u);
                REP(6) for (int u = G - 1 - bx; u < (l == 0 ? 264 : 256); u += G) retout_unit(p, l, lds, l == 0 ? u : u + 4 * (u >> 7) + 4); }
            else if (sp == 5) { KP(); WL(); __syncthreads();
                { pg8::Gemm g{HN, wl + W_OUT, R, 1024, 1024, 1024, 1024}; pg8::StaticOrder S; S.init(16384, 1024, G, bx, 1);
                  pg8::EpiResid E{X, modv + 2048, 0};
                  pg8::gemm_phase<pg8::EpiResid, pg8::StaticOrder, true, true>(ldsl, g, S, E); }
                if (l == 0 && bx < 32) { __syncthreads(); const int q = bx >> 3;
                  pg8::Gemm g{HN + q * 256, wl + W_OUT + q * 256, 512, 1024, 256, 1024, 1024}; pg8::StaticOrder S; S.init(512, 1024, G, bx & 7, 2);
                  pg8::EpiPart E{(float*)(p.ws + OFF_PART) + (size_t)q * 524288, 0};
                  pg8::gemm_phase<pg8::EpiPart, pg8::StaticOrder, true, true>(ldsl, g, S, E); } }
            else if (sp == 6) { KP(); WL(); phase_norm(p, l, 1, false, l == 0 ? modv + 2 * 6144 + 2048 : nullptr); }
            else if (sp == 7) { KP(); WL(); REP(7) { __syncthreads();
                pg8::Gemm g{HN, wl + W_UP, R, 2 * DFF, 1024, 1024, 1024}; pg8::StaticOrder S; S.init(l == 1 ? 16384 : R, 2 * DFF, G, bx, l == 1 ? 1 : 0);
                pg8::EpiFfn E{(bf16_t*)(p.ws + OFF_OV), (float*)(p.ws + OFF_EDGE), p.conv_w + (size_t)l * 3 * 5632, p.conv_b + (size_t)l * 5632, (LAS float*)(ldsl + 131072)};
                pg8::gemm_phase<pg8::EpiFfn, pg8::StaticOrder, true, true>(ldsl, g, S, E); } }
            else if (sp == 8) { KP(); REP(8) phase_ffn_fixup(p, l); }
            else if (sp == 9) { KP(); WL(); __syncthreads();
                { pg8::Gemm g{(const bf16_t*)(p.ws + OFF_OV), wl + W_DN, R, 1024, DFF, DFF, DFF}; pg8::StaticOrder S; S.init(16384, 1024, G, bx, 1);
                  pg8::EpiResid E{X, modv + 5120, 0};
                  pg8::gemm_phase<pg8::EpiResid, pg8::StaticOrder, true, true>(ldsl, g, S, E); }
                if (l == 0 && bx < 32) { __syncthreads(); const int q = bx >> 3; const int koff = q < 2 ? q * 768 : 1536 + (q - 2) * 640, klen = q < 2 ? 768 : 640;
                  pg8::Gemm g{(const bf16_t*)(p.ws + OFF_OV) + koff, wl + W_DN + koff, 512, 1024, klen, DFF, DFF}; pg8::StaticOrder S; S.init(512, 1024, G, bx & 7, 2);
                  pg8::EpiPart E{(float*)(p.ws + OFF_PART) + (size_t)q * 524288, 0};
                  pg8::gemm_phase<pg8::EpiPart, pg8::StaticOrder, true, true>(ldsl, g, S, E); } }
        }
        if (ph + 1 < ph_hi) {
            if (ph_lo < 0) grid.sync();
            { KP(); XcdBarrier b; b.bar = (unsigned*)(p.ws + OFF_CTL); b.x = xb_xcc_id(); b.st = misc; xcd_barrier(b); }
        }
    }
}

extern "C" void kernel_launch(void* const* d_in, const int* in_sizes, int n_in, void* d_out, int out_size, void* d_ws, size_t ws_size, hipStream_t stream) {
    static int grid = 0;
    if (grid == 0) {
        if (n_in != 23 || ws_size < WS_NEED) { fprintf(stderr, "kernel_launch: unexpected problem (n_in %d, ws %zu, need %zu)\n", n_in, ws_size, (size_t)WS_NEED); grid = -1; return; }
        int dev = 0, cus = 0, per_cu = 0;
        hipGetDevice(&dev); hipDeviceGetAttribute(&cus, hipDeviceAttributeMultiprocessorCount, dev);
        if (hipFuncSetAttribute((const void*)mk_fwd, hipFuncAttributeMaxDynamicSharedMemorySize, LDS_BYTES) != hipSuccess) { fprintf(stderr, "kernel_launch: hipFuncSetAttribute failed\n"); grid = -1; return; }
        if (hipOccupancyMaxActiveBlocksPerMultiprocessor(&per_cu, (const void*)mk_fwd, 512, LDS_BYTES) != hipSuccess || per_cu < 1) { fprintf(stderr, "kernel_launch: occupancy query says %d\n", per_cu); per_cu = 1; }
        (void)hipGetLastError();
        grid = cus * per_cu; if (grid > 256) grid = 256;
        fprintf(stderr, "kernel_launch: grid %d (cus %d, per_cu %d)\n", grid, cus, per_cu);
    }
    if (grid < 0) return;
    Params p{};
    const float** pp = (const float**)&p;
    for (int i = 0; i < 23; ++i) pp[i] = (const float*)d_in[i];
    p.out = (float*)d_out; p.ws = (unsigned char*)d_ws;
#if MK_MULTI
    for (int ph = 0; ph < N_PHASES; ++ph) { p.ph_lo = ph; p.ph_hi = ph + 1; void* args[] = {&p};
        hipError_t e = hipLaunchCooperativeKernel((void*)mk_fwd, dim3(grid), dim3(512), args, LDS_BYTES, stream);
        if (e != hipSuccess) { fprintf(stderr, "launch %d failed: %s\n", ph, hipGetErrorString(e)); break; } }
#else
    if (hipMemsetAsync((char*)d_ws + OFF_CTL, 0, CTL_BYTES, stream) != hipSuccess) { fprintf(stderr, "kernel_launch: memset of the barrier words failed\n"); return; }
    p.ph_lo = 0; p.ph_hi = N_PHASES; void* args[] = {&p};
    hipError_t e = hipLaunchCooperativeKernel((void*)mk_fwd, dim3(grid), dim3(512), args, LDS_BYTES, stream);
    if (e != hipSuccess) fprintf(stderr, "cooperative launch failed: %s (grid %d)\n", hipGetErrorString(e), grid);
#endif
}
```

```cpp
#include <hip/hip_runtime.h>
#include <hip/hip_cooperative_groups.h>
#include <cstdio>
#include <cstdint>
namespace cg = cooperative_groups;

#ifndef MK_MULTI
#define MK_MULTI 0
#endif

namespace pg8 {
#define PG8_LAS __attribute__((address_space(3)))
typedef unsigned short bf16_t;
typedef short bf16x8 __attribute__((ext_vector_type(8)));
typedef float f32x4 __attribute__((ext_vector_type(4)));
typedef unsigned u32x4 __attribute__((ext_vector_type(4)));
constexpr int BM = 256, BK = 64, HALF = 128, HTB = HALF * BK * 2  , STAGE_BYTES = 8 * HTB, NXCD = 8, WGM = 8;

__host__ __device__ __forceinline__ int lds_byte(int r, int c) { const int st = (r >> 4) * 2 + (c >> 5), rr = r & 15, cc = c & 31, ob = rr * 64 + cc * 2; return st * 1024 + (ob ^ (((ob >> 9) & 1) << 5)); }
__host__ __device__ __forceinline__ void stage_rc(int b, int& R, int& C) { const int st = b / 1024, sb = b % 1024, swz = sb ^ (((sb >> 9) & 1) << 5); R = (st >> 1) * 16 + swz / 64; C = (st & 1) * 32 + (swz % 64) / 2; }
__host__ __device__ __forceinline__ int perm32(int rho) { const int n = rho >> 4, i = rho & 15; return 8 * (i >> 2) + 4 * n + (i & 3); }

struct Unit { int pm, pn; };
struct Gemm { const bf16_t* A; const bf16_t* Bt; int M, N, K, lda, ldb; };

struct StaticOrder {
    int nM, nN, nwg, G, c, skip;
    __host__ __device__ void init(int M, int N, int G_, int c_, int skip_ = 0) { nM = M / BM; nN = N / BM; nwg = nM * nN; G = G_; c = c_; skip = skip_; }
    __host__ __device__ bool next(int i, Unit& u) const {
        const long L = (long)i * G + c; if (L >= nwg) return false;
        int wgid = (int)L; { const int q = nwg / NXCD, r = nwg % NXCD, xcd = wgid % NXCD, off = wgid / NXCD; wgid = (xcd < r ? xcd * (q + 1) : r * (q + 1) + (xcd - r) * q) + off; }
        const int nig = WGM * nN, gid = wgid / nig, fm = gid * WGM, gsz = (nM - fm) < WGM ? (nM - fm) : WGM;
        u.pm = fm + ((wgid % nig) % gsz); u.pn = (wgid % nig) / gsz; if (skip == 1) u.pm += 1 + (u.pm >= 32 ? 1 : 0); else if (skip == 2) u.pm *= 33; return true;
    }
    __device__ __forceinline__ void a_ready(const Unit&) const {}
    __device__ __forceinline__ void done(const Unit&) const {}
};

__device__ __forceinline__ unsigned cvt_pk_bf16(float lo, float hi) { unsigned r; asm volatile("v_cvt_pk_bf16_f32 %0, %1, %2" : "=v"(r) : "v"(lo), "v"(hi)); return r; }

struct EpiStore {
    static constexpr bool PERM = true, AFTER_DRAIN = false;
    bf16_t* O; int ldc; int ncols; float scale;
    __device__ __forceinline__ void operator()(const f32x4 (&acc)[2][2][4][2], const Unit& u, int wr, int wc, int fr, int fq) const {
        const int row0 = u.pm * BM + wr * 64 + fr; const int col0 = u.pn * BM + wc * 32 + 8 * fq;
#pragma unroll
        for (int ai = 0; ai < 2; ++ai)
#pragma unroll
            for (int m = 0; m < 4; ++m) { bf16_t* rowp = O + (size_t)(row0 + ai * HALF + m * 16) * ldc + col0;
#pragma unroll
                for (int bj = 0; bj < 2; ++bj) { if (col0 + bj * HALF < ncols) {
                    f32x4 v0 = acc[ai][bj][m][0] * scale, v1 = acc[ai][bj][m][1] * scale;
                    u32x4 w; w.x = cvt_pk_bf16(v0[0], v0[1]); w.y = cvt_pk_bf16(v0[2], v0[3]); w.z = cvt_pk_bf16(v1[0], v1[1]); w.w = cvt_pk_bf16(v1[2], v1[3]);
                    *(u32x4*)(rowp + bj * HALF) = w; } } }
    }
};
struct EpiResid {
    static constexpr bool PERM = false, AFTER_DRAIN = false;
    float* X; const float* gate; int row_tile0;
    __device__ __forceinline__ void operator()(const f32x4 (&acc)[2][2][4][2], const Unit& u, int wr, int wc, int fr, int fq) const {
        const int tpm = u.pm + row_tile0; const int bb = tpm / 33, jj = tpm - bb * 33; const float* gv = gate + (jj == 0 ? 2 : bb) * 6144;
        const int col0 = u.pn * BM + wc * 32 + 4 * fq;
#pragma unroll
        for (int ai = 0; ai < 2; ++ai)
#pragma unroll
            for (int m = 0; m < 4; ++m) { float* rowp = X + (size_t)(tpm * BM + ai * HALF + wr * 64 + m * 16 + fr) * 1024 + col0;
#pragma unroll
                for (int bj = 0; bj < 2; ++bj) {
#pragma unroll
                    for (int n = 0; n < 2; ++n) { f32x4* q = (f32x4*)(rowp + bj * HALF + n * 16); const f32x4 gq = *(const f32x4*)(gv + col0 + bj * HALF + n * 16); f32x4 xv = *q; xv = xv + gq * acc[ai][bj][m][n]; *q = xv; }
                    asm volatile("" ::: "memory"); } }
    }
};
struct EpiPart {
    static constexpr bool PERM = false, AFTER_DRAIN = false;
    float* out; int accum;
    __device__ __forceinline__ void operator()(const f32x4 (&acc)[2][2][4][2], const Unit& u, int wr, int wc, int fr, int fq) const {
        const int t = u.pm / 33; const int col0 = u.pn * BM + wc * 32 + 4 * fq;
#pragma unroll
        for (int ai = 0; ai < 2; ++ai)
#pragma unroll
            for (int m = 0; m < 4; ++m) { float* rowp = out + (size_t)(t * BM + ai * HALF + wr * 64 + m * 16 + fr) * 1024 + col0;
#pragma unroll
                for (int bj = 0; bj < 2; ++bj) {
#pragma unroll
                    for (int n = 0; n < 2; ++n) { f32x4* q = (f32x4*)(rowp + bj * HALF + n * 16); f32x4 v = acc[ai][bj][m][n]; if (accum) v = v + *q; *q = v; }
                    asm volatile("" ::: "memory"); } }
    }
};
template <int CTRL> __device__ __forceinline__ float dpp0(float x) { return __builtin_bit_cast(float, __builtin_amdgcn_update_dpp(0, __builtin_bit_cast(int, x), CTRL, 0xf, 0xf, true)); }
struct EpiFfn {
    static constexpr bool PERM = false, AFTER_DRAIN = false;
    bf16_t* ACT; float* EDGE; const float* cw; const float* cb; PG8_LAS float* xl;
    __device__ __forceinline__ void operator()(const f32x4 (&acc)[2][2][4][2], const Unit& u, int wr, int wc, int fr, int fq) const {
        PG8_LAS float* FIRST = xl; PG8_LAS float* LAST = xl + 1024;
        const int cb0 = wc * 32 + 4 * fq;
#pragma unroll
        for (int ai = 0; ai < 2; ++ai)
#pragma unroll
            for (int bj = 0; bj < 2; ++bj)
#pragma unroll
                for (int n = 0; n < 2; ++n) { const int col = bj * HALF + cb0 + n * 16;
                    if (fr == 0) *(PG8_LAS f32x4*)(FIRST + (2 * ai + wr) * 256 + col) = acc[ai][bj][0][n];
                    if (fr == 15) *(PG8_LAS f32x4*)(LAST + (2 * ai + wr) * 256 + col) = acc[ai][bj][3][n]; }
        if (wr == 0 && fr < 2) {
#pragma unroll
            for (int bj = 0; bj < 2; ++bj)
#pragma unroll
                for (int n = 0; n < 2; ++n) *(f32x4*)(EDGE + ((size_t)(u.pm * 4 + fr) * 22 + u.pn) * 256 + bj * HALF + cb0 + n * 16) = acc[0][bj][0][n]; }
        if (wr == 1 && fr >= 14) {
#pragma unroll
            for (int bj = 0; bj < 2; ++bj)
#pragma unroll
                for (int n = 0; n < 2; ++n) *(f32x4*)(EDGE + ((size_t)(u.pm * 4 + 2 + (fr - 14)) * 22 + u.pn) * 256 + bj * HALF + cb0 + n * 16) = acc[1][bj][3][n]; }
        asm volatile("s_waitcnt lgkmcnt(0)" ::: "memory"); __builtin_amdgcn_s_barrier(); asm volatile("" ::: "memory");
#pragma unroll
        for (int n = 0; n < 2; ++n) { const int ch0 = u.pn * HALF + cb0 + n * 16;
            f32x4 wa[3], wb[3];
#pragma unroll
            for (int k = 0; k < 3; ++k) { wa[k] = *(const f32x4*)(cw + k * 5632 + ch0); wb[k] = *(const f32x4*)(cw + k * 5632 + 2816 + ch0); }
            const f32x4 ba = *(const f32x4*)(cb + ch0), bb = *(const f32x4*)(cb + 2816 + ch0);
#pragma unroll
            for (int ai = 0; ai < 2; ++ai) { const int g = 2 * ai + wr;
                f32x4 bu[2], bd[2];
#pragma unroll
                for (int bj = 0; bj < 2; ++bj) { const int col = bj * HALF + cb0 + n * 16; const f32x4 zz = {0.f, 0.f, 0.f, 0.f};
                    bu[bj] = g > 0 ? *(const PG8_LAS f32x4*)(LAST + (g - 1) * 256 + col) : zz; bd[bj] = g < 3 ? *(const PG8_LAS f32x4*)(FIRST + (g + 1) * 256 + col) : zz; }
#pragma unroll
                for (int m = 0; m < 4; ++m) { float o[4];
#pragma unroll
                    for (int e = 0; e < 4; ++e) { float up[2], dn[2];
#pragma unroll
                        for (int bj = 0; bj < 2; ++bj) { const float cur = acc[ai][bj][m][n][e];
                            float x = dpp0<0x111>(cur);
                            if (m > 0) x += dpp0<0x10F>(acc[ai][bj][m - 1][n][e]); else x += (fr == 0 ? bu[bj][e] : 0.f);
                            float y = dpp0<0x101>(cur);
                            if (m < 3) y += dpp0<0x11F>(acc[ai][bj][m + 1][n][e]); else y += (fr == 15 ? bd[bj][e] : 0.f);
                            up[bj] = x; dn[bj] = y; }
                        const float ua = wa[0][e] * up[0] + wa[1][e] * acc[ai][0][m][n][e] + wa[2][e] * dn[0] + ba[e];
                        const float ub = wb[0][e] * up[1] + wb[1][e] * acc[ai][1][m][n][e] + wb[2][e] * dn[1] + bb[e];
                        o[e] = ua * __builtin_amdgcn_rcpf(1.0f + __builtin_amdgcn_exp2f(-1.4426950408889634f * ua)) * ub; }
                    typedef unsigned u32x2 __attribute__((ext_vector_type(2))); u32x2 w; w.x = cvt_pk_bf16(o[0], o[1]); w.y = cvt_pk_bf16(o[2], o[3]);
                    *(u32x2*)(ACT + (size_t)(u.pm * BM + ai * HALF + wr * 64 + m * 16 + fr) * 2816 + ch0) = w; } } }
    }
};

template <class Epi, class Sched, bool ALIGN_EPI = false, bool SP2 = false>
__device__ __forceinline__ void gemm_phase(PG8_LAS unsigned char* lds, const Gemm g, const Sched& S, const Epi& E) {
    int tid = threadIdx.x; asm volatile("" : "+v"(tid));
    const int wid = __builtin_amdgcn_readfirstlane(tid >> 6), lane = tid & 63, wr = wid >> 2, wc = wid & 3, fr = lane & 15, fq = lane >> 4;
    int K = g.K; asm volatile("" : "+s"(K));
    const int nt = K / BK;
    unsigned voffA[2], voffB[2];
#pragma unroll
    for (int i = 0; i < 2; ++i) { int R, C; stage_rc(tid * 16 + i * 8192, R, C); const int Rb = Epi::PERM ? ((R & ~31) + perm32(R & 31)) : R;
        voffA[i] = (unsigned)(R * g.lda + C) * 2u; voffB[i] = (unsigned)(Rb * g.ldb + C) * 2u; }
    const size_t kstep = (size_t)(BK * 2);
    const size_t hstepA = (size_t)HALF * g.lda * 2, hstepB = (size_t)HALF * g.ldb * 2;
    const size_t tstepA = 2 * hstepA, tstepB = 2 * hstepB;
    const unsigned ldsw = (unsigned)wid * 1024u;
    const int aoff = lds_byte(wr * 64 + fr, fq * 8), boff = lds_byte(wc * 32 + fr, fq * 8);
#define PG8_SA(b, h) (((b) * 2 + (h)) * HTB)
#define PG8_SB(b, h) ((4 + (b) * 2 + (h)) * HTB)
#define PG8_STAGE(bufoff, gbase, voff) do { _Pragma("unroll") for (int _i = 0; _i < 2; ++_i) \
        __builtin_amdgcn_global_load_lds((const unsigned*)((const char*)(gbase) + (voff)[_i]), (PG8_LAS unsigned*)(lds + (bufoff) + ldsw + _i * 8192), 16, 0, 0); } while (0)
#define PG8_LDA(dst, b, h) do { _Pragma("unroll") for (int m = 0; m < 4; ++m) _Pragma("unroll") for (int k = 0; k < 2; ++k) dst[m][k] = *(const PG8_LAS bf16x8*)(lds + PG8_SA(b, h) + aoff + m * 2048 + k * 1024); } while (0)
#define PG8_LDB(dst, b, h) do { _Pragma("unroll") for (int n = 0; n < 2; ++n) _Pragma("unroll") for (int k = 0; k < 2; ++k) dst[n][k] = *(const PG8_LAS bf16x8*)(lds + PG8_SB(b, h) + boff + n * 2048 + k * 1024); } while (0)
#define PG8_MMA(ai, bj, At, Bt) do { __builtin_amdgcn_s_setprio(1); _Pragma("unroll") for (int m = 0; m < 4; ++m) _Pragma("unroll") for (int n = 0; n < 2; ++n) _Pragma("unroll") for (int k = 0; k < 2; ++k) \
        acc[ai][bj][m][n] = __builtin_amdgcn_mfma_f32_16x16x32_bf16(Bt[n][k], At[m][k], acc[ai][bj][m][n], 0, 0, 0); __builtin_amdgcn_s_setprio(0); } while (0)
#define PG8_WAIT_V(n) asm volatile("s_waitcnt vmcnt(" #n ")" ::: "memory")
#define PG8_WAIT_L(n) asm volatile("s_waitcnt lgkmcnt(" #n ")" ::: "memory")
#define PG8_BAR __builtin_amdgcn_s_barrier()
#define PG8_SCHED __builtin_amdgcn_sched_barrier(0)
    Unit cur, nxt; int ui = 0;
    if (!S.next(0, cur)) return;
    f32x4 acc[2][2][4][2];
#pragma unroll
    for (int a = 0; a < 2; ++a)
#pragma unroll
        for (int b = 0; b < 2; ++b)
#pragma unroll
            for (int m = 0; m < 4; ++m)
#pragma unroll
                for (int n = 0; n < 2; ++n) acc[a][b][m][n] = (f32x4){0.f, 0.f, 0.f, 0.f};
    bf16x8 At[4][2], B0[2][2], B1[2][2];
    const char* cA = (const char*)g.A + (size_t)cur.pm * tstepA; const char* cB = (const char*)g.Bt + (size_t)cur.pn * tstepB;
    S.a_ready(cur);
    if constexpr (SP2) {
        PG8_STAGE(PG8_SB(0, 0), cB, voffB); PG8_STAGE(PG8_SB(0, 1), cB + hstepB, voffB); PG8_STAGE(PG8_SA(0, 0), cA, voffA); PG8_STAGE(PG8_SA(0, 1), cA + hstepA, voffA);
        if (wr == 1) PG8_BAR;
        PG8_WAIT_V(2); PG8_BAR;
        PG8_STAGE(PG8_SB(1, 0), cB + kstep, voffB); PG8_STAGE(PG8_SA(1, 0), cA + kstep, voffA); PG8_STAGE(PG8_SB(1, 1), cB + hstepB + kstep, voffB);
        PG8_WAIT_V(6); PG8_BAR;
    } else {
        PG8_STAGE(PG8_SB(0, 0), cB, voffB); PG8_STAGE(PG8_SA(0, 0), cA, voffA); PG8_STAGE(PG8_SB(0, 1), cB + hstepB, voffB); PG8_STAGE(PG8_SA(0, 1), cA + hstepA, voffA);
        if (wr == 1) PG8_BAR;
        PG8_WAIT_V(4); PG8_BAR;
        PG8_STAGE(PG8_SB(1, 0), cB + kstep, voffB); PG8_STAGE(PG8_SA(1, 0), cA + kstep, voffA); PG8_STAGE(PG8_SB(1, 1), cB + hstepB + kstep, voffB);
        PG8_WAIT_V(6); PG8_BAR;
    }
    for (;;) {
        const bool has_next = S.next(ui + 1, nxt);
        const char* nA = has_next ? (const char*)g.A + (size_t)nxt.pm * tstepA : cA; const char* nB = has_next ? (const char*)g.Bt + (size_t)nxt.pn * tstepB : cB;
        for (int t = 0; t < nt; t += 2) {
            const bool last = (t == nt - 2);
            const char* a1 = cA + (size_t)(t + 1) * kstep;
            const char* a2 = last ? nA : cA + (size_t)(t + 2) * kstep; const char* b2 = last ? nB : cB + (size_t)(t + 2) * kstep;
            const char* a3 = a2 + kstep; const char* b3 = b2 + kstep;
            if (last && has_next) S.a_ready(nxt);
            if constexpr (SP2) {
            PG8_LDB(B0, 0, 0); PG8_LDB(B1, 0, 1); PG8_SCHED; PG8_LDA(At, 0, 0); PG8_STAGE(PG8_SA(1, 1), a1 + hstepA, voffA);
            PG8_WAIT_V(8); PG8_WAIT_L(0); PG8_BAR; PG8_MMA(0, 0, At, B0); PG8_MMA(0, 1, At, B1); PG8_BAR; PG8_SCHED;
            PG8_LDA(At, 0, 1); PG8_STAGE(PG8_SB(0, 0), b2, voffB); PG8_STAGE(PG8_SB(0, 1), b2 + hstepB, voffB); PG8_STAGE(PG8_SA(0, 0), a2, voffA);
            PG8_WAIT_V(8); PG8_WAIT_L(0); PG8_BAR; PG8_MMA(1, 0, At, B0); PG8_MMA(1, 1, At, B1); PG8_BAR; PG8_SCHED;
            PG8_LDB(B0, 1, 0); PG8_LDB(B1, 1, 1); PG8_SCHED; PG8_LDA(At, 1, 0); PG8_STAGE(PG8_SA(0, 1), a2 + hstepA, voffA);
            PG8_WAIT_V(8); PG8_WAIT_L(0); PG8_BAR; PG8_MMA(0, 0, At, B0); PG8_MMA(0, 1, At, B1); PG8_BAR; PG8_SCHED;
            PG8_LDA(At, 1, 1); PG8_STAGE(PG8_SB(1, 0), b3, voffB); PG8_STAGE(PG8_SB(1, 1), b3 + hstepB, voffB); PG8_STAGE(PG8_SA(1, 0), a3, voffA);
            PG8_WAIT_V(8); PG8_WAIT_L(0); PG8_BAR; PG8_MMA(1, 0, At, B0); PG8_MMA(1, 1, At, B1); PG8_BAR; PG8_SCHED;
            } else {
            PG8_LDB(B0, 0, 0); PG8_SCHED; PG8_LDA(At, 0, 0); PG8_STAGE(PG8_SA(1, 1), a1 + hstepA, voffA);
            PG8_WAIT_L(8); PG8_BAR; PG8_WAIT_L(0); PG8_MMA(0, 0, At, B0); PG8_BAR; PG8_SCHED;
            PG8_LDB(B1, 0, 1); PG8_STAGE(PG8_SB(0, 0), b2, voffB);
            PG8_BAR; PG8_WAIT_L(0); PG8_MMA(0, 1, At, B1); PG8_BAR;
            PG8_LDA(At, 0, 1); PG8_STAGE(PG8_SA(0, 0), a2, voffA);
            PG8_BAR; PG8_WAIT_L(0); PG8_MMA(1, 0, At, B0); PG8_BAR; PG8_SCHED;
            PG8_STAGE(PG8_SB(0, 1), b2 + hstepB, voffB);
            PG8_WAIT_V(6); PG8_BAR; PG8_MMA(1, 1, At, B1); PG8_BAR;
            PG8_LDB(B0, 1, 0); PG8_SCHED; PG8_LDA(At, 1, 0); PG8_STAGE(PG8_SA(0, 1), a2 + hstepA, voffA);
            PG8_WAIT_L(8); PG8_BAR; PG8_WAIT_L(0); PG8_MMA(0, 0, At, B0); PG8_BAR; PG8_SCHED;
            PG8_LDB(B1, 1, 1); PG8_STAGE(PG8_SB(1, 0), b3, voffB);
            PG8_BAR; PG8_WAIT_L(0); PG8_MMA(0, 1, At, B1); PG8_BAR;
            PG8_LDA(At, 1, 1); PG8_STAGE(PG8_SA(1, 0), a3, voffA);
            PG8_BAR; PG8_WAIT_L(0); PG8_MMA(1, 0, At, B0); PG8_BAR; PG8_SCHED;
            PG8_STAGE(PG8_SB(1, 1), b3 + hstepB, voffB);
            PG8_WAIT_V(6); PG8_BAR; PG8_MMA(1, 1, At, B1); PG8_BAR;
            }
        }
        if constexpr (ALIGN_EPI) { if (wr == 0) PG8_BAR; }
        if constexpr (!Epi::AFTER_DRAIN) { E(acc, cur, wr, wc, fr, fq); S.done(cur); }
        if (!has_next) break;
#pragma unroll
        for (int a = 0; a < 2; ++a)
#pragma unroll
            for (int b = 0; b < 2; ++b)
#pragma unroll
                for (int m = 0; m < 4; ++m)
#pragma unroll
                    for (int n = 0; n < 2; ++n) acc[a][b][m][n] = (f32x4){0.f, 0.f, 0.f, 0.f};
        cur = nxt; cA = nA; cB = nB; ++ui;
        if constexpr (ALIGN_EPI) { if (wr == 1) PG8_BAR; }
    }
    PG8_WAIT_V(0);
    if constexpr (!ALIGN_EPI) { if (wr == 0) PG8_BAR; }
    PG8_BAR;
    if constexpr (Epi::AFTER_DRAIN) { E.fused(acc, cur, wr, wc, fr, fq, lds, wid, lane); S.done(cur); }
#undef PG8_SA
#undef PG8_SB
#undef PG8_STAGE
#undef PG8_LDA
#undef PG8_LDB
#undef PG8_MMA
#undef PG8_WAIT_V
#undef PG8_WAIT_L
#undef PG8_BAR
#undef PG8_SCHED
}
}

#define DEV __device__ __forceinline__
#define LAS __attribute__((address_space(3)))
typedef unsigned short bf16_t;
typedef short bf16x8 __attribute__((ext_vector_type(8)));
typedef float f32x4 __attribute__((ext_vector_type(4)));
typedef float f32x2 __attribute__((ext_vector_type(2)));
typedef float f32x16 __attribute__((ext_vector_type(16)));
typedef unsigned u32x4 __attribute__((ext_vector_type(4)));
typedef unsigned u32x2 __attribute__((ext_vector_type(2)));

constexpr int R = 16896, RB = 8448, NCTX = 256, TL = 8192, DM = 1024, INW = 1696, DFF = 2816, HFF = 1408;
constexpr int NWG_T = 512;
constexpr float EPS = 1e-6f;
constexpr int LDS_BYTES = 147456;
constexpr size_t OFF_X = 0, OFF_HN = 69206016, OFF_W = 103809024, OFF_MOD = 152174592, OFF_ROPE = 152436736, OFF_OV = 153485312;
constexpr size_t OV_Q = 0, OV_KN = 25952256, OV_VT = 43253760, OV_SLOC = 60555264, OV_SIN = 69206016, OV_U = 0;
constexpr size_t OFF_PART = 250100224;
constexpr size_t OFF_EDGE = 258488832;
constexpr size_t WS_NEED = OFF_EDGE + 5947392;
constexpr size_t W_IN = 0, W_UQ = 1835008, W_KN = 2129920, W_V = 2260992, W_OUT = 2392064, W_UP = 3440640, W_DN = 9207808, W_LAYER = 12091392;

struct Params {
    const float *x, *c, *ctx, *c_ctx, *w_mod, *b_mod, *norm1_g, *w_in, *ret_decay_f, *ret_decay_b, *mla_q_norm_g, *w_uq, *mla_kv_norm_g, *w_ukv,
        *pool_w, *pool_scale, *w_out, *norm2_g, *w_up, *conv_w, *conv_b, *w_down, *final_norm_g;
    float* out; unsigned char* ws; int ph_lo, ph_hi;
};

DEV int otid() { int t = threadIdx.x; asm volatile("" : "+v"(t)); return t; }
DEV float bf2f(unsigned short x) { return __uint_as_float((unsigned)x << 16); }
DEV unsigned f2bf(float f) { unsigned u = __float_as_uint(f); return (u + 0x7fffu + ((u >> 16) & 1u)) >> 16; }
DEV unsigned pk2(float lo, float hi) { return f2bf(lo) | (f2bf(hi) << 16); }
DEV float wave_sum(float v) {
#pragma unroll
    for (int o = 1; o < 64; o <<= 1) v += __shfl_xor(v, o);
    return v;
}
DEV float siluf(float x) { return x * __builtin_amdgcn_rcpf(1.0f + __builtin_amdgcn_exp2f(-1.4426950408889634f * x)); }
DEV int crow(int r, int hi) { return (r & 3) + 8 * (r >> 2) + 4 * hi; }
DEV bf16x8 pack8(float a0, float a1, float a2, float a3, float a4, float a5, float a6, float a7) {
    u32x4 w; w.x = pg8::cvt_pk_bf16(a0, a1); w.y = pg8::cvt_pk_bf16(a2, a3); w.z = pg8::cvt_pk_bf16(a4, a5); w.w = pg8::cvt_pk_bf16(a6, a7);
    return __builtin_bit_cast(bf16x8, w);
}
DEV int row_mi(int r) { const int b = r / RB; const int s = r - b * RB; return s < NCTX ? 2 : b; }

DEV void transpose_item(const float* W, int K, int Nsrc, bf16_t* WT, int n0, int cs, int k0, float* scr, int lane) {
#pragma unroll
    for (int i = 0; i < 32; ++i) { const int kk = 2 * i + (lane >> 5); scr[kk * 33 + (lane & 31)] = cs >= 0 ? W[(size_t)(k0 + kk) * Nsrc + cs + (lane & 31)] : 0.f; }
    asm volatile("s_waitcnt lgkmcnt(0)" ::: "memory");
    const int c = lane & 7;
#pragma unroll
    for (int j = 0; j < 4; ++j) { const int n = (lane >> 3) + 8 * j; const float* s = scr + (8 * c) * 33 + n;
        u32x4 o; o.x = pk2(s[0 * 33], s[1 * 33]); o.y = pk2(s[2 * 33], s[3 * 33]); o.z = pk2(s[4 * 33], s[5 * 33]); o.w = pk2(s[6 * 33], s[7 * 33]);
        *(u32x4*)(WT + (size_t)(n0 + n) * K + k0 + 8 * c) = o; }
    asm volatile("s_waitcnt lgkmcnt(0)" ::: "memory");
}
DEV int map_in(int n0) { return n0 < 1440 ? n0 : (n0 < INW ? -2 : -1); }
DEV int map_kn(int n0) { return (n0 >> 6) * 128 + (n0 & 63); }
DEV int map_v(int n0) { return (n0 >> 6) * 128 + 64 + (n0 & 63); }
DEV int map_up(int n0) { const int pn = n0 >> 8, w = n0 & 255; return w < 128 ? 128 * pn + w : DFF + 128 * pn + (w - 128); }

DEV void phase_prep(const Params& p, unsigned char* lds) {
    const int tid = otid(), lane = tid & 63, wid = tid >> 6;
    unsigned char* ws = p.ws;
    { f32x2* rope = (f32x2*)(ws + OFF_ROPE);
      for (int idx = blockIdx.x * NWG_T + tid; idx < TL * 16; idx += gridDim.x * NWG_T) { const int t = idx >> 4, i = idx & 15; const int pos = i < 8 ? (t >> 6) : (t & 63);
          const float inv = exp2f(-(float)(i & 7) * 0.125f * 13.287712379549449f); const float ang = (float)pos * inv; f32x2 cs; cs.x = __cosf(ang); cs.y = __sinf(ang); rope[idx] = cs; } }
    { float* scv = (float*)lds;
      float* red = scv + 3 * 1024;
      for (int i = tid; i < 3 * 1024; i += NWG_T) { const int v = i >> 10, k = i & 1023; const float cv = v < 2 ? p.c[v * 1024 + k] : p.c_ctx[k]; scv[i] = siluf(cv); }
      __syncthreads();
      float* modv = (float*)(ws + OFF_MOD);
      for (int it = blockIdx.x; it < 192; it += gridDim.x) { const int l = it / 96, col0 = (it % 96) * 64;
          const float* wm = p.w_mod + (size_t)l * 1024 * 6144 + col0 + lane; float a0 = 0.f, a1 = 0.f, a2 = 0.f;
#pragma unroll 16
          for (int k = wid * 128; k < wid * 128 + 128; ++k) { const float w = wm[(size_t)k * 6144]; a0 += scv[k] * w; a1 += scv[1024 + k] * w; a2 += scv[2048 + k] * w; }
          red[(wid * 3 + 0) * 64 + lane] = a0; red[(wid * 3 + 1) * 64 + lane] = a1; red[(wid * 3 + 2) * 64 + lane] = a2;
          __syncthreads();
          if (tid < 192) { const int v = tid >> 6, cl = tid & 63; float s = 0.f;
#pragma unroll
              for (int w = 0; w < 8; ++w) s += red[(w * 3 + v) * 64 + cl];
              modv[((size_t)l * 3 + v) * 6144 + col0 + cl] = s + p.b_mod[l * 6144 + col0 + cl]; }
          __syncthreads(); }
    }
}
DEV void phase_prep_weights(const Params& p, unsigned char* lds) {
    const int tid = otid(), lane = tid & 63, wid = tid >> 6;
    unsigned char* ws = p.ws;
    { float* scr = (float*)(lds + 32768 + wid * 8704);
      const int gw = blockIdx.x * 8 + wid, NGW = gridDim.x * 8;
      constexpr int I_IN = 16 * 56, I_UQ = 6 * 24, I_KN = 4 * 16, I_V = 4 * 16, I_OUT = 16 * 32, I_UP = 16 * 176, I_DN = 44 * 32, I_L = I_IN + I_UQ + I_KN + I_V + I_OUT + I_UP + I_DN;
      for (int it = gw; it < 2 * I_L; it += NGW) { const int l = it / I_L; int r = it - l * I_L; bf16_t* wl = (bf16_t*)(ws + OFF_W) + (size_t)l * W_LAYER;
          const float* src; int K, Nsrc, nbn, mp; size_t doff;
          if (r < I_IN) { src = p.w_in + (size_t)l * 1024 * INW; K = 1024; Nsrc = INW; nbn = 56; mp = 1; doff = W_IN; }
          else if ((r -= I_IN) < I_UQ) { src = p.w_uq + (size_t)l * 384 * 768; K = 384; Nsrc = 768; nbn = 24; mp = 0; doff = W_UQ; }
          else if ((r -= I_UQ) < I_KN) { src = p.w_ukv + (size_t)l * 256 * 1024; K = 256; Nsrc = 1024; nbn = 16; mp = 2; doff = W_KN; }
          else if ((r -= I_KN) < I_V) { src = p.w_ukv + (size_t)l * 256 * 1024; K = 256; Nsrc = 1024; nbn = 16; mp = 3; doff = W_V; }
          else if ((r -= I_V) < I_OUT) { src = p.w_out + (size_t)l * 1024 * 1024; K = 1024; Nsrc = 1024; nbn = 32; mp = 0; doff = W_OUT; }
          else if ((r -= I_OUT) < I_UP) { src = p.w_up + (size_t)l * 1024 * 5632; K = 1024; Nsrc = 5632; nbn = 176; mp = 4; doff = W_UP; }
          else { r -= I_UP; src = p.w_down + (size_t)l * DFF * 1024; K = DFF; Nsrc = 1024; nbn = 32; mp = 0; doff = W_DN; }
          const int kb = r / nbn, nb = r - kb * nbn, n0 = nb * 32;
          const int cs = mp == 0 ? n0 : mp == 1 ? map_in(n0) : mp == 2 ? map_kn(n0) : mp == 3 ? map_v(n0) : map_up(n0);
          if (cs != -2) transpose_item(src, K, Nsrc, wl + doff, n0, cs, kb * 64, scr, lane); }
    }
    { for (int idx = blockIdx.x * NWG_T + tid; idx < 2 * 1024 * 256; idx += gridDim.x * NWG_T) { const int n = idx & 255, k = (idx >> 8) & 1023, l = idx >> 18; const int g = n >> 6, d = n & 63;
          const float* wr = p.w_in + ((size_t)l * 1024 + k) * INW + 1440 + g * 64; const float* pw = p.pool_w + ((size_t)(l * 4 + g) * 64) * 64 + d; float s = 0.f;
#pragma unroll 8
          for (int c = 0; c < 64; ++c) s += wr[c] * pw[c * 64];
          ((bf16_t*)(ws + OFF_W) + (size_t)l * W_LAYER + W_IN)[(size_t)(1440 + n) * 1024 + k] = (bf16_t)f2bf(s * p.pool_scale[l * 256 + n]); } }
}

DEV void phase_norm(const Params& p, int l, int which, bool first, const float* pgate) {
    const int tid = otid(); const int lane = tid & 63, wid = tid >> 6; const int gw = blockIdx.x * 8 + wid, NGW = gridDim.x * 8;
    float* X = (float*)(p.ws + OFF_X); bf16_t* HN = (bf16_t*)(p.ws + OFF_HN);
    const float* modv = (const float*)(p.ws + OFF_MOD) + (size_t)l * 3 * 6144;
    const float* g = (which == 0 ? p.norm1_g : p.norm2_g) + l * 1024;
    for (int r = gw; r < R; r += NGW) {
        const int b = r / RB, s = r - b * RB; const int mi = s < NCTX ? 2 : b;
        const float* src = first ? (s < NCTX ? p.ctx + ((size_t)b * NCTX + s) * 1024 : p.x + ((size_t)b * TL + (s - NCTX)) * 1024) : X + (size_t)r * 1024;
        const f32x4* xr = (const f32x4*)src + lane; f32x4 v[4]; float ss = 0.f;
#pragma unroll
        for (int j = 0; j < 4; ++j) { v[j] = xr[64 * j]; ss += (v[j].x * v[j].x + v[j].y * v[j].y) + (v[j].z * v[j].z + v[j].w * v[j].w); }
        if (pgate != nullptr && s < NCTX) { const float* PART = (const float*)(p.ws + OFF_PART) + (size_t)(b * NCTX + s) * 1024; ss = 0.f;
#pragma unroll
            for (int j = 0; j < 4; ++j) { const f32x4 gq = ((const f32x4*)pgate)[lane + 64 * j]; f32x4 a = ((const f32x4*)PART)[lane + 64 * j];
#pragma unroll
                for (int q = 1; q < 4; ++q) a = a + ((const f32x4*)(PART + (size_t)q * 524288))[lane + 64 * j];
                v[j] = v[j] + gq * a; ss += (v[j].x * v[j].x + v[j].y * v[j].y) + (v[j].z * v[j].z + v[j].w * v[j].w); } }
        if (first || (pgate != nullptr && s < NCTX)) { f32x4* xo = (f32x4*)(X + (size_t)r * 1024) + lane;
#pragma unroll
            for (int j = 0; j < 4; ++j) xo[64 * j] = v[j]; }
        const float rs = rsqrtf(wave_sum(ss) * (1.f / 1024.f) + EPS);
        const float* mv = modv + mi * 6144 + (which == 0 ? 0 : 3072);
        u32x2* o8 = (u32x2*)(HN + (size_t)r * 1024) + lane;
#pragma unroll
        for (int j = 0; j < 4; ++j) { const f32x4 gg = ((const f32x4*)g)[lane + 64 * j], sh = ((const f32x4*)mv)[lane + 64 * j], sc = ((const f32x4*)(mv + 1024))[lane + 64 * j];
            const f32x4 y = v[j] * rs * gg; const f32x4 h = y * (sc + 1.0f) + sh; u32x2 w; w.x = pk2(h.x, h.y); w.y = pk2(h.z, h.w); o8[64 * j] = w; }
    }
}
DEV void phase_final(const Params& p) {
    const int tid = otid(); const int lane = tid & 63, wid = tid >> 6; const int gw = blockIdx.x * 8 + wid, NGW = gridDim.x * 8;
    const float* X = (const float*)(p.ws + OFF_X);
    for (int q = gw; q < 2 * TL; q += NGW) { const int b = q / TL, t = q - b * TL; const int r = b * RB + NCTX + t;
        const f32x4* xr = (const f32x4*)(X + (size_t)r * 1024) + lane; f32x4 v[4]; float ss = 0.f;
#pragma unroll
        for (int j = 0; j < 4; ++j) { v[j] = xr[64 * j]; ss += (v[j].x * v[j].x + v[j].y * v[j].y) + (v[j].z * v[j].z + v[j].w * v[j].w); }
        const float rs = rsqrtf(wave_sum(ss) * (1.f / 1024.f) + EPS);
        f32x4* o = (f32x4*)(p.out + (size_t)q * 1024) + lane;
#pragma unroll
        for (int j = 0; j < 4; ++j) { const f32x4 gg = ((const f32x4*)p.final_norm_g)[lane + 64 * j]; o[64 * j] = v[j] * rs * gg; } }
}

DEV void phase_rowwise(const Params& p, int l) {
    const int tid = otid(); const int lane = tid & 63, wid = tid >> 6; const int gw = blockIdx.x * 8 + wid, NGW = gridDim.x * 8;
    bf16_t* P = (bf16_t*)p.out; const f32x2* rope = (const f32x2*)(p.ws + OFF_ROPE);
    const float* qg = p.mla_q_norm_g + l * 384; const float* kg = p.mla_kv_norm_g + l * 256;
    float qgv[6];
#pragma unroll
    for (int j = 0; j < 3; ++j) { qgv[2 * j] = qg[2 * (lane + 64 * j)]; qgv[2 * j + 1] = qg[2 * (lane + 64 * j) + 1]; }
    const f32x4 kgv = ((const f32x4*)kg)[lane];
    for (int r0 = gw; r0 < R; r0 += 2 * NGW) {
        unsigned wq[2][3]; u32x2 wk[2]; float x1[2], x2[2]; f32x2 cs[2]; bool val[2], lat[2];
#pragma unroll
        for (int i = 0; i < 2; ++i) { const int r = r0 + i * NGW; val[i] = r < R; const int rr = val[i] ? r : r0; bf16_t* pr = P + (size_t)rr * INW; const int s = rr % RB; lat[i] = s >= NCTX;
            const unsigned* q2 = (const unsigned*)(pr + 768) + lane;
#pragma unroll
            for (int j = 0; j < 3; ++j) wq[i][j] = q2[64 * j];
            wk[i] = *((const u32x2*)(pr + 1152) + lane);
            const int li = lane & 15; x1[i] = bf2f(pr[1408 + li]); x2[i] = bf2f(pr[1408 + 16 + li]); cs[i] = rope[(lat[i] ? s - NCTX : 0) * 16 + li]; }
#pragma unroll
        for (int i = 0; i < 2; ++i) { if (!val[i]) continue; const int r = r0 + i * NGW; bf16_t* pr = P + (size_t)r * INW;
            { float ss = 0.f;
#pragma unroll
              for (int j = 0; j < 3; ++j) { const float a = bf2f(wq[i][j] & 0xffff), c2 = bf2f(wq[i][j] >> 16); ss += a * a + c2 * c2; }
              const float rs = rsqrtf(wave_sum(ss) * (1.f / 384.f) + EPS); unsigned* q2 = (unsigned*)(pr + 768) + lane;
#pragma unroll
              for (int j = 0; j < 3; ++j) q2[64 * j] = pk2(bf2f(wq[i][j] & 0xffff) * rs * qgv[2 * j], bf2f(wq[i][j] >> 16) * rs * qgv[2 * j + 1]); }
            { const float a0 = bf2f(wk[i].x & 0xffff), a1 = bf2f(wk[i].x >> 16), a2 = bf2f(wk[i].y & 0xffff), a3 = bf2f(wk[i].y >> 16);
              const float rs = rsqrtf(wave_sum((a0 * a0 + a1 * a1) + (a2 * a2 + a3 * a3)) * (1.f / 256.f) + EPS);
              u32x2 o; o.x = pk2(a0 * rs * kgv.x, a1 * rs * kgv.y); o.y = pk2(a2 * rs * kgv.z, a3 * rs * kgv.w); *((u32x2*)(pr + 1152) + lane) = o; }
            if (lat[i] && lane < 16) { pr[1408 + lane] = (bf16_t)f2bf(x1[i] * cs[i].x - x2[i] * cs[i].y); pr[1408 + 16 + lane] = (bf16_t)f2bf(x2[i] * cs[i].x + x1[i] * cs[i].y); } }
    }
}

DEV void phase_pool(const Params& p) {
    const int tid = otid(); const bf16_t* P = (const bf16_t*)p.out; bf16_t* MIX = (bf16_t*)(p.ws + OFF_HN);
    for (int idx = blockIdx.x * NWG_T + tid; idx < R * 32; idx += gridDim.x * NWG_T) { const int r = idx >> 5, cg = idx & 31; const int half = 1 << (cg >> 3);
        const int b = r / RB, s = r - b * RB; const int seq0 = s < NCTX ? b * RB : b * RB + NCTX; const int T = s < NCTX ? NCTX : TL; const int t = r - seq0;
        const int lo = max(t - half, 0), hi = min(t + half, T); float sum[8];
#pragma unroll
        for (int j = 0; j < 8; ++j) sum[j] = 0.f;
        const bf16_t* base = P + (size_t)seq0 * INW + 1440 + cg * 8;
        { bf16x8 wv[16]; const bf16x8 zz = {0, 0, 0, 0, 0, 0, 0, 0};
#pragma unroll
          for (int k = 0; k < 16; ++k) { const int tt = t - 8 + k; wv[k] = (tt >= lo && tt < hi) ? *(const bf16x8*)(base + (size_t)tt * INW) : zz; }
#pragma unroll
          for (int k = 0; k < 16; ++k)
#pragma unroll
              for (int j = 0; j < 8; ++j) sum[j] += bf2f((unsigned short)wv[k][j]); }
        const bf16x8 me = *(const bf16x8*)(base + (size_t)t * INW); const float ic = 1.0f / (float)(hi - lo); float o[8];
#pragma unroll
        for (int j = 0; j < 8; ++j) o[j] = sum[j] * ic - bf2f((unsigned short)me[j]);
        *(bf16x8*)(MIX + (size_t)r * 1024 + 768 + cg * 8) = pack8(o[0], o[1], o[2], o[3], o[4], o[5], o[6], o[7]); }
}

DEV float log2_sigmoid(float d) { return -log1pf(__expf(-d)) * 1.4426950408889634f; }
constexpr int ST_P = 272;
DEV void states_item(const Params& p, int l, unsigned char* lds, int it) {
    const int tid = otid(), lane = tid & 63, wid = tid >> 6, l32 = lane & 31, hi = lane >> 5;
    const bf16_t* P = (const bf16_t*)p.out; const f32x2* rope = (const f32x2*)(p.ws + OFF_ROPE);
    float* SLOC = (float*)(p.ws + OFF_OV + OV_SLOC);
    const int gc = it >> 1, hp = it & 1;
    unsigned char* VTl = lds;
    unsigned char* KTl = lds + 2 * 64 * ST_P;
    const int cb = gc % 66; const bool lat = cb >= 2; const int t0 = (cb - 2) * 128; const int r0 = gc * 128;
    __syncthreads();
    { const int tok = tid >> 2, hh = (tid >> 1) & 1, c = tid & 1; const int h = 2 * hp + hh;
      const bf16_t* src = P + (size_t)(r0 + tok) * INW + 128 + h * 32 + 8 * c; const bf16x8 lo = *(const bf16x8*)src, hi8 = *(const bf16x8*)(src + 16);
      const float df = exp2f(log2_sigmoid(p.ret_decay_f[l * 4 + h]) * (float)(127 - tok)) * 0.17677669529663687f, db = exp2f(log2_sigmoid(p.ret_decay_b[l * 4 + h]) * (float)tok) * 0.17677669529663687f;
#pragma unroll
      for (int j = 0; j < 8; ++j) { float x1 = bf2f((unsigned short)lo[j]), x2 = bf2f((unsigned short)hi8[j]);
          if (lat) { const f32x2 cs = rope[(t0 + tok) * 16 + 8 * c + j]; const float y1 = x1 * cs.x - x2 * cs.y, y2 = x2 * cs.x + x1 * cs.y; x1 = y1; x2 = y2; }
          bf16_t* kf = (bf16_t*)(KTl + ((hh * 2 + 0) * 32 + 8 * c + j) * ST_P) + tok; bf16_t* kb = (bf16_t*)(KTl + ((hh * 2 + 1) * 32 + 8 * c + j) * ST_P) + tok;
          kf[0] = (bf16_t)f2bf(x1 * df); kb[0] = (bf16_t)f2bf(x1 * db);
          *(bf16_t*)((unsigned char*)kf + 16 * ST_P) = (bf16_t)f2bf(x2 * df); *(bf16_t*)((unsigned char*)kb + 16 * ST_P) = (bf16_t)f2bf(x2 * db); } }
    for (int task = tid; task < 2048; task += NWG_T) { const int hh = task >> 10, tok = (task >> 3) & 127, ch = task & 7;
        const bf16x8 v = *(const bf16x8*)(P + (size_t)(r0 + tok) * INW + 256 + (2 * hp + hh) * 64 + ch * 8);
#pragma unroll
        for (int j = 0; j < 8; ++j) *((bf16_t*)(VTl + (hh * 64 + ch * 8 + j) * ST_P) + tok) = (bf16_t)v[j]; }
    __syncthreads();
    { const int hh = wid >> 2, dir = (wid >> 1) & 1, dvb = wid & 1; const int h = 2 * hp + hh;
      const unsigned char* ap = VTl + (hh * 64 + 32 * dvb + l32) * ST_P + hi * 16; const unsigned char* bp = KTl + ((hh * 2 + dir) * 32 + l32) * ST_P + hi * 16;
      bf16x8 af[8], bfr[8];
#pragma unroll
      for (int ks = 0; ks < 8; ++ks) { af[ks] = *(const bf16x8*)(ap + ks * 32); bfr[ks] = *(const bf16x8*)(bp + ks * 32); }
      f32x16 acc;
#pragma unroll
      for (int r = 0; r < 16; ++r) acc[r] = 0.f;
#pragma unroll
      for (int ks = 0; ks < 8; ++ks) acc = __builtin_amdgcn_mfma_f32_32x32x16_bf16(af[ks], bfr[ks], acc, 0, 0, 0);
      float* o = SLOC + ((size_t)(gc * 4 + h) * 2 + dir) * 2048 + l32 * 64 + 32 * dvb + 4 * hi;
#pragma unroll
      for (int g4 = 0; g4 < 4; ++g4) *(f32x4*)(o + 8 * g4) = (f32x4){acc[4 * g4], acc[4 * g4 + 1], acc[4 * g4 + 2], acc[4 * g4 + 3]}; }
}
DEV void scan_threads(const Params& p, int l, int gid) {
    if (gid >= 32768) return;
    const int e = gid & 2047, dir = (gid >> 11) & 1, h = (gid >> 12) & 3, b = gid >> 14;
    const float* SLOC = (const float*)(p.ws + OFF_OV + OV_SLOC); float* SIN = (float*)(p.ws + OFF_OV + OV_SIN);
    const float gC = exp2f(log2_sigmoid((dir == 0 ? p.ret_decay_f : p.ret_decay_b)[l * 4 + h]) * 128.f);
    float S = 0.f;
#pragma unroll 11
    for (int st = 0; st < 66; ++st) { const int cb = dir == 0 ? st : (st < 2 ? 1 - st : 67 - st); const size_t idx = ((size_t)((b * 66 + cb) * 4 + h) * 2 + dir) * 2048 + e;
        const float v = SLOC[idx]; SIN[idx] = S; S = S * gC + v; }
}

constexpr int AT_KP = 208, AT_VP = 144, AT_KB = 64 * AT_KP, AT_VBS = 64 * AT_VP, AT_V0 = 4 * AT_KB;
DEV float at_max32(const f32x16& s0, const f32x16& s1) {
    float m0 = __builtin_fmaxf(__builtin_fmaxf(s0[0], s0[1]), s0[2]), m1 = __builtin_fmaxf(__builtin_fmaxf(s1[0], s1[1]), s1[2]);
    m0 = __builtin_fmaxf(__builtin_fmaxf(m0, s0[3]), s0[4]); m1 = __builtin_fmaxf(__builtin_fmaxf(m1, s1[3]), s1[4]);
    m0 = __builtin_fmaxf(__builtin_fmaxf(m0, s0[5]), s0[6]); m1 = __builtin_fmaxf(__builtin_fmaxf(m1, s1[5]), s1[6]);
    m0 = __builtin_fmaxf(__builtin_fmaxf(m0, s0[7]), s0[8]); m1 = __builtin_fmaxf(__builtin_fmaxf(m1, s1[7]), s1[8]);
    m0 = __builtin_fmaxf(__builtin_fmaxf(m0, s0[9]), s0[10]); m1 = __builtin_fmaxf(__builtin_fmaxf(m1, s1[9]), s1[10]);
    m0 = __builtin_fmaxf(__builtin_fmaxf(m0, s0[11]), s0[12]); m1 = __builtin_fmaxf(__builtin_fmaxf(m1, s1[11]), s1[12]);
    m0 = __builtin_fmaxf(__builtin_fmaxf(m0, s0[13]), s0[14]); m1 = __builtin_fmaxf(__builtin_fmaxf(m1, s1[13]), s1[14]);
    return __builtin_fmaxf(__builtin_fmaxf(m0, s0[15]), __builtin_fmaxf(m1, s1[15]));
}
DEV void attn_unit(const Params& p, unsigned char* lds, int u) {
    const int tid = otid(), lane = tid & 63, wid = tid >> 6, l32 = lane & 31, hi = lane >> 5;
    const bf16_t* Q = (const bf16_t*)(p.ws + OFF_OV + OV_Q); const bf16_t* KN = (const bf16_t*)(p.ws + OFF_OV + OV_KN); const bf16_t* VT = (const bf16_t*)(p.ws + OFF_OV + OV_VT);
    const bf16_t* P = (const bf16_t*)p.out; bf16_t* MIX = (bf16_t*)(p.ws + OFF_HN); const f32x2* rope = (const f32x2*)(p.ws + OFF_ROPE);
    const bool isctx = u >= 512; int b, h, qrow0, NT;
    if (!isctx) { b = u >> 8; h = (u >> 5) & 7; qrow0 = b * RB + NCTX + (u & 31) * 256; NT = 132; } else { const int v = u - 512; b = v >> 3; h = v & 7; qrow0 = b * RB; NT = 4; }
    const int krow0 = b * RB; const int qrow = qrow0 + wid * 32 + l32;
    bf16x8 qf[6];
    { const bf16_t* qp = Q + (size_t)qrow * 768 + h * 96 + hi * 8;
#pragma unroll
      for (int d0 = 0; d0 < 6; ++d0) qf[d0] = *(const bf16x8*)(qp + d0 * 16);
      if (!isctx) { const f32x2* rp = rope + (size_t)(qrow - (b * RB + NCTX)) * 16 + hi * 8;
#pragma unroll
          for (int j = 0; j < 8; ++j) { const f32x2 cs = rp[j]; const float x1 = bf2f((unsigned short)qf[4][j]), x2 = bf2f((unsigned short)qf[5][j]);
              qf[4][j] = (short)f2bf(x1 * cs.x - x2 * cs.y); qf[5][j] = (short)f2bf(x2 * cs.x + x1 * cs.y); } } }
    const bf16_t* sp[3]; int sstep[3], lo[3];
#pragma unroll
    for (int k = 0; k < 2; ++k) { const int c = tid + k * 512; const int key = c / 12, part = c - key * 12; lo[k] = key * AT_KP + part * 16;
        if (part < 8) { sp[k] = KN + (size_t)(krow0 + key) * 512 + h * 64 + part * 8; sstep[k] = 64 * 512; } else { sp[k] = P + (size_t)(krow0 + key) * INW + 1408 + (part - 8) * 8; sstep[k] = 64 * INW; } }
    { const int dv = tid >> 3, kc = tid & 7; lo[2] = dv * AT_VP + (kc >> 1) * 32 + (kc & 1) * 8;   sp[2] = VT + (size_t)(h * 64 + dv) * R + krow0 + kc * 8; sstep[2] = 64; }
    const bool hasK2 = tid < 256;
    u32x4 st[3];
#define AT_GLOADK() do { st[0] = *(const u32x4*)sp[0]; sp[0] += sstep[0]; if (hasK2) { st[1] = *(const u32x4*)sp[1]; sp[1] += sstep[1]; } } while (0)
#define AT_GLOADV() do { st[2] = *(const u32x4*)sp[2]; sp[2] += sstep[2]; } while (0)
#define AT_LSTOREK(buf) do { *(u32x4*)((buf) + lo[0]) = st[0]; if (hasK2) *(u32x4*)((buf) + lo[1]) = st[1]; } while (0)
#define AT_LSTOREV(buf) do { unsigned char* d_ = (buf) + lo[2]; *(u32x2*)d_ = (u32x2){st[2].x, st[2].y}; *(u32x2*)(d_ + 16) = (u32x2){st[2].z, st[2].w}; } while (0)
#define AT_SB() __builtin_amdgcn_sched_barrier(0)
    f32x16 o0, o1, sa0, sa1, sb0, sb1, negm;
#pragma unroll
    for (int r = 0; r < 16; ++r) { o0[r] = 0.f; o1[r] = 0.f; sa0[r] = 0.f; sa1[r] = 0.f; negm[r] = 0.f; }
    float mrun = 0.f, lsum = 0.f;
    __syncthreads();
    AT_GLOADK(); AT_GLOADV(); AT_LSTOREK(lds); AT_LSTOREV(lds + AT_V0);
    AT_GLOADK(); AT_GLOADV(); AT_LSTOREK(lds + AT_KB); AT_LSTOREV(lds + AT_V0 + AT_VBS);
    AT_GLOADK(); AT_LSTOREK(lds + 2 * AT_KB);
    __syncthreads();
    { const unsigned char* ka = lds + l32 * AT_KP + hi * 16;
#pragma unroll
      for (int d0 = 0; d0 < 6; ++d0) { const bf16x8 a0 = *(const bf16x8*)(ka + d0 * 32), a1 = *(const bf16x8*)(ka + 32 * AT_KP + d0 * 32);
          sa0 = __builtin_amdgcn_mfma_f32_32x32x16_bf16(a0, qf[d0], sa0, 0, 0, 0); sa1 = __builtin_amdgcn_mfma_f32_32x32x16_bf16(a1, qf[d0], sa1, 0, 0, 0); } }
#define AT_STEP(SA0, SA1, SB0, SB1, tt) do { \
        const int t_ = (tt); const bool nxt_ = t_ + 1 < NT; \
        const unsigned char* kb_ = lds + ((t_ + 1) & 3) * AT_KB; const unsigned char* vb_ = lds + AT_V0 + (t_ & 3) * AT_VBS; \
        if (t_ + 3 < NT) AT_GLOADK(); \
        if (t_ + 2 < NT) AT_GLOADV(); \
        bf16x8 kfr[12]; bf16x8 vfr[8]; \
        { const unsigned char* ka = kb_ + l32 * AT_KP + hi * 16; \
          _Pragma("unroll") for (int d0 = 0; d0 < 6; ++d0) { kfr[2 * d0] = *(const bf16x8*)(ka + d0 * 32); kfr[2 * d0 + 1] = *(const bf16x8*)(ka + 32 * AT_KP + d0 * 32); } } \
        { const float mx = mxc; \
          if (t_ == 0 || __any(mx > 8.0f)) { \
              const float rm = fmaxf(mx, __shfl_xor(mx, 32)); const float delta = (t_ == 0) ? rm : fmaxf(rm, 0.f); const float alpha = (t_ == 0) ? 1.0f : __builtin_amdgcn_exp2f(-delta); \
              mrun += delta; \
              _Pragma("unroll") for (int r = 0; r < 16; ++r) { SA0[r] -= delta; SA1[r] -= delta; o0[r] *= alpha; o1[r] *= alpha; } \
              lsum *= alpha; { const float nm = -mrun; _Pragma("unroll") for (int r = 0; r < 16; ++r) negm[r] = nm; } } } \
        float ls0 = 0.f, ls1 = 0.f; \
        AT_SB(); __builtin_amdgcn_s_setprio(1); \
        _Pragma("unroll") for (int i = 0; i < 8; ++i) { \
            if (i == 0) SB0 = __builtin_amdgcn_mfma_f32_32x32x16_bf16(kfr[0], qf[0], negm, 0, 0, 0); else if (i == 1) SB1 = __builtin_amdgcn_mfma_f32_32x32x16_bf16(kfr[1], qf[0], negm, 0, 0, 0); \
            else if (i & 1) SB1 = __builtin_amdgcn_mfma_f32_32x32x16_bf16(kfr[i], qf[i >> 1], SB1, 0, 0, 0); else SB0 = __builtin_amdgcn_mfma_f32_32x32x16_bf16(kfr[i], qf[i >> 1], SB0, 0, 0, 0); \
            SA0[2 * i] = __builtin_amdgcn_exp2f(SA0[2 * i]); SA0[2 * i + 1] = __builtin_amdgcn_exp2f(SA0[2 * i + 1]); SA1[2 * i] = __builtin_amdgcn_exp2f(SA1[2 * i]); SA1[2 * i + 1] = __builtin_amdgcn_exp2f(SA1[2 * i + 1]); \
            ls0 += SA0[2 * i] + SA0[2 * i + 1]; ls1 += SA1[2 * i] + SA1[2 * i + 1]; \
            AT_SB(); } \
        { const unsigned char* va = vb_ + l32 * AT_VP + hi * 16; \
          _Pragma("unroll") for (int kj = 0; kj < 4; ++kj) { vfr[2 * kj] = *(const bf16x8*)(va + kj * 32); vfr[2 * kj + 1] = *(const bf16x8*)(va + 32 * AT_VP + kj * 32); } } \
        bf16x8 pb[4]; \
        _Pragma("unroll") for (int i = 8; i < 12; ++i) { const int kj = i - 8; const int jp = kj & 1; \
            if (i & 1) SB1 = __builtin_amdgcn_mfma_f32_32x32x16_bf16(kfr[i], qf[i >> 1], SB1, 0, 0, 0); else SB0 = __builtin_amdgcn_mfma_f32_32x32x16_bf16(kfr[i], qf[i >> 1], SB0, 0, 0, 0); \
            if (kj < 2) pb[kj] = pack8(SA0[8 * jp + 0], SA0[8 * jp + 1], SA0[8 * jp + 2], SA0[8 * jp + 3], SA0[8 * jp + 4], SA0[8 * jp + 5], SA0[8 * jp + 6], SA0[8 * jp + 7]); \
            else        pb[kj] = pack8(SA1[8 * jp + 0], SA1[8 * jp + 1], SA1[8 * jp + 2], SA1[8 * jp + 3], SA1[8 * jp + 4], SA1[8 * jp + 5], SA1[8 * jp + 6], SA1[8 * jp + 7]); \
            AT_SB(); } \
        lsum += ls0 + ls1; \
        float mq0 = SB0[0], mq1 = SB1[0]; __builtin_amdgcn_s_setprio(2); \
        _Pragma("unroll") for (int kj = 0; kj < 4; ++kj) { \
            o0 = __builtin_amdgcn_mfma_f32_32x32x16_bf16(vfr[2 * kj], pb[kj], o0, 0, 0, 0); o1 = __builtin_amdgcn_mfma_f32_32x32x16_bf16(vfr[2 * kj + 1], pb[kj], o1, 0, 0, 0); \
            mq0 = __builtin_fmaxf(__builtin_fmaxf(mq0, SB0[4 * kj]), SB0[4 * kj + 1]); mq1 = __builtin_fmaxf(__builtin_fmaxf(mq1, SB1[4 * kj]), SB1[4 * kj + 1]); \
            mq0 = __builtin_fmaxf(__builtin_fmaxf(mq0, SB0[4 * kj + 2]), SB0[4 * kj + 3]); mq1 = __builtin_fmaxf(__builtin_fmaxf(mq1, SB1[4 * kj + 2]), SB1[4 * kj + 3]); \
            AT_SB(); } \
        __builtin_amdgcn_s_setprio(0); mxc = __builtin_fmaxf(mq0, mq1);            \
        if (t_ + 3 < NT) AT_LSTOREK(lds + ((t_ + 3) & 3) * AT_KB); \
        if (t_ + 2 < NT) AT_LSTOREV(lds + AT_V0 + ((t_ + 2) & 3) * AT_VBS); \
        if (t_ & 1) __syncthreads(); \
    } while (0)
    float mxc = at_max32(sa0, sa1);
    for (int t = 0; t < NT; t += 2) { AT_STEP(sa0, sa1, sb0, sb1, t); AT_STEP(sb0, sb1, sa0, sa1, t + 1); }
    lsum += __shfl_xor(lsum, 32);
    const float inv = 1.0f / lsum;
    bf16_t* op = MIX + (size_t)qrow * 1024 + 256 + h * 64 + 4 * hi;
#pragma unroll
    for (int g4 = 0; g4 < 4; ++g4) { u32x2 w0, w1; w0.x = pk2(o0[4 * g4] * inv, o0[4 * g4 + 1] * inv); w0.y = pk2(o0[4 * g4 + 2] * inv, o0[4 * g4 + 3] * inv);
        w1.x = pk2(o1[4 * g4] * inv, o1[4 * g4 + 1] * inv); w1.y = pk2(o1[4 * g4 + 2] * inv, o1[4 * g4 + 3] * inv);
        *(u32x2*)(op + 8 * g4) = w0; *(u32x2*)(op + 32 + 8 * g4) = w1; }
#undef AT_GLOADK
#undef AT_GLOADV
#undef AT_LSTOREK
#undef AT_LSTOREV
#undef AT_STEP
#undef AT_SB
}

constexpr int RT_VP = 264, RT_SP = 144, RT_VB = 2 * 64 * RT_VP;
DEV void retout_unit(const Params& p, int l, unsigned char* lds, int u) {
    const int tid = otid(), lane = tid & 63, wid = tid >> 6, l32 = lane & 31, hi = lane >> 5;
    const int gc = u >> 1, hp = u & 1; const int cb = gc % 66; const bool lat = cb >= 2; const int t0 = (cb - 2) * 128; const int r0 = gc * 128;
    const bf16_t* P = (const bf16_t*)p.out; bf16_t* MIX = (bf16_t*)(p.ws + OFF_HN); const f32x2* rope = (const f32x2*)(p.ws + OFF_ROPE);
    const float* SIN = (const float*)(p.ws + OFF_OV + OV_SIN);
    bf16_t* VTl = (bf16_t*)lds; bf16_t* STl = (bf16_t*)(lds + RT_VB);
    __syncthreads();
    for (int task = tid; task < 2048; task += NWG_T) { const int hh = task >> 10, key = (task >> 3) & 127, ch = task & 7;
        const bf16x8 v = *(const bf16x8*)(P + (size_t)(r0 + key) * INW + 256 + (2 * hp + hh) * 64 + ch * 8);
#pragma unroll
        for (int j = 0; j < 8; ++j) VTl[(hh * 64 + ch * 8 + j) * (RT_VP / 2) + key] = (bf16_t)v[j]; }
    for (int task = tid; task < 8192; task += NWG_T) { const int dv = task & 63, k = (task >> 6) & 31, dir = (task >> 11) & 1, hh = task >> 12;
        STl[(hh * 64 + dv) * (RT_SP / 2) + dir * 32 + k] = (bf16_t)f2bf(SIN[((size_t)(gc * 4 + 2 * hp + hh) * 2 + dir) * 2048 + k * 64 + dv]); }
    __syncthreads();
    const int hh = wid >> 2, h = 2 * hp + hh, qblk = wid & 3; const int n = 32 * qblk + l32; const int rq = r0 + n;
    const float lf = log2_sigmoid(p.ret_decay_f[l * 4 + h]), lb = log2_sigmoid(p.ret_decay_b[l * 4 + h]);
    float qv0[8], qv1[8]; bf16x8 qf0, qf1;
    { const bf16_t* qp = P + (size_t)rq * INW + h * 32 + 8 * hi; const bf16x8 a = *(const bf16x8*)qp, c2 = *(const bf16x8*)(qp + 16);
#pragma unroll
      for (int j = 0; j < 8; ++j) { float x1 = bf2f((unsigned short)a[j]), x2 = bf2f((unsigned short)c2[j]);
          if (lat) { const f32x2 cs = rope[(size_t)(t0 + n) * 16 + 8 * hi + j]; const float y1 = x1 * cs.x - x2 * cs.y, y2 = x2 * cs.x + x1 * cs.y; x1 = y1; x2 = y2; }
          qv0[j] = x1; qv1[j] = x2; }
      qf0 = pack8(qv0[0], qv0[1], qv0[2], qv0[3], qv0[4], qv0[5], qv0[6], qv0[7]); qf1 = pack8(qv1[0], qv1[1], qv1[2], qv1[3], qv1[4], qv1[5], qv1[6], qv1[7]); }
    f32x16 o0, o1;
#pragma unroll
    for (int r = 0; r < 16; ++r) { o0[r] = 0.f; o1[r] = 0.f; }
    const unsigned char* vbase = (const unsigned char*)VTl + (size_t)(hh * 64 + l32) * RT_VP + hi * 8;
    bf16x8 kga[4], kgc[4];
#pragma unroll
    for (int kb = 0; kb < 4; ++kb) { const bf16_t* kp = P + (size_t)(r0 + 32 * kb + l32) * INW + 128 + h * 32 + 8 * hi; kga[kb] = *(const bf16x8*)kp; kgc[kb] = *(const bf16x8*)(kp + 16); }
    __builtin_amdgcn_sched_barrier(0);
#pragma unroll
    for (int kb = 0; kb < 4; ++kb) {
        bf16x8 kf0, kf1;
        { const int key = 32 * kb + l32; const bf16x8 a = kga[kb], c2 = kgc[kb];
          float y1[8], y2[8];
#pragma unroll
          for (int j = 0; j < 8; ++j) { float x1 = bf2f((unsigned short)a[j]), x2 = bf2f((unsigned short)c2[j]);
              if (lat) { const f32x2 cs = rope[(size_t)(t0 + key) * 16 + 8 * hi + j]; const float z1 = x1 * cs.x - x2 * cs.y, z2 = x2 * cs.x + x1 * cs.y; x1 = z1; x2 = z2; }
              y1[j] = x1 * 0.17677669529663687f; y2[j] = x2 * 0.17677669529663687f; }
          kf0 = pack8(y1[0], y1[1], y1[2], y1[3], y1[4], y1[5], y1[6], y1[7]); kf1 = pack8(y2[0], y2[1], y2[2], y2[3], y2[4], y2[5], y2[6], y2[7]); }
        f32x16 s;
#pragma unroll
        for (int r = 0; r < 16; ++r) s[r] = 0.f;
        s = __builtin_amdgcn_mfma_f32_32x32x16_bf16(kf0, qf0, s, 0, 0, 0); s = __builtin_amdgcn_mfma_f32_32x32x16_bf16(kf1, qf1, s, 0, 0, 0);
#pragma unroll
        for (int r = 0; r < 16; ++r) { const int m = 32 * kb + crow(r, hi); const int dl = n - m; const float e = dl >= 0 ? lf * (float)dl : lb * (float)(-dl); s[r] *= __builtin_amdgcn_exp2f(e); }
#pragma unroll
        for (int jp = 0; jp < 2; ++jp) { const bf16x8 pb = pack8(s[8 * jp + 0], s[8 * jp + 1], s[8 * jp + 2], s[8 * jp + 3], s[8 * jp + 4], s[8 * jp + 5], s[8 * jp + 6], s[8 * jp + 7]);
            const unsigned char* vp = vbase + (32 * kb + 16 * jp) * 2;
            const u32x2 a00 = *(const u32x2*)vp, a01 = *(const u32x2*)(vp + 16), a10 = *(const u32x2*)(vp + 32 * RT_VP), a11 = *(const u32x2*)(vp + 32 * RT_VP + 16);
            const bf16x8 A0 = __builtin_bit_cast(bf16x8, (u32x4){a00.x, a00.y, a01.x, a01.y}), A1 = __builtin_bit_cast(bf16x8, (u32x4){a10.x, a10.y, a11.x, a11.y});
            o0 = __builtin_amdgcn_mfma_f32_32x32x16_bf16(A0, pb, o0, 0, 0, 0); o1 = __builtin_amdgcn_mfma_f32_32x32x16_bf16(A1, pb, o1, 0, 0, 0); }
    }
    { const float df = __builtin_amdgcn_exp2f(lf * (float)(n + 1)), db = __builtin_amdgcn_exp2f(lb * (float)(128 - n));
      const unsigned char* sbase = (const unsigned char*)STl + (size_t)(hh * 64 + l32) * RT_SP + hi * 16;
#pragma unroll
      for (int ks = 0; ks < 4; ++ks) { const float dd = ks < 2 ? df : db;
          const bf16x8 qb = (ks & 1) ? pack8(qv1[0] * dd, qv1[1] * dd, qv1[2] * dd, qv1[3] * dd, qv1[4] * dd, qv1[5] * dd, qv1[6] * dd, qv1[7] * dd)
                                     : pack8(qv0[0] * dd, qv0[1] * dd, qv0[2] * dd, qv0[3] * dd, qv0[4] * dd, qv0[5] * dd, qv0[6] * dd, qv0[7] * dd);
          const bf16x8 A0 = *(const bf16x8*)(sbase + ks * 32), A1 = *(const bf16x8*)(sbase + 32 * RT_SP + ks * 32);
          o0 = __builtin_amdgcn_mfma_f32_32x32x16_bf16(A0, qb, o0, 0, 0, 0); o1 = __builtin_amdgcn_mfma_f32_32x32x16_bf16(A1, qb, o1, 0, 0, 0); } }
    float ssq = 0.f;
#pragma unroll
    for (int r = 0; r < 16; ++r) ssq += o0[r] * o0[r] + o1[r] * o1[r];
    ssq += __shfl_xor(ssq, 32);
    const float rstd = rsqrtf(ssq * (1.f / 64.f) + EPS);
    const bf16_t* gp = P + (size_t)rq * INW + 512 + h * 64 + 4 * hi; bf16_t* op = MIX + (size_t)rq * 1024 + h * 64 + 4 * hi;
#pragma unroll
    for (int g4 = 0; g4 < 4; ++g4) { const u32x2 ga = *(const u32x2*)(gp + 8 * g4), gb = *(const u32x2*)(gp + 32 + 8 * g4);
        u32x2 w0, w1;
        w0.x = pk2(o0[4 * g4] * rstd * siluf(bf2f(ga.x & 0xffff)), o0[4 * g4 + 1] * rstd * siluf(bf2f(ga.x >> 16))); w0.y = pk2(o0[4 * g4 + 2] * rstd * siluf(bf2f(ga.y & 0xffff)), o0[4 * g4 + 3] * rstd * siluf(bf2f(ga.y >> 16)));
        w1.x = pk2(o1[4 * g4] * rstd * siluf(bf2f(gb.x & 0xffff)), o1[4 * g4 + 1] * rstd * siluf(bf2f(gb.x >> 16))); w1.y = pk2(o1[4 * g4 + 2] * rstd * siluf(bf2f(gb.y & 0xffff)), o1[4 * g4 + 3] * rstd * siluf(bf2f(gb.y >> 16)));
        *(u32x2*)(op + 8 * g4) = w0; *(u32x2*)(op + 32 + 8 * g4) = w1; }
}

DEV void phase_ffn_fixup(const Params& p, int l) {
    const float* EDGE = (const float*)(p.ws + OFF_EDGE); bf16_t* ACT = (bf16_t*)(p.ws + OFF_OV);
    const float* cw = p.conv_w + (size_t)l * 3 * 5632; const float* cbv = p.conv_b + (size_t)l * 5632;
    for (int idx = blockIdx.x * NWG_T + otid(); idx < 66 * 2 * 704; idx += gridDim.x * NWG_T) {
        const int ch4 = idx % 704, rest = idx / 704; const int which = rest & 1, pm = rest >> 1; const int jj = pm % 33;
        if (l == 1 && jj == 0) continue;
        const int ch = 4 * ch4, pn = ch >> 7, c = ch & 127;
        const bool sstart = jj <= 1, send = (jj == 0) || (jj == 32);
        const f32x4 zz = {0.f, 0.f, 0.f, 0.f};
#define EDG(tile, k, half) (*(const f32x4*)(EDGE + ((size_t)((tile) * 4 + (k)) * 22 + pn) * 256 + (half) * 128 + c))
        f32x4 ua, ub, ca, cb2, da, db;
        if (which == 0) { ua = sstart ? zz : EDG(pm - 1, 3, 0); ub = sstart ? zz : EDG(pm - 1, 3, 1); ca = EDG(pm, 0, 0); cb2 = EDG(pm, 0, 1); da = EDG(pm, 1, 0); db = EDG(pm, 1, 1); }
        else { ua = EDG(pm, 2, 0); ub = EDG(pm, 2, 1); ca = EDG(pm, 3, 0); cb2 = EDG(pm, 3, 1); da = send ? zz : EDG(pm + 1, 0, 0); db = send ? zz : EDG(pm + 1, 0, 1); }
#undef EDG
        const f32x4 wa0 = *(const f32x4*)(cw + ch), wa1 = *(const f32x4*)(cw + 5632 + ch), wa2 = *(const f32x4*)(cw + 2 * 5632 + ch), ba = *(const f32x4*)(cbv + ch);
        const f32x4 wb0 = *(const f32x4*)(cw + DFF + ch), wb1 = *(const f32x4*)(cw + 5632 + DFF + ch), wb2 = *(const f32x4*)(cw + 2 * 5632 + DFF + ch), bb = *(const f32x4*)(cbv + DFF + ch);
        const f32x4 xa = wa0 * ua + wa1 * ca + wa2 * da + ba, xb = wb0 * ub + wb1 * cb2 + wb2 * db + bb;
        u32x2 w; w.x = pk2(siluf(xa.x) * xb.x, siluf(xa.y) * xb.y); w.y = pk2(siluf(xa.z) * xb.z, siluf(xa.w) * xb.w);
        *(u32x2*)(ACT + (size_t)(pm * 256 + (which ? 255 : 0)) * DFF + ch) = w;
    }
}

#define RLX_AGENT __ATOMIC_RELAXED, __HIP_MEMORY_SCOPE_AGENT
#define XB_TMO      128
#define XB_XCNT(j)  (256  + 64 * (j))
#define XB_XSUB(j)  (1280 + 64 * (j))
#define XB_XGEN(j)  (2304 + 64 * (j))
#define XB_TOP      3328
#define XB_TOPGEN   3392
#define XCD_BAR_WORDS 3456
#define XB_SPIN_CAP (1u << 18)

__device__ __forceinline__ unsigned xb_ld(unsigned* p)              { return __hip_atomic_load(p, __ATOMIC_RELAXED, __HIP_MEMORY_SCOPE_AGENT); }
__device__ __forceinline__ unsigned xb_add(unsigned* p, unsigned v) { return __hip_atomic_fetch_add(p, v, __ATOMIC_RELAXED, __HIP_MEMORY_SCOPE_AGENT); }
__device__ __forceinline__ unsigned xb_xcc_id() { return (unsigned)__builtin_amdgcn_s_getreg((3 << 11) | 20) & 0xFu; }
#define XB_SPIN(cond, bar) do { unsigned _sp = 0; while (cond) { __builtin_amdgcn_s_sleep(1); \
    if ((++_sp & 255u) == 0u) { if (xb_ld(&(bar)[XB_TMO])) break; if (_sp > XB_SPIN_CAP) { atomicAdd(&(bar)[XB_TMO], 1u); break; } } } } while (0)

struct XcdBarrier {
    unsigned* bar; unsigned x;
    volatile LAS unsigned* st;
};

__device__ __forceinline__ XcdBarrier xcd_barrier_post(unsigned* bar, volatile LAS unsigned* st) {
    XcdBarrier b; b.bar = bar; b.x = xb_xcc_id(); b.st = st;
    if (threadIdx.x == 0) (void)xb_add(&bar[XB_XCNT(b.x)], 1u);
    return b;
}
__device__ __forceinline__ void xcd_barrier_complete(unsigned* bar, unsigned x, unsigned& nloc, unsigned& nx) {
    const unsigned G = gridDim.x * gridDim.y * gridDim.z;
    unsigned sum, cnt, mine, sp = 0u;
    for (;;) {
        sum = 0u; cnt = 0u; mine = 0u;
#pragma unroll
        for (unsigned j = 0; j < 16; ++j) { const unsigned c = xb_ld(&bar[XB_XCNT(j)]); sum += c; cnt += (c > 0u) ? 1u : 0u; mine = (j == x) ? c : mine; }
        if (sum == G) break;
        __builtin_amdgcn_s_sleep(1);
        if ((++sp & 255u) == 0u) { if (xb_ld(&bar[XB_TMO])) break; if (sp > XB_SPIN_CAP) { atomicAdd(&bar[XB_TMO], 1u); break; } }
    }
    nloc = mine > 0u ? mine : 1u; nx = cnt > 0u ? cnt : 1u;
}

__device__ __forceinline__ void xcd_barrier(const XcdBarrier& b) {
    asm volatile("s_waitcnt vmcnt(0)" ::: "memory");
    __syncthreads();
    if (threadIdx.x == 0) {
        unsigned* bar = b.bar;
        __builtin_amdgcn_s_waitcnt(0);
        unsigned nloc = b.st[0], nx = b.st[1];
        if (nloc == 0u) { xcd_barrier_complete(bar, b.x, nloc, nx); b.st[0] = nloc; b.st[1] = nx; }
        const unsigned old = xb_add(&bar[XB_XSUB(b.x)], 1u);
        const unsigned gen = old / nloc;
        if (old + 1u == (gen + 1u) * nloc) {
            __builtin_amdgcn_fence(__ATOMIC_RELEASE, "agent");
            asm volatile("s_waitcnt vmcnt(0)" ::: "memory");
            const unsigned og = xb_add(&bar[XB_TOP], 1u);
            const unsigned tg = og / nx;
            if (og + 1u == (tg + 1u) * nx) xb_add(&bar[XB_TOPGEN], 1u);
            else XB_SPIN(xb_ld(&bar[XB_TOPGEN]) == tg, bar);
            __builtin_amdgcn_fence(__ATOMIC_ACQUIRE, "agent");
            xb_add(&bar[XB_XGEN(b.x)], 1u);
            asm volatile("s_waitcnt vmcnt(0)" ::: "memory");
        } else {
            XB_SPIN(xb_ld(&bar[XB_XGEN(b.x)]) == gen, bar);
            __builtin_amdgcn_fence(__ATOMIC_ACQUIRE, "agent");
            asm volatile("s_waitcnt vmcnt(0)" ::: "memory");
        }
    }
    __syncthreads();
}


constexpr size_t OFF_CTL = 250000128; constexpr int CTL_BYTES = 16384;
#if defined(__HIP_DEVICE_COMPILE__)
#define KP() const __attribute__((address_space(4))) Params* kp_ = (const __attribute__((address_space(4))) Params*)__builtin_amdgcn_kernarg_segment_ptr(); asm volatile("" : "+s"(kp_)); const Params p = *kp_; \
    bf16_t* HN = (bf16_t*)(p.ws + OFF_HN); bf16_t* P = (bf16_t*)p.out; float* X = (float*)(p.ws + OFF_X); (void)HN; (void)P; (void)X
#else
#define KP() const Params p = p_arg; bf16_t* HN = (bf16_t*)(p.ws + OFF_HN); bf16_t* P = (bf16_t*)p.out; float* X = (float*)(p.ws + OFF_X); (void)HN; (void)P; (void)X
#endif
#define WL() const bf16_t* wl = (const bf16_t*)(p.ws + OFF_W) + (size_t)l * W_LAYER; const float* modv = (const float*)(p.ws + OFF_MOD) + (size_t)l * 3 * 6144; (void)wl; (void)modv
#ifndef DUPM
#define DUPM 0
#endif
#define REP(bit) for (int rep_ = 0; rep_ < (((DUPM) >> (bit)) & 1) + 1; ++rep_)
constexpr int PH_PER_LAYER = 10, N_PHASES = 2 + 2 * PH_PER_LAYER;
__global__ void __launch_bounds__(512, 2) mk_fwd(Params p_arg) {
    extern __shared__ __attribute__((aligned(16))) unsigned char lds[];
    cg::grid_group grid = cg::this_grid();
    const int G = gridDim.x, bx = blockIdx.x; const int vcu = (G % 8 == 0) ? (bx % 8) * (G / 8) + bx / 8 : bx;
    LAS unsigned char* ldsl = (LAS unsigned char*)lds;
    const int ph_lo = p_arg.ph_lo, ph_hi = p_arg.ph_hi;
    volatile LAS unsigned* misc = (volatile LAS unsigned*)(ldsl + (LDS_BYTES - 64));
    { const int t0_ = otid(); if (t0_ < 16) misc[t0_] = 0u; }
    __syncthreads();
    if (ph_hi - ph_lo > 1) (void)xcd_barrier_post((unsigned*)(p_arg.ws + OFF_CTL), misc);
    for (int ph = ph_lo; ph < ph_hi; ++ph) {
        if (ph == 0) { KP(); phase_prep(p, lds); __syncthreads(); }
        else if (ph == N_PHASES - 1) { KP(); phase_final(p);
#if (DUPM >> 10) & 1
            for (int i = 0; i < 20; ++i) grid.sync();
#endif
        }
        else {
            const int l = (ph - 1) / PH_PER_LAYER, sp = (ph - 1) % PH_PER_LAYER;
            if (sp == 0) { KP(); if (l == 0) REP(9) { phase_prep_weights(p, lds); __syncthreads(); }
                phase_norm(p, l, 0, l == 0, l == 1 ? (const float*)(p.ws + OFF_MOD) + 2 * 6144 + 5120 : nullptr); }
            else if (sp == 1) { KP(); WL(); REP(1) { __syncthreads();
                pg8::Gemm g{HN, wl + W_IN, R, 1792, 1024, 1024, 1024}; pg8::StaticOrder S; S.init(R, 1792, G, bx);
                pg8::EpiStore E{P, INW, INW, 1.0f};
                pg8::gemm_phase<pg8::EpiStore, pg8::StaticOrder, true, true>(ldsl, g, S, E); } }
            else if (sp == 2) { KP(); phase_rowwise(p, l); __syncthreads();
                REP(2) phase_pool(p);
                REP(3) for (int it = G - 1 - bx; it < 264; it += G) states_item(p, l, lds, it); __syncthreads(); }
            else if (sp == 3) { KP(); WL(); REP(4) { __syncthreads();
                { pg8::Gemm g{P + 768, wl + W_UQ, R, 768, 384, INW, 384}; pg8::StaticOrder S; S.init(R, 768, G, bx);
                  pg8::EpiStore E{(bf16_t*)(p.ws + OFF_OV + OV_Q), 768, 768, 0.14724444f};
                  pg8::gemm_phase<pg8::EpiStore, pg8::StaticOrder, true, true>(ldsl, g, S, E); }
                __syncthreads();
                { pg8::Gemm g{P + 1152, wl + W_KN, R, 512, 256, INW, 256}; pg8::StaticOrder S; S.init(R, 512, G, (bx + 58) % G);
                  pg8::EpiStore E{(bf16_t*)(p.ws + OFF_OV + OV_KN), 512, 512, 1.0f};
                  pg8::gemm_phase<pg8::EpiStore, pg8::StaticOrder, true, true>(ldsl, g, S, E); }
                __syncthreads();
                { pg8::Gemm g{wl + W_V, P + 1152, 512, R, 256, 256, INW}; pg8::StaticOrder S; S.init(512, R, G, (bx + 182) % G);
                  pg8::EpiStore E{(bf16_t*)(p.ws + OFF_OV + OV_VT), R, R, 1.0f};
                  pg8::gemm_phase<pg8::EpiStore, pg8::StaticOrder, true, true>(ldsl, g, S, E); }
                if (bx >= G - 64) scan_threads(p, l, (bx - (G - 64)) * NWG_T + otid()); } }
            else if (sp == 4) { KP();
                REP(5) for (int u = vcu; u < (l == 0 ? 528 : 512); u += G) attn_unit(p, lds, u);
                REP(6) for (int u = G - 1 - bx; u < (l == 0 ? 264 : 256); u += G) retout_unit(p, l, lds, l == 0 ? u : u + 4 * (u >> 7) + 4); }
            else if (sp == 5) { KP(); WL(); __syncthreads();
                { pg8::Gemm g{HN, wl + W_OUT, R, 1024, 1024, 1024, 1024}; pg8::StaticOrder S; S.init(16384, 1024, G, bx, 1);
                  pg8::EpiResid E{X, modv + 2048, 0};
                  pg8::gemm_phase<pg8::EpiResid, pg8::StaticOrder, true, true>(ldsl, g, S, E); }
                if (l == 0 && bx < 32) { __syncthreads(); const int q = bx >> 3;
                  pg8::Gemm g{HN + q * 256, wl + W_OUT + q * 256, 512, 1024, 256, 1024, 1024}; pg8::StaticOrder S; S.init(512, 1024, G, bx & 7, 2);
                  pg8::EpiPart E{(float*)(p.ws + OFF_PART) + (size_t)q * 524288, 0};
                  pg8::gemm_phase<pg8::EpiPart, pg8::StaticOrder, true, true>(ldsl, g, S, E); } }
            else if (sp == 6) { KP(); WL(); phase_norm(p, l, 1, false, l == 0 ? modv + 2 * 6144 + 2048 : nullptr); }
            else if (sp == 7) { KP(); WL(); REP(7) { __syncthreads();
                pg8::Gemm g{HN, wl + W_UP, R, 2 * DFF, 1024, 1024, 1024}; pg8::StaticOrder S; S.init(l == 1 ? 16384 : R, 2 * DFF, G, bx, l == 1 ? 1 : 0);
                pg8::EpiFfn E{(bf16_t*)(p.ws + OFF_OV), (float*)(p.ws + OFF_EDGE), p.conv_w + (size_t)l * 3 * 5632, p.conv_b + (size_t)l * 5632, (LAS float*)(ldsl + 131072)};
                pg8::gemm_phase<pg8::EpiFfn, pg8::StaticOrder, true, true>(ldsl, g, S, E); } }
            else if (sp == 8) { KP(); REP(8) phase_ffn_fixup(p, l); }
            else if (sp == 9) { KP(); WL(); __syncthreads();
                { pg8::Gemm g{(const bf16_t*)(p.ws + OFF_OV), wl + W_DN, R, 1024, DFF, DFF, DFF}; pg8::StaticOrder S; S.init(16384, 1024, G, bx, 1);
                  pg8::EpiResid E{X, modv + 5120, 0};
                  pg8::gemm_phase<pg8::EpiResid, pg8::StaticOrder, true, true>(ldsl, g, S, E); }
                if (l == 0 && bx < 32) { __syncthreads(); const int q = bx >> 3; const int koff = q < 2 ? q * 768 : 1536 + (q - 2) * 640, klen = q < 2 ? 768 : 640;
                  pg8::Gemm g{(const bf16_t*)(p.ws + OFF_OV) + koff, wl + W_DN + koff, 512, 1024, klen, DFF, DFF}; pg8::StaticOrder S; S.init(512, 1024, G, bx & 7, 2);
                  pg8::EpiPart E{(float*)(p.ws + OFF_PART) + (size_t)q * 524288, 0};
                  pg8::gemm_phase<pg8::EpiPart, pg8::StaticOrder, true, true>(ldsl, g, S, E); } }
        }
        if (ph + 1 < ph_hi) {
            if (ph_lo < 0) grid.sync();
            { KP(); XcdBarrier b; b.bar = (unsigned*)(p.ws + OFF_CTL); b.x = xb_xcc_id(); b.st = misc; xcd_barrier(b); }
        }
    }
}

extern "C" void kernel_launch(void* const* d_in, const int* in_sizes, int n_in, void* d_out, int out_size, void* d_ws, size_t ws_size, hipStream_t stream) {
    static int grid = 0;
    if (grid == 0) {
        if (n_in != 23 || ws_size < WS_NEED) { fprintf(stderr, "kernel_launch: unexpected problem (n_in %d, ws %zu, need %zu)\n", n_in, ws_size, (size_t)WS_NEED); grid = -1; return; }
        int dev = 0, cus = 0, per_cu = 0;
        hipGetDevice(&dev); hipDeviceGetAttribute(&cus, hipDeviceAttributeMultiprocessorCount, dev);
        if (hipFuncSetAttribute((const void*)mk_fwd, hipFuncAttributeMaxDynamicSharedMemorySize, LDS_BYTES) != hipSuccess) { fprintf(stderr, "kernel_launch: hipFuncSetAttribute failed\n"); grid = -1; return; }
        if (hipOccupancyMaxActiveBlocksPerMultiprocessor(&per_cu, (const void*)mk_fwd, 512, LDS_BYTES) != hipSuccess || per_cu < 1) { fprintf(stderr, "kernel_launch: occupancy query says %d\n", per_cu); per_cu = 1; }
        (void)hipGetLastError();
        grid = cus * per_cu; if (grid > 256) grid = 256;
        fprintf(stderr, "kernel_launch: grid %d (cus %d, per_cu %d)\n", grid, cus, per_cu);
    }
    if (grid < 0) return;
    Params p{};
    const float** pp = (const float**)&p;
    for (int i = 0; i < 23; ++i) pp[i] = (const float*)d_in[i];
    p.out = (float*)d_out; p.ws = (unsigned char*)d_ws;
#if MK_MULTI
    for (int ph = 0; ph < N_PHASES; ++ph) { p.ph_lo = ph; p.ph_hi = ph + 1; void* args[] = {&p};
        hipError_t e = hipLaunchCooperativeKernel((void*)mk_fwd, dim3(grid), dim3(512), args, LDS_BYTES, stream);
        if (e != hipSuccess) { fprintf(stderr, "launch %d failed: %s\n", ph, hipGetErrorString(e)); break; } }
#else
    if (hipMemsetAsync((char*)d_ws + OFF_CTL, 0, CTL_BYTES, stream) != hipSuccess) { fprintf(stderr, "kernel_launch: memset of the barrier words failed\n"); return; }
    p.ph_lo = 0; p.ph_hi = N_PHASES; void* args[] = {&p};
    hipError_t e = hipLaunchCooperativeKernel((void*)mk_fwd, dim3(grid), dim3(512), args, LDS_BYTES, stream);
    if (e != hipSuccess) fprintf(stderr, "cooperative launch failed: %s (grid %d)\n", hipGetErrorString(e), grid);
#endif
}
```

```cpp
#include <hip/hip_runtime.h>
#include <hip/hip_cooperative_groups.h>
#include <cstdio>
#include <cstdint>
namespace cg = cooperative_groups;

#ifndef MK_MULTI
#define MK_MULTI 0
#endif

namespace pg8 {
#define PG8_LAS __attribute__((address_space(3)))
typedef unsigned short bf16_t;
typedef short bf16x8 __attribute__((ext_vector_type(8)));
typedef float f32x4 __attribute__((ext_vector_type(4)));
typedef unsigned u32x4 __attribute__((ext_vector_type(4)));
constexpr int BM = 256, BK = 64, HALF = 128, HTB = HALF * BK * 2  , STAGE_BYTES = 8 * HTB, NXCD = 8, WGM = 8;

__host__ __device__ __forceinline__ int lds_byte(int r, int c) { const int st = (r >> 4) * 2 + (c >> 5), rr = r & 15, cc = c & 31, ob = rr * 64 + cc * 2; return st * 1024 + (ob ^ (((ob >> 9) & 1) << 5)); }
__host__ __device__ __forceinline__ void stage_rc(int b, int& R, int& C) { const int st = b / 1024, sb = b % 1024, swz = sb ^ (((sb >> 9) & 1) << 5); R = (st >> 1) * 16 + swz / 64; C = (st & 1) * 32 + (swz % 64) / 2; }
__host__ __device__ __forceinline__ int perm32(int rho) { const int n = rho >> 4, i = rho & 15; return 8 * (i >> 2) + 4 * n + (i & 3); }

struct Unit { int pm, pn; };
struct Gemm { const bf16_t* A; const bf16_t* Bt; int M, N, K, lda, ldb; };

struct StaticOrder {
    int nM, nN, nwg, G, c, skip;
    __host__ __device__ void init(int M, int N, int G_, int c_, int skip_ = 0) { nM = M / BM; nN = N / BM; nwg = nM * nN; G = G_; c = c_; skip = skip_; }
    __host__ __device__ bool next(int i, Unit& u) const {
        const long L = (long)i * G + c; if (L >= nwg) return false;
        int wgid = (int)L; { const int q = nwg / NXCD, r = nwg % NXCD, xcd = wgid % NXCD, off = wgid / NXCD; wgid = (xcd < r ? xcd * (q + 1) : r * (q + 1) + (xcd - r) * q) + off; }
        const int nig = WGM * nN, gid = wgid / nig, fm = gid * WGM, gsz = (nM - fm) < WGM ? (nM - fm) : WGM;
        u.pm = fm + ((wgid % nig) % gsz); u.pn = (wgid % nig) / gsz; if (skip == 1) u.pm += 1 + (u.pm >= 32 ? 1 : 0); else if (skip == 2) u.pm *= 33; return true;
    }
    __device__ __forceinline__ void a_ready(const Unit&) const {}
    __device__ __forceinline__ void done(const Unit&) const {}
};

__device__ __forceinline__ unsigned cvt_pk_bf16(float lo, float hi) { unsigned r; asm volatile("v_cvt_pk_bf16_f32 %0, %1, %2" : "=v"(r) : "v"(lo), "v"(hi)); return r; }

struct EpiStore {
    static constexpr bool PERM = true, AFTER_DRAIN = false;
    bf16_t* O; int ldc; int ncols; float scale;
    __device__ __forceinline__ void operator()(const f32x4 (&acc)[2][2][4][2], const Unit& u, int wr, int wc, int fr, int fq) const {
        const int row0 = u.pm * BM + wr * 64 + fr; const int col0 = u.pn * BM + wc * 32 + 8 * fq;
#pragma unroll
        for (int ai = 0; ai < 2; ++ai)
#pragma unroll
            for (int m = 0; m < 4; ++m) { bf16_t* rowp = O + (size_t)(row0 + ai * HALF + m * 16) * ldc + col0;
#pragma unroll
                for (int bj = 0; bj < 2; ++bj) { if (col0 + bj * HALF < ncols) {
                    f32x4 v0 = acc[ai][bj][m][0] * scale, v1 = acc[ai][bj][m][1] * scale;
                    u32x4 w; w.x = cvt_pk_bf16(v0[0], v0[1]); w.y = cvt_pk_bf16(v0[2], v0[3]); w.z = cvt_pk_bf16(v1[0], v1[1]); w.w = cvt_pk_bf16(v1[2], v1[3]);
                    *(u32x4*)(rowp + bj * HALF) = w; } } }
    }
};
struct EpiResid {
    static constexpr bool PERM = false, AFTER_DRAIN = false;
    float* X; const float* gate; int row_tile0;
    __device__ __forceinline__ void operator()(const f32x4 (&acc)[2][2][4][2], const Unit& u, int wr, int wc, int fr, int fq) const {
        const int tpm = u.pm + row_tile0; const int bb = tpm / 33, jj = tpm - bb * 33; const float* gv = gate + (jj == 0 ? 2 : bb) * 6144;
        const int col0 = u.pn * BM + wc * 32 + 4 * fq;
#pragma unroll
        for (int ai = 0; ai < 2; ++ai)
#pragma unroll
            for (int m = 0; m < 4; ++m) { float* rowp = X + (size_t)(tpm * BM + ai * HALF + wr * 64 + m * 16 + fr) * 1024 + col0;
#pragma unroll
                for (int bj = 0; bj < 2; ++bj) {
#pragma unroll
                    for (int n = 0; n < 2; ++n) { f32x4* q = (f32x4*)(rowp + bj * HALF + n * 16); const f32x4 gq = *(const f32x4*)(gv + col0 + bj * HALF + n * 16); f32x4 xv = *q; xv = xv + gq * acc[ai][bj][m][n]; *q = xv; }
                    asm volatile("" ::: "memory"); } }
    }
};
struct EpiPart {
    static constexpr bool PERM = false, AFTER_DRAIN = false;
    float* out; int accum;
    __device__ __forceinline__ void operator()(const f32x4 (&acc)[2][2][4][2], const Unit& u, int wr, int wc, int fr, int fq) const {
        const int t = u.pm / 33; const int col0 = u.pn * BM + wc * 32 + 4 * fq;
#pragma unroll
        for (int ai = 0; ai < 2; ++ai)
#pragma unroll
            for (int m = 0; m < 4; ++m) { float* rowp = out + (size_t)(t * BM + ai * HALF + wr * 64 + m * 16 + fr) * 1024 + col0;
#pragma unroll
                for (int bj = 0; bj < 2; ++bj) {
#pragma unroll
                    for (int n = 0; n < 2; ++n) { f32x4* q = (f32x4*)(rowp + bj * HALF + n * 16); f32x4 v = acc[ai][bj][m][n]; if (accum) v = v + *q; *q = v; }
                    asm volatile("" ::: "memory"); } }
    }
};
template <int CTRL> __device__ __forceinline__ float dpp0(float x) { return __builtin_bit_cast(float, __builtin_amdgcn_update_dpp(0, __builtin_bit_cast(int, x), CTRL, 0xf, 0xf, true)); }
struct EpiFfn {
    static constexpr bool PERM = false, AFTER_DRAIN = false;
    bf16_t* ACT; float* EDGE; const float* cw; const float* cb; PG8_LAS float* xl;
    __device__ __forceinline__ void operator()(const f32x4 (&acc)[2][2][4][2], const Unit& u, int wr, int wc, int fr, int fq) const {
        PG8_LAS float* FIRST = xl; PG8_LAS float* LAST = xl + 1024;
        const int cb0 = wc * 32 + 4 * fq;
#pragma unroll
        for (int ai = 0; ai < 2; ++ai)
#pragma unroll
            for (int bj = 0; bj < 2; ++bj)
#pragma unroll
                for (int n = 0; n < 2; ++n) { const int col = bj * HALF + cb0 + n * 16;
                    if (fr == 0) *(PG8_LAS f32x4*)(FIRST + (2 * ai + wr) * 256 + col) = acc[ai][bj][0][n];
                    if (fr == 15) *(PG8_LAS f32x4*)(LAST + (2 * ai + wr) * 256 + col) = acc[ai][bj][3][n]; }
        if (wr == 0 && fr < 2) {
#pragma unroll
            for (int bj = 0; bj < 2; ++bj)
#pragma unroll
                for (int n = 0; n < 2; ++n) *(f32x4*)(EDGE + ((size_t)(u.pm * 4 + fr) * 22 + u.pn) * 256 + bj * HALF + cb0 + n * 16) = acc[0][bj][0][n]; }
        if (wr == 1 && fr >= 14) {
#pragma unroll
            for (int bj = 0; bj < 2; ++bj)
#pragma unroll
                for (int n = 0; n < 2; ++n) *(f32x4*)(EDGE + ((size_t)(u.pm * 4 + 2 + (fr - 14)) * 22 + u.pn) * 256 + bj * HALF + cb0 + n * 16) = acc[1][bj][3][n]; }
        asm volatile("s_waitcnt lgkmcnt(0)" ::: "memory"); __builtin_amdgcn_s_barrier(); asm volatile("" ::: "memory");
#pragma unroll
        for (int n = 0; n < 2; ++n) { const int ch0 = u.pn * HALF + cb0 + n * 16;
            f32x4 wa[3], wb[3];
#pragma unroll
            for (int k = 0; k < 3; ++k) { wa[k] = *(const f32x4*)(cw + k * 5632 + ch0); wb[k] = *(const f32x4*)(cw + k * 5632 + 2816 + ch0); }
            const f32x4 ba = *(const f32x4*)(cb + ch0), bb = *(const f32x4*)(cb + 2816 + ch0);
#pragma unroll
            for (int ai = 0; ai < 2; ++ai) { const int g = 2 * ai + wr;
                f32x4 bu[2], bd[2];
#pragma unroll
                for (int bj = 0; bj < 2; ++bj) { const int col = bj * HALF + cb0 + n * 16; const f32x4 zz = {0.f, 0.f, 0.f, 0.f};
                    bu[bj] = g > 0 ? *(const PG8_LAS f32x4*)(LAST + (g - 1) * 256 + col) : zz; bd[bj] = g < 3 ? *(const PG8_LAS f32x4*)(FIRST + (g + 1) * 256 + col) : zz; }
#pragma unroll
                for (int m = 0; m < 4; ++m) { float o[4];
#pragma unroll
                    for (int e = 0; e < 4; ++e) { float up[2], dn[2];
#pragma unroll
                        for (int bj = 0; bj < 2; ++bj) { const float cur = acc[ai][bj][m][n][e];
                            float x = dpp0<0x111>(cur);
                            if (m > 0) x += dpp0<0x10F>(acc[ai][bj][m - 1][n][e]); else x += (fr == 0 ? bu[bj][e] : 0.f);
                            float y = dpp0<0x101>(cur);
                            if (m < 3) y += dpp0<0x11F>(acc[ai][bj][m + 1][n][e]); else y += (fr == 15 ? bd[bj][e] : 0.f);
                            up[bj] = x; dn[bj] = y; }
                        const float ua = wa[0][e] * up[0] + wa[1][e] * acc[ai][0][m][n][e] + wa[2][e] * dn[0] + ba[e];
                        const float ub = wb[0][e] * up[1] + wb[1][e] * acc[ai][1][m][n][e] + wb[2][e] * dn[1] + bb[e];
                        o[e] = ua * __builtin_amdgcn_rcpf(1.0f + __builtin_amdgcn_exp2f(-1.4426950408889634f * ua)) * ub; }
                    typedef unsigned u32x2 __attribute__((ext_vector_type(2))); u32x2 w; w.x = cvt_pk_bf16(o[0], o[1]); w.y = cvt_pk_bf16(o[2], o[3]);
                    *(u32x2*)(ACT + (size_t)(u.pm * BM + ai * HALF + wr * 64 + m * 16 + fr) * 2816 + ch0) = w; } } }
    }
};

template <class Epi, class Sched, bool ALIGN_EPI = false, bool SP2 = false>
__device__ __forceinline__ void gemm_phase(PG8_LAS unsigned char* lds, const Gemm g, const Sched& S, const Epi& E) {
    int tid = threadIdx.x; asm volatile("" : "+v"(tid));
    const int wid = __builtin_amdgcn_readfirstlane(tid >> 6), lane = tid & 63, wr = wid >> 2, wc = wid & 3, fr = lane & 15, fq = lane >> 4;
    int K = g.K; asm volatile("" : "+s"(K));
    const int nt = K / BK;
    unsigned voffA[2], voffB[2];
#pragma unroll
    for (int i = 0; i < 2; ++i) { int R, C; stage_rc(tid * 16 + i * 8192, R, C); const int Rb = Epi::PERM ? ((R & ~31) + perm32(R & 31)) : R;
        voffA[i] = (unsigned)(R * g.lda + C) * 2u; voffB[i] = (unsigned)(Rb * g.ldb + C) * 2u; }
    const size_t kstep = (size_t)(BK * 2);
    const size_t hstepA = (size_t)HALF * g.lda * 2, hstepB = (size_t)HALF * g.ldb * 2;
    const size_t tstepA = 2 * hstepA, tstepB = 2 * hstepB;
    const unsigned ldsw = (unsigned)wid * 1024u;
    const int aoff = lds_byte(wr * 64 + fr, fq * 8), boff = lds_byte(wc * 32 + fr, fq * 8);
#define PG8_SA(b, h) (((b) * 2 + (h)) * HTB)
#define PG8_SB(b, h) ((4 + (b) * 2 + (h)) * HTB)
#define PG8_STAGE(bufoff, gbase, voff) do { _Pragma("unroll") for (int _i = 0; _i < 2; ++_i) \
        __builtin_amdgcn_global_load_lds((const unsigned*)((const char*)(gbase) + (voff)[_i]), (PG8_LAS unsigned*)(lds + (bufoff) + ldsw + _i * 8192), 16, 0, 0); } while (0)
#define PG8_LDA(dst, b, h) do { _Pragma("unroll") for (int m = 0; m < 4; ++m) _Pragma("unroll") for (int k = 0; k < 2; ++k) dst[m][k] = *(const PG8_LAS bf16x8*)(lds + PG8_SA(b, h) + aoff + m * 2048 + k * 1024); } while (0)
#define PG8_LDB(dst, b, h) do { _Pragma("unroll") for (int n = 0; n < 2; ++n) _Pragma("unroll") for (int k = 0; k < 2; ++k) dst[n][k] = *(const PG8_LAS bf16x8*)(lds + PG8_SB(b, h) + boff + n * 2048 + k * 1024); } while (0)
#define PG8_MMA(ai, bj, At, Bt) do { __builtin_amdgcn_s_setprio(1); _Pragma("unroll") for (int m = 0; m < 4; ++m) _Pragma("unroll") for (int n = 0; n < 2; ++n) _Pragma("unroll") for (int k = 0; k < 2; ++k) \
        acc[ai][bj][m][n] = __builtin_amdgcn_mfma_f32_16x16x32_bf16(Bt[n][k], At[m][k], acc[ai][bj][m][n], 0, 0, 0); __builtin_amdgcn_s_setprio(0); } while (0)
#define PG8_WAIT_V(n) asm volatile("s_waitcnt vmcnt(" #n ")" ::: "memory")
#define PG8_WAIT_L(n) asm volatile("s_waitcnt lgkmcnt(" #n ")" ::: "memory")
#define PG8_BAR __builtin_amdgcn_s_barrier()
#define PG8_SCHED __builtin_amdgcn_sched_barrier(0)
    Unit cur, nxt; int ui = 0;
    if (!S.next(0, cur)) return;
    f32x4 acc[2][2][4][2];
#pragma unroll
    for (int a = 0; a < 2; ++a)
#pragma unroll
        for (int b = 0; b < 2; ++b)
#pragma unroll
            for (int m = 0; m < 4; ++m)
#pragma unroll
                for (int n = 0; n < 2; ++n) acc[a][b][m][n] = (f32x4){0.f, 0.f, 0.f, 0.f};
    bf16x8 At[4][2], B0[2][2], B1[2][2];
    const char* cA = (const char*)g.A + (size_t)cur.pm * tstepA; const char* cB = (const char*)g.Bt + (size_t)cur.pn * tstepB;
    S.a_ready(cur);
    if constexpr (SP2) {
        PG8_STAGE(PG8_SB(0, 0), cB, voffB); PG8_STAGE(PG8_SB(0, 1), cB + hstepB, voffB); PG8_STAGE(PG8_SA(0, 0), cA, voffA); PG8_STAGE(PG8_SA(0, 1), cA + hstepA, voffA);
        if (wr == 1) PG8_BAR;
        PG8_WAIT_V(2); PG8_BAR;
        PG8_STAGE(PG8_SB(1, 0), cB + kstep, voffB); PG8_STAGE(PG8_SA(1, 0), cA + kstep, voffA); PG8_STAGE(PG8_SB(1, 1), cB + hstepB + kstep, voffB);
        PG8_WAIT_V(6); PG8_BAR;
    } else {
        PG8_STAGE(PG8_SB(0, 0), cB, voffB); PG8_STAGE(PG8_SA(0, 0), cA, voffA); PG8_STAGE(PG8_SB(0, 1), cB + hstepB, voffB); PG8_STAGE(PG8_SA(0, 1), cA + hstepA, voffA);
        if (wr == 1) PG8_BAR;
        PG8_WAIT_V(4); PG8_BAR;
        PG8_STAGE(PG8_SB(1, 0), cB + kstep, voffB); PG8_STAGE(PG8_SA(1, 0), cA + kstep, voffA); PG8_STAGE(PG8_SB(1, 1), cB + hstepB + kstep, voffB);
        PG8_WAIT_V(6); PG8_BAR;
    }
    for (;;) {
        const bool has_next = S.next(ui + 1, nxt);
        const char* nA = has_next ? (const char*)g.A + (size_t)nxt.pm * tstepA : cA; const char* nB = has_next ? (const char*)g.Bt + (size_t)nxt.pn * tstepB : cB;
        for (int t = 0; t < nt; t += 2) {
            const bool last = (t == nt - 2);
            const char* a1 = cA + (size_t)(t + 1) * kstep;
            const char* a2 = last ? nA : cA + (size_t)(t + 2) * kstep; const char* b2 = last ? nB : cB + (size_t)(t + 2) * kstep;
            const char* a3 = a2 + kstep; const char* b3 = b2 + kstep;
            if (last && has_next) S.a_ready(nxt);
            if constexpr (SP2) {
            PG8_LDB(B0, 0, 0); PG8_LDB(B1, 0, 1); PG8_SCHED; PG8_LDA(At, 0, 0); PG8_STAGE(PG8_SA(1, 1), a1 + hstepA, voffA);
            PG8_WAIT_V(8); PG8_WAIT_L(0); PG8_BAR; PG8_MMA(0, 0, At, B0); PG8_MMA(0, 1, At, B1); PG8_BAR; PG8_SCHED;
            PG8_LDA(At, 0, 1); PG8_STAGE(PG8_SB(0, 0), b2, voffB); PG8_STAGE(PG8_SB(0, 1), b2 + hstepB, voffB); PG8_STAGE(PG8_SA(0, 0), a2, voffA);
            PG8_WAIT_V(8); PG8_WAIT_L(0); PG8_BAR; PG8_MMA(1, 0, At, B0); PG8_MMA(1, 1, At, B1); PG8_BAR; PG8_SCHED;
            PG8_LDB(B0, 1, 0); PG8_LDB(B1, 1, 1); PG8_SCHED; PG8_LDA(At, 1, 0); PG8_STAGE(PG8_SA(0, 1), a2 + hstepA, voffA);
            PG8_WAIT_V(8); PG8_WAIT_L(0); PG8_BAR; PG8_MMA(0, 0, At, B0); PG8_MMA(0, 1, At, B1); PG8_BAR; PG8_SCHED;
            PG8_LDA(At, 1, 1); PG8_STAGE(PG8_SB(1, 0), b3, voffB); PG8_STAGE(PG8_SB(1, 1), b3 + hstepB, voffB); PG8_STAGE(PG8_SA(1, 0), a3, voffA);
            PG8_WAIT_V(8); PG8_WAIT_L(0); PG8_BAR; PG8_MMA(1, 0, At, B0); PG8_MMA(1, 1, At, B1); PG8_BAR; PG8_SCHED;
            } else {
            PG8_LDB(B0, 0, 0); PG8_SCHED; PG8_LDA(At, 0, 0); PG8_STAGE(PG8_SA(1, 1), a1 + hstepA, voffA);
            PG8_WAIT_L(8); PG8_BAR; PG8_WAIT_L(0); PG8_MMA(0, 0, At, B0); PG8_BAR; PG8_SCHED;
            PG8_LDB(B1, 0, 1); PG8_STAGE(PG8_SB(0, 0), b2, voffB);
            PG8_BAR; PG8_WAIT_L(0); PG8_MMA(0, 1, At, B1); PG8_BAR;
            PG8_LDA(At, 0, 1); PG8_STAGE(PG8_SA(0, 0), a2, voffA);
            PG8_BAR; PG8_WAIT_L(0); PG8_MMA(1, 0, At, B0); PG8_BAR; PG8_SCHED;
            PG8_STAGE(PG8_SB(0, 1), b2 + hstepB, voffB);
            PG8_WAIT_V(6); PG8_BAR; PG8_MMA(1, 1, At, B1); PG8_BAR;
            PG8_LDB(B0, 1, 0); PG8_SCHED; PG8_LDA(At, 1, 0); PG8_STAGE(PG8_SA(0, 1), a2 + hstepA, voffA);
            PG8_WAIT_L(8); PG8_BAR; PG8_WAIT_L(0); PG8_MMA(0, 0, At, B0); PG8_BAR; PG8_SCHED;
            PG8_LDB(B1, 1, 1); PG8_STAGE(PG8_SB(1, 0), b3, voffB);
            PG8_BAR; PG8_WAIT_L(0); PG8_MMA(0, 1, At, B1); PG8_BAR;
            PG8_LDA(At, 1, 1); PG8_STAGE(PG8_SA(1, 0), a3, voffA);
            PG8_BAR; PG8_WAIT_L(0); PG8_MMA(1, 0, At, B0); PG8_BAR; PG8_SCHED;
            PG8_STAGE(PG8_SB(1, 1), b3 + hstepB, voffB);
            PG8_WAIT_V(6); PG8_BAR; PG8_MMA(1, 1, At, B1); PG8_BAR;
            }
        }
        if constexpr (ALIGN_EPI) { if (wr == 0) PG8_BAR; }
        if constexpr (!Epi::AFTER_DRAIN) { E(acc, cur, wr, wc, fr, fq); S.done(cur); }
        if (!has_next) break;
#pragma unroll
        for (int a = 0; a < 2; ++a)
#pragma unroll
            for (int b = 0; b < 2; ++b)
#pragma unroll
                for (int m = 0; m < 4; ++m)
#pragma unroll
                    for (int n = 0; n < 2; ++n) acc[a][b][m][n] = (f32x4){0.f, 0.f, 0.f, 0.f};
        cur = nxt; cA = nA; cB = nB; ++ui;
        if constexpr (ALIGN_EPI) { if (wr == 1) PG8_BAR; }
    }
    PG8_WAIT_V(0);
    if constexpr (!ALIGN_EPI) { if (wr == 0) PG8_BAR; }
    PG8_BAR;
    if constexpr (Epi::AFTER_DRAIN) { E.fused(acc, cur, wr, wc, fr, fq, lds, wid, lane); S.done(cur); }
#undef PG8_SA
#undef PG8_SB
#undef PG8_STAGE
#undef PG8_LDA
#undef PG8_LDB
#undef PG8_MMA
#undef PG8_WAIT_V
#undef PG8_WAIT_L
#undef PG8_BAR
#undef PG8_SCHED
}
}

#define DEV __device__ __forceinline__
#define LAS __attribute__((address_space(3)))
typedef unsigned short bf16_t;
typedef short bf16x8 __attribute__((ext_vector_type(8)));
typedef float f32x4 __attribute__((ext_vector_type(4)));
typedef float f32x2 __attribute__((ext_vector_type(2)));
typedef float f32x16 __attribute__((ext_vector_type(16)));
typedef unsigned u32x4 __attribute__((ext_vector_type(4)));
typedef unsigned u32x2 __attribute__((ext_vector_type(2)));

constexpr int R = 16896, RB = 8448, NCTX = 256, TL = 8192, DM = 1024, INW = 1696, DFF = 2816, HFF = 1408;
constexpr int NWG_T = 512;
constexpr float EPS = 1e-6f;
constexpr int LDS_BYTES = 147456;
constexpr size_t OFF_X = 0, OFF_HN = 69206016, OFF_W = 103809024, OFF_MOD = 152174592, OFF_ROPE = 152436736, OFF_OV = 153485312;
constexpr size_t OV_Q = 0, OV_KN = 25952256, OV_VT = 43253760, OV_SLOC = 60555264, OV_SIN = 69206016, OV_U = 0;
constexpr size_t OFF_PART = 250100224;
constexpr size_t OFF_EDGE = 258488832;
constexpr size_t WS_NEED = OFF_EDGE + 5947392;
constexpr size_t W_IN = 0, W_UQ = 1835008, W_KN = 2129920, W_V = 2260992, W_OUT = 2392064, W_UP = 3440640, W_DN = 9207808, W_LAYER = 12091392;

struct Params {
    const float *x, *c, *ctx, *c_ctx, *w_mod, *b_mod, *norm1_g, *w_in, *ret_decay_f, *ret_decay_b, *mla_q_norm_g, *w_uq, *mla_kv_norm_g, *w_ukv,
        *pool_w, *pool_scale, *w_out, *norm2_g, *w_up, *conv_w, *conv_b, *w_down, *final_norm_g;
    float* out; unsigned char* ws; int ph_lo, ph_hi;
};

DEV int otid() { int t = threadIdx.x; asm volatile("" : "+v"(t)); return t; }
DEV float bf2f(unsigned short x) { return __uint_as_float((unsigned)x << 16); }
DEV unsigned f2bf(float f) { unsigned u = __float_as_uint(f); return (u + 0x7fffu + ((u >> 16) & 1u)) >> 16; }
DEV unsigned pk2(float lo, float hi) { return f2bf(lo) | (f2bf(hi) << 16); }
DEV float wave_sum(float v) {
#pragma unroll
    for (int o = 1; o < 64; o <<= 1) v += __shfl_xor(v, o);
    return v;
}
DEV float siluf(float x) { return x * __builtin_amdgcn_rcpf(1.0f + __builtin_amdgcn_exp2f(-1.4426950408889634f * x)); }
DEV int crow(int r, int hi) { return (r & 3) + 8 * (r >> 2) + 4 * hi; }
DEV bf16x8 pack8(float a0, float a1, float a2, float a3, float a4, float a5, float a6, float a7) {
    u32x4 w; w.x = pg8::cvt_pk_bf16(a0, a1); w.y = pg8::cvt_pk_bf16(a2, a3); w.z = pg8::cvt_pk_bf16(a4, a5); w.w = pg8::cvt_pk_bf16(a6, a7);
    return __builtin_bit_cast(bf16x8, w);
}
DEV int row_mi(int r) { const int b = r / RB; const int s = r - b * RB; return s < NCTX ? 2 : b; }

DEV void transpose_item(const float* W, int K, int Nsrc, bf16_t* WT, int n0, int cs, int k0, float* scr, int lane) {
#pragma unroll
    for (int i = 0; i < 32; ++i) { const int kk = 2 * i + (lane >> 5); scr[kk * 33 + (lane & 31)] = cs >= 0 ? W[(size_t)(k0 + kk) * Nsrc + cs + (lane & 31)] : 0.f; }
    asm volatile("s_waitcnt lgkmcnt(0)" ::: "memory");
    const int c = lane & 7;
#pragma unroll
    for (int j = 0; j < 4; ++j) { const int n = (lane >> 3) + 8 * j; const float* s = scr + (8 * c) * 33 + n;
        u32x4 o; o.x = pk2(s[0 * 33], s[1 * 33]); o.y = pk2(s[2 * 33], s[3 * 33]); o.z = pk2(s[4 * 33], s[5 * 33]); o.w = pk2(s[6 * 33], s[7 * 33]);
        *(u32x4*)(WT + (size_t)(n0 + n) * K + k0 + 8 * c) = o; }
    asm volatile("s_waitcnt lgkmcnt(0)" ::: "memory");
}
DEV int map_in(int n0) { return n0 < 1440 ? n0 : (n0 < INW ? -2 : -1); }
DEV int map_kn(int n0) { return (n0 >> 6) * 128 + (n0 & 63); }
DEV int map_v(int n0) { return (n0 >> 6) * 128 + 64 + (n0 & 63); }
DEV int map_up(int n0) { const int pn = n0 >> 8, w = n0 & 255; return w < 128 ? 128 * pn + w : DFF + 128 * pn + (w - 128); }

DEV void phase_prep(const Params& p, unsigned char* lds) {
    const int tid = otid(), lane = tid & 63, wid = tid >> 6;
    unsigned char* ws = p.ws;
    { f32x2* rope = (f32x2*)(ws + OFF_ROPE);
      for (int idx = blockIdx.x * NWG_T + tid; idx < TL * 16; idx += gridDim.x * NWG_T) { const int t = idx >> 4, i = idx & 15; const int pos = i < 8 ? (t >> 6) : (t & 63);
          const float inv = exp2f(-(float)(i & 7) * 0.125f * 13.287712379549449f); const float ang = (float)pos * inv; f32x2 cs; cs.x = __cosf(ang); cs.y = __sinf(ang); rope[idx] = cs; } }
    { float* scv = (float*)lds;
      float* red = scv + 3 * 1024;
      for (int i = tid; i < 3 * 1024; i += NWG_T) { const int v = i >> 10, k = i & 1023; const float cv = v < 2 ? p.c[v * 1024 + k] : p.c_ctx[k]; scv[i] = siluf(cv); }
      __syncthreads();
      float* modv = (float*)(ws + OFF_MOD);
      for (int it = blockIdx.x; it < 192; it += gridDim.x) { const int l = it / 96, col0 = (it % 96) * 64;
          const float* wm = p.w_mod + (size_t)l * 1024 * 6144 + col0 + lane; float a0 = 0.f, a1 = 0.f, a2 = 0.f;
#pragma unroll 16
          for (int k = wid * 128; k < wid * 128 + 128; ++k) { const float w = wm[(size_t)k * 6144]; a0 += scv[k] * w; a1 += scv[1024 + k] * w; a2 += scv[2048 + k] * w; }
          red[(wid * 3 + 0) * 64 + lane] = a0; red[(wid * 3 + 1) * 64 + lane] = a1; red[(wid * 3 + 2) * 64 + lane] = a2;
          __syncthreads();
          if (tid < 192) { const int v = tid >> 6, cl = tid & 63; float s = 0.f;
#pragma unroll
              for (int w = 0; w < 8; ++w) s += red[(w * 3 + v) * 64 + cl];
              modv[((size_t)l * 3 + v) * 6144 + col0 + cl] = s + p.b_mod[l * 6144 + col0 + cl]; }
          __syncthreads(); }
    }
}
DEV void phase_prep_weights(const Params& p, unsigned char* lds) {
    const int tid = otid(), lane = tid & 63, wid = tid >> 6;
    unsigned char* ws = p.ws;
    { float* scr = (float*)(lds + 32768 + wid * 8704);
      const int gw = blockIdx.x * 8 + wid, NGW = gridDim.x * 8;
      constexpr int I_IN = 16 * 56, I_UQ = 6 * 24, I_KN = 4 * 16, I_V = 4 * 16, I_OUT = 16 * 32, I_UP = 16 * 176, I_DN = 44 * 32, I_L = I_IN + I_UQ + I_KN + I_V + I_OUT + I_UP + I_DN;
      for (int it = gw; it < 2 * I_L; it += NGW) { const int l = it / I_L; int r = it - l * I_L; bf16_t* wl = (bf16_t*)(ws + OFF_W) + (size_t)l * W_LAYER;
          const float* src; int K, Nsrc, nbn, mp; size_t doff;
          if (r < I_IN) { src = p.w_in + (size_t)l * 1024 * INW; K = 1024; Nsrc = INW; nbn = 56; mp = 1; doff = W_IN; }
          else if ((r -= I_IN) < I_UQ) { src = p.w_uq + (size_t)l * 384 * 768; K = 384; Nsrc = 768; nbn = 24; mp = 0; doff = W_UQ; }
          else if ((r -= I_UQ) < I_KN) { src = p.w_ukv + (size_t)l * 256 * 1024; K = 256; Nsrc = 1024; nbn = 16; mp = 2; doff = W_KN; }
          else if ((r -= I_KN) < I_V) { src = p.w_ukv + (size_t)l * 256 * 1024; K = 256; Nsrc = 1024; nbn = 16; mp = 3; doff = W_V; }
          else if ((r -= I_V) < I_OUT) { src = p.w_out + (size_t)l * 1024 * 1024; K = 1024; Nsrc = 1024; nbn = 32; mp = 0; doff = W_OUT; }
          else if ((r -= I_OUT) < I_UP) { src = p.w_up + (size_t)l * 1024 * 5632; K = 1024; Nsrc = 5632; nbn = 176; mp = 4; doff = W_UP; }
          else { r -= I_UP; src = p.w_down + (size_t)l * DFF * 1024; K = DFF; Nsrc = 1024; nbn = 32; mp = 0; doff = W_DN; }
          const int kb = r / nbn, nb = r - kb * nbn, n0 = nb * 32;
          const int cs = mp == 0 ? n0 : mp == 1 ? map_in(n0) : mp == 2 ? map_kn(n0) : mp == 3 ? map_v(n0) : map_up(n0);
          if (cs != -2) transpose_item(src, K, Nsrc, wl + doff, n0, cs, kb * 64, scr, lane); }
    }
    { for (int idx = blockIdx.x * NWG_T + tid; idx < 2 * 1024 * 256; idx += gridDim.x * NWG_T) { const int n = idx & 255, k = (idx >> 8) & 1023, l = idx >> 18; const int g = n >> 6, d = n & 63;
          const float* wr = p.w_in + ((size_t)l * 1024 + k) * INW + 1440 + g * 64; const float* pw = p.pool_w + ((size_t)(l * 4 + g) * 64) * 64 + d; float s = 0.f;
#pragma unroll 8
          for (int c = 0; c < 64; ++c) s += wr[c] * pw[c * 64];
          ((bf16_t*)(ws + OFF_W) + (size_t)l * W_LAYER + W_IN)[(size_t)(1440 + n) * 1024 + k] = (bf16_t)f2bf(s * p.pool_scale[l * 256 + n]); } }
}

DEV void phase_norm(const Params& p, int l, int which, bool first, const float* pgate) {
    const int tid = otid(); const int lane = tid & 63, wid = tid >> 6; const int gw = blockIdx.x * 8 + wid, NGW = gridDim.x * 8;
    float* X = (float*)(p.ws + OFF_X); bf16_t* HN = (bf16_t*)(p.ws + OFF_HN);
    const float* modv = (const float*)(p.ws + OFF_MOD) + (size_t)l * 3 * 6144;
    const float* g = (which == 0 ? p.norm1_g : p.norm2_g) + l * 1024;
    for (int r = gw; r < R; r += NGW) {
        const int b = r / RB, s = r - b * RB; const int mi = s < NCTX ? 2 : b;
        const float* src = first ? (s < NCTX ? p.ctx + ((size_t)b * NCTX + s) * 1024 : p.x + ((size_t)b * TL + (s - NCTX)) * 1024) : X + (size_t)r * 1024;
        const f32x4* xr = (const f32x4*)src + lane; f32x4 v[4]; float ss = 0.f;
#pragma unroll
        for (int j = 0; j < 4; ++j) { v[j] = xr[64 * j]; ss += (v[j].x * v[j].x + v[j].y * v[j].y) + (v[j].z * v[j].z + v[j].w * v[j].w); }
        if (pgate != nullptr && s < NCTX) { const float* PART = (const float*)(p.ws + OFF_PART) + (size_t)(b * NCTX + s) * 1024; ss = 0.f;
#pragma unroll
            for (int j = 0; j < 4; ++j) { const f32x4 gq = ((const f32x4*)pgate)[lane + 64 * j]; f32x4 a = ((const f32x4*)PART)[lane + 64 * j];
#pragma unroll
                for (int q = 1; q < 4; ++q) a = a + ((const f32x4*)(PART + (size_t)q * 524288))[lane + 64 * j];
                v[j] = v[j] + gq * a; ss += (v[j].x * v[j].x + v[j].y * v[j].y) + (v[j].z * v[j].z + v[j].w * v[j].w); } }
        if (first || (pgate != nullptr && s < NCTX)) { f32x4* xo = (f32x4*)(X + (size_t)r * 1024) + lane;
#pragma unroll
            for (int j = 0; j < 4; ++j) xo[64 * j] = v[j]; }
        const float rs = rsqrtf(wave_sum(ss) * (1.f / 1024.f) + EPS);
        const float* mv = modv + mi * 6144 + (which == 0 ? 0 : 3072);
        u32x2* o8 = (u32x2*)(HN + (size_t)r * 1024) + lane;
#pragma unroll
        for (int j = 0; j < 4; ++j) { const f32x4 gg = ((const f32x4*)g)[lane + 64 * j], sh = ((const f32x4*)mv)[lane + 64 * j], sc = ((const f32x4*)(mv + 1024))[lane + 64 * j];
            const f32x4 y = v[j] * rs * gg; const f32x4 h = y * (sc + 1.0f) + sh; u32x2 w; w.x = pk2(h.x, h.y); w.y = pk2(h.z, h.w); o8[64 * j] = w; }
    }
}
DEV void phase_final(const Params& p) {
    const int tid = otid(); const int lane = tid & 63, wid = tid >> 6; const int gw = blockIdx.x * 8 + wid, NGW = gridDim.x * 8;
    const float* X = (const float*)(p.ws + OFF_X);
    for (int q = gw; q < 2 * TL; q += NGW) { const int b = q / TL, t = q - b * TL; const int r = b * RB + NCTX + t;
        const f32x4* xr = (const f32x4*)(X + (size_t)r * 1024) + lane; f32x4 v[4]; float ss = 0.f;
#pragma unroll
        for (int j = 0; j < 4; ++j) { v[j] = xr[64 * j]; ss += (v[j].x * v[j].x + v[j].y * v[j].y) + (v[j].z * v[j].z + v[j].w * v[j].w); }
        const float rs = rsqrtf(wave_sum(ss) * (1.f / 1024.f) + EPS);
        f32x4* o = (f32x4*)(p.out + (size_t)q * 1024) + lane;
#pragma unroll
        for (int j = 0; j < 4; ++j) { const f32x4 gg = ((const f32x4*)p.final_norm_g)[lane + 64 * j]; o[64 * j] = v[j] * rs * gg; } }
}

DEV void phase_rowwise(const Params& p, int l) {
    const int tid = otid(); const int lane = tid & 63, wid = tid >> 6; const int gw = blockIdx.x * 8 + wid, NGW = gridDim.x * 8;
    bf16_t* P = (bf16_t*)p.out; const f32x2* rope = (const f32x2*)(p.ws + OFF_ROPE);
    const float* qg = p.mla_q_norm_g + l * 384; const float* kg = p.mla_kv_norm_g + l * 256;
    float qgv[6];
#pragma unroll
    for (int j = 0; j < 3; ++j) { qgv[2 * j] = qg[2 * (lane + 64 * j)]; qgv[2 * j + 1] = qg[2 * (lane + 64 * j) + 1]; }
    const f32x4 kgv = ((const f32x4*)kg)[lane];
    for (int r0 = gw; r0 < R; r0 += 2 * NGW) {
        unsigned wq[2][3]; u32x2 wk[2]; float x1[2], x2[2]; f32x2 cs[2]; bool val[2], lat[2];
#pragma unroll
        for (int i = 0; i < 2; ++i) { const int r = r0 + i * NGW; val[i] = r < R; const int rr = val[i] ? r : r0; bf16_t* pr = P + (size_t)rr * INW; const int s = rr % RB; lat[i] = s >= NCTX;
            const unsigned* q2 = (const unsigned*)(pr + 768) + lane;
#pragma unroll
            for (int j = 0; j < 3; ++j) wq[i][j] = q2[64 * j];
            wk[i] = *((const u32x2*)(pr + 1152) + lane);
            const int li = lane & 15; x1[i] = bf2f(pr[1408 + li]); x2[i] = bf2f(pr[1408 + 16 + li]); cs[i] = rope[(lat[i] ? s - NCTX : 0) * 16 + li]; }
#pragma unroll
        for (int i = 0; i < 2; ++i) { if (!val[i]) continue; const int r = r0 + i * NGW; bf16_t* pr = P + (size_t)r * INW;
            { float ss = 0.f;
#pragma unroll
              for (int j = 0; j < 3; ++j) { const float a = bf2f(wq[i][j] & 0xffff), c2 = bf2f(wq[i][j] >> 16); ss += a * a + c2 * c2; }
              const float rs = rsqrtf(wave_sum(ss) * (1.f / 384.f) + EPS); unsigned* q2 = (unsigned*)(pr + 768) + lane;
#pragma unroll
              for (int j = 0; j < 3; ++j) q2[64 * j] = pk2(bf2f(wq[i][j] & 0xffff) * rs * qgv[2 * j], bf2f(wq[i][j] >> 16) * rs * qgv[2 * j + 1]); }
            { const float a0 = bf2f(wk[i].x & 0xffff), a1 = bf2f(wk[i].x >> 16), a2 = bf2f(wk[i].y & 0xffff), a3 = bf2f(wk[i].y >> 16);
              const float rs = rsqrtf(wave_sum((a0 * a0 + a1 * a1) + (a2 * a2 + a3 * a3)) * (1.f / 256.f) + EPS);
              u32x2 o; o.x = pk2(a0 * rs * kgv.x, a1 * rs * kgv.y); o.y = pk2(a2 * rs * kgv.z, a3 * rs * kgv.w); *((u32x2*)(pr + 1152) + lane) = o; }
            if (lat[i] && lane < 16) { pr[1408 + lane] = (bf16_t)f2bf(x1[i] * cs[i].x - x2[i] * cs[i].y); pr[1408 + 16 + lane] = (bf16_t)f2bf(x2[i] * cs[i].x + x1[i] * cs[i].y); } }
    }
}

DEV void phase_pool(const Params& p) {
    const int tid = otid(); const bf16_t* P = (const bf16_t*)p.out; bf16_t* MIX = (bf16_t*)(p.ws + OFF_HN);
    for (int idx = blockIdx.x * NWG_T + tid; idx < R * 32; idx += gridDim.x * NWG_T) { const int r = idx >> 5, cg = idx & 31; const int half = 1 << (cg >> 3);
        const int b = r / RB, s = r - b * RB; const int seq0 = s < NCTX ? b * RB : b * RB + NCTX; const int T = s < NCTX ? NCTX : TL; const int t = r - seq0;
        const int lo = max(t - half, 0), hi = min(t + half, T); float sum[8];
#pragma unroll
        for (int j = 0; j < 8; ++j) sum[j] = 0.f;
        const bf16_t* base = P + (size_t)seq0 * INW + 1440 + cg * 8;
        { bf16x8 wv[16]; const bf16x8 zz = {0, 0, 0, 0, 0, 0, 0, 0};
#pragma unroll
          for (int k = 0; k < 16; ++k) { const int tt = t - 8 + k; wv[k] = (tt >= lo && tt < hi) ? *(const bf16x8*)(base + (size_t)tt * INW) : zz; }
#pragma unroll
          for (int k = 0; k < 16; ++k)
#pragma unroll
              for (int j = 0; j < 8; ++j) sum[j] += bf2f((unsigned short)wv[k][j]); }
        const bf16x8 me = *(const bf16x8*)(base + (size_t)t * INW); const float ic = 1.0f / (float)(hi - lo); float o[8];
#pragma unroll
        for (int j = 0; j < 8; ++j) o[j] = sum[j] * ic - bf2f((unsigned short)me[j]);
        *(bf16x8*)(MIX + (size_t)r * 1024 + 768 + cg * 8) = pack8(o[0], o[1], o[2], o[3], o[4], o[5], o[6], o[7]); }
}

DEV float log2_sigmoid(float d) { return -log1pf(__expf(-d)) * 1.4426950408889634f; }
constexpr int ST_P = 272;
DEV void states_item(const Params& p, int l, unsigned char* lds, int it) {
    const int tid = otid(), lane = tid & 63, wid = tid >> 6, l32 = lane & 31, hi = lane >> 5;
    const bf16_t* P = (const bf16_t*)p.out; const f32x2* rope = (const f32x2*)(p.ws + OFF_ROPE);
    float* SLOC = (float*)(p.ws + OFF_OV + OV_SLOC);
    const int gc = it >> 1, hp = it & 1;
    unsigned char* VTl = lds;
    unsigned char* KTl = lds + 2 * 64 * ST_P;
    const int cb = gc % 66; const bool lat = cb >= 2; const int t0 = (cb - 2) * 128; const int r0 = gc * 128;
    __syncthreads();
    { const int tok = tid >> 2, hh = (tid >> 1) & 1, c = tid & 1; const int h = 2 * hp + hh;
      const bf16_t* src = P + (size_t)(r0 + tok) * INW + 128 + h * 32 + 8 * c; const bf16x8 lo = *(const bf16x8*)src, hi8 = *(const bf16x8*)(src + 16);
      const float df = exp2f(log2_sigmoid(p.ret_decay_f[l * 4 + h]) * (float)(127 - tok)) * 0.17677669529663687f, db = exp2f(log2_sigmoid(p.ret_decay_b[l * 4 + h]) * (float)tok) * 0.17677669529663687f;
#pragma unroll
      for (int j = 0; j < 8; ++j) { float x1 = bf2f((unsigned short)lo[j]), x2 = bf2f((unsigned short)hi8[j]);
          if (lat) { const f32x2 cs = rope[(t0 + tok) * 16 + 8 * c + j]; const float y1 = x1 * cs.x - x2 * cs.y, y2 = x2 * cs.x + x1 * cs.y; x1 = y1; x2 = y2; }
          bf16_t* kf = (bf16_t*)(KTl + ((hh * 2 + 0) * 32 + 8 * c + j) * ST_P) + tok; bf16_t* kb = (bf16_t*)(KTl + ((hh * 2 + 1) * 32 + 8 * c + j) * ST_P) + tok;
          kf[0] = (bf16_t)f2bf(x1 * df); kb[0] = (bf16_t)f2bf(x1 * db);
          *(bf16_t*)((unsigned char*)kf + 16 * ST_P) = (bf16_t)f2bf(x2 * df); *(bf16_t*)((unsigned char*)kb + 16 * ST_P) = (bf16_t)f2bf(x2 * db); } }
    for (int task = tid; task < 2048; task += NWG_T) { const int hh = task >> 10, tok = (task >> 3) & 127, ch = task & 7;
        const bf16x8 v = *(const bf16x8*)(P + (size_t)(r0 + tok) * INW + 256 + (2 * hp + hh) * 64 + ch * 8);
#pragma unroll
        for (int j = 0; j < 8; ++j) *((bf16_t*)(VTl + (hh * 64 + ch * 8 + j) * ST_P) + tok) = (bf16_t)v[j]; }
    __syncthreads();
    { const int hh = wid >> 2, dir = (wid >> 1) & 1, dvb = wid & 1; const int h = 2 * hp + hh;
      const unsigned char* ap = VTl + (hh * 64 + 32 * dvb + l32) * ST_P + hi * 16; const unsigned char* bp = KTl + ((hh * 2 + dir) * 32 + l32) * ST_P + hi * 16;
      bf16x8 af[8], bfr[8];
#pragma unroll
      for (int ks = 0; ks < 8; ++ks) { af[ks] = *(const bf16x8*)(ap + ks * 32); bfr[ks] = *(const bf16x8*)(bp + ks * 32); }
      f32x16 acc;
#pragma unroll
      for (int r = 0; r < 16; ++r) acc[r] = 0.f;
#pragma unroll
      for (int ks = 0; ks < 8; ++ks) acc = __builtin_amdgcn_mfma_f32_32x32x16_bf16(af[ks], bfr[ks], acc, 0, 0, 0);
      float* o = SLOC + ((size_t)(gc * 4 + h) * 2 + dir) * 2048 + l32 * 64 + 32 * dvb + 4 * hi;
#pragma unroll
      for (int g4 = 0; g4 < 4; ++g4) *(f32x4*)(o + 8 * g4) = (f32x4){acc[4 * g4], acc[4 * g4 + 1], acc[4 * g4 + 2], acc[4 * g4 + 3]}; }
}
DEV void scan_threads(const Params& p, int l, int gid) {
    if (gid >= 32768) return;
    const int e = gid & 2047, dir = (gid >> 11) & 1, h = (gid >> 12) & 3, b = gid >> 14;
    const float* SLOC = (const float*)(p.ws + OFF_OV + OV_SLOC); float* SIN = (float*)(p.ws + OFF_OV + OV_SIN);
    const float gC = exp2f(log2_sigmoid((dir == 0 ? p.ret_decay_f : p.ret_decay_b)[l * 4 + h]) * 128.f);
    float S = 0.f;
#pragma unroll 11
    for (int st = 0; st < 66; ++st) { const int cb = dir == 0 ? st : (st < 2 ? 1 - st : 67 - st); const size_t idx = ((size_t)((b * 66 + cb) * 4 + h) * 2 + dir) * 2048 + e;
        const float v = SLOC[idx]; SIN[idx] = S; S = S * gC + v; }
}

constexpr int AT_KP = 208, AT_VP = 144, AT_KB = 64 * AT_KP, AT_VBS = 64 * AT_VP, AT_V0 = 4 * AT_KB;
DEV float at_max32(const f32x16& s0, const f32x16& s1) {
    float m0 = __builtin_fmaxf(__builtin_fmaxf(s0[0], s0[1]), s0[2]), m1 = __builtin_fmaxf(__builtin_fmaxf(s1[0], s1[1]), s1[2]);
    m0 = __builtin_fmaxf(__builtin_fmaxf(m0, s0[3]), s0[4]); m1 = __builtin_fmaxf(__builtin_fmaxf(m1, s1[3]), s1[4]);
    m0 = __builtin_fmaxf(__builtin_fmaxf(m0, s0[5]), s0[6]); m1 = __builtin_fmaxf(__builtin_fmaxf(m1, s1[5]), s1[6]);
    m0 = __builtin_fmaxf(__builtin_fmaxf(m0, s0[7]), s0[8]); m1 = __builtin_fmaxf(__builtin_fmaxf(m1, s1[7]), s1[8]);
    m0 = __builtin_fmaxf(__builtin_fmaxf(m0, s0[9]), s0[10]); m1 = __builtin_fmaxf(__builtin_fmaxf(m1, s1[9]), s1[10]);
    m0 = __builtin_fmaxf(__builtin_fmaxf(m0, s0[11]), s0[12]); m1 = __builtin_fmaxf(__builtin_fmaxf(m1, s1[11]), s1[12]);
    m0 = __builtin_fmaxf(__builtin_fmaxf(m0, s0[13]), s0[14]); m1 = __builtin_fmaxf(__builtin_fmaxf(m1, s1[13]), s1[14]);
    return __builtin_fmaxf(__builtin_fmaxf(m0, s0[15]), __builtin_fmaxf(m1, s1[15]));
}
DEV void attn_unit(const Params& p, unsigned char* lds, int u) {
    const int tid = otid(), lane = tid & 63, wid = tid >> 6, l32 = lane & 31, hi = lane >> 5;
    const bf16_t* Q = (const bf16_t*)(p.ws + OFF_OV + OV_Q); const bf16_t* KN = (const bf16_t*)(p.ws + OFF_OV + OV_KN); const bf16_t* VT = (const bf16_t*)(p.ws + OFF_OV + OV_VT);
    const bf16_t* P = (const bf16_t*)p.out; bf16_t* MIX = (bf16_t*)(p.ws + OFF_HN); const f32x2* rope = (const f32x2*)(p.ws + OFF_ROPE);
    const bool isctx = u >= 512; int b, h, qrow0, NT;
    if (!isctx) { b = u >> 8; h = (u >> 5) & 7; qrow0 = b * RB + NCTX + (u & 31) * 256; NT = 132; } else { const int v = u - 512; b = v >> 3; h = v & 7; qrow0 = b * RB; NT = 4; }
    const int krow0 = b * RB; const int qrow = qrow0 + wid * 32 + l32;
    bf16x8 qf[6];
    { const bf16_t* qp = Q + (size_t)qrow * 768 + h * 96 + hi * 8;
#pragma unroll
      for (int d0 = 0; d0 < 6; ++d0) qf[d0] = *(const bf16x8*)(qp + d0 * 16);
      if (!isctx) { const f32x2* rp = rope + (size_t)(qrow - (b * RB + NCTX)) * 16 + hi * 8;
#pragma unroll
          for (int j = 0; j < 8; ++j) { const f32x2 cs = rp[j]; const float x1 = bf2f((unsigned short)qf[4][j]), x2 = bf2f((unsigned short)qf[5][j]);
              qf[4][j] = (short)f2bf(x1 * cs.x - x2 * cs.y); qf[5][j] = (short)f2bf(x2 * cs.x + x1 * cs.y); } } }
    const bf16_t* sp[3]; int sstep[3], lo[3];
#pragma unroll
    for (int k = 0; k < 2; ++k) { const int c = tid + k * 512; const int key = c / 12, part = c - key * 12; lo[k] = key * AT_KP + part * 16;
        if (part < 8) { sp[k] = KN + (size_t)(krow0 + key) * 512 + h * 64 + part * 8; sstep[k] = 64 * 512; } else { sp[k] = P + (size_t)(krow0 + key) * INW + 1408 + (part - 8) * 8; sstep[k] = 64 * INW; } }
    { const int dv = tid >> 3, kc = tid & 7; lo[2] = dv * AT_VP + (kc >> 1) * 32 + (kc & 1) * 8;   sp[2] = VT + (size_t)(h * 64 + dv) * R + krow0 + kc * 8; sstep[2] = 64; }
    const bool hasK2 = tid < 256;
    u32x4 st[3];
#define AT_GLOADK() do { st[0] = *(const u32x4*)sp[0]; sp[0] += sstep[0]; if (hasK2) { st[1] = *(const u32x4*)sp[1]; sp[1] += sstep[1]; } } while (0)
#define AT_GLOADV() do { st[2] = *(const u32x4*)sp[2]; sp[2] += sstep[2]; } while (0)
#define AT_LSTOREK(buf) do { *(u32x4*)((buf) + lo[0]) = st[0]; if (hasK2) *(u32x4*)((buf) + lo[1]) = st[1]; } while (0)
#define AT_LSTOREV(buf) do { unsigned char* d_ = (buf) + lo[2]; *(u32x2*)d_ = (u32x2){st[2].x, st[2].y}; *(u32x2*)(d_ + 16) = (u32x2){st[2].z, st[2].w}; } while (0)
#define AT_SB() __builtin_amdgcn_sched_barrier(0)
    f32x16 o0, o1, sa0, sa1, sb0, sb1, negm;
#pragma unroll
    for (int r = 0; r < 16; ++r) { o0[r] = 0.f; o1[r] = 0.f; sa0[r] = 0.f; sa1[r] = 0.f; negm[r] = 0.f; }
    float mrun = 0.f, lsum = 0.f;
    __syncthreads();
    AT_GLOADK(); AT_GLOADV(); AT_LSTOREK(lds); AT_LSTOREV(lds + AT_V0);
    AT_GLOADK(); AT_GLOADV(); AT_LSTOREK(lds + AT_KB); AT_LSTOREV(lds + AT_V0 + AT_VBS);
    AT_GLOADK(); AT_LSTOREK(lds + 2 * AT_KB);
    __syncthreads();
    { const unsigned char* ka = lds + l32 * AT_KP + hi * 16;
#pragma unroll
      for (int d0 = 0; d0 < 6; ++d0) { const bf16x8 a0 = *(const bf16x8*)(ka + d0 * 32), a1 = *(const bf16x8*)(ka + 32 * AT_KP + d0 * 32);
          sa0 = __builtin_amdgcn_mfma_f32_32x32x16_bf16(a0, qf[d0], sa0, 0, 0, 0); sa1 = __builtin_amdgcn_mfma_f32_32x32x16_bf16(a1, qf[d0], sa1, 0, 0, 0); } }
#define AT_QKM(SB0, SB1, i) do { if ((i) == 0) SB0 = __builtin_amdgcn_mfma_f32_32x32x16_bf16(kfr[0], qf[0], negm, 0, 0, 0); else if ((i) == 1) SB1 = __builtin_amdgcn_mfma_f32_32x32x16_bf16(kfr[1], qf[0], negm, 0, 0, 0); \
        else if ((i) & 1) SB1 = __builtin_amdgcn_mfma_f32_32x32x16_bf16(kfr[(i)], qf[(i) >> 1], SB1, 0, 0, 0); else SB0 = __builtin_amdgcn_mfma_f32_32x32x16_bf16(kfr[(i)], qf[(i) >> 1], SB0, 0, 0, 0); } while (0)
#define AT_EXS(acc, SA0, SA1, e) do { if ((e) < 16) { SA0[(e) & 15] = __builtin_amdgcn_exp2f(SA0[(e) & 15]); acc += SA0[(e) & 15]; } else { SA1[(e) & 15] = __builtin_amdgcn_exp2f(SA1[(e) & 15]); acc += SA1[(e) & 15]; } } while (0)
#define AT_PACK(dst, S, r0) dst = pack8(S[(r0) + 0], S[(r0) + 1], S[(r0) + 2], S[(r0) + 3], S[(r0) + 4], S[(r0) + 5], S[(r0) + 6], S[(r0) + 7])
#define AT_MAX4(m0, m1, SB0, SB1, r0) do { m0 = __builtin_fmaxf(__builtin_fmaxf(m0, SB0[(r0) + 0]), SB0[(r0) + 1]); m1 = __builtin_fmaxf(__builtin_fmaxf(m1, SB1[(r0) + 0]), SB1[(r0) + 1]); \
        m0 = __builtin_fmaxf(__builtin_fmaxf(m0, SB0[(r0) + 2]), SB0[(r0) + 3]); m1 = __builtin_fmaxf(__builtin_fmaxf(m1, SB1[(r0) + 2]), SB1[(r0) + 3]); } while (0)
#define AT_STEP(SA0, SA1, SB0, SB1, tt) do { \
        const int t_ = (tt); const bool nxt_ = t_ + 1 < NT; \
        const unsigned char* kb_ = lds + ((t_ + 1) & 3) * AT_KB; const unsigned char* vb_ = lds + AT_V0 + (t_ & 3) * AT_VBS; \
        if (t_ + 3 < NT) AT_GLOADK(); \
        if (t_ + 2 < NT) AT_GLOADV(); \
        bf16x8 kfr[12]; bf16x8 vfr[8]; \
        { const unsigned char* ka = kb_ + l32 * AT_KP + hi * 16; \
          _Pragma("unroll") for (int d0 = 0; d0 < 6; ++d0) { kfr[2 * d0] = *(const bf16x8*)(ka + d0 * 32); kfr[2 * d0 + 1] = *(const bf16x8*)(ka + 32 * AT_KP + d0 * 32); } } \
        { const float mx = mxc; \
          if (t_ == 0 || __any(mx > 8.0f)) { \
              const float rm = fmaxf(mx, __shfl_xor(mx, 32)); const float delta = (t_ == 0) ? rm : fmaxf(rm, 0.f); const float alpha = (t_ == 0) ? 1.0f : __builtin_amdgcn_exp2f(-delta); \
              mrun += delta; \
              _Pragma("unroll") for (int r = 0; r < 16; ++r) { SA0[r] -= delta; SA1[r] -= delta; o0[r] *= alpha; o1[r] *= alpha; } \
              lsum *= alpha; { const float nm = -mrun; _Pragma("unroll") for (int r = 0; r < 16; ++r) negm[r] = nm; } } } \
        float ls0 = 0.f, ls1 = 0.f; \
        AT_SB(); __builtin_amdgcn_s_setprio(1); \
          \
        _Pragma("unroll") for (int i = 0; i < 8; ++i) { \
            AT_QKM(SB0, SB1, i); \
            _Pragma("unroll") for (int k_ = 0; k_ < 3; ++k_) { const int e_ = 3 * i + k_; if (e_ < 16) { SA0[e_ & 15] = __builtin_amdgcn_exp2f(SA0[e_ & 15]); ls0 += SA0[e_ & 15]; } else { SA1[e_ & 15] = __builtin_amdgcn_exp2f(SA1[e_ & 15]); ls1 += SA1[e_ & 15]; } } \
            asm volatile("" : "+v"(ls0), "+v"(ls1)); AT_SB(); } \
        { const unsigned char* va = vb_ + l32 * AT_VP + hi * 16; \
          _Pragma("unroll") for (int kj = 0; kj < 4; ++kj) { vfr[2 * kj] = *(const bf16x8*)(va + kj * 32); vfr[2 * kj + 1] = *(const bf16x8*)(va + 32 * AT_VP + kj * 32); } } \
        bf16x8 pb[4]; \
        _Pragma("unroll") for (int i = 8; i < 12; ++i) { \
            AT_QKM(SB0, SB1, i); \
            _Pragma("unroll") for (int k_ = 0; k_ < 2; ++k_) { const int e_ = 24 + 2 * (i - 8) + k_; SA1[e_ & 15] = __builtin_amdgcn_exp2f(SA1[e_ & 15]); ls1 += SA1[e_ & 15]; } \
            if (i == 9) AT_PACK(pb[0], SA0, 0); \
            if (i == 11) AT_PACK(pb[1], SA0, 8); \
            asm volatile("" : "+v"(ls1)); AT_SB(); } \
        lsum += ls0 + ls1; \
        float mq0 = SB0[0], mq1 = SB1[0]; __builtin_amdgcn_s_setprio(2); \
        _Pragma("unroll") for (int kj = 0; kj < 4; ++kj) { \
            o0 = __builtin_amdgcn_mfma_f32_32x32x16_bf16(vfr[2 * kj], pb[kj], o0, 0, 0, 0); o1 = __builtin_amdgcn_mfma_f32_32x32x16_bf16(vfr[2 * kj + 1], pb[kj], o1, 0, 0, 0); \
            if (kj == 0) AT_PACK(pb[2], SA1, 0); \
            if (kj == 1) AT_PACK(pb[3], SA1, 8); \
            mq0 = __builtin_fmaxf(__builtin_fmaxf(mq0, SB0[4 * kj]), SB0[4 * kj + 1]); mq1 = __builtin_fmaxf(__builtin_fmaxf(mq1, SB1[4 * kj]), SB1[4 * kj + 1]); \
            mq0 = __builtin_fmaxf(__builtin_fmaxf(mq0, SB0[4 * kj + 2]), SB0[4 * kj + 3]); mq1 = __builtin_fmaxf(__builtin_fmaxf(mq1, SB1[4 * kj + 2]), SB1[4 * kj + 3]); \
            asm volatile("" : "+v"(mq0), "+v"(mq1)); AT_SB(); } \
        __builtin_amdgcn_s_setprio(0); mxc = __builtin_fmaxf(mq0, mq1);            \
        if (t_ + 3 < NT) AT_LSTOREK(lds + ((t_ + 3) & 3) * AT_KB); \
        if (t_ + 2 < NT) AT_LSTOREV(lds + AT_V0 + ((t_ + 2) & 3) * AT_VBS); \
        if (t_ & 1) __syncthreads(); \
    } while (0)
    float mxc = at_max32(sa0, sa1);
    for (int t = 0; t < NT; t += 2) { AT_STEP(sa0, sa1, sb0, sb1, t); AT_STEP(sb0, sb1, sa0, sa1, t + 1); }
    lsum += __shfl_xor(lsum, 32);
    const float inv = 1.0f / lsum;
    bf16_t* op = MIX + (size_t)qrow * 1024 + 256 + h * 64 + 4 * hi;
#pragma unroll
    for (int g4 = 0; g4 < 4; ++g4) { u32x2 w0, w1; w0.x = pk2(o0[4 * g4] * inv, o0[4 * g4 + 1] * inv); w0.y = pk2(o0[4 * g4 + 2] * inv, o0[4 * g4 + 3] * inv);
        w1.x = pk2(o1[4 * g4] * inv, o1[4 * g4 + 1] * inv); w1.y = pk2(o1[4 * g4 + 2] * inv, o1[4 * g4 + 3] * inv);
        *(u32x2*)(op + 8 * g4) = w0; *(u32x2*)(op + 32 + 8 * g4) = w1; }
#undef AT_GLOADK
#undef AT_GLOADV
#undef AT_LSTOREK
#undef AT_LSTOREV
#undef AT_STEP
#undef AT_QKM
#undef AT_EXS
#undef AT_PACK
#undef AT_MAX4
#undef AT_SB
}

constexpr int RT_VP = 264, RT_SP = 144, RT_VB = 2 * 64 * RT_VP;
DEV void retout_unit(const Params& p, int l, unsigned char* lds, int u) {
    const int tid = otid(), lane = tid & 63, wid = tid >> 6, l32 = lane & 31, hi = lane >> 5;
    const int gc = u >> 1, hp = u & 1; const int cb = gc % 66; const bool lat = cb >= 2; const int t0 = (cb - 2) * 128; const int r0 = gc * 128;
    const bf16_t* P = (const bf16_t*)p.out; bf16_t* MIX = (bf16_t*)(p.ws + OFF_HN); const f32x2* rope = (const f32x2*)(p.ws + OFF_ROPE);
    const float* SIN = (const float*)(p.ws + OFF_OV + OV_SIN);
    bf16_t* VTl = (bf16_t*)lds; bf16_t* STl = (bf16_t*)(lds + RT_VB);
    __syncthreads();
    for (int task = tid; task < 2048; task += NWG_T) { const int hh = task >> 10, key = (task >> 3) & 127, ch = task & 7;
        const bf16x8 v = *(const bf16x8*)(P + (size_t)(r0 + key) * INW + 256 + (2 * hp + hh) * 64 + ch * 8);
#pragma unroll
        for (int j = 0; j < 8; ++j) VTl[(hh * 64 + ch * 8 + j) * (RT_VP / 2) + key] = (bf16_t)v[j]; }
    for (int task = tid; task < 8192; task += NWG_T) { const int dv = task & 63, k = (task >> 6) & 31, dir = (task >> 11) & 1, hh = task >> 12;
        STl[(hh * 64 + dv) * (RT_SP / 2) + dir * 32 + k] = (bf16_t)f2bf(SIN[((size_t)(gc * 4 + 2 * hp + hh) * 2 + dir) * 2048 + k * 64 + dv]); }
    __syncthreads();
    const int hh = wid >> 2, h = 2 * hp + hh, qblk = wid & 3; const int n = 32 * qblk + l32; const int rq = r0 + n;
    const float lf = log2_sigmoid(p.ret_decay_f[l * 4 + h]), lb = log2_sigmoid(p.ret_decay_b[l * 4 + h]);
    float qv0[8], qv1[8]; bf16x8 qf0, qf1;
    { const bf16_t* qp = P + (size_t)rq * INW + h * 32 + 8 * hi; const bf16x8 a = *(const bf16x8*)qp, c2 = *(const bf16x8*)(qp + 16);
#pragma unroll
      for (int j = 0; j < 8; ++j) { float x1 = bf2f((unsigned short)a[j]), x2 = bf2f((unsigned short)c2[j]);
          if (lat) { const f32x2 cs = rope[(size_t)(t0 + n) * 16 + 8 * hi + j]; const float y1 = x1 * cs.x - x2 * cs.y, y2 = x2 * cs.x + x1 * cs.y; x1 = y1; x2 = y2; }
          qv0[j] = x1; qv1[j] = x2; }
      qf0 = pack8(qv0[0], qv0[1], qv0[2], qv0[3], qv0[4], qv0[5], qv0[6], qv0[7]); qf1 = pack8(qv1[0], qv1[1], qv1[2], qv1[3], qv1[4], qv1[5], qv1[6], qv1[7]); }
    f32x16 o0, o1;
#pragma unroll
    for (int r = 0; r < 16; ++r) { o0[r] = 0.f; o1[r] = 0.f; }
    const unsigned char* vbase = (const unsigned char*)VTl + (size_t)(hh * 64 + l32) * RT_VP + hi * 8;
    bf16x8 kga[4], kgc[4];
#pragma unroll
    for (int kb = 0; kb < 4; ++kb) { const bf16_t* kp = P + (size_t)(r0 + 32 * kb + l32) * INW + 128 + h * 32 + 8 * hi; kga[kb] = *(const bf16x8*)kp; kgc[kb] = *(const bf16x8*)(kp + 16); }
    __builtin_amdgcn_sched_barrier(0);
#pragma unroll
    for (int kb = 0; kb < 4; ++kb) {
        bf16x8 kf0, kf1;
        { const int key = 32 * kb + l32; const bf16x8 a = kga[kb], c2 = kgc[kb];
          float y1[8], y2[8];
#pragma unroll
          for (int j = 0; j < 8; ++j) { float x1 = bf2f((unsigned short)a[j]), x2 = bf2f((unsigned short)c2[j]);
              if (lat) { const f32x2 cs = rope[(size_t)(t0 + key) * 16 + 8 * hi + j]; const float z1 = x1 * cs.x - x2 * cs.y, z2 = x2 * cs.x + x1 * cs.y; x1 = z1; x2 = z2; }
              y1[j] = x1 * 0.17677669529663687f; y2[j] = x2 * 0.17677669529663687f; }
          kf0 = pack8(y1[0], y1[1], y1[2], y1[3], y1[4], y1[5], y1[6], y1[7]); kf1 = pack8(y2[0], y2[1], y2[2], y2[3], y2[4], y2[5], y2[6], y2[7]); }
        f32x16 s;
#pragma unroll
        for (int r = 0; r < 16; ++r) s[r] = 0.f;
        s = __builtin_amdgcn_mfma_f32_32x32x16_bf16(kf0, qf0, s, 0, 0, 0); s = __builtin_amdgcn_mfma_f32_32x32x16_bf16(kf1, qf1, s, 0, 0, 0);
#pragma unroll
        for (int r = 0; r < 16; ++r) { const int m = 32 * kb + crow(r, hi); const int dl = n - m; const float e = dl >= 0 ? lf * (float)dl : lb * (float)(-dl); s[r] *= __builtin_amdgcn_exp2f(e); }
#pragma unroll
        for (int jp = 0; jp < 2; ++jp) { const bf16x8 pb = pack8(s[8 * jp + 0], s[8 * jp + 1], s[8 * jp + 2], s[8 * jp + 3], s[8 * jp + 4], s[8 * jp + 5], s[8 * jp + 6], s[8 * jp + 7]);
            const unsigned char* vp = vbase + (32 * kb + 16 * jp) * 2;
            const u32x2 a00 = *(const u32x2*)vp, a01 = *(const u32x2*)(vp + 16), a10 = *(const u32x2*)(vp + 32 * RT_VP), a11 = *(const u32x2*)(vp + 32 * RT_VP + 16);
            const bf16x8 A0 = __builtin_bit_cast(bf16x8, (u32x4){a00.x, a00.y, a01.x, a01.y}), A1 = __builtin_bit_cast(bf16x8, (u32x4){a10.x, a10.y, a11.x, a11.y});
            o0 = __builtin_amdgcn_mfma_f32_32x32x16_bf16(A0, pb, o0, 0, 0, 0); o1 = __builtin_amdgcn_mfma_f32_32x32x16_bf16(A1, pb, o1, 0, 0, 0); }
    }
    { const float df = __builtin_amdgcn_exp2f(lf * (float)(n + 1)), db = __builtin_amdgcn_exp2f(lb * (float)(128 - n));
      const unsigned char* sbase = (const unsigned char*)STl + (size_t)(hh * 64 + l32) * RT_SP + hi * 16;
#pragma unroll
      for (int ks = 0; ks < 4; ++ks) { const float dd = ks < 2 ? df : db;
          const bf16x8 qb = (ks & 1) ? pack8(qv1[0] * dd, qv1[1] * dd, qv1[2] * dd, qv1[3] * dd, qv1[4] * dd, qv1[5] * dd, qv1[6] * dd, qv1[7] * dd)
                                     : pack8(qv0[0] * dd, qv0[1] * dd, qv0[2] * dd, qv0[3] * dd, qv0[4] * dd, qv0[5] * dd, qv0[6] * dd, qv0[7] * dd);
          const bf16x8 A0 = *(const bf16x8*)(sbase + ks * 32), A1 = *(const bf16x8*)(sbase + 32 * RT_SP + ks * 32);
          o0 = __builtin_amdgcn_mfma_f32_32x32x16_bf16(A0, qb, o0, 0, 0, 0); o1 = __builtin_amdgcn_mfma_f32_32x32x16_bf16(A1, qb, o1, 0, 0, 0); } }
    float ssq = 0.f;
#pragma unroll
    for (int r = 0; r < 16; ++r) ssq += o0[r] * o0[r] + o1[r] * o1[r];
    ssq += __shfl_xor(ssq, 32);
    const float rstd = rsqrtf(ssq * (1.f / 64.f) + EPS);
    const bf16_t* gp = P + (size_t)rq * INW + 512 + h * 64 + 4 * hi; bf16_t* op = MIX + (size_t)rq * 1024 + h * 64 + 4 * hi;
#pragma unroll
    for (int g4 = 0; g4 < 4; ++g4) { const u32x2 ga = *(const u32x2*)(gp + 8 * g4), gb = *(const u32x2*)(gp + 32 + 8 * g4);
        u32x2 w0, w1;
        w0.x = pk2(o0[4 * g4] * rstd * siluf(bf2f(ga.x & 0xffff)), o0[4 * g4 + 1] * rstd * siluf(bf2f(ga.x >> 16))); w0.y = pk2(o0[4 * g4 + 2] * rstd * siluf(bf2f(ga.y & 0xffff)), o0[4 * g4 + 3] * rstd * siluf(bf2f(ga.y >> 16)));
        w1.x = pk2(o1[4 * g4] * rstd * siluf(bf2f(gb.x & 0xffff)), o1[4 * g4 + 1] * rstd * siluf(bf2f(gb.x >> 16))); w1.y = pk2(o1[4 * g4 + 2] * rstd * siluf(bf2f(gb.y & 0xffff)), o1[4 * g4 + 3] * rstd * siluf(bf2f(gb.y >> 16)));
        *(u32x2*)(op + 8 * g4) = w0; *(u32x2*)(op + 32 + 8 * g4) = w1; }
}

DEV void phase_ffn_fixup(const Params& p, int l) {
    const float* EDGE = (const float*)(p.ws + OFF_EDGE); bf16_t* ACT = (bf16_t*)(p.ws + OFF_OV);
    const float* cw = p.conv_w + (size_t)l * 3 * 5632; const float* cbv = p.conv_b + (size_t)l * 5632;
    for (int idx = blockIdx.x * NWG_T + otid(); idx < 66 * 2 * 704; idx += gridDim.x * NWG_T) {
        const int ch4 = idx % 704, rest = idx / 704; const int which = rest & 1, pm = rest >> 1; const int jj = pm % 33;
        if (l == 1 && jj == 0) continue;
        const int ch = 4 * ch4, pn = ch >> 7, c = ch & 127;
        const bool sstart = jj <= 1, send = (jj == 0) || (jj == 32);
        const f32x4 zz = {0.f, 0.f, 0.f, 0.f};
#define EDG(tile, k, half) (*(const f32x4*)(EDGE + ((size_t)((tile) * 4 + (k)) * 22 + pn) * 256 + (half) * 128 + c))
        f32x4 ua, ub, ca, cb2, da, db;
        if (which == 0) { ua = sstart ? zz : EDG(pm - 1, 3, 0); ub = sstart ? zz : EDG(pm - 1, 3, 1); ca = EDG(pm, 0, 0); cb2 = EDG(pm, 0, 1); da = EDG(pm, 1, 0); db = EDG(pm, 1, 1); }
        else { ua = EDG(pm, 2, 0); ub = EDG(pm, 2, 1); ca = EDG(pm, 3, 0); cb2 = EDG(pm, 3, 1); da = send ? zz : EDG(pm + 1, 0, 0); db = send ? zz : EDG(pm + 1, 0, 1); }
#undef EDG
        const f32x4 wa0 = *(const f32x4*)(cw + ch), wa1 = *(const f32x4*)(cw + 5632 + ch), wa2 = *(const f32x4*)(cw + 2 * 5632 + ch), ba = *(const f32x4*)(cbv + ch);
        const f32x4 wb0 = *(const f32x4*)(cw + DFF + ch), wb1 = *(const f32x4*)(cw + 5632 + DFF + ch), wb2 = *(const f32x4*)(cw + 2 * 5632 + DFF + ch), bb = *(const f32x4*)(cbv + DFF + ch);
        const f32x4 xa = wa0 * ua + wa1 * ca + wa2 * da + ba, xb = wb0 * ub + wb1 * cb2 + wb2 * db + bb;
        u32x2 w; w.x = pk2(siluf(xa.x) * xb.x, siluf(xa.y) * xb.y); w.y = pk2(siluf(xa.z) * xb.z, siluf(xa.w) * xb.w);
        *(u32x2*)(ACT + (size_t)(pm * 256 + (which ? 255 : 0)) * DFF + ch) = w;
    }
}

#define RLX_AGENT __ATOMIC_RELAXED, __HIP_MEMORY_SCOPE_AGENT
#define XB_TMO      128
#define XB_XCNT(j)  (256  + 64 * (j))
#define XB_XSUB(j)  (1280 + 64 * (j))
#define XB_XGEN(j)  (2304 + 64 * (j))
#define XB_TOP      3328
#define XB_TOPGEN   3392
#define XCD_BAR_WORDS 3456
#define XB_SPIN_CAP (1u << 18)

__device__ __forceinline__ unsigned xb_ld(unsigned* p)              { return __hip_atomic_load(p, __ATOMIC_RELAXED, __HIP_MEMORY_SCOPE_AGENT); }
__device__ __forceinline__ unsigned xb_add(unsigned* p, unsigned v) { return __hip_atomic_fetch_add(p, v, __ATOMIC_RELAXED, __HIP_MEMORY_SCOPE_AGENT); }
__device__ __forceinline__ unsigned xb_xcc_id() { return (unsigned)__builtin_amdgcn_s_getreg((3 << 11) | 20) & 0xFu; }
#define XB_SPIN(cond, bar) do { unsigned _sp = 0; while (cond) { __builtin_amdgcn_s_sleep(1); \
    if ((++_sp & 255u) == 0u) { if (xb_ld(&(bar)[XB_TMO])) break; if (_sp > XB_SPIN_CAP) { atomicAdd(&(bar)[XB_TMO], 1u); break; } } } } while (0)

struct XcdBarrier {
    unsigned* bar; unsigned x;
    volatile LAS unsigned* st;
};

__device__ __forceinline__ XcdBarrier xcd_barrier_post(unsigned* bar, volatile LAS unsigned* st) {
    XcdBarrier b; b.bar = bar; b.x = xb_xcc_id(); b.st = st;
    if (threadIdx.x == 0) (void)xb_add(&bar[XB_XCNT(b.x)], 1u);
    return b;
}
__device__ __forceinline__ void xcd_barrier_complete(unsigned* bar, unsigned x, unsigned& nloc, unsigned& nx) {
    const unsigned G = gridDim.x * gridDim.y * gridDim.z;
    unsigned sum, cnt, mine, sp = 0u;
    for (;;) {
        sum = 0u; cnt = 0u; mine = 0u;
#pragma unroll
        for (unsigned j = 0; j < 16; ++j) { const unsigned c = xb_ld(&bar[XB_XCNT(j)]); sum += c; cnt += (c > 0u) ? 1u : 0u; mine = (j == x) ? c : mine; }
        if (sum == G) break;
        __builtin_amdgcn_s_sleep(1);
        if ((++sp & 255u) == 0u) { if (xb_ld(&bar[XB_TMO])) break; if (sp > XB_SPIN_CAP) { atomicAdd(&bar[XB_TMO], 1u); break; } }
    }
    nloc = mine > 0u ? mine : 1u; nx = cnt > 0u ? cnt : 1u;
}

__device__ __forceinline__ void xcd_barrier(const XcdBarrier& b) {
    asm volatile("s_waitcnt vmcnt(0)" ::: "memory");
    __syncthreads();
    if (threadIdx.x == 0) {
        unsigned* bar = b.bar;
        __builtin_amdgcn_s_waitcnt(0);
        unsigned nloc = b.st[0], nx = b.st[1];
        if (nloc == 0u) { xcd_barrier_complete(bar, b.x, nloc, nx); b.st[0] = nloc; b.st[1] = nx; }
        const unsigned old = xb_add(&bar[XB_XSUB(b.x)], 1u);
        const unsigned gen = old / nloc;
        if (old + 1u == (gen + 1u) * nloc) {
            __builtin_amdgcn_fence(__ATOMIC_RELEASE, "agent");
            asm volatile("s_waitcnt vmcnt(0)" ::: "memory");
            const unsigned og = xb_add(&bar[XB_TOP], 1u);
            const unsigned tg = og / nx;
            if (og + 1u == (tg + 1u) * nx) xb_add(&bar[XB_TOPGEN], 1u);
            else XB_SPIN(xb_ld(&bar[XB_TOPGEN]) == tg, bar);
            __builtin_amdgcn_fence(__ATOMIC_ACQUIRE, "agent");
            xb_add(&bar[XB_XGEN(b.x)], 1u);
            asm volatile("s_waitcnt vmcnt(0)" ::: "memory");
        } else {
            XB_SPIN(xb_ld(&bar[XB_XGEN(b.x)]) == gen, bar);
            __builtin_amdgcn_fence(__ATOMIC_ACQUIRE, "agent");
            asm volatile("s_waitcnt vmcnt(0)" ::: "memory");
        }
    }
    __syncthreads();
}


constexpr size_t OFF_CTL = 250000128; constexpr int CTL_BYTES = 16384;
#if defined(__HIP_DEVICE_COMPILE__)
#define KP() const __attribute__((address_space(4))) Params* kp_ = (const __attribute__((address_space(4))) Params*)__builtin_amdgcn_kernarg_segment_ptr(); asm volatile("" : "+s"(kp_)); const Params p = *kp_; \
    bf16_t* HN = (bf16_t*)(p.ws + OFF_HN); bf16_t* P = (bf16_t*)p.out; float* X = (float*)(p.ws + OFF_X); (void)HN; (void)P; (void)X
#else
#define KP() const Params p = p_arg; bf16_t* HN = (bf16_t*)(p.ws + OFF_HN); bf16_t* P = (bf16_t*)p.out; float* X = (float*)(p.ws + OFF_X); (void)HN; (void)P; (void)X
#endif
#define WL() const bf16_t* wl = (const bf16_t*)(p.ws + OFF_W) + (size_t)l * W_LAYER; const float* modv = (const float*)(p.ws + OFF_MOD) + (size_t)l * 3 * 6144; (void)wl; (void)modv
#ifndef DUPM
#define DUPM 0
#endif
#define REP(bit) for (int rep_ = 0; rep_ < (((DUPM) >> (bit)) & 1) + 1; ++rep_)
constexpr int PH_PER_LAYER = 10, N_PHASES = 2 + 2 * PH_PER_LAYER;
__global__ void __launch_bounds__(512, 2) mk_fwd(Params p_arg) {
    extern __shared__ __attribute__((aligned(16))) unsigned char lds[];
    cg::grid_group grid = cg::this_grid();
    const int G = gridDim.x, bx = blockIdx.x; const int vcu = (G % 8 == 0) ? (bx % 8) * (G / 8) + bx / 8 : bx;
    LAS unsigned char* ldsl = (LAS unsigned char*)lds;
    const int ph_lo = p_arg.ph_lo, ph_hi = p_arg.ph_hi;
    volatile LAS unsigned* misc = (volatile LAS unsigned*)(ldsl + (LDS_BYTES - 64));
    { const int t0_ = otid(); if (t0_ < 16) misc[t0_] = 0u; }
    __syncthreads();
    if (ph_hi - ph_lo > 1) (void)xcd_barrier_post((unsigned*)(p_arg.ws + OFF_CTL), misc);
    for (int ph = ph_lo; ph < ph_hi; ++ph) {
        if (ph == 0) { KP(); phase_prep(p, lds); __syncthreads(); }
        else if (ph == N_PHASES - 1) { KP(); phase_final(p);
#if (DUPM >> 10) & 1
            for (int i = 0; i < 20; ++i) grid.sync();
#endif
        }
        else {
            const int l = (ph - 1) / PH_PER_LAYER, sp = (ph - 1) % PH_PER_LAYER;
            if (sp == 0) { KP(); if (l == 0) REP(9) { phase_prep_weights(p, lds); __syncthreads(); }
                phase_norm(p, l, 0, l == 0, l == 1 ? (const float*)(p.ws + OFF_MOD) + 2 * 6144 + 5120 : nullptr); }
            else if (sp == 1) { KP(); WL(); REP(1) { __syncthreads();
                pg8::Gemm g{HN, wl + W_IN, R, 1792, 1024, 1024, 1024}; pg8::StaticOrder S; S.init(R, 1792, G, bx);
                pg8::EpiStore E{P, INW, INW, 1.0f};
                pg8::gemm_phase<pg8::EpiStore, pg8::StaticOrder, true, true>(ldsl, g, S, E); } }
            else if (sp == 2) { KP(); phase_rowwise(p, l); __syncthreads();
                REP(2) phase_pool(p);
                REP(3) for (int it = G - 1 - bx; it < 264; it += G) states_item(p, l, lds, it); __syncthreads(); }
            else if (sp == 3) { KP(); WL(); REP(4) { __syncthreads();
                { pg8::Gemm g{P + 768, wl + W_UQ, R, 768, 384, INW, 384}; pg8::StaticOrder S; S.init(R, 768, G, bx);
                  pg8::EpiStore E{(bf16_t*)(p.ws + OFF_OV + OV_Q), 768, 768, 0.14724444f};
                  pg8::gemm_phase<pg8::EpiStore, pg8::StaticOrder, true, true>(ldsl, g, S, E); }
                __syncthreads();
                { pg8::Gemm g{P + 1152, wl + W_KN, R, 512, 256, INW, 256}; pg8::StaticOrder S; S.init(R, 512, G, (bx + 58) % G);
                  pg8::EpiStore E{(bf16_t*)(p.ws + OFF_OV + OV_KN), 512, 512, 1.0f};
                  pg8::gemm_phase<pg8::EpiStore, pg8::StaticOrder, true, true>(ldsl, g, S, E); }
                __syncthreads();
                { pg8::Gemm g{wl + W_V, P + 1152, 512, R, 256, 256, INW}; pg8::StaticOrder S; S.init(512, R, G, (bx + 182) % G);
                  pg8::EpiStore E{(bf16_t*)(p.ws + OFF_OV + OV_VT), R, R, 1.0f};
                  pg8::gemm_phase<pg8::EpiStore, pg8::StaticOrder, true, true>(ldsl, g, S, E); }
                if (bx >= G - 64) scan_threads(p, l, (bx - (G - 64)) * NWG_T + otid()); } }
            else if (sp == 4) { KP();
                REP(5) for (int u = vcu; u < (l == 0 ? 528 : 512); u += G) attn_unit(p, lds, u);
                REP(6) for (int u = G - 1 - bx; u < (l == 0 ? 264 : 256); u += G) retout_unit(p, l, lds, l == 0 ? u : u + 4 * (u >> 7) + 4); }
            else if (sp == 5) { KP(); WL(); __syncthreads();
                { pg8::Gemm g{HN, wl + W_OUT, R, 1024, 1024, 1024, 1024}; pg8::StaticOrder S; S.init(16384, 1024, G, bx, 1);
                  pg8::EpiResid E{X, modv + 2048, 0};
                  pg8::gemm_phase<pg8::EpiResid, pg8::StaticOrder, true, true>(ldsl, g, S, E); }
                if (l == 0 && bx < 32) { __syncthreads(); const int q = bx >> 3;
                  pg8::Gemm g{HN + q * 256, wl + W_OUT + q * 256, 512, 1024, 256, 1024, 1024}; pg8::StaticOrder S; S.init(512, 1024, G, bx & 7, 2);
                  pg8::EpiPart E{(float*)(p.ws + OFF_PART) + (size_t)q * 524288, 0};
                  pg8::gemm_phase<pg8::EpiPart, pg8::StaticOrder, true, true>(ldsl, g, S, E); } }
            else if (sp == 6) { KP(); WL(); phase_norm(p, l, 1, false, l == 0 ? modv + 2 * 6144 + 2048 : nullptr); }
            else if (sp == 7) { KP(); WL(); REP(7) { __syncthreads();
                pg8::Gemm g{HN, wl + W_UP, R, 2 * DFF, 1024, 1024, 1024}; pg8::StaticOrder S; S.init(l == 1 ? 16384 : R, 2 * DFF, G, bx, l == 1 ? 1 : 0);
                pg8::EpiFfn E{(bf16_t*)(p.ws + OFF_OV), (float*)(p.ws + OFF_EDGE), p.conv_w + (size_t)l * 3 * 5632, p.conv_b + (size_t)l * 5632, (LAS float*)(ldsl + 131072)};
                pg8::gemm_phase<pg8::EpiFfn, pg8::StaticOrder, true, true>(ldsl, g, S, E); } }
            else if (sp == 8) { KP(); REP(8) phase_ffn_fixup(p, l); }
            else if (sp == 9) { KP(); WL(); __syncthreads();
                { pg8::Gemm g{(const bf16_t*)(p.ws + OFF_OV), wl + W_DN, R, 1024, DFF, DFF, DFF}; pg8::StaticOrder S; S.init(16384, 1024, G, bx, 1);
                  pg8::EpiResid E{X, modv + 5120, 0};
                  pg8::gemm_phase<pg8::EpiResid, pg8::StaticOrder, true, true>(ldsl, g, S, E); }
                if (l == 0 && bx < 32) { __syncthreads(); const int q = bx >> 3; const int koff = q < 2 ? q * 768 : 1536 + (q - 2) * 640, klen = q < 2 ? 768 : 640;
                  pg8::Gemm g{(const bf16_t*)(p.ws + OFF_OV) + koff, wl + W_DN + koff, 512, 1024, klen, DFF, DFF}; pg8::StaticOrder S; S.init(512, 1024, G, bx & 7, 2);
                  pg8::EpiPart E{(float*)(p.ws + OFF_PART) + (size_t)q * 524288, 0};
                  pg8::gemm_phase<pg8::EpiPart, pg8::StaticOrder, true, true>(ldsl, g, S, E); } }
        }
        if (ph + 1 < ph_hi) {
            if (ph_lo < 0) grid.sync();
            { KP(); XcdBarrier b; b.bar = (unsigned*)(p.ws + OFF_CTL); b.x = xb_xcc_id(); b.st = misc; xcd_barrier(b); }
        }
    }
}

extern "C" void kernel_launch(void* const* d_in, const int* in_sizes, int n_in, void* d_out, int out_size, void* d_ws, size_t ws_size, hipStream_t stream) {
    static int grid = 0;
    if (grid == 0) {
        if (n_in != 23 || ws_size < WS_NEED) { fprintf(stderr, "kernel_launch: unexpected problem (n_in %d, ws %zu, need %zu)\n", n_in, ws_size, (size_t)WS_NEED); grid = -1; return; }
        int dev = 0, cus = 0, per_cu = 0;
        hipGetDevice(&dev); hipDeviceGetAttribute(&cus, hipDeviceAttributeMultiprocessorCount, dev);
        if (hipFuncSetAttribute((const void*)mk_fwd, hipFuncAttributeMaxDynamicSharedMemorySize, LDS_BYTES) != hipSuccess) { fprintf(stderr, "kernel_launch: hipFuncSetAttribute failed\n"); grid = -1; return; }
        if (hipOccupancyMaxActiveBlocksPerMultiprocessor(&per_cu, (const void*)mk_fwd, 512, LDS_BYTES) != hipSuccess || per_cu < 1) { fprintf(stderr, "kernel_launch: occupancy query says %d\n", per_cu); per_cu = 1; }
        (void)hipGetLastError();
        grid = cus * per_cu; if (grid > 256) grid = 256;
        fprintf(stderr, "kernel_launch: grid %d (cus %d, per_cu %d)\n", grid, cus, per_cu);
    }
    if (grid < 0) return;
    Params p{};
    const float** pp = (const float**)&p;
    for (int i = 0; i < 23; ++i) pp[i] = (const float*)d_in[i];
    p.out = (float*)d_out; p.ws = (unsigned char*)d_ws;
#if MK_MULTI
    for (int ph = 0; ph < N_PHASES; ++ph) { p.ph_lo = ph; p.ph_hi = ph + 1; void* args[] = {&p};
        hipError_t e = hipLaunchCooperativeKernel((void*)mk_fwd, dim3(grid), dim3(512), args, LDS_BYTES, stream);
        if (e != hipSuccess) { fprintf(stderr, "launch %d failed: %s\n", ph, hipGetErrorString(e)); break; } }
#else
    if (hipMemsetAsync((char*)d_ws + OFF_CTL, 0, CTL_BYTES, stream) != hipSuccess) { fprintf(stderr, "kernel_launch: memset of the barrier words failed\n"); return; }
    p.ph_lo = 0; p.ph_hi = N_PHASES; void* args[] = {&p};
    hipError_t e = hipLaunchCooperativeKernel((void*)mk_fwd, dim3(grid), dim3(512), args, LDS_BYTES, stream);
    if (e != hipSuccess) fprintf(stderr, "cooperative launch failed: %s (grid %d)\n", hipGetErrorString(e), grid);
#endif
}
```

```cpp
#include <hip/hip_runtime.h>
#include <hip/hip_cooperative_groups.h>
#include <cstdio>
#include <cstdint>
namespace cg = cooperative_groups;

#ifndef MK_MULTI
#define MK_MULTI 0
#endif

namespace pg8 {
#define PG8_LAS __attribute__((address_space(3)))
typedef unsigned short bf16_t;
typedef short bf16x8 __attribute__((ext_vector_type(8)));
typedef float f32x4 __attribute__((ext_vector_type(4)));
typedef unsigned u32x4 __attribute__((ext_vector_type(4)));
constexpr int BM = 256, BK = 64, HALF = 128, HTB = HALF * BK * 2  , STAGE_BYTES = 8 * HTB, NXCD = 8, WGM = 8;

__host__ __device__ __forceinline__ int lds_byte(int r, int c) { const int st = (r >> 4) * 2 + (c >> 5), rr = r & 15, cc = c & 31, ob = rr * 64 + cc * 2; return st * 1024 + (ob ^ (((ob >> 9) & 1) << 5)); }
__host__ __device__ __forceinline__ void stage_rc(int b, int& R, int& C) { const int st = b / 1024, sb = b % 1024, swz = sb ^ (((sb >> 9) & 1) << 5); R = (st >> 1) * 16 + swz / 64; C = (st & 1) * 32 + (swz % 64) / 2; }
__host__ __device__ __forceinline__ int perm32(int rho) { const int n = rho >> 4, i = rho & 15; return 8 * (i >> 2) + 4 * n + (i & 3); }

struct Unit { int pm, pn; };
struct Gemm { const bf16_t* A; const bf16_t* Bt; int M, N, K, lda, ldb; };

struct StaticOrder {
    int nM, nN, nwg, G, c, skip;
    __host__ __device__ void init(int M, int N, int G_, int c_, int skip_ = 0) { nM = M / BM; nN = N / BM; nwg = nM * nN; G = G_; c = c_; skip = skip_; }
    __host__ __device__ bool next(int i, Unit& u) const {
        const long L = (long)i * G + c; if (L >= nwg) return false;
        int wgid = (int)L; { const int q = nwg / NXCD, r = nwg % NXCD, xcd = wgid % NXCD, off = wgid / NXCD; wgid = (xcd < r ? xcd * (q + 1) : r * (q + 1) + (xcd - r) * q) + off; }
        const int nig = WGM * nN, gid = wgid / nig, fm = gid * WGM, gsz = (nM - fm) < WGM ? (nM - fm) : WGM;
        u.pm = fm + ((wgid % nig) % gsz); u.pn = (wgid % nig) / gsz; if (skip == 1) u.pm += 1 + (u.pm >= 32 ? 1 : 0); else if (skip == 2) u.pm *= 33; return true;
    }
    __device__ __forceinline__ void a_ready(const Unit&) const {}
    __device__ __forceinline__ void done(const Unit&) const {}
};

__device__ __forceinline__ unsigned cvt_pk_bf16(float lo, float hi) { unsigned r; asm volatile("v_cvt_pk_bf16_f32 %0, %1, %2" : "=v"(r) : "v"(lo), "v"(hi)); return r; }

struct EpiStore {
    static constexpr bool PERM = true, AFTER_DRAIN = false;
    bf16_t* O; int ldc; int ncols; float scale;
    __device__ __forceinline__ void operator()(const f32x4 (&acc)[2][2][4][2], const Unit& u, int wr, int wc, int fr, int fq) const {
        const int row0 = u.pm * BM + wr * 64 + fr; const int col0 = u.pn * BM + wc * 32 + 8 * fq;
#pragma unroll
        for (int ai = 0; ai < 2; ++ai)
#pragma unroll
            for (int m = 0; m < 4; ++m) { bf16_t* rowp = O + (size_t)(row0 + ai * HALF + m * 16) * ldc + col0;
#pragma unroll
                for (int bj = 0; bj < 2; ++bj) { if (col0 + bj * HALF < ncols) {
                    f32x4 v0 = acc[ai][bj][m][0] * scale, v1 = acc[ai][bj][m][1] * scale;
                    u32x4 w; w.x = cvt_pk_bf16(v0[0], v0[1]); w.y = cvt_pk_bf16(v0[2], v0[3]); w.z = cvt_pk_bf16(v1[0], v1[1]); w.w = cvt_pk_bf16(v1[2], v1[3]);
                    *(u32x4*)(rowp + bj * HALF) = w; } } }
    }
};
struct EpiResid {
    static constexpr bool PERM = false, AFTER_DRAIN = false;
    float* X; const float* gate; int row_tile0;
    __device__ __forceinline__ void operator()(const f32x4 (&acc)[2][2][4][2], const Unit& u, int wr, int wc, int fr, int fq) const {
        const int tpm = u.pm + row_tile0; const int bb = tpm / 33, jj = tpm - bb * 33; const float* gv = gate + (jj == 0 ? 2 : bb) * 6144;
        const int col0 = u.pn * BM + wc * 32 + 4 * fq;
#pragma unroll
        for (int ai = 0; ai < 2; ++ai)
#pragma unroll
            for (int m = 0; m < 4; ++m) { float* rowp = X + (size_t)(tpm * BM + ai * HALF + wr * 64 + m * 16 + fr) * 1024 + col0;
#pragma unroll
                for (int bj = 0; bj < 2; ++bj) {
#pragma unroll
                    for (int n = 0; n < 2; ++n) { f32x4* q = (f32x4*)(rowp + bj * HALF + n * 16); const f32x4 gq = *(const f32x4*)(gv + col0 + bj * HALF + n * 16); f32x4 xv = *q; xv = xv + gq * acc[ai][bj][m][n]; *q = xv; }
                    asm volatile("" ::: "memory"); } }
    }
};
struct EpiPart {
    static constexpr bool PERM = false, AFTER_DRAIN = false;
    float* out; int accum;
    __device__ __forceinline__ void operator()(const f32x4 (&acc)[2][2][4][2], const Unit& u, int wr, int wc, int fr, int fq) const {
        const int t = u.pm / 33; const int col0 = u.pn * BM + wc * 32 + 4 * fq;
#pragma unroll
        for (int ai = 0; ai < 2; ++ai)
#pragma unroll
            for (int m = 0; m < 4; ++m) { float* rowp = out + (size_t)(t * BM + ai * HALF + wr * 64 + m * 16 + fr) * 1024 + col0;
#pragma unroll
                for (int bj = 0; bj < 2; ++bj) {
#pragma unroll
                    for (int n = 0; n < 2; ++n) { f32x4* q = (f32x4*)(rowp + bj * HALF + n * 16); f32x4 v = acc[ai][bj][m][n]; if (accum) v = v + *q; *q = v; }
                    asm volatile("" ::: "memory"); } }
    }
};
template <int CTRL> __device__ __forceinline__ float dpp0(float x) { return __builtin_bit_cast(float, __builtin_amdgcn_update_dpp(0, __builtin_bit_cast(int, x), CTRL, 0xf, 0xf, true)); }
struct EpiFfn {
    static constexpr bool PERM = false, AFTER_DRAIN = false;
    bf16_t* ACT; float* EDGE; const float* cw; const float* cb; PG8_LAS float* xl;
    __device__ __forceinline__ void operator()(const f32x4 (&acc)[2][2][4][2], const Unit& u, int wr, int wc, int fr, int fq) const {
        PG8_LAS float* FIRST = xl; PG8_LAS float* LAST = xl + 1024;
        const int cb0 = wc * 32 + 4 * fq;
#pragma unroll
        for (int ai = 0; ai < 2; ++ai)
#pragma unroll
            for (int bj = 0; bj < 2; ++bj)
#pragma unroll
                for (int n = 0; n < 2; ++n) { const int col = bj * HALF + cb0 + n * 16;
                    if (fr == 0) *(PG8_LAS f32x4*)(FIRST + (2 * ai + wr) * 256 + col) = acc[ai][bj][0][n];
                    if (fr == 15) *(PG8_LAS f32x4*)(LAST + (2 * ai + wr) * 256 + col) = acc[ai][bj][3][n]; }
        if (wr == 0 && fr < 2) {
#pragma unroll
            for (int bj = 0; bj < 2; ++bj)
#pragma unroll
                for (int n = 0; n < 2; ++n) *(f32x4*)(EDGE + ((size_t)(u.pm * 4 + fr) * 22 + u.pn) * 256 + bj * HALF + cb0 + n * 16) = acc[0][bj][0][n]; }
        if (wr == 1 && fr >= 14) {
#pragma unroll
            for (int bj = 0; bj < 2; ++bj)
#pragma unroll
                for (int n = 0; n < 2; ++n) *(f32x4*)(EDGE + ((size_t)(u.pm * 4 + 2 + (fr - 14)) * 22 + u.pn) * 256 + bj * HALF + cb0 + n * 16) = acc[1][bj][3][n]; }
        asm volatile("s_waitcnt lgkmcnt(0)" ::: "memory"); __builtin_amdgcn_s_barrier(); asm volatile("" ::: "memory");
#pragma unroll
        for (int n = 0; n < 2; ++n) { const int ch0 = u.pn * HALF + cb0 + n * 16;
            f32x4 wa[3], wb[3];
#pragma unroll
            for (int k = 0; k < 3; ++k) { wa[k] = *(const f32x4*)(cw + k * 5632 + ch0); wb[k] = *(const f32x4*)(cw + k * 5632 + 2816 + ch0); }
            const f32x4 ba = *(const f32x4*)(cb + ch0), bb = *(const f32x4*)(cb + 2816 + ch0);
#pragma unroll
            for (int ai = 0; ai < 2; ++ai) { const int g = 2 * ai + wr;
                f32x4 bu[2], bd[2];
#pragma unroll
                for (int bj = 0; bj < 2; ++bj) { const int col = bj * HALF + cb0 + n * 16; const f32x4 zz = {0.f, 0.f, 0.f, 0.f};
                    bu[bj] = g > 0 ? *(const PG8_LAS f32x4*)(LAST + (g - 1) * 256 + col) : zz; bd[bj] = g < 3 ? *(const PG8_LAS f32x4*)(FIRST + (g + 1) * 256 + col) : zz; }
#pragma unroll
                for (int m = 0; m < 4; ++m) { float o[4];
#pragma unroll
                    for (int e = 0; e < 4; ++e) { float up[2], dn[2];
#pragma unroll
                        for (int bj = 0; bj < 2; ++bj) { const float cur = acc[ai][bj][m][n][e];
                            float x = dpp0<0x111>(cur);
                            if (m > 0) x += dpp0<0x10F>(acc[ai][bj][m - 1][n][e]); else x += (fr == 0 ? bu[bj][e] : 0.f);
                            float y = dpp0<0x101>(cur);
                            if (m < 3) y += dpp0<0x11F>(acc[ai][bj][m + 1][n][e]); else y += (fr == 15 ? bd[bj][e] : 0.f);
                            up[bj] = x; dn[bj] = y; }
                        const float ua = wa[0][e] * up[0] + wa[1][e] * acc[ai][0][m][n][e] + wa[2][e] * dn[0] + ba[e];
                        const float ub = wb[0][e] * up[1] + wb[1][e] * acc[ai][1][m][n][e] + wb[2][e] * dn[1] + bb[e];
                        o[e] = ua * __builtin_amdgcn_rcpf(1.0f + __builtin_amdgcn_exp2f(-1.4426950408889634f * ua)) * ub; }
                    typedef unsigned u32x2 __attribute__((ext_vector_type(2))); u32x2 w; w.x = cvt_pk_bf16(o[0], o[1]); w.y = cvt_pk_bf16(o[2], o[3]);
                    *(u32x2*)(ACT + (size_t)(u.pm * BM + ai * HALF + wr * 64 + m * 16 + fr) * 2816 + ch0) = w; } } }
    }
};

template <class Epi, class Sched, bool ALIGN_EPI = false, bool SP2 = false>
__device__ __forceinline__ void gemm_phase(PG8_LAS unsigned char* lds, const Gemm g, const Sched& S, const Epi& E) {
    int tid = threadIdx.x; asm volatile("" : "+v"(tid));
    const int wid = __builtin_amdgcn_readfirstlane(tid >> 6), lane = tid & 63, wr = wid >> 2, wc = wid & 3, fr = lane & 15, fq = lane >> 4;
    int K = g.K; asm volatile("" : "+s"(K));
    const int nt = K / BK;
    unsigned voffA[2], voffB[2];
#pragma unroll
    for (int i = 0; i < 2; ++i) { int R, C; stage_rc(tid * 16 + i * 8192, R, C); const int Rb = Epi::PERM ? ((R & ~31) + perm32(R & 31)) : R;
        voffA[i] = (unsigned)(R * g.lda + C) * 2u; voffB[i] = (unsigned)(Rb * g.ldb + C) * 2u; }
    const size_t kstep = (size_t)(BK * 2);
    const size_t hstepA = (size_t)HALF * g.lda * 2, hstepB = (size_t)HALF * g.ldb * 2;
    const size_t tstepA = 2 * hstepA, tstepB = 2 * hstepB;
    const unsigned ldsw = (unsigned)wid * 1024u;
    const int aoff = lds_byte(wr * 64 + fr, fq * 8), boff = lds_byte(wc * 32 + fr, fq * 8);
#define PG8_SA(b, h) (((b) * 2 + (h)) * HTB)
#define PG8_SB(b, h) ((4 + (b) * 2 + (h)) * HTB)
#define PG8_STAGE(bufoff, gbase, voff) do { _Pragma("unroll") for (int _i = 0; _i < 2; ++_i) \
        __builtin_amdgcn_global_load_lds((const unsigned*)((const char*)(gbase) + (voff)[_i]), (PG8_LAS unsigned*)(lds + (bufoff) + ldsw + _i * 8192), 16, 0, 0); } while (0)
#define PG8_LDA(dst, b, h) do { _Pragma("unroll") for (int m = 0; m < 4; ++m) _Pragma("unroll") for (int k = 0; k < 2; ++k) dst[m][k] = *(const PG8_LAS bf16x8*)(lds + PG8_SA(b, h) + aoff + m * 2048 + k * 1024); } while (0)
#define PG8_LDB(dst, b, h) do { _Pragma("unroll") for (int n = 0; n < 2; ++n) _Pragma("unroll") for (int k = 0; k < 2; ++k) dst[n][k] = *(const PG8_LAS bf16x8*)(lds + PG8_SB(b, h) + boff + n * 2048 + k * 1024); } while (0)
#define PG8_MMA(ai, bj, At, Bt) do { __builtin_amdgcn_s_setprio(1); _Pragma("unroll") for (int m = 0; m < 4; ++m) _Pragma("unroll") for (int n = 0; n < 2; ++n) _Pragma("unroll") for (int k = 0; k < 2; ++k) \
        acc[ai][bj][m][n] = __builtin_amdgcn_mfma_f32_16x16x32_bf16(Bt[n][k], At[m][k], acc[ai][bj][m][n], 0, 0, 0); __builtin_amdgcn_s_setprio(0); } while (0)
#define PG8_WAIT_V(n) asm volatile("s_waitcnt vmcnt(" #n ")" ::: "memory")
#define PG8_WAIT_L(n) asm volatile("s_waitcnt lgkmcnt(" #n ")" ::: "memory")
#define PG8_BAR __builtin_amdgcn_s_barrier()
#define PG8_SCHED __builtin_amdgcn_sched_barrier(0)
    Unit cur, nxt; int ui = 0;
    if (!S.next(0, cur)) return;
    f32x4 acc[2][2][4][2];
#pragma unroll
    for (int a = 0; a < 2; ++a)
#pragma unroll
        for (int b = 0; b < 2; ++b)
#pragma unroll
            for (int m = 0; m < 4; ++m)
#pragma unroll
                for (int n = 0; n < 2; ++n) acc[a][b][m][n] = (f32x4){0.f, 0.f, 0.f, 0.f};
    bf16x8 At[4][2], B0[2][2], B1[2][2];
    const char* cA = (const char*)g.A + (size_t)cur.pm * tstepA; const char* cB = (const char*)g.Bt + (size_t)cur.pn * tstepB;
    S.a_ready(cur);
    if constexpr (SP2) {
        PG8_STAGE(PG8_SB(0, 0), cB, voffB); PG8_STAGE(PG8_SB(0, 1), cB + hstepB, voffB); PG8_STAGE(PG8_SA(0, 0), cA, voffA); PG8_STAGE(PG8_SA(0, 1), cA + hstepA, voffA);
        if (wr == 1) PG8_BAR;
        PG8_WAIT_V(2); PG8_BAR;
        PG8_STAGE(PG8_SB(1, 0), cB + kstep, voffB); PG8_STAGE(PG8_SA(1, 0), cA + kstep, voffA); PG8_STAGE(PG8_SB(1, 1), cB + hstepB + kstep, voffB);
        PG8_WAIT_V(6); PG8_BAR;
    } else {
        PG8_STAGE(PG8_SB(0, 0), cB, voffB); PG8_STAGE(PG8_SA(0, 0), cA, voffA); PG8_STAGE(PG8_SB(0, 1), cB + hstepB, voffB); PG8_STAGE(PG8_SA(0, 1), cA + hstepA, voffA);
        if (wr == 1) PG8_BAR;
        PG8_WAIT_V(4); PG8_BAR;
        PG8_STAGE(PG8_SB(1, 0), cB + kstep, voffB); PG8_STAGE(PG8_SA(1, 0), cA + kstep, voffA); PG8_STAGE(PG8_SB(1, 1), cB + hstepB + kstep, voffB);
        PG8_WAIT_V(6); PG8_BAR;
    }
    for (;;) {
        const bool has_next = S.next(ui + 1, nxt);
        const char* nA = has_next ? (const char*)g.A + (size_t)nxt.pm * tstepA : cA; const char* nB = has_next ? (const char*)g.Bt + (size_t)nxt.pn * tstepB : cB;
        for (int t = 0; t < nt; t += 2) {
            const bool last = (t == nt - 2);
            const char* a1 = cA + (size_t)(t + 1) * kstep;
            const char* a2 = last ? nA : cA + (size_t)(t + 2) * kstep; const char* b2 = last ? nB : cB + (size_t)(t + 2) * kstep;
            const char* a3 = a2 + kstep; const char* b3 = b2 + kstep;
            if (last && has_next) S.a_ready(nxt);
            if constexpr (SP2) {
            PG8_LDB(B0, 0, 0); PG8_LDB(B1, 0, 1); PG8_SCHED; PG8_LDA(At, 0, 0); PG8_STAGE(PG8_SA(1, 1), a1 + hstepA, voffA);
            PG8_WAIT_V(8); PG8_WAIT_L(0); PG8_BAR; PG8_MMA(0, 0, At, B0); PG8_MMA(0, 1, At, B1); PG8_BAR; PG8_SCHED;
            PG8_LDA(At, 0, 1); PG8_STAGE(PG8_SB(0, 0), b2, voffB); PG8_STAGE(PG8_SB(0, 1), b2 + hstepB, voffB); PG8_STAGE(PG8_SA(0, 0), a2, voffA);
            PG8_WAIT_V(8); PG8_WAIT_L(0); PG8_BAR; PG8_MMA(1, 0, At, B0); PG8_MMA(1, 1, At, B1); PG8_BAR; PG8_SCHED;
            PG8_LDB(B0, 1, 0); PG8_LDB(B1, 1, 1); PG8_SCHED; PG8_LDA(At, 1, 0); PG8_STAGE(PG8_SA(0, 1), a2 + hstepA, voffA);
            PG8_WAIT_V(8); PG8_WAIT_L(0); PG8_BAR; PG8_MMA(0, 0, At, B0); PG8_MMA(0, 1, At, B1); PG8_BAR; PG8_SCHED;
            PG8_LDA(At, 1, 1); PG8_STAGE(PG8_SB(1, 0), b3, voffB); PG8_STAGE(PG8_SB(1, 1), b3 + hstepB, voffB); PG8_STAGE(PG8_SA(1, 0), a3, voffA);
            PG8_WAIT_V(8); PG8_WAIT_L(0); PG8_BAR; PG8_MMA(1, 0, At, B0); PG8_MMA(1, 1, At, B1); PG8_BAR; PG8_SCHED;
            } else {
            PG8_LDB(B0, 0, 0); PG8_SCHED; PG8_LDA(At, 0, 0); PG8_STAGE(PG8_SA(1, 1), a1 + hstepA, voffA);
            PG8_WAIT_L(8); PG8_BAR; PG8_WAIT_L(0); PG8_MMA(0, 0, At, B0); PG8_BAR; PG8_SCHED;
            PG8_LDB(B1, 0, 1); PG8_STAGE(PG8_SB(0, 0), b2, voffB);
            PG8_BAR; PG8_WAIT_L(0); PG8_MMA(0, 1, At, B1); PG8_BAR;
            PG8_LDA(At, 0, 1); PG8_STAGE(PG8_SA(0, 0), a2, voffA);
            PG8_BAR; PG8_WAIT_L(0); PG8_MMA(1, 0, At, B0); PG8_BAR; PG8_SCHED;
            PG8_STAGE(PG8_SB(0, 1), b2 + hstepB, voffB);
            PG8_WAIT_V(6); PG8_BAR; PG8_MMA(1, 1, At, B1); PG8_BAR;
            PG8_LDB(B0, 1, 0); PG8_SCHED; PG8_LDA(At, 1, 0); PG8_STAGE(PG8_SA(0, 1), a2 + hstepA, voffA);
            PG8_WAIT_L(8); PG8_BAR; PG8_WAIT_L(0); PG8_MMA(0, 0, At, B0); PG8_BAR; PG8_SCHED;
            PG8_LDB(B1, 1, 1); PG8_STAGE(PG8_SB(1, 0), b3, voffB);
            PG8_BAR; PG8_WAIT_L(0); PG8_MMA(0, 1, At, B1); PG8_BAR;
            PG8_LDA(At, 1, 1); PG8_STAGE(PG8_SA(1, 0), a3, voffA);
            PG8_BAR; PG8_WAIT_L(0); PG8_MMA(1, 0, At, B0); PG8_BAR; PG8_SCHED;
            PG8_STAGE(PG8_SB(1, 1), b3 + hstepB, voffB);
            PG8_WAIT_V(6); PG8_BAR; PG8_MMA(1, 1, At, B1); PG8_BAR;
            }
        }
        if constexpr (ALIGN_EPI) { if (wr == 0) PG8_BAR; }
        if constexpr (!Epi::AFTER_DRAIN) { E(acc, cur, wr, wc, fr, fq); S.done(cur); }
        if (!has_next) break;
#pragma unroll
        for (int a = 0; a < 2; ++a)
#pragma unroll
            for (int b = 0; b < 2; ++b)
#pragma unroll
                for (int m = 0; m < 4; ++m)
#pragma unroll
                    for (int n = 0; n < 2; ++n) acc[a][b][m][n] = (f32x4){0.f, 0.f, 0.f, 0.f};
        cur = nxt; cA = nA; cB = nB; ++ui;
        if constexpr (ALIGN_EPI) { if (wr == 1) PG8_BAR; }
    }
    PG8_WAIT_V(0);
    if constexpr (!ALIGN_EPI) { if (wr == 0) PG8_BAR; }
    PG8_BAR;
    if constexpr (Epi::AFTER_DRAIN) { E.fused(acc, cur, wr, wc, fr, fq, lds, wid, lane); S.done(cur); }
#undef PG8_SA
#undef PG8_SB
#undef PG8_STAGE
#undef PG8_LDA
#undef PG8_LDB
#undef PG8_MMA
#undef PG8_WAIT_V
#undef PG8_WAIT_L
#undef PG8_BAR
#undef PG8_SCHED
}
}

#define DEV __device__ __forceinline__
#define LAS __attribute__((address_space(3)))
typedef unsigned short bf16_t;
typedef short bf16x8 __attribute__((ext_vector_type(8)));
typedef float f32x4 __attribute__((ext_vector_type(4)));
typedef float f32x2 __attribute__((ext_vector_type(2)));
typedef float f32x16 __attribute__((ext_vector_type(16)));
typedef unsigned u32x4 __attribute__((ext_vector_type(4)));
typedef unsigned u32x2 __attribute__((ext_vector_type(2)));

constexpr int R = 16896, RB = 8448, NCTX = 256, TL = 8192, DM = 1024, INW = 1696, DFF = 2816, HFF = 1408;
constexpr int NWG_T = 512;
constexpr float EPS = 1e-6f;
constexpr int LDS_BYTES = 147456;
constexpr size_t OFF_X = 0, OFF_HN = 69206016, OFF_W = 103809024, OFF_MOD = 152174592, OFF_ROPE = 152436736, OFF_OV = 153485312;
constexpr size_t OV_Q = 0, OV_KN = 25952256, OV_VT = 43253760, OV_SLOC = 60555264, OV_SIN = 69206016, OV_U = 0;
constexpr size_t OFF_PART = 250100224;
constexpr size_t OFF_EDGE = 258488832;
constexpr size_t WS_NEED = OFF_EDGE + 5947392;
constexpr size_t W_IN = 0, W_UQ = 1835008, W_KN = 2129920, W_V = 2260992, W_OUT = 2392064, W_UP = 3440640, W_DN = 9207808, W_LAYER = 12091392;

struct Params {
    const float *x, *c, *ctx, *c_ctx, *w_mod, *b_mod, *norm1_g, *w_in, *ret_decay_f, *ret_decay_b, *mla_q_norm_g, *w_uq, *mla_kv_norm_g, *w_ukv,
        *pool_w, *pool_scale, *w_out, *norm2_g, *w_up, *conv_w, *conv_b, *w_down, *final_norm_g;
    float* out; unsigned char* ws; int ph_lo, ph_hi;
};

DEV int otid() { int t = threadIdx.x; asm volatile("" : "+v"(t)); return t; }
DEV float bf2f(unsigned short x) { return __uint_as_float((unsigned)x << 16); }
DEV unsigned f2bf(float f) { unsigned u = __float_as_uint(f); return (u + 0x7fffu + ((u >> 16) & 1u)) >> 16; }
DEV unsigned pk2(float lo, float hi) { return f2bf(lo) | (f2bf(hi) << 16); }
DEV float wave_sum(float v) {
#pragma unroll
    for (int o = 1; o < 64; o <<= 1) v += __shfl_xor(v, o);
    return v;
}
DEV float siluf(float x) { return x * __builtin_amdgcn_rcpf(1.0f + __builtin_amdgcn_exp2f(-1.4426950408889634f * x)); }
DEV int crow(int r, int hi) { return (r & 3) + 8 * (r >> 2) + 4 * hi; }
DEV bf16x8 pack8(float a0, float a1, float a2, float a3, float a4, float a5, float a6, float a7) {
    u32x4 w; w.x = pg8::cvt_pk_bf16(a0, a1); w.y = pg8::cvt_pk_bf16(a2, a3); w.z = pg8::cvt_pk_bf16(a4, a5); w.w = pg8::cvt_pk_bf16(a6, a7);
    return __builtin_bit_cast(bf16x8, w);
}
DEV int row_mi(int r) { const int b = r / RB; const int s = r - b * RB; return s < NCTX ? 2 : b; }

DEV void transpose_item(const float* W, int K, int Nsrc, bf16_t* WT, int n0, int cs, int k0, float* scr, int lane) {
#pragma unroll
    for (int i = 0; i < 32; ++i) { const int kk = 2 * i + (lane >> 5); scr[kk * 33 + (lane & 31)] = cs >= 0 ? W[(size_t)(k0 + kk) * Nsrc + cs + (lane & 31)] : 0.f; }
    asm volatile("s_waitcnt lgkmcnt(0)" ::: "memory");
    const int c = lane & 7;
#pragma unroll
    for (int j = 0; j < 4; ++j) { const int n = (lane >> 3) + 8 * j; const float* s = scr + (8 * c) * 33 + n;
        u32x4 o; o.x = pk2(s[0 * 33], s[1 * 33]); o.y = pk2(s[2 * 33], s[3 * 33]); o.z = pk2(s[4 * 33], s[5 * 33]); o.w = pk2(s[6 * 33], s[7 * 33]);
        *(u32x4*)(WT + (size_t)(n0 + n) * K + k0 + 8 * c) = o; }
    asm volatile("s_waitcnt lgkmcnt(0)" ::: "memory");
}
DEV int map_in(int n0) { return n0 < 1440 ? n0 : (n0 < INW ? -2 : -1); }
DEV int map_kn(int n0) { return (n0 >> 6) * 128 + (n0 & 63); }
DEV int map_v(int n0) { return (n0 >> 6) * 128 + 64 + (n0 & 63); }
DEV int map_up(int n0) { const int pn = n0 >> 8, w = n0 & 255; return w < 128 ? 128 * pn + w : DFF + 128 * pn + (w - 128); }

DEV void phase_prep(const Params& p, unsigned char* lds) {
    const int tid = otid(), lane = tid & 63, wid = tid >> 6;
    unsigned char* ws = p.ws;
    { f32x2* rope = (f32x2*)(ws + OFF_ROPE);
      for (int idx = blockIdx.x * NWG_T + tid; idx < TL * 16; idx += gridDim.x * NWG_T) { const int t = idx >> 4, i = idx & 15; const int pos = i < 8 ? (t >> 6) : (t & 63);
          const float inv = exp2f(-(float)(i & 7) * 0.125f * 13.287712379549449f); const float ang = (float)pos * inv; f32x2 cs; cs.x = __cosf(ang); cs.y = __sinf(ang); rope[idx] = cs; } }
    { float* scv = (float*)lds;
      float* red = scv + 3 * 1024;
      for (int i = tid; i < 3 * 1024; i += NWG_T) { const int v = i >> 10, k = i & 1023; const float cv = v < 2 ? p.c[v * 1024 + k] : p.c_ctx[k]; scv[i] = siluf(cv); }
      __syncthreads();
      float* modv = (float*)(ws + OFF_MOD);
      for (int it = blockIdx.x; it < 192; it += gridDim.x) { const int l = it / 96, col0 = (it % 96) * 64;
          const float* wm = p.w_mod + (size_t)l * 1024 * 6144 + col0 + lane; float a0 = 0.f, a1 = 0.f, a2 = 0.f;
#pragma unroll 16
          for (int k = wid * 128; k < wid * 128 + 128; ++k) { const float w = wm[(size_t)k * 6144]; a0 += scv[k] * w; a1 += scv[1024 + k] * w; a2 += scv[2048 + k] * w; }
          red[(wid * 3 + 0) * 64 + lane] = a0; red[(wid * 3 + 1) * 64 + lane] = a1; red[(wid * 3 + 2) * 64 + lane] = a2;
          __syncthreads();
          if (tid < 192) { const int v = tid >> 6, cl = tid & 63; float s = 0.f;
#pragma unroll
              for (int w = 0; w < 8; ++w) s += red[(w * 3 + v) * 64 + cl];
              modv[((size_t)l * 3 + v) * 6144 + col0 + cl] = s + p.b_mod[l * 6144 + col0 + cl]; }
          __syncthreads(); }
    }
}
DEV void phase_prep_weights(const Params& p, unsigned char* lds) {
    const int tid = otid(), lane = tid & 63, wid = tid >> 6;
    unsigned char* ws = p.ws;
    { float* scr = (float*)(lds + 32768 + wid * 8704);
      const int gw = blockIdx.x * 8 + wid, NGW = gridDim.x * 8;
      constexpr int I_IN = 16 * 56, I_UQ = 6 * 24, I_KN = 4 * 16, I_V = 4 * 16, I_OUT = 16 * 32, I_UP = 16 * 176, I_DN = 44 * 32, I_L = I_IN + I_UQ + I_KN + I_V + I_OUT + I_UP + I_DN;
      for (int it = gw; it < 2 * I_L; it += NGW) { const int l = it / I_L; int r = it - l * I_L; bf16_t* wl = (bf16_t*)(ws + OFF_W) + (size_t)l * W_LAYER;
          const float* src; int K, Nsrc, nbn, mp; size_t doff;
          if (r < I_IN) { src = p.w_in + (size_t)l * 1024 * INW; K = 1024; Nsrc = INW; nbn = 56; mp = 1; doff = W_IN; }
          else if ((r -= I_IN) < I_UQ) { src = p.w_uq + (size_t)l * 384 * 768; K = 384; Nsrc = 768; nbn = 24; mp = 0; doff = W_UQ; }
          else if ((r -= I_UQ) < I_KN) { src = p.w_ukv + (size_t)l * 256 * 1024; K = 256; Nsrc = 1024; nbn = 16; mp = 2; doff = W_KN; }
          else if ((r -= I_KN) < I_V) { src = p.w_ukv + (size_t)l * 256 * 1024; K = 256; Nsrc = 1024; nbn = 16; mp = 3; doff = W_V; }
          else if ((r -= I_V) < I_OUT) { src = p.w_out + (size_t)l * 1024 * 1024; K = 1024; Nsrc = 1024; nbn = 32; mp = 0; doff = W_OUT; }
          else if ((r -= I_OUT) < I_UP) { src = p.w_up + (size_t)l * 1024 * 5632; K = 1024; Nsrc = 5632; nbn = 176; mp = 4; doff = W_UP; }
          else { r -= I_UP; src = p.w_down + (size_t)l * DFF * 1024; K = DFF; Nsrc = 1024; nbn = 32; mp = 0; doff = W_DN; }
          const int kb = r / nbn, nb = r - kb * nbn, n0 = nb * 32;
          const int cs = mp == 0 ? n0 : mp == 1 ? map_in(n0) : mp == 2 ? map_kn(n0) : mp == 3 ? map_v(n0) : map_up(n0);
          if (cs != -2) transpose_item(src, K, Nsrc, wl + doff, n0, cs, kb * 64, scr, lane); }
    }
    { for (int idx = blockIdx.x * NWG_T + tid; idx < 2 * 1024 * 256; idx += gridDim.x * NWG_T) { const int n = idx & 255, k = (idx >> 8) & 1023, l = idx >> 18; const int g = n >> 6, d = n & 63;
          const float* wr = p.w_in + ((size_t)l * 1024 + k) * INW + 1440 + g * 64; const float* pw = p.pool_w + ((size_t)(l * 4 + g) * 64) * 64 + d; float s = 0.f;
#pragma unroll 8
          for (int c = 0; c < 64; ++c) s += wr[c] * pw[c * 64];
          ((bf16_t*)(ws + OFF_W) + (size_t)l * W_LAYER + W_IN)[(size_t)(1440 + n) * 1024 + k] = (bf16_t)f2bf(s * p.pool_scale[l * 256 + n]); } }
}

DEV void phase_norm(const Params& p, int l, int which, bool first, const float* pgate) {
    const int tid = otid(); const int lane = tid & 63, wid = tid >> 6; const int gw = blockIdx.x * 8 + wid, NGW = gridDim.x * 8;
    float* X = (float*)(p.ws + OFF_X); bf16_t* HN = (bf16_t*)(p.ws + OFF_HN);
    const float* modv = (const float*)(p.ws + OFF_MOD) + (size_t)l * 3 * 6144;
    const float* g = (which == 0 ? p.norm1_g : p.norm2_g) + l * 1024;
    for (int r = gw; r < R; r += NGW) {
        const int b = r / RB, s = r - b * RB; const int mi = s < NCTX ? 2 : b;
        const float* src = first ? (s < NCTX ? p.ctx + ((size_t)b * NCTX + s) * 1024 : p.x + ((size_t)b * TL + (s - NCTX)) * 1024) : X + (size_t)r * 1024;
        const f32x4* xr = (const f32x4*)src + lane; f32x4 v[4]; float ss = 0.f;
#pragma unroll
        for (int j = 0; j < 4; ++j) { v[j] = xr[64 * j]; ss += (v[j].x * v[j].x + v[j].y * v[j].y) + (v[j].z * v[j].z + v[j].w * v[j].w); }
        if (pgate != nullptr && s < NCTX) { const float* PART = (const float*)(p.ws + OFF_PART) + (size_t)(b * NCTX + s) * 1024; ss = 0.f;
#pragma unroll
            for (int j = 0; j < 4; ++j) { const f32x4 gq = ((const f32x4*)pgate)[lane + 64 * j]; f32x4 a = ((const f32x4*)PART)[lane + 64 * j];
#pragma unroll
                for (int q = 1; q < 4; ++q) a = a + ((const f32x4*)(PART + (size_t)q * 524288))[lane + 64 * j];
                v[j] = v[j] + gq * a; ss += (v[j].x * v[j].x + v[j].y * v[j].y) + (v[j].z * v[j].z + v[j].w * v[j].w); } }
        if (first || (pgate != nullptr && s < NCTX)) { f32x4* xo = (f32x4*)(X + (size_t)r * 1024) + lane;
#pragma unroll
            for (int j = 0; j < 4; ++j) xo[64 * j] = v[j]; }
        const float rs = rsqrtf(wave_sum(ss) * (1.f / 1024.f) + EPS);
        const float* mv = modv + mi * 6144 + (which == 0 ? 0 : 3072);
        u32x2* o8 = (u32x2*)(HN + (size_t)r * 1024) + lane;
#pragma unroll
        for (int j = 0; j < 4; ++j) { const f32x4 gg = ((const f32x4*)g)[lane + 64 * j], sh = ((const f32x4*)mv)[lane + 64 * j], sc = ((const f32x4*)(mv + 1024))[lane + 64 * j];
            const f32x4 y = v[j] * rs * gg; const f32x4 h = y * (sc + 1.0f) + sh; u32x2 w; w.x = pk2(h.x, h.y); w.y = pk2(h.z, h.w); o8[64 * j] = w; }
    }
}
DEV void phase_final(const Params& p) {
    const int tid = otid(); const int lane = tid & 63, wid = tid >> 6; const int gw = blockIdx.x * 8 + wid, NGW = gridDim.x * 8;
    const float* X = (const float*)(p.ws + OFF_X);
    for (int q = gw; q < 2 * TL; q += NGW) { const int b = q / TL, t = q - b * TL; const int r = b * RB + NCTX + t;
        const f32x4* xr = (const f32x4*)(X + (size_t)r * 1024) + lane; f32x4 v[4]; float ss = 0.f;
#pragma unroll
        for (int j = 0; j < 4; ++j) { v[j] = xr[64 * j]; ss += (v[j].x * v[j].x + v[j].y * v[j].y) + (v[j].z * v[j].z + v[j].w * v[j].w); }
        const float rs = rsqrtf(wave_sum(ss) * (1.f / 1024.f) + EPS);
        f32x4* o = (f32x4*)(p.out + (size_t)q * 1024) + lane;
#pragma unroll
        for (int j = 0; j < 4; ++j) { const f32x4 gg = ((const f32x4*)p.final_norm_g)[lane + 64 * j]; o[64 * j] = v[j] * rs * gg; } }
}

DEV void phase_rowwise(const Params& p, int l) {
    const int tid = otid(); const int lane = tid & 63, wid = tid >> 6; const int gw = blockIdx.x * 8 + wid, NGW = gridDim.x * 8;
    bf16_t* P = (bf16_t*)p.out; const f32x2* rope = (const f32x2*)(p.ws + OFF_ROPE);
    const float* qg = p.mla_q_norm_g + l * 384; const float* kg = p.mla_kv_norm_g + l * 256;
    float qgv[6];
#pragma unroll
    for (int j = 0; j < 3; ++j) { qgv[2 * j] = qg[2 * (lane + 64 * j)]; qgv[2 * j + 1] = qg[2 * (lane + 64 * j) + 1]; }
    const f32x4 kgv = ((const f32x4*)kg)[lane];
    for (int r0 = gw; r0 < R; r0 += 2 * NGW) {
        unsigned wq[2][3]; u32x2 wk[2]; float x1[2], x2[2]; f32x2 cs[2]; bool val[2], lat[2];
#pragma unroll
        for (int i = 0; i < 2; ++i) { const int r = r0 + i * NGW; val[i] = r < R; const int rr = val[i] ? r : r0; bf16_t* pr = P + (size_t)rr * INW; const int s = rr % RB; lat[i] = s >= NCTX;
            const unsigned* q2 = (const unsigned*)(pr + 768) + lane;
#pragma unroll
            for (int j = 0; j < 3; ++j) wq[i][j] = q2[64 * j];
            wk[i] = *((const u32x2*)(pr + 1152) + lane);
            const int li = lane & 15; x1[i] = bf2f(pr[1408 + li]); x2[i] = bf2f(pr[1408 + 16 + li]); cs[i] = rope[(lat[i] ? s - NCTX : 0) * 16 + li]; }
#pragma unroll
        for (int i = 0; i < 2; ++i) { if (!val[i]) continue; const int r = r0 + i * NGW; bf16_t* pr = P + (size_t)r * INW;
            { float ss = 0.f;
#pragma unroll
              for (int j = 0; j < 3; ++j) { const float a = bf2f(wq[i][j] & 0xffff), c2 = bf2f(wq[i][j] >> 16); ss += a * a + c2 * c2; }
              const float rs = rsqrtf(wave_sum(ss) * (1.f / 384.f) + EPS); unsigned* q2 = (unsigned*)(pr + 768) + lane;
#pragma unroll
              for (int j = 0; j < 3; ++j) q2[64 * j] = pk2(bf2f(wq[i][j] & 0xffff) * rs * qgv[2 * j], bf2f(wq[i][j] >> 16) * rs * qgv[2 * j + 1]); }
            { const float a0 = bf2f(wk[i].x & 0xffff), a1 = bf2f(wk[i].x >> 16), a2 = bf2f(wk[i].y & 0xffff), a3 = bf2f(wk[i].y >> 16);
              const float rs = rsqrtf(wave_sum((a0 * a0 + a1 * a1) + (a2 * a2 + a3 * a3)) * (1.f / 256.f) + EPS);
              u32x2 o; o.x = pk2(a0 * rs * kgv.x, a1 * rs * kgv.y); o.y = pk2(a2 * rs * kgv.z, a3 * rs * kgv.w); *((u32x2*)(pr + 1152) + lane) = o; }
            if (lat[i] && lane < 16) { pr[1408 + lane] = (bf16_t)f2bf(x1[i] * cs[i].x - x2[i] * cs[i].y); pr[1408 + 16 + lane] = (bf16_t)f2bf(x2[i] * cs[i].x + x1[i] * cs[i].y); } }
    }
}

DEV void phase_pool(const Params& p) {
    const int tid = otid(); const bf16_t* P = (const bf16_t*)p.out; bf16_t* MIX = (bf16_t*)(p.ws + OFF_HN);
    for (int idx = blockIdx.x * NWG_T + tid; idx < R * 32; idx += gridDim.x * NWG_T) { const int r = idx >> 5, cg = idx & 31; const int half = 1 << (cg >> 3);
        const int b = r / RB, s = r - b * RB; const int seq0 = s < NCTX ? b * RB : b * RB + NCTX; const int T = s < NCTX ? NCTX : TL; const int t = r - seq0;
        const int lo = max(t - half, 0), hi = min(t + half, T); float sum[8];
#pragma unroll
        for (int j = 0; j < 8; ++j) sum[j] = 0.f;
        const bf16_t* base = P + (size_t)seq0 * INW + 1440 + cg * 8;
        { bf16x8 wv[16]; const bf16x8 zz = {0, 0, 0, 0, 0, 0, 0, 0};
#pragma unroll
          for (int k = 0; k < 16; ++k) { const int tt = t - 8 + k; wv[k] = (tt >= lo && tt < hi) ? *(const bf16x8*)(base + (size_t)tt * INW) : zz; }
#pragma unroll
          for (int k = 0; k < 16; ++k)
#pragma unroll
              for (int j = 0; j < 8; ++j) sum[j] += bf2f((unsigned short)wv[k][j]); }
        const bf16x8 me = *(const bf16x8*)(base + (size_t)t * INW); const float ic = 1.0f / (float)(hi - lo); float o[8];
#pragma unroll
        for (int j = 0; j < 8; ++j) o[j] = sum[j] * ic - bf2f((unsigned short)me[j]);
        *(bf16x8*)(MIX + (size_t)r * 1024 + 768 + cg * 8) = pack8(o[0], o[1], o[2], o[3], o[4], o[5], o[6], o[7]); }
}

DEV float log2_sigmoid(float d) { return -log1pf(__expf(-d)) * 1.4426950408889634f; }
constexpr int ST_P = 272;
DEV void states_item(const Params& p, int l, unsigned char* lds, int it) {
    const int tid = otid(), lane = tid & 63, wid = tid >> 6, l32 = lane & 31, hi = lane >> 5;
    const bf16_t* P = (const bf16_t*)p.out; const f32x2* rope = (const f32x2*)(p.ws + OFF_ROPE);
    float* SLOC = (float*)(p.ws + OFF_OV + OV_SLOC);
    const int gc = it >> 1, hp = it & 1;
    unsigned char* VTl = lds;
    unsigned char* KTl = lds + 2 * 64 * ST_P;
    const int cb = gc % 66; const bool lat = cb >= 2; const int t0 = (cb - 2) * 128; const int r0 = gc * 128;
    __syncthreads();
    { const int tok = tid >> 2, hh = (tid >> 1) & 1, c = tid & 1; const int h = 2 * hp + hh;
      const bf16_t* src = P + (size_t)(r0 + tok) * INW + 128 + h * 32 + 8 * c; const bf16x8 lo = *(const bf16x8*)src, hi8 = *(const bf16x8*)(src + 16);
      const float df = exp2f(log2_sigmoid(p.ret_decay_f[l * 4 + h]) * (float)(127 - tok)) * 0.17677669529663687f, db = exp2f(log2_sigmoid(p.ret_decay_b[l * 4 + h]) * (float)tok) * 0.17677669529663687f;
#pragma unroll
      for (int j = 0; j < 8; ++j) { float x1 = bf2f((unsigned short)lo[j]), x2 = bf2f((unsigned short)hi8[j]);
          if (lat) { const f32x2 cs = rope[(t0 + tok) * 16 + 8 * c + j]; const float y1 = x1 * cs.x - x2 * cs.y, y2 = x2 * cs.x + x1 * cs.y; x1 = y1; x2 = y2; }
          bf16_t* kf = (bf16_t*)(KTl + ((hh * 2 + 0) * 32 + 8 * c + j) * ST_P) + tok; bf16_t* kb = (bf16_t*)(KTl + ((hh * 2 + 1) * 32 + 8 * c + j) * ST_P) + tok;
          kf[0] = (bf16_t)f2bf(x1 * df); kb[0] = (bf16_t)f2bf(x1 * db);
          *(bf16_t*)((unsigned char*)kf + 16 * ST_P) = (bf16_t)f2bf(x2 * df); *(bf16_t*)((unsigned char*)kb + 16 * ST_P) = (bf16_t)f2bf(x2 * db); } }
    for (int task = tid; task < 2048; task += NWG_T) { const int hh = task >> 10, tok = (task >> 3) & 127, ch = task & 7;
        const bf16x8 v = *(const bf16x8*)(P + (size_t)(r0 + tok) * INW + 256 + (2 * hp + hh) * 64 + ch * 8);
#pragma unroll
        for (int j = 0; j < 8; ++j) *((bf16_t*)(VTl + (hh * 64 + ch * 8 + j) * ST_P) + tok) = (bf16_t)v[j]; }
    __syncthreads();
    { const int hh = wid >> 2, dir = (wid >> 1) & 1, dvb = wid & 1; const int h = 2 * hp + hh;
      const unsigned char* ap = VTl + (hh * 64 + 32 * dvb + l32) * ST_P + hi * 16; const unsigned char* bp = KTl + ((hh * 2 + dir) * 32 + l32) * ST_P + hi * 16;
      bf16x8 af[8], bfr[8];
#pragma unroll
      for (int ks = 0; ks < 8; ++ks) { af[ks] = *(const bf16x8*)(ap + ks * 32); bfr[ks] = *(const bf16x8*)(bp + ks * 32); }
      f32x16 acc;
#pragma unroll
      for (int r = 0; r < 16; ++r) acc[r] = 0.f;
#pragma unroll
      for (int ks = 0; ks < 8; ++ks) acc = __builtin_amdgcn_mfma_f32_32x32x16_bf16(af[ks], bfr[ks], acc, 0, 0, 0);
      float* o = SLOC + ((size_t)(gc * 4 + h) * 2 + dir) * 2048 + l32 * 64 + 32 * dvb + 4 * hi;
#pragma unroll
      for (int g4 = 0; g4 < 4; ++g4) *(f32x4*)(o + 8 * g4) = (f32x4){acc[4 * g4], acc[4 * g4 + 1], acc[4 * g4 + 2], acc[4 * g4 + 3]}; }
}
DEV void scan_threads(const Params& p, int l, int gid) {
    if (gid >= 32768) return;
    const int e = gid & 2047, dir = (gid >> 11) & 1, h = (gid >> 12) & 3, b = gid >> 14;
    const float* SLOC = (const float*)(p.ws + OFF_OV + OV_SLOC); float* SIN = (float*)(p.ws + OFF_OV + OV_SIN);
    const float gC = exp2f(log2_sigmoid((dir == 0 ? p.ret_decay_f : p.ret_decay_b)[l * 4 + h]) * 128.f);
    float S = 0.f;
#pragma unroll 11
    for (int st = 0; st < 66; ++st) { const int cb = dir == 0 ? st : (st < 2 ? 1 - st : 67 - st); const size_t idx = ((size_t)((b * 66 + cb) * 4 + h) * 2 + dir) * 2048 + e;
        const float v = SLOC[idx]; SIN[idx] = S; S = S * gC + v; }
}

constexpr int AT_KP = 208, AT_VP = 144, AT_KB = 64 * AT_KP, AT_VBS = 64 * AT_VP, AT_V0 = 4 * AT_KB;
DEV float at_max32(const f32x16& s0, const f32x16& s1) {
    float m0 = __builtin_fmaxf(__builtin_fmaxf(s0[0], s0[1]), s0[2]), m1 = __builtin_fmaxf(__builtin_fmaxf(s1[0], s1[1]), s1[2]);
    m0 = __builtin_fmaxf(__builtin_fmaxf(m0, s0[3]), s0[4]); m1 = __builtin_fmaxf(__builtin_fmaxf(m1, s1[3]), s1[4]);
    m0 = __builtin_fmaxf(__builtin_fmaxf(m0, s0[5]), s0[6]); m1 = __builtin_fmaxf(__builtin_fmaxf(m1, s1[5]), s1[6]);
    m0 = __builtin_fmaxf(__builtin_fmaxf(m0, s0[7]), s0[8]); m1 = __builtin_fmaxf(__builtin_fmaxf(m1, s1[7]), s1[8]);
    m0 = __builtin_fmaxf(__builtin_fmaxf(m0, s0[9]), s0[10]); m1 = __builtin_fmaxf(__builtin_fmaxf(m1, s1[9]), s1[10]);
    m0 = __builtin_fmaxf(__builtin_fmaxf(m0, s0[11]), s0[12]); m1 = __builtin_fmaxf(__builtin_fmaxf(m1, s1[11]), s1[12]);
    m0 = __builtin_fmaxf(__builtin_fmaxf(m0, s0[13]), s0[14]); m1 = __builtin_fmaxf(__builtin_fmaxf(m1, s1[13]), s1[14]);
    return __builtin_fmaxf(__builtin_fmaxf(m0, s0[15]), __builtin_fmaxf(m1, s1[15]));
}
DEV void attn_unit(const Params& p, unsigned char* lds, int u) {
    const int tid = otid(), lane = tid & 63, wid = tid >> 6, l32 = lane & 31, hi = lane >> 5;
    const bf16_t* Q = (const bf16_t*)(p.ws + OFF_OV + OV_Q); const bf16_t* KN = (const bf16_t*)(p.ws + OFF_OV + OV_KN); const bf16_t* VT = (const bf16_t*)(p.ws + OFF_OV + OV_VT);
    const bf16_t* P = (const bf16_t*)p.out; bf16_t* MIX = (bf16_t*)(p.ws + OFF_HN); const f32x2* rope = (const f32x2*)(p.ws + OFF_ROPE);
    const bool isctx = u >= 512; int b, h, qrow0, NT;
    if (!isctx) { b = u >> 8; h = (u >> 5) & 7; qrow0 = b * RB + NCTX + (u & 31) * 256; NT = 132; } else { const int v = u - 512; b = v >> 3; h = v & 7; qrow0 = b * RB; NT = 4; }
    const int krow0 = b * RB; const int qrow = qrow0 + wid * 32 + l32;
    bf16x8 qf[6];
    { const bf16_t* qp = Q + (size_t)qrow * 768 + h * 96 + hi * 8;
#pragma unroll
      for (int d0 = 0; d0 < 6; ++d0) qf[d0] = *(const bf16x8*)(qp + d0 * 16);
      if (!isctx) { const f32x2* rp = rope + (size_t)(qrow - (b * RB + NCTX)) * 16 + hi * 8;
#pragma unroll
          for (int j = 0; j < 8; ++j) { const f32x2 cs = rp[j]; const float x1 = bf2f((unsigned short)qf[4][j]), x2 = bf2f((unsigned short)qf[5][j]);
              qf[4][j] = (short)f2bf(x1 * cs.x - x2 * cs.y); qf[5][j] = (short)f2bf(x2 * cs.x + x1 * cs.y); } } }
    const bf16_t* sp[3]; int sstep[3], lo[3];
#pragma unroll
    for (int k = 0; k < 2; ++k) { const int c = tid + k * 512; const int key = c / 12, part = c - key * 12; lo[k] = key * AT_KP + part * 16;
        if (part < 8) { sp[k] = KN + (size_t)(krow0 + key) * 512 + h * 64 + part * 8; sstep[k] = 64 * 512; } else { sp[k] = P + (size_t)(krow0 + key) * INW + 1408 + (part - 8) * 8; sstep[k] = 64 * INW; } }
    { const int dv = tid >> 3, kc = tid & 7; lo[2] = dv * AT_VP + (kc >> 1) * 32 + (kc & 1) * 8;   sp[2] = VT + (size_t)(h * 64 + dv) * R + krow0 + kc * 8; sstep[2] = 64; }
    const bool hasK2 = tid < 256;
    u32x4 st[3];
#define AT_GLOADK() do { st[0] = *(const u32x4*)sp[0]; sp[0] += sstep[0]; if (hasK2) { st[1] = *(const u32x4*)sp[1]; sp[1] += sstep[1]; } } while (0)
#define AT_GLOADV() do { st[2] = *(const u32x4*)sp[2]; sp[2] += sstep[2]; } while (0)
#define AT_LSTOREK(buf) do { *(u32x4*)((buf) + lo[0]) = st[0]; if (hasK2) *(u32x4*)((buf) + lo[1]) = st[1]; } while (0)
#define AT_LSTOREV(buf) do { unsigned char* d_ = (buf) + lo[2]; *(u32x2*)d_ = (u32x2){st[2].x, st[2].y}; *(u32x2*)(d_ + 16) = (u32x2){st[2].z, st[2].w}; } while (0)
#define AT_SB() __builtin_amdgcn_sched_barrier(0)
    f32x16 o0, o1, sa0, sa1, sb0, sb1, negm;
#pragma unroll
    for (int r = 0; r < 16; ++r) { o0[r] = 0.f; o1[r] = 0.f; sa0[r] = 0.f; sa1[r] = 0.f; negm[r] = 0.f; }
    float mrun = 0.f, lsum = 0.f;
    __syncthreads();
    AT_GLOADK(); AT_GLOADV(); AT_LSTOREK(lds); AT_LSTOREV(lds + AT_V0);
    AT_GLOADK(); AT_GLOADV(); AT_LSTOREK(lds + AT_KB); AT_LSTOREV(lds + AT_V0 + AT_VBS);
    AT_GLOADK(); AT_LSTOREK(lds + 2 * AT_KB);
    __syncthreads();
    { const unsigned char* ka = lds + l32 * AT_KP + hi * 16;
#pragma unroll
      for (int d0 = 0; d0 < 6; ++d0) { const bf16x8 a0 = *(const bf16x8*)(ka + d0 * 32), a1 = *(const bf16x8*)(ka + 32 * AT_KP + d0 * 32);
          sa0 = __builtin_amdgcn_mfma_f32_32x32x16_bf16(a0, qf[d0], sa0, 0, 0, 0); sa1 = __builtin_amdgcn_mfma_f32_32x32x16_bf16(a1, qf[d0], sa1, 0, 0, 0); } }
#define AT_QKM(SB0, SB1, i) do { if ((i) == 0) SB0 = __builtin_amdgcn_mfma_f32_32x32x16_bf16(kfr[0], qf[0], negm, 0, 0, 0); else if ((i) == 1) SB1 = __builtin_amdgcn_mfma_f32_32x32x16_bf16(kfr[1], qf[0], negm, 0, 0, 0); \
        else if ((i) & 1) SB1 = __builtin_amdgcn_mfma_f32_32x32x16_bf16(kfr[(i)], qf[(i) >> 1], SB1, 0, 0, 0); else SB0 = __builtin_amdgcn_mfma_f32_32x32x16_bf16(kfr[(i)], qf[(i) >> 1], SB0, 0, 0, 0); } while (0)
#define AT_EXS(acc, SA0, SA1, e) do { if ((e) < 16) { SA0[(e) & 15] = __builtin_amdgcn_exp2f(SA0[(e) & 15]); acc += SA0[(e) & 15]; } else { SA1[(e) & 15] = __builtin_amdgcn_exp2f(SA1[(e) & 15]); acc += SA1[(e) & 15]; } } while (0)
#define AT_PACK(dst, S, r0) dst = pack8(S[(r0) + 0], S[(r0) + 1], S[(r0) + 2], S[(r0) + 3], S[(r0) + 4], S[(r0) + 5], S[(r0) + 6], S[(r0) + 7])
#define AT_MAX4(m0, m1, SB0, SB1, r0) do { m0 = __builtin_fmaxf(__builtin_fmaxf(m0, SB0[(r0) + 0]), SB0[(r0) + 1]); m1 = __builtin_fmaxf(__builtin_fmaxf(m1, SB1[(r0) + 0]), SB1[(r0) + 1]); \
        m0 = __builtin_fmaxf(__builtin_fmaxf(m0, SB0[(r0) + 2]), SB0[(r0) + 3]); m1 = __builtin_fmaxf(__builtin_fmaxf(m1, SB1[(r0) + 2]), SB1[(r0) + 3]); } while (0)
#define AT_STEP(SA0, SA1, SB0, SB1, tt) do { \
        const int t_ = (tt); const bool nxt_ = t_ + 1 < NT; \
        const unsigned char* kb_ = lds + ((t_ + 1) & 3) * AT_KB; const unsigned char* vb_ = lds + AT_V0 + (t_ & 3) * AT_VBS; \
        if (t_ + 3 < NT) AT_GLOADK(); \
        if (t_ + 2 < NT) AT_GLOADV(); \
        bf16x8 kfr[12]; bf16x8 vfr[8]; \
        { const unsigned char* ka = kb_ + l32 * AT_KP + hi * 16; \
          _Pragma("unroll") for (int d0 = 0; d0 < 6; ++d0) { kfr[2 * d0] = *(const bf16x8*)(ka + d0 * 32); kfr[2 * d0 + 1] = *(const bf16x8*)(ka + 32 * AT_KP + d0 * 32); } } \
        { const float mx = mxc; \
          if (t_ == 0 || __any(mx > 8.0f)) { \
              const float rm = fmaxf(mx, __shfl_xor(mx, 32)); const float delta = (t_ == 0) ? rm : fmaxf(rm, 0.f); const float alpha = (t_ == 0) ? 1.0f : __builtin_amdgcn_exp2f(-delta); \
              mrun += delta; \
              _Pragma("unroll") for (int r = 0; r < 16; ++r) { SA0[r] -= delta; SA1[r] -= delta; o0[r] *= alpha; o1[r] *= alpha; } \
              lsum *= alpha; { const float nm = -mrun; _Pragma("unroll") for (int r = 0; r < 16; ++r) negm[r] = nm; } } } \
        float ls0 = 0.f, ls1 = 0.f; \
        AT_SB(); __builtin_amdgcn_s_setprio(1); \
          \
        _Pragma("unroll") for (int i = 0; i < 8; ++i) { \
            AT_QKM(SB0, SB1, i); \
            _Pragma("unroll") for (int k_ = 0; k_ < 3; ++k_) { const int e_ = 3 * i + k_; if (e_ < 16) { SA0[e_ & 15] = __builtin_amdgcn_exp2f(SA0[e_ & 15]); asm volatile("" : "+v"(SA0[e_ & 15])); } else { SA1[e_ & 15] = __builtin_amdgcn_exp2f(SA1[e_ & 15]); asm volatile("" : "+v"(SA1[e_ & 15])); } } \
            AT_SB(); } \
        { const unsigned char* va = vb_ + l32 * AT_VP + hi * 16; \
          _Pragma("unroll") for (int kj = 0; kj < 4; ++kj) { vfr[2 * kj] = *(const bf16x8*)(va + kj * 32); vfr[2 * kj + 1] = *(const bf16x8*)(va + 32 * AT_VP + kj * 32); } } \
        bf16x8 pb[4]; \
        _Pragma("unroll") for (int i = 8; i < 12; ++i) { \
            AT_QKM(SB0, SB1, i); \
            _Pragma("unroll") for (int k_ = 0; k_ < 2; ++k_) { const int e_ = 24 + 2 * (i - 8) + k_; SA1[e_ & 15] = __builtin_amdgcn_exp2f(SA1[e_ & 15]); asm volatile("" : "+v"(SA1[e_ & 15])); } \
            if (i == 9) { AT_PACK(pb[0], SA0, 0); asm volatile("" : "+v"(pb[0])); } \
            if (i == 11) { AT_PACK(pb[1], SA0, 8); asm volatile("" : "+v"(pb[1])); } \
            AT_SB(); } \
        float mq0 = SB0[0], mq1 = SB1[0]; __builtin_amdgcn_s_setprio(2); \
        _Pragma("unroll") for (int kj = 0; kj < 4; ++kj) { \
            o0 = __builtin_amdgcn_mfma_f32_32x32x16_bf16(vfr[2 * kj], pb[kj], o0, 0, 0, 0); o1 = __builtin_amdgcn_mfma_f32_32x32x16_bf16(vfr[2 * kj + 1], pb[kj], o1, 0, 0, 0); \
            if (kj == 0) { AT_PACK(pb[2], SA1, 0); asm volatile("" : "+v"(pb[2])); } \
            if (kj == 1) { AT_PACK(pb[3], SA1, 8); asm volatile("" : "+v"(pb[3])); } \
            _Pragma("unroll") for (int r_ = 0; r_ < 4; ++r_) { ls0 += SA0[4 * kj + r_]; ls1 += SA1[4 * kj + r_]; } \
            mq0 = __builtin_fmaxf(__builtin_fmaxf(mq0, SB0[4 * kj]), SB0[4 * kj + 1]); mq1 = __builtin_fmaxf(__builtin_fmaxf(mq1, SB1[4 * kj]), SB1[4 * kj + 1]); \
            mq0 = __builtin_fmaxf(__builtin_fmaxf(mq0, SB0[4 * kj + 2]), SB0[4 * kj + 3]); mq1 = __builtin_fmaxf(__builtin_fmaxf(mq1, SB1[4 * kj + 2]), SB1[4 * kj + 3]); \
            asm volatile("" : "+v"(mq0), "+v"(mq1), "+v"(ls0), "+v"(ls1)); AT_SB(); } \
        lsum += ls0 + ls1; \
        __builtin_amdgcn_s_setprio(0); mxc = __builtin_fmaxf(mq0, mq1);            \
        if (t_ + 3 < NT) AT_LSTOREK(lds + ((t_ + 3) & 3) * AT_KB); \
        if (t_ + 2 < NT) AT_LSTOREV(lds + AT_V0 + ((t_ + 2) & 3) * AT_VBS); \
        if (t_ & 1) __syncthreads(); \
    } while (0)
    float mxc = at_max32(sa0, sa1);
    for (int t = 0; t < NT; t += 2) { AT_STEP(sa0, sa1, sb0, sb1, t); AT_STEP(sb0, sb1, sa0, sa1, t + 1); }
    lsum += __shfl_xor(lsum, 32);
    const float inv = 1.0f / lsum;
    bf16_t* op = MIX + (size_t)qrow * 1024 + 256 + h * 64 + 4 * hi;
#pragma unroll
    for (int g4 = 0; g4 < 4; ++g4) { u32x2 w0, w1; w0.x = pk2(o0[4 * g4] * inv, o0[4 * g4 + 1] * inv); w0.y = pk2(o0[4 * g4 + 2] * inv, o0[4 * g4 + 3] * inv);
        w1.x = pk2(o1[4 * g4] * inv, o1[4 * g4 + 1] * inv); w1.y = pk2(o1[4 * g4 + 2] * inv, o1[4 * g4 + 3] * inv);
        *(u32x2*)(op + 8 * g4) = w0; *(u32x2*)(op + 32 + 8 * g4) = w1; }
#undef AT_GLOADK
#undef AT_GLOADV
#undef AT_LSTOREK
#undef AT_LSTOREV
#undef AT_STEP
#undef AT_QKM
#undef AT_EXS
#undef AT_PACK
#undef AT_MAX4
#undef AT_SB
}

constexpr int RT_VP = 264, RT_SP = 144, RT_VB = 2 * 64 * RT_VP;
DEV void retout_unit(const Params& p, int l, unsigned char* lds, int u) {
    const int tid = otid(), lane = tid & 63, wid = tid >> 6, l32 = lane & 31, hi = lane >> 5;
    const int gc = u >> 1, hp = u & 1; const int cb = gc % 66; const bool lat = cb >= 2; const int t0 = (cb - 2) * 128; const int r0 = gc * 128;
    const bf16_t* P = (const bf16_t*)p.out; bf16_t* MIX = (bf16_t*)(p.ws + OFF_HN); const f32x2* rope = (const f32x2*)(p.ws + OFF_ROPE);
    const float* SIN = (const float*)(p.ws + OFF_OV + OV_SIN);
    bf16_t* VTl = (bf16_t*)lds; bf16_t* STl = (bf16_t*)(lds + RT_VB);
    __syncthreads();
    for (int task = tid; task < 2048; task += NWG_T) { const int hh = task >> 10, key = (task >> 3) & 127, ch = task & 7;
        const bf16x8 v = *(const bf16x8*)(P + (size_t)(r0 + key) * INW + 256 + (2 * hp + hh) * 64 + ch * 8);
#pragma unroll
        for (int j = 0; j < 8; ++j) VTl[(hh * 64 + ch * 8 + j) * (RT_VP / 2) + key] = (bf16_t)v[j]; }
    for (int task = tid; task < 8192; task += NWG_T) { const int dv = task & 63, k = (task >> 6) & 31, dir = (task >> 11) & 1, hh = task >> 12;
        STl[(hh * 64 + dv) * (RT_SP / 2) + dir * 32 + k] = (bf16_t)f2bf(SIN[((size_t)(gc * 4 + 2 * hp + hh) * 2 + dir) * 2048 + k * 64 + dv]); }
    __syncthreads();
    const int hh = wid >> 2, h = 2 * hp + hh, qblk = wid & 3; const int n = 32 * qblk + l32; const int rq = r0 + n;
    const float lf = log2_sigmoid(p.ret_decay_f[l * 4 + h]), lb = log2_sigmoid(p.ret_decay_b[l * 4 + h]);
    float qv0[8], qv1[8]; bf16x8 qf0, qf1;
    { const bf16_t* qp = P + (size_t)rq * INW + h * 32 + 8 * hi; const bf16x8 a = *(const bf16x8*)qp, c2 = *(const bf16x8*)(qp + 16);
#pragma unroll
      for (int j = 0; j < 8; ++j) { float x1 = bf2f((unsigned short)a[j]), x2 = bf2f((unsigned short)c2[j]);
          if (lat) { const f32x2 cs = rope[(size_t)(t0 + n) * 16 + 8 * hi + j]; const float y1 = x1 * cs.x - x2 * cs.y, y2 = x2 * cs.x + x1 * cs.y; x1 = y1; x2 = y2; }
          qv0[j] = x1; qv1[j] = x2; }
      qf0 = pack8(qv0[0], qv0[1], qv0[2], qv0[3], qv0[4], qv0[5], qv0[6], qv0[7]); qf1 = pack8(qv1[0], qv1[1], qv1[2], qv1[3], qv1[4], qv1[5], qv1[6], qv1[7]); }
    f32x16 o0, o1;
#pragma unroll
    for (int r = 0; r < 16; ++r) { o0[r] = 0.f; o1[r] = 0.f; }
    const unsigned char* vbase = (const unsigned char*)VTl + (size_t)(hh * 64 + l32) * RT_VP + hi * 8;
    bf16x8 kga[4], kgc[4];
#pragma unroll
    for (int kb = 0; kb < 4; ++kb) { const bf16_t* kp = P + (size_t)(r0 + 32 * kb + l32) * INW + 128 + h * 32 + 8 * hi; kga[kb] = *(const bf16x8*)kp; kgc[kb] = *(const bf16x8*)(kp + 16); }
    __builtin_amdgcn_sched_barrier(0);
#pragma unroll
    for (int kb = 0; kb < 4; ++kb) {
        bf16x8 kf0, kf1;
        { const int key = 32 * kb + l32; const bf16x8 a = kga[kb], c2 = kgc[kb];
          float y1[8], y2[8];
#pragma unroll
          for (int j = 0; j < 8; ++j) { float x1 = bf2f((unsigned short)a[j]), x2 = bf2f((unsigned short)c2[j]);
              if (lat) { const f32x2 cs = rope[(size_t)(t0 + key) * 16 + 8 * hi + j]; const float z1 = x1 * cs.x - x2 * cs.y, z2 = x2 * cs.x + x1 * cs.y; x1 = z1; x2 = z2; }
              y1[j] = x1 * 0.17677669529663687f; y2[j] = x2 * 0.17677669529663687f; }
          kf0 = pack8(y1[0], y1[1], y1[2], y1[3], y1[4], y1[5], y1[6], y1[7]); kf1 = pack8(y2[0], y2[1], y2[2], y2[3], y2[4], y2[5], y2[6], y2[7]); }
        f32x16 s;
#pragma unroll
        for (int r = 0; r < 16; ++r) s[r] = 0.f;
        s = __builtin_amdgcn_mfma_f32_32x32x16_bf16(kf0, qf0, s, 0, 0, 0); s = __builtin_amdgcn_mfma_f32_32x32x16_bf16(kf1, qf1, s, 0, 0, 0);
#pragma unroll
        for (int r = 0; r < 16; ++r) { const int m = 32 * kb + crow(r, hi); const int dl = n - m; const float e = dl >= 0 ? lf * (float)dl : lb * (float)(-dl); s[r] *= __builtin_amdgcn_exp2f(e); }
#pragma unroll
        for (int jp = 0; jp < 2; ++jp) { const bf16x8 pb = pack8(s[8 * jp + 0], s[8 * jp + 1], s[8 * jp + 2], s[8 * jp + 3], s[8 * jp + 4], s[8 * jp + 5], s[8 * jp + 6], s[8 * jp + 7]);
            const unsigned char* vp = vbase + (32 * kb + 16 * jp) * 2;
            const u32x2 a00 = *(const u32x2*)vp, a01 = *(const u32x2*)(vp + 16), a10 = *(const u32x2*)(vp + 32 * RT_VP), a11 = *(const u32x2*)(vp + 32 * RT_VP + 16);
            const bf16x8 A0 = __builtin_bit_cast(bf16x8, (u32x4){a00.x, a00.y, a01.x, a01.y}), A1 = __builtin_bit_cast(bf16x8, (u32x4){a10.x, a10.y, a11.x, a11.y});
            o0 = __builtin_amdgcn_mfma_f32_32x32x16_bf16(A0, pb, o0, 0, 0, 0); o1 = __builtin_amdgcn_mfma_f32_32x32x16_bf16(A1, pb, o1, 0, 0, 0); }
    }
    { const float df = __builtin_amdgcn_exp2f(lf * (float)(n + 1)), db = __builtin_amdgcn_exp2f(lb * (float)(128 - n));
      const unsigned char* sbase = (const unsigned char*)STl + (size_t)(hh * 64 + l32) * RT_SP + hi * 16;
#pragma unroll
      for (int ks = 0; ks < 4; ++ks) { const float dd = ks < 2 ? df : db;
          const bf16x8 qb = (ks & 1) ? pack8(qv1[0] * dd, qv1[1] * dd, qv1[2] * dd, qv1[3] * dd, qv1[4] * dd, qv1[5] * dd, qv1[6] * dd, qv1[7] * dd)
                                     : pack8(qv0[0] * dd, qv0[1] * dd, qv0[2] * dd, qv0[3] * dd, qv0[4] * dd, qv0[5] * dd, qv0[6] * dd, qv0[7] * dd);
          const bf16x8 A0 = *(const bf16x8*)(sbase + ks * 32), A1 = *(const bf16x8*)(sbase + 32 * RT_SP + ks * 32);
          o0 = __builtin_amdgcn_mfma_f32_32x32x16_bf16(A0, qb, o0, 0, 0, 0); o1 = __builtin_amdgcn_mfma_f32_32x32x16_bf16(A1, qb, o1, 0, 0, 0); } }
    float ssq = 0.f;
#pragma unroll
    for (int r = 0; r < 16; ++r) ssq += o0[r] * o0[r] + o1[r] * o1[r];
    ssq += __shfl_xor(ssq, 32);
    const float rstd = rsqrtf(ssq * (1.f / 64.f) + EPS);
    const bf16_t* gp = P + (size_t)rq * INW + 512 + h * 64 + 4 * hi; bf16_t* op = MIX + (size_t)rq * 1024 + h * 64 + 4 * hi;
#pragma unroll
    for (int g4 = 0; g4 < 4; ++g4) { const u32x2 ga = *(const u32x2*)(gp + 8 * g4), gb = *(const u32x2*)(gp + 32 + 8 * g4);
        u32x2 w0, w1;
        w0.x = pk2(o0[4 * g4] * rstd * siluf(bf2f(ga.x & 0xffff)), o0[4 * g4 + 1] * rstd * siluf(bf2f(ga.x >> 16))); w0.y = pk2(o0[4 * g4 + 2] * rstd * siluf(bf2f(ga.y & 0xffff)), o0[4 * g4 + 3] * rstd * siluf(bf2f(ga.y >> 16)));
        w1.x = pk2(o1[4 * g4] * rstd * siluf(bf2f(gb.x & 0xffff)), o1[4 * g4 + 1] * rstd * siluf(bf2f(gb.x >> 16))); w1.y = pk2(o1[4 * g4 + 2] * rstd * siluf(bf2f(gb.y & 0xffff)), o1[4 * g4 + 3] * rstd * siluf(bf2f(gb.y >> 16)));
        *(u32x2*)(op + 8 * g4) = w0; *(u32x2*)(op + 32 + 8 * g4) = w1; }
}

DEV void phase_ffn_fixup(const Params& p, int l) {
    const float* EDGE = (const float*)(p.ws + OFF_EDGE); bf16_t* ACT = (bf16_t*)(p.ws + OFF_OV);
    const float* cw = p.conv_w + (size_t)l * 3 * 5632; const float* cbv = p.conv_b + (size_t)l * 5632;
    for (int idx = blockIdx.x * NWG_T + otid(); idx < 66 * 2 * 704; idx += gridDim.x * NWG_T) {
        const int ch4 = idx % 704, rest = idx / 704; const int which = rest & 1, pm = rest >> 1; const int jj = pm % 33;
        if (l == 1 && jj == 0) continue;
        const int ch = 4 * ch4, pn = ch >> 7, c = ch & 127;
        const bool sstart = jj <= 1, send = (jj == 0) || (jj == 32);
        const f32x4 zz = {0.f, 0.f, 0.f, 0.f};
#define EDG(tile, k, half) (*(const f32x4*)(EDGE + ((size_t)((tile) * 4 + (k)) * 22 + pn) * 256 + (half) * 128 + c))
        f32x4 ua, ub, ca, cb2, da, db;
        if (which == 0) { ua = sstart ? zz : EDG(pm - 1, 3, 0); ub = sstart ? zz : EDG(pm - 1, 3, 1); ca = EDG(pm, 0, 0); cb2 = EDG(pm, 0, 1); da = EDG(pm, 1, 0); db = EDG(pm, 1, 1); }
        else { ua = EDG(pm, 2, 0); ub = EDG(pm, 2, 1); ca = EDG(pm, 3, 0); cb2 = EDG(pm, 3, 1); da = send ? zz : EDG(pm + 1, 0, 0); db = send ? zz : EDG(pm + 1, 0, 1); }
#undef EDG
        const f32x4 wa0 = *(const f32x4*)(cw + ch), wa1 = *(const f32x4*)(cw + 5632 + ch), wa2 = *(const f32x4*)(cw + 2 * 5632 + ch), ba = *(const f32x4*)(cbv + ch);
        const f32x4 wb0 = *(const f32x4*)(cw + DFF + ch), wb1 = *(const f32x4*)(cw + 5632 + DFF + ch), wb2 = *(const f32x4*)(cw + 2 * 5632 + DFF + ch), bb = *(const f32x4*)(cbv + DFF + ch);
        const f32x4 xa = wa0 * ua + wa1 * ca + wa2 * da + ba, xb = wb0 * ub + wb1 * cb2 + wb2 * db + bb;
        u32x2 w; w.x = pk2(siluf(xa.x) * xb.x, siluf(xa.y) * xb.y); w.y = pk2(siluf(xa.z) * xb.z, siluf(xa.w) * xb.w);
        *(u32x2*)(ACT + (size_t)(pm * 256 + (which ? 255 : 0)) * DFF + ch) = w;
    }
}

#define RLX_AGENT __ATOMIC_RELAXED, __HIP_MEMORY_SCOPE_AGENT
#define XB_TMO      128
#define XB_XCNT(j)  (256  + 64 * (j))
#define XB_XSUB(j)  (1280 + 64 * (j))
#define XB_XGEN(j)  (2304 + 64 * (j))
#define XB_TOP      3328
#define XB_TOPGEN   3392
#define XCD_BAR_WORDS 3456
#define XB_SPIN_CAP (1u << 18)

__device__ __forceinline__ unsigned xb_ld(unsigned* p)              { return __hip_atomic_load(p, __ATOMIC_RELAXED, __HIP_MEMORY_SCOPE_AGENT); }
__device__ __forceinline__ unsigned xb_add(unsigned* p, unsigned v) { return __hip_atomic_fetch_add(p, v, __ATOMIC_RELAXED, __HIP_MEMORY_SCOPE_AGENT); }
__device__ __forceinline__ unsigned xb_xcc_id() { return (unsigned)__builtin_amdgcn_s_getreg((3 << 11) | 20) & 0xFu; }
#define XB_SPIN(cond, bar) do { unsigned _sp = 0; while (cond) { __builtin_amdgcn_s_sleep(1); \
    if ((++_sp & 255u) == 0u) { if (xb_ld(&(bar)[XB_TMO])) break; if (_sp > XB_SPIN_CAP) { atomicAdd(&(bar)[XB_TMO], 1u); break; } } } } while (0)

struct XcdBarrier {
    unsigned* bar; unsigned x;
    volatile LAS unsigned* st;
};

__device__ __forceinline__ XcdBarrier xcd_barrier_post(unsigned* bar, volatile LAS unsigned* st) {
    XcdBarrier b; b.bar = bar; b.x = xb_xcc_id(); b.st = st;
    if (threadIdx.x == 0) (void)xb_add(&bar[XB_XCNT(b.x)], 1u);
    return b;
}
__device__ __forceinline__ void xcd_barrier_complete(unsigned* bar, unsigned x, unsigned& nloc, unsigned& nx) {
    const unsigned G = gridDim.x * gridDim.y * gridDim.z;
    unsigned sum, cnt, mine, sp = 0u;
    for (;;) {
        sum = 0u; cnt = 0u; mine = 0u;
#pragma unroll
        for (unsigned j = 0; j < 16; ++j) { const unsigned c = xb_ld(&bar[XB_XCNT(j)]); sum += c; cnt += (c > 0u) ? 1u : 0u; mine = (j == x) ? c : mine; }
        if (sum == G) break;
        __builtin_amdgcn_s_sleep(1);
        if ((++sp & 255u) == 0u) { if (xb_ld(&bar[XB_TMO])) break; if (sp > XB_SPIN_CAP) { atomicAdd(&bar[XB_TMO], 1u); break; } }
    }
    nloc = mine > 0u ? mine : 1u; nx = cnt > 0u ? cnt : 1u;
}

__device__ __forceinline__ void xcd_barrier(const XcdBarrier& b) {
    asm volatile("s_waitcnt vmcnt(0)" ::: "memory");
    __syncthreads();
    if (threadIdx.x == 0) {
        unsigned* bar = b.bar;
        __builtin_amdgcn_s_waitcnt(0);
        unsigned nloc = b.st[0], nx = b.st[1];
        if (nloc == 0u) { xcd_barrier_complete(bar, b.x, nloc, nx); b.st[0] = nloc; b.st[1] = nx; }
        const unsigned old = xb_add(&bar[XB_XSUB(b.x)], 1u);
        const unsigned gen = old / nloc;
        if (old + 1u == (gen + 1u) * nloc) {
            __builtin_amdgcn_fence(__ATOMIC_RELEASE, "agent");
            asm volatile("s_waitcnt vmcnt(0)" ::: "memory");
            const unsigned og = xb_add(&bar[XB_TOP], 1u);
            const unsigned tg = og / nx;
            if (og + 1u == (tg + 1u) * nx) xb_add(&bar[XB_TOPGEN], 1u);
            else XB_SPIN(xb_ld(&bar[XB_TOPGEN]) == tg, bar);
            __builtin_amdgcn_fence(__ATOMIC_ACQUIRE, "agent");
            xb_add(&bar[XB_XGEN(b.x)], 1u);
            asm volatile("s_waitcnt vmcnt(0)" ::: "memory");
        } else {
            XB_SPIN(xb_ld(&bar[XB_XGEN(b.x)]) == gen, bar);
            __builtin_amdgcn_fence(__ATOMIC_ACQUIRE, "agent");
            asm volatile("s_waitcnt vmcnt(0)" ::: "memory");
        }
    }
    __syncthreads();
}


constexpr size_t OFF_CTL = 250000128; constexpr int CTL_BYTES = 16384;
#if defined(__HIP_DEVICE_COMPILE__)
#define KP() const __attribute__((address_space(4))) Params* kp_ = (const __attribute__((address_space(4))) Params*)__builtin_amdgcn_kernarg_segment_ptr(); asm volatile("" : "+s"(kp_)); const Params p = *kp_; \
    bf16_t* HN = (bf16_t*)(p.ws + OFF_HN); bf16_t* P = (bf16_t*)p.out; float* X = (float*)(p.ws + OFF_X); (void)HN; (void)P; (void)X
#else
#define KP() const Params p = p_arg; bf16_t* HN = (bf16_t*)(p.ws + OFF_HN); bf16_t* P = (bf16_t*)p.out; float* X = (float*)(p.ws + OFF_X); (void)HN; (void)P; (void)X
#endif
#define WL() const bf16_t* wl = (const bf16_t*)(p.ws + OFF_W) + (size_t)l * W_LAYER; const float* modv = (const float*)(p.ws + OFF_MOD) + (size_t)l * 3 * 6144; (void)wl; (void)modv
#ifndef DUPM
#define DUPM 0
#endif
#define REP(bit) for (int rep_ = 0; rep_ < (((DUPM) >> (bit)) & 1) + 1; ++rep_)
constexpr int PH_PER_LAYER = 10, N_PHASES = 2 + 2 * PH_PER_LAYER;
__global__ void __launch_bounds__(512, 2) mk_fwd(Params p_arg) {
    extern __shared__ __attribute__((aligned(16))) unsigned char lds[];
    cg::grid_group grid = cg::this_grid();
    const int G = gridDim.x, bx = blockIdx.x; const int vcu = (G % 8 == 0) ? (bx % 8) * (G / 8) + bx / 8 : bx;
    LAS unsigned char* ldsl = (LAS unsigned char*)lds;
    const int ph_lo = p_arg.ph_lo, ph_hi = p_arg.ph_hi;
    volatile LAS unsigned* misc = (volatile LAS unsigned*)(ldsl + (LDS_BYTES - 64));
    { const int t0_ = otid(); if (t0_ < 16) misc[t0_] = 0u; }
    __syncthreads();
    if (ph_hi - ph_lo > 1) (void)xcd_barrier_post((unsigned*)(p_arg.ws + OFF_CTL), misc);
    for (int ph = ph_lo; ph < ph_hi; ++ph) {
        if (ph == 0) { KP(); phase_prep(p, lds); __syncthreads(); }
        else if (ph == N_PHASES - 1) { KP(); phase_final(p);
#if (DUPM >> 10) & 1
            for (int i = 0; i < 20; ++i) grid.sync();
#endif
        }
        else {
            const int l = (ph - 1) / PH_PER_LAYER, sp = (ph - 1) % PH_PER_LAYER;
            if (sp == 0) { KP(); if (l == 0) REP(9) { phase_prep_weights(p, lds); __syncthreads(); }
                phase_norm(p, l, 0, l == 0, l == 1 ? (const float*)(p.ws + OFF_MOD) + 2 * 6144 + 5120 : nullptr); }
            else if (sp == 1) { KP(); WL(); REP(1) { __syncthreads();
                pg8::Gemm g{HN, wl + W_IN, R, 1792, 1024, 1024, 1024}; pg8::StaticOrder S; S.init(R, 1792, G, bx);
                pg8::EpiStore E{P, INW, INW, 1.0f};
                pg8::gemm_phase<pg8::EpiStore, pg8::StaticOrder, true, true>(ldsl, g, S, E); } }
            else if (sp == 2) { KP(); phase_rowwise(p, l); __syncthreads();
                REP(2) phase_pool(p);
                REP(3) for (int it = G - 1 - bx; it < 264; it += G) states_item(p, l, lds, it); __syncthreads(); }
            else if (sp == 3) { KP(); WL(); REP(4) { __syncthreads();
                { pg8::Gemm g{P + 768, wl + W_UQ, R, 768, 384, INW, 384}; pg8::StaticOrder S; S.init(R, 768, G, bx);
                  pg8::EpiStore E{(bf16_t*)(p.ws + OFF_OV + OV_Q), 768, 768, 0.14724444f};
                  pg8::gemm_phase<pg8::EpiStore, pg8::StaticOrder, true, true>(ldsl, g, S, E); }
                __syncthreads();
                { pg8::Gemm g{P + 1152, wl + W_KN, R, 512, 256, INW, 256}; pg8::StaticOrder S; S.init(R, 512, G, (bx + 58) % G);
                  pg8::EpiStore E{(bf16_t*)(p.ws + OFF_OV + OV_KN), 512, 512, 1.0f};
                  pg8::gemm_phase<pg8::EpiStore, pg8::StaticOrder, true, true>(ldsl, g, S, E); }
                __syncthreads();
                { pg8::Gemm g{wl + W_V, P + 1152, 512, R, 256, 256, INW}; pg8::StaticOrder S; S.init(512, R, G, (bx + 182) % G);
                  pg8::EpiStore E{(bf16_t*)(p.ws + OFF_OV + OV_VT), R, R, 1.0f};
                  pg8::gemm_phase<pg8::EpiStore, pg8::StaticOrder, true, true>(ldsl, g, S, E); }
                if (bx >= G - 64) scan_threads(p, l, (bx - (G - 64)) * NWG_T + otid()); } }
            else if (sp == 4) { KP();
                REP(5) for (int u = vcu; u < (l == 0 ? 528 : 512); u += G) attn_unit(p, lds, u);
                REP(6) for (int u = G - 1 - bx; u < (l == 0 ? 264 : 256); u += G) retout_unit(p, l, lds, l == 0 ? u : u + 4 * (u >> 7) + 4); }
            else if (sp == 5) { KP(); WL(); __syncthreads();
                { pg8::Gemm g{HN, wl + W_OUT, R, 1024, 1024, 1024, 1024}; pg8::StaticOrder S; S.init(16384, 1024, G, bx, 1);
                  pg8::EpiResid E{X, modv + 2048, 0};
                  pg8::gemm_phase<pg8::EpiResid, pg8::StaticOrder, true, true>(ldsl, g, S, E); }
                if (l == 0 && bx < 32) { __syncthreads(); const int q = bx >> 3;
                  pg8::Gemm g{HN + q * 256, wl + W_OUT + q * 256, 512, 1024, 256, 1024, 1024}; pg8::StaticOrder S; S.init(512, 1024, G, bx & 7, 2);
                  pg8::EpiPart E{(float*)(p.ws + OFF_PART) + (size_t)q * 524288, 0};
                  pg8::gemm_phase<pg8::EpiPart, pg8::StaticOrder, true, true>(ldsl, g, S, E); } }
            else if (sp == 6) { KP(); WL(); phase_norm(p, l, 1, false, l == 0 ? modv + 2 * 6144 + 2048 : nullptr); }
            else if (sp == 7) { KP(); WL(); REP(7) { __syncthreads();
                pg8::Gemm g{HN, wl + W_UP, R, 2 * DFF, 1024, 1024, 1024}; pg8::StaticOrder S; S.init(l == 1 ? 16384 : R, 2 * DFF, G, bx, l == 1 ? 1 : 0);
                pg8::EpiFfn E{(bf16_t*)(p.ws + OFF_OV), (float*)(p.ws + OFF_EDGE), p.conv_w + (size_t)l * 3 * 5632, p.conv_b + (size_t)l * 5632, (LAS float*)(ldsl + 131072)};
                pg8::gemm_phase<pg8::EpiFfn, pg8::StaticOrder, true, true>(ldsl, g, S, E); } }
            else if (sp == 8) { KP(); REP(8) phase_ffn_fixup(p, l); }
            else if (sp == 9) { KP(); WL(); __syncthreads();
                { pg8::Gemm g{(const bf16_t*)(p.ws + OFF_OV), wl + W_DN, R, 1024, DFF, DFF, DFF}; pg8::StaticOrder S; S.init(16384, 1024, G, bx, 1);
                  pg8::EpiResid E{X, modv + 5120, 0};
                  pg8::gemm_phase<pg8::EpiResid, pg8::StaticOrder, true, true>(ldsl, g, S, E); }
                if (l == 0 && bx < 32) { __syncthreads(); const int q = bx >> 3; const int koff = q < 2 ? q * 768 : 1536 + (q - 2) * 640, klen = q < 2 ? 768 : 640;
                  pg8::Gemm g{(const bf16_t*)(p.ws + OFF_OV) + koff, wl + W_DN + koff, 512, 1024, klen, DFF, DFF}; pg8::StaticOrder S; S.init(512, 1024, G, bx & 7, 2);
                  pg8::EpiPart E{(float*)(p.ws + OFF_PART) + (size_t)q * 524288, 0};
                  pg8::gemm_phase<pg8::EpiPart, pg8::StaticOrder, true, true>(ldsl, g, S, E); } }
        }
        if (ph + 1 < ph_hi) {
            if (ph_lo < 0) grid.sync();
            { KP(); XcdBarrier b; b.bar = (unsigned*)(p.ws + OFF_CTL); b.x = xb_xcc_id(); b.st = misc; xcd_barrier(b); }
        }
    }
}

extern "C" void kernel_launch(void* const* d_in, const int* in_sizes, int n_in, void* d_out, int out_size, void* d_ws, size_t ws_size, hipStream_t stream) {
    static int grid = 0;
    if (grid == 0) {
        if (n_in != 23 || ws_size < WS_NEED) { fprintf(stderr, "kernel_launch: unexpected problem (n_in %d, ws %zu, need %zu)\n", n_in, ws_size, (size_t)WS_NEED); grid = -1; return; }
        int dev = 0, cus = 0, per_cu = 0;
        hipGetDevice(&dev); hipDeviceGetAttribute(&cus, hipDeviceAttributeMultiprocessorCount, dev);
        if (hipFuncSetAttribute((const void*)mk_fwd, hipFuncAttributeMaxDynamicSharedMemorySize, LDS_BYTES) != hipSuccess) { fprintf(stderr, "kernel_launch: hipFuncSetAttribute failed\n"); grid = -1; return; }
        if (hipOccupancyMaxActiveBlocksPerMultiprocessor(&per_cu, (const void*)mk_fwd, 512, LDS_BYTES) != hipSuccess || per_cu < 1) { fprintf(stderr, "kernel_launch: occupancy query says %d\n", per_cu); per_cu = 1; }
        (void)hipGetLastError();
        grid = cus * per_cu; if (grid > 256) grid = 256;
        fprintf(stderr, "kernel_launch: grid %d (cus %d, per_cu %d)\n", grid, cus, per_cu);
    }
    if (grid < 0) return;
    Params p{};
    const float** pp = (const float**)&p;
    for (int i = 0; i < 23; ++i) pp[i] = (const float*)d_in[i];
    p.out = (float*)d_out; p.ws = (unsigned char*)d_ws;
#if MK_MULTI
    for (int ph = 0; ph < N_PHASES; ++ph) { p.ph_lo = ph; p.ph_hi = ph + 1; void* args[] = {&p};
        hipError_t e = hipLaunchCooperativeKernel((void*)mk_fwd, dim3(grid), dim3(512), args, LDS_BYTES, stream);
        if (e != hipSuccess) { fprintf(stderr, "launch %d failed: %s\n", ph, hipGetErrorString(e)); break; } }
#else
    if (hipMemsetAsync((char*)d_ws + OFF_CTL, 0, CTL_BYTES, stream) != hipSuccess) { fprintf(stderr, "kernel_launch: memset of the barrier words failed\n"); return; }
    p.ph_lo = 0; p.ph_hi = N_PHASES; void* args[] = {&p};
    hipError_t e = hipLaunchCooperativeKernel((void*)mk_fwd, dim3(grid), dim3(512), args, LDS_BYTES, stream);
    if (e != hipSuccess) fprintf(stderr, "cooperative launch failed: %s (grid %d)\n", hipGetErrorString(e), grid);
#endif
}
```

```cpp
#include <hip/hip_runtime.h>
#include <hip/hip_cooperative_groups.h>
#include <cstdio>
#include <cstdint>
namespace cg = cooperative_groups;

#ifndef MK_MULTI
#define MK_MULTI 0
#endif

namespace pg8 {
#define PG8_LAS __attribute__((address_space(3)))
typedef unsigned short bf16_t;
typedef short bf16x8 __attribute__((ext_vector_type(8)));
typedef float f32x4 __attribute__((ext_vector_type(4)));
typedef unsigned u32x4 __attribute__((ext_vector_type(4)));
constexpr int BM = 256, BK = 64, HALF = 128, HTB = HALF * BK * 2  , STAGE_BYTES = 8 * HTB, NXCD = 8, WGM = 8;

__host__ __device__ __forceinline__ int lds_byte(int r, int c) { const int st = (r >> 4) * 2 + (c >> 5), rr = r & 15, cc = c & 31, ob = rr * 64 + cc * 2; return st * 1024 + (ob ^ (((ob >> 9) & 1) << 5)); }
__host__ __device__ __forceinline__ void stage_rc(int b, int& R, int& C) { const int st = b / 1024, sb = b % 1024, swz = sb ^ (((sb >> 9) & 1) << 5); R = (st >> 1) * 16 + swz / 64; C = (st & 1) * 32 + (swz % 64) / 2; }
__host__ __device__ __forceinline__ int perm32(int rho) { const int n = rho >> 4, i = rho & 15; return 8 * (i >> 2) + 4 * n + (i & 3); }

struct Unit { int pm, pn; };
struct Gemm { const bf16_t* A; const bf16_t* Bt; int M, N, K, lda, ldb; };

struct StaticOrder {
    int nM, nN, nwg, G, c, skip;
    __host__ __device__ void init(int M, int N, int G_, int c_, int skip_ = 0) { nM = M / BM; nN = N / BM; nwg = nM * nN; G = G_; c = c_; skip = skip_; }
    __host__ __device__ bool next(int i, Unit& u) const {
        const long L = (long)i * G + c; if (L >= nwg) return false;
        int wgid = (int)L; { const int q = nwg / NXCD, r = nwg % NXCD, xcd = wgid % NXCD, off = wgid / NXCD; wgid = (xcd < r ? xcd * (q + 1) : r * (q + 1) + (xcd - r) * q) + off; }
        const int nig = WGM * nN, gid = wgid / nig, fm = gid * WGM, gsz = (nM - fm) < WGM ? (nM - fm) : WGM;
        u.pm = fm + ((wgid % nig) % gsz); u.pn = (wgid % nig) / gsz; if (skip == 1) u.pm += 1 + (u.pm >= 32 ? 1 : 0); else if (skip == 2) u.pm *= 33; return true;
    }
    __device__ __forceinline__ void a_ready(const Unit&) const {}
    __device__ __forceinline__ void done(const Unit&) const {}
};

__device__ __forceinline__ unsigned cvt_pk_bf16(float lo, float hi) { unsigned r; asm volatile("v_cvt_pk_bf16_f32 %0, %1, %2" : "=v"(r) : "v"(lo), "v"(hi)); return r; }

struct EpiStore {
    static constexpr bool PERM = true, AFTER_DRAIN = false, APERM = false;
    bf16_t* O; int ldc; int ncols; float scale;
    __device__ __forceinline__ void operator()(const f32x4 (&acc)[2][2][4][2], const Unit& u, int wr, int wc, int fr, int fq) const {
        const int row0 = u.pm * BM + wr * 64 + fr; const int col0 = u.pn * BM + wc * 32 + 8 * fq;
#pragma unroll
        for (int ai = 0; ai < 2; ++ai)
#pragma unroll
            for (int m = 0; m < 4; ++m) { bf16_t* rowp = O + (size_t)(row0 + ai * HALF + m * 16) * ldc + col0;
#pragma unroll
                for (int bj = 0; bj < 2; ++bj) { if (col0 + bj * HALF < ncols) {
                    f32x4 v0 = acc[ai][bj][m][0] * scale, v1 = acc[ai][bj][m][1] * scale;
                    u32x4 w; w.x = cvt_pk_bf16(v0[0], v0[1]); w.y = cvt_pk_bf16(v0[2], v0[3]); w.z = cvt_pk_bf16(v1[0], v1[1]); w.w = cvt_pk_bf16(v1[2], v1[3]);
                    *(u32x4*)(rowp + bj * HALF) = w; } } }
    }
};
struct EpiResid {
    static constexpr bool PERM = false, AFTER_DRAIN = false, APERM = false;
    float* X; const float* gate; int row_tile0;
    __device__ __forceinline__ void operator()(const f32x4 (&acc)[2][2][4][2], const Unit& u, int wr, int wc, int fr, int fq) const {
        const int tpm = u.pm + row_tile0; const int bb = tpm / 33, jj = tpm - bb * 33; const float* gv = gate + (jj == 0 ? 2 : bb) * 6144;
        const int col0 = u.pn * BM + wc * 32 + 4 * fq;
#pragma unroll
        for (int ai = 0; ai < 2; ++ai)
#pragma unroll
            for (int m = 0; m < 4; ++m) { float* rowp = X + (size_t)(tpm * BM + ai * HALF + wr * 64 + m * 16 + fr) * 1024 + col0;
#pragma unroll
                for (int bj = 0; bj < 2; ++bj) {
#pragma unroll
                    for (int n = 0; n < 2; ++n) { f32x4* q = (f32x4*)(rowp + bj * HALF + n * 16); const f32x4 gq = *(const f32x4*)(gv + col0 + bj * HALF + n * 16); f32x4 xv = *q; xv = xv + gq * acc[ai][bj][m][n]; *q = xv; }
                    asm volatile("" ::: "memory"); } }
    }
};
struct EpiPart {
    static constexpr bool PERM = false, AFTER_DRAIN = false, APERM = false;
    float* out; int accum;
    __device__ __forceinline__ void operator()(const f32x4 (&acc)[2][2][4][2], const Unit& u, int wr, int wc, int fr, int fq) const {
        const int t = u.pm / 33; const int col0 = u.pn * BM + wc * 32 + 4 * fq;
#pragma unroll
        for (int ai = 0; ai < 2; ++ai)
#pragma unroll
            for (int m = 0; m < 4; ++m) { float* rowp = out + (size_t)(t * BM + ai * HALF + wr * 64 + m * 16 + fr) * 1024 + col0;
#pragma unroll
                for (int bj = 0; bj < 2; ++bj) {
#pragma unroll
                    for (int n = 0; n < 2; ++n) { f32x4* q = (f32x4*)(rowp + bj * HALF + n * 16); f32x4 v = acc[ai][bj][m][n]; if (accum) v = v + *q; *q = v; }
                    asm volatile("" ::: "memory"); } }
    }
};
template <int CTRL> __device__ __forceinline__ float dpp0(float x) { return __builtin_bit_cast(float, __builtin_amdgcn_update_dpp(0, __builtin_bit_cast(int, x), CTRL, 0xf, 0xf, true)); }
struct EpiFfn {
    static constexpr bool PERM = false, AFTER_DRAIN = false, APERM = true;
    bf16_t* ACT; float* EDGE; const float* cw; const float* cb; PG8_LAS float* xl;
    __device__ __forceinline__ void operator()(const f32x4 (&acc)[2][2][4][2], const Unit& u, int wr, int wc, int fr, int fq) const {
        PG8_LAS float* FIRST = xl; PG8_LAS float* LAST = xl + 1024;
        const int cb0 = wc * 32 + 4 * fq;
#pragma unroll
        for (int ai = 0; ai < 2; ++ai)
#pragma unroll
            for (int bj = 0; bj < 2; ++bj)
#pragma unroll
                for (int n = 0; n < 2; ++n) { const int col = bj * HALF + cb0 + n * 16;
                    if (fr == 0) *(PG8_LAS f32x4*)(FIRST + (2 * ai + wr) * 256 + col) = acc[ai][bj][0][n];
                    if (fr == 15) *(PG8_LAS f32x4*)(LAST + (2 * ai + wr) * 256 + col) = acc[ai][bj][3][n]; }
        if (wr == 0 && fr == 0) {
#pragma unroll
            for (int bj = 0; bj < 2; ++bj)
#pragma unroll
                for (int n = 0; n < 2; ++n) { float* ep = EDGE + ((size_t)(u.pm * 4) * 22 + u.pn) * 256 + bj * HALF + cb0 + n * 16; *(f32x4*)ep = acc[0][bj][0][n]; *(f32x4*)(ep + 22 * 256) = acc[0][bj][1][n]; } }
        if (wr == 1 && fr == 15) {
#pragma unroll
            for (int bj = 0; bj < 2; ++bj)
#pragma unroll
                for (int n = 0; n < 2; ++n) { float* ep = EDGE + ((size_t)(u.pm * 4 + 2) * 22 + u.pn) * 256 + bj * HALF + cb0 + n * 16; *(f32x4*)ep = acc[1][bj][2][n]; *(f32x4*)(ep + 22 * 256) = acc[1][bj][3][n]; } }
        asm volatile("s_waitcnt lgkmcnt(0)" ::: "memory"); __builtin_amdgcn_s_barrier(); asm volatile("" ::: "memory");
#pragma unroll
        for (int n = 0; n < 2; ++n) { const int ch0 = u.pn * HALF + cb0 + n * 16;
            f32x4 wa[3], wb[3];
#pragma unroll
            for (int k = 0; k < 3; ++k) { wa[k] = *(const f32x4*)(cw + k * 5632 + ch0); wb[k] = *(const f32x4*)(cw + k * 5632 + 2816 + ch0); }
            const f32x4 ba = *(const f32x4*)(cb + ch0), bb = *(const f32x4*)(cb + 2816 + ch0);
#pragma unroll
            for (int ai = 0; ai < 2; ++ai) { const int g = 2 * ai + wr;
                f32x4 bu[2], bd[2];
#pragma unroll
                for (int bj = 0; bj < 2; ++bj) { const int col = bj * HALF + cb0 + n * 16; const f32x4 zz = {0.f, 0.f, 0.f, 0.f};
                    bu[bj] = g > 0 ? *(const PG8_LAS f32x4*)(LAST + (g - 1) * 256 + col) : zz; bd[bj] = g < 3 ? *(const PG8_LAS f32x4*)(FIRST + (g + 1) * 256 + col) : zz; }
                float o[4][4];
#pragma unroll
                for (int e = 0; e < 4; ++e) { float cv[2][4];
#pragma unroll
                    for (int bj = 0; bj < 2; ++bj) { const float v0 = acc[ai][bj][0][n][e], v1 = acc[ai][bj][1][n][e], v2 = acc[ai][bj][2][n][e], v3 = acc[ai][bj][3][n][e];
                        const float w0 = bj ? wb[0][e] : wa[0][e], w1 = bj ? wb[1][e] : wa[1][e], w2 = bj ? wb[2][e] : wa[2][e], bs = bj ? bb[e] : ba[e];
                        const float upx = dpp0<0x111>(v3) + (fr == 0 ? bu[bj][e] : 0.f);
                        const float dnx = dpp0<0x101>(v0) + (fr == 15 ? bd[bj][e] : 0.f);
                        cv[bj][0] = w0 * upx + w1 * v0 + w2 * v1 + bs; cv[bj][1] = w0 * v0 + w1 * v1 + w2 * v2 + bs;
                        cv[bj][2] = w0 * v1 + w1 * v2 + w2 * v3 + bs;  cv[bj][3] = w0 * v2 + w1 * v3 + w2 * dnx + bs; }
#pragma unroll
                    for (int m = 0; m < 4; ++m) o[m][e] = cv[0][m] * __builtin_amdgcn_rcpf(1.0f + __builtin_amdgcn_exp2f(-1.4426950408889634f * cv[0][m])) * cv[1][m]; }
#pragma unroll
                for (int m = 0; m < 4; ++m) { typedef unsigned u32x2 __attribute__((ext_vector_type(2))); u32x2 w; w.x = cvt_pk_bf16(o[m][0], o[m][1]); w.y = cvt_pk_bf16(o[m][2], o[m][3]);
                    *(u32x2*)(ACT + (size_t)(u.pm * BM + ai * HALF + wr * 64 + 4 * fr + m) * 2816 + ch0) = w; } } }
    }
};

template <class Epi, class Sched, bool ALIGN_EPI = false, bool SP2 = false>
__device__ __forceinline__ void gemm_phase(PG8_LAS unsigned char* lds, const Gemm g, const Sched& S, const Epi& E) {
    int tid = threadIdx.x; asm volatile("" : "+v"(tid));
    const int wid = __builtin_amdgcn_readfirstlane(tid >> 6), lane = tid & 63, wr = wid >> 2, wc = wid & 3, fr = lane & 15, fq = lane >> 4;
    int K = g.K; asm volatile("" : "+s"(K));
    const int nt = K / BK;
    unsigned voffA[2], voffB[2];
#pragma unroll
    for (int i = 0; i < 2; ++i) { int R, C; stage_rc(tid * 16 + i * 8192, R, C); const int Rb = Epi::PERM ? ((R & ~31) + perm32(R & 31)) : R;
        const int Ra = Epi::APERM ? ((R & ~63) + 4 * (R & 15) + ((R >> 4) & 3)) : R;
        voffA[i] = (unsigned)(Ra * g.lda + C) * 2u; voffB[i] = (unsigned)(Rb * g.ldb + C) * 2u; }
    const size_t kstep = (size_t)(BK * 2);
    const size_t hstepA = (size_t)HALF * g.lda * 2, hstepB = (size_t)HALF * g.ldb * 2;
    const size_t tstepA = 2 * hstepA, tstepB = 2 * hstepB;
    const unsigned ldsw = (unsigned)wid * 1024u;
    const int aoff = lds_byte(wr * 64 + fr, fq * 8), boff = lds_byte(wc * 32 + fr, fq * 8);
#define PG8_SA(b, h) (((b) * 2 + (h)) * HTB)
#define PG8_SB(b, h) ((4 + (b) * 2 + (h)) * HTB)
#define PG8_STAGE(bufoff, gbase, voff) do { _Pragma("unroll") for (int _i = 0; _i < 2; ++_i) \
        __builtin_amdgcn_global_load_lds((const unsigned*)((const char*)(gbase) + (voff)[_i]), (PG8_LAS unsigned*)(lds + (bufoff) + ldsw + _i * 8192), 16, 0, 0); } while (0)
#define PG8_LDA(dst, b, h) do { _Pragma("unroll") for (int m = 0; m < 4; ++m) _Pragma("unroll") for (int k = 0; k < 2; ++k) dst[m][k] = *(const PG8_LAS bf16x8*)(lds + PG8_SA(b, h) + aoff + m * 2048 + k * 1024); } while (0)
#define PG8_LDB(dst, b, h) do { _Pragma("unroll") for (int n = 0; n < 2; ++n) _Pragma("unroll") for (int k = 0; k < 2; ++k) dst[n][k] = *(const PG8_LAS bf16x8*)(lds + PG8_SB(b, h) + boff + n * 2048 + k * 1024); } while (0)
#define PG8_MMA(ai, bj, At, Bt) do { __builtin_amdgcn_s_setprio(1); _Pragma("unroll") for (int m = 0; m < 4; ++m) _Pragma("unroll") for (int n = 0; n < 2; ++n) _Pragma("unroll") for (int k = 0; k < 2; ++k) \
        acc[ai][bj][m][n] = __builtin_amdgcn_mfma_f32_16x16x32_bf16(Bt[n][k], At[m][k], acc[ai][bj][m][n], 0, 0, 0); __builtin_amdgcn_s_setprio(0); } while (0)
#define PG8_WAIT_V(n) asm volatile("s_waitcnt vmcnt(" #n ")" ::: "memory")
#define PG8_WAIT_L(n) asm volatile("s_waitcnt lgkmcnt(" #n ")" ::: "memory")
#define PG8_BAR __builtin_amdgcn_s_barrier()
#define PG8_SCHED __builtin_amdgcn_sched_barrier(0)
    Unit cur, nxt; int ui = 0;
    if (!S.next(0, cur)) return;
    f32x4 acc[2][2][4][2];
#pragma unroll
    for (int a = 0; a < 2; ++a)
#pragma unroll
        for (int b = 0; b < 2; ++b)
#pragma unroll
            for (int m = 0; m < 4; ++m)
#pragma unroll
                for (int n = 0; n < 2; ++n) acc[a][b][m][n] = (f32x4){0.f, 0.f, 0.f, 0.f};
    bf16x8 At[4][2], B0[2][2], B1[2][2];
    const char* cA = (const char*)g.A + (size_t)cur.pm * tstepA; const char* cB = (const char*)g.Bt + (size_t)cur.pn * tstepB;
    S.a_ready(cur);
    if constexpr (SP2) {
        PG8_STAGE(PG8_SB(0, 0), cB, voffB); PG8_STAGE(PG8_SB(0, 1), cB + hstepB, voffB); PG8_STAGE(PG8_SA(0, 0), cA, voffA); PG8_STAGE(PG8_SA(0, 1), cA + hstepA, voffA);
        if (wr == 1) PG8_BAR;
        PG8_WAIT_V(2); PG8_BAR;
        PG8_STAGE(PG8_SB(1, 0), cB + kstep, voffB); PG8_STAGE(PG8_SA(1, 0), cA + kstep, voffA); PG8_STAGE(PG8_SB(1, 1), cB + hstepB + kstep, voffB);
        PG8_WAIT_V(6); PG8_BAR;
    } else {
        PG8_STAGE(PG8_SB(0, 0), cB, voffB); PG8_STAGE(PG8_SA(0, 0), cA, voffA); PG8_STAGE(PG8_SB(0, 1), cB + hstepB, voffB); PG8_STAGE(PG8_SA(0, 1), cA + hstepA, voffA);
        if (wr == 1) PG8_BAR;
        PG8_WAIT_V(4); PG8_BAR;
        PG8_STAGE(PG8_SB(1, 0), cB + kstep, voffB); PG8_STAGE(PG8_SA(1, 0), cA + kstep, voffA); PG8_STAGE(PG8_SB(1, 1), cB + hstepB + kstep, voffB);
        PG8_WAIT_V(6); PG8_BAR;
    }
    for (;;) {
        const bool has_next = S.next(ui + 1, nxt);
        const char* nA = has_next ? (const char*)g.A + (size_t)nxt.pm * tstepA : cA; const char* nB = has_next ? (const char*)g.Bt + (size_t)nxt.pn * tstepB : cB;
        for (int t = 0; t < nt; t += 2) {
            const bool last = (t == nt - 2);
            const char* a1 = cA + (size_t)(t + 1) * kstep;
            const char* a2 = last ? nA : cA + (size_t)(t + 2) * kstep; const char* b2 = last ? nB : cB + (size_t)(t + 2) * kstep;
            const char* a3 = a2 + kstep; const char* b3 = b2 + kstep;
            if (last && has_next) S.a_ready(nxt);
            if constexpr (SP2) {
            PG8_LDB(B0, 0, 0); PG8_LDB(B1, 0, 1); PG8_SCHED; PG8_LDA(At, 0, 0); PG8_STAGE(PG8_SA(1, 1), a1 + hstepA, voffA);
            PG8_WAIT_V(8); PG8_WAIT_L(0); PG8_BAR; PG8_MMA(0, 0, At, B0); PG8_MMA(0, 1, At, B1); PG8_BAR; PG8_SCHED;
            PG8_LDA(At, 0, 1); PG8_STAGE(PG8_SB(0, 0), b2, voffB); PG8_STAGE(PG8_SB(0, 1), b2 + hstepB, voffB); PG8_STAGE(PG8_SA(0, 0), a2, voffA);
            PG8_WAIT_V(8); PG8_WAIT_L(0); PG8_BAR; PG8_MMA(1, 0, At, B0); PG8_MMA(1, 1, At, B1); PG8_BAR; PG8_SCHED;
            PG8_LDB(B0, 1, 0); PG8_LDB(B1, 1, 1); PG8_SCHED; PG8_LDA(At, 1, 0); PG8_STAGE(PG8_SA(0, 1), a2 + hstepA, voffA);
            PG8_WAIT_V(8); PG8_WAIT_L(0); PG8_BAR; PG8_MMA(0, 0, At, B0); PG8_MMA(0, 1, At, B1); PG8_BAR; PG8_SCHED;
            PG8_LDA(At, 1, 1); PG8_STAGE(PG8_SB(1, 0), b3, voffB); PG8_STAGE(PG8_SB(1, 1), b3 + hstepB, voffB); PG8_STAGE(PG8_SA(1, 0), a3, voffA);
            PG8_WAIT_V(8); PG8_WAIT_L(0); PG8_BAR; PG8_MMA(1, 0, At, B0); PG8_MMA(1, 1, At, B1); PG8_BAR; PG8_SCHED;
            } else {
            PG8_LDB(B0, 0, 0); PG8_SCHED; PG8_LDA(At, 0, 0); PG8_STAGE(PG8_SA(1, 1), a1 + hstepA, voffA);
            PG8_WAIT_L(8); PG8_BAR; PG8_WAIT_L(0); PG8_MMA(0, 0, At, B0); PG8_BAR; PG8_SCHED;
            PG8_LDB(B1, 0, 1); PG8_STAGE(PG8_SB(0, 0), b2, voffB);
            PG8_BAR; PG8_WAIT_L(0); PG8_MMA(0, 1, At, B1); PG8_BAR;
            PG8_LDA(At, 0, 1); PG8_STAGE(PG8_SA(0, 0), a2, voffA);
            PG8_BAR; PG8_WAIT_L(0); PG8_MMA(1, 0, At, B0); PG8_BAR; PG8_SCHED;
            PG8_STAGE(PG8_SB(0, 1), b2 + hstepB, voffB);
            PG8_WAIT_V(6); PG8_BAR; PG8_MMA(1, 1, At, B1); PG8_BAR;
            PG8_LDB(B0, 1, 0); PG8_SCHED; PG8_LDA(At, 1, 0); PG8_STAGE(PG8_SA(0, 1), a2 + hstepA, voffA);
            PG8_WAIT_L(8); PG8_BAR; PG8_WAIT_L(0); PG8_MMA(0, 0, At, B0); PG8_BAR; PG8_SCHED;
            PG8_LDB(B1, 1, 1); PG8_STAGE(PG8_SB(1, 0), b3, voffB);
            PG8_BAR; PG8_WAIT_L(0); PG8_MMA(0, 1, At, B1); PG8_BAR;
            PG8_LDA(At, 1, 1); PG8_STAGE(PG8_SA(1, 0), a3, voffA);
            PG8_BAR; PG8_WAIT_L(0); PG8_MMA(1, 0, At, B0); PG8_BAR; PG8_SCHED;
            PG8_STAGE(PG8_SB(1, 1), b3 + hstepB, voffB);
            PG8_WAIT_V(6); PG8_BAR; PG8_MMA(1, 1, At, B1); PG8_BAR;
            }
        }
        if constexpr (ALIGN_EPI) { if (wr == 0) PG8_BAR; }
        if constexpr (!Epi::AFTER_DRAIN) { E(acc, cur, wr, wc, fr, fq); S.done(cur); }
        if (!has_next) break;
#pragma unroll
        for (int a = 0; a < 2; ++a)
#pragma unroll
            for (int b = 0; b < 2; ++b)
#pragma unroll
                for (int m = 0; m < 4; ++m)
#pragma unroll
                    for (int n = 0; n < 2; ++n) acc[a][b][m][n] = (f32x4){0.f, 0.f, 0.f, 0.f};
        cur = nxt; cA = nA; cB = nB; ++ui;
        if constexpr (ALIGN_EPI) { if (wr == 1) PG8_BAR; }
    }
    PG8_WAIT_V(0);
    if constexpr (!ALIGN_EPI) { if (wr == 0) PG8_BAR; }
    PG8_BAR;
    if constexpr (Epi::AFTER_DRAIN) { E.fused(acc, cur, wr, wc, fr, fq, lds, wid, lane); S.done(cur); }
#undef PG8_SA
#undef PG8_SB
#undef PG8_STAGE
#undef PG8_LDA
#undef PG8_LDB
#undef PG8_MMA
#undef PG8_WAIT_V
#undef PG8_WAIT_L
#undef PG8_BAR
#undef PG8_SCHED
}
}

#define DEV __device__ __forceinline__
#define LAS __attribute__((address_space(3)))
typedef unsigned short bf16_t;
typedef short bf16x8 __attribute__((ext_vector_type(8)));
typedef float f32x4 __attribute__((ext_vector_type(4)));
typedef float f32x2 __attribute__((ext_vector_type(2)));
typedef float f32x16 __attribute__((ext_vector_type(16)));
typedef unsigned u32x4 __attribute__((ext_vector_type(4)));
typedef unsigned u32x2 __attribute__((ext_vector_type(2)));

constexpr int R = 16896, RB = 8448, NCTX = 256, TL = 8192, DM = 1024, INW = 1696, DFF = 2816, HFF = 1408;
constexpr int NWG_T = 512;
constexpr float EPS = 1e-6f;
constexpr int LDS_BYTES = 147456;
constexpr size_t OFF_X = 0, OFF_HN = 69206016, OFF_W = 103809024, OFF_MOD = 152174592, OFF_ROPE = 152436736, OFF_OV = 153485312;
constexpr size_t OV_Q = 0, OV_KN = 25952256, OV_VT = 43253760, OV_SLOC = 60555264, OV_SIN = 69206016, OV_U = 0;
constexpr size_t OFF_PART = 250100224;
constexpr size_t OFF_EDGE = 258488832;
constexpr size_t WS_NEED = OFF_EDGE + 5947392;
constexpr size_t W_IN = 0, W_UQ = 1835008, W_KN = 2129920, W_V = 2260992, W_OUT = 2392064, W_UP = 3440640, W_DN = 9207808, W_LAYER = 12091392;

struct Params {
    const float *x, *c, *ctx, *c_ctx, *w_mod, *b_mod, *norm1_g, *w_in, *ret_decay_f, *ret_decay_b, *mla_q_norm_g, *w_uq, *mla_kv_norm_g, *w_ukv,
        *pool_w, *pool_scale, *w_out, *norm2_g, *w_up, *conv_w, *conv_b, *w_down, *final_norm_g;
    float* out; unsigned char* ws; int ph_lo, ph_hi;
};

DEV int otid() { int t = threadIdx.x; asm volatile("" : "+v"(t)); return t; }
DEV float bf2f(unsigned short x) { return __uint_as_float((unsigned)x << 16); }
DEV unsigned f2bf(float f) { unsigned u = __float_as_uint(f); return (u + 0x7fffu + ((u >> 16) & 1u)) >> 16; }
DEV unsigned pk2(float lo, float hi) { return f2bf(lo) | (f2bf(hi) << 16); }
DEV float wave_sum(float v) {
#pragma unroll
    for (int o = 1; o < 64; o <<= 1) v += __shfl_xor(v, o);
    return v;
}
DEV float siluf(float x) { return x * __builtin_amdgcn_rcpf(1.0f + __builtin_amdgcn_exp2f(-1.4426950408889634f * x)); }
DEV int crow(int r, int hi) { return (r & 3) + 8 * (r >> 2) + 4 * hi; }
DEV bf16x8 pack8(float a0, float a1, float a2, float a3, float a4, float a5, float a6, float a7) {
    u32x4 w; w.x = pg8::cvt_pk_bf16(a0, a1); w.y = pg8::cvt_pk_bf16(a2, a3); w.z = pg8::cvt_pk_bf16(a4, a5); w.w = pg8::cvt_pk_bf16(a6, a7);
    return __builtin_bit_cast(bf16x8, w);
}
DEV int row_mi(int r) { const int b = r / RB; const int s = r - b * RB; return s < NCTX ? 2 : b; }

DEV void transpose_item(const float* W, int K, int Nsrc, bf16_t* WT, int n0, int cs, int k0, float* scr, int lane) {
#pragma unroll
    for (int i = 0; i < 32; ++i) { const int kk = 2 * i + (lane >> 5); scr[kk * 33 + (lane & 31)] = cs >= 0 ? W[(size_t)(k0 + kk) * Nsrc + cs + (lane & 31)] : 0.f; }
    asm volatile("s_waitcnt lgkmcnt(0)" ::: "memory");
    const int c = lane & 7;
#pragma unroll
    for (int j = 0; j < 4; ++j) { const int n = (lane >> 3) + 8 * j; const float* s = scr + (8 * c) * 33 + n;
        u32x4 o; o.x = pk2(s[0 * 33], s[1 * 33]); o.y = pk2(s[2 * 33], s[3 * 33]); o.z = pk2(s[4 * 33], s[5 * 33]); o.w = pk2(s[6 * 33], s[7 * 33]);
        *(u32x4*)(WT + (size_t)(n0 + n) * K + k0 + 8 * c) = o; }
    asm volatile("s_waitcnt lgkmcnt(0)" ::: "memory");
}
DEV int map_in(int n0) { return n0 < 1440 ? n0 : (n0 < INW ? -2 : -1); }
DEV int map_kn(int n0) { return (n0 >> 6) * 128 + (n0 & 63); }
DEV int map_v(int n0) { return (n0 >> 6) * 128 + 64 + (n0 & 63); }
DEV int map_up(int n0) { const int pn = n0 >> 8, w = n0 & 255; return w < 128 ? 128 * pn + w : DFF + 128 * pn + (w - 128); }

DEV void phase_prep(const Params& p, unsigned char* lds) {
    const int tid = otid(), lane = tid & 63, wid = tid >> 6;
    unsigned char* ws = p.ws;
    { f32x2* rope = (f32x2*)(ws + OFF_ROPE);
      for (int idx = blockIdx.x * NWG_T + tid; idx < TL * 16; idx += gridDim.x * NWG_T) { const int t = idx >> 4, i = idx & 15; const int pos = i < 8 ? (t >> 6) : (t & 63);
          const float inv = exp2f(-(float)(i & 7) * 0.125f * 13.287712379549449f); const float ang = (float)pos * inv; f32x2 cs; cs.x = __cosf(ang); cs.y = __sinf(ang); rope[idx] = cs; } }
    { float* scv = (float*)lds;
      float* red = scv + 3 * 1024;
      for (int i = tid; i < 3 * 1024; i += NWG_T) { const int v = i >> 10, k = i & 1023; const float cv = v < 2 ? p.c[v * 1024 + k] : p.c_ctx[k]; scv[i] = siluf(cv); }
      __syncthreads();
      float* modv = (float*)(ws + OFF_MOD);
      for (int it = blockIdx.x; it < 192; it += gridDim.x) { const int l = it / 96, col0 = (it % 96) * 64;
          const float* wm = p.w_mod + (size_t)l * 1024 * 6144 + col0 + lane; float a0 = 0.f, a1 = 0.f, a2 = 0.f;
#pragma unroll 16
          for (int k = wid * 128; k < wid * 128 + 128; ++k) { const float w = wm[(size_t)k * 6144]; a0 += scv[k] * w; a1 += scv[1024 + k] * w; a2 += scv[2048 + k] * w; }
          red[(wid * 3 + 0) * 64 + lane] = a0; red[(wid * 3 + 1) * 64 + lane] = a1; red[(wid * 3 + 2) * 64 + lane] = a2;
          __syncthreads();
          if (tid < 192) { const int v = tid >> 6, cl = tid & 63; float s = 0.f;
#pragma unroll
              for (int w = 0; w < 8; ++w) s += red[(w * 3 + v) * 64 + cl];
              modv[((size_t)l * 3 + v) * 6144 + col0 + cl] = s + p.b_mod[l * 6144 + col0 + cl]; }
          __syncthreads(); }
    }
}
DEV void phase_prep_weights(const Params& p, unsigned char* lds) {
    const int tid = otid(), lane = tid & 63, wid = tid >> 6;
    unsigned char* ws = p.ws;
    { float* scr = (float*)(lds + 32768 + wid * 8704);
      const int gw = blockIdx.x * 8 + wid, NGW = gridDim.x * 8;
      constexpr int I_IN = 16 * 56, I_UQ = 6 * 24, I_KN = 4 * 16, I_V = 4 * 16, I_OUT = 16 * 32, I_UP = 16 * 176, I_DN = 44 * 32, I_L = I_IN + I_UQ + I_KN + I_V + I_OUT + I_UP + I_DN;
      for (int it = gw; it < 2 * I_L; it += NGW) { const int l = it / I_L; int r = it - l * I_L; bf16_t* wl = (bf16_t*)(ws + OFF_W) + (size_t)l * W_LAYER;
          const float* src; int K, Nsrc, nbn, mp; size_t doff;
          if (r < I_IN) { src = p.w_in + (size_t)l * 1024 * INW; K = 1024; Nsrc = INW; nbn = 56; mp = 1; doff = W_IN; }
          else if ((r -= I_IN) < I_UQ) { src = p.w_uq + (size_t)l * 384 * 768; K = 384; Nsrc = 768; nbn = 24; mp = 0; doff = W_UQ; }
          else if ((r -= I_UQ) < I_KN) { src = p.w_ukv + (size_t)l * 256 * 1024; K = 256; Nsrc = 1024; nbn = 16; mp = 2; doff = W_KN; }
          else if ((r -= I_KN) < I_V) { src = p.w_ukv + (size_t)l * 256 * 1024; K = 256; Nsrc = 1024; nbn = 16; mp = 3; doff = W_V; }
          else if ((r -= I_V) < I_OUT) { src = p.w_out + (size_t)l * 1024 * 1024; K = 1024; Nsrc = 1024; nbn = 32; mp = 0; doff = W_OUT; }
          else if ((r -= I_OUT) < I_UP) { src = p.w_up + (size_t)l * 1024 * 5632; K = 1024; Nsrc = 5632; nbn = 176; mp = 4; doff = W_UP; }
          else { r -= I_UP; src = p.w_down + (size_t)l * DFF * 1024; K = DFF; Nsrc = 1024; nbn = 32; mp = 0; doff = W_DN; }
          const int kb = r / nbn, nb = r - kb * nbn, n0 = nb * 32;
          const int cs = mp == 0 ? n0 : mp == 1 ? map_in(n0) : mp == 2 ? map_kn(n0) : mp == 3 ? map_v(n0) : map_up(n0);
          if (cs != -2) transpose_item(src, K, Nsrc, wl + doff, n0, cs, kb * 64, scr, lane); }
    }
    { for (int idx = blockIdx.x * NWG_T + tid; idx < 2 * 1024 * 256; idx += gridDim.x * NWG_T) { const int n = idx & 255, k = (idx >> 8) & 1023, l = idx >> 18; const int g = n >> 6, d = n & 63;
          const float* wr = p.w_in + ((size_t)l * 1024 + k) * INW + 1440 + g * 64; const float* pw = p.pool_w + ((size_t)(l * 4 + g) * 64) * 64 + d; float s = 0.f;
#pragma unroll 8
          for (int c = 0; c < 64; ++c) s += wr[c] * pw[c * 64];
          ((bf16_t*)(ws + OFF_W) + (size_t)l * W_LAYER + W_IN)[(size_t)(1440 + n) * 1024 + k] = (bf16_t)f2bf(s * p.pool_scale[l * 256 + n]); } }
}

DEV void phase_norm(const Params& p, int l, int which, bool first, const float* pgate) {
    const int tid = otid(); const int lane = tid & 63, wid = tid >> 6; const int gw = blockIdx.x * 8 + wid, NGW = gridDim.x * 8;
    float* X = (float*)(p.ws + OFF_X); bf16_t* HN = (bf16_t*)(p.ws + OFF_HN);
    const float* modv = (const float*)(p.ws + OFF_MOD) + (size_t)l * 3 * 6144;
    const float* g = (which == 0 ? p.norm1_g : p.norm2_g) + l * 1024;
    for (int r = gw; r < R; r += NGW) {
        const int b = r / RB, s = r - b * RB; const int mi = s < NCTX ? 2 : b;
        const float* src = first ? (s < NCTX ? p.ctx + ((size_t)b * NCTX + s) * 1024 : p.x + ((size_t)b * TL + (s - NCTX)) * 1024) : X + (size_t)r * 1024;
        const f32x4* xr = (const f32x4*)src + lane; f32x4 v[4]; float ss = 0.f;
#pragma unroll
        for (int j = 0; j < 4; ++j) { v[j] = xr[64 * j]; ss += (v[j].x * v[j].x + v[j].y * v[j].y) + (v[j].z * v[j].z + v[j].w * v[j].w); }
        if (pgate != nullptr && s < NCTX) { const float* PART = (const float*)(p.ws + OFF_PART) + (size_t)(b * NCTX + s) * 1024; ss = 0.f;
#pragma unroll
            for (int j = 0; j < 4; ++j) { const f32x4 gq = ((const f32x4*)pgate)[lane + 64 * j]; f32x4 a = ((const f32x4*)PART)[lane + 64 * j];
#pragma unroll
                for (int q = 1; q < 4; ++q) a = a + ((const f32x4*)(PART + (size_t)q * 524288))[lane + 64 * j];
                v[j] = v[j] + gq * a; ss += (v[j].x * v[j].x + v[j].y * v[j].y) + (v[j].z * v[j].z + v[j].w * v[j].w); } }
        if (first || (pgate != nullptr && s < NCTX)) { f32x4* xo = (f32x4*)(X + (size_t)r * 1024) + lane;
#pragma unroll
            for (int j = 0; j < 4; ++j) xo[64 * j] = v[j]; }
        const float rs = rsqrtf(wave_sum(ss) * (1.f / 1024.f) + EPS);
        const float* mv = modv + mi * 6144 + (which == 0 ? 0 : 3072);
        u32x2* o8 = (u32x2*)(HN + (size_t)r * 1024) + lane;
#pragma unroll
        for (int j = 0; j < 4; ++j) { const f32x4 gg = ((const f32x4*)g)[lane + 64 * j], sh = ((const f32x4*)mv)[lane + 64 * j], sc = ((const f32x4*)(mv + 1024))[lane + 64 * j];
            const f32x4 y = v[j] * rs * gg; const f32x4 h = y * (sc + 1.0f) + sh; u32x2 w; w.x = pk2(h.x, h.y); w.y = pk2(h.z, h.w); o8[64 * j] = w; }
    }
}
DEV void phase_final(const Params& p) {
    const int tid = otid(); const int lane = tid & 63, wid = tid >> 6; const int gw = blockIdx.x * 8 + wid, NGW = gridDim.x * 8;
    const float* X = (const float*)(p.ws + OFF_X);
    for (int q = gw; q < 2 * TL; q += NGW) { const int b = q / TL, t = q - b * TL; const int r = b * RB + NCTX + t;
        const f32x4* xr = (const f32x4*)(X + (size_t)r * 1024) + lane; f32x4 v[4]; float ss = 0.f;
#pragma unroll
        for (int j = 0; j < 4; ++j) { v[j] = xr[64 * j]; ss += (v[j].x * v[j].x + v[j].y * v[j].y) + (v[j].z * v[j].z + v[j].w * v[j].w); }
        const float rs = rsqrtf(wave_sum(ss) * (1.f / 1024.f) + EPS);
        f32x4* o = (f32x4*)(p.out + (size_t)q * 1024) + lane;
#pragma unroll
        for (int j = 0; j < 4; ++j) { const f32x4 gg = ((const f32x4*)p.final_norm_g)[lane + 64 * j]; o[64 * j] = v[j] * rs * gg; } }
}

DEV void phase_rowwise(const Params& p, int l) {
    const int tid = otid(); const int lane = tid & 63, wid = tid >> 6; const int gw = blockIdx.x * 8 + wid, NGW = gridDim.x * 8;
    bf16_t* P = (bf16_t*)p.out; const f32x2* rope = (const f32x2*)(p.ws + OFF_ROPE);
    const float* qg = p.mla_q_norm_g + l * 384; const float* kg = p.mla_kv_norm_g + l * 256;
    float qgv[6];
#pragma unroll
    for (int j = 0; j < 3; ++j) { qgv[2 * j] = qg[2 * (lane + 64 * j)]; qgv[2 * j + 1] = qg[2 * (lane + 64 * j) + 1]; }
    const f32x4 kgv = ((const f32x4*)kg)[lane];
    for (int r0 = gw; r0 < R; r0 += 2 * NGW) {
        unsigned wq[2][3]; u32x2 wk[2]; float x1[2], x2[2]; f32x2 cs[2]; bool val[2], lat[2];
#pragma unroll
        for (int i = 0; i < 2; ++i) { const int r = r0 + i * NGW; val[i] = r < R; const int rr = val[i] ? r : r0; bf16_t* pr = P + (size_t)rr * INW; const int s = rr % RB; lat[i] = s >= NCTX;
            const unsigned* q2 = (const unsigned*)(pr + 768) + lane;
#pragma unroll
            for (int j = 0; j < 3; ++j) wq[i][j] = q2[64 * j];
            wk[i] = *((const u32x2*)(pr + 1152) + lane);
            const int li = lane & 15; x1[i] = bf2f(pr[1408 + li]); x2[i] = bf2f(pr[1408 + 16 + li]); cs[i] = rope[(lat[i] ? s - NCTX : 0) * 16 + li]; }
#pragma unroll
        for (int i = 0; i < 2; ++i) { if (!val[i]) continue; const int r = r0 + i * NGW; bf16_t* pr = P + (size_t)r * INW;
            { float ss = 0.f;
#pragma unroll
              for (int j = 0; j < 3; ++j) { const float a = bf2f(wq[i][j] & 0xffff), c2 = bf2f(wq[i][j] >> 16); ss += a * a + c2 * c2; }
              const float rs = rsqrtf(wave_sum(ss) * (1.f / 384.f) + EPS); unsigned* q2 = (unsigned*)(pr + 768) + lane;
#pragma unroll
              for (int j = 0; j < 3; ++j) q2[64 * j] = pk2(bf2f(wq[i][j] & 0xffff) * rs * qgv[2 * j], bf2f(wq[i][j] >> 16) * rs * qgv[2 * j + 1]); }
            { const float a0 = bf2f(wk[i].x & 0xffff), a1 = bf2f(wk[i].x >> 16), a2 = bf2f(wk[i].y & 0xffff), a3 = bf2f(wk[i].y >> 16);
              const float rs = rsqrtf(wave_sum((a0 * a0 + a1 * a1) + (a2 * a2 + a3 * a3)) * (1.f / 256.f) + EPS);
              u32x2 o; o.x = pk2(a0 * rs * kgv.x, a1 * rs * kgv.y); o.y = pk2(a2 * rs * kgv.z, a3 * rs * kgv.w); *((u32x2*)(pr + 1152) + lane) = o; }
            if (lat[i] && lane < 16) { pr[1408 + lane] = (bf16_t)f2bf(x1[i] * cs[i].x - x2[i] * cs[i].y); pr[1408 + 16 + lane] = (bf16_t)f2bf(x2[i] * cs[i].x + x1[i] * cs[i].y); } }
    }
}

DEV void phase_pool(const Params& p) {
    const int tid = otid(); const bf16_t* P = (const bf16_t*)p.out; bf16_t* MIX = (bf16_t*)(p.ws + OFF_HN);
    for (int idx = blockIdx.x * NWG_T + tid; idx < R * 32; idx += gridDim.x * NWG_T) { const int r = idx >> 5, cg = idx & 31; const int half = 1 << (cg >> 3);
        const int b = r / RB, s = r - b * RB; const int seq0 = s < NCTX ? b * RB : b * RB + NCTX; const int T = s < NCTX ? NCTX : TL; const int t = r - seq0;
        const int lo = max(t - half, 0), hi = min(t + half, T); float sum[8];
#pragma unroll
        for (int j = 0; j < 8; ++j) sum[j] = 0.f;
        const bf16_t* base = P + (size_t)seq0 * INW + 1440 + cg * 8;
        { bf16x8 wv[16]; const bf16x8 zz = {0, 0, 0, 0, 0, 0, 0, 0};
#pragma unroll
          for (int k = 0; k < 16; ++k) { const int tt = t - 8 + k; wv[k] = (tt >= lo && tt < hi) ? *(const bf16x8*)(base + (size_t)tt * INW) : zz; }
#pragma unroll
          for (int k = 0; k < 16; ++k)
#pragma unroll
              for (int j = 0; j < 8; ++j) sum[j] += bf2f((unsigned short)wv[k][j]); }
        const bf16x8 me = *(const bf16x8*)(base + (size_t)t * INW); const float ic = 1.0f / (float)(hi - lo); float o[8];
#pragma unroll
        for (int j = 0; j < 8; ++j) o[j] = sum[j] * ic - bf2f((unsigned short)me[j]);
        *(bf16x8*)(MIX + (size_t)r * 1024 + 768 + cg * 8) = pack8(o[0], o[1], o[2], o[3], o[4], o[5], o[6], o[7]); }
}

DEV float log2_sigmoid(float d) { return -log1pf(__expf(-d)) * 1.4426950408889634f; }
constexpr int ST_P = 272;
DEV void states_item(const Params& p, int l, unsigned char* lds, int it) {
    const int tid = otid(), lane = tid & 63, wid = tid >> 6, l32 = lane & 31, hi = lane >> 5;
    const bf16_t* P = (const bf16_t*)p.out; const f32x2* rope = (const f32x2*)(p.ws + OFF_ROPE);
    float* SLOC = (float*)(p.ws + OFF_OV + OV_SLOC);
    const int gc = it >> 1, hp = it & 1;
    unsigned char* VTl = lds;
    unsigned char* KTl = lds + 2 * 64 * ST_P;
    const int cb = gc % 66; const bool lat = cb >= 2; const int t0 = (cb - 2) * 128; const int r0 = gc * 128;
    __syncthreads();
    { const int tok = tid >> 2, hh = (tid >> 1) & 1, c = tid & 1; const int h = 2 * hp + hh;
      const bf16_t* src = P + (size_t)(r0 + tok) * INW + 128 + h * 32 + 8 * c; const bf16x8 lo = *(const bf16x8*)src, hi8 = *(const bf16x8*)(src + 16);
      const float df = exp2f(log2_sigmoid(p.ret_decay_f[l * 4 + h]) * (float)(127 - tok)) * 0.17677669529663687f, db = exp2f(log2_sigmoid(p.ret_decay_b[l * 4 + h]) * (float)tok) * 0.17677669529663687f;
#pragma unroll
      for (int j = 0; j < 8; ++j) { float x1 = bf2f((unsigned short)lo[j]), x2 = bf2f((unsigned short)hi8[j]);
          if (lat) { const f32x2 cs = rope[(t0 + tok) * 16 + 8 * c + j]; const float y1 = x1 * cs.x - x2 * cs.y, y2 = x2 * cs.x + x1 * cs.y; x1 = y1; x2 = y2; }
          bf16_t* kf = (bf16_t*)(KTl + ((hh * 2 + 0) * 32 + 8 * c + j) * ST_P) + tok; bf16_t* kb = (bf16_t*)(KTl + ((hh * 2 + 1) * 32 + 8 * c + j) * ST_P) + tok;
          kf[0] = (bf16_t)f2bf(x1 * df); kb[0] = (bf16_t)f2bf(x1 * db);
          *(bf16_t*)((unsigned char*)kf + 16 * ST_P) = (bf16_t)f2bf(x2 * df); *(bf16_t*)((unsigned char*)kb + 16 * ST_P) = (bf16_t)f2bf(x2 * db); } }
    for (int task = tid; task < 2048; task += NWG_T) { const int hh = task >> 10, tok = (task >> 3) & 127, ch = task & 7;
        const bf16x8 v = *(const bf16x8*)(P + (size_t)(r0 + tok) * INW + 256 + (2 * hp + hh) * 64 + ch * 8);
#pragma unroll
        for (int j = 0; j < 8; ++j) *((bf16_t*)(VTl + (hh * 64 + ch * 8 + j) * ST_P) + tok) = (bf16_t)v[j]; }
    __syncthreads();
    { const int hh = wid >> 2, dir = (wid >> 1) & 1, dvb = wid & 1; const int h = 2 * hp + hh;
      const unsigned char* ap = VTl + (hh * 64 + 32 * dvb + l32) * ST_P + hi * 16; const unsigned char* bp = KTl + ((hh * 2 + dir) * 32 + l32) * ST_P + hi * 16;
      bf16x8 af[8], bfr[8];
#pragma unroll
      for (int ks = 0; ks < 8; ++ks) { af[ks] = *(const bf16x8*)(ap + ks * 32); bfr[ks] = *(const bf16x8*)(bp + ks * 32); }
      f32x16 acc;
#pragma unroll
      for (int r = 0; r < 16; ++r) acc[r] = 0.f;
#pragma unroll
      for (int ks = 0; ks < 8; ++ks) acc = __builtin_amdgcn_mfma_f32_32x32x16_bf16(af[ks], bfr[ks], acc, 0, 0, 0);
      float* o = SLOC + ((size_t)(gc * 4 + h) * 2 + dir) * 2048 + l32 * 64 + 32 * dvb + 4 * hi;
#pragma unroll
      for (int g4 = 0; g4 < 4; ++g4) *(f32x4*)(o + 8 * g4) = (f32x4){acc[4 * g4], acc[4 * g4 + 1], acc[4 * g4 + 2], acc[4 * g4 + 3]}; }
}
DEV void scan_threads(const Params& p, int l, int gid) {
    if (gid >= 32768) return;
    const int e = gid & 2047, dir = (gid >> 11) & 1, h = (gid >> 12) & 3, b = gid >> 14;
    const float* SLOC = (const float*)(p.ws + OFF_OV + OV_SLOC); float* SIN = (float*)(p.ws + OFF_OV + OV_SIN);
    const float gC = exp2f(log2_sigmoid((dir == 0 ? p.ret_decay_f : p.ret_decay_b)[l * 4 + h]) * 128.f);
    float S = 0.f;
#pragma unroll 11
    for (int st = 0; st < 66; ++st) { const int cb = dir == 0 ? st : (st < 2 ? 1 - st : 67 - st); const size_t idx = ((size_t)((b * 66 + cb) * 4 + h) * 2 + dir) * 2048 + e;
        const float v = SLOC[idx]; SIN[idx] = S; S = S * gC + v; }
}

constexpr int AT_KP = 208, AT_VP = 144, AT_KB = 64 * AT_KP, AT_VBS = 64 * AT_VP, AT_V0 = 4 * AT_KB;
DEV float at_max32(const f32x16& s0, const f32x16& s1) {
    float m0 = __builtin_fmaxf(__builtin_fmaxf(s0[0], s0[1]), s0[2]), m1 = __builtin_fmaxf(__builtin_fmaxf(s1[0], s1[1]), s1[2]);
    m0 = __builtin_fmaxf(__builtin_fmaxf(m0, s0[3]), s0[4]); m1 = __builtin_fmaxf(__builtin_fmaxf(m1, s1[3]), s1[4]);
    m0 = __builtin_fmaxf(__builtin_fmaxf(m0, s0[5]), s0[6]); m1 = __builtin_fmaxf(__builtin_fmaxf(m1, s1[5]), s1[6]);
    m0 = __builtin_fmaxf(__builtin_fmaxf(m0, s0[7]), s0[8]); m1 = __builtin_fmaxf(__builtin_fmaxf(m1, s1[7]), s1[8]);
    m0 = __builtin_fmaxf(__builtin_fmaxf(m0, s0[9]), s0[10]); m1 = __builtin_fmaxf(__builtin_fmaxf(m1, s1[9]), s1[10]);
    m0 = __builtin_fmaxf(__builtin_fmaxf(m0, s0[11]), s0[12]); m1 = __builtin_fmaxf(__builtin_fmaxf(m1, s1[11]), s1[12]);
    m0 = __builtin_fmaxf(__builtin_fmaxf(m0, s0[13]), s0[14]); m1 = __builtin_fmaxf(__builtin_fmaxf(m1, s1[13]), s1[14]);
    return __builtin_fmaxf(__builtin_fmaxf(m0, s0[15]), __builtin_fmaxf(m1, s1[15]));
}
DEV void attn_unit(const Params& p, unsigned char* lds, int u) {
    const int tid = otid(), lane = tid & 63, wid = tid >> 6, l32 = lane & 31, hi = lane >> 5;
    const bf16_t* Q = (const bf16_t*)(p.ws + OFF_OV + OV_Q); const bf16_t* KN = (const bf16_t*)(p.ws + OFF_OV + OV_KN); const bf16_t* VT = (const bf16_t*)(p.ws + OFF_OV + OV_VT);
    const bf16_t* P = (const bf16_t*)p.out; bf16_t* MIX = (bf16_t*)(p.ws + OFF_HN); const f32x2* rope = (const f32x2*)(p.ws + OFF_ROPE);
    const bool isctx = u >= 512; int b, h, qrow0, NT;
    if (!isctx) { b = u >> 8; h = (u >> 5) & 7; qrow0 = b * RB + NCTX + (u & 31) * 256; NT = 132; } else { const int v = u - 512; b = v >> 3; h = v & 7; qrow0 = b * RB; NT = 4; }
    const int krow0 = b * RB; const int qrow = qrow0 + wid * 32 + l32;
    bf16x8 qf[6];
    { const bf16_t* qp = Q + (size_t)qrow * 768 + h * 96 + hi * 8;
#pragma unroll
      for (int d0 = 0; d0 < 6; ++d0) qf[d0] = *(const bf16x8*)(qp + d0 * 16);
      if (!isctx) { const f32x2* rp = rope + (size_t)(qrow - (b * RB + NCTX)) * 16 + hi * 8;
#pragma unroll
          for (int j = 0; j < 8; ++j) { const f32x2 cs = rp[j]; const float x1 = bf2f((unsigned short)qf[4][j]), x2 = bf2f((unsigned short)qf[5][j]);
              qf[4][j] = (short)f2bf(x1 * cs.x - x2 * cs.y); qf[5][j] = (short)f2bf(x2 * cs.x + x1 * cs.y); } } }
    const bf16_t* sp[3]; int sstep[3], lo[3];
#pragma unroll
    for (int k = 0; k < 2; ++k) { const int c = tid + k * 512; const int key = c / 12, part = c - key * 12; lo[k] = key * AT_KP + part * 16;
        if (part < 8) { sp[k] = KN + (size_t)(krow0 + key) * 512 + h * 64 + part * 8; sstep[k] = 64 * 512; } else { sp[k] = P + (size_t)(krow0 + key) * INW + 1408 + (part - 8) * 8; sstep[k] = 64 * INW; } }
    { const int dv = tid >> 3, kc = tid & 7; lo[2] = dv * AT_VP + (kc >> 1) * 32 + (kc & 1) * 8;   sp[2] = VT + (size_t)(h * 64 + dv) * R + krow0 + kc * 8; sstep[2] = 64; }
    const bool hasK2 = tid < 256;
    u32x4 st[3];
#define AT_GLOADK() do { st[0] = *(const u32x4*)sp[0]; sp[0] += sstep[0]; if (hasK2) { st[1] = *(const u32x4*)sp[1]; sp[1] += sstep[1]; } } while (0)
#define AT_GLOADV() do { st[2] = *(const u32x4*)sp[2]; sp[2] += sstep[2]; } while (0)
#define AT_LSTOREK(buf) do { *(u32x4*)((buf) + lo[0]) = st[0]; if (hasK2) *(u32x4*)((buf) + lo[1]) = st[1]; } while (0)
#define AT_LSTOREV(buf) do { unsigned char* d_ = (buf) + lo[2]; *(u32x2*)d_ = (u32x2){st[2].x, st[2].y}; *(u32x2*)(d_ + 16) = (u32x2){st[2].z, st[2].w}; } while (0)
#define AT_SB() __builtin_amdgcn_sched_barrier(0)
    f32x16 o0, o1, sa0, sa1, sb0, sb1, negm;
#pragma unroll
    for (int r = 0; r < 16; ++r) { o0[r] = 0.f; o1[r] = 0.f; sa0[r] = 0.f; sa1[r] = 0.f; negm[r] = 0.f; }
    float mrun = 0.f, lsum = 0.f;
    __syncthreads();
    AT_GLOADK(); AT_GLOADV(); AT_LSTOREK(lds); AT_LSTOREV(lds + AT_V0);
    AT_GLOADK(); AT_GLOADV(); AT_LSTOREK(lds + AT_KB); AT_LSTOREV(lds + AT_V0 + AT_VBS);
    AT_GLOADK(); AT_LSTOREK(lds + 2 * AT_KB);
    __syncthreads();
    { const unsigned char* ka = lds + l32 * AT_KP + hi * 16;
#pragma unroll
      for (int d0 = 0; d0 < 6; ++d0) { const bf16x8 a0 = *(const bf16x8*)(ka + d0 * 32), a1 = *(const bf16x8*)(ka + 32 * AT_KP + d0 * 32);
          sa0 = __builtin_amdgcn_mfma_f32_32x32x16_bf16(a0, qf[d0], sa0, 0, 0, 0); sa1 = __builtin_amdgcn_mfma_f32_32x32x16_bf16(a1, qf[d0], sa1, 0, 0, 0); } }
#define AT_QKM(SB0, SB1, i) do { if ((i) == 0) SB0 = __builtin_amdgcn_mfma_f32_32x32x16_bf16(kfr[0], qf[0], negm, 0, 0, 0); else if ((i) == 1) SB1 = __builtin_amdgcn_mfma_f32_32x32x16_bf16(kfr[1], qf[0], negm, 0, 0, 0); \
        else if ((i) & 1) SB1 = __builtin_amdgcn_mfma_f32_32x32x16_bf16(kfr[(i)], qf[(i) >> 1], SB1, 0, 0, 0); else SB0 = __builtin_amdgcn_mfma_f32_32x32x16_bf16(kfr[(i)], qf[(i) >> 1], SB0, 0, 0, 0); } while (0)
#define AT_EXS(acc, SA0, SA1, e) do { if ((e) < 16) { SA0[(e) & 15] = __builtin_amdgcn_exp2f(SA0[(e) & 15]); acc += SA0[(e) & 15]; } else { SA1[(e) & 15] = __builtin_amdgcn_exp2f(SA1[(e) & 15]); acc += SA1[(e) & 15]; } } while (0)
#define AT_PACK(dst, S, r0) dst = pack8(S[(r0) + 0], S[(r0) + 1], S[(r0) + 2], S[(r0) + 3], S[(r0) + 4], S[(r0) + 5], S[(r0) + 6], S[(r0) + 7])
#define AT_MAX4(m0, m1, SB0, SB1, r0) do { m0 = __builtin_fmaxf(__builtin_fmaxf(m0, SB0[(r0) + 0]), SB0[(r0) + 1]); m1 = __builtin_fmaxf(__builtin_fmaxf(m1, SB1[(r0) + 0]), SB1[(r0) + 1]); \
        m0 = __builtin_fmaxf(__builtin_fmaxf(m0, SB0[(r0) + 2]), SB0[(r0) + 3]); m1 = __builtin_fmaxf(__builtin_fmaxf(m1, SB1[(r0) + 2]), SB1[(r0) + 3]); } while (0)
#define AT_STEP(SA0, SA1, SB0, SB1, tt) do { \
        const int t_ = (tt); const bool nxt_ = t_ + 1 < NT; \
        const unsigned char* kb_ = lds + ((t_ + 1) & 3) * AT_KB; const unsigned char* vb_ = lds + AT_V0 + (t_ & 3) * AT_VBS; \
        if (t_ + 3 < NT) AT_GLOADK(); \
        if (t_ + 2 < NT) AT_GLOADV(); \
        bf16x8 kfr[12]; bf16x8 vfr[8]; \
        { const unsigned char* ka = kb_ + l32 * AT_KP + hi * 16; \
          _Pragma("unroll") for (int d0 = 0; d0 < 6; ++d0) { kfr[2 * d0] = *(const bf16x8*)(ka + d0 * 32); kfr[2 * d0 + 1] = *(const bf16x8*)(ka + 32 * AT_KP + d0 * 32); } } \
        { const float mx = mxc; \
          if (t_ == 0 || __any(mx > 8.0f)) { \
              const float rm = fmaxf(mx, __shfl_xor(mx, 32)); const float delta = (t_ == 0) ? rm : fmaxf(rm, 0.f); const float alpha = (t_ == 0) ? 1.0f : __builtin_amdgcn_exp2f(-delta); \
              mrun += delta; \
              _Pragma("unroll") for (int r = 0; r < 16; ++r) { SA0[r] -= delta; SA1[r] -= delta; o0[r] *= alpha; o1[r] *= alpha; } \
              lsum *= alpha; { const float nm = -mrun; _Pragma("unroll") for (int r = 0; r < 16; ++r) negm[r] = nm; } } } \
        float ls0 = 0.f, ls1 = 0.f; \
        AT_SB(); __builtin_amdgcn_s_setprio(1); \
          \
        _Pragma("unroll") for (int i = 0; i < 8; ++i) { \
            AT_QKM(SB0, SB1, i); \
            _Pragma("unroll") for (int k_ = 0; k_ < 3; ++k_) { const int e_ = 3 * i + k_; if (e_ < 16) { SA0[e_ & 15] = __builtin_amdgcn_exp2f(SA0[e_ & 15]); asm volatile("" : "+v"(SA0[e_ & 15])); } else { SA1[e_ & 15] = __builtin_amdgcn_exp2f(SA1[e_ & 15]); asm volatile("" : "+v"(SA1[e_ & 15])); } } \
            AT_SB(); } \
        { const unsigned char* va = vb_ + l32 * AT_VP + hi * 16; \
          _Pragma("unroll") for (int kj = 0; kj < 4; ++kj) { vfr[2 * kj] = *(const bf16x8*)(va + kj * 32); vfr[2 * kj + 1] = *(const bf16x8*)(va + 32 * AT_VP + kj * 32); } } \
        bf16x8 pb[4]; \
        _Pragma("unroll") for (int i = 8; i < 12; ++i) { \
            AT_QKM(SB0, SB1, i); \
            _Pragma("unroll") for (int k_ = 0; k_ < 2; ++k_) { const int e_ = 24 + 2 * (i - 8) + k_; SA1[e_ & 15] = __builtin_amdgcn_exp2f(SA1[e_ & 15]); asm volatile("" : "+v"(SA1[e_ & 15])); } \
            if (i == 9) { AT_PACK(pb[0], SA0, 0); asm volatile("" : "+v"(pb[0])); } \
            if (i == 11) { AT_PACK(pb[1], SA0, 8); asm volatile("" : "+v"(pb[1])); } \
            AT_SB(); } \
        float mq0 = SB0[0], mq1 = SB1[0]; __builtin_amdgcn_s_setprio(2); \
        _Pragma("unroll") for (int kj = 0; kj < 4; ++kj) { \
            o0 = __builtin_amdgcn_mfma_f32_32x32x16_bf16(vfr[2 * kj], pb[kj], o0, 0, 0, 0); o1 = __builtin_amdgcn_mfma_f32_32x32x16_bf16(vfr[2 * kj + 1], pb[kj], o1, 0, 0, 0); \
            if (kj == 0) { AT_PACK(pb[2], SA1, 0); asm volatile("" : "+v"(pb[2])); } \
            if (kj == 1) { AT_PACK(pb[3], SA1, 8); asm volatile("" : "+v"(pb[3])); } \
            _Pragma("unroll") for (int r_ = 0; r_ < 4; ++r_) { ls0 += SA0[4 * kj + r_]; ls1 += SA1[4 * kj + r_]; } \
            mq0 = __builtin_fmaxf(__builtin_fmaxf(mq0, SB0[4 * kj]), SB0[4 * kj + 1]); mq1 = __builtin_fmaxf(__builtin_fmaxf(mq1, SB1[4 * kj]), SB1[4 * kj + 1]); \
            mq0 = __builtin_fmaxf(__builtin_fmaxf(mq0, SB0[4 * kj + 2]), SB0[4 * kj + 3]); mq1 = __builtin_fmaxf(__builtin_fmaxf(mq1, SB1[4 * kj + 2]), SB1[4 * kj + 3]); \
            asm volatile("" : "+v"(mq0), "+v"(mq1), "+v"(ls0), "+v"(ls1)); AT_SB(); } \
        lsum += ls0 + ls1; \
        __builtin_amdgcn_s_setprio(0); mxc = __builtin_fmaxf(mq0, mq1);            \
        if (t_ + 3 < NT) AT_LSTOREK(lds + ((t_ + 3) & 3) * AT_KB); \
        if (t_ + 2 < NT) AT_LSTOREV(lds + AT_V0 + ((t_ + 2) & 3) * AT_VBS); \
        if (t_ & 1) __syncthreads(); \
    } while (0)
    float mxc = at_max32(sa0, sa1);
    for (int t = 0; t < NT; t += 2) { AT_STEP(sa0, sa1, sb0, sb1, t); AT_STEP(sb0, sb1, sa0, sa1, t + 1); }
    lsum += __shfl_xor(lsum, 32);
    const float inv = 1.0f / lsum;
    bf16_t* op = MIX + (size_t)qrow * 1024 + 256 + h * 64 + 4 * hi;
#pragma unroll
    for (int g4 = 0; g4 < 4; ++g4) { u32x2 w0, w1; w0.x = pk2(o0[4 * g4] * inv, o0[4 * g4 + 1] * inv); w0.y = pk2(o0[4 * g4 + 2] * inv, o0[4 * g4 + 3] * inv);
        w1.x = pk2(o1[4 * g4] * inv, o1[4 * g4 + 1] * inv); w1.y = pk2(o1[4 * g4 + 2] * inv, o1[4 * g4 + 3] * inv);
        *(u32x2*)(op + 8 * g4) = w0; *(u32x2*)(op + 32 + 8 * g4) = w1; }
#undef AT_GLOADK
#undef AT_GLOADV
#undef AT_LSTOREK
#undef AT_LSTOREV
#undef AT_STEP
#undef AT_QKM
#undef AT_EXS
#undef AT_PACK
#undef AT_MAX4
#undef AT_SB
}

constexpr int RT_VP = 264, RT_SP = 144, RT_VB = 2 * 64 * RT_VP;
DEV void retout_unit(const Params& p, int l, unsigned char* lds, int u) {
    const int tid = otid(), lane = tid & 63, wid = tid >> 6, l32 = lane & 31, hi = lane >> 5;
    const int gc = u >> 1, hp = u & 1; const int cb = gc % 66; const bool lat = cb >= 2; const int t0 = (cb - 2) * 128; const int r0 = gc * 128;
    const bf16_t* P = (const bf16_t*)p.out; bf16_t* MIX = (bf16_t*)(p.ws + OFF_HN); const f32x2* rope = (const f32x2*)(p.ws + OFF_ROPE);
    const float* SIN = (const float*)(p.ws + OFF_OV + OV_SIN);
    bf16_t* VTl = (bf16_t*)lds; bf16_t* STl = (bf16_t*)(lds + RT_VB);
    __syncthreads();
    for (int task = tid; task < 2048; task += NWG_T) { const int hh = task >> 10, key = (task >> 3) & 127, ch = task & 7;
        const bf16x8 v = *(const bf16x8*)(P + (size_t)(r0 + key) * INW + 256 + (2 * hp + hh) * 64 + ch * 8);
#pragma unroll
        for (int j = 0; j < 8; ++j) VTl[(hh * 64 + ch * 8 + j) * (RT_VP / 2) + key] = (bf16_t)v[j]; }
    for (int task = tid; task < 8192; task += NWG_T) { const int dv = task & 63, k = (task >> 6) & 31, dir = (task >> 11) & 1, hh = task >> 12;
        STl[(hh * 64 + dv) * (RT_SP / 2) + dir * 32 + k] = (bf16_t)f2bf(SIN[((size_t)(gc * 4 + 2 * hp + hh) * 2 + dir) * 2048 + k * 64 + dv]); }
    __syncthreads();
    const int hh = wid >> 2, h = 2 * hp + hh, qblk = wid & 3; const int n = 32 * qblk + l32; const int rq = r0 + n;
    const float lf = log2_sigmoid(p.ret_decay_f[l * 4 + h]), lb = log2_sigmoid(p.ret_decay_b[l * 4 + h]);
    float qv0[8], qv1[8]; bf16x8 qf0, qf1;
    { const bf16_t* qp = P + (size_t)rq * INW + h * 32 + 8 * hi; const bf16x8 a = *(const bf16x8*)qp, c2 = *(const bf16x8*)(qp + 16);
#pragma unroll
      for (int j = 0; j < 8; ++j) { float x1 = bf2f((unsigned short)a[j]), x2 = bf2f((unsigned short)c2[j]);
          if (lat) { const f32x2 cs = rope[(size_t)(t0 + n) * 16 + 8 * hi + j]; const float y1 = x1 * cs.x - x2 * cs.y, y2 = x2 * cs.x + x1 * cs.y; x1 = y1; x2 = y2; }
          qv0[j] = x1; qv1[j] = x2; }
      qf0 = pack8(qv0[0], qv0[1], qv0[2], qv0[3], qv0[4], qv0[5], qv0[6], qv0[7]); qf1 = pack8(qv1[0], qv1[1], qv1[2], qv1[3], qv1[4], qv1[5], qv1[6], qv1[7]); }
    f32x16 o0, o1;
#pragma unroll
    for (int r = 0; r < 16; ++r) { o0[r] = 0.f; o1[r] = 0.f; }
    const unsigned char* vbase = (const unsigned char*)VTl + (size_t)(hh * 64 + l32) * RT_VP + hi * 8;
    bf16x8 kga[4], kgc[4];
#pragma unroll
    for (int kb = 0; kb < 4; ++kb) { const bf16_t* kp = P + (size_t)(r0 + 32 * kb + l32) * INW + 128 + h * 32 + 8 * hi; kga[kb] = *(const bf16x8*)kp; kgc[kb] = *(const bf16x8*)(kp + 16); }
    __builtin_amdgcn_sched_barrier(0);
#pragma unroll
    for (int kb = 0; kb < 4; ++kb) {
        bf16x8 kf0, kf1;
        { const int key = 32 * kb + l32; const bf16x8 a = kga[kb], c2 = kgc[kb];
          float y1[8], y2[8];
#pragma unroll
          for (int j = 0; j < 8; ++j) { float x1 = bf2f((unsigned short)a[j]), x2 = bf2f((unsigned short)c2[j]);
              if (lat) { const f32x2 cs = rope[(size_t)(t0 + key) * 16 + 8 * hi + j]; const float z1 = x1 * cs.x - x2 * cs.y, z2 = x2 * cs.x + x1 * cs.y; x1 = z1; x2 = z2; }
              y1[j] = x1 * 0.17677669529663687f; y2[j] = x2 * 0.17677669529663687f; }
          kf0 = pack8(y1[0], y1[1], y1[2], y1[3], y1[4], y1[5], y1[6], y1[7]); kf1 = pack8(y2[0], y2[1], y2[2], y2[3], y2[4], y2[5], y2[6], y2[7]); }
        f32x16 s;
#pragma unroll
        for (int r = 0; r < 16; ++r) s[r] = 0.f;
        s = __builtin_amdgcn_mfma_f32_32x32x16_bf16(kf0, qf0, s, 0, 0, 0); s = __builtin_amdgcn_mfma_f32_32x32x16_bf16(kf1, qf1, s, 0, 0, 0);
#pragma unroll
        for (int r = 0; r < 16; ++r) { const int m = 32 * kb + crow(r, hi); const int dl = n - m; const float e = dl >= 0 ? lf * (float)dl : lb * (float)(-dl); s[r] *= __builtin_amdgcn_exp2f(e); }
#pragma unroll
        for (int jp = 0; jp < 2; ++jp) { const bf16x8 pb = pack8(s[8 * jp + 0], s[8 * jp + 1], s[8 * jp + 2], s[8 * jp + 3], s[8 * jp + 4], s[8 * jp + 5], s[8 * jp + 6], s[8 * jp + 7]);
            const unsigned char* vp = vbase + (32 * kb + 16 * jp) * 2;
            const u32x2 a00 = *(const u32x2*)vp, a01 = *(const u32x2*)(vp + 16), a10 = *(const u32x2*)(vp + 32 * RT_VP), a11 = *(const u32x2*)(vp + 32 * RT_VP + 16);
            const bf16x8 A0 = __builtin_bit_cast(bf16x8, (u32x4){a00.x, a00.y, a01.x, a01.y}), A1 = __builtin_bit_cast(bf16x8, (u32x4){a10.x, a10.y, a11.x, a11.y});
            o0 = __builtin_amdgcn_mfma_f32_32x32x16_bf16(A0, pb, o0, 0, 0, 0); o1 = __builtin_amdgcn_mfma_f32_32x32x16_bf16(A1, pb, o1, 0, 0, 0); }
    }
    { const float df = __builtin_amdgcn_exp2f(lf * (float)(n + 1)), db = __builtin_amdgcn_exp2f(lb * (float)(128 - n));
      const unsigned char* sbase = (const unsigned char*)STl + (size_t)(hh * 64 + l32) * RT_SP + hi * 16;
#pragma unroll
      for (int ks = 0; ks < 4; ++ks) { const float dd = ks < 2 ? df : db;
          const bf16x8 qb = (ks & 1) ? pack8(qv1[0] * dd, qv1[1] * dd, qv1[2] * dd, qv1[3] * dd, qv1[4] * dd, qv1[5] * dd, qv1[6] * dd, qv1[7] * dd)
                                     : pack8(qv0[0] * dd, qv0[1] * dd, qv0[2] * dd, qv0[3] * dd, qv0[4] * dd, qv0[5] * dd, qv0[6] * dd, qv0[7] * dd);
          const bf16x8 A0 = *(const bf16x8*)(sbase + ks * 32), A1 = *(const bf16x8*)(sbase + 32 * RT_SP + ks * 32);
          o0 = __builtin_amdgcn_mfma_f32_32x32x16_bf16(A0, qb, o0, 0, 0, 0); o1 = __builtin_amdgcn_mfma_f32_32x32x16_bf16(A1, qb, o1, 0, 0, 0); } }
    float ssq = 0.f;
#pragma unroll
    for (int r = 0; r < 16; ++r) ssq += o0[r] * o0[r] + o1[r] * o1[r];
    ssq += __shfl_xor(ssq, 32);
    const float rstd = rsqrtf(ssq * (1.f / 64.f) + EPS);
    const bf16_t* gp = P + (size_t)rq * INW + 512 + h * 64 + 4 * hi; bf16_t* op = MIX + (size_t)rq * 1024 + h * 64 + 4 * hi;
#pragma unroll
    for (int g4 = 0; g4 < 4; ++g4) { const u32x2 ga = *(const u32x2*)(gp + 8 * g4), gb = *(const u32x2*)(gp + 32 + 8 * g4);
        u32x2 w0, w1;
        w0.x = pk2(o0[4 * g4] * rstd * siluf(bf2f(ga.x & 0xffff)), o0[4 * g4 + 1] * rstd * siluf(bf2f(ga.x >> 16))); w0.y = pk2(o0[4 * g4 + 2] * rstd * siluf(bf2f(ga.y & 0xffff)), o0[4 * g4 + 3] * rstd * siluf(bf2f(ga.y >> 16)));
        w1.x = pk2(o1[4 * g4] * rstd * siluf(bf2f(gb.x & 0xffff)), o1[4 * g4 + 1] * rstd * siluf(bf2f(gb.x >> 16))); w1.y = pk2(o1[4 * g4 + 2] * rstd * siluf(bf2f(gb.y & 0xffff)), o1[4 * g4 + 3] * rstd * siluf(bf2f(gb.y >> 16)));
        *(u32x2*)(op + 8 * g4) = w0; *(u32x2*)(op + 32 + 8 * g4) = w1; }
}

DEV void phase_ffn_fixup(const Params& p, int l) {
    const float* EDGE = (const float*)(p.ws + OFF_EDGE); bf16_t* ACT = (bf16_t*)(p.ws + OFF_OV);
    const float* cw = p.conv_w + (size_t)l * 3 * 5632; const float* cbv = p.conv_b + (size_t)l * 5632;
    for (int idx = blockIdx.x * NWG_T + otid(); idx < 66 * 2 * 704; idx += gridDim.x * NWG_T) {
        const int ch4 = idx % 704, rest = idx / 704; const int which = rest & 1, pm = rest >> 1; const int jj = pm % 33;
        if (l == 1 && jj == 0) continue;
        const int ch = 4 * ch4, pn = ch >> 7, c = ch & 127;
        const bool sstart = jj <= 1, send = (jj == 0) || (jj == 32);
        const f32x4 zz = {0.f, 0.f, 0.f, 0.f};
#define EDG(tile, k, half) (*(const f32x4*)(EDGE + ((size_t)((tile) * 4 + (k)) * 22 + pn) * 256 + (half) * 128 + c))
        f32x4 ua, ub, ca, cb2, da, db;
        if (which == 0) { ua = sstart ? zz : EDG(pm - 1, 3, 0); ub = sstart ? zz : EDG(pm - 1, 3, 1); ca = EDG(pm, 0, 0); cb2 = EDG(pm, 0, 1); da = EDG(pm, 1, 0); db = EDG(pm, 1, 1); }
        else { ua = EDG(pm, 2, 0); ub = EDG(pm, 2, 1); ca = EDG(pm, 3, 0); cb2 = EDG(pm, 3, 1); da = send ? zz : EDG(pm + 1, 0, 0); db = send ? zz : EDG(pm + 1, 0, 1); }
#undef EDG
        const f32x4 wa0 = *(const f32x4*)(cw + ch), wa1 = *(const f32x4*)(cw + 5632 + ch), wa2 = *(const f32x4*)(cw + 2 * 5632 + ch), ba = *(const f32x4*)(cbv + ch);
        const f32x4 wb0 = *(const f32x4*)(cw + DFF + ch), wb1 = *(const f32x4*)(cw + 5632 + DFF + ch), wb2 = *(const f32x4*)(cw + 2 * 5632 + DFF + ch), bb = *(const f32x4*)(cbv + DFF + ch);
        const f32x4 xa = wa0 * ua + wa1 * ca + wa2 * da + ba, xb = wb0 * ub + wb1 * cb2 + wb2 * db + bb;
        u32x2 w; w.x = pk2(siluf(xa.x) * xb.x, siluf(xa.y) * xb.y); w.y = pk2(siluf(xa.z) * xb.z, siluf(xa.w) * xb.w);
        *(u32x2*)(ACT + (size_t)(pm * 256 + (which ? 255 : 0)) * DFF + ch) = w;
    }
}

#define RLX_AGENT __ATOMIC_RELAXED, __HIP_MEMORY_SCOPE_AGENT
#define XB_TMO      128
#define XB_XCNT(j)  (256  + 64 * (j))
#define XB_XSUB(j)  (1280 + 64 * (j))
#define XB_XGEN(j)  (2304 + 64 * (j))
#define XB_TOP      3328
#define XB_TOPGEN   3392
#define XCD_BAR_WORDS 3456
#define XB_SPIN_CAP (1u << 18)

__device__ __forceinline__ unsigned xb_ld(unsigned* p)              { return __hip_atomic_load(p, __ATOMIC_RELAXED, __HIP_MEMORY_SCOPE_AGENT); }
__device__ __forceinline__ unsigned xb_add(unsigned* p, unsigned v) { return __hip_atomic_fetch_add(p, v, __ATOMIC_RELAXED, __HIP_MEMORY_SCOPE_AGENT); }
__device__ __forceinline__ unsigned xb_xcc_id() { return (unsigned)__builtin_amdgcn_s_getreg((3 << 11) | 20) & 0xFu; }
#define XB_SPIN(cond, bar) do { unsigned _sp = 0; while (cond) { __builtin_amdgcn_s_sleep(1); \
    if ((++_sp & 255u) == 0u) { if (xb_ld(&(bar)[XB_TMO])) break; if (_sp > XB_SPIN_CAP) { atomicAdd(&(bar)[XB_TMO], 1u); break; } } } } while (0)

struct XcdBarrier {
    unsigned* bar; unsigned x;
    volatile LAS unsigned* st;
};

__device__ __forceinline__ XcdBarrier xcd_barrier_post(unsigned* bar, volatile LAS unsigned* st) {
    XcdBarrier b; b.bar = bar; b.x = xb_xcc_id(); b.st = st;
    if (threadIdx.x == 0) (void)xb_add(&bar[XB_XCNT(b.x)], 1u);
    return b;
}
__device__ __forceinline__ void xcd_barrier_complete(unsigned* bar, unsigned x, unsigned& nloc, unsigned& nx) {
    const unsigned G = gridDim.x * gridDim.y * gridDim.z;
    unsigned sum, cnt, mine, sp = 0u;
    for (;;) {
        sum = 0u; cnt = 0u; mine = 0u;
#pragma unroll
        for (unsigned j = 0; j < 16; ++j) { const unsigned c = xb_ld(&bar[XB_XCNT(j)]); sum += c; cnt += (c > 0u) ? 1u : 0u; mine = (j == x) ? c : mine; }
        if (sum == G) break;
        __builtin_amdgcn_s_sleep(1);
        if ((++sp & 255u) == 0u) { if (xb_ld(&bar[XB_TMO])) break; if (sp > XB_SPIN_CAP) { atomicAdd(&bar[XB_TMO], 1u); break; } }
    }
    nloc = mine > 0u ? mine : 1u; nx = cnt > 0u ? cnt : 1u;
}

__device__ __forceinline__ void xcd_barrier(const XcdBarrier& b) {
    asm volatile("s_waitcnt vmcnt(0)" ::: "memory");
    __syncthreads();
    if (threadIdx.x == 0) {
        unsigned* bar = b.bar;
        __builtin_amdgcn_s_waitcnt(0);
        unsigned nloc = b.st[0], nx = b.st[1];
        if (nloc == 0u) { xcd_barrier_complete(bar, b.x, nloc, nx); b.st[0] = nloc; b.st[1] = nx; }
        const unsigned old = xb_add(&bar[XB_XSUB(b.x)], 1u);
        const unsigned gen = old / nloc;
        if (old + 1u == (gen + 1u) * nloc) {
            __builtin_amdgcn_fence(__ATOMIC_RELEASE, "agent");
            asm volatile("s_waitcnt vmcnt(0)" ::: "memory");
            const unsigned og = xb_add(&bar[XB_TOP], 1u);
            const unsigned tg = og / nx;
            if (og + 1u == (tg + 1u) * nx) xb_add(&bar[XB_TOPGEN], 1u);
            else XB_SPIN(xb_ld(&bar[XB_TOPGEN]) == tg, bar);
            __builtin_amdgcn_fence(__ATOMIC_ACQUIRE, "agent");
            xb_add(&bar[XB_XGEN(b.x)], 1u);
            asm volatile("s_waitcnt vmcnt(0)" ::: "memory");
        } else {
            XB_SPIN(xb_ld(&bar[XB_XGEN(b.x)]) == gen, bar);
            __builtin_amdgcn_fence(__ATOMIC_ACQUIRE, "agent");
            asm volatile("s_waitcnt vmcnt(0)" ::: "memory");
        }
    }
    __syncthreads();
}


constexpr size_t OFF_CTL = 250000128; constexpr int CTL_BYTES = 16384;
#if defined(__HIP_DEVICE_COMPILE__)
#define KP() const __attribute__((address_space(4))) Params* kp_ = (const __attribute__((address_space(4))) Params*)__builtin_amdgcn_kernarg_segment_ptr(); asm volatile("" : "+s"(kp_)); const Params p = *kp_; \
    bf16_t* HN = (bf16_t*)(p.ws + OFF_HN); bf16_t* P = (bf16_t*)p.out; float* X = (float*)(p.ws + OFF_X); (void)HN; (void)P; (void)X
#else
#define KP() const Params p = p_arg; bf16_t* HN = (bf16_t*)(p.ws + OFF_HN); bf16_t* P = (bf16_t*)p.out; float* X = (float*)(p.ws + OFF_X); (void)HN; (void)P; (void)X
#endif
#define WL() const bf16_t* wl = (const bf16_t*)(p.ws + OFF_W) + (size_t)l * W_LAYER; const float* modv = (const float*)(p.ws + OFF_MOD) + (size_t)l * 3 * 6144; (void)wl; (void)modv
#ifndef DUPM
#define DUPM 0
#endif
#define REP(bit) for (int rep_ = 0; rep_ < (((DUPM) >> (bit)) & 1) + 1; ++rep_)
constexpr int PH_PER_LAYER = 10, N_PHASES = 2 + 2 * PH_PER_LAYER;
__global__ void __launch_bounds__(512, 2) mk_fwd(Params p_arg) {
    extern __shared__ __attribute__((aligned(16))) unsigned char lds[];
    cg::grid_group grid = cg::this_grid();
    const int G = gridDim.x, bx = blockIdx.x; const int vcu = (G % 8 == 0) ? (bx % 8) * (G / 8) + bx / 8 : bx;
    LAS unsigned char* ldsl = (LAS unsigned char*)lds;
    const int ph_lo = p_arg.ph_lo, ph_hi = p_arg.ph_hi;
    volatile LAS unsigned* misc = (volatile LAS unsigned*)(ldsl + (LDS_BYTES - 64));
    { const int t0_ = otid(); if (t0_ < 16) misc[t0_] = 0u; }
    __syncthreads();
    if (ph_hi - ph_lo > 1) (void)xcd_barrier_post((unsigned*)(p_arg.ws + OFF_CTL), misc);
    for (int ph = ph_lo; ph < ph_hi; ++ph) {
        if (ph == 0) { KP(); phase_prep(p, lds); __syncthreads(); }
        else if (ph == N_PHASES - 1) { KP(); phase_final(p);
#if (DUPM >> 10) & 1
            for (int i = 0; i < 20; ++i) grid.sync();
#endif
        }
        else {
            const int l = (ph - 1) / PH_PER_LAYER, sp = (ph - 1) % PH_PER_LAYER;
            if (sp == 0) { KP(); if (l == 0) REP(9) { phase_prep_weights(p, lds); __syncthreads(); }
                phase_norm(p, l, 0, l == 0, l == 1 ? (const float*)(p.ws + OFF_MOD) + 2 * 6144 + 5120 : nullptr); }
            else if (sp == 1) { KP(); WL(); REP(1) { __syncthreads();
                pg8::Gemm g{HN, wl + W_IN, R, 1792, 1024, 1024, 1024}; pg8::StaticOrder S; S.init(R, 1792, G, bx);
                pg8::EpiStore E{P, INW, INW, 1.0f};
                pg8::gemm_phase<pg8::EpiStore, pg8::StaticOrder, true, true>(ldsl, g, S, E); } }
            else if (sp == 2) { KP(); phase_rowwise(p, l); __syncthreads();
                REP(2) phase_pool(p);
                REP(3) for (int it = G - 1 - bx; it < 264; it += G) states_item(p, l, lds, it); __syncthreads(); }
            else if (sp == 3) { KP(); WL(); REP(4) { __syncthreads();
                { pg8::Gemm g{P + 768, wl + W_UQ, R, 768, 384, INW, 384}; pg8::StaticOrder S; S.init(R, 768, G, bx);
                  pg8::EpiStore E{(bf16_t*)(p.ws + OFF_OV + OV_Q), 768, 768, 0.14724444f};
                  pg8::gemm_phase<pg8::EpiStore, pg8::StaticOrder, true, true>(ldsl, g, S, E); }
                __syncthreads();
                { pg8::Gemm g{P + 1152, wl + W_KN, R, 512, 256, INW, 256}; pg8::StaticOrder S; S.init(R, 512, G, (bx + 58) % G);
                  pg8::EpiStore E{(bf16_t*)(p.ws + OFF_OV + OV_KN), 512, 512, 1.0f};
                  pg8::gemm_phase<pg8::EpiStore, pg8::StaticOrder, true, true>(ldsl, g, S, E); }
                __syncthreads();
                { pg8::Gemm g{wl + W_V, P + 1152, 512, R, 256, 256, INW}; pg8::StaticOrder S; S.init(512, R, G, (bx + 182) % G);
                  pg8::EpiStore E{(bf16_t*)(p.ws + OFF_OV + OV_VT), R, R, 1.0f};
                  pg8::gemm_phase<pg8::EpiStore, pg8::StaticOrder, true, true>(ldsl, g, S, E); }
                if (bx >= G - 64) scan_threads(p, l, (bx - (G - 64)) * NWG_T + otid()); } }
            else if (sp == 4) { KP();
                REP(5) for (int u = vcu; u < (l == 0 ? 528 : 512); u += G) attn_unit(p, lds, u);
                REP(6) for (int u = G - 1 - bx; u < (l == 0 ? 264 : 256); u += G) retout_unit(p, l, lds, l == 0 ? u : u + 4 * (u >> 7) + 4); }
            else if (sp == 5) { KP(); WL(); __syncthreads();
                { pg8::Gemm g{HN, wl + W_OUT, R, 1024, 1024, 1024, 1024}; pg8::StaticOrder S; S.init(16384, 1024, G, bx, 1);
                  pg8::EpiResid E{X, modv + 2048, 0};
                  pg8::gemm_phase<pg8::EpiResid, pg8::StaticOrder, true, true>(ldsl, g, S, E); }
                if (l == 0 && bx < 32) { __syncthreads(); const int q = bx >> 3;
                  pg8::Gemm g{HN + q * 256, wl + W_OUT + q * 256, 512, 1024, 256, 1024, 1024}; pg8::StaticOrder S; S.init(512, 1024, G, bx & 7, 2);
                  pg8::EpiPart E{(float*)(p.ws + OFF_PART) + (size_t)q * 524288, 0};
                  pg8::gemm_phase<pg8::EpiPart, pg8::StaticOrder, true, true>(ldsl, g, S, E); } }
            else if (sp == 6) { KP(); WL(); phase_norm(p, l, 1, false, l == 0 ? modv + 2 * 6144 + 2048 : nullptr); }
            else if (sp == 7) { KP(); WL(); REP(7) { __syncthreads();
                pg8::Gemm g{HN, wl + W_UP, R, 2 * DFF, 1024, 1024, 1024}; pg8::StaticOrder S; S.init(l == 1 ? 16384 : R, 2 * DFF, G, bx, l == 1 ? 1 : 0);
                pg8::EpiFfn E{(bf16_t*)(p.ws + OFF_OV), (float*)(p.ws + OFF_EDGE), p.conv_w + (size_t)l * 3 * 5632, p.conv_b + (size_t)l * 5632, (LAS float*)(ldsl + 131072)};
                pg8::gemm_phase<pg8::EpiFfn, pg8::StaticOrder, true, true>(ldsl, g, S, E); } }
            else if (sp == 8) { KP(); REP(8) phase_ffn_fixup(p, l); }
            else if (sp == 9) { KP(); WL(); __syncthreads();
                { pg8::Gemm g{(const bf16_t*)(p.ws + OFF_OV), wl + W_DN, R, 1024, DFF, DFF, DFF}; pg8::StaticOrder S; S.init(16384, 1024, G, bx, 1);
                  pg8::EpiResid E{X, modv + 5120, 0};
                  pg8::gemm_phase<pg8::EpiResid, pg8::StaticOrder, true, true>(ldsl, g, S, E); }
                if (l == 0 && bx < 32) { __syncthreads(); const int q = bx >> 3; const int koff = q < 2 ? q * 768 : 1536 + (q - 2) * 640, klen = q < 2 ? 768 : 640;
                  pg8::Gemm g{(const bf16_t*)(p.ws + OFF_OV) + koff, wl + W_DN + koff, 512, 1024, klen, DFF, DFF}; pg8::StaticOrder S; S.init(512, 1024, G, bx & 7, 2);
                  pg8::EpiPart E{(float*)(p.ws + OFF_PART) + (size_t)q * 524288, 0};
                  pg8::gemm_phase<pg8::EpiPart, pg8::StaticOrder, true, true>(ldsl, g, S, E); } }
        }
        if (ph + 1 < ph_hi) {
            if (ph_lo < 0) grid.sync();
            { KP(); XcdBarrier b; b.bar = (unsigned*)(p.ws + OFF_CTL); b.x = xb_xcc_id(); b.st = misc; xcd_barrier(b); }
        }
    }
}

extern "C" void kernel_launch(void* const* d_in, const int* in_sizes, int n_in, void* d_out, int out_size, void* d_ws, size_t ws_size, hipStream_t stream) {
    static int grid = 0;
    if (grid == 0) {
        if (n_in != 23 || ws_size < WS_NEED) { fprintf(stderr, "kernel_launch: unexpected problem (n_in %d, ws %zu, need %zu)\n", n_in, ws_size, (size_t)WS_NEED); grid = -1; return; }
        int dev = 0, cus = 0, per_cu = 0;
        hipGetDevice(&dev); hipDeviceGetAttribute(&cus, hipDeviceAttributeMultiprocessorCount, dev);
        if (hipFuncSetAttribute((const void*)mk_fwd, hipFuncAttributeMaxDynamicSharedMemorySize, LDS_BYTES) != hipSuccess) { fprintf(stderr, "kernel_launch: hipFuncSetAttribute failed\n"); grid = -1; return; }
        if (hipOccupancyMaxActiveBlocksPerMultiprocessor(&per_cu, (const void*)mk_fwd, 512, LDS_BYTES) != hipSuccess || per_cu < 1) { fprintf(stderr, "kernel_launch: occupancy query says %d\n", per_cu); per_cu = 1; }
        (void)hipGetLastError();
        grid = cus * per_cu; if (grid > 256) grid = 256;
        fprintf(stderr, "kernel_launch: grid %d (cus %d, per_cu %d)\n", grid, cus, per_cu);
    }
    if (grid < 0) return;
    Params p{};
    const float** pp = (const float**)&p;
    for (int i = 0; i < 23; ++i) pp[i] = (const float*)d_in[i];
    p.out = (float*)d_out; p.ws = (unsigned char*)d_ws;
#if MK_MULTI
    for (int ph = 0; ph < N_PHASES; ++ph) { p.ph_lo = ph; p.ph_hi = ph + 1; void* args[] = {&p};
        hipError_t e = hipLaunchCooperativeKernel((void*)mk_fwd, dim3(grid), dim3(512), args, LDS_BYTES, stream);
        if (e != hipSuccess) { fprintf(stderr, "launch %d failed: %s\n", ph, hipGetErrorString(e)); break; } }
#else
    if (hipMemsetAsync((char*)d_ws + OFF_CTL, 0, CTL_BYTES, stream) != hipSuccess) { fprintf(stderr, "kernel_launch: memset of the barrier words failed\n"); return; }
    p.ph_lo = 0; p.ph_hi = N_PHASES; void* args[] = {&p};
    hipError_t e = hipLaunchCooperativeKernel((void*)mk_fwd, dim3(grid), dim3(512), args, LDS_BYTES, stream);
    if (e != hipSuccess) fprintf(stderr, "cooperative launch failed: %s (grid %d)\n", hipGetErrorString(e), grid);
#endif
}
```

```cpp
#include <hip/hip_runtime.h>
#include <hip/hip_cooperative_groups.h>
#include <cstdio>
#include <cstdint>
namespace cg = cooperative_groups;

#ifndef MK_MULTI
#define MK_MULTI 0
#endif

namespace pg8 {
#define PG8_LAS __attribute__((address_space(3)))
typedef unsigned short bf16_t;
typedef short bf16x8 __attribute__((ext_vector_type(8)));
typedef float f32x4 __attribute__((ext_vector_type(4)));
typedef unsigned u32x4 __attribute__((ext_vector_type(4)));
constexpr int BM = 256, BK = 64, HALF = 128, HTB = HALF * BK * 2  , STAGE_BYTES = 8 * HTB, NXCD = 8, WGM = 8;

__host__ __device__ __forceinline__ int lds_byte(int r, int c) { const int st = (r >> 4) * 2 + (c >> 5), rr = r & 15, cc = c & 31, ob = rr * 64 + cc * 2; return st * 1024 + (ob ^ (((ob >> 9) & 1) << 5)); }
__host__ __device__ __forceinline__ void stage_rc(int b, int& R, int& C) { const int st = b / 1024, sb = b % 1024, swz = sb ^ (((sb >> 9) & 1) << 5); R = (st >> 1) * 16 + swz / 64; C = (st & 1) * 32 + (swz % 64) / 2; }
__host__ __device__ __forceinline__ int perm32(int rho) { const int n = rho >> 4, i = rho & 15; return 8 * (i >> 2) + 4 * n + (i & 3); }

struct Unit { int pm, pn; };
struct Gemm { const bf16_t* A; const bf16_t* Bt; int M, N, K, lda, ldb; };

struct StaticOrder {
    int nM, nN, nwg, G, c, skip;
    __host__ __device__ void init(int M, int N, int G_, int c_, int skip_ = 0) { nM = M / BM; nN = N / BM; nwg = nM * nN; G = G_; c = c_; skip = skip_; }
    __host__ __device__ bool next(int i, Unit& u) const {
        const long L = (long)i * G + c; if (L >= nwg) return false;
        int wgid = (int)L; { const int q = nwg / NXCD, r = nwg % NXCD, xcd = wgid % NXCD, off = wgid / NXCD; wgid = (xcd < r ? xcd * (q + 1) : r * (q + 1) + (xcd - r) * q) + off; }
        const int nig = WGM * nN, gid = wgid / nig, fm = gid * WGM, gsz = (nM - fm) < WGM ? (nM - fm) : WGM;
        u.pm = fm + ((wgid % nig) % gsz); u.pn = (wgid % nig) / gsz; if (skip == 1) u.pm += 1 + (u.pm >= 32 ? 1 : 0); else if (skip == 2) u.pm *= 33; return true;
    }
    __device__ __forceinline__ void a_ready(const Unit&) const {}
    __device__ __forceinline__ void done(const Unit&) const {}
};

__device__ __forceinline__ unsigned cvt_pk_bf16(float lo, float hi) { unsigned r; asm volatile("v_cvt_pk_bf16_f32 %0, %1, %2" : "=v"(r) : "v"(lo), "v"(hi)); return r; }

struct EpiStore {
    static constexpr bool PERM = true, AFTER_DRAIN = false, APERM = false;
    bf16_t* O; int ldc; int ncols; float scale;
    __device__ __forceinline__ void operator()(const f32x4 (&acc)[2][2][4][2], const Unit& u, int wr, int wc, int fr, int fq) const {
        const int row0 = u.pm * BM + wr * 64 + fr; const int col0 = u.pn * BM + wc * 32 + 8 * fq;
#pragma unroll
        for (int ai = 0; ai < 2; ++ai)
#pragma unroll
            for (int m = 0; m < 4; ++m) { bf16_t* rowp = O + (size_t)(row0 + ai * HALF + m * 16) * ldc + col0;
#pragma unroll
                for (int bj = 0; bj < 2; ++bj) { if (col0 + bj * HALF < ncols) {
                    f32x4 v0 = acc[ai][bj][m][0] * scale, v1 = acc[ai][bj][m][1] * scale;
                    u32x4 w; w.x = cvt_pk_bf16(v0[0], v0[1]); w.y = cvt_pk_bf16(v0[2], v0[3]); w.z = cvt_pk_bf16(v1[0], v1[1]); w.w = cvt_pk_bf16(v1[2], v1[3]);
                    *(u32x4*)(rowp + bj * HALF) = w; } } }
    }
};
struct EpiResid {
    static constexpr bool PERM = false, AFTER_DRAIN = false, APERM = false;
    float* X; const float* gate; int row_tile0;
    __device__ __forceinline__ void operator()(const f32x4 (&acc)[2][2][4][2], const Unit& u, int wr, int wc, int fr, int fq) const {
        const int tpm = u.pm + row_tile0; const int bb = tpm / 33, jj = tpm - bb * 33; const float* gv = gate + (jj == 0 ? 2 : bb) * 6144;
        const int col0 = u.pn * BM + wc * 32 + 4 * fq;
#pragma unroll
        for (int ai = 0; ai < 2; ++ai)
#pragma unroll
            for (int m = 0; m < 4; ++m) { float* rowp = X + (size_t)(tpm * BM + ai * HALF + wr * 64 + m * 16 + fr) * 1024 + col0;
#pragma unroll
                for (int bj = 0; bj < 2; ++bj) {
#pragma unroll
                    for (int n = 0; n < 2; ++n) { f32x4* q = (f32x4*)(rowp + bj * HALF + n * 16); const f32x4 gq = *(const f32x4*)(gv + col0 + bj * HALF + n * 16); f32x4 xv = *q; xv = xv + gq * acc[ai][bj][m][n]; *q = xv; }
                    asm volatile("" ::: "memory"); } }
    }
};
struct EpiPart {
    static constexpr bool PERM = false, AFTER_DRAIN = false, APERM = false;
    float* out; int accum;
    __device__ __forceinline__ void operator()(const f32x4 (&acc)[2][2][4][2], const Unit& u, int wr, int wc, int fr, int fq) const {
        const int t = u.pm / 33; const int col0 = u.pn * BM + wc * 32 + 4 * fq;
#pragma unroll
        for (int ai = 0; ai < 2; ++ai)
#pragma unroll
            for (int m = 0; m < 4; ++m) { float* rowp = out + (size_t)(t * BM + ai * HALF + wr * 64 + m * 16 + fr) * 1024 + col0;
#pragma unroll
                for (int bj = 0; bj < 2; ++bj) {
#pragma unroll
                    for (int n = 0; n < 2; ++n) { f32x4* q = (f32x4*)(rowp + bj * HALF + n * 16); f32x4 v = acc[ai][bj][m][n]; if (accum) v = v + *q; *q = v; }
                    asm volatile("" ::: "memory"); } }
    }
};
template <int CTRL> __device__ __forceinline__ float dpp0(float x) { return __builtin_bit_cast(float, __builtin_amdgcn_update_dpp(0, __builtin_bit_cast(int, x), CTRL, 0xf, 0xf, true)); }
struct EpiFfn {
    static constexpr bool PERM = false, AFTER_DRAIN = false, APERM = true;
    bf16_t* ACT; float* EDGE; const float* cw; const float* cb; PG8_LAS float* xl;
    __device__ __forceinline__ void operator()(const f32x4 (&acc)[2][2][4][2], const Unit& u, int wr, int wc, int fr, int fq) const {
        PG8_LAS float* FIRST = xl; PG8_LAS float* LAST = xl + 1024;
        const int cb0 = wc * 32 + 4 * fq;
#pragma unroll
        for (int ai = 0; ai < 2; ++ai)
#pragma unroll
            for (int bj = 0; bj < 2; ++bj)
#pragma unroll
                for (int n = 0; n < 2; ++n) { const int col = bj * HALF + cb0 + n * 16;
                    if (fr == 0) *(PG8_LAS f32x4*)(FIRST + (2 * ai + wr) * 256 + col) = acc[ai][bj][0][n];
                    if (fr == 15) *(PG8_LAS f32x4*)(LAST + (2 * ai + wr) * 256 + col) = acc[ai][bj][3][n]; }
        if (wr == 0 && fr == 0) {
#pragma unroll
            for (int bj = 0; bj < 2; ++bj)
#pragma unroll
                for (int n = 0; n < 2; ++n) { float* ep = EDGE + ((size_t)(u.pm * 4) * 22 + u.pn) * 256 + bj * HALF + cb0 + n * 16; *(f32x4*)ep = acc[0][bj][0][n]; *(f32x4*)(ep + 22 * 256) = acc[0][bj][1][n]; } }
        if (wr == 1 && fr == 15) {
#pragma unroll
            for (int bj = 0; bj < 2; ++bj)
#pragma unroll
                for (int n = 0; n < 2; ++n) { float* ep = EDGE + ((size_t)(u.pm * 4 + 2) * 22 + u.pn) * 256 + bj * HALF + cb0 + n * 16; *(f32x4*)ep = acc[1][bj][2][n]; *(f32x4*)(ep + 22 * 256) = acc[1][bj][3][n]; } }
        asm volatile("s_waitcnt lgkmcnt(0)" ::: "memory"); __builtin_amdgcn_s_barrier(); asm volatile("" ::: "memory");
#pragma unroll
        for (int n = 0; n < 2; ++n) { const int ch0 = u.pn * HALF + cb0 + n * 16;
            f32x4 wa[3], wb[3];
#pragma unroll
            for (int k = 0; k < 3; ++k) { wa[k] = *(const f32x4*)(cw + k * 5632 + ch0); wb[k] = *(const f32x4*)(cw + k * 5632 + 2816 + ch0); }
            const f32x4 ba = *(const f32x4*)(cb + ch0), bb = *(const f32x4*)(cb + 2816 + ch0);
#pragma unroll
            for (int ai = 0; ai < 2; ++ai) { const int g = 2 * ai + wr;
                f32x4 bu[2], bd[2];
#pragma unroll
                for (int bj = 0; bj < 2; ++bj) { const int col = bj * HALF + cb0 + n * 16; const f32x4 zz = {0.f, 0.f, 0.f, 0.f};
                    bu[bj] = g > 0 ? *(const PG8_LAS f32x4*)(LAST + (g - 1) * 256 + col) : zz; bd[bj] = g < 3 ? *(const PG8_LAS f32x4*)(FIRST + (g + 1) * 256 + col) : zz; }
                float o[4][4];
#pragma unroll
                for (int e = 0; e < 4; ++e) { float cv[2][4];
#pragma unroll
                    for (int bj = 0; bj < 2; ++bj) { const float v0 = acc[ai][bj][0][n][e], v1 = acc[ai][bj][1][n][e], v2 = acc[ai][bj][2][n][e], v3 = acc[ai][bj][3][n][e];
                        const float w0 = bj ? wb[0][e] : wa[0][e], w1 = bj ? wb[1][e] : wa[1][e], w2 = bj ? wb[2][e] : wa[2][e], bs = bj ? bb[e] : ba[e];
                        const float upx = dpp0<0x111>(v3) + (fr == 0 ? bu[bj][e] : 0.f);
                        const float dnx = dpp0<0x101>(v0) + (fr == 15 ? bd[bj][e] : 0.f);
                        cv[bj][0] = w0 * upx + w1 * v0 + w2 * v1 + bs; cv[bj][1] = w0 * v0 + w1 * v1 + w2 * v2 + bs;
                        cv[bj][2] = w0 * v1 + w1 * v2 + w2 * v3 + bs;  cv[bj][3] = w0 * v2 + w1 * v3 + w2 * dnx + bs; }
#pragma unroll
                    for (int m = 0; m < 4; ++m) o[m][e] = cv[0][m] * __builtin_amdgcn_rcpf(1.0f + __builtin_amdgcn_exp2f(-1.4426950408889634f * cv[0][m])) * cv[1][m]; }
#pragma unroll
                for (int m = 0; m < 4; ++m) { typedef unsigned u32x2 __attribute__((ext_vector_type(2))); u32x2 w; w.x = cvt_pk_bf16(o[m][0], o[m][1]); w.y = cvt_pk_bf16(o[m][2], o[m][3]);
                    *(u32x2*)(ACT + (size_t)(u.pm * BM + ai * HALF + wr * 64 + 4 * fr + m) * 2816 + ch0) = w; } } }
    }
};

template <class Epi, class Sched, bool ALIGN_EPI = false, bool SP2 = false>
__device__ __forceinline__ void gemm_phase(PG8_LAS unsigned char* lds, const Gemm g, const Sched& S, const Epi& E) {
    int tid = threadIdx.x; asm volatile("" : "+v"(tid));
    const int wid = __builtin_amdgcn_readfirstlane(tid >> 6), lane = tid & 63, wr = wid >> 2, wc = wid & 3, fr = lane & 15, fq = lane >> 4;
    int K = g.K; asm volatile("" : "+s"(K));
    const int nt = K / BK;
    unsigned voffA[2], voffB[2];
#pragma unroll
    for (int i = 0; i < 2; ++i) { int R, C; stage_rc(tid * 16 + i * 8192, R, C); const int Rb = Epi::PERM ? ((R & ~31) + perm32(R & 31)) : R;
        const int Ra = Epi::APERM ? ((R & ~63) + 4 * (R & 15) + ((R >> 4) & 3)) : R;
        voffA[i] = (unsigned)(Ra * g.lda + C) * 2u; voffB[i] = (unsigned)(Rb * g.ldb + C) * 2u; }
    const size_t kstep = (size_t)(BK * 2);
    const size_t hstepA = (size_t)HALF * g.lda * 2, hstepB = (size_t)HALF * g.ldb * 2;
    const size_t tstepA = 2 * hstepA, tstepB = 2 * hstepB;
    const unsigned ldsw = (unsigned)wid * 1024u;
    const int aoff = lds_byte(wr * 64 + fr, fq * 8), boff = lds_byte(wc * 32 + fr, fq * 8);
#define PG8_SA(b, h) (((b) * 2 + (h)) * HTB)
#define PG8_SB(b, h) ((4 + (b) * 2 + (h)) * HTB)
#define PG8_STAGE(bufoff, gbase, voff) do { _Pragma("unroll") for (int _i = 0; _i < 2; ++_i) \
        __builtin_amdgcn_global_load_lds((const unsigned*)((const char*)(gbase) + (voff)[_i]), (PG8_LAS unsigned*)(lds + (bufoff) + ldsw + _i * 8192), 16, 0, 0); } while (0)
#define PG8_LDA(dst, b, h) do { _Pragma("unroll") for (int m = 0; m < 4; ++m) _Pragma("unroll") for (int k = 0; k < 2; ++k) dst[m][k] = *(const PG8_LAS bf16x8*)(lds + PG8_SA(b, h) + aoff + m * 2048 + k * 1024); } while (0)
#define PG8_LDB(dst, b, h) do { _Pragma("unroll") for (int n = 0; n < 2; ++n) _Pragma("unroll") for (int k = 0; k < 2; ++k) dst[n][k] = *(const PG8_LAS bf16x8*)(lds + PG8_SB(b, h) + boff + n * 2048 + k * 1024); } while (0)
#define PG8_MMA(ai, bj, At, Bt) do { __builtin_amdgcn_s_setprio(1); _Pragma("unroll") for (int m = 0; m < 4; ++m) _Pragma("unroll") for (int n = 0; n < 2; ++n) _Pragma("unroll") for (int k = 0; k < 2; ++k) \
        acc[ai][bj][m][n] = __builtin_amdgcn_mfma_f32_16x16x32_bf16(Bt[n][k], At[m][k], acc[ai][bj][m][n], 0, 0, 0); __builtin_amdgcn_s_setprio(0); } while (0)
#define PG8_WAIT_V(n) asm volatile("s_waitcnt vmcnt(" #n ")" ::: "memory")
#define PG8_WAIT_L(n) asm volatile("s_waitcnt lgkmcnt(" #n ")" ::: "memory")
#define PG8_BAR __builtin_amdgcn_s_barrier()
#define PG8_SCHED __builtin_amdgcn_sched_barrier(0)
    Unit cur, nxt; int ui = 0;
    if (!S.next(0, cur)) return;
    f32x4 acc[2][2][4][2];
#pragma unroll
    for (int a = 0; a < 2; ++a)
#pragma unroll
        for (int b = 0; b < 2; ++b)
#pragma unroll
            for (int m = 0; m < 4; ++m)
#pragma unroll
                for (int n = 0; n < 2; ++n) acc[a][b][m][n] = (f32x4){0.f, 0.f, 0.f, 0.f};
    bf16x8 At[4][2], B0[2][2], B1[2][2];
    const char* cA = (const char*)g.A + (size_t)cur.pm * tstepA; const char* cB = (const char*)g.Bt + (size_t)cur.pn * tstepB;
    S.a_ready(cur);
    if constexpr (SP2) {
        PG8_STAGE(PG8_SB(0, 0), cB, voffB); PG8_STAGE(PG8_SB(0, 1), cB + hstepB, voffB); PG8_STAGE(PG8_SA(0, 0), cA, voffA); PG8_STAGE(PG8_SA(0, 1), cA + hstepA, voffA);
        if (wr == 1) PG8_BAR;
        PG8_WAIT_V(2); PG8_BAR;
        PG8_STAGE(PG8_SB(1, 0), cB + kstep, voffB); PG8_STAGE(PG8_SA(1, 0), cA + kstep, voffA); PG8_STAGE(PG8_SB(1, 1), cB + hstepB + kstep, voffB);
        PG8_WAIT_V(6); PG8_BAR;
    } else {
        PG8_STAGE(PG8_SB(0, 0), cB, voffB); PG8_STAGE(PG8_SA(0, 0), cA, voffA); PG8_STAGE(PG8_SB(0, 1), cB + hstepB, voffB); PG8_STAGE(PG8_SA(0, 1), cA + hstepA, voffA);
        if (wr == 1) PG8_BAR;
        PG8_WAIT_V(4); PG8_BAR;
        PG8_STAGE(PG8_SB(1, 0), cB + kstep, voffB); PG8_STAGE(PG8_SA(1, 0), cA + kstep, voffA); PG8_STAGE(PG8_SB(1, 1), cB + hstepB + kstep, voffB);
        PG8_WAIT_V(6); PG8_BAR;
    }
    for (;;) {
        const bool has_next = S.next(ui + 1, nxt);
        const char* nA = has_next ? (const char*)g.A + (size_t)nxt.pm * tstepA : cA; const char* nB = has_next ? (const char*)g.Bt + (size_t)nxt.pn * tstepB : cB;
        for (int t = 0; t < nt; t += 2) {
            const bool last = (t == nt - 2);
            const char* a1 = cA + (size_t)(t + 1) * kstep;
            const char* a2 = last ? nA : cA + (size_t)(t + 2) * kstep; const char* b2 = last ? nB : cB + (size_t)(t + 2) * kstep;
            const char* a3 = a2 + kstep; const char* b3 = b2 + kstep;
            if (last && has_next) S.a_ready(nxt);
            if constexpr (SP2) {
            PG8_LDB(B0, 0, 0); PG8_LDB(B1, 0, 1); PG8_SCHED; PG8_LDA(At, 0, 0); PG8_STAGE(PG8_SA(1, 1), a1 + hstepA, voffA);
            PG8_WAIT_V(8); PG8_WAIT_L(0); PG8_BAR; PG8_MMA(0, 0, At, B0); PG8_MMA(0, 1, At, B1); PG8_BAR; PG8_SCHED;
            PG8_LDA(At, 0, 1); PG8_STAGE(PG8_SB(0, 0), b2, voffB); PG8_STAGE(PG8_SB(0, 1), b2 + hstepB, voffB); PG8_STAGE(PG8_SA(0, 0), a2, voffA);
            PG8_WAIT_V(8); PG8_WAIT_L(0); PG8_BAR; PG8_MMA(1, 0, At, B0); PG8_MMA(1, 1, At, B1); PG8_BAR; PG8_SCHED;
            PG8_LDB(B0, 1, 0); PG8_LDB(B1, 1, 1); PG8_SCHED; PG8_LDA(At, 1, 0); PG8_STAGE(PG8_SA(0, 1), a2 + hstepA, voffA);
            PG8_WAIT_V(8); PG8_WAIT_L(0); PG8_BAR; PG8_MMA(0, 0, At, B0); PG8_MMA(0, 1, At, B1); PG8_BAR; PG8_SCHED;
            PG8_LDA(At, 1, 1); PG8_STAGE(PG8_SB(1, 0), b3, voffB); PG8_STAGE(PG8_SB(1, 1), b3 + hstepB, voffB); PG8_STAGE(PG8_SA(1, 0), a3, voffA);
            PG8_WAIT_V(8); PG8_WAIT_L(0); PG8_BAR; PG8_MMA(1, 0, At, B0); PG8_MMA(1, 1, At, B1); PG8_BAR; PG8_SCHED;
            } else {
            PG8_LDB(B0, 0, 0); PG8_SCHED; PG8_LDA(At, 0, 0); PG8_STAGE(PG8_SA(1, 1), a1 + hstepA, voffA);
            PG8_WAIT_L(8); PG8_BAR; PG8_WAIT_L(0); PG8_MMA(0, 0, At, B0); PG8_BAR; PG8_SCHED;
            PG8_LDB(B1, 0, 1); PG8_STAGE(PG8_SB(0, 0), b2, voffB);
            PG8_BAR; PG8_WAIT_L(0); PG8_MMA(0, 1, At, B1); PG8_BAR;
            PG8_LDA(At, 0, 1); PG8_STAGE(PG8_SA(0, 0), a2, voffA);
            PG8_BAR; PG8_WAIT_L(0); PG8_MMA(1, 0, At, B0); PG8_BAR; PG8_SCHED;
            PG8_STAGE(PG8_SB(0, 1), b2 + hstepB, voffB);
            PG8_WAIT_V(6); PG8_BAR; PG8_MMA(1, 1, At, B1); PG8_BAR;
            PG8_LDB(B0, 1, 0); PG8_SCHED; PG8_LDA(At, 1, 0); PG8_STAGE(PG8_SA(0, 1), a2 + hstepA, voffA);
            PG8_WAIT_L(8); PG8_BAR; PG8_WAIT_L(0); PG8_MMA(0, 0, At, B0); PG8_BAR; PG8_SCHED;
            PG8_LDB(B1, 1, 1); PG8_STAGE(PG8_SB(1, 0), b3, voffB);
            PG8_BAR; PG8_WAIT_L(0); PG8_MMA(0, 1, At, B1); PG8_BAR;
            PG8_LDA(At, 1, 1); PG8_STAGE(PG8_SA(1, 0), a3, voffA);
            PG8_BAR; PG8_WAIT_L(0); PG8_MMA(1, 0, At, B0); PG8_BAR; PG8_SCHED;
            PG8_STAGE(PG8_SB(1, 1), b3 + hstepB, voffB);
            PG8_WAIT_V(6); PG8_BAR; PG8_MMA(1, 1, At, B1); PG8_BAR;
            }
        }
        if constexpr (ALIGN_EPI) { if (wr == 0) PG8_BAR; }
        if constexpr (!Epi::AFTER_DRAIN) { E(acc, cur, wr, wc, fr, fq); S.done(cur); }
        if (!has_next) break;
#pragma unroll
        for (int a = 0; a < 2; ++a)
#pragma unroll
            for (int b = 0; b < 2; ++b)
#pragma unroll
                for (int m = 0; m < 4; ++m)
#pragma unroll
                    for (int n = 0; n < 2; ++n) acc[a][b][m][n] = (f32x4){0.f, 0.f, 0.f, 0.f};
        cur = nxt; cA = nA; cB = nB; ++ui;
        if constexpr (ALIGN_EPI) { if (wr == 1) PG8_BAR; }
    }
    PG8_WAIT_V(0);
    if constexpr (!ALIGN_EPI) { if (wr == 0) PG8_BAR; }
    PG8_BAR;
    if constexpr (Epi::AFTER_DRAIN) { E.fused(acc, cur, wr, wc, fr, fq, lds, wid, lane); S.done(cur); }
#undef PG8_SA
#undef PG8_SB
#undef PG8_STAGE
#undef PG8_LDA
#undef PG8_LDB
#undef PG8_MMA
#undef PG8_WAIT_V
#undef PG8_WAIT_L
#undef PG8_BAR
#undef PG8_SCHED
}
}

#define DEV __device__ __forceinline__
#define LAS __attribute__((address_space(3)))
typedef unsigned short bf16_t;
typedef short bf16x8 __attribute__((ext_vector_type(8)));
typedef float f32x4 __attribute__((ext_vector_type(4)));
typedef float f32x2 __attribute__((ext_vector_type(2)));
typedef float f32x16 __attribute__((ext_vector_type(16)));
typedef unsigned u32x4 __attribute__((ext_vector_type(4)));
typedef unsigned u32x2 __attribute__((ext_vector_type(2)));

constexpr int R = 16896, RB = 8448, NCTX = 256, TL = 8192, DM = 1024, INW = 1696, DFF = 2816, HFF = 1408;
constexpr int NWG_T = 512;
constexpr float EPS = 1e-6f;
constexpr int LDS_BYTES = 147456;
constexpr size_t OFF_X = 0, OFF_HN = 69206016, OFF_W = 103809024, OFF_MOD = 152174592, OFF_ROPE = 152436736, OFF_OV = 153485312;
constexpr size_t OV_Q = 0, OV_KN = 25952256, OV_VT = 43253760, OV_SLOC = 60555264, OV_SIN = 69206016, OV_U = 0;
constexpr size_t OFF_PART = 250100224;
constexpr size_t OFF_EDGE = 258488832;
constexpr size_t WS_NEED = OFF_EDGE + 5947392;
constexpr size_t W_IN = 0, W_UQ = 1835008, W_KN = 2129920, W_V = 2260992, W_OUT = 2392064, W_UP = 3440640, W_DN = 9207808, W_LAYER = 12091392;

struct Params {
    const float *x, *c, *ctx, *c_ctx, *w_mod, *b_mod, *norm1_g, *w_in, *ret_decay_f, *ret_decay_b, *mla_q_norm_g, *w_uq, *mla_kv_norm_g, *w_ukv,
        *pool_w, *pool_scale, *w_out, *norm2_g, *w_up, *conv_w, *conv_b, *w_down, *final_norm_g;
    float* out; unsigned char* ws; int ph_lo, ph_hi;
};

DEV int otid() { int t = threadIdx.x; asm volatile("" : "+v"(t)); return t; }
DEV float bf2f(unsigned short x) { return __uint_as_float((unsigned)x << 16); }
DEV unsigned f2bf(float f) { unsigned u = __float_as_uint(f); return (u + 0x7fffu + ((u >> 16) & 1u)) >> 16; }
DEV unsigned pk2(float lo, float hi) { return f2bf(lo) | (f2bf(hi) << 16); }
DEV float wave_sum(float v) {
#pragma unroll
    for (int o = 1; o < 64; o <<= 1) v += __shfl_xor(v, o);
    return v;
}
DEV float siluf(float x) { return x * __builtin_amdgcn_rcpf(1.0f + __builtin_amdgcn_exp2f(-1.4426950408889634f * x)); }
DEV int crow(int r, int hi) { return (r & 3) + 8 * (r >> 2) + 4 * hi; }
DEV bf16x8 pack8(float a0, float a1, float a2, float a3, float a4, float a5, float a6, float a7) {
    u32x4 w; w.x = pg8::cvt_pk_bf16(a0, a1); w.y = pg8::cvt_pk_bf16(a2, a3); w.z = pg8::cvt_pk_bf16(a4, a5); w.w = pg8::cvt_pk_bf16(a6, a7);
    return __builtin_bit_cast(bf16x8, w);
}
DEV int row_mi(int r) { const int b = r / RB; const int s = r - b * RB; return s < NCTX ? 2 : b; }

DEV void transpose_item(const float* W, int K, int Nsrc, bf16_t* WT, int n0, int cs, int k0, float* scr, int lane) {
#pragma unroll
    for (int i = 0; i < 32; ++i) { const int kk = 2 * i + (lane >> 5); scr[kk * 33 + (lane & 31)] = cs >= 0 ? W[(size_t)(k0 + kk) * Nsrc + cs + (lane & 31)] : 0.f; }
    asm volatile("s_waitcnt lgkmcnt(0)" ::: "memory");
    const int c = lane & 7;
#pragma unroll
    for (int j = 0; j < 4; ++j) { const int n = (lane >> 3) + 8 * j; const float* s = scr + (8 * c) * 33 + n;
        u32x4 o; o.x = pk2(s[0 * 33], s[1 * 33]); o.y = pk2(s[2 * 33], s[3 * 33]); o.z = pk2(s[4 * 33], s[5 * 33]); o.w = pk2(s[6 * 33], s[7 * 33]);
        *(u32x4*)(WT + (size_t)(n0 + n) * K + k0 + 8 * c) = o; }
    asm volatile("s_waitcnt lgkmcnt(0)" ::: "memory");
}
DEV int map_in(int n0) { return n0 < 1440 ? n0 : (n0 < INW ? -2 : -1); }
DEV int map_kn(int n0) { return (n0 >> 6) * 128 + (n0 & 63); }
DEV int map_v(int n0) { return (n0 >> 6) * 128 + 64 + (n0 & 63); }
DEV int map_up(int n0) { const int pn = n0 >> 8, w = n0 & 255; return w < 128 ? 128 * pn + w : DFF + 128 * pn + (w - 128); }

DEV void phase_prep(const Params& p, unsigned char* lds) {
    const int tid = otid(), lane = tid & 63, wid = tid >> 6;
    unsigned char* ws = p.ws;
    { f32x2* rope = (f32x2*)(ws + OFF_ROPE);
      for (int idx = blockIdx.x * NWG_T + tid; idx < TL * 16; idx += gridDim.x * NWG_T) { const int t = idx >> 4, i = idx & 15; const int pos = i < 8 ? (t >> 6) : (t & 63);
          const float inv = exp2f(-(float)(i & 7) * 0.125f * 13.287712379549449f); const float ang = (float)pos * inv; f32x2 cs; cs.x = __cosf(ang); cs.y = __sinf(ang); rope[idx] = cs; } }
    { float* scv = (float*)lds;
      float* red = scv + 3 * 1024;
      for (int i = tid; i < 3 * 1024; i += NWG_T) { const int v = i >> 10, k = i & 1023; const float cv = v < 2 ? p.c[v * 1024 + k] : p.c_ctx[k]; scv[i] = siluf(cv); }
      __syncthreads();
      float* modv = (float*)(ws + OFF_MOD);
      for (int it = blockIdx.x; it < 192; it += gridDim.x) { const int l = it / 96, col0 = (it % 96) * 64;
          const float* wm = p.w_mod + (size_t)l * 1024 * 6144 + col0 + lane; float a0 = 0.f, a1 = 0.f, a2 = 0.f;
#pragma unroll 16
          for (int k = wid * 128; k < wid * 128 + 128; ++k) { const float w = wm[(size_t)k * 6144]; a0 += scv[k] * w; a1 += scv[1024 + k] * w; a2 += scv[2048 + k] * w; }
          red[(wid * 3 + 0) * 64 + lane] = a0; red[(wid * 3 + 1) * 64 + lane] = a1; red[(wid * 3 + 2) * 64 + lane] = a2;
          __syncthreads();
          if (tid < 192) { const int v = tid >> 6, cl = tid & 63; float s = 0.f;
#pragma unroll
              for (int w = 0; w < 8; ++w) s += red[(w * 3 + v) * 64 + cl];
              modv[((size_t)l * 3 + v) * 6144 + col0 + cl] = s + p.b_mod[l * 6144 + col0 + cl]; }
          __syncthreads(); }
    }
}
DEV void phase_prep_weights(const Params& p, unsigned char* lds) {
    const int tid = otid(), lane = tid & 63, wid = tid >> 6;
    unsigned char* ws = p.ws;
    { float* scr = (float*)(lds + 32768 + wid * 8704);
      const int gw = blockIdx.x * 8 + wid, NGW = gridDim.x * 8;
      constexpr int I_IN = 16 * 56, I_UQ = 6 * 24, I_KN = 4 * 16, I_V = 4 * 16, I_OUT = 16 * 32, I_UP = 16 * 176, I_DN = 44 * 32, I_L = I_IN + I_UQ + I_KN + I_V + I_OUT + I_UP + I_DN;
      for (int it = gw; it < 2 * I_L; it += NGW) { const int l = it / I_L; int r = it - l * I_L; bf16_t* wl = (bf16_t*)(ws + OFF_W) + (size_t)l * W_LAYER;
          const float* src; int K, Nsrc, nbn, mp; size_t doff;
          if (r < I_IN) { src = p.w_in + (size_t)l * 1024 * INW; K = 1024; Nsrc = INW; nbn = 56; mp = 1; doff = W_IN; }
          else if ((r -= I_IN) < I_UQ) { src = p.w_uq + (size_t)l * 384 * 768; K = 384; Nsrc = 768; nbn = 24; mp = 0; doff = W_UQ; }
          else if ((r -= I_UQ) < I_KN) { src = p.w_ukv + (size_t)l * 256 * 1024; K = 256; Nsrc = 1024; nbn = 16; mp = 2; doff = W_KN; }
          else if ((r -= I_KN) < I_V) { src = p.w_ukv + (size_t)l * 256 * 1024; K = 256; Nsrc = 1024; nbn = 16; mp = 3; doff = W_V; }
          else if ((r -= I_V) < I_OUT) { src = p.w_out + (size_t)l * 1024 * 1024; K = 1024; Nsrc = 1024; nbn = 32; mp = 0; doff = W_OUT; }
          else if ((r -= I_OUT) < I_UP) { src = p.w_up + (size_t)l * 1024 * 5632; K = 1024; Nsrc = 5632; nbn = 176; mp = 4; doff = W_UP; }
          else { r -= I_UP; src = p.w_down + (size_t)l * DFF * 1024; K = DFF; Nsrc = 1024; nbn = 32; mp = 0; doff = W_DN; }
          const int kb = r / nbn, nb = r - kb * nbn, n0 = nb * 32;
          const int cs = mp == 0 ? n0 : mp == 1 ? map_in(n0) : mp == 2 ? map_kn(n0) : mp == 3 ? map_v(n0) : map_up(n0);
          if (cs != -2) transpose_item(src, K, Nsrc, wl + doff, n0, cs, kb * 64, scr, lane); }
    }
    { for (int idx = blockIdx.x * NWG_T + tid; idx < 2 * 1024 * 256; idx += gridDim.x * NWG_T) { const int n = idx & 255, k = (idx >> 8) & 1023, l = idx >> 18; const int g = n >> 6, d = n & 63;
          const float* wr = p.w_in + ((size_t)l * 1024 + k) * INW + 1440 + g * 64; const float* pw = p.pool_w + ((size_t)(l * 4 + g) * 64) * 64 + d; float s = 0.f;
#pragma unroll 8
          for (int c = 0; c < 64; ++c) s += wr[c] * pw[c * 64];
          ((bf16_t*)(ws + OFF_W) + (size_t)l * W_LAYER + W_IN)[(size_t)(1440 + n) * 1024 + k] = (bf16_t)f2bf(s * p.pool_scale[l * 256 + n]); } }
}

DEV void phase_norm(const Params& p, int l, int which, bool first, const float* pgate) {
    const int tid = otid(); const int lane = tid & 63, wid = tid >> 6; const int gw = blockIdx.x * 8 + wid, NGW = gridDim.x * 8;
    float* X = (float*)(p.ws + OFF_X); bf16_t* HN = (bf16_t*)(p.ws + OFF_HN);
    const float* modv = (const float*)(p.ws + OFF_MOD) + (size_t)l * 3 * 6144;
    const float* g = (which == 0 ? p.norm1_g : p.norm2_g) + l * 1024;
    for (int r = gw; r < R; r += NGW) {
        const int b = r / RB, s = r - b * RB; const int mi = s < NCTX ? 2 : b;
        const float* src = first ? (s < NCTX ? p.ctx + ((size_t)b * NCTX + s) * 1024 : p.x + ((size_t)b * TL + (s - NCTX)) * 1024) : X + (size_t)r * 1024;
        const f32x4* xr = (const f32x4*)src + lane; f32x4 v[4]; float ss = 0.f;
#pragma unroll
        for (int j = 0; j < 4; ++j) { v[j] = xr[64 * j]; ss += (v[j].x * v[j].x + v[j].y * v[j].y) + (v[j].z * v[j].z + v[j].w * v[j].w); }
        if (pgate != nullptr && s < NCTX) { const float* PART = (const float*)(p.ws + OFF_PART) + (size_t)(b * NCTX + s) * 1024; ss = 0.f;
#pragma unroll
            for (int j = 0; j < 4; ++j) { const f32x4 gq = ((const f32x4*)pgate)[lane + 64 * j]; f32x4 a = ((const f32x4*)PART)[lane + 64 * j];
#pragma unroll
                for (int q = 1; q < 4; ++q) a = a + ((const f32x4*)(PART + (size_t)q * 524288))[lane + 64 * j];
                v[j] = v[j] + gq * a; ss += (v[j].x * v[j].x + v[j].y * v[j].y) + (v[j].z * v[j].z + v[j].w * v[j].w); } }
        if (first || (pgate != nullptr && s < NCTX)) { f32x4* xo = (f32x4*)(X + (size_t)r * 1024) + lane;
#pragma unroll
            for (int j = 0; j < 4; ++j) xo[64 * j] = v[j]; }
        const float rs = rsqrtf(wave_sum(ss) * (1.f / 1024.f) + EPS);
        const float* mv = modv + mi * 6144 + (which == 0 ? 0 : 3072);
        u32x2* o8 = (u32x2*)(HN + (size_t)r * 1024) + lane;
#pragma unroll
        for (int j = 0; j < 4; ++j) { const f32x4 gg = ((const f32x4*)g)[lane + 64 * j], sh = ((const f32x4*)mv)[lane + 64 * j], sc = ((const f32x4*)(mv + 1024))[lane + 64 * j];
            const f32x4 y = v[j] * rs * gg; const f32x4 h = y * (sc + 1.0f) + sh; u32x2 w; w.x = pk2(h.x, h.y); w.y = pk2(h.z, h.w); o8[64 * j] = w; }
    }
}
DEV void phase_final(const Params& p) {
    const int tid = otid(); const int lane = tid & 63, wid = tid >> 6; const int gw = blockIdx.x * 8 + wid, NGW = gridDim.x * 8;
    const float* X = (const float*)(p.ws + OFF_X);
    for (int q = gw; q < 2 * TL; q += NGW) { const int b = q / TL, t = q - b * TL; const int r = b * RB + NCTX + t;
        const f32x4* xr = (const f32x4*)(X + (size_t)r * 1024) + lane; f32x4 v[4]; float ss = 0.f;
#pragma unroll
        for (int j = 0; j < 4; ++j) { v[j] = xr[64 * j]; ss += (v[j].x * v[j].x + v[j].y * v[j].y) + (v[j].z * v[j].z + v[j].w * v[j].w); }
        const float rs = rsqrtf(wave_sum(ss) * (1.f / 1024.f) + EPS);
        f32x4* o = (f32x4*)(p.out + (size_t)q * 1024) + lane;
#pragma unroll
        for (int j = 0; j < 4; ++j) { const f32x4 gg = ((const f32x4*)p.final_norm_g)[lane + 64 * j]; o[64 * j] = v[j] * rs * gg; } }
}

DEV void phase_rowwise(const Params& p, int l) {
    const int tid = otid(); const int lane = tid & 63, wid = tid >> 6; const int gw = blockIdx.x * 8 + wid, NGW = gridDim.x * 8;
    bf16_t* P = (bf16_t*)p.out; const f32x2* rope = (const f32x2*)(p.ws + OFF_ROPE);
    const float* qg = p.mla_q_norm_g + l * 384; const float* kg = p.mla_kv_norm_g + l * 256;
    float qgv[6];
#pragma unroll
    for (int j = 0; j < 3; ++j) { qgv[2 * j] = qg[2 * (lane + 64 * j)]; qgv[2 * j + 1] = qg[2 * (lane + 64 * j) + 1]; }
    const f32x4 kgv = ((const f32x4*)kg)[lane];
    for (int r0 = gw; r0 < R; r0 += 2 * NGW) {
        unsigned wq[2][3]; u32x2 wk[2]; float x1[2], x2[2]; f32x2 cs[2]; bool val[2], lat[2];
#pragma unroll
        for (int i = 0; i < 2; ++i) { const int r = r0 + i * NGW; val[i] = r < R; const int rr = val[i] ? r : r0; bf16_t* pr = P + (size_t)rr * INW; const int s = rr % RB; lat[i] = s >= NCTX;
            const unsigned* q2 = (const unsigned*)(pr + 768) + lane;
#pragma unroll
            for (int j = 0; j < 3; ++j) wq[i][j] = q2[64 * j];
            wk[i] = *((const u32x2*)(pr + 1152) + lane);
            const int li = lane & 15; x1[i] = bf2f(pr[1408 + li]); x2[i] = bf2f(pr[1408 + 16 + li]); cs[i] = rope[(lat[i] ? s - NCTX : 0) * 16 + li]; }
#pragma unroll
        for (int i = 0; i < 2; ++i) { if (!val[i]) continue; const int r = r0 + i * NGW; bf16_t* pr = P + (size_t)r * INW;
            { float ss = 0.f;
#pragma unroll
              for (int j = 0; j < 3; ++j) { const float a = bf2f(wq[i][j] & 0xffff), c2 = bf2f(wq[i][j] >> 16); ss += a * a + c2 * c2; }
              const float rs = rsqrtf(wave_sum(ss) * (1.f / 384.f) + EPS); unsigned* q2 = (unsigned*)(pr + 768) + lane;
#pragma unroll
              for (int j = 0; j < 3; ++j) q2[64 * j] = pk2(bf2f(wq[i][j] & 0xffff) * rs * qgv[2 * j], bf2f(wq[i][j] >> 16) * rs * qgv[2 * j + 1]); }
            { const float a0 = bf2f(wk[i].x & 0xffff), a1 = bf2f(wk[i].x >> 16), a2 = bf2f(wk[i].y & 0xffff), a3 = bf2f(wk[i].y >> 16);
              const float rs = rsqrtf(wave_sum((a0 * a0 + a1 * a1) + (a2 * a2 + a3 * a3)) * (1.f / 256.f) + EPS);
              u32x2 o; o.x = pk2(a0 * rs * kgv.x, a1 * rs * kgv.y); o.y = pk2(a2 * rs * kgv.z, a3 * rs * kgv.w); *((u32x2*)(pr + 1152) + lane) = o; }
            if (lat[i] && lane < 16) { pr[1408 + lane] = (bf16_t)f2bf(x1[i] * cs[i].x - x2[i] * cs[i].y); pr[1408 + 16 + lane] = (bf16_t)f2bf(x2[i] * cs[i].x + x1[i] * cs[i].y); } }
    }
}

DEV void phase_pool(const Params& p) {
    const int tid = otid(); const bf16_t* P = (const bf16_t*)p.out; bf16_t* MIX = (bf16_t*)(p.ws + OFF_HN);
    for (int idx = blockIdx.x * NWG_T + tid; idx < R * 32; idx += gridDim.x * NWG_T) { const int r = idx >> 5, cg = idx & 31; const int half = 1 << (cg >> 3);
        const int b = r / RB, s = r - b * RB; const int seq0 = s < NCTX ? b * RB : b * RB + NCTX; const int T = s < NCTX ? NCTX : TL; const int t = r - seq0;
        const int lo = max(t - half, 0), hi = min(t + half, T); float sum[8];
#pragma unroll
        for (int j = 0; j < 8; ++j) sum[j] = 0.f;
        const bf16_t* base = P + (size_t)seq0 * INW + 1440 + cg * 8;
        { bf16x8 wv[16]; const bf16x8 zz = {0, 0, 0, 0, 0, 0, 0, 0};
#pragma unroll
          for (int k = 0; k < 16; ++k) { const int tt = t - 8 + k; wv[k] = (tt >= lo && tt < hi) ? *(const bf16x8*)(base + (size_t)tt * INW) : zz; }
#pragma unroll
          for (int k = 0; k < 16; ++k)
#pragma unroll
              for (int j = 0; j < 8; ++j) sum[j] += bf2f((unsigned short)wv[k][j]); }
        const bf16x8 me = *(const bf16x8*)(base + (size_t)t * INW); const float ic = 1.0f / (float)(hi - lo); float o[8];
#pragma unroll
        for (int j = 0; j < 8; ++j) o[j] = sum[j] * ic - bf2f((unsigned short)me[j]);
        *(bf16x8*)(MIX + (size_t)r * 1024 + 768 + cg * 8) = pack8(o[0], o[1], o[2], o[3], o[4], o[5], o[6], o[7]); }
}

DEV float log2_sigmoid(float d) { return -log1pf(__expf(-d)) * 1.4426950408889634f; }
constexpr int ST_P = 272;
DEV void states_item(const Params& p, int l, unsigned char* lds, int it) {
    const int tid = otid(), lane = tid & 63, wid = tid >> 6, l32 = lane & 31, hi = lane >> 5;
    const bf16_t* P = (const bf16_t*)p.out; const f32x2* rope = (const f32x2*)(p.ws + OFF_ROPE);
    float* SLOC = (float*)(p.ws + OFF_OV + OV_SLOC);
    const int gc = it >> 1, hp = it & 1;
    unsigned char* VTl = lds;
    unsigned char* KTl = lds + 2 * 64 * ST_P;
    const int cb = gc % 66; const bool lat = cb >= 2; const int t0 = (cb - 2) * 128; const int r0 = gc * 128;
    __syncthreads();
    { const int tok = tid >> 2, hh = (tid >> 1) & 1, c = tid & 1; const int h = 2 * hp + hh;
      const bf16_t* src = P + (size_t)(r0 + tok) * INW + 128 + h * 32 + 8 * c; const bf16x8 lo = *(const bf16x8*)src, hi8 = *(const bf16x8*)(src + 16);
      const float df = exp2f(log2_sigmoid(p.ret_decay_f[l * 4 + h]) * (float)(127 - tok)) * 0.17677669529663687f, db = exp2f(log2_sigmoid(p.ret_decay_b[l * 4 + h]) * (float)tok) * 0.17677669529663687f;
#pragma unroll
      for (int j = 0; j < 8; ++j) { float x1 = bf2f((unsigned short)lo[j]), x2 = bf2f((unsigned short)hi8[j]);
          if (lat) { const f32x2 cs = rope[(t0 + tok) * 16 + 8 * c + j]; const float y1 = x1 * cs.x - x2 * cs.y, y2 = x2 * cs.x + x1 * cs.y; x1 = y1; x2 = y2; }
          bf16_t* kf = (bf16_t*)(KTl + ((hh * 2 + 0) * 32 + 8 * c + j) * ST_P) + tok; bf16_t* kb = (bf16_t*)(KTl + ((hh * 2 + 1) * 32 + 8 * c + j) * ST_P) + tok;
          kf[0] = (bf16_t)f2bf(x1 * df); kb[0] = (bf16_t)f2bf(x1 * db);
          *(bf16_t*)((unsigned char*)kf + 16 * ST_P) = (bf16_t)f2bf(x2 * df); *(bf16_t*)((unsigned char*)kb + 16 * ST_P) = (bf16_t)f2bf(x2 * db); } }
    for (int task = tid; task < 2048; task += NWG_T) { const int hh = task >> 10, tok = (task >> 3) & 127, ch = task & 7;
        const bf16x8 v = *(const bf16x8*)(P + (size_t)(r0 + tok) * INW + 256 + (2 * hp + hh) * 64 + ch * 8);
#pragma unroll
        for (int j = 0; j < 8; ++j) *((bf16_t*)(VTl + (hh * 64 + ch * 8 + j) * ST_P) + tok) = (bf16_t)v[j]; }
    __syncthreads();
    { const int hh = wid >> 2, dir = (wid >> 1) & 1, dvb = wid & 1; const int h = 2 * hp + hh;
      const unsigned char* ap = VTl + (hh * 64 + 32 * dvb + l32) * ST_P + hi * 16; const unsigned char* bp = KTl + ((hh * 2 + dir) * 32 + l32) * ST_P + hi * 16;
      bf16x8 af[8], bfr[8];
#pragma unroll
      for (int ks = 0; ks < 8; ++ks) { af[ks] = *(const bf16x8*)(ap + ks * 32); bfr[ks] = *(const bf16x8*)(bp + ks * 32); }
      f32x16 acc;
#pragma unroll
      for (int r = 0; r < 16; ++r) acc[r] = 0.f;
#pragma unroll
      for (int ks = 0; ks < 8; ++ks) acc = __builtin_amdgcn_mfma_f32_32x32x16_bf16(af[ks], bfr[ks], acc, 0, 0, 0);
      float* o = SLOC + ((size_t)(gc * 4 + h) * 2 + dir) * 2048 + l32 * 64 + 32 * dvb + 4 * hi;
#pragma unroll
      for (int g4 = 0; g4 < 4; ++g4) *(f32x4*)(o + 8 * g4) = (f32x4){acc[4 * g4], acc[4 * g4 + 1], acc[4 * g4 + 2], acc[4 * g4 + 3]}; }
}
DEV void scan_threads(const Params& p, int l, int gid) {
    if (gid >= 32768) return;
    const int e = gid & 2047, dir = (gid >> 11) & 1, h = (gid >> 12) & 3, b = gid >> 14;
    const float* SLOC = (const float*)(p.ws + OFF_OV + OV_SLOC); float* SIN = (float*)(p.ws + OFF_OV + OV_SIN);
    const float gC = exp2f(log2_sigmoid((dir == 0 ? p.ret_decay_f : p.ret_decay_b)[l * 4 + h]) * 128.f);
    float S = 0.f;
#pragma unroll 11
    for (int st = 0; st < 66; ++st) { const int cb = dir == 0 ? st : (st < 2 ? 1 - st : 67 - st); const size_t idx = ((size_t)((b * 66 + cb) * 4 + h) * 2 + dir) * 2048 + e;
        const float v = SLOC[idx]; SIN[idx] = S; S = S * gC + v; }
}

constexpr int AT_KP = 208, AT_VP = 144, AT_KB = 64 * AT_KP, AT_VBS = 64 * AT_VP, AT_V0 = 4 * AT_KB;
DEV float at_max32(const f32x16& s0, const f32x16& s1) {
    float m0 = __builtin_fmaxf(__builtin_fmaxf(s0[0], s0[1]), s0[2]), m1 = __builtin_fmaxf(__builtin_fmaxf(s1[0], s1[1]), s1[2]);
    m0 = __builtin_fmaxf(__builtin_fmaxf(m0, s0[3]), s0[4]); m1 = __builtin_fmaxf(__builtin_fmaxf(m1, s1[3]), s1[4]);
    m0 = __builtin_fmaxf(__builtin_fmaxf(m0, s0[5]), s0[6]); m1 = __builtin_fmaxf(__builtin_fmaxf(m1, s1[5]), s1[6]);
    m0 = __builtin_fmaxf(__builtin_fmaxf(m0, s0[7]), s0[8]); m1 = __builtin_fmaxf(__builtin_fmaxf(m1, s1[7]), s1[8]);
    m0 = __builtin_fmaxf(__builtin_fmaxf(m0, s0[9]), s0[10]); m1 = __builtin_fmaxf(__builtin_fmaxf(m1, s1[9]), s1[10]);
    m0 = __builtin_fmaxf(__builtin_fmaxf(m0, s0[11]), s0[12]); m1 = __builtin_fmaxf(__builtin_fmaxf(m1, s1[11]), s1[12]);
    m0 = __builtin_fmaxf(__builtin_fmaxf(m0, s0[13]), s0[14]); m1 = __builtin_fmaxf(__builtin_fmaxf(m1, s1[13]), s1[14]);
    return __builtin_fmaxf(__builtin_fmaxf(m0, s0[15]), __builtin_fmaxf(m1, s1[15]));
}
DEV void attn_unit(const Params& p, unsigned char* lds, int u) {
    const int tid = otid(), lane = tid & 63, wid = tid >> 6, l32 = lane & 31, hi = lane >> 5;
    const bf16_t* Q = (const bf16_t*)(p.ws + OFF_OV + OV_Q); const bf16_t* KN = (const bf16_t*)(p.ws + OFF_OV + OV_KN); const bf16_t* VT = (const bf16_t*)(p.ws + OFF_OV + OV_VT);
    const bf16_t* P = (const bf16_t*)p.out; bf16_t* MIX = (bf16_t*)(p.ws + OFF_HN); const f32x2* rope = (const f32x2*)(p.ws + OFF_ROPE);
    const bool isctx = u >= 512; int b, h, qrow0, NT;
    if (!isctx) { b = u >> 8; h = (u >> 5) & 7; qrow0 = b * RB + NCTX + (u & 31) * 256; NT = 132; } else { const int v = u - 512; b = v >> 3; h = v & 7; qrow0 = b * RB; NT = 4; }
    const int krow0 = b * RB; const int qrow = qrow0 + wid * 32 + l32;
    bf16x8 qf[6];
    { const bf16_t* qp = Q + (size_t)qrow * 768 + h * 96 + hi * 8;
#pragma unroll
      for (int d0 = 0; d0 < 6; ++d0) qf[d0] = *(const bf16x8*)(qp + d0 * 16);
      if (!isctx) { const f32x2* rp = rope + (size_t)(qrow - (b * RB + NCTX)) * 16 + hi * 8;
#pragma unroll
          for (int j = 0; j < 8; ++j) { const f32x2 cs = rp[j]; const float x1 = bf2f((unsigned short)qf[4][j]), x2 = bf2f((unsigned short)qf[5][j]);
              qf[4][j] = (short)f2bf(x1 * cs.x - x2 * cs.y); qf[5][j] = (short)f2bf(x2 * cs.x + x1 * cs.y); } } }
    const bf16_t* sp[3]; int sstep[3], lo[3];
#pragma unroll
    for (int k = 0; k < 2; ++k) { const int c = tid + k * 512; const int key = c / 12, part = c - key * 12; lo[k] = key * AT_KP + part * 16;
        if (part < 8) { sp[k] = KN + (size_t)(krow0 + key) * 512 + h * 64 + part * 8; sstep[k] = 64 * 512; } else { sp[k] = P + (size_t)(krow0 + key) * INW + 1408 + (part - 8) * 8; sstep[k] = 64 * INW; } }
    { const int dv = tid >> 3, kc = tid & 7; lo[2] = dv * AT_VP + (kc >> 1) * 32 + (kc & 1) * 8;   sp[2] = VT + (size_t)(h * 64 + dv) * R + krow0 + kc * 8; sstep[2] = 64; }
    const bool hasK2 = tid < 256;
    u32x4 st[3];
#define AT_GLOADK() do { st[0] = *(const u32x4*)sp[0]; sp[0] += sstep[0]; if (hasK2) { st[1] = *(const u32x4*)sp[1]; sp[1] += sstep[1]; } } while (0)
#define AT_GLOADV() do { st[2] = *(const u32x4*)sp[2]; sp[2] += sstep[2]; } while (0)
#define AT_LSTOREK(buf) do { *(u32x4*)((buf) + lo[0]) = st[0]; if (hasK2) *(u32x4*)((buf) + lo[1]) = st[1]; } while (0)
#define AT_LSTOREV(buf) do { unsigned char* d_ = (buf) + lo[2]; *(u32x2*)d_ = (u32x2){st[2].x, st[2].y}; *(u32x2*)(d_ + 16) = (u32x2){st[2].z, st[2].w}; } while (0)
#define AT_SB() __builtin_amdgcn_sched_barrier(0)
    f32x16 o0, o1, sa0, sa1, sb0, sb1, negm;
#pragma unroll
    for (int r = 0; r < 16; ++r) { o0[r] = 0.f; o1[r] = 0.f; sa0[r] = 0.f; sa1[r] = 0.f; negm[r] = 0.f; }
    float mrun = 0.f, lsum = 0.f;
    __syncthreads();
    AT_GLOADK(); AT_GLOADV(); AT_LSTOREK(lds); AT_LSTOREV(lds + AT_V0);
    AT_GLOADK(); AT_GLOADV(); AT_LSTOREK(lds + AT_KB); AT_LSTOREV(lds + AT_V0 + AT_VBS);
    AT_GLOADK(); AT_LSTOREK(lds + 2 * AT_KB);
    __syncthreads();
    { const unsigned char* ka = lds + l32 * AT_KP + hi * 16;
#pragma unroll
      for (int d0 = 0; d0 < 6; ++d0) { const bf16x8 a0 = *(const bf16x8*)(ka + d0 * 32), a1 = *(const bf16x8*)(ka + 32 * AT_KP + d0 * 32);
          sa0 = __builtin_amdgcn_mfma_f32_32x32x16_bf16(a0, qf[d0], sa0, 0, 0, 0); sa1 = __builtin_amdgcn_mfma_f32_32x32x16_bf16(a1, qf[d0], sa1, 0, 0, 0); } }
#define AT_QKM(SB0, SB1, i) do { if ((i) == 0) SB0 = __builtin_amdgcn_mfma_f32_32x32x16_bf16(kfr[0], qf[0], negm, 0, 0, 0); else if ((i) == 1) SB1 = __builtin_amdgcn_mfma_f32_32x32x16_bf16(kfr[1], qf[0], negm, 0, 0, 0); \
        else if ((i) & 1) SB1 = __builtin_amdgcn_mfma_f32_32x32x16_bf16(kfr[(i)], qf[(i) >> 1], SB1, 0, 0, 0); else SB0 = __builtin_amdgcn_mfma_f32_32x32x16_bf16(kfr[(i)], qf[(i) >> 1], SB0, 0, 0, 0); } while (0)
#define AT_EXS(acc, SA0, SA1, e) do { if ((e) < 16) { SA0[(e) & 15] = __builtin_amdgcn_exp2f(SA0[(e) & 15]); acc += SA0[(e) & 15]; } else { SA1[(e) & 15] = __builtin_amdgcn_exp2f(SA1[(e) & 15]); acc += SA1[(e) & 15]; } } while (0)
#define AT_PACK(dst, S, r0) dst = pack8(S[(r0) + 0], S[(r0) + 1], S[(r0) + 2], S[(r0) + 3], S[(r0) + 4], S[(r0) + 5], S[(r0) + 6], S[(r0) + 7])
#define AT_MAX4(m0, m1, SB0, SB1, r0) do { m0 = __builtin_fmaxf(__builtin_fmaxf(m0, SB0[(r0) + 0]), SB0[(r0) + 1]); m1 = __builtin_fmaxf(__builtin_fmaxf(m1, SB1[(r0) + 0]), SB1[(r0) + 1]); \
        m0 = __builtin_fmaxf(__builtin_fmaxf(m0, SB0[(r0) + 2]), SB0[(r0) + 3]); m1 = __builtin_fmaxf(__builtin_fmaxf(m1, SB1[(r0) + 2]), SB1[(r0) + 3]); } while (0)
#define AT_STEP(SA0, SA1, SB0, SB1, tt) do { \
        const int t_ = (tt); const bool nxt_ = t_ + 1 < NT; \
        const unsigned char* kb_ = lds + ((t_ + 1) & 3) * AT_KB; const unsigned char* vb_ = lds + AT_V0 + (t_ & 3) * AT_VBS; \
        if (t_ + 3 < NT) AT_GLOADK(); \
        if (t_ + 2 < NT) AT_GLOADV(); \
        bf16x8 kfr[12]; bf16x8 vfr[8]; \
        { const unsigned char* ka = kb_ + l32 * AT_KP + hi * 16; \
          _Pragma("unroll") for (int d0 = 0; d0 < 6; ++d0) { kfr[2 * d0] = *(const bf16x8*)(ka + d0 * 32); kfr[2 * d0 + 1] = *(const bf16x8*)(ka + 32 * AT_KP + d0 * 32); } } \
        { const float mx = mxc; \
          if (t_ == 0 || __any(mx > 8.0f)) { \
              const float rm = fmaxf(mx, __shfl_xor(mx, 32)); const float delta = (t_ == 0) ? rm : fmaxf(rm, 0.f); const float alpha = (t_ == 0) ? 1.0f : __builtin_amdgcn_exp2f(-delta); \
              mrun += delta; \
              _Pragma("unroll") for (int r = 0; r < 16; ++r) { SA0[r] -= delta; SA1[r] -= delta; o0[r] *= alpha; o1[r] *= alpha; } \
              lsum *= alpha; { const float nm = -mrun; _Pragma("unroll") for (int r = 0; r < 16; ++r) negm[r] = nm; } } } \
        float ls0 = 0.f, ls1 = 0.f; \
        AT_SB(); __builtin_amdgcn_s_setprio(1); \
          \
        _Pragma("unroll") for (int i = 0; i < 8; ++i) { \
            AT_QKM(SB0, SB1, i); \
            _Pragma("unroll") for (int k_ = 0; k_ < 3; ++k_) { const int e_ = 3 * i + k_; if (e_ < 16) { SA0[e_ & 15] = __builtin_amdgcn_exp2f(SA0[e_ & 15]); asm volatile("" : "+v"(SA0[e_ & 15])); } else { SA1[e_ & 15] = __builtin_amdgcn_exp2f(SA1[e_ & 15]); asm volatile("" : "+v"(SA1[e_ & 15])); } } \
            AT_SB(); } \
        { const unsigned char* va = vb_ + l32 * AT_VP + hi * 16; \
          _Pragma("unroll") for (int kj = 0; kj < 4; ++kj) { vfr[2 * kj] = *(const bf16x8*)(va + kj * 32); vfr[2 * kj + 1] = *(const bf16x8*)(va + 32 * AT_VP + kj * 32); } } \
        bf16x8 pb[4]; \
        _Pragma("unroll") for (int i = 8; i < 12; ++i) { \
            AT_QKM(SB0, SB1, i); \
            _Pragma("unroll") for (int k_ = 0; k_ < 2; ++k_) { const int e_ = 24 + 2 * (i - 8) + k_; SA1[e_ & 15] = __builtin_amdgcn_exp2f(SA1[e_ & 15]); asm volatile("" : "+v"(SA1[e_ & 15])); } \
            if (i == 9) { AT_PACK(pb[0], SA0, 0); asm volatile("" : "+v"(pb[0])); } \
            if (i == 11) { AT_PACK(pb[1], SA0, 8); asm volatile("" : "+v"(pb[1])); } \
            AT_SB(); } \
        float mq0 = SB0[0], mq1 = SB1[0]; __builtin_amdgcn_s_setprio(2); \
        _Pragma("unroll") for (int kj = 0; kj < 4; ++kj) { \
            o0 = __builtin_amdgcn_mfma_f32_32x32x16_bf16(vfr[2 * kj], pb[kj], o0, 0, 0, 0); o1 = __builtin_amdgcn_mfma_f32_32x32x16_bf16(vfr[2 * kj + 1], pb[kj], o1, 0, 0, 0); \
            if (kj == 0) { AT_PACK(pb[2], SA1, 0); asm volatile("" : "+v"(pb[2])); } \
            if (kj == 1) { AT_PACK(pb[3], SA1, 8); asm volatile("" : "+v"(pb[3])); } \
            if (kj == 2) { if (t_ + 3 < NT) AT_LSTOREK(lds + ((t_ + 3) & 3) * AT_KB); if (t_ + 2 < NT) AT_LSTOREV(lds + AT_V0 + ((t_ + 2) & 3) * AT_VBS); }     \
            _Pragma("unroll") for (int r_ = 0; r_ < 4; ++r_) { ls0 += SA0[4 * kj + r_]; ls1 += SA1[4 * kj + r_]; } \
            mq0 = __builtin_fmaxf(__builtin_fmaxf(mq0, SB0[4 * kj]), SB0[4 * kj + 1]); mq1 = __builtin_fmaxf(__builtin_fmaxf(mq1, SB1[4 * kj]), SB1[4 * kj + 1]); \
            mq0 = __builtin_fmaxf(__builtin_fmaxf(mq0, SB0[4 * kj + 2]), SB0[4 * kj + 3]); mq1 = __builtin_fmaxf(__builtin_fmaxf(mq1, SB1[4 * kj + 2]), SB1[4 * kj + 3]); \
            asm volatile("" : "+v"(mq0), "+v"(mq1), "+v"(ls0), "+v"(ls1)); AT_SB(); } \
        lsum += ls0 + ls1; \
        __builtin_amdgcn_s_setprio(0); mxc = __builtin_fmaxf(mq0, mq1);            \
        if (t_ & 1) __syncthreads(); \
    } while (0)
    float mxc = at_max32(sa0, sa1);
    for (int t = 0; t < NT; t += 2) { AT_STEP(sa0, sa1, sb0, sb1, t); AT_STEP(sb0, sb1, sa0, sa1, t + 1); }
    lsum += __shfl_xor(lsum, 32);
    const float inv = 1.0f / lsum;
    bf16_t* op = MIX + (size_t)qrow * 1024 + 256 + h * 64 + 4 * hi;
#pragma unroll
    for (int g4 = 0; g4 < 4; ++g4) { u32x2 w0, w1; w0.x = pk2(o0[4 * g4] * inv, o0[4 * g4 + 1] * inv); w0.y = pk2(o0[4 * g4 + 2] * inv, o0[4 * g4 + 3] * inv);
        w1.x = pk2(o1[4 * g4] * inv, o1[4 * g4 + 1] * inv); w1.y = pk2(o1[4 * g4 + 2] * inv, o1[4 * g4 + 3] * inv);
        *(u32x2*)(op + 8 * g4) = w0; *(u32x2*)(op + 32 + 8 * g4) = w1; }
#undef AT_GLOADK
#undef AT_GLOADV
#undef AT_LSTOREK
#undef AT_LSTOREV
#undef AT_STEP
#undef AT_QKM
#undef AT_EXS
#undef AT_PACK
#undef AT_MAX4
#undef AT_SB
}

constexpr int RT_VP = 264, RT_SP = 144, RT_VB = 2 * 64 * RT_VP;
DEV void retout_unit(const Params& p, int l, unsigned char* lds, int u) {
    const int tid = otid(), lane = tid & 63, wid = tid >> 6, l32 = lane & 31, hi = lane >> 5;
    const int gc = u >> 1, hp = u & 1; const int cb = gc % 66; const bool lat = cb >= 2; const int t0 = (cb - 2) * 128; const int r0 = gc * 128;
    const bf16_t* P = (const bf16_t*)p.out; bf16_t* MIX = (bf16_t*)(p.ws + OFF_HN); const f32x2* rope = (const f32x2*)(p.ws + OFF_ROPE);
    const float* SIN = (const float*)(p.ws + OFF_OV + OV_SIN);
    bf16_t* VTl = (bf16_t*)lds; bf16_t* STl = (bf16_t*)(lds + RT_VB);
    __syncthreads();
    for (int task = tid; task < 2048; task += NWG_T) { const int hh = task >> 10, key = (task >> 3) & 127, ch = task & 7;
        const bf16x8 v = *(const bf16x8*)(P + (size_t)(r0 + key) * INW + 256 + (2 * hp + hh) * 64 + ch * 8);
#pragma unroll
        for (int j = 0; j < 8; ++j) VTl[(hh * 64 + ch * 8 + j) * (RT_VP / 2) + key] = (bf16_t)v[j]; }
    for (int task = tid; task < 8192; task += NWG_T) { const int dv = task & 63, k = (task >> 6) & 31, dir = (task >> 11) & 1, hh = task >> 12;
        STl[(hh * 64 + dv) * (RT_SP / 2) + dir * 32 + k] = (bf16_t)f2bf(SIN[((size_t)(gc * 4 + 2 * hp + hh) * 2 + dir) * 2048 + k * 64 + dv]); }
    __syncthreads();
    const int hh = wid >> 2, h = 2 * hp + hh, qblk = wid & 3; const int n = 32 * qblk + l32; const int rq = r0 + n;
    const float lf = log2_sigmoid(p.ret_decay_f[l * 4 + h]), lb = log2_sigmoid(p.ret_decay_b[l * 4 + h]);
    float qv0[8], qv1[8]; bf16x8 qf0, qf1;
    { const bf16_t* qp = P + (size_t)rq * INW + h * 32 + 8 * hi; const bf16x8 a = *(const bf16x8*)qp, c2 = *(const bf16x8*)(qp + 16);
#pragma unroll
      for (int j = 0; j < 8; ++j) { float x1 = bf2f((unsigned short)a[j]), x2 = bf2f((unsigned short)c2[j]);
          if (lat) { const f32x2 cs = rope[(size_t)(t0 + n) * 16 + 8 * hi + j]; const float y1 = x1 * cs.x - x2 * cs.y, y2 = x2 * cs.x + x1 * cs.y; x1 = y1; x2 = y2; }
          qv0[j] = x1; qv1[j] = x2; }
      qf0 = pack8(qv0[0], qv0[1], qv0[2], qv0[3], qv0[4], qv0[5], qv0[6], qv0[7]); qf1 = pack8(qv1[0], qv1[1], qv1[2], qv1[3], qv1[4], qv1[5], qv1[6], qv1[7]); }
    f32x16 o0, o1;
#pragma unroll
    for (int r = 0; r < 16; ++r) { o0[r] = 0.f; o1[r] = 0.f; }
    const unsigned char* vbase = (const unsigned char*)VTl + (size_t)(hh * 64 + l32) * RT_VP + hi * 8;
    bf16x8 kga[4], kgc[4];
#pragma unroll
    for (int kb = 0; kb < 4; ++kb) { const bf16_t* kp = P + (size_t)(r0 + 32 * kb + l32) * INW + 128 + h * 32 + 8 * hi; kga[kb] = *(const bf16x8*)kp; kgc[kb] = *(const bf16x8*)(kp + 16); }
    __builtin_amdgcn_sched_barrier(0);
#pragma unroll
    for (int kb = 0; kb < 4; ++kb) {
        bf16x8 kf0, kf1;
        { const int key = 32 * kb + l32; const bf16x8 a = kga[kb], c2 = kgc[kb];
          float y1[8], y2[8];
#pragma unroll
          for (int j = 0; j < 8; ++j) { float x1 = bf2f((unsigned short)a[j]), x2 = bf2f((unsigned short)c2[j]);
              if (lat) { const f32x2 cs = rope[(size_t)(t0 + key) * 16 + 8 * hi + j]; const float z1 = x1 * cs.x - x2 * cs.y, z2 = x2 * cs.x + x1 * cs.y; x1 = z1; x2 = z2; }
              y1[j] = x1 * 0.17677669529663687f; y2[j] = x2 * 0.17677669529663687f; }
          kf0 = pack8(y1[0], y1[1], y1[2], y1[3], y1[4], y1[5], y1[6], y1[7]); kf1 = pack8(y2[0], y2[1], y2[2], y2[3], y2[4], y2[5], y2[6], y2[7]); }
        f32x16 s;
#pragma unroll
        for (int r = 0; r < 16; ++r) s[r] = 0.f;
        s = __builtin_amdgcn_mfma_f32_32x32x16_bf16(kf0, qf0, s, 0, 0, 0); s = __builtin_amdgcn_mfma_f32_32x32x16_bf16(kf1, qf1, s, 0, 0, 0);
#pragma unroll
        for (int r = 0; r < 16; ++r) { const int m = 32 * kb + crow(r, hi); const int dl = n - m; const float e = dl >= 0 ? lf * (float)dl : lb * (float)(-dl); s[r] *= __builtin_amdgcn_exp2f(e); }
#pragma unroll
        for (int jp = 0; jp < 2; ++jp) { const bf16x8 pb = pack8(s[8 * jp + 0], s[8 * jp + 1], s[8 * jp + 2], s[8 * jp + 3], s[8 * jp + 4], s[8 * jp + 5], s[8 * jp + 6], s[8 * jp + 7]);
            const unsigned char* vp = vbase + (32 * kb + 16 * jp) * 2;
            const u32x2 a00 = *(const u32x2*)vp, a01 = *(const u32x2*)(vp + 16), a10 = *(const u32x2*)(vp + 32 * RT_VP), a11 = *(const u32x2*)(vp + 32 * RT_VP + 16);
            const bf16x8 A0 = __builtin_bit_cast(bf16x8, (u32x4){a00.x, a00.y, a01.x, a01.y}), A1 = __builtin_bit_cast(bf16x8, (u32x4){a10.x, a10.y, a11.x, a11.y});
            o0 = __builtin_amdgcn_mfma_f32_32x32x16_bf16(A0, pb, o0, 0, 0, 0); o1 = __builtin_amdgcn_mfma_f32_32x32x16_bf16(A1, pb, o1, 0, 0, 0); }
    }
    { const float df = __builtin_amdgcn_exp2f(lf * (float)(n + 1)), db = __builtin_amdgcn_exp2f(lb * (float)(128 - n));
      const unsigned char* sbase = (const unsigned char*)STl + (size_t)(hh * 64 + l32) * RT_SP + hi * 16;
#pragma unroll
      for (int ks = 0; ks < 4; ++ks) { const float dd = ks < 2 ? df : db;
          const bf16x8 qb = (ks & 1) ? pack8(qv1[0] * dd, qv1[1] * dd, qv1[2] * dd, qv1[3] * dd, qv1[4] * dd, qv1[5] * dd, qv1[6] * dd, qv1[7] * dd)
                                     : pack8(qv0[0] * dd, qv0[1] * dd, qv0[2] * dd, qv0[3] * dd, qv0[4] * dd, qv0[5] * dd, qv0[6] * dd, qv0[7] * dd);
          const bf16x8 A0 = *(const bf16x8*)(sbase + ks * 32), A1 = *(const bf16x8*)(sbase + 32 * RT_SP + ks * 32);
          o0 = __builtin_amdgcn_mfma_f32_32x32x16_bf16(A0, qb, o0, 0, 0, 0); o1 = __builtin_amdgcn_mfma_f32_32x32x16_bf16(A1, qb, o1, 0, 0, 0); } }
    float ssq = 0.f;
#pragma unroll
    for (int r = 0; r < 16; ++r) ssq += o0[r] * o0[r] + o1[r] * o1[r];
    ssq += __shfl_xor(ssq, 32);
    const float rstd = rsqrtf(ssq * (1.f / 64.f) + EPS);
    const bf16_t* gp = P + (size_t)rq * INW + 512 + h * 64 + 4 * hi; bf16_t* op = MIX + (size_t)rq * 1024 + h * 64 + 4 * hi;
#pragma unroll
    for (int g4 = 0; g4 < 4; ++g4) { const u32x2 ga = *(const u32x2*)(gp + 8 * g4), gb = *(const u32x2*)(gp + 32 + 8 * g4);
        u32x2 w0, w1;
        w0.x = pk2(o0[4 * g4] * rstd * siluf(bf2f(ga.x & 0xffff)), o0[4 * g4 + 1] * rstd * siluf(bf2f(ga.x >> 16))); w0.y = pk2(o0[4 * g4 + 2] * rstd * siluf(bf2f(ga.y & 0xffff)), o0[4 * g4 + 3] * rstd * siluf(bf2f(ga.y >> 16)));
        w1.x = pk2(o1[4 * g4] * rstd * siluf(bf2f(gb.x & 0xffff)), o1[4 * g4 + 1] * rstd * siluf(bf2f(gb.x >> 16))); w1.y = pk2(o1[4 * g4 + 2] * rstd * siluf(bf2f(gb.y & 0xffff)), o1[4 * g4 + 3] * rstd * siluf(bf2f(gb.y >> 16)));
        *(u32x2*)(op + 8 * g4) = w0; *(u32x2*)(op + 32 + 8 * g4) = w1; }
}

DEV void phase_ffn_fixup(const Params& p, int l) {
    const float* EDGE = (const float*)(p.ws + OFF_EDGE); bf16_t* ACT = (bf16_t*)(p.ws + OFF_OV);
    const float* cw = p.conv_w + (size_t)l * 3 * 5632; const float* cbv = p.conv_b + (size_t)l * 5632;
    for (int idx = blockIdx.x * NWG_T + otid(); idx < 66 * 2 * 704; idx += gridDim.x * NWG_T) {
        const int ch4 = idx % 704, rest = idx / 704; const int which = rest & 1, pm = rest >> 1; const int jj = pm % 33;
        if (l == 1 && jj == 0) continue;
        const int ch = 4 * ch4, pn = ch >> 7, c = ch & 127;
        const bool sstart = jj <= 1, send = (jj == 0) || (jj == 32);
        const f32x4 zz = {0.f, 0.f, 0.f, 0.f};
#define EDG(tile, k, half) (*(const f32x4*)(EDGE + ((size_t)((tile) * 4 + (k)) * 22 + pn) * 256 + (half) * 128 + c))
        f32x4 ua, ub, ca, cb2, da, db;
        if (which == 0) { ua = sstart ? zz : EDG(pm - 1, 3, 0); ub = sstart ? zz : EDG(pm - 1, 3, 1); ca = EDG(pm, 0, 0); cb2 = EDG(pm, 0, 1); da = EDG(pm, 1, 0); db = EDG(pm, 1, 1); }
        else { ua = EDG(pm, 2, 0); ub = EDG(pm, 2, 1); ca = EDG(pm, 3, 0); cb2 = EDG(pm, 3, 1); da = send ? zz : EDG(pm + 1, 0, 0); db = send ? zz : EDG(pm + 1, 0, 1); }
#undef EDG
        const f32x4 wa0 = *(const f32x4*)(cw + ch), wa1 = *(const f32x4*)(cw + 5632 + ch), wa2 = *(const f32x4*)(cw + 2 * 5632 + ch), ba = *(const f32x4*)(cbv + ch);
        const f32x4 wb0 = *(const f32x4*)(cw + DFF + ch), wb1 = *(const f32x4*)(cw + 5632 + DFF + ch), wb2 = *(const f32x4*)(cw + 2 * 5632 + DFF + ch), bb = *(const f32x4*)(cbv + DFF + ch);
        const f32x4 xa = wa0 * ua + wa1 * ca + wa2 * da + ba, xb = wb0 * ub + wb1 * cb2 + wb2 * db + bb;
        u32x2 w; w.x = pk2(siluf(xa.x) * xb.x, siluf(xa.y) * xb.y); w.y = pk2(siluf(xa.z) * xb.z, siluf(xa.w) * xb.w);
        *(u32x2*)(ACT + (size_t)(pm * 256 + (which ? 255 : 0)) * DFF + ch) = w;
    }
}

#define RLX_AGENT __ATOMIC_RELAXED, __HIP_MEMORY_SCOPE_AGENT
#define XB_TMO      128
#define XB_XCNT(j)  (256  + 64 * (j))
#define XB_XSUB(j)  (1280 + 64 * (j))
#define XB_XGEN(j)  (2304 + 64 * (j))
#define XB_TOP      3328
#define XB_TOPGEN   3392
#define XCD_BAR_WORDS 3456
#define XB_SPIN_CAP (1u << 18)

__device__ __forceinline__ unsigned xb_ld(unsigned* p)              { return __hip_atomic_load(p, __ATOMIC_RELAXED, __HIP_MEMORY_SCOPE_AGENT); }
__device__ __forceinline__ unsigned xb_add(unsigned* p, unsigned v) { return __hip_atomic_fetch_add(p, v, __ATOMIC_RELAXED, __HIP_MEMORY_SCOPE_AGENT); }
__device__ __forceinline__ unsigned xb_xcc_id() { return (unsigned)__builtin_amdgcn_s_getreg((3 << 11) | 20) & 0xFu; }
#define XB_SPIN(cond, bar) do { unsigned _sp = 0; while (cond) { __builtin_amdgcn_s_sleep(1); \
    if ((++_sp & 255u) == 0u) { if (xb_ld(&(bar)[XB_TMO])) break; if (_sp > XB_SPIN_CAP) { atomicAdd(&(bar)[XB_TMO], 1u); break; } } } } while (0)

struct XcdBarrier {
    unsigned* bar; unsigned x;
    volatile LAS unsigned* st;
};

__device__ __forceinline__ XcdBarrier xcd_barrier_post(unsigned* bar, volatile LAS unsigned* st) {
    XcdBarrier b; b.bar = bar; b.x = xb_xcc_id(); b.st = st;
    if (threadIdx.x == 0) (void)xb_add(&bar[XB_XCNT(b.x)], 1u);
    return b;
}
__device__ __forceinline__ void xcd_barrier_complete(unsigned* bar, unsigned x, unsigned& nloc, unsigned& nx) {
    const unsigned G = gridDim.x * gridDim.y * gridDim.z;
    unsigned sum, cnt, mine, sp = 0u;
    for (;;) {
        sum = 0u; cnt = 0u; mine = 0u;
#pragma unroll
        for (unsigned j = 0; j < 16; ++j) { const unsigned c = xb_ld(&bar[XB_XCNT(j)]); sum += c; cnt += (c > 0u) ? 1u : 0u; mine = (j == x) ? c : mine; }
        if (sum == G) break;
        __builtin_amdgcn_s_sleep(1);
        if ((++sp & 255u) == 0u) { if (xb_ld(&bar[XB_TMO])) break; if (sp > XB_SPIN_CAP) { atomicAdd(&bar[XB_TMO], 1u); break; } }
    }
    nloc = mine > 0u ? mine : 1u; nx = cnt > 0u ? cnt : 1u;
}

__device__ __forceinline__ void xcd_barrier(const XcdBarrier& b) {
    asm volatile("s_waitcnt vmcnt(0)" ::: "memory");
    __syncthreads();
    if (threadIdx.x == 0) {
        unsigned* bar = b.bar;
        __builtin_amdgcn_s_waitcnt(0);
        unsigned nloc = b.st[0], nx = b.st[1];
        if (nloc == 0u) { xcd_barrier_complete(bar, b.x, nloc, nx); b.st[0] = nloc; b.st[1] = nx; }
        const unsigned old = xb_add(&bar[XB_XSUB(b.x)], 1u);
        const unsigned gen = old / nloc;
        if (old + 1u == (gen + 1u) * nloc) {
            __builtin_amdgcn_fence(__ATOMIC_RELEASE, "agent");
            asm volatile("s_waitcnt vmcnt(0)" ::: "memory");
            const unsigned og = xb_add(&bar[XB_TOP], 1u);
            const unsigned tg = og / nx;
            if (og + 1u == (tg + 1u) * nx) xb_add(&bar[XB_TOPGEN], 1u);
            else XB_SPIN(xb_ld(&bar[XB_TOPGEN]) == tg, bar);
            __builtin_amdgcn_fence(__ATOMIC_ACQUIRE, "agent");
            xb_add(&bar[XB_XGEN(b.x)], 1u);
            asm volatile("s_waitcnt vmcnt(0)" ::: "memory");
        } else {
            XB_SPIN(xb_ld(&bar[XB_XGEN(b.x)]) == gen, bar);
            __builtin_amdgcn_fence(__ATOMIC_ACQUIRE, "agent");
            asm volatile("s_waitcnt vmcnt(0)" ::: "memory");
        }
    }
    __syncthreads();
}


constexpr size_t OFF_CTL = 250000128; constexpr int CTL_BYTES = 16384;
#if defined(__HIP_DEVICE_COMPILE__)
#define KP() const __attribute__((address_space(4))) Params* kp_ = (const __attribute__((address_space(4))) Params*)__builtin_amdgcn_kernarg_segment_ptr(); asm volatile("" : "+s"(kp_)); const Params p = *kp_; \
    bf16_t* HN = (bf16_t*)(p.ws + OFF_HN); bf16_t* P = (bf16_t*)p.out; float* X = (float*)(p.ws + OFF_X); (void)HN; (void)P; (void)X
#else
#define KP() const Params p = p_arg; bf16_t* HN = (bf16_t*)(p.ws + OFF_HN); bf16_t* P = (bf16_t*)p.out; float* X = (float*)(p.ws + OFF_X); (void)HN; (void)P; (void)X
#endif
#define WL() const bf16_t* wl = (const bf16_t*)(p.ws + OFF_W) + (size_t)l * W_LAYER; const float* modv = (const float*)(p.ws + OFF_MOD) + (size_t)l * 3 * 6144; (void)wl; (void)modv
#ifndef DUPM
#define DUPM 0
#endif
#define REP(bit) for (int rep_ = 0; rep_ < (((DUPM) >> (bit)) & 1) + 1; ++rep_)
constexpr int PH_PER_LAYER = 10, N_PHASES = 2 + 2 * PH_PER_LAYER;
__global__ void __launch_bounds__(512, 2) mk_fwd(Params p_arg) {
    extern __shared__ __attribute__((aligned(16))) unsigned char lds[];
    cg::grid_group grid = cg::this_grid();
    const int G = gridDim.x, bx = blockIdx.x; const int vcu = (G % 8 == 0) ? (bx % 8) * (G / 8) + bx / 8 : bx;
    LAS unsigned char* ldsl = (LAS unsigned char*)lds;
    const int ph_lo = p_arg.ph_lo, ph_hi = p_arg.ph_hi;
    volatile LAS unsigned* misc = (volatile LAS unsigned*)(ldsl + (LDS_BYTES - 64));
    { const int t0_ = otid(); if (t0_ < 16) misc[t0_] = 0u; }
    __syncthreads();
    if (ph_hi - ph_lo > 1) (void)xcd_barrier_post((unsigned*)(p_arg.ws + OFF_CTL), misc);
    for (int ph = ph_lo; ph < ph_hi; ++ph) {
        if (ph == 0) { KP(); phase_prep(p, lds); __syncthreads(); }
        else if (ph == N_PHASES - 1) { KP(); phase_final(p);
#if (DUPM >> 10) & 1
            for (int i = 0; i < 20; ++i) grid.sync();
#endif
        }
        else {
            const int l = (ph - 1) / PH_PER_LAYER, sp = (ph - 1) % PH_PER_LAYER;
            if (sp == 0) { KP(); if (l == 0) REP(9) { phase_prep_weights(p, lds); __syncthreads(); }
                phase_norm(p, l, 0, l == 0, l == 1 ? (const float*)(p.ws + OFF_MOD) + 2 * 6144 + 5120 : nullptr); }
            else if (sp == 1) { KP(); WL(); REP(1) { __syncthreads();
                pg8::Gemm g{HN, wl + W_IN, R, 1792, 1024, 1024, 1024}; pg8::StaticOrder S; S.init(R, 1792, G, bx);
                pg8::EpiStore E{P, INW, INW, 1.0f};
                pg8::gemm_phase<pg8::EpiStore, pg8::StaticOrder, true, true>(ldsl, g, S, E); } }
            else if (sp == 2) { KP(); phase_rowwise(p, l); __syncthreads();
                REP(2) phase_pool(p);
                REP(3) for (int it = G - 1 - bx; it < 264; it += G) states_item(p, l, lds, it); __syncthreads(); }
            else if (sp == 3) { KP(); WL(); REP(4) { __syncthreads();
                { pg8::Gemm g{P + 768, wl + W_UQ, R, 768, 384, INW, 384}; pg8::StaticOrder S; S.init(R, 768, G, bx);
                  pg8::EpiStore E{(bf16_t*)(p.ws + OFF_OV + OV_Q), 768, 768, 0.14724444f};
                  pg8::gemm_phase<pg8::EpiStore, pg8::StaticOrder, true, true>(ldsl, g, S, E); }
                __syncthreads();
                { pg8::Gemm g{P + 1152, wl + W_KN, R, 512, 256, INW, 256}; pg8::StaticOrder S; S.init(R, 512, G, (bx + 58) % G);
                  pg8::EpiStore E{(bf16_t*)(p.ws + OFF_OV + OV_KN), 512, 512, 1.0f};
                  pg8::gemm_phase<pg8::EpiStore, pg8::StaticOrder, true, true>(ldsl, g, S, E); }
                __syncthreads();
                { pg8::Gemm g{wl + W_V, P + 1152, 512, R, 256, 256, INW}; pg8::StaticOrder S; S.init(512, R, G, (bx + 182) % G);
                  pg8::EpiStore E{(bf16_t*)(p.ws + OFF_OV + OV_VT), R, R, 1.0f};
                  pg8::gemm_phase<pg8::EpiStore, pg8::StaticOrder, true, true>(ldsl, g, S, E); }
                if (bx >= G - 64) scan_threads(p, l, (bx - (G - 64)) * NWG_T + otid()); } }
            else if (sp == 4) { KP();
                REP(5) for (int u = vcu; u < (l == 0 ? 528 : 512); u += G) attn_unit(p, lds, u);
                REP(6) for (int u = G - 1 - bx; u < (l == 0 ? 264 : 256); u += G) retout_unit(p, l, lds, l == 0 ? u : u + 4 * (u >> 7) + 4); }
            else if (sp == 5) { KP(); WL(); __syncthreads();
                { pg8::Gemm g{HN, wl + W_OUT, R, 1024, 1024, 1024, 1024}; pg8::StaticOrder S; S.init(16384, 1024, G, bx, 1);
                  pg8::EpiResid E{X, modv + 2048, 0};
                  pg8::gemm_phase<pg8::EpiResid, pg8::StaticOrder, true, true>(ldsl, g, S, E); }
                if (l == 0 && bx < 32) { __syncthreads(); const int q = bx >> 3;
                  pg8::Gemm g{HN + q * 256, wl + W_OUT + q * 256, 512, 1024, 256, 1024, 1024}; pg8::StaticOrder S; S.init(512, 1024, G, bx & 7, 2);
                  pg8::EpiPart E{(float*)(p.ws + OFF_PART) + (size_t)q * 524288, 0};
                  pg8::gemm_phase<pg8::EpiPart, pg8::StaticOrder, true, true>(ldsl, g, S, E); } }
            else if (sp == 6) { KP(); WL(); phase_norm(p, l, 1, false, l == 0 ? modv + 2 * 6144 + 2048 : nullptr); }
            else if (sp == 7) { KP(); WL(); REP(7) { __syncthreads();
                pg8::Gemm g{HN, wl + W_UP, R, 2 * DFF, 1024, 1024, 1024}; pg8::StaticOrder S; S.init(l == 1 ? 16384 : R, 2 * DFF, G, bx, l == 1 ? 1 : 0);
                pg8::EpiFfn E{(bf16_t*)(p.ws + OFF_OV), (float*)(p.ws + OFF_EDGE), p.conv_w + (size_t)l * 3 * 5632, p.conv_b + (size_t)l * 5632, (LAS float*)(ldsl + 131072)};
                pg8::gemm_phase<pg8::EpiFfn, pg8::StaticOrder, true, true>(ldsl, g, S, E); } }
            else if (sp == 8) { KP(); REP(8) phase_ffn_fixup(p, l); }
            else if (sp == 9) { KP(); WL(); __syncthreads();
                { pg8::Gemm g{(const bf16_t*)(p.ws + OFF_OV), wl + W_DN, R, 1024, DFF, DFF, DFF}; pg8::StaticOrder S; S.init(16384, 1024, G, bx, 1);
                  pg8::EpiResid E{X, modv + 5120, 0};
                  pg8::gemm_phase<pg8::EpiResid, pg8::StaticOrder, true, true>(ldsl, g, S, E); }
                if (l == 0 && bx < 32) { __syncthreads(); const int q = bx >> 3; const int koff = q < 2 ? q * 768 : 1536 + (q - 2) * 640, klen = q < 2 ? 768 : 640;
                  pg8::Gemm g{(const bf16_t*)(p.ws + OFF_OV) + koff, wl + W_DN + koff, 512, 1024, klen, DFF, DFF}; pg8::StaticOrder S; S.init(512, 1024, G, bx & 7, 2);
                  pg8::EpiPart E{(float*)(p.ws + OFF_PART) + (size_t)q * 524288, 0};
                  pg8::gemm_phase<pg8::EpiPart, pg8::StaticOrder, true, true>(ldsl, g, S, E); } }
        }
        if (ph + 1 < ph_hi) {
            if (ph_lo < 0) grid.sync();
            { KP(); XcdBarrier b; b.bar = (unsigned*)(p.ws + OFF_CTL); b.x = xb_xcc_id(); b.st = misc; xcd_barrier(b); }
        }
    }
}

extern "C" void kernel_launch(void* const* d_in, const int* in_sizes, int n_in, void* d_out, int out_size, void* d_ws, size_t ws_size, hipStream_t stream) {
    static int grid = 0;
    if (grid == 0) {
        if (n_in != 23 || ws_size < WS_NEED) { fprintf(stderr, "kernel_launch: unexpected problem (n_in %d, ws %zu, need %zu)\n", n_in, ws_size, (size_t)WS_NEED); grid = -1; return; }
        int dev = 0, cus = 0, per_cu = 0;
        hipGetDevice(&dev); hipDeviceGetAttribute(&cus, hipDeviceAttributeMultiprocessorCount, dev);
        if (hipFuncSetAttribute((const void*)mk_fwd, hipFuncAttributeMaxDynamicSharedMemorySize, LDS_BYTES) != hipSuccess) { fprintf(stderr, "kernel_launch: hipFuncSetAttribute failed\n"); grid = -1; return; }
        if (hipOccupancyMaxActiveBlocksPerMultiprocessor(&per_cu, (const void*)mk_fwd, 512, LDS_BYTES) != hipSuccess || per_cu < 1) { fprintf(stderr, "kernel_launch: occupancy query says %d\n", per_cu); per_cu = 1; }
        (void)hipGetLastError();
        grid = cus * per_cu; if (grid > 256) grid = 256;
        fprintf(stderr, "kernel_launch: grid %d (cus %d, per_cu %d)\n", grid, cus, per_cu);
    }
    if (grid < 0) return;
    Params p{};
    const float** pp = (const float**)&p;
    for (int i = 0; i < 23; ++i) pp[i] = (const float*)d_in[i];
    p.out = (float*)d_out; p.ws = (unsigned char*)d_ws;
#if MK_MULTI
    for (int ph = 0; ph < N_PHASES; ++ph) { p.ph_lo = ph; p.ph_hi = ph + 1; void* args[] = {&p};
        hipError_t e = hipLaunchCooperativeKernel((void*)mk_fwd, dim3(grid), dim3(512), args, LDS_BYTES, stream);
        if (e != hipSuccess) { fprintf(stderr, "launch %d failed: %s\n", ph, hipGetErrorString(e)); break; } }
#else
    if (hipMemsetAsync((char*)d_ws + OFF_CTL, 0, CTL_BYTES, stream) != hipSuccess) { fprintf(stderr, "kernel_launch: memset of the barrier words failed\n"); return; }
    p.ph_lo = 0; p.ph_hi = N_PHASES; void* args[] = {&p};
    hipError_t e = hipLaunchCooperativeKernel((void*)mk_fwd, dim3(grid), dim3(512), args, LDS_BYTES, stream);
    if (e != hipSuccess) fprintf(stderr, "cooperative launch failed: %s (grid %d)\n", hipGetErrorString(e), grid);
#endif
}
```

```cpp
#include <hip/hip_runtime.h>
#include <hip/hip_cooperative_groups.h>
#include <cstdio>
#include <cstdint>
namespace cg = cooperative_groups;

#ifndef MK_MULTI
#define MK_MULTI 0
#endif

namespace pg8 {
#define PG8_LAS __attribute__((address_space(3)))
typedef unsigned short bf16_t;
typedef short bf16x8 __attribute__((ext_vector_type(8)));
typedef float f32x4 __attribute__((ext_vector_type(4)));
typedef unsigned u32x4 __attribute__((ext_vector_type(4)));
constexpr int BM = 256, BK = 64, HALF = 128, HTB = HALF * BK * 2  , STAGE_BYTES = 8 * HTB, NXCD = 8, WGM = 8;

__host__ __device__ __forceinline__ int lds_byte(int r, int c) { const int st = (r >> 4) * 2 + (c >> 5), rr = r & 15, cc = c & 31, ob = rr * 64 + cc * 2; return st * 1024 + (ob ^ (((ob >> 9) & 1) << 5)); }
__host__ __device__ __forceinline__ void stage_rc(int b, int& R, int& C) { const int st = b / 1024, sb = b % 1024, swz = sb ^ (((sb >> 9) & 1) << 5); R = (st >> 1) * 16 + swz / 64; C = (st & 1) * 32 + (swz % 64) / 2; }
__host__ __device__ __forceinline__ int perm32(int rho) { const int n = rho >> 4, i = rho & 15; return 8 * (i >> 2) + 4 * n + (i & 3); }

struct Unit { int pm, pn; };
struct Gemm { const bf16_t* A; const bf16_t* Bt; int M, N, K, lda, ldb; };

struct StaticOrder {
    int nM, nN, nwg, G, c, skip;
    __host__ __device__ void init(int M, int N, int G_, int c_, int skip_ = 0) { nM = M / BM; nN = N / BM; nwg = nM * nN; G = G_; c = c_; skip = skip_; }
    __host__ __device__ bool next(int i, Unit& u) const {
        const long L = (long)i * G + c; if (L >= nwg) return false;
        int wgid = (int)L; { const int q = nwg / NXCD, r = nwg % NXCD, xcd = wgid % NXCD, off = wgid / NXCD; wgid = (xcd < r ? xcd * (q + 1) : r * (q + 1) + (xcd - r) * q) + off; }
        const int nig = WGM * nN, gid = wgid / nig, fm = gid * WGM, gsz = (nM - fm) < WGM ? (nM - fm) : WGM;
        u.pm = fm + ((wgid % nig) % gsz); u.pn = (wgid % nig) / gsz; if (skip == 1) u.pm += 1 + (u.pm >= 32 ? 1 : 0); else if (skip == 2) u.pm *= 33; return true;
    }
    __device__ __forceinline__ void a_ready(const Unit&) const {}
    __device__ __forceinline__ void done(const Unit&) const {}
};

__device__ __forceinline__ unsigned cvt_pk_bf16(float lo, float hi) { unsigned r; asm volatile("v_cvt_pk_bf16_f32 %0, %1, %2" : "=v"(r) : "v"(lo), "v"(hi)); return r; }

struct EpiStore {
    static constexpr bool PERM = true, AFTER_DRAIN = false, APERM = false;
    bf16_t* O; int ldc; int ncols; float scale;
    __device__ __forceinline__ void operator()(const f32x4 (&acc)[2][2][4][2], const Unit& u, int wr, int wc, int fr, int fq) const {
        const int row0 = u.pm * BM + wr * 64 + fr; const int col0 = u.pn * BM + wc * 32 + 8 * fq;
#pragma unroll
        for (int ai = 0; ai < 2; ++ai)
#pragma unroll
            for (int m = 0; m < 4; ++m) { bf16_t* rowp = O + (size_t)(row0 + ai * HALF + m * 16) * ldc + col0;
#pragma unroll
                for (int bj = 0; bj < 2; ++bj) { if (col0 + bj * HALF < ncols) {
                    f32x4 v0 = acc[ai][bj][m][0] * scale, v1 = acc[ai][bj][m][1] * scale;
                    u32x4 w; w.x = cvt_pk_bf16(v0[0], v0[1]); w.y = cvt_pk_bf16(v0[2], v0[3]); w.z = cvt_pk_bf16(v1[0], v1[1]); w.w = cvt_pk_bf16(v1[2], v1[3]);
                    *(u32x4*)(rowp + bj * HALF) = w; } } }
    }
};
struct EpiResid {
    static constexpr bool PERM = false, AFTER_DRAIN = false, APERM = false;
    float* X; const float* gate; int row_tile0;
    __device__ __forceinline__ void operator()(const f32x4 (&acc)[2][2][4][2], const Unit& u, int wr, int wc, int fr, int fq) const {
        const int tpm = u.pm + row_tile0; const int bb = tpm / 33, jj = tpm - bb * 33; const float* gv = gate + (jj == 0 ? 2 : bb) * 6144;
        const int col0 = u.pn * BM + wc * 32 + 4 * fq;
#pragma unroll
        for (int ai = 0; ai < 2; ++ai)
#pragma unroll
            for (int m = 0; m < 4; ++m) { float* rowp = X + (size_t)(tpm * BM + ai * HALF + wr * 64 + m * 16 + fr) * 1024 + col0;
#pragma unroll
                for (int bj = 0; bj < 2; ++bj) {
#pragma unroll
                    for (int n = 0; n < 2; ++n) { f32x4* q = (f32x4*)(rowp + bj * HALF + n * 16); const f32x4 gq = *(const f32x4*)(gv + col0 + bj * HALF + n * 16); f32x4 xv = *q; xv = xv + gq * acc[ai][bj][m][n]; *q = xv; }
                    asm volatile("" ::: "memory"); } }
    }
};
struct EpiPart {
    static constexpr bool PERM = false, AFTER_DRAIN = false, APERM = false;
    float* out; int accum;
    __device__ __forceinline__ void operator()(const f32x4 (&acc)[2][2][4][2], const Unit& u, int wr, int wc, int fr, int fq) const {
        const int t = u.pm / 33; const int col0 = u.pn * BM + wc * 32 + 4 * fq;
#pragma unroll
        for (int ai = 0; ai < 2; ++ai)
#pragma unroll
            for (int m = 0; m < 4; ++m) { float* rowp = out + (size_t)(t * BM + ai * HALF + wr * 64 + m * 16 + fr) * 1024 + col0;
#pragma unroll
                for (int bj = 0; bj < 2; ++bj) {
#pragma unroll
                    for (int n = 0; n < 2; ++n) { f32x4* q = (f32x4*)(rowp + bj * HALF + n * 16); f32x4 v = acc[ai][bj][m][n]; if (accum) v = v + *q; *q = v; }
                    asm volatile("" ::: "memory"); } }
    }
};
template <int CTRL> __device__ __forceinline__ float dpp0(float x) { return __builtin_bit_cast(float, __builtin_amdgcn_update_dpp(0, __builtin_bit_cast(int, x), CTRL, 0xf, 0xf, true)); }
struct EpiFfn {
    static constexpr bool PERM = false, AFTER_DRAIN = false, APERM = true;
    bf16_t* ACT; float* EDGE; const float* cw; const float* cb; PG8_LAS float* xl;
    __device__ __forceinline__ void operator()(const f32x4 (&acc)[2][2][4][2], const Unit& u, int wr, int wc, int fr, int fq) const {
        PG8_LAS float* FIRST = xl; PG8_LAS float* LAST = xl + 1024;
        const int cb0 = wc * 32 + 4 * fq;
#pragma unroll
        for (int ai = 0; ai < 2; ++ai)
#pragma unroll
            for (int bj = 0; bj < 2; ++bj)
#pragma unroll
                for (int n = 0; n < 2; ++n) { const int col = bj * HALF + cb0 + n * 16;
                    if (fr == 0) *(PG8_LAS f32x4*)(FIRST + (2 * ai + wr) * 256 + col) = acc[ai][bj][0][n];
                    if (fr == 15) *(PG8_LAS f32x4*)(LAST + (2 * ai + wr) * 256 + col) = acc[ai][bj][3][n]; }
        if (wr == 0 && fr == 0) {
#pragma unroll
            for (int bj = 0; bj < 2; ++bj)
#pragma unroll
                for (int n = 0; n < 2; ++n) { float* ep = EDGE + ((size_t)(u.pm * 4) * 22 + u.pn) * 256 + bj * HALF + cb0 + n * 16; *(f32x4*)ep = acc[0][bj][0][n]; *(f32x4*)(ep + 22 * 256) = acc[0][bj][1][n]; } }
        if (wr == 1 && fr == 15) {
#pragma unroll
            for (int bj = 0; bj < 2; ++bj)
#pragma unroll
                for (int n = 0; n < 2; ++n) { float* ep = EDGE + ((size_t)(u.pm * 4 + 2) * 22 + u.pn) * 256 + bj * HALF + cb0 + n * 16; *(f32x4*)ep = acc[1][bj][2][n]; *(f32x4*)(ep + 22 * 256) = acc[1][bj][3][n]; } }
        asm volatile("s_waitcnt lgkmcnt(0)" ::: "memory"); __builtin_amdgcn_s_barrier(); asm volatile("" ::: "memory");
#pragma unroll
        for (int n = 0; n < 2; ++n) { const int ch0 = u.pn * HALF + cb0 + n * 16;
            f32x4 wa[3], wb[3];
#pragma unroll
            for (int k = 0; k < 3; ++k) { wa[k] = *(const f32x4*)(cw + k * 5632 + ch0); wb[k] = *(const f32x4*)(cw + k * 5632 + 2816 + ch0); }
            const f32x4 ba = *(const f32x4*)(cb + ch0), bb = *(const f32x4*)(cb + 2816 + ch0);
#pragma unroll
            for (int ai = 0; ai < 2; ++ai) { const int g = 2 * ai + wr;
                f32x4 bu[2], bd[2];
#pragma unroll
                for (int bj = 0; bj < 2; ++bj) { const int col = bj * HALF + cb0 + n * 16; const f32x4 zz = {0.f, 0.f, 0.f, 0.f};
                    bu[bj] = g > 0 ? *(const PG8_LAS f32x4*)(LAST + (g - 1) * 256 + col) : zz; bd[bj] = g < 3 ? *(const PG8_LAS f32x4*)(FIRST + (g + 1) * 256 + col) : zz; }
                float o[4][4];
#pragma unroll
                for (int e = 0; e < 4; ++e) { float cv[2][4];
#pragma unroll
                    for (int bj = 0; bj < 2; ++bj) { const float v0 = acc[ai][bj][0][n][e], v1 = acc[ai][bj][1][n][e], v2 = acc[ai][bj][2][n][e], v3 = acc[ai][bj][3][n][e];
                        const float w0 = bj ? wb[0][e] : wa[0][e], w1 = bj ? wb[1][e] : wa[1][e], w2 = bj ? wb[2][e] : wa[2][e], bs = bj ? bb[e] : ba[e];
                        const float upx = dpp0<0x111>(v3) + (fr == 0 ? bu[bj][e] : 0.f);
                        const float dnx = dpp0<0x101>(v0) + (fr == 15 ? bd[bj][e] : 0.f);
                        cv[bj][0] = w0 * upx + w1 * v0 + w2 * v1 + bs; cv[bj][1] = w0 * v0 + w1 * v1 + w2 * v2 + bs;
                        cv[bj][2] = w0 * v1 + w1 * v2 + w2 * v3 + bs;  cv[bj][3] = w0 * v2 + w1 * v3 + w2 * dnx + bs; }
#pragma unroll
                    for (int m = 0; m < 4; ++m) o[m][e] = cv[0][m] * __builtin_amdgcn_rcpf(1.0f + __builtin_amdgcn_exp2f(-1.4426950408889634f * cv[0][m])) * cv[1][m]; }
#pragma unroll
                for (int m = 0; m < 4; ++m) { typedef unsigned u32x2 __attribute__((ext_vector_type(2))); u32x2 w; w.x = cvt_pk_bf16(o[m][0], o[m][1]); w.y = cvt_pk_bf16(o[m][2], o[m][3]);
                    *(u32x2*)(ACT + (size_t)(u.pm * BM + ai * HALF + wr * 64 + 4 * fr + m) * 2816 + ch0) = w; } } }
    }
};

template <class Epi, class Sched, bool ALIGN_EPI = false, bool SP2 = false>
__device__ __forceinline__ void gemm_phase(PG8_LAS unsigned char* lds, const Gemm g, const Sched& S, const Epi& E) {
    int tid = threadIdx.x; asm volatile("" : "+v"(tid));
    const int wid = __builtin_amdgcn_readfirstlane(tid >> 6), lane = tid & 63, wr = wid >> 2, wc = wid & 3, fr = lane & 15, fq = lane >> 4;
    int K = g.K; asm volatile("" : "+s"(K));
    const int nt = K / BK;
    unsigned voffA[2], voffB[2];
#pragma unroll
    for (int i = 0; i < 2; ++i) { int R, C; stage_rc(tid * 16 + i * 8192, R, C); const int Rb = Epi::PERM ? ((R & ~31) + perm32(R & 31)) : R;
        const int Ra = Epi::APERM ? ((R & ~63) + 4 * (R & 15) + ((R >> 4) & 3)) : R;
        voffA[i] = (unsigned)(Ra * g.lda + C) * 2u; voffB[i] = (unsigned)(Rb * g.ldb + C) * 2u; }
    const size_t kstep = (size_t)(BK * 2);
    const size_t hstepA = (size_t)HALF * g.lda * 2, hstepB = (size_t)HALF * g.ldb * 2;
    const size_t tstepA = 2 * hstepA, tstepB = 2 * hstepB;
    const unsigned ldsw = (unsigned)wid * 1024u;
    const int aoff = lds_byte(wr * 64 + fr, fq * 8), boff = lds_byte(wc * 32 + fr, fq * 8);
#define PG8_SA(b, h) (((b) * 2 + (h)) * HTB)
#define PG8_SB(b, h) ((4 + (b) * 2 + (h)) * HTB)
#define PG8_STAGE(bufoff, gbase, voff) do { _Pragma("unroll") for (int _i = 0; _i < 2; ++_i) \
        __builtin_amdgcn_global_load_lds((const unsigned*)((const char*)(gbase) + (voff)[_i]), (PG8_LAS unsigned*)(lds + (bufoff) + ldsw + _i * 8192), 16, 0, 0); } while (0)
#define PG8_LDA(dst, b, h) do { _Pragma("unroll") for (int m = 0; m < 4; ++m) _Pragma("unroll") for (int k = 0; k < 2; ++k) dst[m][k] = *(const PG8_LAS bf16x8*)(lds + PG8_SA(b, h) + aoff + m * 2048 + k * 1024); } while (0)
#define PG8_LDB(dst, b, h) do { _Pragma("unroll") for (int n = 0; n < 2; ++n) _Pragma("unroll") for (int k = 0; k < 2; ++k) dst[n][k] = *(const PG8_LAS bf16x8*)(lds + PG8_SB(b, h) + boff + n * 2048 + k * 1024); } while (0)
#define PG8_MMA(ai, bj, At, Bt) do { __builtin_amdgcn_s_setprio(1); _Pragma("unroll") for (int m = 0; m < 4; ++m) _Pragma("unroll") for (int n = 0; n < 2; ++n) _Pragma("unroll") for (int k = 0; k < 2; ++k) \
        acc[ai][bj][m][n] = __builtin_amdgcn_mfma_f32_16x16x32_bf16(Bt[n][k], At[m][k], acc[ai][bj][m][n], 0, 0, 0); __builtin_amdgcn_s_setprio(0); } while (0)
#define PG8_WAIT_V(n) asm volatile("s_waitcnt vmcnt(" #n ")" ::: "memory")
#define PG8_WAIT_L(n) asm volatile("s_waitcnt lgkmcnt(" #n ")" ::: "memory")
#define PG8_BAR __builtin_amdgcn_s_barrier()
#define PG8_SCHED __builtin_amdgcn_sched_barrier(0)
    Unit cur, nxt; int ui = 0;
    if (!S.next(0, cur)) return;
    f32x4 acc[2][2][4][2];
#pragma unroll
    for (int a = 0; a < 2; ++a)
#pragma unroll
        for (int b = 0; b < 2; ++b)
#pragma unroll
            for (int m = 0; m < 4; ++m)
#pragma unroll
                for (int n = 0; n < 2; ++n) acc[a][b][m][n] = (f32x4){0.f, 0.f, 0.f, 0.f};
    bf16x8 At[4][2], B0[2][2], B1[2][2];
    const char* cA = (const char*)g.A + (size_t)cur.pm * tstepA; const char* cB = (const char*)g.Bt + (size_t)cur.pn * tstepB;
    S.a_ready(cur);
    if constexpr (SP2) {
        PG8_STAGE(PG8_SB(0, 0), cB, voffB); PG8_STAGE(PG8_SB(0, 1), cB + hstepB, voffB); PG8_STAGE(PG8_SA(0, 0), cA, voffA); PG8_STAGE(PG8_SA(0, 1), cA + hstepA, voffA);
        if (wr == 1) PG8_BAR;
        PG8_WAIT_V(2); PG8_BAR;
        PG8_STAGE(PG8_SB(1, 0), cB + kstep, voffB); PG8_STAGE(PG8_SA(1, 0), cA + kstep, voffA); PG8_STAGE(PG8_SB(1, 1), cB + hstepB + kstep, voffB);
        PG8_WAIT_V(6); PG8_BAR;
    } else {
        PG8_STAGE(PG8_SB(0, 0), cB, voffB); PG8_STAGE(PG8_SA(0, 0), cA, voffA); PG8_STAGE(PG8_SB(0, 1), cB + hstepB, voffB); PG8_STAGE(PG8_SA(0, 1), cA + hstepA, voffA);
        if (wr == 1) PG8_BAR;
        PG8_WAIT_V(4); PG8_BAR;
        PG8_STAGE(PG8_SB(1, 0), cB + kstep, voffB); PG8_STAGE(PG8_SA(1, 0), cA + kstep, voffA); PG8_STAGE(PG8_SB(1, 1), cB + hstepB + kstep, voffB);
        PG8_WAIT_V(6); PG8_BAR;
    }
    for (;;) {
        const bool has_next = S.next(ui + 1, nxt);
        const char* nA = has_next ? (const char*)g.A + (size_t)nxt.pm * tstepA : cA; const char* nB = has_next ? (const char*)g.Bt + (size_t)nxt.pn * tstepB : cB;
        for (int t = 0; t < nt; t += 2) {
            const bool last = (t == nt - 2);
            const char* a1 = cA + (size_t)(t + 1) * kstep;
            const char* a2 = last ? nA : cA + (size_t)(t + 2) * kstep; const char* b2 = last ? nB : cB + (size_t)(t + 2) * kstep;
            const char* a3 = a2 + kstep; const char* b3 = b2 + kstep;
            if (last && has_next) S.a_ready(nxt);
            if constexpr (SP2) {
            PG8_LDB(B0, 0, 0); PG8_LDB(B1, 0, 1); PG8_SCHED; PG8_LDA(At, 0, 0); PG8_STAGE(PG8_SA(1, 1), a1 + hstepA, voffA);
            PG8_WAIT_V(8); PG8_WAIT_L(0); PG8_BAR; PG8_MMA(0, 0, At, B0); PG8_MMA(0, 1, At, B1); PG8_BAR; PG8_SCHED;
            PG8_LDA(At, 0, 1); PG8_STAGE(PG8_SB(0, 0), b2, voffB); PG8_STAGE(PG8_SB(0, 1), b2 + hstepB, voffB); PG8_STAGE(PG8_SA(0, 0), a2, voffA);
            PG8_WAIT_V(8); PG8_WAIT_L(0); PG8_BAR; PG8_MMA(1, 0, At, B0); PG8_MMA(1, 1, At, B1); PG8_BAR; PG8_SCHED;
            PG8_LDB(B0, 1, 0); PG8_LDB(B1, 1, 1); PG8_SCHED; PG8_LDA(At, 1, 0); PG8_STAGE(PG8_SA(0, 1), a2 + hstepA, voffA);
            PG8_WAIT_V(8); PG8_WAIT_L(0); PG8_BAR; PG8_MMA(0, 0, At, B0); PG8_MMA(0, 1, At, B1); PG8_BAR; PG8_SCHED;
            PG8_LDA(At, 1, 1); PG8_STAGE(PG8_SB(1, 0), b3, voffB); PG8_STAGE(PG8_SB(1, 1), b3 + hstepB, voffB); PG8_STAGE(PG8_SA(1, 0), a3, voffA);
            PG8_WAIT_V(8); PG8_WAIT_L(0); PG8_BAR; PG8_MMA(1, 0, At, B0); PG8_MMA(1, 1, At, B1); PG8_BAR; PG8_SCHED;
            } else {
            PG8_LDB(B0, 0, 0); PG8_SCHED; PG8_LDA(At, 0, 0); PG8_STAGE(PG8_SA(1, 1), a1 + hstepA, voffA);
            PG8_WAIT_L(8); PG8_BAR; PG8_WAIT_L(0); PG8_MMA(0, 0, At, B0); PG8_BAR; PG8_SCHED;
            PG8_LDB(B1, 0, 1); PG8_STAGE(PG8_SB(0, 0), b2, voffB);
            PG8_BAR; PG8_WAIT_L(0); PG8_MMA(0, 1, At, B1); PG8_BAR;
            PG8_LDA(At, 0, 1); PG8_STAGE(PG8_SA(0, 0), a2, voffA);
            PG8_BAR; PG8_WAIT_L(0); PG8_MMA(1, 0, At, B0); PG8_BAR; PG8_SCHED;
            PG8_STAGE(PG8_SB(0, 1), b2 + hstepB, voffB);
            PG8_WAIT_V(6); PG8_BAR; PG8_MMA(1, 1, At, B1); PG8_BAR;
            PG8_LDB(B0, 1, 0); PG8_SCHED; PG8_LDA(At, 1, 0); PG8_STAGE(PG8_SA(0, 1), a2 + hstepA, voffA);
            PG8_WAIT_L(8); PG8_BAR; PG8_WAIT_L(0); PG8_MMA(0, 0, At, B0); PG8_BAR; PG8_SCHED;
            PG8_LDB(B1, 1, 1); PG8_STAGE(PG8_SB(1, 0), b3, voffB);
            PG8_BAR; PG8_WAIT_L(0); PG8_MMA(0, 1, At, B1); PG8_BAR;
            PG8_LDA(At, 1, 1); PG8_STAGE(PG8_SA(1, 0), a3, voffA);
            PG8_BAR; PG8_WAIT_L(0); PG8_MMA(1, 0, At, B0); PG8_BAR; PG8_SCHED;
            PG8_STAGE(PG8_SB(1, 1), b3 + hstepB, voffB);
            PG8_WAIT_V(6); PG8_BAR; PG8_MMA(1, 1, At, B1); PG8_BAR;
            }
        }
        if constexpr (ALIGN_EPI) { if (wr == 0) PG8_BAR; }
        if constexpr (!Epi::AFTER_DRAIN) { E(acc, cur, wr, wc, fr, fq); S.done(cur); }
        if (!has_next) break;
#pragma unroll
        for (int a = 0; a < 2; ++a)
#pragma unroll
            for (int b = 0; b < 2; ++b)
#pragma unroll
                for (int m = 0; m < 4; ++m)
#pragma unroll
                    for (int n = 0; n < 2; ++n) acc[a][b][m][n] = (f32x4){0.f, 0.f, 0.f, 0.f};
        cur = nxt; cA = nA; cB = nB; ++ui;
        if constexpr (ALIGN_EPI) { if (wr == 1) PG8_BAR; }
    }
    PG8_WAIT_V(0);
    if constexpr (!ALIGN_EPI) { if (wr == 0) PG8_BAR; }
    PG8_BAR;
    if constexpr (Epi::AFTER_DRAIN) { E.fused(acc, cur, wr, wc, fr, fq, lds, wid, lane); S.done(cur); }
#undef PG8_SA
#undef PG8_SB
#undef PG8_STAGE
#undef PG8_LDA
#undef PG8_LDB
#undef PG8_MMA
#undef PG8_WAIT_V
#undef PG8_WAIT_L
#undef PG8_BAR
#undef PG8_SCHED
}
}

#define DEV __device__ __forceinline__
#define LAS __attribute__((address_space(3)))
typedef unsigned short bf16_t;
typedef short bf16x8 __attribute__((ext_vector_type(8)));
typedef float f32x4 __attribute__((ext_vector_type(4)));
typedef float f32x2 __attribute__((ext_vector_type(2)));
typedef float f32x16 __attribute__((ext_vector_type(16)));
typedef unsigned u32x4 __attribute__((ext_vector_type(4)));
typedef unsigned u32x2 __attribute__((ext_vector_type(2)));

constexpr int R = 16896, RB = 8448, NCTX = 256, TL = 8192, DM = 1024, INW = 1696, DFF = 2816, HFF = 1408;
constexpr int NWG_T = 512;
constexpr float EPS = 1e-6f;
constexpr int LDS_BYTES = 147456;
constexpr size_t OFF_X = 0, OFF_HN = 69206016, OFF_W = 103809024, OFF_MOD = 152174592, OFF_ROPE = 152436736, OFF_OV = 153485312;
constexpr size_t OV_Q = 0, OV_KN = 25952256, OV_VT = 43253760, OV_SLOC = 60555264, OV_SIN = 69206016, OV_U = 0;
constexpr size_t OFF_PART = 250100224;
constexpr size_t OFF_EDGE = 258488832;
constexpr size_t WS_NEED = OFF_EDGE + 5947392;
constexpr size_t W_IN = 0, W_UQ = 1835008, W_KN = 2129920, W_V = 2260992, W_OUT = 2392064, W_UP = 3440640, W_DN = 9207808, W_LAYER = 12091392;

struct Params {
    const float *x, *c, *ctx, *c_ctx, *w_mod, *b_mod, *norm1_g, *w_in, *ret_decay_f, *ret_decay_b, *mla_q_norm_g, *w_uq, *mla_kv_norm_g, *w_ukv,
        *pool_w, *pool_scale, *w_out, *norm2_g, *w_up, *conv_w, *conv_b, *w_down, *final_norm_g;
    float* out; unsigned char* ws; int ph_lo, ph_hi;
};

DEV int otid() { int t = threadIdx.x; asm volatile("" : "+v"(t)); return t; }
DEV float bf2f(unsigned short x) { return __uint_as_float((unsigned)x << 16); }
DEV unsigned f2bf(float f) { unsigned u = __float_as_uint(f); return (u + 0x7fffu + ((u >> 16) & 1u)) >> 16; }
DEV unsigned pk2(float lo, float hi) { return f2bf(lo) | (f2bf(hi) << 16); }
DEV float wave_sum(float v) {
#pragma unroll
    for (int o = 1; o < 64; o <<= 1) v += __shfl_xor(v, o);
    return v;
}
DEV float siluf(float x) { return x * __builtin_amdgcn_rcpf(1.0f + __builtin_amdgcn_exp2f(-1.4426950408889634f * x)); }
DEV int crow(int r, int hi) { return (r & 3) + 8 * (r >> 2) + 4 * hi; }
DEV bf16x8 pack8(float a0, float a1, float a2, float a3, float a4, float a5, float a6, float a7) {
    u32x4 w; w.x = pg8::cvt_pk_bf16(a0, a1); w.y = pg8::cvt_pk_bf16(a2, a3); w.z = pg8::cvt_pk_bf16(a4, a5); w.w = pg8::cvt_pk_bf16(a6, a7);
    return __builtin_bit_cast(bf16x8, w);
}
DEV int row_mi(int r) { const int b = r / RB; const int s = r - b * RB; return s < NCTX ? 2 : b; }

DEV void transpose_item(const float* W, int K, int Nsrc, bf16_t* WT, int n0, int cs, int k0, float* scr, int lane) {
#pragma unroll
    for (int i = 0; i < 32; ++i) { const int kk = 2 * i + (lane >> 5); scr[kk * 33 + (lane & 31)] = cs >= 0 ? W[(size_t)(k0 + kk) * Nsrc + cs + (lane & 31)] : 0.f; }
    asm volatile("s_waitcnt lgkmcnt(0)" ::: "memory");
    const int c = lane & 7;
#pragma unroll
    for (int j = 0; j < 4; ++j) { const int n = (lane >> 3) + 8 * j; const float* s = scr + (8 * c) * 33 + n;
        u32x4 o; o.x = pk2(s[0 * 33], s[1 * 33]); o.y = pk2(s[2 * 33], s[3 * 33]); o.z = pk2(s[4 * 33], s[5 * 33]); o.w = pk2(s[6 * 33], s[7 * 33]);
        *(u32x4*)(WT + (size_t)(n0 + n) * K + k0 + 8 * c) = o; }
    asm volatile("s_waitcnt lgkmcnt(0)" ::: "memory");
}
DEV int map_in(int n0) { return n0 < 1440 ? n0 : (n0 < INW ? -2 : -1); }
DEV int map_kn(int n0) { return (n0 >> 6) * 128 + (n0 & 63); }
DEV int map_v(int n0) { return (n0 >> 6) * 128 + 64 + (n0 & 63); }
DEV int map_up(int n0) { const int pn = n0 >> 8, w = n0 & 255; return w < 128 ? 128 * pn + w : DFF + 128 * pn + (w - 128); }

DEV void phase_prep(const Params& p, unsigned char* lds) {
    const int tid = otid(), lane = tid & 63, wid = tid >> 6;
    unsigned char* ws = p.ws;
    { f32x2* rope = (f32x2*)(ws + OFF_ROPE);
      for (int idx = blockIdx.x * NWG_T + tid; idx < TL * 16; idx += gridDim.x * NWG_T) { const int t = idx >> 4, i = idx & 15; const int pos = i < 8 ? (t >> 6) : (t & 63);
          const float inv = exp2f(-(float)(i & 7) * 0.125f * 13.287712379549449f); const float ang = (float)pos * inv; f32x2 cs; cs.x = __cosf(ang); cs.y = __sinf(ang); rope[idx] = cs; } }
    { float* scv = (float*)lds;
      float* red = scv + 3 * 1024;
      for (int i = tid; i < 3 * 1024; i += NWG_T) { const int v = i >> 10, k = i & 1023; const float cv = v < 2 ? p.c[v * 1024 + k] : p.c_ctx[k]; scv[i] = siluf(cv); }
      __syncthreads();
      float* modv = (float*)(ws + OFF_MOD);
      for (int it = blockIdx.x; it < 192; it += gridDim.x) { const int l = it / 96, col0 = (it % 96) * 64;
          const float* wm = p.w_mod + (size_t)l * 1024 * 6144 + col0 + lane; float a0 = 0.f, a1 = 0.f, a2 = 0.f;
#pragma unroll 16
          for (int k = wid * 128; k < wid * 128 + 128; ++k) { const float w = wm[(size_t)k * 6144]; a0 += scv[k] * w; a1 += scv[1024 + k] * w; a2 += scv[2048 + k] * w; }
          red[(wid * 3 + 0) * 64 + lane] = a0; red[(wid * 3 + 1) * 64 + lane] = a1; red[(wid * 3 + 2) * 64 + lane] = a2;
          __syncthreads();
          if (tid < 192) { const int v = tid >> 6, cl = tid & 63; float s = 0.f;
#pragma unroll
              for (int w = 0; w < 8; ++w) s += red[(w * 3 + v) * 64 + cl];
              modv[((size_t)l * 3 + v) * 6144 + col0 + cl] = s + p.b_mod[l * 6144 + col0 + cl]; }
          __syncthreads(); }
    }
}
DEV void phase_prep_weights(const Params& p, unsigned char* lds) {
    const int tid = otid(), lane = tid & 63, wid = tid >> 6;
    unsigned char* ws = p.ws;
    { float* scr = (float*)(lds + 32768 + wid * 8704);
      const int gw = blockIdx.x * 8 + wid, NGW = gridDim.x * 8;
      constexpr int I_IN = 16 * 56, I_UQ = 6 * 24, I_KN = 4 * 16, I_V = 4 * 16, I_OUT = 16 * 32, I_UP = 16 * 176, I_DN = 44 * 32, I_L = I_IN + I_UQ + I_KN + I_V + I_OUT + I_UP + I_DN;
      for (int it = gw; it < 2 * I_L; it += NGW) { const int l = it / I_L; int r = it - l * I_L; bf16_t* wl = (bf16_t*)(ws + OFF_W) + (size_t)l * W_LAYER;
          const float* src; int K, Nsrc, nbn, mp; size_t doff;
          if (r < I_IN) { src = p.w_in + (size_t)l * 1024 * INW; K = 1024; Nsrc = INW; nbn = 56; mp = 1; doff = W_IN; }
          else if ((r -= I_IN) < I_UQ) { src = p.w_uq + (size_t)l * 384 * 768; K = 384; Nsrc = 768; nbn = 24; mp = 0; doff = W_UQ; }
          else if ((r -= I_UQ) < I_KN) { src = p.w_ukv + (size_t)l * 256 * 1024; K = 256; Nsrc = 1024; nbn = 16; mp = 2; doff = W_KN; }
          else if ((r -= I_KN) < I_V) { src = p.w_ukv + (size_t)l * 256 * 1024; K = 256; Nsrc = 1024; nbn = 16; mp = 3; doff = W_V; }
          else if ((r -= I_V) < I_OUT) { src = p.w_out + (size_t)l * 1024 * 1024; K = 1024; Nsrc = 1024; nbn = 32; mp = 0; doff = W_OUT; }
          else if ((r -= I_OUT) < I_UP) { src = p.w_up + (size_t)l * 1024 * 5632; K = 1024; Nsrc = 5632; nbn = 176; mp = 4; doff = W_UP; }
          else { r -= I_UP; src = p.w_down + (size_t)l * DFF * 1024; K = DFF; Nsrc = 1024; nbn = 32; mp = 0; doff = W_DN; }
          const int kb = r / nbn, nb = r - kb * nbn, n0 = nb * 32;
          const int cs = mp == 0 ? n0 : mp == 1 ? map_in(n0) : mp == 2 ? map_kn(n0) : mp == 3 ? map_v(n0) : map_up(n0);
          if (cs != -2) transpose_item(src, K, Nsrc, wl + doff, n0, cs, kb * 64, scr, lane); }
    }
    { for (int idx = blockIdx.x * NWG_T + tid; idx < 2 * 1024 * 256; idx += gridDim.x * NWG_T) { const int n = idx & 255, k = (idx >> 8) & 1023, l = idx >> 18; const int g = n >> 6, d = n & 63;
          const float* wr = p.w_in + ((size_t)l * 1024 + k) * INW + 1440 + g * 64; const float* pw = p.pool_w + ((size_t)(l * 4 + g) * 64) * 64 + d; float s = 0.f;
#pragma unroll 8
          for (int c = 0; c < 64; ++c) s += wr[c] * pw[c * 64];
          ((bf16_t*)(ws + OFF_W) + (size_t)l * W_LAYER + W_IN)[(size_t)(1440 + n) * 1024 + k] = (bf16_t)f2bf(s * p.pool_scale[l * 256 + n]); } }
}

DEV void phase_norm(const Params& p, int l, int which, bool first, const float* pgate) {
    const int tid = otid(); const int lane = tid & 63, wid = tid >> 6; const int gw = blockIdx.x * 8 + wid, NGW = gridDim.x * 8;
    float* X = (float*)(p.ws + OFF_X); bf16_t* HN = (bf16_t*)(p.ws + OFF_HN);
    const float* modv = (const float*)(p.ws + OFF_MOD) + (size_t)l * 3 * 6144;
    const float* g = (which == 0 ? p.norm1_g : p.norm2_g) + l * 1024;
    for (int r = gw; r < R; r += NGW) {
        const int b = r / RB, s = r - b * RB; const int mi = s < NCTX ? 2 : b;
        const float* src = first ? (s < NCTX ? p.ctx + ((size_t)b * NCTX + s) * 1024 : p.x + ((size_t)b * TL + (s - NCTX)) * 1024) : X + (size_t)r * 1024;
        const f32x4* xr = (const f32x4*)src + lane; f32x4 v[4]; float ss = 0.f;
#pragma unroll
        for (int j = 0; j < 4; ++j) { v[j] = xr[64 * j]; ss += (v[j].x * v[j].x + v[j].y * v[j].y) + (v[j].z * v[j].z + v[j].w * v[j].w); }
        if (pgate != nullptr && s < NCTX) { const float* PART = (const float*)(p.ws + OFF_PART) + (size_t)(b * NCTX + s) * 1024; ss = 0.f;
#pragma unroll
            for (int j = 0; j < 4; ++j) { const f32x4 gq = ((const f32x4*)pgate)[lane + 64 * j]; f32x4 a = ((const f32x4*)PART)[lane + 64 * j];
#pragma unroll
                for (int q = 1; q < 4; ++q) a = a + ((const f32x4*)(PART + (size_t)q * 524288))[lane + 64 * j];
                v[j] = v[j] + gq * a; ss += (v[j].x * v[j].x + v[j].y * v[j].y) + (v[j].z * v[j].z + v[j].w * v[j].w); } }
        if (first || (pgate != nullptr && s < NCTX)) { f32x4* xo = (f32x4*)(X + (size_t)r * 1024) + lane;
#pragma unroll
            for (int j = 0; j < 4; ++j) xo[64 * j] = v[j]; }
        const float rs = rsqrtf(wave_sum(ss) * (1.f / 1024.f) + EPS);
        const float* mv = modv + mi * 6144 + (which == 0 ? 0 : 3072);
        u32x2* o8 = (u32x2*)(HN + (size_t)r * 1024) + lane;
#pragma unroll
        for (int j = 0; j < 4; ++j) { const f32x4 gg = ((const f32x4*)g)[lane + 64 * j], sh = ((const f32x4*)mv)[lane + 64 * j], sc = ((const f32x4*)(mv + 1024))[lane + 64 * j];
            const f32x4 y = v[j] * rs * gg; const f32x4 h = y * (sc + 1.0f) + sh; u32x2 w; w.x = pk2(h.x, h.y); w.y = pk2(h.z, h.w); o8[64 * j] = w; }
    }
}
DEV void phase_final(const Params& p) {
    const int tid = otid(); const int lane = tid & 63, wid = tid >> 6; const int gw = blockIdx.x * 8 + wid, NGW = gridDim.x * 8;
    const float* X = (const float*)(p.ws + OFF_X);
    for (int q = gw; q < 2 * TL; q += NGW) { const int b = q / TL, t = q - b * TL; const int r = b * RB + NCTX + t;
        const f32x4* xr = (const f32x4*)(X + (size_t)r * 1024) + lane; f32x4 v[4]; float ss = 0.f;
#pragma unroll
        for (int j = 0; j < 4; ++j) { v[j] = xr[64 * j]; ss += (v[j].x * v[j].x + v[j].y * v[j].y) + (v[j].z * v[j].z + v[j].w * v[j].w); }
        const float rs = rsqrtf(wave_sum(ss) * (1.f / 1024.f) + EPS);
        f32x4* o = (f32x4*)(p.out + (size_t)q * 1024) + lane;
#pragma unroll
        for (int j = 0; j < 4; ++j) { const f32x4 gg = ((const f32x4*)p.final_norm_g)[lane + 64 * j]; o[64 * j] = v[j] * rs * gg; } }
}

DEV void phase_rowwise(const Params& p, int l) {
    const int tid = otid(); const int lane = tid & 63, wid = tid >> 6; const int gw = blockIdx.x * 8 + wid, NGW = gridDim.x * 8;
    bf16_t* P = (bf16_t*)p.out; const f32x2* rope = (const f32x2*)(p.ws + OFF_ROPE);
    const float* qg = p.mla_q_norm_g + l * 384; const float* kg = p.mla_kv_norm_g + l * 256;
    float qgv[6];
#pragma unroll
    for (int j = 0; j < 3; ++j) { qgv[2 * j] = qg[2 * (lane + 64 * j)]; qgv[2 * j + 1] = qg[2 * (lane + 64 * j) + 1]; }
    const f32x4 kgv = ((const f32x4*)kg)[lane];
    for (int r0 = gw; r0 < R; r0 += 2 * NGW) {
        unsigned wq[2][3]; u32x2 wk[2]; float x1[2], x2[2]; f32x2 cs[2]; bool val[2], lat[2];
#pragma unroll
        for (int i = 0; i < 2; ++i) { const int r = r0 + i * NGW; val[i] = r < R; const int rr = val[i] ? r : r0; bf16_t* pr = P + (size_t)rr * INW; const int s = rr % RB; lat[i] = s >= NCTX;
            const unsigned* q2 = (const unsigned*)(pr + 768) + lane;
#pragma unroll
            for (int j = 0; j < 3; ++j) wq[i][j] = q2[64 * j];
            wk[i] = *((const u32x2*)(pr + 1152) + lane);
            const int li = lane & 15; x1[i] = bf2f(pr[1408 + li]); x2[i] = bf2f(pr[1408 + 16 + li]); cs[i] = rope[(lat[i] ? s - NCTX : 0) * 16 + li]; }
#pragma unroll
        for (int i = 0; i < 2; ++i) { if (!val[i]) continue; const int r = r0 + i * NGW; bf16_t* pr = P + (size_t)r * INW;
            { float ss = 0.f;
#pragma unroll
              for (int j = 0; j < 3; ++j) { const float a = bf2f(wq[i][j] & 0xffff), c2 = bf2f(wq[i][j] >> 16); ss += a * a + c2 * c2; }
              const float rs = rsqrtf(wave_sum(ss) * (1.f / 384.f) + EPS); unsigned* q2 = (unsigned*)(pr + 768) + lane;
#pragma unroll
              for (int j = 0; j < 3; ++j) q2[64 * j] = pk2(bf2f(wq[i][j] & 0xffff) * rs * qgv[2 * j], bf2f(wq[i][j] >> 16) * rs * qgv[2 * j + 1]); }
            { const float a0 = bf2f(wk[i].x & 0xffff), a1 = bf2f(wk[i].x >> 16), a2 = bf2f(wk[i].y & 0xffff), a3 = bf2f(wk[i].y >> 16);
              const float rs = rsqrtf(wave_sum((a0 * a0 + a1 * a1) + (a2 * a2 + a3 * a3)) * (1.f / 256.f) + EPS);
              u32x2 o; o.x = pk2(a0 * rs * kgv.x, a1 * rs * kgv.y); o.y = pk2(a2 * rs * kgv.z, a3 * rs * kgv.w); *((u32x2*)(pr + 1152) + lane) = o; }
            if (lat[i] && lane < 16) { pr[1408 + lane] = (bf16_t)f2bf(x1[i] * cs[i].x - x2[i] * cs[i].y); pr[1408 + 16 + lane] = (bf16_t)f2bf(x2[i] * cs[i].x + x1[i] * cs[i].y); } }
    }
}

DEV void phase_pool(const Params& p) {
    const int tid = otid(); const bf16_t* P = (const bf16_t*)p.out; bf16_t* MIX = (bf16_t*)(p.ws + OFF_HN);
    for (int idx = blockIdx.x * NWG_T + tid; idx < R * 32; idx += gridDim.x * NWG_T) { const int r = idx >> 5, cg = idx & 31; const int half = 1 << (cg >> 3);
        const int b = r / RB, s = r - b * RB; const int seq0 = s < NCTX ? b * RB : b * RB + NCTX; const int T = s < NCTX ? NCTX : TL; const int t = r - seq0;
        const int lo = max(t - half, 0), hi = min(t + half, T); float sum[8];
#pragma unroll
        for (int j = 0; j < 8; ++j) sum[j] = 0.f;
        const bf16_t* base = P + (size_t)seq0 * INW + 1440 + cg * 8;
        { bf16x8 wv[16]; const bf16x8 zz = {0, 0, 0, 0, 0, 0, 0, 0};
#pragma unroll
          for (int k = 0; k < 16; ++k) { const int tt = t - 8 + k; wv[k] = (tt >= lo && tt < hi) ? *(const bf16x8*)(base + (size_t)tt * INW) : zz; }
#pragma unroll
          for (int k = 0; k < 16; ++k)
#pragma unroll
              for (int j = 0; j < 8; ++j) sum[j] += bf2f((unsigned short)wv[k][j]); }
        const bf16x8 me = *(const bf16x8*)(base + (size_t)t * INW); const float ic = 1.0f / (float)(hi - lo); float o[8];
#pragma unroll
        for (int j = 0; j < 8; ++j) o[j] = sum[j] * ic - bf2f((unsigned short)me[j]);
        *(bf16x8*)(MIX + (size_t)r * 1024 + 768 + cg * 8) = pack8(o[0], o[1], o[2], o[3], o[4], o[5], o[6], o[7]); }
}

DEV float log2_sigmoid(float d) { return -log1pf(__expf(-d)) * 1.4426950408889634f; }
constexpr int ST_P = 272;
DEV void states_item(const Params& p, int l, unsigned char* lds, int it) {
    const int tid = otid(), lane = tid & 63, wid = tid >> 6, l32 = lane & 31, hi = lane >> 5;
    const bf16_t* P = (const bf16_t*)p.out; const f32x2* rope = (const f32x2*)(p.ws + OFF_ROPE);
    float* SLOC = (float*)(p.ws + OFF_OV + OV_SLOC);
    const int gc = it >> 1, hp = it & 1;
    unsigned char* VTl = lds;
    unsigned char* KTl = lds + 2 * 64 * ST_P;
    const int cb = gc % 66; const bool lat = cb >= 2; const int t0 = (cb - 2) * 128; const int r0 = gc * 128;
    __syncthreads();
    { const int tok = tid >> 2, hh = (tid >> 1) & 1, c = tid & 1; const int h = 2 * hp + hh;
      const bf16_t* src = P + (size_t)(r0 + tok) * INW + 128 + h * 32 + 8 * c; const bf16x8 lo = *(const bf16x8*)src, hi8 = *(const bf16x8*)(src + 16);
      const float df = exp2f(log2_sigmoid(p.ret_decay_f[l * 4 + h]) * (float)(127 - tok)) * 0.17677669529663687f, db = exp2f(log2_sigmoid(p.ret_decay_b[l * 4 + h]) * (float)tok) * 0.17677669529663687f;
#pragma unroll
      for (int j = 0; j < 8; ++j) { float x1 = bf2f((unsigned short)lo[j]), x2 = bf2f((unsigned short)hi8[j]);
          if (lat) { const f32x2 cs = rope[(t0 + tok) * 16 + 8 * c + j]; const float y1 = x1 * cs.x - x2 * cs.y, y2 = x2 * cs.x + x1 * cs.y; x1 = y1; x2 = y2; }
          bf16_t* kf = (bf16_t*)(KTl + ((hh * 2 + 0) * 32 + 8 * c + j) * ST_P) + tok; bf16_t* kb = (bf16_t*)(KTl + ((hh * 2 + 1) * 32 + 8 * c + j) * ST_P) + tok;
          kf[0] = (bf16_t)f2bf(x1 * df); kb[0] = (bf16_t)f2bf(x1 * db);
          *(bf16_t*)((unsigned char*)kf + 16 * ST_P) = (bf16_t)f2bf(x2 * df); *(bf16_t*)((unsigned char*)kb + 16 * ST_P) = (bf16_t)f2bf(x2 * db); } }
    for (int task = tid; task < 2048; task += NWG_T) { const int hh = task >> 10, tok = (task >> 3) & 127, ch = task & 7;
        const bf16x8 v = *(const bf16x8*)(P + (size_t)(r0 + tok) * INW + 256 + (2 * hp + hh) * 64 + ch * 8);
#pragma unroll
        for (int j = 0; j < 8; ++j) *((bf16_t*)(VTl + (hh * 64 + ch * 8 + j) * ST_P) + tok) = (bf16_t)v[j]; }
    __syncthreads();
    { const int hh = wid >> 2, dir = (wid >> 1) & 1, dvb = wid & 1; const int h = 2 * hp + hh;
      const unsigned char* ap = VTl + (hh * 64 + 32 * dvb + l32) * ST_P + hi * 16; const unsigned char* bp = KTl + ((hh * 2 + dir) * 32 + l32) * ST_P + hi * 16;
      bf16x8 af[8], bfr[8];
#pragma unroll
      for (int ks = 0; ks < 8; ++ks) { af[ks] = *(const bf16x8*)(ap + ks * 32); bfr[ks] = *(const bf16x8*)(bp + ks * 32); }
      f32x16 acc;
#pragma unroll
      for (int r = 0; r < 16; ++r) acc[r] = 0.f;
#pragma unroll
      for (int ks = 0; ks < 8; ++ks) acc = __builtin_amdgcn_mfma_f32_32x32x16_bf16(af[ks], bfr[ks], acc, 0, 0, 0);
      float* o = SLOC + ((size_t)(gc * 4 + h) * 2 + dir) * 2048 + l32 * 64 + 32 * dvb + 4 * hi;
#pragma unroll
      for (int g4 = 0; g4 < 4; ++g4) *(f32x4*)(o + 8 * g4) = (f32x4){acc[4 * g4], acc[4 * g4 + 1], acc[4 * g4 + 2], acc[4 * g4 + 3]}; }
}
DEV void scan_threads(const Params& p, int l, int gid) {
    if (gid >= 32768) return;
    const int e = gid & 2047, dir = (gid >> 11) & 1, h = (gid >> 12) & 3, b = gid >> 14;
    const float* SLOC = (const float*)(p.ws + OFF_OV + OV_SLOC); float* SIN = (float*)(p.ws + OFF_OV + OV_SIN);
    const float gC = exp2f(log2_sigmoid((dir == 0 ? p.ret_decay_f : p.ret_decay_b)[l * 4 + h]) * 128.f);
    float S = 0.f;
#pragma unroll 11
    for (int st = 0; st < 66; ++st) { const int cb = dir == 0 ? st : (st < 2 ? 1 - st : 67 - st); const size_t idx = ((size_t)((b * 66 + cb) * 4 + h) * 2 + dir) * 2048 + e;
        const float v = SLOC[idx]; SIN[idx] = S; S = S * gC + v; }
}

constexpr int AT_KP = 208, AT_VP = 144, AT_KB = 64 * AT_KP, AT_VBS = 64 * AT_VP, AT_V0 = 4 * AT_KB;
DEV float at_max32(const f32x16& s0, const f32x16& s1) {
    float m0 = __builtin_fmaxf(__builtin_fmaxf(s0[0], s0[1]), s0[2]), m1 = __builtin_fmaxf(__builtin_fmaxf(s1[0], s1[1]), s1[2]);
    m0 = __builtin_fmaxf(__builtin_fmaxf(m0, s0[3]), s0[4]); m1 = __builtin_fmaxf(__builtin_fmaxf(m1, s1[3]), s1[4]);
    m0 = __builtin_fmaxf(__builtin_fmaxf(m0, s0[5]), s0[6]); m1 = __builtin_fmaxf(__builtin_fmaxf(m1, s1[5]), s1[6]);
    m0 = __builtin_fmaxf(__builtin_fmaxf(m0, s0[7]), s0[8]); m1 = __builtin_fmaxf(__builtin_fmaxf(m1, s1[7]), s1[8]);
    m0 = __builtin_fmaxf(__builtin_fmaxf(m0, s0[9]), s0[10]); m1 = __builtin_fmaxf(__builtin_fmaxf(m1, s1[9]), s1[10]);
    m0 = __builtin_fmaxf(__builtin_fmaxf(m0, s0[11]), s0[12]); m1 = __builtin_fmaxf(__builtin_fmaxf(m1, s1[11]), s1[12]);
    m0 = __builtin_fmaxf(__builtin_fmaxf(m0, s0[13]), s0[14]); m1 = __builtin_fmaxf(__builtin_fmaxf(m1, s1[13]), s1[14]);
    return __builtin_fmaxf(__builtin_fmaxf(m0, s0[15]), __builtin_fmaxf(m1, s1[15]));
}
DEV void attn_unit(const Params& p, unsigned char* lds, int u) {
    const int tid = otid(), lane = tid & 63, wid = tid >> 6, l32 = lane & 31, hi = lane >> 5;
    const bf16_t* Q = (const bf16_t*)(p.ws + OFF_OV + OV_Q); const bf16_t* KN = (const bf16_t*)(p.ws + OFF_OV + OV_KN); const bf16_t* VT = (const bf16_t*)(p.ws + OFF_OV + OV_VT);
    const bf16_t* P = (const bf16_t*)p.out; bf16_t* MIX = (bf16_t*)(p.ws + OFF_HN); const f32x2* rope = (const f32x2*)(p.ws + OFF_ROPE);
    const bool isctx = u >= 512; int b, h, qrow0, NT;
    if (!isctx) { b = u >> 8; h = (u >> 5) & 7; qrow0 = b * RB + NCTX + (u & 31) * 256; NT = 132; } else { const int v = u - 512; b = v >> 3; h = v & 7; qrow0 = b * RB; NT = 4; }
    const int krow0 = b * RB; const int qrow = qrow0 + wid * 32 + l32;
    bf16x8 qf[6];
    { const bf16_t* qp = Q + (size_t)qrow * 768 + h * 96 + hi * 8;
#pragma unroll
      for (int d0 = 0; d0 < 6; ++d0) qf[d0] = *(const bf16x8*)(qp + d0 * 16);
      if (!isctx) { const f32x2* rp = rope + (size_t)(qrow - (b * RB + NCTX)) * 16 + hi * 8;
#pragma unroll
          for (int j = 0; j < 8; ++j) { const f32x2 cs = rp[j]; const float x1 = bf2f((unsigned short)qf[4][j]), x2 = bf2f((unsigned short)qf[5][j]);
              qf[4][j] = (short)f2bf(x1 * cs.x - x2 * cs.y); qf[5][j] = (short)f2bf(x2 * cs.x + x1 * cs.y); } } }
    const bf16_t* sp[3]; int sstep[3], lo[3];
#pragma unroll
    for (int k = 0; k < 2; ++k) { const int c = tid + k * 512; const int key = c / 12, part = c - key * 12; lo[k] = key * AT_KP + part * 16;
        if (part < 8) { sp[k] = KN + (size_t)(krow0 + key) * 512 + h * 64 + part * 8; sstep[k] = 64 * 512; } else { sp[k] = P + (size_t)(krow0 + key) * INW + 1408 + (part - 8) * 8; sstep[k] = 64 * INW; } }
    { const int dv = tid >> 3, kc = tid & 7; lo[2] = dv * AT_VP + (kc >> 1) * 32 + (kc & 1) * 8;   sp[2] = VT + (size_t)(h * 64 + dv) * R + krow0 + kc * 8; sstep[2] = 64; }
    const bool hasK2 = tid < 256;
    u32x4 st[3];
#define AT_GLOADK() do { st[0] = *(const u32x4*)sp[0]; sp[0] += sstep[0]; if (hasK2) { st[1] = *(const u32x4*)sp[1]; sp[1] += sstep[1]; } } while (0)
#define AT_GLOADV() do { st[2] = *(const u32x4*)sp[2]; sp[2] += sstep[2]; } while (0)
#define AT_LSTOREK(buf) do { *(u32x4*)((buf) + lo[0]) = st[0]; if (hasK2) *(u32x4*)((buf) + lo[1]) = st[1]; } while (0)
#define AT_LSTOREV(buf) do { unsigned char* d_ = (buf) + lo[2]; *(u32x2*)d_ = (u32x2){st[2].x, st[2].y}; *(u32x2*)(d_ + 16) = (u32x2){st[2].z, st[2].w}; } while (0)
#define AT_SB() __builtin_amdgcn_sched_barrier(0)
    f32x16 o0, o1, sa0, sa1, sb0, sb1, negm;
#pragma unroll
    for (int r = 0; r < 16; ++r) { o0[r] = 0.f; o1[r] = 0.f; sa0[r] = 0.f; sa1[r] = 0.f; negm[r] = 0.f; }
    float mrun = 0.f, lsum = 0.f;
    __syncthreads();
    AT_GLOADK(); AT_GLOADV(); AT_LSTOREK(lds); AT_LSTOREV(lds + AT_V0);
    AT_GLOADK(); AT_GLOADV(); AT_LSTOREK(lds + AT_KB); AT_LSTOREV(lds + AT_V0 + AT_VBS);
    AT_GLOADK(); AT_LSTOREK(lds + 2 * AT_KB);
    __syncthreads();
    { const unsigned char* ka = lds + l32 * AT_KP + hi * 16;
#pragma unroll
      for (int d0 = 0; d0 < 6; ++d0) { const bf16x8 a0 = *(const bf16x8*)(ka + d0 * 32), a1 = *(const bf16x8*)(ka + 32 * AT_KP + d0 * 32);
          sa0 = __builtin_amdgcn_mfma_f32_32x32x16_bf16(a0, qf[d0], sa0, 0, 0, 0); sa1 = __builtin_amdgcn_mfma_f32_32x32x16_bf16(a1, qf[d0], sa1, 0, 0, 0); } }
#define AT_QKM(SB0, SB1, i) do { if ((i) == 0) SB0 = __builtin_amdgcn_mfma_f32_32x32x16_bf16(kfr[0], qf[0], negm, 0, 0, 0); else if ((i) == 1) SB1 = __builtin_amdgcn_mfma_f32_32x32x16_bf16(kfr[1], qf[0], negm, 0, 0, 0); \
        else if ((i) & 1) SB1 = __builtin_amdgcn_mfma_f32_32x32x16_bf16(kfr[(i)], qf[(i) >> 1], SB1, 0, 0, 0); else SB0 = __builtin_amdgcn_mfma_f32_32x32x16_bf16(kfr[(i)], qf[(i) >> 1], SB0, 0, 0, 0); } while (0)
#define AT_EXS(acc, SA0, SA1, e) do { if ((e) < 16) { SA0[(e) & 15] = __builtin_amdgcn_exp2f(SA0[(e) & 15]); acc += SA0[(e) & 15]; } else { SA1[(e) & 15] = __builtin_amdgcn_exp2f(SA1[(e) & 15]); acc += SA1[(e) & 15]; } } while (0)
#define AT_PACK(dst, S, r0) dst = pack8(S[(r0) + 0], S[(r0) + 1], S[(r0) + 2], S[(r0) + 3], S[(r0) + 4], S[(r0) + 5], S[(r0) + 6], S[(r0) + 7])
#define AT_MAX4(m0, m1, SB0, SB1, r0) do { m0 = __builtin_fmaxf(__builtin_fmaxf(m0, SB0[(r0) + 0]), SB0[(r0) + 1]); m1 = __builtin_fmaxf(__builtin_fmaxf(m1, SB1[(r0) + 0]), SB1[(r0) + 1]); \
        m0 = __builtin_fmaxf(__builtin_fmaxf(m0, SB0[(r0) + 2]), SB0[(r0) + 3]); m1 = __builtin_fmaxf(__builtin_fmaxf(m1, SB1[(r0) + 2]), SB1[(r0) + 3]); } while (0)
#define AT_STEP(SA0, SA1, SB0, SB1, tt) do { \
        const int t_ = (tt); const bool nxt_ = t_ + 1 < NT; \
        const unsigned char* kb_ = lds + ((t_ + 1) & 3) * AT_KB; const unsigned char* vb_ = lds + AT_V0 + (t_ & 3) * AT_VBS; \
        if (t_ + 3 < NT) AT_GLOADK(); \
        if (t_ + 2 < NT) AT_GLOADV(); \
        bf16x8 kfr[12]; bf16x8 vfr[8]; \
        { const unsigned char* ka = kb_ + l32 * AT_KP + hi * 16; \
          _Pragma("unroll") for (int d0 = 0; d0 < 6; ++d0) { kfr[2 * d0] = *(const bf16x8*)(ka + d0 * 32); kfr[2 * d0 + 1] = *(const bf16x8*)(ka + 32 * AT_KP + d0 * 32); } } \
        { const float mx = mxc; \
          if (t_ == 0 || __any(mx > 8.0f)) { \
              const float rm = fmaxf(mx, __shfl_xor(mx, 32)); const float delta = (t_ == 0) ? rm : fmaxf(rm, 0.f); const float alpha = (t_ == 0) ? 1.0f : __builtin_amdgcn_exp2f(-delta); \
              mrun += delta; \
              _Pragma("unroll") for (int r = 0; r < 16; ++r) { SA0[r] -= delta; SA1[r] -= delta; o0[r] *= alpha; o1[r] *= alpha; } \
              lsum *= alpha; { const float nm = -mrun; _Pragma("unroll") for (int r = 0; r < 16; ++r) negm[r] = nm; } } } \
        float ls0 = 0.f, ls1 = 0.f; \
        AT_SB(); __builtin_amdgcn_s_setprio(1); \
          \
        _Pragma("unroll") for (int i = 0; i < 8; ++i) { \
            AT_QKM(SB0, SB1, i); \
            _Pragma("unroll") for (int k_ = 0; k_ < 3; ++k_) { const int e_ = 3 * i + k_; if (e_ < 16) { SA0[e_ & 15] = __builtin_amdgcn_exp2f(SA0[e_ & 15]); asm volatile("" : "+v"(SA0[e_ & 15])); } else { SA1[e_ & 15] = __builtin_amdgcn_exp2f(SA1[e_ & 15]); asm volatile("" : "+v"(SA1[e_ & 15])); } } \
            AT_SB(); } \
        { const unsigned char* va = vb_ + l32 * AT_VP + hi * 16; \
          _Pragma("unroll") for (int kj = 0; kj < 4; ++kj) { vfr[2 * kj] = *(const bf16x8*)(va + kj * 32); vfr[2 * kj + 1] = *(const bf16x8*)(va + 32 * AT_VP + kj * 32); } } \
        bf16x8 pb[4]; \
        _Pragma("unroll") for (int i = 8; i < 12; ++i) { \
            AT_QKM(SB0, SB1, i); \
            _Pragma("unroll") for (int k_ = 0; k_ < 2; ++k_) { const int e_ = 24 + 2 * (i - 8) + k_; SA1[e_ & 15] = __builtin_amdgcn_exp2f(SA1[e_ & 15]); asm volatile("" : "+v"(SA1[e_ & 15])); } \
            if (i == 9) { AT_PACK(pb[0], SA0, 0); asm volatile("" : "+v"(pb[0])); } \
            if (i == 11) { AT_PACK(pb[1], SA0, 8); asm volatile("" : "+v"(pb[1])); } \
            AT_SB(); } \
        float mq0 = SB0[0], mq1 = SB1[0]; __builtin_amdgcn_s_setprio(2); \
        _Pragma("unroll") for (int kj = 0; kj < 4; ++kj) { \
            o0 = __builtin_amdgcn_mfma_f32_32x32x16_bf16(vfr[2 * kj], pb[kj], o0, 0, 0, 0); o1 = __builtin_amdgcn_mfma_f32_32x32x16_bf16(vfr[2 * kj + 1], pb[kj], o1, 0, 0, 0); \
            if (kj == 0) { AT_PACK(pb[2], SA1, 0); asm volatile("" : "+v"(pb[2])); } \
            if (kj == 1) { AT_PACK(pb[3], SA1, 8); asm volatile("" : "+v"(pb[3])); } \
            if (kj == 2) { if (t_ + 3 < NT) AT_LSTOREK(lds + ((t_ + 3) & 3) * AT_KB); if (t_ + 2 < NT) AT_LSTOREV(lds + AT_V0 + ((t_ + 2) & 3) * AT_VBS); }     \
            _Pragma("unroll") for (int r_ = 0; r_ < 4; ++r_) { ls0 += SA0[4 * kj + r_]; ls1 += SA1[4 * kj + r_]; } \
            mq0 = __builtin_fmaxf(__builtin_fmaxf(mq0, SB0[4 * kj]), SB0[4 * kj + 1]); mq1 = __builtin_fmaxf(__builtin_fmaxf(mq1, SB1[4 * kj]), SB1[4 * kj + 1]); \
            mq0 = __builtin_fmaxf(__builtin_fmaxf(mq0, SB0[4 * kj + 2]), SB0[4 * kj + 3]); mq1 = __builtin_fmaxf(__builtin_fmaxf(mq1, SB1[4 * kj + 2]), SB1[4 * kj + 3]); \
            asm volatile("" : "+v"(mq0), "+v"(mq1), "+v"(ls0), "+v"(ls1)); AT_SB(); } \
        lsum += ls0 + ls1; \
        __builtin_amdgcn_s_setprio(0); mxc = __builtin_fmaxf(mq0, mq1);            \
        if (t_ & 1) __syncthreads(); \
    } while (0)
    float mxc = at_max32(sa0, sa1);
    for (int t = 0; t < NT; t += 2) { AT_STEP(sa0, sa1, sb0, sb1, t); AT_STEP(sb0, sb1, sa0, sa1, t + 1); }
    lsum += __shfl_xor(lsum, 32);
    const float inv = 1.0f / lsum;
    bf16_t* op = MIX + (size_t)qrow * 1024 + 256 + h * 64 + 4 * hi;
#pragma unroll
    for (int g4 = 0; g4 < 4; ++g4) { u32x2 w0, w1; w0.x = pk2(o0[4 * g4] * inv, o0[4 * g4 + 1] * inv); w0.y = pk2(o0[4 * g4 + 2] * inv, o0[4 * g4 + 3] * inv);
        w1.x = pk2(o1[4 * g4] * inv, o1[4 * g4 + 1] * inv); w1.y = pk2(o1[4 * g4 + 2] * inv, o1[4 * g4 + 3] * inv);
        *(u32x2*)(op + 8 * g4) = w0; *(u32x2*)(op + 32 + 8 * g4) = w1; }
#undef AT_GLOADK
#undef AT_GLOADV
#undef AT_LSTOREK
#undef AT_LSTOREV
#undef AT_STEP
#undef AT_QKM
#undef AT_EXS
#undef AT_PACK
#undef AT_MAX4
#undef AT_SB
}

constexpr int RT_VP = 264, RT_SP = 144, RT_VB = 2 * 64 * RT_VP;
DEV void retout_unit(const Params& p, int l, unsigned char* lds, int u, bool early) {
    const int tid = otid(), lane = tid & 63, wid = tid >> 6, l32 = lane & 31, hi = lane >> 5;
    const int gc = u >> 1, hp = u & 1; const int cb = gc % 66; const bool lat = cb >= 2; const int t0 = (cb - 2) * 128; const int r0 = gc * 128;
    const bf16_t* P = (const bf16_t*)p.out; bf16_t* MIX = (bf16_t*)(p.ws + OFF_HN); const f32x2* rope = (const f32x2*)(p.ws + OFF_ROPE);
    const float* SIN = (const float*)(p.ws + OFF_OV + OV_SIN);
    bf16_t* VTl = (bf16_t*)lds; bf16_t* STl = (bf16_t*)(lds + RT_VB);
    __syncthreads();
    for (int task = tid; task < 2048; task += NWG_T) { const int hh = task >> 10, key = (task >> 3) & 127, ch = task & 7;
        const bf16x8 v = *(const bf16x8*)(P + (size_t)(r0 + key) * INW + 256 + (2 * hp + hh) * 64 + ch * 8);
#pragma unroll
        for (int j = 0; j < 8; ++j) VTl[(hh * 64 + ch * 8 + j) * (RT_VP / 2) + key] = (bf16_t)v[j]; }
    for (int task = tid; task < 8192; task += NWG_T) { const int dv = task & 63, k = (task >> 6) & 31, dir = (task >> 11) & 1, hh = task >> 12;
        float sv;
        if (!early) sv = SIN[((size_t)(gc * 4 + 2 * hp + hh) * 2 + dir) * 2048 + k * 64 + dv];
        else { const int og = dir == 0 ? gc - 1 : gc + 1; const bool zero = dir == 0 ? (cb == 0) : (cb == 1);
               sv = zero ? 0.f : ((const float*)(p.ws + OFF_OV + OV_SLOC))[((size_t)(og * 4 + 2 * hp + hh) * 2 + dir) * 2048 + k * 64 + dv]; }
        STl[(hh * 64 + dv) * (RT_SP / 2) + dir * 32 + k] = (bf16_t)f2bf(sv); }
    __syncthreads();
    const int hh = wid >> 2, h = 2 * hp + hh, qblk = wid & 3; const int n = 32 * qblk + l32; const int rq = r0 + n;
    const float lf = log2_sigmoid(p.ret_decay_f[l * 4 + h]), lb = log2_sigmoid(p.ret_decay_b[l * 4 + h]);
    float qv0[8], qv1[8]; bf16x8 qf0, qf1;
    { const bf16_t* qp = P + (size_t)rq * INW + h * 32 + 8 * hi; const bf16x8 a = *(const bf16x8*)qp, c2 = *(const bf16x8*)(qp + 16);
#pragma unroll
      for (int j = 0; j < 8; ++j) { float x1 = bf2f((unsigned short)a[j]), x2 = bf2f((unsigned short)c2[j]);
          if (lat) { const f32x2 cs = rope[(size_t)(t0 + n) * 16 + 8 * hi + j]; const float y1 = x1 * cs.x - x2 * cs.y, y2 = x2 * cs.x + x1 * cs.y; x1 = y1; x2 = y2; }
          qv0[j] = x1; qv1[j] = x2; }
      qf0 = pack8(qv0[0], qv0[1], qv0[2], qv0[3], qv0[4], qv0[5], qv0[6], qv0[7]); qf1 = pack8(qv1[0], qv1[1], qv1[2], qv1[3], qv1[4], qv1[5], qv1[6], qv1[7]); }
    f32x16 o0, o1;
#pragma unroll
    for (int r = 0; r < 16; ++r) { o0[r] = 0.f; o1[r] = 0.f; }
    const unsigned char* vbase = (const unsigned char*)VTl + (size_t)(hh * 64 + l32) * RT_VP + hi * 8;
    bf16x8 kga[4], kgc[4];
#pragma unroll
    for (int kb = 0; kb < 4; ++kb) { const bf16_t* kp = P + (size_t)(r0 + 32 * kb + l32) * INW + 128 + h * 32 + 8 * hi; kga[kb] = *(const bf16x8*)kp; kgc[kb] = *(const bf16x8*)(kp + 16); }
    __builtin_amdgcn_sched_barrier(0);
#pragma unroll
    for (int kb = 0; kb < 4; ++kb) {
        bf16x8 kf0, kf1;
        { const int key = 32 * kb + l32; const bf16x8 a = kga[kb], c2 = kgc[kb];
          float y1[8], y2[8];
#pragma unroll
          for (int j = 0; j < 8; ++j) { float x1 = bf2f((unsigned short)a[j]), x2 = bf2f((unsigned short)c2[j]);
              if (lat) { const f32x2 cs = rope[(size_t)(t0 + key) * 16 + 8 * hi + j]; const float z1 = x1 * cs.x - x2 * cs.y, z2 = x2 * cs.x + x1 * cs.y; x1 = z1; x2 = z2; }
              y1[j] = x1 * 0.17677669529663687f; y2[j] = x2 * 0.17677669529663687f; }
          kf0 = pack8(y1[0], y1[1], y1[2], y1[3], y1[4], y1[5], y1[6], y1[7]); kf1 = pack8(y2[0], y2[1], y2[2], y2[3], y2[4], y2[5], y2[6], y2[7]); }
        f32x16 s;
#pragma unroll
        for (int r = 0; r < 16; ++r) s[r] = 0.f;
        s = __builtin_amdgcn_mfma_f32_32x32x16_bf16(kf0, qf0, s, 0, 0, 0); s = __builtin_amdgcn_mfma_f32_32x32x16_bf16(kf1, qf1, s, 0, 0, 0);
#pragma unroll
        for (int r = 0; r < 16; ++r) { const int m = 32 * kb + crow(r, hi); const int dl = n - m; const float e = dl >= 0 ? lf * (float)dl : lb * (float)(-dl); s[r] *= __builtin_amdgcn_exp2f(e); }
#pragma unroll
        for (int jp = 0; jp < 2; ++jp) { const bf16x8 pb = pack8(s[8 * jp + 0], s[8 * jp + 1], s[8 * jp + 2], s[8 * jp + 3], s[8 * jp + 4], s[8 * jp + 5], s[8 * jp + 6], s[8 * jp + 7]);
            const unsigned char* vp = vbase + (32 * kb + 16 * jp) * 2;
            const u32x2 a00 = *(const u32x2*)vp, a01 = *(const u32x2*)(vp + 16), a10 = *(const u32x2*)(vp + 32 * RT_VP), a11 = *(const u32x2*)(vp + 32 * RT_VP + 16);
            const bf16x8 A0 = __builtin_bit_cast(bf16x8, (u32x4){a00.x, a00.y, a01.x, a01.y}), A1 = __builtin_bit_cast(bf16x8, (u32x4){a10.x, a10.y, a11.x, a11.y});
            o0 = __builtin_amdgcn_mfma_f32_32x32x16_bf16(A0, pb, o0, 0, 0, 0); o1 = __builtin_amdgcn_mfma_f32_32x32x16_bf16(A1, pb, o1, 0, 0, 0); }
    }
    { const float df = __builtin_amdgcn_exp2f(lf * (float)(n + 1)), db = __builtin_amdgcn_exp2f(lb * (float)(128 - n));
      const unsigned char* sbase = (const unsigned char*)STl + (size_t)(hh * 64 + l32) * RT_SP + hi * 16;
#pragma unroll
      for (int ks = 0; ks < 4; ++ks) { const float dd = ks < 2 ? df : db;
          const bf16x8 qb = (ks & 1) ? pack8(qv1[0] * dd, qv1[1] * dd, qv1[2] * dd, qv1[3] * dd, qv1[4] * dd, qv1[5] * dd, qv1[6] * dd, qv1[7] * dd)
                                     : pack8(qv0[0] * dd, qv0[1] * dd, qv0[2] * dd, qv0[3] * dd, qv0[4] * dd, qv0[5] * dd, qv0[6] * dd, qv0[7] * dd);
          const bf16x8 A0 = *(const bf16x8*)(sbase + ks * 32), A1 = *(const bf16x8*)(sbase + 32 * RT_SP + ks * 32);
          o0 = __builtin_amdgcn_mfma_f32_32x32x16_bf16(A0, qb, o0, 0, 0, 0); o1 = __builtin_amdgcn_mfma_f32_32x32x16_bf16(A1, qb, o1, 0, 0, 0); } }
    float ssq = 0.f;
#pragma unroll
    for (int r = 0; r < 16; ++r) ssq += o0[r] * o0[r] + o1[r] * o1[r];
    ssq += __shfl_xor(ssq, 32);
    const float rstd = rsqrtf(ssq * (1.f / 64.f) + EPS);
    const bf16_t* gp = P + (size_t)rq * INW + 512 + h * 64 + 4 * hi; bf16_t* op = MIX + (size_t)rq * 1024 + h * 64 + 4 * hi;
#pragma unroll
    for (int g4 = 0; g4 < 4; ++g4) { const u32x2 ga = *(const u32x2*)(gp + 8 * g4), gb = *(const u32x2*)(gp + 32 + 8 * g4);
        u32x2 w0, w1;
        w0.x = pk2(o0[4 * g4] * rstd * siluf(bf2f(ga.x & 0xffff)), o0[4 * g4 + 1] * rstd * siluf(bf2f(ga.x >> 16))); w0.y = pk2(o0[4 * g4 + 2] * rstd * siluf(bf2f(ga.y & 0xffff)), o0[4 * g4 + 3] * rstd * siluf(bf2f(ga.y >> 16)));
        w1.x = pk2(o1[4 * g4] * rstd * siluf(bf2f(gb.x & 0xffff)), o1[4 * g4 + 1] * rstd * siluf(bf2f(gb.x >> 16))); w1.y = pk2(o1[4 * g4 + 2] * rstd * siluf(bf2f(gb.y & 0xffff)), o1[4 * g4 + 3] * rstd * siluf(bf2f(gb.y >> 16)));
        *(u32x2*)(op + 8 * g4) = w0; *(u32x2*)(op + 32 + 8 * g4) = w1; }
}

DEV void phase_ffn_fixup(const Params& p, int l) {
    const float* EDGE = (const float*)(p.ws + OFF_EDGE); bf16_t* ACT = (bf16_t*)(p.ws + OFF_OV);
    const float* cw = p.conv_w + (size_t)l * 3 * 5632; const float* cbv = p.conv_b + (size_t)l * 5632;
    for (int idx = blockIdx.x * NWG_T + otid(); idx < 66 * 2 * 704; idx += gridDim.x * NWG_T) {
        const int ch4 = idx % 704, rest = idx / 704; const int which = rest & 1, pm = rest >> 1; const int jj = pm % 33;
        if (l == 1 && jj == 0) continue;
        const int ch = 4 * ch4, pn = ch >> 7, c = ch & 127;
        const bool sstart = jj <= 1, send = (jj == 0) || (jj == 32);
        const f32x4 zz = {0.f, 0.f, 0.f, 0.f};
#define EDG(tile, k, half) (*(const f32x4*)(EDGE + ((size_t)((tile) * 4 + (k)) * 22 + pn) * 256 + (half) * 128 + c))
        f32x4 ua, ub, ca, cb2, da, db;
        if (which == 0) { ua = sstart ? zz : EDG(pm - 1, 3, 0); ub = sstart ? zz : EDG(pm - 1, 3, 1); ca = EDG(pm, 0, 0); cb2 = EDG(pm, 0, 1); da = EDG(pm, 1, 0); db = EDG(pm, 1, 1); }
        else { ua = EDG(pm, 2, 0); ub = EDG(pm, 2, 1); ca = EDG(pm, 3, 0); cb2 = EDG(pm, 3, 1); da = send ? zz : EDG(pm + 1, 0, 0); db = send ? zz : EDG(pm + 1, 0, 1); }
#undef EDG
        const f32x4 wa0 = *(const f32x4*)(cw + ch), wa1 = *(const f32x4*)(cw + 5632 + ch), wa2 = *(const f32x4*)(cw + 2 * 5632 + ch), ba = *(const f32x4*)(cbv + ch);
        const f32x4 wb0 = *(const f32x4*)(cw + DFF + ch), wb1 = *(const f32x4*)(cw + 5632 + DFF + ch), wb2 = *(const f32x4*)(cw + 2 * 5632 + DFF + ch), bb = *(const f32x4*)(cbv + DFF + ch);
        const f32x4 xa = wa0 * ua + wa1 * ca + wa2 * da + ba, xb = wb0 * ub + wb1 * cb2 + wb2 * db + bb;
        u32x2 w; w.x = pk2(siluf(xa.x) * xb.x, siluf(xa.y) * xb.y); w.y = pk2(siluf(xa.z) * xb.z, siluf(xa.w) * xb.w);
        *(u32x2*)(ACT + (size_t)(pm * 256 + (which ? 255 : 0)) * DFF + ch) = w;
    }
}

#define RLX_AGENT __ATOMIC_RELAXED, __HIP_MEMORY_SCOPE_AGENT
#define XB_TMO      128
#define XB_XCNT(j)  (256  + 64 * (j))
#define XB_XSUB(j)  (1280 + 64 * (j))
#define XB_XGEN(j)  (2304 + 64 * (j))
#define XB_TOP      3328
#define XB_TOPGEN   3392
#define XCD_BAR_WORDS 3456
#define XB_SPIN_CAP (1u << 18)

__device__ __forceinline__ unsigned xb_ld(unsigned* p)              { return __hip_atomic_load(p, __ATOMIC_RELAXED, __HIP_MEMORY_SCOPE_AGENT); }
__device__ __forceinline__ unsigned xb_add(unsigned* p, unsigned v) { return __hip_atomic_fetch_add(p, v, __ATOMIC_RELAXED, __HIP_MEMORY_SCOPE_AGENT); }
__device__ __forceinline__ unsigned xb_xcc_id() { return (unsigned)__builtin_amdgcn_s_getreg((3 << 11) | 20) & 0xFu; }
#define XB_SPIN(cond, bar) do { unsigned _sp = 0; while (cond) { __builtin_amdgcn_s_sleep(1); \
    if ((++_sp & 255u) == 0u) { if (xb_ld(&(bar)[XB_TMO])) break; if (_sp > XB_SPIN_CAP) { atomicAdd(&(bar)[XB_TMO], 1u); break; } } } } while (0)

struct XcdBarrier {
    unsigned* bar; unsigned x;
    volatile LAS unsigned* st;
};

__device__ __forceinline__ XcdBarrier xcd_barrier_post(unsigned* bar, volatile LAS unsigned* st) {
    XcdBarrier b; b.bar = bar; b.x = xb_xcc_id(); b.st = st;
    if (threadIdx.x == 0) (void)xb_add(&bar[XB_XCNT(b.x)], 1u);
    return b;
}
__device__ __forceinline__ void xcd_barrier_complete(unsigned* bar, unsigned x, unsigned& nloc, unsigned& nx) {
    const unsigned G = gridDim.x * gridDim.y * gridDim.z;
    unsigned sum, cnt, mine, sp = 0u;
    for (;;) {
        sum = 0u; cnt = 0u; mine = 0u;
#pragma unroll
        for (unsigned j = 0; j < 16; ++j) { const unsigned c = xb_ld(&bar[XB_XCNT(j)]); sum += c; cnt += (c > 0u) ? 1u : 0u; mine = (j == x) ? c : mine; }
        if (sum == G) break;
        __builtin_amdgcn_s_sleep(1);
        if ((++sp & 255u) == 0u) { if (xb_ld(&bar[XB_TMO])) break; if (sp > XB_SPIN_CAP) { atomicAdd(&bar[XB_TMO], 1u); break; } }
    }
    nloc = mine > 0u ? mine : 1u; nx = cnt > 0u ? cnt : 1u;
}

__device__ __forceinline__ void xcd_barrier(const XcdBarrier& b) {
    asm volatile("s_waitcnt vmcnt(0)" ::: "memory");
    __syncthreads();
    if (threadIdx.x == 0) {
        unsigned* bar = b.bar;
        __builtin_amdgcn_s_waitcnt(0);
        unsigned nloc = b.st[0], nx = b.st[1];
        if (nloc == 0u) { xcd_barrier_complete(bar, b.x, nloc, nx); b.st[0] = nloc; b.st[1] = nx; }
        const unsigned old = xb_add(&bar[XB_XSUB(b.x)], 1u);
        const unsigned gen = old / nloc;
        if (old + 1u == (gen + 1u) * nloc) {
            __builtin_amdgcn_fence(__ATOMIC_RELEASE, "agent");
            asm volatile("s_waitcnt vmcnt(0)" ::: "memory");
            const unsigned og = xb_add(&bar[XB_TOP], 1u);
            const unsigned tg = og / nx;
            if (og + 1u == (tg + 1u) * nx) xb_add(&bar[XB_TOPGEN], 1u);
            else XB_SPIN(xb_ld(&bar[XB_TOPGEN]) == tg, bar);
            __builtin_amdgcn_fence(__ATOMIC_ACQUIRE, "agent");
            xb_add(&bar[XB_XGEN(b.x)], 1u);
            asm volatile("s_waitcnt vmcnt(0)" ::: "memory");
        } else {
            XB_SPIN(xb_ld(&bar[XB_XGEN(b.x)]) == gen, bar);
            __builtin_amdgcn_fence(__ATOMIC_ACQUIRE, "agent");
            asm volatile("s_waitcnt vmcnt(0)" ::: "memory");
        }
    }
    __syncthreads();
}


constexpr size_t OFF_CTL = 250000128; constexpr int CTL_BYTES = 16384;
#if defined(__HIP_DEVICE_COMPILE__)
#define KP() const __attribute__((address_space(4))) Params* kp_ = (const __attribute__((address_space(4))) Params*)__builtin_amdgcn_kernarg_segment_ptr(); asm volatile("" : "+s"(kp_)); const Params p = *kp_; \
    bf16_t* HN = (bf16_t*)(p.ws + OFF_HN); bf16_t* P = (bf16_t*)p.out; float* X = (float*)(p.ws + OFF_X); (void)HN; (void)P; (void)X
#else
#define KP() const Params p = p_arg; bf16_t* HN = (bf16_t*)(p.ws + OFF_HN); bf16_t* P = (bf16_t*)p.out; float* X = (float*)(p.ws + OFF_X); (void)HN; (void)P; (void)X
#endif
#define WL() const bf16_t* wl = (const bf16_t*)(p.ws + OFF_W) + (size_t)l * W_LAYER; const float* modv = (const float*)(p.ws + OFF_MOD) + (size_t)l * 3 * 6144; (void)wl; (void)modv
#ifndef DUPM
#define DUPM 0
#endif
#define REP(bit) for (int rep_ = 0; rep_ < (((DUPM) >> (bit)) & 1) + 1; ++rep_)
constexpr int PH_PER_LAYER = 10, N_PHASES = 2 + 2 * PH_PER_LAYER;
__global__ void __launch_bounds__(512, 2) mk_fwd(Params p_arg) {
    extern __shared__ __attribute__((aligned(16))) unsigned char lds[];
    cg::grid_group grid = cg::this_grid();
    const int G = gridDim.x, bx = blockIdx.x; const int vcu = (G % 8 == 0) ? (bx % 8) * (G / 8) + bx / 8 : bx;
    LAS unsigned char* ldsl = (LAS unsigned char*)lds;
    const int ph_lo = p_arg.ph_lo, ph_hi = p_arg.ph_hi;
    volatile LAS unsigned* misc = (volatile LAS unsigned*)(ldsl + (LDS_BYTES - 64));
    { const int t0_ = otid(); if (t0_ < 16) misc[t0_] = 0u; }
    __syncthreads();
    if (ph_hi - ph_lo > 1) (void)xcd_barrier_post((unsigned*)(p_arg.ws + OFF_CTL), misc);
    for (int ph = ph_lo; ph < ph_hi; ++ph) {
        if (ph == 0) { KP(); phase_prep(p, lds); __syncthreads(); }
        else if (ph == N_PHASES - 1) { KP(); phase_final(p);
#if (DUPM >> 10) & 1
            for (int i = 0; i < 20; ++i) grid.sync();
#endif
        }
        else {
            const int l = (ph - 1) / PH_PER_LAYER, sp = (ph - 1) % PH_PER_LAYER;
            if (sp == 0) { KP(); if (l == 0) REP(9) { phase_prep_weights(p, lds); __syncthreads(); }
                phase_norm(p, l, 0, l == 0, l == 1 ? (const float*)(p.ws + OFF_MOD) + 2 * 6144 + 5120 : nullptr); }
            else if (sp == 1) { KP(); WL(); REP(1) { __syncthreads();
                pg8::Gemm g{HN, wl + W_IN, R, 1792, 1024, 1024, 1024}; pg8::StaticOrder S; S.init(R, 1792, G, bx);
                pg8::EpiStore E{P, INW, INW, 1.0f};
                pg8::gemm_phase<pg8::EpiStore, pg8::StaticOrder, true, true>(ldsl, g, S, E); } }
            else if (sp == 2) { KP(); phase_rowwise(p, l); __syncthreads();
                REP(2) phase_pool(p);
                REP(3) for (int it = G - 1 - bx; it < 264; it += G) states_item(p, l, lds, it); __syncthreads(); }
            else if (sp == 3) { KP(); WL(); REP(4) { __syncthreads();
                { pg8::Gemm g{P + 768, wl + W_UQ, R, 768, 384, INW, 384}; pg8::StaticOrder S; S.init(R, 768, G, bx);
                  pg8::EpiStore E{(bf16_t*)(p.ws + OFF_OV + OV_Q), 768, 768, 0.14724444f};
                  pg8::gemm_phase<pg8::EpiStore, pg8::StaticOrder, true, true>(ldsl, g, S, E); }
                __syncthreads();
                { pg8::Gemm g{P + 1152, wl + W_KN, R, 512, 256, INW, 256}; pg8::StaticOrder S; S.init(R, 512, G, (bx + 58) % G);
                  pg8::EpiStore E{(bf16_t*)(p.ws + OFF_OV + OV_KN), 512, 512, 1.0f};
                  pg8::gemm_phase<pg8::EpiStore, pg8::StaticOrder, true, true>(ldsl, g, S, E); }
                __syncthreads();
                { pg8::Gemm g{wl + W_V, P + 1152, 512, R, 256, 256, INW}; pg8::StaticOrder S; S.init(512, R, G, (bx + 182) % G);
                  pg8::EpiStore E{(bf16_t*)(p.ws + OFF_OV + OV_VT), R, R, 1.0f};
                  pg8::gemm_phase<pg8::EpiStore, pg8::StaticOrder, true, true>(ldsl, g, S, E); }
                if (bx >= G - 64) scan_threads(p, l, (bx - (G - 64)) * NWG_T + otid());
                if (l == 0 && bx >= G - 50 && bx < G - 42) { const int i8 = bx - (G - 50); const int gcs = (i8 >> 1) < 2 ? (i8 >> 1) : 64 + (i8 >> 1); retout_unit(p, l, lds, gcs * 2 + (i8 & 1), true); } } }
            else if (sp == 4) { KP();
                REP(5) for (int u = vcu; u < (l == 0 ? 528 : 512); u += G) attn_unit(p, lds, u);
                REP(6) for (int u = G - 1 - bx; u < 256; u += G) retout_unit(p, l, lds, u + 4 * (u >> 7) + 4, false); }
            else if (sp == 5) { KP(); WL(); __syncthreads();
                { pg8::Gemm g{HN, wl + W_OUT, R, 1024, 1024, 1024, 1024}; pg8::StaticOrder S; S.init(16384, 1024, G, bx, 1);
                  pg8::EpiResid E{X, modv + 2048, 0};
                  pg8::gemm_phase<pg8::EpiResid, pg8::StaticOrder, true, true>(ldsl, g, S, E); }
                if (l == 0 && bx < 32) { __syncthreads(); const int q = bx >> 3;
                  pg8::Gemm g{HN + q * 256, wl + W_OUT + q * 256, 512, 1024, 256, 1024, 1024}; pg8::StaticOrder S; S.init(512, 1024, G, bx & 7, 2);
                  pg8::EpiPart E{(float*)(p.ws + OFF_PART) + (size_t)q * 524288, 0};
                  pg8::gemm_phase<pg8::EpiPart, pg8::StaticOrder, true, true>(ldsl, g, S, E); } }
            else if (sp == 6) { KP(); WL(); phase_norm(p, l, 1, false, l == 0 ? modv + 2 * 6144 + 2048 : nullptr); }
            else if (sp == 7) { KP(); WL(); REP(7) { __syncthreads();
                pg8::Gemm g{HN, wl + W_UP, R, 2 * DFF, 1024, 1024, 1024}; pg8::StaticOrder S; S.init(l == 1 ? 16384 : R, 2 * DFF, G, bx, l == 1 ? 1 : 0);
                pg8::EpiFfn E{(bf16_t*)(p.ws + OFF_OV), (float*)(p.ws + OFF_EDGE), p.conv_w + (size_t)l * 3 * 5632, p.conv_b + (size_t)l * 5632, (LAS float*)(ldsl + 131072)};
                pg8::gemm_phase<pg8::EpiFfn, pg8::StaticOrder, true, true>(ldsl, g, S, E); } }
            else if (sp == 8) { KP(); REP(8) phase_ffn_fixup(p, l); }
            else if (sp == 9) { KP(); WL(); __syncthreads();
                { pg8::Gemm g{(const bf16_t*)(p.ws + OFF_OV), wl + W_DN, R, 1024, DFF, DFF, DFF}; pg8::StaticOrder S; S.init(16384, 1024, G, bx, 1);
                  pg8::EpiResid E{X, modv + 5120, 0};
                  pg8::gemm_phase<pg8::EpiResid, pg8::StaticOrder, true, true>(ldsl, g, S, E); }
                if (l == 0 && bx < 32) { __syncthreads(); const int q = bx >> 3; const int koff = q < 2 ? q * 768 : 1536 + (q - 2) * 640, klen = q < 2 ? 768 : 640;
                  pg8::Gemm g{(const bf16_t*)(p.ws + OFF_OV) + koff, wl + W_DN + koff, 512, 1024, klen, DFF, DFF}; pg8::StaticOrder S; S.init(512, 1024, G, bx & 7, 2);
                  pg8::EpiPart E{(float*)(p.ws + OFF_PART) + (size_t)q * 524288, 0};
                  pg8::gemm_phase<pg8::EpiPart, pg8::StaticOrder, true, true>(ldsl, g, S, E); } }
        }
        if (ph + 1 < ph_hi) {
            if (ph_lo < 0) grid.sync();
            { KP(); XcdBarrier b; b.bar = (unsigned*)(p.ws + OFF_CTL); b.x = xb_xcc_id(); b.st = misc; xcd_barrier(b); }
        }
    }
}

extern "C" void kernel_launch(void* const* d_in, const int* in_sizes, int n_in, void* d_out, int out_size, void* d_ws, size_t ws_size, hipStream_t stream) {
    static int grid = 0;
    if (grid == 0) {
        if (n_in != 23 || ws_size < WS_NEED) { fprintf(stderr, "kernel_launch: unexpected problem (n_in %d, ws %zu, need %zu)\n", n_in, ws_size, (size_t)WS_NEED); grid = -1; return; }
        int dev = 0, cus = 0, per_cu = 0;
        hipGetDevice(&dev); hipDeviceGetAttribute(&cus, hipDeviceAttributeMultiprocessorCount, dev);
        if (hipFuncSetAttribute((const void*)mk_fwd, hipFuncAttributeMaxDynamicSharedMemorySize, LDS_BYTES) != hipSuccess) { fprintf(stderr, "kernel_launch: hipFuncSetAttribute failed\n"); grid = -1; return; }
        if (hipOccupancyMaxActiveBlocksPerMultiprocessor(&per_cu, (const void*)mk_fwd, 512, LDS_BYTES) != hipSuccess || per_cu < 1) { fprintf(stderr, "kernel_launch: occupancy query says %d\n", per_cu); per_cu = 1; }
        (void)hipGetLastError();
        grid = cus * per_cu; if (grid > 256) grid = 256;
        fprintf(stderr, "kernel_launch: grid %d (cus %d, per_cu %d)\n", grid, cus, per_cu);
    }
    if (grid < 0) return;
    Params p{};
    const float** pp = (const float**)&p;
    for (int i = 0; i < 23; ++i) pp[i] = (const float*)d_in[i];
    p.out = (float*)d_out; p.ws = (unsigned char*)d_ws;
#if MK_MULTI
    for (int ph = 0; ph < N_PHASES; ++ph) { p.ph_lo = ph; p.ph_hi = ph + 1; void* args[] = {&p};
        hipError_t e = hipLaunchCooperativeKernel((void*)mk_fwd, dim3(grid), dim3(512), args, LDS_BYTES, stream);
        if (e != hipSuccess) { fprintf(stderr, "launch %d failed: %s\n", ph, hipGetErrorString(e)); break; } }
#else
    if (hipMemsetAsync((char*)d_ws + OFF_CTL, 0, CTL_BYTES, stream) != hipSuccess) { fprintf(stderr, "kernel_launch: memset of the barrier words failed\n"); return; }
    p.ph_lo = 0; p.ph_hi = N_PHASES; void* args[] = {&p};
    hipError_t e = hipLaunchCooperativeKernel((void*)mk_fwd, dim3(grid), dim3(512), args, LDS_BYTES, stream);
    if (e != hipSuccess) fprintf(stderr, "cooperative launch failed: %s (grid %d)\n", hipGetErrorString(e), grid);
#endif
}
```

```cpp
#include <hip/hip_runtime.h>
#include <hip/hip_cooperative_groups.h>
#include <cstdio>
#include <cstdint>
namespace cg = cooperative_groups;

#ifndef MK_MULTI
#define MK_MULTI 0
#endif

namespace pg8 {
#define PG8_LAS __attribute__((address_space(3)))
typedef unsigned short bf16_t;
typedef short bf16x8 __attribute__((ext_vector_type(8)));
typedef float f32x4 __attribute__((ext_vector_type(4)));
typedef unsigned u32x4 __attribute__((ext_vector_type(4)));
constexpr int BM = 256, BK = 64, HALF = 128, HTB = HALF * BK * 2  , STAGE_BYTES = 8 * HTB, NXCD = 8, WGM = 8;

__host__ __device__ __forceinline__ int lds_byte(int r, int c) { const int st = (r >> 4) * 2 + (c >> 5), rr = r & 15, cc = c & 31, ob = rr * 64 + cc * 2; return st * 1024 + (ob ^ (((ob >> 9) & 1) << 5)); }
__host__ __device__ __forceinline__ void stage_rc(int b, int& R, int& C) { const int st = b / 1024, sb = b % 1024, swz = sb ^ (((sb >> 9) & 1) << 5); R = (st >> 1) * 16 + swz / 64; C = (st & 1) * 32 + (swz % 64) / 2; }
__host__ __device__ __forceinline__ int perm32(int rho) { const int n = rho >> 4, i = rho & 15; return 8 * (i >> 2) + 4 * n + (i & 3); }

struct Unit { int pm, pn; };
struct Gemm { const bf16_t* A; const bf16_t* Bt; int M, N, K, lda, ldb; };

struct StaticOrder {
    int nM, nN, nwg, G, c, skip;
    __host__ __device__ void init(int M, int N, int G_, int c_, int skip_ = 0) { nM = M / BM; nN = N / BM; nwg = nM * nN; G = G_; c = c_; skip = skip_; }
    __host__ __device__ bool next(int i, Unit& u) const {
        const long L = (long)i * G + c; if (L >= nwg) return false;
        int wgid = (int)L; { const int q = nwg / NXCD, r = nwg % NXCD, xcd = wgid % NXCD, off = wgid / NXCD; wgid = (xcd < r ? xcd * (q + 1) : r * (q + 1) + (xcd - r) * q) + off; }
        const int nig = WGM * nN, gid = wgid / nig, fm = gid * WGM, gsz = (nM - fm) < WGM ? (nM - fm) : WGM;
        u.pm = fm + ((wgid % nig) % gsz); u.pn = (wgid % nig) / gsz; if (skip == 1) u.pm += 1 + (u.pm >= 32 ? 1 : 0); else if (skip == 2) u.pm *= 33; return true;
    }
    __device__ __forceinline__ void a_ready(const Unit&) const {}
    __device__ __forceinline__ void done(const Unit&) const {}
};

__device__ __forceinline__ unsigned cvt_pk_bf16(float lo, float hi) { unsigned r; asm volatile("v_cvt_pk_bf16_f32 %0, %1, %2" : "=v"(r) : "v"(lo), "v"(hi)); return r; }

struct EpiStore {
    static constexpr bool PERM = true, AFTER_DRAIN = false, APERM = false;
    bf16_t* O; int ldc; int ncols; float scale;
    __device__ __forceinline__ void operator()(const f32x4 (&acc)[2][2][4][2], const Unit& u, int wr, int wc, int fr, int fq) const {
        const int row0 = u.pm * BM + wr * 64 + fr; const int col0 = u.pn * BM + wc * 32 + 8 * fq;
#pragma unroll
        for (int ai = 0; ai < 2; ++ai)
#pragma unroll
            for (int m = 0; m < 4; ++m) { bf16_t* rowp = O + (size_t)(row0 + ai * HALF + m * 16) * ldc + col0;
#pragma unroll
                for (int bj = 0; bj < 2; ++bj) { if (col0 + bj * HALF < ncols) {
                    f32x4 v0 = acc[ai][bj][m][0] * scale, v1 = acc[ai][bj][m][1] * scale;
                    u32x4 w; w.x = cvt_pk_bf16(v0[0], v0[1]); w.y = cvt_pk_bf16(v0[2], v0[3]); w.z = cvt_pk_bf16(v1[0], v1[1]); w.w = cvt_pk_bf16(v1[2], v1[3]);
                    *(u32x4*)(rowp + bj * HALF) = w; } } }
    }
};
struct EpiResid {
    static constexpr bool PERM = false, AFTER_DRAIN = false, APERM = false;
    float* X; const float* gate; int row_tile0;
    __device__ __forceinline__ void operator()(const f32x4 (&acc)[2][2][4][2], const Unit& u, int wr, int wc, int fr, int fq) const {
        const int tpm = u.pm + row_tile0; const int bb = tpm / 33, jj = tpm - bb * 33; const float* gv = gate + (jj == 0 ? 2 : bb) * 6144;
        const int col0 = u.pn * BM + wc * 32 + 4 * fq;
#pragma unroll
        for (int ai = 0; ai < 2; ++ai)
#pragma unroll
            for (int m = 0; m < 4; ++m) { float* rowp = X + (size_t)(tpm * BM + ai * HALF + wr * 64 + m * 16 + fr) * 1024 + col0;
#pragma unroll
                for (int bj = 0; bj < 2; ++bj) {
#pragma unroll
                    for (int n = 0; n < 2; ++n) { f32x4* q = (f32x4*)(rowp + bj * HALF + n * 16); const f32x4 gq = *(const f32x4*)(gv + col0 + bj * HALF + n * 16); f32x4 xv = *q; xv = xv + gq * acc[ai][bj][m][n]; *q = xv; }
                    asm volatile("" ::: "memory"); } }
    }
};
struct EpiPart {
    static constexpr bool PERM = false, AFTER_DRAIN = false, APERM = false;
    float* out; int accum;
    __device__ __forceinline__ void operator()(const f32x4 (&acc)[2][2][4][2], const Unit& u, int wr, int wc, int fr, int fq) const {
        const int t = u.pm / 33; const int col0 = u.pn * BM + wc * 32 + 4 * fq;
#pragma unroll
        for (int ai = 0; ai < 2; ++ai)
#pragma unroll
            for (int m = 0; m < 4; ++m) { float* rowp = out + (size_t)(t * BM + ai * HALF + wr * 64 + m * 16 + fr) * 1024 + col0;
#pragma unroll
                for (int bj = 0; bj < 2; ++bj) {
#pragma unroll
                    for (int n = 0; n < 2; ++n) { f32x4* q = (f32x4*)(rowp + bj * HALF + n * 16); f32x4 v = acc[ai][bj][m][n]; if (accum) v = v + *q; *q = v; }
                    asm volatile("" ::: "memory"); } }
    }
};
template <int CTRL> __device__ __forceinline__ float dpp0(float x) { return __builtin_bit_cast(float, __builtin_amdgcn_update_dpp(0, __builtin_bit_cast(int, x), CTRL, 0xf, 0xf, true)); }
struct EpiFfn {
    static constexpr bool PERM = false, AFTER_DRAIN = false, APERM = true;
    bf16_t* ACT; float* EDGE; const float* cw; const float* cb; PG8_LAS float* xl;
    __device__ __forceinline__ void operator()(const f32x4 (&acc)[2][2][4][2], const Unit& u, int wr, int wc, int fr, int fq) const {
        PG8_LAS float* FIRST = xl; PG8_LAS float* LAST = xl + 1024;
        const int cb0 = wc * 32 + 4 * fq;
#pragma unroll
        for (int ai = 0; ai < 2; ++ai)
#pragma unroll
            for (int bj = 0; bj < 2; ++bj)
#pragma unroll
                for (int n = 0; n < 2; ++n) { const int col = bj * HALF + cb0 + n * 16;
                    if (fr == 0) *(PG8_LAS f32x4*)(FIRST + (2 * ai + wr) * 256 + col) = acc[ai][bj][0][n];
                    if (fr == 15) *(PG8_LAS f32x4*)(LAST + (2 * ai + wr) * 256 + col) = acc[ai][bj][3][n]; }
        if (wr == 0 && fr == 0) {
#pragma unroll
            for (int bj = 0; bj < 2; ++bj)
#pragma unroll
                for (int n = 0; n < 2; ++n) { float* ep = EDGE + ((size_t)(u.pm * 4) * 22 + u.pn) * 256 + bj * HALF + cb0 + n * 16; *(f32x4*)ep = acc[0][bj][0][n]; *(f32x4*)(ep + 22 * 256) = acc[0][bj][1][n]; } }
        if (wr == 1 && fr == 15) {
#pragma unroll
            for (int bj = 0; bj < 2; ++bj)
#pragma unroll
                for (int n = 0; n < 2; ++n) { float* ep = EDGE + ((size_t)(u.pm * 4 + 2) * 22 + u.pn) * 256 + bj * HALF + cb0 + n * 16; *(f32x4*)ep = acc[1][bj][2][n]; *(f32x4*)(ep + 22 * 256) = acc[1][bj][3][n]; } }
        asm volatile("s_waitcnt lgkmcnt(0)" ::: "memory"); __builtin_amdgcn_s_barrier(); asm volatile("" ::: "memory");
#pragma unroll
        for (int n = 0; n < 2; ++n) { const int ch0 = u.pn * HALF + cb0 + n * 16;
            f32x4 wa[3], wb[3];
#pragma unroll
            for (int k = 0; k < 3; ++k) { wa[k] = *(const f32x4*)(cw + k * 5632 + ch0); wb[k] = *(const f32x4*)(cw + k * 5632 + 2816 + ch0); }
            const f32x4 ba = *(const f32x4*)(cb + ch0), bb = *(const f32x4*)(cb + 2816 + ch0);
#pragma unroll
            for (int ai = 0; ai < 2; ++ai) { const int g = 2 * ai + wr;
                f32x4 bu[2], bd[2];
#pragma unroll
                for (int bj = 0; bj < 2; ++bj) { const int col = bj * HALF + cb0 + n * 16; const f32x4 zz = {0.f, 0.f, 0.f, 0.f};
                    bu[bj] = g > 0 ? *(const PG8_LAS f32x4*)(LAST + (g - 1) * 256 + col) : zz; bd[bj] = g < 3 ? *(const PG8_LAS f32x4*)(FIRST + (g + 1) * 256 + col) : zz; }
                float o[4][4];
#pragma unroll
                for (int e = 0; e < 4; ++e) { float cv[2][4];
#pragma unroll
                    for (int bj = 0; bj < 2; ++bj) { const float v0 = acc[ai][bj][0][n][e], v1 = acc[ai][bj][1][n][e], v2 = acc[ai][bj][2][n][e], v3 = acc[ai][bj][3][n][e];
                        const float w0 = bj ? wb[0][e] : wa[0][e], w1 = bj ? wb[1][e] : wa[1][e], w2 = bj ? wb[2][e] : wa[2][e], bs = bj ? bb[e] : ba[e];
                        const float upx = dpp0<0x111>(v3) + (fr == 0 ? bu[bj][e] : 0.f);
                        const float dnx = dpp0<0x101>(v0) + (fr == 15 ? bd[bj][e] : 0.f);
                        cv[bj][0] = w0 * upx + w1 * v0 + w2 * v1 + bs; cv[bj][1] = w0 * v0 + w1 * v1 + w2 * v2 + bs;
                        cv[bj][2] = w0 * v1 + w1 * v2 + w2 * v3 + bs;  cv[bj][3] = w0 * v2 + w1 * v3 + w2 * dnx + bs; }
#pragma unroll
                    for (int m = 0; m < 4; ++m) o[m][e] = cv[0][m] * __builtin_amdgcn_rcpf(1.0f + __builtin_amdgcn_exp2f(-1.4426950408889634f * cv[0][m])) * cv[1][m]; }
#pragma unroll
                for (int m = 0; m < 4; ++m) { typedef unsigned u32x2 __attribute__((ext_vector_type(2))); u32x2 w; w.x = cvt_pk_bf16(o[m][0], o[m][1]); w.y = cvt_pk_bf16(o[m][2], o[m][3]);
                    *(u32x2*)(ACT + (size_t)(u.pm * BM + ai * HALF + wr * 64 + 4 * fr + m) * 2816 + ch0) = w; } } }
    }
};

template <class Epi, class Sched, bool ALIGN_EPI = false, bool SP2 = false>
__device__ __forceinline__ void gemm_phase(PG8_LAS unsigned char* lds, const Gemm g, const Sched& S, const Epi& E) {
    int tid = threadIdx.x; asm volatile("" : "+v"(tid));
    const int wid = __builtin_amdgcn_readfirstlane(tid >> 6), lane = tid & 63, wr = wid >> 2, wc = wid & 3, fr = lane & 15, fq = lane >> 4;
    int K = g.K; asm volatile("" : "+s"(K));
    const int nt = K / BK;
    unsigned voffA[2], voffB[2];
#pragma unroll
    for (int i = 0; i < 2; ++i) { int R, C; stage_rc(tid * 16 + i * 8192, R, C); const int Rb = Epi::PERM ? ((R & ~31) + perm32(R & 31)) : R;
        const int Ra = Epi::APERM ? ((R & ~63) + 4 * (R & 15) + ((R >> 4) & 3)) : R;
        voffA[i] = (unsigned)(Ra * g.lda + C) * 2u; voffB[i] = (unsigned)(Rb * g.ldb + C) * 2u; }
    const size_t kstep = (size_t)(BK * 2);
    const size_t hstepA = (size_t)HALF * g.lda * 2, hstepB = (size_t)HALF * g.ldb * 2;
    const size_t tstepA = 2 * hstepA, tstepB = 2 * hstepB;
    const unsigned ldsw = (unsigned)wid * 1024u;
    const int aoff = lds_byte(wr * 64 + fr, fq * 8), boff = lds_byte(wc * 32 + fr, fq * 8);
#define PG8_SA(b, h) (((b) * 2 + (h)) * HTB)
#define PG8_SB(b, h) ((4 + (b) * 2 + (h)) * HTB)
#define PG8_STAGE(bufoff, gbase, voff) do { _Pragma("unroll") for (int _i = 0; _i < 2; ++_i) \
        __builtin_amdgcn_global_load_lds((const unsigned*)((const char*)(gbase) + (voff)[_i]), (PG8_LAS unsigned*)(lds + (bufoff) + ldsw + _i * 8192), 16, 0, 0); } while (0)
#define PG8_LDA(dst, b, h) do { _Pragma("unroll") for (int m = 0; m < 4; ++m) _Pragma("unroll") for (int k = 0; k < 2; ++k) dst[m][k] = *(const PG8_LAS bf16x8*)(lds + PG8_SA(b, h) + aoff + m * 2048 + k * 1024); } while (0)
#define PG8_LDB(dst, b, h) do { _Pragma("unroll") for (int n = 0; n < 2; ++n) _Pragma("unroll") for (int k = 0; k < 2; ++k) dst[n][k] = *(const PG8_LAS bf16x8*)(lds + PG8_SB(b, h) + boff + n * 2048 + k * 1024); } while (0)
#define PG8_MMA(ai, bj, At, Bt) do { __builtin_amdgcn_s_setprio(1); _Pragma("unroll") for (int m = 0; m < 4; ++m) _Pragma("unroll") for (int n = 0; n < 2; ++n) _Pragma("unroll") for (int k = 0; k < 2; ++k) \
        acc[ai][bj][m][n] = __builtin_amdgcn_mfma_f32_16x16x32_bf16(Bt[n][k], At[m][k], acc[ai][bj][m][n], 0, 0, 0); __builtin_amdgcn_s_setprio(0); } while (0)
#define PG8_WAIT_V(n) asm volatile("s_waitcnt vmcnt(" #n ")" ::: "memory")
#define PG8_WAIT_L(n) asm volatile("s_waitcnt lgkmcnt(" #n ")" ::: "memory")
#define PG8_BAR __builtin_amdgcn_s_barrier()
#define PG8_SCHED __builtin_amdgcn_sched_barrier(0)
    Unit cur, nxt; int ui = 0;
    if (!S.next(0, cur)) return;
    f32x4 acc[2][2][4][2];
#pragma unroll
    for (int a = 0; a < 2; ++a)
#pragma unroll
        for (int b = 0; b < 2; ++b)
#pragma unroll
            for (int m = 0; m < 4; ++m)
#pragma unroll
                for (int n = 0; n < 2; ++n) acc[a][b][m][n] = (f32x4){0.f, 0.f, 0.f, 0.f};
    bf16x8 At[4][2], B0[2][2], B1[2][2];
    const char* cA = (const char*)g.A + (size_t)cur.pm * tstepA; const char* cB = (const char*)g.Bt + (size_t)cur.pn * tstepB;
    S.a_ready(cur);
    if constexpr (SP2) {
        PG8_STAGE(PG8_SB(0, 0), cB, voffB); PG8_STAGE(PG8_SB(0, 1), cB + hstepB, voffB); PG8_STAGE(PG8_SA(0, 0), cA, voffA); PG8_STAGE(PG8_SA(0, 1), cA + hstepA, voffA);
        if (wr == 1) PG8_BAR;
        PG8_WAIT_V(2); PG8_BAR;
        PG8_STAGE(PG8_SB(1, 0), cB + kstep, voffB); PG8_STAGE(PG8_SA(1, 0), cA + kstep, voffA); PG8_STAGE(PG8_SB(1, 1), cB + hstepB + kstep, voffB);
        PG8_WAIT_V(6); PG8_BAR;
    } else {
        PG8_STAGE(PG8_SB(0, 0), cB, voffB); PG8_STAGE(PG8_SA(0, 0), cA, voffA); PG8_STAGE(PG8_SB(0, 1), cB + hstepB, voffB); PG8_STAGE(PG8_SA(0, 1), cA + hstepA, voffA);
        if (wr == 1) PG8_BAR;
        PG8_WAIT_V(4); PG8_BAR;
        PG8_STAGE(PG8_SB(1, 0), cB + kstep, voffB); PG8_STAGE(PG8_SA(1, 0), cA + kstep, voffA); PG8_STAGE(PG8_SB(1, 1), cB + hstepB + kstep, voffB);
        PG8_WAIT_V(6); PG8_BAR;
    }
    for (;;) {
        const bool has_next = S.next(ui + 1, nxt);
        const char* nA = has_next ? (const char*)g.A + (size_t)nxt.pm * tstepA : cA; const char* nB = has_next ? (const char*)g.Bt + (size_t)nxt.pn * tstepB : cB;
        for (int t = 0; t < nt; t += 2) {
            const bool last = (t == nt - 2);
            const char* a1 = cA + (size_t)(t + 1) * kstep;
            const char* a2 = last ? nA : cA + (size_t)(t + 2) * kstep; const char* b2 = last ? nB : cB + (size_t)(t + 2) * kstep;
            const char* a3 = a2 + kstep; const char* b3 = b2 + kstep;
            if (last && has_next) S.a_ready(nxt);
            if constexpr (SP2) {
            PG8_LDB(B0, 0, 0); PG8_LDB(B1, 0, 1); PG8_SCHED; PG8_LDA(At, 0, 0); PG8_STAGE(PG8_SA(1, 1), a1 + hstepA, voffA);
            PG8_WAIT_V(8); PG8_WAIT_L(0); PG8_BAR; PG8_MMA(0, 0, At, B0); PG8_MMA(0, 1, At, B1); PG8_BAR; PG8_SCHED;
            PG8_LDA(At, 0, 1); PG8_STAGE(PG8_SB(0, 0), b2, voffB); PG8_STAGE(PG8_SB(0, 1), b2 + hstepB, voffB); PG8_STAGE(PG8_SA(0, 0), a2, voffA);
            PG8_WAIT_V(8); PG8_WAIT_L(0); PG8_BAR; PG8_MMA(1, 0, At, B0); PG8_MMA(1, 1, At, B1); PG8_BAR; PG8_SCHED;
            PG8_LDB(B0, 1, 0); PG8_LDB(B1, 1, 1); PG8_SCHED; PG8_LDA(At, 1, 0); PG8_STAGE(PG8_SA(0, 1), a2 + hstepA, voffA);
            PG8_WAIT_V(8); PG8_WAIT_L(0); PG8_BAR; PG8_MMA(0, 0, At, B0); PG8_MMA(0, 1, At, B1); PG8_BAR; PG8_SCHED;
            PG8_LDA(At, 1, 1); PG8_STAGE(PG8_SB(1, 0), b3, voffB); PG8_STAGE(PG8_SB(1, 1), b3 + hstepB, voffB); PG8_STAGE(PG8_SA(1, 0), a3, voffA);
            PG8_WAIT_V(8); PG8_WAIT_L(0); PG8_BAR; PG8_MMA(1, 0, At, B0); PG8_MMA(1, 1, At, B1); PG8_BAR; PG8_SCHED;
            } else {
            PG8_LDB(B0, 0, 0); PG8_SCHED; PG8_LDA(At, 0, 0); PG8_STAGE(PG8_SA(1, 1), a1 + hstepA, voffA);
            PG8_WAIT_L(8); PG8_BAR; PG8_WAIT_L(0); PG8_MMA(0, 0, At, B0); PG8_BAR; PG8_SCHED;
            PG8_LDB(B1, 0, 1); PG8_STAGE(PG8_SB(0, 0), b2, voffB);
            PG8_BAR; PG8_WAIT_L(0); PG8_MMA(0, 1, At, B1); PG8_BAR;
            PG8_LDA(At, 0, 1); PG8_STAGE(PG8_SA(0, 0), a2, voffA);
            PG8_BAR; PG8_WAIT_L(0); PG8_MMA(1, 0, At, B0); PG8_BAR; PG8_SCHED;
            PG8_STAGE(PG8_SB(0, 1), b2 + hstepB, voffB);
            PG8_WAIT_V(6); PG8_BAR; PG8_MMA(1, 1, At, B1); PG8_BAR;
            PG8_LDB(B0, 1, 0); PG8_SCHED; PG8_LDA(At, 1, 0); PG8_STAGE(PG8_SA(0, 1), a2 + hstepA, voffA);
            PG8_WAIT_L(8); PG8_BAR; PG8_WAIT_L(0); PG8_MMA(0, 0, At, B0); PG8_BAR; PG8_SCHED;
            PG8_LDB(B1, 1, 1); PG8_STAGE(PG8_SB(1, 0), b3, voffB);
            PG8_BAR; PG8_WAIT_L(0); PG8_MMA(0, 1, At, B1); PG8_BAR;
            PG8_LDA(At, 1, 1); PG8_STAGE(PG8_SA(1, 0), a3, voffA);
            PG8_BAR; PG8_WAIT_L(0); PG8_MMA(1, 0, At, B0); PG8_BAR; PG8_SCHED;
            PG8_STAGE(PG8_SB(1, 1), b3 + hstepB, voffB);
            PG8_WAIT_V(6); PG8_BAR; PG8_MMA(1, 1, At, B1); PG8_BAR;
            }
        }
        if constexpr (ALIGN_EPI) { if (wr == 0) PG8_BAR; }
        if constexpr (!Epi::AFTER_DRAIN) { E(acc, cur, wr, wc, fr, fq); S.done(cur); }
        if (!has_next) break;
#pragma unroll
        for (int a = 0; a < 2; ++a)
#pragma unroll
            for (int b = 0; b < 2; ++b)
#pragma unroll
                for (int m = 0; m < 4; ++m)
#pragma unroll
                    for (int n = 0; n < 2; ++n) acc[a][b][m][n] = (f32x4){0.f, 0.f, 0.f, 0.f};
        cur = nxt; cA = nA; cB = nB; ++ui;
        if constexpr (ALIGN_EPI) { if (wr == 1) PG8_BAR; }
    }
    PG8_WAIT_V(0);
    if constexpr (!ALIGN_EPI) { if (wr == 0) PG8_BAR; }
    PG8_BAR;
    if constexpr (Epi::AFTER_DRAIN) { E.fused(acc, cur, wr, wc, fr, fq, lds, wid, lane); S.done(cur); }
#undef PG8_SA
#undef PG8_SB
#undef PG8_STAGE
#undef PG8_LDA
#undef PG8_LDB
#undef PG8_MMA
#undef PG8_WAIT_V
#undef PG8_WAIT_L
#undef PG8_BAR
#undef PG8_SCHED
}
}

#define DEV __device__ __forceinline__
#define LAS __attribute__((address_space(3)))
typedef unsigned short bf16_t;
typedef short bf16x8 __attribute__((ext_vector_type(8)));
typedef float f32x4 __attribute__((ext_vector_type(4)));
typedef float f32x2 __attribute__((ext_vector_type(2)));
typedef float f32x16 __attribute__((ext_vector_type(16)));
typedef unsigned u32x4 __attribute__((ext_vector_type(4)));
typedef unsigned u32x2 __attribute__((ext_vector_type(2)));

constexpr int R = 16896, RB = 8448, NCTX = 256, TL = 8192, DM = 1024, INW = 1696, DFF = 2816, HFF = 1408;
constexpr int NWG_T = 512;
constexpr float EPS = 1e-6f;
constexpr int LDS_BYTES = 147456;
constexpr size_t OFF_X = 0, OFF_HN = 69206016, OFF_W = 103809024, OFF_MOD = 152174592, OFF_ROPE = 152436736, OFF_OV = 153485312;
constexpr size_t OV_Q = 0, OV_KN = 25952256, OV_VT = 43253760, OV_SLOC = 60555264, OV_SIN = 69206016, OV_U = 0;
constexpr size_t OFF_PART = 250100224;
constexpr size_t OFF_EDGE = 258488832;
constexpr size_t WS_NEED = OFF_EDGE + 5947392;
constexpr size_t W_IN = 0, W_UQ = 1835008, W_KN = 2129920, W_V = 2260992, W_OUT = 2392064, W_UP = 3440640, W_DN = 9207808, W_LAYER = 12091392;

struct Params {
    const float *x, *c, *ctx, *c_ctx, *w_mod, *b_mod, *norm1_g, *w_in, *ret_decay_f, *ret_decay_b, *mla_q_norm_g, *w_uq, *mla_kv_norm_g, *w_ukv,
        *pool_w, *pool_scale, *w_out, *norm2_g, *w_up, *conv_w, *conv_b, *w_down, *final_norm_g;
    float* out; unsigned char* ws; int ph_lo, ph_hi;
};

DEV int otid() { int t = threadIdx.x; asm volatile("" : "+v"(t)); return t; }
DEV float bf2f(unsigned short x) { return __uint_as_float((unsigned)x << 16); }
DEV unsigned f2bf(float f) { unsigned u = __float_as_uint(f); return (u + 0x7fffu + ((u >> 16) & 1u)) >> 16; }
DEV unsigned pk2(float lo, float hi) { return f2bf(lo) | (f2bf(hi) << 16); }
DEV float wave_sum(float v) {
#pragma unroll
    for (int o = 1; o < 64; o <<= 1) v += __shfl_xor(v, o);
    return v;
}
DEV float siluf(float x) { return x * __builtin_amdgcn_rcpf(1.0f + __builtin_amdgcn_exp2f(-1.4426950408889634f * x)); }
DEV int crow(int r, int hi) { return (r & 3) + 8 * (r >> 2) + 4 * hi; }
DEV bf16x8 pack8(float a0, float a1, float a2, float a3, float a4, float a5, float a6, float a7) {
    u32x4 w; w.x = pg8::cvt_pk_bf16(a0, a1); w.y = pg8::cvt_pk_bf16(a2, a3); w.z = pg8::cvt_pk_bf16(a4, a5); w.w = pg8::cvt_pk_bf16(a6, a7);
    return __builtin_bit_cast(bf16x8, w);
}
DEV int row_mi(int r) { const int b = r / RB; const int s = r - b * RB; return s < NCTX ? 2 : b; }

DEV void transpose_item(const float* W, int K, int Nsrc, bf16_t* WT, int n0, int cs, int k0, float* scr, int lane) {
#pragma unroll
    for (int i = 0; i < 32; ++i) { const int kk = 2 * i + (lane >> 5); scr[kk * 33 + (lane & 31)] = cs >= 0 ? W[(size_t)(k0 + kk) * Nsrc + cs + (lane & 31)] : 0.f; }
    asm volatile("s_waitcnt lgkmcnt(0)" ::: "memory");
    const int c = lane & 7;
#pragma unroll
    for (int j = 0; j < 4; ++j) { const int n = (lane >> 3) + 8 * j; const float* s = scr + (8 * c) * 33 + n;
        u32x4 o; o.x = pk2(s[0 * 33], s[1 * 33]); o.y = pk2(s[2 * 33], s[3 * 33]); o.z = pk2(s[4 * 33], s[5 * 33]); o.w = pk2(s[6 * 33], s[7 * 33]);
        *(u32x4*)(WT + (size_t)(n0 + n) * K + k0 + 8 * c) = o; }
    asm volatile("s_waitcnt lgkmcnt(0)" ::: "memory");
}
DEV int map_in(int n0) { return n0 < 1440 ? n0 : (n0 < INW ? -2 : -1); }
DEV int map_kn(int n0) { return (n0 >> 6) * 128 + (n0 & 63); }
DEV int map_v(int n0) { return (n0 >> 6) * 128 + 64 + (n0 & 63); }
DEV int map_up(int n0) { const int pn = n0 >> 8, w = n0 & 255; return w < 128 ? 128 * pn + w : DFF + 128 * pn + (w - 128); }

DEV void phase_prep(const Params& p, unsigned char* lds) {
    const int tid = otid(), lane = tid & 63, wid = tid >> 6;
    unsigned char* ws = p.ws;
    { f32x2* rope = (f32x2*)(ws + OFF_ROPE);
      for (int idx = blockIdx.x * NWG_T + tid; idx < TL * 16; idx += gridDim.x * NWG_T) { const int t = idx >> 4, i = idx & 15; const int pos = i < 8 ? (t >> 6) : (t & 63);
          const float inv = exp2f(-(float)(i & 7) * 0.125f * 13.287712379549449f); const float ang = (float)pos * inv; f32x2 cs; cs.x = __cosf(ang); cs.y = __sinf(ang); rope[idx] = cs; } }
    { float* scv = (float*)lds;
      float* red = scv + 3 * 1024;
      for (int i = tid; i < 3 * 1024; i += NWG_T) { const int v = i >> 10, k = i & 1023; const float cv = v < 2 ? p.c[v * 1024 + k] : p.c_ctx[k]; scv[i] = siluf(cv); }
      __syncthreads();
      float* modv = (float*)(ws + OFF_MOD);
      for (int it = blockIdx.x; it < 192; it += gridDim.x) { const int l = it / 96, col0 = (it % 96) * 64;
          const float* wm = p.w_mod + (size_t)l * 1024 * 6144 + col0 + lane; float a0 = 0.f, a1 = 0.f, a2 = 0.f;
#pragma unroll 16
          for (int k = wid * 128; k < wid * 128 + 128; ++k) { const float w = wm[(size_t)k * 6144]; a0 += scv[k] * w; a1 += scv[1024 + k] * w; a2 += scv[2048 + k] * w; }
          red[(wid * 3 + 0) * 64 + lane] = a0; red[(wid * 3 + 1) * 64 + lane] = a1; red[(wid * 3 + 2) * 64 + lane] = a2;
          __syncthreads();
          if (tid < 192) { const int v = tid >> 6, cl = tid & 63; float s = 0.f;
#pragma unroll
              for (int w = 0; w < 8; ++w) s += red[(w * 3 + v) * 64 + cl];
              modv[((size_t)l * 3 + v) * 6144 + col0 + cl] = s + p.b_mod[l * 6144 + col0 + cl]; }
          __syncthreads(); }
    }
}
DEV void phase_prep_weights(const Params& p, unsigned char* lds) {
    const int tid = otid(), lane = tid & 63, wid = tid >> 6;
    unsigned char* ws = p.ws;
    { float* scr = (float*)(lds + 32768 + wid * 8704);
      const int gw = blockIdx.x * 8 + wid, NGW = gridDim.x * 8;
      constexpr int I_IN = 16 * 56, I_UQ = 6 * 24, I_KN = 4 * 16, I_V = 4 * 16, I_OUT = 16 * 32, I_UP = 16 * 176, I_DN = 44 * 32, I_L = I_IN + I_UQ + I_KN + I_V + I_OUT + I_UP + I_DN;
      for (int it = gw; it < 2 * I_L; it += NGW) { const int l = it / I_L; int r = it - l * I_L; bf16_t* wl = (bf16_t*)(ws + OFF_W) + (size_t)l * W_LAYER;
          const float* src; int K, Nsrc, nbn, mp; size_t doff;
          if (r < I_IN) { src = p.w_in + (size_t)l * 1024 * INW; K = 1024; Nsrc = INW; nbn = 56; mp = 1; doff = W_IN; }
          else if ((r -= I_IN) < I_UQ) { src = p.w_uq + (size_t)l * 384 * 768; K = 384; Nsrc = 768; nbn = 24; mp = 0; doff = W_UQ; }
          else if ((r -= I_UQ) < I_KN) { src = p.w_ukv + (size_t)l * 256 * 1024; K = 256; Nsrc = 1024; nbn = 16; mp = 2; doff = W_KN; }
          else if ((r -= I_KN) < I_V) { src = p.w_ukv + (size_t)l * 256 * 1024; K = 256; Nsrc = 1024; nbn = 16; mp = 3; doff = W_V; }
          else if ((r -= I_V) < I_OUT) { src = p.w_out + (size_t)l * 1024 * 1024; K = 1024; Nsrc = 1024; nbn = 32; mp = 0; doff = W_OUT; }
          else if ((r -= I_OUT) < I_UP) { src = p.w_up + (size_t)l * 1024 * 5632; K = 1024; Nsrc = 5632; nbn = 176; mp = 4; doff = W_UP; }
          else { r -= I_UP; src = p.w_down + (size_t)l * DFF * 1024; K = DFF; Nsrc = 1024; nbn = 32; mp = 0; doff = W_DN; }
          const int kb = r / nbn, nb = r - kb * nbn, n0 = nb * 32;
          const int cs = mp == 0 ? n0 : mp == 1 ? map_in(n0) : mp == 2 ? map_kn(n0) : mp == 3 ? map_v(n0) : map_up(n0);
          if (cs != -2) transpose_item(src, K, Nsrc, wl + doff, n0, cs, kb * 64, scr, lane); }
    }
    { for (int idx = blockIdx.x * NWG_T + tid; idx < 2 * 1024 * 256; idx += gridDim.x * NWG_T) { const int n = idx & 255, k = (idx >> 8) & 1023, l = idx >> 18; const int g = n >> 6, d = n & 63;
          const float* wr = p.w_in + ((size_t)l * 1024 + k) * INW + 1440 + g * 64; const float* pw = p.pool_w + ((size_t)(l * 4 + g) * 64) * 64 + d; float s = 0.f;
#pragma unroll 8
          for (int c = 0; c < 64; ++c) s += wr[c] * pw[c * 64];
          ((bf16_t*)(ws + OFF_W) + (size_t)l * W_LAYER + W_IN)[(size_t)(1440 + n) * 1024 + k] = (bf16_t)f2bf(s * p.pool_scale[l * 256 + n]); } }
}

DEV void phase_norm(const Params& p, int l, int which, bool first, const float* pgate, const float* pbase, int pcount) {
    const int tid = otid(); const int lane = tid & 63, wid = tid >> 6; const int gw = blockIdx.x * 8 + wid, NGW = gridDim.x * 8;
    float* X = (float*)(p.ws + OFF_X); bf16_t* HN = (bf16_t*)(p.ws + OFF_HN);
    const float* modv = (const float*)(p.ws + OFF_MOD) + (size_t)l * 3 * 6144;
    const float* g = (which == 0 ? p.norm1_g : p.norm2_g) + l * 1024;
    for (int r = gw; r < R; r += NGW) {
        const int b = r / RB, s = r - b * RB; const int mi = s < NCTX ? 2 : b;
        const float* src = first ? (s < NCTX ? p.ctx + ((size_t)b * NCTX + s) * 1024 : p.x + ((size_t)b * TL + (s - NCTX)) * 1024) : X + (size_t)r * 1024;
        const f32x4* xr = (const f32x4*)src + lane; f32x4 v[4]; float ss = 0.f;
#pragma unroll
        for (int j = 0; j < 4; ++j) { v[j] = xr[64 * j]; ss += (v[j].x * v[j].x + v[j].y * v[j].y) + (v[j].z * v[j].z + v[j].w * v[j].w); }
        if (pgate != nullptr && s < NCTX) { const float* PART = pbase + (size_t)(b * NCTX + s) * 1024; ss = 0.f;
#pragma unroll
            for (int j = 0; j < 4; ++j) { const f32x4 gq = ((const f32x4*)pgate)[lane + 64 * j]; f32x4 a = ((const f32x4*)PART)[lane + 64 * j];
                for (int q = 1; q < pcount; ++q) a = a + ((const f32x4*)(PART + (size_t)q * 524288))[lane + 64 * j];
                v[j] = v[j] + gq * a; ss += (v[j].x * v[j].x + v[j].y * v[j].y) + (v[j].z * v[j].z + v[j].w * v[j].w); } }
        if (first || (pgate != nullptr && s < NCTX)) { f32x4* xo = (f32x4*)(X + (size_t)r * 1024) + lane;
#pragma unroll
            for (int j = 0; j < 4; ++j) xo[64 * j] = v[j]; }
        const float rs = rsqrtf(wave_sum(ss) * (1.f / 1024.f) + EPS);
        const float* mv = modv + mi * 6144 + (which == 0 ? 0 : 3072);
        u32x2* o8 = (u32x2*)(HN + (size_t)r * 1024) + lane;
#pragma unroll
        for (int j = 0; j < 4; ++j) { const f32x4 gg = ((const f32x4*)g)[lane + 64 * j], sh = ((const f32x4*)mv)[lane + 64 * j], sc = ((const f32x4*)(mv + 1024))[lane + 64 * j];
            const f32x4 y = v[j] * rs * gg; const f32x4 h = y * (sc + 1.0f) + sh; u32x2 w; w.x = pk2(h.x, h.y); w.y = pk2(h.z, h.w); o8[64 * j] = w; }
    }
}
DEV void phase_final(const Params& p) {
    const int tid = otid(); const int lane = tid & 63, wid = tid >> 6; const int gw = blockIdx.x * 8 + wid, NGW = gridDim.x * 8;
    const float* X = (const float*)(p.ws + OFF_X);
    for (int q = gw; q < 2 * TL; q += NGW) { const int b = q / TL, t = q - b * TL; const int r = b * RB + NCTX + t;
        const f32x4* xr = (const f32x4*)(X + (size_t)r * 1024) + lane; f32x4 v[4]; float ss = 0.f;
#pragma unroll
        for (int j = 0; j < 4; ++j) { v[j] = xr[64 * j]; ss += (v[j].x * v[j].x + v[j].y * v[j].y) + (v[j].z * v[j].z + v[j].w * v[j].w); }
        const float rs = rsqrtf(wave_sum(ss) * (1.f / 1024.f) + EPS);
        f32x4* o = (f32x4*)(p.out + (size_t)q * 1024) + lane;
#pragma unroll
        for (int j = 0; j < 4; ++j) { const f32x4 gg = ((const f32x4*)p.final_norm_g)[lane + 64 * j]; o[64 * j] = v[j] * rs * gg; } }
}

DEV void phase_rowwise(const Params& p, int l) {
    const int tid = otid(); const int lane = tid & 63, wid = tid >> 6; const int gw = blockIdx.x * 8 + wid, NGW = gridDim.x * 8;
    bf16_t* P = (bf16_t*)p.out; const f32x2* rope = (const f32x2*)(p.ws + OFF_ROPE);
    const float* qg = p.mla_q_norm_g + l * 384; const float* kg = p.mla_kv_norm_g + l * 256;
    float qgv[6];
#pragma unroll
    for (int j = 0; j < 3; ++j) { qgv[2 * j] = qg[2 * (lane + 64 * j)]; qgv[2 * j + 1] = qg[2 * (lane + 64 * j) + 1]; }
    const f32x4 kgv = ((const f32x4*)kg)[lane];
    for (int r0 = gw; r0 < R; r0 += 2 * NGW) {
        unsigned wq[2][3]; u32x2 wk[2]; float x1[2], x2[2]; f32x2 cs[2]; bool val[2], lat[2];
#pragma unroll
        for (int i = 0; i < 2; ++i) { const int r = r0 + i * NGW; val[i] = r < R; const int rr = val[i] ? r : r0; bf16_t* pr = P + (size_t)rr * INW; const int s = rr % RB; lat[i] = s >= NCTX;
            const unsigned* q2 = (const unsigned*)(pr + 768) + lane;
#pragma unroll
            for (int j = 0; j < 3; ++j) wq[i][j] = q2[64 * j];
            wk[i] = *((const u32x2*)(pr + 1152) + lane);
            const int li = lane & 15; x1[i] = bf2f(pr[1408 + li]); x2[i] = bf2f(pr[1408 + 16 + li]); cs[i] = rope[(lat[i] ? s - NCTX : 0) * 16 + li]; }
#pragma unroll
        for (int i = 0; i < 2; ++i) { if (!val[i]) continue; const int r = r0 + i * NGW; bf16_t* pr = P + (size_t)r * INW;
            { float ss = 0.f;
#pragma unroll
              for (int j = 0; j < 3; ++j) { const float a = bf2f(wq[i][j] & 0xffff), c2 = bf2f(wq[i][j] >> 16); ss += a * a + c2 * c2; }
              const float rs = rsqrtf(wave_sum(ss) * (1.f / 384.f) + EPS); unsigned* q2 = (unsigned*)(pr + 768) + lane;
#pragma unroll
              for (int j = 0; j < 3; ++j) q2[64 * j] = pk2(bf2f(wq[i][j] & 0xffff) * rs * qgv[2 * j], bf2f(wq[i][j] >> 16) * rs * qgv[2 * j + 1]); }
            { const float a0 = bf2f(wk[i].x & 0xffff), a1 = bf2f(wk[i].x >> 16), a2 = bf2f(wk[i].y & 0xffff), a3 = bf2f(wk[i].y >> 16);
              const float rs = rsqrtf(wave_sum((a0 * a0 + a1 * a1) + (a2 * a2 + a3 * a3)) * (1.f / 256.f) + EPS);
              u32x2 o; o.x = pk2(a0 * rs * kgv.x, a1 * rs * kgv.y); o.y = pk2(a2 * rs * kgv.z, a3 * rs * kgv.w); *((u32x2*)(pr + 1152) + lane) = o; }
            if (lat[i] && lane < 16) { pr[1408 + lane] = (bf16_t)f2bf(x1[i] * cs[i].x - x2[i] * cs[i].y); pr[1408 + 16 + lane] = (bf16_t)f2bf(x2[i] * cs[i].x + x1[i] * cs[i].y); } }
    }
}

DEV void phase_pool(const Params& p) {
    const int tid = otid(); const bf16_t* P = (const bf16_t*)p.out; bf16_t* MIX = (bf16_t*)(p.ws + OFF_HN);
    for (int idx = blockIdx.x * NWG_T + tid; idx < R * 32; idx += gridDim.x * NWG_T) { const int r = idx >> 5, cg = idx & 31; const int half = 1 << (cg >> 3);
        const int b = r / RB, s = r - b * RB; const int seq0 = s < NCTX ? b * RB : b * RB + NCTX; const int T = s < NCTX ? NCTX : TL; const int t = r - seq0;
        const int lo = max(t - half, 0), hi = min(t + half, T); float sum[8];
#pragma unroll
        for (int j = 0; j < 8; ++j) sum[j] = 0.f;
        const bf16_t* base = P + (size_t)seq0 * INW + 1440 + cg * 8;
        { bf16x8 wv[16]; const bf16x8 zz = {0, 0, 0, 0, 0, 0, 0, 0};
#pragma unroll
          for (int k = 0; k < 16; ++k) { const int tt = t - 8 + k; wv[k] = (tt >= lo && tt < hi) ? *(const bf16x8*)(base + (size_t)tt * INW) : zz; }
#pragma unroll
          for (int k = 0; k < 16; ++k)
#pragma unroll
              for (int j = 0; j < 8; ++j) sum[j] += bf2f((unsigned short)wv[k][j]); }
        const bf16x8 me = *(const bf16x8*)(base + (size_t)t * INW); const float ic = 1.0f / (float)(hi - lo); float o[8];
#pragma unroll
        for (int j = 0; j < 8; ++j) o[j] = sum[j] * ic - bf2f((unsigned short)me[j]);
        *(bf16x8*)(MIX + (size_t)r * 1024 + 768 + cg * 8) = pack8(o[0], o[1], o[2], o[3], o[4], o[5], o[6], o[7]); }
}

DEV float log2_sigmoid(float d) { return -log1pf(__expf(-d)) * 1.4426950408889634f; }
constexpr int ST_P = 272;
DEV void states_item(const Params& p, int l, unsigned char* lds, int it) {
    const int tid = otid(), lane = tid & 63, wid = tid >> 6, l32 = lane & 31, hi = lane >> 5;
    const bf16_t* P = (const bf16_t*)p.out; const f32x2* rope = (const f32x2*)(p.ws + OFF_ROPE);
    float* SLOC = (float*)(p.ws + OFF_OV + OV_SLOC);
    const int gc = it >> 1, hp = it & 1;
    unsigned char* VTl = lds;
    unsigned char* KTl = lds + 2 * 64 * ST_P;
    const int cb = gc % 66; const bool lat = cb >= 2; const int t0 = (cb - 2) * 128; const int r0 = gc * 128;
    __syncthreads();
    { const int tok = tid >> 2, hh = (tid >> 1) & 1, c = tid & 1; const int h = 2 * hp + hh;
      const bf16_t* src = P + (size_t)(r0 + tok) * INW + 128 + h * 32 + 8 * c; const bf16x8 lo = *(const bf16x8*)src, hi8 = *(const bf16x8*)(src + 16);
      const float df = exp2f(log2_sigmoid(p.ret_decay_f[l * 4 + h]) * (float)(127 - tok)) * 0.17677669529663687f, db = exp2f(log2_sigmoid(p.ret_decay_b[l * 4 + h]) * (float)tok) * 0.17677669529663687f;
#pragma unroll
      for (int j = 0; j < 8; ++j) { float x1 = bf2f((unsigned short)lo[j]), x2 = bf2f((unsigned short)hi8[j]);
          if (lat) { const f32x2 cs = rope[(t0 + tok) * 16 + 8 * c + j]; const float y1 = x1 * cs.x - x2 * cs.y, y2 = x2 * cs.x + x1 * cs.y; x1 = y1; x2 = y2; }
          bf16_t* kf = (bf16_t*)(KTl + ((hh * 2 + 0) * 32 + 8 * c + j) * ST_P) + tok; bf16_t* kb = (bf16_t*)(KTl + ((hh * 2 + 1) * 32 + 8 * c + j) * ST_P) + tok;
          kf[0] = (bf16_t)f2bf(x1 * df); kb[0] = (bf16_t)f2bf(x1 * db);
          *(bf16_t*)((unsigned char*)kf + 16 * ST_P) = (bf16_t)f2bf(x2 * df); *(bf16_t*)((unsigned char*)kb + 16 * ST_P) = (bf16_t)f2bf(x2 * db); } }
    for (int task = tid; task < 2048; task += NWG_T) { const int hh = task >> 10, tok = (task >> 3) & 127, ch = task & 7;
        const bf16x8 v = *(const bf16x8*)(P + (size_t)(r0 + tok) * INW + 256 + (2 * hp + hh) * 64 + ch * 8);
#pragma unroll
        for (int j = 0; j < 8; ++j) *((bf16_t*)(VTl + (hh * 64 + ch * 8 + j) * ST_P) + tok) = (bf16_t)v[j]; }
    __syncthreads();
    { const int hh = wid >> 2, dir = (wid >> 1) & 1, dvb = wid & 1; const int h = 2 * hp + hh;
      const unsigned char* ap = VTl + (hh * 64 + 32 * dvb + l32) * ST_P + hi * 16; const unsigned char* bp = KTl + ((hh * 2 + dir) * 32 + l32) * ST_P + hi * 16;
      bf16x8 af[8], bfr[8];
#pragma unroll
      for (int ks = 0; ks < 8; ++ks) { af[ks] = *(const bf16x8*)(ap + ks * 32); bfr[ks] = *(const bf16x8*)(bp + ks * 32); }
      f32x16 acc;
#pragma unroll
      for (int r = 0; r < 16; ++r) acc[r] = 0.f;
#pragma unroll
      for (int ks = 0; ks < 8; ++ks) acc = __builtin_amdgcn_mfma_f32_32x32x16_bf16(af[ks], bfr[ks], acc, 0, 0, 0);
      float* o = SLOC + ((size_t)(gc * 4 + h) * 2 + dir) * 2048 + l32 * 64 + 32 * dvb + 4 * hi;
#pragma unroll
      for (int g4 = 0; g4 < 4; ++g4) *(f32x4*)(o + 8 * g4) = (f32x4){acc[4 * g4], acc[4 * g4 + 1], acc[4 * g4 + 2], acc[4 * g4 + 3]}; }
}
DEV void scan_threads(const Params& p, int l, int gid) {
    if (gid >= 32768) return;
    const int e = gid & 2047, dir = (gid >> 11) & 1, h = (gid >> 12) & 3, b = gid >> 14;
    const float* SLOC = (const float*)(p.ws + OFF_OV + OV_SLOC); float* SIN = (float*)(p.ws + OFF_OV + OV_SIN);
    const float gC = exp2f(log2_sigmoid((dir == 0 ? p.ret_decay_f : p.ret_decay_b)[l * 4 + h]) * 128.f);
    float S = 0.f;
#pragma unroll 11
    for (int st = 0; st < 66; ++st) { const int cb = dir == 0 ? st : (st < 2 ? 1 - st : 67 - st); const size_t idx = ((size_t)((b * 66 + cb) * 4 + h) * 2 + dir) * 2048 + e;
        const float v = SLOC[idx]; SIN[idx] = S; S = S * gC + v; }
}

constexpr int AT_KP = 208, AT_VP = 144, AT_KB = 64 * AT_KP, AT_VBS = 64 * AT_VP, AT_V0 = 4 * AT_KB;
DEV float at_max32(const f32x16& s0, const f32x16& s1) {
    float m0 = __builtin_fmaxf(__builtin_fmaxf(s0[0], s0[1]), s0[2]), m1 = __builtin_fmaxf(__builtin_fmaxf(s1[0], s1[1]), s1[2]);
    m0 = __builtin_fmaxf(__builtin_fmaxf(m0, s0[3]), s0[4]); m1 = __builtin_fmaxf(__builtin_fmaxf(m1, s1[3]), s1[4]);
    m0 = __builtin_fmaxf(__builtin_fmaxf(m0, s0[5]), s0[6]); m1 = __builtin_fmaxf(__builtin_fmaxf(m1, s1[5]), s1[6]);
    m0 = __builtin_fmaxf(__builtin_fmaxf(m0, s0[7]), s0[8]); m1 = __builtin_fmaxf(__builtin_fmaxf(m1, s1[7]), s1[8]);
    m0 = __builtin_fmaxf(__builtin_fmaxf(m0, s0[9]), s0[10]); m1 = __builtin_fmaxf(__builtin_fmaxf(m1, s1[9]), s1[10]);
    m0 = __builtin_fmaxf(__builtin_fmaxf(m0, s0[11]), s0[12]); m1 = __builtin_fmaxf(__builtin_fmaxf(m1, s1[11]), s1[12]);
    m0 = __builtin_fmaxf(__builtin_fmaxf(m0, s0[13]), s0[14]); m1 = __builtin_fmaxf(__builtin_fmaxf(m1, s1[13]), s1[14]);
    return __builtin_fmaxf(__builtin_fmaxf(m0, s0[15]), __builtin_fmaxf(m1, s1[15]));
}
DEV void attn_unit(const Params& p, unsigned char* lds, int u) {
    const int tid = otid(), lane = tid & 63, wid = tid >> 6, l32 = lane & 31, hi = lane >> 5;
    const bf16_t* Q = (const bf16_t*)(p.ws + OFF_OV + OV_Q); const bf16_t* KN = (const bf16_t*)(p.ws + OFF_OV + OV_KN); const bf16_t* VT = (const bf16_t*)(p.ws + OFF_OV + OV_VT);
    const bf16_t* P = (const bf16_t*)p.out; bf16_t* MIX = (bf16_t*)(p.ws + OFF_HN); const f32x2* rope = (const f32x2*)(p.ws + OFF_ROPE);
    const bool isctx = u >= 512; int b, h, qrow0, NT;
    if (!isctx) { b = u >> 8; h = (u >> 5) & 7; qrow0 = b * RB + NCTX + (u & 31) * 256; NT = 132; } else { const int v = u - 512; b = v >> 3; h = v & 7; qrow0 = b * RB; NT = 4; }
    const int krow0 = b * RB; const int qrow = qrow0 + wid * 32 + l32;
    bf16x8 qf[6];
    { const bf16_t* qp = Q + (size_t)qrow * 768 + h * 96 + hi * 8;
#pragma unroll
      for (int d0 = 0; d0 < 6; ++d0) qf[d0] = *(const bf16x8*)(qp + d0 * 16);
      if (!isctx) { const f32x2* rp = rope + (size_t)(qrow - (b * RB + NCTX)) * 16 + hi * 8;
#pragma unroll
          for (int j = 0; j < 8; ++j) { const f32x2 cs = rp[j]; const float x1 = bf2f((unsigned short)qf[4][j]), x2 = bf2f((unsigned short)qf[5][j]);
              qf[4][j] = (short)f2bf(x1 * cs.x - x2 * cs.y); qf[5][j] = (short)f2bf(x2 * cs.x + x1 * cs.y); } } }
    const bf16_t* sp[3]; int sstep[3], lo[3];
#pragma unroll
    for (int k = 0; k < 2; ++k) { const int c = tid + k * 512; const int key = c / 12, part = c - key * 12; lo[k] = key * AT_KP + part * 16;
        if (part < 8) { sp[k] = KN + (size_t)(krow0 + key) * 512 + h * 64 + part * 8; sstep[k] = 64 * 512; } else { sp[k] = P + (size_t)(krow0 + key) * INW + 1408 + (part - 8) * 8; sstep[k] = 64 * INW; } }
    { const int dv = tid >> 3, kc = tid & 7; lo[2] = dv * AT_VP + (kc >> 1) * 32 + (kc & 1) * 8;   sp[2] = VT + (size_t)(h * 64 + dv) * R + krow0 + kc * 8; sstep[2] = 64; }
    const bool hasK2 = tid < 256;
    u32x4 st[3];
#define AT_GLOADK() do { st[0] = *(const u32x4*)sp[0]; sp[0] += sstep[0]; if (hasK2) { st[1] = *(const u32x4*)sp[1]; sp[1] += sstep[1]; } } while (0)
#define AT_GLOADV() do { st[2] = *(const u32x4*)sp[2]; sp[2] += sstep[2]; } while (0)
#define AT_LSTOREK(buf) do { *(u32x4*)((buf) + lo[0]) = st[0]; if (hasK2) *(u32x4*)((buf) + lo[1]) = st[1]; } while (0)
#define AT_LSTOREV(buf) do { unsigned char* d_ = (buf) + lo[2]; *(u32x2*)d_ = (u32x2){st[2].x, st[2].y}; *(u32x2*)(d_ + 16) = (u32x2){st[2].z, st[2].w}; } while (0)
#define AT_SB() __builtin_amdgcn_sched_barrier(0)
    f32x16 o0, o1, sa0, sa1, sb0, sb1, negm;
#pragma unroll
    for (int r = 0; r < 16; ++r) { o0[r] = 0.f; o1[r] = 0.f; sa0[r] = 0.f; sa1[r] = 0.f; negm[r] = 0.f; }
    float mrun = 0.f, lsum = 0.f;
    __syncthreads();
    AT_GLOADK(); AT_GLOADV(); AT_LSTOREK(lds); AT_LSTOREV(lds + AT_V0);
    AT_GLOADK(); AT_GLOADV(); AT_LSTOREK(lds + AT_KB); AT_LSTOREV(lds + AT_V0 + AT_VBS);
    AT_GLOADK(); AT_LSTOREK(lds + 2 * AT_KB);
    __syncthreads();
    { const unsigned char* ka = lds + l32 * AT_KP + hi * 16;
#pragma unroll
      for (int d0 = 0; d0 < 6; ++d0) { const bf16x8 a0 = *(const bf16x8*)(ka + d0 * 32), a1 = *(const bf16x8*)(ka + 32 * AT_KP + d0 * 32);
          sa0 = __builtin_amdgcn_mfma_f32_32x32x16_bf16(a0, qf[d0], sa0, 0, 0, 0); sa1 = __builtin_amdgcn_mfma_f32_32x32x16_bf16(a1, qf[d0], sa1, 0, 0, 0); } }
#define AT_QKM(SB0, SB1, i) do { if ((i) == 0) SB0 = __builtin_amdgcn_mfma_f32_32x32x16_bf16(kfr[0], qf[0], negm, 0, 0, 0); else if ((i) == 1) SB1 = __builtin_amdgcn_mfma_f32_32x32x16_bf16(kfr[1], qf[0], negm, 0, 0, 0); \
        else if ((i) & 1) SB1 = __builtin_amdgcn_mfma_f32_32x32x16_bf16(kfr[(i)], qf[(i) >> 1], SB1, 0, 0, 0); else SB0 = __builtin_amdgcn_mfma_f32_32x32x16_bf16(kfr[(i)], qf[(i) >> 1], SB0, 0, 0, 0); } while (0)
#define AT_EXS(acc, SA0, SA1, e) do { if ((e) < 16) { SA0[(e) & 15] = __builtin_amdgcn_exp2f(SA0[(e) & 15]); acc += SA0[(e) & 15]; } else { SA1[(e) & 15] = __builtin_amdgcn_exp2f(SA1[(e) & 15]); acc += SA1[(e) & 15]; } } while (0)
#define AT_PACK(dst, S, r0) dst = pack8(S[(r0) + 0], S[(r0) + 1], S[(r0) + 2], S[(r0) + 3], S[(r0) + 4], S[(r0) + 5], S[(r0) + 6], S[(r0) + 7])
#define AT_MAX4(m0, m1, SB0, SB1, r0) do { m0 = __builtin_fmaxf(__builtin_fmaxf(m0, SB0[(r0) + 0]), SB0[(r0) + 1]); m1 = __builtin_fmaxf(__builtin_fmaxf(m1, SB1[(r0) + 0]), SB1[(r0) + 1]); \
        m0 = __builtin_fmaxf(__builtin_fmaxf(m0, SB0[(r0) + 2]), SB0[(r0) + 3]); m1 = __builtin_fmaxf(__builtin_fmaxf(m1, SB1[(r0) + 2]), SB1[(r0) + 3]); } while (0)
#define AT_STEP(SA0, SA1, SB0, SB1, tt) do { \
        const int t_ = (tt); const bool nxt_ = t_ + 1 < NT; \
        const unsigned char* kb_ = lds + ((t_ + 1) & 3) * AT_KB; const unsigned char* vb_ = lds + AT_V0 + (t_ & 3) * AT_VBS; \
        if (t_ + 3 < NT) AT_GLOADK(); \
        if (t_ + 2 < NT) AT_GLOADV(); \
        bf16x8 kfr[12]; bf16x8 vfr[8]; \
        { const unsigned char* ka = kb_ + l32 * AT_KP + hi * 16; \
          _Pragma("unroll") for (int d0 = 0; d0 < 6; ++d0) { kfr[2 * d0] = *(const bf16x8*)(ka + d0 * 32); kfr[2 * d0 + 1] = *(const bf16x8*)(ka + 32 * AT_KP + d0 * 32); } } \
        { const float mx = mxc; \
          if (t_ == 0 || __any(mx > 8.0f)) { \
              const float rm = fmaxf(mx, __shfl_xor(mx, 32)); const float delta = (t_ == 0) ? rm : fmaxf(rm, 0.f); const float alpha = (t_ == 0) ? 1.0f : __builtin_amdgcn_exp2f(-delta); \
              mrun += delta; \
              _Pragma("unroll") for (int r = 0; r < 16; ++r) { SA0[r] -= delta; SA1[r] -= delta; o0[r] *= alpha; o1[r] *= alpha; } \
              lsum *= alpha; { const float nm = -mrun; _Pragma("unroll") for (int r = 0; r < 16; ++r) negm[r] = nm; } } } \
        float ls0 = 0.f, ls1 = 0.f; \
        AT_SB(); __builtin_amdgcn_s_setprio(1); \
          \
        _Pragma("unroll") for (int i = 0; i < 8; ++i) { \
            AT_QKM(SB0, SB1, i); \
            _Pragma("unroll") for (int k_ = 0; k_ < 3; ++k_) { const int e_ = 3 * i + k_; if (e_ < 16) { SA0[e_ & 15] = __builtin_amdgcn_exp2f(SA0[e_ & 15]); asm volatile("" : "+v"(SA0[e_ & 15])); } else { SA1[e_ & 15] = __builtin_amdgcn_exp2f(SA1[e_ & 15]); asm volatile("" : "+v"(SA1[e_ & 15])); } } \
            AT_SB(); } \
        { const unsigned char* va = vb_ + l32 * AT_VP + hi * 16; \
          _Pragma("unroll") for (int kj = 0; kj < 4; ++kj) { vfr[2 * kj] = *(const bf16x8*)(va + kj * 32); vfr[2 * kj + 1] = *(const bf16x8*)(va + 32 * AT_VP + kj * 32); } } \
        bf16x8 pb[4]; \
        _Pragma("unroll") for (int i = 8; i < 12; ++i) { \
            AT_QKM(SB0, SB1, i); \
            _Pragma("unroll") for (int k_ = 0; k_ < 2; ++k_) { const int e_ = 24 + 2 * (i - 8) + k_; SA1[e_ & 15] = __builtin_amdgcn_exp2f(SA1[e_ & 15]); asm volatile("" : "+v"(SA1[e_ & 15])); } \
            if (i == 9) { AT_PACK(pb[0], SA0, 0); asm volatile("" : "+v"(pb[0])); } \
            if (i == 11) { AT_PACK(pb[1], SA0, 8); asm volatile("" : "+v"(pb[1])); } \
            AT_SB(); } \
        float mq0 = SB0[0], mq1 = SB1[0]; __builtin_amdgcn_s_setprio(2); \
        _Pragma("unroll") for (int kj = 0; kj < 4; ++kj) { \
            o0 = __builtin_amdgcn_mfma_f32_32x32x16_bf16(vfr[2 * kj], pb[kj], o0, 0, 0, 0); o1 = __builtin_amdgcn_mfma_f32_32x32x16_bf16(vfr[2 * kj + 1], pb[kj], o1, 0, 0, 0); \
            if (kj == 0) { AT_PACK(pb[2], SA1, 0); asm volatile("" : "+v"(pb[2])); } \
            if (kj == 1) { AT_PACK(pb[3], SA1, 8); asm volatile("" : "+v"(pb[3])); } \
            if (kj == 2) { if (t_ + 3 < NT) AT_LSTOREK(lds + ((t_ + 3) & 3) * AT_KB); if (t_ + 2 < NT) AT_LSTOREV(lds + AT_V0 + ((t_ + 2) & 3) * AT_VBS); }     \
            _Pragma("unroll") for (int r_ = 0; r_ < 4; ++r_) { ls0 += SA0[4 * kj + r_]; ls1 += SA1[4 * kj + r_]; } \
            mq0 = __builtin_fmaxf(__builtin_fmaxf(mq0, SB0[4 * kj]), SB0[4 * kj + 1]); mq1 = __builtin_fmaxf(__builtin_fmaxf(mq1, SB1[4 * kj]), SB1[4 * kj + 1]); \
            mq0 = __builtin_fmaxf(__builtin_fmaxf(mq0, SB0[4 * kj + 2]), SB0[4 * kj + 3]); mq1 = __builtin_fmaxf(__builtin_fmaxf(mq1, SB1[4 * kj + 2]), SB1[4 * kj + 3]); \
            asm volatile("" : "+v"(mq0), "+v"(mq1), "+v"(ls0), "+v"(ls1)); AT_SB(); } \
        lsum += ls0 + ls1; \
        __builtin_amdgcn_s_setprio(0); mxc = __builtin_fmaxf(mq0, mq1);            \
        if (t_ & 1) __syncthreads(); \
    } while (0)
    float mxc = at_max32(sa0, sa1);
    for (int t = 0; t < NT; t += 2) { AT_STEP(sa0, sa1, sb0, sb1, t); AT_STEP(sb0, sb1, sa0, sa1, t + 1); }
    lsum += __shfl_xor(lsum, 32);
    const float inv = 1.0f / lsum;
    bf16_t* op = MIX + (size_t)qrow * 1024 + 256 + h * 64 + 4 * hi;
#pragma unroll
    for (int g4 = 0; g4 < 4; ++g4) { u32x2 w0, w1; w0.x = pk2(o0[4 * g4] * inv, o0[4 * g4 + 1] * inv); w0.y = pk2(o0[4 * g4 + 2] * inv, o0[4 * g4 + 3] * inv);
        w1.x = pk2(o1[4 * g4] * inv, o1[4 * g4 + 1] * inv); w1.y = pk2(o1[4 * g4 + 2] * inv, o1[4 * g4 + 3] * inv);
        *(u32x2*)(op + 8 * g4) = w0; *(u32x2*)(op + 32 + 8 * g4) = w1; }
#undef AT_GLOADK
#undef AT_GLOADV
#undef AT_LSTOREK
#undef AT_LSTOREV
#undef AT_STEP
#undef AT_QKM
#undef AT_EXS
#undef AT_PACK
#undef AT_MAX4
#undef AT_SB
}

constexpr int RT_VP = 264, RT_SP = 144, RT_VB = 2 * 64 * RT_VP;
DEV void retout_unit(const Params& p, int l, unsigned char* lds, int u, bool early) {
    const int tid = otid(), lane = tid & 63, wid = tid >> 6, l32 = lane & 31, hi = lane >> 5;
    const int gc = u >> 1, hp = u & 1; const int cb = gc % 66; const bool lat = cb >= 2; const int t0 = (cb - 2) * 128; const int r0 = gc * 128;
    const bf16_t* P = (const bf16_t*)p.out; bf16_t* MIX = (bf16_t*)(p.ws + OFF_HN); const f32x2* rope = (const f32x2*)(p.ws + OFF_ROPE);
    const float* SIN = (const float*)(p.ws + OFF_OV + OV_SIN);
    bf16_t* VTl = (bf16_t*)lds; bf16_t* STl = (bf16_t*)(lds + RT_VB);
    __syncthreads();
    for (int task = tid; task < 2048; task += NWG_T) { const int hh = task >> 10, key = (task >> 3) & 127, ch = task & 7;
        const bf16x8 v = *(const bf16x8*)(P + (size_t)(r0 + key) * INW + 256 + (2 * hp + hh) * 64 + ch * 8);
#pragma unroll
        for (int j = 0; j < 8; ++j) VTl[(hh * 64 + ch * 8 + j) * (RT_VP / 2) + key] = (bf16_t)v[j]; }
    for (int task = tid; task < 8192; task += NWG_T) { const int dv = task & 63, k = (task >> 6) & 31, dir = (task >> 11) & 1, hh = task >> 12;
        float sv;
        if (!early) sv = SIN[((size_t)(gc * 4 + 2 * hp + hh) * 2 + dir) * 2048 + k * 64 + dv];
        else { const int og = dir == 0 ? gc - 1 : gc + 1; const bool zero = dir == 0 ? (cb == 0) : (cb == 1);
               sv = zero ? 0.f : ((const float*)(p.ws + OFF_OV + OV_SLOC))[((size_t)(og * 4 + 2 * hp + hh) * 2 + dir) * 2048 + k * 64 + dv]; }
        STl[(hh * 64 + dv) * (RT_SP / 2) + dir * 32 + k] = (bf16_t)f2bf(sv); }
    __syncthreads();
    const int hh = wid >> 2, h = 2 * hp + hh, qblk = wid & 3; const int n = 32 * qblk + l32; const int rq = r0 + n;
    const float lf = log2_sigmoid(p.ret_decay_f[l * 4 + h]), lb = log2_sigmoid(p.ret_decay_b[l * 4 + h]);
    float qv0[8], qv1[8]; bf16x8 qf0, qf1;
    { const bf16_t* qp = P + (size_t)rq * INW + h * 32 + 8 * hi; const bf16x8 a = *(const bf16x8*)qp, c2 = *(const bf16x8*)(qp + 16);
#pragma unroll
      for (int j = 0; j < 8; ++j) { float x1 = bf2f((unsigned short)a[j]), x2 = bf2f((unsigned short)c2[j]);
          if (lat) { const f32x2 cs = rope[(size_t)(t0 + n) * 16 + 8 * hi + j]; const float y1 = x1 * cs.x - x2 * cs.y, y2 = x2 * cs.x + x1 * cs.y; x1 = y1; x2 = y2; }
          qv0[j] = x1; qv1[j] = x2; }
      qf0 = pack8(qv0[0], qv0[1], qv0[2], qv0[3], qv0[4], qv0[5], qv0[6], qv0[7]); qf1 = pack8(qv1[0], qv1[1], qv1[2], qv1[3], qv1[4], qv1[5], qv1[6], qv1[7]); }
    f32x16 o0, o1;
#pragma unroll
    for (int r = 0; r < 16; ++r) { o0[r] = 0.f; o1[r] = 0.f; }
    const unsigned char* vbase = (const unsigned char*)VTl + (size_t)(hh * 64 + l32) * RT_VP + hi * 8;
    bf16x8 kga[4], kgc[4];
#pragma unroll
    for (int kb = 0; kb < 4; ++kb) { const bf16_t* kp = P + (size_t)(r0 + 32 * kb + l32) * INW + 128 + h * 32 + 8 * hi; kga[kb] = *(const bf16x8*)kp; kgc[kb] = *(const bf16x8*)(kp + 16); }
    __builtin_amdgcn_sched_barrier(0);
#pragma unroll
    for (int kb = 0; kb < 4; ++kb) {
        bf16x8 kf0, kf1;
        { const int key = 32 * kb + l32; const bf16x8 a = kga[kb], c2 = kgc[kb];
          float y1[8], y2[8];
#pragma unroll
          for (int j = 0; j < 8; ++j) { float x1 = bf2f((unsigned short)a[j]), x2 = bf2f((unsigned short)c2[j]);
              if (lat) { const f32x2 cs = rope[(size_t)(t0 + key) * 16 + 8 * hi + j]; const float z1 = x1 * cs.x - x2 * cs.y, z2 = x2 * cs.x + x1 * cs.y; x1 = z1; x2 = z2; }
              y1[j] = x1 * 0.17677669529663687f; y2[j] = x2 * 0.17677669529663687f; }
          kf0 = pack8(y1[0], y1[1], y1[2], y1[3], y1[4], y1[5], y1[6], y1[7]); kf1 = pack8(y2[0], y2[1], y2[2], y2[3], y2[4], y2[5], y2[6], y2[7]); }
        f32x16 s;
#pragma unroll
        for (int r = 0; r < 16; ++r) s[r] = 0.f;
        s = __builtin_amdgcn_mfma_f32_32x32x16_bf16(kf0, qf0, s, 0, 0, 0); s = __builtin_amdgcn_mfma_f32_32x32x16_bf16(kf1, qf1, s, 0, 0, 0);
#pragma unroll
        for (int r = 0; r < 16; ++r) { const int m = 32 * kb + crow(r, hi); const int dl = n - m; const float e = dl >= 0 ? lf * (float)dl : lb * (float)(-dl); s[r] *= __builtin_amdgcn_exp2f(e); }
#pragma unroll
        for (int jp = 0; jp < 2; ++jp) { const bf16x8 pb = pack8(s[8 * jp + 0], s[8 * jp + 1], s[8 * jp + 2], s[8 * jp + 3], s[8 * jp + 4], s[8 * jp + 5], s[8 * jp + 6], s[8 * jp + 7]);
            const unsigned char* vp = vbase + (32 * kb + 16 * jp) * 2;
            const u32x2 a00 = *(const u32x2*)vp, a01 = *(const u32x2*)(vp + 16), a10 = *(const u32x2*)(vp + 32 * RT_VP), a11 = *(const u32x2*)(vp + 32 * RT_VP + 16);
            const bf16x8 A0 = __builtin_bit_cast(bf16x8, (u32x4){a00.x, a00.y, a01.x, a01.y}), A1 = __builtin_bit_cast(bf16x8, (u32x4){a10.x, a10.y, a11.x, a11.y});
            o0 = __builtin_amdgcn_mfma_f32_32x32x16_bf16(A0, pb, o0, 0, 0, 0); o1 = __builtin_amdgcn_mfma_f32_32x32x16_bf16(A1, pb, o1, 0, 0, 0); }
    }
    { const float df = __builtin_amdgcn_exp2f(lf * (float)(n + 1)), db = __builtin_amdgcn_exp2f(lb * (float)(128 - n));
      const unsigned char* sbase = (const unsigned char*)STl + (size_t)(hh * 64 + l32) * RT_SP + hi * 16;
#pragma unroll
      for (int ks = 0; ks < 4; ++ks) { const float dd = ks < 2 ? df : db;
          const bf16x8 qb = (ks & 1) ? pack8(qv1[0] * dd, qv1[1] * dd, qv1[2] * dd, qv1[3] * dd, qv1[4] * dd, qv1[5] * dd, qv1[6] * dd, qv1[7] * dd)
                                     : pack8(qv0[0] * dd, qv0[1] * dd, qv0[2] * dd, qv0[3] * dd, qv0[4] * dd, qv0[5] * dd, qv0[6] * dd, qv0[7] * dd);
          const bf16x8 A0 = *(const bf16x8*)(sbase + ks * 32), A1 = *(const bf16x8*)(sbase + 32 * RT_SP + ks * 32);
          o0 = __builtin_amdgcn_mfma_f32_32x32x16_bf16(A0, qb, o0, 0, 0, 0); o1 = __builtin_amdgcn_mfma_f32_32x32x16_bf16(A1, qb, o1, 0, 0, 0); } }
    float ssq = 0.f;
#pragma unroll
    for (int r = 0; r < 16; ++r) ssq += o0[r] * o0[r] + o1[r] * o1[r];
    ssq += __shfl_xor(ssq, 32);
    const float rstd = rsqrtf(ssq * (1.f / 64.f) + EPS);
    const bf16_t* gp = P + (size_t)rq * INW + 512 + h * 64 + 4 * hi; bf16_t* op = MIX + (size_t)rq * 1024 + h * 64 + 4 * hi;
#pragma unroll
    for (int g4 = 0; g4 < 4; ++g4) { const u32x2 ga = *(const u32x2*)(gp + 8 * g4), gb = *(const u32x2*)(gp + 32 + 8 * g4);
        u32x2 w0, w1;
        w0.x = pk2(o0[4 * g4] * rstd * siluf(bf2f(ga.x & 0xffff)), o0[4 * g4 + 1] * rstd * siluf(bf2f(ga.x >> 16))); w0.y = pk2(o0[4 * g4 + 2] * rstd * siluf(bf2f(ga.y & 0xffff)), o0[4 * g4 + 3] * rstd * siluf(bf2f(ga.y >> 16)));
        w1.x = pk2(o1[4 * g4] * rstd * siluf(bf2f(gb.x & 0xffff)), o1[4 * g4 + 1] * rstd * siluf(bf2f(gb.x >> 16))); w1.y = pk2(o1[4 * g4 + 2] * rstd * siluf(bf2f(gb.y & 0xffff)), o1[4 * g4 + 3] * rstd * siluf(bf2f(gb.y >> 16)));
        *(u32x2*)(op + 8 * g4) = w0; *(u32x2*)(op + 32 + 8 * g4) = w1; }
}

DEV void phase_ffn_fixup(const Params& p, int l) {
    const float* EDGE = (const float*)(p.ws + OFF_EDGE); bf16_t* ACT = (bf16_t*)(p.ws + OFF_OV);
    const float* cw = p.conv_w + (size_t)l * 3 * 5632; const float* cbv = p.conv_b + (size_t)l * 5632;
    for (int idx = blockIdx.x * NWG_T + otid(); idx < 66 * 2 * 704; idx += gridDim.x * NWG_T) {
        const int ch4 = idx % 704, rest = idx / 704; const int which = rest & 1, pm = rest >> 1; const int jj = pm % 33;
        if (l == 1 && jj == 0) continue;
        const int ch = 4 * ch4, pn = ch >> 7, c = ch & 127;
        const bool sstart = jj <= 1, send = (jj == 0) || (jj == 32);
        const f32x4 zz = {0.f, 0.f, 0.f, 0.f};
#define EDG(tile, k, half) (*(const f32x4*)(EDGE + ((size_t)((tile) * 4 + (k)) * 22 + pn) * 256 + (half) * 128 + c))
        f32x4 ua, ub, ca, cb2, da, db;
        if (which == 0) { ua = sstart ? zz : EDG(pm - 1, 3, 0); ub = sstart ? zz : EDG(pm - 1, 3, 1); ca = EDG(pm, 0, 0); cb2 = EDG(pm, 0, 1); da = EDG(pm, 1, 0); db = EDG(pm, 1, 1); }
        else { ua = EDG(pm, 2, 0); ub = EDG(pm, 2, 1); ca = EDG(pm, 3, 0); cb2 = EDG(pm, 3, 1); da = send ? zz : EDG(pm + 1, 0, 0); db = send ? zz : EDG(pm + 1, 0, 1); }
#undef EDG
        const f32x4 wa0 = *(const f32x4*)(cw + ch), wa1 = *(const f32x4*)(cw + 5632 + ch), wa2 = *(const f32x4*)(cw + 2 * 5632 + ch), ba = *(const f32x4*)(cbv + ch);
        const f32x4 wb0 = *(const f32x4*)(cw + DFF + ch), wb1 = *(const f32x4*)(cw + 5632 + DFF + ch), wb2 = *(const f32x4*)(cw + 2 * 5632 + DFF + ch), bb = *(const f32x4*)(cbv + DFF + ch);
        const f32x4 xa = wa0 * ua + wa1 * ca + wa2 * da + ba, xb = wb0 * ub + wb1 * cb2 + wb2 * db + bb;
        u32x2 w; w.x = pk2(siluf(xa.x) * xb.x, siluf(xa.y) * xb.y); w.y = pk2(siluf(xa.z) * xb.z, siluf(xa.w) * xb.w);
        *(u32x2*)(ACT + (size_t)(pm * 256 + (which ? 255 : 0)) * DFF + ch) = w;
    }
}

#define RLX_AGENT __ATOMIC_RELAXED, __HIP_MEMORY_SCOPE_AGENT
#define XB_TMO      128
#define XB_XCNT(j)  (256  + 64 * (j))
#define XB_XSUB(j)  (1280 + 64 * (j))
#define XB_XGEN(j)  (2304 + 64 * (j))
#define XB_TOP      3328
#define XB_TOPGEN   3392
#define XCD_BAR_WORDS 3456
#define XB_SPIN_CAP (1u << 18)

__device__ __forceinline__ unsigned xb_ld(unsigned* p)              { return __hip_atomic_load(p, __ATOMIC_RELAXED, __HIP_MEMORY_SCOPE_AGENT); }
__device__ __forceinline__ unsigned xb_add(unsigned* p, unsigned v) { return __hip_atomic_fetch_add(p, v, __ATOMIC_RELAXED, __HIP_MEMORY_SCOPE_AGENT); }
__device__ __forceinline__ unsigned xb_xcc_id() { return (unsigned)__builtin_amdgcn_s_getreg((3 << 11) | 20) & 0xFu; }
#define XB_SPIN(cond, bar) do { unsigned _sp = 0; while (cond) { __builtin_amdgcn_s_sleep(1); \
    if ((++_sp & 255u) == 0u) { if (xb_ld(&(bar)[XB_TMO])) break; if (_sp > XB_SPIN_CAP) { atomicAdd(&(bar)[XB_TMO], 1u); break; } } } } while (0)

struct XcdBarrier {
    unsigned* bar; unsigned x;
    volatile LAS unsigned* st;
};

__device__ __forceinline__ XcdBarrier xcd_barrier_post(unsigned* bar, volatile LAS unsigned* st) {
    XcdBarrier b; b.bar = bar; b.x = xb_xcc_id(); b.st = st;
    if (threadIdx.x == 0) (void)xb_add(&bar[XB_XCNT(b.x)], 1u);
    return b;
}
__device__ __forceinline__ void xcd_barrier_complete(unsigned* bar, unsigned x, unsigned& nloc, unsigned& nx) {
    const unsigned G = gridDim.x * gridDim.y * gridDim.z;
    unsigned sum, cnt, mine, sp = 0u;
    for (;;) {
        sum = 0u; cnt = 0u; mine = 0u;
#pragma unroll
        for (unsigned j = 0; j < 16; ++j) { const unsigned c = xb_ld(&bar[XB_XCNT(j)]); sum += c; cnt += (c > 0u) ? 1u : 0u; mine = (j == x) ? c : mine; }
        if (sum == G) break;
        __builtin_amdgcn_s_sleep(1);
        if ((++sp & 255u) == 0u) { if (xb_ld(&bar[XB_TMO])) break; if (sp > XB_SPIN_CAP) { atomicAdd(&bar[XB_TMO], 1u); break; } }
    }
    nloc = mine > 0u ? mine : 1u; nx = cnt > 0u ? cnt : 1u;
}

__device__ __forceinline__ void xcd_barrier(const XcdBarrier& b) {
    asm volatile("s_waitcnt vmcnt(0)" ::: "memory");
    __syncthreads();
    if (threadIdx.x == 0) {
        unsigned* bar = b.bar;
        __builtin_amdgcn_s_waitcnt(0);
        unsigned nloc = b.st[0], nx = b.st[1];
        if (nloc == 0u) { xcd_barrier_complete(bar, b.x, nloc, nx); b.st[0] = nloc; b.st[1] = nx; }
        const unsigned old = xb_add(&bar[XB_XSUB(b.x)], 1u);
        const unsigned gen = old / nloc;
        if (old + 1u == (gen + 1u) * nloc) {
            __builtin_amdgcn_fence(__ATOMIC_RELEASE, "agent");
            asm volatile("s_waitcnt vmcnt(0)" ::: "memory");
            const unsigned og = xb_add(&bar[XB_TOP], 1u);
            const unsigned tg = og / nx;
            if (og + 1u == (tg + 1u) * nx) xb_add(&bar[XB_TOPGEN], 1u);
            else XB_SPIN(xb_ld(&bar[XB_TOPGEN]) == tg, bar);
            __builtin_amdgcn_fence(__ATOMIC_ACQUIRE, "agent");
            xb_add(&bar[XB_XGEN(b.x)], 1u);
            asm volatile("s_waitcnt vmcnt(0)" ::: "memory");
        } else {
            XB_SPIN(xb_ld(&bar[XB_XGEN(b.x)]) == gen, bar);
            __builtin_amdgcn_fence(__ATOMIC_ACQUIRE, "agent");
            asm volatile("s_waitcnt vmcnt(0)" ::: "memory");
        }
    }
    __syncthreads();
}


constexpr size_t OFF_CTL = 250000128; constexpr int CTL_BYTES = 16384;
#if defined(__HIP_DEVICE_COMPILE__)
#define KP() const __attribute__((address_space(4))) Params* kp_ = (const __attribute__((address_space(4))) Params*)__builtin_amdgcn_kernarg_segment_ptr(); asm volatile("" : "+s"(kp_)); const Params p = *kp_; \
    bf16_t* HN = (bf16_t*)(p.ws + OFF_HN); bf16_t* P = (bf16_t*)p.out; float* X = (float*)(p.ws + OFF_X); (void)HN; (void)P; (void)X
#else
#define KP() const Params p = p_arg; bf16_t* HN = (bf16_t*)(p.ws + OFF_HN); bf16_t* P = (bf16_t*)p.out; float* X = (float*)(p.ws + OFF_X); (void)HN; (void)P; (void)X
#endif
#define WL() const bf16_t* wl = (const bf16_t*)(p.ws + OFF_W) + (size_t)l * W_LAYER; const float* modv = (const float*)(p.ws + OFF_MOD) + (size_t)l * 3 * 6144; (void)wl; (void)modv
#ifndef DUPM
#define DUPM 0
#endif
#define REP(bit) for (int rep_ = 0; rep_ < (((DUPM) >> (bit)) & 1) + 1; ++rep_)
constexpr int PH_PER_LAYER = 10, N_PHASES = 2 + 2 * PH_PER_LAYER;
__global__ void __launch_bounds__(512, 2) mk_fwd(Params p_arg) {
    extern __shared__ __attribute__((aligned(16))) unsigned char lds[];
    cg::grid_group grid = cg::this_grid();
    const int G = gridDim.x, bx = blockIdx.x; const int vcu = (G % 8 == 0) ? (bx % 8) * (G / 8) + bx / 8 : bx;
    LAS unsigned char* ldsl = (LAS unsigned char*)lds;
    const int ph_lo = p_arg.ph_lo, ph_hi = p_arg.ph_hi;
    volatile LAS unsigned* misc = (volatile LAS unsigned*)(ldsl + (LDS_BYTES - 64));
    { const int t0_ = otid(); if (t0_ < 16) misc[t0_] = 0u; }
    __syncthreads();
    if (ph_hi - ph_lo > 1) (void)xcd_barrier_post((unsigned*)(p_arg.ws + OFF_CTL), misc);
    for (int ph = ph_lo; ph < ph_hi; ++ph) {
        if (ph == 0) { KP(); phase_prep(p, lds); __syncthreads(); }
        else if (ph == N_PHASES - 1) { KP(); phase_final(p);
#if (DUPM >> 10) & 1
            for (int i = 0; i < 20; ++i) grid.sync();
#endif
        }
        else {
            const int l = (ph - 1) / PH_PER_LAYER, sp = (ph - 1) % PH_PER_LAYER;
            if (sp == 0) { KP(); if (l == 0) REP(9) { phase_prep_weights(p, lds); __syncthreads(); }
                phase_norm(p, l, 0, l == 0, l == 1 ? (const float*)(p.ws + OFF_MOD) + 2 * 6144 + 5120 : nullptr, (const float*)p.out, 11); }
            else if (sp == 1) { KP(); WL(); REP(1) { __syncthreads();
                pg8::Gemm g{HN, wl + W_IN, R, 1792, 1024, 1024, 1024}; pg8::StaticOrder S; S.init(R, 1792, G, bx);
                pg8::EpiStore E{P, INW, INW, 1.0f};
                pg8::gemm_phase<pg8::EpiStore, pg8::StaticOrder, true, true>(ldsl, g, S, E); } }
            else if (sp == 2) { KP(); phase_rowwise(p, l); __syncthreads();
                REP(2) phase_pool(p);
                REP(3) for (int it = G - 1 - bx; it < 264; it += G) states_item(p, l, lds, it); __syncthreads(); }
            else if (sp == 3) { KP(); WL(); REP(4) { __syncthreads();
                { pg8::Gemm g{P + 768, wl + W_UQ, R, 768, 384, INW, 384}; pg8::StaticOrder S; S.init(R, 768, G, bx);
                  pg8::EpiStore E{(bf16_t*)(p.ws + OFF_OV + OV_Q), 768, 768, 0.14724444f};
                  pg8::gemm_phase<pg8::EpiStore, pg8::StaticOrder, true, true>(ldsl, g, S, E); }
                __syncthreads();
                { pg8::Gemm g{P + 1152, wl + W_KN, R, 512, 256, INW, 256}; pg8::StaticOrder S; S.init(R, 512, G, (bx + 58) % G);
                  pg8::EpiStore E{(bf16_t*)(p.ws + OFF_OV + OV_KN), 512, 512, 1.0f};
                  pg8::gemm_phase<pg8::EpiStore, pg8::StaticOrder, true, true>(ldsl, g, S, E); }
                __syncthreads();
                { pg8::Gemm g{wl + W_V, P + 1152, 512, R, 256, 256, INW}; pg8::StaticOrder S; S.init(512, R, G, (bx + 182) % G);
                  pg8::EpiStore E{(bf16_t*)(p.ws + OFF_OV + OV_VT), R, R, 1.0f};
                  pg8::gemm_phase<pg8::EpiStore, pg8::StaticOrder, true, true>(ldsl, g, S, E); }
                if (bx >= G - 64) scan_threads(p, l, (bx - (G - 64)) * NWG_T + otid());
                if (l == 0 && bx >= G - 50 && bx < G - 42) { const int i8 = bx - (G - 50); const int gcs = (i8 >> 1) < 2 ? (i8 >> 1) : 64 + (i8 >> 1); retout_unit(p, l, lds, gcs * 2 + (i8 & 1), true); } } }
            else if (sp == 4) { KP();
                REP(5) for (int u = vcu; u < (l == 0 ? 528 : 512); u += G) attn_unit(p, lds, u);
                REP(6) for (int u = G - 1 - bx; u < 256; u += G) retout_unit(p, l, lds, u + 4 * (u >> 7) + 4, false); }
            else if (sp == 5) { KP(); WL(); __syncthreads();
                { pg8::Gemm g{HN, wl + W_OUT, R, 1024, 1024, 1024, 1024}; pg8::StaticOrder S; S.init(16384, 1024, G, bx, 1);
                  pg8::EpiResid E{X, modv + 2048, 0};
                  pg8::gemm_phase<pg8::EpiResid, pg8::StaticOrder, true, true>(ldsl, g, S, E); }
                if (l == 0 && bx < 32) { __syncthreads(); const int q = bx >> 3;
                  pg8::Gemm g{HN + q * 256, wl + W_OUT + q * 256, 512, 1024, 256, 1024, 1024}; pg8::StaticOrder S; S.init(512, 1024, G, bx & 7, 2);
                  pg8::EpiPart E{(float*)(p.ws + OFF_PART) + (size_t)q * 524288, 0};
                  pg8::gemm_phase<pg8::EpiPart, pg8::StaticOrder, true, true>(ldsl, g, S, E); } }
            else if (sp == 6) { KP(); WL(); phase_norm(p, l, 1, false, l == 0 ? modv + 2 * 6144 + 2048 : nullptr, (const float*)(p.ws + OFF_PART), 4); }
            else if (sp == 7) { KP(); WL(); REP(7) { __syncthreads();
                pg8::Gemm g{HN, wl + W_UP, R, 2 * DFF, 1024, 1024, 1024}; pg8::StaticOrder S; S.init(l == 1 ? 16384 : R, 2 * DFF, G, bx, l == 1 ? 1 : 0);
                pg8::EpiFfn E{(bf16_t*)(p.ws + OFF_OV), (float*)(p.ws + OFF_EDGE), p.conv_w + (size_t)l * 3 * 5632, p.conv_b + (size_t)l * 5632, (LAS float*)(ldsl + 131072)};
                pg8::gemm_phase<pg8::EpiFfn, pg8::StaticOrder, true, true>(ldsl, g, S, E); } }
            else if (sp == 8) { KP(); REP(8) phase_ffn_fixup(p, l); }
            else if (sp == 9) { KP(); WL(); __syncthreads();
                { pg8::Gemm g{(const bf16_t*)(p.ws + OFF_OV), wl + W_DN, R, 1024, DFF, DFF, DFF}; pg8::StaticOrder S; S.init(16384, 1024, G, bx, 1);
                  pg8::EpiResid E{X, modv + 5120, 0};
                  pg8::gemm_phase<pg8::EpiResid, pg8::StaticOrder, true, true>(ldsl, g, S, E); }
                if (l == 0 && bx < 88) { __syncthreads(); const int q = bx >> 3; const int koff = q * 256, klen = 256;
                  pg8::Gemm g{(const bf16_t*)(p.ws + OFF_OV) + koff, wl + W_DN + koff, 512, 1024, klen, DFF, DFF}; pg8::StaticOrder S; S.init(512, 1024, G, bx & 7, 2);
                  pg8::EpiPart E{(float*)p.out + (size_t)q * 524288, 0};
                  pg8::gemm_phase<pg8::EpiPart, pg8::StaticOrder, true, true>(ldsl, g, S, E); } }
        }
        if (ph + 1 < ph_hi) {
            if (ph_lo < 0) grid.sync();
            { KP(); XcdBarrier b; b.bar = (unsigned*)(p.ws + OFF_CTL); b.x = xb_xcc_id(); b.st = misc; xcd_barrier(b); }
        }
    }
}

extern "C" void kernel_launch(void* const* d_in, const int* in_sizes, int n_in, void* d_out, int out_size, void* d_ws, size_t ws_size, hipStream_t stream) {
    static int grid = 0;
    if (grid == 0) {
        if (n_in != 23 || ws_size < WS_NEED) { fprintf(stderr, "kernel_launch: unexpected problem (n_in %d, ws %zu, need %zu)\n", n_in, ws_size, (size_t)WS_NEED); grid = -1; return; }
        int dev = 0, cus = 0, per_cu = 0;
        hipGetDevice(&dev); hipDeviceGetAttribute(&cus, hipDeviceAttributeMultiprocessorCount, dev);
        if (hipFuncSetAttribute((const void*)mk_fwd, hipFuncAttributeMaxDynamicSharedMemorySize, LDS_BYTES) != hipSuccess) { fprintf(stderr, "kernel_launch: hipFuncSetAttribute failed\n"); grid = -1; return; }
        if (hipOccupancyMaxActiveBlocksPerMultiprocessor(&per_cu, (const void*)mk_fwd, 512, LDS_BYTES) != hipSuccess || per_cu < 1) { fprintf(stderr, "kernel_launch: occupancy query says %d\n", per_cu); per_cu = 1; }
        (void)hipGetLastError();
        grid = cus * per_cu; if (grid > 256) grid = 256;
        fprintf(stderr, "kernel_launch: grid %d (cus %d, per_cu %d)\n", grid, cus, per_cu);
    }
    if (grid < 0) return;
    Params p{};
    const float** pp = (const float**)&p;
    for (int i = 0; i < 23; ++i) pp[i] = (const float*)d_in[i];
    p.out = (float*)d_out; p.ws = (unsigned char*)d_ws;
#if MK_MULTI
    for (int ph = 0; ph < N_PHASES; ++ph) { p.ph_lo = ph; p.ph_hi = ph + 1; void* args[] = {&p};
        hipError_t e = hipLaunchCooperativeKernel((void*)mk_fwd, dim3(grid), dim3(512), args, LDS_BYTES, stream);
        if (e != hipSuccess) { fprintf(stderr, "launch %d failed: %s\n", ph, hipGetErrorString(e)); break; } }
#else
    if (hipMemsetAsync((char*)d_ws + OFF_CTL, 0, CTL_BYTES, stream) != hipSuccess) { fprintf(stderr, "kernel_launch: memset of the barrier words failed\n"); return; }
    p.ph_lo = 0; p.ph_hi = N_PHASES; void* args[] = {&p};
    hipError_t e = hipLaunchCooperativeKernel((void*)mk_fwd, dim3(grid), dim3(512), args, LDS_BYTES, stream);
    if (e != hipSuccess) fprintf(stderr, "cooperative launch failed: %s (grid %d)\n", hipGetErrorString(e), grid);
#endif
}
```

```cpp
#include <hip/hip_runtime.h>
#include <hip/hip_cooperative_groups.h>
#include <cstdio>
#include <cstdint>
namespace cg = cooperative_groups;

#ifndef MK_MULTI
#define MK_MULTI 0
#endif

namespace pg8 {
#define PG8_LAS __attribute__((address_space(3)))
typedef unsigned short bf16_t;
typedef short bf16x8 __attribute__((ext_vector_type(8)));
typedef float f32x4 __attribute__((ext_vector_type(4)));
typedef unsigned u32x4 __attribute__((ext_vector_type(4)));
constexpr int BM = 256, BK = 64, HALF = 128, HTB = HALF * BK * 2  , STAGE_BYTES = 8 * HTB, NXCD = 8, WGM = 8;

__host__ __device__ __forceinline__ int lds_byte(int r, int c) { const int st = (r >> 4) * 2 + (c >> 5), rr = r & 15, cc = c & 31, ob = rr * 64 + cc * 2; return st * 1024 + (ob ^ (((ob >> 9) & 1) << 5)); }
__host__ __device__ __forceinline__ void stage_rc(int b, int& R, int& C) { const int st = b / 1024, sb = b % 1024, swz = sb ^ (((sb >> 9) & 1) << 5); R = (st >> 1) * 16 + swz / 64; C = (st & 1) * 32 + (swz % 64) / 2; }
__host__ __device__ __forceinline__ int perm32(int rho) { const int n = rho >> 4, i = rho & 15; return 8 * (i >> 2) + 4 * n + (i & 3); }

struct Unit { int pm, pn; };
struct Gemm { const bf16_t* A; const bf16_t* Bt; int M, N, K, lda, ldb; };

struct StaticOrder {
    int nM, nN, nwg, G, c, skip;
    __host__ __device__ void init(int M, int N, int G_, int c_, int skip_ = 0) { nM = M / BM; nN = N / BM; nwg = nM * nN; G = G_; c = c_; skip = skip_; }
    __host__ __device__ bool next(int i, Unit& u) const {
        const long L = (long)i * G + c; if (L >= nwg) return false;
        int wgid = (int)L; { const int q = nwg / NXCD, r = nwg % NXCD, xcd = wgid % NXCD, off = wgid / NXCD; wgid = (xcd < r ? xcd * (q + 1) : r * (q + 1) + (xcd - r) * q) + off; }
        const int nig = WGM * nN, gid = wgid / nig, fm = gid * WGM, gsz = (nM - fm) < WGM ? (nM - fm) : WGM;
        u.pm = fm + ((wgid % nig) % gsz); u.pn = (wgid % nig) / gsz; if (skip == 1) u.pm += 1 + (u.pm >= 32 ? 1 : 0); else if (skip == 2) u.pm *= 33; return true;
    }
    __device__ __forceinline__ void a_ready(const Unit&) const {}
    __device__ __forceinline__ void done(const Unit&) const {}
};

__device__ __forceinline__ unsigned cvt_pk_bf16(float lo, float hi) { unsigned r; asm volatile("v_cvt_pk_bf16_f32 %0, %1, %2" : "=v"(r) : "v"(lo), "v"(hi)); return r; }

struct EpiStore {
    static constexpr bool PERM = true, AFTER_DRAIN = false, APERM = false;
    bf16_t* O; int ldc; int ncols; float scale;
    __device__ __forceinline__ void operator()(const f32x4 (&acc)[2][2][4][2], const Unit& u, int wr, int wc, int fr, int fq) const {
        const int row0 = u.pm * BM + wr * 64 + fr; const int col0 = u.pn * BM + wc * 32 + 8 * fq;
#pragma unroll
        for (int ai = 0; ai < 2; ++ai)
#pragma unroll
            for (int m = 0; m < 4; ++m) { bf16_t* rowp = O + (size_t)(row0 + ai * HALF + m * 16) * ldc + col0;
#pragma unroll
                for (int bj = 0; bj < 2; ++bj) { if (col0 + bj * HALF < ncols) {
                    f32x4 v0 = acc[ai][bj][m][0] * scale, v1 = acc[ai][bj][m][1] * scale;
                    u32x4 w; w.x = cvt_pk_bf16(v0[0], v0[1]); w.y = cvt_pk_bf16(v0[2], v0[3]); w.z = cvt_pk_bf16(v1[0], v1[1]); w.w = cvt_pk_bf16(v1[2], v1[3]);
                    *(u32x4*)(rowp + bj * HALF) = w; } } }
    }
};
struct EpiResid {
    static constexpr bool PERM = false, AFTER_DRAIN = false, APERM = false;
    float* X; const float* gate; int row_tile0;
    __device__ __forceinline__ void operator()(const f32x4 (&acc)[2][2][4][2], const Unit& u, int wr, int wc, int fr, int fq) const {
        const int tpm = u.pm + row_tile0; const int bb = tpm / 33, jj = tpm - bb * 33; const float* gv = gate + (jj == 0 ? 2 : bb) * 6144;
        const int col0 = u.pn * BM + wc * 32 + 4 * fq;
#pragma unroll
        for (int ai = 0; ai < 2; ++ai)
#pragma unroll
            for (int m = 0; m < 4; ++m) { float* rowp = X + (size_t)(tpm * BM + ai * HALF + wr * 64 + m * 16 + fr) * 1024 + col0;
#pragma unroll
                for (int bj = 0; bj < 2; ++bj) {
#pragma unroll
                    for (int n = 0; n < 2; ++n) { f32x4* q = (f32x4*)(rowp + bj * HALF + n * 16); const f32x4 gq = *(const f32x4*)(gv + col0 + bj * HALF + n * 16); f32x4 xv = *q; xv = xv + gq * acc[ai][bj][m][n]; *q = xv; }
                    asm volatile("" ::: "memory"); } }
    }
};
struct EpiPart {
    static constexpr bool PERM = false, AFTER_DRAIN = false, APERM = false;
    float* out; int accum;
    __device__ __forceinline__ void operator()(const f32x4 (&acc)[2][2][4][2], const Unit& u, int wr, int wc, int fr, int fq) const {
        const int t = u.pm / 33; const int col0 = u.pn * BM + wc * 32 + 4 * fq;
#pragma unroll
        for (int ai = 0; ai < 2; ++ai)
#pragma unroll
            for (int m = 0; m < 4; ++m) { float* rowp = out + (size_t)(t * BM + ai * HALF + wr * 64 + m * 16 + fr) * 1024 + col0;
#pragma unroll
                for (int bj = 0; bj < 2; ++bj) {
#pragma unroll
                    for (int n = 0; n < 2; ++n) { f32x4* q = (f32x4*)(rowp + bj * HALF + n * 16); f32x4 v = acc[ai][bj][m][n]; if (accum) v = v + *q; *q = v; }
                    asm volatile("" ::: "memory"); } }
    }
};
template <int CTRL> __device__ __forceinline__ float dpp0(float x) { return __builtin_bit_cast(float, __builtin_amdgcn_update_dpp(0, __builtin_bit_cast(int, x), CTRL, 0xf, 0xf, true)); }
struct EpiFfn {
    static constexpr bool PERM = false, AFTER_DRAIN = false, APERM = true;
    bf16_t* ACT; float* EDGE; const float* cw; const float* cb; PG8_LAS float* xl;
    __device__ __forceinline__ void operator()(const f32x4 (&acc)[2][2][4][2], const Unit& u, int wr, int wc, int fr, int fq) const {
        PG8_LAS float* FIRST = xl; PG8_LAS float* LAST = xl + 1024;
        const int cb0 = wc * 32 + 4 * fq;
#pragma unroll
        for (int ai = 0; ai < 2; ++ai)
#pragma unroll
            for (int bj = 0; bj < 2; ++bj)
#pragma unroll
                for (int n = 0; n < 2; ++n) { const int col = bj * HALF + cb0 + n * 16;
                    if (fr == 0) *(PG8_LAS f32x4*)(FIRST + (2 * ai + wr) * 256 + col) = acc[ai][bj][0][n];
                    if (fr == 15) *(PG8_LAS f32x4*)(LAST + (2 * ai + wr) * 256 + col) = acc[ai][bj][3][n]; }
        if (wr == 0 && fr == 0) {
#pragma unroll
            for (int bj = 0; bj < 2; ++bj)
#pragma unroll
                for (int n = 0; n < 2; ++n) { float* ep = EDGE + ((size_t)(u.pm * 4) * 22 + u.pn) * 256 + bj * HALF + cb0 + n * 16; *(f32x4*)ep = acc[0][bj][0][n]; *(f32x4*)(ep + 22 * 256) = acc[0][bj][1][n]; } }
        if (wr == 1 && fr == 15) {
#pragma unroll
            for (int bj = 0; bj < 2; ++bj)
#pragma unroll
                for (int n = 0; n < 2; ++n) { float* ep = EDGE + ((size_t)(u.pm * 4 + 2) * 22 + u.pn) * 256 + bj * HALF + cb0 + n * 16; *(f32x4*)ep = acc[1][bj][2][n]; *(f32x4*)(ep + 22 * 256) = acc[1][bj][3][n]; } }
        asm volatile("s_waitcnt lgkmcnt(0)" ::: "memory"); __builtin_amdgcn_s_barrier(); asm volatile("" ::: "memory");
#pragma unroll
        for (int n = 0; n < 2; ++n) { const int ch0 = u.pn * HALF + cb0 + n * 16;
            f32x4 wa[3], wb[3];
#pragma unroll
            for (int k = 0; k < 3; ++k) { wa[k] = *(const f32x4*)(cw + k * 5632 + ch0); wb[k] = *(const f32x4*)(cw + k * 5632 + 2816 + ch0); }
            const f32x4 ba = *(const f32x4*)(cb + ch0), bb = *(const f32x4*)(cb + 2816 + ch0);
#pragma unroll
            for (int ai = 0; ai < 2; ++ai) { const int g = 2 * ai + wr;
                f32x4 bu[2], bd[2];
#pragma unroll
                for (int bj = 0; bj < 2; ++bj) { const int col = bj * HALF + cb0 + n * 16; const f32x4 zz = {0.f, 0.f, 0.f, 0.f};
                    bu[bj] = g > 0 ? *(const PG8_LAS f32x4*)(LAST + (g - 1) * 256 + col) : zz; bd[bj] = g < 3 ? *(const PG8_LAS f32x4*)(FIRST + (g + 1) * 256 + col) : zz; }
                float o[4][4];
#pragma unroll
                for (int e = 0; e < 4; ++e) { float cv[2][4];
#pragma unroll
                    for (int bj = 0; bj < 2; ++bj) { const float v0 = acc[ai][bj][0][n][e], v1 = acc[ai][bj][1][n][e], v2 = acc[ai][bj][2][n][e], v3 = acc[ai][bj][3][n][e];
                        const float w0 = bj ? wb[0][e] : wa[0][e], w1 = bj ? wb[1][e] : wa[1][e], w2 = bj ? wb[2][e] : wa[2][e], bs = bj ? bb[e] : ba[e];
                        const float upx = dpp0<0x111>(v3) + (fr == 0 ? bu[bj][e] : 0.f);
                        const float dnx = dpp0<0x101>(v0) + (fr == 15 ? bd[bj][e] : 0.f);
                        cv[bj][0] = w0 * upx + w1 * v0 + w2 * v1 + bs; cv[bj][1] = w0 * v0 + w1 * v1 + w2 * v2 + bs;
                        cv[bj][2] = w0 * v1 + w1 * v2 + w2 * v3 + bs;  cv[bj][3] = w0 * v2 + w1 * v3 + w2 * dnx + bs; }
#pragma unroll
                    for (int m = 0; m < 4; ++m) o[m][e] = cv[0][m] * __builtin_amdgcn_rcpf(1.0f + __builtin_amdgcn_exp2f(-1.4426950408889634f * cv[0][m])) * cv[1][m]; }
#pragma unroll
                for (int m = 0; m < 4; ++m) { typedef unsigned u32x2 __attribute__((ext_vector_type(2))); u32x2 w; w.x = cvt_pk_bf16(o[m][0], o[m][1]); w.y = cvt_pk_bf16(o[m][2], o[m][3]);
                    *(u32x2*)(ACT + (size_t)(u.pm * BM + ai * HALF + wr * 64 + 4 * fr + m) * 2816 + ch0) = w; } } }
    }
};

template <class Epi, class Sched, bool ALIGN_EPI = false, bool SP2 = false>
__device__ __forceinline__ void gemm_phase(PG8_LAS unsigned char* lds, const Gemm g, const Sched& S, const Epi& E) {
    int tid = threadIdx.x; asm volatile("" : "+v"(tid));
    const int wid = __builtin_amdgcn_readfirstlane(tid >> 6), lane = tid & 63, wr = wid >> 2, wc = wid & 3, fr = lane & 15, fq = lane >> 4;
    int K = g.K; asm volatile("" : "+s"(K));
    const int nt = K / BK;
    unsigned voffA[2], voffB[2];
#pragma unroll
    for (int i = 0; i < 2; ++i) { int R, C; stage_rc(tid * 16 + i * 8192, R, C); const int Rb = Epi::PERM ? ((R & ~31) + perm32(R & 31)) : R;
        const int Ra = Epi::APERM ? ((R & ~63) + 4 * (R & 15) + ((R >> 4) & 3)) : R;
        voffA[i] = (unsigned)(Ra * g.lda + C) * 2u; voffB[i] = (unsigned)(Rb * g.ldb + C) * 2u; }
    const size_t kstep = (size_t)(BK * 2);
    const size_t hstepA = (size_t)HALF * g.lda * 2, hstepB = (size_t)HALF * g.ldb * 2;
    const size_t tstepA = 2 * hstepA, tstepB = 2 * hstepB;
    const unsigned ldsw = (unsigned)wid * 1024u;
    const int aoff = lds_byte(wr * 64 + fr, fq * 8), boff = lds_byte(wc * 32 + fr, fq * 8);
#define PG8_SA(b, h) (((b) * 2 + (h)) * HTB)
#define PG8_SB(b, h) ((4 + (b) * 2 + (h)) * HTB)
#define PG8_STAGE(bufoff, gbase, voff) do { _Pragma("unroll") for (int _i = 0; _i < 2; ++_i) \
        __builtin_amdgcn_global_load_lds((const unsigned*)((const char*)(gbase) + (voff)[_i]), (PG8_LAS unsigned*)(lds + (bufoff) + ldsw + _i * 8192), 16, 0, 0); } while (0)
#define PG8_LDA(dst, b, h) do { _Pragma("unroll") for (int m = 0; m < 4; ++m) _Pragma("unroll") for (int k = 0; k < 2; ++k) dst[m][k] = *(const PG8_LAS bf16x8*)(lds + PG8_SA(b, h) + aoff + m * 2048 + k * 1024); } while (0)
#define PG8_LDB(dst, b, h) do { _Pragma("unroll") for (int n = 0; n < 2; ++n) _Pragma("unroll") for (int k = 0; k < 2; ++k) dst[n][k] = *(const PG8_LAS bf16x8*)(lds + PG8_SB(b, h) + boff + n * 2048 + k * 1024); } while (0)
#define PG8_MMA(ai, bj, At, Bt) do { __builtin_amdgcn_s_setprio(1); _Pragma("unroll") for (int m = 0; m < 4; ++m) _Pragma("unroll") for (int n = 0; n < 2; ++n) _Pragma("unroll") for (int k = 0; k < 2; ++k) \
        acc[ai][bj][m][n] = __builtin_amdgcn_mfma_f32_16x16x32_bf16(Bt[n][k], At[m][k], acc[ai][bj][m][n], 0, 0, 0); __builtin_amdgcn_s_setprio(0); } while (0)
#define PG8_WAIT_V(n) asm volatile("s_waitcnt vmcnt(" #n ")" ::: "memory")
#define PG8_WAIT_L(n) asm volatile("s_waitcnt lgkmcnt(" #n ")" ::: "memory")
#define PG8_BAR __builtin_amdgcn_s_barrier()
#define PG8_SCHED __builtin_amdgcn_sched_barrier(0)
    Unit cur, nxt; int ui = 0;
    if (!S.next(0, cur)) return;
    f32x4 acc[2][2][4][2];
#pragma unroll
    for (int a = 0; a < 2; ++a)
#pragma unroll
        for (int b = 0; b < 2; ++b)
#pragma unroll
            for (int m = 0; m < 4; ++m)
#pragma unroll
                for (int n = 0; n < 2; ++n) acc[a][b][m][n] = (f32x4){0.f, 0.f, 0.f, 0.f};
    bf16x8 At[4][2], B0[2][2], B1[2][2];
    const char* cA = (const char*)g.A + (size_t)cur.pm * tstepA; const char* cB = (const char*)g.Bt + (size_t)cur.pn * tstepB;
    S.a_ready(cur);
    if constexpr (SP2) {
        PG8_STAGE(PG8_SB(0, 0), cB, voffB); PG8_STAGE(PG8_SB(0, 1), cB + hstepB, voffB); PG8_STAGE(PG8_SA(0, 0), cA, voffA); PG8_STAGE(PG8_SA(0, 1), cA + hstepA, voffA);
        if (wr == 1) PG8_BAR;
        PG8_WAIT_V(2); PG8_BAR;
        PG8_STAGE(PG8_SB(1, 0), cB + kstep, voffB); PG8_STAGE(PG8_SA(1, 0), cA + kstep, voffA); PG8_STAGE(PG8_SB(1, 1), cB + hstepB + kstep, voffB);
        PG8_WAIT_V(6); PG8_BAR;
    } else {
        PG8_STAGE(PG8_SB(0, 0), cB, voffB); PG8_STAGE(PG8_SA(0, 0), cA, voffA); PG8_STAGE(PG8_SB(0, 1), cB + hstepB, voffB); PG8_STAGE(PG8_SA(0, 1), cA + hstepA, voffA);
        if (wr == 1) PG8_BAR;
        PG8_WAIT_V(4); PG8_BAR;
        PG8_STAGE(PG8_SB(1, 0), cB + kstep, voffB); PG8_STAGE(PG8_SA(1, 0), cA + kstep, voffA); PG8_STAGE(PG8_SB(1, 1), cB + hstepB + kstep, voffB);
        PG8_WAIT_V(6); PG8_BAR;
    }
    for (;;) {
        const bool has_next = S.next(ui + 1, nxt);
        const char* nA = has_next ? (const char*)g.A + (size_t)nxt.pm * tstepA : cA; const char* nB = has_next ? (const char*)g.Bt + (size_t)nxt.pn * tstepB : cB;
        for (int t = 0; t < nt; t += 2) {
            const bool last = (t == nt - 2);
            const char* a1 = cA + (size_t)(t + 1) * kstep;
            const char* a2 = last ? nA : cA + (size_t)(t + 2) * kstep; const char* b2 = last ? nB : cB + (size_t)(t + 2) * kstep;
            const char* a3 = a2 + kstep; const char* b3 = b2 + kstep;
            if (last && has_next) S.a_ready(nxt);
            if constexpr (SP2) {
            PG8_LDB(B0, 0, 0); PG8_LDB(B1, 0, 1); PG8_SCHED; PG8_LDA(At, 0, 0); PG8_STAGE(PG8_SA(1, 1), a1 + hstepA, voffA);
            PG8_WAIT_V(8); PG8_WAIT_L(0); PG8_BAR; PG8_MMA(0, 0, At, B0); PG8_MMA(0, 1, At, B1); PG8_BAR; PG8_SCHED;
            PG8_LDA(At, 0, 1); PG8_STAGE(PG8_SB(0, 0), b2, voffB); PG8_STAGE(PG8_SB(0, 1), b2 + hstepB, voffB); PG8_STAGE(PG8_SA(0, 0), a2, voffA);
            PG8_WAIT_V(8); PG8_WAIT_L(0); PG8_BAR; PG8_MMA(1, 0, At, B0); PG8_MMA(1, 1, At, B1); PG8_BAR; PG8_SCHED;
            PG8_LDB(B0, 1, 0); PG8_LDB(B1, 1, 1); PG8_SCHED; PG8_LDA(At, 1, 0); PG8_STAGE(PG8_SA(0, 1), a2 + hstepA, voffA);
            PG8_WAIT_V(8); PG8_WAIT_L(0); PG8_BAR; PG8_MMA(0, 0, At, B0); PG8_MMA(0, 1, At, B1); PG8_BAR; PG8_SCHED;
            PG8_LDA(At, 1, 1); PG8_STAGE(PG8_SB(1, 0), b3, voffB); PG8_STAGE(PG8_SB(1, 1), b3 + hstepB, voffB); PG8_STAGE(PG8_SA(1, 0), a3, voffA);
            PG8_WAIT_V(8); PG8_WAIT_L(0); PG8_BAR; PG8_MMA(1, 0, At, B0); PG8_MMA(1, 1, At, B1); PG8_BAR; PG8_SCHED;
            } else {
            PG8_LDB(B0, 0, 0); PG8_SCHED; PG8_LDA(At, 0, 0); PG8_STAGE(PG8_SA(1, 1), a1 + hstepA, voffA);
            PG8_WAIT_L(8); PG8_BAR; PG8_WAIT_L(0); PG8_MMA(0, 0, At, B0); PG8_BAR; PG8_SCHED;
            PG8_LDB(B1, 0, 1); PG8_STAGE(PG8_SB(0, 0), b2, voffB);
            PG8_BAR; PG8_WAIT_L(0); PG8_MMA(0, 1, At, B1); PG8_BAR;
            PG8_LDA(At, 0, 1); PG8_STAGE(PG8_SA(0, 0), a2, voffA);
            PG8_BAR; PG8_WAIT_L(0); PG8_MMA(1, 0, At, B0); PG8_BAR; PG8_SCHED;
            PG8_STAGE(PG8_SB(0, 1), b2 + hstepB, voffB);
            PG8_WAIT_V(6); PG8_BAR; PG8_MMA(1, 1, At, B1); PG8_BAR;
            PG8_LDB(B0, 1, 0); PG8_SCHED; PG8_LDA(At, 1, 0); PG8_STAGE(PG8_SA(0, 1), a2 + hstepA, voffA);
            PG8_WAIT_L(8); PG8_BAR; PG8_WAIT_L(0); PG8_MMA(0, 0, At, B0); PG8_BAR; PG8_SCHED;
            PG8_LDB(B1, 1, 1); PG8_STAGE(PG8_SB(1, 0), b3, voffB);
            PG8_BAR; PG8_WAIT_L(0); PG8_MMA(0, 1, At, B1); PG8_BAR;
            PG8_LDA(At, 1, 1); PG8_STAGE(PG8_SA(1, 0), a3, voffA);
            PG8_BAR; PG8_WAIT_L(0); PG8_MMA(1, 0, At, B0); PG8_BAR; PG8_SCHED;
            PG8_STAGE(PG8_SB(1, 1), b3 + hstepB, voffB);
            PG8_WAIT_V(6); PG8_BAR; PG8_MMA(1, 1, At, B1); PG8_BAR;
            }
        }
        if constexpr (ALIGN_EPI) { if (wr == 0) PG8_BAR; }
        if constexpr (!Epi::AFTER_DRAIN) { E(acc, cur, wr, wc, fr, fq); S.done(cur); }
        if (!has_next) break;
#pragma unroll
        for (int a = 0; a < 2; ++a)
#pragma unroll
            for (int b = 0; b < 2; ++b)
#pragma unroll
                for (int m = 0; m < 4; ++m)
#pragma unroll
                    for (int n = 0; n < 2; ++n) acc[a][b][m][n] = (f32x4){0.f, 0.f, 0.f, 0.f};
        cur = nxt; cA = nA; cB = nB; ++ui;
        if constexpr (ALIGN_EPI) { if (wr == 1) PG8_BAR; }
    }
    PG8_WAIT_V(0);
    if constexpr (!ALIGN_EPI) { if (wr == 0) PG8_BAR; }
    PG8_BAR;
    if constexpr (Epi::AFTER_DRAIN) { E.fused(acc, cur, wr, wc, fr, fq, lds, wid, lane); S.done(cur); }
#undef PG8_SA
#undef PG8_SB
#undef PG8_STAGE
#undef PG8_LDA
#undef PG8_LDB
#undef PG8_MMA
#undef PG8_WAIT_V
#undef PG8_WAIT_L
#undef PG8_BAR
#undef PG8_SCHED
}
}

#define DEV __device__ __forceinline__
#define LAS __attribute__((address_space(3)))
typedef unsigned short bf16_t;
typedef short bf16x8 __attribute__((ext_vector_type(8)));
typedef float f32x4 __attribute__((ext_vector_type(4)));
typedef float f32x2 __attribute__((ext_vector_type(2)));
typedef float f32x16 __attribute__((ext_vector_type(16)));
typedef unsigned u32x4 __attribute__((ext_vector_type(4)));
typedef unsigned u32x2 __attribute__((ext_vector_type(2)));

constexpr int R = 16896, RB = 8448, NCTX = 256, TL = 8192, DM = 1024, INW = 1696, DFF = 2816, HFF = 1408;
constexpr int NWG_T = 512;
constexpr float EPS = 1e-6f;
constexpr int LDS_BYTES = 147456;
constexpr size_t OFF_X = 0, OFF_HN = 69206016, OFF_W = 103809024, OFF_MOD = 152174592, OFF_ROPE = 152436736, OFF_OV = 153485312;
constexpr size_t OV_Q = 0, OV_KN = 25952256, OV_VT = 43253760, OV_SLOC = 60555264, OV_SIN = 69206016, OV_U = 0;
constexpr size_t OFF_PART = 250100224;
constexpr size_t OFF_EDGE = 258488832;
constexpr size_t WS_NEED = OFF_EDGE + 5947392;
constexpr size_t W_IN = 0, W_UQ = 1835008, W_KN = 2129920, W_V = 2260992, W_OUT = 2392064, W_UP = 3440640, W_DN = 9207808, W_LAYER = 12091392;

struct Params {
    const float *x, *c, *ctx, *c_ctx, *w_mod, *b_mod, *norm1_g, *w_in, *ret_decay_f, *ret_decay_b, *mla_q_norm_g, *w_uq, *mla_kv_norm_g, *w_ukv,
        *pool_w, *pool_scale, *w_out, *norm2_g, *w_up, *conv_w, *conv_b, *w_down, *final_norm_g;
    float* out; unsigned char* ws; int ph_lo, ph_hi;
};

DEV int otid() { int t = threadIdx.x; asm volatile("" : "+v"(t)); return t; }
DEV float bf2f(unsigned short x) { return __uint_as_float((unsigned)x << 16); }
DEV unsigned f2bf(float f) { unsigned u = __float_as_uint(f); return (u + 0x7fffu + ((u >> 16) & 1u)) >> 16; }
DEV unsigned pk2(float lo, float hi) { return f2bf(lo) | (f2bf(hi) << 16); }
DEV float wave_sum(float v) {
#pragma unroll
    for (int o = 1; o < 64; o <<= 1) v += __shfl_xor(v, o);
    return v;
}
DEV float siluf(float x) { return x * __builtin_amdgcn_rcpf(1.0f + __builtin_amdgcn_exp2f(-1.4426950408889634f * x)); }
DEV int crow(int r, int hi) { return (r & 3) + 8 * (r >> 2) + 4 * hi; }
DEV bf16x8 pack8(float a0, float a1, float a2, float a3, float a4, float a5, float a6, float a7) {
    u32x4 w; w.x = pg8::cvt_pk_bf16(a0, a1); w.y = pg8::cvt_pk_bf16(a2, a3); w.z = pg8::cvt_pk_bf16(a4, a5); w.w = pg8::cvt_pk_bf16(a6, a7);
    return __builtin_bit_cast(bf16x8, w);
}
DEV int row_mi(int r) { const int b = r / RB; const int s = r - b * RB; return s < NCTX ? 2 : b; }

DEV void transpose_item(const float* W, int K, int Nsrc, bf16_t* WT, int n0, int cs, int k0, float* scr, int lane) {
#pragma unroll
    for (int i = 0; i < 32; ++i) { const int kk = 2 * i + (lane >> 5); scr[kk * 33 + (lane & 31)] = cs >= 0 ? W[(size_t)(k0 + kk) * Nsrc + cs + (lane & 31)] : 0.f; }
    asm volatile("s_waitcnt lgkmcnt(0)" ::: "memory");
    const int c = lane & 7;
#pragma unroll
    for (int j = 0; j < 4; ++j) { const int n = (lane >> 3) + 8 * j; const float* s = scr + (8 * c) * 33 + n;
        u32x4 o; o.x = pk2(s[0 * 33], s[1 * 33]); o.y = pk2(s[2 * 33], s[3 * 33]); o.z = pk2(s[4 * 33], s[5 * 33]); o.w = pk2(s[6 * 33], s[7 * 33]);
        *(u32x4*)(WT + (size_t)(n0 + n) * K + k0 + 8 * c) = o; }
    asm volatile("s_waitcnt lgkmcnt(0)" ::: "memory");
}
DEV int map_in(int n0) { return n0 < 1440 ? n0 : (n0 < INW ? -2 : -1); }
DEV int map_kn(int n0) { return (n0 >> 6) * 128 + (n0 & 63); }
DEV int map_v(int n0) { return (n0 >> 6) * 128 + 64 + (n0 & 63); }
DEV int map_up(int n0) { const int pn = n0 >> 8, w = n0 & 255; return w < 128 ? 128 * pn + w : DFF + 128 * pn + (w - 128); }

DEV void phase_prep(const Params& p, unsigned char* lds) {
    const int tid = otid(), lane = tid & 63, wid = tid >> 6;
    unsigned char* ws = p.ws;
    { f32x2* rope = (f32x2*)(ws + OFF_ROPE);
      for (int idx = blockIdx.x * NWG_T + tid; idx < TL * 16; idx += gridDim.x * NWG_T) { const int t = idx >> 4, i = idx & 15; const int pos = i < 8 ? (t >> 6) : (t & 63);
          const float inv = exp2f(-(float)(i & 7) * 0.125f * 13.287712379549449f); const float ang = (float)pos * inv; f32x2 cs; cs.x = __cosf(ang); cs.y = __sinf(ang); rope[idx] = cs; } }
    { float* scv = (float*)lds;
      float* red = scv + 3 * 1024;
      for (int i = tid; i < 3 * 1024; i += NWG_T) { const int v = i >> 10, k = i & 1023; const float cv = v < 2 ? p.c[v * 1024 + k] : p.c_ctx[k]; scv[i] = siluf(cv); }
      __syncthreads();
      float* modv = (float*)(ws + OFF_MOD);
      for (int it = blockIdx.x; it < 192; it += gridDim.x) { const int l = it / 96, col0 = (it % 96) * 64;
          const float* wm = p.w_mod + (size_t)l * 1024 * 6144 + col0 + lane; float a0 = 0.f, a1 = 0.f, a2 = 0.f;
#pragma unroll 16
          for (int k = wid * 128; k < wid * 128 + 128; ++k) { const float w = wm[(size_t)k * 6144]; a0 += scv[k] * w; a1 += scv[1024 + k] * w; a2 += scv[2048 + k] * w; }
          red[(wid * 3 + 0) * 64 + lane] = a0; red[(wid * 3 + 1) * 64 + lane] = a1; red[(wid * 3 + 2) * 64 + lane] = a2;
          __syncthreads();
          if (tid < 192) { const int v = tid >> 6, cl = tid & 63; float s = 0.f;
#pragma unroll
              for (int w = 0; w < 8; ++w) s += red[(w * 3 + v) * 64 + cl];
              modv[((size_t)l * 3 + v) * 6144 + col0 + cl] = s + p.b_mod[l * 6144 + col0 + cl]; }
          __syncthreads(); }
    }
}
DEV void phase_prep_weights(const Params& p, unsigned char* lds) {
    const int tid = otid(), lane = tid & 63, wid = tid >> 6;
    unsigned char* ws = p.ws;
    { float* scr = (float*)(lds + 32768 + wid * 8704);
      const int gw = blockIdx.x * 8 + wid, NGW = gridDim.x * 8;
      constexpr int I_IN = 16 * 56, I_UQ = 6 * 24, I_KN = 4 * 16, I_V = 4 * 16, I_OUT = 16 * 32, I_UP = 16 * 176, I_DN = 44 * 32, I_L = I_IN + I_UQ + I_KN + I_V + I_OUT + I_UP + I_DN;
#define PW_DECODE(it_, SRC, DST, KK, NS, N0, CS, K0) do { const int l = (it_) / I_L; int r = (it_) - l * I_L; bf16_t* wl = (bf16_t*)(ws + OFF_W) + (size_t)l * W_LAYER; int nbn, mp; size_t doff; \
          if (r < I_IN) { SRC = p.w_in + (size_t)l * 1024 * INW; KK = 1024; NS = INW; nbn = 56; mp = 1; doff = W_IN; } \
          else if ((r -= I_IN) < I_UQ) { SRC = p.w_uq + (size_t)l * 384 * 768; KK = 384; NS = 768; nbn = 24; mp = 0; doff = W_UQ; } \
          else if ((r -= I_UQ) < I_KN) { SRC = p.w_ukv + (size_t)l * 256 * 1024; KK = 256; NS = 1024; nbn = 16; mp = 2; doff = W_KN; } \
          else if ((r -= I_KN) < I_V) { SRC = p.w_ukv + (size_t)l * 256 * 1024; KK = 256; NS = 1024; nbn = 16; mp = 3; doff = W_V; } \
          else if ((r -= I_V) < I_OUT) { SRC = p.w_out + (size_t)l * 1024 * 1024; KK = 1024; NS = 1024; nbn = 32; mp = 0; doff = W_OUT; } \
          else if ((r -= I_OUT) < I_UP) { SRC = p.w_up + (size_t)l * 1024 * 5632; KK = 1024; NS = 5632; nbn = 176; mp = 4; doff = W_UP; } \
          else { r -= I_UP; SRC = p.w_down + (size_t)l * DFF * 1024; KK = DFF; NS = 1024; nbn = 32; mp = 0; doff = W_DN; } \
          const int kb = r / nbn, nb = r - kb * nbn; N0 = nb * 32; K0 = kb * 64; DST = wl + doff; \
          CS = mp == 0 ? N0 : mp == 1 ? map_in(N0) : mp == 2 ? map_kn(N0) : mp == 3 ? map_v(N0) : map_up(N0); } while (0)
#define PW_LOAD(RG, SRC, NS, CS, K0) do { _Pragma("unroll") for (int i = 0; i < 32; ++i) { const int kk = 2 * i + (lane >> 5); RG[i] = (CS) >= 0 ? (SRC)[(size_t)((K0) + kk) * (NS) + (CS) + (lane & 31)] : 0.f; } } while (0)
      const float* sA = nullptr; bf16_t* dA = nullptr; int kA = 0, nsA = 0, n0A = 0, csA = -2, k0A = 0; float ra[32];
      int it = gw;
      if (it < 2 * I_L) { PW_DECODE(it, sA, dA, kA, nsA, n0A, csA, k0A); if (csA != -2) PW_LOAD(ra, sA, nsA, csA, k0A); }
      while (it < 2 * I_L) {
          const int itn = it + NGW; const float* sB = nullptr; bf16_t* dB = nullptr; int kB = 0, nsB = 0, n0B = 0, csB = -2, k0B = 0; float rb[32];
          if (itn < 2 * I_L) { PW_DECODE(itn, sB, dB, kB, nsB, n0B, csB, k0B); if (csB != -2) PW_LOAD(rb, sB, nsB, csB, k0B); }
          if (csA != -2) {
#pragma unroll
              for (int i = 0; i < 32; ++i) { const int kk = 2 * i + (lane >> 5); scr[kk * 33 + (lane & 31)] = ra[i]; }
              asm volatile("s_waitcnt lgkmcnt(0)" ::: "memory");
              const int c = lane & 7;
#pragma unroll
              for (int j = 0; j < 4; ++j) { const int n = (lane >> 3) + 8 * j; const float* sp_ = scr + (8 * c) * 33 + n;
                  u32x4 o; o.x = pk2(sp_[0 * 33], sp_[1 * 33]); o.y = pk2(sp_[2 * 33], sp_[3 * 33]); o.z = pk2(sp_[4 * 33], sp_[5 * 33]); o.w = pk2(sp_[6 * 33], sp_[7 * 33]);
                  *(u32x4*)(dA + (size_t)(n0A + n) * kA + k0A + 8 * c) = o; }
              asm volatile("s_waitcnt lgkmcnt(0)" ::: "memory"); }
          sA = sB; dA = dB; kA = kB; nsA = nsB; n0A = n0B; csA = csB; k0A = k0B;
#pragma unroll
          for (int i = 0; i < 32; ++i) ra[i] = rb[i];
          it = itn; }
#undef PW_DECODE
#undef PW_LOAD
    }
    { for (int idx = blockIdx.x * NWG_T + tid; idx < 2 * 1024 * 256; idx += gridDim.x * NWG_T) { const int n = idx & 255, k = (idx >> 8) & 1023, l = idx >> 18; const int g = n >> 6, d = n & 63;
          const float* wr = p.w_in + ((size_t)l * 1024 + k) * INW + 1440 + g * 64; const float* pw = p.pool_w + ((size_t)(l * 4 + g) * 64) * 64 + d; float s = 0.f;
#pragma unroll 8
          for (int c = 0; c < 64; ++c) s += wr[c] * pw[c * 64];
          ((bf16_t*)(ws + OFF_W) + (size_t)l * W_LAYER + W_IN)[(size_t)(1440 + n) * 1024 + k] = (bf16_t)f2bf(s * p.pool_scale[l * 256 + n]); } }
}

DEV void phase_norm(const Params& p, int l, int which, bool first, const float* pgate) {
    const int tid = otid(); const int lane = tid & 63, wid = tid >> 6; const int gw = blockIdx.x * 8 + wid, NGW = gridDim.x * 8;
    float* X = (float*)(p.ws + OFF_X); bf16_t* HN = (bf16_t*)(p.ws + OFF_HN);
    const float* modv = (const float*)(p.ws + OFF_MOD) + (size_t)l * 3 * 6144;
    const float* g = (which == 0 ? p.norm1_g : p.norm2_g) + l * 1024;
    for (int r = gw; r < R; r += NGW) {
        const int b = r / RB, s = r - b * RB; const int mi = s < NCTX ? 2 : b;
        const float* src = first ? (s < NCTX ? p.ctx + ((size_t)b * NCTX + s) * 1024 : p.x + ((size_t)b * TL + (s - NCTX)) * 1024) : X + (size_t)r * 1024;
        const f32x4* xr = (const f32x4*)src + lane; f32x4 v[4]; float ss = 0.f;
#pragma unroll
        for (int j = 0; j < 4; ++j) { v[j] = xr[64 * j]; ss += (v[j].x * v[j].x + v[j].y * v[j].y) + (v[j].z * v[j].z + v[j].w * v[j].w); }
        if (pgate != nullptr && s < NCTX) { const float* PART = (const float*)(p.ws + OFF_PART) + (size_t)(b * NCTX + s) * 1024; ss = 0.f;
#pragma unroll
            for (int j = 0; j < 4; ++j) { const f32x4 gq = ((const f32x4*)pgate)[lane + 64 * j]; f32x4 a = ((const f32x4*)PART)[lane + 64 * j];
#pragma unroll
                for (int q = 1; q < 4; ++q) a = a + ((const f32x4*)(PART + (size_t)q * 524288))[lane + 64 * j];
                v[j] = v[j] + gq * a; ss += (v[j].x * v[j].x + v[j].y * v[j].y) + (v[j].z * v[j].z + v[j].w * v[j].w); } }
        if (first || (pgate != nullptr && s < NCTX)) { f32x4* xo = (f32x4*)(X + (size_t)r * 1024) + lane;
#pragma unroll
            for (int j = 0; j < 4; ++j) xo[64 * j] = v[j]; }
        const float rs = rsqrtf(wave_sum(ss) * (1.f / 1024.f) + EPS);
        const float* mv = modv + mi * 6144 + (which == 0 ? 0 : 3072);
        u32x2* o8 = (u32x2*)(HN + (size_t)r * 1024) + lane;
#pragma unroll
        for (int j = 0; j < 4; ++j) { const f32x4 gg = ((const f32x4*)g)[lane + 64 * j], sh = ((const f32x4*)mv)[lane + 64 * j], sc = ((const f32x4*)(mv + 1024))[lane + 64 * j];
            const f32x4 y = v[j] * rs * gg; const f32x4 h = y * (sc + 1.0f) + sh; u32x2 w; w.x = pk2(h.x, h.y); w.y = pk2(h.z, h.w); o8[64 * j] = w; }
    }
}
DEV void phase_final(const Params& p) {
    const int tid = otid(); const int lane = tid & 63, wid = tid >> 6; const int gw = blockIdx.x * 8 + wid, NGW = gridDim.x * 8;
    const float* X = (const float*)(p.ws + OFF_X);
    for (int q = gw; q < 2 * TL; q += NGW) { const int b = q / TL, t = q - b * TL; const int r = b * RB + NCTX + t;
        const f32x4* xr = (const f32x4*)(X + (size_t)r * 1024) + lane; f32x4 v[4]; float ss = 0.f;
#pragma unroll
        for (int j = 0; j < 4; ++j) { v[j] = xr[64 * j]; ss += (v[j].x * v[j].x + v[j].y * v[j].y) + (v[j].z * v[j].z + v[j].w * v[j].w); }
        const float rs = rsqrtf(wave_sum(ss) * (1.f / 1024.f) + EPS);
        f32x4* o = (f32x4*)(p.out + (size_t)q * 1024) + lane;
#pragma unroll
        for (int j = 0; j < 4; ++j) { const f32x4 gg = ((const f32x4*)p.final_norm_g)[lane + 64 * j]; o[64 * j] = v[j] * rs * gg; } }
}

DEV void phase_rowwise(const Params& p, int l) {
    const int tid = otid(); const int lane = tid & 63, wid = tid >> 6; const int gw = blockIdx.x * 8 + wid, NGW = gridDim.x * 8;
    bf16_t* P = (bf16_t*)p.out; const f32x2* rope = (const f32x2*)(p.ws + OFF_ROPE);
    const float* qg = p.mla_q_norm_g + l * 384; const float* kg = p.mla_kv_norm_g + l * 256;
    float qgv[6];
#pragma unroll
    for (int j = 0; j < 3; ++j) { qgv[2 * j] = qg[2 * (lane + 64 * j)]; qgv[2 * j + 1] = qg[2 * (lane + 64 * j) + 1]; }
    const f32x4 kgv = ((const f32x4*)kg)[lane];
    for (int r0 = gw; r0 < R; r0 += 2 * NGW) {
        unsigned wq[2][3]; u32x2 wk[2]; float x1[2], x2[2]; f32x2 cs[2]; bool val[2], lat[2];
#pragma unroll
        for (int i = 0; i < 2; ++i) { const int r = r0 + i * NGW; val[i] = r < R; const int rr = val[i] ? r : r0; bf16_t* pr = P + (size_t)rr * INW; const int s = rr % RB; lat[i] = s >= NCTX;
            const unsigned* q2 = (const unsigned*)(pr + 768) + lane;
#pragma unroll
            for (int j = 0; j < 3; ++j) wq[i][j] = q2[64 * j];
            wk[i] = *((const u32x2*)(pr + 1152) + lane);
            const int li = lane & 15; x1[i] = bf2f(pr[1408 + li]); x2[i] = bf2f(pr[1408 + 16 + li]); cs[i] = rope[(lat[i] ? s - NCTX : 0) * 16 + li]; }
#pragma unroll
        for (int i = 0; i < 2; ++i) { if (!val[i]) continue; const int r = r0 + i * NGW; bf16_t* pr = P + (size_t)r * INW;
            { float ss = 0.f;
#pragma unroll
              for (int j = 0; j < 3; ++j) { const float a = bf2f(wq[i][j] & 0xffff), c2 = bf2f(wq[i][j] >> 16); ss += a * a + c2 * c2; }
              const float rs = rsqrtf(wave_sum(ss) * (1.f / 384.f) + EPS); unsigned* q2 = (unsigned*)(pr + 768) + lane;
#pragma unroll
              for (int j = 0; j < 3; ++j) q2[64 * j] = pk2(bf2f(wq[i][j] & 0xffff) * rs * qgv[2 * j], bf2f(wq[i][j] >> 16) * rs * qgv[2 * j + 1]); }
            { const float a0 = bf2f(wk[i].x & 0xffff), a1 = bf2f(wk[i].x >> 16), a2 = bf2f(wk[i].y & 0xffff), a3 = bf2f(wk[i].y >> 16);
              const float rs = rsqrtf(wave_sum((a0 * a0 + a1 * a1) + (a2 * a2 + a3 * a3)) * (1.f / 256.f) + EPS);
              u32x2 o; o.x = pk2(a0 * rs * kgv.x, a1 * rs * kgv.y); o.y = pk2(a2 * rs * kgv.z, a3 * rs * kgv.w); *((u32x2*)(pr + 1152) + lane) = o; }
            if (lat[i] && lane < 16) { pr[1408 + lane] = (bf16_t)f2bf(x1[i] * cs[i].x - x2[i] * cs[i].y); pr[1408 + 16 + lane] = (bf16_t)f2bf(x2[i] * cs[i].x + x1[i] * cs[i].y); } }
    }
}

DEV void phase_pool(const Params& p) {
    const int tid = otid(); const bf16_t* P = (const bf16_t*)p.out; bf16_t* MIX = (bf16_t*)(p.ws + OFF_HN);
    for (int idx = blockIdx.x * NWG_T + tid; idx < R * 32; idx += gridDim.x * NWG_T) { const int r = idx >> 5, cg = idx & 31; const int half = 1 << (cg >> 3);
        const int b = r / RB, s = r - b * RB; const int seq0 = s < NCTX ? b * RB : b * RB + NCTX; const int T = s < NCTX ? NCTX : TL; const int t = r - seq0;
        const int lo = max(t - half, 0), hi = min(t + half, T); float sum[8];
#pragma unroll
        for (int j = 0; j < 8; ++j) sum[j] = 0.f;
        const bf16_t* base = P + (size_t)seq0 * INW + 1440 + cg * 8;
        { bf16x8 wv[16]; const bf16x8 zz = {0, 0, 0, 0, 0, 0, 0, 0};
#pragma unroll
          for (int k = 0; k < 16; ++k) { const int tt = t - 8 + k; wv[k] = (tt >= lo && tt < hi) ? *(const bf16x8*)(base + (size_t)tt * INW) : zz; }
#pragma unroll
          for (int k = 0; k < 16; ++k)
#pragma unroll
              for (int j = 0; j < 8; ++j) sum[j] += bf2f((unsigned short)wv[k][j]); }
        const bf16x8 me = *(const bf16x8*)(base + (size_t)t * INW); const float ic = 1.0f / (float)(hi - lo); float o[8];
#pragma unroll
        for (int j = 0; j < 8; ++j) o[j] = sum[j] * ic - bf2f((unsigned short)me[j]);
        *(bf16x8*)(MIX + (size_t)r * 1024 + 768 + cg * 8) = pack8(o[0], o[1], o[2], o[3], o[4], o[5], o[6], o[7]); }
}

DEV float log2_sigmoid(float d) { return -log1pf(__expf(-d)) * 1.4426950408889634f; }
constexpr int ST_P = 272;
DEV void states_item(const Params& p, int l, unsigned char* lds, int it) {
    const int tid = otid(), lane = tid & 63, wid = tid >> 6, l32 = lane & 31, hi = lane >> 5;
    const bf16_t* P = (const bf16_t*)p.out; const f32x2* rope = (const f32x2*)(p.ws + OFF_ROPE);
    float* SLOC = (float*)(p.ws + OFF_OV + OV_SLOC);
    const int gc = it >> 1, hp = it & 1;
    unsigned char* VTl = lds;
    unsigned char* KTl = lds + 2 * 64 * ST_P;
    const int cb = gc % 66; const bool lat = cb >= 2; const int t0 = (cb - 2) * 128; const int r0 = gc * 128;
    __syncthreads();
    { const int tok = tid >> 2, hh = (tid >> 1) & 1, c = tid & 1; const int h = 2 * hp + hh;
      const bf16_t* src = P + (size_t)(r0 + tok) * INW + 128 + h * 32 + 8 * c; const bf16x8 lo = *(const bf16x8*)src, hi8 = *(const bf16x8*)(src + 16);
      const float df = exp2f(log2_sigmoid(p.ret_decay_f[l * 4 + h]) * (float)(127 - tok)) * 0.17677669529663687f, db = exp2f(log2_sigmoid(p.ret_decay_b[l * 4 + h]) * (float)tok) * 0.17677669529663687f;
#pragma unroll
      for (int j = 0; j < 8; ++j) { float x1 = bf2f((unsigned short)lo[j]), x2 = bf2f((unsigned short)hi8[j]);
          if (lat) { const f32x2 cs = rope[(t0 + tok) * 16 + 8 * c + j]; const float y1 = x1 * cs.x - x2 * cs.y, y2 = x2 * cs.x + x1 * cs.y; x1 = y1; x2 = y2; }
          bf16_t* kf = (bf16_t*)(KTl + ((hh * 2 + 0) * 32 + 8 * c + j) * ST_P) + tok; bf16_t* kb = (bf16_t*)(KTl + ((hh * 2 + 1) * 32 + 8 * c + j) * ST_P) + tok;
          kf[0] = (bf16_t)f2bf(x1 * df); kb[0] = (bf16_t)f2bf(x1 * db);
          *(bf16_t*)((unsigned char*)kf + 16 * ST_P) = (bf16_t)f2bf(x2 * df); *(bf16_t*)((unsigned char*)kb + 16 * ST_P) = (bf16_t)f2bf(x2 * db); } }
    for (int task = tid; task < 2048; task += NWG_T) { const int hh = task >> 10, tok = (task >> 3) & 127, ch = task & 7;
        const bf16x8 v = *(const bf16x8*)(P + (size_t)(r0 + tok) * INW + 256 + (2 * hp + hh) * 64 + ch * 8);
#pragma unroll
        for (int j = 0; j < 8; ++j) *((bf16_t*)(VTl + (hh * 64 + ch * 8 + j) * ST_P) + tok) = (bf16_t)v[j]; }
    __syncthreads();
    { const int hh = wid >> 2, dir = (wid >> 1) & 1, dvb = wid & 1; const int h = 2 * hp + hh;
      const unsigned char* ap = VTl + (hh * 64 + 32 * dvb + l32) * ST_P + hi * 16; const unsigned char* bp = KTl + ((hh * 2 + dir) * 32 + l32) * ST_P + hi * 16;
      bf16x8 af[8], bfr[8];
#pragma unroll
      for (int ks = 0; ks < 8; ++ks) { af[ks] = *(const bf16x8*)(ap + ks * 32); bfr[ks] = *(const bf16x8*)(bp + ks * 32); }
      f32x16 acc;
#pragma unroll
      for (int r = 0; r < 16; ++r) acc[r] = 0.f;
#pragma unroll
      for (int ks = 0; ks < 8; ++ks) acc = __builtin_amdgcn_mfma_f32_32x32x16_bf16(af[ks], bfr[ks], acc, 0, 0, 0);
      float* o = SLOC + ((size_t)(gc * 4 + h) * 2 + dir) * 2048 + l32 * 64 + 32 * dvb + 4 * hi;
#pragma unroll
      for (int g4 = 0; g4 < 4; ++g4) *(f32x4*)(o + 8 * g4) = (f32x4){acc[4 * g4], acc[4 * g4 + 1], acc[4 * g4 + 2], acc[4 * g4 + 3]}; }
}
DEV void scan_threads(const Params& p, int l, int gid) {
    if (gid >= 32768) return;
    const int e = gid & 2047, dir = (gid >> 11) & 1, h = (gid >> 12) & 3, b = gid >> 14;
    const float* SLOC = (const float*)(p.ws + OFF_OV + OV_SLOC); float* SIN = (float*)(p.ws + OFF_OV + OV_SIN);
    const float gC = exp2f(log2_sigmoid((dir == 0 ? p.ret_decay_f : p.ret_decay_b)[l * 4 + h]) * 128.f);
    float S = 0.f;
#pragma unroll 11
    for (int st = 0; st < 66; ++st) { const int cb = dir == 0 ? st : (st < 2 ? 1 - st : 67 - st); const size_t idx = ((size_t)((b * 66 + cb) * 4 + h) * 2 + dir) * 2048 + e;
        const float v = SLOC[idx]; SIN[idx] = S; S = S * gC + v; }
}

constexpr int AT_KP = 208, AT_VP = 144, AT_KB = 64 * AT_KP, AT_VBS = 64 * AT_VP, AT_V0 = 4 * AT_KB;
DEV float at_max32(const f32x16& s0, const f32x16& s1) {
    float m0 = __builtin_fmaxf(__builtin_fmaxf(s0[0], s0[1]), s0[2]), m1 = __builtin_fmaxf(__builtin_fmaxf(s1[0], s1[1]), s1[2]);
    m0 = __builtin_fmaxf(__builtin_fmaxf(m0, s0[3]), s0[4]); m1 = __builtin_fmaxf(__builtin_fmaxf(m1, s1[3]), s1[4]);
    m0 = __builtin_fmaxf(__builtin_fmaxf(m0, s0[5]), s0[6]); m1 = __builtin_fmaxf(__builtin_fmaxf(m1, s1[5]), s1[6]);
    m0 = __builtin_fmaxf(__builtin_fmaxf(m0, s0[7]), s0[8]); m1 = __builtin_fmaxf(__builtin_fmaxf(m1, s1[7]), s1[8]);
    m0 = __builtin_fmaxf(__builtin_fmaxf(m0, s0[9]), s0[10]); m1 = __builtin_fmaxf(__builtin_fmaxf(m1, s1[9]), s1[10]);
    m0 = __builtin_fmaxf(__builtin_fmaxf(m0, s0[11]), s0[12]); m1 = __builtin_fmaxf(__builtin_fmaxf(m1, s1[11]), s1[12]);
    m0 = __builtin_fmaxf(__builtin_fmaxf(m0, s0[13]), s0[14]); m1 = __builtin_fmaxf(__builtin_fmaxf(m1, s1[13]), s1[14]);
    return __builtin_fmaxf(__builtin_fmaxf(m0, s0[15]), __builtin_fmaxf(m1, s1[15]));
}
DEV void attn_unit(const Params& p, unsigned char* lds, int u) {
    const int tid = otid(), lane = tid & 63, wid = tid >> 6, l32 = lane & 31, hi = lane >> 5;
    const bf16_t* Q = (const bf16_t*)(p.ws + OFF_OV + OV_Q); const bf16_t* KN = (const bf16_t*)(p.ws + OFF_OV + OV_KN); const bf16_t* VT = (const bf16_t*)(p.ws + OFF_OV + OV_VT);
    const bf16_t* P = (const bf16_t*)p.out; bf16_t* MIX = (bf16_t*)(p.ws + OFF_HN); const f32x2* rope = (const f32x2*)(p.ws + OFF_ROPE);
    const bool isctx = u >= 512; int b, h, qrow0, NT;
    if (!isctx) { b = u >> 8; h = (u >> 5) & 7; qrow0 = b * RB + NCTX + (u & 31) * 256; NT = 132; } else { const int v = u - 512; b = v >> 3; h = v & 7; qrow0 = b * RB; NT = 4; }
    const int krow0 = b * RB; const int qrow = qrow0 + wid * 32 + l32;
    bf16x8 qf[6];
    { const bf16_t* qp = Q + (size_t)qrow * 768 + h * 96 + hi * 8;
#pragma unroll
      for (int d0 = 0; d0 < 6; ++d0) qf[d0] = *(const bf16x8*)(qp + d0 * 16);
      if (!isctx) { const f32x2* rp = rope + (size_t)(qrow - (b * RB + NCTX)) * 16 + hi * 8;
#pragma unroll
          for (int j = 0; j < 8; ++j) { const f32x2 cs = rp[j]; const float x1 = bf2f((unsigned short)qf[4][j]), x2 = bf2f((unsigned short)qf[5][j]);
              qf[4][j] = (short)f2bf(x1 * cs.x - x2 * cs.y); qf[5][j] = (short)f2bf(x2 * cs.x + x1 * cs.y); } } }
    const bf16_t* sp[3]; int sstep[3], lo[3];
#pragma unroll
    for (int k = 0; k < 2; ++k) { const int c = tid + k * 512; const int key = c / 12, part = c - key * 12; lo[k] = key * AT_KP + part * 16;
        if (part < 8) { sp[k] = KN + (size_t)(krow0 + key) * 512 + h * 64 + part * 8; sstep[k] = 64 * 512; } else { sp[k] = P + (size_t)(krow0 + key) * INW + 1408 + (part - 8) * 8; sstep[k] = 64 * INW; } }
    { const int dv = tid >> 3, kc = tid & 7; lo[2] = dv * AT_VP + (kc >> 1) * 32 + (kc & 1) * 8;   sp[2] = VT + (size_t)(h * 64 + dv) * R + krow0 + kc * 8; sstep[2] = 64; }
    const bool hasK2 = tid < 256;
    u32x4 st[3];
#define AT_GLOADK() do { st[0] = *(const u32x4*)sp[0]; sp[0] += sstep[0]; if (hasK2) { st[1] = *(const u32x4*)sp[1]; sp[1] += sstep[1]; } } while (0)
#define AT_GLOADV() do { st[2] = *(const u32x4*)sp[2]; sp[2] += sstep[2]; } while (0)
#define AT_LSTOREK(buf) do { *(u32x4*)((buf) + lo[0]) = st[0]; if (hasK2) *(u32x4*)((buf) + lo[1]) = st[1]; } while (0)
#define AT_LSTOREV(buf) do { unsigned char* d_ = (buf) + lo[2]; *(u32x2*)d_ = (u32x2){st[2].x, st[2].y}; *(u32x2*)(d_ + 16) = (u32x2){st[2].z, st[2].w}; } while (0)
#define AT_SB() __builtin_amdgcn_sched_barrier(0)
    f32x16 o0, o1, sa0, sa1, sb0, sb1, negm;
#pragma unroll
    for (int r = 0; r < 16; ++r) { o0[r] = 0.f; o1[r] = 0.f; sa0[r] = 0.f; sa1[r] = 0.f; negm[r] = 0.f; }
    float mrun = 0.f, lsum = 0.f;
    __syncthreads();
    AT_GLOADK(); AT_GLOADV(); AT_LSTOREK(lds); AT_LSTOREV(lds + AT_V0);
    AT_GLOADK(); AT_GLOADV(); AT_LSTOREK(lds + AT_KB); AT_LSTOREV(lds + AT_V0 + AT_VBS);
    AT_GLOADK(); AT_LSTOREK(lds + 2 * AT_KB);
    __syncthreads();
    { const unsigned char* ka = lds + l32 * AT_KP + hi * 16;
#pragma unroll
      for (int d0 = 0; d0 < 6; ++d0) { const bf16x8 a0 = *(const bf16x8*)(ka + d0 * 32), a1 = *(const bf16x8*)(ka + 32 * AT_KP + d0 * 32);
          sa0 = __builtin_amdgcn_mfma_f32_32x32x16_bf16(a0, qf[d0], sa0, 0, 0, 0); sa1 = __builtin_amdgcn_mfma_f32_32x32x16_bf16(a1, qf[d0], sa1, 0, 0, 0); } }
#define AT_QKM(SB0, SB1, i) do { if ((i) == 0) SB0 = __builtin_amdgcn_mfma_f32_32x32x16_bf16(kfr[0], qf[0], negm, 0, 0, 0); else if ((i) == 1) SB1 = __builtin_amdgcn_mfma_f32_32x32x16_bf16(kfr[1], qf[0], negm, 0, 0, 0); \
        else if ((i) & 1) SB1 = __builtin_amdgcn_mfma_f32_32x32x16_bf16(kfr[(i)], qf[(i) >> 1], SB1, 0, 0, 0); else SB0 = __builtin_amdgcn_mfma_f32_32x32x16_bf16(kfr[(i)], qf[(i) >> 1], SB0, 0, 0, 0); } while (0)
#define AT_EXS(acc, SA0, SA1, e) do { if ((e) < 16) { SA0[(e) & 15] = __builtin_amdgcn_exp2f(SA0[(e) & 15]); acc += SA0[(e) & 15]; } else { SA1[(e) & 15] = __builtin_amdgcn_exp2f(SA1[(e) & 15]); acc += SA1[(e) & 15]; } } while (0)
#define AT_PACK(dst, S, r0) dst = pack8(S[(r0) + 0], S[(r0) + 1], S[(r0) + 2], S[(r0) + 3], S[(r0) + 4], S[(r0) + 5], S[(r0) + 6], S[(r0) + 7])
#define AT_MAX4(m0, m1, SB0, SB1, r0) do { m0 = __builtin_fmaxf(__builtin_fmaxf(m0, SB0[(r0) + 0]), SB0[(r0) + 1]); m1 = __builtin_fmaxf(__builtin_fmaxf(m1, SB1[(r0) + 0]), SB1[(r0) + 1]); \
        m0 = __builtin_fmaxf(__builtin_fmaxf(m0, SB0[(r0) + 2]), SB0[(r0) + 3]); m1 = __builtin_fmaxf(__builtin_fmaxf(m1, SB1[(r0) + 2]), SB1[(r0) + 3]); } while (0)
#define AT_STEP(SA0, SA1, SB0, SB1, tt) do { \
        const int t_ = (tt); const bool nxt_ = t_ + 1 < NT; \
        const unsigned char* kb_ = lds + ((t_ + 1) & 3) * AT_KB; const unsigned char* vb_ = lds + AT_V0 + (t_ & 3) * AT_VBS; \
        if (t_ + 3 < NT) AT_GLOADK(); \
        if (t_ + 2 < NT) AT_GLOADV(); \
        bf16x8 kfr[12]; bf16x8 vfr[8]; \
        { const unsigned char* ka = kb_ + l32 * AT_KP + hi * 16; \
          _Pragma("unroll") for (int d0 = 0; d0 < 6; ++d0) { kfr[2 * d0] = *(const bf16x8*)(ka + d0 * 32); kfr[2 * d0 + 1] = *(const bf16x8*)(ka + 32 * AT_KP + d0 * 32); } } \
        { const float mx = mxc; \
          if (t_ == 0 || __any(mx > 8.0f)) { \
              const float rm = fmaxf(mx, __shfl_xor(mx, 32)); const float delta = (t_ == 0) ? rm : fmaxf(rm, 0.f); const float alpha = (t_ == 0) ? 1.0f : __builtin_amdgcn_exp2f(-delta); \
              mrun += delta; \
              _Pragma("unroll") for (int r = 0; r < 16; ++r) { SA0[r] -= delta; SA1[r] -= delta; o0[r] *= alpha; o1[r] *= alpha; } \
              lsum *= alpha; { const float nm = -mrun; _Pragma("unroll") for (int r = 0; r < 16; ++r) negm[r] = nm; } } } \
        float ls0 = 0.f, ls1 = 0.f; \
        AT_SB(); __builtin_amdgcn_s_setprio(1); \
          \
        _Pragma("unroll") for (int i = 0; i < 8; ++i) { \
            AT_QKM(SB0, SB1, i); \
            _Pragma("unroll") for (int k_ = 0; k_ < 3; ++k_) { const int e_ = 3 * i + k_; if (e_ < 16) { SA0[e_ & 15] = __builtin_amdgcn_exp2f(SA0[e_ & 15]); asm volatile("" : "+v"(SA0[e_ & 15])); } else { SA1[e_ & 15] = __builtin_amdgcn_exp2f(SA1[e_ & 15]); asm volatile("" : "+v"(SA1[e_ & 15])); } } \
            AT_SB(); } \
        { const unsigned char* va = vb_ + l32 * AT_VP + hi * 16; \
          _Pragma("unroll") for (int kj = 0; kj < 4; ++kj) { vfr[2 * kj] = *(const bf16x8*)(va + kj * 32); vfr[2 * kj + 1] = *(const bf16x8*)(va + 32 * AT_VP + kj * 32); } } \
        bf16x8 pb[4]; \
        _Pragma("unroll") for (int i = 8; i < 12; ++i) { \
            AT_QKM(SB0, SB1, i); \
            _Pragma("unroll") for (int k_ = 0; k_ < 2; ++k_) { const int e_ = 24 + 2 * (i - 8) + k_; SA1[e_ & 15] = __builtin_amdgcn_exp2f(SA1[e_ & 15]); asm volatile("" : "+v"(SA1[e_ & 15])); } \
            if (i == 9) { AT_PACK(pb[0], SA0, 0); asm volatile("" : "+v"(pb[0])); } \
            if (i == 11) { AT_PACK(pb[1], SA0, 8); asm volatile("" : "+v"(pb[1])); } \
            AT_SB(); } \
        float mq0 = SB0[0], mq1 = SB1[0]; __builtin_amdgcn_s_setprio(2); \
        _Pragma("unroll") for (int kj = 0; kj < 4; ++kj) { \
            o0 = __builtin_amdgcn_mfma_f32_32x32x16_bf16(vfr[2 * kj], pb[kj], o0, 0, 0, 0); o1 = __builtin_amdgcn_mfma_f32_32x32x16_bf16(vfr[2 * kj + 1], pb[kj], o1, 0, 0, 0); \
            if (kj == 0) { AT_PACK(pb[2], SA1, 0); asm volatile("" : "+v"(pb[2])); } \
            if (kj == 1) { AT_PACK(pb[3], SA1, 8); asm volatile("" : "+v"(pb[3])); } \
            if (kj == 2) { if (t_ + 3 < NT) AT_LSTOREK(lds + ((t_ + 3) & 3) * AT_KB); if (t_ + 2 < NT) AT_LSTOREV(lds + AT_V0 + ((t_ + 2) & 3) * AT_VBS); }     \
            _Pragma("unroll") for (int r_ = 0; r_ < 4; ++r_) { ls0 += SA0[4 * kj + r_]; ls1 += SA1[4 * kj + r_]; } \
            mq0 = __builtin_fmaxf(__builtin_fmaxf(mq0, SB0[4 * kj]), SB0[4 * kj + 1]); mq1 = __builtin_fmaxf(__builtin_fmaxf(mq1, SB1[4 * kj]), SB1[4 * kj + 1]); \
            mq0 = __builtin_fmaxf(__builtin_fmaxf(mq0, SB0[4 * kj + 2]), SB0[4 * kj + 3]); mq1 = __builtin_fmaxf(__builtin_fmaxf(mq1, SB1[4 * kj + 2]), SB1[4 * kj + 3]); \
            asm volatile("" : "+v"(mq0), "+v"(mq1), "+v"(ls0), "+v"(ls1)); AT_SB(); } \
        lsum += ls0 + ls1; \
        __builtin_amdgcn_s_setprio(0); mxc = __builtin_fmaxf(mq0, mq1);            \
        if (t_ & 1) __syncthreads(); \
    } while (0)
    float mxc = at_max32(sa0, sa1);
    for (int t = 0; t < NT; t += 2) { AT_STEP(sa0, sa1, sb0, sb1, t); AT_STEP(sb0, sb1, sa0, sa1, t + 1); }
    lsum += __shfl_xor(lsum, 32);
    const float inv = 1.0f / lsum;
    bf16_t* op = MIX + (size_t)qrow * 1024 + 256 + h * 64 + 4 * hi;
#pragma unroll
    for (int g4 = 0; g4 < 4; ++g4) { u32x2 w0, w1; w0.x = pk2(o0[4 * g4] * inv, o0[4 * g4 + 1] * inv); w0.y = pk2(o0[4 * g4 + 2] * inv, o0[4 * g4 + 3] * inv);
        w1.x = pk2(o1[4 * g4] * inv, o1[4 * g4 + 1] * inv); w1.y = pk2(o1[4 * g4 + 2] * inv, o1[4 * g4 + 3] * inv);
        *(u32x2*)(op + 8 * g4) = w0; *(u32x2*)(op + 32 + 8 * g4) = w1; }
#undef AT_GLOADK
#undef AT_GLOADV
#undef AT_LSTOREK
#undef AT_LSTOREV
#undef AT_STEP
#undef AT_QKM
#undef AT_EXS
#undef AT_PACK
#undef AT_MAX4
#undef AT_SB
}

constexpr int RT_VP = 264, RT_SP = 144, RT_VB = 2 * 64 * RT_VP;
DEV void retout_unit(const Params& p, int l, unsigned char* lds, int u, bool early) {
    const int tid = otid(), lane = tid & 63, wid = tid >> 6, l32 = lane & 31, hi = lane >> 5;
    const int gc = u >> 1, hp = u & 1; const int cb = gc % 66; const bool lat = cb >= 2; const int t0 = (cb - 2) * 128; const int r0 = gc * 128;
    const bf16_t* P = (const bf16_t*)p.out; bf16_t* MIX = (bf16_t*)(p.ws + OFF_HN); const f32x2* rope = (const f32x2*)(p.ws + OFF_ROPE);
    const float* SIN = (const float*)(p.ws + OFF_OV + OV_SIN);
    bf16_t* VTl = (bf16_t*)lds; bf16_t* STl = (bf16_t*)(lds + RT_VB);
    __syncthreads();
    for (int task = tid; task < 2048; task += NWG_T) { const int hh = task >> 10, key = (task >> 3) & 127, ch = task & 7;
        const bf16x8 v = *(const bf16x8*)(P + (size_t)(r0 + key) * INW + 256 + (2 * hp + hh) * 64 + ch * 8);
#pragma unroll
        for (int j = 0; j < 8; ++j) VTl[(hh * 64 + ch * 8 + j) * (RT_VP / 2) + key] = (bf16_t)v[j]; }
    for (int task = tid; task < 8192; task += NWG_T) { const int dv = task & 63, k = (task >> 6) & 31, dir = (task >> 11) & 1, hh = task >> 12;
        float sv;
        if (!early) sv = SIN[((size_t)(gc * 4 + 2 * hp + hh) * 2 + dir) * 2048 + k * 64 + dv];
        else { const int og = dir == 0 ? gc - 1 : gc + 1; const bool zero = dir == 0 ? (cb == 0) : (cb == 1);
               sv = zero ? 0.f : ((const float*)(p.ws + OFF_OV + OV_SLOC))[((size_t)(og * 4 + 2 * hp + hh) * 2 + dir) * 2048 + k * 64 + dv]; }
        STl[(hh * 64 + dv) * (RT_SP / 2) + dir * 32 + k] = (bf16_t)f2bf(sv); }
    __syncthreads();
    const int hh = wid >> 2, h = 2 * hp + hh, qblk = wid & 3; const int n = 32 * qblk + l32; const int rq = r0 + n;
    const float lf = log2_sigmoid(p.ret_decay_f[l * 4 + h]), lb = log2_sigmoid(p.ret_decay_b[l * 4 + h]);
    float qv0[8], qv1[8]; bf16x8 qf0, qf1;
    { const bf16_t* qp = P + (size_t)rq * INW + h * 32 + 8 * hi; const bf16x8 a = *(const bf16x8*)qp, c2 = *(const bf16x8*)(qp + 16);
#pragma unroll
      for (int j = 0; j < 8; ++j) { float x1 = bf2f((unsigned short)a[j]), x2 = bf2f((unsigned short)c2[j]);
          if (lat) { const f32x2 cs = rope[(size_t)(t0 + n) * 16 + 8 * hi + j]; const float y1 = x1 * cs.x - x2 * cs.y, y2 = x2 * cs.x + x1 * cs.y; x1 = y1; x2 = y2; }
          qv0[j] = x1; qv1[j] = x2; }
      qf0 = pack8(qv0[0], qv0[1], qv0[2], qv0[3], qv0[4], qv0[5], qv0[6], qv0[7]); qf1 = pack8(qv1[0], qv1[1], qv1[2], qv1[3], qv1[4], qv1[5], qv1[6], qv1[7]); }
    f32x16 o0, o1;
#pragma unroll
    for (int r = 0; r < 16; ++r) { o0[r] = 0.f; o1[r] = 0.f; }
    const unsigned char* vbase = (const unsigned char*)VTl + (size_t)(hh * 64 + l32) * RT_VP + hi * 8;
    bf16x8 kga[4], kgc[4];
#pragma unroll
    for (int kb = 0; kb < 4; ++kb) { const bf16_t* kp = P + (size_t)(r0 + 32 * kb + l32) * INW + 128 + h * 32 + 8 * hi; kga[kb] = *(const bf16x8*)kp; kgc[kb] = *(const bf16x8*)(kp + 16); }
    __builtin_amdgcn_sched_barrier(0);
#pragma unroll
    for (int kb = 0; kb < 4; ++kb) {
        bf16x8 kf0, kf1;
        { const int key = 32 * kb + l32; const bf16x8 a = kga[kb], c2 = kgc[kb];
          float y1[8], y2[8];
#pragma unroll
          for (int j = 0; j < 8; ++j) { float x1 = bf2f((unsigned short)a[j]), x2 = bf2f((unsigned short)c2[j]);
              if (lat) { const f32x2 cs = rope[(size_t)(t0 + key) * 16 + 8 * hi + j]; const float z1 = x1 * cs.x - x2 * cs.y, z2 = x2 * cs.x + x1 * cs.y; x1 = z1; x2 = z2; }
              y1[j] = x1 * 0.17677669529663687f; y2[j] = x2 * 0.17677669529663687f; }
          kf0 = pack8(y1[0], y1[1], y1[2], y1[3], y1[4], y1[5], y1[6], y1[7]); kf1 = pack8(y2[0], y2[1], y2[2], y2[3], y2[4], y2[5], y2[6], y2[7]); }
        f32x16 s;
#pragma unroll
        for (int r = 0; r < 16; ++r) s[r] = 0.f;
        s = __builtin_amdgcn_mfma_f32_32x32x16_bf16(kf0, qf0, s, 0, 0, 0); s = __builtin_amdgcn_mfma_f32_32x32x16_bf16(kf1, qf1, s, 0, 0, 0);
#pragma unroll
        for (int r = 0; r < 16; ++r) { const int m = 32 * kb + crow(r, hi); const int dl = n - m; const float e = dl >= 0 ? lf * (float)dl : lb * (float)(-dl); s[r] *= __builtin_amdgcn_exp2f(e); }
#pragma unroll
        for (int jp = 0; jp < 2; ++jp) { const bf16x8 pb = pack8(s[8 * jp + 0], s[8 * jp + 1], s[8 * jp + 2], s[8 * jp + 3], s[8 * jp + 4], s[8 * jp + 5], s[8 * jp + 6], s[8 * jp + 7]);
            const unsigned char* vp = vbase + (32 * kb + 16 * jp) * 2;
            const u32x2 a00 = *(const u32x2*)vp, a01 = *(const u32x2*)(vp + 16), a10 = *(const u32x2*)(vp + 32 * RT_VP), a11 = *(const u32x2*)(vp + 32 * RT_VP + 16);
            const bf16x8 A0 = __builtin_bit_cast(bf16x8, (u32x4){a00.x, a00.y, a01.x, a01.y}), A1 = __builtin_bit_cast(bf16x8, (u32x4){a10.x, a10.y, a11.x, a11.y});
            o0 = __builtin_amdgcn_mfma_f32_32x32x16_bf16(A0, pb, o0, 0, 0, 0); o1 = __builtin_amdgcn_mfma_f32_32x32x16_bf16(A1, pb, o1, 0, 0, 0); }
    }
    { const float df = __builtin_amdgcn_exp2f(lf * (float)(n + 1)), db = __builtin_amdgcn_exp2f(lb * (float)(128 - n));
      const unsigned char* sbase = (const unsigned char*)STl + (size_t)(hh * 64 + l32) * RT_SP + hi * 16;
#pragma unroll
      for (int ks = 0; ks < 4; ++ks) { const float dd = ks < 2 ? df : db;
          const bf16x8 qb = (ks & 1) ? pack8(qv1[0] * dd, qv1[1] * dd, qv1[2] * dd, qv1[3] * dd, qv1[4] * dd, qv1[5] * dd, qv1[6] * dd, qv1[7] * dd)
                                     : pack8(qv0[0] * dd, qv0[1] * dd, qv0[2] * dd, qv0[3] * dd, qv0[4] * dd, qv0[5] * dd, qv0[6] * dd, qv0[7] * dd);
          const bf16x8 A0 = *(const bf16x8*)(sbase + ks * 32), A1 = *(const bf16x8*)(sbase + 32 * RT_SP + ks * 32);
          o0 = __builtin_amdgcn_mfma_f32_32x32x16_bf16(A0, qb, o0, 0, 0, 0); o1 = __builtin_amdgcn_mfma_f32_32x32x16_bf16(A1, qb, o1, 0, 0, 0); } }
    float ssq = 0.f;
#pragma unroll
    for (int r = 0; r < 16; ++r) ssq += o0[r] * o0[r] + o1[r] * o1[r];
    ssq += __shfl_xor(ssq, 32);
    const float rstd = rsqrtf(ssq * (1.f / 64.f) + EPS);
    const bf16_t* gp = P + (size_t)rq * INW + 512 + h * 64 + 4 * hi; bf16_t* op = MIX + (size_t)rq * 1024 + h * 64 + 4 * hi;
#pragma unroll
    for (int g4 = 0; g4 < 4; ++g4) { const u32x2 ga = *(const u32x2*)(gp + 8 * g4), gb = *(const u32x2*)(gp + 32 + 8 * g4);
        u32x2 w0, w1;
        w0.x = pk2(o0[4 * g4] * rstd * siluf(bf2f(ga.x & 0xffff)), o0[4 * g4 + 1] * rstd * siluf(bf2f(ga.x >> 16))); w0.y = pk2(o0[4 * g4 + 2] * rstd * siluf(bf2f(ga.y & 0xffff)), o0[4 * g4 + 3] * rstd * siluf(bf2f(ga.y >> 16)));
        w1.x = pk2(o1[4 * g4] * rstd * siluf(bf2f(gb.x & 0xffff)), o1[4 * g4 + 1] * rstd * siluf(bf2f(gb.x >> 16))); w1.y = pk2(o1[4 * g4 + 2] * rstd * siluf(bf2f(gb.y & 0xffff)), o1[4 * g4 + 3] * rstd * siluf(bf2f(gb.y >> 16)));
        *(u32x2*)(op + 8 * g4) = w0; *(u32x2*)(op + 32 + 8 * g4) = w1; }
}

DEV void phase_ffn_fixup(const Params& p, int l) {
    const float* EDGE = (const float*)(p.ws + OFF_EDGE); bf16_t* ACT = (bf16_t*)(p.ws + OFF_OV);
    const float* cw = p.conv_w + (size_t)l * 3 * 5632; const float* cbv = p.conv_b + (size_t)l * 5632;
    for (int idx = blockIdx.x * NWG_T + otid(); idx < 66 * 2 * 704; idx += gridDim.x * NWG_T) {
        const int ch4 = idx % 704, rest = idx / 704; const int which = rest & 1, pm = rest >> 1; const int jj = pm % 33;
        if (l == 1 && jj == 0) continue;
        const int ch = 4 * ch4, pn = ch >> 7, c = ch & 127;
        const bool sstart = jj <= 1, send = (jj == 0) || (jj == 32);
        const f32x4 zz = {0.f, 0.f, 0.f, 0.f};
#define EDG(tile, k, half) (*(const f32x4*)(EDGE + ((size_t)((tile) * 4 + (k)) * 22 + pn) * 256 + (half) * 128 + c))
        f32x4 ua, ub, ca, cb2, da, db;
        if (which == 0) { ua = sstart ? zz : EDG(pm - 1, 3, 0); ub = sstart ? zz : EDG(pm - 1, 3, 1); ca = EDG(pm, 0, 0); cb2 = EDG(pm, 0, 1); da = EDG(pm, 1, 0); db = EDG(pm, 1, 1); }
        else { ua = EDG(pm, 2, 0); ub = EDG(pm, 2, 1); ca = EDG(pm, 3, 0); cb2 = EDG(pm, 3, 1); da = send ? zz : EDG(pm + 1, 0, 0); db = send ? zz : EDG(pm + 1, 0, 1); }
#undef EDG
        const f32x4 wa0 = *(const f32x4*)(cw + ch), wa1 = *(const f32x4*)(cw + 5632 + ch), wa2 = *(const f32x4*)(cw + 2 * 5632 + ch), ba = *(const f32x4*)(cbv + ch);
        const f32x4 wb0 = *(const f32x4*)(cw + DFF + ch), wb1 = *(const f32x4*)(cw + 5632 + DFF + ch), wb2 = *(const f32x4*)(cw + 2 * 5632 + DFF + ch), bb = *(const f32x4*)(cbv + DFF + ch);
        const f32x4 xa = wa0 * ua + wa1 * ca + wa2 * da + ba, xb = wb0 * ub + wb1 * cb2 + wb2 * db + bb;
        u32x2 w; w.x = pk2(siluf(xa.x) * xb.x, siluf(xa.y) * xb.y); w.y = pk2(siluf(xa.z) * xb.z, siluf(xa.w) * xb.w);
        *(u32x2*)(ACT + (size_t)(pm * 256 + (which ? 255 : 0)) * DFF + ch) = w;
    }
}

#define RLX_AGENT __ATOMIC_RELAXED, __HIP_MEMORY_SCOPE_AGENT
#define XB_TMO      128
#define XB_XCNT(j)  (256  + 64 * (j))
#define XB_XSUB(j)  (1280 + 64 * (j))
#define XB_XGEN(j)  (2304 + 64 * (j))
#define XB_TOP      3328
#define XB_TOPGEN   3392
#define XCD_BAR_WORDS 3456
#define XB_SPIN_CAP (1u << 18)

__device__ __forceinline__ unsigned xb_ld(unsigned* p)              { return __hip_atomic_load(p, __ATOMIC_RELAXED, __HIP_MEMORY_SCOPE_AGENT); }
__device__ __forceinline__ unsigned xb_add(unsigned* p, unsigned v) { return __hip_atomic_fetch_add(p, v, __ATOMIC_RELAXED, __HIP_MEMORY_SCOPE_AGENT); }
__device__ __forceinline__ unsigned xb_xcc_id() { return (unsigned)__builtin_amdgcn_s_getreg((3 << 11) | 20) & 0xFu; }
#define XB_SPIN(cond, bar) do { unsigned _sp = 0; while (cond) { __builtin_amdgcn_s_sleep(1); \
    if ((++_sp & 255u) == 0u) { if (xb_ld(&(bar)[XB_TMO])) break; if (_sp > XB_SPIN_CAP) { atomicAdd(&(bar)[XB_TMO], 1u); break; } } } } while (0)

struct XcdBarrier {
    unsigned* bar; unsigned x;
    volatile LAS unsigned* st;
};

__device__ __forceinline__ XcdBarrier xcd_barrier_post(unsigned* bar, volatile LAS unsigned* st) {
    XcdBarrier b; b.bar = bar; b.x = xb_xcc_id(); b.st = st;
    if (threadIdx.x == 0) (void)xb_add(&bar[XB_XCNT(b.x)], 1u);
    return b;
}
__device__ __forceinline__ void xcd_barrier_complete(unsigned* bar, unsigned x, unsigned& nloc, unsigned& nx) {
    const unsigned G = gridDim.x * gridDim.y * gridDim.z;
    unsigned sum, cnt, mine, sp = 0u;
    for (;;) {
        sum = 0u; cnt = 0u; mine = 0u;
#pragma unroll
        for (unsigned j = 0; j < 16; ++j) { const unsigned c = xb_ld(&bar[XB_XCNT(j)]); sum += c; cnt += (c > 0u) ? 1u : 0u; mine = (j == x) ? c : mine; }
        if (sum == G) break;
        __builtin_amdgcn_s_sleep(1);
        if ((++sp & 255u) == 0u) { if (xb_ld(&bar[XB_TMO])) break; if (sp > XB_SPIN_CAP) { atomicAdd(&bar[XB_TMO], 1u); break; } }
    }
    nloc = mine > 0u ? mine : 1u; nx = cnt > 0u ? cnt : 1u;
}

__device__ __forceinline__ void xcd_barrier(const XcdBarrier& b) {
    asm volatile("s_waitcnt vmcnt(0)" ::: "memory");
    __syncthreads();
    if (threadIdx.x == 0) {
        unsigned* bar = b.bar;
        __builtin_amdgcn_s_waitcnt(0);
        unsigned nloc = b.st[0], nx = b.st[1];
        if (nloc == 0u) { xcd_barrier_complete(bar, b.x, nloc, nx); b.st[0] = nloc; b.st[1] = nx; }
        const unsigned old = xb_add(&bar[XB_XSUB(b.x)], 1u);
        const unsigned gen = old / nloc;
        if (old + 1u == (gen + 1u) * nloc) {
            __builtin_amdgcn_fence(__ATOMIC_RELEASE, "agent");
            asm volatile("s_waitcnt vmcnt(0)" ::: "memory");
            const unsigned og = xb_add(&bar[XB_TOP], 1u);
            const unsigned tg = og / nx;
            if (og + 1u == (tg + 1u) * nx) xb_add(&bar[XB_TOPGEN], 1u);
            else XB_SPIN(xb_ld(&bar[XB_TOPGEN]) == tg, bar);
            __builtin_amdgcn_fence(__ATOMIC_ACQUIRE, "agent");
            xb_add(&bar[XB_XGEN(b.x)], 1u);
            asm volatile("s_waitcnt vmcnt(0)" ::: "memory");
        } else {
            XB_SPIN(xb_ld(&bar[XB_XGEN(b.x)]) == gen, bar);
            __builtin_amdgcn_fence(__ATOMIC_ACQUIRE, "agent");
            asm volatile("s_waitcnt vmcnt(0)" ::: "memory");
        }
    }
    __syncthreads();
}


constexpr size_t OFF_CTL = 250000128; constexpr int CTL_BYTES = 16384;
#if defined(__HIP_DEVICE_COMPILE__)
#define KP() const __attribute__((address_space(4))) Params* kp_ = (const __attribute__((address_space(4))) Params*)__builtin_amdgcn_kernarg_segment_ptr(); asm volatile("" : "+s"(kp_)); const Params p = *kp_; \
    bf16_t* HN = (bf16_t*)(p.ws + OFF_HN); bf16_t* P = (bf16_t*)p.out; float* X = (float*)(p.ws + OFF_X); (void)HN; (void)P; (void)X
#else
#define KP() const Params p = p_arg; bf16_t* HN = (bf16_t*)(p.ws + OFF_HN); bf16_t* P = (bf16_t*)p.out; float* X = (float*)(p.ws + OFF_X); (void)HN; (void)P; (void)X
#endif
#define WL() const bf16_t* wl = (const bf16_t*)(p.ws + OFF_W) + (size_t)l * W_LAYER; const float* modv = (const float*)(p.ws + OFF_MOD) + (size_t)l * 3 * 6144; (void)wl; (void)modv
#ifndef DUPM
#define DUPM 0
#endif
#define REP(bit) for (int rep_ = 0; rep_ < (((DUPM) >> (bit)) & 1) + 1; ++rep_)
constexpr int PH_PER_LAYER = 10, N_PHASES = 2 + 2 * PH_PER_LAYER;
__global__ void __launch_bounds__(512, 2) mk_fwd(Params p_arg) {
    extern __shared__ __attribute__((aligned(16))) unsigned char lds[];
    cg::grid_group grid = cg::this_grid();
    const int G = gridDim.x, bx = blockIdx.x; const int vcu = (G % 8 == 0) ? (bx % 8) * (G / 8) + bx / 8 : bx;
    LAS unsigned char* ldsl = (LAS unsigned char*)lds;
    const int ph_lo = p_arg.ph_lo, ph_hi = p_arg.ph_hi;
    volatile LAS unsigned* misc = (volatile LAS unsigned*)(ldsl + (LDS_BYTES - 64));
    { const int t0_ = otid(); if (t0_ < 16) misc[t0_] = 0u; }
    __syncthreads();
    if (ph_hi - ph_lo > 1) (void)xcd_barrier_post((unsigned*)(p_arg.ws + OFF_CTL), misc);
    for (int ph = ph_lo; ph < ph_hi; ++ph) {
        if (ph == 0) { KP(); phase_prep(p, lds); __syncthreads(); }
        else if (ph == N_PHASES - 1) { KP(); phase_final(p);
#if (DUPM >> 10) & 1
            for (int i = 0; i < 20; ++i) grid.sync();
#endif
        }
        else {
            const int l = (ph - 1) / PH_PER_LAYER, sp = (ph - 1) % PH_PER_LAYER;
            if (sp == 0) { KP(); if (l == 0) REP(9) { phase_prep_weights(p, lds); __syncthreads(); }
                phase_norm(p, l, 0, l == 0, l == 1 ? (const float*)(p.ws + OFF_MOD) + 2 * 6144 + 5120 : nullptr); }
            else if (sp == 1) { KP(); WL(); REP(1) { __syncthreads();
                pg8::Gemm g{HN, wl + W_IN, R, 1792, 1024, 1024, 1024}; pg8::StaticOrder S; S.init(R, 1792, G, bx);
                pg8::EpiStore E{P, INW, INW, 1.0f};
                pg8::gemm_phase<pg8::EpiStore, pg8::StaticOrder, true, true>(ldsl, g, S, E); } }
            else if (sp == 2) { KP(); phase_rowwise(p, l); __syncthreads();
                REP(2) phase_pool(p);
                REP(3) for (int it = G - 1 - bx; it < 264; it += G) states_item(p, l, lds, it); __syncthreads(); }
            else if (sp == 3) { KP(); WL(); REP(4) { __syncthreads();
                { pg8::Gemm g{P + 768, wl + W_UQ, R, 768, 384, INW, 384}; pg8::StaticOrder S; S.init(R, 768, G, bx);
                  pg8::EpiStore E{(bf16_t*)(p.ws + OFF_OV + OV_Q), 768, 768, 0.14724444f};
                  pg8::gemm_phase<pg8::EpiStore, pg8::StaticOrder, true, true>(ldsl, g, S, E); }
                __syncthreads();
                { pg8::Gemm g{P + 1152, wl + W_KN, R, 512, 256, INW, 256}; pg8::StaticOrder S; S.init(R, 512, G, (bx + 58) % G);
                  pg8::EpiStore E{(bf16_t*)(p.ws + OFF_OV + OV_KN), 512, 512, 1.0f};
                  pg8::gemm_phase<pg8::EpiStore, pg8::StaticOrder, true, true>(ldsl, g, S, E); }
                __syncthreads();
                { pg8::Gemm g{wl + W_V, P + 1152, 512, R, 256, 256, INW}; pg8::StaticOrder S; S.init(512, R, G, (bx + 182) % G);
                  pg8::EpiStore E{(bf16_t*)(p.ws + OFF_OV + OV_VT), R, R, 1.0f};
                  pg8::gemm_phase<pg8::EpiStore, pg8::StaticOrder, true, true>(ldsl, g, S, E); }
                if (bx >= G - 64) scan_threads(p, l, (bx - (G - 64)) * NWG_T + otid());
                if (l == 0 && bx >= G - 50 && bx < G - 42) { const int i8 = bx - (G - 50); const int gcs = (i8 >> 1) < 2 ? (i8 >> 1) : 64 + (i8 >> 1); retout_unit(p, l, lds, gcs * 2 + (i8 & 1), true); } } }
            else if (sp == 4) { KP();
                REP(5) for (int u = vcu; u < (l == 0 ? 528 : 512); u += G) attn_unit(p, lds, u);
                REP(6) for (int u = G - 1 - bx; u < 256; u += G) retout_unit(p, l, lds, u + 4 * (u >> 7) + 4, false); }
            else if (sp == 5) { KP(); WL(); __syncthreads();
                { pg8::Gemm g{HN, wl + W_OUT, R, 1024, 1024, 1024, 1024}; pg8::StaticOrder S; S.init(16384, 1024, G, bx, 1);
                  pg8::EpiResid E{X, modv + 2048, 0};
                  pg8::gemm_phase<pg8::EpiResid, pg8::StaticOrder, true, true>(ldsl, g, S, E); }
                if (l == 0 && bx < 32) { __syncthreads(); const int q = bx >> 3;
                  pg8::Gemm g{HN + q * 256, wl + W_OUT + q * 256, 512, 1024, 256, 1024, 1024}; pg8::StaticOrder S; S.init(512, 1024, G, bx & 7, 2);
                  pg8::EpiPart E{(float*)(p.ws + OFF_PART) + (size_t)q * 524288, 0};
                  pg8::gemm_phase<pg8::EpiPart, pg8::StaticOrder, true, true>(ldsl, g, S, E); } }
            else if (sp == 6) { KP(); WL(); phase_norm(p, l, 1, false, l == 0 ? modv + 2 * 6144 + 2048 : nullptr); }
            else if (sp == 7) { KP(); WL(); REP(7) { __syncthreads();
                pg8::Gemm g{HN, wl + W_UP, R, 2 * DFF, 1024, 1024, 1024}; pg8::StaticOrder S; S.init(l == 1 ? 16384 : R, 2 * DFF, G, bx, l == 1 ? 1 : 0);
                pg8::EpiFfn E{(bf16_t*)(p.ws + OFF_OV), (float*)(p.ws + OFF_EDGE), p.conv_w + (size_t)l * 3 * 5632, p.conv_b + (size_t)l * 5632, (LAS float*)(ldsl + 131072)};
                pg8::gemm_phase<pg8::EpiFfn, pg8::StaticOrder, true, true>(ldsl, g, S, E); } }
            else if (sp == 8) { KP(); REP(8) phase_ffn_fixup(p, l); }
            else if (sp == 9) { KP(); WL(); __syncthreads();
                { pg8::Gemm g{(const bf16_t*)(p.ws + OFF_OV), wl + W_DN, R, 1024, DFF, DFF, DFF}; pg8::StaticOrder S; S.init(16384, 1024, G, bx, 1);
                  pg8::EpiResid E{X, modv + 5120, 0};
                  pg8::gemm_phase<pg8::EpiResid, pg8::StaticOrder, true, true>(ldsl, g, S, E); }
                if (l == 0 && bx < 32) { __syncthreads(); const int q = bx >> 3; const int koff = q < 2 ? q * 768 : 1536 + (q - 2) * 640, klen = q < 2 ? 768 : 640;
                  pg8::Gemm g{(const bf16_t*)(p.ws + OFF_OV) + koff, wl + W_DN + koff, 512, 1024, klen, DFF, DFF}; pg8::StaticOrder S; S.init(512, 1024, G, bx & 7, 2);
                  pg8::EpiPart E{(float*)(p.ws + OFF_PART) + (size_t)q * 524288, 0};
                  pg8::gemm_phase<pg8::EpiPart, pg8::StaticOrder, true, true>(ldsl, g, S, E); } }
        }
        if (ph + 1 < ph_hi) {
            if (ph_lo < 0) grid.sync();
            { KP(); XcdBarrier b; b.bar = (unsigned*)(p.ws + OFF_CTL); b.x = xb_xcc_id(); b.st = misc; xcd_barrier(b); }
        }
    }
}

extern "C" void kernel_launch(void* const* d_in, const int* in_sizes, int n_in, void* d_out, int out_size, void* d_ws, size_t ws_size, hipStream_t stream) {
    static int grid = 0;
    if (grid == 0) {
        if (n_in != 23 || ws_size < WS_NEED) { fprintf(stderr, "kernel_launch: unexpected problem (n_in %d, ws %zu, need %zu)\n", n_in, ws_size, (size_t)WS_NEED); grid = -1; return; }
        int dev = 0, cus = 0, per_cu = 0;
        hipGetDevice(&dev); hipDeviceGetAttribute(&cus, hipDeviceAttributeMultiprocessorCount, dev);
        if (hipFuncSetAttribute((const void*)mk_fwd, hipFuncAttributeMaxDynamicSharedMemorySize, LDS_BYTES) != hipSuccess) { fprintf(stderr, "kernel_launch: hipFuncSetAttribute failed\n"); grid = -1; return; }
        if (hipOccupancyMaxActiveBlocksPerMultiprocessor(&per_cu, (const void*)mk_fwd, 512, LDS_BYTES) != hipSuccess || per_cu < 1) { fprintf(stderr, "kernel_launch: occupancy query says %d\n", per_cu); per_cu = 1; }
        (void)hipGetLastError();
        grid = cus * per_cu; if (grid > 256) grid = 256;
        fprintf(stderr, "kernel_launch: grid %d (cus %d, per_cu %d)\n", grid, cus, per_cu);
    }
    if (grid < 0) return;
    Params p{};
    const float** pp = (const float**)&p;
    for (int i = 0; i < 23; ++i) pp[i] = (const float*)d_in[i];
    p.out = (float*)d_out; p.ws = (unsigned char*)d_ws;
#if MK_MULTI
    for (int ph = 0; ph < N_PHASES; ++ph) { p.ph_lo = ph; p.ph_hi = ph + 1; void* args[] = {&p};
        hipError_t e = hipLaunchCooperativeKernel((void*)mk_fwd, dim3(grid), dim3(512), args, LDS_BYTES, stream);
        if (e != hipSuccess) { fprintf(stderr, "launch %d failed: %s\n", ph, hipGetErrorString(e)); break; } }
#else
    if (hipMemsetAsync((char*)d_ws + OFF_CTL, 0, CTL_BYTES, stream) != hipSuccess) { fprintf(stderr, "kernel_launch: memset of the barrier words failed\n"); return; }
    p.ph_lo = 0; p.ph_hi = N_PHASES; void* args[] = {&p};
    hipError_t e = hipLaunchCooperativeKernel((void*)mk_fwd, dim3(grid), dim3(512), args, LDS_BYTES, stream);
    if (e != hipSuccess) fprintf(stderr, "cooperative launch failed: %s (grid %d)\n", hipGetErrorString(e), grid);
#endif
}
```

```cpp
#include <hip/hip_runtime.h>
#include <hip/hip_cooperative_groups.h>
#include <cstdio>
#include <cstdint>
namespace cg = cooperative_groups;

#ifndef MK_MULTI
#define MK_MULTI 0
#endif

namespace pg8 {
#define PG8_LAS __attribute__((address_space(3)))
typedef unsigned short bf16_t;
typedef short bf16x8 __attribute__((ext_vector_type(8)));
typedef float f32x4 __attribute__((ext_vector_type(4)));
typedef unsigned u32x4 __attribute__((ext_vector_type(4)));
constexpr int BM = 256, BK = 64, HALF = 128, HTB = HALF * BK * 2  , STAGE_BYTES = 8 * HTB, NXCD = 8, WGM = 8;

__host__ __device__ __forceinline__ int lds_byte(int r, int c) { const int st = (r >> 4) * 2 + (c >> 5), rr = r & 15, cc = c & 31, ob = rr * 64 + cc * 2; return st * 1024 + (ob ^ (((ob >> 9) & 1) << 5)); }
__host__ __device__ __forceinline__ void stage_rc(int b, int& R, int& C) { const int st = b / 1024, sb = b % 1024, swz = sb ^ (((sb >> 9) & 1) << 5); R = (st >> 1) * 16 + swz / 64; C = (st & 1) * 32 + (swz % 64) / 2; }
__host__ __device__ __forceinline__ int perm32(int rho) { const int n = rho >> 4, i = rho & 15; return 8 * (i >> 2) + 4 * n + (i & 3); }

struct Unit { int pm, pn; };
struct Gemm { const bf16_t* A; const bf16_t* Bt; int M, N, K, lda, ldb; };

struct StaticOrder {
    int nM, nN, nwg, G, c, skip;
    __host__ __device__ void init(int M, int N, int G_, int c_, int skip_ = 0) { nM = M / BM; nN = N / BM; nwg = nM * nN; G = G_; c = c_; skip = skip_; }
    __host__ __device__ bool next(int i, Unit& u) const {
        const long L = (long)i * G + c; if (L >= nwg) return false;
        int wgid = (int)L; { const int q = nwg / NXCD, r = nwg % NXCD, xcd = wgid % NXCD, off = wgid / NXCD; wgid = (xcd < r ? xcd * (q + 1) : r * (q + 1) + (xcd - r) * q) + off; }
        const int nig = WGM * nN, gid = wgid / nig, fm = gid * WGM, gsz = (nM - fm) < WGM ? (nM - fm) : WGM;
        u.pm = fm + ((wgid % nig) % gsz); u.pn = (wgid % nig) / gsz; if (skip == 1) u.pm += 1 + (u.pm >= 32 ? 1 : 0); else if (skip == 2) u.pm *= 33; return true;
    }
    __device__ __forceinline__ void a_ready(const Unit&) const {}
    __device__ __forceinline__ void done(const Unit&) const {}
};

__device__ __forceinline__ unsigned cvt_pk_bf16(float lo, float hi) { unsigned r; asm volatile("v_cvt_pk_bf16_f32 %0, %1, %2" : "=v"(r) : "v"(lo), "v"(hi)); return r; }

struct EpiStore {
    static constexpr bool PERM = true, AFTER_DRAIN = false, APERM = false;
    bf16_t* O; int ldc; int ncols; float scale;
    __device__ __forceinline__ void operator()(const f32x4 (&acc)[2][2][4][2], const Unit& u, int wr, int wc, int fr, int fq) const {
        const int row0 = u.pm * BM + wr * 64 + fr; const int col0 = u.pn * BM + wc * 32 + 8 * fq;
#pragma unroll
        for (int ai = 0; ai < 2; ++ai)
#pragma unroll
            for (int m = 0; m < 4; ++m) { bf16_t* rowp = O + (size_t)(row0 + ai * HALF + m * 16) * ldc + col0;
#pragma unroll
                for (int bj = 0; bj < 2; ++bj) { if (col0 + bj * HALF < ncols) {
                    f32x4 v0 = acc[ai][bj][m][0] * scale, v1 = acc[ai][bj][m][1] * scale;
                    u32x4 w; w.x = cvt_pk_bf16(v0[0], v0[1]); w.y = cvt_pk_bf16(v0[2], v0[3]); w.z = cvt_pk_bf16(v1[0], v1[1]); w.w = cvt_pk_bf16(v1[2], v1[3]);
                    *(u32x4*)(rowp + bj * HALF) = w; } } }
    }
};
struct EpiResid {
    static constexpr bool PERM = false, AFTER_DRAIN = false, APERM = false;
    float* X; const float* gate; int row_tile0;
    __device__ __forceinline__ void operator()(const f32x4 (&acc)[2][2][4][2], const Unit& u, int wr, int wc, int fr, int fq) const {
        const int tpm = u.pm + row_tile0; const int bb = tpm / 33, jj = tpm - bb * 33; const float* gv = gate + (jj == 0 ? 2 : bb) * 6144;
        const int col0 = u.pn * BM + wc * 32 + 4 * fq;
#pragma unroll
        for (int ai = 0; ai < 2; ++ai)
#pragma unroll
            for (int m = 0; m < 4; ++m) { float* rowp = X + (size_t)(tpm * BM + ai * HALF + wr * 64 + m * 16 + fr) * 1024 + col0;
#pragma unroll
                for (int bj = 0; bj < 2; ++bj) {
#pragma unroll
                    for (int n = 0; n < 2; ++n) { f32x4* q = (f32x4*)(rowp + bj * HALF + n * 16); const f32x4 gq = *(const f32x4*)(gv + col0 + bj * HALF + n * 16); f32x4 xv = *q; xv = xv + gq * acc[ai][bj][m][n]; *q = xv; }
                    asm volatile("" ::: "memory"); } }
    }
};
struct EpiPart {
    static constexpr bool PERM = false, AFTER_DRAIN = false, APERM = false;
    float* out; int accum;
    __device__ __forceinline__ void operator()(const f32x4 (&acc)[2][2][4][2], const Unit& u, int wr, int wc, int fr, int fq) const {
        const int t = u.pm / 33; const int col0 = u.pn * BM + wc * 32 + 4 * fq;
#pragma unroll
        for (int ai = 0; ai < 2; ++ai)
#pragma unroll
            for (int m = 0; m < 4; ++m) { float* rowp = out + (size_t)(t * BM + ai * HALF + wr * 64 + m * 16 + fr) * 1024 + col0;
#pragma unroll
                for (int bj = 0; bj < 2; ++bj) {
#pragma unroll
                    for (int n = 0; n < 2; ++n) { f32x4* q = (f32x4*)(rowp + bj * HALF + n * 16); f32x4 v = acc[ai][bj][m][n]; if (accum) v = v + *q; *q = v; }
                    asm volatile("" ::: "memory"); } }
    }
};
template <int CTRL> __device__ __forceinline__ float dpp0(float x) { return __builtin_bit_cast(float, __builtin_amdgcn_update_dpp(0, __builtin_bit_cast(int, x), CTRL, 0xf, 0xf, true)); }
struct EpiFfn {
    static constexpr bool PERM = false, AFTER_DRAIN = false, APERM = true;
    bf16_t* ACT; float* EDGE; const float* cw; const float* cb; PG8_LAS float* xl;
    __device__ __forceinline__ void operator()(const f32x4 (&acc)[2][2][4][2], const Unit& u, int wr, int wc, int fr, int fq) const {
        PG8_LAS float* FIRST = xl; PG8_LAS float* LAST = xl + 1024;
        const int cb0 = wc * 32 + 4 * fq;
#pragma unroll
        for (int ai = 0; ai < 2; ++ai)
#pragma unroll
            for (int bj = 0; bj < 2; ++bj)
#pragma unroll
                for (int n = 0; n < 2; ++n) { const int col = bj * HALF + cb0 + n * 16;
                    if (fr == 0) *(PG8_LAS f32x4*)(FIRST + (2 * ai + wr) * 256 + col) = acc[ai][bj][0][n];
                    if (fr == 15) *(PG8_LAS f32x4*)(LAST + (2 * ai + wr) * 256 + col) = acc[ai][bj][3][n]; }
        if (wr == 0 && fr == 0) {
#pragma unroll
            for (int bj = 0; bj < 2; ++bj)
#pragma unroll
                for (int n = 0; n < 2; ++n) { float* ep = EDGE + ((size_t)(u.pm * 4) * 22 + u.pn) * 256 + bj * HALF + cb0 + n * 16; *(f32x4*)ep = acc[0][bj][0][n]; *(f32x4*)(ep + 22 * 256) = acc[0][bj][1][n]; } }
        if (wr == 1 && fr == 15) {
#pragma unroll
            for (int bj = 0; bj < 2; ++bj)
#pragma unroll
                for (int n = 0; n < 2; ++n) { float* ep = EDGE + ((size_t)(u.pm * 4 + 2) * 22 + u.pn) * 256 + bj * HALF + cb0 + n * 16; *(f32x4*)ep = acc[1][bj][2][n]; *(f32x4*)(ep + 22 * 256) = acc[1][bj][3][n]; } }
        asm volatile("s_waitcnt lgkmcnt(0)" ::: "memory"); __builtin_amdgcn_s_barrier(); asm volatile("" ::: "memory");
#pragma unroll
        for (int n = 0; n < 2; ++n) { const int ch0 = u.pn * HALF + cb0 + n * 16;
            f32x4 wa[3], wb[3];
#pragma unroll
            for (int k = 0; k < 3; ++k) { wa[k] = *(const f32x4*)(cw + k * 5632 + ch0); wb[k] = *(const f32x4*)(cw + k * 5632 + 2816 + ch0); }
            const f32x4 ba = *(const f32x4*)(cb + ch0), bb = *(const f32x4*)(cb + 2816 + ch0);
#pragma unroll
            for (int ai = 0; ai < 2; ++ai) { const int g = 2 * ai + wr;
                f32x4 bu[2], bd[2];
#pragma unroll
                for (int bj = 0; bj < 2; ++bj) { const int col = bj * HALF + cb0 + n * 16; const f32x4 zz = {0.f, 0.f, 0.f, 0.f};
                    bu[bj] = g > 0 ? *(const PG8_LAS f32x4*)(LAST + (g - 1) * 256 + col) : zz; bd[bj] = g < 3 ? *(const PG8_LAS f32x4*)(FIRST + (g + 1) * 256 + col) : zz; }
                float o[4][4];
#pragma unroll
                for (int e = 0; e < 4; ++e) { float cv[2][4];
#pragma unroll
                    for (int bj = 0; bj < 2; ++bj) { const float v0 = acc[ai][bj][0][n][e], v1 = acc[ai][bj][1][n][e], v2 = acc[ai][bj][2][n][e], v3 = acc[ai][bj][3][n][e];
                        const float w0 = bj ? wb[0][e] : wa[0][e], w1 = bj ? wb[1][e] : wa[1][e], w2 = bj ? wb[2][e] : wa[2][e], bs = bj ? bb[e] : ba[e];
                        const float upx = dpp0<0x111>(v3) + (fr == 0 ? bu[bj][e] : 0.f);
                        const float dnx = dpp0<0x101>(v0) + (fr == 15 ? bd[bj][e] : 0.f);
                        cv[bj][0] = w0 * upx + w1 * v0 + w2 * v1 + bs; cv[bj][1] = w0 * v0 + w1 * v1 + w2 * v2 + bs;
                        cv[bj][2] = w0 * v1 + w1 * v2 + w2 * v3 + bs;  cv[bj][3] = w0 * v2 + w1 * v3 + w2 * dnx + bs; }
#pragma unroll
                    for (int m = 0; m < 4; ++m) o[m][e] = cv[0][m] * __builtin_amdgcn_rcpf(1.0f + __builtin_amdgcn_exp2f(-1.4426950408889634f * cv[0][m])) * cv[1][m]; }
#pragma unroll
                for (int m = 0; m < 4; ++m) { typedef unsigned u32x2 __attribute__((ext_vector_type(2))); u32x2 w; w.x = cvt_pk_bf16(o[m][0], o[m][1]); w.y = cvt_pk_bf16(o[m][2], o[m][3]);
                    *(u32x2*)(ACT + (size_t)(u.pm * BM + ai * HALF + wr * 64 + 4 * fr + m) * 2816 + ch0) = w; } } }
    }
};

template <class Epi, class Sched, bool ALIGN_EPI = false, bool SP2 = false>
__device__ __forceinline__ void gemm_phase(PG8_LAS unsigned char* lds, const Gemm g, const Sched& S, const Epi& E) {
    int tid = threadIdx.x; asm volatile("" : "+v"(tid));
    const int wid = __builtin_amdgcn_readfirstlane(tid >> 6), lane = tid & 63, wr = wid >> 2, wc = wid & 3, fr = lane & 15, fq = lane >> 4;
    int K = g.K; asm volatile("" : "+s"(K));
    const int nt = K / BK;
    unsigned voffA[2], voffB[2];
#pragma unroll
    for (int i = 0; i < 2; ++i) { int R, C; stage_rc(tid * 16 + i * 8192, R, C); const int Rb = Epi::PERM ? ((R & ~31) + perm32(R & 31)) : R;
        const int Ra = Epi::APERM ? ((R & ~63) + 4 * (R & 15) + ((R >> 4) & 3)) : R;
        voffA[i] = (unsigned)(Ra * g.lda + C) * 2u; voffB[i] = (unsigned)(Rb * g.ldb + C) * 2u; }
    const size_t kstep = (size_t)(BK * 2);
    const size_t hstepA = (size_t)HALF * g.lda * 2, hstepB = (size_t)HALF * g.ldb * 2;
    const size_t tstepA = 2 * hstepA, tstepB = 2 * hstepB;
    const unsigned ldsw = (unsigned)wid * 1024u;
    const int aoff = lds_byte(wr * 64 + fr, fq * 8), boff = lds_byte(wc * 32 + fr, fq * 8);
#define PG8_SA(b, h) (((b) * 2 + (h)) * HTB)
#define PG8_SB(b, h) ((4 + (b) * 2 + (h)) * HTB)
#define PG8_STAGE(bufoff, gbase, voff) do { _Pragma("unroll") for (int _i = 0; _i < 2; ++_i) \
        __builtin_amdgcn_global_load_lds((const unsigned*)((const char*)(gbase) + (voff)[_i]), (PG8_LAS unsigned*)(lds + (bufoff) + ldsw + _i * 8192), 16, 0, 0); } while (0)
#define PG8_LDA(dst, b, h) do { _Pragma("unroll") for (int m = 0; m < 4; ++m) _Pragma("unroll") for (int k = 0; k < 2; ++k) dst[m][k] = *(const PG8_LAS bf16x8*)(lds + PG8_SA(b, h) + aoff + m * 2048 + k * 1024); } while (0)
#define PG8_LDB(dst, b, h) do { _Pragma("unroll") for (int n = 0; n < 2; ++n) _Pragma("unroll") for (int k = 0; k < 2; ++k) dst[n][k] = *(const PG8_LAS bf16x8*)(lds + PG8_SB(b, h) + boff + n * 2048 + k * 1024); } while (0)
#define PG8_MMA(ai, bj, At, Bt) do { __builtin_amdgcn_s_setprio(1); _Pragma("unroll") for (int m = 0; m < 4; ++m) _Pragma("unroll") for (int n = 0; n < 2; ++n) _Pragma("unroll") for (int k = 0; k < 2; ++k) \
        acc[ai][bj][m][n] = __builtin_amdgcn_mfma_f32_16x16x32_bf16(Bt[n][k], At[m][k], acc[ai][bj][m][n], 0, 0, 0); __builtin_amdgcn_s_setprio(0); } while (0)
#define PG8_WAIT_V(n) asm volatile("s_waitcnt vmcnt(" #n ")" ::: "memory")
#define PG8_WAIT_L(n) asm volatile("s_waitcnt lgkmcnt(" #n ")" ::: "memory")
#define PG8_BAR __builtin_amdgcn_s_barrier()
#define PG8_SCHED __builtin_amdgcn_sched_barrier(0)
    Unit cur, nxt; int ui = 0;
    if (!S.next(0, cur)) return;
    f32x4 acc[2][2][4][2];
#pragma unroll
    for (int a = 0; a < 2; ++a)
#pragma unroll
        for (int b = 0; b < 2; ++b)
#pragma unroll
            for (int m = 0; m < 4; ++m)
#pragma unroll
                for (int n = 0; n < 2; ++n) acc[a][b][m][n] = (f32x4){0.f, 0.f, 0.f, 0.f};
    bf16x8 At[4][2], B0[2][2], B1[2][2];
    const char* cA = (const char*)g.A + (size_t)cur.pm * tstepA; const char* cB = (const char*)g.Bt + (size_t)cur.pn * tstepB;
    S.a_ready(cur);
    if constexpr (SP2) {
        PG8_STAGE(PG8_SB(0, 0), cB, voffB); PG8_STAGE(PG8_SB(0, 1), cB + hstepB, voffB); PG8_STAGE(PG8_SA(0, 0), cA, voffA); PG8_STAGE(PG8_SA(0, 1), cA + hstepA, voffA);
        if (wr == 1) PG8_BAR;
        PG8_WAIT_V(2); PG8_BAR;
        PG8_STAGE(PG8_SB(1, 0), cB + kstep, voffB); PG8_STAGE(PG8_SA(1, 0), cA + kstep, voffA); PG8_STAGE(PG8_SB(1, 1), cB + hstepB + kstep, voffB);
        PG8_WAIT_V(6); PG8_BAR;
    } else {
        PG8_STAGE(PG8_SB(0, 0), cB, voffB); PG8_STAGE(PG8_SA(0, 0), cA, voffA); PG8_STAGE(PG8_SB(0, 1), cB + hstepB, voffB); PG8_STAGE(PG8_SA(0, 1), cA + hstepA, voffA);
        if (wr == 1) PG8_BAR;
        PG8_WAIT_V(4); PG8_BAR;
        PG8_STAGE(PG8_SB(1, 0), cB + kstep, voffB); PG8_STAGE(PG8_SA(1, 0), cA + kstep, voffA); PG8_STAGE(PG8_SB(1, 1), cB + hstepB + kstep, voffB);
        PG8_WAIT_V(6); PG8_BAR;
    }
    for (;;) {
        const bool has_next = S.next(ui + 1, nxt);
        const char* nA = has_next ? (const char*)g.A + (size_t)nxt.pm * tstepA : cA; const char* nB = has_next ? (const char*)g.Bt + (size_t)nxt.pn * tstepB : cB;
        for (int t = 0; t < nt; t += 2) {
            const bool last = (t == nt - 2);
            const char* a1 = cA + (size_t)(t + 1) * kstep;
            const char* a2 = last ? nA : cA + (size_t)(t + 2) * kstep; const char* b2 = last ? nB : cB + (size_t)(t + 2) * kstep;
            const char* a3 = a2 + kstep; const char* b3 = b2 + kstep;
            if (last && has_next) S.a_ready(nxt);
            if constexpr (SP2) {
            PG8_LDB(B0, 0, 0); PG8_LDB(B1, 0, 1); PG8_SCHED; PG8_LDA(At, 0, 0); PG8_STAGE(PG8_SA(1, 1), a1 + hstepA, voffA);
            PG8_WAIT_V(8); PG8_WAIT_L(0); PG8_BAR; PG8_MMA(0, 0, At, B0); PG8_MMA(0, 1, At, B1); PG8_BAR; PG8_SCHED;
            PG8_LDA(At, 0, 1); PG8_STAGE(PG8_SB(0, 0), b2, voffB); PG8_STAGE(PG8_SB(0, 1), b2 + hstepB, voffB); PG8_STAGE(PG8_SA(0, 0), a2, voffA);
            PG8_WAIT_V(8); PG8_WAIT_L(0); PG8_BAR; PG8_MMA(1, 0, At, B0); PG8_MMA(1, 1, At, B1); PG8_BAR; PG8_SCHED;
            PG8_LDB(B0, 1, 0); PG8_LDB(B1, 1, 1); PG8_SCHED; PG8_LDA(At, 1, 0); PG8_STAGE(PG8_SA(0, 1), a2 + hstepA, voffA);
            PG8_WAIT_V(8); PG8_WAIT_L(0); PG8_BAR; PG8_MMA(0, 0, At, B0); PG8_MMA(0, 1, At, B1); PG8_BAR; PG8_SCHED;
            PG8_LDA(At, 1, 1); PG8_STAGE(PG8_SB(1, 0), b3, voffB); PG8_STAGE(PG8_SB(1, 1), b3 + hstepB, voffB); PG8_STAGE(PG8_SA(1, 0), a3, voffA);
            PG8_WAIT_V(8); PG8_WAIT_L(0); PG8_BAR; PG8_MMA(1, 0, At, B0); PG8_MMA(1, 1, At, B1); PG8_BAR; PG8_SCHED;
            } else {
            PG8_LDB(B0, 0, 0); PG8_SCHED; PG8_LDA(At, 0, 0); PG8_STAGE(PG8_SA(1, 1), a1 + hstepA, voffA);
            PG8_WAIT_L(8); PG8_BAR; PG8_WAIT_L(0); PG8_MMA(0, 0, At, B0); PG8_BAR; PG8_SCHED;
            PG8_LDB(B1, 0, 1); PG8_STAGE(PG8_SB(0, 0), b2, voffB);
            PG8_BAR; PG8_WAIT_L(0); PG8_MMA(0, 1, At, B1); PG8_BAR;
            PG8_LDA(At, 0, 1); PG8_STAGE(PG8_SA(0, 0), a2, voffA);
            PG8_BAR; PG8_WAIT_L(0); PG8_MMA(1, 0, At, B0); PG8_BAR; PG8_SCHED;
            PG8_STAGE(PG8_SB(0, 1), b2 + hstepB, voffB);
            PG8_WAIT_V(6); PG8_BAR; PG8_MMA(1, 1, At, B1); PG8_BAR;
            PG8_LDB(B0, 1, 0); PG8_SCHED; PG8_LDA(At, 1, 0); PG8_STAGE(PG8_SA(0, 1), a2 + hstepA, voffA);
            PG8_WAIT_L(8); PG8_BAR; PG8_WAIT_L(0); PG8_MMA(0, 0, At, B0); PG8_BAR; PG8_SCHED;
            PG8_LDB(B1, 1, 1); PG8_STAGE(PG8_SB(1, 0), b3, voffB);
            PG8_BAR; PG8_WAIT_L(0); PG8_MMA(0, 1, At, B1); PG8_BAR;
            PG8_LDA(At, 1, 1); PG8_STAGE(PG8_SA(1, 0), a3, voffA);
            PG8_BAR; PG8_WAIT_L(0); PG8_MMA(1, 0, At, B0); PG8_BAR; PG8_SCHED;
            PG8_STAGE(PG8_SB(1, 1), b3 + hstepB, voffB);
            PG8_WAIT_V(6); PG8_BAR; PG8_MMA(1, 1, At, B1); PG8_BAR;
            }
        }
        if constexpr (ALIGN_EPI) { if (wr == 0) PG8_BAR; }
        if constexpr (!Epi::AFTER_DRAIN) { E(acc, cur, wr, wc, fr, fq); S.done(cur); }
        if (!has_next) break;
#pragma unroll
        for (int a = 0; a < 2; ++a)
#pragma unroll
            for (int b = 0; b < 2; ++b)
#pragma unroll
                for (int m = 0; m < 4; ++m)
#pragma unroll
                    for (int n = 0; n < 2; ++n) acc[a][b][m][n] = (f32x4){0.f, 0.f, 0.f, 0.f};
        cur = nxt; cA = nA; cB = nB; ++ui;
        if constexpr (ALIGN_EPI) { if (wr == 1) PG8_BAR; }
    }
    PG8_WAIT_V(0);
    if constexpr (!ALIGN_EPI) { if (wr == 0) PG8_BAR; }
    PG8_BAR;
    if constexpr (Epi::AFTER_DRAIN) { E.fused(acc, cur, wr, wc, fr, fq, lds, wid, lane); S.done(cur); }
#undef PG8_SA
#undef PG8_SB
#undef PG8_STAGE
#undef PG8_LDA
#undef PG8_LDB
#undef PG8_MMA
#undef PG8_WAIT_V
#undef PG8_WAIT_L
#undef PG8_BAR
#undef PG8_SCHED
}
}

#define DEV __device__ __forceinline__
#define LAS __attribute__((address_space(3)))
typedef unsigned short bf16_t;
typedef short bf16x8 __attribute__((ext_vector_type(8)));
typedef float f32x4 __attribute__((ext_vector_type(4)));
typedef float f32x2 __attribute__((ext_vector_type(2)));
typedef float f32x16 __attribute__((ext_vector_type(16)));
typedef unsigned u32x4 __attribute__((ext_vector_type(4)));
typedef unsigned u32x2 __attribute__((ext_vector_type(2)));

constexpr int R = 16896, RB = 8448, NCTX = 256, TL = 8192, DM = 1024, INW = 1696, DFF = 2816, HFF = 1408;
constexpr int NWG_T = 512;
constexpr float EPS = 1e-6f;
constexpr int LDS_BYTES = 147456;
constexpr size_t OFF_X = 0, OFF_HN = 69206016, OFF_W = 103809024, OFF_MOD = 152174592, OFF_ROPE = 152436736, OFF_OV = 153485312;
constexpr size_t OV_Q = 0, OV_KN = 25952256, OV_VT = 43253760, OV_SLOC = 60555264, OV_SIN = 69206016, OV_U = 0;
constexpr size_t OFF_PART = 250100224;
constexpr size_t OFF_EDGE = 258488832;
constexpr size_t WS_NEED = OFF_EDGE + 5947392;
constexpr size_t W_IN = 0, W_UQ = 1835008, W_KN = 2129920, W_V = 2260992, W_OUT = 2392064, W_UP = 3440640, W_DN = 9207808, W_LAYER = 12091392;

struct Params {
    const float *x, *c, *ctx, *c_ctx, *w_mod, *b_mod, *norm1_g, *w_in, *ret_decay_f, *ret_decay_b, *mla_q_norm_g, *w_uq, *mla_kv_norm_g, *w_ukv,
        *pool_w, *pool_scale, *w_out, *norm2_g, *w_up, *conv_w, *conv_b, *w_down, *final_norm_g;
    float* out; unsigned char* ws; int ph_lo, ph_hi;
};

DEV int otid() { int t = threadIdx.x; asm volatile("" : "+v"(t)); return t; }
DEV float bf2f(unsigned short x) { return __uint_as_float((unsigned)x << 16); }
DEV unsigned f2bf(float f) { unsigned u = __float_as_uint(f); return (u + 0x7fffu + ((u >> 16) & 1u)) >> 16; }
DEV unsigned pk2(float lo, float hi) { return f2bf(lo) | (f2bf(hi) << 16); }
DEV float wave_sum(float v) {
#pragma unroll
    for (int o = 1; o < 64; o <<= 1) v += __shfl_xor(v, o);
    return v;
}
DEV float siluf(float x) { return x * __builtin_amdgcn_rcpf(1.0f + __builtin_amdgcn_exp2f(-1.4426950408889634f * x)); }
DEV int crow(int r, int hi) { return (r & 3) + 8 * (r >> 2) + 4 * hi; }
DEV bf16x8 pack8(float a0, float a1, float a2, float a3, float a4, float a5, float a6, float a7) {
    u32x4 w; w.x = pg8::cvt_pk_bf16(a0, a1); w.y = pg8::cvt_pk_bf16(a2, a3); w.z = pg8::cvt_pk_bf16(a4, a5); w.w = pg8::cvt_pk_bf16(a6, a7);
    return __builtin_bit_cast(bf16x8, w);
}
DEV int row_mi(int r) { const int b = r / RB; const int s = r - b * RB; return s < NCTX ? 2 : b; }

DEV void transpose_item(const float* W, int K, int Nsrc, bf16_t* WT, int n0, int cs, int k0, float* scr, int lane) {
#pragma unroll
    for (int i = 0; i < 32; ++i) { const int kk = 2 * i + (lane >> 5); scr[kk * 33 + (lane & 31)] = cs >= 0 ? W[(size_t)(k0 + kk) * Nsrc + cs + (lane & 31)] : 0.f; }
    asm volatile("s_waitcnt lgkmcnt(0)" ::: "memory");
    const int c = lane & 7;
#pragma unroll
    for (int j = 0; j < 4; ++j) { const int n = (lane >> 3) + 8 * j; const float* s = scr + (8 * c) * 33 + n;
        u32x4 o; o.x = pk2(s[0 * 33], s[1 * 33]); o.y = pk2(s[2 * 33], s[3 * 33]); o.z = pk2(s[4 * 33], s[5 * 33]); o.w = pk2(s[6 * 33], s[7 * 33]);
        *(u32x4*)(WT + (size_t)(n0 + n) * K + k0 + 8 * c) = o; }
    asm volatile("s_waitcnt lgkmcnt(0)" ::: "memory");
}
DEV int map_in(int n0) { return n0 < 1440 ? n0 : (n0 < INW ? -2 : -1); }
DEV int map_kn(int n0) { return (n0 >> 6) * 128 + (n0 & 63); }
DEV int map_v(int n0) { return (n0 >> 6) * 128 + 64 + (n0 & 63); }
DEV int map_up(int n0) { const int pn = n0 >> 8, w = n0 & 255; return w < 128 ? 128 * pn + w : DFF + 128 * pn + (w - 128); }

DEV void phase_prep(const Params& p, unsigned char* lds) {
    const int tid = otid(), lane = tid & 63, wid = tid >> 6;
    unsigned char* ws = p.ws;
    { f32x2* rope = (f32x2*)(ws + OFF_ROPE);
      for (int idx = blockIdx.x * NWG_T + tid; idx < TL * 16; idx += gridDim.x * NWG_T) { const int t = idx >> 4, i = idx & 15; const int pos = i < 8 ? (t >> 6) : (t & 63);
          const float inv = exp2f(-(float)(i & 7) * 0.125f * 13.287712379549449f); const float ang = (float)pos * inv; f32x2 cs; cs.x = __cosf(ang); cs.y = __sinf(ang); rope[idx] = cs; } }
    { float* scv = (float*)lds;
      float* red = scv + 3 * 1024;
      for (int i = tid; i < 3 * 1024; i += NWG_T) { const int v = i >> 10, k = i & 1023; const float cv = v < 2 ? p.c[v * 1024 + k] : p.c_ctx[k]; scv[i] = siluf(cv); }
      __syncthreads();
      float* modv = (float*)(ws + OFF_MOD);
      for (int it = blockIdx.x; it < 192; it += gridDim.x) { const int l = it / 96, col0 = (it % 96) * 64;
          const float* wm = p.w_mod + (size_t)l * 1024 * 6144 + col0 + lane; float a0 = 0.f, a1 = 0.f, a2 = 0.f;
#pragma unroll 16
          for (int k = wid * 128; k < wid * 128 + 128; ++k) { const float w = wm[(size_t)k * 6144]; a0 += scv[k] * w; a1 += scv[1024 + k] * w; a2 += scv[2048 + k] * w; }
          red[(wid * 3 + 0) * 64 + lane] = a0; red[(wid * 3 + 1) * 64 + lane] = a1; red[(wid * 3 + 2) * 64 + lane] = a2;
          __syncthreads();
          if (tid < 192) { const int v = tid >> 6, cl = tid & 63; float s = 0.f;
#pragma unroll
              for (int w = 0; w < 8; ++w) s += red[(w * 3 + v) * 64 + cl];
              modv[((size_t)l * 3 + v) * 6144 + col0 + cl] = s + p.b_mod[l * 6144 + col0 + cl]; }
          __syncthreads(); }
    }
}
DEV void phase_prep_weights(const Params& p, unsigned char* lds) {
    const int tid = otid(), lane = tid & 63, wid = tid >> 6;
    unsigned char* ws = p.ws;
    { float* scr = (float*)(lds + 32768 + wid * 8704);
      const int gw = blockIdx.x * 8 + wid, NGW = gridDim.x * 8;
      constexpr int I_IN = 16 * 56, I_UQ = 6 * 24, I_KN = 4 * 16, I_V = 4 * 16, I_OUT = 16 * 32, I_UP = 16 * 176, I_DN = 44 * 32, I_L = I_IN + I_UQ + I_KN + I_V + I_OUT + I_UP + I_DN;
#define PW_DECODE(it_, SRC, DST, KK, NS, N0, CS, K0) do { const int l = (it_) / I_L; int r = (it_) - l * I_L; bf16_t* wl = (bf16_t*)(ws + OFF_W) + (size_t)l * W_LAYER; int nbn, mp; size_t doff; \
          if (r < I_IN) { SRC = p.w_in + (size_t)l * 1024 * INW; KK = 1024; NS = INW; nbn = 56; mp = 1; doff = W_IN; } \
          else if ((r -= I_IN) < I_UQ) { SRC = p.w_uq + (size_t)l * 384 * 768; KK = 384; NS = 768; nbn = 24; mp = 0; doff = W_UQ; } \
          else if ((r -= I_UQ) < I_KN) { SRC = p.w_ukv + (size_t)l * 256 * 1024; KK = 256; NS = 1024; nbn = 16; mp = 2; doff = W_KN; } \
          else if ((r -= I_KN) < I_V) { SRC = p.w_ukv + (size_t)l * 256 * 1024; KK = 256; NS = 1024; nbn = 16; mp = 3; doff = W_V; } \
          else if ((r -= I_V) < I_OUT) { SRC = p.w_out + (size_t)l * 1024 * 1024; KK = 1024; NS = 1024; nbn = 32; mp = 0; doff = W_OUT; } \
          else if ((r -= I_OUT) < I_UP) { SRC = p.w_up + (size_t)l * 1024 * 5632; KK = 1024; NS = 5632; nbn = 176; mp = 4; doff = W_UP; } \
          else { r -= I_UP; SRC = p.w_down + (size_t)l * DFF * 1024; KK = DFF; NS = 1024; nbn = 32; mp = 0; doff = W_DN; } \
          const int kb = r / nbn, nb = r - kb * nbn; N0 = nb * 32; K0 = kb * 64; DST = wl + doff; \
          CS = mp == 0 ? N0 : mp == 1 ? map_in(N0) : mp == 2 ? map_kn(N0) : mp == 3 ? map_v(N0) : map_up(N0); } while (0)
#define PW_LOAD(RG, SRC, NS, CS, K0) do { _Pragma("unroll") for (int i = 0; i < 32; ++i) { const int kk = 2 * i + (lane >> 5); RG[i] = (CS) >= 0 ? (SRC)[(size_t)((K0) + kk) * (NS) + (CS) + (lane & 31)] : 0.f; } } while (0)
      const float* sA = nullptr; bf16_t* dA = nullptr; int kA = 0, nsA = 0, n0A = 0, csA = -2, k0A = 0; float ra[32];
      int it = gw;
      if (it < 2 * I_L) { PW_DECODE(it, sA, dA, kA, nsA, n0A, csA, k0A); if (csA != -2) PW_LOAD(ra, sA, nsA, csA, k0A); }
      while (it < 2 * I_L) {
          const int itn = it + NGW; const float* sB = nullptr; bf16_t* dB = nullptr; int kB = 0, nsB = 0, n0B = 0, csB = -2, k0B = 0; float rb[32];
          if (itn < 2 * I_L) { PW_DECODE(itn, sB, dB, kB, nsB, n0B, csB, k0B); if (csB != -2) PW_LOAD(rb, sB, nsB, csB, k0B); }
          if (csA != -2) {
#pragma unroll
              for (int i = 0; i < 32; ++i) { const int kk = 2 * i + (lane >> 5); scr[kk * 33 + (lane & 31)] = ra[i]; }
              asm volatile("s_waitcnt lgkmcnt(0)" ::: "memory");
              const int c = lane & 7;
#pragma unroll
              for (int j = 0; j < 4; ++j) { const int n = (lane >> 3) + 8 * j; const float* sp_ = scr + (8 * c) * 33 + n;
                  u32x4 o; o.x = pk2(sp_[0 * 33], sp_[1 * 33]); o.y = pk2(sp_[2 * 33], sp_[3 * 33]); o.z = pk2(sp_[4 * 33], sp_[5 * 33]); o.w = pk2(sp_[6 * 33], sp_[7 * 33]);
                  *(u32x4*)(dA + (size_t)(n0A + n) * kA + k0A + 8 * c) = o; }
              asm volatile("s_waitcnt lgkmcnt(0)" ::: "memory"); }
          sA = sB; dA = dB; kA = kB; nsA = nsB; n0A = n0B; csA = csB; k0A = k0B;
#pragma unroll
          for (int i = 0; i < 32; ++i) ra[i] = rb[i];
          it = itn; }
#undef PW_DECODE
#undef PW_LOAD
    }
    { for (int idx = blockIdx.x * NWG_T + tid; idx < 2 * 1024 * 256; idx += gridDim.x * NWG_T) { const int n = idx & 255, k = (idx >> 8) & 1023, l = idx >> 18; const int g = n >> 6, d = n & 63;
          const float* wr = p.w_in + ((size_t)l * 1024 + k) * INW + 1440 + g * 64; const float* pw = p.pool_w + ((size_t)(l * 4 + g) * 64) * 64 + d; float s = 0.f;
#pragma unroll 8
          for (int c = 0; c < 64; ++c) s += wr[c] * pw[c * 64];
          ((bf16_t*)(ws + OFF_W) + (size_t)l * W_LAYER + W_IN)[(size_t)(1440 + n) * 1024 + k] = (bf16_t)f2bf(s * p.pool_scale[l * 256 + n]); } }
}

DEV void phase_norm(const Params& p, int l, int which, bool first, const float* pgate) {
    const int tid = otid(); const int lane = tid & 63, wid = tid >> 6; const int gw = blockIdx.x * 8 + wid, NGW = gridDim.x * 8;
    float* X = (float*)(p.ws + OFF_X); bf16_t* HN = (bf16_t*)(p.ws + OFF_HN);
    const float* modv = (const float*)(p.ws + OFF_MOD) + (size_t)l * 3 * 6144;
    const float* g = (which == 0 ? p.norm1_g : p.norm2_g) + l * 1024;
    for (int r = gw; r < R; r += NGW) {
        const int b = r / RB, s = r - b * RB; const int mi = s < NCTX ? 2 : b;
        const float* src = first ? (s < NCTX ? p.ctx + ((size_t)b * NCTX + s) * 1024 : p.x + ((size_t)b * TL + (s - NCTX)) * 1024) : X + (size_t)r * 1024;
        const f32x4* xr = (const f32x4*)src + lane; f32x4 v[4]; float ss = 0.f;
#pragma unroll
        for (int j = 0; j < 4; ++j) { v[j] = xr[64 * j]; ss += (v[j].x * v[j].x + v[j].y * v[j].y) + (v[j].z * v[j].z + v[j].w * v[j].w); }
        if (pgate != nullptr && s < NCTX) { const float* PART = (const float*)(p.ws + OFF_PART) + (size_t)(b * NCTX + s) * 1024; ss = 0.f;
#pragma unroll
            for (int j = 0; j < 4; ++j) { const f32x4 gq = ((const f32x4*)pgate)[lane + 64 * j]; f32x4 a = ((const f32x4*)PART)[lane + 64 * j];
#pragma unroll
                for (int q = 1; q < 4; ++q) a = a + ((const f32x4*)(PART + (size_t)q * 524288))[lane + 64 * j];
                v[j] = v[j] + gq * a; ss += (v[j].x * v[j].x + v[j].y * v[j].y) + (v[j].z * v[j].z + v[j].w * v[j].w); } }
        if (first || (pgate != nullptr && s < NCTX)) { f32x4* xo = (f32x4*)(X + (size_t)r * 1024) + lane;
#pragma unroll
            for (int j = 0; j < 4; ++j) xo[64 * j] = v[j]; }
        const float rs = rsqrtf(wave_sum(ss) * (1.f / 1024.f) + EPS);
        const float* mv = modv + mi * 6144 + (which == 0 ? 0 : 3072);
        u32x2* o8 = (u32x2*)(HN + (size_t)r * 1024) + lane;
#pragma unroll
        for (int j = 0; j < 4; ++j) { const f32x4 gg = ((const f32x4*)g)[lane + 64 * j], sh = ((const f32x4*)mv)[lane + 64 * j], sc = ((const f32x4*)(mv + 1024))[lane + 64 * j];
            const f32x4 y = v[j] * rs * gg; const f32x4 h = y * (sc + 1.0f) + sh; u32x2 w; w.x = pk2(h.x, h.y); w.y = pk2(h.z, h.w); o8[64 * j] = w; }
    }
}
DEV void phase_final(const Params& p) {
    const int tid = otid(); const int lane = tid & 63, wid = tid >> 6; const int gw = blockIdx.x * 8 + wid, NGW = gridDim.x * 8;
    const float* X = (const float*)(p.ws + OFF_X);
    for (int q = gw; q < 2 * TL; q += NGW) { const int b = q / TL, t = q - b * TL; const int r = b * RB + NCTX + t;
        const f32x4* xr = (const f32x4*)(X + (size_t)r * 1024) + lane; f32x4 v[4]; float ss = 0.f;
#pragma unroll
        for (int j = 0; j < 4; ++j) { v[j] = xr[64 * j]; ss += (v[j].x * v[j].x + v[j].y * v[j].y) + (v[j].z * v[j].z + v[j].w * v[j].w); }
        const float rs = rsqrtf(wave_sum(ss) * (1.f / 1024.f) + EPS);
        f32x4* o = (f32x4*)(p.out + (size_t)q * 1024) + lane;
#pragma unroll
        for (int j = 0; j < 4; ++j) { const f32x4 gg = ((const f32x4*)p.final_norm_g)[lane + 64 * j]; o[64 * j] = v[j] * rs * gg; } }
}

DEV void phase_rowwise(const Params& p, int l) {
    const int tid = otid(); const int lane = tid & 63, wid = tid >> 6; const int gw = blockIdx.x * 8 + wid, NGW = gridDim.x * 8;
    bf16_t* P = (bf16_t*)p.out; const f32x2* rope = (const f32x2*)(p.ws + OFF_ROPE);
    const float* qg = p.mla_q_norm_g + l * 384; const float* kg = p.mla_kv_norm_g + l * 256;
    float qgv[6];
#pragma unroll
    for (int j = 0; j < 3; ++j) { qgv[2 * j] = qg[2 * (lane + 64 * j)]; qgv[2 * j + 1] = qg[2 * (lane + 64 * j) + 1]; }
    const f32x4 kgv = ((const f32x4*)kg)[lane];
    for (int r0 = gw; r0 < R; r0 += 2 * NGW) {
        unsigned wq[2][3]; u32x2 wk[2]; float x1[2], x2[2]; f32x2 cs[2]; bool val[2], lat[2];
#pragma unroll
        for (int i = 0; i < 2; ++i) { const int r = r0 + i * NGW; val[i] = r < R; const int rr = val[i] ? r : r0; bf16_t* pr = P + (size_t)rr * INW; const int s = rr % RB; lat[i] = s >= NCTX;
            const unsigned* q2 = (const unsigned*)(pr + 768) + lane;
#pragma unroll
            for (int j = 0; j < 3; ++j) wq[i][j] = q2[64 * j];
            wk[i] = *((const u32x2*)(pr + 1152) + lane);
            const int li = lane & 15; x1[i] = bf2f(pr[1408 + li]); x2[i] = bf2f(pr[1408 + 16 + li]); cs[i] = rope[(lat[i] ? s - NCTX : 0) * 16 + li]; }
#pragma unroll
        for (int i = 0; i < 2; ++i) { if (!val[i]) continue; const int r = r0 + i * NGW; bf16_t* pr = P + (size_t)r * INW;
            { float ss = 0.f;
#pragma unroll
              for (int j = 0; j < 3; ++j) { const float a = bf2f(wq[i][j] & 0xffff), c2 = bf2f(wq[i][j] >> 16); ss += a * a + c2 * c2; }
              const float rs = rsqrtf(wave_sum(ss) * (1.f / 384.f) + EPS); unsigned* q2 = (unsigned*)(pr + 768) + lane;
#pragma unroll
              for (int j = 0; j < 3; ++j) q2[64 * j] = pk2(bf2f(wq[i][j] & 0xffff) * rs * qgv[2 * j], bf2f(wq[i][j] >> 16) * rs * qgv[2 * j + 1]); }
            { const float a0 = bf2f(wk[i].x & 0xffff), a1 = bf2f(wk[i].x >> 16), a2 = bf2f(wk[i].y & 0xffff), a3 = bf2f(wk[i].y >> 16);
              const float rs = rsqrtf(wave_sum((a0 * a0 + a1 * a1) + (a2 * a2 + a3 * a3)) * (1.f / 256.f) + EPS);
              u32x2 o; o.x = pk2(a0 * rs * kgv.x, a1 * rs * kgv.y); o.y = pk2(a2 * rs * kgv.z, a3 * rs * kgv.w); *((u32x2*)(pr + 1152) + lane) = o; }
            if (lat[i] && lane < 16) { pr[1408 + lane] = (bf16_t)f2bf(x1[i] * cs[i].x - x2[i] * cs[i].y); pr[1408 + 16 + lane] = (bf16_t)f2bf(x2[i] * cs[i].x + x1[i] * cs[i].y); } }
    }
}

DEV void phase_pool(const Params& p) {
    const int tid = otid(); const bf16_t* P = (const bf16_t*)p.out; bf16_t* MIX = (bf16_t*)(p.ws + OFF_HN);
    for (int idx = blockIdx.x * NWG_T + tid; idx < R * 32; idx += gridDim.x * NWG_T) { const int r = idx >> 5, cg = idx & 31; const int half = 1 << (cg >> 3);
        const int b = r / RB, s = r - b * RB; const int seq0 = s < NCTX ? b * RB : b * RB + NCTX; const int T = s < NCTX ? NCTX : TL; const int t = r - seq0;
        const int lo = max(t - half, 0), hi = min(t + half, T); float sum[8];
#pragma unroll
        for (int j = 0; j < 8; ++j) sum[j] = 0.f;
        const bf16_t* base = P + (size_t)seq0 * INW + 1440 + cg * 8;
        { bf16x8 wv[16]; const bf16x8 zz = {0, 0, 0, 0, 0, 0, 0, 0};
#pragma unroll
          for (int k = 0; k < 16; ++k) { const int tt = t - 8 + k; wv[k] = (tt >= lo && tt < hi) ? *(const bf16x8*)(base + (size_t)tt * INW) : zz; }
#pragma unroll
          for (int k = 0; k < 16; ++k)
#pragma unroll
              for (int j = 0; j < 8; ++j) sum[j] += bf2f((unsigned short)wv[k][j]); }
        const bf16x8 me = *(const bf16x8*)(base + (size_t)t * INW); const float ic = 1.0f / (float)(hi - lo); float o[8];
#pragma unroll
        for (int j = 0; j < 8; ++j) o[j] = sum[j] * ic - bf2f((unsigned short)me[j]);
        *(bf16x8*)(MIX + (size_t)r * 1024 + 768 + cg * 8) = pack8(o[0], o[1], o[2], o[3], o[4], o[5], o[6], o[7]); }
}

DEV float log2_sigmoid(float d) { return -log1pf(__expf(-d)) * 1.4426950408889634f; }
constexpr int ST_P = 272;
DEV void states_item(const Params& p, int l, unsigned char* lds, int it) {
    const int tid = otid(), lane = tid & 63, wid = tid >> 6, l32 = lane & 31, hi = lane >> 5;
    const bf16_t* P = (const bf16_t*)p.out; const f32x2* rope = (const f32x2*)(p.ws + OFF_ROPE);
    float* SLOC = (float*)(p.ws + OFF_OV + OV_SLOC);
    const int gc = it >> 1, hp = it & 1;
    unsigned char* VTl = lds;
    unsigned char* KTl = lds + 2 * 64 * ST_P;
    const int cb = gc % 66; const bool lat = cb >= 2; const int t0 = (cb - 2) * 128; const int r0 = gc * 128;
    __syncthreads();
    { const int tok = tid >> 2, hh = (tid >> 1) & 1, c = tid & 1; const int h = 2 * hp + hh;
      const bf16_t* src = P + (size_t)(r0 + tok) * INW + 128 + h * 32 + 8 * c; const bf16x8 lo = *(const bf16x8*)src, hi8 = *(const bf16x8*)(src + 16);
      const float df = exp2f(log2_sigmoid(p.ret_decay_f[l * 4 + h]) * (float)(127 - tok)) * 0.17677669529663687f, db = exp2f(log2_sigmoid(p.ret_decay_b[l * 4 + h]) * (float)tok) * 0.17677669529663687f;
#pragma unroll
      for (int j = 0; j < 8; ++j) { float x1 = bf2f((unsigned short)lo[j]), x2 = bf2f((unsigned short)hi8[j]);
          if (lat) { const f32x2 cs = rope[(t0 + tok) * 16 + 8 * c + j]; const float y1 = x1 * cs.x - x2 * cs.y, y2 = x2 * cs.x + x1 * cs.y; x1 = y1; x2 = y2; }
          bf16_t* kf = (bf16_t*)(KTl + ((hh * 2 + 0) * 32 + 8 * c + j) * ST_P) + tok; bf16_t* kb = (bf16_t*)(KTl + ((hh * 2 + 1) * 32 + 8 * c + j) * ST_P) + tok;
          kf[0] = (bf16_t)f2bf(x1 * df); kb[0] = (bf16_t)f2bf(x1 * db);
          *(bf16_t*)((unsigned char*)kf + 16 * ST_P) = (bf16_t)f2bf(x2 * df); *(bf16_t*)((unsigned char*)kb + 16 * ST_P) = (bf16_t)f2bf(x2 * db); } }
    for (int task = tid; task < 2048; task += NWG_T) { const int hh = task >> 10, tok = (task >> 3) & 127, ch = task & 7;
        const bf16x8 v = *(const bf16x8*)(P + (size_t)(r0 + tok) * INW + 256 + (2 * hp + hh) * 64 + ch * 8);
#pragma unroll
        for (int j = 0; j < 8; ++j) *((bf16_t*)(VTl + (hh * 64 + ch * 8 + j) * ST_P) + tok) = (bf16_t)v[j]; }
    __syncthreads();
    { const int hh = wid >> 2, dir = (wid >> 1) & 1, dvb = wid & 1; const int h = 2 * hp + hh;
      const unsigned char* ap = VTl + (hh * 64 + 32 * dvb + l32) * ST_P + hi * 16; const unsigned char* bp = KTl + ((hh * 2 + dir) * 32 + l32) * ST_P + hi * 16;
      bf16x8 af[8], bfr[8];
#pragma unroll
      for (int ks = 0; ks < 8; ++ks) { af[ks] = *(const bf16x8*)(ap + ks * 32); bfr[ks] = *(const bf16x8*)(bp + ks * 32); }
      f32x16 acc;
#pragma unroll
      for (int r = 0; r < 16; ++r) acc[r] = 0.f;
#pragma unroll
      for (int ks = 0; ks < 8; ++ks) acc = __builtin_amdgcn_mfma_f32_32x32x16_bf16(af[ks], bfr[ks], acc, 0, 0, 0);
      float* o = SLOC + ((size_t)(gc * 4 + h) * 2 + dir) * 2048 + l32 * 64 + 32 * dvb + 4 * hi;
#pragma unroll
      for (int g4 = 0; g4 < 4; ++g4) *(f32x4*)(o + 8 * g4) = (f32x4){acc[4 * g4], acc[4 * g4 + 1], acc[4 * g4 + 2], acc[4 * g4 + 3]}; }
}
DEV void scan_threads(const Params& p, int l, int gid) {
    if (gid >= 32768) return;
    const int e = gid & 2047, dir = (gid >> 11) & 1, h = (gid >> 12) & 3, b = gid >> 14;
    const float* SLOC = (const float*)(p.ws + OFF_OV + OV_SLOC); float* SIN = (float*)(p.ws + OFF_OV + OV_SIN);
    const float gC = exp2f(log2_sigmoid((dir == 0 ? p.ret_decay_f : p.ret_decay_b)[l * 4 + h]) * 128.f);
    float S = 0.f;
#pragma unroll 11
    for (int st = 0; st < 66; ++st) { const int cb = dir == 0 ? st : (st < 2 ? 1 - st : 67 - st); const size_t idx = ((size_t)((b * 66 + cb) * 4 + h) * 2 + dir) * 2048 + e;
        const float v = SLOC[idx]; SIN[idx] = S; S = S * gC + v; }
}

constexpr int AT_KP = 208, AT_VP = 144, AT_KB = 64 * AT_KP, AT_VBS = 64 * AT_VP, AT_V0 = 4 * AT_KB;
DEV float at_max32(const f32x16& s0, const f32x16& s1) {
    float m0 = __builtin_fmaxf(__builtin_fmaxf(s0[0], s0[1]), s0[2]), m1 = __builtin_fmaxf(__builtin_fmaxf(s1[0], s1[1]), s1[2]);
    m0 = __builtin_fmaxf(__builtin_fmaxf(m0, s0[3]), s0[4]); m1 = __builtin_fmaxf(__builtin_fmaxf(m1, s1[3]), s1[4]);
    m0 = __builtin_fmaxf(__builtin_fmaxf(m0, s0[5]), s0[6]); m1 = __builtin_fmaxf(__builtin_fmaxf(m1, s1[5]), s1[6]);
    m0 = __builtin_fmaxf(__builtin_fmaxf(m0, s0[7]), s0[8]); m1 = __builtin_fmaxf(__builtin_fmaxf(m1, s1[7]), s1[8]);
    m0 = __builtin_fmaxf(__builtin_fmaxf(m0, s0[9]), s0[10]); m1 = __builtin_fmaxf(__builtin_fmaxf(m1, s1[9]), s1[10]);
    m0 = __builtin_fmaxf(__builtin_fmaxf(m0, s0[11]), s0[12]); m1 = __builtin_fmaxf(__builtin_fmaxf(m1, s1[11]), s1[12]);
    m0 = __builtin_fmaxf(__builtin_fmaxf(m0, s0[13]), s0[14]); m1 = __builtin_fmaxf(__builtin_fmaxf(m1, s1[13]), s1[14]);
    return __builtin_fmaxf(__builtin_fmaxf(m0, s0[15]), __builtin_fmaxf(m1, s1[15]));
}
DEV void attn_unit(const Params& p, unsigned char* lds, int u) {
    const int tid = otid(), lane = tid & 63, wid = tid >> 6, l32 = lane & 31, hi = lane >> 5;
    const bf16_t* Q = (const bf16_t*)(p.ws + OFF_OV + OV_Q); const bf16_t* KN = (const bf16_t*)(p.ws + OFF_OV + OV_KN); const bf16_t* VT = (const bf16_t*)(p.ws + OFF_OV + OV_VT);
    const bf16_t* P = (const bf16_t*)p.out; bf16_t* MIX = (bf16_t*)(p.ws + OFF_HN); const f32x2* rope = (const f32x2*)(p.ws + OFF_ROPE);
    const bool isctx = u >= 512; int b, h, qrow0, NT;
    if (!isctx) { b = u >> 8; h = (u >> 5) & 7; qrow0 = b * RB + NCTX + (u & 31) * 256; NT = 132; } else { const int v = u - 512; b = v >> 3; h = v & 7; qrow0 = b * RB; NT = 4; }
    const int krow0 = b * RB; const int qrow = qrow0 + wid * 32 + l32;
    bf16x8 qf[6];
    { const bf16_t* qp = Q + (size_t)qrow * 768 + h * 96 + hi * 8;
#pragma unroll
      for (int d0 = 0; d0 < 6; ++d0) qf[d0] = *(const bf16x8*)(qp + d0 * 16);
      if (!isctx) { const f32x2* rp = rope + (size_t)(qrow - (b * RB + NCTX)) * 16 + hi * 8;
#pragma unroll
          for (int j = 0; j < 8; ++j) { const f32x2 cs = rp[j]; const float x1 = bf2f((unsigned short)qf[4][j]), x2 = bf2f((unsigned short)qf[5][j]);
              qf[4][j] = (short)f2bf(x1 * cs.x - x2 * cs.y); qf[5][j] = (short)f2bf(x2 * cs.x + x1 * cs.y); } } }
    const bf16_t* sp[3]; int sstep[3], lo[3];
#pragma unroll
    for (int k = 0; k < 2; ++k) { const int c = tid + k * 512; const int key = c / 12, part = c - key * 12; lo[k] = key * AT_KP + part * 16;
        if (part < 8) { sp[k] = KN + (size_t)(krow0 + key) * 512 + h * 64 + part * 8; sstep[k] = 64 * 512; } else { sp[k] = P + (size_t)(krow0 + key) * INW + 1408 + (part - 8) * 8; sstep[k] = 64 * INW; } }
    { const int dv = tid >> 3, kc = tid & 7; lo[2] = dv * AT_VP + (kc >> 1) * 32 + (kc & 1) * 8;   sp[2] = VT + (size_t)(h * 64 + dv) * R + krow0 + kc * 8; sstep[2] = 64; }
    const bool hasK2 = tid < 256;
    u32x4 st[3];
#define AT_GLOADK() do { st[0] = *(const u32x4*)sp[0]; sp[0] += sstep[0]; if (hasK2) { st[1] = *(const u32x4*)sp[1]; sp[1] += sstep[1]; } } while (0)
#define AT_GLOADV() do { st[2] = *(const u32x4*)sp[2]; sp[2] += sstep[2]; } while (0)
#define AT_LSTOREK(buf) do { *(u32x4*)((buf) + lo[0]) = st[0]; if (hasK2) *(u32x4*)((buf) + lo[1]) = st[1]; } while (0)
#define AT_LSTOREV(buf) do { unsigned char* d_ = (buf) + lo[2]; *(u32x2*)d_ = (u32x2){st[2].x, st[2].y}; *(u32x2*)(d_ + 16) = (u32x2){st[2].z, st[2].w}; } while (0)
#define AT_SB() __builtin_amdgcn_sched_barrier(0)
    f32x16 o0, o1, sa0, sa1, sb0, sb1, negm;
#pragma unroll
    for (int r = 0; r < 16; ++r) { o0[r] = 0.f; o1[r] = 0.f; sa0[r] = 0.f; sa1[r] = 0.f; negm[r] = 0.f; }
    float mrun = 0.f, lsum = 0.f;
    __syncthreads();
    AT_GLOADK(); AT_GLOADV(); AT_LSTOREK(lds); AT_LSTOREV(lds + AT_V0);
    AT_GLOADK(); AT_GLOADV(); AT_LSTOREK(lds + AT_KB); AT_LSTOREV(lds + AT_V0 + AT_VBS);
    AT_GLOADK(); AT_LSTOREK(lds + 2 * AT_KB);
    __syncthreads();
    { const unsigned char* ka = lds + l32 * AT_KP + hi * 16;
#pragma unroll
      for (int d0 = 0; d0 < 6; ++d0) { const bf16x8 a0 = *(const bf16x8*)(ka + d0 * 32), a1 = *(const bf16x8*)(ka + 32 * AT_KP + d0 * 32);
          sa0 = __builtin_amdgcn_mfma_f32_32x32x16_bf16(a0, qf[d0], sa0, 0, 0, 0); sa1 = __builtin_amdgcn_mfma_f32_32x32x16_bf16(a1, qf[d0], sa1, 0, 0, 0); } }
#define AT_QKM(SB0, SB1, i) do { if ((i) == 0) SB0 = __builtin_amdgcn_mfma_f32_32x32x16_bf16(kfr[0], qf[0], negm, 0, 0, 0); else if ((i) == 1) SB1 = __builtin_amdgcn_mfma_f32_32x32x16_bf16(kfr[1], qf[0], negm, 0, 0, 0); \
        else if ((i) & 1) SB1 = __builtin_amdgcn_mfma_f32_32x32x16_bf16(kfr[(i)], qf[(i) >> 1], SB1, 0, 0, 0); else SB0 = __builtin_amdgcn_mfma_f32_32x32x16_bf16(kfr[(i)], qf[(i) >> 1], SB0, 0, 0, 0); } while (0)
#define AT_EXS(acc, SA0, SA1, e) do { if ((e) < 16) { SA0[(e) & 15] = __builtin_amdgcn_exp2f(SA0[(e) & 15]); acc += SA0[(e) & 15]; } else { SA1[(e) & 15] = __builtin_amdgcn_exp2f(SA1[(e) & 15]); acc += SA1[(e) & 15]; } } while (0)
#define AT_PACK(dst, S, r0) dst = pack8(S[(r0) + 0], S[(r0) + 1], S[(r0) + 2], S[(r0) + 3], S[(r0) + 4], S[(r0) + 5], S[(r0) + 6], S[(r0) + 7])
#define AT_MAX4(m0, m1, SB0, SB1, r0) do { m0 = __builtin_fmaxf(__builtin_fmaxf(m0, SB0[(r0) + 0]), SB0[(r0) + 1]); m1 = __builtin_fmaxf(__builtin_fmaxf(m1, SB1[(r0) + 0]), SB1[(r0) + 1]); \
        m0 = __builtin_fmaxf(__builtin_fmaxf(m0, SB0[(r0) + 2]), SB0[(r0) + 3]); m1 = __builtin_fmaxf(__builtin_fmaxf(m1, SB1[(r0) + 2]), SB1[(r0) + 3]); } while (0)
#define AT_STEP(SA0, SA1, SB0, SB1, tt) do { \
        const int t_ = (tt); const bool nxt_ = t_ + 1 < NT; \
        const unsigned char* kb_ = lds + ((t_ + 1) & 3) * AT_KB; const unsigned char* vb_ = lds + AT_V0 + (t_ & 3) * AT_VBS; \
        if (t_ + 3 < NT) AT_GLOADK(); \
        if (t_ + 2 < NT) AT_GLOADV(); \
        bf16x8 kfr[12]; bf16x8 vfr[8]; \
        { const unsigned char* ka = kb_ + l32 * AT_KP + hi * 16; \
          _Pragma("unroll") for (int d0 = 0; d0 < 6; ++d0) { kfr[2 * d0] = *(const bf16x8*)(ka + d0 * 32); kfr[2 * d0 + 1] = *(const bf16x8*)(ka + 32 * AT_KP + d0 * 32); } } \
        { const float mx = mxc; \
          if (t_ == 0 || __any(mx > 8.0f)) { \
              const float rm = fmaxf(mx, __shfl_xor(mx, 32)); const float delta = (t_ == 0) ? rm : fmaxf(rm, 0.f); const float alpha = (t_ == 0) ? 1.0f : __builtin_amdgcn_exp2f(-delta); \
              mrun += delta; \
              _Pragma("unroll") for (int r = 0; r < 16; ++r) { SA0[r] -= delta; SA1[r] -= delta; o0[r] *= alpha; o1[r] *= alpha; } \
              lsum *= alpha; { const float nm = -mrun; _Pragma("unroll") for (int r = 0; r < 16; ++r) negm[r] = nm; } } } \
        float ls0 = 0.f, ls1 = 0.f; \
        AT_SB(); __builtin_amdgcn_s_setprio(1); \
          \
        _Pragma("unroll") for (int i = 0; i < 8; ++i) { \
            AT_QKM(SB0, SB1, i); \
            _Pragma("unroll") for (int k_ = 0; k_ < 3; ++k_) { const int e_ = 3 * i + k_; if (e_ < 16) { SA0[e_ & 15] = __builtin_amdgcn_exp2f(SA0[e_ & 15]); asm volatile("" : "+v"(SA0[e_ & 15])); } else { SA1[e_ & 15] = __builtin_amdgcn_exp2f(SA1[e_ & 15]); asm volatile("" : "+v"(SA1[e_ & 15])); } } \
            AT_SB(); } \
        { const unsigned char* va = vb_ + l32 * AT_VP + hi * 16; \
          _Pragma("unroll") for (int kj = 0; kj < 4; ++kj) { vfr[2 * kj] = *(const bf16x8*)(va + kj * 32); vfr[2 * kj + 1] = *(const bf16x8*)(va + 32 * AT_VP + kj * 32); } } \
        bf16x8 pb[4]; \
        _Pragma("unroll") for (int i = 8; i < 12; ++i) { \
            AT_QKM(SB0, SB1, i); \
            _Pragma("unroll") for (int k_ = 0; k_ < 2; ++k_) { const int e_ = 24 + 2 * (i - 8) + k_; SA1[e_ & 15] = __builtin_amdgcn_exp2f(SA1[e_ & 15]); asm volatile("" : "+v"(SA1[e_ & 15])); } \
            if (i == 9) { AT_PACK(pb[0], SA0, 0); asm volatile("" : "+v"(pb[0])); } \
            if (i == 11) { AT_PACK(pb[1], SA0, 8); asm volatile("" : "+v"(pb[1])); } \
            AT_SB(); } \
        float mq0 = SB0[0], mq1 = SB1[0]; __builtin_amdgcn_s_setprio(2); \
        _Pragma("unroll") for (int kj = 0; kj < 4; ++kj) { \
            o0 = __builtin_amdgcn_mfma_f32_32x32x16_bf16(vfr[2 * kj], pb[kj], o0, 0, 0, 0); o1 = __builtin_amdgcn_mfma_f32_32x32x16_bf16(vfr[2 * kj + 1], pb[kj], o1, 0, 0, 0); \
            if (kj == 0) { AT_PACK(pb[2], SA1, 0); asm volatile("" : "+v"(pb[2])); } \
            if (kj == 1) { AT_PACK(pb[3], SA1, 8); asm volatile("" : "+v"(pb[3])); } \
            if (kj == 2) { if (t_ + 3 < NT) AT_LSTOREK(lds + ((t_ + 3) & 3) * AT_KB); if (t_ + 2 < NT) AT_LSTOREV(lds + AT_V0 + ((t_ + 2) & 3) * AT_VBS); }     \
            _Pragma("unroll") for (int r_ = 0; r_ < 4; ++r_) { ls0 += SA0[4 * kj + r_]; ls1 += SA1[4 * kj + r_]; } \
            mq0 = __builtin_fmaxf(__builtin_fmaxf(mq0, SB0[4 * kj]), SB0[4 * kj + 1]); mq1 = __builtin_fmaxf(__builtin_fmaxf(mq1, SB1[4 * kj]), SB1[4 * kj + 1]); \
            mq0 = __builtin_fmaxf(__builtin_fmaxf(mq0, SB0[4 * kj + 2]), SB0[4 * kj + 3]); mq1 = __builtin_fmaxf(__builtin_fmaxf(mq1, SB1[4 * kj + 2]), SB1[4 * kj + 3]); \
            asm volatile("" : "+v"(mq0), "+v"(mq1), "+v"(ls0), "+v"(ls1)); AT_SB(); } \
        lsum += ls0 + ls1; \
        __builtin_amdgcn_s_setprio(0); mxc = __builtin_fmaxf(mq0, mq1);            \
        if (t_ & 1) __syncthreads(); \
    } while (0)
    float mxc = at_max32(sa0, sa1);
    for (int t = 0; t < NT; t += 2) { AT_STEP(sa0, sa1, sb0, sb1, t); AT_STEP(sb0, sb1, sa0, sa1, t + 1); }
    lsum += __shfl_xor(lsum, 32);
    const float inv = 1.0f / lsum;
    bf16_t* op = MIX + (size_t)qrow * 1024 + 256 + h * 64 + 4 * hi;
#pragma unroll
    for (int g4 = 0; g4 < 4; ++g4) { u32x2 w0, w1; w0.x = pk2(o0[4 * g4] * inv, o0[4 * g4 + 1] * inv); w0.y = pk2(o0[4 * g4 + 2] * inv, o0[4 * g4 + 3] * inv);
        w1.x = pk2(o1[4 * g4] * inv, o1[4 * g4 + 1] * inv); w1.y = pk2(o1[4 * g4 + 2] * inv, o1[4 * g4 + 3] * inv);
        *(u32x2*)(op + 8 * g4) = w0; *(u32x2*)(op + 32 + 8 * g4) = w1; }
#undef AT_GLOADK
#undef AT_GLOADV
#undef AT_LSTOREK
#undef AT_LSTOREV
#undef AT_STEP
#undef AT_QKM
#undef AT_EXS
#undef AT_PACK
#undef AT_MAX4
#undef AT_SB
}

constexpr int RT_VP = 264, RT_SP = 144, RT_VB = 2 * 64 * RT_VP;
DEV void retout_unit(const Params& p, int l, unsigned char* lds, int u, bool early) {
    const int tid = otid(), lane = tid & 63, wid = tid >> 6, l32 = lane & 31, hi = lane >> 5;
    const int gc = u >> 1, hp = u & 1; const int cb = gc % 66; const bool lat = cb >= 2; const int t0 = (cb - 2) * 128; const int r0 = gc * 128;
    const bf16_t* P = (const bf16_t*)p.out; bf16_t* MIX = (bf16_t*)(p.ws + OFF_HN); const f32x2* rope = (const f32x2*)(p.ws + OFF_ROPE);
    const float* SIN = (const float*)(p.ws + OFF_OV + OV_SIN);
    bf16_t* VTl = (bf16_t*)lds; bf16_t* STl = (bf16_t*)(lds + RT_VB);
    const int hh = wid >> 2, h = 2 * hp + hh, qblk = wid & 3; const int n = 32 * qblk + l32; const int rq = r0 + n;
    bf16x8 qra, qrc, kga[4], kgc[4];
    { const bf16_t* qp = P + (size_t)rq * INW + h * 32 + 8 * hi; qra = *(const bf16x8*)qp; qrc = *(const bf16x8*)(qp + 16);
#pragma unroll
      for (int kb = 0; kb < 4; ++kb) { const bf16_t* kp = P + (size_t)(r0 + 32 * kb + l32) * INW + 128 + h * 32 + 8 * hi; kga[kb] = *(const bf16x8*)kp; kgc[kb] = *(const bf16x8*)(kp + 16); } }
    __syncthreads();
    for (int task = tid; task < 2048; task += NWG_T) { const int hh = task >> 10, key = (task >> 3) & 127, ch = task & 7;
        const bf16x8 v = *(const bf16x8*)(P + (size_t)(r0 + key) * INW + 256 + (2 * hp + hh) * 64 + ch * 8);
#pragma unroll
        for (int j = 0; j < 8; ++j) VTl[(hh * 64 + ch * 8 + j) * (RT_VP / 2) + key] = (bf16_t)v[j]; }
    for (int task = tid; task < 8192; task += NWG_T) { const int dv = task & 63, k = (task >> 6) & 31, dir = (task >> 11) & 1, hh = task >> 12;
        float sv;
        if (!early) sv = SIN[((size_t)(gc * 4 + 2 * hp + hh) * 2 + dir) * 2048 + k * 64 + dv];
        else { const int og = dir == 0 ? gc - 1 : gc + 1; const bool zero = dir == 0 ? (cb == 0) : (cb == 1);
               sv = zero ? 0.f : ((const float*)(p.ws + OFF_OV + OV_SLOC))[((size_t)(og * 4 + 2 * hp + hh) * 2 + dir) * 2048 + k * 64 + dv]; }
        STl[(hh * 64 + dv) * (RT_SP / 2) + dir * 32 + k] = (bf16_t)f2bf(sv); }
    __syncthreads();
    const float lf = log2_sigmoid(p.ret_decay_f[l * 4 + h]), lb = log2_sigmoid(p.ret_decay_b[l * 4 + h]);
    float qv0[8], qv1[8]; bf16x8 qf0, qf1;
    { const bf16x8 a = qra, c2 = qrc;
#pragma unroll
      for (int j = 0; j < 8; ++j) { float x1 = bf2f((unsigned short)a[j]), x2 = bf2f((unsigned short)c2[j]);
          if (lat) { const f32x2 cs = rope[(size_t)(t0 + n) * 16 + 8 * hi + j]; const float y1 = x1 * cs.x - x2 * cs.y, y2 = x2 * cs.x + x1 * cs.y; x1 = y1; x2 = y2; }
          qv0[j] = x1; qv1[j] = x2; }
      qf0 = pack8(qv0[0], qv0[1], qv0[2], qv0[3], qv0[4], qv0[5], qv0[6], qv0[7]); qf1 = pack8(qv1[0], qv1[1], qv1[2], qv1[3], qv1[4], qv1[5], qv1[6], qv1[7]); }
    f32x16 o0, o1;
#pragma unroll
    for (int r = 0; r < 16; ++r) { o0[r] = 0.f; o1[r] = 0.f; }
    const unsigned char* vbase = (const unsigned char*)VTl + (size_t)(hh * 64 + l32) * RT_VP + hi * 8;
#pragma unroll
    for (int kb = 0; kb < 4; ++kb) {
        bf16x8 kf0, kf1;
        { const int key = 32 * kb + l32; const bf16x8 a = kga[kb], c2 = kgc[kb];
          float y1[8], y2[8];
#pragma unroll
          for (int j = 0; j < 8; ++j) { float x1 = bf2f((unsigned short)a[j]), x2 = bf2f((unsigned short)c2[j]);
              if (lat) { const f32x2 cs = rope[(size_t)(t0 + key) * 16 + 8 * hi + j]; const float z1 = x1 * cs.x - x2 * cs.y, z2 = x2 * cs.x + x1 * cs.y; x1 = z1; x2 = z2; }
              y1[j] = x1 * 0.17677669529663687f; y2[j] = x2 * 0.17677669529663687f; }
          kf0 = pack8(y1[0], y1[1], y1[2], y1[3], y1[4], y1[5], y1[6], y1[7]); kf1 = pack8(y2[0], y2[1], y2[2], y2[3], y2[4], y2[5], y2[6], y2[7]); }
        f32x16 s;
#pragma unroll
        for (int r = 0; r < 16; ++r) s[r] = 0.f;
        s = __builtin_amdgcn_mfma_f32_32x32x16_bf16(kf0, qf0, s, 0, 0, 0); s = __builtin_amdgcn_mfma_f32_32x32x16_bf16(kf1, qf1, s, 0, 0, 0);
#pragma unroll
        for (int r = 0; r < 16; ++r) { const int m = 32 * kb + crow(r, hi); const int dl = n - m; const float e = dl >= 0 ? lf * (float)dl : lb * (float)(-dl); s[r] *= __builtin_amdgcn_exp2f(e); }
#pragma unroll
        for (int jp = 0; jp < 2; ++jp) { const bf16x8 pb = pack8(s[8 * jp + 0], s[8 * jp + 1], s[8 * jp + 2], s[8 * jp + 3], s[8 * jp + 4], s[8 * jp + 5], s[8 * jp + 6], s[8 * jp + 7]);
            const unsigned char* vp = vbase + (32 * kb + 16 * jp) * 2;
            const u32x2 a00 = *(const u32x2*)vp, a01 = *(const u32x2*)(vp + 16), a10 = *(const u32x2*)(vp + 32 * RT_VP), a11 = *(const u32x2*)(vp + 32 * RT_VP + 16);
            const bf16x8 A0 = __builtin_bit_cast(bf16x8, (u32x4){a00.x, a00.y, a01.x, a01.y}), A1 = __builtin_bit_cast(bf16x8, (u32x4){a10.x, a10.y, a11.x, a11.y});
            o0 = __builtin_amdgcn_mfma_f32_32x32x16_bf16(A0, pb, o0, 0, 0, 0); o1 = __builtin_amdgcn_mfma_f32_32x32x16_bf16(A1, pb, o1, 0, 0, 0); }
    }
    { const float df = __builtin_amdgcn_exp2f(lf * (float)(n + 1)), db = __builtin_amdgcn_exp2f(lb * (float)(128 - n));
      const unsigned char* sbase = (const unsigned char*)STl + (size_t)(hh * 64 + l32) * RT_SP + hi * 16;
#pragma unroll
      for (int ks = 0; ks < 4; ++ks) { const float dd = ks < 2 ? df : db;
          const bf16x8 qb = (ks & 1) ? pack8(qv1[0] * dd, qv1[1] * dd, qv1[2] * dd, qv1[3] * dd, qv1[4] * dd, qv1[5] * dd, qv1[6] * dd, qv1[7] * dd)
                                     : pack8(qv0[0] * dd, qv0[1] * dd, qv0[2] * dd, qv0[3] * dd, qv0[4] * dd, qv0[5] * dd, qv0[6] * dd, qv0[7] * dd);
          const bf16x8 A0 = *(const bf16x8*)(sbase + ks * 32), A1 = *(const bf16x8*)(sbase + 32 * RT_SP + ks * 32);
          o0 = __builtin_amdgcn_mfma_f32_32x32x16_bf16(A0, qb, o0, 0, 0, 0); o1 = __builtin_amdgcn_mfma_f32_32x32x16_bf16(A1, qb, o1, 0, 0, 0); } }
    float ssq = 0.f;
#pragma unroll
    for (int r = 0; r < 16; ++r) ssq += o0[r] * o0[r] + o1[r] * o1[r];
    ssq += __shfl_xor(ssq, 32);
    const float rstd = rsqrtf(ssq * (1.f / 64.f) + EPS);
    const bf16_t* gp = P + (size_t)rq * INW + 512 + h * 64 + 4 * hi; bf16_t* op = MIX + (size_t)rq * 1024 + h * 64 + 4 * hi;
#pragma unroll
    for (int g4 = 0; g4 < 4; ++g4) { const u32x2 ga = *(const u32x2*)(gp + 8 * g4), gb = *(const u32x2*)(gp + 32 + 8 * g4);
        u32x2 w0, w1;
        w0.x = pk2(o0[4 * g4] * rstd * siluf(bf2f(ga.x & 0xffff)), o0[4 * g4 + 1] * rstd * siluf(bf2f(ga.x >> 16))); w0.y = pk2(o0[4 * g4 + 2] * rstd * siluf(bf2f(ga.y & 0xffff)), o0[4 * g4 + 3] * rstd * siluf(bf2f(ga.y >> 16)));
        w1.x = pk2(o1[4 * g4] * rstd * siluf(bf2f(gb.x & 0xffff)), o1[4 * g4 + 1] * rstd * siluf(bf2f(gb.x >> 16))); w1.y = pk2(o1[4 * g4 + 2] * rstd * siluf(bf2f(gb.y & 0xffff)), o1[4 * g4 + 3] * rstd * siluf(bf2f(gb.y >> 16)));
        *(u32x2*)(op + 8 * g4) = w0; *(u32x2*)(op + 32 + 8 * g4) = w1; }
}

DEV void phase_ffn_fixup(const Params& p, int l) {
    const float* EDGE = (const float*)(p.ws + OFF_EDGE); bf16_t* ACT = (bf16_t*)(p.ws + OFF_OV);
    const float* cw = p.conv_w + (size_t)l * 3 * 5632; const float* cbv = p.conv_b + (size_t)l * 5632;
    for (int idx = blockIdx.x * NWG_T + otid(); idx < 66 * 2 * 704; idx += gridDim.x * NWG_T) {
        const int ch4 = idx % 704, rest = idx / 704; const int which = rest & 1, pm = rest >> 1; const int jj = pm % 33;
        if (l == 1 && jj == 0) continue;
        const int ch = 4 * ch4, pn = ch >> 7, c = ch & 127;
        const bool sstart = jj <= 1, send = (jj == 0) || (jj == 32);
        const f32x4 zz = {0.f, 0.f, 0.f, 0.f};
#define EDG(tile, k, half) (*(const f32x4*)(EDGE + ((size_t)((tile) * 4 + (k)) * 22 + pn) * 256 + (half) * 128 + c))
        f32x4 ua, ub, ca, cb2, da, db;
        if (which == 0) { ua = sstart ? zz : EDG(pm - 1, 3, 0); ub = sstart ? zz : EDG(pm - 1, 3, 1); ca = EDG(pm, 0, 0); cb2 = EDG(pm, 0, 1); da = EDG(pm, 1, 0); db = EDG(pm, 1, 1); }
        else { ua = EDG(pm, 2, 0); ub = EDG(pm, 2, 1); ca = EDG(pm, 3, 0); cb2 = EDG(pm, 3, 1); da = send ? zz : EDG(pm + 1, 0, 0); db = send ? zz : EDG(pm + 1, 0, 1); }
#undef EDG
        const f32x4 wa0 = *(const f32x4*)(cw + ch), wa1 = *(const f32x4*)(cw + 5632 + ch), wa2 = *(const f32x4*)(cw + 2 * 5632 + ch), ba = *(const f32x4*)(cbv + ch);
        const f32x4 wb0 = *(const f32x4*)(cw + DFF + ch), wb1 = *(const f32x4*)(cw + 5632 + DFF + ch), wb2 = *(const f32x4*)(cw + 2 * 5632 + DFF + ch), bb = *(const f32x4*)(cbv + DFF + ch);
        const f32x4 xa = wa0 * ua + wa1 * ca + wa2 * da + ba, xb = wb0 * ub + wb1 * cb2 + wb2 * db + bb;
        u32x2 w; w.x = pk2(siluf(xa.x) * xb.x, siluf(xa.y) * xb.y); w.y = pk2(siluf(xa.z) * xb.z, siluf(xa.w) * xb.w);
        *(u32x2*)(ACT + (size_t)(pm * 256 + (which ? 255 : 0)) * DFF + ch) = w;
    }
}

#define RLX_AGENT __ATOMIC_RELAXED, __HIP_MEMORY_SCOPE_AGENT
#define XB_TMO      128
#define XB_XCNT(j)  (256  + 64 * (j))
#define XB_XSUB(j)  (1280 + 64 * (j))
#define XB_XGEN(j)  (2304 + 64 * (j))
#define XB_TOP      3328
#define XB_TOPGEN   3392
#define XCD_BAR_WORDS 3456
#define XB_SPIN_CAP (1u << 18)

__device__ __forceinline__ unsigned xb_ld(unsigned* p)              { return __hip_atomic_load(p, __ATOMIC_RELAXED, __HIP_MEMORY_SCOPE_AGENT); }
__device__ __forceinline__ unsigned xb_add(unsigned* p, unsigned v) { return __hip_atomic_fetch_add(p, v, __ATOMIC_RELAXED, __HIP_MEMORY_SCOPE_AGENT); }
__device__ __forceinline__ unsigned xb_xcc_id() { return (unsigned)__builtin_amdgcn_s_getreg((3 << 11) | 20) & 0xFu; }
#define XB_SPIN(cond, bar) do { unsigned _sp = 0; while (cond) { __builtin_amdgcn_s_sleep(1); \
    if ((++_sp & 255u) == 0u) { if (xb_ld(&(bar)[XB_TMO])) break; if (_sp > XB_SPIN_CAP) { atomicAdd(&(bar)[XB_TMO], 1u); break; } } } } while (0)

struct XcdBarrier {
    unsigned* bar; unsigned x;
    volatile LAS unsigned* st;
};

__device__ __forceinline__ XcdBarrier xcd_barrier_post(unsigned* bar, volatile LAS unsigned* st) {
    XcdBarrier b; b.bar = bar; b.x = xb_xcc_id(); b.st = st;
    if (threadIdx.x == 0) (void)xb_add(&bar[XB_XCNT(b.x)], 1u);
    return b;
}
__device__ __forceinline__ void xcd_barrier_complete(unsigned* bar, unsigned x, unsigned& nloc, unsigned& nx) {
    const unsigned G = gridDim.x * gridDim.y * gridDim.z;
    unsigned sum, cnt, mine, sp = 0u;
    for (;;) {
        sum = 0u; cnt = 0u; mine = 0u;
#pragma unroll
        for (unsigned j = 0; j < 16; ++j) { const unsigned c = xb_ld(&bar[XB_XCNT(j)]); sum += c; cnt += (c > 0u) ? 1u : 0u; mine = (j == x) ? c : mine; }
        if (sum == G) break;
        __builtin_amdgcn_s_sleep(1);
        if ((++sp & 255u) == 0u) { if (xb_ld(&bar[XB_TMO])) break; if (sp > XB_SPIN_CAP) { atomicAdd(&bar[XB_TMO], 1u); break; } }
    }
    nloc = mine > 0u ? mine : 1u; nx = cnt > 0u ? cnt : 1u;
}

__device__ __forceinline__ void xcd_barrier(const XcdBarrier& b) {
    asm volatile("s_waitcnt vmcnt(0)" ::: "memory");
    __syncthreads();
    if (threadIdx.x == 0) {
        unsigned* bar = b.bar;
        __builtin_amdgcn_s_waitcnt(0);
        unsigned nloc = b.st[0], nx = b.st[1];
        if (nloc == 0u) { xcd_barrier_complete(bar, b.x, nloc, nx); b.st[0] = nloc; b.st[1] = nx; }
        const unsigned old = xb_add(&bar[XB_XSUB(b.x)], 1u);
        const unsigned gen = old / nloc;
        if (old + 1u == (gen + 1u) * nloc) {
            __builtin_amdgcn_fence(__ATOMIC_RELEASE, "agent");
            asm volatile("s_waitcnt vmcnt(0)" ::: "memory");
            const unsigned og = xb_add(&bar[XB_TOP], 1u);
            const unsigned tg = og / nx;
            if (og + 1u == (tg + 1u) * nx) xb_add(&bar[XB_TOPGEN], 1u);
            else XB_SPIN(xb_ld(&bar[XB_TOPGEN]) == tg, bar);
            __builtin_amdgcn_fence(__ATOMIC_ACQUIRE, "agent");
            xb_add(&bar[XB_XGEN(b.x)], 1u);
            asm volatile("s_waitcnt vmcnt(0)" ::: "memory");
        } else {
            XB_SPIN(xb_ld(&bar[XB_XGEN(b.x)]) == gen, bar);
            __builtin_amdgcn_fence(__ATOMIC_ACQUIRE, "agent");
            asm volatile("s_waitcnt vmcnt(0)" ::: "memory");
        }
    }
    __syncthreads();
}


constexpr size_t OFF_CTL = 250000128; constexpr int CTL_BYTES = 16384;
#if defined(__HIP_DEVICE_COMPILE__)
#define KP() const __attribute__((address_space(4))) Params* kp_ = (const __attribute__((address_space(4))) Params*)__builtin_amdgcn_kernarg_segment_ptr(); asm volatile("" : "+s"(kp_)); const Params p = *kp_; \
    bf16_t* HN = (bf16_t*)(p.ws + OFF_HN); bf16_t* P = (bf16_t*)p.out; float* X = (float*)(p.ws + OFF_X); (void)HN; (void)P; (void)X
#else
#define KP() const Params p = p_arg; bf16_t* HN = (bf16_t*)(p.ws + OFF_HN); bf16_t* P = (bf16_t*)p.out; float* X = (float*)(p.ws + OFF_X); (void)HN; (void)P; (void)X
#endif
#define WL() const bf16_t* wl = (const bf16_t*)(p.ws + OFF_W) + (size_t)l * W_LAYER; const float* modv = (const float*)(p.ws + OFF_MOD) + (size_t)l * 3 * 6144; (void)wl; (void)modv
#ifndef DUPM
#define DUPM 0
#endif
#define REP(bit) for (int rep_ = 0; rep_ < (((DUPM) >> (bit)) & 1) + 1; ++rep_)
constexpr int PH_PER_LAYER = 10, N_PHASES = 2 + 2 * PH_PER_LAYER;
__global__ void __launch_bounds__(512, 2) mk_fwd(Params p_arg) {
    extern __shared__ __attribute__((aligned(16))) unsigned char lds[];
    cg::grid_group grid = cg::this_grid();
    const int G = gridDim.x, bx = blockIdx.x; const int vcu = (G % 8 == 0) ? (bx % 8) * (G / 8) + bx / 8 : bx;
    LAS unsigned char* ldsl = (LAS unsigned char*)lds;
    const int ph_lo = p_arg.ph_lo, ph_hi = p_arg.ph_hi;
    volatile LAS unsigned* misc = (volatile LAS unsigned*)(ldsl + (LDS_BYTES - 64));
    { const int t0_ = otid(); if (t0_ < 16) misc[t0_] = 0u; }
    __syncthreads();
    if (ph_hi - ph_lo > 1) (void)xcd_barrier_post((unsigned*)(p_arg.ws + OFF_CTL), misc);
    for (int ph = ph_lo; ph < ph_hi; ++ph) {
        if (ph == 0) { KP(); phase_prep(p, lds); __syncthreads(); }
        else if (ph == N_PHASES - 1) { KP(); phase_final(p);
#if (DUPM >> 10) & 1
            for (int i = 0; i < 20; ++i) grid.sync();
#endif
        }
        else {
            const int l = (ph - 1) / PH_PER_LAYER, sp = (ph - 1) % PH_PER_LAYER;
            if (sp == 0) { KP(); if (l == 0) REP(9) { phase_prep_weights(p, lds); __syncthreads(); }
                phase_norm(p, l, 0, l == 0, l == 1 ? (const float*)(p.ws + OFF_MOD) + 2 * 6144 + 5120 : nullptr); }
            else if (sp == 1) { KP(); WL(); REP(1) { __syncthreads();
                pg8::Gemm g{HN, wl + W_IN, R, 1792, 1024, 1024, 1024}; pg8::StaticOrder S; S.init(R, 1792, G, bx);
                pg8::EpiStore E{P, INW, INW, 1.0f};
                pg8::gemm_phase<pg8::EpiStore, pg8::StaticOrder, true, true>(ldsl, g, S, E); } }
            else if (sp == 2) { KP(); phase_rowwise(p, l); __syncthreads();
                REP(2) phase_pool(p);
                REP(3) for (int it = G - 1 - bx; it < 264; it += G) states_item(p, l, lds, it); __syncthreads(); }
            else if (sp == 3) { KP(); WL(); REP(4) { __syncthreads();
                { pg8::Gemm g{P + 768, wl + W_UQ, R, 768, 384, INW, 384}; pg8::StaticOrder S; S.init(R, 768, G, bx);
                  pg8::EpiStore E{(bf16_t*)(p.ws + OFF_OV + OV_Q), 768, 768, 0.14724444f};
                  pg8::gemm_phase<pg8::EpiStore, pg8::StaticOrder, true, true>(ldsl, g, S, E); }
                __syncthreads();
                { pg8::Gemm g{P + 1152, wl + W_KN, R, 512, 256, INW, 256}; pg8::StaticOrder S; S.init(R, 512, G, (bx + 58) % G);
                  pg8::EpiStore E{(bf16_t*)(p.ws + OFF_OV + OV_KN), 512, 512, 1.0f};
                  pg8::gemm_phase<pg8::EpiStore, pg8::StaticOrder, true, true>(ldsl, g, S, E); }
                __syncthreads();
                { pg8::Gemm g{wl + W_V, P + 1152, 512, R, 256, 256, INW}; pg8::StaticOrder S; S.init(512, R, G, (bx + 182) % G);
                  pg8::EpiStore E{(bf16_t*)(p.ws + OFF_OV + OV_VT), R, R, 1.0f};
                  pg8::gemm_phase<pg8::EpiStore, pg8::StaticOrder, true, true>(ldsl, g, S, E); }
                if (bx >= G - 64) scan_threads(p, l, (bx - (G - 64)) * NWG_T + otid());
                if (l == 0 && bx >= G - 50 && bx < G - 42) { const int i8 = bx - (G - 50); const int gcs = (i8 >> 1) < 2 ? (i8 >> 1) : 64 + (i8 >> 1); retout_unit(p, l, lds, gcs * 2 + (i8 & 1), true); } } }
            else if (sp == 4) { KP();
                REP(5) for (int u = vcu; u < (l == 0 ? 528 : 512); u += G) attn_unit(p, lds, u);
                REP(6) for (int u = G - 1 - bx; u < 256; u += G) retout_unit(p, l, lds, u + 4 * (u >> 7) + 4, false); }
            else if (sp == 5) { KP(); WL(); __syncthreads();
                { pg8::Gemm g{HN, wl + W_OUT, R, 1024, 1024, 1024, 1024}; pg8::StaticOrder S; S.init(16384, 1024, G, bx, 1);
                  pg8::EpiResid E{X, modv + 2048, 0};
                  pg8::gemm_phase<pg8::EpiResid, pg8::StaticOrder, true, true>(ldsl, g, S, E); }
                if (l == 0 && bx < 32) { __syncthreads(); const int q = bx >> 3;
                  pg8::Gemm g{HN + q * 256, wl + W_OUT + q * 256, 512, 1024, 256, 1024, 1024}; pg8::StaticOrder S; S.init(512, 1024, G, bx & 7, 2);
                  pg8::EpiPart E{(float*)(p.ws + OFF_PART) + (size_t)q * 524288, 0};
                  pg8::gemm_phase<pg8::EpiPart, pg8::StaticOrder, true, true>(ldsl, g, S, E); } }
            else if (sp == 6) { KP(); WL(); phase_norm(p, l, 1, false, l == 0 ? modv + 2 * 6144 + 2048 : nullptr); }
            else if (sp == 7) { KP(); WL(); REP(7) { __syncthreads();
                pg8::Gemm g{HN, wl + W_UP, R, 2 * DFF, 1024, 1024, 1024}; pg8::StaticOrder S; S.init(l == 1 ? 16384 : R, 2 * DFF, G, bx, l == 1 ? 1 : 0);
                pg8::EpiFfn E{(bf16_t*)(p.ws + OFF_OV), (float*)(p.ws + OFF_EDGE), p.conv_w + (size_t)l * 3 * 5632, p.conv_b + (size_t)l * 5632, (LAS float*)(ldsl + 131072)};
                pg8::gemm_phase<pg8::EpiFfn, pg8::StaticOrder, true, true>(ldsl, g, S, E); } }
            else if (sp == 8) { KP(); REP(8) phase_ffn_fixup(p, l); }
            else if (sp == 9) { KP(); WL(); __syncthreads();
                { pg8::Gemm g{(const bf16_t*)(p.ws + OFF_OV), wl + W_DN, R, 1024, DFF, DFF, DFF}; pg8::StaticOrder S; S.init(16384, 1024, G, bx, 1);
                  pg8::EpiResid E{X, modv + 5120, 0};
                  pg8::gemm_phase<pg8::EpiResid, pg8::StaticOrder, true, true>(ldsl, g, S, E); }
                if (l == 0 && bx < 32) { __syncthreads(); const int q = bx >> 3; const int koff = q < 2 ? q * 768 : 1536 + (q - 2) * 640, klen = q < 2 ? 768 : 640;
                  pg8::Gemm g{(const bf16_t*)(p.ws + OFF_OV) + koff, wl + W_DN + koff, 512, 1024, klen, DFF, DFF}; pg8::StaticOrder S; S.init(512, 1024, G, bx & 7, 2);
                  pg8::EpiPart E{(float*)(p.ws + OFF_PART) + (size_t)q * 524288, 0};
                  pg8::gemm_phase<pg8::EpiPart, pg8::StaticOrder, true, true>(ldsl, g, S, E); } }
        }
        if (ph + 1 < ph_hi) {
            if (ph_lo < 0) grid.sync();
            { KP(); XcdBarrier b; b.bar = (unsigned*)(p.ws + OFF_CTL); b.x = xb_xcc_id(); b.st = misc; xcd_barrier(b); }
        }
    }
}

extern "C" void kernel_launch(void* const* d_in, const int* in_sizes, int n_in, void* d_out, int out_size, void* d_ws, size_t ws_size, hipStream_t stream) {
    static int grid = 0;
    if (grid == 0) {
        if (n_in != 23 || ws_size < WS_NEED) { fprintf(stderr, "kernel_launch: unexpected problem (n_in %d, ws %zu, need %zu)\n", n_in, ws_size, (size_t)WS_NEED); grid = -1; return; }
        int dev = 0, cus = 0, per_cu = 0;
        hipGetDevice(&dev); hipDeviceGetAttribute(&cus, hipDeviceAttributeMultiprocessorCount, dev);
        if (hipFuncSetAttribute((const void*)mk_fwd, hipFuncAttributeMaxDynamicSharedMemorySize, LDS_BYTES) != hipSuccess) { fprintf(stderr, "kernel_launch: hipFuncSetAttribute failed\n"); grid = -1; return; }
        if (hipOccupancyMaxActiveBlocksPerMultiprocessor(&per_cu, (const void*)mk_fwd, 512, LDS_BYTES) != hipSuccess || per_cu < 1) { fprintf(stderr, "kernel_launch: occupancy query says %d\n", per_cu); per_cu = 1; }
        (void)hipGetLastError();
        grid = cus * per_cu; if (grid > 256) grid = 256;
        fprintf(stderr, "kernel_launch: grid %d (cus %d, per_cu %d)\n", grid, cus, per_cu);
    }
    if (grid < 0) return;
    Params p{};
    const float** pp = (const float**)&p;
    for (int i = 0; i < 23; ++i) pp[i] = (const float*)d_in[i];
    p.out = (float*)d_out; p.ws = (unsigned char*)d_ws;
#if MK_MULTI
    for (int ph = 0; ph < N_PHASES; ++ph) { p.ph_lo = ph; p.ph_hi = ph + 1; void* args[] = {&p};
        hipError_t e = hipLaunchCooperativeKernel((void*)mk_fwd, dim3(grid), dim3(512), args, LDS_BYTES, stream);
        if (e != hipSuccess) { fprintf(stderr, "launch %d failed: %s\n", ph, hipGetErrorString(e)); break; } }
#else
    if (hipMemsetAsync((char*)d_ws + OFF_CTL, 0, CTL_BYTES, stream) != hipSuccess) { fprintf(stderr, "kernel_launch: memset of the barrier words failed\n"); return; }
    p.ph_lo = 0; p.ph_hi = N_PHASES; void* args[] = {&p};
    hipError_t e = hipLaunchCooperativeKernel((void*)mk_fwd, dim3(grid), dim3(512), args, LDS_BYTES, stream);
    if (e != hipSuccess) fprintf(stderr, "cooperative launch failed: %s (grid %d)\n", hipGetErrorString(e), grid);
#endif
}
```
